# Optimizing an MI355X kernel written in HIP

```python
import jax, jax.numpy as jnp
from jax import lax
import numpy as np

D_MODEL = 1024
BATCH = 16
SEQ = 2048
DEPTH = 2

GRID_W = 64
CTX_LEN = 256
EPS = 1e-6
N_MOD = 6

HEAD_DIM = 128
N_HEADS = 8
N_KV_HEADS = 2
GQA_GROUP = N_HEADS // N_KV_HEADS
Q_BLOCK = 128
ROPE_THETA = 10000.0
CONV_WIDTH = 512
CONV_KERNEL = 31
FNET_GROUPS = 4
FNET_GROUP_DIM = 128
FNET_WIDTH = FNET_GROUPS * FNET_GROUP_DIM
N_BRANCHES = 3
N_EXPERTS = 32
TOP_K = 4
D_FF = D_MODEL
SWIGLU_LIMIT = 7.0
SWIGLU_ALPHA = 1.702

Q_DIM = N_HEADS * HEAD_DIM
KV_DIM = N_KV_HEADS * HEAD_DIM
OFF_Q = 0
OFF_K = OFF_Q + Q_DIM
OFF_V = OFF_K + KV_DIM
OFF_CONV = OFF_V + KV_DIM
OFF_FNET = OFF_CONV + 2 * CONV_WIDTH
OFF_GATE = OFF_FNET + FNET_WIDTH
IN_COLS = OFF_GATE + N_BRANCHES * D_MODEL

kernel_name = "hybrid_gated_attn_conv_fnet_moe_dit"


def _rms(x, g):
    xf = x.astype(jnp.float32)
    y = xf * lax.rsqrt(jnp.mean(xf * xf, axis=-1, keepdims=True) + EPS)
    return (y * g.astype(jnp.float32)).astype(x.dtype)


def _layernorm(x, g, b):
    xf = x.astype(jnp.float32)
    mu = jnp.mean(xf, axis=-1, keepdims=True)
    xc = xf - mu
    var = jnp.mean(xc * xc, axis=-1, keepdims=True)
    y = xc * lax.rsqrt(var + EPS) * g.astype(jnp.float32) + b.astype(jnp.float32)
    return y.astype(x.dtype)


def _modulate(h, shift, scale):
    return h * (1 + scale[:, None, :]) + shift[:, None, :]


def _rope_tables(rows, dtype):
    row = jnp.repeat(jnp.arange(rows, dtype=jnp.float32), GRID_W)
    col = jnp.tile(jnp.arange(GRID_W, dtype=jnp.float32), rows)
    n_freq = HEAD_DIM // 4
    inv_freq = ROPE_THETA ** (-jnp.arange(n_freq, dtype=jnp.float32) / n_freq)
    ang_r = row[:, None] * inv_freq[None, :]
    ang_c = col[:, None] * inv_freq[None, :]
    ang = jnp.concatenate([ang_r, ang_r, ang_c, ang_c], axis=-1)
    return jnp.cos(ang).astype(dtype), jnp.sin(ang).astype(dtype)


def _rot_half_axial(t):
    ts = t.reshape(t.shape[:-1] + (2, 2, HEAD_DIM // 4))
    ts = jnp.stack([-ts[..., 1, :], ts[..., 0, :]], axis=-2)
    return ts.reshape(t.shape)


def _rope(t, cos, sin):
    return t * cos[:, None, :] + _rot_half_axial(t) * sin[:, None, :]


def _kv_heads(ukv, kn_g):
    b, l, _ = ukv.shape
    k = _rms(ukv[..., :KV_DIM].reshape(b, l, N_KV_HEADS, HEAD_DIM), kn_g)
    v = ukv[..., KV_DIM:].reshape(b, l, N_KV_HEADS, HEAD_DIM)
    return k, v


def _qkv_heads(u, qn_g, kn_g):
    b, l, _ = u.shape
    q = _rms(u[..., OFF_Q:OFF_K].reshape(b, l, N_HEADS, HEAD_DIM), qn_g)
    k, v = _kv_heads(u[..., OFF_K:OFF_CONV], kn_g)
    return q, k, v


def _attend(q, k, v, q_block):
    b, lq = q.shape[:2]
    nblk = lq // q_block
    qb = jnp.moveaxis(q.reshape(b, nblk, q_block, N_KV_HEADS, GQA_GROUP, HEAD_DIM), 1, 0)
    scale = HEAD_DIM ** -0.5

    def one_block(qi):
        s = jnp.einsum('bqkgd,bskd->bkgqs', qi, k, preferred_element_type=jnp.float32) * scale
        p = jax.nn.softmax(s, axis=-1).astype(v.dtype)
        return jnp.einsum('bkgqs,bskd->bqkgd', p, v)

    o = lax.map(one_block, qb)
    return jnp.moveaxis(o, 0, 1).reshape(b, lq, Q_DIM)


def _dwconv(h, w, bias):
    pad = CONV_KERNEL // 2
    y = lax.conv_general_dilated(h, w[:, None, :].astype(h.dtype), window_strides=(1,),
                                 padding=[(pad, pad)], dimension_numbers=('NWC', 'WIO', 'NWC'),
                                 feature_group_count=h.shape[-1])
    return y + bias


def _conv_branch(u, dw_w, dw_b, ln_g, ln_b, w_o):
    a, g = jnp.split(u, 2, axis=-1)
    h = a * jax.nn.sigmoid(g)
    h = _dwconv(h, dw_w, dw_b)
    h = jax.nn.silu(_layernorm(h, ln_g, ln_b))
    return h @ w_o


def _fnet_branch(u, w_o):
    b, l, _ = u.shape
    ug = u.reshape(b, l, FNET_GROUPS, FNET_GROUP_DIM).astype(jnp.float32)
    f = jnp.fft.fft2(ug, axes=(1, 3), norm='ortho').real.astype(u.dtype)
    return f.reshape(b, l, FNET_WIDTH) @ w_o


def _token_mixer(u, q, k, v, q_block, w_attn_o, conv_dw_w, conv_dw_b, conv_ln_g, conv_ln_b,
                 w_conv_o, w_fnet_o, w_out):
    b, l, _ = u.shape
    y_attn = _attend(q, k, v, q_block) @ w_attn_o
    y_conv = _conv_branch(u[..., OFF_CONV:OFF_FNET], conv_dw_w, conv_dw_b, conv_ln_g, conv_ln_b, w_conv_o)
    y_fnet = _fnet_branch(u[..., OFF_FNET:OFF_GATE], w_fnet_o)
    gates = jax.nn.sigmoid(u[..., OFF_GATE:IN_COLS].reshape(b, l, N_BRANCHES, D_MODEL))
    merged = gates[..., 0, :] * y_attn + gates[..., 1, :] * y_conv + gates[..., 2, :] * y_fnet
    return merged @ w_out


def _moe(h, router_w, router_b, w_gate, b_gate, w_up, b_up, w_down, b_down):
    b, l, d = h.shape
    t = h.reshape(b * l, d)
    logits = (t @ router_w + router_b).astype(jnp.float32)
    top_v, top_i = lax.top_k(logits, TOP_K)
    probs = jax.nn.softmax(top_v, axis=-1)
    combine = jnp.sum(jax.nn.one_hot(top_i, N_EXPERTS, dtype=jnp.float32) * probs[..., None], axis=1)
    out = jnp.zeros(t.shape, jnp.float32)
    for e in range(N_EXPERTS):
        g = jnp.minimum(t @ w_gate[e] + b_gate[e], SWIGLU_LIMIT)
        up = jnp.clip(t @ w_up[e] + b_up[e], -SWIGLU_LIMIT, SWIGLU_LIMIT)
        y = ((up + 1) * (g * jax.nn.sigmoid(SWIGLU_ALPHA * g))) @ w_down[e] + b_down[e]
        out = out + combine[:, e:e + 1] * y
    return out.astype(h.dtype).reshape(b, l, d)


def setup_inputs(seed: int = 0) -> dict:
    key = jax.random.key(seed)
    ks = jax.random.split(key, 29)

    def nrm(k, shape, s):
        return jax.random.normal(k, shape, jnp.float32) * s

    L = DEPTH
    return {
        "x": nrm(ks[0], (BATCH, SEQ, D_MODEL), 1.0),
        "c": nrm(ks[1], (BATCH, D_MODEL), 1.0),
        "ctx": nrm(ks[2], (BATCH, CTX_LEN, D_MODEL), 1.0),
        "c_ctx": nrm(ks[3], (D_MODEL,), 1.0),
        "w_ada": nrm(ks[4], (L, D_MODEL, N_MOD * D_MODEL), 0.5 * D_MODEL ** -0.5),
        "b_ada": nrm(ks[5], (L, N_MOD * D_MODEL), 0.02),
        "g_pre_mix": 1.0 + nrm(ks[6], (L, D_MODEL), 0.02),
        "g_post_mix": 1.0 + nrm(ks[7], (L, D_MODEL), 0.02),
        "g_pre_ffn": 1.0 + nrm(ks[8], (L, D_MODEL), 0.02),
        "g_post_ffn": 1.0 + nrm(ks[9], (L, D_MODEL), 0.02),
        "w_in": nrm(ks[10], (L, D_MODEL, IN_COLS), D_MODEL ** -0.5),
        "q_norm_g": 1.0 + nrm(ks[11], (L, HEAD_DIM), 0.02),
        "k_norm_g": 1.0 + nrm(ks[12], (L, HEAD_DIM), 0.02),
        "w_attn_o": nrm(ks[13], (L, Q_DIM, D_MODEL), Q_DIM ** -0.5),
        "conv_dw_w": nrm(ks[14], (L, CONV_KERNEL, CONV_WIDTH), CONV_KERNEL ** -0.5),
        "conv_dw_b": nrm(ks[15], (L, CONV_WIDTH), 0.02),
        "conv_ln_g": 1.0 + nrm(ks[16], (L, CONV_WIDTH), 0.02),
        "conv_ln_b": nrm(ks[17], (L, CONV_WIDTH), 0.02),
        "w_conv_o": nrm(ks[18], (L, CONV_WIDTH, D_MODEL), CONV_WIDTH ** -0.5),
        "w_fnet_o": nrm(ks[19], (L, FNET_WIDTH, D_MODEL), FNET_WIDTH ** -0.5),
        "w_out": nrm(ks[20], (L, D_MODEL, D_MODEL), D_MODEL ** -0.5),
        "router_w": nrm(ks[21], (L, D_MODEL, N_EXPERTS), D_MODEL ** -0.5),
        "router_b": nrm(ks[22], (L, N_EXPERTS), 0.01),
        "w_gate": nrm(ks[23], (L, N_EXPERTS, D_MODEL, D_FF), D_MODEL ** -0.5),
        "b_gate": nrm(ks[24], (L, N_EXPERTS, D_FF), 0.01),
        "w_up": nrm(ks[25], (L, N_EXPERTS, D_MODEL, D_FF), D_MODEL ** -0.5),
        "b_up": nrm(ks[26], (L, N_EXPERTS, D_FF), 0.01),
        "w_down": nrm(ks[27], (L, N_EXPERTS, D_FF, D_MODEL), D_FF ** -0.5),
        "b_down": nrm(ks[28], (L, N_EXPERTS, D_MODEL), 0.01),
    }


def reference(x, c, ctx, c_ctx, w_ada, b_ada, g_pre_mix, g_post_mix, g_pre_ffn, g_post_ffn,
              w_in, q_norm_g, k_norm_g, w_attn_o, conv_dw_w, conv_dw_b, conv_ln_g, conv_ln_b,
              w_conv_o, w_fnet_o, w_out, router_w, router_b, w_gate, b_gate, w_up, b_up,
              w_down, b_down):
    rows = x.shape[1] // GRID_W
    cos, sin = _rope_tables(rows, x.dtype)
    silu_c = jax.nn.silu(c)
    silu_cc = jax.nn.silu(c_ctx)[None, :]
    xl, xc = x, ctx
    for l in range(DEPTH):
        last = l == DEPTH - 1
        mod_l = (silu_c @ w_ada[l] + b_ada[l]).reshape(-1, N_MOD, D_MODEL)
        mod_c = (silu_cc @ w_ada[l] + b_ada[l]).reshape(1, N_MOD, D_MODEL)
        mix_p = (w_attn_o[l], conv_dw_w[l], conv_dw_b[l], conv_ln_g[l], conv_ln_b[l],
                 w_conv_o[l], w_fnet_o[l], w_out[l])
        moe_p = (router_w[l], router_b[l], w_gate[l], b_gate[l], w_up[l], b_up[l],
                 w_down[l], b_down[l])

        hl = _modulate(_rms(xl, g_pre_mix[l]), mod_l[:, 0], mod_l[:, 1])
        hc = _modulate(_rms(xc, g_pre_mix[l]), mod_c[:, 0], mod_c[:, 1])
        if last:
            kc, vc = _kv_heads(hc @ w_in[l][:, OFF_K:OFF_CONV], k_norm_g[l])
        else:
            uc = hc @ w_in[l]
            qc, kc, vc = _qkv_heads(uc, q_norm_g[l], k_norm_g[l])
        ul = hl @ w_in[l]
        ql, kl, vl = _qkv_heads(ul, q_norm_g[l], k_norm_g[l])
        ql, kl = _rope(ql, cos, sin), _rope(kl, cos, sin)
        k_all = jnp.concatenate([kl, kc], axis=1)
        v_all = jnp.concatenate([vl, vc], axis=1)
        mix_l = _token_mixer(ul, ql, k_all, v_all, Q_BLOCK, *mix_p)
        xl_new = xl + mod_l[:, 2][:, None, :] * _rms(mix_l, g_post_mix[l])
        if not last:
            mix_c = _token_mixer(uc, qc, kc, vc, CTX_LEN, *mix_p)
            xc = xc + mod_c[:, 2][:, None, :] * _rms(mix_c, g_post_mix[l])
        xl = xl_new

        hl = _modulate(_rms(xl, g_pre_ffn[l]), mod_l[:, 3], mod_l[:, 4])
        if last:
            yl = _moe(hl, *moe_p)
        else:
            hc = _modulate(_rms(xc, g_pre_ffn[l]), mod_c[:, 3], mod_c[:, 4])
            y = _moe(jnp.concatenate([hc, hl], axis=1), *moe_p)
            yc, yl = y[:, :xc.shape[1]], y[:, xc.shape[1]:]
            xc = xc + mod_c[:, 5][:, None, :] * _rms(yc, g_post_ffn[l])
        xl = xl + mod_l[:, 5][:, None, :] * _rms(yl, g_post_ffn[l])
    return xl
```

```cpp
#include <hip/hip_runtime.h>
#include <cstdio>
#include <cstdint>
#ifndef MK_PER_PHASE
#define MK_PER_PHASE 0
#endif
namespace pg8 {
#define PG8_LAS __attribute__((address_space(3)))
typedef unsigned short bf16_t;
typedef short bf16x8 __attribute__((ext_vector_type(8)));
typedef float f32x4 __attribute__((ext_vector_type(4)));
typedef unsigned u32x4 __attribute__((ext_vector_type(4)));
constexpr int BM = 256, BK = 64, HALF = 128, HTB = HALF * BK * 2  , STAGE_BYTES = 8 * HTB, NXCD = 8, WGM = 8;

__host__ __device__ __forceinline__ int lds_byte(int r, int c) { const int st = (r >> 4) * 2 + (c >> 5), rr = r & 15, cc = c & 31, ob = rr * 64 + cc * 2; return st * 1024 + (ob ^ (((ob >> 9) & 1) << 5)); }
__host__ __device__ __forceinline__ void stage_rc(int b, int& R, int& C) { const int st = b / 1024, sb = b % 1024, swz = sb ^ (((sb >> 9) & 1) << 5); R = (st >> 1) * 16 + swz / 64; C = (st & 1) * 32 + (swz % 64) / 2; }
__host__ __device__ __forceinline__ int perm32(int rho) { const int n = rho >> 4, i = rho & 15; return 8 * (i >> 2) + 4 * n + (i & 3); }

struct Unit { int pm, pn; };
struct Gemm { const bf16_t* A; const bf16_t* Bt; int M, N, K; };

struct StaticOrder {
    int nM, nN, nwg, G, c;
    __host__ __device__ void init(int M, int N, int G_, int c_) { nM = M / BM; nN = N / BM; nwg = nM * nN; G = G_; c = c_; }
    __host__ __device__ bool next(int i, Unit& u) const {
        const long L = (long)i * G + c; if (L >= nwg) return false;
        int wgid = (int)L; { const int q = nwg / NXCD, r = nwg % NXCD, xcd = wgid % NXCD, off = wgid / NXCD; wgid = (xcd < r ? xcd * (q + 1) : r * (q + 1) + (xcd - r) * q) + off; }
        const int nig = WGM * nN, gid = wgid / nig, fm = gid * WGM, gsz = (nM - fm) < WGM ? (nM - fm) : WGM;
        u.pm = fm + ((wgid % nig) % gsz); u.pn = (wgid % nig) / gsz; return true;
    }
    __device__ __forceinline__ void a_ready(const Unit&) const {}
    __device__ __forceinline__ void done(const Unit&) const {}
};

typedef __bf16 bf16x2_native __attribute__((ext_vector_type(2)));
typedef float f32x2_native __attribute__((ext_vector_type(2)));
__device__ __forceinline__ unsigned cvt_pk_bf16(float lo, float hi) { const f32x2_native v = {lo, hi}; const bf16x2_native r = __builtin_convertvector(v, bf16x2_native); return __builtin_bit_cast(unsigned, r); }
typedef float f32x2 __attribute__((ext_vector_type(2)));
__device__ __forceinline__ f32x2 gelu_pk(f32x2 v) {
    const f32x2 av = __builtin_elementwise_abs(v), d = av * 0.2316418882f + 1.0f;
    f32x2 t; t.x = __builtin_amdgcn_rcpf(d.x); t.y = __builtin_amdgcn_rcpf(d.y);
    f32x2 q = t * 0.5307027145f + (-0.7265760135f); q = q * t + 0.7107068705f; q = q * t + (-0.142248368f); q = q * t + 0.127414796f; q = q * t;
    const f32x2 s = (v * v) * (-0.72134752044f);
    f32x2 e; e.x = __builtin_amdgcn_exp2f(s.x); e.y = __builtin_amdgcn_exp2f(s.y);
    const f32x2 m = v * (q * e), r = v - m;
    f32x2 o; o.x = v.x < 0.f ? m.x : r.x; o.y = v.y < 0.f ? m.y : r.y; return o;
}

template <int ACT  > struct EpiBf16 {
    static constexpr bool PERM = true, AFTER_DRAIN = false; static_assert(ACT == 0 || ACT == 1, "EpiBf16: ACT is 0 (none) or 1 (gelu_pk)");
    bf16_t* O; int ldc; const float* bias; int split_cols; size_t split_stride; float scale0;
    __device__ __forceinline__ void operator()(const f32x4 (&acc)[2][2][4][2], const Unit& u, int wr, int wc, int fr, int fq) const {
        const int row0 = u.pm * BM + wr * 64 + fr; int colt = u.pn * BM; bf16_t* base = O;
        float sc = 1.f; if (split_cols) { const int t = colt / split_cols; base += (size_t)t * split_stride; colt -= t * split_cols; if (t == 0) sc = scale0; }
        const int col0 = colt + wc * 32 + 8 * fq, bcol0 = u.pn * BM + wc * 32 + 8 * fq;
        f32x4 bv[2][2];
#pragma unroll
        for (int bj = 0; bj < 2; ++bj)
#pragma unroll
            for (int n = 0; n < 2; ++n) bv[bj][n] = bias ? *(const f32x4*)(bias + bcol0 + bj * HALF + 4 * n) : (f32x4){0.f, 0.f, 0.f, 0.f};
#pragma unroll
        for (int ai = 0; ai < 2; ++ai)
#pragma unroll
            for (int m = 0; m < 4; ++m) { bf16_t* rowp = base + (size_t)(row0 + ai * HALF + m * 16) * ldc + col0;
#pragma unroll
                for (int bj = 0; bj < 2; ++bj) { f32x4 v0 = acc[ai][bj][m][0] + bv[bj][0], v1 = acc[ai][bj][m][1] + bv[bj][1];
                    if (ACT == 1) { f32x2 a = gelu_pk((f32x2){v0[0], v0[1]}), b = gelu_pk((f32x2){v0[2], v0[3]}), c = gelu_pk((f32x2){v1[0], v1[1]}), d = gelu_pk((f32x2){v1[2], v1[3]});
                        v0 = (f32x4){a.x, a.y, b.x, b.y}; v1 = (f32x4){c.x, c.y, d.x, d.y}; }
                    v0 = v0 * sc; v1 = v1 * sc; u32x4 w; w.x = cvt_pk_bf16(v0[0], v0[1]); w.y = cvt_pk_bf16(v0[2], v0[3]); w.z = cvt_pk_bf16(v1[0], v1[1]); w.w = cvt_pk_bf16(v1[2], v1[3]);
                    *(u32x4*)(rowp + bj * HALF) = w; } }
    }
};

__device__ __forceinline__ float fast_sigmoid(float x) { return __builtin_amdgcn_rcpf(1.0f + __builtin_amdgcn_exp2f(-1.4426950408889634f * x)); }
__device__ __forceinline__ u32x4 pack8(const f32x4& a, const f32x4& b) { u32x4 w; w.x = cvt_pk_bf16(a[0], a[1]); w.y = cvt_pk_bf16(a[2], a[3]); w.z = cvt_pk_bf16(b[0], b[1]); w.w = cvt_pk_bf16(b[2], b[3]); return w; }
__device__ __forceinline__ void unpack8(const u32x4& w, f32x4& a, f32x4& b) {
    a[0] = __uint_as_float(w.x << 16); a[1] = __uint_as_float(w.x & 0xffff0000u); a[2] = __uint_as_float(w.y << 16); a[3] = __uint_as_float(w.y & 0xffff0000u);
    b[0] = __uint_as_float(w.z << 16); b[1] = __uint_as_float(w.z & 0xffff0000u); b[2] = __uint_as_float(w.w << 16); b[3] = __uint_as_float(w.w & 0xffff0000u); }
__device__ __forceinline__ void store_tile_bf16(const f32x4 (&acc)[2][2][4][2], bf16_t* base, int ldc, int wr, int wc, int fr, int fq) {
    const int rt = wr * 64 + fr, cb = wc * 32 + 8 * fq;
#pragma unroll
    for (int ai = 0; ai < 2; ++ai)
#pragma unroll
        for (int m = 0; m < 4; ++m) { bf16_t* rowp = base + (size_t)(rt + ai * HALF + m * 16) * ldc + cb;
#pragma unroll
            for (int bj = 0; bj < 2; ++bj) *(u32x4*)(rowp + bj * HALF) = pack8(acc[ai][bj][m][0], acc[ai][bj][m][1]); }
}
struct EpiInproj {
    static constexpr bool PERM = true, AFTER_DRAIN = false;
    bf16_t *q, *k, *v, *cu;
    __device__ __forceinline__ void operator()(const f32x4 (&acc)[2][2][4][2], const Unit& u, int wr, int wc, int fr, int fq) const {
        bf16_t* base; int ldc; const bool glu = u.pn >= 6;
        if (u.pn < 4) { base = q + (size_t)u.pm * 256 * 1024 + u.pn * 256; ldc = 1024; }
        else if (u.pn < 6) { const int m0 = u.pm * 256; const int kr = m0 < 32768 ? (m0 >> 11) * 2304 + (m0 & 2047) : ((m0 - 32768) >> 8) * 2304 + 2048; base = (u.pn == 4 ? k : v) + (size_t)kr * 256; ldc = 256; }
        else { base = cu + (size_t)u.pm * 256 * 512 + (u.pn - 6) * 128; ldc = 512; }
        base += (size_t)(wr * 64 + fr) * ldc + wc * 32 + 8 * fq;
#pragma unroll
        for (int ai = 0; ai < 2; ++ai)
#pragma unroll
            for (int m = 0; m < 4; ++m) { bf16_t* rowp = base + (size_t)(ai * HALF + m * 16) * ldc;
                if (!glu) { *(u32x4*)rowp = pack8(acc[ai][0][m][0], acc[ai][0][m][1]); *(u32x4*)(rowp + HALF) = pack8(acc[ai][1][m][0], acc[ai][1][m][1]); }
                else { f32x4 a0 = acc[ai][0][m][0], a1 = acc[ai][0][m][1]; const f32x4 g0 = acc[ai][1][m][0], g1 = acc[ai][1][m][1];
#pragma unroll
                    for (int j = 0; j < 4; ++j) { a0[j] *= fast_sigmoid(g0[j]); a1[j] *= fast_sigmoid(g1[j]); }
                    *(u32x4*)rowp = pack8(a0, a1); } }
    }
};
struct EpiYT {
    static constexpr bool PERM = true, AFTER_DRAIN = false;
    bf16_t *yt, *ytc;
    __device__ __forceinline__ void operator()(const f32x4 (&acc)[2][2][4][2], const Unit& u, int wr, int wc, int fr, int fq) const {
        const int cs = u.pm >> 1, chb = (u.pm & 1) * 256; bf16_t* base; int ldc;
        if (u.pn < 128) { const int b = u.pn >> 3, pos0 = (u.pn & 7) * 256; base = yt + (size_t)(b * 512 + chb) * 4096 + cs * 2048 + pos0; ldc = 4096; }
        else { const int b = u.pn - 128; base = ytc + (size_t)(b * 512 + chb) * 512 + cs * 256; ldc = 512; }
        store_tile_bf16(acc, base, ldc, wr, wc, fr, fq);
    }
};
struct EpiDFT {
    static constexpr bool PERM = true, AFTER_DRAIN = false;
    bf16_t* z; int rowbase, rpb;
    __device__ __forceinline__ void operator()(const f32x4 (&acc)[2][2][4][2], const Unit& u, int wr, int wc, int fr, int fq) const {
        store_tile_bf16(acc, z + (size_t)(rowbase + (u.pn >> 1) * rpb + u.pm * 256) * 512 + (u.pn & 1) * 256, 512, wr, wc, fr, fq);
    }
};
struct EpiGates {
    static constexpr bool PERM = true, AFTER_DRAIN = false;
    bf16_t* g;
    __device__ __forceinline__ void operator()(const f32x4 (&acc)[2][2][4][2], const Unit& u, int wr, int wc, int fr, int fq) const {
        const int rt = wr * 64 + fr, cb = wc * 32 + 8 * fq; bf16_t* base = g + (size_t)u.pm * 256 * 3072 + u.pn * 256 + cb;
#pragma unroll
        for (int ai = 0; ai < 2; ++ai)
#pragma unroll
            for (int m = 0; m < 4; ++m)
#pragma unroll
                for (int bj = 0; bj < 2; ++bj) { f32x4 a0 = acc[ai][bj][m][0], a1 = acc[ai][bj][m][1];
#pragma unroll
                    for (int j = 0; j < 4; ++j) { a0[j] = fast_sigmoid(a0[j]); a1[j] = fast_sigmoid(a1[j]); }
                    *(u32x4*)(base + (size_t)(rt + ai * HALF + m * 16) * 3072 + bj * HALF) = pack8(a0, a1); }
    }
};
template <bool FIRST> struct EpiMerge {
    static constexpr bool PERM = true, AFTER_DRAIN = false;
    bf16_t* mg; const bf16_t* g; int br;
    __device__ __forceinline__ void operator()(const f32x4 (&acc)[2][2][4][2], const Unit& u, int wr, int wc, int fr, int fq) const {
        const int rt = u.pm * 256 + wr * 64 + fr, cb = u.pn * 256 + wc * 32 + 8 * fq;
#pragma unroll
        for (int ai = 0; ai < 2; ++ai)
#pragma unroll
            for (int m = 0; m < 4; ++m)
#pragma unroll
                for (int bj = 0; bj < 2; ++bj) { const size_t row = (size_t)(rt + ai * HALF + m * 16); const int col = cb + bj * HALF;
                    const u32x4 gw = *(const u32x4*)(g + row * 3072 + br * 1024 + col); f32x4 g0, g1; unpack8(gw, g0, g1);
                    f32x4 v0 = acc[ai][bj][m][0] * g0, v1 = acc[ai][bj][m][1] * g1;
                    if (!FIRST) { const u32x4 ow = *(const u32x4*)(mg + row * 1024 + col); f32x4 o0, o1; unpack8(ow, o0, o1); v0 += o0; v1 += o1; }
                    *(u32x4*)(mg + row * 1024 + col) = pack8(v0, v1); }
    }
};
struct EpiRouter {
    static constexpr bool PERM = true, AFTER_DRAIN = false;
    float* lg;
    __device__ __forceinline__ void operator()(const f32x4 (&acc)[2][2][4][2], const Unit& u, int wr, int wc, int fr, int fq) const {
        if (wc < 2) { const int rt = u.pm * 256 + wr * 64 + fr, cb = wc * 32 + 8 * fq;
#pragma unroll
            for (int ai = 0; ai < 2; ++ai)
#pragma unroll
                for (int m = 0; m < 4; ++m) { float* p = lg + (size_t)(rt + ai * HALF + m * 16) * 64 + cb; *(f32x4*)p = acc[ai][0][m][0]; *(f32x4*)(p + 4) = acc[ai][0][m][1]; } }
    }
};
struct EpiSwiGLU {
    static constexpr bool PERM = true, AFTER_DRAIN = false;
    bf16_t* act; const float* bg; const float* bu;
    __device__ __forceinline__ void operator()(const f32x4 (&acc)[2][2][4][2], const Unit& u, int wr, int wc, int fr, int fq) const {
        const int e = u.pn >> 3, col = (u.pn & 7) * 128 + wc * 32 + 8 * fq, rt = u.pm * 256 + wr * 64 + fr;
        const f32x4 bg0 = *(const f32x4*)(bg + e * 1024 + col), bg1 = *(const f32x4*)(bg + e * 1024 + col + 4), bu0 = *(const f32x4*)(bu + e * 1024 + col), bu1 = *(const f32x4*)(bu + e * 1024 + col + 4);
#pragma unroll
        for (int ai = 0; ai < 2; ++ai)
#pragma unroll
            for (int m = 0; m < 4; ++m) { f32x4 g0 = acc[ai][0][m][0] + bg0, g1 = acc[ai][0][m][1] + bg1, u0 = acc[ai][1][m][0] + bu0, u1 = acc[ai][1][m][1] + bu1;
#pragma unroll
                for (int j = 0; j < 4; ++j) { const float ga = fminf(g0[j], 7.0f), gb = fminf(g1[j], 7.0f); const float ua = fminf(fmaxf(u0[j], -7.0f), 7.0f), ub = fminf(fmaxf(u1[j], -7.0f), 7.0f);
                    g0[j] = (ua + 1.0f) * (ga * fast_sigmoid(1.702f * ga)); g1[j] = (ub + 1.0f) * (gb * fast_sigmoid(1.702f * gb)); }
                *(u32x4*)(act + (size_t)(rt + ai * HALF + m * 16) * 1024 + col) = pack8(g0, g1); }
    }
};
struct GroupedOrder {
    int nM, nN, nwg, G, c; const int* tile_e;
    __device__ void init(int nM_, int nN_, int G_, int c_, const int* te) { nM = nM_; nN = nN_; nwg = nM * nN; G = G_; c = c_; tile_e = te; }
    __device__ bool next(int i, Unit& u) const {
        const long L = (long)i * G + c; if (L >= nwg) return false;
        int wgid = (int)L; { const int q = nwg / NXCD, r = nwg % NXCD, xcd = wgid % NXCD, off = wgid / NXCD; wgid = (xcd < r ? xcd * (q + 1) : r * (q + 1) + (xcd - r) * q) + off; }
        const int nig = WGM * nN, gid = wgid / nig, fm = gid * WGM, gsz = (nM - fm) < WGM ? (nM - fm) : WGM;
        u.pm = fm + ((wgid % nig) % gsz); const int pl = (wgid % nig) / gsz; u.pn = __builtin_amdgcn_readfirstlane(tile_e[u.pm]) * nN + pl; return true;
    }
    __device__ __forceinline__ void a_ready(const Unit&) const {}
    __device__ __forceinline__ void done(const Unit&) const {}
};
struct DftOrder {
    int lg, n, G, c;
    __device__ void init(int lg_, int nb, int G_, int c_) { lg = lg_; n = (nb * 2) << lg_; G = G_; c = c_; }
    __device__ bool next(int i, Unit& u) const { const int L = i * G + c; if (L >= n) return false; const int b = L >> (lg + 1), rem = L & ((2 << lg) - 1); u.pm = rem & ((1 << lg) - 1); u.pn = 2 * b + (rem >> lg); return true; }
    __device__ __forceinline__ void a_ready(const Unit&) const {}
    __device__ __forceinline__ void done(const Unit&) const {}
};

template <class Epi, class Sched, bool ALIGN_EPI = false, bool SP2 = false>
__device__ __forceinline__ void gemm_phase(PG8_LAS unsigned char* lds, const Gemm g, const Sched& S, const Epi& E) {
    int tid_ = threadIdx.x; asm volatile("" : "+v"(tid_));
    const int tid = tid_, wid = __builtin_amdgcn_readfirstlane(tid >> 6), lane = tid & 63, wr = wid >> 2, wc = wid & 3, fr = lane & 15, fq = lane >> 4;
    const int K = g.K, nt = K / BK;
    unsigned voffA[2], voffB[2];
#pragma unroll
    for (int i = 0; i < 2; ++i) { int R, C; stage_rc(tid * 16 + i * 8192, R, C); const int Rb = Epi::PERM ? ((R & ~31) + perm32(R & 31)) : R;
        voffA[i] = (unsigned)(R * K + C) * 2u; voffB[i] = (unsigned)(Rb * K + C) * 2u; }
    const size_t kstep = (size_t)(BK * 2);
    const size_t hstep = (size_t)HALF * K * 2;
    const size_t tstep = 2 * hstep;
    const unsigned ldsw = (unsigned)wid * 1024u;
    const int aoff = lds_byte(wr * 64 + fr, fq * 8), boff = lds_byte(wc * 32 + fr, fq * 8);
#define PG8_SA(b, h) (((b) * 2 + (h)) * HTB)
#define PG8_SB(b, h) ((4 + (b) * 2 + (h)) * HTB)
#define PG8_STAGE(bufoff, gbase, voff) do { _Pragma("unroll") for (int _i = 0; _i < 2; ++_i) \
        __builtin_amdgcn_global_load_lds((const unsigned*)((const char*)(gbase) + (voff)[_i]), (PG8_LAS unsigned*)(lds + (bufoff) + ldsw + _i * 8192), 16, 0, 0); } while (0)
#define PG8_LDA(dst, b, h) do { _Pragma("unroll") for (int m = 0; m < 4; ++m) _Pragma("unroll") for (int k = 0; k < 2; ++k) dst[m][k] = *(const PG8_LAS bf16x8*)(lds + PG8_SA(b, h) + aoff + m * 2048 + k * 1024); } while (0)
#define PG8_LDB(dst, b, h) do { _Pragma("unroll") for (int n = 0; n < 2; ++n) _Pragma("unroll") for (int k = 0; k < 2; ++k) dst[n][k] = *(const PG8_LAS bf16x8*)(lds + PG8_SB(b, h) + boff + n * 2048 + k * 1024); } while (0)
#define PG8_MMA(ai, bj, At, Bt) do { __builtin_amdgcn_s_setprio(1); _Pragma("unroll") for (int m = 0; m < 4; ++m) _Pragma("unroll") for (int n = 0; n < 2; ++n) _Pragma("unroll") for (int k = 0; k < 2; ++k) \
        acc[ai][bj][m][n] = __builtin_amdgcn_mfma_f32_16x16x32_bf16(Bt[n][k], At[m][k], acc[ai][bj][m][n], 0, 0, 0); __builtin_amdgcn_s_setprio(0); } while (0)
#define PG8_WAIT_V(n) asm volatile("s_waitcnt vmcnt(" #n ")" ::: "memory")
#define PG8_WAIT_L(n) asm volatile("s_waitcnt lgkmcnt(" #n ")" ::: "memory")
#define PG8_BAR __builtin_amdgcn_s_barrier()
#define PG8_SCHED __builtin_amdgcn_sched_barrier(0)
    Unit cur, nxt; int ui = 0;
    if (!S.next(0, cur)) return;
    f32x4 acc[2][2][4][2];
#pragma unroll
    for (int a = 0; a < 2; ++a)
#pragma unroll
        for (int b = 0; b < 2; ++b)
#pragma unroll
            for (int m = 0; m < 4; ++m)
#pragma unroll
                for (int n = 0; n < 2; ++n) acc[a][b][m][n] = (f32x4){0.f, 0.f, 0.f, 0.f};
    bf16x8 At[4][2], B0[2][2], B1[2][2];
    const char* cA = (const char*)g.A + (size_t)cur.pm * tstep; const char* cB = (const char*)g.Bt + (size_t)cur.pn * tstep;
    S.a_ready(cur);
    if constexpr (SP2) {
        PG8_STAGE(PG8_SB(0, 0), cB, voffB); PG8_STAGE(PG8_SB(0, 1), cB + hstep, voffB); PG8_STAGE(PG8_SA(0, 0), cA, voffA); PG8_STAGE(PG8_SA(0, 1), cA + hstep, voffA);
        if (wr == 1) PG8_BAR;
        PG8_WAIT_V(2); PG8_BAR;
        PG8_STAGE(PG8_SB(1, 0), cB + kstep, voffB); PG8_STAGE(PG8_SA(1, 0), cA + kstep, voffA); PG8_STAGE(PG8_SB(1, 1), cB + hstep + kstep, voffB);
        PG8_WAIT_V(6); PG8_BAR;
    } else {
        PG8_STAGE(PG8_SB(0, 0), cB, voffB); PG8_STAGE(PG8_SA(0, 0), cA, voffA); PG8_STAGE(PG8_SB(0, 1), cB + hstep, voffB); PG8_STAGE(PG8_SA(0, 1), cA + hstep, voffA);
        if (wr == 1) PG8_BAR;
        PG8_WAIT_V(4); PG8_BAR;
        PG8_STAGE(PG8_SB(1, 0), cB + kstep, voffB); PG8_STAGE(PG8_SA(1, 0), cA + kstep, voffA); PG8_STAGE(PG8_SB(1, 1), cB + hstep + kstep, voffB);
        PG8_WAIT_V(6); PG8_BAR;
    }
    for (;;) {
        const bool has_next = S.next(ui + 1, nxt);
        const char* nA = has_next ? (const char*)g.A + (size_t)nxt.pm * tstep : cA; const char* nB = has_next ? (const char*)g.Bt + (size_t)nxt.pn * tstep : cB;
        for (int t = 0; t < nt; t += 2) {
            const bool last = (t == nt - 2);
            const char* a1 = cA + (size_t)(t + 1) * kstep;
            const char* a2 = last ? nA : cA + (size_t)(t + 2) * kstep; const char* b2 = last ? nB : cB + (size_t)(t + 2) * kstep;
            const char* a3 = a2 + kstep; const char* b3 = b2 + kstep;
            if (last && has_next) S.a_ready(nxt);
            if constexpr (SP2) {
            PG8_LDB(B0, 0, 0); PG8_LDB(B1, 0, 1); PG8_SCHED; PG8_LDA(At, 0, 0); PG8_STAGE(PG8_SA(1, 1), a1 + hstep, voffA);
            PG8_WAIT_V(8); PG8_WAIT_L(0); PG8_BAR; PG8_MMA(0, 0, At, B0); PG8_MMA(0, 1, At, B1); PG8_BAR; PG8_SCHED;
            PG8_LDA(At, 0, 1); PG8_STAGE(PG8_SB(0, 0), b2, voffB); PG8_STAGE(PG8_SB(0, 1), b2 + hstep, voffB); PG8_STAGE(PG8_SA(0, 0), a2, voffA);
            PG8_WAIT_V(8); PG8_WAIT_L(0); PG8_BAR; PG8_MMA(1, 0, At, B0); PG8_MMA(1, 1, At, B1); PG8_BAR; PG8_SCHED;
            PG8_LDB(B0, 1, 0); PG8_LDB(B1, 1, 1); PG8_SCHED; PG8_LDA(At, 1, 0); PG8_STAGE(PG8_SA(0, 1), a2 + hstep, voffA);
            PG8_WAIT_V(8); PG8_WAIT_L(0); PG8_BAR; PG8_MMA(0, 0, At, B0); PG8_MMA(0, 1, At, B1); PG8_BAR; PG8_SCHED;
            PG8_LDA(At, 1, 1); PG8_STAGE(PG8_SB(1, 0), b3, voffB); PG8_STAGE(PG8_SB(1, 1), b3 + hstep, voffB); PG8_STAGE(PG8_SA(1, 0), a3, voffA);
            PG8_WAIT_V(8); PG8_WAIT_L(0); PG8_BAR; PG8_MMA(1, 0, At, B0); PG8_MMA(1, 1, At, B1); PG8_BAR; PG8_SCHED;
            } else {
            PG8_LDB(B0, 0, 0); PG8_SCHED; PG8_LDA(At, 0, 0); PG8_STAGE(PG8_SA(1, 1), a1 + hstep, voffA);
            PG8_WAIT_L(8); PG8_BAR; PG8_WAIT_L(0); PG8_MMA(0, 0, At, B0); PG8_BAR; PG8_SCHED;
            PG8_LDB(B1, 0, 1); PG8_STAGE(PG8_SB(0, 0), b2, voffB);
            PG8_BAR; PG8_WAIT_L(0); PG8_MMA(0, 1, At, B1); PG8_BAR;
            PG8_LDA(At, 0, 1); PG8_STAGE(PG8_SA(0, 0), a2, voffA);
            PG8_BAR; PG8_WAIT_L(0); PG8_MMA(1, 0, At, B0); PG8_BAR; PG8_SCHED;
            PG8_STAGE(PG8_SB(0, 1), b2 + hstep, voffB);
            PG8_WAIT_V(6); PG8_BAR; PG8_MMA(1, 1, At, B1); PG8_BAR;
            PG8_LDB(B0, 1, 0); PG8_SCHED; PG8_LDA(At, 1, 0); PG8_STAGE(PG8_SA(0, 1), a2 + hstep, voffA);
            PG8_WAIT_L(8); PG8_BAR; PG8_WAIT_L(0); PG8_MMA(0, 0, At, B0); PG8_BAR; PG8_SCHED;
            PG8_LDB(B1, 1, 1); PG8_STAGE(PG8_SB(1, 0), b3, voffB);
            PG8_BAR; PG8_WAIT_L(0); PG8_MMA(0, 1, At, B1); PG8_BAR;
            PG8_LDA(At, 1, 1); PG8_STAGE(PG8_SA(1, 0), a3, voffA);
            PG8_BAR; PG8_WAIT_L(0); PG8_MMA(1, 0, At, B0); PG8_BAR; PG8_SCHED;
            PG8_STAGE(PG8_SB(1, 1), b3 + hstep, voffB);
            PG8_WAIT_V(6); PG8_BAR; PG8_MMA(1, 1, At, B1); PG8_BAR;
            }
        }
        if constexpr (ALIGN_EPI) { if (wr == 0) PG8_BAR; }
        if constexpr (!Epi::AFTER_DRAIN) { E(acc, cur, wr, wc, fr, fq); S.done(cur); }
        if (!has_next) break;
#pragma unroll
        for (int a = 0; a < 2; ++a)
#pragma unroll
            for (int b = 0; b < 2; ++b)
#pragma unroll
                for (int m = 0; m < 4; ++m)
#pragma unroll
                    for (int n = 0; n < 2; ++n) acc[a][b][m][n] = (f32x4){0.f, 0.f, 0.f, 0.f};
        cur = nxt; cA = nA; cB = nB; ++ui;
        if constexpr (ALIGN_EPI) { if (wr == 1) PG8_BAR; }
    }
    PG8_WAIT_V(0);
    if constexpr (!ALIGN_EPI) { if (wr == 0) PG8_BAR; }
    PG8_BAR;
    if constexpr (Epi::AFTER_DRAIN) { E.fused(acc, cur, wr, wc, fr, fq, lds, wid, lane); S.done(cur); }
#undef PG8_SA
#undef PG8_SB
#undef PG8_STAGE
#undef PG8_LDA
#undef PG8_LDB
#undef PG8_MMA
#undef PG8_WAIT_V
#undef PG8_WAIT_L
#undef PG8_BAR
#undef PG8_SCHED
}
}
namespace att {
typedef unsigned short bf16;
constexpr int   D = 128, NW = 8, QBLK = 32, KVBLK = 64;
constexpr float SCALE = 0.088388347648318440f;
constexpr float THR = 8.f;
constexpr int SDEPTH = 2;
constexpr int LDQ = 1024, LDK = 256, LDO = 1024;
constexpr size_t SHM_V = KVBLK * D * 2, SHM_K = KVBLK * D * 2, SHM_ATTN = 2 * SHM_V + 2 * SHM_K + NW * 64 * 4;
using bf16x8 = __attribute__((ext_vector_type(8))) short;
using s16x4  = __attribute__((ext_vector_type(4))) short;
using f32x16 = __attribute__((ext_vector_type(16))) float;
using f32x8  = __attribute__((ext_vector_type(8))) float;
using u32x4  = __attribute__((ext_vector_type(4))) unsigned;
#define KSWZ(row, colB) ((row) * 256 + ((colB) ^ (((row) & 7) << 4)))
#define SBAR() __builtin_amdgcn_sched_barrier(0)
__device__ __forceinline__ int crow(int r, int hi) { return (r & 3) + 8 * (r >> 2) + 4 * hi; }
__device__ __forceinline__ unsigned cvtpk(float lo, float hi) { return pg8::cvt_pk_bf16(lo, hi); }
template <typename TIn> struct Stage;
template <> struct Stage<bf16>  { using T = bf16x8;
  __device__ static __forceinline__ T ld8(const bf16* p) { return *reinterpret_cast<const bf16x8*>(p); }
  __device__ static __forceinline__ bf16x8 tobf(T x) { return x; } };
template <> struct Stage<float> { using T = f32x8;
  __device__ static __forceinline__ T ld8(const float* p) { return *reinterpret_cast<const f32x8*>(p); }
  __device__ static __forceinline__ bf16x8 tobf(T x) {
    u32x4 w = {cvtpk(x[0], x[1]), cvtpk(x[2], x[3]), cvtpk(x[4], x[5]), cvtpk(x[6], x[7])}; return *reinterpret_cast<bf16x8*>(&w); } };

__device__ __forceinline__ void partialSM(f32x16& p0, f32x16& p1, float& m_reg, float& mn, float& alpha) {
  constexpr float C = SCALE * 1.4426950408889634f;
  float pmax = p0[0]; for (int r = 1; r < 16; ++r) pmax = fmaxf(pmax, p0[r]); for (int r = 0; r < 16; ++r) pmax = fmaxf(pmax, p1[r]);
  { auto rr = __builtin_amdgcn_permlane32_swap(__float_as_uint(pmax), __float_as_uint(pmax), false, false);
    pmax = fmaxf(__uint_as_float(rr[0]), __uint_as_float(rr[1])); }
  if (__builtin_expect(__all(pmax - m_reg <= THR / SCALE), 1)) { mn = m_reg; alpha = 1.f; }
  else { mn = fmaxf(m_reg, pmax); alpha = __builtin_amdgcn_exp2f((m_reg - mn) * C); m_reg = mn; }
  float mnC = -mn * C;
  for (int r = 0; r < 16; ++r) p0[r] = fmaf(p0[r], C, mnC); for (int r = 0; r < 16; ++r) p1[r] = fmaf(p1[r], C, mnC);
  for (int r = 0; r < 16; ++r) p0[r] = __builtin_amdgcn_exp2f(p0[r]);
}
__device__ __forceinline__ void finishSM(f32x16& p0, f32x16& p1, float alpha, float& l_reg, bf16x8& pa0, bf16x8& pa1, bf16x8& pa2, bf16x8& pa3) {
  for (int r = 0; r < 16; ++r) p1[r] = __builtin_amdgcn_exp2f(p1[r]);
  float ps = 0; for (int r = 0; r < 16; ++r) ps += p0[r]; for (int r = 0; r < 16; ++r) ps += p1[r];
  { auto rr = __builtin_amdgcn_permlane32_swap(__float_as_uint(ps), __float_as_uint(ps), false, false);
    ps = __uint_as_float(rr[0]) + __uint_as_float(rr[1]); }
  l_reg = l_reg * alpha + ps;
#define PK4(P, BASE, OUT) do { unsigned a0 = cvtpk(P[BASE + 0], P[BASE + 1]), a1 = cvtpk(P[BASE + 2], P[BASE + 3]);   \
    unsigned b0 = cvtpk(P[BASE + 4], P[BASE + 5]), b1 = cvtpk(P[BASE + 6], P[BASE + 7]);                              \
    auto r0 = __builtin_amdgcn_permlane32_swap(a0, b0, false, false); auto r1 = __builtin_amdgcn_permlane32_swap(a1, b1, false, false); \
    u32x4 w = {r0[0], r1[0], r0[1], r1[1]}; OUT = *reinterpret_cast<bf16x8*>(&w); } while (0)
  PK4(p0, 0, pa0); PK4(p0, 8, pa1); PK4(p1, 0, pa2); PK4(p1, 8, pa3);
#undef PK4
}
__device__ __forceinline__ void qkt(f32x16& p0, f32x16& p1, const bf16* Ks, const bf16x8* qr, int r32, int hi) {
  p0 = f32x16{}; p1 = f32x16{};
  for (int d0 = 0; d0 < 8; ++d0) { int cb = (d0 * 16 + hi * 8) * 2;
    bf16x8 b0 = *reinterpret_cast<const bf16x8*>((const char*)Ks + KSWZ(r32, cb));
    bf16x8 b1 = *reinterpret_cast<const bf16x8*>((const char*)Ks + KSWZ(32 + r32, cb));
    p0 = __builtin_amdgcn_mfma_f32_32x32x16_bf16(b0, qr[d0], p0, 0, 0, 0);
    p1 = __builtin_amdgcn_mfma_f32_32x32x16_bf16(b1, qr[d0], p1, 0, 0, 0); }
}
__device__ __forceinline__ int v_st(int k, int c) { const int kk = (k & ~0xC) | ((k & 4) << 1) | ((k & 8) >> 1); return ((kk >> 3) * 4 + (c >> 5)) * 512 + ((kk & 7) * 32 + (c & 31)) * 2; }
__device__ __forceinline__ int v_rd_base(int lane) { return ((lane & 3) << 3) | (((lane >> 2) & 3) << 6) | (((lane >> 4) & 1) << 5) | (((lane >> 5) & 1) << 8); }
constexpr int v_rd_off(int d0, int ks, int half) { return d0 * 512 + ks * 4096 + half * 2048; }
template <int OFF> __device__ __forceinline__ s16x4 tr_read(int vb) {
  s16x4 r; asm volatile("ds_read_b64_tr_b16 %0, %1 offset:%2" : "=&v"(r) : "v"(vb), "i"(OFF) : "memory"); return r;
}
template <int D0> __device__ __forceinline__ void pv_one(f32x16& od, int vb, bf16x8 pa0, bf16x8 pa1, bf16x8 pa2, bf16x8 pa3) {
  const s16x4 l0 = tr_read<v_rd_off(D0, 0, 0)>(vb), h0 = tr_read<v_rd_off(D0, 0, 1)>(vb), l1 = tr_read<v_rd_off(D0, 1, 0)>(vb), h1 = tr_read<v_rd_off(D0, 1, 1)>(vb);
  const s16x4 l2 = tr_read<v_rd_off(D0, 2, 0)>(vb), h2 = tr_read<v_rd_off(D0, 2, 1)>(vb), l3 = tr_read<v_rd_off(D0, 3, 0)>(vb), h3 = tr_read<v_rd_off(D0, 3, 1)>(vb);
  asm volatile("s_waitcnt lgkmcnt(0)" ::: "memory"); SBAR();
#define PK(L, H) (bf16x8){L[0], L[1], L[2], L[3], H[0], H[1], H[2], H[3]}
  od = __builtin_amdgcn_mfma_f32_32x32x16_bf16(pa0, PK(l0, h0), od, 0, 0, 0);
  od = __builtin_amdgcn_mfma_f32_32x32x16_bf16(pa1, PK(l1, h1), od, 0, 0, 0);
  od = __builtin_amdgcn_mfma_f32_32x32x16_bf16(pa2, PK(l2, h2), od, 0, 0, 0);
  od = __builtin_amdgcn_mfma_f32_32x32x16_bf16(pa3, PK(l3, h3), od, 0, 0, 0);
#undef PK
}
__device__ __forceinline__ void pv_d0(f32x16* o, int vb, bf16x8 pa0, bf16x8 pa1, bf16x8 pa2, bf16x8 pa3) {
  pv_one<0>(o[0], vb, pa0, pa1, pa2, pa3); pv_one<1>(o[1], vb, pa0, pa1, pa2, pa3); pv_one<2>(o[2], vb, pa0, pa1, pa2, pa3); pv_one<3>(o[3], vb, pa0, pa1, pa2, pa3);
}

template <typename TQ>
__device__ __forceinline__ void attn_dense_body(const TQ* __restrict__ Qb, const bf16* __restrict__ Kh, const bf16* __restrict__ Vh,
                                                bf16* __restrict__ Ob, int seq, char* lds) {
  using St = Stage<bf16>; using SQ = Stage<TQ>;
  int tid_ = threadIdx.x; asm volatile("" : "+v"(tid_));
  const int tid = tid_, wid = tid >> 6, lane = tid & 63, r32 = lane & 31, hi = lane >> 5;
  bf16* V_lds = (bf16*)lds; bf16* K_lds = (bf16*)(lds + 2 * SHM_V);
  float* ws = (float*)(lds + 2 * SHM_V + 2 * SHM_K) + wid * 64; float* li_l = ws; float* al_l = ws + 32;
  float m_reg = -1e30f, l_reg = 0; f32x16 o[4] = {}; bf16x8 qr[8];
  const TQ* Qw = Qb + (long)(wid * QBLK + r32) * LDQ + hi * 8;
#pragma unroll
  for (int d0 = 0; d0 < 8; ++d0) qr[d0] = SQ::tobf(SQ::ld8(Qw + d0 * 16));
  const int sr = tid >> 4, sc = (tid & 15) * 8, vst0 = v_st(sr, sc), vst1 = v_st(32 + sr, sc);
  const int vb0 = (int)(uintptr_t)V_lds + v_rd_base(lane);
  struct { typename St::T vs0, vs1, ks0, ks1; } sr_[SDEPTH];
#define SLOAD(i, k0) do { sr_[i].vs0 = St::ld8(&Vh[(long)((k0) + sr) * LDK + sc]); sr_[i].vs1 = St::ld8(&Vh[(long)((k0) + 32 + sr) * LDK + sc]); \
    sr_[i].ks0 = St::ld8(&Kh[(long)((k0) + sr) * LDK + sc]); sr_[i].ks1 = St::ld8(&Kh[(long)((k0) + 32 + sr) * LDK + sc]); } while (0)
#define SWRITE(b, i) do { *(bf16x8*)((char*)V_lds + (b) * SHM_V + vst0) = St::tobf(sr_[i].vs0);          \
    *(bf16x8*)((char*)V_lds + (b) * SHM_V + vst1) = St::tobf(sr_[i].vs1); int kc = sc * 2;               \
    *(bf16x8*)((char*)K_lds + (b) * SHM_K + KSWZ(sr, kc)) = St::tobf(sr_[i].ks0);                       \
    *(bf16x8*)((char*)K_lds + (b) * SHM_K + KSWZ(32 + sr, kc)) = St::tobf(sr_[i].ks1); } while (0)
#define SWAIT() do { if constexpr (SDEPTH == 2) asm volatile("s_waitcnt vmcnt(4)" ::: "memory"); else asm volatile("s_waitcnt vmcnt(0)" ::: "memory"); } while (0)
#define RESC(a) do { if (__any((a) < 1.f)) { if (hi == 0) al_l[r32] = (a); asm volatile("s_waitcnt lgkmcnt(0)" ::: "memory"); \
    for (int d = 0; d < 4; ++d) for (int r = 0; r < 16; ++r) o[d][r] *= al_l[crow(r, hi)]; } } while (0)
  f32x16 pA0, pA1, pB0, pB1; float mnA, mnB, alA, alB; bf16x8 pa0, pa1, pa2, pa3; const int NT = seq / KVBLK;
  constexpr int SE = 0, SO = SDEPTH - 1;
  SLOAD(SE, 0); asm volatile("s_waitcnt vmcnt(0)" ::: "memory"); SWRITE(0, SE); __syncthreads();
  qkt(pA0, pA1, K_lds, qr, r32, hi); partialSM(pA0, pA1, m_reg, mnA, alA);
  SLOAD(SO, KVBLK); if constexpr (SDEPTH == 2) { if (2 < NT) SLOAD(SE, 2 * KVBLK); }
  SWAIT(); SWRITE(1, SO); __syncthreads();
  for (int j = 1; j + 1 < NT; j += 2) {
    SBAR(); qkt(pB0, pB1, (bf16*)((char*)K_lds + SHM_K), qr, r32, hi);
    finishSM(pA0, pA1, alA, l_reg, pa0, pa1, pa2, pa3); SBAR();
    SLOAD(SO, (j + SDEPTH) * KVBLK); SBAR();
    pv_d0(o, vb0, pa0, pa1, pa2, pa3); partialSM(pB0, pB1, m_reg, mnB, alB);
    __syncthreads(); SWAIT(); SWRITE(0, SE);
    RESC(alB); __syncthreads();
    SBAR(); qkt(pA0, pA1, K_lds, qr, r32, hi);
    finishSM(pB0, pB1, alB, l_reg, pa0, pa1, pa2, pa3); SBAR();
    if (SDEPTH == 1 || j + 3 < NT) SLOAD(SE, (j + 1 + SDEPTH) * KVBLK); SBAR();
    pv_d0(o, vb0 + (int)SHM_V, pa0, pa1, pa2, pa3); partialSM(pA0, pA1, m_reg, mnA, alA);
    __syncthreads(); SWAIT(); SWRITE(1, SO);
    RESC(alA); __syncthreads();
  }
  SBAR(); qkt(pB0, pB1, (bf16*)((char*)K_lds + SHM_K), qr, r32, hi);
  finishSM(pA0, pA1, alA, l_reg, pa0, pa1, pa2, pa3); SBAR();
  pv_d0(o, vb0, pa0, pa1, pa2, pa3); partialSM(pB0, pB1, m_reg, mnB, alB);
  __syncthreads(); RESC(alB);
  finishSM(pB0, pB1, alB, l_reg, pa0, pa1, pa2, pa3); SBAR();
  pv_d0(o, vb0 + (int)SHM_V, pa0, pa1, pa2, pa3);
  if (hi == 0) li_l[r32] = l_reg; asm volatile("s_waitcnt lgkmcnt(0)" ::: "memory");
  float rli[16];
#pragma unroll
  for (int r = 0; r < 16; ++r) rli[r] = __builtin_amdgcn_rcpf(li_l[crow(r, hi)]);
  bf16* Ow = Ob + (long)(wid * QBLK) * LDO;
#pragma unroll
  for (int r = 0; r < 16; ++r) { int orow = crow(r, hi);
    for (int d0 = 0; d0 < 4; ++d0) Ow[(long)orow * LDO + d0 * 32 + r32] = (bf16)(cvtpk(o[d0][r] * rli[r], 0.f) & 0xffffu); }
#undef SLOAD
#undef SWRITE
#undef SWAIT
#undef RESC
}
#undef KSWZ
#undef SBAR
}

#define GAS __attribute__((address_space(1)))
#define LAS __attribute__((address_space(3)))
typedef unsigned short bf16;
typedef unsigned v4u __attribute__((ext_vector_type(4)));
typedef float f32x4 __attribute__((ext_vector_type(4)));
typedef short bf16x8 __attribute__((ext_vector_type(8)));
typedef GAS unsigned gu32;
typedef GAS unsigned long long gu64;
#define RLX_AGENT __ATOMIC_RELAXED, __HIP_MEMORY_SCOPE_AGENT
#define LDS_WAIT() asm volatile("s_waitcnt lgkmcnt(0)" ::: "memory")
#define VM_WAIT() asm volatile("s_waitcnt vmcnt(0)" ::: "memory")
__device__ __forceinline__ unsigned long long rt() { return __builtin_amdgcn_s_memrealtime(); }
__device__ __forceinline__ unsigned f2bf(float f) { unsigned u = __builtin_bit_cast(unsigned, f); return (u + 0x7fffu + ((u >> 16) & 1u)) >> 16; }
__device__ __forceinline__ unsigned pk2(float lo, float hi) { return f2bf(lo) | (f2bf(hi) << 16); }

#define XB_TMO      128
#define XB_XCNT(j)  (256  + 64 * (j))
#define XB_XSUB(j)  (1280 + 64 * (j))
#define XB_XGEN(j)  (2304 + 64 * (j))
#define XB_TOP      3328
#define XB_TOPGEN   3392
#define XCD_BAR_WORDS 3456
#define XB_SPIN_CAP (1u << 18)

__device__ __forceinline__ unsigned xb_ld(unsigned* p)              { return __hip_atomic_load(p, __ATOMIC_RELAXED, __HIP_MEMORY_SCOPE_AGENT); }
__device__ __forceinline__ unsigned xb_add(unsigned* p, unsigned v) { return __hip_atomic_fetch_add(p, v, __ATOMIC_RELAXED, __HIP_MEMORY_SCOPE_AGENT); }
__device__ __forceinline__ unsigned xb_xcc_id() { return (unsigned)__builtin_amdgcn_s_getreg((3 << 11) | 20) & 0xFu; }
#define XB_SPIN(cond, bar) do { unsigned _sp = 0; while (cond) { __builtin_amdgcn_s_sleep(1); \
    if ((++_sp & 255u) == 0u) { if (xb_ld(&(bar)[XB_TMO])) break; if (_sp > XB_SPIN_CAP) { atomicAdd(&(bar)[XB_TMO], 1u); break; } } } } while (0)

struct XcdBarrier {
    unsigned* bar; unsigned x;
    volatile LAS unsigned* st;
};

__device__ __forceinline__ XcdBarrier xcd_barrier_post(unsigned* bar, volatile LAS unsigned* st) {
    XcdBarrier b; b.bar = bar; b.x = xb_xcc_id(); b.st = st;
    if (threadIdx.x == 0) (void)xb_add(&bar[XB_XCNT(b.x)], 1u);
    return b;
}
__device__ __forceinline__ void xcd_barrier_complete(unsigned* bar, unsigned x, unsigned& nloc, unsigned& nx) {
    const unsigned G = gridDim.x * gridDim.y * gridDim.z;
    unsigned sum, cnt, mine, sp = 0u;
    for (;;) {
        sum = 0u; cnt = 0u; mine = 0u;
#pragma unroll
        for (unsigned j = 0; j < 16; ++j) { const unsigned c = xb_ld(&bar[XB_XCNT(j)]); sum += c; cnt += (c > 0u) ? 1u : 0u; mine = (j == x) ? c : mine; }
        if (sum == G) break;
        __builtin_amdgcn_s_sleep(1);
        if ((++sp & 255u) == 0u) { if (xb_ld(&bar[XB_TMO])) break; if (sp > XB_SPIN_CAP) { atomicAdd(&bar[XB_TMO], 1u); break; } }
    }
    nloc = mine > 0u ? mine : 1u; nx = cnt > 0u ? cnt : 1u;
}

__device__ __forceinline__ void xcd_barrier(const XcdBarrier& b) {
    asm volatile("s_waitcnt vmcnt(0)" ::: "memory");
    __syncthreads();
    if (threadIdx.x == 0) {
        unsigned* bar = b.bar;
        __builtin_amdgcn_s_waitcnt(0);
        unsigned nloc = b.st[0], nx = b.st[1];
        if (nloc == 0u) { xcd_barrier_complete(bar, b.x, nloc, nx); b.st[0] = nloc; b.st[1] = nx; }
        const unsigned old = xb_add(&bar[XB_XSUB(b.x)], 1u);
        const unsigned gen = old / nloc;
        if (old + 1u == (gen + 1u) * nloc) {
            __builtin_amdgcn_fence(__ATOMIC_RELEASE, "agent");
            asm volatile("s_waitcnt vmcnt(0)" ::: "memory");
            const unsigned og = xb_add(&bar[XB_TOP], 1u);
            const unsigned tg = og / nx;
            if (og + 1u == (tg + 1u) * nx) xb_add(&bar[XB_TOPGEN], 1u);
            else XB_SPIN(xb_ld(&bar[XB_TOPGEN]) == tg, bar);
            __builtin_amdgcn_fence(__ATOMIC_ACQUIRE, "agent");
            xb_add(&bar[XB_XGEN(b.x)], 1u);
            asm volatile("s_waitcnt vmcnt(0)" ::: "memory");
        } else {
            XB_SPIN(xb_ld(&bar[XB_XGEN(b.x)]) == gen, bar);
            __builtin_amdgcn_fence(__ATOMIC_ACQUIRE, "agent");
            asm volatile("s_waitcnt vmcnt(0)" ::: "memory");
        }
    }
    __syncthreads();
}
constexpr int DM = 1024, NB = 16, SEQ = 2048, CTXL = 256, TL = NB * SEQ, TC = NB * CTXL, TALL = TL + TC;
constexpr int INCOLS = 6144, OFF_FNET = 2560, OFF_GATE = 3072;
constexpr int NEXP = 32, KVROWS = SEQ + CTXL;
constexpr float EPS = 1e-6f;
constexpr int NWAVES = 8, NTHR = NWAVES * 64;
constexpr int NPL = 13, NPH = 2 + 2 * NPL;
#ifndef MK_PER_PHASE
#define MK_PER_PHASE 0
#endif
constexpr size_t MiB = 1u << 20;
constexpr size_t WS_CTL = 0, CTL_ZERO_BYTES = 1 * MiB;
constexpr size_t WS_MOD = 1 * MiB;
constexpr size_t WS_TAB = 2 * MiB;
constexpr size_t WS_TOPI = 3 * MiB, WS_TOPP = 4 * MiB, WS_SLOT = 5 * MiB, WS_CNT = 6 * MiB;
constexpr size_t WS_LOGIT = 7 * MiB;
constexpr size_t WS_WSMALL = 17 * MiB, WSMALL_LAYER = 20 * MiB;
constexpr size_t OFFS_WIN = 0, OFFS_WF = 5 * MiB, OFFS_WG = 7 * MiB, OFFS_WAO = 13 * MiB, OFFS_WCO = 15 * MiB, OFFS_WFO = 16 * MiB, OFFS_WOUT = 17 * MiB, OFFS_ROUT = 19 * MiB;
constexpr size_t WS_DFTL = 57 * MiB, WS_DFTC = 73 * MiB;
constexpr size_t WS_XC = 74 * MiB;
constexpr size_t WS_H = 90 * MiB;
constexpr size_t WS_WGU = 162 * MiB, WS_WD = 290 * MiB;
constexpr size_t WS_BIG = 354 * MiB;
constexpr size_t WS_Q = WS_BIG, WS_K = WS_Q + 72 * MiB, WS_V = WS_K + 18 * MiB, WS_CU = WS_V + 18 * MiB, WS_YT = WS_CU + 36 * MiB, WS_YTC = WS_YT + 64 * MiB;
constexpr size_t WS_GATES = WS_BIG;
constexpr size_t WS_AO = WS_BIG + 216 * MiB, WS_CH = WS_AO + 72 * MiB, WS_Z = WS_CH + 36 * MiB;
constexpr size_t WS_MIX = WS_AO;
constexpr size_t WS_MERGED = WS_BIG + 360 * MiB;
constexpr int SLOT_ROWS = 608 * 256;
constexpr size_t WS_HS = WS_BIG, WS_ACT = WS_BIG + 304 * MiB, WS_END = WS_BIG + 608 * MiB;
static_assert(WS_YTC + 8 * MiB == WS_AO && WS_Z + 36 * MiB == WS_MERGED && WS_MERGED + 72 * MiB <= WS_END && (size_t)SLOT_ROWS * 2048 == 304 * MiB, "ws map");
constexpr int CW_TMO = 0, CW_CODE = 1, CW_BAR = 4096;
constexpr int CNT_TILE_E = 16384, CNT_NT = 16384 + 1024;

constexpr int RING_OFF = 0, RING_BYTES = 131072;
constexpr int LDSCTL_OFF = RING_BYTES, MISC_OFF = LDSCTL_OFF + 320, LDS_CT = LDSCTL_OFF + 512, LDS_SM = LDSCTL_OFF + 1024;
constexpr int LDS_BYTES = 147456;

typedef unsigned u32x2 __attribute__((ext_vector_type(2)));
typedef int i32x4 __attribute__((ext_vector_type(4)));
typedef float f32x2 __attribute__((ext_vector_type(2)));
struct Args { const float* in[29]; float* out; unsigned char* ws; int ph_lo, ph_hi; };
typedef const __attribute__((address_space(4))) unsigned char* kptr_t;
struct AV {
    kptr_t kp;
    __device__ __forceinline__ const float* in(int i) const { return *(const float* const __attribute__((address_space(4)))*)(kp + 8 * i); }
    __device__ __forceinline__ float* out() const { return *(float* const __attribute__((address_space(4)))*)(kp + 8 * 29); }
    __device__ __forceinline__ unsigned char* ws() const { return *(unsigned char* const __attribute__((address_space(4)))*)(kp + 8 * 30); }
};
__device__ __forceinline__ AV av_get() { AV a; a.kp = (kptr_t)__builtin_amdgcn_kernarg_segment_ptr(); asm volatile("" : "+s"(a.kp)); return a; }

struct Frame {
    LAS unsigned char* lds; volatile LAS unsigned* MISC; gu32* ctl;
    int tid, lane, wave, vcu, G;
};

__device__ __forceinline__ float shx(float v, int m, int lane) { return __int_as_float(__builtin_amdgcn_ds_bpermute((lane ^ m) << 2, __float_as_int(v))); }
__device__ __forceinline__ float wave_sum(float v, int lane) {
#pragma unroll
    for (int o = 1; o < 64; o <<= 1) v += shx(v, o, lane);
    return v;
}
__device__ __forceinline__ float sigmoidf_(float x) { return 1.0f / (1.0f + __expf(-x)); }
__device__ __forceinline__ f32x4 bf4(u32x2 w) { f32x4 r; r[0] = __uint_as_float(w.x << 16); r[1] = __uint_as_float(w.x & 0xffff0000u); r[2] = __uint_as_float(w.y << 16); r[3] = __uint_as_float(w.y & 0xffff0000u); return r; }
__device__ __forceinline__ u32x2 pk4(f32x4 v) { u32x2 w; w.x = pk2(v[0], v[1]); w.y = pk2(v[2], v[3]); return w; }
__device__ __forceinline__ void ld_row_f32(f32x4 (&v)[4], const float* p, int lane) {
#pragma unroll
    for (int j = 0; j < 4; ++j) v[j] = ((const GAS f32x4*)p)[lane + 64 * j];
}
__device__ __forceinline__ void st_row_f32(const f32x4 (&v)[4], float* p, int lane) {
#pragma unroll
    for (int j = 0; j < 4; ++j) ((GAS f32x4*)p)[lane + 64 * j] = v[j];
}
__device__ __forceinline__ void ld_row_bf16(f32x4 (&v)[4], const bf16* p, int lane) {
#pragma unroll
    for (int j = 0; j < 4; ++j) v[j] = bf4(((const GAS u32x2*)p)[lane + 64 * j]);
}
__device__ __forceinline__ void st_row_bf16(const f32x4 (&v)[4], bf16* p, int lane) {
#pragma unroll
    for (int j = 0; j < 4; ++j) ((GAS u32x2*)p)[lane + 64 * j] = pk4(v[j]);
}
__device__ __forceinline__ void rms_gain(f32x4 (&v)[4], const float* g, int lane) {
    float ss = 0.f;
#pragma unroll
    for (int j = 0; j < 4; ++j) ss += (v[j][0] * v[j][0] + v[j][1] * v[j][1]) + (v[j][2] * v[j][2] + v[j][3] * v[j][3]);
    const float r = 1.0f / sqrtf(wave_sum(ss, lane) * (1.0f / 1024.0f) + EPS);
#pragma unroll
    for (int j = 0; j < 4; ++j) { const f32x4 gg = ((const GAS f32x4*)g)[lane + 64 * j]; v[j] = v[j] * r * gg; }
}
__device__ __forceinline__ void modulate_store(const f32x4 (&v)[4], const float* shift, const float* scale, bf16* o, int lane) {
#pragma unroll
    for (int j = 0; j < 4; ++j) { const f32x4 sh = ((const GAS f32x4*)shift)[lane + 64 * j], sc = ((const GAS f32x4*)scale)[lane + 64 * j];
        ((GAS u32x2*)o)[lane + 64 * j] = pk4(v[j] * (sc + 1.0f) + sh); }
}
__device__ __forceinline__ int krow_of(int m) { return m < TL ? (m >> 11) * KVROWS + (m & 2047) : ((m - TL) >> 8) * KVROWS + SEQ + ((m - TL) & 255); }

__device__ __forceinline__ void transpose_item(const float* W, int ldw, int K, bf16* WT, int dst_row0, int k0, int n0, LAS float* scr, int lane) {
#pragma unroll 8
    for (int i = 0; i < 32; ++i) { const int kk = 2 * i + (lane >> 5); scr[kk * 33 + (lane & 31)] = W[(size_t)(k0 + kk) * ldw + n0 + (lane & 31)]; }
    LDS_WAIT(); asm volatile("" ::: "memory");
    const int c = lane & 7;
#pragma unroll
    for (int j = 0; j < 4; ++j) { const int n = (lane >> 3) + 8 * j; const LAS float* s = scr + (8 * c) * 33 + n;
        v4u o; o.x = pk2(s[0 * 33], s[1 * 33]); o.y = pk2(s[2 * 33], s[3 * 33]); o.z = pk2(s[4 * 33], s[5 * 33]); o.w = pk2(s[6 * 33], s[7 * 33]);
        *(GAS v4u*)(WT + (size_t)(dst_row0 + n) * K + k0 + 8 * c) = o; }
    LDS_WAIT(); asm volatile("" ::: "memory");
}
constexpr int IT_S0 = 16 * 80, IT_S1 = 16 * 96, IT_S2 = 512, IT_S3 = 512, IT_S4 = 256, IT_S5 = 256, IT_SMALL = IT_S0 + IT_S1 + IT_S2 + IT_S3 + IT_S4 + IT_S5;
__device__ __forceinline__ void small_item(const AV& a, int l, int r, LAS float* scr, int lane) {
    unsigned char* wl = a.ws() + WS_WSMALL + (size_t)l * WSMALL_LAYER; const float* win = a.in(10) + (size_t)l * DM * INCOLS;
    if (r < IT_S0) { const int kb = r / 80, n0 = (r % 80) * 32; int dr;
        if (n0 < 1536) dr = n0; else { int cc = n0 - 1536; if (cc < 512) dr = 1536 + (cc >> 7) * 256 + (cc & 127); else { cc -= 512; dr = 1536 + (cc >> 7) * 256 + 128 + (cc & 127); } }
        transpose_item(win, INCOLS, DM, (bf16*)(wl + OFFS_WIN), dr, kb * 64, n0, scr, lane); return; }
    r -= IT_S0;
    if (r < IT_S1) { const int kb = r / 96, nb = r % 96; transpose_item(win, INCOLS, DM, (bf16*)(wl + OFFS_WG), nb * 32, kb * 64, OFF_GATE + nb * 32, scr, lane); return; }
    r -= IT_S1;
    if (r < IT_S2) { const int kb = r / 32, nb = r % 32; transpose_item(a.in(13) + (size_t)l * DM * DM, DM, DM, (bf16*)(wl + OFFS_WAO), nb * 32, kb * 64, nb * 32, scr, lane); return; }
    r -= IT_S2;
    if (r < IT_S3) { const int kb = r / 32, nb = r % 32; transpose_item(a.in(20) + (size_t)l * DM * DM, DM, DM, (bf16*)(wl + OFFS_WOUT), nb * 32, kb * 64, nb * 32, scr, lane); return; }
    r -= IT_S3;
    if (r < IT_S4) { const int kb = r / 32, nb = r % 32; transpose_item(a.in(18) + (size_t)l * 512 * DM, DM, 512, (bf16*)(wl + OFFS_WCO), nb * 32, kb * 64, nb * 32, scr, lane); return; }
    r -= IT_S4;
    { const int kb = r / 32, nb = r % 32; transpose_item(a.in(19) + (size_t)l * 512 * DM, DM, 512, (bf16*)(wl + OFFS_WFO), nb * 32, kb * 64, nb * 32, scr, lane); }
}
constexpr int IT_MOE = NEXP * 3 * 512;
__device__ __forceinline__ void moe_item(const AV& a, int l, int idx, LAS float* scr, int lane) {
    const int e = idx / 1536, r = idx % 1536, which = r / 512, it = r % 512, kb = it / 32, n0 = (it % 32) * 32; const size_t eo = ((size_t)l * NEXP + e) << 20;
    if (which == 0) transpose_item(a.in(23) + eo, DM, DM, (bf16*)(a.ws() + WS_WGU) + (size_t)e * 2048 * 1024, (n0 >> 7) * 256 + (n0 & 127), kb * 64, n0, scr, lane);
    else if (which == 1) transpose_item(a.in(25) + eo, DM, DM, (bf16*)(a.ws() + WS_WGU) + (size_t)e * 2048 * 1024, (n0 >> 7) * 256 + 128 + (n0 & 127), kb * 64, n0, scr, lane);
    else transpose_item(a.in(27) + eo, DM, DM, (bf16*)(a.ws() + WS_WD) + (size_t)e * 1024 * 1024, n0, kb * 64, n0, scr, lane);
}
__device__ __forceinline__ void fold_job(const AV& a, int j, const LAS float* ct, int lane) {
    const int l = j >> 10, r = j & 1023, g = r >> 8, kblk = (r >> 4) & 15, k2g = r & 15, k = kblk * 64 + lane;
    const float* wrow = a.in(10) + (size_t)l * DM * INCOLS + (size_t)k * INCOLS + OFF_FNET + g * 128;
    float ac[8], as[8];
#pragma unroll
    for (int i = 0; i < 8; ++i) { ac[i] = 0.f; as[i] = 0.f; }
    for (int n4 = 0; n4 < 32; ++n4) { const f32x4 w = *(const GAS f32x4*)(wrow + n4 * 4);
#pragma unroll
        for (int q = 0; q < 4; ++q) { const int n2 = n4 * 4 + q;
#pragma unroll
            for (int i = 0; i < 8; ++i) { const int ph = (n2 * (k2g * 8 + i)) & 127; ac[i] += w[q] * ct[ph]; as[i] += w[q] * ct[(ph - 32) & 127]; } } }
    bf16* wf = (bf16*)(a.ws() + WS_WSMALL + (size_t)l * WSMALL_LAYER + OFFS_WF);
#pragma unroll
    for (int i = 0; i < 8; ++i) { const int ch = g * 128 + k2g * 8 + i;
        wf[(size_t)ch * 1024 + k] = (bf16)f2bf(ac[i] * 0.08838834764831845f); wf[(size_t)(512 + ch) * 1024 + k] = (bf16)f2bf(as[i] * 0.08838834764831845f); }
}
__device__ __forceinline__ void p0_prologue(const Frame& F, const AV& a) {
    const int gw = F.vcu * NWAVES + F.wave, NGW = F.G * NWAVES, gt = F.vcu * NTHR + F.tid, NGT = F.G * NTHR;
    LAS float* ct = (LAS float*)(F.lds + LDS_CT);
    if (F.tid < 128) ct[F.tid] = cospif((float)F.tid * (1.0f / 64.0f));
    for (int job = blockIdx.x; job < 2 * 96; job += F.G) {
        const int l = job / 96, n0 = (job % 96) * 64;
        LAS float* s = (LAS float*)(F.lds + RING_OFF); LAS float* red = s + 17 * 1024;
        for (int i = F.tid; i < 17 * 1024; i += NTHR) { const int b = i >> 10, k = i & 1023; const float cv = b < 16 ? a.in(1)[b * 1024 + k] : a.in(3)[k]; s[i] = cv * sigmoidf_(cv); }
        __syncthreads();
        const int col = F.tid & 63, ks = F.tid >> 6; float acc[17];
#pragma unroll
        for (int b = 0; b < 17; ++b) acc[b] = 0.f;
        const float* w = a.in(4) + (size_t)l * DM * INCOLS + n0 + col;
        for (int k = ks * 128; k < ks * 128 + 128; ++k) { const float wv = w[(size_t)k * INCOLS];
#pragma unroll
            for (int b = 0; b < 17; ++b) acc[b] += s[b * 1024 + k] * wv; }
#pragma unroll
        for (int b = 0; b < 17; ++b) red[(ks * 17 + b) * 64 + col] = acc[b];
        __syncthreads();
        for (int i = F.tid; i < 17 * 64; i += NTHR) { const int b = i >> 6, c2 = i & 63; float t = 0.f;
#pragma unroll
            for (int q = 0; q < 8; ++q) t += red[(q * 17 + b) * 64 + c2];
            ((float*)(a.ws() + WS_MOD))[((size_t)l * 17 + b) * INCOLS + n0 + c2] = t + a.in(5)[l * INCOLS + n0 + c2]; }
        __syncthreads();
    }
    __syncthreads();
    for (int i = gt; i < 64 * 32; i += NGT) { const int p = i >> 5, f = i & 31; const float inv = powf(10000.0f, -(float)f / 32.0f), ang = (float)p * inv; ((f32x2*)(a.ws() + WS_TAB))[i] = (f32x2){cosf(ang), sinf(ang)}; }
    for (int i = gt; i < 2048 * 512; i += NGT) { const int k1 = i >> 9, c0 = (i & 511) * 8; float v[8];
#pragma unroll
        for (int q = 0; q < 8; ++q) { const int col = c0 + q, n1 = col & 2047, rr = (k1 * n1) & 2047; const float x = (float)rr * (1.0f / 1024.0f); v[q] = (col >> 11) ? -sinpif(x) : cospif(x); v[q] *= 0.022097086912079608f; }
        v4u o; o.x = pk2(v[0], v[1]); o.y = pk2(v[2], v[3]); o.z = pk2(v[4], v[5]); o.w = pk2(v[6], v[7]); ((GAS v4u*)(a.ws() + WS_DFTL))[i] = o; }
    for (int i = gt; i < 256 * 64; i += NGT) { const int k1 = i >> 6, c0 = (i & 63) * 8; float v[8];
#pragma unroll
        for (int q = 0; q < 8; ++q) { const int col = c0 + q, n1 = col & 255, rr = (k1 * n1) & 255; const float x = (float)rr * (1.0f / 128.0f); v[q] = (col >> 8) ? -sinpif(x) : cospif(x); v[q] *= 0.0625f; }
        v4u o; o.x = pk2(v[0], v[1]); o.y = pk2(v[2], v[3]); o.z = pk2(v[4], v[5]); o.w = pk2(v[6], v[7]); ((GAS v4u*)(a.ws() + WS_DFTC))[i] = o; }
    for (int i = gt; i < 2 * 256 * 1024; i += NGT) { const int l = i >> 18, r = (i >> 10) & 255, k = i & 1023; unsigned o = 0u;
        if (r < 64) { const float w = a.in(21)[((size_t)l * DM + k) * NEXP + (r & 31)]; const unsigned hi = f2bf(w); o = hi; if (r >= 32) o = f2bf(w - __uint_as_float(hi << 16)); }
        ((bf16*)(a.ws() + WS_WSMALL + (size_t)l * WSMALL_LAYER + OFFS_ROUT))[(size_t)r * 1024 + k] = (bf16)o; }
    for (int j = gw; j < 2048; j += NGW) fold_job(a, j, ct, F.lane);
    LAS float* scr = (LAS float*)(F.lds + RING_OFF + F.wave * 16384);
    for (int it = gw; it < 2 * IT_SMALL; it += NGW) small_item(a, it / IT_SMALL, it % IT_SMALL, scr, F.lane);
    for (int it = gw; it < IT_MOE; it += NGW) moe_item(a, 0, it, scr, F.lane);
}
__device__ __forceinline__ void p1_norm0(const Frame& F, const AV& a) {
    const int gw = F.vcu * NWAVES + F.wave, NGW = F.G * NWAVES;
    for (int m = gw; m < TALL; m += NGW) {
        f32x4 v[4]; ld_row_f32(v, m < TL ? a.in(0) + (size_t)m * DM : a.in(2) + (size_t)(m - TL) * DM, F.lane);
        rms_gain(v, a.in(6), F.lane);
        const float* modv = (const float*)(a.ws() + WS_MOD) + (size_t)(m < TL ? (m >> 11) : 16) * INCOLS;
        modulate_store(v, modv, modv + 1024, (bf16*)(a.ws() + WS_H) + (size_t)m * DM, F.lane);
    }
}
__device__ __forceinline__ void qk_fix_vec(bf16* p, const float* g, const f32x2* tab, bool rope, int t, int sub, int lane) {
    f32x4 x[4]; float ss = 0.f;
#pragma unroll
    for (int jj = 0; jj < 4; ++jj) { x[jj] = bf4(*(const GAS u32x2*)(p + jj * 32 + sub * 4)); ss += (x[jj][0] * x[jj][0] + x[jj][1] * x[jj][1]) + (x[jj][2] * x[jj][2] + x[jj][3] * x[jj][3]); }
    ss += shx(ss, 1, lane); ss += shx(ss, 2, lane); ss += shx(ss, 4, lane);
    const float r = 1.0f / sqrtf(ss * (1.0f / 128.0f) + EPS);
#pragma unroll
    for (int jj = 0; jj < 4; ++jj) { const f32x4 gg = *(const GAS f32x4*)(g + jj * 32 + sub * 4); x[jj] = x[jj] * r * gg; }
    if (rope) { const int pr = t >> 6, pc = t & 63;
#pragma unroll
        for (int i = 0; i < 4; ++i) { const f32x2 cr = tab[pr * 32 + sub * 4 + i], cc = tab[pc * 32 + sub * 4 + i];
            const float a0 = x[0][i], a1 = x[1][i], b0 = x[2][i], b1 = x[3][i];
            x[0][i] = a0 * cr.x - a1 * cr.y; x[1][i] = a1 * cr.x + a0 * cr.y; x[2][i] = b0 * cc.x - b1 * cc.y; x[3][i] = b1 * cc.x + b0 * cc.y; } }
#pragma unroll
    for (int jj = 0; jj < 4; ++jj) *(GAS u32x2*)(p + jj * 32 + sub * 4) = pk4(x[jj]);
}
__device__ __forceinline__ void p_qkfix(const Frame& F, const AV& a, int l, int M) {
    const int gw = F.vcu * NWAVES + F.wave, NGW = F.G * NWAVES; const f32x2* tab = (const f32x2*)(a.ws() + WS_TAB);
    for (int m = gw; m < M; m += NGW) { const bool lat = m < TL; const int t = m & 2047, hh = F.lane >> 3, sub = F.lane & 7;
        if (lat || l == 0) qk_fix_vec((bf16*)(a.ws() + WS_Q) + (size_t)m * DM + hh * 128, a.in(11) + l * 128, tab, lat, t, sub, F.lane);
        if (F.lane < 16) qk_fix_vec((bf16*)(a.ws() + WS_K) + (size_t)krow_of(m) * 256 + hh * 128, a.in(12) + l * 128, tab, lat, t, sub, F.lane);
    }
}
__device__ __forceinline__ void p_conv(const Frame& F, const AV& a, int l, int njobs) {
    LAS unsigned char* lin = F.lds + RING_OFF; LAS float* lout = (LAS float*)(F.lds + RING_OFF + 62 * 1024);
    const bf16* cu = (const bf16*)(a.ws() + WS_CU); bf16* chb = (bf16*)(a.ws() + WS_CH);
    const int cp = F.tid & 255, pg = F.tid >> 8;
    f32x2 wv[31];
#pragma unroll
    for (int j = 0; j < 31; ++j) wv[j] = *(const GAS f32x2*)(a.in(14) + ((size_t)l * 31 + j) * 512 + 2 * cp);
    const f32x2 cb2 = *(const GAS f32x2*)(a.in(15) + l * 512 + 2 * cp);
    for (int job = F.vcu; job < njobs; job += F.G) {
        int rowbase, L, t0;
        if (job < 1024) { rowbase = (job >> 6) * SEQ; L = SEQ; t0 = (job & 63) * 32; } else { const int jc = job - 1024; rowbase = TL + (jc >> 3) * CTXL; L = CTXL; t0 = (jc & 7) * 32; }
        for (int idx = F.tid; idx < 62 * 64; idx += NTHR) { const int row = idx >> 6, ch = idx & 63, p = t0 - 15 + row; v4u val = (v4u){0u, 0u, 0u, 0u};
            if (p >= 0 && p < L) val = *(const GAS v4u*)(cu + (size_t)(rowbase + p) * 512 + ch * 8);
            *(LAS v4u*)(lin + row * 1024 + ch * 16) = val; }
        __syncthreads();
#pragma unroll
        for (int chunk = 0; chunk < 2; ++chunk) {
            f32x2 acc[8];
#pragma unroll
            for (int i = 0; i < 8; ++i) acc[i] = cb2;
            const int r0 = pg * 16 + chunk * 8;
#pragma unroll
            for (int r = 0; r < 38; ++r) { const unsigned w = *(const LAS unsigned*)(lin + (r0 + r) * 1024 + cp * 4); const float x0 = __uint_as_float(w << 16), x1 = __uint_as_float(w & 0xffff0000u);
#pragma unroll
                for (int i = 0; i < 8; ++i) { const int j = r - i; if (j >= 0 && j <= 30) { acc[i].x += x0 * wv[j].x; acc[i].y += x1 * wv[j].y; } } }
#pragma unroll
            for (int i = 0; i < 8; ++i) *(LAS f32x2*)(lout + (r0 + i) * 512 + 2 * cp) = acc[i];
        }
        __syncthreads();
#pragma unroll
        for (int pp = 0; pp < 4; ++pp) { const int p = F.wave * 4 + pp; const LAS float* src = lout + p * 512 + F.lane * 8;
            f32x4 y0 = *(const LAS f32x4*)src, y1 = *(const LAS f32x4*)(src + 4);
            const float mean = wave_sum((y0[0] + y0[1]) + (y0[2] + y0[3]) + (y1[0] + y1[1]) + (y1[2] + y1[3]), F.lane) * (1.0f / 512.0f);
            y0 = y0 - mean; y1 = y1 - mean;
            const float var = wave_sum((y0[0] * y0[0] + y0[1] * y0[1]) + (y0[2] * y0[2] + y0[3] * y0[3]) + (y1[0] * y1[0] + y1[1] * y1[1]) + (y1[2] * y1[2] + y1[3] * y1[3]), F.lane) * (1.0f / 512.0f);
            const float rs = 1.0f / sqrtf(var + EPS);
            const f32x4 g0 = *(const GAS f32x4*)(a.in(16) + l * 512 + F.lane * 8), g1 = *(const GAS f32x4*)(a.in(16) + l * 512 + F.lane * 8 + 4);
            const f32x4 b0 = *(const GAS f32x4*)(a.in(17) + l * 512 + F.lane * 8), b1 = *(const GAS f32x4*)(a.in(17) + l * 512 + F.lane * 8 + 4);
            y0 = y0 * rs * g0 + b0; y1 = y1 * rs * g1 + b1;
#pragma unroll
            for (int q = 0; q < 4; ++q) { y0[q] = y0[q] * sigmoidf_(y0[q]); y1[q] = y1[q] * sigmoidf_(y1[q]); }
            v4u o; o.x = pk2(y0[0], y0[1]); o.y = pk2(y0[2], y0[3]); o.z = pk2(y1[0], y1[1]); o.w = pk2(y1[2], y1[3]);
            *(GAS v4u*)(chb + (size_t)(rowbase + t0 + p) * 512 + F.lane * 8) = o; }
        __syncthreads();
    }
}
__device__ __forceinline__ void p_rowpass1(const Frame& F, const AV& a, int l, int M) {
    const int gw = F.vcu * NWAVES + F.wave, NGW = F.G * NWAVES;
    for (int m = gw; m < M; m += NGW) {
        const float* xs = (l == 0) ? (m < TL ? a.in(0) + (size_t)m * DM : a.in(2) + (size_t)(m - TL) * DM) : (m < TL ? a.out() + (size_t)m * DM : (const float*)(a.ws() + WS_XC) + (size_t)(m - TL) * DM);
        float* xd = m < TL ? a.out() + (size_t)m * DM : (float*)(a.ws() + WS_XC) + (size_t)(m - TL) * DM;
        const float* modv = (const float*)(a.ws() + WS_MOD) + ((size_t)l * 17 + (m < TL ? (m >> 11) : 16)) * INCOLS;
        f32x4 x[4], y[4]; ld_row_f32(x, xs, F.lane); ld_row_bf16(y, (const bf16*)(a.ws() + WS_MIX) + (size_t)m * DM, F.lane);
        rms_gain(y, a.in(7) + l * DM, F.lane);
#pragma unroll
        for (int j = 0; j < 4; ++j) { const f32x4 gt = ((const GAS f32x4*)(modv + 2 * 1024))[F.lane + 64 * j]; x[j] = x[j] + gt * y[j]; }
        st_row_f32(x, xd, F.lane);
        rms_gain(x, a.in(8) + l * DM, F.lane);
        modulate_store(x, modv + 3 * 1024, modv + 4 * 1024, (bf16*)(a.ws() + WS_H) + (size_t)m * DM, F.lane);
    }
}
__device__ __forceinline__ void p_topk(const Frame& F, const AV& a, int l, int M) {
    LAS int* cntl = (LAS int*)(F.lds + LDS_SM);
    if (F.tid < 32) cntl[F.tid] = 0;
    __syncthreads();
    const int TPB = (M + F.G - 1) / F.G, m0 = blockIdx.x * TPB, m1 = (m0 + TPB < M) ? m0 + TPB : M;
    const float* lg = (const float*)(a.ws() + WS_LOGIT);
    for (int m = m0 + F.wave; m < m1; m += NWAVES) {
        float v = -3.0e38f;
        if (F.lane < 32) v = lg[(size_t)m * 64 + F.lane] + lg[(size_t)m * 64 + 32 + F.lane] + a.in(22)[l * NEXP + F.lane];
        unsigned ub = __float_as_uint(v); ub = (ub & 0x80000000u) ? ~ub : (ub | 0x80000000u);
        unsigned long long key = ((unsigned long long)ub << 32) | (unsigned)(63 - F.lane);
        int ids[4]; float vals[4];
#pragma unroll
        for (int k = 0; k < 4; ++k) { unsigned long long mx = key;
#pragma unroll
            for (int o = 1; o < 64; o <<= 1) { const int pa = (F.lane ^ o) << 2; const unsigned long long t = ((unsigned long long)(unsigned)__builtin_amdgcn_ds_bpermute(pa, (int)(unsigned)(mx >> 32)) << 32) | (unsigned)__builtin_amdgcn_ds_bpermute(pa, (int)(unsigned)mx); mx = t > mx ? t : mx; }
            const int id = 63 - (int)(mx & 63ull); ids[k] = id; vals[k] = __int_as_float(__builtin_amdgcn_ds_bpermute(id << 2, __float_as_int(v))); if (F.lane == id) key = 0ull; }
        const float e1 = __expf(vals[1] - vals[0]), e2 = __expf(vals[2] - vals[0]), e3 = __expf(vals[3] - vals[0]), inv = 1.0f / (1.0f + e1 + e2 + e3);
        if (F.lane == 0) { *(GAS i32x4*)((int*)(a.ws() + WS_TOPI) + (size_t)m * 4) = (i32x4){ids[0], ids[1], ids[2], ids[3]};
            *(GAS f32x4*)((float*)(a.ws() + WS_TOPP) + (size_t)m * 4) = (f32x4){inv, e1 * inv, e2 * inv, e3 * inv}; }
        if (F.lane < 4) __hip_atomic_fetch_add(&cntl[F.lane == 0 ? ids[0] : F.lane == 1 ? ids[1] : F.lane == 2 ? ids[2] : ids[3]], 1, __ATOMIC_RELAXED, __HIP_MEMORY_SCOPE_WORKGROUP);
    }
    __syncthreads();
    if (F.tid < 32) ((int*)(a.ws() + WS_CNT))[blockIdx.x * 32 + F.tid] = cntl[F.tid];
}
__device__ __forceinline__ void p_slots(const Frame& F, const AV& a, int M) {
    LAS int* sm = (LAS int*)(F.lds + LDS_SM);
    LAS int *tot = sm, *bef = sm + 32, *base = sm + 64, *tst = sm + 96  , *mask = sm + 160  , *ids = sm + 320  , *slot = sm + 960  ;
    const int* cnt = (const int*)(a.ws() + WS_CNT);
    { LAS int* ptot = sm + 1600; LAS int* pbef = sm + 2112; const int e = F.tid & 31, part = F.tid >> 5; int t = 0, b = 0;
#pragma unroll 4
      for (int q = part; q < F.G; q += 16) { const int c = cnt[q * 32 + e]; t += c; if (q < (int)blockIdx.x) b += c; }
      ptot[part * 32 + e] = t; pbef[part * 32 + e] = b;
      __syncthreads();
      if (F.tid < 32) { int tt = 0, bb = 0;
#pragma unroll
          for (int q = 0; q < 16; ++q) { tt += ptot[q * 32 + F.tid]; bb += pbef[q * 32 + F.tid]; }
          tot[F.tid] = tt; bef[F.tid] = bb; } }
    __syncthreads();
    if (F.tid == 0) { int ts = 0; for (int e = 0; e < 32; ++e) { tst[e] = ts; base[e] = ts * 256 + bef[e]; ts += (tot[e] + 255) >> 8; } tst[32] = ts; }
    __syncthreads();
    const int NT = tst[32];
    if (blockIdx.x == 0) { int* te = (int*)(a.ws() + WS_CNT) + CNT_TILE_E;
        for (int t = F.tid; t < NT; t += NTHR) { int e = 0; for (int q = 1; q < 32; ++q) if (t >= tst[q]) e = q; te[t] = e; }
        if (F.tid == 0) ((int*)(a.ws() + WS_CNT))[CNT_NT] = NT; }
    const int TPB = (M + F.G - 1) / F.G, m0 = blockIdx.x * TPB, m1 = (m0 + TPB < M) ? m0 + TPB : M, nt = m1 > m0 ? m1 - m0 : 0;
    for (int tl = F.tid; tl < nt; tl += NTHR) { const i32x4 id = *(const GAS i32x4*)((const int*)(a.ws() + WS_TOPI) + (size_t)(m0 + tl) * 4);
        ids[tl * 4 + 0] = id.x; ids[tl * 4 + 1] = id.y; ids[tl * 4 + 2] = id.z; ids[tl * 4 + 3] = id.w; mask[tl] = (1 << id.x) | (1 << id.y) | (1 << id.z) | (1 << id.w); }
    __syncthreads();
    for (int p = F.tid; p < nt * 4; p += NTHR) { const int tl = p >> 2, e = ids[p]; int rank = 0; for (int q = 0; q < tl; ++q) rank += (mask[q] >> e) & 1;
        const int s = base[e] + rank; slot[p] = s; ((int*)(a.ws() + WS_SLOT))[(size_t)(m0 + tl) * 4 + (p & 3)] = s; }
    __syncthreads();
    const bf16* h = (const bf16*)(a.ws() + WS_H); bf16* hs = (bf16*)(a.ws() + WS_HS);
    for (int p = F.wave; p < nt * 4; p += NWAVES) { const GAS v4u* src = (const GAS v4u*)(h + (size_t)(m0 + (p >> 2)) * DM); GAS v4u* dst = (GAS v4u*)(hs + (size_t)slot[p] * DM);
        const v4u x0 = src[F.lane], x1 = src[F.lane + 64]; dst[F.lane] = x0; dst[F.lane + 64] = x1; }
    if (blockIdx.x < 32) { const int e = blockIdx.x, r0 = tst[e] * 256 + tot[e], r1 = tst[e + 1] * 256;
        for (int r = r0 + F.wave; r < r1; r += NWAVES) { GAS v4u* dst = (GAS v4u*)(hs + (size_t)r * DM); dst[F.lane] = (v4u){0u, 0u, 0u, 0u}; dst[F.lane + 64] = (v4u){0u, 0u, 0u, 0u}; } }
    __syncthreads();
}
__device__ __forceinline__ void p_combine(const Frame& F, const AV& a, int l, int M) {
    const int gw = F.vcu * NWAVES + F.wave, NGW = F.G * NWAVES; const bf16* ys = (const bf16*)(a.ws() + WS_HS);
    for (int m = gw; m < M; m += NGW) {
        const i32x4 sl = *(const GAS i32x4*)((const int*)(a.ws() + WS_SLOT) + (size_t)m * 4); const f32x4 pr = *(const GAS f32x4*)((const float*)(a.ws() + WS_TOPP) + (size_t)m * 4);
        f32x4 y[4], t[4];
        ld_row_bf16(y, ys + (size_t)sl.x * DM, F.lane);
#pragma unroll
        for (int j = 0; j < 4; ++j) y[j] = y[j] * pr[0];
        ld_row_bf16(t, ys + (size_t)sl.y * DM, F.lane);
#pragma unroll
        for (int j = 0; j < 4; ++j) y[j] += t[j] * pr[1];
        ld_row_bf16(t, ys + (size_t)sl.z * DM, F.lane);
#pragma unroll
        for (int j = 0; j < 4; ++j) y[j] += t[j] * pr[2];
        ld_row_bf16(t, ys + (size_t)sl.w * DM, F.lane);
#pragma unroll
        for (int j = 0; j < 4; ++j) y[j] += t[j] * pr[3];
        rms_gain(y, a.in(9) + l * DM, F.lane);
        float* xd = m < TL ? a.out() + (size_t)m * DM : (float*)(a.ws() + WS_XC) + (size_t)(m - TL) * DM;
        const int b = m < TL ? (m >> 11) : 16;
        const float* modv = (const float*)(a.ws() + WS_MOD) + ((size_t)l * 17 + b) * INCOLS;
        f32x4 x[4]; ld_row_f32(x, xd, F.lane);
#pragma unroll
        for (int j = 0; j < 4; ++j) { const f32x4 gt = ((const GAS f32x4*)(modv + 5 * 1024))[F.lane + 64 * j]; x[j] = x[j] + gt * y[j]; }
        st_row_f32(x, xd, F.lane);
        if (l == 0) { rms_gain(x, a.in(6) + DM, F.lane); const float* mod1 = (const float*)(a.ws() + WS_MOD) + ((size_t)17 + b) * INCOLS;
            modulate_store(x, mod1, mod1 + 1024, (bf16*)(a.ws() + WS_H) + (size_t)m * DM, F.lane); }
    }
}
#ifdef DBG_CHECK
#ifndef DBG_GSUB
#define DBG_GSUB 0
#endif
__device__ __forceinline__ double bfd(bf16 b) { return (double)__uint_as_float(((unsigned)b) << 16); }
__device__ __forceinline__ unsigned hsh(unsigned x) { x ^= x >> 16; x *= 0x7feb352du; x ^= x >> 15; x *= 0x846ca68bu; x ^= x >> 16; return x; }
__device__ __forceinline__ int samp_row(int i, int M, unsigned salt) { const int sp[12] = {0, 1, 255, 256, 2047, 2048, 4095, 32767, 32768, 32769, 33023, 36863}; if (i < 12 && sp[i] < M) return sp[i]; return (int)(hsh(i * 7919u + salt) % (unsigned)M); }
__device__ __forceinline__ void rec(float* res, int stage, double got, double want, double flo) { const double e = fabs(got - want) / (fabs(want) + flo); const float f = (e == e) ? (float)e : 1e30f; atomicMax((unsigned*)res + stage, __float_as_uint(f)); }
__device__ double dot_h_w(const bf16* hrow, const float* w, int ldw, int col) { double s = 0; for (int k = 0; k < 1024; ++k) s += bfd(hrow[k]) * (double)w[(size_t)k * ldw + col]; return s; }
__device__ double dsig(double x) { return 1.0 / (1.0 + exp(-x)); }
constexpr double PI_D = 3.14159265358979323846;
enum { ST_MOD = 0, ST_H0, ST_INPROJ, ST_YT, ST_QKFIX, ST_CONV, ST_Z, ST_ATTN, ST_GATES, ST_MERGED, ST_MIX, ST_ROW1, ST_LOGIT, ST_TOPK, ST_SLOTS, ST_ACT, ST_YSLOT, ST_COMB, ST_GATESB, ST_N };
__global__ void chk(Args A, int stage, int l, float* res, float* snap) {
    const int i = threadIdx.x; unsigned char* ws = A.ws; const int M = (l == 0) ? TALL : TL; const int rs = stage + 32 * l;
    const bf16* H = (const bf16*)(ws + WS_H); const float* win = A.in[10] + (size_t)l * DM * INCOLS; const float* modb = (const float*)(ws + WS_MOD);
    if (stage == ST_MOD) { const int ll = i & 1, b = (i >> 1) % 17, n = (int)(hsh(i) % 6144u); double s = 0; for (int k = 0; k < 1024; ++k) { const double cv = b < 16 ? A.in[1][b * 1024 + k] : A.in[3][k]; s += cv * dsig(cv) * (double)A.in[4][((size_t)ll * 1024 + k) * 6144 + n]; }
        s += A.in[5][ll * 6144 + n]; rec(res, rs, modb[((size_t)ll * 17 + b) * 6144 + n], s, 0.02); }
    else if (stage == ST_H0) { const int m = samp_row(i, TALL, 1), c = (int)(hsh(i + 77) % 1024u); const float* x = m < TL ? A.in[0] + (size_t)m * DM : A.in[2] + (size_t)(m - TL) * DM; double ss = 0; for (int k = 0; k < 1024; ++k) ss += (double)x[k] * x[k];
        const float* mv = modb + (size_t)(m < TL ? (m >> 11) : 16) * 6144; const double want = x[c] / sqrt(ss / 1024 + 1e-6) * A.in[6][c] * (1.0 + mv[1024 + c]) + mv[c]; rec(res, rs, bfd(H[(size_t)m * DM + c]), want, 0.05); }
    else if (stage == ST_INPROJ) { const int m = samp_row(i, TALL, 2), kind = i & 3; const bf16* hr = H + (size_t)m * DM;
        if (kind == 0) { const int n = (int)(hsh(i + 5) % 1024u); rec(res, rs, bfd(((const bf16*)(ws + WS_Q))[(size_t)m * DM + n]), dot_h_w(hr, win, INCOLS, n), 0.05); }
        else if (kind == 1) { const int n = (int)(hsh(i + 6) % 256u); rec(res, rs, bfd(((const bf16*)(ws + WS_K))[(size_t)krow_of(m) * 256 + n]), dot_h_w(hr, win, INCOLS, 1024 + n), 0.05); }
        else if (kind == 2) { const int n = (int)(hsh(i + 7) % 256u); rec(res, rs, bfd(((const bf16*)(ws + WS_V))[(size_t)krow_of(m) * 256 + n]), dot_h_w(hr, win, INCOLS, 1280 + n), 0.05); }
        else { const int c = (int)(hsh(i + 8) % 512u); if (l == 0 || m < TL) { const double a = dot_h_w(hr, win, INCOLS, 1536 + c), g = dot_h_w(hr, win, INCOLS, 2048 + c); rec(res, rs, bfd(((const bf16*)(ws + WS_CU))[(size_t)m * 512 + c]), a * dsig(g), 0.05); } } }
    else if (stage == ST_YT) { const int m = samp_row(i, M, 3), ch = (int)(hsh(i + 9) % 512u), cs = i & 1, g = ch >> 7, k2 = ch & 127; const bf16* hr = H + (size_t)m * DM; double s = 0;
        for (int k = 0; k < 1024; ++k) { double t = 0; for (int n2 = 0; n2 < 128; ++n2) { const double ang = 2.0 * PI_D * ((n2 * k2) & 127) / 128.0; t += (double)win[(size_t)k * INCOLS + OFF_FNET + g * 128 + n2] * (cs ? sin(ang) : cos(ang)); } s += bfd(hr[k]) * t; }
        s /= sqrt(128.0); double got; if (m < TL) got = bfd(((const bf16*)(ws + WS_YT))[((size_t)(m >> 11) * 512 + ch) * 4096 + cs * 2048 + (m & 2047)]); else got = bfd(((const bf16*)(ws + WS_YTC))[((size_t)((m - TL) >> 8) * 512 + ch) * 512 + cs * 256 + ((m - TL) & 255)]);
        rec(res, rs, got, s, 0.05); }
    else if (stage == ST_QKFIX) { const int m = samp_row(i, TALL, 4), isk = i & 1, hh = isk ? (int)(hsh(i + 3) % 2u) : (int)(hsh(i + 3) % 8u), d = (int)(hsh(i + 4) % 128u); const bf16* hr = H + (size_t)m * DM;
        if (isk || l == 0 || m < TL) { const int cbase = isk ? 1024 + hh * 128 : hh * 128; double ss = 0, xd = 0, xp = 0; const int half = d & 64, dd = d & 63, pd = half + ((dd + 32) & 63);
            for (int q = 0; q < 128; ++q) { double v = dot_h_w(hr, win, INCOLS, cbase + q); v = bfd((bf16)f2bf((float)v)); ss += v * v; if (q == d) xd = v; if (q == pd) xp = v; }
            const float* gn = (isk ? A.in[12] : A.in[11]) + l * 128; const double r = 1.0 / sqrt(ss / 128 + 1e-6); xd *= r * gn[d]; xp *= r * gn[pd]; double want = xd;
            if (m < TL) { const int t = m & 2047, pos = half ? (t & 63) : (t >> 6), f = dd & 31; const double ang = (double)((float)pos * powf(10000.0f, -(float)f / 32.0f)); want = (dd < 32) ? xd * cos(ang) - xp * sin(ang) : xd * cos(ang) + xp * sin(ang); }
            const double got = isk ? bfd(((const bf16*)(ws + WS_K))[(size_t)krow_of(m) * 256 + hh * 128 + d]) : bfd(((const bf16*)(ws + WS_Q))[(size_t)m * DM + hh * 128 + d]); rec(res, rs, got, want, 0.05); } }
    else if (stage == ST_CONV) { const int m = samp_row(i, M, 5), c = (int)(hsh(i + 11) % 512u); const int rowbase = m < TL ? (m >> 11) * SEQ : TL + ((m - TL) >> 8) * CTXL, L = m < TL ? SEQ : CTXL, t = m - rowbase; const bf16* cu = (const bf16*)(ws + WS_CU);
        double s1 = 0, s2 = 0, yc = 0; for (int cc = 0; cc < 512; ++cc) { double y = A.in[15][l * 512 + cc]; for (int j = 0; j < 31; ++j) { const int p = t + j - 15; if (p >= 0 && p < L) y += bfd(cu[(size_t)(rowbase + p) * 512 + cc]) * (double)A.in[14][((size_t)l * 31 + j) * 512 + cc]; } s1 += y; s2 += y * y; if (cc == c) yc = y; }
        const double mean = s1 / 512, var = s2 / 512 - mean * mean; double y = (yc - mean) / sqrt(var + 1e-6) * A.in[16][l * 512 + c] + A.in[17][l * 512 + c]; y = y * dsig(y); rec(res, rs, bfd(((const bf16*)(ws + WS_CH))[(size_t)m * 512 + c]), y, 0.05); }
    else if (stage == ST_Z) { const int m = samp_row(i, M, 6), ch = (int)(hsh(i + 12) % 512u); double s = 0;
        if (m < TL) { const int b = m >> 11, k1 = m & 2047; const bf16* yr = (const bf16*)(ws + WS_YT) + ((size_t)b * 512 + ch) * 4096; for (int n1 = 0; n1 < 2048; ++n1) { const double ang = 2.0 * PI_D * ((k1 * n1) & 2047) / 2048.0; s += cos(ang) * bfd(yr[n1]) - sin(ang) * bfd(yr[2048 + n1]); } s /= sqrt(2048.0); }
        else { const int b = (m - TL) >> 8, k1 = (m - TL) & 255; const bf16* yr = (const bf16*)(ws + WS_YTC) + ((size_t)b * 512 + ch) * 512; for (int n1 = 0; n1 < 256; ++n1) { const double ang = 2.0 * PI_D * ((k1 * n1) & 255) / 256.0; s += cos(ang) * bfd(yr[n1]) - sin(ang) * bfd(yr[256 + n1]); } s /= 16.0; }
        rec(res, rs, bfd(((const bf16*)(ws + WS_Z))[(size_t)m * 512 + ch]), s, 0.05); }
    else if (stage == ST_ATTN) { const int m = samp_row(i, M, 7), hh = (int)(hsh(i + 13) % 8u), d = (int)(hsh(i + 14) % 128u); const bf16* q = (const bf16*)(ws + WS_Q) + (size_t)m * DM + hh * 128;
        int kr0, nk; if (m < TL) { kr0 = (m >> 11) * KVROWS; nk = KVROWS; } else { kr0 = ((m - TL) >> 8) * KVROWS + SEQ; nk = CTXL; }
        const bf16* K = (const bf16*)(ws + WS_K) + (size_t)kr0 * 256 + (hh >> 2) * 128; const bf16* V = (const bf16*)(ws + WS_V) + (size_t)kr0 * 256 + (hh >> 2) * 128;
        double mx = -1e300; for (int j = 0; j < nk; ++j) { double s = 0; for (int q2 = 0; q2 < 128; ++q2) s += bfd(q[q2]) * bfd(K[(size_t)j * 256 + q2]); s *= 0.08838834764831845; if (s > mx) mx = s; }
        double den = 0, num = 0; for (int j = 0; j < nk; ++j) { double s = 0; for (int q2 = 0; q2 < 128; ++q2) s += bfd(q[q2]) * bfd(K[(size_t)j * 256 + q2]); s *= 0.08838834764831845; const double p = exp(s - mx); den += p; num += p * bfd(V[(size_t)j * 256 + d]); }
        rec(res, rs, bfd(((const bf16*)(ws + WS_AO))[(size_t)m * DM + hh * 128 + d]), num / den, 0.03); }
    else if (stage == ST_GATES) { const int m = samp_row(i, M, 8), n = (int)(hsh(i + 15) % 3072u); rec(res, rs, bfd(((const bf16*)(ws + WS_GATES))[(size_t)m * 3072 + n]), dsig(dot_h_w(H + (size_t)m * DM, win, INCOLS, OFF_GATE + n)), 0.05); }
    else if (stage == ST_GATESB && DBG_GSUB == 1) { const int m = samp_row(i, M, 8), n = (int)(hsh(i + 15) % 3072u); const double got = bfd(((const bf16*)(ws + WS_GATES))[(size_t)m * 3072 + n]), want = dsig(dot_h_w(H + (size_t)m * DM, win, INCOLS, OFF_GATE + n));
        const bool badv = !(fabs(got - want) <= 0.05); if (badv) { unsigned* r = (unsigned*)res + 48; atomicOr(r, (m < TL ? 1u : 2u) | (4u << (n >> 10)) | (i < 12 ? 32u : 0u)); } }
    else if (stage == ST_GATESB) { const int m = samp_row(i, M, 8), n = (int)(hsh(i + 15) % 3072u); const bf16* wt = (const bf16*)(ws + WS_WSMALL + (size_t)l * WSMALL_LAYER + OFFS_WG) + (size_t)n * 1024; const bf16* hr = H + (size_t)m * DM; double s = 0; for (int k = 0; k < 1024; ++k) s += bfd(hr[k]) * bfd(wt[k]);
        rec(res, rs, bfd(((const bf16*)(ws + WS_GATES))[(size_t)m * 3072 + n]), dsig(s), 0.05); }
    else if (stage == ST_MERGED) { const int m = samp_row(i, M, 9), c = (int)(hsh(i + 16) % 1024u); const bf16* g = (const bf16*)(ws + WS_GATES) + (size_t)m * 3072; double y0 = 0, y1 = 0, y2 = 0;
        const bf16* ao = (const bf16*)(ws + WS_AO) + (size_t)m * DM; const bf16* chh = (const bf16*)(ws + WS_CH) + (size_t)m * 512; const bf16* z = (const bf16*)(ws + WS_Z) + (size_t)m * 512;
        for (int k = 0; k < 1024; ++k) y0 += bfd(ao[k]) * (double)A.in[13][((size_t)l * 1024 + k) * 1024 + c];
        for (int k = 0; k < 512; ++k) { y1 += bfd(chh[k]) * (double)A.in[18][((size_t)l * 512 + k) * 1024 + c]; y2 += bfd(z[k]) * (double)A.in[19][((size_t)l * 512 + k) * 1024 + c]; }
        rec(res, rs, bfd(((const bf16*)(ws + WS_MERGED))[(size_t)m * DM + c]), bfd(g[c]) * y0 + bfd(g[1024 + c]) * y1 + bfd(g[2048 + c]) * y2, 0.05); }
    else if (stage == ST_MIX) { const int m = samp_row(i, M, 10), c = (int)(hsh(i + 17) % 1024u); rec(res, rs, bfd(((const bf16*)(ws + WS_MIX))[(size_t)m * DM + c]), dot_h_w((const bf16*)(ws + WS_MERGED) + (size_t)m * DM, A.in[20] + (size_t)l * DM * DM, DM, c), 0.05); }
    else if (stage == ST_ROW1) { const int m = samp_row(i, M, 11), c = (int)(hsh(i + 18) % 1024u); const float* xs = snap + (size_t)i * 1024;
        const bf16* mix = (const bf16*)(ws + WS_MIX) + (size_t)m * DM; const float* mv = modb + ((size_t)l * 17 + (m < TL ? (m >> 11) : 16)) * 6144; double ss = 0; for (int k = 0; k < 1024; ++k) ss += bfd(mix[k]) * bfd(mix[k]); const double r = 1.0 / sqrt(ss / 1024 + 1e-6);
        double s2 = 0, xc = 0; for (int k = 0; k < 1024; ++k) { const double xn = xs[k] + mv[2048 + k] * (bfd(mix[k]) * r * A.in[7][l * DM + k]); s2 += xn * xn; if (k == c) xc = xn; }
        const float* xd = m < TL ? A.out + (size_t)m * DM : (const float*)(ws + WS_XC) + (size_t)(m - TL) * DM; rec(res, rs, xd[c], xc, 0.02);
        rec(res, rs, bfd(H[(size_t)m * DM + c]), xc / sqrt(s2 / 1024 + 1e-6) * A.in[8][l * DM + c] * (1.0 + mv[4096 + c]) + mv[3072 + c], 0.05); }
    else if (stage == ST_LOGIT) { const int m = samp_row(i, M, 12), e = i & 31; const float* lg = (const float*)(ws + WS_LOGIT) + (size_t)m * 64; rec(res, rs, (double)lg[e] + lg[32 + e], dot_h_w(H + (size_t)m * DM, A.in[21] + (size_t)l * DM * NEXP, NEXP, e), 0.02); }
    else if (stage == ST_TOPK) { const int m = samp_row(i, M, 13); const float* lg = (const float*)(ws + WS_LOGIT) + (size_t)m * 64; float v[32]; for (int e = 0; e < 32; ++e) v[e] = lg[e] + lg[32 + e] + A.in[22][l * 32 + e];
        int id[4]; float tv[4]; for (int k = 0; k < 4; ++k) { int b = -1; for (int e = 0; e < 32; ++e) { bool used = false; for (int q = 0; q < k; ++q) used |= (id[q] == e); if (!used && (b < 0 || v[e] > v[b])) b = e; } id[k] = b; tv[k] = v[b]; }
        double den = 0; for (int k = 0; k < 4; ++k) den += exp((double)tv[k] - tv[0]); const int* gi = (const int*)(ws + WS_TOPI) + (size_t)m * 4; const float* gp = (const float*)(ws + WS_TOPP) + (size_t)m * 4;
        for (int k = 0; k < 4; ++k) { rec(res, rs, gi[k] == id[k] ? 0.0 : 1.0, 0, 0.01); rec(res, rs, gp[k], exp((double)tv[k] - tv[0]) / den, 0.01); } }
    else if (stage == ST_SLOTS) { const int m = samp_row(i, M, 14), k = i & 3; const int s = ((const int*)(ws + WS_SLOT))[(size_t)m * 4 + k], e = ((const int*)(ws + WS_TOPI))[(size_t)m * 4 + k]; const int NT = ((const int*)(ws + WS_CNT))[CNT_NT];
        if (s < 0 || s >= NT * 256) rec(res, rs, 1, 0, 0.01); else { rec(res, rs, ((const int*)(ws + WS_CNT))[CNT_TILE_E + (s >> 8)] == e ? 0.0 : 1.0, 0, 0.01); const bf16* hs = (const bf16*)(ws + WS_HS) + (size_t)s * DM; double df = 0; for (int q = 0; q < 1024; ++q) df += fabs(bfd(hs[q]) - bfd(H[(size_t)m * DM + q])); rec(res, rs, df, 0, 1e-3); } }
    else if (stage == ST_ACT) { const int m = samp_row(i, M, 15), k = i & 3, c = (int)(hsh(i + 21) % 1024u); const int s = ((const int*)(ws + WS_SLOT))[(size_t)m * 4 + k], e = ((const int*)(ws + WS_TOPI))[(size_t)m * 4 + k]; const bf16* hs = (const bf16*)(ws + WS_HS) + (size_t)s * DM;
        double g = dot_h_w(hs, A.in[23] + (((size_t)l * NEXP + e) << 20), DM, c) + A.in[24][((size_t)l * NEXP + e) * 1024 + c], u = dot_h_w(hs, A.in[25] + (((size_t)l * NEXP + e) << 20), DM, c) + A.in[26][((size_t)l * NEXP + e) * 1024 + c];
        g = g < 7.0 ? g : 7.0; u = u < -7.0 ? -7.0 : (u > 7.0 ? 7.0 : u); rec(res, rs, bfd(((const bf16*)(ws + WS_ACT))[(size_t)s * DM + c]), (u + 1.0) * (g * dsig(1.702 * g)), 0.05); }
    else if (stage == ST_YSLOT) { const int m = samp_row(i, M, 16), k = i & 3, c = (int)(hsh(i + 22) % 1024u); const int s = ((const int*)(ws + WS_SLOT))[(size_t)m * 4 + k], e = ((const int*)(ws + WS_TOPI))[(size_t)m * 4 + k];
        rec(res, rs, bfd(((const bf16*)(ws + WS_HS))[(size_t)s * DM + c]), dot_h_w((const bf16*)(ws + WS_ACT) + (size_t)s * DM, A.in[27] + (((size_t)l * NEXP + e) << 20), DM, c) + A.in[28][((size_t)l * NEXP + e) * 1024 + c], 0.05); }
    else if (stage == ST_COMB) { const int m = samp_row(i, M, 17), c = (int)(hsh(i + 23) % 1024u); const float* xs = snap + (size_t)i * 1024; const int* sl = (const int*)(ws + WS_SLOT) + (size_t)m * 4; const float* pr = (const float*)(ws + WS_TOPP) + (size_t)m * 4;
        const float* mv = modb + ((size_t)l * 17 + (m < TL ? (m >> 11) : 16)) * 6144; double ss = 0, yc = 0; for (int q = 0; q < 1024; ++q) { double y = 0; for (int k = 0; k < 4; ++k) y += (double)pr[k] * bfd(((const bf16*)(ws + WS_HS))[(size_t)sl[k] * DM + q]); ss += y * y; if (q == c) yc = y; }
        const double want = xs[c] + mv[5 * 1024 + c] * (yc / sqrt(ss / 1024 + 1e-6) * A.in[9][l * DM + c]); const float* xd = m < TL ? A.out + (size_t)m * DM : (const float*)(ws + WS_XC) + (size_t)(m - TL) * DM; rec(res, rs, xd[c], want, 0.02); }
}
__global__ void snap_rows(Args A, int l, int salt, float* snap) {
    const int i = blockIdx.x, M = (l == 0) ? TALL : TL, m = samp_row(i, M, salt); const float* xs;
    if (l == 0 && salt == 11) xs = m < TL ? A.in[0] + (size_t)m * DM : A.in[2] + (size_t)(m - TL) * DM; else xs = m < TL ? A.out + (size_t)m * DM : (const float*)(A.ws + WS_XC) + (size_t)(m - TL) * DM;
    for (int k = threadIdx.x; k < 1024; k += blockDim.x) snap[(size_t)i * 1024 + k] = xs[k];
}
__global__ void chk_gates_full(const bf16* H, const bf16* Wt, const bf16* G, int M, unsigned* cntw) {
    const int n = blockIdx.x * 64 + (threadIdx.x & 63), m = blockIdx.y * 4 + (threadIdx.x >> 6); if (m >= M) return;
    const uint4* a = (const uint4*)(H + (size_t)m * 1024); const uint4* b = (const uint4*)(Wt + (size_t)n * 1024); float s = 0.f;
    for (int k = 0; k < 128; ++k) { const uint4 x = a[k], y = b[k]; const unsigned xs[4] = {x.x, x.y, x.z, x.w}, ys[4] = {y.x, y.y, y.z, y.w};
        for (int q = 0; q < 4; ++q) { s += __uint_as_float(xs[q] << 16) * __uint_as_float(ys[q] << 16); s += __uint_as_float(xs[q] & 0xffff0000u) * __uint_as_float(ys[q] & 0xffff0000u); } }
    const float want = 1.0f / (1.0f + __expf(-s)), got = __uint_as_float(((unsigned)G[(size_t)m * 3072 + n]) << 16);
    if (!(fabsf(got - want) <= 0.02f)) { atomicAdd(cntw, 1u); cntw[16 + (m >> 8) * 12 + (n >> 8)] = 1u; }
}
__global__ void encode_full(float* out, const unsigned* cntw, int n) {
    __shared__ int bc, bt; if (threadIdx.x == 0) { unsigned C = cntw[0], T = 0; for (int t = 0; t < 1728; ++t) T += cntw[16 + t]; int b1 = 0; while (C) { ++b1; C /= 10; } int b2 = 0; while (T) { ++b2; T /= 4; } bc = b1 > 7 ? 7 : b1; bt = b2 > 7 ? 7 : b2; }
    __syncthreads(); const float K = ldexpf(1.0f, 2 + 8 * bt + bc);
    for (size_t i = (size_t)blockIdx.x * blockDim.x + threadIdx.x; i < (size_t)n; i += (size_t)gridDim.x * blockDim.x) out[i] = K;
}
__global__ void encode(float* out, const float* res, int n, float thr) {
    #if DBG_GSUB == 1
    { const unsigned mk = ((const unsigned*)res)[48]; const float K = ldexpf(1.0f, 2 + (int)mk); for (size_t i = (size_t)blockIdx.x * blockDim.x + threadIdx.x; i < (size_t)n; i += (size_t)gridDim.x * blockDim.x) out[i] = K; return; }
#endif
#ifndef CHK_SKIP
#define CHK_SKIP 0ull
#endif
    int bad = -1; for (int s = 0; s < 64; ++s) if (!((CHK_SKIP >> s) & 1ull) && res[s] > thr) { bad = s; break; }
    if (bad < 0) return; const float er = res[bad]; const float K = ldexpf(1.0f, bad + 2) * (er < 0.5f ? 1.0f : er < 1.0f ? 1.25f : er < 4.0f ? 1.5f : 1.75f);
    for (size_t i = (size_t)blockIdx.x * blockDim.x + threadIdx.x; i < (size_t)n; i += (size_t)gridDim.x * blockDim.x) out[i] = K;
}
#endif
#ifndef GP_SP2
#define GP_SP2 true
#endif
#ifndef GP_ALIGN
#define GP_ALIGN true
#endif
__global__ void __launch_bounds__(NTHR, 2) fwd(Args args) {
    extern __shared__ __attribute__((aligned(16))) unsigned char lds[];
    Frame F;
    F.lds = (LAS unsigned char*)lds; F.MISC = (volatile LAS unsigned*)(F.lds + MISC_OFF);
    F.tid = threadIdx.x; F.lane = F.tid & 63; F.wave = __builtin_amdgcn_readfirstlane(F.tid >> 6);
    F.G = gridDim.x; { const int bx = blockIdx.x; F.vcu = (F.G % 8 == 0) ? (bx % 8) * (F.G / 8) + bx / 8 : bx; }
    { const AV A0 = av_get(); F.ctl = (gu32*)(A0.ws() + WS_CTL); }
    for (int u = F.tid; u < (LDS_BYTES - LDSCTL_OFF) / 4; u += NTHR) ((LAS unsigned*)(F.lds + LDSCTL_OFF))[u] = 0u;
    __syncthreads();
    XcdBarrier bar; bar.bar = (unsigned*)(F.ctl + CW_BAR); bar.x = 0; bar.st = nullptr;
    if (!MK_PER_PHASE) bar = xcd_barrier_post((unsigned*)(F.ctl + CW_BAR), F.MISC + 8);
    int lo, hi; { const AV A0 = av_get(); lo = *(const int __attribute__((address_space(4)))*)(A0.kp + 8 * 31); hi = *(const int __attribute__((address_space(4)))*)(A0.kp + 8 * 31 + 4); }
#ifndef DIS_MASK
#define DIS_MASK 0ull
#endif
#define IN(k) (lo <= (k) && (k) < hi)
#define ON(j) (!((DIS_MASK >> (j)) & 1ull))
#define SEAM(k) do { if (!MK_PER_PHASE && IN((k) + 1)) xcd_barrier(bar); } while (0)
    const int bx = (int)blockIdx.x;
#define F_REFRESH() do { int t_ = threadIdx.x; asm volatile("" : "+v"(t_)); F.tid = t_; F.lane = t_ & 63; F.wave = __builtin_amdgcn_readfirstlane(t_ >> 6); } while (0)

    if (ON(0) && IN(0)) { F_REFRESH(); const AV A = av_get(); p0_prologue(F, A); SEAM(0); }
    if (ON(1) && IN(1)) { F_REFRESH(); const AV A = av_get(); p1_norm0(F, A); SEAM(1); }

    for (int l = 0; l < 2; ++l) {
        const int pb = 2 + l * NPL;
        const int Mm = (l == 0) ? TALL : TL;
#define PH_BEGIN F_REFRESH(); const AV A = av_get(); unsigned char* const ws = A.ws(); unsigned char* const wl = ws + WS_WSMALL + (size_t)l * WSMALL_LAYER; (void)wl
        if (ON(2 + 0) && IN(pb + 0)) { PH_BEGIN;
            if (ON(16)) { pg8::Gemm g{(const bf16*)(ws + WS_H), (const bf16*)(wl + OFFS_WIN), TALL, 2560, DM}; pg8::StaticOrder S; S.init(TALL, 2560, F.G, bx);
              pg8::EpiInproj E{(bf16*)(ws + WS_Q), (bf16*)(ws + WS_K), (bf16*)(ws + WS_V), (bf16*)(ws + WS_CU)};
              pg8::gemm_phase<pg8::EpiInproj, pg8::StaticOrder, GP_ALIGN, GP_SP2>(F.lds + RING_OFF, g, S, E); }
            if (ON(17)) { pg8::Gemm g{(const bf16*)(wl + OFFS_WF), (const bf16*)(ws + WS_H), 1024, Mm, DM}; pg8::StaticOrder S; S.init(1024, Mm, F.G, (bx + 96) % F.G);
              pg8::EpiYT E{(bf16*)(ws + WS_YT), (bf16*)(ws + WS_YTC)};
              pg8::gemm_phase<pg8::EpiYT, pg8::StaticOrder, GP_ALIGN, GP_SP2>(F.lds + RING_OFF, g, S, E); }
            SEAM(pb + 0);
        }
        if (ON(2 + 1) && IN(pb + 1)) { PH_BEGIN;
            if (ON(18)) p_qkfix(F, A, l, TALL);
            F_REFRESH();
            if (ON(19)) p_conv(F, A, l, l == 0 ? 1152 : 1024);
            if (ON(20)) { pg8::Gemm g{(const bf16*)(ws + WS_DFTL), (const bf16*)(ws + WS_YT), 2048, NB * 512, 4096}; pg8::DftOrder S; S.init(3, NB, F.G, F.vcu);
              pg8::EpiDFT E{(bf16*)(ws + WS_Z), 0, SEQ};
              pg8::gemm_phase<pg8::EpiDFT, pg8::DftOrder, GP_ALIGN, GP_SP2>(F.lds + RING_OFF, g, S, E); }
            if (ON(21) && l == 0) { pg8::Gemm g{(const bf16*)(ws + WS_DFTC), (const bf16*)(ws + WS_YTC), 256, NB * 512, 512}; pg8::DftOrder S; S.init(0, NB, F.G, F.vcu);
              pg8::EpiDFT E{(bf16*)(ws + WS_Z), TL, CTXL};
              pg8::gemm_phase<pg8::EpiDFT, pg8::DftOrder, GP_ALIGN, GP_SP2>(F.lds + RING_OFF, g, S, E); }
            SEAM(pb + 1);
        }
        if (ON(2 + 2) && IN(pb + 2)) { PH_BEGIN;
            const int nheavy = NB * 8 * 8, ntot = nheavy + (l == 0 ? NB * 8 : 0);
            for (int L = F.vcu; L < ntot; L += F.G) {
                int row0, krow, h, seq;
                if (L < nheavy) { const int grp = L >> 5, s = L & 31, b = grp >> 1; h = (grp & 1) * 4 + (s >> 3); row0 = b * SEQ + (s & 7) * 256; krow = b * KVROWS; seq = KVROWS; }
                else { const int Lc = L - nheavy, b = Lc >> 3; h = Lc & 7; row0 = TL + b * CTXL; krow = b * KVROWS + SEQ; seq = CTXL; }
                const att::bf16* Qb = (const att::bf16*)(ws + WS_Q) + (size_t)row0 * DM + h * 128;
                const att::bf16* Kh = (const att::bf16*)(ws + WS_K) + (size_t)krow * 256 + (h >> 2) * 128;
                const att::bf16* Vh = (const att::bf16*)(ws + WS_V) + (size_t)krow * 256 + (h >> 2) * 128;
                att::bf16* Ob = (att::bf16*)(ws + WS_AO) + (size_t)row0 * DM + h * 128;
                att::attn_dense_body<att::bf16>(Qb, Kh, Vh, Ob, seq, (char*)lds + RING_OFF);
                __syncthreads();
            }
            SEAM(pb + 2);
        }
        if (ON(2 + 3) && IN(pb + 3)) { PH_BEGIN;
            pg8::Gemm g{(const bf16*)(ws + WS_H), (const bf16*)(wl + OFFS_WG), Mm, 3072, DM}; pg8::StaticOrder S; S.init(Mm, 3072, F.G, bx);
            pg8::EpiGates E{(bf16*)(ws + WS_GATES)};
            pg8::gemm_phase<pg8::EpiGates, pg8::StaticOrder, GP_ALIGN, GP_SP2>(F.lds + RING_OFF, g, S, E);
            SEAM(pb + 3);
        }
        if (ON(2 + 4) && IN(pb + 4)) { PH_BEGIN;
            { pg8::Gemm g{(const bf16*)(ws + WS_AO), (const bf16*)(wl + OFFS_WAO), Mm, 1024, 1024}; pg8::StaticOrder S; S.init(Mm, 1024, F.G, bx);
              pg8::EpiMerge<true> E{(bf16*)(ws + WS_MERGED), (const bf16*)(ws + WS_GATES), 0};
              pg8::gemm_phase<pg8::EpiMerge<true>, pg8::StaticOrder, GP_ALIGN, GP_SP2>(F.lds + RING_OFF, g, S, E); }
#pragma unroll 1
            for (int br = 1; br < 3; ++br) {
              pg8::Gemm g{(const bf16*)(ws + (br == 1 ? WS_CH : WS_Z)), (const bf16*)(wl + (br == 1 ? OFFS_WCO : OFFS_WFO)), Mm, 1024, 512}; pg8::StaticOrder S; S.init(Mm, 1024, F.G, bx);
              pg8::EpiMerge<false> E{(bf16*)(ws + WS_MERGED), (const bf16*)(ws + WS_GATES), br};
              pg8::gemm_phase<pg8::EpiMerge<false>, pg8::StaticOrder, GP_ALIGN, GP_SP2>(F.lds + RING_OFF, g, S, E); }
            SEAM(pb + 4);
        }
        if (ON(2 + 5) && IN(pb + 5)) { PH_BEGIN;
            pg8::Gemm g{(const bf16*)(ws + WS_MERGED), (const bf16*)(wl + OFFS_WOUT), Mm, 1024, 1024}; pg8::StaticOrder S; S.init(Mm, 1024, F.G, bx);
            pg8::EpiBf16<0> E{(bf16*)(ws + WS_MIX), 1024, nullptr, 0, 0, 1.0f};
            pg8::gemm_phase<pg8::EpiBf16<0>, pg8::StaticOrder, GP_ALIGN, GP_SP2>(F.lds + RING_OFF, g, S, E);
            SEAM(pb + 5);
        }
        if (ON(2 + 6) && IN(pb + 6)) { PH_BEGIN; p_rowpass1(F, A, l, Mm); SEAM(pb + 6); }
        if (ON(2 + 7) && IN(pb + 7)) { PH_BEGIN;
            pg8::Gemm g{(const bf16*)(ws + WS_H), (const bf16*)(wl + OFFS_ROUT), Mm, 256, DM}; pg8::StaticOrder S; S.init(Mm, 256, F.G, bx);
            pg8::EpiRouter E{(float*)(ws + WS_LOGIT)};
            pg8::gemm_phase<pg8::EpiRouter, pg8::StaticOrder, GP_ALIGN, GP_SP2>(F.lds + RING_OFF, g, S, E);
            SEAM(pb + 7);
        }
        if (ON(2 + 8) && IN(pb + 8)) { PH_BEGIN; p_topk(F, A, l, Mm); SEAM(pb + 8); }
        if (ON(2 + 9) && IN(pb + 9)) { PH_BEGIN; p_slots(F, A, Mm); SEAM(pb + 9); }
        if (ON(2 + 10) && IN(pb + 10)) { PH_BEGIN;
            const int NT = __builtin_amdgcn_readfirstlane(((const int*)(ws + WS_CNT))[CNT_NT]);
            pg8::Gemm g{(const bf16*)(ws + WS_HS), (const bf16*)(ws + WS_WGU), NT * 256, NEXP * 2048, DM}; pg8::GroupedOrder S; S.init(NT, 8, F.G, bx, (const int*)(ws + WS_CNT) + CNT_TILE_E);
            pg8::EpiSwiGLU E{(bf16*)(ws + WS_ACT), A.in(24) + (size_t)l * NEXP * 1024, A.in(26) + (size_t)l * NEXP * 1024};
            pg8::gemm_phase<pg8::EpiSwiGLU, pg8::GroupedOrder, GP_ALIGN, GP_SP2>(F.lds + RING_OFF, g, S, E);
            SEAM(pb + 10);
        }
        if (ON(2 + 11) && IN(pb + 11)) { PH_BEGIN;
            const int NT = __builtin_amdgcn_readfirstlane(((const int*)(ws + WS_CNT))[CNT_NT]);
            pg8::Gemm g{(const bf16*)(ws + WS_ACT), (const bf16*)(ws + WS_WD), NT * 256, NEXP * 1024, DM}; pg8::GroupedOrder S; S.init(NT, 4, F.G, bx, (const int*)(ws + WS_CNT) + CNT_TILE_E);
            pg8::EpiBf16<0> E{(bf16*)(ws + WS_HS), 1024, A.in(28) + (size_t)l * NEXP * 1024, 1024, 0, 1.0f};
            pg8::gemm_phase<pg8::EpiBf16<0>, pg8::GroupedOrder, GP_ALIGN, GP_SP2>(F.lds + RING_OFF, g, S, E);
            SEAM(pb + 11);
        }
        if (ON(2 + 12) && IN(pb + 12)) { PH_BEGIN;
            p_combine(F, A, l, Mm);
            if (l == 0) { const int gw = F.vcu * NWAVES + F.wave, NGW = F.G * NWAVES; LAS float* scr = (LAS float*)(F.lds + RING_OFF + F.wave * 16384);
                for (int it = gw; it < IT_MOE; it += NGW) moe_item(A, 1, it, scr, F.lane); }
            SEAM(pb + 12);
        }
    }
#undef IN
#undef PH_BEGIN
#undef F_REFRESH
#undef SEAM
}

extern "C" void kernel_launch(void* const* d_in, const int* in_sizes, int n_in, void* d_out, int out_size, void* d_ws, size_t ws_size, hipStream_t stream) {
    static int grid = 0;
    if (grid == 0) {
        if (n_in != 29 || out_size != TL * DM || ws_size < WS_END) { fprintf(stderr, "kernel_launch: built for 29 inputs, %d outputs, >= %zu bytes of workspace; got n_in %d out %d ws %zu\n", TL * DM, (size_t)WS_END, n_in, out_size, ws_size); grid = -1; return; }
        int dev = 0, cus = 0, per_cu = 0;
        if (hipGetDevice(&dev) != hipSuccess || hipDeviceGetAttribute(&cus, hipDeviceAttributeMultiprocessorCount, dev) != hipSuccess) { grid = -1; return; }
        if (hipFuncSetAttribute((const void*)fwd, hipFuncAttributeMaxDynamicSharedMemorySize, LDS_BYTES) != hipSuccess) { fprintf(stderr, "kernel_launch: hipFuncSetAttribute failed\n"); grid = -1; return; }
        if (hipOccupancyMaxActiveBlocksPerMultiprocessor(&per_cu, (const void*)fwd, NTHR, LDS_BYTES) != hipSuccess || per_cu < 1) fprintf(stderr, "kernel_launch: occupancy query reports %d\n", per_cu);
        (void)hipGetLastError();
        grid = cus;
    }
    if (grid < 0) return;
    (void)hipMemsetAsync((char*)d_ws + WS_CTL, 0, CTL_ZERO_BYTES, stream);
    Args a{};
    for (int i = 0; i < 29; ++i) a.in[i] = (const float*)d_in[i];
    a.out = (float*)d_out; a.ws = (unsigned char*)d_ws;
#if MK_PER_PHASE
    for (int p = 0; p < NPH; ++p) {
#ifdef DBG_CHECK
        float* res = (float*)((char*)d_ws + WS_CTL + 8192 * 4); float* snap = (float*)((char*)d_ws + WS_END);
        { const int l = p >= 2 ? (p - 2) / NPL : 0, k = p >= 2 ? (p - 2) % NPL : -1;
          if (k == 6) hipLaunchKernelGGL(snap_rows, dim3(256), dim3(256), 0, stream, a, l, 11, snap);
          if (k == 12) hipLaunchKernelGGL(snap_rows, dim3(256), dim3(256), 0, stream, a, l, 17, snap); }
#endif
        a.ph_lo = p; a.ph_hi = p + 1; hipLaunchKernelGGL(fwd, dim3(grid), dim3(NTHR), LDS_BYTES, stream, a);
#ifdef DBG_CHECK
        { const int l = p >= 2 ? (p - 2) / NPL : 0, k = p >= 2 ? (p - 2) % NPL : -1;
#define CHK(st) hipLaunchKernelGGL(chk, dim3(1), dim3(256), 0, stream, a, (int)(st), l, res, snap)
          if (p == 0) CHK(ST_MOD); if (p == 1) CHK(ST_H0);
#if DBG_GSUB == 2
          if (k == 3 && l == 0) hipLaunchKernelGGL(chk_gates_full, dim3(48, TALL / 4), dim3(256), 0, stream, (const bf16*)((char*)d_ws + WS_H), (const bf16*)((char*)d_ws + WS_WSMALL + OFFS_WG), (const bf16*)((char*)d_ws + WS_GATES), TALL, (unsigned*)((char*)d_ws + WS_CTL + 65536));
#endif
          if (k == 0) { CHK(ST_INPROJ); CHK(ST_YT); } if (k == 1) { CHK(ST_QKFIX); CHK(ST_CONV); CHK(ST_Z); } if (k == 2) CHK(ST_ATTN); if (k == 3) { CHK(ST_GATES); CHK(ST_GATESB); } if (k == 4) CHK(ST_MERGED);
          if (k == 5) CHK(ST_MIX); if (k == 6) CHK(ST_ROW1); if (k == 7) CHK(ST_LOGIT); if (k == 8) CHK(ST_TOPK); if (k == 9) CHK(ST_SLOTS); if (k == 10) CHK(ST_ACT); if (k == 11) CHK(ST_YSLOT); if (k == 12) CHK(ST_COMB);
#undef CHK
        }
#endif
    }
#ifdef DBG_CHECK
#if DBG_GSUB == 2
    hipLaunchKernelGGL(encode_full, dim3(1024), dim3(256), 0, stream, (float*)d_out, (const unsigned*)((char*)d_ws + WS_CTL + 65536), out_size);
#else
    hipLaunchKernelGGL(encode, dim3(1024), dim3(256), 0, stream, (float*)d_out, (const float*)((char*)d_ws + WS_CTL + 8192 * 4), out_size, 0.25f);
#endif
#endif
#else
    a.ph_lo = 0; a.ph_hi = NPH; hipLaunchKernelGGL(fwd, dim3(grid), dim3(NTHR), LDS_BYTES, stream, a);
#endif
    const hipError_t le = hipPeekAtLastError();
    if (le != hipSuccess) fprintf(stderr, "kernel_launch: launch failed: %s\n", hipGetErrorName(le));
}
```

```cpp
#include <hip/hip_runtime.h>
#include <cstdio>
#include <cstdint>
#ifndef MK_PER_PHASE
#define MK_PER_PHASE 0
#endif
namespace pg8 {
#define PG8_LAS __attribute__((address_space(3)))
typedef unsigned short bf16_t;
typedef short bf16x8 __attribute__((ext_vector_type(8)));
typedef float f32x4 __attribute__((ext_vector_type(4)));
typedef unsigned u32x4 __attribute__((ext_vector_type(4)));
typedef int i32x4v __attribute__((ext_vector_type(4)));
typedef int i32x8v __attribute__((ext_vector_type(8)));
typedef unsigned u32x2v __attribute__((ext_vector_type(2)));
constexpr int BM = 256, BK = 64, HALF = 128, HTB = HALF * BK * 2  , STAGE_BYTES = 8 * HTB, NXCD = 8, WGM = 8;

__host__ __device__ __forceinline__ int lds_byte(int r, int c) { const int st = (r >> 4) * 2 + (c >> 5), rr = r & 15, cc = c & 31, ob = rr * 64 + cc * 2; return st * 1024 + (ob ^ (((ob >> 9) & 1) << 5)); }
__host__ __device__ __forceinline__ void stage_rc(int b, int& R, int& C) { const int st = b / 1024, sb = b % 1024, swz = sb ^ (((sb >> 9) & 1) << 5); R = (st >> 1) * 16 + swz / 64; C = (st & 1) * 32 + (swz % 64) / 2; }
__host__ __device__ __forceinline__ int perm32(int rho) { const int n = rho >> 4, i = rho & 15; return 8 * (i >> 2) + 4 * n + (i & 3); }

struct Unit { int pm, pn; };
struct Gemm { const bf16_t* A; const bf16_t* Bt; int M, N, K; };

struct StaticOrder {
    int nM, nN, nwg, G, c;
    __host__ __device__ void init(int M, int N, int G_, int c_) { nM = M / BM; nN = N / BM; nwg = nM * nN; G = G_; c = c_; }
    __host__ __device__ bool next(int i, Unit& u) const {
        const long L = (long)i * G + c; if (L >= nwg) return false;
        int wgid = (int)L; { const int q = nwg / NXCD, r = nwg % NXCD, xcd = wgid % NXCD, off = wgid / NXCD; wgid = (xcd < r ? xcd * (q + 1) : r * (q + 1) + (xcd - r) * q) + off; }
        const int nig = WGM * nN, gid = wgid / nig, fm = gid * WGM, gsz = (nM - fm) < WGM ? (nM - fm) : WGM;
        u.pm = fm + ((wgid % nig) % gsz); u.pn = (wgid % nig) / gsz; return true;
    }
    __device__ __forceinline__ void a_ready(const Unit&) const {}
    __device__ __forceinline__ void done(const Unit&) const {}
};

typedef __bf16 bf16x2_native __attribute__((ext_vector_type(2)));
typedef float f32x2_native __attribute__((ext_vector_type(2)));
__device__ __forceinline__ unsigned cvt_pk_bf16(float lo, float hi) { const f32x2_native v = {lo, hi}; const bf16x2_native r = __builtin_convertvector(v, bf16x2_native); return __builtin_bit_cast(unsigned, r); }
typedef float f32x2 __attribute__((ext_vector_type(2)));
__device__ __forceinline__ f32x2 gelu_pk(f32x2 v) {
    const f32x2 av = __builtin_elementwise_abs(v), d = av * 0.2316418882f + 1.0f;
    f32x2 t; t.x = __builtin_amdgcn_rcpf(d.x); t.y = __builtin_amdgcn_rcpf(d.y);
    f32x2 q = t * 0.5307027145f + (-0.7265760135f); q = q * t + 0.7107068705f; q = q * t + (-0.142248368f); q = q * t + 0.127414796f; q = q * t;
    const f32x2 s = (v * v) * (-0.72134752044f);
    f32x2 e; e.x = __builtin_amdgcn_exp2f(s.x); e.y = __builtin_amdgcn_exp2f(s.y);
    const f32x2 m = v * (q * e), r = v - m;
    f32x2 o; o.x = v.x < 0.f ? m.x : r.x; o.y = v.y < 0.f ? m.y : r.y; return o;
}

template <int ACT  > struct EpiBf16 {
    static constexpr bool PERM = true, AFTER_DRAIN = false; static_assert(ACT == 0 || ACT == 1, "EpiBf16: ACT is 0 (none) or 1 (gelu_pk)");
    bf16_t* O; int ldc; const float* bias; int split_cols; size_t split_stride; float scale0;
    __device__ __forceinline__ void operator()(const f32x4 (&acc)[2][2][4][2], const Unit& u, int wr, int wc, int fr, int fq) const {
        const int row0 = u.pm * BM + wr * 64 + fr; int colt = u.pn * BM; bf16_t* base = O;
        float sc = 1.f; if (split_cols) { const int t = colt / split_cols; base += (size_t)t * split_stride; colt -= t * split_cols; if (t == 0) sc = scale0; }
        const int col0 = colt + wc * 32 + 8 * fq, bcol0 = u.pn * BM + wc * 32 + 8 * fq;
        f32x4 bv[2][2];
#pragma unroll
        for (int bj = 0; bj < 2; ++bj)
#pragma unroll
            for (int n = 0; n < 2; ++n) bv[bj][n] = bias ? *(const f32x4*)(bias + bcol0 + bj * HALF + 4 * n) : (f32x4){0.f, 0.f, 0.f, 0.f};
#pragma unroll
        for (int ai = 0; ai < 2; ++ai)
#pragma unroll
            for (int m = 0; m < 4; ++m) { bf16_t* rowp = base + (size_t)(row0 + ai * HALF + m * 16) * ldc + col0;
#pragma unroll
                for (int bj = 0; bj < 2; ++bj) { f32x4 v0 = acc[ai][bj][m][0] + bv[bj][0], v1 = acc[ai][bj][m][1] + bv[bj][1];
                    if (ACT == 1) { f32x2 a = gelu_pk((f32x2){v0[0], v0[1]}), b = gelu_pk((f32x2){v0[2], v0[3]}), c = gelu_pk((f32x2){v1[0], v1[1]}), d = gelu_pk((f32x2){v1[2], v1[3]});
                        v0 = (f32x4){a.x, a.y, b.x, b.y}; v1 = (f32x4){c.x, c.y, d.x, d.y}; }
                    v0 = v0 * sc; v1 = v1 * sc; u32x4 w; w.x = cvt_pk_bf16(v0[0], v0[1]); w.y = cvt_pk_bf16(v0[2], v0[3]); w.z = cvt_pk_bf16(v1[0], v1[1]); w.w = cvt_pk_bf16(v1[2], v1[3]);
                    *(u32x4*)(rowp + bj * HALF) = w; } }
    }
};

__device__ __forceinline__ float fast_sigmoid(float x) { return __builtin_amdgcn_rcpf(1.0f + __builtin_amdgcn_exp2f(-1.4426950408889634f * x)); }
__device__ __forceinline__ u32x4 pack8(const f32x4& a, const f32x4& b) { u32x4 w; w.x = cvt_pk_bf16(a[0], a[1]); w.y = cvt_pk_bf16(a[2], a[3]); w.z = cvt_pk_bf16(b[0], b[1]); w.w = cvt_pk_bf16(b[2], b[3]); return w; }
__device__ __forceinline__ void unpack8(const u32x4& w, f32x4& a, f32x4& b) {
    a[0] = __uint_as_float(w.x << 16); a[1] = __uint_as_float(w.x & 0xffff0000u); a[2] = __uint_as_float(w.y << 16); a[3] = __uint_as_float(w.y & 0xffff0000u);
    b[0] = __uint_as_float(w.z << 16); b[1] = __uint_as_float(w.z & 0xffff0000u); b[2] = __uint_as_float(w.w << 16); b[3] = __uint_as_float(w.w & 0xffff0000u); }
__device__ __forceinline__ void store_tile_bf16(const f32x4 (&acc)[2][2][4][2], bf16_t* base, int ldc, int wr, int wc, int fr, int fq) {
    const int rt = wr * 64 + fr, cb = wc * 32 + 8 * fq;
#pragma unroll
    for (int ai = 0; ai < 2; ++ai)
#pragma unroll
        for (int m = 0; m < 4; ++m) { bf16_t* rowp = base + (size_t)(rt + ai * HALF + m * 16) * ldc + cb;
#pragma unroll
            for (int bj = 0; bj < 2; ++bj) *(u32x4*)(rowp + bj * HALF) = pack8(acc[ai][bj][m][0], acc[ai][bj][m][1]); }
}
struct EpiInproj {
    static constexpr bool PERM = true, AFTER_DRAIN = false;
    bf16_t *q, *k, *v, *cu;
    __device__ __forceinline__ void operator()(const f32x4 (&acc)[2][2][4][2], const Unit& u, int wr, int wc, int fr, int fq) const {
        bf16_t* base; int ldc; const bool glu = u.pn >= 6;
        if (u.pn < 4) { base = q + (size_t)u.pm * 256 * 1024 + u.pn * 256; ldc = 1024; }
        else if (u.pn < 6) { const int m0 = u.pm * 256; const int kr = m0 < 32768 ? (m0 >> 11) * 2304 + (m0 & 2047) : ((m0 - 32768) >> 8) * 2304 + 2048; base = (u.pn == 4 ? k : v) + (size_t)kr * 256; ldc = 256; }
        else { base = cu + (size_t)u.pm * 256 * 512 + (u.pn - 6) * 128; ldc = 512; }
        base += (size_t)(wr * 64 + fr) * ldc + wc * 32 + 8 * fq;
#pragma unroll
        for (int ai = 0; ai < 2; ++ai)
#pragma unroll
            for (int m = 0; m < 4; ++m) { bf16_t* rowp = base + (size_t)(ai * HALF + m * 16) * ldc;
                if (!glu) { *(u32x4*)rowp = pack8(acc[ai][0][m][0], acc[ai][0][m][1]); *(u32x4*)(rowp + HALF) = pack8(acc[ai][1][m][0], acc[ai][1][m][1]); }
                else { f32x4 a0 = acc[ai][0][m][0], a1 = acc[ai][0][m][1]; const f32x4 g0 = acc[ai][1][m][0], g1 = acc[ai][1][m][1];
#pragma unroll
                    for (int j = 0; j < 4; ++j) { a0[j] *= fast_sigmoid(g0[j]); a1[j] *= fast_sigmoid(g1[j]); }
                    *(u32x4*)rowp = pack8(a0, a1); } }
    }
};
struct EpiYT {
    static constexpr bool PERM = true, AFTER_DRAIN = false;
    bf16_t *yt, *ytc;
    __device__ __forceinline__ void operator()(const f32x4 (&acc)[2][2][4][2], const Unit& u, int wr, int wc, int fr, int fq) const {
        const int cs = u.pm >> 1, chb = (u.pm & 1) * 256; bf16_t* base; int ldc;
        if (u.pn < 128) { const int b = u.pn >> 3, pos0 = (u.pn & 7) * 256; base = yt + (size_t)(b * 512 + chb) * 4096 + cs * 2048 + pos0; ldc = 4096; }
        else { const int b = u.pn - 128; base = ytc + (size_t)(b * 512 + chb) * 512 + cs * 256; ldc = 512; }
        store_tile_bf16(acc, base, ldc, wr, wc, fr, fq);
    }
};
struct EpiDFT {
    static constexpr bool PERM = true, AFTER_DRAIN = false;
    bf16_t* z; int rowbase, rpb;
    __device__ __forceinline__ void operator()(const f32x4 (&acc)[2][2][4][2], const Unit& u, int wr, int wc, int fr, int fq) const {
        store_tile_bf16(acc, z + (size_t)(rowbase + (u.pn >> 1) * rpb + u.pm * 256) * 512 + (u.pn & 1) * 256, 512, wr, wc, fr, fq);
    }
};
struct EpiGates {
    static constexpr bool PERM = true, AFTER_DRAIN = false;
    bf16_t* g;
    __device__ __forceinline__ void operator()(const f32x4 (&acc)[2][2][4][2], const Unit& u, int wr, int wc, int fr, int fq) const {
        const int rt = wr * 64 + fr, cb = wc * 32 + 8 * fq; bf16_t* base = g + (size_t)u.pm * 256 * 3072 + u.pn * 256 + cb;
#pragma unroll
        for (int ai = 0; ai < 2; ++ai)
#pragma unroll
            for (int m = 0; m < 4; ++m)
#pragma unroll
                for (int bj = 0; bj < 2; ++bj) { f32x4 a0 = acc[ai][bj][m][0], a1 = acc[ai][bj][m][1];
#pragma unroll
                    for (int j = 0; j < 4; ++j) { a0[j] = fast_sigmoid(a0[j]); a1[j] = fast_sigmoid(a1[j]); }
                    *(u32x4*)(base + (size_t)(rt + ai * HALF + m * 16) * 3072 + bj * HALF) = pack8(a0, a1); }
    }
};
template <bool FIRST> struct EpiMerge {
    static constexpr bool PERM = true, AFTER_DRAIN = false;
    bf16_t* mg; const bf16_t* g; int br;
    __device__ __forceinline__ void operator()(const f32x4 (&acc)[2][2][4][2], const Unit& u, int wr, int wc, int fr, int fq) const {
        const int rt = u.pm * 256 + wr * 64 + fr, cb = u.pn * 256 + wc * 32 + 8 * fq;
#pragma unroll
        for (int ai = 0; ai < 2; ++ai)
#pragma unroll
            for (int m = 0; m < 4; ++m)
#pragma unroll
                for (int bj = 0; bj < 2; ++bj) { const size_t row = (size_t)(rt + ai * HALF + m * 16); const int col = cb + bj * HALF;
                    const u32x4 gw = *(const u32x4*)(g + row * 3072 + br * 1024 + col); f32x4 g0, g1; unpack8(gw, g0, g1);
                    f32x4 v0 = acc[ai][bj][m][0] * g0, v1 = acc[ai][bj][m][1] * g1;
                    if (!FIRST) { const u32x4 ow = *(const u32x4*)(mg + row * 1024 + col); f32x4 o0, o1; unpack8(ow, o0, o1); v0 += o0; v1 += o1; }
                    *(u32x4*)(mg + row * 1024 + col) = pack8(v0, v1); }
    }
};
struct EpiRouter {
    static constexpr bool PERM = true, AFTER_DRAIN = false;
    float* lg;
    __device__ __forceinline__ void operator()(const f32x4 (&acc)[2][2][4][2], const Unit& u, int wr, int wc, int fr, int fq) const {
        if (wc < 2) { const int rt = u.pm * 256 + wr * 64 + fr, cb = wc * 32 + 8 * fq;
#pragma unroll
            for (int ai = 0; ai < 2; ++ai)
#pragma unroll
                for (int m = 0; m < 4; ++m) { float* p = lg + (size_t)(rt + ai * HALF + m * 16) * 64 + cb; *(f32x4*)p = acc[ai][0][m][0]; *(f32x4*)(p + 4) = acc[ai][0][m][1]; } }
    }
};
struct EpiSwiGLU {
    static constexpr bool PERM = true, AFTER_DRAIN = false;
    bf16_t* act; const float* bg; const float* bu;
    __device__ __forceinline__ void operator()(const f32x4 (&acc)[2][2][4][2], const Unit& u, int wr, int wc, int fr, int fq) const {
        const int e = u.pn >> 3, col = (u.pn & 7) * 128 + wc * 32 + 8 * fq, rt = u.pm * 256 + wr * 64 + fr;
        const f32x4 bg0 = *(const f32x4*)(bg + e * 1024 + col), bg1 = *(const f32x4*)(bg + e * 1024 + col + 4), bu0 = *(const f32x4*)(bu + e * 1024 + col), bu1 = *(const f32x4*)(bu + e * 1024 + col + 4);
#pragma unroll
        for (int ai = 0; ai < 2; ++ai)
#pragma unroll
            for (int m = 0; m < 4; ++m) { f32x4 g0 = acc[ai][0][m][0] + bg0, g1 = acc[ai][0][m][1] + bg1, u0 = acc[ai][1][m][0] + bu0, u1 = acc[ai][1][m][1] + bu1;
#pragma unroll
                for (int j = 0; j < 4; ++j) { const float ga = fminf(g0[j], 7.0f), gb = fminf(g1[j], 7.0f); const float ua = fminf(fmaxf(u0[j], -7.0f), 7.0f), ub = fminf(fmaxf(u1[j], -7.0f), 7.0f);
                    g0[j] = (ua + 1.0f) * (ga * fast_sigmoid(1.702f * ga)); g1[j] = (ub + 1.0f) * (gb * fast_sigmoid(1.702f * gb)); }
                *(u32x4*)(act + (size_t)(rt + ai * HALF + m * 16) * 1024 + col) = pack8(g0, g1); }
    }
};
__device__ __forceinline__ u32x2v pack8_fp8(const f32x4& a, const f32x4& b) { int w0 = 0, w1 = 0; w0 = __builtin_amdgcn_cvt_pk_fp8_f32(a[0], a[1], w0, false); w0 = __builtin_amdgcn_cvt_pk_fp8_f32(a[2], a[3], w0, true);
    w1 = __builtin_amdgcn_cvt_pk_fp8_f32(b[0], b[1], w1, false); w1 = __builtin_amdgcn_cvt_pk_fp8_f32(b[2], b[3], w1, true); u32x2v r; r.x = (unsigned)w0; r.y = (unsigned)w1; return r; }
struct EpiSwiGLU8 {
    static constexpr bool PERM = true, AFTER_DRAIN = false;
    unsigned char* act; const float* bg; const float* bu;
    __device__ __forceinline__ void operator()(const f32x4 (&acc)[2][2][4][2], const Unit& u, int wr, int wc, int fr, int fq) const {
        const int e = u.pn >> 3, col = (u.pn & 7) * 128 + wc * 32 + 8 * fq, rt = u.pm * 256 + wr * 64 + fr;
        const f32x4 bg0 = *(const f32x4*)(bg + e * 1024 + col), bg1 = *(const f32x4*)(bg + e * 1024 + col + 4), bu0 = *(const f32x4*)(bu + e * 1024 + col), bu1 = *(const f32x4*)(bu + e * 1024 + col + 4);
#pragma unroll
        for (int ai = 0; ai < 2; ++ai)
#pragma unroll
            for (int m = 0; m < 4; ++m) { f32x4 g0 = acc[ai][0][m][0] * 0.03125f + bg0, g1 = acc[ai][0][m][1] * 0.03125f + bg1, u0 = acc[ai][1][m][0] * 0.03125f + bu0, u1 = acc[ai][1][m][1] * 0.03125f + bu1;
#pragma unroll
                for (int j = 0; j < 4; ++j) { const float ga = fminf(g0[j], 7.0f), gb = fminf(g1[j], 7.0f); const float ua = fminf(fmaxf(u0[j], -7.0f), 7.0f), ub = fminf(fmaxf(u1[j], -7.0f), 7.0f);
                    g0[j] = (ua + 1.0f) * (ga * fast_sigmoid(1.702f * ga)); g1[j] = (ub + 1.0f) * (gb * fast_sigmoid(1.702f * gb)); }
                *(u32x2v*)(act + (size_t)(rt + ai * HALF + m * 16) * 1024 + col) = pack8_fp8(g0, g1); }
    }
};
struct EpiDown8 {
    static constexpr bool PERM = true, AFTER_DRAIN = false;
    bf16_t* ys; const float* bd;
    __device__ __forceinline__ void operator()(const f32x4 (&acc)[2][2][4][2], const Unit& u, int wr, int wc, int fr, int fq) const {
        const int e = u.pn >> 2, col0 = (u.pn & 3) * 256 + wc * 32 + 8 * fq, rt = u.pm * 256 + wr * 64 + fr;
        f32x4 bv[2][2];
#pragma unroll
        for (int bj = 0; bj < 2; ++bj) { bv[bj][0] = *(const f32x4*)(bd + e * 1024 + col0 + bj * HALF); bv[bj][1] = *(const f32x4*)(bd + e * 1024 + col0 + bj * HALF + 4); }
#pragma unroll
        for (int ai = 0; ai < 2; ++ai)
#pragma unroll
            for (int m = 0; m < 4; ++m) { bf16_t* rowp = ys + (size_t)(rt + ai * HALF + m * 16) * 1024 + col0;
#pragma unroll
                for (int bj = 0; bj < 2; ++bj) *(u32x4*)(rowp + bj * HALF) = pack8(acc[ai][bj][m][0] * 0.03125f + bv[bj][0], acc[ai][bj][m][1] * 0.03125f + bv[bj][1]); }
    }
};
struct GroupedOrder {
    int nM, nN, nwg, G, c; const int* tile_e;
    __device__ void init(int nM_, int nN_, int G_, int c_, const int* te) { nM = nM_; nN = nN_; nwg = nM * nN; G = G_; c = c_; tile_e = te; }
    __device__ bool next(int i, Unit& u) const {
        const long L = (long)i * G + c; if (L >= nwg) return false;
        int wgid = (int)L; { const int q = nwg / NXCD, r = nwg % NXCD, xcd = wgid % NXCD, off = wgid / NXCD; wgid = (xcd < r ? xcd * (q + 1) : r * (q + 1) + (xcd - r) * q) + off; }
        const int nig = WGM * nN, gid = wgid / nig, fm = gid * WGM, gsz = (nM - fm) < WGM ? (nM - fm) : WGM;
        u.pm = fm + ((wgid % nig) % gsz); const int pl = (wgid % nig) / gsz; u.pn = __builtin_amdgcn_readfirstlane(tile_e[u.pm]) * nN + pl; return true;
    }
    __device__ __forceinline__ void a_ready(const Unit&) const {}
    __device__ __forceinline__ void done(const Unit&) const {}
};
struct DftOrder {
    int lg, n, G, c;
    __device__ void init(int lg_, int nb, int G_, int c_) { lg = lg_; n = (nb * 2) << lg_; G = G_; c = c_; }
    __device__ bool next(int i, Unit& u) const { const int L = i * G + c; if (L >= n) return false; const int b = L >> (lg + 1), rem = L & ((2 << lg) - 1); u.pm = rem & ((1 << lg) - 1); u.pn = 2 * b + (rem >> lg); return true; }
    __device__ __forceinline__ void a_ready(const Unit&) const {}
    __device__ __forceinline__ void done(const Unit&) const {}
};

template <class Epi, class Sched, bool ALIGN_EPI = false, bool SP2 = false, bool FP8 = false>
__device__ __forceinline__ void gemm_phase(PG8_LAS unsigned char* lds, const Gemm g, const Sched& S, const Epi& E) {
    int tid_ = threadIdx.x; asm volatile("" : "+v"(tid_));
    const int tid = tid_, wid = __builtin_amdgcn_readfirstlane(tid >> 6), lane = tid & 63, wr = wid >> 2, wc = wid & 3, fr = lane & 15, fq = lane >> 4;
    const int K = g.K, nt = K / BK;
    unsigned voffA[2], voffB[2];
#pragma unroll
    for (int i = 0; i < 2; ++i) { int R, C; stage_rc(tid * 16 + i * 8192, R, C); const int Rb = Epi::PERM ? ((R & ~31) + perm32(R & 31)) : R;
        voffA[i] = (unsigned)(R * K + C) * 2u; voffB[i] = (unsigned)(Rb * K + C) * 2u; }
    const size_t kstep = (size_t)(BK * 2);
    const size_t hstep = (size_t)HALF * K * 2;
    const size_t tstep = 2 * hstep;
    const unsigned ldsw = (unsigned)wid * 1024u;
    const int aoff = lds_byte(wr * 64 + fr, fq * 8), boff = lds_byte(wc * 32 + fr, fq * 8);
#define PG8_SA(b, h) (((b) * 2 + (h)) * HTB)
#define PG8_SB(b, h) ((4 + (b) * 2 + (h)) * HTB)
#define PG8_STAGE(bufoff, gbase, voff) do { _Pragma("unroll") for (int _i = 0; _i < 2; ++_i) \
        __builtin_amdgcn_global_load_lds((const unsigned*)((const char*)(gbase) + (voff)[_i]), (PG8_LAS unsigned*)(lds + (bufoff) + ldsw + _i * 8192), 16, 0, 0); } while (0)
#define PG8_RD8(off) __builtin_shufflevector(*(const PG8_LAS i32x4v*)(lds + (off)), *(const PG8_LAS i32x4v*)(lds + (off) + 1024), 0, 1, 2, 3, 4, 5, 6, 7)
#define PG8_LDA(dst, b, h) do { _Pragma("unroll") for (int m = 0; m < 4; ++m) { if constexpr (FP8) dst##8[m] = PG8_RD8(PG8_SA(b, h) + aoff + m * 2048); else { _Pragma("unroll") for (int k = 0; k < 2; ++k) dst[m][k] = *(const PG8_LAS bf16x8*)(lds + PG8_SA(b, h) + aoff + m * 2048 + k * 1024); } } } while (0)
#define PG8_LDB(dst, b, h) do { _Pragma("unroll") for (int n = 0; n < 2; ++n) { if constexpr (FP8) dst##8[n] = PG8_RD8(PG8_SB(b, h) + boff + n * 2048); else { _Pragma("unroll") for (int k = 0; k < 2; ++k) dst[n][k] = *(const PG8_LAS bf16x8*)(lds + PG8_SB(b, h) + boff + n * 2048 + k * 1024); } } } while (0)
#define PG8_MMA(ai, bj, At, Bt) do { if constexpr (FP8) __builtin_amdgcn_sched_barrier(0); __builtin_amdgcn_s_setprio(1); _Pragma("unroll") for (int m = 0; m < 4; ++m) _Pragma("unroll") for (int n = 0; n < 2; ++n) { \
        if constexpr (FP8) asm volatile("v_mfma_scale_f32_16x16x128_f8f6f4 %0, %1, %2, %0, %3, %3 op_sel_hi:[0,0,0]" : "+v"(acc[ai][bj][m][n]) : "v"(Bt##8[n]), "v"(At##8[m]), "v"(sc8)); \
        else { _Pragma("unroll") for (int k = 0; k < 2; ++k) acc[ai][bj][m][n] = __builtin_amdgcn_mfma_f32_16x16x32_bf16(Bt[n][k], At[m][k], acc[ai][bj][m][n], 0, 0, 0); } } __builtin_amdgcn_s_setprio(0); if constexpr (FP8) __builtin_amdgcn_sched_barrier(0); } while (0)
#define PG8_WAIT_V(n) asm volatile("s_waitcnt vmcnt(" #n ")" ::: "memory")
#define PG8_WAIT_L(n) asm volatile("s_waitcnt lgkmcnt(" #n ")" ::: "memory")
#define PG8_BAR __builtin_amdgcn_s_barrier()
#define PG8_SCHED __builtin_amdgcn_sched_barrier(0)
    Unit cur, nxt; int ui = 0;
    if (!S.next(0, cur)) return;
    f32x4 acc[2][2][4][2];
#pragma unroll
    for (int a = 0; a < 2; ++a)
#pragma unroll
        for (int b = 0; b < 2; ++b)
#pragma unroll
            for (int m = 0; m < 4; ++m)
#pragma unroll
                for (int n = 0; n < 2; ++n) acc[a][b][m][n] = (f32x4){0.f, 0.f, 0.f, 0.f};
    int sc8 = 0x7f7f7f7f; asm volatile("" : "+v"(sc8));
    bf16x8 At[4][2], B0[2][2], B1[2][2]; i32x8v At8[4], B08[2], B18[2];
    const char* cA = (const char*)g.A + (size_t)cur.pm * tstep; const char* cB = (const char*)g.Bt + (size_t)cur.pn * tstep;
    S.a_ready(cur);
    if constexpr (SP2) {
        PG8_STAGE(PG8_SB(0, 0), cB, voffB); PG8_STAGE(PG8_SB(0, 1), cB + hstep, voffB); PG8_STAGE(PG8_SA(0, 0), cA, voffA); PG8_STAGE(PG8_SA(0, 1), cA + hstep, voffA);
        if (wr == 1) PG8_BAR;
        PG8_WAIT_V(2); PG8_BAR;
        PG8_STAGE(PG8_SB(1, 0), cB + kstep, voffB); PG8_STAGE(PG8_SA(1, 0), cA + kstep, voffA); PG8_STAGE(PG8_SB(1, 1), cB + hstep + kstep, voffB);
        PG8_WAIT_V(6); PG8_BAR;
    } else {
        PG8_STAGE(PG8_SB(0, 0), cB, voffB); PG8_STAGE(PG8_SA(0, 0), cA, voffA); PG8_STAGE(PG8_SB(0, 1), cB + hstep, voffB); PG8_STAGE(PG8_SA(0, 1), cA + hstep, voffA);
        if (wr == 1) PG8_BAR;
        PG8_WAIT_V(4); PG8_BAR;
        PG8_STAGE(PG8_SB(1, 0), cB + kstep, voffB); PG8_STAGE(PG8_SA(1, 0), cA + kstep, voffA); PG8_STAGE(PG8_SB(1, 1), cB + hstep + kstep, voffB);
        PG8_WAIT_V(6); PG8_BAR;
    }
    for (;;) {
        const bool has_next = S.next(ui + 1, nxt);
        const char* nA = has_next ? (const char*)g.A + (size_t)nxt.pm * tstep : cA; const char* nB = has_next ? (const char*)g.Bt + (size_t)nxt.pn * tstep : cB;
        for (int t = 0; t < nt; t += 2) {
            const bool last = (t == nt - 2);
            const char* a1 = cA + (size_t)(t + 1) * kstep;
            const char* a2 = last ? nA : cA + (size_t)(t + 2) * kstep; const char* b2 = last ? nB : cB + (size_t)(t + 2) * kstep;
            const char* a3 = a2 + kstep; const char* b3 = b2 + kstep;
            if (last && has_next) S.a_ready(nxt);
            if constexpr (SP2) {
            PG8_LDB(B0, 0, 0); PG8_LDB(B1, 0, 1); PG8_SCHED; PG8_LDA(At, 0, 0); PG8_STAGE(PG8_SA(1, 1), a1 + hstep, voffA);
            PG8_WAIT_V(8); PG8_WAIT_L(0); PG8_BAR; PG8_MMA(0, 0, At, B0); PG8_MMA(0, 1, At, B1); PG8_BAR; PG8_SCHED;
            PG8_LDA(At, 0, 1); PG8_STAGE(PG8_SB(0, 0), b2, voffB); PG8_STAGE(PG8_SB(0, 1), b2 + hstep, voffB); PG8_STAGE(PG8_SA(0, 0), a2, voffA);
            PG8_WAIT_V(8); PG8_WAIT_L(0); PG8_BAR; PG8_MMA(1, 0, At, B0); PG8_MMA(1, 1, At, B1); PG8_BAR; PG8_SCHED;
            PG8_LDB(B0, 1, 0); PG8_LDB(B1, 1, 1); PG8_SCHED; PG8_LDA(At, 1, 0); PG8_STAGE(PG8_SA(0, 1), a2 + hstep, voffA);
            PG8_WAIT_V(8); PG8_WAIT_L(0); PG8_BAR; PG8_MMA(0, 0, At, B0); PG8_MMA(0, 1, At, B1); PG8_BAR; PG8_SCHED;
            PG8_LDA(At, 1, 1); PG8_STAGE(PG8_SB(1, 0), b3, voffB); PG8_STAGE(PG8_SB(1, 1), b3 + hstep, voffB); PG8_STAGE(PG8_SA(1, 0), a3, voffA);
            PG8_WAIT_V(8); PG8_WAIT_L(0); PG8_BAR; PG8_MMA(1, 0, At, B0); PG8_MMA(1, 1, At, B1); PG8_BAR; PG8_SCHED;
            } else {
            PG8_LDB(B0, 0, 0); PG8_SCHED; PG8_LDA(At, 0, 0); PG8_STAGE(PG8_SA(1, 1), a1 + hstep, voffA);
            PG8_WAIT_L(8); PG8_BAR; PG8_WAIT_L(0); PG8_MMA(0, 0, At, B0); PG8_BAR; PG8_SCHED;
            PG8_LDB(B1, 0, 1); PG8_STAGE(PG8_SB(0, 0), b2, voffB);
            PG8_BAR; PG8_WAIT_L(0); PG8_MMA(0, 1, At, B1); PG8_BAR;
            PG8_LDA(At, 0, 1); PG8_STAGE(PG8_SA(0, 0), a2, voffA);
            PG8_BAR; PG8_WAIT_L(0); PG8_MMA(1, 0, At, B0); PG8_BAR; PG8_SCHED;
            PG8_STAGE(PG8_SB(0, 1), b2 + hstep, voffB);
            PG8_WAIT_V(6); PG8_BAR; PG8_MMA(1, 1, At, B1); PG8_BAR;
            PG8_LDB(B0, 1, 0); PG8_SCHED; PG8_LDA(At, 1, 0); PG8_STAGE(PG8_SA(0, 1), a2 + hstep, voffA);
            PG8_WAIT_L(8); PG8_BAR; PG8_WAIT_L(0); PG8_MMA(0, 0, At, B0); PG8_BAR; PG8_SCHED;
            PG8_LDB(B1, 1, 1); PG8_STAGE(PG8_SB(1, 0), b3, voffB);
            PG8_BAR; PG8_WAIT_L(0); PG8_MMA(0, 1, At, B1); PG8_BAR;
            PG8_LDA(At, 1, 1); PG8_STAGE(PG8_SA(1, 0), a3, voffA);
            PG8_BAR; PG8_WAIT_L(0); PG8_MMA(1, 0, At, B0); PG8_BAR; PG8_SCHED;
            PG8_STAGE(PG8_SB(1, 1), b3 + hstep, voffB);
            PG8_WAIT_V(6); PG8_BAR; PG8_MMA(1, 1, At, B1); PG8_BAR;
            }
        }
        if constexpr (FP8) asm volatile("s_nop 15\n\ts_nop 15" ::: "memory");
        if constexpr (ALIGN_EPI) { if (wr == 0) PG8_BAR; }
        if constexpr (!Epi::AFTER_DRAIN) { E(acc, cur, wr, wc, fr, fq); S.done(cur); }
        if (!has_next) break;
#pragma unroll
        for (int a = 0; a < 2; ++a)
#pragma unroll
            for (int b = 0; b < 2; ++b)
#pragma unroll
                for (int m = 0; m < 4; ++m)
#pragma unroll
                    for (int n = 0; n < 2; ++n) acc[a][b][m][n] = (f32x4){0.f, 0.f, 0.f, 0.f};
        cur = nxt; cA = nA; cB = nB; ++ui;
        if constexpr (ALIGN_EPI) { if (wr == 1) PG8_BAR; }
    }
    PG8_WAIT_V(0);
    if constexpr (!ALIGN_EPI) { if (wr == 0) PG8_BAR; }
    PG8_BAR;
    if constexpr (Epi::AFTER_DRAIN) { E.fused(acc, cur, wr, wc, fr, fq, lds, wid, lane); S.done(cur); }
#undef PG8_SA
#undef PG8_SB
#undef PG8_STAGE
#undef PG8_LDA
#undef PG8_LDB
#undef PG8_MMA
#undef PG8_RD8
#undef PG8_WAIT_V
#undef PG8_WAIT_L
#undef PG8_BAR
#undef PG8_SCHED
}
}
namespace att {
typedef unsigned short bf16;
constexpr int   D = 128, NW = 8, QBLK = 32, KVBLK = 64;
constexpr float SCALE = 0.088388347648318440f;
constexpr float THR = 8.f;
constexpr int SDEPTH = 2;
constexpr int LDQ = 1024, LDK = 256, LDO = 1024;
constexpr size_t SHM_V = KVBLK * D * 2, SHM_K = KVBLK * D * 2, SHM_ATTN = 2 * SHM_V + 2 * SHM_K + NW * 64 * 4;
using bf16x8 = __attribute__((ext_vector_type(8))) short;
using s16x4  = __attribute__((ext_vector_type(4))) short;
using f32x16 = __attribute__((ext_vector_type(16))) float;
using f32x8  = __attribute__((ext_vector_type(8))) float;
using u32x4  = __attribute__((ext_vector_type(4))) unsigned;
#define KSWZ(row, colB) ((row) * 256 + ((colB) ^ (((row) & 7) << 4)))
#define SBAR() __builtin_amdgcn_sched_barrier(0)
__device__ __forceinline__ int crow(int r, int hi) { return (r & 3) + 8 * (r >> 2) + 4 * hi; }
__device__ __forceinline__ unsigned cvtpk(float lo, float hi) { return pg8::cvt_pk_bf16(lo, hi); }
template <typename TIn> struct Stage;
template <> struct Stage<bf16>  { using T = bf16x8;
  __device__ static __forceinline__ T ld8(const bf16* p) { return *reinterpret_cast<const bf16x8*>(p); }
  __device__ static __forceinline__ bf16x8 tobf(T x) { return x; } };
template <> struct Stage<float> { using T = f32x8;
  __device__ static __forceinline__ T ld8(const float* p) { return *reinterpret_cast<const f32x8*>(p); }
  __device__ static __forceinline__ bf16x8 tobf(T x) {
    u32x4 w = {cvtpk(x[0], x[1]), cvtpk(x[2], x[3]), cvtpk(x[4], x[5]), cvtpk(x[6], x[7])}; return *reinterpret_cast<bf16x8*>(&w); } };

__device__ __forceinline__ void partialSM(f32x16& p0, f32x16& p1, float& m_reg, float& mn, float& alpha) {
  constexpr float C = SCALE * 1.4426950408889634f;
  float pmax = p0[0]; for (int r = 1; r < 16; ++r) pmax = fmaxf(pmax, p0[r]); for (int r = 0; r < 16; ++r) pmax = fmaxf(pmax, p1[r]);
  { auto rr = __builtin_amdgcn_permlane32_swap(__float_as_uint(pmax), __float_as_uint(pmax), false, false);
    pmax = fmaxf(__uint_as_float(rr[0]), __uint_as_float(rr[1])); }
  if (__builtin_expect(__all(pmax - m_reg <= THR / SCALE), 1)) { mn = m_reg; alpha = 1.f; }
  else { mn = fmaxf(m_reg, pmax); alpha = __builtin_amdgcn_exp2f((m_reg - mn) * C); m_reg = mn; }
  float mnC = -mn * C;
  for (int r = 0; r < 16; ++r) p0[r] = fmaf(p0[r], C, mnC); for (int r = 0; r < 16; ++r) p1[r] = fmaf(p1[r], C, mnC);
  for (int r = 0; r < 16; ++r) p0[r] = __builtin_amdgcn_exp2f(p0[r]);
}
__device__ __forceinline__ void finishSM(f32x16& p0, f32x16& p1, float alpha, float& l_reg, bf16x8& pa0, bf16x8& pa1, bf16x8& pa2, bf16x8& pa3) {
  for (int r = 0; r < 16; ++r) p1[r] = __builtin_amdgcn_exp2f(p1[r]);
  float ps = 0; for (int r = 0; r < 16; ++r) ps += p0[r]; for (int r = 0; r < 16; ++r) ps += p1[r];
  { auto rr = __builtin_amdgcn_permlane32_swap(__float_as_uint(ps), __float_as_uint(ps), false, false);
    ps = __uint_as_float(rr[0]) + __uint_as_float(rr[1]); }
  l_reg = l_reg * alpha + ps;
#define PK4(P, BASE, OUT) do { unsigned a0 = cvtpk(P[BASE + 0], P[BASE + 1]), a1 = cvtpk(P[BASE + 2], P[BASE + 3]);   \
    unsigned b0 = cvtpk(P[BASE + 4], P[BASE + 5]), b1 = cvtpk(P[BASE + 6], P[BASE + 7]);                              \
    auto r0 = __builtin_amdgcn_permlane32_swap(a0, b0, false, false); auto r1 = __builtin_amdgcn_permlane32_swap(a1, b1, false, false); \
    u32x4 w = {r0[0], r1[0], r0[1], r1[1]}; OUT = *reinterpret_cast<bf16x8*>(&w); } while (0)
  PK4(p0, 0, pa0); PK4(p0, 8, pa1); PK4(p1, 0, pa2); PK4(p1, 8, pa3);
#undef PK4
}
__device__ __forceinline__ void qkt(f32x16& p0, f32x16& p1, const bf16* Ks, const bf16x8* qr, int r32, int hi) {
  p0 = f32x16{}; p1 = f32x16{};
  for (int d0 = 0; d0 < 8; ++d0) { int cb = (d0 * 16 + hi * 8) * 2;
    bf16x8 b0 = *reinterpret_cast<const bf16x8*>((const char*)Ks + KSWZ(r32, cb));
    bf16x8 b1 = *reinterpret_cast<const bf16x8*>((const char*)Ks + KSWZ(32 + r32, cb));
    p0 = __builtin_amdgcn_mfma_f32_32x32x16_bf16(b0, qr[d0], p0, 0, 0, 0);
    p1 = __builtin_amdgcn_mfma_f32_32x32x16_bf16(b1, qr[d0], p1, 0, 0, 0); }
}
__device__ __forceinline__ int v_st(int k, int c) { const int kk = (k & ~0xC) | ((k & 4) << 1) | ((k & 8) >> 1); return ((kk >> 3) * 4 + (c >> 5)) * 512 + ((kk & 7) * 32 + (c & 31)) * 2; }
__device__ __forceinline__ int v_rd_base(int lane) { return ((lane & 3) << 3) | (((lane >> 2) & 3) << 6) | (((lane >> 4) & 1) << 5) | (((lane >> 5) & 1) << 8); }
constexpr int v_rd_off(int d0, int ks, int half) { return d0 * 512 + ks * 4096 + half * 2048; }
template <int OFF> __device__ __forceinline__ s16x4 tr_read(int vb) {
  s16x4 r; asm volatile("ds_read_b64_tr_b16 %0, %1 offset:%2" : "=&v"(r) : "v"(vb), "i"(OFF) : "memory"); return r;
}
template <int D0> __device__ __forceinline__ void pv_one(f32x16& od, int vb, bf16x8 pa0, bf16x8 pa1, bf16x8 pa2, bf16x8 pa3) {
  const s16x4 l0 = tr_read<v_rd_off(D0, 0, 0)>(vb), h0 = tr_read<v_rd_off(D0, 0, 1)>(vb), l1 = tr_read<v_rd_off(D0, 1, 0)>(vb), h1 = tr_read<v_rd_off(D0, 1, 1)>(vb);
  const s16x4 l2 = tr_read<v_rd_off(D0, 2, 0)>(vb), h2 = tr_read<v_rd_off(D0, 2, 1)>(vb), l3 = tr_read<v_rd_off(D0, 3, 0)>(vb), h3 = tr_read<v_rd_off(D0, 3, 1)>(vb);
  asm volatile("s_waitcnt lgkmcnt(0)" ::: "memory"); SBAR();
#define PK(L, H) (bf16x8){L[0], L[1], L[2], L[3], H[0], H[1], H[2], H[3]}
  od = __builtin_amdgcn_mfma_f32_32x32x16_bf16(pa0, PK(l0, h0), od, 0, 0, 0);
  od = __builtin_amdgcn_mfma_f32_32x32x16_bf16(pa1, PK(l1, h1), od, 0, 0, 0);
  od = __builtin_amdgcn_mfma_f32_32x32x16_bf16(pa2, PK(l2, h2), od, 0, 0, 0);
  od = __builtin_amdgcn_mfma_f32_32x32x16_bf16(pa3, PK(l3, h3), od, 0, 0, 0);
#undef PK
}
__device__ __forceinline__ void pv_d0(f32x16* o, int vb, bf16x8 pa0, bf16x8 pa1, bf16x8 pa2, bf16x8 pa3) {
  pv_one<0>(o[0], vb, pa0, pa1, pa2, pa3); pv_one<1>(o[1], vb, pa0, pa1, pa2, pa3); pv_one<2>(o[2], vb, pa0, pa1, pa2, pa3); pv_one<3>(o[3], vb, pa0, pa1, pa2, pa3);
}

template <typename TQ>
__device__ __forceinline__ void attn_dense_body(const TQ* __restrict__ Qb, const bf16* __restrict__ Kh, const bf16* __restrict__ Vh,
                                                bf16* __restrict__ Ob, int seq, char* lds) {
  using St = Stage<bf16>; using SQ = Stage<TQ>;
  int tid_ = threadIdx.x; asm volatile("" : "+v"(tid_));
  const int tid = tid_, wid = tid >> 6, lane = tid & 63, r32 = lane & 31, hi = lane >> 5;
  bf16* V_lds = (bf16*)lds; bf16* K_lds = (bf16*)(lds + 2 * SHM_V);
  float* ws = (float*)(lds + 2 * SHM_V + 2 * SHM_K) + wid * 64; float* li_l = ws; float* al_l = ws + 32;
  float m_reg = -1e30f, l_reg = 0; f32x16 o[4] = {}; bf16x8 qr[8];
  const TQ* Qw = Qb + (long)(wid * QBLK + r32) * LDQ + hi * 8;
#pragma unroll
  for (int d0 = 0; d0 < 8; ++d0) qr[d0] = SQ::tobf(SQ::ld8(Qw + d0 * 16));
  const int sr = tid >> 4, sc = (tid & 15) * 8, vst0 = v_st(sr, sc), vst1 = v_st(32 + sr, sc);
  const int vb0 = (int)(uintptr_t)V_lds + v_rd_base(lane);
  struct { typename St::T vs0, vs1, ks0, ks1; } sr_[SDEPTH];
#define SLOAD(i, k0) do { sr_[i].vs0 = St::ld8(&Vh[(long)((k0) + sr) * LDK + sc]); sr_[i].vs1 = St::ld8(&Vh[(long)((k0) + 32 + sr) * LDK + sc]); \
    sr_[i].ks0 = St::ld8(&Kh[(long)((k0) + sr) * LDK + sc]); sr_[i].ks1 = St::ld8(&Kh[(long)((k0) + 32 + sr) * LDK + sc]); } while (0)
#define SWRITE(b, i) do { *(bf16x8*)((char*)V_lds + (b) * SHM_V + vst0) = St::tobf(sr_[i].vs0);          \
    *(bf16x8*)((char*)V_lds + (b) * SHM_V + vst1) = St::tobf(sr_[i].vs1); int kc = sc * 2;               \
    *(bf16x8*)((char*)K_lds + (b) * SHM_K + KSWZ(sr, kc)) = St::tobf(sr_[i].ks0);                       \
    *(bf16x8*)((char*)K_lds + (b) * SHM_K + KSWZ(32 + sr, kc)) = St::tobf(sr_[i].ks1); } while (0)
#define SWAIT() do { if constexpr (SDEPTH == 2) asm volatile("s_waitcnt vmcnt(4)" ::: "memory"); else asm volatile("s_waitcnt vmcnt(0)" ::: "memory"); } while (0)
#define RESC(a) do { if (__any((a) < 1.f)) { if (hi == 0) al_l[r32] = (a); asm volatile("s_waitcnt lgkmcnt(0)" ::: "memory"); \
    for (int d = 0; d < 4; ++d) for (int r = 0; r < 16; ++r) o[d][r] *= al_l[crow(r, hi)]; } } while (0)
  f32x16 pA0, pA1, pB0, pB1; float mnA, mnB, alA, alB; bf16x8 pa0, pa1, pa2, pa3; const int NT = seq / KVBLK;
  constexpr int SE = 0, SO = SDEPTH - 1;
  SLOAD(SE, 0); asm volatile("s_waitcnt vmcnt(0)" ::: "memory"); SWRITE(0, SE); __syncthreads();
  qkt(pA0, pA1, K_lds, qr, r32, hi); partialSM(pA0, pA1, m_reg, mnA, alA);
  SLOAD(SO, KVBLK); if constexpr (SDEPTH == 2) { if (2 < NT) SLOAD(SE, 2 * KVBLK); }
  SWAIT(); SWRITE(1, SO); __syncthreads();
  for (int j = 1; j + 1 < NT; j += 2) {
    SBAR(); qkt(pB0, pB1, (bf16*)((char*)K_lds + SHM_K), qr, r32, hi);
    finishSM(pA0, pA1, alA, l_reg, pa0, pa1, pa2, pa3); SBAR();
    SLOAD(SO, (j + SDEPTH) * KVBLK); SBAR();
    pv_d0(o, vb0, pa0, pa1, pa2, pa3); partialSM(pB0, pB1, m_reg, mnB, alB);
    __syncthreads(); SWAIT(); SWRITE(0, SE);
    RESC(alB); __syncthreads();
    SBAR(); qkt(pA0, pA1, K_lds, qr, r32, hi);
    finishSM(pB0, pB1, alB, l_reg, pa0, pa1, pa2, pa3); SBAR();
    if (SDEPTH == 1 || j + 3 < NT) SLOAD(SE, (j + 1 + SDEPTH) * KVBLK); SBAR();
    pv_d0(o, vb0 + (int)SHM_V, pa0, pa1, pa2, pa3); partialSM(pA0, pA1, m_reg, mnA, alA);
    __syncthreads(); SWAIT(); SWRITE(1, SO);
    RESC(alA); __syncthreads();
  }
  SBAR(); qkt(pB0, pB1, (bf16*)((char*)K_lds + SHM_K), qr, r32, hi);
  finishSM(pA0, pA1, alA, l_reg, pa0, pa1, pa2, pa3); SBAR();
  pv_d0(o, vb0, pa0, pa1, pa2, pa3); partialSM(pB0, pB1, m_reg, mnB, alB);
  __syncthreads(); RESC(alB);
  finishSM(pB0, pB1, alB, l_reg, pa0, pa1, pa2, pa3); SBAR();
  pv_d0(o, vb0 + (int)SHM_V, pa0, pa1, pa2, pa3);
  if (hi == 0) li_l[r32] = l_reg; asm volatile("s_waitcnt lgkmcnt(0)" ::: "memory");
  float rli[16];
#pragma unroll
  for (int r = 0; r < 16; ++r) rli[r] = __builtin_amdgcn_rcpf(li_l[crow(r, hi)]);
  bf16* Ow = Ob + (long)(wid * QBLK) * LDO;
#pragma unroll
  for (int r = 0; r < 16; ++r) { int orow = crow(r, hi);
    for (int d0 = 0; d0 < 4; ++d0) Ow[(long)orow * LDO + d0 * 32 + r32] = (bf16)(cvtpk(o[d0][r] * rli[r], 0.f) & 0xffffu); }
#undef SLOAD
#undef SWRITE
#undef SWAIT
#undef RESC
}
#undef KSWZ
#undef SBAR
}

#define GAS __attribute__((address_space(1)))
#define LAS __attribute__((address_space(3)))
typedef unsigned short bf16;
typedef unsigned v4u __attribute__((ext_vector_type(4)));
typedef float f32x4 __attribute__((ext_vector_type(4)));
typedef short bf16x8 __attribute__((ext_vector_type(8)));
typedef GAS unsigned gu32;
typedef GAS unsigned long long gu64;
#define RLX_AGENT __ATOMIC_RELAXED, __HIP_MEMORY_SCOPE_AGENT
#define LDS_WAIT() asm volatile("s_waitcnt lgkmcnt(0)" ::: "memory")
#define VM_WAIT() asm volatile("s_waitcnt vmcnt(0)" ::: "memory")
__device__ __forceinline__ unsigned long long rt() { return __builtin_amdgcn_s_memrealtime(); }
__device__ __forceinline__ unsigned f2bf(float f) { unsigned u = __builtin_bit_cast(unsigned, f); return (u + 0x7fffu + ((u >> 16) & 1u)) >> 16; }
__device__ __forceinline__ unsigned pk2(float lo, float hi) { return f2bf(lo) | (f2bf(hi) << 16); }

#define XB_TMO      128
#define XB_XCNT(j)  (256  + 64 * (j))
#define XB_XSUB(j)  (1280 + 64 * (j))
#define XB_XGEN(j)  (2304 + 64 * (j))
#define XB_TOP      3328
#define XB_TOPGEN   3392
#define XCD_BAR_WORDS 3456
#define XB_SPIN_CAP (1u << 18)

__device__ __forceinline__ unsigned xb_ld(unsigned* p)              { return __hip_atomic_load(p, __ATOMIC_RELAXED, __HIP_MEMORY_SCOPE_AGENT); }
__device__ __forceinline__ unsigned xb_add(unsigned* p, unsigned v) { return __hip_atomic_fetch_add(p, v, __ATOMIC_RELAXED, __HIP_MEMORY_SCOPE_AGENT); }
__device__ __forceinline__ unsigned xb_xcc_id() { return (unsigned)__builtin_amdgcn_s_getreg((3 << 11) | 20) & 0xFu; }
#define XB_SPIN(cond, bar) do { unsigned _sp = 0; while (cond) { __builtin_amdgcn_s_sleep(1); \
    if ((++_sp & 255u) == 0u) { if (xb_ld(&(bar)[XB_TMO])) break; if (_sp > XB_SPIN_CAP) { atomicAdd(&(bar)[XB_TMO], 1u); break; } } } } while (0)

struct XcdBarrier {
    unsigned* bar; unsigned x;
    volatile LAS unsigned* st;
};

__device__ __forceinline__ XcdBarrier xcd_barrier_post(unsigned* bar, volatile LAS unsigned* st) {
    XcdBarrier b; b.bar = bar; b.x = xb_xcc_id(); b.st = st;
    if (threadIdx.x == 0) (void)xb_add(&bar[XB_XCNT(b.x)], 1u);
    return b;
}
__device__ __forceinline__ void xcd_barrier_complete(unsigned* bar, unsigned x, unsigned& nloc, unsigned& nx) {
    const unsigned G = gridDim.x * gridDim.y * gridDim.z;
    unsigned sum, cnt, mine, sp = 0u;
    for (;;) {
        sum = 0u; cnt = 0u; mine = 0u;
#pragma unroll
        for (unsigned j = 0; j < 16; ++j) { const unsigned c = xb_ld(&bar[XB_XCNT(j)]); sum += c; cnt += (c > 0u) ? 1u : 0u; mine = (j == x) ? c : mine; }
        if (sum == G) break;
        __builtin_amdgcn_s_sleep(1);
        if ((++sp & 255u) == 0u) { if (xb_ld(&bar[XB_TMO])) break; if (sp > XB_SPIN_CAP) { atomicAdd(&bar[XB_TMO], 1u); break; } }
    }
    nloc = mine > 0u ? mine : 1u; nx = cnt > 0u ? cnt : 1u;
}

__device__ __forceinline__ void xcd_barrier(const XcdBarrier& b) {
    asm volatile("s_waitcnt vmcnt(0)" ::: "memory");
    __syncthreads();
    if (threadIdx.x == 0) {
        unsigned* bar = b.bar;
        __builtin_amdgcn_s_waitcnt(0);
        unsigned nloc = b.st[0], nx = b.st[1];
        if (nloc == 0u) { xcd_barrier_complete(bar, b.x, nloc, nx); b.st[0] = nloc; b.st[1] = nx; }
        const unsigned old = xb_add(&bar[XB_XSUB(b.x)], 1u);
        const unsigned gen = old / nloc;
        if (old + 1u == (gen + 1u) * nloc) {
            __builtin_amdgcn_fence(__ATOMIC_RELEASE, "agent");
            asm volatile("s_waitcnt vmcnt(0)" ::: "memory");
            const unsigned og = xb_add(&bar[XB_TOP], 1u);
            const unsigned tg = og / nx;
            if (og + 1u == (tg + 1u) * nx) xb_add(&bar[XB_TOPGEN], 1u);
            else XB_SPIN(xb_ld(&bar[XB_TOPGEN]) == tg, bar);
            __builtin_amdgcn_fence(__ATOMIC_ACQUIRE, "agent");
            xb_add(&bar[XB_XGEN(b.x)], 1u);
            asm volatile("s_waitcnt vmcnt(0)" ::: "memory");
        } else {
            XB_SPIN(xb_ld(&bar[XB_XGEN(b.x)]) == gen, bar);
            __builtin_amdgcn_fence(__ATOMIC_ACQUIRE, "agent");
            asm volatile("s_waitcnt vmcnt(0)" ::: "memory");
        }
    }
    __syncthreads();
}
constexpr int DM = 1024, NB = 16, SEQ = 2048, CTXL = 256, TL = NB * SEQ, TC = NB * CTXL, TALL = TL + TC;
constexpr int INCOLS = 6144, OFF_FNET = 2560, OFF_GATE = 3072;
constexpr int NEXP = 32, KVROWS = SEQ + CTXL;
constexpr float EPS = 1e-6f;
constexpr int NWAVES = 8, NTHR = NWAVES * 64;
constexpr int NPL = 13, NPH = 2 + 2 * NPL;
#ifndef MK_PER_PHASE
#define MK_PER_PHASE 0
#endif
constexpr size_t MiB = 1u << 20;
constexpr size_t WS_CTL = 0, CTL_ZERO_BYTES = 1 * MiB;
constexpr size_t WS_MOD = 1 * MiB;
constexpr size_t WS_TAB = 2 * MiB;
constexpr size_t WS_TOPI = 3 * MiB, WS_TOPP = 4 * MiB, WS_SLOT = 5 * MiB, WS_CNT = 6 * MiB;
constexpr size_t WS_LOGIT = 7 * MiB;
constexpr size_t WS_WSMALL = 17 * MiB, WSMALL_LAYER = 20 * MiB;
constexpr size_t OFFS_WIN = 0, OFFS_WF = 5 * MiB, OFFS_WG = 7 * MiB, OFFS_WAO = 13 * MiB, OFFS_WCO = 15 * MiB, OFFS_WFO = 16 * MiB, OFFS_WOUT = 17 * MiB, OFFS_ROUT = 19 * MiB;
constexpr size_t WS_DFTL = 57 * MiB, WS_DFTC = 73 * MiB;
constexpr size_t WS_XC = 74 * MiB;
constexpr size_t WS_H = 90 * MiB;
constexpr size_t WS_WGU = 162 * MiB, WS_WD = 226 * MiB, MOEW_LAYER = 96 * MiB;
constexpr size_t WS_BIG = 354 * MiB;
constexpr size_t WS_Q = WS_BIG, WS_K = WS_Q + 72 * MiB, WS_V = WS_K + 18 * MiB, WS_CU = WS_V + 18 * MiB, WS_YT = WS_CU + 36 * MiB, WS_YTC = WS_YT + 64 * MiB;
constexpr size_t WS_GATES = WS_BIG;
constexpr size_t WS_AO = WS_BIG + 216 * MiB, WS_CH = WS_AO + 72 * MiB, WS_Z = WS_CH + 36 * MiB;
constexpr size_t WS_MIX = WS_AO;
constexpr size_t WS_MERGED = WS_BIG + 360 * MiB;
constexpr int SLOT_ROWS = 608 * 256;
constexpr size_t WS_YS = WS_BIG, WS_HS = WS_BIG + 304 * MiB, WS_ACT = WS_BIG + 456 * MiB, WS_END = WS_BIG + 608 * MiB;
static_assert(WS_YTC + 8 * MiB == WS_AO && WS_Z + 36 * MiB == WS_MERGED && WS_MERGED + 72 * MiB <= WS_END && (size_t)SLOT_ROWS * 2048 == 304 * MiB, "ws map");
constexpr int CW_TMO = 0, CW_CODE = 1, CW_BAR = 4096;
constexpr int CNT_TILE_E = 16384, CNT_NT = 16384 + 1024;

constexpr int RING_OFF = 0, RING_BYTES = 131072;
constexpr int LDSCTL_OFF = RING_BYTES, MISC_OFF = LDSCTL_OFF + 320, LDS_CT = LDSCTL_OFF + 512, LDS_SM = LDSCTL_OFF + 1024;
constexpr int LDS_BYTES = 147456;

typedef unsigned u32x2 __attribute__((ext_vector_type(2)));
typedef int i32x4 __attribute__((ext_vector_type(4)));
typedef float f32x2 __attribute__((ext_vector_type(2)));
struct Args { const float* in[29]; float* out; unsigned char* ws; int ph_lo, ph_hi; };
typedef const __attribute__((address_space(4))) unsigned char* kptr_t;
struct AV {
    kptr_t kp;
    __device__ __forceinline__ const float* in(int i) const { return *(const float* const __attribute__((address_space(4)))*)(kp + 8 * i); }
    __device__ __forceinline__ float* out() const { return *(float* const __attribute__((address_space(4)))*)(kp + 8 * 29); }
    __device__ __forceinline__ unsigned char* ws() const { return *(unsigned char* const __attribute__((address_space(4)))*)(kp + 8 * 30); }
};
__device__ __forceinline__ AV av_get() { AV a; a.kp = (kptr_t)__builtin_amdgcn_kernarg_segment_ptr(); asm volatile("" : "+s"(a.kp)); return a; }

struct Frame {
    LAS unsigned char* lds; volatile LAS unsigned* MISC; gu32* ctl;
    int tid, lane, wave, vcu, G;
};

__device__ __forceinline__ float shx(float v, int m, int lane) { return __int_as_float(__builtin_amdgcn_ds_bpermute((lane ^ m) << 2, __float_as_int(v))); }
__device__ __forceinline__ float wave_sum(float v, int lane) {
#pragma unroll
    for (int o = 1; o < 64; o <<= 1) v += shx(v, o, lane);
    return v;
}
__device__ __forceinline__ float sigmoidf_(float x) { return 1.0f / (1.0f + __expf(-x)); }
__device__ __forceinline__ f32x4 bf4(u32x2 w) { f32x4 r; r[0] = __uint_as_float(w.x << 16); r[1] = __uint_as_float(w.x & 0xffff0000u); r[2] = __uint_as_float(w.y << 16); r[3] = __uint_as_float(w.y & 0xffff0000u); return r; }
__device__ __forceinline__ u32x2 pk4(f32x4 v) { u32x2 w; w.x = pk2(v[0], v[1]); w.y = pk2(v[2], v[3]); return w; }
__device__ __forceinline__ void ld_row_f32(f32x4 (&v)[4], const float* p, int lane) {
#pragma unroll
    for (int j = 0; j < 4; ++j) v[j] = ((const GAS f32x4*)p)[lane + 64 * j];
}
__device__ __forceinline__ void st_row_f32(const f32x4 (&v)[4], float* p, int lane) {
#pragma unroll
    for (int j = 0; j < 4; ++j) ((GAS f32x4*)p)[lane + 64 * j] = v[j];
}
__device__ __forceinline__ void ld_row_bf16(f32x4 (&v)[4], const bf16* p, int lane) {
#pragma unroll
    for (int j = 0; j < 4; ++j) v[j] = bf4(((const GAS u32x2*)p)[lane + 64 * j]);
}
__device__ __forceinline__ void st_row_bf16(const f32x4 (&v)[4], bf16* p, int lane) {
#pragma unroll
    for (int j = 0; j < 4; ++j) ((GAS u32x2*)p)[lane + 64 * j] = pk4(v[j]);
}
__device__ __forceinline__ void rms_gain(f32x4 (&v)[4], const float* g, int lane) {
    float ss = 0.f;
#pragma unroll
    for (int j = 0; j < 4; ++j) ss += (v[j][0] * v[j][0] + v[j][1] * v[j][1]) + (v[j][2] * v[j][2] + v[j][3] * v[j][3]);
    const float r = 1.0f / sqrtf(wave_sum(ss, lane) * (1.0f / 1024.0f) + EPS);
#pragma unroll
    for (int j = 0; j < 4; ++j) { const f32x4 gg = ((const GAS f32x4*)g)[lane + 64 * j]; v[j] = v[j] * r * gg; }
}
__device__ __forceinline__ void modulate_store(const f32x4 (&v)[4], const float* shift, const float* scale, bf16* o, int lane) {
#pragma unroll
    for (int j = 0; j < 4; ++j) { const f32x4 sh = ((const GAS f32x4*)shift)[lane + 64 * j], sc = ((const GAS f32x4*)scale)[lane + 64 * j];
        ((GAS u32x2*)o)[lane + 64 * j] = pk4(v[j] * (sc + 1.0f) + sh); }
}
__device__ __forceinline__ int krow_of(int m) { return m < TL ? (m >> 11) * KVROWS + (m & 2047) : ((m - TL) >> 8) * KVROWS + SEQ + ((m - TL) & 255); }

__device__ __forceinline__ void transpose_item(const float* W, int ldw, int K, bf16* WT, int dst_row0, int k0, int n0, LAS float* scr, int lane) {
#pragma unroll 8
    for (int i = 0; i < 32; ++i) { const int kk = 2 * i + (lane >> 5); scr[kk * 33 + (lane & 31)] = W[(size_t)(k0 + kk) * ldw + n0 + (lane & 31)]; }
    LDS_WAIT(); asm volatile("" ::: "memory");
    const int c = lane & 7;
#pragma unroll
    for (int j = 0; j < 4; ++j) { const int n = (lane >> 3) + 8 * j; const LAS float* s = scr + (8 * c) * 33 + n;
        v4u o; o.x = pk2(s[0 * 33], s[1 * 33]); o.y = pk2(s[2 * 33], s[3 * 33]); o.z = pk2(s[4 * 33], s[5 * 33]); o.w = pk2(s[6 * 33], s[7 * 33]);
        *(GAS v4u*)(WT + (size_t)(dst_row0 + n) * K + k0 + 8 * c) = o; }
    LDS_WAIT(); asm volatile("" ::: "memory");
}
constexpr int IT_S0 = 16 * 80, IT_S1 = 16 * 96, IT_S2 = 512, IT_S3 = 512, IT_S4 = 256, IT_S5 = 256, IT_SMALL = IT_S0 + IT_S1 + IT_S2 + IT_S3 + IT_S4 + IT_S5;
__device__ __forceinline__ void small_item(const AV& a, int l, int r, LAS float* scr, int lane) {
    unsigned char* wl = a.ws() + WS_WSMALL + (size_t)l * WSMALL_LAYER; const float* win = a.in(10) + (size_t)l * DM * INCOLS;
    if (r < IT_S0) { const int kb = r / 80, n0 = (r % 80) * 32; int dr;
        if (n0 < 1536) dr = n0; else { int cc = n0 - 1536; if (cc < 512) dr = 1536 + (cc >> 7) * 256 + (cc & 127); else { cc -= 512; dr = 1536 + (cc >> 7) * 256 + 128 + (cc & 127); } }
        transpose_item(win, INCOLS, DM, (bf16*)(wl + OFFS_WIN), dr, kb * 64, n0, scr, lane); return; }
    r -= IT_S0;
    if (r < IT_S1) { const int kb = r / 96, nb = r % 96; transpose_item(win, INCOLS, DM, (bf16*)(wl + OFFS_WG), nb * 32, kb * 64, OFF_GATE + nb * 32, scr, lane); return; }
    r -= IT_S1;
    if (r < IT_S2) { const int kb = r / 32, nb = r % 32; transpose_item(a.in(13) + (size_t)l * DM * DM, DM, DM, (bf16*)(wl + OFFS_WAO), nb * 32, kb * 64, nb * 32, scr, lane); return; }
    r -= IT_S2;
    if (r < IT_S3) { const int kb = r / 32, nb = r % 32; transpose_item(a.in(20) + (size_t)l * DM * DM, DM, DM, (bf16*)(wl + OFFS_WOUT), nb * 32, kb * 64, nb * 32, scr, lane); return; }
    r -= IT_S3;
    if (r < IT_S4) { const int kb = r / 32, nb = r % 32; transpose_item(a.in(18) + (size_t)l * 512 * DM, DM, 512, (bf16*)(wl + OFFS_WCO), nb * 32, kb * 64, nb * 32, scr, lane); return; }
    r -= IT_S4;
    { const int kb = r / 32, nb = r % 32; transpose_item(a.in(19) + (size_t)l * 512 * DM, DM, 512, (bf16*)(wl + OFFS_WFO), nb * 32, kb * 64, nb * 32, scr, lane); }
}
__device__ __forceinline__ void transpose_item_fp8(const float* W, int ldw, int K, unsigned char* WT, int dst_row0, int k0, int n0, float scale, LAS float* scr, int lane) {
#pragma unroll 8
    for (int i = 0; i < 32; ++i) { const int kk = 2 * i + (lane >> 5); scr[kk * 33 + (lane & 31)] = W[(size_t)(k0 + kk) * ldw + n0 + (lane & 31)] * scale; }
    LDS_WAIT(); asm volatile("" ::: "memory");
#pragma unroll
    for (int j = 0; j < 2; ++j) { const int q = lane + 64 * j, n = q >> 2, c = q & 3; const LAS float* s = scr + (16 * c) * 33 + n; v4u o;
        int w;
        w = 0; w = __builtin_amdgcn_cvt_pk_fp8_f32(s[0 * 33], s[1 * 33], w, false); w = __builtin_amdgcn_cvt_pk_fp8_f32(s[2 * 33], s[3 * 33], w, true); o.x = (unsigned)w;
        w = 0; w = __builtin_amdgcn_cvt_pk_fp8_f32(s[4 * 33], s[5 * 33], w, false); w = __builtin_amdgcn_cvt_pk_fp8_f32(s[6 * 33], s[7 * 33], w, true); o.y = (unsigned)w;
        w = 0; w = __builtin_amdgcn_cvt_pk_fp8_f32(s[8 * 33], s[9 * 33], w, false); w = __builtin_amdgcn_cvt_pk_fp8_f32(s[10 * 33], s[11 * 33], w, true); o.z = (unsigned)w;
        w = 0; w = __builtin_amdgcn_cvt_pk_fp8_f32(s[12 * 33], s[13 * 33], w, false); w = __builtin_amdgcn_cvt_pk_fp8_f32(s[14 * 33], s[15 * 33], w, true); o.w = (unsigned)w;
        *(GAS v4u*)(WT + (size_t)(dst_row0 + n) * K + k0 + 16 * c) = o; }
    LDS_WAIT(); asm volatile("" ::: "memory");
}
constexpr int IT_MOE = NEXP * 3 * 512;
__device__ __forceinline__ void moe_item(const AV& a, int l, int idx, LAS float* scr, int lane) {
    const int e = idx / 1536, r = idx % 1536, which = r / 512, it = r % 512, kb = it / 32, n0 = (it % 32) * 32; const size_t eo = ((size_t)l * NEXP + e) << 20;
    unsigned char* wgu = a.ws() + WS_WGU + (size_t)l * MOEW_LAYER + (size_t)e * 2048 * 1024; unsigned char* wd = a.ws() + WS_WD + (size_t)l * MOEW_LAYER + (size_t)e * 1024 * 1024;
    if (which == 0) transpose_item_fp8(a.in(23) + eo, DM, DM, wgu, (n0 >> 7) * 256 + (n0 & 127), kb * 64, n0, 32.0f, scr, lane);
    else if (which == 1) transpose_item_fp8(a.in(25) + eo, DM, DM, wgu, (n0 >> 7) * 256 + 128 + (n0 & 127), kb * 64, n0, 32.0f, scr, lane);
    else transpose_item_fp8(a.in(27) + eo, DM, DM, wd, n0, kb * 64, n0, 32.0f, scr, lane);
}
__device__ __forceinline__ void fold_job(const AV& a, int j, const LAS float* ct, int lane) {
    const int l = j >> 10, r = j & 1023, g = r >> 8, kblk = (r >> 4) & 15, k2g = r & 15, k = kblk * 64 + lane;
    const float* wrow = a.in(10) + (size_t)l * DM * INCOLS + (size_t)k * INCOLS + OFF_FNET + g * 128;
    float ac[8], as[8];
#pragma unroll
    for (int i = 0; i < 8; ++i) { ac[i] = 0.f; as[i] = 0.f; }
    for (int n4 = 0; n4 < 32; ++n4) { const f32x4 w = *(const GAS f32x4*)(wrow + n4 * 4);
#pragma unroll
        for (int q = 0; q < 4; ++q) { const int n2 = n4 * 4 + q;
#pragma unroll
            for (int i = 0; i < 8; ++i) { const int ph = (n2 * (k2g * 8 + i)) & 127; ac[i] += w[q] * ct[ph]; as[i] += w[q] * ct[(ph - 32) & 127]; } } }
    bf16* wf = (bf16*)(a.ws() + WS_WSMALL + (size_t)l * WSMALL_LAYER + OFFS_WF);
#pragma unroll
    for (int i = 0; i < 8; ++i) { const int ch = g * 128 + k2g * 8 + i;
        wf[(size_t)ch * 1024 + k] = (bf16)f2bf(ac[i] * 0.08838834764831845f); wf[(size_t)(512 + ch) * 1024 + k] = (bf16)f2bf(as[i] * 0.08838834764831845f); }
}
__device__ __forceinline__ void p0_prologue(const Frame& F, const AV& a) {
    const int gw = F.vcu * NWAVES + F.wave, NGW = F.G * NWAVES, gt = F.vcu * NTHR + F.tid, NGT = F.G * NTHR;
    LAS float* ct = (LAS float*)(F.lds + LDS_CT);
    if (F.tid < 128) ct[F.tid] = cospif((float)F.tid * (1.0f / 64.0f));
    for (int job = blockIdx.x; job < 2 * 96; job += F.G) {
        const int l = job / 96, n0 = (job % 96) * 64;
        LAS float* s = (LAS float*)(F.lds + RING_OFF); LAS float* red = s + 17 * 1024;
        for (int i = F.tid; i < 17 * 1024; i += NTHR) { const int b = i >> 10, k = i & 1023; const float cv = b < 16 ? a.in(1)[b * 1024 + k] : a.in(3)[k]; s[i] = cv * sigmoidf_(cv); }
        __syncthreads();
        const int col = F.tid & 63, ks = F.tid >> 6; float acc[17];
#pragma unroll
        for (int b = 0; b < 17; ++b) acc[b] = 0.f;
        const float* w = a.in(4) + (size_t)l * DM * INCOLS + n0 + col;
        for (int k = ks * 128; k < ks * 128 + 128; ++k) { const float wv = w[(size_t)k * INCOLS];
#pragma unroll
            for (int b = 0; b < 17; ++b) acc[b] += s[b * 1024 + k] * wv; }
#pragma unroll
        for (int b = 0; b < 17; ++b) red[(ks * 17 + b) * 64 + col] = acc[b];
        __syncthreads();
        for (int i = F.tid; i < 17 * 64; i += NTHR) { const int b = i >> 6, c2 = i & 63; float t = 0.f;
#pragma unroll
            for (int q = 0; q < 8; ++q) t += red[(q * 17 + b) * 64 + c2];
            ((float*)(a.ws() + WS_MOD))[((size_t)l * 17 + b) * INCOLS + n0 + c2] = t + a.in(5)[l * INCOLS + n0 + c2]; }
        __syncthreads();
    }
    __syncthreads();
    for (int i = gt; i < 64 * 32; i += NGT) { const int p = i >> 5, f = i & 31; const float inv = powf(10000.0f, -(float)f / 32.0f), ang = (float)p * inv; ((f32x2*)(a.ws() + WS_TAB))[i] = (f32x2){cosf(ang), sinf(ang)}; }
    for (int i = gt; i < 2048 * 512; i += NGT) { const int k1 = i >> 9, c0 = (i & 511) * 8; float v[8];
#pragma unroll
        for (int q = 0; q < 8; ++q) { const int col = c0 + q, n1 = col & 2047, rr = (k1 * n1) & 2047; const float x = (float)rr * (1.0f / 1024.0f); v[q] = (col >> 11) ? -sinpif(x) : cospif(x); v[q] *= 0.022097086912079608f; }
        v4u o; o.x = pk2(v[0], v[1]); o.y = pk2(v[2], v[3]); o.z = pk2(v[4], v[5]); o.w = pk2(v[6], v[7]); ((GAS v4u*)(a.ws() + WS_DFTL))[i] = o; }
    for (int i = gt; i < 256 * 64; i += NGT) { const int k1 = i >> 6, c0 = (i & 63) * 8; float v[8];
#pragma unroll
        for (int q = 0; q < 8; ++q) { const int col = c0 + q, n1 = col & 255, rr = (k1 * n1) & 255; const float x = (float)rr * (1.0f / 128.0f); v[q] = (col >> 8) ? -sinpif(x) : cospif(x); v[q] *= 0.0625f; }
        v4u o; o.x = pk2(v[0], v[1]); o.y = pk2(v[2], v[3]); o.z = pk2(v[4], v[5]); o.w = pk2(v[6], v[7]); ((GAS v4u*)(a.ws() + WS_DFTC))[i] = o; }
    for (int i = gt; i < 2 * 256 * 1024; i += NGT) { const int l = i >> 18, r = (i >> 10) & 255, k = i & 1023; unsigned o = 0u;
        if (r < 64) { const float w = a.in(21)[((size_t)l * DM + k) * NEXP + (r & 31)]; const unsigned hi = f2bf(w); o = hi; if (r >= 32) o = f2bf(w - __uint_as_float(hi << 16)); }
        ((bf16*)(a.ws() + WS_WSMALL + (size_t)l * WSMALL_LAYER + OFFS_ROUT))[(size_t)r * 1024 + k] = (bf16)o; }
    for (int j = gw; j < 2048; j += NGW) fold_job(a, j, ct, F.lane);
    LAS float* scr = (LAS float*)(F.lds + RING_OFF + F.wave * 16384);
    for (int it = gw; it < 2 * IT_SMALL; it += NGW) small_item(a, it / IT_SMALL, it % IT_SMALL, scr, F.lane);
    for (int it = gw; it < 2 * IT_MOE; it += NGW) moe_item(a, it / IT_MOE, it % IT_MOE, scr, F.lane);
}
__device__ __forceinline__ void p1_norm0(const Frame& F, const AV& a) {
    const int gw = F.vcu * NWAVES + F.wave, NGW = F.G * NWAVES;
    for (int m = gw; m < TALL; m += NGW) {
        f32x4 v[4]; ld_row_f32(v, m < TL ? a.in(0) + (size_t)m * DM : a.in(2) + (size_t)(m - TL) * DM, F.lane);
        rms_gain(v, a.in(6), F.lane);
        const float* modv = (const float*)(a.ws() + WS_MOD) + (size_t)(m < TL ? (m >> 11) : 16) * INCOLS;
        modulate_store(v, modv, modv + 1024, (bf16*)(a.ws() + WS_H) + (size_t)m * DM, F.lane);
    }
}
__device__ __forceinline__ void qk_fix_vec(bf16* p, const float* g, const f32x2* tab, bool rope, int t, int sub, int lane) {
    f32x4 x[4]; float ss = 0.f;
#pragma unroll
    for (int jj = 0; jj < 4; ++jj) { x[jj] = bf4(*(const GAS u32x2*)(p + jj * 32 + sub * 4)); ss += (x[jj][0] * x[jj][0] + x[jj][1] * x[jj][1]) + (x[jj][2] * x[jj][2] + x[jj][3] * x[jj][3]); }
    ss += shx(ss, 1, lane); ss += shx(ss, 2, lane); ss += shx(ss, 4, lane);
    const float r = 1.0f / sqrtf(ss * (1.0f / 128.0f) + EPS);
#pragma unroll
    for (int jj = 0; jj < 4; ++jj) { const f32x4 gg = *(const GAS f32x4*)(g + jj * 32 + sub * 4); x[jj] = x[jj] * r * gg; }
    if (rope) { const int pr = t >> 6, pc = t & 63;
#pragma unroll
        for (int i = 0; i < 4; ++i) { const f32x2 cr = tab[pr * 32 + sub * 4 + i], cc = tab[pc * 32 + sub * 4 + i];
            const float a0 = x[0][i], a1 = x[1][i], b0 = x[2][i], b1 = x[3][i];
            x[0][i] = a0 * cr.x - a1 * cr.y; x[1][i] = a1 * cr.x + a0 * cr.y; x[2][i] = b0 * cc.x - b1 * cc.y; x[3][i] = b1 * cc.x + b0 * cc.y; } }
#pragma unroll
    for (int jj = 0; jj < 4; ++jj) *(GAS u32x2*)(p + jj * 32 + sub * 4) = pk4(x[jj]);
}
__device__ __forceinline__ void p_qkfix(const Frame& F, const AV& a, int l, int M) {
    const int gw = F.vcu * NWAVES + F.wave, NGW = F.G * NWAVES; const f32x2* tab = (const f32x2*)(a.ws() + WS_TAB);
    for (int m = gw; m < M; m += NGW) { const bool lat = m < TL; const int t = m & 2047, hh = F.lane >> 3, sub = F.lane & 7;
        if (lat || l == 0) qk_fix_vec((bf16*)(a.ws() + WS_Q) + (size_t)m * DM + hh * 128, a.in(11) + l * 128, tab, lat, t, sub, F.lane);
        if (F.lane < 16) qk_fix_vec((bf16*)(a.ws() + WS_K) + (size_t)krow_of(m) * 256 + hh * 128, a.in(12) + l * 128, tab, lat, t, sub, F.lane);
    }
}
__device__ __forceinline__ void p_conv(const Frame& F, const AV& a, int l, int njobs) {
    LAS unsigned char* lin = F.lds + RING_OFF; LAS float* lout = (LAS float*)(F.lds + RING_OFF + 62 * 1024);
    const bf16* cu = (const bf16*)(a.ws() + WS_CU); bf16* chb = (bf16*)(a.ws() + WS_CH);
    const int cp = F.tid & 255, pg = F.tid >> 8;
    f32x2 wv[31];
#pragma unroll
    for (int j = 0; j < 31; ++j) wv[j] = *(const GAS f32x2*)(a.in(14) + ((size_t)l * 31 + j) * 512 + 2 * cp);
    const f32x2 cb2 = *(const GAS f32x2*)(a.in(15) + l * 512 + 2 * cp);
    for (int job = F.vcu; job < njobs; job += F.G) {
        int rowbase, L, t0;
        if (job < 1024) { rowbase = (job >> 6) * SEQ; L = SEQ; t0 = (job & 63) * 32; } else { const int jc = job - 1024; rowbase = TL + (jc >> 3) * CTXL; L = CTXL; t0 = (jc & 7) * 32; }
        for (int idx = F.tid; idx < 62 * 64; idx += NTHR) { const int row = idx >> 6, ch = idx & 63, p = t0 - 15 + row; v4u val = (v4u){0u, 0u, 0u, 0u};
            if (p >= 0 && p < L) val = *(const GAS v4u*)(cu + (size_t)(rowbase + p) * 512 + ch * 8);
            *(LAS v4u*)(lin + row * 1024 + ch * 16) = val; }
        __syncthreads();
#pragma unroll
        for (int chunk = 0; chunk < 2; ++chunk) {
            f32x2 acc[8];
#pragma unroll
            for (int i = 0; i < 8; ++i) acc[i] = cb2;
            const int r0 = pg * 16 + chunk * 8;
#pragma unroll
            for (int r = 0; r < 38; ++r) { const unsigned w = *(const LAS unsigned*)(lin + (r0 + r) * 1024 + cp * 4); const float x0 = __uint_as_float(w << 16), x1 = __uint_as_float(w & 0xffff0000u);
#pragma unroll
                for (int i = 0; i < 8; ++i) { const int j = r - i; if (j >= 0 && j <= 30) { acc[i].x += x0 * wv[j].x; acc[i].y += x1 * wv[j].y; } } }
#pragma unroll
            for (int i = 0; i < 8; ++i) *(LAS f32x2*)(lout + (r0 + i) * 512 + 2 * cp) = acc[i];
        }
        __syncthreads();
#pragma unroll
        for (int pp = 0; pp < 4; ++pp) { const int p = F.wave * 4 + pp; const LAS float* src = lout + p * 512 + F.lane * 8;
            f32x4 y0 = *(const LAS f32x4*)src, y1 = *(const LAS f32x4*)(src + 4);
            const float mean = wave_sum((y0[0] + y0[1]) + (y0[2] + y0[3]) + (y1[0] + y1[1]) + (y1[2] + y1[3]), F.lane) * (1.0f / 512.0f);
            y0 = y0 - mean; y1 = y1 - mean;
            const float var = wave_sum((y0[0] * y0[0] + y0[1] * y0[1]) + (y0[2] * y0[2] + y0[3] * y0[3]) + (y1[0] * y1[0] + y1[1] * y1[1]) + (y1[2] * y1[2] + y1[3] * y1[3]), F.lane) * (1.0f / 512.0f);
            const float rs = 1.0f / sqrtf(var + EPS);
            const f32x4 g0 = *(const GAS f32x4*)(a.in(16) + l * 512 + F.lane * 8), g1 = *(const GAS f32x4*)(a.in(16) + l * 512 + F.lane * 8 + 4);
            const f32x4 b0 = *(const GAS f32x4*)(a.in(17) + l * 512 + F.lane * 8), b1 = *(const GAS f32x4*)(a.in(17) + l * 512 + F.lane * 8 + 4);
            y0 = y0 * rs * g0 + b0; y1 = y1 * rs * g1 + b1;
#pragma unroll
            for (int q = 0; q < 4; ++q) { y0[q] = y0[q] * sigmoidf_(y0[q]); y1[q] = y1[q] * sigmoidf_(y1[q]); }
            v4u o; o.x = pk2(y0[0], y0[1]); o.y = pk2(y0[2], y0[3]); o.z = pk2(y1[0], y1[1]); o.w = pk2(y1[2], y1[3]);
            *(GAS v4u*)(chb + (size_t)(rowbase + t0 + p) * 512 + F.lane * 8) = o; }
        __syncthreads();
    }
}
__device__ __forceinline__ void p_rowpass1(const Frame& F, const AV& a, int l, int M) {
    const int gw = F.vcu * NWAVES + F.wave, NGW = F.G * NWAVES;
    for (int m = gw; m < M; m += NGW) {
        const float* xs = (l == 0) ? (m < TL ? a.in(0) + (size_t)m * DM : a.in(2) + (size_t)(m - TL) * DM) : (m < TL ? a.out() + (size_t)m * DM : (const float*)(a.ws() + WS_XC) + (size_t)(m - TL) * DM);
        float* xd = m < TL ? a.out() + (size_t)m * DM : (float*)(a.ws() + WS_XC) + (size_t)(m - TL) * DM;
        const float* modv = (const float*)(a.ws() + WS_MOD) + ((size_t)l * 17 + (m < TL ? (m >> 11) : 16)) * INCOLS;
        f32x4 x[4], y[4]; ld_row_f32(x, xs, F.lane); ld_row_bf16(y, (const bf16*)(a.ws() + WS_MIX) + (size_t)m * DM, F.lane);
        rms_gain(y, a.in(7) + l * DM, F.lane);
#pragma unroll
        for (int j = 0; j < 4; ++j) { const f32x4 gt = ((const GAS f32x4*)(modv + 2 * 1024))[F.lane + 64 * j]; x[j] = x[j] + gt * y[j]; }
        st_row_f32(x, xd, F.lane);
        rms_gain(x, a.in(8) + l * DM, F.lane);
        modulate_store(x, modv + 3 * 1024, modv + 4 * 1024, (bf16*)(a.ws() + WS_H) + (size_t)m * DM, F.lane);
    }
}
__device__ __forceinline__ void p_topk(const Frame& F, const AV& a, int l, int M) {
    LAS int* cntl = (LAS int*)(F.lds + LDS_SM);
    if (F.tid < 32) cntl[F.tid] = 0;
    __syncthreads();
    const int TPB = (M + F.G - 1) / F.G, m0 = blockIdx.x * TPB, m1 = (m0 + TPB < M) ? m0 + TPB : M;
    const float* lg = (const float*)(a.ws() + WS_LOGIT);
    for (int m = m0 + F.wave; m < m1; m += NWAVES) {
        float v = -3.0e38f;
        if (F.lane < 32) v = lg[(size_t)m * 64 + F.lane] + lg[(size_t)m * 64 + 32 + F.lane] + a.in(22)[l * NEXP + F.lane];
        unsigned ub = __float_as_uint(v); ub = (ub & 0x80000000u) ? ~ub : (ub | 0x80000000u);
        unsigned long long key = ((unsigned long long)ub << 32) | (unsigned)(63 - F.lane);
        int ids[4]; float vals[4];
#pragma unroll
        for (int k = 0; k < 4; ++k) { unsigned long long mx = key;
#pragma unroll
            for (int o = 1; o < 64; o <<= 1) { const int pa = (F.lane ^ o) << 2; const unsigned long long t = ((unsigned long long)(unsigned)__builtin_amdgcn_ds_bpermute(pa, (int)(unsigned)(mx >> 32)) << 32) | (unsigned)__builtin_amdgcn_ds_bpermute(pa, (int)(unsigned)mx); mx = t > mx ? t : mx; }
            const int id = 63 - (int)(mx & 63ull); ids[k] = id; vals[k] = __int_as_float(__builtin_amdgcn_ds_bpermute(id << 2, __float_as_int(v))); if (F.lane == id) key = 0ull; }
        const float e1 = __expf(vals[1] - vals[0]), e2 = __expf(vals[2] - vals[0]), e3 = __expf(vals[3] - vals[0]), inv = 1.0f / (1.0f + e1 + e2 + e3);
        if (F.lane == 0) { *(GAS i32x4*)((int*)(a.ws() + WS_TOPI) + (size_t)m * 4) = (i32x4){ids[0], ids[1], ids[2], ids[3]};
            *(GAS f32x4*)((float*)(a.ws() + WS_TOPP) + (size_t)m * 4) = (f32x4){inv, e1 * inv, e2 * inv, e3 * inv}; }
        if (F.lane < 4) __hip_atomic_fetch_add(&cntl[F.lane == 0 ? ids[0] : F.lane == 1 ? ids[1] : F.lane == 2 ? ids[2] : ids[3]], 1, __ATOMIC_RELAXED, __HIP_MEMORY_SCOPE_WORKGROUP);
    }
    __syncthreads();
    if (F.tid < 32) ((int*)(a.ws() + WS_CNT))[blockIdx.x * 32 + F.tid] = cntl[F.tid];
}
__device__ __forceinline__ void p_slots(const Frame& F, const AV& a, int M) {
    LAS int* sm = (LAS int*)(F.lds + LDS_SM);
    LAS int *tot = sm, *bef = sm + 32, *base = sm + 64, *tst = sm + 96  , *mask = sm + 160  , *ids = sm + 320  , *slot = sm + 960  ;
    const int* cnt = (const int*)(a.ws() + WS_CNT);
    { LAS int* ptot = sm + 1600; LAS int* pbef = sm + 2112; const int e = F.tid & 31, part = F.tid >> 5; int t = 0, b = 0;
#pragma unroll 4
      for (int q = part; q < F.G; q += 16) { const int c = cnt[q * 32 + e]; t += c; if (q < (int)blockIdx.x) b += c; }
      ptot[part * 32 + e] = t; pbef[part * 32 + e] = b;
      __syncthreads();
      if (F.tid < 32) { int tt = 0, bb = 0;
#pragma unroll
          for (int q = 0; q < 16; ++q) { tt += ptot[q * 32 + F.tid]; bb += pbef[q * 32 + F.tid]; }
          tot[F.tid] = tt; bef[F.tid] = bb; } }
    __syncthreads();
    if (F.tid == 0) { int ts = 0; for (int e = 0; e < 32; ++e) { tst[e] = ts; base[e] = ts * 256 + bef[e]; ts += (tot[e] + 255) >> 8; } tst[32] = ts; }
    __syncthreads();
    const int NT = tst[32];
    if (blockIdx.x == 0) { int* te = (int*)(a.ws() + WS_CNT) + CNT_TILE_E;
        for (int t = F.tid; t < NT; t += NTHR) { int e = 0; for (int q = 1; q < 32; ++q) if (t >= tst[q]) e = q; te[t] = e; }
        if (F.tid == 0) ((int*)(a.ws() + WS_CNT))[CNT_NT] = NT; }
    const int TPB = (M + F.G - 1) / F.G, m0 = blockIdx.x * TPB, m1 = (m0 + TPB < M) ? m0 + TPB : M, nt = m1 > m0 ? m1 - m0 : 0;
    for (int tl = F.tid; tl < nt; tl += NTHR) { const i32x4 id = *(const GAS i32x4*)((const int*)(a.ws() + WS_TOPI) + (size_t)(m0 + tl) * 4);
        ids[tl * 4 + 0] = id.x; ids[tl * 4 + 1] = id.y; ids[tl * 4 + 2] = id.z; ids[tl * 4 + 3] = id.w; mask[tl] = (1 << id.x) | (1 << id.y) | (1 << id.z) | (1 << id.w); }
    __syncthreads();
    for (int p = F.tid; p < nt * 4; p += NTHR) { const int tl = p >> 2, e = ids[p]; int rank = 0; for (int q = 0; q < tl; ++q) rank += (mask[q] >> e) & 1;
        const int s = base[e] + rank; slot[p] = s; ((int*)(a.ws() + WS_SLOT))[(size_t)(m0 + tl) * 4 + (p & 3)] = s; }
    __syncthreads();
    const bf16* h = (const bf16*)(a.ws() + WS_H); unsigned char* hs = a.ws() + WS_HS;
    for (int p = F.wave; p < nt * 4; p += NWAVES) { const GAS v4u* src = (const GAS v4u*)(h + (size_t)(m0 + (p >> 2)) * DM); GAS u32x2* dst = (GAS u32x2*)(hs + (size_t)slot[p] * DM);
#pragma unroll
        for (int j = 0; j < 2; ++j) { const v4u x = src[F.lane + 64 * j]; int w0 = 0, w1 = 0;
            w0 = __builtin_amdgcn_cvt_pk_fp8_f32(__uint_as_float(x.x << 16), __uint_as_float(x.x & 0xffff0000u), w0, false); w0 = __builtin_amdgcn_cvt_pk_fp8_f32(__uint_as_float(x.y << 16), __uint_as_float(x.y & 0xffff0000u), w0, true);
            w1 = __builtin_amdgcn_cvt_pk_fp8_f32(__uint_as_float(x.z << 16), __uint_as_float(x.z & 0xffff0000u), w1, false); w1 = __builtin_amdgcn_cvt_pk_fp8_f32(__uint_as_float(x.w << 16), __uint_as_float(x.w & 0xffff0000u), w1, true);
            u32x2 o; o.x = (unsigned)w0; o.y = (unsigned)w1; dst[F.lane + 64 * j] = o; } }
    if (blockIdx.x < 32) { const int e = blockIdx.x, r0 = tst[e] * 256 + tot[e], r1 = tst[e + 1] * 256;
        for (int r = r0 + F.wave; r < r1; r += NWAVES) { GAS v4u* dst = (GAS v4u*)(hs + (size_t)r * DM); dst[F.lane] = (v4u){0u, 0u, 0u, 0u}; } }
    __syncthreads();
}
__device__ __forceinline__ void p_combine(const Frame& F, const AV& a, int l, int M) {
    const int gw = F.vcu * NWAVES + F.wave, NGW = F.G * NWAVES; const bf16* ys = (const bf16*)(a.ws() + WS_YS);
    for (int m = gw; m < M; m += NGW) {
        const i32x4 sl = *(const GAS i32x4*)((const int*)(a.ws() + WS_SLOT) + (size_t)m * 4); const f32x4 pr = *(const GAS f32x4*)((const float*)(a.ws() + WS_TOPP) + (size_t)m * 4);
        f32x4 y[4], t[4];
        ld_row_bf16(y, ys + (size_t)sl.x * DM, F.lane);
#pragma unroll
        for (int j = 0; j < 4; ++j) y[j] = y[j] * pr[0];
        ld_row_bf16(t, ys + (size_t)sl.y * DM, F.lane);
#pragma unroll
        for (int j = 0; j < 4; ++j) y[j] += t[j] * pr[1];
        ld_row_bf16(t, ys + (size_t)sl.z * DM, F.lane);
#pragma unroll
        for (int j = 0; j < 4; ++j) y[j] += t[j] * pr[2];
        ld_row_bf16(t, ys + (size_t)sl.w * DM, F.lane);
#pragma unroll
        for (int j = 0; j < 4; ++j) y[j] += t[j] * pr[3];
        rms_gain(y, a.in(9) + l * DM, F.lane);
        float* xd = m < TL ? a.out() + (size_t)m * DM : (float*)(a.ws() + WS_XC) + (size_t)(m - TL) * DM;
        const int b = m < TL ? (m >> 11) : 16;
        const float* modv = (const float*)(a.ws() + WS_MOD) + ((size_t)l * 17 + b) * INCOLS;
        f32x4 x[4]; ld_row_f32(x, xd, F.lane);
#pragma unroll
        for (int j = 0; j < 4; ++j) { const f32x4 gt = ((const GAS f32x4*)(modv + 5 * 1024))[F.lane + 64 * j]; x[j] = x[j] + gt * y[j]; }
        st_row_f32(x, xd, F.lane);
        if (l == 0) { rms_gain(x, a.in(6) + DM, F.lane); const float* mod1 = (const float*)(a.ws() + WS_MOD) + ((size_t)17 + b) * INCOLS;
            modulate_store(x, mod1, mod1 + 1024, (bf16*)(a.ws() + WS_H) + (size_t)m * DM, F.lane); }
    }
}
#ifdef DBG_CHECK
#ifndef DBG_GSUB
#define DBG_GSUB 0
#endif
__device__ __forceinline__ double bfd(bf16 b) { return (double)__uint_as_float(((unsigned)b) << 16); }
__device__ __forceinline__ unsigned hsh(unsigned x) { x ^= x >> 16; x *= 0x7feb352du; x ^= x >> 15; x *= 0x846ca68bu; x ^= x >> 16; return x; }
__device__ __forceinline__ int samp_row(int i, int M, unsigned salt) { const int sp[12] = {0, 1, 255, 256, 2047, 2048, 4095, 32767, 32768, 32769, 33023, 36863}; if (i < 12 && sp[i] < M) return sp[i]; return (int)(hsh(i * 7919u + salt) % (unsigned)M); }
__device__ __forceinline__ void rec(float* res, int stage, double got, double want, double flo) { const double e = fabs(got - want) / (fabs(want) + flo); const float f = (e == e) ? (float)e : 1e30f; atomicMax((unsigned*)res + stage, __float_as_uint(f)); }
__device__ double dot_h_w(const bf16* hrow, const float* w, int ldw, int col) { double s = 0; for (int k = 0; k < 1024; ++k) s += bfd(hrow[k]) * (double)w[(size_t)k * ldw + col]; return s; }
__device__ double dsig(double x) { return 1.0 / (1.0 + exp(-x)); }
constexpr double PI_D = 3.14159265358979323846;
enum { ST_MOD = 0, ST_H0, ST_INPROJ, ST_YT, ST_QKFIX, ST_CONV, ST_Z, ST_ATTN, ST_GATES, ST_MERGED, ST_MIX, ST_ROW1, ST_LOGIT, ST_TOPK, ST_SLOTS, ST_ACT, ST_YSLOT, ST_COMB, ST_GATESB, ST_N };
__global__ void chk(Args A, int stage, int l, float* res, float* snap) {
    const int i = threadIdx.x; unsigned char* ws = A.ws; const int M = (l == 0) ? TALL : TL; const int rs = stage + 32 * l;
    const bf16* H = (const bf16*)(ws + WS_H); const float* win = A.in[10] + (size_t)l * DM * INCOLS; const float* modb = (const float*)(ws + WS_MOD);
    if (stage == ST_MOD) { const int ll = i & 1, b = (i >> 1) % 17, n = (int)(hsh(i) % 6144u); double s = 0; for (int k = 0; k < 1024; ++k) { const double cv = b < 16 ? A.in[1][b * 1024 + k] : A.in[3][k]; s += cv * dsig(cv) * (double)A.in[4][((size_t)ll * 1024 + k) * 6144 + n]; }
        s += A.in[5][ll * 6144 + n]; rec(res, rs, modb[((size_t)ll * 17 + b) * 6144 + n], s, 0.02); }
    else if (stage == ST_H0) { const int m = samp_row(i, TALL, 1), c = (int)(hsh(i + 77) % 1024u); const float* x = m < TL ? A.in[0] + (size_t)m * DM : A.in[2] + (size_t)(m - TL) * DM; double ss = 0; for (int k = 0; k < 1024; ++k) ss += (double)x[k] * x[k];
        const float* mv = modb + (size_t)(m < TL ? (m >> 11) : 16) * 6144; const double want = x[c] / sqrt(ss / 1024 + 1e-6) * A.in[6][c] * (1.0 + mv[1024 + c]) + mv[c]; rec(res, rs, bfd(H[(size_t)m * DM + c]), want, 0.05); }
    else if (stage == ST_INPROJ) { const int m = samp_row(i, TALL, 2), kind = i & 3; const bf16* hr = H + (size_t)m * DM;
        if (kind == 0) { const int n = (int)(hsh(i + 5) % 1024u); rec(res, rs, bfd(((const bf16*)(ws + WS_Q))[(size_t)m * DM + n]), dot_h_w(hr, win, INCOLS, n), 0.05); }
        else if (kind == 1) { const int n = (int)(hsh(i + 6) % 256u); rec(res, rs, bfd(((const bf16*)(ws + WS_K))[(size_t)krow_of(m) * 256 + n]), dot_h_w(hr, win, INCOLS, 1024 + n), 0.05); }
        else if (kind == 2) { const int n = (int)(hsh(i + 7) % 256u); rec(res, rs, bfd(((const bf16*)(ws + WS_V))[(size_t)krow_of(m) * 256 + n]), dot_h_w(hr, win, INCOLS, 1280 + n), 0.05); }
        else { const int c = (int)(hsh(i + 8) % 512u); if (l == 0 || m < TL) { const double a = dot_h_w(hr, win, INCOLS, 1536 + c), g = dot_h_w(hr, win, INCOLS, 2048 + c); rec(res, rs, bfd(((const bf16*)(ws + WS_CU))[(size_t)m * 512 + c]), a * dsig(g), 0.05); } } }
    else if (stage == ST_YT) { const int m = samp_row(i, M, 3), ch = (int)(hsh(i + 9) % 512u), cs = i & 1, g = ch >> 7, k2 = ch & 127; const bf16* hr = H + (size_t)m * DM; double s = 0;
        for (int k = 0; k < 1024; ++k) { double t = 0; for (int n2 = 0; n2 < 128; ++n2) { const double ang = 2.0 * PI_D * ((n2 * k2) & 127) / 128.0; t += (double)win[(size_t)k * INCOLS + OFF_FNET + g * 128 + n2] * (cs ? sin(ang) : cos(ang)); } s += bfd(hr[k]) * t; }
        s /= sqrt(128.0); double got; if (m < TL) got = bfd(((const bf16*)(ws + WS_YT))[((size_t)(m >> 11) * 512 + ch) * 4096 + cs * 2048 + (m & 2047)]); else got = bfd(((const bf16*)(ws + WS_YTC))[((size_t)((m - TL) >> 8) * 512 + ch) * 512 + cs * 256 + ((m - TL) & 255)]);
        rec(res, rs, got, s, 0.05); }
    else if (stage == ST_QKFIX) { const int m = samp_row(i, TALL, 4), isk = i & 1, hh = isk ? (int)(hsh(i + 3) % 2u) : (int)(hsh(i + 3) % 8u), d = (int)(hsh(i + 4) % 128u); const bf16* hr = H + (size_t)m * DM;
        if (isk || l == 0 || m < TL) { const int cbase = isk ? 1024 + hh * 128 : hh * 128; double ss = 0, xd = 0, xp = 0; const int half = d & 64, dd = d & 63, pd = half + ((dd + 32) & 63);
            for (int q = 0; q < 128; ++q) { double v = dot_h_w(hr, win, INCOLS, cbase + q); v = bfd((bf16)f2bf((float)v)); ss += v * v; if (q == d) xd = v; if (q == pd) xp = v; }
            const float* gn = (isk ? A.in[12] : A.in[11]) + l * 128; const double r = 1.0 / sqrt(ss / 128 + 1e-6); xd *= r * gn[d]; xp *= r * gn[pd]; double want = xd;
            if (m < TL) { const int t = m & 2047, pos = half ? (t & 63) : (t >> 6), f = dd & 31; const double ang = (double)((float)pos * powf(10000.0f, -(float)f / 32.0f)); want = (dd < 32) ? xd * cos(ang) - xp * sin(ang) : xd * cos(ang) + xp * sin(ang); }
            const double got = isk ? bfd(((const bf16*)(ws + WS_K))[(size_t)krow_of(m) * 256 + hh * 128 + d]) : bfd(((const bf16*)(ws + WS_Q))[(size_t)m * DM + hh * 128 + d]); rec(res, rs, got, want, 0.05); } }
    else if (stage == ST_CONV) { const int m = samp_row(i, M, 5), c = (int)(hsh(i + 11) % 512u); const int rowbase = m < TL ? (m >> 11) * SEQ : TL + ((m - TL) >> 8) * CTXL, L = m < TL ? SEQ : CTXL, t = m - rowbase; const bf16* cu = (const bf16*)(ws + WS_CU);
        double s1 = 0, s2 = 0, yc = 0; for (int cc = 0; cc < 512; ++cc) { double y = A.in[15][l * 512 + cc]; for (int j = 0; j < 31; ++j) { const int p = t + j - 15; if (p >= 0 && p < L) y += bfd(cu[(size_t)(rowbase + p) * 512 + cc]) * (double)A.in[14][((size_t)l * 31 + j) * 512 + cc]; } s1 += y; s2 += y * y; if (cc == c) yc = y; }
        const double mean = s1 / 512, var = s2 / 512 - mean * mean; double y = (yc - mean) / sqrt(var + 1e-6) * A.in[16][l * 512 + c] + A.in[17][l * 512 + c]; y = y * dsig(y); rec(res, rs, bfd(((const bf16*)(ws + WS_CH))[(size_t)m * 512 + c]), y, 0.05); }
    else if (stage == ST_Z) { const int m = samp_row(i, M, 6), ch = (int)(hsh(i + 12) % 512u); double s = 0;
        if (m < TL) { const int b = m >> 11, k1 = m & 2047; const bf16* yr = (const bf16*)(ws + WS_YT) + ((size_t)b * 512 + ch) * 4096; for (int n1 = 0; n1 < 2048; ++n1) { const double ang = 2.0 * PI_D * ((k1 * n1) & 2047) / 2048.0; s += cos(ang) * bfd(yr[n1]) - sin(ang) * bfd(yr[2048 + n1]); } s /= sqrt(2048.0); }
        else { const int b = (m - TL) >> 8, k1 = (m - TL) & 255; const bf16* yr = (const bf16*)(ws + WS_YTC) + ((size_t)b * 512 + ch) * 512; for (int n1 = 0; n1 < 256; ++n1) { const double ang = 2.0 * PI_D * ((k1 * n1) & 255) / 256.0; s += cos(ang) * bfd(yr[n1]) - sin(ang) * bfd(yr[256 + n1]); } s /= 16.0; }
        rec(res, rs, bfd(((const bf16*)(ws + WS_Z))[(size_t)m * 512 + ch]), s, 0.05); }
    else if (stage == ST_ATTN) { const int m = samp_row(i, M, 7), hh = (int)(hsh(i + 13) % 8u), d = (int)(hsh(i + 14) % 128u); const bf16* q = (const bf16*)(ws + WS_Q) + (size_t)m * DM + hh * 128;
        int kr0, nk; if (m < TL) { kr0 = (m >> 11) * KVROWS; nk = KVROWS; } else { kr0 = ((m - TL) >> 8) * KVROWS + SEQ; nk = CTXL; }
        const bf16* K = (const bf16*)(ws + WS_K) + (size_t)kr0 * 256 + (hh >> 2) * 128; const bf16* V = (const bf16*)(ws + WS_V) + (size_t)kr0 * 256 + (hh >> 2) * 128;
        double mx = -1e300; for (int j = 0; j < nk; ++j) { double s = 0; for (int q2 = 0; q2 < 128; ++q2) s += bfd(q[q2]) * bfd(K[(size_t)j * 256 + q2]); s *= 0.08838834764831845; if (s > mx) mx = s; }
        double den = 0, num = 0; for (int j = 0; j < nk; ++j) { double s = 0; for (int q2 = 0; q2 < 128; ++q2) s += bfd(q[q2]) * bfd(K[(size_t)j * 256 + q2]); s *= 0.08838834764831845; const double p = exp(s - mx); den += p; num += p * bfd(V[(size_t)j * 256 + d]); }
        rec(res, rs, bfd(((const bf16*)(ws + WS_AO))[(size_t)m * DM + hh * 128 + d]), num / den, 0.03); }
    else if (stage == ST_GATES) { const int m = samp_row(i, M, 8), n = (int)(hsh(i + 15) % 3072u); rec(res, rs, bfd(((const bf16*)(ws + WS_GATES))[(size_t)m * 3072 + n]), dsig(dot_h_w(H + (size_t)m * DM, win, INCOLS, OFF_GATE + n)), 0.05); }
    else if (stage == ST_GATESB && DBG_GSUB == 1) { const int m = samp_row(i, M, 8), n = (int)(hsh(i + 15) % 3072u); const double got = bfd(((const bf16*)(ws + WS_GATES))[(size_t)m * 3072 + n]), want = dsig(dot_h_w(H + (size_t)m * DM, win, INCOLS, OFF_GATE + n));
        const bool badv = !(fabs(got - want) <= 0.05); if (badv) { unsigned* r = (unsigned*)res + 48; atomicOr(r, (m < TL ? 1u : 2u) | (4u << (n >> 10)) | (i < 12 ? 32u : 0u)); } }
    else if (stage == ST_GATESB) { const int m = samp_row(i, M, 8), n = (int)(hsh(i + 15) % 3072u); const bf16* wt = (const bf16*)(ws + WS_WSMALL + (size_t)l * WSMALL_LAYER + OFFS_WG) + (size_t)n * 1024; const bf16* hr = H + (size_t)m * DM; double s = 0; for (int k = 0; k < 1024; ++k) s += bfd(hr[k]) * bfd(wt[k]);
        rec(res, rs, bfd(((const bf16*)(ws + WS_GATES))[(size_t)m * 3072 + n]), dsig(s), 0.05); }
    else if (stage == ST_MERGED) { const int m = samp_row(i, M, 9), c = (int)(hsh(i + 16) % 1024u); const bf16* g = (const bf16*)(ws + WS_GATES) + (size_t)m * 3072; double y0 = 0, y1 = 0, y2 = 0;
        const bf16* ao = (const bf16*)(ws + WS_AO) + (size_t)m * DM; const bf16* chh = (const bf16*)(ws + WS_CH) + (size_t)m * 512; const bf16* z = (const bf16*)(ws + WS_Z) + (size_t)m * 512;
        for (int k = 0; k < 1024; ++k) y0 += bfd(ao[k]) * (double)A.in[13][((size_t)l * 1024 + k) * 1024 + c];
        for (int k = 0; k < 512; ++k) { y1 += bfd(chh[k]) * (double)A.in[18][((size_t)l * 512 + k) * 1024 + c]; y2 += bfd(z[k]) * (double)A.in[19][((size_t)l * 512 + k) * 1024 + c]; }
        rec(res, rs, bfd(((const bf16*)(ws + WS_MERGED))[(size_t)m * DM + c]), bfd(g[c]) * y0 + bfd(g[1024 + c]) * y1 + bfd(g[2048 + c]) * y2, 0.05); }
    else if (stage == ST_MIX) { const int m = samp_row(i, M, 10), c = (int)(hsh(i + 17) % 1024u); rec(res, rs, bfd(((const bf16*)(ws + WS_MIX))[(size_t)m * DM + c]), dot_h_w((const bf16*)(ws + WS_MERGED) + (size_t)m * DM, A.in[20] + (size_t)l * DM * DM, DM, c), 0.05); }
    else if (stage == ST_ROW1) { const int m = samp_row(i, M, 11), c = (int)(hsh(i + 18) % 1024u); const float* xs = snap + (size_t)i * 1024;
        const bf16* mix = (const bf16*)(ws + WS_MIX) + (size_t)m * DM; const float* mv = modb + ((size_t)l * 17 + (m < TL ? (m >> 11) : 16)) * 6144; double ss = 0; for (int k = 0; k < 1024; ++k) ss += bfd(mix[k]) * bfd(mix[k]); const double r = 1.0 / sqrt(ss / 1024 + 1e-6);
        double s2 = 0, xc = 0; for (int k = 0; k < 1024; ++k) { const double xn = xs[k] + mv[2048 + k] * (bfd(mix[k]) * r * A.in[7][l * DM + k]); s2 += xn * xn; if (k == c) xc = xn; }
        const float* xd = m < TL ? A.out + (size_t)m * DM : (const float*)(ws + WS_XC) + (size_t)(m - TL) * DM; rec(res, rs, xd[c], xc, 0.02);
        rec(res, rs, bfd(H[(size_t)m * DM + c]), xc / sqrt(s2 / 1024 + 1e-6) * A.in[8][l * DM + c] * (1.0 + mv[4096 + c]) + mv[3072 + c], 0.05); }
    else if (stage == ST_LOGIT) { const int m = samp_row(i, M, 12), e = i & 31; const float* lg = (const float*)(ws + WS_LOGIT) + (size_t)m * 64; rec(res, rs, (double)lg[e] + lg[32 + e], dot_h_w(H + (size_t)m * DM, A.in[21] + (size_t)l * DM * NEXP, NEXP, e), 0.02); }
    else if (stage == ST_TOPK) { const int m = samp_row(i, M, 13); const float* lg = (const float*)(ws + WS_LOGIT) + (size_t)m * 64; float v[32]; for (int e = 0; e < 32; ++e) v[e] = lg[e] + lg[32 + e] + A.in[22][l * 32 + e];
        int id[4]; float tv[4]; for (int k = 0; k < 4; ++k) { int b = -1; for (int e = 0; e < 32; ++e) { bool used = false; for (int q = 0; q < k; ++q) used |= (id[q] == e); if (!used && (b < 0 || v[e] > v[b])) b = e; } id[k] = b; tv[k] = v[b]; }
        double den = 0; for (int k = 0; k < 4; ++k) den += exp((double)tv[k] - tv[0]); const int* gi = (const int*)(ws + WS_TOPI) + (size_t)m * 4; const float* gp = (const float*)(ws + WS_TOPP) + (size_t)m * 4;
        for (int k = 0; k < 4; ++k) { rec(res, rs, gi[k] == id[k] ? 0.0 : 1.0, 0, 0.01); rec(res, rs, gp[k], exp((double)tv[k] - tv[0]) / den, 0.01); } }
    else if (stage == ST_SLOTS) { const int m = samp_row(i, M, 14), k = i & 3; const int s = ((const int*)(ws + WS_SLOT))[(size_t)m * 4 + k], e = ((const int*)(ws + WS_TOPI))[(size_t)m * 4 + k]; const int NT = ((const int*)(ws + WS_CNT))[CNT_NT];
        if (s < 0 || s >= NT * 256) rec(res, rs, 1, 0, 0.01); else { rec(res, rs, ((const int*)(ws + WS_CNT))[CNT_TILE_E + (s >> 8)] == e ? 0.0 : 1.0, 0, 0.01); const bf16* hs = (const bf16*)(ws + WS_HS) + (size_t)s * DM; double df = 0; for (int q = 0; q < 1024; ++q) df += fabs(bfd(hs[q]) - bfd(H[(size_t)m * DM + q])); rec(res, rs, df, 0, 1e-3); } }
    else if (stage == ST_ACT) { const int m = samp_row(i, M, 15), k = i & 3, c = (int)(hsh(i + 21) % 1024u); const int s = ((const int*)(ws + WS_SLOT))[(size_t)m * 4 + k], e = ((const int*)(ws + WS_TOPI))[(size_t)m * 4 + k]; const bf16* hs = (const bf16*)(ws + WS_HS) + (size_t)s * DM;
        double g = dot_h_w(hs, A.in[23] + (((size_t)l * NEXP + e) << 20), DM, c) + A.in[24][((size_t)l * NEXP + e) * 1024 + c], u = dot_h_w(hs, A.in[25] + (((size_t)l * NEXP + e) << 20), DM, c) + A.in[26][((size_t)l * NEXP + e) * 1024 + c];
        g = g < 7.0 ? g : 7.0; u = u < -7.0 ? -7.0 : (u > 7.0 ? 7.0 : u); rec(res, rs, bfd(((const bf16*)(ws + WS_ACT))[(size_t)s * DM + c]), (u + 1.0) * (g * dsig(1.702 * g)), 0.05); }
    else if (stage == ST_YSLOT) { const int m = samp_row(i, M, 16), k = i & 3, c = (int)(hsh(i + 22) % 1024u); const int s = ((const int*)(ws + WS_SLOT))[(size_t)m * 4 + k], e = ((const int*)(ws + WS_TOPI))[(size_t)m * 4 + k];
        rec(res, rs, bfd(((const bf16*)(ws + WS_HS))[(size_t)s * DM + c]), dot_h_w((const bf16*)(ws + WS_ACT) + (size_t)s * DM, A.in[27] + (((size_t)l * NEXP + e) << 20), DM, c) + A.in[28][((size_t)l * NEXP + e) * 1024 + c], 0.05); }
    else if (stage == ST_COMB) { const int m = samp_row(i, M, 17), c = (int)(hsh(i + 23) % 1024u); const float* xs = snap + (size_t)i * 1024; const int* sl = (const int*)(ws + WS_SLOT) + (size_t)m * 4; const float* pr = (const float*)(ws + WS_TOPP) + (size_t)m * 4;
        const float* mv = modb + ((size_t)l * 17 + (m < TL ? (m >> 11) : 16)) * 6144; double ss = 0, yc = 0; for (int q = 0; q < 1024; ++q) { double y = 0; for (int k = 0; k < 4; ++k) y += (double)pr[k] * bfd(((const bf16*)(ws + WS_HS))[(size_t)sl[k] * DM + q]); ss += y * y; if (q == c) yc = y; }
        const double want = xs[c] + mv[5 * 1024 + c] * (yc / sqrt(ss / 1024 + 1e-6) * A.in[9][l * DM + c]); const float* xd = m < TL ? A.out + (size_t)m * DM : (const float*)(ws + WS_XC) + (size_t)(m - TL) * DM; rec(res, rs, xd[c], want, 0.02); }
}
__global__ void snap_rows(Args A, int l, int salt, float* snap) {
    const int i = blockIdx.x, M = (l == 0) ? TALL : TL, m = samp_row(i, M, salt); const float* xs;
    if (l == 0 && salt == 11) xs = m < TL ? A.in[0] + (size_t)m * DM : A.in[2] + (size_t)(m - TL) * DM; else xs = m < TL ? A.out + (size_t)m * DM : (const float*)(A.ws + WS_XC) + (size_t)(m - TL) * DM;
    for (int k = threadIdx.x; k < 1024; k += blockDim.x) snap[(size_t)i * 1024 + k] = xs[k];
}
__global__ void chk_gates_full(const bf16* H, const bf16* Wt, const bf16* G, int M, unsigned* cntw) {
    const int n = blockIdx.x * 64 + (threadIdx.x & 63), m = blockIdx.y * 4 + (threadIdx.x >> 6); if (m >= M) return;
    const uint4* a = (const uint4*)(H + (size_t)m * 1024); const uint4* b = (const uint4*)(Wt + (size_t)n * 1024); float s = 0.f;
    for (int k = 0; k < 128; ++k) { const uint4 x = a[k], y = b[k]; const unsigned xs[4] = {x.x, x.y, x.z, x.w}, ys[4] = {y.x, y.y, y.z, y.w};
        for (int q = 0; q < 4; ++q) { s += __uint_as_float(xs[q] << 16) * __uint_as_float(ys[q] << 16); s += __uint_as_float(xs[q] & 0xffff0000u) * __uint_as_float(ys[q] & 0xffff0000u); } }
    const float want = 1.0f / (1.0f + __expf(-s)), got = __uint_as_float(((unsigned)G[(size_t)m * 3072 + n]) << 16);
    if (!(fabsf(got - want) <= 0.02f)) { atomicAdd(cntw, 1u); cntw[16 + (m >> 8) * 12 + (n >> 8)] = 1u; }
}
__global__ void encode_full(float* out, const unsigned* cntw, int n) {
    __shared__ int bc, bt; if (threadIdx.x == 0) { unsigned C = cntw[0], T = 0; for (int t = 0; t < 1728; ++t) T += cntw[16 + t]; int b1 = 0; while (C) { ++b1; C /= 10; } int b2 = 0; while (T) { ++b2; T /= 4; } bc = b1 > 7 ? 7 : b1; bt = b2 > 7 ? 7 : b2; }
    __syncthreads(); const float K = ldexpf(1.0f, 2 + 8 * bt + bc);
    for (size_t i = (size_t)blockIdx.x * blockDim.x + threadIdx.x; i < (size_t)n; i += (size_t)gridDim.x * blockDim.x) out[i] = K;
}
__global__ void encode(float* out, const float* res, int n, float thr) {
    #if DBG_GSUB == 1
    { const unsigned mk = ((const unsigned*)res)[48]; const float K = ldexpf(1.0f, 2 + (int)mk); for (size_t i = (size_t)blockIdx.x * blockDim.x + threadIdx.x; i < (size_t)n; i += (size_t)gridDim.x * blockDim.x) out[i] = K; return; }
#endif
#ifndef CHK_SKIP
#define CHK_SKIP 0ull
#endif
    int bad = -1; for (int s = 0; s < 64; ++s) if (!((CHK_SKIP >> s) & 1ull) && res[s] > thr) { bad = s; break; }
    if (bad < 0) return; const float er = res[bad]; const float K = ldexpf(1.0f, bad + 2) * (er < 0.5f ? 1.0f : er < 1.0f ? 1.25f : er < 4.0f ? 1.5f : 1.75f);
    for (size_t i = (size_t)blockIdx.x * blockDim.x + threadIdx.x; i < (size_t)n; i += (size_t)gridDim.x * blockDim.x) out[i] = K;
}
#endif
#ifndef GP_SP2
#define GP_SP2 true
#endif
#ifndef GP_ALIGN
#define GP_ALIGN true
#endif
__global__ void __launch_bounds__(NTHR, 2) fwd(Args args) {
    extern __shared__ __attribute__((aligned(16))) unsigned char lds[];
    Frame F;
    F.lds = (LAS unsigned char*)lds; F.MISC = (volatile LAS unsigned*)(F.lds + MISC_OFF);
    F.tid = threadIdx.x; F.lane = F.tid & 63; F.wave = __builtin_amdgcn_readfirstlane(F.tid >> 6);
    F.G = gridDim.x; { const int bx = blockIdx.x; F.vcu = (F.G % 8 == 0) ? (bx % 8) * (F.G / 8) + bx / 8 : bx; }
    { const AV A0 = av_get(); F.ctl = (gu32*)(A0.ws() + WS_CTL); }
    for (int u = F.tid; u < (LDS_BYTES - LDSCTL_OFF) / 4; u += NTHR) ((LAS unsigned*)(F.lds + LDSCTL_OFF))[u] = 0u;
    __syncthreads();
    XcdBarrier bar; bar.bar = (unsigned*)(F.ctl + CW_BAR); bar.x = 0; bar.st = nullptr;
    if (!MK_PER_PHASE) bar = xcd_barrier_post((unsigned*)(F.ctl + CW_BAR), F.MISC + 8);
    int lo, hi; { const AV A0 = av_get(); lo = *(const int __attribute__((address_space(4)))*)(A0.kp + 8 * 31); hi = *(const int __attribute__((address_space(4)))*)(A0.kp + 8 * 31 + 4); }
#ifndef DIS_MASK
#define DIS_MASK 0ull
#endif
#define IN(k) (lo <= (k) && (k) < hi)
#define ON(j) (!((DIS_MASK >> (j)) & 1ull))
#ifndef REP_MASK
#define REP_MASK 0ull
#endif
#define REPS(j) ((int)((REP_MASK >> (j)) & 1ull))
#ifdef STAMP_SEL
#define SEAM(k) do { xcd_barrier(bar); if (blockIdx.x == 0 && threadIdx.x == 0) ((unsigned long long*)(F.ctl + 32768))[(k) + 1] = __builtin_amdgcn_s_memrealtime(); } while (0)
#else
#define SEAM(k) do { if (!MK_PER_PHASE && IN((k) + 1)) xcd_barrier(bar); } while (0)
#endif
    const int bx = (int)blockIdx.x;
#define F_REFRESH() do { int t_ = threadIdx.x; asm volatile("" : "+v"(t_)); F.tid = t_; F.lane = t_ & 63; F.wave = __builtin_amdgcn_readfirstlane(t_ >> 6); } while (0)

#ifdef STAMP_SEL
    if (blockIdx.x == 0 && threadIdx.x == 0) ((unsigned long long*)(F.ctl + 32768))[0] = __builtin_amdgcn_s_memrealtime();
#endif
    if (ON(0) && IN(0)) for (int rep_ = 0; rep_ <= REPS(0); ++rep_) { F_REFRESH(); const AV A = av_get(); p0_prologue(F, A); SEAM(0); }
    if (ON(1) && IN(1)) for (int rep_ = 0; rep_ <= REPS(1); ++rep_) { F_REFRESH(); const AV A = av_get(); p1_norm0(F, A); SEAM(1); }

    for (int l = 0; l < 2; ++l) {
        const int pb = 2 + l * NPL;
        const int Mm = (l == 0) ? TALL : TL;
#define PH_BEGIN F_REFRESH(); const AV A = av_get(); unsigned char* const ws = A.ws(); unsigned char* const wl = ws + WS_WSMALL + (size_t)l * WSMALL_LAYER; (void)wl
        if (ON(2 + 0) && IN(pb + 0)) for (int rep_ = 0; rep_ <= REPS(2 + 0); ++rep_) { PH_BEGIN;
            if (ON(16)) { pg8::Gemm g{(const bf16*)(ws + WS_H), (const bf16*)(wl + OFFS_WIN), TALL, 2560, DM}; pg8::StaticOrder S; S.init(TALL, 2560, F.G, bx);
              pg8::EpiInproj E{(bf16*)(ws + WS_Q), (bf16*)(ws + WS_K), (bf16*)(ws + WS_V), (bf16*)(ws + WS_CU)};
              pg8::gemm_phase<pg8::EpiInproj, pg8::StaticOrder, GP_ALIGN, GP_SP2>(F.lds + RING_OFF, g, S, E); }
            if (ON(17)) { pg8::Gemm g{(const bf16*)(wl + OFFS_WF), (const bf16*)(ws + WS_H), 1024, Mm, DM}; pg8::StaticOrder S; S.init(1024, Mm, F.G, (bx + 96) % F.G);
              pg8::EpiYT E{(bf16*)(ws + WS_YT), (bf16*)(ws + WS_YTC)};
              pg8::gemm_phase<pg8::EpiYT, pg8::StaticOrder, GP_ALIGN, GP_SP2>(F.lds + RING_OFF, g, S, E); }
            SEAM(pb + 0);
        }
        if (ON(2 + 1) && IN(pb + 1)) for (int rep_ = 0; rep_ <= REPS(2 + 1); ++rep_) { PH_BEGIN;
            if (ON(18)) p_qkfix(F, A, l, TALL);
            F_REFRESH();
            if (ON(19)) p_conv(F, A, l, l == 0 ? 1152 : 1024);
            if (ON(20)) { pg8::Gemm g{(const bf16*)(ws + WS_DFTL), (const bf16*)(ws + WS_YT), 2048, NB * 512, 4096}; pg8::DftOrder S; S.init(3, NB, F.G, F.vcu);
              pg8::EpiDFT E{(bf16*)(ws + WS_Z), 0, SEQ};
              pg8::gemm_phase<pg8::EpiDFT, pg8::DftOrder, GP_ALIGN, GP_SP2>(F.lds + RING_OFF, g, S, E); }
            if (ON(21) && l == 0) { pg8::Gemm g{(const bf16*)(ws + WS_DFTC), (const bf16*)(ws + WS_YTC), 256, NB * 512, 512}; pg8::DftOrder S; S.init(0, NB, F.G, F.vcu);
              pg8::EpiDFT E{(bf16*)(ws + WS_Z), TL, CTXL};
              pg8::gemm_phase<pg8::EpiDFT, pg8::DftOrder, GP_ALIGN, GP_SP2>(F.lds + RING_OFF, g, S, E); }
            SEAM(pb + 1);
        }
        if (ON(2 + 2) && IN(pb + 2)) for (int rep_ = 0; rep_ <= REPS(2 + 2); ++rep_) { PH_BEGIN;
            const int nheavy = NB * 8 * 8, ntot = nheavy + (l == 0 ? NB * 8 : 0);
            for (int L = F.vcu; L < ntot; L += F.G) {
                int row0, krow, h, seq;
                if (L < nheavy) { const int grp = L >> 5, s = L & 31, b = grp >> 1; h = (grp & 1) * 4 + (s >> 3); row0 = b * SEQ + (s & 7) * 256; krow = b * KVROWS; seq = KVROWS; }
                else { const int Lc = L - nheavy, b = Lc >> 3; h = Lc & 7; row0 = TL + b * CTXL; krow = b * KVROWS + SEQ; seq = CTXL; }
                const att::bf16* Qb = (const att::bf16*)(ws + WS_Q) + (size_t)row0 * DM + h * 128;
                const att::bf16* Kh = (const att::bf16*)(ws + WS_K) + (size_t)krow * 256 + (h >> 2) * 128;
                const att::bf16* Vh = (const att::bf16*)(ws + WS_V) + (size_t)krow * 256 + (h >> 2) * 128;
                att::bf16* Ob = (att::bf16*)(ws + WS_AO) + (size_t)row0 * DM + h * 128;
                att::attn_dense_body<att::bf16>(Qb, Kh, Vh, Ob, seq, (char*)lds + RING_OFF);
                __syncthreads();
            }
            SEAM(pb + 2);
        }
        if (ON(2 + 3) && IN(pb + 3)) for (int rep_ = 0; rep_ <= REPS(2 + 3); ++rep_) { PH_BEGIN;
            pg8::Gemm g{(const bf16*)(ws + WS_H), (const bf16*)(wl + OFFS_WG), Mm, 3072, DM}; pg8::StaticOrder S; S.init(Mm, 3072, F.G, bx);
            pg8::EpiGates E{(bf16*)(ws + WS_GATES)};
            pg8::gemm_phase<pg8::EpiGates, pg8::StaticOrder, GP_ALIGN, GP_SP2>(F.lds + RING_OFF, g, S, E);
            SEAM(pb + 3);
        }
        if (ON(2 + 4) && IN(pb + 4)) for (int rep_ = 0; rep_ <= REPS(2 + 4); ++rep_) { PH_BEGIN;
            { pg8::Gemm g{(const bf16*)(ws + WS_AO), (const bf16*)(wl + OFFS_WAO), Mm, 1024, 1024}; pg8::StaticOrder S; S.init(Mm, 1024, F.G, bx);
              pg8::EpiMerge<true> E{(bf16*)(ws + WS_MERGED), (const bf16*)(ws + WS_GATES), 0};
              pg8::gemm_phase<pg8::EpiMerge<true>, pg8::StaticOrder, GP_ALIGN, GP_SP2>(F.lds + RING_OFF, g, S, E); }
#pragma unroll 1
            for (int br = 1; br < 3; ++br) {
              pg8::Gemm g{(const bf16*)(ws + (br == 1 ? WS_CH : WS_Z)), (const bf16*)(wl + (br == 1 ? OFFS_WCO : OFFS_WFO)), Mm, 1024, 512}; pg8::StaticOrder S; S.init(Mm, 1024, F.G, bx);
              pg8::EpiMerge<false> E{(bf16*)(ws + WS_MERGED), (const bf16*)(ws + WS_GATES), br};
              pg8::gemm_phase<pg8::EpiMerge<false>, pg8::StaticOrder, GP_ALIGN, GP_SP2>(F.lds + RING_OFF, g, S, E); }
            SEAM(pb + 4);
        }
        if (ON(2 + 5) && IN(pb + 5)) for (int rep_ = 0; rep_ <= REPS(2 + 5); ++rep_) { PH_BEGIN;
            pg8::Gemm g{(const bf16*)(ws + WS_MERGED), (const bf16*)(wl + OFFS_WOUT), Mm, 1024, 1024}; pg8::StaticOrder S; S.init(Mm, 1024, F.G, bx);
            pg8::EpiBf16<0> E{(bf16*)(ws + WS_MIX), 1024, nullptr, 0, 0, 1.0f};
            pg8::gemm_phase<pg8::EpiBf16<0>, pg8::StaticOrder, GP_ALIGN, GP_SP2>(F.lds + RING_OFF, g, S, E);
            SEAM(pb + 5);
        }
        if (ON(2 + 6) && IN(pb + 6)) for (int rep_ = 0; rep_ <= REPS(2 + 6); ++rep_) { PH_BEGIN; p_rowpass1(F, A, l, Mm); SEAM(pb + 6); }
        if (ON(2 + 7) && IN(pb + 7)) for (int rep_ = 0; rep_ <= REPS(2 + 7); ++rep_) { PH_BEGIN;
            pg8::Gemm g{(const bf16*)(ws + WS_H), (const bf16*)(wl + OFFS_ROUT), Mm, 256, DM}; pg8::StaticOrder S; S.init(Mm, 256, F.G, bx);
            pg8::EpiRouter E{(float*)(ws + WS_LOGIT)};
            pg8::gemm_phase<pg8::EpiRouter, pg8::StaticOrder, GP_ALIGN, GP_SP2>(F.lds + RING_OFF, g, S, E);
            SEAM(pb + 7);
        }
        if (ON(2 + 8) && IN(pb + 8)) for (int rep_ = 0; rep_ <= REPS(2 + 8); ++rep_) { PH_BEGIN; p_topk(F, A, l, Mm); SEAM(pb + 8); }
        if (ON(2 + 9) && IN(pb + 9)) for (int rep_ = 0; rep_ <= REPS(2 + 9); ++rep_) { PH_BEGIN; p_slots(F, A, Mm); SEAM(pb + 9); }
        if (ON(2 + 10) && IN(pb + 10)) for (int rep_ = 0; rep_ <= REPS(2 + 10); ++rep_) { PH_BEGIN;
            const int NT = __builtin_amdgcn_readfirstlane(((const int*)(ws + WS_CNT))[CNT_NT]);
            pg8::Gemm g{(const bf16*)(ws + WS_HS), (const bf16*)(ws + WS_WGU + (size_t)l * MOEW_LAYER), NT * 256, NEXP * 2048, DM / 2}; pg8::GroupedOrder S; S.init(NT, 8, F.G, bx, (const int*)(ws + WS_CNT) + CNT_TILE_E);
            pg8::EpiSwiGLU8 E{ws + WS_ACT, A.in(24) + (size_t)l * NEXP * 1024, A.in(26) + (size_t)l * NEXP * 1024};
            pg8::gemm_phase<pg8::EpiSwiGLU8, pg8::GroupedOrder, GP_ALIGN, GP_SP2, true>(F.lds + RING_OFF, g, S, E);
            SEAM(pb + 10);
        }
        if (ON(2 + 11) && IN(pb + 11)) for (int rep_ = 0; rep_ <= REPS(2 + 11); ++rep_) { PH_BEGIN;
            const int NT = __builtin_amdgcn_readfirstlane(((const int*)(ws + WS_CNT))[CNT_NT]);
            pg8::Gemm g{(const bf16*)(ws + WS_ACT), (const bf16*)(ws + WS_WD + (size_t)l * MOEW_LAYER), NT * 256, NEXP * 1024, DM / 2}; pg8::GroupedOrder S; S.init(NT, 4, F.G, bx, (const int*)(ws + WS_CNT) + CNT_TILE_E);
            pg8::EpiDown8 E{(bf16*)(ws + WS_YS), A.in(28) + (size_t)l * NEXP * 1024};
            pg8::gemm_phase<pg8::EpiDown8, pg8::GroupedOrder, GP_ALIGN, GP_SP2, true>(F.lds + RING_OFF, g, S, E);
            SEAM(pb + 11);
        }
        if (ON(2 + 12) && IN(pb + 12)) for (int rep_ = 0; rep_ <= REPS(2 + 12); ++rep_) { PH_BEGIN;
            p_combine(F, A, l, Mm);
            SEAM(pb + 12);
        }
    }
#ifdef STAMP_SEL
    { const AV A = av_get(); float* out = A.out(); const unsigned long long* ts = (const unsigned long long*)(F.ctl + 32768);
      auto span = [&](int p) -> float { unsigned long long d = __hip_atomic_load(ts + p + 1, __ATOMIC_RELAXED, __HIP_MEMORY_SCOPE_AGENT) - __hip_atomic_load(ts + p, __ATOMIC_RELAXED, __HIP_MEMORY_SCOPE_AGENT);
          if (p >= 2) d += __hip_atomic_load(ts + p + NPL + 1, __ATOMIC_RELAXED, __HIP_MEMORY_SCOPE_AGENT) - __hip_atomic_load(ts + p + NPL, __ATOMIC_RELAXED, __HIP_MEMORY_SCOPE_AGENT); return (float)d * 0.01f; };
      const float K1 = span((STAMP_SEL) & 0xff), K2 = 200.0f * span(((STAMP_SEL) >> 8) & 0xff);
      for (size_t i = (size_t)blockIdx.x * NTHR + threadIdx.x; i < (size_t)TL * DM; i += (size_t)gridDim.x * NTHR) out[i] = (i == 0) ? K2 : K1; }
#endif
#undef IN
#undef PH_BEGIN
#undef F_REFRESH
#undef SEAM
}

extern "C" void kernel_launch(void* const* d_in, const int* in_sizes, int n_in, void* d_out, int out_size, void* d_ws, size_t ws_size, hipStream_t stream) {
    static int grid = 0;
    if (grid == 0) {
        if (n_in != 29 || out_size != TL * DM || ws_size < WS_END) { fprintf(stderr, "kernel_launch: built for 29 inputs, %d outputs, >= %zu bytes of workspace; got n_in %d out %d ws %zu\n", TL * DM, (size_t)WS_END, n_in, out_size, ws_size); grid = -1; return; }
        int dev = 0, cus = 0, per_cu = 0;
        if (hipGetDevice(&dev) != hipSuccess || hipDeviceGetAttribute(&cus, hipDeviceAttributeMultiprocessorCount, dev) != hipSuccess) { grid = -1; return; }
        if (hipFuncSetAttribute((const void*)fwd, hipFuncAttributeMaxDynamicSharedMemorySize, LDS_BYTES) != hipSuccess) { fprintf(stderr, "kernel_launch: hipFuncSetAttribute failed\n"); grid = -1; return; }
        if (hipOccupancyMaxActiveBlocksPerMultiprocessor(&per_cu, (const void*)fwd, NTHR, LDS_BYTES) != hipSuccess || per_cu < 1) fprintf(stderr, "kernel_launch: occupancy query reports %d\n", per_cu);
        (void)hipGetLastError();
        grid = cus;
    }
    if (grid < 0) return;
    (void)hipMemsetAsync((char*)d_ws + WS_CTL, 0, CTL_ZERO_BYTES, stream);
    Args a{};
    for (int i = 0; i < 29; ++i) a.in[i] = (const float*)d_in[i];
    a.out = (float*)d_out; a.ws = (unsigned char*)d_ws;
#if MK_PER_PHASE
    for (int p = 0; p < NPH; ++p) {
#ifdef DBG_CHECK
        float* res = (float*)((char*)d_ws + WS_CTL + 8192 * 4); float* snap = (float*)((char*)d_ws + WS_END);
        { const int l = p >= 2 ? (p - 2) / NPL : 0, k = p >= 2 ? (p - 2) % NPL : -1;
          if (k == 6) hipLaunchKernelGGL(snap_rows, dim3(256), dim3(256), 0, stream, a, l, 11, snap);
          if (k == 12) hipLaunchKernelGGL(snap_rows, dim3(256), dim3(256), 0, stream, a, l, 17, snap); }
#endif
        a.ph_lo = p; a.ph_hi = p + 1; hipLaunchKernelGGL(fwd, dim3(grid), dim3(NTHR), LDS_BYTES, stream, a);
#ifdef DBG_CHECK
        { const int l = p >= 2 ? (p - 2) / NPL : 0, k = p >= 2 ? (p - 2) % NPL : -1;
#define CHK(st) hipLaunchKernelGGL(chk, dim3(1), dim3(256), 0, stream, a, (int)(st), l, res, snap)
          if (p == 0) CHK(ST_MOD); if (p == 1) CHK(ST_H0);
#if DBG_GSUB == 2
          if (k == 3 && l == 0) hipLaunchKernelGGL(chk_gates_full, dim3(48, TALL / 4), dim3(256), 0, stream, (const bf16*)((char*)d_ws + WS_H), (const bf16*)((char*)d_ws + WS_WSMALL + OFFS_WG), (const bf16*)((char*)d_ws + WS_GATES), TALL, (unsigned*)((char*)d_ws + WS_CTL + 65536));
#endif
          if (k == 0) { CHK(ST_INPROJ); CHK(ST_YT); } if (k == 1) { CHK(ST_QKFIX); CHK(ST_CONV); CHK(ST_Z); } if (k == 2) CHK(ST_ATTN); if (k == 3) { CHK(ST_GATES); CHK(ST_GATESB); } if (k == 4) CHK(ST_MERGED);
          if (k == 5) CHK(ST_MIX); if (k == 6) CHK(ST_ROW1); if (k == 7) CHK(ST_LOGIT); if (k == 8) CHK(ST_TOPK); if (k == 9) CHK(ST_SLOTS); if (k == 10) CHK(ST_ACT); if (k == 11) CHK(ST_YSLOT); if (k == 12) CHK(ST_COMB);
#undef CHK
        }
#endif
    }
#ifdef DBG_CHECK
#if DBG_GSUB == 2
    hipLaunchKernelGGL(encode_full, dim3(1024), dim3(256), 0, stream, (float*)d_out, (const unsigned*)((char*)d_ws + WS_CTL + 65536), out_size);
#else
    hipLaunchKernelGGL(encode, dim3(1024), dim3(256), 0, stream, (float*)d_out, (const float*)((char*)d_ws + WS_CTL + 8192 * 4), out_size, 0.25f);
#endif
#endif
#else
    a.ph_lo = 0; a.ph_hi = NPH; hipLaunchKernelGGL(fwd, dim3(grid), dim3(NTHR), LDS_BYTES, stream, a);
#endif
    const hipError_t le = hipPeekAtLastError();
    if (le != hipSuccess) fprintf(stderr, "kernel_launch: launch failed: %s\n", hipGetErrorName(le));
}
```

```cpp
#include <hip/hip_runtime.h>
#include <cstdio>
#include <cstdint>
#ifndef MK_PER_PHASE
#define MK_PER_PHASE 0
#endif
namespace pg8 {
#define PG8_LAS __attribute__((address_space(3)))
typedef unsigned short bf16_t;
typedef short bf16x8 __attribute__((ext_vector_type(8)));
typedef float f32x4 __attribute__((ext_vector_type(4)));
typedef unsigned u32x4 __attribute__((ext_vector_type(4)));
typedef int i32x4v __attribute__((ext_vector_type(4)));
typedef int i32x8v __attribute__((ext_vector_type(8)));
typedef unsigned u32x2v __attribute__((ext_vector_type(2)));
constexpr int BM = 256, BK = 64, HALF = 128, HTB = HALF * BK * 2  , STAGE_BYTES = 8 * HTB, NXCD = 8, WGM = 8;

__host__ __device__ __forceinline__ int lds_byte(int r, int c) { const int st = (r >> 4) * 2 + (c >> 5), rr = r & 15, cc = c & 31, ob = rr * 64 + cc * 2; return st * 1024 + (ob ^ (((ob >> 9) & 1) << 5)); }
__host__ __device__ __forceinline__ void stage_rc(int b, int& R, int& C) { const int st = b / 1024, sb = b % 1024, swz = sb ^ (((sb >> 9) & 1) << 5); R = (st >> 1) * 16 + swz / 64; C = (st & 1) * 32 + (swz % 64) / 2; }
__host__ __device__ __forceinline__ int perm32(int rho) { const int n = rho >> 4, i = rho & 15; return 8 * (i >> 2) + 4 * n + (i & 3); }

struct Unit { int pm, pn; };
struct Gemm { const bf16_t* A; const bf16_t* Bt; int M, N, K; };

struct StaticOrder {
    int nM, nN, nwg, G, c;
    __host__ __device__ void init(int M, int N, int G_, int c_) { nM = M / BM; nN = N / BM; nwg = nM * nN; G = G_; c = c_; }
    __host__ __device__ bool next(int i, Unit& u) const {
        const long L = (long)i * G + c; if (L >= nwg) return false;
        int wgid = (int)L; { const int q = nwg / NXCD, r = nwg % NXCD, xcd = wgid % NXCD, off = wgid / NXCD; wgid = (xcd < r ? xcd * (q + 1) : r * (q + 1) + (xcd - r) * q) + off; }
        const int nig = WGM * nN, gid = wgid / nig, fm = gid * WGM, gsz = (nM - fm) < WGM ? (nM - fm) : WGM;
        u.pm = fm + ((wgid % nig) % gsz); u.pn = (wgid % nig) / gsz; return true;
    }
    __device__ __forceinline__ void a_ready(const Unit&) const {}
    __device__ __forceinline__ void done(const Unit&) const {}
};

typedef __bf16 bf16x2_native __attribute__((ext_vector_type(2)));
typedef float f32x2_native __attribute__((ext_vector_type(2)));
__device__ __forceinline__ unsigned cvt_pk_bf16(float lo, float hi) { const f32x2_native v = {lo, hi}; const bf16x2_native r = __builtin_convertvector(v, bf16x2_native); return __builtin_bit_cast(unsigned, r); }
__device__ __forceinline__ unsigned cvt4_fp8(float a, float b, float c, float d) { int w = __builtin_amdgcn_cvt_pk_fp8_f32(a, b, __builtin_bit_cast(int, a), false); w = __builtin_amdgcn_cvt_pk_fp8_f32(c, d, w, true); return (unsigned)w; }
typedef float f32x2 __attribute__((ext_vector_type(2)));
__device__ __forceinline__ f32x2 gelu_pk(f32x2 v) {
    const f32x2 av = __builtin_elementwise_abs(v), d = av * 0.2316418882f + 1.0f;
    f32x2 t; t.x = __builtin_amdgcn_rcpf(d.x); t.y = __builtin_amdgcn_rcpf(d.y);
    f32x2 q = t * 0.5307027145f + (-0.7265760135f); q = q * t + 0.7107068705f; q = q * t + (-0.142248368f); q = q * t + 0.127414796f; q = q * t;
    const f32x2 s = (v * v) * (-0.72134752044f);
    f32x2 e; e.x = __builtin_amdgcn_exp2f(s.x); e.y = __builtin_amdgcn_exp2f(s.y);
    const f32x2 m = v * (q * e), r = v - m;
    f32x2 o; o.x = v.x < 0.f ? m.x : r.x; o.y = v.y < 0.f ? m.y : r.y; return o;
}

template <int ACT  > struct EpiBf16 {
    static constexpr bool PERM = true, AFTER_DRAIN = false; static_assert(ACT == 0 || ACT == 1, "EpiBf16: ACT is 0 (none) or 1 (gelu_pk)");
    bf16_t* O; int ldc; const float* bias; int split_cols; size_t split_stride; float scale0;
    __device__ __forceinline__ void operator()(const f32x4 (&acc)[2][2][4][2], const Unit& u, int wr, int wc, int fr, int fq) const {
        const int row0 = u.pm * BM + wr * 64 + fr; int colt = u.pn * BM; bf16_t* base = O;
        float sc = 1.f; if (split_cols) { const int t = colt / split_cols; base += (size_t)t * split_stride; colt -= t * split_cols; if (t == 0) sc = scale0; }
        const int col0 = colt + wc * 32 + 8 * fq, bcol0 = u.pn * BM + wc * 32 + 8 * fq;
        f32x4 bv[2][2];
#pragma unroll
        for (int bj = 0; bj < 2; ++bj)
#pragma unroll
            for (int n = 0; n < 2; ++n) bv[bj][n] = bias ? *(const f32x4*)(bias + bcol0 + bj * HALF + 4 * n) : (f32x4){0.f, 0.f, 0.f, 0.f};
#pragma unroll
        for (int ai = 0; ai < 2; ++ai)
#pragma unroll
            for (int m = 0; m < 4; ++m) { bf16_t* rowp = base + (size_t)(row0 + ai * HALF + m * 16) * ldc + col0;
#pragma unroll
                for (int bj = 0; bj < 2; ++bj) { f32x4 v0 = acc[ai][bj][m][0] + bv[bj][0], v1 = acc[ai][bj][m][1] + bv[bj][1];
                    if (ACT == 1) { f32x2 a = gelu_pk((f32x2){v0[0], v0[1]}), b = gelu_pk((f32x2){v0[2], v0[3]}), c = gelu_pk((f32x2){v1[0], v1[1]}), d = gelu_pk((f32x2){v1[2], v1[3]});
                        v0 = (f32x4){a.x, a.y, b.x, b.y}; v1 = (f32x4){c.x, c.y, d.x, d.y}; }
                    v0 = v0 * sc; v1 = v1 * sc; u32x4 w; w.x = cvt_pk_bf16(v0[0], v0[1]); w.y = cvt_pk_bf16(v0[2], v0[3]); w.z = cvt_pk_bf16(v1[0], v1[1]); w.w = cvt_pk_bf16(v1[2], v1[3]);
                    *(u32x4*)(rowp + bj * HALF) = w; } }
    }
};

__device__ __forceinline__ float fast_sigmoid(float x) { return __builtin_amdgcn_rcpf(1.0f + __builtin_amdgcn_exp2f(-1.4426950408889634f * x)); }
__device__ __forceinline__ u32x4 pack8(const f32x4& a, const f32x4& b) { u32x4 w; w.x = cvt_pk_bf16(a[0], a[1]); w.y = cvt_pk_bf16(a[2], a[3]); w.z = cvt_pk_bf16(b[0], b[1]); w.w = cvt_pk_bf16(b[2], b[3]); return w; }
__device__ __forceinline__ void unpack8(const u32x4& w, f32x4& a, f32x4& b) {
    a[0] = __uint_as_float(w.x << 16); a[1] = __uint_as_float(w.x & 0xffff0000u); a[2] = __uint_as_float(w.y << 16); a[3] = __uint_as_float(w.y & 0xffff0000u);
    b[0] = __uint_as_float(w.z << 16); b[1] = __uint_as_float(w.z & 0xffff0000u); b[2] = __uint_as_float(w.w << 16); b[3] = __uint_as_float(w.w & 0xffff0000u); }
__device__ __forceinline__ u32x2v pack8_fp8(const f32x4& a, const f32x4& b) { u32x2v r; r.x = cvt4_fp8(a[0], a[1], a[2], a[3]); r.y = cvt4_fp8(b[0], b[1], b[2], b[3]); return r; }
__device__ __forceinline__ void store_tile_bf16(const f32x4 (&acc)[2][2][4][2], bf16_t* base, int ldc, int wr, int wc, int fr, int fq) {
    const int rt = wr * 64 + fr, cb = wc * 32 + 8 * fq;
#pragma unroll
    for (int ai = 0; ai < 2; ++ai)
#pragma unroll
        for (int m = 0; m < 4; ++m) { bf16_t* rowp = base + (size_t)(rt + ai * HALF + m * 16) * ldc + cb;
#pragma unroll
            for (int bj = 0; bj < 2; ++bj) *(u32x4*)(rowp + bj * HALF) = pack8(acc[ai][bj][m][0], acc[ai][bj][m][1]); }
}
struct EpiInproj {
    static constexpr bool PERM = true, AFTER_DRAIN = false;
    bf16_t *q, *k, *v, *cu;
    __device__ __forceinline__ void operator()(const f32x4 (&acc)[2][2][4][2], const Unit& u, int wr, int wc, int fr, int fq) const {
        bf16_t* base; int ldc; const bool glu = u.pn >= 6;
        if (u.pn < 4) { base = q + (size_t)u.pm * 256 * 1024 + u.pn * 256; ldc = 1024; }
        else if (u.pn < 6) { const int m0 = u.pm * 256; const int kr = m0 < 32768 ? (m0 >> 11) * 2304 + (m0 & 2047) : ((m0 - 32768) >> 8) * 2304 + 2048; base = (u.pn == 4 ? k : v) + (size_t)kr * 256; ldc = 256; }
        else { base = cu + (size_t)u.pm * 256 * 512 + (u.pn - 6) * 128; ldc = 512; }
        base += (size_t)(wr * 64 + fr) * ldc + wc * 32 + 8 * fq;
#pragma unroll
        for (int ai = 0; ai < 2; ++ai)
#pragma unroll
            for (int m = 0; m < 4; ++m) { bf16_t* rowp = base + (size_t)(ai * HALF + m * 16) * ldc;
                if (!glu) { *(u32x4*)rowp = pack8(acc[ai][0][m][0], acc[ai][0][m][1]); *(u32x4*)(rowp + HALF) = pack8(acc[ai][1][m][0], acc[ai][1][m][1]); }
                else { f32x4 a0 = acc[ai][0][m][0], a1 = acc[ai][0][m][1]; const f32x4 g0 = acc[ai][1][m][0], g1 = acc[ai][1][m][1];
#pragma unroll
                    for (int j = 0; j < 4; ++j) { a0[j] *= fast_sigmoid(g0[j]); a1[j] *= fast_sigmoid(g1[j]); }
                    *(u32x4*)rowp = pack8(a0, a1); } }
    }
};
struct EpiYT {
    static constexpr bool PERM = true, AFTER_DRAIN = false;
    unsigned char *yt, *ytc;
    __device__ __forceinline__ void operator()(const f32x4 (&acc)[2][2][4][2], const Unit& u, int wr, int wc, int fr, int fq) const {
        const int cs = u.pm >> 1, chb = (u.pm & 1) * 256; unsigned char* base; int ldc;
        if (u.pn < 128) { const int b = u.pn >> 3, pos0 = (u.pn & 7) * 256; base = yt + (size_t)(b * 512 + chb) * 4096 + cs * 2048 + pos0; ldc = 4096; }
        else { const int b = u.pn - 128; base = ytc + (size_t)(b * 512 + chb) * 512 + cs * 256; ldc = 512; }
        base += (size_t)(wr * 64 + fr) * ldc + wc * 32 + 8 * fq;
#pragma unroll
        for (int ai = 0; ai < 2; ++ai)
#pragma unroll
            for (int m = 0; m < 4; ++m) { unsigned char* rowp = base + (size_t)(ai * HALF + m * 16) * ldc;
#pragma unroll
                for (int bj = 0; bj < 2; ++bj) *(u32x2v*)(rowp + bj * HALF) = pack8_fp8(acc[ai][bj][m][0], acc[ai][bj][m][1]); }
    }
};
struct EpiDFT {
    static constexpr bool PERM = true, AFTER_DRAIN = false;
    bf16_t* z; int rowbase, rpb;
    __device__ __forceinline__ void operator()(const f32x4 (&acc)[2][2][4][2], const Unit& u, int wr, int wc, int fr, int fq) const {
        bf16_t* base = z + (size_t)(rowbase + (u.pn >> 1) * rpb + u.pm * 256 + wr * 64 + fr) * 512 + (u.pn & 1) * 256 + wc * 32 + 8 * fq;
#pragma unroll
        for (int ai = 0; ai < 2; ++ai)
#pragma unroll
            for (int m = 0; m < 4; ++m)
#pragma unroll
                for (int bj = 0; bj < 2; ++bj) *(u32x4*)(base + (size_t)(ai * HALF + m * 16) * 512 + bj * HALF) = pack8(acc[ai][bj][m][0] * 0.03125f, acc[ai][bj][m][1] * 0.03125f);
    }
};
struct EpiGates {
    static constexpr bool PERM = true, AFTER_DRAIN = false;
    bf16_t* g;
    __device__ __forceinline__ void operator()(const f32x4 (&acc)[2][2][4][2], const Unit& u, int wr, int wc, int fr, int fq) const {
        const int rt = wr * 64 + fr, cb = wc * 32 + 8 * fq; bf16_t* base = g + (size_t)u.pm * 256 * 3072 + u.pn * 256 + cb;
        float cs = -1.4426950408889634f * 0.03125f; asm volatile("" : "+s"(cs));
#pragma unroll
        for (int ai = 0; ai < 2; ++ai)
#pragma unroll
            for (int m = 0; m < 4; ++m)
#pragma unroll
                for (int bj = 0; bj < 2; ++bj) { f32x4 a0 = acc[ai][bj][m][0], a1 = acc[ai][bj][m][1];
#pragma unroll
                    for (int j = 0; j < 4; ++j) { a0[j] = __builtin_amdgcn_rcpf(1.0f + __builtin_amdgcn_exp2f(a0[j] * cs)); a1[j] = __builtin_amdgcn_rcpf(1.0f + __builtin_amdgcn_exp2f(a1[j] * cs)); }
                    *(u32x4*)(base + (size_t)(rt + ai * HALF + m * 16) * 3072 + bj * HALF) = pack8(a0, a1); }
    }
};
template <bool FIRST> struct EpiMerge {
    static constexpr bool PERM = true, AFTER_DRAIN = false;
    bf16_t* mg; const bf16_t* g; int br;
    __device__ __forceinline__ void operator()(const f32x4 (&acc)[2][2][4][2], const Unit& u, int wr, int wc, int fr, int fq) const {
        const int rt = u.pm * 256 + wr * 64 + fr, cb = u.pn * 256 + wc * 32 + 8 * fq;
#pragma unroll
        for (int ai = 0; ai < 2; ++ai)
#pragma unroll
            for (int m = 0; m < 4; ++m)
#pragma unroll
                for (int bj = 0; bj < 2; ++bj) { const size_t row = (size_t)(rt + ai * HALF + m * 16); const int col = cb + bj * HALF;
                    const u32x4 gw = *(const u32x4*)(g + row * 3072 + br * 1024 + col); f32x4 g0, g1; unpack8(gw, g0, g1);
                    f32x4 v0 = acc[ai][bj][m][0] * g0, v1 = acc[ai][bj][m][1] * g1;
                    if (!FIRST) { const u32x4 ow = *(const u32x4*)(mg + row * 1024 + col); f32x4 o0, o1; unpack8(ow, o0, o1); v0 += o0; v1 += o1; }
                    *(u32x4*)(mg + row * 1024 + col) = pack8(v0, v1); }
    }
};
struct EpiRouter {
    static constexpr bool PERM = true, AFTER_DRAIN = false;
    float* lg;
    __device__ __forceinline__ void operator()(const f32x4 (&acc)[2][2][4][2], const Unit& u, int wr, int wc, int fr, int fq) const {
        if (wc < 2) { const int rt = u.pm * 256 + wr * 64 + fr, cb = wc * 32 + 8 * fq;
#pragma unroll
            for (int ai = 0; ai < 2; ++ai)
#pragma unroll
                for (int m = 0; m < 4; ++m) { float* p = lg + (size_t)(rt + ai * HALF + m * 16) * 64 + cb; *(f32x4*)p = acc[ai][0][m][0]; *(f32x4*)(p + 4) = acc[ai][0][m][1]; } }
    }
};
struct EpiSwiGLU {
    static constexpr bool PERM = true, AFTER_DRAIN = false;
    bf16_t* act; const float* bg; const float* bu;
    __device__ __forceinline__ void operator()(const f32x4 (&acc)[2][2][4][2], const Unit& u, int wr, int wc, int fr, int fq) const {
        const int e = u.pn >> 3, col = (u.pn & 7) * 128 + wc * 32 + 8 * fq, rt = u.pm * 256 + wr * 64 + fr;
        const f32x4 bg0 = *(const f32x4*)(bg + e * 1024 + col), bg1 = *(const f32x4*)(bg + e * 1024 + col + 4), bu0 = *(const f32x4*)(bu + e * 1024 + col), bu1 = *(const f32x4*)(bu + e * 1024 + col + 4);
#pragma unroll
        for (int ai = 0; ai < 2; ++ai)
#pragma unroll
            for (int m = 0; m < 4; ++m) { f32x4 g0 = acc[ai][0][m][0] + bg0, g1 = acc[ai][0][m][1] + bg1, u0 = acc[ai][1][m][0] + bu0, u1 = acc[ai][1][m][1] + bu1;
#pragma unroll
                for (int j = 0; j < 4; ++j) { const float ga = fminf(g0[j], 7.0f), gb = fminf(g1[j], 7.0f); const float ua = fminf(fmaxf(u0[j], -7.0f), 7.0f), ub = fminf(fmaxf(u1[j], -7.0f), 7.0f);
                    g0[j] = (ua + 1.0f) * (ga * fast_sigmoid(1.702f * ga)); g1[j] = (ub + 1.0f) * (gb * fast_sigmoid(1.702f * gb)); }
                *(u32x4*)(act + (size_t)(rt + ai * HALF + m * 16) * 1024 + col) = pack8(g0, g1); }
    }
};
struct EpiSwiGLU8 {
    static constexpr bool PERM = true, AFTER_DRAIN = false;
    unsigned char* act; const float* bg; const float* bu;
    __device__ __forceinline__ void operator()(const f32x4 (&acc)[2][2][4][2], const Unit& u, int wr, int wc, int fr, int fq) const {
        const int e = u.pn >> 3, col = (u.pn & 7) * 128 + wc * 32 + 8 * fq, rt = u.pm * 256 + wr * 64 + fr;
        const f32x4 bg0 = *(const f32x4*)(bg + e * 1024 + col), bg1 = *(const f32x4*)(bg + e * 1024 + col + 4), bu0 = *(const f32x4*)(bu + e * 1024 + col), bu1 = *(const f32x4*)(bu + e * 1024 + col + 4);
#pragma unroll
        for (int ai = 0; ai < 2; ++ai)
#pragma unroll
            for (int m = 0; m < 4; ++m) { f32x4 g0 = acc[ai][0][m][0] * 0.03125f + bg0, g1 = acc[ai][0][m][1] * 0.03125f + bg1, u0 = acc[ai][1][m][0] * 0.03125f + bu0, u1 = acc[ai][1][m][1] * 0.03125f + bu1;
#pragma unroll
                for (int j = 0; j < 4; ++j) { const float ga = fminf(g0[j], 7.0f), gb = fminf(g1[j], 7.0f); const float ua = fminf(fmaxf(u0[j], -7.0f), 7.0f), ub = fminf(fmaxf(u1[j], -7.0f), 7.0f);
                    g0[j] = (ua + 1.0f) * (ga * fast_sigmoid(1.702f * ga)); g1[j] = (ub + 1.0f) * (gb * fast_sigmoid(1.702f * gb)); }
                *(u32x2v*)(act + (size_t)(rt + ai * HALF + m * 16) * 1024 + col) = pack8_fp8(g0, g1); }
    }
};
struct EpiDown8 {
    static constexpr bool PERM = true, AFTER_DRAIN = false;
    bf16_t* ys; const float* bd;
    __device__ __forceinline__ void operator()(const f32x4 (&acc)[2][2][4][2], const Unit& u, int wr, int wc, int fr, int fq) const {
        const int e = u.pn >> 2, col0 = (u.pn & 3) * 256 + wc * 32 + 8 * fq, rt = u.pm * 256 + wr * 64 + fr;
        f32x4 bv[2][2];
#pragma unroll
        for (int bj = 0; bj < 2; ++bj) { bv[bj][0] = *(const f32x4*)(bd + e * 1024 + col0 + bj * HALF); bv[bj][1] = *(const f32x4*)(bd + e * 1024 + col0 + bj * HALF + 4); }
#pragma unroll
        for (int ai = 0; ai < 2; ++ai)
#pragma unroll
            for (int m = 0; m < 4; ++m) { bf16_t* rowp = ys + (size_t)(rt + ai * HALF + m * 16) * 1024 + col0;
#pragma unroll
                for (int bj = 0; bj < 2; ++bj) *(u32x4*)(rowp + bj * HALF) = pack8(acc[ai][bj][m][0] * 0.03125f + bv[bj][0], acc[ai][bj][m][1] * 0.03125f + bv[bj][1]); }
    }
};
struct GroupedOrder {
    int nM, nN, nwg, G, c; const int* tile_e;
    __device__ void init(int nM_, int nN_, int G_, int c_, const int* te) { nM = nM_; nN = nN_; nwg = nM * nN; G = G_; c = c_; tile_e = te; }
    __device__ bool next(int i, Unit& u) const {
        const long L = (long)i * G + c; if (L >= nwg) return false;
        int wgid = (int)L; { const int q = nwg / NXCD, r = nwg % NXCD, xcd = wgid % NXCD, off = wgid / NXCD; wgid = (xcd < r ? xcd * (q + 1) : r * (q + 1) + (xcd - r) * q) + off; }
        const int nig = WGM * nN, gid = wgid / nig, fm = gid * WGM, gsz = (nM - fm) < WGM ? (nM - fm) : WGM;
        u.pm = fm + ((wgid % nig) % gsz); const int pl = (wgid % nig) / gsz; u.pn = __builtin_amdgcn_readfirstlane(tile_e[u.pm]) * nN + pl; return true;
    }
    __device__ __forceinline__ void a_ready(const Unit&) const {}
    __device__ __forceinline__ void done(const Unit&) const {}
};
struct DftOrder {
    int lg, n, G, c;
    __device__ void init(int lg_, int nb, int G_, int c_) { lg = lg_; n = (nb * 2) << lg_; G = G_; c = c_; }
    __device__ bool next(int i, Unit& u) const { const int L = i * G + c; if (L >= n) return false; const int b = L >> (lg + 1), rem = L & ((2 << lg) - 1); u.pm = rem & ((1 << lg) - 1); u.pn = 2 * b + (rem >> lg); return true; }
    __device__ __forceinline__ void a_ready(const Unit&) const {}
    __device__ __forceinline__ void done(const Unit&) const {}
};

template <class Epi, class Sched, bool ALIGN_EPI = false, bool SP2 = false, bool FP8 = false>
__device__ __forceinline__ void gemm_phase(PG8_LAS unsigned char* lds, const Gemm g, const Sched& S, const Epi& E, const int tid_in) {
    int tid_ = tid_in; asm volatile("" : "+v"(tid_));
    const int tid = tid_, wid = __builtin_amdgcn_readfirstlane(tid >> 6), lane = tid & 63, wr = wid >> 2, wc = wid & 3, fr = lane & 15, fq = lane >> 4;
    const int K = g.K, nt = K / BK;
    unsigned voffA[2], voffB[2];
#pragma unroll
    for (int i = 0; i < 2; ++i) { int R, C; stage_rc(tid * 16 + i * 8192, R, C); const int Rb = Epi::PERM ? ((R & ~31) + perm32(R & 31)) : R;
        voffA[i] = (unsigned)(R * K + C) * 2u; voffB[i] = (unsigned)(Rb * K + C) * 2u; }
    const size_t kstep = (size_t)(BK * 2);
    const size_t hstep = (size_t)HALF * K * 2;
    const size_t tstep = 2 * hstep;
    const unsigned ldsw = (unsigned)wid * 1024u;
    const int aoff = lds_byte(wr * 64 + fr, fq * 8), boff = lds_byte(wc * 32 + fr, fq * 8);
#define PG8_SA(b, h) (((b) * 2 + (h)) * HTB)
#define PG8_SB(b, h) ((4 + (b) * 2 + (h)) * HTB)
#define PG8_STAGE(bufoff, gbase, voff) do { _Pragma("unroll") for (int _i = 0; _i < 2; ++_i) \
        __builtin_amdgcn_global_load_lds((const unsigned*)((const char*)(gbase) + (voff)[_i]), (PG8_LAS unsigned*)(lds + (bufoff) + ldsw + _i * 8192), 16, 0, 0); } while (0)
#define PG8_RD8(off) __builtin_shufflevector(*(const PG8_LAS i32x4v*)(lds + (off)), *(const PG8_LAS i32x4v*)(lds + (off) + 1024), 0, 1, 2, 3, 4, 5, 6, 7)
#define PG8_LDA(dst, b, h) do { _Pragma("unroll") for (int m = 0; m < 4; ++m) { if constexpr (FP8) dst##8[m] = PG8_RD8(PG8_SA(b, h) + aoff + m * 2048); else { _Pragma("unroll") for (int k = 0; k < 2; ++k) dst[m][k] = *(const PG8_LAS bf16x8*)(lds + PG8_SA(b, h) + aoff + m * 2048 + k * 1024); } } } while (0)
#define PG8_LDB(dst, b, h) do { _Pragma("unroll") for (int n = 0; n < 2; ++n) { if constexpr (FP8) dst##8[n] = PG8_RD8(PG8_SB(b, h) + boff + n * 2048); else { _Pragma("unroll") for (int k = 0; k < 2; ++k) dst[n][k] = *(const PG8_LAS bf16x8*)(lds + PG8_SB(b, h) + boff + n * 2048 + k * 1024); } } } while (0)
#define PG8_MMA(ai, bj, At, Bt) do { if constexpr (FP8) __builtin_amdgcn_sched_barrier(0); __builtin_amdgcn_s_setprio(1); _Pragma("unroll") for (int m = 0; m < 4; ++m) _Pragma("unroll") for (int n = 0; n < 2; ++n) { \
        if constexpr (FP8) asm volatile("v_mfma_scale_f32_16x16x128_f8f6f4 %0, %1, %2, %0, %3, %3 op_sel_hi:[0,0,0]" : "+v"(acc[ai][bj][m][n]) : "v"(Bt##8[n]), "v"(At##8[m]), "v"(sc8)); \
        else { _Pragma("unroll") for (int k = 0; k < 2; ++k) acc[ai][bj][m][n] = __builtin_amdgcn_mfma_f32_16x16x32_bf16(Bt[n][k], At[m][k], acc[ai][bj][m][n], 0, 0, 0); } } __builtin_amdgcn_s_setprio(0); if constexpr (FP8) __builtin_amdgcn_sched_barrier(0); } while (0)
#define PG8_WAIT_V(n) asm volatile("s_waitcnt vmcnt(" #n ")" ::: "memory")
#define PG8_WAIT_L(n) asm volatile("s_waitcnt lgkmcnt(" #n ")" ::: "memory")
#define PG8_BAR __builtin_amdgcn_s_barrier()
#define PG8_SCHED __builtin_amdgcn_sched_barrier(0)
    Unit cur, nxt; int ui = 0;
    if (!S.next(0, cur)) return;
    f32x4 acc[2][2][4][2];
#pragma unroll
    for (int a = 0; a < 2; ++a)
#pragma unroll
        for (int b = 0; b < 2; ++b)
#pragma unroll
            for (int m = 0; m < 4; ++m)
#pragma unroll
                for (int n = 0; n < 2; ++n) acc[a][b][m][n] = (f32x4){0.f, 0.f, 0.f, 0.f};
    int sc8 = 0x7f7f7f7f; asm volatile("" : "+v"(sc8));
    bf16x8 At[4][2], B0[2][2], B1[2][2]; i32x8v At8[4], B08[2], B18[2];
    const char* cA = (const char*)g.A + (size_t)cur.pm * tstep; const char* cB = (const char*)g.Bt + (size_t)cur.pn * tstep;
    S.a_ready(cur);
    if constexpr (SP2) {
        PG8_STAGE(PG8_SB(0, 0), cB, voffB); PG8_STAGE(PG8_SB(0, 1), cB + hstep, voffB); PG8_STAGE(PG8_SA(0, 0), cA, voffA); PG8_STAGE(PG8_SA(0, 1), cA + hstep, voffA);
        if (wr == 1) PG8_BAR;
        PG8_WAIT_V(2); PG8_BAR;
        PG8_STAGE(PG8_SB(1, 0), cB + kstep, voffB); PG8_STAGE(PG8_SA(1, 0), cA + kstep, voffA); PG8_STAGE(PG8_SB(1, 1), cB + hstep + kstep, voffB);
        PG8_WAIT_V(6); PG8_BAR;
    } else {
        PG8_STAGE(PG8_SB(0, 0), cB, voffB); PG8_STAGE(PG8_SA(0, 0), cA, voffA); PG8_STAGE(PG8_SB(0, 1), cB + hstep, voffB); PG8_STAGE(PG8_SA(0, 1), cA + hstep, voffA);
        if (wr == 1) PG8_BAR;
        PG8_WAIT_V(4); PG8_BAR;
        PG8_STAGE(PG8_SB(1, 0), cB + kstep, voffB); PG8_STAGE(PG8_SA(1, 0), cA + kstep, voffA); PG8_STAGE(PG8_SB(1, 1), cB + hstep + kstep, voffB);
        PG8_WAIT_V(6); PG8_BAR;
    }
    for (;;) {
        const bool has_next = S.next(ui + 1, nxt);
        const char* nA = has_next ? (const char*)g.A + (size_t)nxt.pm * tstep : cA; const char* nB = has_next ? (const char*)g.Bt + (size_t)nxt.pn * tstep : cB;
        for (int t = 0; t < nt; t += 2) {
            const bool last = (t == nt - 2);
            const char* a1 = cA + (size_t)(t + 1) * kstep;
            const char* a2 = last ? nA : cA + (size_t)(t + 2) * kstep; const char* b2 = last ? nB : cB + (size_t)(t + 2) * kstep;
            const char* a3 = a2 + kstep; const char* b3 = b2 + kstep;
            if (last && has_next) S.a_ready(nxt);
            if constexpr (SP2) {
            PG8_LDB(B0, 0, 0); PG8_LDB(B1, 0, 1); PG8_SCHED; PG8_LDA(At, 0, 0); PG8_STAGE(PG8_SA(1, 1), a1 + hstep, voffA);
            PG8_WAIT_V(8); PG8_WAIT_L(0); PG8_BAR; PG8_MMA(0, 0, At, B0); PG8_MMA(0, 1, At, B1); PG8_BAR; PG8_SCHED;
            PG8_LDA(At, 0, 1); PG8_STAGE(PG8_SB(0, 0), b2, voffB); PG8_STAGE(PG8_SB(0, 1), b2 + hstep, voffB); PG8_STAGE(PG8_SA(0, 0), a2, voffA);
            PG8_WAIT_V(8); PG8_WAIT_L(0); PG8_BAR; PG8_MMA(1, 0, At, B0); PG8_MMA(1, 1, At, B1); PG8_BAR; PG8_SCHED;
            PG8_LDB(B0, 1, 0); PG8_LDB(B1, 1, 1); PG8_SCHED; PG8_LDA(At, 1, 0); PG8_STAGE(PG8_SA(0, 1), a2 + hstep, voffA);
            PG8_WAIT_V(8); PG8_WAIT_L(0); PG8_BAR; PG8_MMA(0, 0, At, B0); PG8_MMA(0, 1, At, B1); PG8_BAR; PG8_SCHED;
            PG8_LDA(At, 1, 1); PG8_STAGE(PG8_SB(1, 0), b3, voffB); PG8_STAGE(PG8_SB(1, 1), b3 + hstep, voffB); PG8_STAGE(PG8_SA(1, 0), a3, voffA);
            PG8_WAIT_V(8); PG8_WAIT_L(0); PG8_BAR; PG8_MMA(1, 0, At, B0); PG8_MMA(1, 1, At, B1); PG8_BAR; PG8_SCHED;
            } else {
            PG8_LDB(B0, 0, 0); PG8_SCHED; PG8_LDA(At, 0, 0); PG8_STAGE(PG8_SA(1, 1), a1 + hstep, voffA);
            PG8_WAIT_L(8); PG8_BAR; PG8_WAIT_L(0); PG8_MMA(0, 0, At, B0); PG8_BAR; PG8_SCHED;
            PG8_LDB(B1, 0, 1); PG8_STAGE(PG8_SB(0, 0), b2, voffB);
            PG8_BAR; PG8_WAIT_L(0); PG8_MMA(0, 1, At, B1); PG8_BAR;
            PG8_LDA(At, 0, 1); PG8_STAGE(PG8_SA(0, 0), a2, voffA);
            PG8_BAR; PG8_WAIT_L(0); PG8_MMA(1, 0, At, B0); PG8_BAR; PG8_SCHED;
            PG8_STAGE(PG8_SB(0, 1), b2 + hstep, voffB);
            PG8_WAIT_V(6); PG8_BAR; PG8_MMA(1, 1, At, B1); PG8_BAR;
            PG8_LDB(B0, 1, 0); PG8_SCHED; PG8_LDA(At, 1, 0); PG8_STAGE(PG8_SA(0, 1), a2 + hstep, voffA);
            PG8_WAIT_L(8); PG8_BAR; PG8_WAIT_L(0); PG8_MMA(0, 0, At, B0); PG8_BAR; PG8_SCHED;
            PG8_LDB(B1, 1, 1); PG8_STAGE(PG8_SB(1, 0), b3, voffB);
            PG8_BAR; PG8_WAIT_L(0); PG8_MMA(0, 1, At, B1); PG8_BAR;
            PG8_LDA(At, 1, 1); PG8_STAGE(PG8_SA(1, 0), a3, voffA);
            PG8_BAR; PG8_WAIT_L(0); PG8_MMA(1, 0, At, B0); PG8_BAR; PG8_SCHED;
            PG8_STAGE(PG8_SB(1, 1), b3 + hstep, voffB);
            PG8_WAIT_V(6); PG8_BAR; PG8_MMA(1, 1, At, B1); PG8_BAR;
            }
        }
        if constexpr (FP8) asm volatile("s_nop 15\n\ts_nop 15" ::: "memory");
        if constexpr (ALIGN_EPI) { if (wr == 0) PG8_BAR; }
        if constexpr (!Epi::AFTER_DRAIN) { E(acc, cur, wr, wc, fr, fq); S.done(cur); }
        if (!has_next) break;
#pragma unroll
        for (int a = 0; a < 2; ++a)
#pragma unroll
            for (int b = 0; b < 2; ++b)
#pragma unroll
                for (int m = 0; m < 4; ++m)
#pragma unroll
                    for (int n = 0; n < 2; ++n) acc[a][b][m][n] = (f32x4){0.f, 0.f, 0.f, 0.f};
        cur = nxt; cA = nA; cB = nB; ++ui;
        if constexpr (ALIGN_EPI) { if (wr == 1) PG8_BAR; }
    }
    PG8_WAIT_V(0);
    if constexpr (!ALIGN_EPI) { if (wr == 0) PG8_BAR; }
    PG8_BAR;
    if constexpr (Epi::AFTER_DRAIN) { E.fused(acc, cur, wr, wc, fr, fq, lds, wid, lane); S.done(cur); }
#undef PG8_SA
#undef PG8_SB
#undef PG8_STAGE
#undef PG8_LDA
#undef PG8_LDB
#undef PG8_MMA
#undef PG8_RD8
#undef PG8_WAIT_V
#undef PG8_WAIT_L
#undef PG8_BAR
#undef PG8_SCHED
}
}
namespace att {
typedef unsigned short bf16;
constexpr int   D = 128, NW = 8, QBLK = 32, KVBLK = 64;
constexpr float SCALE = 0.088388347648318440f;
constexpr float THR = 8.f;
constexpr int SDEPTH = 2;
constexpr int LDQ = 1024, LDK = 256, LDO = 1024;
constexpr size_t SHM_V = KVBLK * D * 2, SHM_K = KVBLK * D * 2, SHM_ATTN = 2 * SHM_V + 2 * SHM_K + NW * 64 * 4;
using bf16x8 = __attribute__((ext_vector_type(8))) short;
using s16x4  = __attribute__((ext_vector_type(4))) short;
using f32x16 = __attribute__((ext_vector_type(16))) float;
using f32x8  = __attribute__((ext_vector_type(8))) float;
using u32x4  = __attribute__((ext_vector_type(4))) unsigned;
#define KSWZ(row, colB) ((row) * 256 + ((colB) ^ (((row) & 7) << 4)))
#define SBAR() __builtin_amdgcn_sched_barrier(0)
__device__ __forceinline__ int crow(int r, int hi) { return (r & 3) + 8 * (r >> 2) + 4 * hi; }
__device__ __forceinline__ unsigned cvtpk(float lo, float hi) { return pg8::cvt_pk_bf16(lo, hi); }
template <typename TIn> struct Stage;
template <> struct Stage<bf16>  { using T = bf16x8;
  __device__ static __forceinline__ T ld8(const bf16* p) { return *reinterpret_cast<const bf16x8*>(p); }
  __device__ static __forceinline__ bf16x8 tobf(T x) { return x; } };
template <> struct Stage<float> { using T = f32x8;
  __device__ static __forceinline__ T ld8(const float* p) { return *reinterpret_cast<const f32x8*>(p); }
  __device__ static __forceinline__ bf16x8 tobf(T x) {
    u32x4 w = {cvtpk(x[0], x[1]), cvtpk(x[2], x[3]), cvtpk(x[4], x[5]), cvtpk(x[6], x[7])}; return *reinterpret_cast<bf16x8*>(&w); } };

__device__ __forceinline__ void partialSM(f32x16& p0, f32x16& p1, float& m_reg, float& mn, float& alpha) {
  constexpr float C = SCALE * 1.4426950408889634f;
  float pmax = p0[0]; for (int r = 1; r < 16; ++r) pmax = fmaxf(pmax, p0[r]); for (int r = 0; r < 16; ++r) pmax = fmaxf(pmax, p1[r]);
  { auto rr = __builtin_amdgcn_permlane32_swap(__float_as_uint(pmax), __float_as_uint(pmax), false, false);
    pmax = fmaxf(__uint_as_float(rr[0]), __uint_as_float(rr[1])); }
  if (__builtin_expect(__all(pmax - m_reg <= THR / SCALE), 1)) { mn = m_reg; alpha = 1.f; }
  else { mn = fmaxf(m_reg, pmax); alpha = __builtin_amdgcn_exp2f((m_reg - mn) * C); m_reg = mn; }
  float mnC = -mn * C;
  for (int r = 0; r < 16; ++r) p0[r] = fmaf(p0[r], C, mnC); for (int r = 0; r < 16; ++r) p1[r] = fmaf(p1[r], C, mnC);
  for (int r = 0; r < 16; ++r) p0[r] = __builtin_amdgcn_exp2f(p0[r]);
}
__device__ __forceinline__ void finishSM(f32x16& p0, f32x16& p1, float alpha, float& l_reg, bf16x8& pa0, bf16x8& pa1, bf16x8& pa2, bf16x8& pa3) {
  for (int r = 0; r < 16; ++r) p1[r] = __builtin_amdgcn_exp2f(p1[r]);
  float ps = 0; for (int r = 0; r < 16; ++r) ps += p0[r]; for (int r = 0; r < 16; ++r) ps += p1[r];
  { auto rr = __builtin_amdgcn_permlane32_swap(__float_as_uint(ps), __float_as_uint(ps), false, false);
    ps = __uint_as_float(rr[0]) + __uint_as_float(rr[1]); }
  l_reg = l_reg * alpha + ps;
#define PK4(P, BASE, OUT) do { unsigned a0 = cvtpk(P[BASE + 0], P[BASE + 1]), a1 = cvtpk(P[BASE + 2], P[BASE + 3]);   \
    unsigned b0 = cvtpk(P[BASE + 4], P[BASE + 5]), b1 = cvtpk(P[BASE + 6], P[BASE + 7]);                              \
    auto r0 = __builtin_amdgcn_permlane32_swap(a0, b0, false, false); auto r1 = __builtin_amdgcn_permlane32_swap(a1, b1, false, false); \
    u32x4 w = {r0[0], r1[0], r0[1], r1[1]}; OUT = *reinterpret_cast<bf16x8*>(&w); } while (0)
  PK4(p0, 0, pa0); PK4(p0, 8, pa1); PK4(p1, 0, pa2); PK4(p1, 8, pa3);
#undef PK4
}
__device__ __forceinline__ void qkt(f32x16& p0, f32x16& p1, const bf16* Ks, const bf16x8* qr, int r32, int hi) {
  p0 = f32x16{}; p1 = f32x16{};
  for (int d0 = 0; d0 < 8; ++d0) { int cb = (d0 * 16 + hi * 8) * 2;
    bf16x8 b0 = *reinterpret_cast<const bf16x8*>((const char*)Ks + KSWZ(r32, cb));
    bf16x8 b1 = *reinterpret_cast<const bf16x8*>((const char*)Ks + KSWZ(32 + r32, cb));
    p0 = __builtin_amdgcn_mfma_f32_32x32x16_bf16(b0, qr[d0], p0, 0, 0, 0);
    p1 = __builtin_amdgcn_mfma_f32_32x32x16_bf16(b1, qr[d0], p1, 0, 0, 0); }
}
__device__ __forceinline__ int v_st(int k, int c) { const int kk = (k & ~0xC) | ((k & 4) << 1) | ((k & 8) >> 1); return ((kk >> 3) * 4 + (c >> 5)) * 512 + ((kk & 7) * 32 + (c & 31)) * 2; }
__device__ __forceinline__ int v_rd_base(int lane) { return ((lane & 3) << 3) | (((lane >> 2) & 3) << 6) | (((lane >> 4) & 1) << 5) | (((lane >> 5) & 1) << 8); }
constexpr int v_rd_off(int d0, int ks, int half) { return d0 * 512 + ks * 4096 + half * 2048; }
template <int OFF> __device__ __forceinline__ s16x4 tr_read(int vb) {
  s16x4 r; asm volatile("ds_read_b64_tr_b16 %0, %1 offset:%2" : "=&v"(r) : "v"(vb), "i"(OFF) : "memory"); return r;
}
template <int D0> __device__ __forceinline__ void pv_one(f32x16& od, int vb, bf16x8 pa0, bf16x8 pa1, bf16x8 pa2, bf16x8 pa3) {
  const s16x4 l0 = tr_read<v_rd_off(D0, 0, 0)>(vb), h0 = tr_read<v_rd_off(D0, 0, 1)>(vb), l1 = tr_read<v_rd_off(D0, 1, 0)>(vb), h1 = tr_read<v_rd_off(D0, 1, 1)>(vb);
  const s16x4 l2 = tr_read<v_rd_off(D0, 2, 0)>(vb), h2 = tr_read<v_rd_off(D0, 2, 1)>(vb), l3 = tr_read<v_rd_off(D0, 3, 0)>(vb), h3 = tr_read<v_rd_off(D0, 3, 1)>(vb);
  asm volatile("s_waitcnt lgkmcnt(0)" ::: "memory"); SBAR();
#define PK(L, H) (bf16x8){L[0], L[1], L[2], L[3], H[0], H[1], H[2], H[3]}
  od = __builtin_amdgcn_mfma_f32_32x32x16_bf16(pa0, PK(l0, h0), od, 0, 0, 0);
  od = __builtin_amdgcn_mfma_f32_32x32x16_bf16(pa1, PK(l1, h1), od, 0, 0, 0);
  od = __builtin_amdgcn_mfma_f32_32x32x16_bf16(pa2, PK(l2, h2), od, 0, 0, 0);
  od = __builtin_amdgcn_mfma_f32_32x32x16_bf16(pa3, PK(l3, h3), od, 0, 0, 0);
#undef PK
}
__device__ __forceinline__ void pv_d0(f32x16* o, int vb, bf16x8 pa0, bf16x8 pa1, bf16x8 pa2, bf16x8 pa3) {
  pv_one<0>(o[0], vb, pa0, pa1, pa2, pa3); pv_one<1>(o[1], vb, pa0, pa1, pa2, pa3); pv_one<2>(o[2], vb, pa0, pa1, pa2, pa3); pv_one<3>(o[3], vb, pa0, pa1, pa2, pa3);
}

template <typename TQ>
__device__ __forceinline__ void attn_dense_body(const TQ* __restrict__ Qb, const bf16* __restrict__ Kh, const bf16* __restrict__ Vh,
                                                bf16* __restrict__ Ob, int seq, char* lds, const int tid_in) {
  using St = Stage<bf16>; using SQ = Stage<TQ>;
  int tid_ = tid_in; asm volatile("" : "+v"(tid_));
  const int tid = tid_, wid = tid >> 6, lane = tid & 63, r32 = lane & 31, hi = lane >> 5;
  bf16* V_lds = (bf16*)lds; bf16* K_lds = (bf16*)(lds + 2 * SHM_V);
  float* ws = (float*)(lds + 2 * SHM_V + 2 * SHM_K) + wid * 64; float* li_l = ws; float* al_l = ws + 32;
  float m_reg = -1e30f, l_reg = 0; f32x16 o[4] = {}; bf16x8 qr[8];
  const TQ* Qw = Qb + (long)(wid * QBLK + r32) * LDQ + hi * 8;
#pragma unroll
  for (int d0 = 0; d0 < 8; ++d0) qr[d0] = SQ::tobf(SQ::ld8(Qw + d0 * 16));
  const int sr = tid >> 4, sc = (tid & 15) * 8, vst0 = v_st(sr, sc), vst1 = v_st(32 + sr, sc);
  const int vb0 = (int)(uintptr_t)V_lds + v_rd_base(lane);
  struct { typename St::T vs0, vs1, ks0, ks1; } sr_[SDEPTH];
#define SLOAD(i, k0) do { sr_[i].vs0 = St::ld8(&Vh[(long)((k0) + sr) * LDK + sc]); sr_[i].vs1 = St::ld8(&Vh[(long)((k0) + 32 + sr) * LDK + sc]); \
    sr_[i].ks0 = St::ld8(&Kh[(long)((k0) + sr) * LDK + sc]); sr_[i].ks1 = St::ld8(&Kh[(long)((k0) + 32 + sr) * LDK + sc]); } while (0)
#define SWRITE(b, i) do { *(bf16x8*)((char*)V_lds + (b) * SHM_V + vst0) = St::tobf(sr_[i].vs0);          \
    *(bf16x8*)((char*)V_lds + (b) * SHM_V + vst1) = St::tobf(sr_[i].vs1); int kc = sc * 2;               \
    *(bf16x8*)((char*)K_lds + (b) * SHM_K + KSWZ(sr, kc)) = St::tobf(sr_[i].ks0);                       \
    *(bf16x8*)((char*)K_lds + (b) * SHM_K + KSWZ(32 + sr, kc)) = St::tobf(sr_[i].ks1); } while (0)
#define SWAIT() do { if constexpr (SDEPTH == 2) asm volatile("s_waitcnt vmcnt(4)" ::: "memory"); else asm volatile("s_waitcnt vmcnt(0)" ::: "memory"); } while (0)
#define RESC(a) do { if (__any((a) < 1.f)) { if (hi == 0) al_l[r32] = (a); asm volatile("s_waitcnt lgkmcnt(0)" ::: "memory"); \
    for (int d = 0; d < 4; ++d) for (int r = 0; r < 16; ++r) o[d][r] *= al_l[crow(r, hi)]; } } while (0)
  f32x16 pA0, pA1, pB0, pB1; float mnA, mnB, alA, alB; bf16x8 pa0, pa1, pa2, pa3; const int NT = seq / KVBLK;
  constexpr int SE = 0, SO = SDEPTH - 1;
  SLOAD(SE, 0); asm volatile("s_waitcnt vmcnt(0)" ::: "memory"); SWRITE(0, SE); __syncthreads();
  qkt(pA0, pA1, K_lds, qr, r32, hi); partialSM(pA0, pA1, m_reg, mnA, alA);
  SLOAD(SO, KVBLK); if constexpr (SDEPTH == 2) { if (2 < NT) SLOAD(SE, 2 * KVBLK); }
  SWAIT(); SWRITE(1, SO); __syncthreads();
  for (int j = 1; j + 1 < NT; j += 2) {
    SBAR(); qkt(pB0, pB1, (bf16*)((char*)K_lds + SHM_K), qr, r32, hi);
    finishSM(pA0, pA1, alA, l_reg, pa0, pa1, pa2, pa3); SBAR();
    SLOAD(SO, (j + SDEPTH) * KVBLK); SBAR();
    pv_d0(o, vb0, pa0, pa1, pa2, pa3); partialSM(pB0, pB1, m_reg, mnB, alB);
    __syncthreads(); SWAIT(); SWRITE(0, SE);
    RESC(alB); __syncthreads();
    SBAR(); qkt(pA0, pA1, K_lds, qr, r32, hi);
    finishSM(pB0, pB1, alB, l_reg, pa0, pa1, pa2, pa3); SBAR();
    if (SDEPTH == 1 || j + 3 < NT) SLOAD(SE, (j + 1 + SDEPTH) * KVBLK); SBAR();
    pv_d0(o, vb0 + (int)SHM_V, pa0, pa1, pa2, pa3); partialSM(pA0, pA1, m_reg, mnA, alA);
    __syncthreads(); SWAIT(); SWRITE(1, SO);
    RESC(alA); __syncthreads();
  }
  SBAR(); qkt(pB0, pB1, (bf16*)((char*)K_lds + SHM_K), qr, r32, hi);
  finishSM(pA0, pA1, alA, l_reg, pa0, pa1, pa2, pa3); SBAR();
  pv_d0(o, vb0, pa0, pa1, pa2, pa3); partialSM(pB0, pB1, m_reg, mnB, alB);
  __syncthreads(); RESC(alB);
  finishSM(pB0, pB1, alB, l_reg, pa0, pa1, pa2, pa3); SBAR();
  pv_d0(o, vb0 + (int)SHM_V, pa0, pa1, pa2, pa3);
  if (hi == 0) li_l[r32] = l_reg; asm volatile("s_waitcnt lgkmcnt(0)" ::: "memory");
  float rli[16];
#pragma unroll
  for (int r = 0; r < 16; ++r) rli[r] = __builtin_amdgcn_rcpf(li_l[crow(r, hi)]);
  bf16* Ow = Ob + (long)(wid * QBLK) * LDO;
#pragma unroll
  for (int r = 0; r < 16; ++r) { int orow = crow(r, hi);
    for (int d0 = 0; d0 < 4; ++d0) Ow[(long)orow * LDO + d0 * 32 + r32] = (bf16)(cvtpk(o[d0][r] * rli[r], 0.f) & 0xffffu); }
#undef SLOAD
#undef SWRITE
#undef SWAIT
#undef RESC
}
#undef KSWZ
#undef SBAR
}

#define GAS __attribute__((address_space(1)))
#define LAS __attribute__((address_space(3)))
typedef unsigned short bf16;
typedef unsigned v4u __attribute__((ext_vector_type(4)));
typedef float f32x4 __attribute__((ext_vector_type(4)));
typedef short bf16x8 __attribute__((ext_vector_type(8)));
typedef GAS unsigned gu32;
typedef GAS unsigned long long gu64;
#define RLX_AGENT __ATOMIC_RELAXED, __HIP_MEMORY_SCOPE_AGENT
#define LDS_WAIT() asm volatile("s_waitcnt lgkmcnt(0)" ::: "memory")
#define VM_WAIT() asm volatile("s_waitcnt vmcnt(0)" ::: "memory")
__device__ __forceinline__ unsigned long long rt() { return __builtin_amdgcn_s_memrealtime(); }
__device__ __forceinline__ unsigned f2bf(float f) { unsigned u = __builtin_bit_cast(unsigned, f); return (u + 0x7fffu + ((u >> 16) & 1u)) >> 16; }
__device__ __forceinline__ unsigned pk2(float lo, float hi) { return f2bf(lo) | (f2bf(hi) << 16); }

#define XB_TMO      128
#define XB_XCNT(j)  (256  + 64 * (j))
#define XB_XSUB(j)  (1280 + 64 * (j))
#define XB_XGEN(j)  (2304 + 64 * (j))
#define XB_TOP      3328
#define XB_TOPGEN   3392
#define XCD_BAR_WORDS 3456
#define XB_SPIN_CAP (1u << 18)

__device__ __forceinline__ unsigned xb_ld(unsigned* p)              { return __hip_atomic_load(p, __ATOMIC_RELAXED, __HIP_MEMORY_SCOPE_AGENT); }
__device__ __forceinline__ unsigned xb_add(unsigned* p, unsigned v) { return __hip_atomic_fetch_add(p, v, __ATOMIC_RELAXED, __HIP_MEMORY_SCOPE_AGENT); }
__device__ __forceinline__ unsigned xb_xcc_id() { return (unsigned)__builtin_amdgcn_s_getreg((3 << 11) | 20) & 0xFu; }
#define XB_SPIN(cond, bar) do { unsigned _sp = 0; while (cond) { __builtin_amdgcn_s_sleep(1); \
    if ((++_sp & 255u) == 0u) { if (xb_ld(&(bar)[XB_TMO])) break; if (_sp > XB_SPIN_CAP) { atomicAdd(&(bar)[XB_TMO], 1u); break; } } } } while (0)

struct XcdBarrier {
    unsigned* bar; unsigned x;
    volatile LAS unsigned* st;
};

__device__ __forceinline__ XcdBarrier xcd_barrier_post(unsigned* bar, volatile LAS unsigned* st) {
    XcdBarrier b; b.bar = bar; b.x = xb_xcc_id(); b.st = st;
    if (threadIdx.x == 0) (void)xb_add(&bar[XB_XCNT(b.x)], 1u);
    return b;
}
__device__ __forceinline__ void xcd_barrier_complete(unsigned* bar, unsigned x, unsigned& nloc, unsigned& nx) {
    const unsigned G = gridDim.x * gridDim.y * gridDim.z;
    unsigned sum, cnt, mine, sp = 0u;
    for (;;) {
        sum = 0u; cnt = 0u; mine = 0u;
#pragma unroll
        for (unsigned j = 0; j < 16; ++j) { const unsigned c = xb_ld(&bar[XB_XCNT(j)]); sum += c; cnt += (c > 0u) ? 1u : 0u; mine = (j == x) ? c : mine; }
        if (sum == G) break;
        __builtin_amdgcn_s_sleep(1);
        if ((++sp & 255u) == 0u) { if (xb_ld(&bar[XB_TMO])) break; if (sp > XB_SPIN_CAP) { atomicAdd(&bar[XB_TMO], 1u); break; } }
    }
    nloc = mine > 0u ? mine : 1u; nx = cnt > 0u ? cnt : 1u;
}

__device__ __forceinline__ void xcd_barrier(const XcdBarrier& b) {
    asm volatile("s_waitcnt vmcnt(0)" ::: "memory");
    __syncthreads();
    if (threadIdx.x == 0) {
        unsigned* bar = b.bar;
        __builtin_amdgcn_s_waitcnt(0);
        unsigned nloc = b.st[0], nx = b.st[1];
        if (nloc == 0u) { xcd_barrier_complete(bar, b.x, nloc, nx); b.st[0] = nloc; b.st[1] = nx; }
        const unsigned old = xb_add(&bar[XB_XSUB(b.x)], 1u);
        const unsigned gen = old / nloc;
        if (old + 1u == (gen + 1u) * nloc) {
            __builtin_amdgcn_fence(__ATOMIC_RELEASE, "agent");
            asm volatile("s_waitcnt vmcnt(0)" ::: "memory");
            const unsigned og = xb_add(&bar[XB_TOP], 1u);
            const unsigned tg = og / nx;
            if (og + 1u == (tg + 1u) * nx) xb_add(&bar[XB_TOPGEN], 1u);
            else XB_SPIN(xb_ld(&bar[XB_TOPGEN]) == tg, bar);
            __builtin_amdgcn_fence(__ATOMIC_ACQUIRE, "agent");
            xb_add(&bar[XB_XGEN(b.x)], 1u);
            asm volatile("s_waitcnt vmcnt(0)" ::: "memory");
        } else {
            XB_SPIN(xb_ld(&bar[XB_XGEN(b.x)]) == gen, bar);
            __builtin_amdgcn_fence(__ATOMIC_ACQUIRE, "agent");
            asm volatile("s_waitcnt vmcnt(0)" ::: "memory");
        }
    }
    __syncthreads();
}
constexpr int DM = 1024, NB = 16, SEQ = 2048, CTXL = 256, TL = NB * SEQ, TC = NB * CTXL, TALL = TL + TC;
constexpr int INCOLS = 6144, OFF_FNET = 2560, OFF_GATE = 3072;
constexpr int NEXP = 32, KVROWS = SEQ + CTXL;
constexpr float EPS = 1e-6f;
constexpr int NWAVES = 8, NTHR = NWAVES * 64;
constexpr int NPL = 13, NPH = 2 + 2 * NPL;
#ifndef MK_PER_PHASE
#define MK_PER_PHASE 0
#endif
constexpr size_t MiB = 1u << 20;
constexpr size_t WS_CTL = 0, CTL_ZERO_BYTES = 1 * MiB;
constexpr size_t WS_MOD = 1 * MiB;
constexpr size_t WS_TAB = 2 * MiB;
constexpr size_t WS_TOPI = 3 * MiB, WS_TOPP = 4 * MiB, WS_SLOT = 5 * MiB, WS_CNT = 6 * MiB;
constexpr size_t WS_LOGIT = 7 * MiB;
constexpr size_t WS_WSMALL = 17 * MiB, WSMALL_LAYER = 20 * MiB;
constexpr size_t OFFS_WIN = 0, OFFS_WF = 5 * MiB, OFFS_WG = 7 * MiB, OFFS_WAO = 13 * MiB, OFFS_WCO = 15 * MiB, OFFS_WFO = 16 * MiB, OFFS_WOUT = 17 * MiB, OFFS_ROUT = 19 * MiB;
constexpr size_t WS_DFTL = 57 * MiB, WS_DFTC = 73 * MiB;
constexpr size_t WS_XC = 74 * MiB;
constexpr size_t WS_H = 90 * MiB;
constexpr size_t WS_WGU = 162 * MiB, WS_WD = 226 * MiB, MOEW_LAYER = 96 * MiB;
constexpr size_t WS_BIG = 354 * MiB;
constexpr size_t WS_Q = WS_BIG, WS_K = WS_Q + 72 * MiB, WS_V = WS_K + 18 * MiB, WS_CU = WS_V + 18 * MiB, WS_YT = WS_CU + 36 * MiB, WS_YTC = WS_YT + 64 * MiB;
constexpr size_t WS_GATES = WS_BIG;
constexpr size_t WS_AO = WS_BIG + 216 * MiB, WS_CH = WS_AO + 72 * MiB, WS_Z = WS_CH + 36 * MiB;
constexpr size_t WS_MIX = WS_AO;
constexpr size_t WS_MERGED = WS_BIG + 360 * MiB;
constexpr int SLOT_ROWS = 608 * 256;
constexpr size_t WS_YS = WS_BIG, WS_HS = WS_BIG + 304 * MiB, WS_ACT = WS_BIG + 456 * MiB, WS_END = WS_BIG + 608 * MiB;
constexpr size_t WS_H8 = WS_END;
constexpr size_t WS_END2 = WS_END + 36 * MiB;
static_assert(WS_YTC + 8 * MiB == WS_AO && WS_Z + 36 * MiB == WS_MERGED && WS_MERGED + 72 * MiB <= WS_END && (size_t)SLOT_ROWS * 2048 == 304 * MiB, "ws map");
constexpr int CW_TMO = 0, CW_CODE = 1, CW_BAR = 4096;
constexpr int CNT_TILE_E = 16384, CNT_NT = 16384 + 1024;

constexpr int RING_OFF = 0, RING_BYTES = 131072;
constexpr int LDSCTL_OFF = RING_BYTES, MISC_OFF = LDSCTL_OFF + 320, LDS_CT = LDSCTL_OFF + 512, LDS_SM = LDSCTL_OFF + 1024;
constexpr int LDS_BYTES = 147456;

typedef unsigned u32x2 __attribute__((ext_vector_type(2)));
typedef int i32x4 __attribute__((ext_vector_type(4)));
typedef float f32x2 __attribute__((ext_vector_type(2)));
struct Args { const float* in[29]; float* out; unsigned char* ws; int ph_lo, ph_hi; };
typedef const __attribute__((address_space(4))) unsigned char* kptr_t;
struct AV {
    kptr_t kp;
    __device__ __forceinline__ const float* in(int i) const { return *(const float* const __attribute__((address_space(4)))*)(kp + 8 * i); }
    __device__ __forceinline__ float* out() const { return *(float* const __attribute__((address_space(4)))*)(kp + 8 * 29); }
    __device__ __forceinline__ unsigned char* ws() const { return *(unsigned char* const __attribute__((address_space(4)))*)(kp + 8 * 30); }
};
__device__ __forceinline__ AV av_get() { AV a; a.kp = (kptr_t)__builtin_amdgcn_kernarg_segment_ptr(); asm volatile("" : "+s"(a.kp)); return a; }

struct Frame {
    LAS unsigned char* lds; volatile LAS unsigned* MISC; gu32* ctl;
    int tid, lane, wave, vcu, G;
};

__device__ __forceinline__ float shx(float v, int m, int lane) { return __int_as_float(__builtin_amdgcn_ds_bpermute((lane ^ m) << 2, __float_as_int(v))); }
__device__ __forceinline__ float wave_sum(float v, int lane) {
#pragma unroll
    for (int o = 1; o < 64; o <<= 1) v += shx(v, o, lane);
    return v;
}
__device__ __forceinline__ float sigmoidf_(float x) { return 1.0f / (1.0f + __expf(-x)); }
__device__ __forceinline__ f32x4 bf4(u32x2 w) { f32x4 r; r[0] = __uint_as_float(w.x << 16); r[1] = __uint_as_float(w.x & 0xffff0000u); r[2] = __uint_as_float(w.y << 16); r[3] = __uint_as_float(w.y & 0xffff0000u); return r; }
__device__ __forceinline__ u32x2 pk4(f32x4 v) { u32x2 w; w.x = pk2(v[0], v[1]); w.y = pk2(v[2], v[3]); return w; }
__device__ __forceinline__ void ld_row_f32(f32x4 (&v)[4], const float* p, int lane) {
#pragma unroll
    for (int j = 0; j < 4; ++j) v[j] = ((const GAS f32x4*)p)[lane + 64 * j];
}
__device__ __forceinline__ void st_row_f32(const f32x4 (&v)[4], float* p, int lane) {
#pragma unroll
    for (int j = 0; j < 4; ++j) ((GAS f32x4*)p)[lane + 64 * j] = v[j];
}
__device__ __forceinline__ void ld_row_bf16(f32x4 (&v)[4], const bf16* p, int lane) {
#pragma unroll
    for (int j = 0; j < 4; ++j) v[j] = bf4(((const GAS u32x2*)p)[lane + 64 * j]);
}
__device__ __forceinline__ void st_row_bf16(const f32x4 (&v)[4], bf16* p, int lane) {
#pragma unroll
    for (int j = 0; j < 4; ++j) ((GAS u32x2*)p)[lane + 64 * j] = pk4(v[j]);
}
__device__ __forceinline__ void rms_gain(f32x4 (&v)[4], const float* g, int lane) {
    float ss = 0.f;
#pragma unroll
    for (int j = 0; j < 4; ++j) ss += (v[j][0] * v[j][0] + v[j][1] * v[j][1]) + (v[j][2] * v[j][2] + v[j][3] * v[j][3]);
    const float r = 1.0f / sqrtf(wave_sum(ss, lane) * (1.0f / 1024.0f) + EPS);
#pragma unroll
    for (int j = 0; j < 4; ++j) { const f32x4 gg = ((const GAS f32x4*)g)[lane + 64 * j]; v[j] = v[j] * r * gg; }
}
__device__ __forceinline__ void modulate_store(const f32x4 (&v)[4], const float* shift, const float* scale, bf16* o, int lane) {
#pragma unroll
    for (int j = 0; j < 4; ++j) { const f32x4 sh = ((const GAS f32x4*)shift)[lane + 64 * j], sc = ((const GAS f32x4*)scale)[lane + 64 * j];
        ((GAS u32x2*)o)[lane + 64 * j] = pk4(v[j] * (sc + 1.0f) + sh); }
}
__device__ __forceinline__ unsigned pk4_fp8(f32x4 v) { return pg8::cvt4_fp8(v[0], v[1], v[2], v[3]); }
__device__ __forceinline__ void modulate_store2(const f32x4 (&v)[4], const float* shift, const float* scale, bf16* o, unsigned char* o8, int lane) {
#pragma unroll
    for (int j = 0; j < 4; ++j) { const f32x4 sh = ((const GAS f32x4*)shift)[lane + 64 * j], sc = ((const GAS f32x4*)scale)[lane + 64 * j]; const f32x4 r = v[j] * (sc + 1.0f) + sh;
        ((GAS u32x2*)o)[lane + 64 * j] = pk4(r); ((GAS unsigned*)o8)[lane + 64 * j] = pk4_fp8(r); }
}
__device__ __forceinline__ int krow_of(int m) { return m < TL ? (m >> 11) * KVROWS + (m & 2047) : ((m - TL) >> 8) * KVROWS + SEQ + ((m - TL) & 255); }

__device__ __forceinline__ void transpose_item(const float* W, int ldw, int K, bf16* WT, int dst_row0, int k0, int n0, LAS float* scr, int lane) {
#pragma unroll 8
    for (int i = 0; i < 32; ++i) { const int kk = 2 * i + (lane >> 5); scr[kk * 33 + (lane & 31)] = W[(size_t)(k0 + kk) * ldw + n0 + (lane & 31)]; }
    LDS_WAIT(); asm volatile("" ::: "memory");
    const int c = lane & 7;
#pragma unroll
    for (int j = 0; j < 4; ++j) { const int n = (lane >> 3) + 8 * j; const LAS float* s = scr + (8 * c) * 33 + n;
        v4u o; o.x = pk2(s[0 * 33], s[1 * 33]); o.y = pk2(s[2 * 33], s[3 * 33]); o.z = pk2(s[4 * 33], s[5 * 33]); o.w = pk2(s[6 * 33], s[7 * 33]);
        *(GAS v4u*)(WT + (size_t)(dst_row0 + n) * K + k0 + 8 * c) = o; }
    LDS_WAIT(); asm volatile("" ::: "memory");
}
__device__ __forceinline__ void transpose_item_fp8(const float* W, int ldw, int K, unsigned char* WT, int dst_row0, int k0, int n0, float scale, LAS float* scr, int lane) {
#pragma unroll 8
    for (int i = 0; i < 32; ++i) { const int kk = 2 * i + (lane >> 5); scr[kk * 33 + (lane & 31)] = W[(size_t)(k0 + kk) * ldw + n0 + (lane & 31)] * scale; }
    LDS_WAIT(); asm volatile("" ::: "memory");
#pragma unroll
    for (int j = 0; j < 2; ++j) { const int q = lane + 64 * j, n = q >> 2, c = q & 3; const LAS float* s = scr + (16 * c) * 33 + n; v4u o;
        o.x = pg8::cvt4_fp8(s[0 * 33], s[1 * 33], s[2 * 33], s[3 * 33]); o.y = pg8::cvt4_fp8(s[4 * 33], s[5 * 33], s[6 * 33], s[7 * 33]); o.z = pg8::cvt4_fp8(s[8 * 33], s[9 * 33], s[10 * 33], s[11 * 33]); o.w = pg8::cvt4_fp8(s[12 * 33], s[13 * 33], s[14 * 33], s[15 * 33]);
        *(GAS v4u*)(WT + (size_t)(dst_row0 + n) * K + k0 + 16 * c) = o; }
    LDS_WAIT(); asm volatile("" ::: "memory");
}
constexpr int IT_S0 = 16 * 80, IT_S1 = 16 * 96, IT_S2 = 512, IT_S3 = 512, IT_S4 = 256, IT_S5 = 256, IT_SMALL = IT_S0 + IT_S1 + IT_S2 + IT_S3 + IT_S4 + IT_S5;
__device__ __forceinline__ void small_item(const AV& a, int l, int r, LAS float* scr, int lane) {
    unsigned char* wl = a.ws() + WS_WSMALL + (size_t)l * WSMALL_LAYER; const float* win = a.in(10) + (size_t)l * DM * INCOLS;
    if (r < IT_S0) { const int kb = r / 80, n0 = (r % 80) * 32; int dr;
        if (n0 < 1536) dr = n0; else { int cc = n0 - 1536; if (cc < 512) dr = 1536 + (cc >> 7) * 256 + (cc & 127); else { cc -= 512; dr = 1536 + (cc >> 7) * 256 + 128 + (cc & 127); } }
        transpose_item(win, INCOLS, DM, (bf16*)(wl + OFFS_WIN), dr, kb * 64, n0, scr, lane); return; }
    r -= IT_S0;
    if (r < IT_S1) { const int kb = r / 96, nb = r % 96; transpose_item_fp8(win, INCOLS, DM, wl + OFFS_WG, nb * 32, kb * 64, OFF_GATE + nb * 32, 32.0f, scr, lane); return; }
    r -= IT_S1;
    if (r < IT_S2) { const int kb = r / 32, nb = r % 32; transpose_item(a.in(13) + (size_t)l * DM * DM, DM, DM, (bf16*)(wl + OFFS_WAO), nb * 32, kb * 64, nb * 32, scr, lane); return; }
    r -= IT_S2;
    if (r < IT_S3) { const int kb = r / 32, nb = r % 32; transpose_item(a.in(20) + (size_t)l * DM * DM, DM, DM, (bf16*)(wl + OFFS_WOUT), nb * 32, kb * 64, nb * 32, scr, lane); return; }
    r -= IT_S3;
    if (r < IT_S4) { const int kb = r / 32, nb = r % 32; transpose_item(a.in(18) + (size_t)l * 512 * DM, DM, 512, (bf16*)(wl + OFFS_WCO), nb * 32, kb * 64, nb * 32, scr, lane); return; }
    r -= IT_S4;
    { const int kb = r / 32, nb = r % 32; transpose_item(a.in(19) + (size_t)l * 512 * DM, DM, 512, (bf16*)(wl + OFFS_WFO), nb * 32, kb * 64, nb * 32, scr, lane); }
}
constexpr int IT_MOE = NEXP * 3 * 512;
__device__ __forceinline__ void moe_item(const AV& a, int l, int idx, LAS float* scr, int lane) {
    const int e = idx / 1536, r = idx % 1536, which = r / 512, it = r % 512, kb = it / 32, n0 = (it % 32) * 32; const size_t eo = ((size_t)l * NEXP + e) << 20;
    unsigned char* wgu = a.ws() + WS_WGU + (size_t)l * MOEW_LAYER + (size_t)e * 2048 * 1024; unsigned char* wd = a.ws() + WS_WD + (size_t)l * MOEW_LAYER + (size_t)e * 1024 * 1024;
    if (which == 0) transpose_item_fp8(a.in(23) + eo, DM, DM, wgu, (n0 >> 7) * 256 + (n0 & 127), kb * 64, n0, 32.0f, scr, lane);
    else if (which == 1) transpose_item_fp8(a.in(25) + eo, DM, DM, wgu, (n0 >> 7) * 256 + 128 + (n0 & 127), kb * 64, n0, 32.0f, scr, lane);
    else transpose_item_fp8(a.in(27) + eo, DM, DM, wd, n0, kb * 64, n0, 32.0f, scr, lane);
}
__device__ __forceinline__ void fold_job(const AV& a, int j, const LAS float* ct, int lane) {
    const int l = j >> 10, r = j & 1023, g = r >> 8, kblk = (r >> 4) & 15, k2g = r & 15, k = kblk * 64 + lane;
    const float* wrow = a.in(10) + (size_t)l * DM * INCOLS + (size_t)k * INCOLS + OFF_FNET + g * 128;
    float ac[8], as[8];
#pragma unroll
    for (int i = 0; i < 8; ++i) { ac[i] = 0.f; as[i] = 0.f; }
    for (int n4 = 0; n4 < 32; ++n4) { const f32x4 w = *(const GAS f32x4*)(wrow + n4 * 4);
#pragma unroll
        for (int q = 0; q < 4; ++q) { const int n2 = n4 * 4 + q;
#pragma unroll
            for (int i = 0; i < 8; ++i) { const int ph = (n2 * (k2g * 8 + i)) & 127; ac[i] += w[q] * ct[ph]; as[i] += w[q] * ct[(ph - 32) & 127]; } } }
    bf16* wf = (bf16*)(a.ws() + WS_WSMALL + (size_t)l * WSMALL_LAYER + OFFS_WF);
#pragma unroll
    for (int i = 0; i < 8; ++i) { const int ch = g * 128 + k2g * 8 + i;
        wf[(size_t)ch * 1024 + k] = (bf16)f2bf(ac[i] * 0.08838834764831845f); wf[(size_t)(512 + ch) * 1024 + k] = (bf16)f2bf(as[i] * 0.08838834764831845f); }
}
__device__ __forceinline__ void p0_prologue(const Frame& F, const AV& a) {
    const int gw = F.vcu * NWAVES + F.wave, NGW = F.G * NWAVES, gt = F.vcu * NTHR + F.tid, NGT = F.G * NTHR;
    LAS float* ct = (LAS float*)(F.lds + LDS_CT);
    if (F.tid < 128) ct[F.tid] = cospif((float)F.tid * (1.0f / 64.0f));
    for (int job = blockIdx.x; job < 2 * 96; job += F.G) {
        const int l = job / 96, n0 = (job % 96) * 64;
        LAS float* s = (LAS float*)(F.lds + RING_OFF); LAS float* red = s + 17 * 1024;
        for (int i = F.tid; i < 17 * 1024; i += NTHR) { const int b = i >> 10, k = i & 1023; const float cv = b < 16 ? a.in(1)[b * 1024 + k] : a.in(3)[k]; s[i] = cv * sigmoidf_(cv); }
        __syncthreads();
        const int col = F.tid & 63, ks = F.tid >> 6; float acc[17];
#pragma unroll
        for (int b = 0; b < 17; ++b) acc[b] = 0.f;
        const float* w = a.in(4) + (size_t)l * DM * INCOLS + n0 + col;
        for (int k = ks * 128; k < ks * 128 + 128; ++k) { const float wv = w[(size_t)k * INCOLS];
#pragma unroll
            for (int b = 0; b < 17; ++b) acc[b] += s[b * 1024 + k] * wv; }
#pragma unroll
        for (int b = 0; b < 17; ++b) red[(ks * 17 + b) * 64 + col] = acc[b];
        __syncthreads();
        for (int i = F.tid; i < 17 * 64; i += NTHR) { const int b = i >> 6, c2 = i & 63; float t = 0.f;
#pragma unroll
            for (int q = 0; q < 8; ++q) t += red[(q * 17 + b) * 64 + c2];
            ((float*)(a.ws() + WS_MOD))[((size_t)l * 17 + b) * INCOLS + n0 + c2] = t + a.in(5)[l * INCOLS + n0 + c2]; }
        __syncthreads();
    }
    __syncthreads();
    for (int i = gt; i < 64 * 32; i += NGT) { const int p = i >> 5, f = i & 31; const float inv = powf(10000.0f, -(float)f / 32.0f), ang = (float)p * inv; ((f32x2*)(a.ws() + WS_TAB))[i] = (f32x2){cosf(ang), sinf(ang)}; }
    for (int i = gt; i < 2048 * 256; i += NGT) { const int k1 = i >> 8, c0 = (i & 255) * 16; float v[16];
#pragma unroll
        for (int q = 0; q < 16; ++q) { const int col = c0 + q, n1 = col & 2047, rr = (k1 * n1) & 2047; const float x = (float)rr * (1.0f / 1024.0f); v[q] = ((col >> 11) ? -sinpif(x) : cospif(x)) * (32.0f * 0.022097086912079608f); }
        v4u o; o.x = pk4_fp8((f32x4){v[0], v[1], v[2], v[3]}); o.y = pk4_fp8((f32x4){v[4], v[5], v[6], v[7]}); o.z = pk4_fp8((f32x4){v[8], v[9], v[10], v[11]}); o.w = pk4_fp8((f32x4){v[12], v[13], v[14], v[15]}); ((GAS v4u*)(a.ws() + WS_DFTL))[i] = o; }
    for (int i = gt; i < 256 * 32; i += NGT) { const int k1 = i >> 5, c0 = (i & 31) * 16; float v[16];
#pragma unroll
        for (int q = 0; q < 16; ++q) { const int col = c0 + q, n1 = col & 255, rr = (k1 * n1) & 255; const float x = (float)rr * (1.0f / 128.0f); v[q] = ((col >> 8) ? -sinpif(x) : cospif(x)) * (32.0f * 0.0625f); }
        v4u o; o.x = pk4_fp8((f32x4){v[0], v[1], v[2], v[3]}); o.y = pk4_fp8((f32x4){v[4], v[5], v[6], v[7]}); o.z = pk4_fp8((f32x4){v[8], v[9], v[10], v[11]}); o.w = pk4_fp8((f32x4){v[12], v[13], v[14], v[15]}); ((GAS v4u*)(a.ws() + WS_DFTC))[i] = o; }
    for (int i = gt; i < 2 * 256 * 1024; i += NGT) { const int l = i >> 18, r = (i >> 10) & 255, k = i & 1023; unsigned o = 0u;
        if (r < 64) { const float w = a.in(21)[((size_t)l * DM + k) * NEXP + (r & 31)]; const unsigned hi = f2bf(w); o = hi; if (r >= 32) o = f2bf(w - __uint_as_float(hi << 16)); }
        ((bf16*)(a.ws() + WS_WSMALL + (size_t)l * WSMALL_LAYER + OFFS_ROUT))[(size_t)r * 1024 + k] = (bf16)o; }
    for (int j = gw; j < 2048; j += NGW) fold_job(a, j, ct, F.lane);
    LAS float* scr = (LAS float*)(F.lds + RING_OFF + F.wave * 16384);
    for (int it = gw; it < 2 * IT_SMALL; it += NGW) small_item(a, it / IT_SMALL, it % IT_SMALL, scr, F.lane);
    for (int it = gw; it < 2 * IT_MOE; it += NGW) moe_item(a, it / IT_MOE, it % IT_MOE, scr, F.lane);
}
__device__ __forceinline__ void p1_norm0(const Frame& F, const AV& a) {
    const int gw = F.vcu * NWAVES + F.wave, NGW = F.G * NWAVES;
    for (int m = gw; m < TALL; m += NGW) {
        f32x4 v[4]; ld_row_f32(v, m < TL ? a.in(0) + (size_t)m * DM : a.in(2) + (size_t)(m - TL) * DM, F.lane);
        rms_gain(v, a.in(6), F.lane);
        const float* modv = (const float*)(a.ws() + WS_MOD) + (size_t)(m < TL ? (m >> 11) : 16) * INCOLS;
        modulate_store2(v, modv, modv + 1024, (bf16*)(a.ws() + WS_H) + (size_t)m * DM, a.ws() + WS_H8 + (size_t)m * DM, F.lane);
    }
}
__device__ __forceinline__ void qk_fix_vec(bf16* p, const float* g, const f32x2* tab, bool rope, int t, int sub, int lane) {
    f32x4 x[4]; float ss = 0.f;
#pragma unroll
    for (int jj = 0; jj < 4; ++jj) { x[jj] = bf4(*(const GAS u32x2*)(p + jj * 32 + sub * 4)); ss += (x[jj][0] * x[jj][0] + x[jj][1] * x[jj][1]) + (x[jj][2] * x[jj][2] + x[jj][3] * x[jj][3]); }
    ss += shx(ss, 1, lane); ss += shx(ss, 2, lane); ss += shx(ss, 4, lane);
    const float r = 1.0f / sqrtf(ss * (1.0f / 128.0f) + EPS);
#pragma unroll
    for (int jj = 0; jj < 4; ++jj) { const f32x4 gg = *(const GAS f32x4*)(g + jj * 32 + sub * 4); x[jj] = x[jj] * r * gg; }
    if (rope) { const int pr = t >> 6, pc = t & 63;
#pragma unroll
        for (int i = 0; i < 4; ++i) { const f32x2 cr = tab[pr * 32 + sub * 4 + i], cc = tab[pc * 32 + sub * 4 + i];
            const float a0 = x[0][i], a1 = x[1][i], b0 = x[2][i], b1 = x[3][i];
            x[0][i] = a0 * cr.x - a1 * cr.y; x[1][i] = a1 * cr.x + a0 * cr.y; x[2][i] = b0 * cc.x - b1 * cc.y; x[3][i] = b1 * cc.x + b0 * cc.y; } }
#pragma unroll
    for (int jj = 0; jj < 4; ++jj) *(GAS u32x2*)(p + jj * 32 + sub * 4) = pk4(x[jj]);
}
__device__ __forceinline__ void p_qkfix(const Frame& F, const AV& a, int l, int M) {
    const int gw = F.vcu * NWAVES + F.wave, NGW = F.G * NWAVES; const f32x2* tab = (const f32x2*)(a.ws() + WS_TAB);
    for (int m = gw; m < M; m += NGW) { const bool lat = m < TL; const int t = m & 2047, hh = F.lane >> 3, sub = F.lane & 7;
        if (lat || l == 0) qk_fix_vec((bf16*)(a.ws() + WS_Q) + (size_t)m * DM + hh * 128, a.in(11) + l * 128, tab, lat, t, sub, F.lane);
        if (F.lane < 16) qk_fix_vec((bf16*)(a.ws() + WS_K) + (size_t)krow_of(m) * 256 + hh * 128, a.in(12) + l * 128, tab, lat, t, sub, F.lane);
    }
}
__device__ __forceinline__ void p_conv(const Frame& F, const AV& a, int l, int njobs) {
    LAS unsigned char* lin = F.lds + RING_OFF; LAS float* lout = (LAS float*)(F.lds + RING_OFF + 62 * 1024);
    const bf16* cu = (const bf16*)(a.ws() + WS_CU); bf16* chb = (bf16*)(a.ws() + WS_CH);
    const int cp = F.tid & 255, pg = F.tid >> 8;
    f32x2 wv[31];
#pragma unroll
    for (int j = 0; j < 31; ++j) wv[j] = *(const GAS f32x2*)(a.in(14) + ((size_t)l * 31 + j) * 512 + 2 * cp);
    const f32x2 cb2 = *(const GAS f32x2*)(a.in(15) + l * 512 + 2 * cp);
    for (int job = F.vcu; job < njobs; job += F.G) {
        int rowbase, L, t0;
        if (job < 1024) { rowbase = (job >> 6) * SEQ; L = SEQ; t0 = (job & 63) * 32; } else { const int jc = job - 1024; rowbase = TL + (jc >> 3) * CTXL; L = CTXL; t0 = (jc & 7) * 32; }
        for (int idx = F.tid; idx < 62 * 64; idx += NTHR) { const int row = idx >> 6, ch = idx & 63, p = t0 - 15 + row; v4u val = (v4u){0u, 0u, 0u, 0u};
            if (p >= 0 && p < L) val = *(const GAS v4u*)(cu + (size_t)(rowbase + p) * 512 + ch * 8);
            *(LAS v4u*)(lin + row * 1024 + ch * 16) = val; }
        __syncthreads();
#pragma unroll
        for (int chunk = 0; chunk < 2; ++chunk) {
            f32x2 acc[8];
#pragma unroll
            for (int i = 0; i < 8; ++i) acc[i] = cb2;
            const int r0 = pg * 16 + chunk * 8;
#pragma unroll
            for (int r = 0; r < 38; ++r) { const unsigned w = *(const LAS unsigned*)(lin + (r0 + r) * 1024 + cp * 4); const float x0 = __uint_as_float(w << 16), x1 = __uint_as_float(w & 0xffff0000u);
#pragma unroll
                for (int i = 0; i < 8; ++i) { const int j = r - i; if (j >= 0 && j <= 30) { acc[i].x += x0 * wv[j].x; acc[i].y += x1 * wv[j].y; } } }
#pragma unroll
            for (int i = 0; i < 8; ++i) *(LAS f32x2*)(lout + (r0 + i) * 512 + 2 * cp) = acc[i];
        }
        __syncthreads();
#pragma unroll
        for (int pp = 0; pp < 4; ++pp) { const int p = F.wave * 4 + pp; const LAS float* src = lout + p * 512 + F.lane * 8;
            f32x4 y0 = *(const LAS f32x4*)src, y1 = *(const LAS f32x4*)(src + 4);
            const float mean = wave_sum((y0[0] + y0[1]) + (y0[2] + y0[3]) + (y1[0] + y1[1]) + (y1[2] + y1[3]), F.lane) * (1.0f / 512.0f);
            y0 = y0 - mean; y1 = y1 - mean;
            const float var = wave_sum((y0[0] * y0[0] + y0[1] * y0[1]) + (y0[2] * y0[2] + y0[3] * y0[3]) + (y1[0] * y1[0] + y1[1] * y1[1]) + (y1[2] * y1[2] + y1[3] * y1[3]), F.lane) * (1.0f / 512.0f);
            const float rs = 1.0f / sqrtf(var + EPS);
            const f32x4 g0 = *(const GAS f32x4*)(a.in(16) + l * 512 + F.lane * 8), g1 = *(const GAS f32x4*)(a.in(16) + l * 512 + F.lane * 8 + 4);
            const f32x4 b0 = *(const GAS f32x4*)(a.in(17) + l * 512 + F.lane * 8), b1 = *(const GAS f32x4*)(a.in(17) + l * 512 + F.lane * 8 + 4);
            y0 = y0 * rs * g0 + b0; y1 = y1 * rs * g1 + b1;
#pragma unroll
            for (int q = 0; q < 4; ++q) { y0[q] = y0[q] * sigmoidf_(y0[q]); y1[q] = y1[q] * sigmoidf_(y1[q]); }
            v4u o; o.x = pk2(y0[0], y0[1]); o.y = pk2(y0[2], y0[3]); o.z = pk2(y1[0], y1[1]); o.w = pk2(y1[2], y1[3]);
            *(GAS v4u*)(chb + (size_t)(rowbase + t0 + p) * 512 + F.lane * 8) = o; }
        __syncthreads();
    }
}
__device__ __forceinline__ void p_rowpass1(const Frame& F, const AV& a, int l, int M) {
    const int gw = F.vcu * NWAVES + F.wave, NGW = F.G * NWAVES;
    for (int m = gw; m < M; m += NGW) {
        const float* xs = (l == 0) ? (m < TL ? a.in(0) + (size_t)m * DM : a.in(2) + (size_t)(m - TL) * DM) : (m < TL ? a.out() + (size_t)m * DM : (const float*)(a.ws() + WS_XC) + (size_t)(m - TL) * DM);
        float* xd = m < TL ? a.out() + (size_t)m * DM : (float*)(a.ws() + WS_XC) + (size_t)(m - TL) * DM;
        const float* modv = (const float*)(a.ws() + WS_MOD) + ((size_t)l * 17 + (m < TL ? (m >> 11) : 16)) * INCOLS;
        f32x4 x[4], y[4]; ld_row_f32(x, xs, F.lane); ld_row_bf16(y, (const bf16*)(a.ws() + WS_MIX) + (size_t)m * DM, F.lane);
        rms_gain(y, a.in(7) + l * DM, F.lane);
#pragma unroll
        for (int j = 0; j < 4; ++j) { const f32x4 gt = ((const GAS f32x4*)(modv + 2 * 1024))[F.lane + 64 * j]; x[j] = x[j] + gt * y[j]; }
        st_row_f32(x, xd, F.lane);
        rms_gain(x, a.in(8) + l * DM, F.lane);
        modulate_store(x, modv + 3 * 1024, modv + 4 * 1024, (bf16*)(a.ws() + WS_H) + (size_t)m * DM, F.lane);
    }
}
__device__ __forceinline__ void p_topk(const Frame& F, const AV& a, int l, int M) {
    LAS int* cntl = (LAS int*)(F.lds + LDS_SM);
    if (F.tid < 32) cntl[F.tid] = 0;
    __syncthreads();
    const int TPB = (M + F.G - 1) / F.G, m0 = blockIdx.x * TPB, m1 = (m0 + TPB < M) ? m0 + TPB : M;
    const float* lg = (const float*)(a.ws() + WS_LOGIT);
    for (int m = m0 + F.wave; m < m1; m += NWAVES) {
        float v = -3.0e38f;
        if (F.lane < 32) v = lg[(size_t)m * 64 + F.lane] + lg[(size_t)m * 64 + 32 + F.lane] + a.in(22)[l * NEXP + F.lane];
        unsigned ub = __float_as_uint(v); ub = (ub & 0x80000000u) ? ~ub : (ub | 0x80000000u);
        unsigned long long key = ((unsigned long long)ub << 32) | (unsigned)(63 - F.lane);
        int ids[4]; float vals[4];
#pragma unroll
        for (int k = 0; k < 4; ++k) { unsigned long long mx = key;
#pragma unroll
            for (int o = 1; o < 64; o <<= 1) { const int pa = (F.lane ^ o) << 2; const unsigned long long t = ((unsigned long long)(unsigned)__builtin_amdgcn_ds_bpermute(pa, (int)(unsigned)(mx >> 32)) << 32) | (unsigned)__builtin_amdgcn_ds_bpermute(pa, (int)(unsigned)mx); mx = t > mx ? t : mx; }
            const int id = 63 - (int)(mx & 63ull); ids[k] = id; vals[k] = __int_as_float(__builtin_amdgcn_ds_bpermute(id << 2, __float_as_int(v))); if (F.lane == id) key = 0ull; }
        const float e1 = __expf(vals[1] - vals[0]), e2 = __expf(vals[2] - vals[0]), e3 = __expf(vals[3] - vals[0]), inv = 1.0f / (1.0f + e1 + e2 + e3);
        if (F.lane == 0) { *(GAS i32x4*)((int*)(a.ws() + WS_TOPI) + (size_t)m * 4) = (i32x4){ids[0], ids[1], ids[2], ids[3]};
            *(GAS f32x4*)((float*)(a.ws() + WS_TOPP) + (size_t)m * 4) = (f32x4){inv, e1 * inv, e2 * inv, e3 * inv}; }
        if (F.lane < 4) __hip_atomic_fetch_add(&cntl[F.lane == 0 ? ids[0] : F.lane == 1 ? ids[1] : F.lane == 2 ? ids[2] : ids[3]], 1, __ATOMIC_RELAXED, __HIP_MEMORY_SCOPE_WORKGROUP);
    }
    __syncthreads();
    if (F.tid < 32) ((int*)(a.ws() + WS_CNT))[blockIdx.x * 32 + F.tid] = cntl[F.tid];
}
__device__ __forceinline__ void p_slots(const Frame& F, const AV& a, int M) {
    LAS int* sm = (LAS int*)(F.lds + LDS_SM);
    LAS int *tot = sm, *bef = sm + 32, *base = sm + 64, *tst = sm + 96  , *mask = sm + 160  , *ids = sm + 320  , *slot = sm + 960  ;
    const int* cnt = (const int*)(a.ws() + WS_CNT);
    { LAS int* ptot = sm + 1600; LAS int* pbef = sm + 2112; const int e = F.tid & 31, part = F.tid >> 5; int t = 0, b = 0;
#pragma unroll 4
      for (int q = part; q < F.G; q += 16) { const int c = cnt[q * 32 + e]; t += c; if (q < (int)blockIdx.x) b += c; }
      ptot[part * 32 + e] = t; pbef[part * 32 + e] = b;
      __syncthreads();
      if (F.tid < 32) { int tt = 0, bb = 0;
#pragma unroll
          for (int q = 0; q < 16; ++q) { tt += ptot[q * 32 + F.tid]; bb += pbef[q * 32 + F.tid]; }
          tot[F.tid] = tt; bef[F.tid] = bb; } }
    __syncthreads();
    if (F.tid == 0) { int ts = 0; for (int e = 0; e < 32; ++e) { tst[e] = ts; base[e] = ts * 256 + bef[e]; ts += (tot[e] + 255) >> 8; } tst[32] = ts; }
    __syncthreads();
    const int NT = tst[32];
    if (blockIdx.x == 0) { int* te = (int*)(a.ws() + WS_CNT) + CNT_TILE_E;
        for (int t = F.tid; t < NT; t += NTHR) { int e = 0; for (int q = 1; q < 32; ++q) if (t >= tst[q]) e = q; te[t] = e; }
        if (F.tid == 0) ((int*)(a.ws() + WS_CNT))[CNT_NT] = NT; }
    const int TPB = (M + F.G - 1) / F.G, m0 = blockIdx.x * TPB, m1 = (m0 + TPB < M) ? m0 + TPB : M, nt = m1 > m0 ? m1 - m0 : 0;
    for (int tl = F.tid; tl < nt; tl += NTHR) { const i32x4 id = *(const GAS i32x4*)((const int*)(a.ws() + WS_TOPI) + (size_t)(m0 + tl) * 4);
        ids[tl * 4 + 0] = id.x; ids[tl * 4 + 1] = id.y; ids[tl * 4 + 2] = id.z; ids[tl * 4 + 3] = id.w; mask[tl] = (1 << id.x) | (1 << id.y) | (1 << id.z) | (1 << id.w); }
    __syncthreads();
    for (int p = F.tid; p < nt * 4; p += NTHR) { const int tl = p >> 2, e = ids[p]; int rank = 0; for (int q = 0; q < tl; ++q) rank += (mask[q] >> e) & 1;
        const int s = base[e] + rank; slot[p] = s; ((int*)(a.ws() + WS_SLOT))[(size_t)(m0 + tl) * 4 + (p & 3)] = s; }
    __syncthreads();
    const bf16* h = (const bf16*)(a.ws() + WS_H); unsigned char* hs = a.ws() + WS_HS;
    for (int p = F.wave; p < nt * 4; p += NWAVES) { const GAS v4u* src = (const GAS v4u*)(h + (size_t)(m0 + (p >> 2)) * DM); GAS u32x2* dst = (GAS u32x2*)(hs + (size_t)slot[p] * DM);
#pragma unroll
        for (int j = 0; j < 2; ++j) { const v4u x = src[F.lane + 64 * j]; u32x2 o;
            o.x = pg8::cvt4_fp8(__uint_as_float(x.x << 16), __uint_as_float(x.x & 0xffff0000u), __uint_as_float(x.y << 16), __uint_as_float(x.y & 0xffff0000u));
            o.y = pg8::cvt4_fp8(__uint_as_float(x.z << 16), __uint_as_float(x.z & 0xffff0000u), __uint_as_float(x.w << 16), __uint_as_float(x.w & 0xffff0000u));
            dst[F.lane + 64 * j] = o; } }
    if (blockIdx.x < 32) { const int e = blockIdx.x, r0 = tst[e] * 256 + tot[e], r1 = tst[e + 1] * 256;
        unsigned zz = 0u; asm volatile("" : "+v"(zz));
        for (int r = r0 + F.wave; r < r1; r += NWAVES) { GAS v4u* dst = (GAS v4u*)(hs + (size_t)r * DM); dst[F.lane] = (v4u){zz, zz, zz, zz}; } }
    __syncthreads();
}
__device__ __forceinline__ void p_combine(const Frame& F, const AV& a, int l, int M) {
    const int gw = F.vcu * NWAVES + F.wave, NGW = F.G * NWAVES; const bf16* ys = (const bf16*)(a.ws() + WS_YS);
    for (int m = gw; m < M; m += NGW) {
        const i32x4 sl = *(const GAS i32x4*)((const int*)(a.ws() + WS_SLOT) + (size_t)m * 4); const f32x4 pr = *(const GAS f32x4*)((const float*)(a.ws() + WS_TOPP) + (size_t)m * 4);
        f32x4 y[4], t[4];
        ld_row_bf16(y, ys + (size_t)sl.x * DM, F.lane);
#pragma unroll
        for (int j = 0; j < 4; ++j) y[j] = y[j] * pr[0];
        ld_row_bf16(t, ys + (size_t)sl.y * DM, F.lane);
#pragma unroll
        for (int j = 0; j < 4; ++j) y[j] += t[j] * pr[1];
        ld_row_bf16(t, ys + (size_t)sl.z * DM, F.lane);
#pragma unroll
        for (int j = 0; j < 4; ++j) y[j] += t[j] * pr[2];
        ld_row_bf16(t, ys + (size_t)sl.w * DM, F.lane);
#pragma unroll
        for (int j = 0; j < 4; ++j) y[j] += t[j] * pr[3];
        rms_gain(y, a.in(9) + l * DM, F.lane);
        float* xd = m < TL ? a.out() + (size_t)m * DM : (float*)(a.ws() + WS_XC) + (size_t)(m - TL) * DM;
        const int b = m < TL ? (m >> 11) : 16;
        const float* modv = (const float*)(a.ws() + WS_MOD) + ((size_t)l * 17 + b) * INCOLS;
        f32x4 x[4]; ld_row_f32(x, xd, F.lane);
#pragma unroll
        for (int j = 0; j < 4; ++j) { const f32x4 gt = ((const GAS f32x4*)(modv + 5 * 1024))[F.lane + 64 * j]; x[j] = x[j] + gt * y[j]; }
        st_row_f32(x, xd, F.lane);
        if (l == 0) { rms_gain(x, a.in(6) + DM, F.lane); const float* mod1 = (const float*)(a.ws() + WS_MOD) + ((size_t)17 + b) * INCOLS;
            modulate_store2(x, mod1, mod1 + 1024, (bf16*)(a.ws() + WS_H) + (size_t)m * DM, a.ws() + WS_H8 + (size_t)m * DM, F.lane); }
    }
}
#ifdef DBG_CHECK
#ifndef DBG_GSUB
#define DBG_GSUB 0
#endif
__device__ __forceinline__ double bfd(bf16 b) { return (double)__uint_as_float(((unsigned)b) << 16); }
__device__ __forceinline__ unsigned hsh(unsigned x) { x ^= x >> 16; x *= 0x7feb352du; x ^= x >> 15; x *= 0x846ca68bu; x ^= x >> 16; return x; }
__device__ __forceinline__ int samp_row(int i, int M, unsigned salt) { const int sp[12] = {0, 1, 255, 256, 2047, 2048, 4095, 32767, 32768, 32769, 33023, 36863}; if (i < 12 && sp[i] < M) return sp[i]; return (int)(hsh(i * 7919u + salt) % (unsigned)M); }
__device__ __forceinline__ void rec(float* res, int stage, double got, double want, double flo) { const double e = fabs(got - want) / (fabs(want) + flo); const float f = (e == e) ? (float)e : 1e30f; atomicMax((unsigned*)res + stage, __float_as_uint(f)); }
__device__ double dot_h_w(const bf16* hrow, const float* w, int ldw, int col) { double s = 0; for (int k = 0; k < 1024; ++k) s += bfd(hrow[k]) * (double)w[(size_t)k * ldw + col]; return s; }
__device__ double dsig(double x) { return 1.0 / (1.0 + exp(-x)); }
constexpr double PI_D = 3.14159265358979323846;
enum { ST_MOD = 0, ST_H0, ST_INPROJ, ST_YT, ST_QKFIX, ST_CONV, ST_Z, ST_ATTN, ST_GATES, ST_MERGED, ST_MIX, ST_ROW1, ST_LOGIT, ST_TOPK, ST_SLOTS, ST_ACT, ST_YSLOT, ST_COMB, ST_GATESB, ST_N };
__global__ void chk(Args A, int stage, int l, float* res, float* snap) {
    const int i = threadIdx.x; unsigned char* ws = A.ws; const int M = (l == 0) ? TALL : TL; const int rs = stage + 32 * l;
    const bf16* H = (const bf16*)(ws + WS_H); const float* win = A.in[10] + (size_t)l * DM * INCOLS; const float* modb = (const float*)(ws + WS_MOD);
    if (stage == ST_MOD) { const int ll = i & 1, b = (i >> 1) % 17, n = (int)(hsh(i) % 6144u); double s = 0; for (int k = 0; k < 1024; ++k) { const double cv = b < 16 ? A.in[1][b * 1024 + k] : A.in[3][k]; s += cv * dsig(cv) * (double)A.in[4][((size_t)ll * 1024 + k) * 6144 + n]; }
        s += A.in[5][ll * 6144 + n]; rec(res, rs, modb[((size_t)ll * 17 + b) * 6144 + n], s, 0.02); }
    else if (stage == ST_H0) { const int m = samp_row(i, TALL, 1), c = (int)(hsh(i + 77) % 1024u); const float* x = m < TL ? A.in[0] + (size_t)m * DM : A.in[2] + (size_t)(m - TL) * DM; double ss = 0; for (int k = 0; k < 1024; ++k) ss += (double)x[k] * x[k];
        const float* mv = modb + (size_t)(m < TL ? (m >> 11) : 16) * 6144; const double want = x[c] / sqrt(ss / 1024 + 1e-6) * A.in[6][c] * (1.0 + mv[1024 + c]) + mv[c]; rec(res, rs, bfd(H[(size_t)m * DM + c]), want, 0.05); }
    else if (stage == ST_INPROJ) { const int m = samp_row(i, TALL, 2), kind = i & 3; const bf16* hr = H + (size_t)m * DM;
        if (kind == 0) { const int n = (int)(hsh(i + 5) % 1024u); rec(res, rs, bfd(((const bf16*)(ws + WS_Q))[(size_t)m * DM + n]), dot_h_w(hr, win, INCOLS, n), 0.05); }
        else if (kind == 1) { const int n = (int)(hsh(i + 6) % 256u); rec(res, rs, bfd(((const bf16*)(ws + WS_K))[(size_t)krow_of(m) * 256 + n]), dot_h_w(hr, win, INCOLS, 1024 + n), 0.05); }
        else if (kind == 2) { const int n = (int)(hsh(i + 7) % 256u); rec(res, rs, bfd(((const bf16*)(ws + WS_V))[(size_t)krow_of(m) * 256 + n]), dot_h_w(hr, win, INCOLS, 1280 + n), 0.05); }
        else { const int c = (int)(hsh(i + 8) % 512u); if (l == 0 || m < TL) { const double a = dot_h_w(hr, win, INCOLS, 1536 + c), g = dot_h_w(hr, win, INCOLS, 2048 + c); rec(res, rs, bfd(((const bf16*)(ws + WS_CU))[(size_t)m * 512 + c]), a * dsig(g), 0.05); } } }
    else if (stage == ST_YT) { const int m = samp_row(i, M, 3), ch = (int)(hsh(i + 9) % 512u), cs = i & 1, g = ch >> 7, k2 = ch & 127; const bf16* hr = H + (size_t)m * DM; double s = 0;
        for (int k = 0; k < 1024; ++k) { double t = 0; for (int n2 = 0; n2 < 128; ++n2) { const double ang = 2.0 * PI_D * ((n2 * k2) & 127) / 128.0; t += (double)win[(size_t)k * INCOLS + OFF_FNET + g * 128 + n2] * (cs ? sin(ang) : cos(ang)); } s += bfd(hr[k]) * t; }
        s /= sqrt(128.0); double got; if (m < TL) got = bfd(((const bf16*)(ws + WS_YT))[((size_t)(m >> 11) * 512 + ch) * 4096 + cs * 2048 + (m & 2047)]); else got = bfd(((const bf16*)(ws + WS_YTC))[((size_t)((m - TL) >> 8) * 512 + ch) * 512 + cs * 256 + ((m - TL) & 255)]);
        rec(res, rs, got, s, 0.05); }
    else if (stage == ST_QKFIX) { const int m = samp_row(i, TALL, 4), isk = i & 1, hh = isk ? (int)(hsh(i + 3) % 2u) : (int)(hsh(i + 3) % 8u), d = (int)(hsh(i + 4) % 128u); const bf16* hr = H + (size_t)m * DM;
        if (isk || l == 0 || m < TL) { const int cbase = isk ? 1024 + hh * 128 : hh * 128; double ss = 0, xd = 0, xp = 0; const int half = d & 64, dd = d & 63, pd = half + ((dd + 32) & 63);
            for (int q = 0; q < 128; ++q) { double v = dot_h_w(hr, win, INCOLS, cbase + q); v = bfd((bf16)f2bf((float)v)); ss += v * v; if (q == d) xd = v; if (q == pd) xp = v; }
            const float* gn = (isk ? A.in[12] : A.in[11]) + l * 128; const double r = 1.0 / sqrt(ss / 128 + 1e-6); xd *= r * gn[d]; xp *= r * gn[pd]; double want = xd;
            if (m < TL) { const int t = m & 2047, pos = half ? (t & 63) : (t >> 6), f = dd & 31; const double ang = (double)((float)pos * powf(10000.0f, -(float)f / 32.0f)); want = (dd < 32) ? xd * cos(ang) - xp * sin(ang) : xd * cos(ang) + xp * sin(ang); }
            const double got = isk ? bfd(((const bf16*)(ws + WS_K))[(size_t)krow_of(m) * 256 + hh * 128 + d]) : bfd(((const bf16*)(ws + WS_Q))[(size_t)m * DM + hh * 128 + d]); rec(res, rs, got, want, 0.05); } }
    else if (stage == ST_CONV) { const int m = samp_row(i, M, 5), c = (int)(hsh(i + 11) % 512u); const int rowbase = m < TL ? (m >> 11) * SEQ : TL + ((m - TL) >> 8) * CTXL, L = m < TL ? SEQ : CTXL, t = m - rowbase; const bf16* cu = (const bf16*)(ws + WS_CU);
        double s1 = 0, s2 = 0, yc = 0; for (int cc = 0; cc < 512; ++cc) { double y = A.in[15][l * 512 + cc]; for (int j = 0; j < 31; ++j) { const int p = t + j - 15; if (p >= 0 && p < L) y += bfd(cu[(size_t)(rowbase + p) * 512 + cc]) * (double)A.in[14][((size_t)l * 31 + j) * 512 + cc]; } s1 += y; s2 += y * y; if (cc == c) yc = y; }
        const double mean = s1 / 512, var = s2 / 512 - mean * mean; double y = (yc - mean) / sqrt(var + 1e-6) * A.in[16][l * 512 + c] + A.in[17][l * 512 + c]; y = y * dsig(y); rec(res, rs, bfd(((const bf16*)(ws + WS_CH))[(size_t)m * 512 + c]), y, 0.05); }
    else if (stage == ST_Z) { const int m = samp_row(i, M, 6), ch = (int)(hsh(i + 12) % 512u); double s = 0;
        if (m < TL) { const int b = m >> 11, k1 = m & 2047; const bf16* yr = (const bf16*)(ws + WS_YT) + ((size_t)b * 512 + ch) * 4096; for (int n1 = 0; n1 < 2048; ++n1) { const double ang = 2.0 * PI_D * ((k1 * n1) & 2047) / 2048.0; s += cos(ang) * bfd(yr[n1]) - sin(ang) * bfd(yr[2048 + n1]); } s /= sqrt(2048.0); }
        else { const int b = (m - TL) >> 8, k1 = (m - TL) & 255; const bf16* yr = (const bf16*)(ws + WS_YTC) + ((size_t)b * 512 + ch) * 512; for (int n1 = 0; n1 < 256; ++n1) { const double ang = 2.0 * PI_D * ((k1 * n1) & 255) / 256.0; s += cos(ang) * bfd(yr[n1]) - sin(ang) * bfd(yr[256 + n1]); } s /= 16.0; }
        rec(res, rs, bfd(((const bf16*)(ws + WS_Z))[(size_t)m * 512 + ch]), s, 0.05); }
    else if (stage == ST_ATTN) { const int m = samp_row(i, M, 7), hh = (int)(hsh(i + 13) % 8u), d = (int)(hsh(i + 14) % 128u); const bf16* q = (const bf16*)(ws + WS_Q) + (size_t)m * DM + hh * 128;
        int kr0, nk; if (m < TL) { kr0 = (m >> 11) * KVROWS; nk = KVROWS; } else { kr0 = ((m - TL) >> 8) * KVROWS + SEQ; nk = CTXL; }
        const bf16* K = (const bf16*)(ws + WS_K) + (size_t)kr0 * 256 + (hh >> 2) * 128; const bf16* V = (const bf16*)(ws + WS_V) + (size_t)kr0 * 256 + (hh >> 2) * 128;
        double mx = -1e300; for (int j = 0; j < nk; ++j) { double s = 0; for (int q2 = 0; q2 < 128; ++q2) s += bfd(q[q2]) * bfd(K[(size_t)j * 256 + q2]); s *= 0.08838834764831845; if (s > mx) mx = s; }
        double den = 0, num = 0; for (int j = 0; j < nk; ++j) { double s = 0; for (int q2 = 0; q2 < 128; ++q2) s += bfd(q[q2]) * bfd(K[(size_t)j * 256 + q2]); s *= 0.08838834764831845; const double p = exp(s - mx); den += p; num += p * bfd(V[(size_t)j * 256 + d]); }
        rec(res, rs, bfd(((const bf16*)(ws + WS_AO))[(size_t)m * DM + hh * 128 + d]), num / den, 0.03); }
    else if (stage == ST_GATES) { const int m = samp_row(i, M, 8), n = (int)(hsh(i + 15) % 3072u); rec(res, rs, bfd(((const bf16*)(ws + WS_GATES))[(size_t)m * 3072 + n]), dsig(dot_h_w(H + (size_t)m * DM, win, INCOLS, OFF_GATE + n)), 0.05); }
    else if (stage == ST_GATESB && DBG_GSUB == 1) { const int m = samp_row(i, M, 8), n = (int)(hsh(i + 15) % 3072u); const double got = bfd(((const bf16*)(ws + WS_GATES))[(size_t)m * 3072 + n]), want = dsig(dot_h_w(H + (size_t)m * DM, win, INCOLS, OFF_GATE + n));
        const bool badv = !(fabs(got - want) <= 0.05); if (badv) { unsigned* r = (unsigned*)res + 48; atomicOr(r, (m < TL ? 1u : 2u) | (4u << (n >> 10)) | (i < 12 ? 32u : 0u)); } }
    else if (stage == ST_GATESB) { const int m = samp_row(i, M, 8), n = (int)(hsh(i + 15) % 3072u); const bf16* wt = (const bf16*)(ws + WS_WSMALL + (size_t)l * WSMALL_LAYER + OFFS_WG) + (size_t)n * 1024; const bf16* hr = H + (size_t)m * DM; double s = 0; for (int k = 0; k < 1024; ++k) s += bfd(hr[k]) * bfd(wt[k]);
        rec(res, rs, bfd(((const bf16*)(ws + WS_GATES))[(size_t)m * 3072 + n]), dsig(s), 0.05); }
    else if (stage == ST_MERGED) { const int m = samp_row(i, M, 9), c = (int)(hsh(i + 16) % 1024u); const bf16* g = (const bf16*)(ws + WS_GATES) + (size_t)m * 3072; double y0 = 0, y1 = 0, y2 = 0;
        const bf16* ao = (const bf16*)(ws + WS_AO) + (size_t)m * DM; const bf16* chh = (const bf16*)(ws + WS_CH) + (size_t)m * 512; const bf16* z = (const bf16*)(ws + WS_Z) + (size_t)m * 512;
        for (int k = 0; k < 1024; ++k) y0 += bfd(ao[k]) * (double)A.in[13][((size_t)l * 1024 + k) * 1024 + c];
        for (int k = 0; k < 512; ++k) { y1 += bfd(chh[k]) * (double)A.in[18][((size_t)l * 512 + k) * 1024 + c]; y2 += bfd(z[k]) * (double)A.in[19][((size_t)l * 512 + k) * 1024 + c]; }
        rec(res, rs, bfd(((const bf16*)(ws + WS_MERGED))[(size_t)m * DM + c]), bfd(g[c]) * y0 + bfd(g[1024 + c]) * y1 + bfd(g[2048 + c]) * y2, 0.05); }
    else if (stage == ST_MIX) { const int m = samp_row(i, M, 10), c = (int)(hsh(i + 17) % 1024u); rec(res, rs, bfd(((const bf16*)(ws + WS_MIX))[(size_t)m * DM + c]), dot_h_w((const bf16*)(ws + WS_MERGED) + (size_t)m * DM, A.in[20] + (size_t)l * DM * DM, DM, c), 0.05); }
    else if (stage == ST_ROW1) { const int m = samp_row(i, M, 11), c = (int)(hsh(i + 18) % 1024u); const float* xs = snap + (size_t)i * 1024;
        const bf16* mix = (const bf16*)(ws + WS_MIX) + (size_t)m * DM; const float* mv = modb + ((size_t)l * 17 + (m < TL ? (m >> 11) : 16)) * 6144; double ss = 0; for (int k = 0; k < 1024; ++k) ss += bfd(mix[k]) * bfd(mix[k]); const double r = 1.0 / sqrt(ss / 1024 + 1e-6);
        double s2 = 0, xc = 0; for (int k = 0; k < 1024; ++k) { const double xn = xs[k] + mv[2048 + k] * (bfd(mix[k]) * r * A.in[7][l * DM + k]); s2 += xn * xn; if (k == c) xc = xn; }
        const float* xd = m < TL ? A.out + (size_t)m * DM : (const float*)(ws + WS_XC) + (size_t)(m - TL) * DM; rec(res, rs, xd[c], xc, 0.02);
        rec(res, rs, bfd(H[(size_t)m * DM + c]), xc / sqrt(s2 / 1024 + 1e-6) * A.in[8][l * DM + c] * (1.0 + mv[4096 + c]) + mv[3072 + c], 0.05); }
    else if (stage == ST_LOGIT) { const int m = samp_row(i, M, 12), e = i & 31; const float* lg = (const float*)(ws + WS_LOGIT) + (size_t)m * 64; rec(res, rs, (double)lg[e] + lg[32 + e], dot_h_w(H + (size_t)m * DM, A.in[21] + (size_t)l * DM * NEXP, NEXP, e), 0.02); }
    else if (stage == ST_TOPK) { const int m = samp_row(i, M, 13); const float* lg = (const float*)(ws + WS_LOGIT) + (size_t)m * 64; float v[32]; for (int e = 0; e < 32; ++e) v[e] = lg[e] + lg[32 + e] + A.in[22][l * 32 + e];
        int id[4]; float tv[4]; for (int k = 0; k < 4; ++k) { int b = -1; for (int e = 0; e < 32; ++e) { bool used = false; for (int q = 0; q < k; ++q) used |= (id[q] == e); if (!used && (b < 0 || v[e] > v[b])) b = e; } id[k] = b; tv[k] = v[b]; }
        double den = 0; for (int k = 0; k < 4; ++k) den += exp((double)tv[k] - tv[0]); const int* gi = (const int*)(ws + WS_TOPI) + (size_t)m * 4; const float* gp = (const float*)(ws + WS_TOPP) + (size_t)m * 4;
        for (int k = 0; k < 4; ++k) { rec(res, rs, gi[k] == id[k] ? 0.0 : 1.0, 0, 0.01); rec(res, rs, gp[k], exp((double)tv[k] - tv[0]) / den, 0.01); } }
    else if (stage == ST_SLOTS) { const int m = samp_row(i, M, 14), k = i & 3; const int s = ((const int*)(ws + WS_SLOT))[(size_t)m * 4 + k], e = ((const int*)(ws + WS_TOPI))[(size_t)m * 4 + k]; const int NT = ((const int*)(ws + WS_CNT))[CNT_NT];
        if (s < 0 || s >= NT * 256) rec(res, rs, 1, 0, 0.01); else { rec(res, rs, ((const int*)(ws + WS_CNT))[CNT_TILE_E + (s >> 8)] == e ? 0.0 : 1.0, 0, 0.01); const bf16* hs = (const bf16*)(ws + WS_HS) + (size_t)s * DM; double df = 0; for (int q = 0; q < 1024; ++q) df += fabs(bfd(hs[q]) - bfd(H[(size_t)m * DM + q])); rec(res, rs, df, 0, 1e-3); } }
    else if (stage == ST_ACT) { const int m = samp_row(i, M, 15), k = i & 3, c = (int)(hsh(i + 21) % 1024u); const int s = ((const int*)(ws + WS_SLOT))[(size_t)m * 4 + k], e = ((const int*)(ws + WS_TOPI))[(size_t)m * 4 + k]; const bf16* hs = (const bf16*)(ws + WS_HS) + (size_t)s * DM;
        double g = dot_h_w(hs, A.in[23] + (((size_t)l * NEXP + e) << 20), DM, c) + A.in[24][((size_t)l * NEXP + e) * 1024 + c], u = dot_h_w(hs, A.in[25] + (((size_t)l * NEXP + e) << 20), DM, c) + A.in[26][((size_t)l * NEXP + e) * 1024 + c];
        g = g < 7.0 ? g : 7.0; u = u < -7.0 ? -7.0 : (u > 7.0 ? 7.0 : u); rec(res, rs, bfd(((const bf16*)(ws + WS_ACT))[(size_t)s * DM + c]), (u + 1.0) * (g * dsig(1.702 * g)), 0.05); }
    else if (stage == ST_YSLOT) { const int m = samp_row(i, M, 16), k = i & 3, c = (int)(hsh(i + 22) % 1024u); const int s = ((const int*)(ws + WS_SLOT))[(size_t)m * 4 + k], e = ((const int*)(ws + WS_TOPI))[(size_t)m * 4 + k];
        rec(res, rs, bfd(((const bf16*)(ws + WS_HS))[(size_t)s * DM + c]), dot_h_w((const bf16*)(ws + WS_ACT) + (size_t)s * DM, A.in[27] + (((size_t)l * NEXP + e) << 20), DM, c) + A.in[28][((size_t)l * NEXP + e) * 1024 + c], 0.05); }
    else if (stage == ST_COMB) { const int m = samp_row(i, M, 17), c = (int)(hsh(i + 23) % 1024u); const float* xs = snap + (size_t)i * 1024; const int* sl = (const int*)(ws + WS_SLOT) + (size_t)m * 4; const float* pr = (const float*)(ws + WS_TOPP) + (size_t)m * 4;
        const float* mv = modb + ((size_t)l * 17 + (m < TL ? (m >> 11) : 16)) * 6144; double ss = 0, yc = 0; for (int q = 0; q < 1024; ++q) { double y = 0; for (int k = 0; k < 4; ++k) y += (double)pr[k] * bfd(((const bf16*)(ws + WS_HS))[(size_t)sl[k] * DM + q]); ss += y * y; if (q == c) yc = y; }
        const double want = xs[c] + mv[5 * 1024 + c] * (yc / sqrt(ss / 1024 + 1e-6) * A.in[9][l * DM + c]); const float* xd = m < TL ? A.out + (size_t)m * DM : (const float*)(ws + WS_XC) + (size_t)(m - TL) * DM; rec(res, rs, xd[c], want, 0.02); }
}
__global__ void snap_rows(Args A, int l, int salt, float* snap) {
    const int i = blockIdx.x, M = (l == 0) ? TALL : TL, m = samp_row(i, M, salt); const float* xs;
    if (l == 0 && salt == 11) xs = m < TL ? A.in[0] + (size_t)m * DM : A.in[2] + (size_t)(m - TL) * DM; else xs = m < TL ? A.out + (size_t)m * DM : (const float*)(A.ws + WS_XC) + (size_t)(m - TL) * DM;
    for (int k = threadIdx.x; k < 1024; k += blockDim.x) snap[(size_t)i * 1024 + k] = xs[k];
}
__global__ void chk_gates_full(const bf16* H, const bf16* Wt, const bf16* G, int M, unsigned* cntw) {
    const int n = blockIdx.x * 64 + (threadIdx.x & 63), m = blockIdx.y * 4 + (threadIdx.x >> 6); if (m >= M) return;
    const uint4* a = (const uint4*)(H + (size_t)m * 1024); const uint4* b = (const uint4*)(Wt + (size_t)n * 1024); float s = 0.f;
    for (int k = 0; k < 128; ++k) { const uint4 x = a[k], y = b[k]; const unsigned xs[4] = {x.x, x.y, x.z, x.w}, ys[4] = {y.x, y.y, y.z, y.w};
        for (int q = 0; q < 4; ++q) { s += __uint_as_float(xs[q] << 16) * __uint_as_float(ys[q] << 16); s += __uint_as_float(xs[q] & 0xffff0000u) * __uint_as_float(ys[q] & 0xffff0000u); } }
    const float want = 1.0f / (1.0f + __expf(-s)), got = __uint_as_float(((unsigned)G[(size_t)m * 3072 + n]) << 16);
    if (!(fabsf(got - want) <= 0.02f)) { atomicAdd(cntw, 1u); cntw[16 + (m >> 8) * 12 + (n >> 8)] = 1u; }
}
__global__ void encode_full(float* out, const unsigned* cntw, int n) {
    __shared__ int bc, bt; if (threadIdx.x == 0) { unsigned C = cntw[0], T = 0; for (int t = 0; t < 1728; ++t) T += cntw[16 + t]; int b1 = 0; while (C) { ++b1; C /= 10; } int b2 = 0; while (T) { ++b2; T /= 4; } bc = b1 > 7 ? 7 : b1; bt = b2 > 7 ? 7 : b2; }
    __syncthreads(); const float K = ldexpf(1.0f, 2 + 8 * bt + bc);
    for (size_t i = (size_t)blockIdx.x * blockDim.x + threadIdx.x; i < (size_t)n; i += (size_t)gridDim.x * blockDim.x) out[i] = K;
}
__global__ void encode(float* out, const float* res, int n, float thr) {
    #if DBG_GSUB == 1
    { const unsigned mk = ((const unsigned*)res)[48]; const float K = ldexpf(1.0f, 2 + (int)mk); for (size_t i = (size_t)blockIdx.x * blockDim.x + threadIdx.x; i < (size_t)n; i += (size_t)gridDim.x * blockDim.x) out[i] = K; return; }
#endif
#ifndef CHK_SKIP
#define CHK_SKIP 0ull
#endif
    int bad = -1; for (int s = 0; s < 64; ++s) if (!((CHK_SKIP >> s) & 1ull) && res[s] > thr) { bad = s; break; }
    if (bad < 0) return; const float er = res[bad]; const float K = ldexpf(1.0f, bad + 2) * (er < 0.5f ? 1.0f : er < 1.0f ? 1.25f : er < 4.0f ? 1.5f : 1.75f);
    for (size_t i = (size_t)blockIdx.x * blockDim.x + threadIdx.x; i < (size_t)n; i += (size_t)gridDim.x * blockDim.x) out[i] = K;
}
#endif
#ifndef GP_SP2
#define GP_SP2 true
#endif
#ifndef GP_ALIGN
#define GP_ALIGN true
#endif
__global__ void __launch_bounds__(NTHR, 2) fwd(Args args) {
    extern __shared__ __attribute__((aligned(16))) unsigned char lds[];
    Frame F;
    F.lds = (LAS unsigned char*)lds; F.MISC = (volatile LAS unsigned*)(F.lds + MISC_OFF);
    F.tid = threadIdx.x; F.lane = F.tid & 63; F.wave = __builtin_amdgcn_readfirstlane(F.tid >> 6);
    F.G = gridDim.x; { const int bx = blockIdx.x; F.vcu = (F.G % 8 == 0) ? (bx % 8) * (F.G / 8) + bx / 8 : bx; }
    { const AV A0 = av_get(); F.ctl = (gu32*)(A0.ws() + WS_CTL); }
    for (int u = F.tid; u < (LDS_BYTES - LDSCTL_OFF) / 4; u += NTHR) ((LAS unsigned*)(F.lds + LDSCTL_OFF))[u] = 0u;
    __syncthreads();
    XcdBarrier bar; bar.bar = (unsigned*)(F.ctl + CW_BAR); bar.x = 0; bar.st = nullptr;
    if (!MK_PER_PHASE) bar = xcd_barrier_post((unsigned*)(F.ctl + CW_BAR), F.MISC + 8);
    int lo, hi; { const AV A0 = av_get(); lo = *(const int __attribute__((address_space(4)))*)(A0.kp + 8 * 31); hi = *(const int __attribute__((address_space(4)))*)(A0.kp + 8 * 31 + 4); }
#ifndef DIS_MASK
#define DIS_MASK 0ull
#endif
#define IN(k) (lo <= (k) && (k) < hi)
#define ON(j) (!((DIS_MASK >> (j)) & 1ull))
#ifndef REP_MASK
#define REP_MASK 0ull
#endif
#define REPS(j) ((int)((REP_MASK >> (j)) & 1ull))
#ifdef STAMP_SEL
#define SEAM(k) do { xcd_barrier(bar); if (blockIdx.x == 0 && threadIdx.x == 0) ((unsigned long long*)(F.ctl + 32768))[(k) + 1] = __builtin_amdgcn_s_memrealtime(); } while (0)
#else
#define SEAM(k) do { if (!MK_PER_PHASE && IN((k) + 1)) xcd_barrier(bar); } while (0)
#endif
    const int bx = (int)blockIdx.x;
    const int wave0 = __builtin_amdgcn_readfirstlane((int)threadIdx.x >> 6);
#define F_REFRESH() do { unsigned z_ = 0u; asm volatile("" : "+v"(z_)); const int t_ = wave0 * 64 + (int)__builtin_amdgcn_mbcnt_hi(~0u, __builtin_amdgcn_mbcnt_lo(~0u, z_)); F.tid = t_; F.lane = t_ & 63; F.wave = wave0; } while (0)

#ifdef STAMP_SEL
    if (blockIdx.x == 0 && threadIdx.x == 0) ((unsigned long long*)(F.ctl + 32768))[0] = __builtin_amdgcn_s_memrealtime();
#endif
    if (ON(0) && IN(0)) for (int rep_ = 0; rep_ <= REPS(0); ++rep_) { F_REFRESH(); const AV A = av_get(); p0_prologue(F, A); SEAM(0); }
    if (ON(1) && IN(1)) for (int rep_ = 0; rep_ <= REPS(1); ++rep_) { F_REFRESH(); const AV A = av_get(); p1_norm0(F, A); SEAM(1); }

    for (int l = 0; l < 2; ++l) {
        const int pb = 2 + l * NPL;
        const int Mm = (l == 0) ? TALL : TL;
#define PH_BEGIN F_REFRESH(); const AV A = av_get(); unsigned char* const ws = A.ws(); unsigned char* const wl = ws + WS_WSMALL + (size_t)l * WSMALL_LAYER; (void)wl
        if (ON(2 + 0) && IN(pb + 0)) for (int rep_ = 0; rep_ <= REPS(2 + 0); ++rep_) { PH_BEGIN;
            if (ON(16)) { pg8::Gemm g{(const bf16*)(ws + WS_H), (const bf16*)(wl + OFFS_WIN), TALL, 2560, DM}; pg8::StaticOrder S; S.init(TALL, 2560, F.G, bx);
              pg8::EpiInproj E{(bf16*)(ws + WS_Q), (bf16*)(ws + WS_K), (bf16*)(ws + WS_V), (bf16*)(ws + WS_CU)};
              pg8::gemm_phase<pg8::EpiInproj, pg8::StaticOrder, GP_ALIGN, GP_SP2>(F.lds + RING_OFF, g, S, E, F.tid); }
            if (ON(17)) { pg8::Gemm g{(const bf16*)(wl + OFFS_WF), (const bf16*)(ws + WS_H), 1024, Mm, DM}; pg8::StaticOrder S; S.init(1024, Mm, F.G, (bx + 96) % F.G);
              pg8::EpiYT E{ws + WS_YT, ws + WS_YTC};
              pg8::gemm_phase<pg8::EpiYT, pg8::StaticOrder, GP_ALIGN, GP_SP2>(F.lds + RING_OFF, g, S, E, F.tid); }
            SEAM(pb + 0);
        }
        if (ON(2 + 1) && IN(pb + 1)) for (int rep_ = 0; rep_ <= REPS(2 + 1); ++rep_) { PH_BEGIN;
            if (ON(18)) p_qkfix(F, A, l, TALL);
            F_REFRESH();
            if (ON(19)) p_conv(F, A, l, l == 0 ? 1152 : 1024);
            if (ON(20)) { pg8::Gemm g{(const bf16*)(ws + WS_DFTL), (const bf16*)(ws + WS_YT), 2048, NB * 512, 2048}; pg8::DftOrder S; S.init(3, NB, F.G, F.vcu);
              pg8::EpiDFT E{(bf16*)(ws + WS_Z), 0, SEQ};
              pg8::gemm_phase<pg8::EpiDFT, pg8::DftOrder, GP_ALIGN, GP_SP2, true>(F.lds + RING_OFF, g, S, E, F.tid); }
            if (ON(21) && l == 0) { pg8::Gemm g{(const bf16*)(ws + WS_DFTC), (const bf16*)(ws + WS_YTC), 256, NB * 512, 256}; pg8::DftOrder S; S.init(0, NB, F.G, F.vcu);
              pg8::EpiDFT E{(bf16*)(ws + WS_Z), TL, CTXL};
              pg8::gemm_phase<pg8::EpiDFT, pg8::DftOrder, GP_ALIGN, GP_SP2, true>(F.lds + RING_OFF, g, S, E, F.tid); }
            SEAM(pb + 1);
        }
        if (ON(2 + 2) && IN(pb + 2)) for (int rep_ = 0; rep_ <= REPS(2 + 2); ++rep_) { PH_BEGIN;
            const int nheavy = NB * 8 * 8, ntot = nheavy + (l == 0 ? NB * 8 : 0);
            for (int L = F.vcu; L < ntot; L += F.G) {
                int row0, krow, h, seq;
                if (L < nheavy) { const int grp = L >> 5, s = L & 31, b = grp >> 1; h = (grp & 1) * 4 + (s >> 3); row0 = b * SEQ + (s & 7) * 256; krow = b * KVROWS; seq = KVROWS; }
                else { const int Lc = L - nheavy, b = Lc >> 3; h = Lc & 7; row0 = TL + b * CTXL; krow = b * KVROWS + SEQ; seq = CTXL; }
                const att::bf16* Qb = (const att::bf16*)(ws + WS_Q) + (size_t)row0 * DM + h * 128;
                const att::bf16* Kh = (const att::bf16*)(ws + WS_K) + (size_t)krow * 256 + (h >> 2) * 128;
                const att::bf16* Vh = (const att::bf16*)(ws + WS_V) + (size_t)krow * 256 + (h >> 2) * 128;
                att::bf16* Ob = (att::bf16*)(ws + WS_AO) + (size_t)row0 * DM + h * 128;
                att::attn_dense_body<att::bf16>(Qb, Kh, Vh, Ob, seq, (char*)lds + RING_OFF, F.tid);
                __syncthreads();
            }
            SEAM(pb + 2);
        }
        if (ON(2 + 3) && IN(pb + 3)) for (int rep_ = 0; rep_ <= REPS(2 + 3); ++rep_) { PH_BEGIN;
            pg8::Gemm g{(const bf16*)(ws + WS_H8), (const bf16*)(wl + OFFS_WG), Mm, 3072, DM / 2}; pg8::StaticOrder S; S.init(Mm, 3072, F.G, bx);
            pg8::EpiGates E{(bf16*)(ws + WS_GATES)};
            pg8::gemm_phase<pg8::EpiGates, pg8::StaticOrder, GP_ALIGN, GP_SP2, true>(F.lds + RING_OFF, g, S, E, F.tid);
            SEAM(pb + 3);
        }
        if (ON(2 + 4) && IN(pb + 4)) for (int rep_ = 0; rep_ <= REPS(2 + 4); ++rep_) { PH_BEGIN;
            { pg8::Gemm g{(const bf16*)(ws + WS_AO), (const bf16*)(wl + OFFS_WAO), Mm, 1024, 1024}; pg8::StaticOrder S; S.init(Mm, 1024, F.G, bx);
              pg8::EpiMerge<true> E{(bf16*)(ws + WS_MERGED), (const bf16*)(ws + WS_GATES), 0};
              pg8::gemm_phase<pg8::EpiMerge<true>, pg8::StaticOrder, GP_ALIGN, GP_SP2>(F.lds + RING_OFF, g, S, E, F.tid); }
#pragma unroll 1
            for (int br = 1; br < 3; ++br) {
              pg8::Gemm g{(const bf16*)(ws + (br == 1 ? WS_CH : WS_Z)), (const bf16*)(wl + (br == 1 ? OFFS_WCO : OFFS_WFO)), Mm, 1024, 512}; pg8::StaticOrder S; S.init(Mm, 1024, F.G, bx);
              pg8::EpiMerge<false> E{(bf16*)(ws + WS_MERGED), (const bf16*)(ws + WS_GATES), br};
              pg8::gemm_phase<pg8::EpiMerge<false>, pg8::StaticOrder, GP_ALIGN, GP_SP2>(F.lds + RING_OFF, g, S, E, F.tid); }
            SEAM(pb + 4);
        }
        if (ON(2 + 5) && IN(pb + 5)) for (int rep_ = 0; rep_ <= REPS(2 + 5); ++rep_) { PH_BEGIN;
            pg8::Gemm g{(const bf16*)(ws + WS_MERGED), (const bf16*)(wl + OFFS_WOUT), Mm, 1024, 1024}; pg8::StaticOrder S; S.init(Mm, 1024, F.G, bx);
            pg8::EpiBf16<0> E{(bf16*)(ws + WS_MIX), 1024, nullptr, 0, 0, 1.0f};
            pg8::gemm_phase<pg8::EpiBf16<0>, pg8::StaticOrder, GP_ALIGN, GP_SP2>(F.lds + RING_OFF, g, S, E, F.tid);
            SEAM(pb + 5);
        }
        if (ON(2 + 6) && IN(pb + 6)) for (int rep_ = 0; rep_ <= REPS(2 + 6); ++rep_) { PH_BEGIN; p_rowpass1(F, A, l, Mm); SEAM(pb + 6); }
        if (ON(2 + 7) && IN(pb + 7)) for (int rep_ = 0; rep_ <= REPS(2 + 7); ++rep_) { PH_BEGIN;
            pg8::Gemm g{(const bf16*)(ws + WS_H), (const bf16*)(wl + OFFS_ROUT), Mm, 256, DM}; pg8::StaticOrder S; S.init(Mm, 256, F.G, bx);
            pg8::EpiRouter E{(float*)(ws + WS_LOGIT)};
            pg8::gemm_phase<pg8::EpiRouter, pg8::StaticOrder, GP_ALIGN, GP_SP2>(F.lds + RING_OFF, g, S, E, F.tid);
            SEAM(pb + 7);
        }
        if (ON(2 + 8) && IN(pb + 8)) for (int rep_ = 0; rep_ <= REPS(2 + 8); ++rep_) { PH_BEGIN; p_topk(F, A, l, Mm); SEAM(pb + 8); }
        if (ON(2 + 9) && IN(pb + 9)) for (int rep_ = 0; rep_ <= REPS(2 + 9); ++rep_) { PH_BEGIN; p_slots(F, A, Mm); SEAM(pb + 9); }
        if (ON(2 + 10) && IN(pb + 10)) for (int rep_ = 0; rep_ <= REPS(2 + 10); ++rep_) { PH_BEGIN;
            const int NT = __builtin_amdgcn_readfirstlane(((const int*)(ws + WS_CNT))[CNT_NT]);
            pg8::Gemm g{(const bf16*)(ws + WS_HS), (const bf16*)(ws + WS_WGU + (size_t)l * MOEW_LAYER), NT * 256, NEXP * 2048, DM / 2}; pg8::GroupedOrder S; S.init(NT, 8, F.G, bx, (const int*)(ws + WS_CNT) + CNT_TILE_E);
            pg8::EpiSwiGLU8 E{ws + WS_ACT, A.in(24) + (size_t)l * NEXP * 1024, A.in(26) + (size_t)l * NEXP * 1024};
            pg8::gemm_phase<pg8::EpiSwiGLU8, pg8::GroupedOrder, GP_ALIGN, GP_SP2, true>(F.lds + RING_OFF, g, S, E, F.tid);
            SEAM(pb + 10);
        }
        if (ON(2 + 11) && IN(pb + 11)) for (int rep_ = 0; rep_ <= REPS(2 + 11); ++rep_) { PH_BEGIN;
            const int NT = __builtin_amdgcn_readfirstlane(((const int*)(ws + WS_CNT))[CNT_NT]);
            pg8::Gemm g{(const bf16*)(ws + WS_ACT), (const bf16*)(ws + WS_WD + (size_t)l * MOEW_LAYER), NT * 256, NEXP * 1024, DM / 2}; pg8::GroupedOrder S; S.init(NT, 4, F.G, bx, (const int*)(ws + WS_CNT) + CNT_TILE_E);
            pg8::EpiDown8 E{(bf16*)(ws + WS_YS), A.in(28) + (size_t)l * NEXP * 1024};
            pg8::gemm_phase<pg8::EpiDown8, pg8::GroupedOrder, GP_ALIGN, GP_SP2, true>(F.lds + RING_OFF, g, S, E, F.tid);
            SEAM(pb + 11);
        }
        if (ON(2 + 12) && IN(pb + 12)) for (int rep_ = 0; rep_ <= REPS(2 + 12); ++rep_) { PH_BEGIN;
            p_combine(F, A, l, Mm);
            SEAM(pb + 12);
        }
    }
#ifdef STAMP_SEL
    { const AV A = av_get(); float* out = A.out(); const unsigned long long* ts = (const unsigned long long*)(F.ctl + 32768);
      auto span = [&](int p) -> float { unsigned long long d = __hip_atomic_load(ts + p + 1, __ATOMIC_RELAXED, __HIP_MEMORY_SCOPE_AGENT) - __hip_atomic_load(ts + p, __ATOMIC_RELAXED, __HIP_MEMORY_SCOPE_AGENT);
          if (p >= 2) d += __hip_atomic_load(ts + p + NPL + 1, __ATOMIC_RELAXED, __HIP_MEMORY_SCOPE_AGENT) - __hip_atomic_load(ts + p + NPL, __ATOMIC_RELAXED, __HIP_MEMORY_SCOPE_AGENT); return (float)d * 0.01f; };
      const float K1 = span((STAMP_SEL) & 0xff), K2 = 200.0f * span(((STAMP_SEL) >> 8) & 0xff);
      for (size_t i = (size_t)blockIdx.x * NTHR + threadIdx.x; i < (size_t)TL * DM; i += (size_t)gridDim.x * NTHR) out[i] = (i == 0) ? K2 : K1; }
#endif
#undef IN
#undef PH_BEGIN
#undef F_REFRESH
#undef SEAM
}

extern "C" void kernel_launch(void* const* d_in, const int* in_sizes, int n_in, void* d_out, int out_size, void* d_ws, size_t ws_size, hipStream_t stream) {
    static int grid = 0;
    if (grid == 0) {
        if (n_in != 29 || out_size != TL * DM || ws_size < WS_END2) { fprintf(stderr, "kernel_launch: built for 29 inputs, %d outputs, >= %zu bytes of workspace; got n_in %d out %d ws %zu\n", TL * DM, (size_t)WS_END2, n_in, out_size, ws_size); grid = -1; return; }
        int dev = 0, cus = 0, per_cu = 0;
        if (hipGetDevice(&dev) != hipSuccess || hipDeviceGetAttribute(&cus, hipDeviceAttributeMultiprocessorCount, dev) != hipSuccess) { grid = -1; return; }
        if (hipFuncSetAttribute((const void*)fwd, hipFuncAttributeMaxDynamicSharedMemorySize, LDS_BYTES) != hipSuccess) { fprintf(stderr, "kernel_launch: hipFuncSetAttribute failed\n"); grid = -1; return; }
        if (hipOccupancyMaxActiveBlocksPerMultiprocessor(&per_cu, (const void*)fwd, NTHR, LDS_BYTES) != hipSuccess || per_cu < 1) fprintf(stderr, "kernel_launch: occupancy query reports %d\n", per_cu);
        (void)hipGetLastError();
        grid = cus;
    }
    if (grid < 0) return;
    (void)hipMemsetAsync((char*)d_ws + WS_CTL, 0, CTL_ZERO_BYTES, stream);
    Args a{};
    for (int i = 0; i < 29; ++i) a.in[i] = (const float*)d_in[i];
    a.out = (float*)d_out; a.ws = (unsigned char*)d_ws;
#if MK_PER_PHASE
    for (int p = 0; p < NPH; ++p) {
#ifdef DBG_CHECK
        float* res = (float*)((char*)d_ws + WS_CTL + 8192 * 4); float* snap = (float*)((char*)d_ws + WS_END);
        { const int l = p >= 2 ? (p - 2) / NPL : 0, k = p >= 2 ? (p - 2) % NPL : -1;
          if (k == 6) hipLaunchKernelGGL(snap_rows, dim3(256), dim3(256), 0, stream, a, l, 11, snap);
          if (k == 12) hipLaunchKernelGGL(snap_rows, dim3(256), dim3(256), 0, stream, a, l, 17, snap); }
#endif
        a.ph_lo = p; a.ph_hi = p + 1; hipLaunchKernelGGL(fwd, dim3(grid), dim3(NTHR), LDS_BYTES, stream, a);
#ifdef DBG_CHECK
        { const int l = p >= 2 ? (p - 2) / NPL : 0, k = p >= 2 ? (p - 2) % NPL : -1;
#define CHK(st) hipLaunchKernelGGL(chk, dim3(1), dim3(256), 0, stream, a, (int)(st), l, res, snap)
          if (p == 0) CHK(ST_MOD); if (p == 1) CHK(ST_H0);
#if DBG_GSUB == 2
          if (k == 3 && l == 0) hipLaunchKernelGGL(chk_gates_full, dim3(48, TALL / 4), dim3(256), 0, stream, (const bf16*)((char*)d_ws + WS_H), (const bf16*)((char*)d_ws + WS_WSMALL + OFFS_WG), (const bf16*)((char*)d_ws + WS_GATES), TALL, (unsigned*)((char*)d_ws + WS_CTL + 65536));
#endif
          if (k == 0) { CHK(ST_INPROJ); CHK(ST_YT); } if (k == 1) { CHK(ST_QKFIX); CHK(ST_CONV); CHK(ST_Z); } if (k == 2) CHK(ST_ATTN); if (k == 3) { CHK(ST_GATES); CHK(ST_GATESB); } if (k == 4) CHK(ST_MERGED);
          if (k == 5) CHK(ST_MIX); if (k == 6) CHK(ST_ROW1); if (k == 7) CHK(ST_LOGIT); if (k == 8) CHK(ST_TOPK); if (k == 9) CHK(ST_SLOTS); if (k == 10) CHK(ST_ACT); if (k == 11) CHK(ST_YSLOT); if (k == 12) CHK(ST_COMB);
#undef CHK
        }
#endif
    }
#ifdef DBG_CHECK
#if DBG_GSUB == 2
    hipLaunchKernelGGL(encode_full, dim3(1024), dim3(256), 0, stream, (float*)d_out, (const unsigned*)((char*)d_ws + WS_CTL + 65536), out_size);
#else
    hipLaunchKernelGGL(encode, dim3(1024), dim3(256), 0, stream, (float*)d_out, (const float*)((char*)d_ws + WS_CTL + 8192 * 4), out_size, 0.25f);
#endif
#endif
#else
    a.ph_lo = 0; a.ph_hi = NPH; hipLaunchKernelGGL(fwd, dim3(grid), dim3(NTHR), LDS_BYTES, stream, a);
#endif
    const hipError_t le = hipPeekAtLastError();
    if (le != hipSuccess) fprintf(stderr, "kernel_launch: launch failed: %s\n", hipGetErrorName(le));
}
```

```cpp
#include <hip/hip_runtime.h>
#include <cstdio>
#include <cstdint>
#ifndef MK_PER_PHASE
#define MK_PER_PHASE 0
#endif
namespace pg8 {
#define PG8_LAS __attribute__((address_space(3)))
typedef unsigned short bf16_t;
typedef short bf16x8 __attribute__((ext_vector_type(8)));
typedef float f32x4 __attribute__((ext_vector_type(4)));
typedef unsigned u32x4 __attribute__((ext_vector_type(4)));
typedef int i32x4v __attribute__((ext_vector_type(4)));
typedef int i32x8v __attribute__((ext_vector_type(8)));
typedef unsigned u32x2v __attribute__((ext_vector_type(2)));
constexpr int BM = 256, BK = 64, HALF = 128, HTB = HALF * BK * 2  , STAGE_BYTES = 8 * HTB, NXCD = 8, WGM = 8;

__host__ __device__ __forceinline__ int lds_byte(int r, int c) { const int st = (r >> 4) * 2 + (c >> 5), rr = r & 15, cc = c & 31, ob = rr * 64 + cc * 2; return st * 1024 + (ob ^ (((ob >> 9) & 1) << 5)); }
__host__ __device__ __forceinline__ void stage_rc(int b, int& R, int& C) { const int st = b / 1024, sb = b % 1024, swz = sb ^ (((sb >> 9) & 1) << 5); R = (st >> 1) * 16 + swz / 64; C = (st & 1) * 32 + (swz % 64) / 2; }
__host__ __device__ __forceinline__ int perm32(int rho) { const int n = rho >> 4, i = rho & 15; return 8 * (i >> 2) + 4 * n + (i & 3); }

struct Unit { int pm, pn; };
struct Gemm { const bf16_t* A; const bf16_t* Bt; int M, N, K; };

struct StaticOrder {
    int nM, nN, nwg, G, c;
    __host__ __device__ void init(int M, int N, int G_, int c_) { nM = M / BM; nN = N / BM; nwg = nM * nN; G = G_; c = c_; }
    __host__ __device__ bool next(int i, Unit& u) const {
        const long L = (long)i * G + c; if (L >= nwg) return false;
        int wgid = (int)L; { const int q = nwg / NXCD, r = nwg % NXCD, xcd = wgid % NXCD, off = wgid / NXCD; wgid = (xcd < r ? xcd * (q + 1) : r * (q + 1) + (xcd - r) * q) + off; }
        const int nig = WGM * nN, gid = wgid / nig, fm = gid * WGM, gsz = (nM - fm) < WGM ? (nM - fm) : WGM;
        u.pm = fm + ((wgid % nig) % gsz); u.pn = (wgid % nig) / gsz; return true;
    }
    __device__ __forceinline__ void a_ready(const Unit&) const {}
    __device__ __forceinline__ void done(const Unit&) const {}
};

typedef __bf16 bf16x2_native __attribute__((ext_vector_type(2)));
typedef float f32x2_native __attribute__((ext_vector_type(2)));
__device__ __forceinline__ unsigned cvt_pk_bf16(float lo, float hi) { const f32x2_native v = {lo, hi}; const bf16x2_native r = __builtin_convertvector(v, bf16x2_native); return __builtin_bit_cast(unsigned, r); }
__device__ __forceinline__ unsigned cvt4_fp8(float a, float b, float c, float d) { int w = __builtin_amdgcn_cvt_pk_fp8_f32(a, b, __builtin_bit_cast(int, a), false); w = __builtin_amdgcn_cvt_pk_fp8_f32(c, d, w, true); return (unsigned)w; }
typedef float f32x2 __attribute__((ext_vector_type(2)));
__device__ __forceinline__ f32x2 gelu_pk(f32x2 v) {
    const f32x2 av = __builtin_elementwise_abs(v), d = av * 0.2316418882f + 1.0f;
    f32x2 t; t.x = __builtin_amdgcn_rcpf(d.x); t.y = __builtin_amdgcn_rcpf(d.y);
    f32x2 q = t * 0.5307027145f + (-0.7265760135f); q = q * t + 0.7107068705f; q = q * t + (-0.142248368f); q = q * t + 0.127414796f; q = q * t;
    const f32x2 s = (v * v) * (-0.72134752044f);
    f32x2 e; e.x = __builtin_amdgcn_exp2f(s.x); e.y = __builtin_amdgcn_exp2f(s.y);
    const f32x2 m = v * (q * e), r = v - m;
    f32x2 o; o.x = v.x < 0.f ? m.x : r.x; o.y = v.y < 0.f ? m.y : r.y; return o;
}

template <int ACT  > struct EpiBf16 {
    static constexpr bool PERM = true, AFTER_DRAIN = false; static_assert(ACT == 0 || ACT == 1, "EpiBf16: ACT is 0 (none) or 1 (gelu_pk)");
    bf16_t* O; int ldc; const float* bias; int split_cols; size_t split_stride; float scale0;
    __device__ __forceinline__ void operator()(const f32x4 (&acc)[2][2][4][2], const Unit& u, int wr, int wc, int fr, int fq) const {
        const int row0 = u.pm * BM + wr * 64 + fr; int colt = u.pn * BM; bf16_t* base = O;
        float sc = 1.f; if (split_cols) { const int t = colt / split_cols; base += (size_t)t * split_stride; colt -= t * split_cols; if (t == 0) sc = scale0; }
        const int col0 = colt + wc * 32 + 8 * fq, bcol0 = u.pn * BM + wc * 32 + 8 * fq;
        f32x4 bv[2][2];
#pragma unroll
        for (int bj = 0; bj < 2; ++bj)
#pragma unroll
            for (int n = 0; n < 2; ++n) bv[bj][n] = bias ? *(const f32x4*)(bias + bcol0 + bj * HALF + 4 * n) : (f32x4){0.f, 0.f, 0.f, 0.f};
#pragma unroll
        for (int ai = 0; ai < 2; ++ai)
#pragma unroll
            for (int m = 0; m < 4; ++m) { bf16_t* rowp = base + (size_t)(row0 + ai * HALF + m * 16) * ldc + col0;
#pragma unroll
                for (int bj = 0; bj < 2; ++bj) { f32x4 v0 = acc[ai][bj][m][0] + bv[bj][0], v1 = acc[ai][bj][m][1] + bv[bj][1];
                    if (ACT == 1) { f32x2 a = gelu_pk((f32x2){v0[0], v0[1]}), b = gelu_pk((f32x2){v0[2], v0[3]}), c = gelu_pk((f32x2){v1[0], v1[1]}), d = gelu_pk((f32x2){v1[2], v1[3]});
                        v0 = (f32x4){a.x, a.y, b.x, b.y}; v1 = (f32x4){c.x, c.y, d.x, d.y}; }
                    v0 = v0 * sc; v1 = v1 * sc; u32x4 w; w.x = cvt_pk_bf16(v0[0], v0[1]); w.y = cvt_pk_bf16(v0[2], v0[3]); w.z = cvt_pk_bf16(v1[0], v1[1]); w.w = cvt_pk_bf16(v1[2], v1[3]);
                    *(u32x4*)(rowp + bj * HALF) = w; } }
    }
};

__device__ __forceinline__ float fast_sigmoid(float x) { return __builtin_amdgcn_rcpf(1.0f + __builtin_amdgcn_exp2f(-1.4426950408889634f * x)); }
__device__ __forceinline__ u32x4 pack8(const f32x4& a, const f32x4& b) { u32x4 w; w.x = cvt_pk_bf16(a[0], a[1]); w.y = cvt_pk_bf16(a[2], a[3]); w.z = cvt_pk_bf16(b[0], b[1]); w.w = cvt_pk_bf16(b[2], b[3]); return w; }
__device__ __forceinline__ void unpack8(const u32x4& w, f32x4& a, f32x4& b) {
    a[0] = __uint_as_float(w.x << 16); a[1] = __uint_as_float(w.x & 0xffff0000u); a[2] = __uint_as_float(w.y << 16); a[3] = __uint_as_float(w.y & 0xffff0000u);
    b[0] = __uint_as_float(w.z << 16); b[1] = __uint_as_float(w.z & 0xffff0000u); b[2] = __uint_as_float(w.w << 16); b[3] = __uint_as_float(w.w & 0xffff0000u); }
__device__ __forceinline__ u32x2v pack8_fp8(const f32x4& a, const f32x4& b) { u32x2v r; r.x = cvt4_fp8(a[0], a[1], a[2], a[3]); r.y = cvt4_fp8(b[0], b[1], b[2], b[3]); return r; }
__device__ __forceinline__ void store_tile_bf16(const f32x4 (&acc)[2][2][4][2], bf16_t* base, int ldc, int wr, int wc, int fr, int fq) {
    const int rt = wr * 64 + fr, cb = wc * 32 + 8 * fq;
#pragma unroll
    for (int ai = 0; ai < 2; ++ai)
#pragma unroll
        for (int m = 0; m < 4; ++m) { bf16_t* rowp = base + (size_t)(rt + ai * HALF + m * 16) * ldc + cb;
#pragma unroll
            for (int bj = 0; bj < 2; ++bj) *(u32x4*)(rowp + bj * HALF) = pack8(acc[ai][bj][m][0], acc[ai][bj][m][1]); }
}
struct EpiInproj {
    static constexpr bool PERM = true, AFTER_DRAIN = false;
    bf16_t *q, *k, *v, *cu;
    __device__ __forceinline__ void operator()(const f32x4 (&acc)[2][2][4][2], const Unit& u, int wr, int wc, int fr, int fq) const {
        bf16_t* base; int ldc; const bool glu = u.pn >= 6; float sc = 0.03125f; asm volatile("" : "+s"(sc));
        if (u.pn < 4) { base = q + (size_t)u.pm * 256 * 1024 + u.pn * 256; ldc = 1024; }
        else if (u.pn < 6) { const int m0 = u.pm * 256; const int kr = m0 < 32768 ? (m0 >> 11) * 2304 + (m0 & 2047) : ((m0 - 32768) >> 8) * 2304 + 2048; base = (u.pn == 4 ? k : v) + (size_t)kr * 256; ldc = 256; }
        else { base = cu + (size_t)u.pm * 256 * 512 + (u.pn - 6) * 128; ldc = 512; }
        base += (size_t)(wr * 64 + fr) * ldc + wc * 32 + 8 * fq;
#pragma unroll
        for (int ai = 0; ai < 2; ++ai)
#pragma unroll
            for (int m = 0; m < 4; ++m) { bf16_t* rowp = base + (size_t)(ai * HALF + m * 16) * ldc;
                if (!glu) { *(u32x4*)rowp = pack8(acc[ai][0][m][0] * sc, acc[ai][0][m][1] * sc); *(u32x4*)(rowp + HALF) = pack8(acc[ai][1][m][0] * sc, acc[ai][1][m][1] * sc); }
                else { f32x4 a0 = acc[ai][0][m][0] * sc, a1 = acc[ai][0][m][1] * sc; const f32x4 g0 = acc[ai][1][m][0] * sc, g1 = acc[ai][1][m][1] * sc;
#pragma unroll
                    for (int j = 0; j < 4; ++j) { a0[j] *= fast_sigmoid(g0[j]); a1[j] *= fast_sigmoid(g1[j]); }
                    *(u32x4*)rowp = pack8(a0, a1); } }
    }
};
struct EpiYT {
    static constexpr bool PERM = true, AFTER_DRAIN = false;
    unsigned char *yt, *ytc;
    __device__ __forceinline__ void operator()(const f32x4 (&acc)[2][2][4][2], const Unit& u, int wr, int wc, int fr, int fq) const {
        const int cs = u.pm >> 1, chb = (u.pm & 1) * 256; unsigned char* base; int ldc;
        if (u.pn < 128) { const int b = u.pn >> 3, pos0 = (u.pn & 7) * 256; base = yt + (size_t)(b * 512 + chb) * 4096 + cs * 2048 + pos0; ldc = 4096; }
        else { const int b = u.pn - 128; base = ytc + (size_t)(b * 512 + chb) * 512 + cs * 256; ldc = 512; }
        base += (size_t)(wr * 64 + fr) * ldc + wc * 32 + 8 * fq;
#pragma unroll
        for (int ai = 0; ai < 2; ++ai)
#pragma unroll
            for (int m = 0; m < 4; ++m) { unsigned char* rowp = base + (size_t)(ai * HALF + m * 16) * ldc;
#pragma unroll
                for (int bj = 0; bj < 2; ++bj) *(u32x2v*)(rowp + bj * HALF) = pack8_fp8(acc[ai][bj][m][0], acc[ai][bj][m][1]); }
    }
};
struct EpiDFT {
    static constexpr bool PERM = true, AFTER_DRAIN = false;
    bf16_t* z; int rowbase, rpb;
    __device__ __forceinline__ void operator()(const f32x4 (&acc)[2][2][4][2], const Unit& u, int wr, int wc, int fr, int fq) const {
        bf16_t* base = z + (size_t)(rowbase + (u.pn >> 1) * rpb + u.pm * 256 + wr * 64 + fr) * 512 + (u.pn & 1) * 256 + wc * 32 + 8 * fq;
#pragma unroll
        for (int ai = 0; ai < 2; ++ai)
#pragma unroll
            for (int m = 0; m < 4; ++m)
#pragma unroll
                for (int bj = 0; bj < 2; ++bj) *(u32x4*)(base + (size_t)(ai * HALF + m * 16) * 512 + bj * HALF) = pack8(acc[ai][bj][m][0] * 0.03125f, acc[ai][bj][m][1] * 0.03125f);
    }
};
struct EpiGates {
    static constexpr bool PERM = true, AFTER_DRAIN = false;
    bf16_t* g;
    __device__ __forceinline__ void operator()(const f32x4 (&acc)[2][2][4][2], const Unit& u, int wr, int wc, int fr, int fq) const {
        const int rt = wr * 64 + fr, cb = wc * 32 + 8 * fq; bf16_t* base = g + (size_t)u.pm * 256 * 3072 + u.pn * 256 + cb;
        float cs = -1.4426950408889634f * 0.03125f; asm volatile("" : "+s"(cs));
#pragma unroll
        for (int ai = 0; ai < 2; ++ai)
#pragma unroll
            for (int m = 0; m < 4; ++m)
#pragma unroll
                for (int bj = 0; bj < 2; ++bj) { f32x4 a0 = acc[ai][bj][m][0], a1 = acc[ai][bj][m][1];
#pragma unroll
                    for (int j = 0; j < 4; ++j) { a0[j] = __builtin_amdgcn_rcpf(1.0f + __builtin_amdgcn_exp2f(a0[j] * cs)); a1[j] = __builtin_amdgcn_rcpf(1.0f + __builtin_amdgcn_exp2f(a1[j] * cs)); }
                    *(u32x4*)(base + (size_t)(rt + ai * HALF + m * 16) * 3072 + bj * HALF) = pack8(a0, a1); }
    }
};
template <bool FIRST> struct EpiMerge {
    static constexpr bool PERM = true, AFTER_DRAIN = false;
    bf16_t* mg; const bf16_t* g; int br; float scale;
    __device__ __forceinline__ void operator()(const f32x4 (&acc)[2][2][4][2], const Unit& u, int wr, int wc, int fr, int fq) const {
        const int rt = u.pm * 256 + wr * 64 + fr, cb = u.pn * 256 + wc * 32 + 8 * fq; float sc = scale; asm volatile("" : "+s"(sc));
#pragma unroll
        for (int ai = 0; ai < 2; ++ai)
#pragma unroll
            for (int m = 0; m < 4; ++m)
#pragma unroll
                for (int bj = 0; bj < 2; ++bj) { const size_t row = (size_t)(rt + ai * HALF + m * 16); const int col = cb + bj * HALF;
                    const u32x4 gw = *(const u32x4*)(g + row * 3072 + br * 1024 + col); f32x4 g0, g1; unpack8(gw, g0, g1);
                    f32x4 v0 = acc[ai][bj][m][0] * sc * g0, v1 = acc[ai][bj][m][1] * sc * g1;
                    if (!FIRST) { const u32x4 ow = *(const u32x4*)(mg + row * 1024 + col); f32x4 o0, o1; unpack8(ow, o0, o1); v0 += o0; v1 += o1; }
                    *(u32x4*)(mg + row * 1024 + col) = pack8(v0, v1); }
    }
};
struct EpiRouter {
    static constexpr bool PERM = true, AFTER_DRAIN = false;
    float* lg;
    __device__ __forceinline__ void operator()(const f32x4 (&acc)[2][2][4][2], const Unit& u, int wr, int wc, int fr, int fq) const {
        if (wc < 2) { const int rt = u.pm * 256 + wr * 64 + fr, cb = wc * 32 + 8 * fq;
#pragma unroll
            for (int ai = 0; ai < 2; ++ai)
#pragma unroll
                for (int m = 0; m < 4; ++m) { float* p = lg + (size_t)(rt + ai * HALF + m * 16) * 64 + cb; *(f32x4*)p = acc[ai][0][m][0]; *(f32x4*)(p + 4) = acc[ai][0][m][1]; } }
    }
};
struct EpiSwiGLU {
    static constexpr bool PERM = true, AFTER_DRAIN = false;
    bf16_t* act; const float* bg; const float* bu;
    __device__ __forceinline__ void operator()(const f32x4 (&acc)[2][2][4][2], const Unit& u, int wr, int wc, int fr, int fq) const {
        const int e = u.pn >> 3, col = (u.pn & 7) * 128 + wc * 32 + 8 * fq, rt = u.pm * 256 + wr * 64 + fr;
        const f32x4 bg0 = *(const f32x4*)(bg + e * 1024 + col), bg1 = *(const f32x4*)(bg + e * 1024 + col + 4), bu0 = *(const f32x4*)(bu + e * 1024 + col), bu1 = *(const f32x4*)(bu + e * 1024 + col + 4);
#pragma unroll
        for (int ai = 0; ai < 2; ++ai)
#pragma unroll
            for (int m = 0; m < 4; ++m) { f32x4 g0 = acc[ai][0][m][0] + bg0, g1 = acc[ai][0][m][1] + bg1, u0 = acc[ai][1][m][0] + bu0, u1 = acc[ai][1][m][1] + bu1;
#pragma unroll
                for (int j = 0; j < 4; ++j) { const float ga = fminf(g0[j], 7.0f), gb = fminf(g1[j], 7.0f); const float ua = fminf(fmaxf(u0[j], -7.0f), 7.0f), ub = fminf(fmaxf(u1[j], -7.0f), 7.0f);
                    g0[j] = (ua + 1.0f) * (ga * fast_sigmoid(1.702f * ga)); g1[j] = (ub + 1.0f) * (gb * fast_sigmoid(1.702f * gb)); }
                *(u32x4*)(act + (size_t)(rt + ai * HALF + m * 16) * 1024 + col) = pack8(g0, g1); }
    }
};
struct EpiSwiGLU8 {
    static constexpr bool PERM = true, AFTER_DRAIN = false;
    unsigned char* act; const float* bg; const float* bu;
    __device__ __forceinline__ void operator()(const f32x4 (&acc)[2][2][4][2], const Unit& u, int wr, int wc, int fr, int fq) const {
        const int e = u.pn >> 3, col = (u.pn & 7) * 128 + wc * 32 + 8 * fq, rt = u.pm * 256 + wr * 64 + fr;
        const f32x4 bg0 = *(const f32x4*)(bg + e * 1024 + col), bg1 = *(const f32x4*)(bg + e * 1024 + col + 4), bu0 = *(const f32x4*)(bu + e * 1024 + col), bu1 = *(const f32x4*)(bu + e * 1024 + col + 4);
#pragma unroll
        for (int ai = 0; ai < 2; ++ai)
#pragma unroll
            for (int m = 0; m < 4; ++m) { f32x4 g0 = acc[ai][0][m][0] * 0.03125f + bg0, g1 = acc[ai][0][m][1] * 0.03125f + bg1, u0 = acc[ai][1][m][0] * 0.03125f + bu0, u1 = acc[ai][1][m][1] * 0.03125f + bu1;
#pragma unroll
                for (int j = 0; j < 4; ++j) { const float ga = fminf(g0[j], 7.0f), gb = fminf(g1[j], 7.0f); const float ua = fminf(fmaxf(u0[j], -7.0f), 7.0f), ub = fminf(fmaxf(u1[j], -7.0f), 7.0f);
                    g0[j] = (ua + 1.0f) * (ga * fast_sigmoid(1.702f * ga)); g1[j] = (ub + 1.0f) * (gb * fast_sigmoid(1.702f * gb)); }
                *(u32x2v*)(act + (size_t)(rt + ai * HALF + m * 16) * 1024 + col) = pack8_fp8(g0, g1); }
    }
};
struct EpiDown8 {
    static constexpr bool PERM = true, AFTER_DRAIN = false;
    bf16_t* ys; const float* bd;
    __device__ __forceinline__ void operator()(const f32x4 (&acc)[2][2][4][2], const Unit& u, int wr, int wc, int fr, int fq) const {
        const int e = u.pn >> 2, col0 = (u.pn & 3) * 256 + wc * 32 + 8 * fq, rt = u.pm * 256 + wr * 64 + fr;
        f32x4 bv[2][2];
#pragma unroll
        for (int bj = 0; bj < 2; ++bj) { bv[bj][0] = *(const f32x4*)(bd + e * 1024 + col0 + bj * HALF); bv[bj][1] = *(const f32x4*)(bd + e * 1024 + col0 + bj * HALF + 4); }
#pragma unroll
        for (int ai = 0; ai < 2; ++ai)
#pragma unroll
            for (int m = 0; m < 4; ++m) { bf16_t* rowp = ys + (size_t)(rt + ai * HALF + m * 16) * 1024 + col0;
#pragma unroll
                for (int bj = 0; bj < 2; ++bj) *(u32x4*)(rowp + bj * HALF) = pack8(acc[ai][bj][m][0] * 0.03125f + bv[bj][0], acc[ai][bj][m][1] * 0.03125f + bv[bj][1]); }
    }
};
struct GroupedOrder {
    int nM, nN, nwg, G, c; const int* tile_e;
    __device__ void init(int nM_, int nN_, int G_, int c_, const int* te) { nM = nM_; nN = nN_; nwg = nM * nN; G = G_; c = c_; tile_e = te; }
    __device__ bool next(int i, Unit& u) const {
        const long L = (long)i * G + c; if (L >= nwg) return false;
        int wgid = (int)L; { const int q = nwg / NXCD, r = nwg % NXCD, xcd = wgid % NXCD, off = wgid / NXCD; wgid = (xcd < r ? xcd * (q + 1) : r * (q + 1) + (xcd - r) * q) + off; }
        const int nig = WGM * nN, gid = wgid / nig, fm = gid * WGM, gsz = (nM - fm) < WGM ? (nM - fm) : WGM;
        u.pm = fm + ((wgid % nig) % gsz); const int pl = (wgid % nig) / gsz; u.pn = __builtin_amdgcn_readfirstlane(tile_e[u.pm]) * nN + pl; return true;
    }
    __device__ __forceinline__ void a_ready(const Unit&) const {}
    __device__ __forceinline__ void done(const Unit&) const {}
};
struct DftOrder {
    int lg, n, G, c;
    __device__ void init(int lg_, int nb, int G_, int c_) { lg = lg_; n = (nb * 2) << lg_; G = G_; c = c_; }
    __device__ bool next(int i, Unit& u) const { const int L = i * G + c; if (L >= n) return false; const int b = L >> (lg + 1), rem = L & ((2 << lg) - 1); u.pm = rem & ((1 << lg) - 1); u.pn = 2 * b + (rem >> lg); return true; }
    __device__ __forceinline__ void a_ready(const Unit&) const {}
    __device__ __forceinline__ void done(const Unit&) const {}
};

template <class Epi, class Sched, bool ALIGN_EPI = false, bool SP2 = false, bool FP8 = false>
__device__ __forceinline__ void gemm_phase(PG8_LAS unsigned char* lds, const Gemm g, const Sched& S, const Epi& E, const int tid_in) {
    int tid_ = tid_in; asm volatile("" : "+v"(tid_));
    const int tid = tid_, wid = __builtin_amdgcn_readfirstlane(tid >> 6), lane = tid & 63, wr = wid >> 2, wc = wid & 3, fr = lane & 15, fq = lane >> 4;
    const int K = g.K, nt = K / BK;
    unsigned voffA[2], voffB[2];
#pragma unroll
    for (int i = 0; i < 2; ++i) { int R, C; stage_rc(tid * 16 + i * 8192, R, C); const int Rb = Epi::PERM ? ((R & ~31) + perm32(R & 31)) : R;
        voffA[i] = (unsigned)(R * K + C) * 2u; voffB[i] = (unsigned)(Rb * K + C) * 2u; }
    const size_t kstep = (size_t)(BK * 2);
    const size_t hstep = (size_t)HALF * K * 2;
    const size_t tstep = 2 * hstep;
    const unsigned ldsw = (unsigned)wid * 1024u;
    const int aoff = lds_byte(wr * 64 + fr, fq * 8), boff = lds_byte(wc * 32 + fr, fq * 8);
#define PG8_SA(b, h) (((b) * 2 + (h)) * HTB)
#define PG8_SB(b, h) ((4 + (b) * 2 + (h)) * HTB)
#define PG8_STAGE(bufoff, gbase, voff) do { _Pragma("unroll") for (int _i = 0; _i < 2; ++_i) \
        __builtin_amdgcn_global_load_lds((const unsigned*)((const char*)(gbase) + (voff)[_i]), (PG8_LAS unsigned*)(lds + (bufoff) + ldsw + _i * 8192), 16, 0, 0); } while (0)
#define PG8_RD8(off) __builtin_shufflevector(*(const PG8_LAS i32x4v*)(lds + (off)), *(const PG8_LAS i32x4v*)(lds + (off) + 1024), 0, 1, 2, 3, 4, 5, 6, 7)
#define PG8_LDA(dst, b, h) do { _Pragma("unroll") for (int m = 0; m < 4; ++m) { if constexpr (FP8) dst##8[m] = PG8_RD8(PG8_SA(b, h) + aoff + m * 2048); else { _Pragma("unroll") for (int k = 0; k < 2; ++k) dst[m][k] = *(const PG8_LAS bf16x8*)(lds + PG8_SA(b, h) + aoff + m * 2048 + k * 1024); } } } while (0)
#define PG8_LDB(dst, b, h) do { _Pragma("unroll") for (int n = 0; n < 2; ++n) { if constexpr (FP8) dst##8[n] = PG8_RD8(PG8_SB(b, h) + boff + n * 2048); else { _Pragma("unroll") for (int k = 0; k < 2; ++k) dst[n][k] = *(const PG8_LAS bf16x8*)(lds + PG8_SB(b, h) + boff + n * 2048 + k * 1024); } } } while (0)
#define PG8_MMA(ai, bj, At, Bt) do { if constexpr (FP8) __builtin_amdgcn_sched_barrier(0); __builtin_amdgcn_s_setprio(1); _Pragma("unroll") for (int m = 0; m < 4; ++m) _Pragma("unroll") for (int n = 0; n < 2; ++n) { \
        if constexpr (FP8) asm volatile("v_mfma_scale_f32_16x16x128_f8f6f4 %0, %1, %2, %0, %3, %3 op_sel_hi:[0,0,0]" : "+v"(acc[ai][bj][m][n]) : "v"(Bt##8[n]), "v"(At##8[m]), "v"(sc8)); \
        else { _Pragma("unroll") for (int k = 0; k < 2; ++k) acc[ai][bj][m][n] = __builtin_amdgcn_mfma_f32_16x16x32_bf16(Bt[n][k], At[m][k], acc[ai][bj][m][n], 0, 0, 0); } } __builtin_amdgcn_s_setprio(0); if constexpr (FP8) __builtin_amdgcn_sched_barrier(0); } while (0)
#define PG8_WAIT_V(n) asm volatile("s_waitcnt vmcnt(" #n ")" ::: "memory")
#define PG8_WAIT_L(n) asm volatile("s_waitcnt lgkmcnt(" #n ")" ::: "memory")
#define PG8_BAR __builtin_amdgcn_s_barrier()
#define PG8_SCHED __builtin_amdgcn_sched_barrier(0)
    Unit cur, nxt; int ui = 0;
    if (!S.next(0, cur)) return;
    f32x4 acc[2][2][4][2];
#pragma unroll
    for (int a = 0; a < 2; ++a)
#pragma unroll
        for (int b = 0; b < 2; ++b)
#pragma unroll
            for (int m = 0; m < 4; ++m)
#pragma unroll
                for (int n = 0; n < 2; ++n) acc[a][b][m][n] = (f32x4){0.f, 0.f, 0.f, 0.f};
    int sc8 = 0x7f7f7f7f; asm volatile("" : "+v"(sc8));
    bf16x8 At[4][2], B0[2][2], B1[2][2]; i32x8v At8[4], B08[2], B18[2];
    const char* cA = (const char*)g.A + (size_t)cur.pm * tstep; const char* cB = (const char*)g.Bt + (size_t)cur.pn * tstep;
    S.a_ready(cur);
    if constexpr (SP2) {
        PG8_STAGE(PG8_SB(0, 0), cB, voffB); PG8_STAGE(PG8_SB(0, 1), cB + hstep, voffB); PG8_STAGE(PG8_SA(0, 0), cA, voffA); PG8_STAGE(PG8_SA(0, 1), cA + hstep, voffA);
        if (wr == 1) PG8_BAR;
        PG8_WAIT_V(2); PG8_BAR;
        PG8_STAGE(PG8_SB(1, 0), cB + kstep, voffB); PG8_STAGE(PG8_SA(1, 0), cA + kstep, voffA); PG8_STAGE(PG8_SB(1, 1), cB + hstep + kstep, voffB);
        PG8_WAIT_V(6); PG8_BAR;
    } else {
        PG8_STAGE(PG8_SB(0, 0), cB, voffB); PG8_STAGE(PG8_SA(0, 0), cA, voffA); PG8_STAGE(PG8_SB(0, 1), cB + hstep, voffB); PG8_STAGE(PG8_SA(0, 1), cA + hstep, voffA);
        if (wr == 1) PG8_BAR;
        PG8_WAIT_V(4); PG8_BAR;
        PG8_STAGE(PG8_SB(1, 0), cB + kstep, voffB); PG8_STAGE(PG8_SA(1, 0), cA + kstep, voffA); PG8_STAGE(PG8_SB(1, 1), cB + hstep + kstep, voffB);
        PG8_WAIT_V(6); PG8_BAR;
    }
    for (;;) {
        const bool has_next = S.next(ui + 1, nxt);
        const char* nA = has_next ? (const char*)g.A + (size_t)nxt.pm * tstep : cA; const char* nB = has_next ? (const char*)g.Bt + (size_t)nxt.pn * tstep : cB;
        for (int t = 0; t < nt; t += 2) {
            const bool last = (t == nt - 2);
            const char* a1 = cA + (size_t)(t + 1) * kstep;
            const char* a2 = last ? nA : cA + (size_t)(t + 2) * kstep; const char* b2 = last ? nB : cB + (size_t)(t + 2) * kstep;
            const char* a3 = a2 + kstep; const char* b3 = b2 + kstep;
            if (last && has_next) S.a_ready(nxt);
            if constexpr (SP2) {
            PG8_LDB(B0, 0, 0); PG8_LDB(B1, 0, 1); PG8_SCHED; PG8_LDA(At, 0, 0); PG8_STAGE(PG8_SA(1, 1), a1 + hstep, voffA);
            PG8_WAIT_V(8); PG8_WAIT_L(0); PG8_BAR; PG8_MMA(0, 0, At, B0); PG8_MMA(0, 1, At, B1); PG8_BAR; PG8_SCHED;
            PG8_LDA(At, 0, 1); PG8_STAGE(PG8_SB(0, 0), b2, voffB); PG8_STAGE(PG8_SB(0, 1), b2 + hstep, voffB); PG8_STAGE(PG8_SA(0, 0), a2, voffA);
            PG8_WAIT_V(8); PG8_WAIT_L(0); PG8_BAR; PG8_MMA(1, 0, At, B0); PG8_MMA(1, 1, At, B1); PG8_BAR; PG8_SCHED;
            PG8_LDB(B0, 1, 0); PG8_LDB(B1, 1, 1); PG8_SCHED; PG8_LDA(At, 1, 0); PG8_STAGE(PG8_SA(0, 1), a2 + hstep, voffA);
            PG8_WAIT_V(8); PG8_WAIT_L(0); PG8_BAR; PG8_MMA(0, 0, At, B0); PG8_MMA(0, 1, At, B1); PG8_BAR; PG8_SCHED;
            PG8_LDA(At, 1, 1); PG8_STAGE(PG8_SB(1, 0), b3, voffB); PG8_STAGE(PG8_SB(1, 1), b3 + hstep, voffB); PG8_STAGE(PG8_SA(1, 0), a3, voffA);
            PG8_WAIT_V(8); PG8_WAIT_L(0); PG8_BAR; PG8_MMA(1, 0, At, B0); PG8_MMA(1, 1, At, B1); PG8_BAR; PG8_SCHED;
            } else {
            PG8_LDB(B0, 0, 0); PG8_SCHED; PG8_LDA(At, 0, 0); PG8_STAGE(PG8_SA(1, 1), a1 + hstep, voffA);
            PG8_WAIT_L(8); PG8_BAR; PG8_WAIT_L(0); PG8_MMA(0, 0, At, B0); PG8_BAR; PG8_SCHED;
            PG8_LDB(B1, 0, 1); PG8_STAGE(PG8_SB(0, 0), b2, voffB);
            PG8_BAR; PG8_WAIT_L(0); PG8_MMA(0, 1, At, B1); PG8_BAR;
            PG8_LDA(At, 0, 1); PG8_STAGE(PG8_SA(0, 0), a2, voffA);
            PG8_BAR; PG8_WAIT_L(0); PG8_MMA(1, 0, At, B0); PG8_BAR; PG8_SCHED;
            PG8_STAGE(PG8_SB(0, 1), b2 + hstep, voffB);
            PG8_WAIT_V(6); PG8_BAR; PG8_MMA(1, 1, At, B1); PG8_BAR;
            PG8_LDB(B0, 1, 0); PG8_SCHED; PG8_LDA(At, 1, 0); PG8_STAGE(PG8_SA(0, 1), a2 + hstep, voffA);
            PG8_WAIT_L(8); PG8_BAR; PG8_WAIT_L(0); PG8_MMA(0, 0, At, B0); PG8_BAR; PG8_SCHED;
            PG8_LDB(B1, 1, 1); PG8_STAGE(PG8_SB(1, 0), b3, voffB);
            PG8_BAR; PG8_WAIT_L(0); PG8_MMA(0, 1, At, B1); PG8_BAR;
            PG8_LDA(At, 1, 1); PG8_STAGE(PG8_SA(1, 0), a3, voffA);
            PG8_BAR; PG8_WAIT_L(0); PG8_MMA(1, 0, At, B0); PG8_BAR; PG8_SCHED;
            PG8_STAGE(PG8_SB(1, 1), b3 + hstep, voffB);
            PG8_WAIT_V(6); PG8_BAR; PG8_MMA(1, 1, At, B1); PG8_BAR;
            }
        }
        if constexpr (FP8) asm volatile("s_nop 15\n\ts_nop 15" ::: "memory");
        if constexpr (ALIGN_EPI) { if (wr == 0) PG8_BAR; }
        if constexpr (!Epi::AFTER_DRAIN) { E(acc, cur, wr, wc, fr, fq); S.done(cur); }
        if (!has_next) break;
#pragma unroll
        for (int a = 0; a < 2; ++a)
#pragma unroll
            for (int b = 0; b < 2; ++b)
#pragma unroll
                for (int m = 0; m < 4; ++m)
#pragma unroll
                    for (int n = 0; n < 2; ++n) acc[a][b][m][n] = (f32x4){0.f, 0.f, 0.f, 0.f};
        cur = nxt; cA = nA; cB = nB; ++ui;
        if constexpr (ALIGN_EPI) { if (wr == 1) PG8_BAR; }
    }
    PG8_WAIT_V(0);
    if constexpr (!ALIGN_EPI) { if (wr == 0) PG8_BAR; }
    PG8_BAR;
    if constexpr (Epi::AFTER_DRAIN) { E.fused(acc, cur, wr, wc, fr, fq, lds, wid, lane); S.done(cur); }
#undef PG8_SA
#undef PG8_SB
#undef PG8_STAGE
#undef PG8_LDA
#undef PG8_LDB
#undef PG8_MMA
#undef PG8_RD8
#undef PG8_WAIT_V
#undef PG8_WAIT_L
#undef PG8_BAR
#undef PG8_SCHED
}
}
namespace att {
typedef unsigned short bf16;
constexpr int   D = 128, NW = 8, QBLK = 32, KVBLK = 64;
constexpr float SCALE = 0.088388347648318440f;
constexpr float THR = 8.f;
constexpr int SDEPTH = 2;
constexpr int LDQ = 1024, LDK = 256, LDO = 1024;
constexpr size_t SHM_V = KVBLK * D * 2, SHM_K = KVBLK * D * 2, SHM_ATTN = 2 * SHM_V + 2 * SHM_K + NW * 64 * 4;
using bf16x8 = __attribute__((ext_vector_type(8))) short;
using s16x4  = __attribute__((ext_vector_type(4))) short;
using f32x16 = __attribute__((ext_vector_type(16))) float;
using f32x8  = __attribute__((ext_vector_type(8))) float;
using u32x4  = __attribute__((ext_vector_type(4))) unsigned;
#define KSWZ(row, colB) ((row) * 256 + ((colB) ^ (((row) & 7) << 4)))
#define SBAR() __builtin_amdgcn_sched_barrier(0)
__device__ __forceinline__ int crow(int r, int hi) { return (r & 3) + 8 * (r >> 2) + 4 * hi; }
__device__ __forceinline__ unsigned cvtpk(float lo, float hi) { return pg8::cvt_pk_bf16(lo, hi); }
template <typename TIn> struct Stage;
template <> struct Stage<bf16>  { using T = bf16x8;
  __device__ static __forceinline__ T ld8(const bf16* p) { return *reinterpret_cast<const bf16x8*>(p); }
  __device__ static __forceinline__ bf16x8 tobf(T x) { return x; } };
template <> struct Stage<float> { using T = f32x8;
  __device__ static __forceinline__ T ld8(const float* p) { return *reinterpret_cast<const f32x8*>(p); }
  __device__ static __forceinline__ bf16x8 tobf(T x) {
    u32x4 w = {cvtpk(x[0], x[1]), cvtpk(x[2], x[3]), cvtpk(x[4], x[5]), cvtpk(x[6], x[7])}; return *reinterpret_cast<bf16x8*>(&w); } };

__device__ __forceinline__ void partialSM(f32x16& p0, f32x16& p1, float& m_reg, float& mn, float& alpha) {
  constexpr float C = SCALE * 1.4426950408889634f;
  float pmax = p0[0]; for (int r = 1; r < 16; ++r) pmax = fmaxf(pmax, p0[r]); for (int r = 0; r < 16; ++r) pmax = fmaxf(pmax, p1[r]);
  { auto rr = __builtin_amdgcn_permlane32_swap(__float_as_uint(pmax), __float_as_uint(pmax), false, false);
    pmax = fmaxf(__uint_as_float(rr[0]), __uint_as_float(rr[1])); }
  if (__builtin_expect(__all(pmax - m_reg <= THR / SCALE), 1)) { mn = m_reg; alpha = 1.f; }
  else { mn = fmaxf(m_reg, pmax); alpha = __builtin_amdgcn_exp2f((m_reg - mn) * C); m_reg = mn; }
  float mnC = -mn * C;
  for (int r = 0; r < 16; ++r) p0[r] = fmaf(p0[r], C, mnC); for (int r = 0; r < 16; ++r) p1[r] = fmaf(p1[r], C, mnC);
  for (int r = 0; r < 16; ++r) p0[r] = __builtin_amdgcn_exp2f(p0[r]);
}
__device__ __forceinline__ void finishSM(f32x16& p0, f32x16& p1, float alpha, float& l_reg, bf16x8& pa0, bf16x8& pa1, bf16x8& pa2, bf16x8& pa3) {
  for (int r = 0; r < 16; ++r) p1[r] = __builtin_amdgcn_exp2f(p1[r]);
  float ps = 0; for (int r = 0; r < 16; ++r) ps += p0[r]; for (int r = 0; r < 16; ++r) ps += p1[r];
  { auto rr = __builtin_amdgcn_permlane32_swap(__float_as_uint(ps), __float_as_uint(ps), false, false);
    ps = __uint_as_float(rr[0]) + __uint_as_float(rr[1]); }
  l_reg = l_reg * alpha + ps;
#define PK4(P, BASE, OUT) do { unsigned a0 = cvtpk(P[BASE + 0], P[BASE + 1]), a1 = cvtpk(P[BASE + 2], P[BASE + 3]);   \
    unsigned b0 = cvtpk(P[BASE + 4], P[BASE + 5]), b1 = cvtpk(P[BASE + 6], P[BASE + 7]);                              \
    auto r0 = __builtin_amdgcn_permlane32_swap(a0, b0, false, false); auto r1 = __builtin_amdgcn_permlane32_swap(a1, b1, false, false); \
    u32x4 w = {r0[0], r1[0], r0[1], r1[1]}; OUT = *reinterpret_cast<bf16x8*>(&w); } while (0)
  PK4(p0, 0, pa0); PK4(p0, 8, pa1); PK4(p1, 0, pa2); PK4(p1, 8, pa3);
#undef PK4
}
__device__ __forceinline__ void qkt(f32x16& p0, f32x16& p1, const bf16* Ks, const bf16x8* qr, int r32, int hi) {
  p0 = f32x16{}; p1 = f32x16{};
  for (int d0 = 0; d0 < 8; ++d0) { int cb = (d0 * 16 + hi * 8) * 2;
    bf16x8 b0 = *reinterpret_cast<const bf16x8*>((const char*)Ks + KSWZ(r32, cb));
    bf16x8 b1 = *reinterpret_cast<const bf16x8*>((const char*)Ks + KSWZ(32 + r32, cb));
    p0 = __builtin_amdgcn_mfma_f32_32x32x16_bf16(b0, qr[d0], p0, 0, 0, 0);
    p1 = __builtin_amdgcn_mfma_f32_32x32x16_bf16(b1, qr[d0], p1, 0, 0, 0); }
}
__device__ __forceinline__ int v_st(int k, int c) { const int kk = (k & ~0xC) | ((k & 4) << 1) | ((k & 8) >> 1); return ((kk >> 3) * 4 + (c >> 5)) * 512 + ((kk & 7) * 32 + (c & 31)) * 2; }
__device__ __forceinline__ int v_rd_base(int lane) { return ((lane & 3) << 3) | (((lane >> 2) & 3) << 6) | (((lane >> 4) & 1) << 5) | (((lane >> 5) & 1) << 8); }
constexpr int v_rd_off(int d0, int ks, int half) { return d0 * 512 + ks * 4096 + half * 2048; }
template <int OFF> __device__ __forceinline__ s16x4 tr_read(int vb) {
  s16x4 r; asm volatile("ds_read_b64_tr_b16 %0, %1 offset:%2" : "=&v"(r) : "v"(vb), "i"(OFF) : "memory"); return r;
}
template <int D0> __device__ __forceinline__ void pv_one(f32x16& od, int vb, bf16x8 pa0, bf16x8 pa1, bf16x8 pa2, bf16x8 pa3) {
  const s16x4 l0 = tr_read<v_rd_off(D0, 0, 0)>(vb), h0 = tr_read<v_rd_off(D0, 0, 1)>(vb), l1 = tr_read<v_rd_off(D0, 1, 0)>(vb), h1 = tr_read<v_rd_off(D0, 1, 1)>(vb);
  const s16x4 l2 = tr_read<v_rd_off(D0, 2, 0)>(vb), h2 = tr_read<v_rd_off(D0, 2, 1)>(vb), l3 = tr_read<v_rd_off(D0, 3, 0)>(vb), h3 = tr_read<v_rd_off(D0, 3, 1)>(vb);
  asm volatile("s_waitcnt lgkmcnt(0)" ::: "memory"); SBAR();
#define PK(L, H) (bf16x8){L[0], L[1], L[2], L[3], H[0], H[1], H[2], H[3]}
  od = __builtin_amdgcn_mfma_f32_32x32x16_bf16(pa0, PK(l0, h0), od, 0, 0, 0);
  od = __builtin_amdgcn_mfma_f32_32x32x16_bf16(pa1, PK(l1, h1), od, 0, 0, 0);
  od = __builtin_amdgcn_mfma_f32_32x32x16_bf16(pa2, PK(l2, h2), od, 0, 0, 0);
  od = __builtin_amdgcn_mfma_f32_32x32x16_bf16(pa3, PK(l3, h3), od, 0, 0, 0);
#undef PK
}
__device__ __forceinline__ void pv_d0(f32x16* o, int vb, bf16x8 pa0, bf16x8 pa1, bf16x8 pa2, bf16x8 pa3) {
  pv_one<0>(o[0], vb, pa0, pa1, pa2, pa3); pv_one<1>(o[1], vb, pa0, pa1, pa2, pa3); pv_one<2>(o[2], vb, pa0, pa1, pa2, pa3); pv_one<3>(o[3], vb, pa0, pa1, pa2, pa3);
}

template <typename TQ>
__device__ __forceinline__ void attn_dense_body(const TQ* __restrict__ Qb, const bf16* __restrict__ Kh, const bf16* __restrict__ Vh,
                                                unsigned char* __restrict__ Ob, int seq, char* lds, const int tid_in) {
  using St = Stage<bf16>; using SQ = Stage<TQ>;
  int tid_ = tid_in; asm volatile("" : "+v"(tid_));
  const int tid = tid_, wid = tid >> 6, lane = tid & 63, r32 = lane & 31, hi = lane >> 5;
  bf16* V_lds = (bf16*)lds; bf16* K_lds = (bf16*)(lds + 2 * SHM_V);
  float* ws = (float*)(lds + 2 * SHM_V + 2 * SHM_K) + wid * 64; float* li_l = ws; float* al_l = ws + 32;
  float m_reg = -1e30f, l_reg = 0; f32x16 o[4] = {}; bf16x8 qr[8];
  const TQ* Qw = Qb + (long)(wid * QBLK + r32) * LDQ + hi * 8;
#pragma unroll
  for (int d0 = 0; d0 < 8; ++d0) qr[d0] = SQ::tobf(SQ::ld8(Qw + d0 * 16));
  const int sr = tid >> 4, sc = (tid & 15) * 8, vst0 = v_st(sr, sc), vst1 = v_st(32 + sr, sc);
  const int vb0 = (int)(uintptr_t)V_lds + v_rd_base(lane);
  struct { typename St::T vs0, vs1, ks0, ks1; } sr_[SDEPTH];
#define SLOAD(i, k0) do { sr_[i].vs0 = St::ld8(&Vh[(long)((k0) + sr) * LDK + sc]); sr_[i].vs1 = St::ld8(&Vh[(long)((k0) + 32 + sr) * LDK + sc]); \
    sr_[i].ks0 = St::ld8(&Kh[(long)((k0) + sr) * LDK + sc]); sr_[i].ks1 = St::ld8(&Kh[(long)((k0) + 32 + sr) * LDK + sc]); } while (0)
#define SWRITE(b, i) do { *(bf16x8*)((char*)V_lds + (b) * SHM_V + vst0) = St::tobf(sr_[i].vs0);          \
    *(bf16x8*)((char*)V_lds + (b) * SHM_V + vst1) = St::tobf(sr_[i].vs1); int kc = sc * 2;               \
    *(bf16x8*)((char*)K_lds + (b) * SHM_K + KSWZ(sr, kc)) = St::tobf(sr_[i].ks0);                       \
    *(bf16x8*)((char*)K_lds + (b) * SHM_K + KSWZ(32 + sr, kc)) = St::tobf(sr_[i].ks1); } while (0)
#define SWAIT() do { if constexpr (SDEPTH == 2) asm volatile("s_waitcnt vmcnt(4)" ::: "memory"); else asm volatile("s_waitcnt vmcnt(0)" ::: "memory"); } while (0)
#define RESC(a) do { if (__any((a) < 1.f)) { if (hi == 0) al_l[r32] = (a); asm volatile("s_waitcnt lgkmcnt(0)" ::: "memory"); \
    for (int d = 0; d < 4; ++d) for (int r = 0; r < 16; ++r) o[d][r] *= al_l[crow(r, hi)]; } } while (0)
  f32x16 pA0, pA1, pB0, pB1; float mnA, mnB, alA, alB; bf16x8 pa0, pa1, pa2, pa3; const int NT = seq / KVBLK;
  constexpr int SE = 0, SO = SDEPTH - 1;
  SLOAD(SE, 0); asm volatile("s_waitcnt vmcnt(0)" ::: "memory"); SWRITE(0, SE); __syncthreads();
  qkt(pA0, pA1, K_lds, qr, r32, hi); partialSM(pA0, pA1, m_reg, mnA, alA);
  SLOAD(SO, KVBLK); if constexpr (SDEPTH == 2) { if (2 < NT) SLOAD(SE, 2 * KVBLK); }
  SWAIT(); SWRITE(1, SO); __syncthreads();
  for (int j = 1; j + 1 < NT; j += 2) {
    SBAR(); qkt(pB0, pB1, (bf16*)((char*)K_lds + SHM_K), qr, r32, hi);
    finishSM(pA0, pA1, alA, l_reg, pa0, pa1, pa2, pa3); SBAR();
    SLOAD(SO, (j + SDEPTH) * KVBLK); SBAR();
    pv_d0(o, vb0, pa0, pa1, pa2, pa3); partialSM(pB0, pB1, m_reg, mnB, alB);
    __syncthreads(); SWAIT(); SWRITE(0, SE);
    RESC(alB); __syncthreads();
    SBAR(); qkt(pA0, pA1, K_lds, qr, r32, hi);
    finishSM(pB0, pB1, alB, l_reg, pa0, pa1, pa2, pa3); SBAR();
    if (SDEPTH == 1 || j + 3 < NT) SLOAD(SE, (j + 1 + SDEPTH) * KVBLK); SBAR();
    pv_d0(o, vb0 + (int)SHM_V, pa0, pa1, pa2, pa3); partialSM(pA0, pA1, m_reg, mnA, alA);
    __syncthreads(); SWAIT(); SWRITE(1, SO);
    RESC(alA); __syncthreads();
  }
  SBAR(); qkt(pB0, pB1, (bf16*)((char*)K_lds + SHM_K), qr, r32, hi);
  finishSM(pA0, pA1, alA, l_reg, pa0, pa1, pa2, pa3); SBAR();
  pv_d0(o, vb0, pa0, pa1, pa2, pa3); partialSM(pB0, pB1, m_reg, mnB, alB);
  __syncthreads(); RESC(alB);
  finishSM(pB0, pB1, alB, l_reg, pa0, pa1, pa2, pa3); SBAR();
  pv_d0(o, vb0 + (int)SHM_V, pa0, pa1, pa2, pa3);
  if (hi == 0) li_l[r32] = l_reg; asm volatile("s_waitcnt lgkmcnt(0)" ::: "memory");
  float rli[16];
#pragma unroll
  for (int r = 0; r < 16; ++r) rli[r] = __builtin_amdgcn_rcpf(li_l[crow(r, hi)]);
  unsigned char* Ow = Ob + (long)(wid * QBLK) * LDO;
#pragma unroll
  for (int r = 0; r < 16; ++r) { int orow = crow(r, hi);
    for (int d0 = 0; d0 < 4; ++d0) { const float ov = o[d0][r] * rli[r] * 64.0f; Ow[(long)orow * LDO + d0 * 32 + r32] = (unsigned char)(__builtin_amdgcn_cvt_pk_fp8_f32(ov, ov, __builtin_bit_cast(int, ov), false) & 0xff); } }
#undef SLOAD
#undef SWRITE
#undef SWAIT
#undef RESC
}
#undef KSWZ
#undef SBAR
}

#define GAS __attribute__((address_space(1)))
#define LAS __attribute__((address_space(3)))
typedef unsigned short bf16;
typedef unsigned v4u __attribute__((ext_vector_type(4)));
typedef float f32x4 __attribute__((ext_vector_type(4)));
typedef short bf16x8 __attribute__((ext_vector_type(8)));
typedef GAS unsigned gu32;
typedef GAS unsigned long long gu64;
#define RLX_AGENT __ATOMIC_RELAXED, __HIP_MEMORY_SCOPE_AGENT
#define LDS_WAIT() asm volatile("s_waitcnt lgkmcnt(0)" ::: "memory")
#define VM_WAIT() asm volatile("s_waitcnt vmcnt(0)" ::: "memory")
__device__ __forceinline__ unsigned long long rt() { return __builtin_amdgcn_s_memrealtime(); }
__device__ __forceinline__ unsigned f2bf(float f) { unsigned u = __builtin_bit_cast(unsigned, f); return (u + 0x7fffu + ((u >> 16) & 1u)) >> 16; }
__device__ __forceinline__ unsigned pk2(float lo, float hi) { return f2bf(lo) | (f2bf(hi) << 16); }

#define XB_TMO      128
#define XB_XCNT(j)  (256  + 64 * (j))
#define XB_XSUB(j)  (1280 + 64 * (j))
#define XB_XGEN(j)  (2304 + 64 * (j))
#define XB_TOP      3328
#define XB_TOPGEN   3392
#define XCD_BAR_WORDS 3456
#define XB_SPIN_CAP (1u << 18)

__device__ __forceinline__ unsigned xb_ld(unsigned* p)              { return __hip_atomic_load(p, __ATOMIC_RELAXED, __HIP_MEMORY_SCOPE_AGENT); }
__device__ __forceinline__ unsigned xb_add(unsigned* p, unsigned v) { return __hip_atomic_fetch_add(p, v, __ATOMIC_RELAXED, __HIP_MEMORY_SCOPE_AGENT); }
__device__ __forceinline__ unsigned xb_xcc_id() { return (unsigned)__builtin_amdgcn_s_getreg((3 << 11) | 20) & 0xFu; }
#define XB_SPIN(cond, bar) do { unsigned _sp = 0; while (cond) { __builtin_amdgcn_s_sleep(1); \
    if ((++_sp & 255u) == 0u) { if (xb_ld(&(bar)[XB_TMO])) break; if (_sp > XB_SPIN_CAP) { atomicAdd(&(bar)[XB_TMO], 1u); break; } } } } while (0)

struct XcdBarrier {
    unsigned* bar; unsigned x;
    volatile LAS unsigned* st;
};

__device__ __forceinline__ XcdBarrier xcd_barrier_post(unsigned* bar, volatile LAS unsigned* st) {
    XcdBarrier b; b.bar = bar; b.x = xb_xcc_id(); b.st = st;
    if (threadIdx.x == 0) (void)xb_add(&bar[XB_XCNT(b.x)], 1u);
    return b;
}
__device__ __forceinline__ void xcd_barrier_complete(unsigned* bar, unsigned x, unsigned& nloc, unsigned& nx) {
    const unsigned G = gridDim.x * gridDim.y * gridDim.z;
    unsigned sum, cnt, mine, sp = 0u;
    for (;;) {
        sum = 0u; cnt = 0u; mine = 0u;
#pragma unroll
        for (unsigned j = 0; j < 16; ++j) { const unsigned c = xb_ld(&bar[XB_XCNT(j)]); sum += c; cnt += (c > 0u) ? 1u : 0u; mine = (j == x) ? c : mine; }
        if (sum == G) break;
        __builtin_amdgcn_s_sleep(1);
        if ((++sp & 255u) == 0u) { if (xb_ld(&bar[XB_TMO])) break; if (sp > XB_SPIN_CAP) { atomicAdd(&bar[XB_TMO], 1u); break; } }
    }
    nloc = mine > 0u ? mine : 1u; nx = cnt > 0u ? cnt : 1u;
}

__device__ __forceinline__ void xcd_barrier(const XcdBarrier& b) {
    asm volatile("s_waitcnt vmcnt(0)" ::: "memory");
    __syncthreads();
    if (threadIdx.x == 0) {
        unsigned* bar = b.bar;
        __builtin_amdgcn_s_waitcnt(0);
        unsigned nloc = b.st[0], nx = b.st[1];
        if (nloc == 0u) { xcd_barrier_complete(bar, b.x, nloc, nx); b.st[0] = nloc; b.st[1] = nx; }
        const unsigned old = xb_add(&bar[XB_XSUB(b.x)], 1u);
        const unsigned gen = old / nloc;
        if (old + 1u == (gen + 1u) * nloc) {
            __builtin_amdgcn_fence(__ATOMIC_RELEASE, "agent");
            asm volatile("s_waitcnt vmcnt(0)" ::: "memory");
            const unsigned og = xb_add(&bar[XB_TOP], 1u);
            const unsigned tg = og / nx;
            if (og + 1u == (tg + 1u) * nx) xb_add(&bar[XB_TOPGEN], 1u);
            else XB_SPIN(xb_ld(&bar[XB_TOPGEN]) == tg, bar);
            __builtin_amdgcn_fence(__ATOMIC_ACQUIRE, "agent");
            xb_add(&bar[XB_XGEN(b.x)], 1u);
            asm volatile("s_waitcnt vmcnt(0)" ::: "memory");
        } else {
            XB_SPIN(xb_ld(&bar[XB_XGEN(b.x)]) == gen, bar);
            __builtin_amdgcn_fence(__ATOMIC_ACQUIRE, "agent");
            asm volatile("s_waitcnt vmcnt(0)" ::: "memory");
        }
    }
    __syncthreads();
}
constexpr int DM = 1024, NB = 16, SEQ = 2048, CTXL = 256, TL = NB * SEQ, TC = NB * CTXL, TALL = TL + TC;
constexpr int INCOLS = 6144, OFF_FNET = 2560, OFF_GATE = 3072;
constexpr int NEXP = 32, KVROWS = SEQ + CTXL;
constexpr float EPS = 1e-6f;
constexpr int NWAVES = 8, NTHR = NWAVES * 64;
constexpr int NPL = 13, NPH = 2 + 2 * NPL;
#ifndef MK_PER_PHASE
#define MK_PER_PHASE 0
#endif
constexpr size_t MiB = 1u << 20;
constexpr size_t WS_CTL = 0, CTL_ZERO_BYTES = 1 * MiB;
constexpr size_t WS_MOD = 1 * MiB;
constexpr size_t WS_TAB = 2 * MiB;
constexpr size_t WS_TOPI = 3 * MiB, WS_TOPP = 4 * MiB, WS_SLOT = 5 * MiB, WS_CNT = 6 * MiB;
constexpr size_t WS_LOGIT = 7 * MiB;
constexpr size_t WS_WSMALL = 17 * MiB, WSMALL_LAYER = 20 * MiB;
constexpr size_t OFFS_WIN = 0, OFFS_WF = 5 * MiB, OFFS_WG = 7 * MiB, OFFS_WAO = 13 * MiB, OFFS_WCO = 15 * MiB, OFFS_WFO = 16 * MiB, OFFS_WOUT = 17 * MiB, OFFS_ROUT = 19 * MiB;
constexpr size_t WS_DFTL = 57 * MiB, WS_DFTC = 73 * MiB;
constexpr size_t WS_XC = 74 * MiB;
constexpr size_t WS_H = 90 * MiB;
constexpr size_t WS_WGU = 162 * MiB, WS_WD = 226 * MiB, MOEW_LAYER = 96 * MiB;
constexpr size_t WS_BIG = 354 * MiB;
constexpr size_t WS_Q = WS_BIG, WS_K = WS_Q + 72 * MiB, WS_V = WS_K + 18 * MiB, WS_CU = WS_V + 18 * MiB, WS_YT = WS_CU + 36 * MiB, WS_YTC = WS_YT + 64 * MiB;
constexpr size_t WS_GATES = WS_BIG;
constexpr size_t WS_AO = WS_BIG + 216 * MiB, WS_CH = WS_AO + 72 * MiB, WS_Z = WS_CH + 36 * MiB;
constexpr size_t WS_MIX = WS_AO;
constexpr size_t WS_MERGED = WS_BIG + 360 * MiB;
constexpr int SLOT_ROWS = 608 * 256;
constexpr size_t WS_YS = WS_BIG, WS_HS = WS_BIG + 304 * MiB, WS_ACT = WS_BIG + 456 * MiB, WS_END = WS_BIG + 608 * MiB;
constexpr size_t WS_H8 = WS_END;
constexpr size_t WS_END2 = WS_END + 36 * MiB;
static_assert(WS_YTC + 8 * MiB == WS_AO && WS_Z + 36 * MiB == WS_MERGED && WS_MERGED + 72 * MiB <= WS_END && (size_t)SLOT_ROWS * 2048 == 304 * MiB, "ws map");
constexpr int CW_TMO = 0, CW_CODE = 1, CW_BAR = 4096;
constexpr int CNT_TILE_E = 16384, CNT_NT = 16384 + 1024;

constexpr int RING_OFF = 0, RING_BYTES = 131072;
constexpr int LDSCTL_OFF = RING_BYTES, MISC_OFF = LDSCTL_OFF + 320, LDS_CT = LDSCTL_OFF + 512, LDS_SM = LDSCTL_OFF + 1024;
constexpr int LDS_BYTES = 147456;

typedef unsigned u32x2 __attribute__((ext_vector_type(2)));
typedef int i32x4 __attribute__((ext_vector_type(4)));
typedef float f32x2 __attribute__((ext_vector_type(2)));
struct Args { const float* in[29]; float* out; unsigned char* ws; int ph_lo, ph_hi; };
typedef const __attribute__((address_space(4))) unsigned char* kptr_t;
struct AV {
    kptr_t kp;
    __device__ __forceinline__ const float* in(int i) const { return *(const float* const __attribute__((address_space(4)))*)(kp + 8 * i); }
    __device__ __forceinline__ float* out() const { return *(float* const __attribute__((address_space(4)))*)(kp + 8 * 29); }
    __device__ __forceinline__ unsigned char* ws() const { return *(unsigned char* const __attribute__((address_space(4)))*)(kp + 8 * 30); }
};
__device__ __forceinline__ AV av_get() { AV a; a.kp = (kptr_t)__builtin_amdgcn_kernarg_segment_ptr(); asm volatile("" : "+s"(a.kp)); return a; }

struct Frame {
    LAS unsigned char* lds; volatile LAS unsigned* MISC; gu32* ctl;
    int tid, lane, wave, vcu, G;
};

__device__ __forceinline__ float shx(float v, int m, int lane) { return __int_as_float(__builtin_amdgcn_ds_bpermute((lane ^ m) << 2, __float_as_int(v))); }
__device__ __forceinline__ float wave_sum(float v, int lane) {
#pragma unroll
    for (int o = 1; o < 64; o <<= 1) v += shx(v, o, lane);
    return v;
}
__device__ __forceinline__ float sigmoidf_(float x) { return 1.0f / (1.0f + __expf(-x)); }
__device__ __forceinline__ f32x4 bf4(u32x2 w) { f32x4 r; r[0] = __uint_as_float(w.x << 16); r[1] = __uint_as_float(w.x & 0xffff0000u); r[2] = __uint_as_float(w.y << 16); r[3] = __uint_as_float(w.y & 0xffff0000u); return r; }
__device__ __forceinline__ u32x2 pk4(f32x4 v) { u32x2 w; w.x = pk2(v[0], v[1]); w.y = pk2(v[2], v[3]); return w; }
__device__ __forceinline__ void ld_row_f32(f32x4 (&v)[4], const float* p, int lane) {
#pragma unroll
    for (int j = 0; j < 4; ++j) v[j] = ((const GAS f32x4*)p)[lane + 64 * j];
}
__device__ __forceinline__ void st_row_f32(const f32x4 (&v)[4], float* p, int lane) {
#pragma unroll
    for (int j = 0; j < 4; ++j) ((GAS f32x4*)p)[lane + 64 * j] = v[j];
}
__device__ __forceinline__ void ld_row_bf16(f32x4 (&v)[4], const bf16* p, int lane) {
#pragma unroll
    for (int j = 0; j < 4; ++j) v[j] = bf4(((const GAS u32x2*)p)[lane + 64 * j]);
}
__device__ __forceinline__ void st_row_bf16(const f32x4 (&v)[4], bf16* p, int lane) {
#pragma unroll
    for (int j = 0; j < 4; ++j) ((GAS u32x2*)p)[lane + 64 * j] = pk4(v[j]);
}
__device__ __forceinline__ void rms_gain(f32x4 (&v)[4], const float* g, int lane) {
    float ss = 0.f;
#pragma unroll
    for (int j = 0; j < 4; ++j) ss += (v[j][0] * v[j][0] + v[j][1] * v[j][1]) + (v[j][2] * v[j][2] + v[j][3] * v[j][3]);
    const float r = 1.0f / sqrtf(wave_sum(ss, lane) * (1.0f / 1024.0f) + EPS);
#pragma unroll
    for (int j = 0; j < 4; ++j) { const f32x4 gg = ((const GAS f32x4*)g)[lane + 64 * j]; v[j] = v[j] * r * gg; }
}
__device__ __forceinline__ void modulate_store(const f32x4 (&v)[4], const float* shift, const float* scale, bf16* o, int lane) {
#pragma unroll
    for (int j = 0; j < 4; ++j) { const f32x4 sh = ((const GAS f32x4*)shift)[lane + 64 * j], sc = ((const GAS f32x4*)scale)[lane + 64 * j];
        ((GAS u32x2*)o)[lane + 64 * j] = pk4(v[j] * (sc + 1.0f) + sh); }
}
__device__ __forceinline__ unsigned pk4_fp8(f32x4 v) { return pg8::cvt4_fp8(v[0], v[1], v[2], v[3]); }
__device__ __forceinline__ void modulate_store2(const f32x4 (&v)[4], const float* shift, const float* scale, bf16* o, unsigned char* o8, int lane) {
#pragma unroll
    for (int j = 0; j < 4; ++j) { const f32x4 sh = ((const GAS f32x4*)shift)[lane + 64 * j], sc = ((const GAS f32x4*)scale)[lane + 64 * j]; const f32x4 r = v[j] * (sc + 1.0f) + sh;
        ((GAS u32x2*)o)[lane + 64 * j] = pk4(r); ((GAS unsigned*)o8)[lane + 64 * j] = pk4_fp8(r); }
}
__device__ __forceinline__ int krow_of(int m) { return m < TL ? (m >> 11) * KVROWS + (m & 2047) : ((m - TL) >> 8) * KVROWS + SEQ + ((m - TL) & 255); }

__device__ __forceinline__ void load_block(const float* W, int ldw, int k0, int n0, float scale, LAS float* scr, int lane) {
    f32x4 v[8]; const int kr = lane >> 3, c4 = (lane & 7) * 4;
#pragma unroll
    for (int i = 0; i < 8; ++i) v[i] = *(const GAS f32x4*)(W + (size_t)(k0 + kr + 8 * i) * ldw + n0 + c4);
#pragma unroll
    for (int i = 0; i < 8; ++i) { LAS float* d = scr + (kr + 8 * i) * 33 + c4; d[0] = v[i][0] * scale; d[1] = v[i][1] * scale; d[2] = v[i][2] * scale; d[3] = v[i][3] * scale; }
    LDS_WAIT(); asm volatile("" ::: "memory");
}
__device__ __forceinline__ void transpose_item(const float* W, int ldw, int K, bf16* WT, int dst_row0, int k0, int n0, LAS float* scr, int lane) {
    load_block(W, ldw, k0, n0, 1.0f, scr, lane);
    const int c = lane & 7;
#pragma unroll
    for (int j = 0; j < 4; ++j) { const int n = (lane >> 3) + 8 * j; const LAS float* s = scr + (8 * c) * 33 + n;
        v4u o; o.x = pk2(s[0 * 33], s[1 * 33]); o.y = pk2(s[2 * 33], s[3 * 33]); o.z = pk2(s[4 * 33], s[5 * 33]); o.w = pk2(s[6 * 33], s[7 * 33]);
        *(GAS v4u*)(WT + (size_t)(dst_row0 + n) * K + k0 + 8 * c) = o; }
    LDS_WAIT(); asm volatile("" ::: "memory");
}
__device__ __forceinline__ void transpose_item_fp8(const float* W, int ldw, int K, unsigned char* WT, int dst_row0, int k0, int n0, float scale, LAS float* scr, int lane) {
    load_block(W, ldw, k0, n0, scale, scr, lane);
#pragma unroll
    for (int j = 0; j < 2; ++j) { const int q = lane + 64 * j, n = q >> 2, c = q & 3; const LAS float* s = scr + (16 * c) * 33 + n; v4u o;
        o.x = pg8::cvt4_fp8(s[0 * 33], s[1 * 33], s[2 * 33], s[3 * 33]); o.y = pg8::cvt4_fp8(s[4 * 33], s[5 * 33], s[6 * 33], s[7 * 33]); o.z = pg8::cvt4_fp8(s[8 * 33], s[9 * 33], s[10 * 33], s[11 * 33]); o.w = pg8::cvt4_fp8(s[12 * 33], s[13 * 33], s[14 * 33], s[15 * 33]);
        *(GAS v4u*)(WT + (size_t)(dst_row0 + n) * K + k0 + 16 * c) = o; }
    LDS_WAIT(); asm volatile("" ::: "memory");
}
constexpr int IT_S0 = 16 * 80, IT_S1 = 16 * 96, IT_S2 = 512, IT_S3 = 512, IT_S4 = 256, IT_S5 = 256, IT_SMALL = IT_S0 + IT_S1 + IT_S2 + IT_S3 + IT_S4 + IT_S5;
__device__ __forceinline__ void small_item(const AV& a, int l, int r, LAS float* scr, int lane) {
    unsigned char* wl = a.ws() + WS_WSMALL + (size_t)l * WSMALL_LAYER; const float* win = a.in(10) + (size_t)l * DM * INCOLS;
    if (r < IT_S0) { const int kb = r / 80, n0 = (r % 80) * 32; int dr;
        if (n0 < 1536) dr = n0; else { int cc = n0 - 1536; if (cc < 512) dr = 1536 + (cc >> 7) * 256 + (cc & 127); else { cc -= 512; dr = 1536 + (cc >> 7) * 256 + 128 + (cc & 127); } }
        transpose_item_fp8(win, INCOLS, DM, wl + OFFS_WIN, dr, kb * 64, n0, 32.0f, scr, lane); return; }
    r -= IT_S0;
    if (r < IT_S1) { const int kb = r / 96, nb = r % 96; transpose_item_fp8(win, INCOLS, DM, wl + OFFS_WG, nb * 32, kb * 64, OFF_GATE + nb * 32, 32.0f, scr, lane); return; }
    r -= IT_S1;
    if (r < IT_S2) { const int kb = r / 32, nb = r % 32; transpose_item_fp8(a.in(13) + (size_t)l * DM * DM, DM, DM, wl + OFFS_WAO, nb * 32, kb * 64, nb * 32, 32.0f, scr, lane); return; }
    r -= IT_S2;
    if (r < IT_S3) { const int kb = r / 32, nb = r % 32; transpose_item(a.in(20) + (size_t)l * DM * DM, DM, DM, (bf16*)(wl + OFFS_WOUT), nb * 32, kb * 64, nb * 32, scr, lane); return; }
    r -= IT_S3;
    if (r < IT_S4) { const int kb = r / 32, nb = r % 32; transpose_item(a.in(18) + (size_t)l * 512 * DM, DM, 512, (bf16*)(wl + OFFS_WCO), nb * 32, kb * 64, nb * 32, scr, lane); return; }
    r -= IT_S4;
    { const int kb = r / 32, nb = r % 32; transpose_item(a.in(19) + (size_t)l * 512 * DM, DM, 512, (bf16*)(wl + OFFS_WFO), nb * 32, kb * 64, nb * 32, scr, lane); }
}
constexpr int IT_MOE = NEXP * 3 * 512;
struct MoeIt { const float* W; unsigned char* WT; int dr, k0; };
__device__ __forceinline__ MoeIt moe_decode(const AV& a, int gi) {
    const int l = gi / IT_MOE, idx = gi % IT_MOE, e = idx / 1536, r = idx % 1536, which = r / 512, it = r % 512, kb = it / 32, n0 = (it % 32) * 32; const size_t eo = ((size_t)l * NEXP + e) << 20;
    MoeIt m; m.k0 = kb * 64;
    if (which == 0) { m.W = a.in(23) + eo + n0; m.WT = a.ws() + WS_WGU + (size_t)l * MOEW_LAYER + (size_t)e * 2048 * 1024; m.dr = (n0 >> 7) * 256 + (n0 & 127); }
    else if (which == 1) { m.W = a.in(25) + eo + n0; m.WT = a.ws() + WS_WGU + (size_t)l * MOEW_LAYER + (size_t)e * 2048 * 1024; m.dr = (n0 >> 7) * 256 + 128 + (n0 & 127); }
    else { m.W = a.in(27) + eo + n0; m.WT = a.ws() + WS_WD + (size_t)l * MOEW_LAYER + (size_t)e * 1024 * 1024; m.dr = n0; }
    return m;
}
__device__ __forceinline__ void moe_issue(f32x4 (&v)[8], const MoeIt& m, int lane) {
    const float* p = m.W + (size_t)(m.k0 + (lane >> 3)) * DM + (lane & 7) * 4;
#pragma unroll
    for (int i = 0; i < 8; ++i) v[i] = *(const GAS f32x4*)(p + (size_t)(8 * i) * DM);
}
__device__ __forceinline__ void moe_finish(const f32x4 (&v)[8], const MoeIt& m, LAS float* scr, int lane) {
    const int kr = lane >> 3, c4 = (lane & 7) * 4;
#pragma unroll
    for (int i = 0; i < 8; ++i) { LAS float* d = scr + (kr + 8 * i) * 33 + c4; d[0] = v[i][0] * 32.0f; d[1] = v[i][1] * 32.0f; d[2] = v[i][2] * 32.0f; d[3] = v[i][3] * 32.0f; }
    LDS_WAIT(); asm volatile("" ::: "memory");
#pragma unroll
    for (int j = 0; j < 2; ++j) { const int q = lane + 64 * j, n = q >> 2, c = q & 3; const LAS float* s = scr + (16 * c) * 33 + n; v4u o;
        o.x = pg8::cvt4_fp8(s[0 * 33], s[1 * 33], s[2 * 33], s[3 * 33]); o.y = pg8::cvt4_fp8(s[4 * 33], s[5 * 33], s[6 * 33], s[7 * 33]); o.z = pg8::cvt4_fp8(s[8 * 33], s[9 * 33], s[10 * 33], s[11 * 33]); o.w = pg8::cvt4_fp8(s[12 * 33], s[13 * 33], s[14 * 33], s[15 * 33]);
        *(GAS v4u*)(m.WT + (size_t)(m.dr + n) * DM + m.k0 + 16 * c) = o; }
    LDS_WAIT(); asm volatile("" ::: "memory");
}
__device__ __forceinline__ void moe_convert_all(const AV& a, int gw, int NGW, LAS float* scr, int lane) {
    constexpr int NIT = 2 * IT_MOE; f32x4 va[8], vb[8]; int it = gw; if (it >= NIT) return;
    MoeIt ma = moe_decode(a, it), mb = ma; moe_issue(va, ma, lane);
    for (;;) {
        const bool h1 = it + NGW < NIT; if (h1) { mb = moe_decode(a, it + NGW); moe_issue(vb, mb, lane); }
        moe_finish(va, ma, scr, lane); if (!h1) break; it += NGW;
        const bool h2 = it + NGW < NIT; if (h2) { ma = moe_decode(a, it + NGW); moe_issue(va, ma, lane); }
        moe_finish(vb, mb, scr, lane); if (!h2) break; it += NGW;
    }
}
__device__ __forceinline__ void fold_job(const AV& a, int j, const LAS float* ct, int lane) {
    const int l = j >> 10, r = j & 1023, g = r >> 8, kblk = (r >> 4) & 15, k2g = r & 15, k = kblk * 64 + lane;
    const float* wrow = a.in(10) + (size_t)l * DM * INCOLS + (size_t)k * INCOLS + OFF_FNET + g * 128;
    float ac[8], as[8];
#pragma unroll
    for (int i = 0; i < 8; ++i) { ac[i] = 0.f; as[i] = 0.f; }
    for (int n4 = 0; n4 < 32; ++n4) { const f32x4 w = *(const GAS f32x4*)(wrow + n4 * 4);
#pragma unroll
        for (int q = 0; q < 4; ++q) { const int n2 = n4 * 4 + q;
#pragma unroll
            for (int i = 0; i < 8; ++i) { const int ph = (n2 * (k2g * 8 + i)) & 127; ac[i] += w[q] * ct[ph]; as[i] += w[q] * ct[(ph - 32) & 127]; } } }
    bf16* wf = (bf16*)(a.ws() + WS_WSMALL + (size_t)l * WSMALL_LAYER + OFFS_WF);
#pragma unroll
    for (int i = 0; i < 8; ++i) { const int ch = g * 128 + k2g * 8 + i;
        wf[(size_t)ch * 1024 + k] = (bf16)f2bf(ac[i] * 0.08838834764831845f); wf[(size_t)(512 + ch) * 1024 + k] = (bf16)f2bf(as[i] * 0.08838834764831845f); }
}
__device__ __forceinline__ void p0_prologue(const Frame& F, const AV& a) {
    const int gw = F.vcu * NWAVES + F.wave, NGW = F.G * NWAVES, gt = F.vcu * NTHR + F.tid, NGT = F.G * NTHR;
    LAS float* ct = (LAS float*)(F.lds + LDS_CT);
    if (F.tid < 128) ct[F.tid] = cospif((float)F.tid * (1.0f / 64.0f));
    for (int job = blockIdx.x; job < 2 * 96; job += F.G) {
        const int l = job / 96, n0 = (job % 96) * 64;
        LAS float* s = (LAS float*)(F.lds + RING_OFF); LAS float* red = s + 17 * 1024;
        for (int i = F.tid; i < 17 * 1024; i += NTHR) { const int b = i >> 10, k = i & 1023; const float cv = b < 16 ? a.in(1)[b * 1024 + k] : a.in(3)[k]; s[i] = cv * sigmoidf_(cv); }
        __syncthreads();
        const int col = F.tid & 63, ks = F.tid >> 6; float acc[17];
#pragma unroll
        for (int b = 0; b < 17; ++b) acc[b] = 0.f;
        const float* w = a.in(4) + (size_t)l * DM * INCOLS + n0 + col;
        for (int k = ks * 128; k < ks * 128 + 128; k += 16) { float wv[16];
#pragma unroll
            for (int q = 0; q < 16; ++q) wv[q] = w[(size_t)(k + q) * INCOLS];
#pragma unroll
            for (int q = 0; q < 16; ++q)
#pragma unroll
                for (int b = 0; b < 17; ++b) acc[b] += s[b * 1024 + k + q] * wv[q]; }
#pragma unroll
        for (int b = 0; b < 17; ++b) red[(ks * 17 + b) * 64 + col] = acc[b];
        __syncthreads();
        for (int i = F.tid; i < 17 * 64; i += NTHR) { const int b = i >> 6, c2 = i & 63; float t = 0.f;
#pragma unroll
            for (int q = 0; q < 8; ++q) t += red[(q * 17 + b) * 64 + c2];
            ((float*)(a.ws() + WS_MOD))[((size_t)l * 17 + b) * INCOLS + n0 + c2] = t + a.in(5)[l * INCOLS + n0 + c2]; }
        __syncthreads();
    }
    __syncthreads();
    for (int i = gt; i < 64 * 32; i += NGT) { const int p = i >> 5, f = i & 31; const float inv = powf(10000.0f, -(float)f / 32.0f), ang = (float)p * inv; ((f32x2*)(a.ws() + WS_TAB))[i] = (f32x2){cosf(ang), sinf(ang)}; }
    for (int i = gt; i < 2048 * 256; i += NGT) { const int k1 = i >> 8, c0 = (i & 255) * 16; float v[16];
#pragma unroll
        for (int q = 0; q < 16; ++q) { const int col = c0 + q, n1 = col & 2047, rr = (k1 * n1) & 2047; const float x = (float)rr * (1.0f / 1024.0f); v[q] = ((col >> 11) ? -sinpif(x) : cospif(x)) * (32.0f * 0.022097086912079608f); }
        v4u o; o.x = pk4_fp8((f32x4){v[0], v[1], v[2], v[3]}); o.y = pk4_fp8((f32x4){v[4], v[5], v[6], v[7]}); o.z = pk4_fp8((f32x4){v[8], v[9], v[10], v[11]}); o.w = pk4_fp8((f32x4){v[12], v[13], v[14], v[15]}); ((GAS v4u*)(a.ws() + WS_DFTL))[i] = o; }
    for (int i = gt; i < 256 * 32; i += NGT) { const int k1 = i >> 5, c0 = (i & 31) * 16; float v[16];
#pragma unroll
        for (int q = 0; q < 16; ++q) { const int col = c0 + q, n1 = col & 255, rr = (k1 * n1) & 255; const float x = (float)rr * (1.0f / 128.0f); v[q] = ((col >> 8) ? -sinpif(x) : cospif(x)) * (32.0f * 0.0625f); }
        v4u o; o.x = pk4_fp8((f32x4){v[0], v[1], v[2], v[3]}); o.y = pk4_fp8((f32x4){v[4], v[5], v[6], v[7]}); o.z = pk4_fp8((f32x4){v[8], v[9], v[10], v[11]}); o.w = pk4_fp8((f32x4){v[12], v[13], v[14], v[15]}); ((GAS v4u*)(a.ws() + WS_DFTC))[i] = o; }
    for (int i = gt; i < 2 * 256 * 1024; i += NGT) { const int l = i >> 18, r = (i >> 10) & 255, k = i & 1023; unsigned o = 0u;
        if (r < 64) { const float w = a.in(21)[((size_t)l * DM + k) * NEXP + (r & 31)]; const unsigned hi = f2bf(w); o = hi; if (r >= 32) o = f2bf(w - __uint_as_float(hi << 16)); }
        ((bf16*)(a.ws() + WS_WSMALL + (size_t)l * WSMALL_LAYER + OFFS_ROUT))[(size_t)r * 1024 + k] = (bf16)o; }
    for (int j = gw; j < 2048; j += NGW) fold_job(a, j, ct, F.lane);
    LAS float* scr = (LAS float*)(F.lds + RING_OFF + F.wave * 16384);
    for (int it = gw; it < 2 * IT_SMALL; it += NGW) small_item(a, it / IT_SMALL, it % IT_SMALL, scr, F.lane);
    moe_convert_all(a, gw, NGW, scr, F.lane);
}
__device__ __forceinline__ void p1_norm0(const Frame& F, const AV& a) {
    const int gw = F.vcu * NWAVES + F.wave, NGW = F.G * NWAVES;
    for (int m = gw; m < TALL; m += NGW) {
        f32x4 v[4]; ld_row_f32(v, m < TL ? a.in(0) + (size_t)m * DM : a.in(2) + (size_t)(m - TL) * DM, F.lane);
        rms_gain(v, a.in(6), F.lane);
        const float* modv = (const float*)(a.ws() + WS_MOD) + (size_t)(m < TL ? (m >> 11) : 16) * INCOLS;
        modulate_store2(v, modv, modv + 1024, (bf16*)(a.ws() + WS_H) + (size_t)m * DM, a.ws() + WS_H8 + (size_t)m * DM, F.lane);
    }
}
__device__ __forceinline__ void qk_fix_vec(bf16* p, const float* g, const f32x2* tab, bool rope, int t, int sub, int lane) {
    f32x4 x[4]; float ss = 0.f;
#pragma unroll
    for (int jj = 0; jj < 4; ++jj) { x[jj] = bf4(*(const GAS u32x2*)(p + jj * 32 + sub * 4)); ss += (x[jj][0] * x[jj][0] + x[jj][1] * x[jj][1]) + (x[jj][2] * x[jj][2] + x[jj][3] * x[jj][3]); }
    ss += shx(ss, 1, lane); ss += shx(ss, 2, lane); ss += shx(ss, 4, lane);
    const float r = 1.0f / sqrtf(ss * (1.0f / 128.0f) + EPS);
#pragma unroll
    for (int jj = 0; jj < 4; ++jj) { const f32x4 gg = *(const GAS f32x4*)(g + jj * 32 + sub * 4); x[jj] = x[jj] * r * gg; }
    if (rope) { const int pr = t >> 6, pc = t & 63;
#pragma unroll
        for (int i = 0; i < 4; ++i) { const f32x2 cr = tab[pr * 32 + sub * 4 + i], cc = tab[pc * 32 + sub * 4 + i];
            const float a0 = x[0][i], a1 = x[1][i], b0 = x[2][i], b1 = x[3][i];
            x[0][i] = a0 * cr.x - a1 * cr.y; x[1][i] = a1 * cr.x + a0 * cr.y; x[2][i] = b0 * cc.x - b1 * cc.y; x[3][i] = b1 * cc.x + b0 * cc.y; } }
#pragma unroll
    for (int jj = 0; jj < 4; ++jj) *(GAS u32x2*)(p + jj * 32 + sub * 4) = pk4(x[jj]);
}
__device__ __forceinline__ void p_qkfix(const Frame& F, const AV& a, int l, int M) {
    const int gw = F.vcu * NWAVES + F.wave, NGW = F.G * NWAVES; const f32x2* tab = (const f32x2*)(a.ws() + WS_TAB);
    for (int m = gw; m < M; m += NGW) { const bool lat = m < TL; const int t = m & 2047, hh = F.lane >> 3, sub = F.lane & 7;
        if (lat || l == 0) qk_fix_vec((bf16*)(a.ws() + WS_Q) + (size_t)m * DM + hh * 128, a.in(11) + l * 128, tab, lat, t, sub, F.lane);
        if (F.lane < 16) qk_fix_vec((bf16*)(a.ws() + WS_K) + (size_t)krow_of(m) * 256 + hh * 128, a.in(12) + l * 128, tab, lat, t, sub, F.lane);
    }
}
__device__ __forceinline__ void p_conv(const Frame& F, const AV& a, int l, int njobs) {
    LAS unsigned char* lin = F.lds + RING_OFF; LAS float* lout = (LAS float*)(F.lds + RING_OFF + 62 * 1024);
    const bf16* cu = (const bf16*)(a.ws() + WS_CU); bf16* chb = (bf16*)(a.ws() + WS_CH);
    const int cp = F.tid & 255, pg = F.tid >> 8;
    f32x2 wv[31];
#pragma unroll
    for (int j = 0; j < 31; ++j) wv[j] = *(const GAS f32x2*)(a.in(14) + ((size_t)l * 31 + j) * 512 + 2 * cp);
    const f32x2 cb2 = *(const GAS f32x2*)(a.in(15) + l * 512 + 2 * cp);
    for (int job = F.vcu; job < njobs; job += F.G) {
        int rowbase, L, t0;
        if (job < 1024) { rowbase = (job >> 6) * SEQ; L = SEQ; t0 = (job & 63) * 32; } else { const int jc = job - 1024; rowbase = TL + (jc >> 3) * CTXL; L = CTXL; t0 = (jc & 7) * 32; }
        for (int idx = F.tid; idx < 62 * 64; idx += NTHR) { const int row = idx >> 6, ch = idx & 63, p = t0 - 15 + row; v4u val = (v4u){0u, 0u, 0u, 0u};
            if (p >= 0 && p < L) val = *(const GAS v4u*)(cu + (size_t)(rowbase + p) * 512 + ch * 8);
            *(LAS v4u*)(lin + row * 1024 + ch * 16) = val; }
        __syncthreads();
#pragma unroll
        for (int chunk = 0; chunk < 2; ++chunk) {
            f32x2 acc[8];
#pragma unroll
            for (int i = 0; i < 8; ++i) acc[i] = cb2;
            const int r0 = pg * 16 + chunk * 8;
#pragma unroll
            for (int r = 0; r < 38; ++r) { const unsigned w = *(const LAS unsigned*)(lin + (r0 + r) * 1024 + cp * 4); const float x0 = __uint_as_float(w << 16), x1 = __uint_as_float(w & 0xffff0000u);
#pragma unroll
                for (int i = 0; i < 8; ++i) { const int j = r - i; if (j >= 0 && j <= 30) { acc[i].x += x0 * wv[j].x; acc[i].y += x1 * wv[j].y; } } }
#pragma unroll
            for (int i = 0; i < 8; ++i) *(LAS f32x2*)(lout + (r0 + i) * 512 + 2 * cp) = acc[i];
        }
        __syncthreads();
#pragma unroll
        for (int pp = 0; pp < 4; ++pp) { const int p = F.wave * 4 + pp; const LAS float* src = lout + p * 512 + F.lane * 8;
            f32x4 y0 = *(const LAS f32x4*)src, y1 = *(const LAS f32x4*)(src + 4);
            const float mean = wave_sum((y0[0] + y0[1]) + (y0[2] + y0[3]) + (y1[0] + y1[1]) + (y1[2] + y1[3]), F.lane) * (1.0f / 512.0f);
            y0 = y0 - mean; y1 = y1 - mean;
            const float var = wave_sum((y0[0] * y0[0] + y0[1] * y0[1]) + (y0[2] * y0[2] + y0[3] * y0[3]) + (y1[0] * y1[0] + y1[1] * y1[1]) + (y1[2] * y1[2] + y1[3] * y1[3]), F.lane) * (1.0f / 512.0f);
            const float rs = 1.0f / sqrtf(var + EPS);
            const f32x4 g0 = *(const GAS f32x4*)(a.in(16) + l * 512 + F.lane * 8), g1 = *(const GAS f32x4*)(a.in(16) + l * 512 + F.lane * 8 + 4);
            const f32x4 b0 = *(const GAS f32x4*)(a.in(17) + l * 512 + F.lane * 8), b1 = *(const GAS f32x4*)(a.in(17) + l * 512 + F.lane * 8 + 4);
            y0 = y0 * rs * g0 + b0; y1 = y1 * rs * g1 + b1;
#pragma unroll
            for (int q = 0; q < 4; ++q) { y0[q] = y0[q] * sigmoidf_(y0[q]); y1[q] = y1[q] * sigmoidf_(y1[q]); }
            v4u o; o.x = pk2(y0[0], y0[1]); o.y = pk2(y0[2], y0[3]); o.z = pk2(y1[0], y1[1]); o.w = pk2(y1[2], y1[3]);
            *(GAS v4u*)(chb + (size_t)(rowbase + t0 + p) * 512 + F.lane * 8) = o; }
        __syncthreads();
    }
}
__device__ __forceinline__ void p_rowpass1(const Frame& F, const AV& a, int l, int M) {
    const int gw = F.vcu * NWAVES + F.wave, NGW = F.G * NWAVES;
    for (int m = gw; m < M; m += NGW) {
        const float* xs = (l == 0) ? (m < TL ? a.in(0) + (size_t)m * DM : a.in(2) + (size_t)(m - TL) * DM) : (m < TL ? a.out() + (size_t)m * DM : (const float*)(a.ws() + WS_XC) + (size_t)(m - TL) * DM);
        float* xd = m < TL ? a.out() + (size_t)m * DM : (float*)(a.ws() + WS_XC) + (size_t)(m - TL) * DM;
        const float* modv = (const float*)(a.ws() + WS_MOD) + ((size_t)l * 17 + (m < TL ? (m >> 11) : 16)) * INCOLS;
        f32x4 x[4], y[4]; ld_row_f32(x, xs, F.lane); ld_row_bf16(y, (const bf16*)(a.ws() + WS_MIX) + (size_t)m * DM, F.lane);
        rms_gain(y, a.in(7) + l * DM, F.lane);
#pragma unroll
        for (int j = 0; j < 4; ++j) { const f32x4 gt = ((const GAS f32x4*)(modv + 2 * 1024))[F.lane + 64 * j]; x[j] = x[j] + gt * y[j]; }
        st_row_f32(x, xd, F.lane);
        rms_gain(x, a.in(8) + l * DM, F.lane);
        modulate_store(x, modv + 3 * 1024, modv + 4 * 1024, (bf16*)(a.ws() + WS_H) + (size_t)m * DM, F.lane);
    }
}
__device__ __forceinline__ void p_topk(const Frame& F, const AV& a, int l, int M) {
    LAS int* cntl = (LAS int*)(F.lds + LDS_SM);
    if (F.tid < 32) cntl[F.tid] = 0;
    __syncthreads();
    const int TPB = (M + F.G - 1) / F.G, m0 = blockIdx.x * TPB, m1 = (m0 + TPB < M) ? m0 + TPB : M;
    const float* lg = (const float*)(a.ws() + WS_LOGIT);
    for (int m = m0 + F.wave; m < m1; m += NWAVES) {
        float v = -3.0e38f;
        if (F.lane < 32) v = lg[(size_t)m * 64 + F.lane] + lg[(size_t)m * 64 + 32 + F.lane] + a.in(22)[l * NEXP + F.lane];
        unsigned ub = __float_as_uint(v); ub = (ub & 0x80000000u) ? ~ub : (ub | 0x80000000u);
        unsigned long long key = ((unsigned long long)ub << 32) | (unsigned)(63 - F.lane);
        int ids[4]; float vals[4];
#pragma unroll
        for (int k = 0; k < 4; ++k) { unsigned long long mx = key;
#pragma unroll
            for (int o = 1; o < 64; o <<= 1) { const int pa = (F.lane ^ o) << 2; const unsigned long long t = ((unsigned long long)(unsigned)__builtin_amdgcn_ds_bpermute(pa, (int)(unsigned)(mx >> 32)) << 32) | (unsigned)__builtin_amdgcn_ds_bpermute(pa, (int)(unsigned)mx); mx = t > mx ? t : mx; }
            const int id = 63 - (int)(mx & 63ull); ids[k] = id; vals[k] = __int_as_float(__builtin_amdgcn_ds_bpermute(id << 2, __float_as_int(v))); if (F.lane == id) key = 0ull; }
        const float e1 = __expf(vals[1] - vals[0]), e2 = __expf(vals[2] - vals[0]), e3 = __expf(vals[3] - vals[0]), inv = 1.0f / (1.0f + e1 + e2 + e3);
        if (F.lane == 0) { *(GAS i32x4*)((int*)(a.ws() + WS_TOPI) + (size_t)m * 4) = (i32x4){ids[0], ids[1], ids[2], ids[3]};
            *(GAS f32x4*)((float*)(a.ws() + WS_TOPP) + (size_t)m * 4) = (f32x4){inv, e1 * inv, e2 * inv, e3 * inv}; }
        if (F.lane < 4) __hip_atomic_fetch_add(&cntl[F.lane == 0 ? ids[0] : F.lane == 1 ? ids[1] : F.lane == 2 ? ids[2] : ids[3]], 1, __ATOMIC_RELAXED, __HIP_MEMORY_SCOPE_WORKGROUP);
    }
    __syncthreads();
    if (F.tid < 32) ((int*)(a.ws() + WS_CNT))[blockIdx.x * 32 + F.tid] = cntl[F.tid];
}
__device__ __forceinline__ void p_slots(const Frame& F, const AV& a, int M) {
    LAS int* sm = (LAS int*)(F.lds + LDS_SM);
    LAS int *tot = sm, *bef = sm + 32, *base = sm + 64, *tst = sm + 96  , *mask = sm + 160  , *ids = sm + 320  , *slot = sm + 960  ;
    const int* cnt = (const int*)(a.ws() + WS_CNT);
    { LAS int* ptot = sm + 1600; LAS int* pbef = sm + 2112; const int e = F.tid & 31, part = F.tid >> 5; int t = 0, b = 0;
#pragma unroll 4
      for (int q = part; q < F.G; q += 16) { const int c = cnt[q * 32 + e]; t += c; if (q < (int)blockIdx.x) b += c; }
      ptot[part * 32 + e] = t; pbef[part * 32 + e] = b;
      __syncthreads();
      if (F.tid < 32) { int tt = 0, bb = 0;
#pragma unroll
          for (int q = 0; q < 16; ++q) { tt += ptot[q * 32 + F.tid]; bb += pbef[q * 32 + F.tid]; }
          tot[F.tid] = tt; bef[F.tid] = bb; } }
    __syncthreads();
    if (F.tid == 0) { int ts = 0; for (int e = 0; e < 32; ++e) { tst[e] = ts; base[e] = ts * 256 + bef[e]; ts += (tot[e] + 255) >> 8; } tst[32] = ts; }
    __syncthreads();
    const int NT = tst[32];
    if (blockIdx.x == 0) { int* te = (int*)(a.ws() + WS_CNT) + CNT_TILE_E;
        for (int t = F.tid; t < NT; t += NTHR) { int e = 0; for (int q = 1; q < 32; ++q) if (t >= tst[q]) e = q; te[t] = e; }
        if (F.tid == 0) ((int*)(a.ws() + WS_CNT))[CNT_NT] = NT; }
    const int TPB = (M + F.G - 1) / F.G, m0 = blockIdx.x * TPB, m1 = (m0 + TPB < M) ? m0 + TPB : M, nt = m1 > m0 ? m1 - m0 : 0;
    for (int tl = F.tid; tl < nt; tl += NTHR) { const i32x4 id = *(const GAS i32x4*)((const int*)(a.ws() + WS_TOPI) + (size_t)(m0 + tl) * 4);
        ids[tl * 4 + 0] = id.x; ids[tl * 4 + 1] = id.y; ids[tl * 4 + 2] = id.z; ids[tl * 4 + 3] = id.w; mask[tl] = (1 << id.x) | (1 << id.y) | (1 << id.z) | (1 << id.w); }
    __syncthreads();
    for (int p = F.tid; p < nt * 4; p += NTHR) { const int tl = p >> 2, e = ids[p]; int rank = 0; for (int q = 0; q < tl; ++q) rank += (mask[q] >> e) & 1;
        const int s = base[e] + rank; slot[p] = s; ((int*)(a.ws() + WS_SLOT))[(size_t)(m0 + tl) * 4 + (p & 3)] = s; }
    __syncthreads();
    const bf16* h = (const bf16*)(a.ws() + WS_H); unsigned char* hs = a.ws() + WS_HS;
    for (int p = F.wave; p < nt * 4; p += NWAVES) { const GAS v4u* src = (const GAS v4u*)(h + (size_t)(m0 + (p >> 2)) * DM); GAS u32x2* dst = (GAS u32x2*)(hs + (size_t)slot[p] * DM);
#pragma unroll
        for (int j = 0; j < 2; ++j) { const v4u x = src[F.lane + 64 * j]; u32x2 o;
            o.x = pg8::cvt4_fp8(__uint_as_float(x.x << 16), __uint_as_float(x.x & 0xffff0000u), __uint_as_float(x.y << 16), __uint_as_float(x.y & 0xffff0000u));
            o.y = pg8::cvt4_fp8(__uint_as_float(x.z << 16), __uint_as_float(x.z & 0xffff0000u), __uint_as_float(x.w << 16), __uint_as_float(x.w & 0xffff0000u));
            dst[F.lane + 64 * j] = o; } }
    if (blockIdx.x < 32) { const int e = blockIdx.x, r0 = tst[e] * 256 + tot[e], r1 = tst[e + 1] * 256;
        unsigned zz = 0u; asm volatile("" : "+v"(zz));
        for (int r = r0 + F.wave; r < r1; r += NWAVES) { GAS v4u* dst = (GAS v4u*)(hs + (size_t)r * DM); dst[F.lane] = (v4u){zz, zz, zz, zz}; } }
    __syncthreads();
}
__device__ __forceinline__ void p_combine(const Frame& F, const AV& a, int l, int M) {
    const int gw = F.vcu * NWAVES + F.wave, NGW = F.G * NWAVES; const bf16* ys = (const bf16*)(a.ws() + WS_YS);
    for (int m = gw; m < M; m += NGW) {
        const i32x4 sl = *(const GAS i32x4*)((const int*)(a.ws() + WS_SLOT) + (size_t)m * 4); const f32x4 pr = *(const GAS f32x4*)((const float*)(a.ws() + WS_TOPP) + (size_t)m * 4);
        f32x4 y[4], t[4];
        ld_row_bf16(y, ys + (size_t)sl.x * DM, F.lane);
#pragma unroll
        for (int j = 0; j < 4; ++j) y[j] = y[j] * pr[0];
        ld_row_bf16(t, ys + (size_t)sl.y * DM, F.lane);
#pragma unroll
        for (int j = 0; j < 4; ++j) y[j] += t[j] * pr[1];
        ld_row_bf16(t, ys + (size_t)sl.z * DM, F.lane);
#pragma unroll
        for (int j = 0; j < 4; ++j) y[j] += t[j] * pr[2];
        ld_row_bf16(t, ys + (size_t)sl.w * DM, F.lane);
#pragma unroll
        for (int j = 0; j < 4; ++j) y[j] += t[j] * pr[3];
        rms_gain(y, a.in(9) + l * DM, F.lane);
        float* xd = m < TL ? a.out() + (size_t)m * DM : (float*)(a.ws() + WS_XC) + (size_t)(m - TL) * DM;
        const int b = m < TL ? (m >> 11) : 16;
        const float* modv = (const float*)(a.ws() + WS_MOD) + ((size_t)l * 17 + b) * INCOLS;
        f32x4 x[4]; ld_row_f32(x, xd, F.lane);
#pragma unroll
        for (int j = 0; j < 4; ++j) { const f32x4 gt = ((const GAS f32x4*)(modv + 5 * 1024))[F.lane + 64 * j]; x[j] = x[j] + gt * y[j]; }
        st_row_f32(x, xd, F.lane);
        if (l == 0) { rms_gain(x, a.in(6) + DM, F.lane); const float* mod1 = (const float*)(a.ws() + WS_MOD) + ((size_t)17 + b) * INCOLS;
            modulate_store2(x, mod1, mod1 + 1024, (bf16*)(a.ws() + WS_H) + (size_t)m * DM, a.ws() + WS_H8 + (size_t)m * DM, F.lane); }
    }
}
#ifdef DBG_CHECK
#ifndef DBG_GSUB
#define DBG_GSUB 0
#endif
__device__ __forceinline__ double bfd(bf16 b) { return (double)__uint_as_float(((unsigned)b) << 16); }
__device__ __forceinline__ unsigned hsh(unsigned x) { x ^= x >> 16; x *= 0x7feb352du; x ^= x >> 15; x *= 0x846ca68bu; x ^= x >> 16; return x; }
__device__ __forceinline__ int samp_row(int i, int M, unsigned salt) { const int sp[12] = {0, 1, 255, 256, 2047, 2048, 4095, 32767, 32768, 32769, 33023, 36863}; if (i < 12 && sp[i] < M) return sp[i]; return (int)(hsh(i * 7919u + salt) % (unsigned)M); }
__device__ __forceinline__ void rec(float* res, int stage, double got, double want, double flo) { const double e = fabs(got - want) / (fabs(want) + flo); const float f = (e == e) ? (float)e : 1e30f; atomicMax((unsigned*)res + stage, __float_as_uint(f)); }
__device__ double dot_h_w(const bf16* hrow, const float* w, int ldw, int col) { double s = 0; for (int k = 0; k < 1024; ++k) s += bfd(hrow[k]) * (double)w[(size_t)k * ldw + col]; return s; }
__device__ double dsig(double x) { return 1.0 / (1.0 + exp(-x)); }
constexpr double PI_D = 3.14159265358979323846;
enum { ST_MOD = 0, ST_H0, ST_INPROJ, ST_YT, ST_QKFIX, ST_CONV, ST_Z, ST_ATTN, ST_GATES, ST_MERGED, ST_MIX, ST_ROW1, ST_LOGIT, ST_TOPK, ST_SLOTS, ST_ACT, ST_YSLOT, ST_COMB, ST_GATESB, ST_N };
__global__ void chk(Args A, int stage, int l, float* res, float* snap) {
    const int i = threadIdx.x; unsigned char* ws = A.ws; const int M = (l == 0) ? TALL : TL; const int rs = stage + 32 * l;
    const bf16* H = (const bf16*)(ws + WS_H); const float* win = A.in[10] + (size_t)l * DM * INCOLS; const float* modb = (const float*)(ws + WS_MOD);
    if (stage == ST_MOD) { const int ll = i & 1, b = (i >> 1) % 17, n = (int)(hsh(i) % 6144u); double s = 0; for (int k = 0; k < 1024; ++k) { const double cv = b < 16 ? A.in[1][b * 1024 + k] : A.in[3][k]; s += cv * dsig(cv) * (double)A.in[4][((size_t)ll * 1024 + k) * 6144 + n]; }
        s += A.in[5][ll * 6144 + n]; rec(res, rs, modb[((size_t)ll * 17 + b) * 6144 + n], s, 0.02); }
    else if (stage == ST_H0) { const int m = samp_row(i, TALL, 1), c = (int)(hsh(i + 77) % 1024u); const float* x = m < TL ? A.in[0] + (size_t)m * DM : A.in[2] + (size_t)(m - TL) * DM; double ss = 0; for (int k = 0; k < 1024; ++k) ss += (double)x[k] * x[k];
        const float* mv = modb + (size_t)(m < TL ? (m >> 11) : 16) * 6144; const double want = x[c] / sqrt(ss / 1024 + 1e-6) * A.in[6][c] * (1.0 + mv[1024 + c]) + mv[c]; rec(res, rs, bfd(H[(size_t)m * DM + c]), want, 0.05); }
    else if (stage == ST_INPROJ) { const int m = samp_row(i, TALL, 2), kind = i & 3; const bf16* hr = H + (size_t)m * DM;
        if (kind == 0) { const int n = (int)(hsh(i + 5) % 1024u); rec(res, rs, bfd(((const bf16*)(ws + WS_Q))[(size_t)m * DM + n]), dot_h_w(hr, win, INCOLS, n), 0.05); }
        else if (kind == 1) { const int n = (int)(hsh(i + 6) % 256u); rec(res, rs, bfd(((const bf16*)(ws + WS_K))[(size_t)krow_of(m) * 256 + n]), dot_h_w(hr, win, INCOLS, 1024 + n), 0.05); }
        else if (kind == 2) { const int n = (int)(hsh(i + 7) % 256u); rec(res, rs, bfd(((const bf16*)(ws + WS_V))[(size_t)krow_of(m) * 256 + n]), dot_h_w(hr, win, INCOLS, 1280 + n), 0.05); }
        else { const int c = (int)(hsh(i + 8) % 512u); if (l == 0 || m < TL) { const double a = dot_h_w(hr, win, INCOLS, 1536 + c), g = dot_h_w(hr, win, INCOLS, 2048 + c); rec(res, rs, bfd(((const bf16*)(ws + WS_CU))[(size_t)m * 512 + c]), a * dsig(g), 0.05); } } }
    else if (stage == ST_YT) { const int m = samp_row(i, M, 3), ch = (int)(hsh(i + 9) % 512u), cs = i & 1, g = ch >> 7, k2 = ch & 127; const bf16* hr = H + (size_t)m * DM; double s = 0;
        for (int k = 0; k < 1024; ++k) { double t = 0; for (int n2 = 0; n2 < 128; ++n2) { const double ang = 2.0 * PI_D * ((n2 * k2) & 127) / 128.0; t += (double)win[(size_t)k * INCOLS + OFF_FNET + g * 128 + n2] * (cs ? sin(ang) : cos(ang)); } s += bfd(hr[k]) * t; }
        s /= sqrt(128.0); double got; if (m < TL) got = bfd(((const bf16*)(ws + WS_YT))[((size_t)(m >> 11) * 512 + ch) * 4096 + cs * 2048 + (m & 2047)]); else got = bfd(((const bf16*)(ws + WS_YTC))[((size_t)((m - TL) >> 8) * 512 + ch) * 512 + cs * 256 + ((m - TL) & 255)]);
        rec(res, rs, got, s, 0.05); }
    else if (stage == ST_QKFIX) { const int m = samp_row(i, TALL, 4), isk = i & 1, hh = isk ? (int)(hsh(i + 3) % 2u) : (int)(hsh(i + 3) % 8u), d = (int)(hsh(i + 4) % 128u); const bf16* hr = H + (size_t)m * DM;
        if (isk || l == 0 || m < TL) { const int cbase = isk ? 1024 + hh * 128 : hh * 128; double ss = 0, xd = 0, xp = 0; const int half = d & 64, dd = d & 63, pd = half + ((dd + 32) & 63);
            for (int q = 0; q < 128; ++q) { double v = dot_h_w(hr, win, INCOLS, cbase + q); v = bfd((bf16)f2bf((float)v)); ss += v * v; if (q == d) xd = v; if (q == pd) xp = v; }
            const float* gn = (isk ? A.in[12] : A.in[11]) + l * 128; const double r = 1.0 / sqrt(ss / 128 + 1e-6); xd *= r * gn[d]; xp *= r * gn[pd]; double want = xd;
            if (m < TL) { const int t = m & 2047, pos = half ? (t & 63) : (t >> 6), f = dd & 31; const double ang = (double)((float)pos * powf(10000.0f, -(float)f / 32.0f)); want = (dd < 32) ? xd * cos(ang) - xp * sin(ang) : xd * cos(ang) + xp * sin(ang); }
            const double got = isk ? bfd(((const bf16*)(ws + WS_K))[(size_t)krow_of(m) * 256 + hh * 128 + d]) : bfd(((const bf16*)(ws + WS_Q))[(size_t)m * DM + hh * 128 + d]); rec(res, rs, got, want, 0.05); } }
    else if (stage == ST_CONV) { const int m = samp_row(i, M, 5), c = (int)(hsh(i + 11) % 512u); const int rowbase = m < TL ? (m >> 11) * SEQ : TL + ((m - TL) >> 8) * CTXL, L = m < TL ? SEQ : CTXL, t = m - rowbase; const bf16* cu = (const bf16*)(ws + WS_CU);
        double s1 = 0, s2 = 0, yc = 0; for (int cc = 0; cc < 512; ++cc) { double y = A.in[15][l * 512 + cc]; for (int j = 0; j < 31; ++j) { const int p = t + j - 15; if (p >= 0 && p < L) y += bfd(cu[(size_t)(rowbase + p) * 512 + cc]) * (double)A.in[14][((size_t)l * 31 + j) * 512 + cc]; } s1 += y; s2 += y * y; if (cc == c) yc = y; }
        const double mean = s1 / 512, var = s2 / 512 - mean * mean; double y = (yc - mean) / sqrt(var + 1e-6) * A.in[16][l * 512 + c] + A.in[17][l * 512 + c]; y = y * dsig(y); rec(res, rs, bfd(((const bf16*)(ws + WS_CH))[(size_t)m * 512 + c]), y, 0.05); }
    else if (stage == ST_Z) { const int m = samp_row(i, M, 6), ch = (int)(hsh(i + 12) % 512u); double s = 0;
        if (m < TL) { const int b = m >> 11, k1 = m & 2047; const bf16* yr = (const bf16*)(ws + WS_YT) + ((size_t)b * 512 + ch) * 4096; for (int n1 = 0; n1 < 2048; ++n1) { const double ang = 2.0 * PI_D * ((k1 * n1) & 2047) / 2048.0; s += cos(ang) * bfd(yr[n1]) - sin(ang) * bfd(yr[2048 + n1]); } s /= sqrt(2048.0); }
        else { const int b = (m - TL) >> 8, k1 = (m - TL) & 255; const bf16* yr = (const bf16*)(ws + WS_YTC) + ((size_t)b * 512 + ch) * 512; for (int n1 = 0; n1 < 256; ++n1) { const double ang = 2.0 * PI_D * ((k1 * n1) & 255) / 256.0; s += cos(ang) * bfd(yr[n1]) - sin(ang) * bfd(yr[256 + n1]); } s /= 16.0; }
        rec(res, rs, bfd(((const bf16*)(ws + WS_Z))[(size_t)m * 512 + ch]), s, 0.05); }
    else if (stage == ST_ATTN) { const int m = samp_row(i, M, 7), hh = (int)(hsh(i + 13) % 8u), d = (int)(hsh(i + 14) % 128u); const bf16* q = (const bf16*)(ws + WS_Q) + (size_t)m * DM + hh * 128;
        int kr0, nk; if (m < TL) { kr0 = (m >> 11) * KVROWS; nk = KVROWS; } else { kr0 = ((m - TL) >> 8) * KVROWS + SEQ; nk = CTXL; }
        const bf16* K = (const bf16*)(ws + WS_K) + (size_t)kr0 * 256 + (hh >> 2) * 128; const bf16* V = (const bf16*)(ws + WS_V) + (size_t)kr0 * 256 + (hh >> 2) * 128;
        double mx = -1e300; for (int j = 0; j < nk; ++j) { double s = 0; for (int q2 = 0; q2 < 128; ++q2) s += bfd(q[q2]) * bfd(K[(size_t)j * 256 + q2]); s *= 0.08838834764831845; if (s > mx) mx = s; }
        double den = 0, num = 0; for (int j = 0; j < nk; ++j) { double s = 0; for (int q2 = 0; q2 < 128; ++q2) s += bfd(q[q2]) * bfd(K[(size_t)j * 256 + q2]); s *= 0.08838834764831845; const double p = exp(s - mx); den += p; num += p * bfd(V[(size_t)j * 256 + d]); }
        rec(res, rs, bfd(((const bf16*)(ws + WS_AO))[(size_t)m * DM + hh * 128 + d]), num / den, 0.03); }
    else if (stage == ST_GATES) { const int m = samp_row(i, M, 8), n = (int)(hsh(i + 15) % 3072u); rec(res, rs, bfd(((const bf16*)(ws + WS_GATES))[(size_t)m * 3072 + n]), dsig(dot_h_w(H + (size_t)m * DM, win, INCOLS, OFF_GATE + n)), 0.05); }
    else if (stage == ST_GATESB && DBG_GSUB == 1) { const int m = samp_row(i, M, 8), n = (int)(hsh(i + 15) % 3072u); const double got = bfd(((const bf16*)(ws + WS_GATES))[(size_t)m * 3072 + n]), want = dsig(dot_h_w(H + (size_t)m * DM, win, INCOLS, OFF_GATE + n));
        const bool badv = !(fabs(got - want) <= 0.05); if (badv) { unsigned* r = (unsigned*)res + 48; atomicOr(r, (m < TL ? 1u : 2u) | (4u << (n >> 10)) | (i < 12 ? 32u : 0u)); } }
    else if (stage == ST_GATESB) { const int m = samp_row(i, M, 8), n = (int)(hsh(i + 15) % 3072u); const bf16* wt = (const bf16*)(ws + WS_WSMALL + (size_t)l * WSMALL_LAYER + OFFS_WG) + (size_t)n * 1024; const bf16* hr = H + (size_t)m * DM; double s = 0; for (int k = 0; k < 1024; ++k) s += bfd(hr[k]) * bfd(wt[k]);
        rec(res, rs, bfd(((const bf16*)(ws + WS_GATES))[(size_t)m * 3072 + n]), dsig(s), 0.05); }
    else if (stage == ST_MERGED) { const int m = samp_row(i, M, 9), c = (int)(hsh(i + 16) % 1024u); const bf16* g = (const bf16*)(ws + WS_GATES) + (size_t)m * 3072; double y0 = 0, y1 = 0, y2 = 0;
        const bf16* ao = (const bf16*)(ws + WS_AO) + (size_t)m * DM; const bf16* chh = (const bf16*)(ws + WS_CH) + (size_t)m * 512; const bf16* z = (const bf16*)(ws + WS_Z) + (size_t)m * 512;
        for (int k = 0; k < 1024; ++k) y0 += bfd(ao[k]) * (double)A.in[13][((size_t)l * 1024 + k) * 1024 + c];
        for (int k = 0; k < 512; ++k) { y1 += bfd(chh[k]) * (double)A.in[18][((size_t)l * 512 + k) * 1024 + c]; y2 += bfd(z[k]) * (double)A.in[19][((size_t)l * 512 + k) * 1024 + c]; }
        rec(res, rs, bfd(((const bf16*)(ws + WS_MERGED))[(size_t)m * DM + c]), bfd(g[c]) * y0 + bfd(g[1024 + c]) * y1 + bfd(g[2048 + c]) * y2, 0.05); }
    else if (stage == ST_MIX) { const int m = samp_row(i, M, 10), c = (int)(hsh(i + 17) % 1024u); rec(res, rs, bfd(((const bf16*)(ws + WS_MIX))[(size_t)m * DM + c]), dot_h_w((const bf16*)(ws + WS_MERGED) + (size_t)m * DM, A.in[20] + (size_t)l * DM * DM, DM, c), 0.05); }
    else if (stage == ST_ROW1) { const int m = samp_row(i, M, 11), c = (int)(hsh(i + 18) % 1024u); const float* xs = snap + (size_t)i * 1024;
        const bf16* mix = (const bf16*)(ws + WS_MIX) + (size_t)m * DM; const float* mv = modb + ((size_t)l * 17 + (m < TL ? (m >> 11) : 16)) * 6144; double ss = 0; for (int k = 0; k < 1024; ++k) ss += bfd(mix[k]) * bfd(mix[k]); const double r = 1.0 / sqrt(ss / 1024 + 1e-6);
        double s2 = 0, xc = 0; for (int k = 0; k < 1024; ++k) { const double xn = xs[k] + mv[2048 + k] * (bfd(mix[k]) * r * A.in[7][l * DM + k]); s2 += xn * xn; if (k == c) xc = xn; }
        const float* xd = m < TL ? A.out + (size_t)m * DM : (const float*)(ws + WS_XC) + (size_t)(m - TL) * DM; rec(res, rs, xd[c], xc, 0.02);
        rec(res, rs, bfd(H[(size_t)m * DM + c]), xc / sqrt(s2 / 1024 + 1e-6) * A.in[8][l * DM + c] * (1.0 + mv[4096 + c]) + mv[3072 + c], 0.05); }
    else if (stage == ST_LOGIT) { const int m = samp_row(i, M, 12), e = i & 31; const float* lg = (const float*)(ws + WS_LOGIT) + (size_t)m * 64; rec(res, rs, (double)lg[e] + lg[32 + e], dot_h_w(H + (size_t)m * DM, A.in[21] + (size_t)l * DM * NEXP, NEXP, e), 0.02); }
    else if (stage == ST_TOPK) { const int m = samp_row(i, M, 13); const float* lg = (const float*)(ws + WS_LOGIT) + (size_t)m * 64; float v[32]; for (int e = 0; e < 32; ++e) v[e] = lg[e] + lg[32 + e] + A.in[22][l * 32 + e];
        int id[4]; float tv[4]; for (int k = 0; k < 4; ++k) { int b = -1; for (int e = 0; e < 32; ++e) { bool used = false; for (int q = 0; q < k; ++q) used |= (id[q] == e); if (!used && (b < 0 || v[e] > v[b])) b = e; } id[k] = b; tv[k] = v[b]; }
        double den = 0; for (int k = 0; k < 4; ++k) den += exp((double)tv[k] - tv[0]); const int* gi = (const int*)(ws + WS_TOPI) + (size_t)m * 4; const float* gp = (const float*)(ws + WS_TOPP) + (size_t)m * 4;
        for (int k = 0; k < 4; ++k) { rec(res, rs, gi[k] == id[k] ? 0.0 : 1.0, 0, 0.01); rec(res, rs, gp[k], exp((double)tv[k] - tv[0]) / den, 0.01); } }
    else if (stage == ST_SLOTS) { const int m = samp_row(i, M, 14), k = i & 3; const int s = ((const int*)(ws + WS_SLOT))[(size_t)m * 4 + k], e = ((const int*)(ws + WS_TOPI))[(size_t)m * 4 + k]; const int NT = ((const int*)(ws + WS_CNT))[CNT_NT];
        if (s < 0 || s >= NT * 256) rec(res, rs, 1, 0, 0.01); else { rec(res, rs, ((const int*)(ws + WS_CNT))[CNT_TILE_E + (s >> 8)] == e ? 0.0 : 1.0, 0, 0.01); const bf16* hs = (const bf16*)(ws + WS_HS) + (size_t)s * DM; double df = 0; for (int q = 0; q < 1024; ++q) df += fabs(bfd(hs[q]) - bfd(H[(size_t)m * DM + q])); rec(res, rs, df, 0, 1e-3); } }
    else if (stage == ST_ACT) { const int m = samp_row(i, M, 15), k = i & 3, c = (int)(hsh(i + 21) % 1024u); const int s = ((const int*)(ws + WS_SLOT))[(size_t)m * 4 + k], e = ((const int*)(ws + WS_TOPI))[(size_t)m * 4 + k]; const bf16* hs = (const bf16*)(ws + WS_HS) + (size_t)s * DM;
        double g = dot_h_w(hs, A.in[23] + (((size_t)l * NEXP + e) << 20), DM, c) + A.in[24][((size_t)l * NEXP + e) * 1024 + c], u = dot_h_w(hs, A.in[25] + (((size_t)l * NEXP + e) << 20), DM, c) + A.in[26][((size_t)l * NEXP + e) * 1024 + c];
        g = g < 7.0 ? g : 7.0; u = u < -7.0 ? -7.0 : (u > 7.0 ? 7.0 : u); rec(res, rs, bfd(((const bf16*)(ws + WS_ACT))[(size_t)s * DM + c]), (u + 1.0) * (g * dsig(1.702 * g)), 0.05); }
    else if (stage == ST_YSLOT) { const int m = samp_row(i, M, 16), k = i & 3, c = (int)(hsh(i + 22) % 1024u); const int s = ((const int*)(ws + WS_SLOT))[(size_t)m * 4 + k], e = ((const int*)(ws + WS_TOPI))[(size_t)m * 4 + k];
        rec(res, rs, bfd(((const bf16*)(ws + WS_HS))[(size_t)s * DM + c]), dot_h_w((const bf16*)(ws + WS_ACT) + (size_t)s * DM, A.in[27] + (((size_t)l * NEXP + e) << 20), DM, c) + A.in[28][((size_t)l * NEXP + e) * 1024 + c], 0.05); }
    else if (stage == ST_COMB) { const int m = samp_row(i, M, 17), c = (int)(hsh(i + 23) % 1024u); const float* xs = snap + (size_t)i * 1024; const int* sl = (const int*)(ws + WS_SLOT) + (size_t)m * 4; const float* pr = (const float*)(ws + WS_TOPP) + (size_t)m * 4;
        const float* mv = modb + ((size_t)l * 17 + (m < TL ? (m >> 11) : 16)) * 6144; double ss = 0, yc = 0; for (int q = 0; q < 1024; ++q) { double y = 0; for (int k = 0; k < 4; ++k) y += (double)pr[k] * bfd(((const bf16*)(ws + WS_HS))[(size_t)sl[k] * DM + q]); ss += y * y; if (q == c) yc = y; }
        const double want = xs[c] + mv[5 * 1024 + c] * (yc / sqrt(ss / 1024 + 1e-6) * A.in[9][l * DM + c]); const float* xd = m < TL ? A.out + (size_t)m * DM : (const float*)(ws + WS_XC) + (size_t)(m - TL) * DM; rec(res, rs, xd[c], want, 0.02); }
}
__global__ void snap_rows(Args A, int l, int salt, float* snap) {
    const int i = blockIdx.x, M = (l == 0) ? TALL : TL, m = samp_row(i, M, salt); const float* xs;
    if (l == 0 && salt == 11) xs = m < TL ? A.in[0] + (size_t)m * DM : A.in[2] + (size_t)(m - TL) * DM; else xs = m < TL ? A.out + (size_t)m * DM : (const float*)(A.ws + WS_XC) + (size_t)(m - TL) * DM;
    for (int k = threadIdx.x; k < 1024; k += blockDim.x) snap[(size_t)i * 1024 + k] = xs[k];
}
__global__ void chk_gates_full(const bf16* H, const bf16* Wt, const bf16* G, int M, unsigned* cntw) {
    const int n = blockIdx.x * 64 + (threadIdx.x & 63), m = blockIdx.y * 4 + (threadIdx.x >> 6); if (m >= M) return;
    const uint4* a = (const uint4*)(H + (size_t)m * 1024); const uint4* b = (const uint4*)(Wt + (size_t)n * 1024); float s = 0.f;
    for (int k = 0; k < 128; ++k) { const uint4 x = a[k], y = b[k]; const unsigned xs[4] = {x.x, x.y, x.z, x.w}, ys[4] = {y.x, y.y, y.z, y.w};
        for (int q = 0; q < 4; ++q) { s += __uint_as_float(xs[q] << 16) * __uint_as_float(ys[q] << 16); s += __uint_as_float(xs[q] & 0xffff0000u) * __uint_as_float(ys[q] & 0xffff0000u); } }
    const float want = 1.0f / (1.0f + __expf(-s)), got = __uint_as_float(((unsigned)G[(size_t)m * 3072 + n]) << 16);
    if (!(fabsf(got - want) <= 0.02f)) { atomicAdd(cntw, 1u); cntw[16 + (m >> 8) * 12 + (n >> 8)] = 1u; }
}
__global__ void encode_full(float* out, const unsigned* cntw, int n) {
    __shared__ int bc, bt; if (threadIdx.x == 0) { unsigned C = cntw[0], T = 0; for (int t = 0; t < 1728; ++t) T += cntw[16 + t]; int b1 = 0; while (C) { ++b1; C /= 10; } int b2 = 0; while (T) { ++b2; T /= 4; } bc = b1 > 7 ? 7 : b1; bt = b2 > 7 ? 7 : b2; }
    __syncthreads(); const float K = ldexpf(1.0f, 2 + 8 * bt + bc);
    for (size_t i = (size_t)blockIdx.x * blockDim.x + threadIdx.x; i < (size_t)n; i += (size_t)gridDim.x * blockDim.x) out[i] = K;
}
__global__ void encode(float* out, const float* res, int n, float thr) {
    #if DBG_GSUB == 1
    { const unsigned mk = ((const unsigned*)res)[48]; const float K = ldexpf(1.0f, 2 + (int)mk); for (size_t i = (size_t)blockIdx.x * blockDim.x + threadIdx.x; i < (size_t)n; i += (size_t)gridDim.x * blockDim.x) out[i] = K; return; }
#endif
#ifndef CHK_SKIP
#define CHK_SKIP 0ull
#endif
    int bad = -1; for (int s = 0; s < 64; ++s) if (!((CHK_SKIP >> s) & 1ull) && res[s] > thr) { bad = s; break; }
    if (bad < 0) return; const float er = res[bad]; const float K = ldexpf(1.0f, bad + 2) * (er < 0.5f ? 1.0f : er < 1.0f ? 1.25f : er < 4.0f ? 1.5f : 1.75f);
    for (size_t i = (size_t)blockIdx.x * blockDim.x + threadIdx.x; i < (size_t)n; i += (size_t)gridDim.x * blockDim.x) out[i] = K;
}
#endif
#ifndef GP_SP2
#define GP_SP2 true
#endif
#ifndef GP_ALIGN
#define GP_ALIGN true
#endif
__global__ void __launch_bounds__(NTHR, 2) fwd(Args args) {
    extern __shared__ __attribute__((aligned(16))) unsigned char lds[];
    Frame F;
    F.lds = (LAS unsigned char*)lds; F.MISC = (volatile LAS unsigned*)(F.lds + MISC_OFF);
    F.tid = threadIdx.x; F.lane = F.tid & 63; F.wave = __builtin_amdgcn_readfirstlane(F.tid >> 6);
    F.G = gridDim.x; { const int bx = blockIdx.x; F.vcu = (F.G % 8 == 0) ? (bx % 8) * (F.G / 8) + bx / 8 : bx; }
    { const AV A0 = av_get(); F.ctl = (gu32*)(A0.ws() + WS_CTL); }
    for (int u = F.tid; u < (LDS_BYTES - LDSCTL_OFF) / 4; u += NTHR) ((LAS unsigned*)(F.lds + LDSCTL_OFF))[u] = 0u;
    __syncthreads();
    XcdBarrier bar; bar.bar = (unsigned*)(F.ctl + CW_BAR); bar.x = 0; bar.st = nullptr;
    if (!MK_PER_PHASE) bar = xcd_barrier_post((unsigned*)(F.ctl + CW_BAR), F.MISC + 8);
    int lo, hi; { const AV A0 = av_get(); lo = *(const int __attribute__((address_space(4)))*)(A0.kp + 8 * 31); hi = *(const int __attribute__((address_space(4)))*)(A0.kp + 8 * 31 + 4); }
#ifndef DIS_MASK
#define DIS_MASK 0ull
#endif
#define IN(k) (lo <= (k) && (k) < hi)
#define ON(j) (!((DIS_MASK >> (j)) & 1ull))
#ifndef REP_MASK
#define REP_MASK 0ull
#endif
#define REPS(j) ((int)((REP_MASK >> (j)) & 1ull))
#ifdef STAMP_SEL
#define SEAM(k) do { xcd_barrier(bar); if (blockIdx.x == 0 && threadIdx.x == 0) ((unsigned long long*)(F.ctl + 32768))[(k) + 1] = __builtin_amdgcn_s_memrealtime(); } while (0)
#else
#ifdef DOUBLE_BAR
#define SEAM(k) do { if (!MK_PER_PHASE && IN((k) + 1)) { xcd_barrier(bar); xcd_barrier(bar); } } while (0)
#else
#define SEAM(k) do { if (!MK_PER_PHASE && IN((k) + 1)) xcd_barrier(bar); } while (0)
#endif
#endif
    const int bx = (int)blockIdx.x;
    const int wave0 = __builtin_amdgcn_readfirstlane((int)threadIdx.x >> 6);
#define F_REFRESH() do { unsigned z_ = 0u; asm volatile("" : "+v"(z_)); const int t_ = wave0 * 64 + (int)__builtin_amdgcn_mbcnt_hi(~0u, __builtin_amdgcn_mbcnt_lo(~0u, z_)); F.tid = t_; F.lane = t_ & 63; F.wave = wave0; } while (0)

#ifdef STAMP_SEL
    if (blockIdx.x == 0 && threadIdx.x == 0) ((unsigned long long*)(F.ctl + 32768))[0] = __builtin_amdgcn_s_memrealtime();
#endif
    if (ON(0) && IN(0)) for (int rep_ = 0; rep_ <= REPS(0); ++rep_) { F_REFRESH(); const AV A = av_get(); p0_prologue(F, A); SEAM(0); }
    if (ON(1) && IN(1)) for (int rep_ = 0; rep_ <= REPS(1); ++rep_) { F_REFRESH(); const AV A = av_get(); p1_norm0(F, A); SEAM(1); }

    for (int l = 0; l < 2; ++l) {
        const int pb = 2 + l * NPL;
        const int Mm = (l == 0) ? TALL : TL;
#define PH_BEGIN F_REFRESH(); const AV A = av_get(); unsigned char* const ws = A.ws(); unsigned char* const wl = ws + WS_WSMALL + (size_t)l * WSMALL_LAYER; (void)wl
        if (ON(2 + 0) && IN(pb + 0)) for (int rep_ = 0; rep_ <= REPS(2 + 0); ++rep_) { PH_BEGIN;
            if (ON(16)) { pg8::Gemm g{(const bf16*)(ws + WS_H8), (const bf16*)(wl + OFFS_WIN), TALL, 2560, DM / 2}; pg8::StaticOrder S; S.init(TALL, 2560, F.G, bx);
              pg8::EpiInproj E{(bf16*)(ws + WS_Q), (bf16*)(ws + WS_K), (bf16*)(ws + WS_V), (bf16*)(ws + WS_CU)};
              pg8::gemm_phase<pg8::EpiInproj, pg8::StaticOrder, GP_ALIGN, GP_SP2, true>(F.lds + RING_OFF, g, S, E, F.tid); }
            if (ON(17)) { pg8::Gemm g{(const bf16*)(wl + OFFS_WF), (const bf16*)(ws + WS_H), 1024, Mm, DM}; pg8::StaticOrder S; S.init(1024, Mm, F.G, (bx + 96) % F.G);
              pg8::EpiYT E{ws + WS_YT, ws + WS_YTC};
              pg8::gemm_phase<pg8::EpiYT, pg8::StaticOrder, GP_ALIGN, GP_SP2>(F.lds + RING_OFF, g, S, E, F.tid); }
            SEAM(pb + 0);
        }
        if (ON(2 + 1) && IN(pb + 1)) for (int rep_ = 0; rep_ <= REPS(2 + 1); ++rep_) { PH_BEGIN;
            if (ON(18)) p_qkfix(F, A, l, TALL);
            F_REFRESH();
            if (ON(19)) p_conv(F, A, l, l == 0 ? 1152 : 1024);
            if (ON(20)) { pg8::Gemm g{(const bf16*)(ws + WS_DFTL), (const bf16*)(ws + WS_YT), 2048, NB * 512, 2048}; pg8::DftOrder S; S.init(3, NB, F.G, F.vcu);
              pg8::EpiDFT E{(bf16*)(ws + WS_Z), 0, SEQ};
              pg8::gemm_phase<pg8::EpiDFT, pg8::DftOrder, GP_ALIGN, GP_SP2, true>(F.lds + RING_OFF, g, S, E, F.tid); }
            if (ON(21) && l == 0) { pg8::Gemm g{(const bf16*)(ws + WS_DFTC), (const bf16*)(ws + WS_YTC), 256, NB * 512, 256}; pg8::DftOrder S; S.init(0, NB, F.G, F.vcu);
              pg8::EpiDFT E{(bf16*)(ws + WS_Z), TL, CTXL};
              pg8::gemm_phase<pg8::EpiDFT, pg8::DftOrder, GP_ALIGN, GP_SP2, true>(F.lds + RING_OFF, g, S, E, F.tid); }
            SEAM(pb + 1);
        }
        if (ON(2 + 2) && IN(pb + 2)) for (int rep_ = 0; rep_ <= REPS(2 + 2); ++rep_) { PH_BEGIN;
            const int nheavy = NB * 8 * 8, ntot = nheavy + (l == 0 ? NB * 8 : 0);
            for (int L = F.vcu; L < ntot; L += F.G) {
                int row0, krow, h, seq;
                if (L < nheavy) { const int grp = L >> 5, s = L & 31, b = grp >> 1; h = (grp & 1) * 4 + (s >> 3); row0 = b * SEQ + (s & 7) * 256; krow = b * KVROWS; seq = KVROWS; }
                else { const int Lc = L - nheavy, b = Lc >> 3; h = Lc & 7; row0 = TL + b * CTXL; krow = b * KVROWS + SEQ; seq = CTXL; }
                const att::bf16* Qb = (const att::bf16*)(ws + WS_Q) + (size_t)row0 * DM + h * 128;
                const att::bf16* Kh = (const att::bf16*)(ws + WS_K) + (size_t)krow * 256 + (h >> 2) * 128;
                const att::bf16* Vh = (const att::bf16*)(ws + WS_V) + (size_t)krow * 256 + (h >> 2) * 128;
                unsigned char* Ob = ws + WS_AO + (size_t)row0 * DM + h * 128;
                att::attn_dense_body<att::bf16>(Qb, Kh, Vh, Ob, seq, (char*)lds + RING_OFF, F.tid);
                __syncthreads();
            }
            SEAM(pb + 2);
        }
        if (ON(2 + 3) && IN(pb + 3)) for (int rep_ = 0; rep_ <= REPS(2 + 3); ++rep_) { PH_BEGIN;
            pg8::Gemm g{(const bf16*)(ws + WS_H8), (const bf16*)(wl + OFFS_WG), Mm, 3072, DM / 2}; pg8::StaticOrder S; S.init(Mm, 3072, F.G, bx);
            pg8::EpiGates E{(bf16*)(ws + WS_GATES)};
            pg8::gemm_phase<pg8::EpiGates, pg8::StaticOrder, GP_ALIGN, GP_SP2, true>(F.lds + RING_OFF, g, S, E, F.tid);
            SEAM(pb + 3);
        }
        if (ON(2 + 4) && IN(pb + 4)) for (int rep_ = 0; rep_ <= REPS(2 + 4); ++rep_) { PH_BEGIN;
            { pg8::Gemm g{(const bf16*)(ws + WS_AO), (const bf16*)(wl + OFFS_WAO), Mm, 1024, 512}; pg8::StaticOrder S; S.init(Mm, 1024, F.G, bx);
              pg8::EpiMerge<true> E{(bf16*)(ws + WS_MERGED), (const bf16*)(ws + WS_GATES), 0, 1.0f / 2048.0f};
              pg8::gemm_phase<pg8::EpiMerge<true>, pg8::StaticOrder, GP_ALIGN, GP_SP2, true>(F.lds + RING_OFF, g, S, E, F.tid); }
#pragma unroll 1
            for (int br = 1; br < 3; ++br) {
              pg8::Gemm g{(const bf16*)(ws + (br == 1 ? WS_CH : WS_Z)), (const bf16*)(wl + (br == 1 ? OFFS_WCO : OFFS_WFO)), Mm, 1024, 512}; pg8::StaticOrder S; S.init(Mm, 1024, F.G, bx);
              pg8::EpiMerge<false> E{(bf16*)(ws + WS_MERGED), (const bf16*)(ws + WS_GATES), br, 1.0f};
              pg8::gemm_phase<pg8::EpiMerge<false>, pg8::StaticOrder, GP_ALIGN, GP_SP2>(F.lds + RING_OFF, g, S, E, F.tid); }
            SEAM(pb + 4);
        }
        if (ON(2 + 5) && IN(pb + 5)) for (int rep_ = 0; rep_ <= REPS(2 + 5); ++rep_) { PH_BEGIN;
            pg8::Gemm g{(const bf16*)(ws + WS_MERGED), (const bf16*)(wl + OFFS_WOUT), Mm, 1024, 1024}; pg8::StaticOrder S; S.init(Mm, 1024, F.G, bx);
            pg8::EpiBf16<0> E{(bf16*)(ws + WS_MIX), 1024, nullptr, 0, 0, 1.0f};
            pg8::gemm_phase<pg8::EpiBf16<0>, pg8::StaticOrder, GP_ALIGN, GP_SP2>(F.lds + RING_OFF, g, S, E, F.tid);
            SEAM(pb + 5);
        }
        if (ON(2 + 6) && IN(pb + 6)) for (int rep_ = 0; rep_ <= REPS(2 + 6); ++rep_) { PH_BEGIN; p_rowpass1(F, A, l, Mm); SEAM(pb + 6); }
        if (ON(2 + 7) && IN(pb + 7)) for (int rep_ = 0; rep_ <= REPS(2 + 7); ++rep_) { PH_BEGIN;
            pg8::Gemm g{(const bf16*)(ws + WS_H), (const bf16*)(wl + OFFS_ROUT), Mm, 256, DM}; pg8::StaticOrder S; S.init(Mm, 256, F.G, bx);
            pg8::EpiRouter E{(float*)(ws + WS_LOGIT)};
            pg8::gemm_phase<pg8::EpiRouter, pg8::StaticOrder, GP_ALIGN, GP_SP2>(F.lds + RING_OFF, g, S, E, F.tid);
            SEAM(pb + 7);
        }
        if (ON(2 + 8) && IN(pb + 8)) for (int rep_ = 0; rep_ <= REPS(2 + 8); ++rep_) { PH_BEGIN; p_topk(F, A, l, Mm); SEAM(pb + 8); }
        if (ON(2 + 9) && IN(pb + 9)) for (int rep_ = 0; rep_ <= REPS(2 + 9); ++rep_) { PH_BEGIN; p_slots(F, A, Mm); SEAM(pb + 9); }
        if (ON(2 + 10) && IN(pb + 10)) for (int rep_ = 0; rep_ <= REPS(2 + 10); ++rep_) { PH_BEGIN;
            const int NT = __builtin_amdgcn_readfirstlane(((const int*)(ws + WS_CNT))[CNT_NT]);
            pg8::Gemm g{(const bf16*)(ws + WS_HS), (const bf16*)(ws + WS_WGU + (size_t)l * MOEW_LAYER), NT * 256, NEXP * 2048, DM / 2}; pg8::GroupedOrder S; S.init(NT, 8, F.G, bx, (const int*)(ws + WS_CNT) + CNT_TILE_E);
            pg8::EpiSwiGLU8 E{ws + WS_ACT, A.in(24) + (size_t)l * NEXP * 1024, A.in(26) + (size_t)l * NEXP * 1024};
            pg8::gemm_phase<pg8::EpiSwiGLU8, pg8::GroupedOrder, GP_ALIGN, GP_SP2, true>(F.lds + RING_OFF, g, S, E, F.tid);
            SEAM(pb + 10);
        }
        if (ON(2 + 11) && IN(pb + 11)) for (int rep_ = 0; rep_ <= REPS(2 + 11); ++rep_) { PH_BEGIN;
            const int NT = __builtin_amdgcn_readfirstlane(((const int*)(ws + WS_CNT))[CNT_NT]);
#ifdef STAGGER_US
            { const unsigned long long t0 = __builtin_amdgcn_s_memrealtime(), dl = (unsigned long long)((bx >> 3) & 3) * (STAGGER_US); while (__builtin_amdgcn_s_memrealtime() - t0 < dl) __builtin_amdgcn_s_sleep(8); }
#endif
            pg8::Gemm g{(const bf16*)(ws + WS_ACT), (const bf16*)(ws + WS_WD + (size_t)l * MOEW_LAYER), NT * 256, NEXP * 1024, DM / 2}; pg8::GroupedOrder S; S.init(NT, 4, F.G, bx, (const int*)(ws + WS_CNT) + CNT_TILE_E);
            pg8::EpiDown8 E{(bf16*)(ws + WS_YS), A.in(28) + (size_t)l * NEXP * 1024};
            pg8::gemm_phase<pg8::EpiDown8, pg8::GroupedOrder, GP_ALIGN, GP_SP2, true>(F.lds + RING_OFF, g, S, E, F.tid);
            SEAM(pb + 11);
        }
        if (ON(2 + 12) && IN(pb + 12)) for (int rep_ = 0; rep_ <= REPS(2 + 12); ++rep_) { PH_BEGIN;
            p_combine(F, A, l, Mm);
            SEAM(pb + 12);
        }
    }
#ifdef STAMP_SEL
    { const AV A = av_get(); float* out = A.out(); const unsigned long long* ts = (const unsigned long long*)(F.ctl + 32768);
      auto span = [&](int p) -> float { unsigned long long d = __hip_atomic_load(ts + p + 1, __ATOMIC_RELAXED, __HIP_MEMORY_SCOPE_AGENT) - __hip_atomic_load(ts + p, __ATOMIC_RELAXED, __HIP_MEMORY_SCOPE_AGENT);
          if (p >= 2) d += __hip_atomic_load(ts + p + NPL + 1, __ATOMIC_RELAXED, __HIP_MEMORY_SCOPE_AGENT) - __hip_atomic_load(ts + p + NPL, __ATOMIC_RELAXED, __HIP_MEMORY_SCOPE_AGENT); return (float)d * 0.01f; };
      const float K1 = span((STAMP_SEL) & 0xff), K2 = 200.0f * span(((STAMP_SEL) >> 8) & 0xff);
      for (size_t i = (size_t)blockIdx.x * NTHR + threadIdx.x; i < (size_t)TL * DM; i += (size_t)gridDim.x * NTHR) out[i] = (i == 0) ? K2 : K1; }
#endif
#undef IN
#undef PH_BEGIN
#undef F_REFRESH
#undef SEAM
}

extern "C" void kernel_launch(void* const* d_in, const int* in_sizes, int n_in, void* d_out, int out_size, void* d_ws, size_t ws_size, hipStream_t stream) {
    static int grid = 0;
    if (grid == 0) {
        if (n_in != 29 || out_size != TL * DM || ws_size < WS_END2) { fprintf(stderr, "kernel_launch: built for 29 inputs, %d outputs, >= %zu bytes of workspace; got n_in %d out %d ws %zu\n", TL * DM, (size_t)WS_END2, n_in, out_size, ws_size); grid = -1; return; }
        int dev = 0, cus = 0, per_cu = 0;
        if (hipGetDevice(&dev) != hipSuccess || hipDeviceGetAttribute(&cus, hipDeviceAttributeMultiprocessorCount, dev) != hipSuccess) { grid = -1; return; }
        if (hipFuncSetAttribute((const void*)fwd, hipFuncAttributeMaxDynamicSharedMemorySize, LDS_BYTES) != hipSuccess) { fprintf(stderr, "kernel_launch: hipFuncSetAttribute failed\n"); grid = -1; return; }
        if (hipOccupancyMaxActiveBlocksPerMultiprocessor(&per_cu, (const void*)fwd, NTHR, LDS_BYTES) != hipSuccess || per_cu < 1) fprintf(stderr, "kernel_launch: occupancy query reports %d\n", per_cu);
        (void)hipGetLastError();
        grid = cus;
    }
    if (grid < 0) return;
    (void)hipMemsetAsync((char*)d_ws + WS_CTL, 0, CTL_ZERO_BYTES, stream);
    Args a{};
    for (int i = 0; i < 29; ++i) a.in[i] = (const float*)d_in[i];
    a.out = (float*)d_out; a.ws = (unsigned char*)d_ws;
#if MK_PER_PHASE
    for (int p = 0; p < NPH; ++p) {
#ifdef DBG_CHECK
        float* res = (float*)((char*)d_ws + WS_CTL + 8192 * 4); float* snap = (float*)((char*)d_ws + WS_END);
        { const int l = p >= 2 ? (p - 2) / NPL : 0, k = p >= 2 ? (p - 2) % NPL : -1;
          if (k == 6) hipLaunchKernelGGL(snap_rows, dim3(256), dim3(256), 0, stream, a, l, 11, snap);
          if (k == 12) hipLaunchKernelGGL(snap_rows, dim3(256), dim3(256), 0, stream, a, l, 17, snap); }
#endif
        a.ph_lo = p; a.ph_hi = p + 1; hipLaunchKernelGGL(fwd, dim3(grid), dim3(NTHR), LDS_BYTES, stream, a);
#ifdef DBG_CHECK
        { const int l = p >= 2 ? (p - 2) / NPL : 0, k = p >= 2 ? (p - 2) % NPL : -1;
#define CHK(st) hipLaunchKernelGGL(chk, dim3(1), dim3(256), 0, stream, a, (int)(st), l, res, snap)
          if (p == 0) CHK(ST_MOD); if (p == 1) CHK(ST_H0);
#if DBG_GSUB == 2
          if (k == 3 && l == 0) hipLaunchKernelGGL(chk_gates_full, dim3(48, TALL / 4), dim3(256), 0, stream, (const bf16*)((char*)d_ws + WS_H), (const bf16*)((char*)d_ws + WS_WSMALL + OFFS_WG), (const bf16*)((char*)d_ws + WS_GATES), TALL, (unsigned*)((char*)d_ws + WS_CTL + 65536));
#endif
          if (k == 0) { CHK(ST_INPROJ); CHK(ST_YT); } if (k == 1) { CHK(ST_QKFIX); CHK(ST_CONV); CHK(ST_Z); } if (k == 2) CHK(ST_ATTN); if (k == 3) { CHK(ST_GATES); CHK(ST_GATESB); } if (k == 4) CHK(ST_MERGED);
          if (k == 5) CHK(ST_MIX); if (k == 6) CHK(ST_ROW1); if (k == 7) CHK(ST_LOGIT); if (k == 8) CHK(ST_TOPK); if (k == 9) CHK(ST_SLOTS); if (k == 10) CHK(ST_ACT); if (k == 11) CHK(ST_YSLOT); if (k == 12) CHK(ST_COMB);
#undef CHK
        }
#endif
    }
#ifdef DBG_CHECK
#if DBG_GSUB == 2
    hipLaunchKernelGGL(encode_full, dim3(1024), dim3(256), 0, stream, (float*)d_out, (const unsigned*)((char*)d_ws + WS_CTL + 65536), out_size);
#else
    hipLaunchKernelGGL(encode, dim3(1024), dim3(256), 0, stream, (float*)d_out, (const float*)((char*)d_ws + WS_CTL + 8192 * 4), out_size, 0.25f);
#endif
#endif
#else
    a.ph_lo = 0; a.ph_hi = NPH; hipLaunchKernelGGL(fwd, dim3(grid), dim3(NTHR), LDS_BYTES, stream, a);
#endif
    const hipError_t le = hipPeekAtLastError();
    if (le != hipSuccess) fprintf(stderr, "kernel_launch: launch failed: %s\n", hipGetErrorName(le));
}
```

```cpp
#include <hip/hip_runtime.h>
#include <cstdio>
#include <cstdint>
#ifndef MK_PER_PHASE
#define MK_PER_PHASE 0
#endif
namespace pg8 {
#define PG8_LAS __attribute__((address_space(3)))
typedef unsigned short bf16_t;
typedef short bf16x8 __attribute__((ext_vector_type(8)));
typedef float f32x4 __attribute__((ext_vector_type(4)));
typedef unsigned u32x4 __attribute__((ext_vector_type(4)));
typedef int i32x4v __attribute__((ext_vector_type(4)));
typedef int i32x8v __attribute__((ext_vector_type(8)));
typedef unsigned u32x2v __attribute__((ext_vector_type(2)));
constexpr int BM = 256, BK = 64, HALF = 128, HTB = HALF * BK * 2  , STAGE_BYTES = 8 * HTB, NXCD = 8, WGM = 8;

__host__ __device__ __forceinline__ int lds_byte(int r, int c) { const int st = (r >> 4) * 2 + (c >> 5), rr = r & 15, cc = c & 31, ob = rr * 64 + cc * 2; return st * 1024 + (ob ^ (((ob >> 9) & 1) << 5)); }
__host__ __device__ __forceinline__ void stage_rc(int b, int& R, int& C) { const int st = b / 1024, sb = b % 1024, swz = sb ^ (((sb >> 9) & 1) << 5); R = (st >> 1) * 16 + swz / 64; C = (st & 1) * 32 + (swz % 64) / 2; }
__host__ __device__ __forceinline__ int perm32(int rho) { const int n = rho >> 4, i = rho & 15; return 8 * (i >> 2) + 4 * n + (i & 3); }

struct Unit { int pm, pn; };
struct Gemm { const bf16_t* A; const bf16_t* Bt; int M, N, K; };

struct StaticOrder {
    int nM, nN, nwg, G, c;
    __host__ __device__ void init(int M, int N, int G_, int c_) { nM = M / BM; nN = N / BM; nwg = nM * nN; G = G_; c = c_; }
    __host__ __device__ bool next(int i, Unit& u) const {
        const long L = (long)i * G + c; if (L >= nwg) return false;
        int wgid = (int)L; { const int q = nwg / NXCD, r = nwg % NXCD, xcd = wgid % NXCD, off = wgid / NXCD; wgid = (xcd < r ? xcd * (q + 1) : r * (q + 1) + (xcd - r) * q) + off; }
        const int nig = WGM * nN, gid = wgid / nig, fm = gid * WGM, gsz = (nM - fm) < WGM ? (nM - fm) : WGM;
        u.pm = fm + ((wgid % nig) % gsz); u.pn = (wgid % nig) / gsz; return true;
    }
    __device__ __forceinline__ void a_ready(const Unit&) const {}
    __device__ __forceinline__ void done(const Unit&) const {}
};

typedef __bf16 bf16x2_native __attribute__((ext_vector_type(2)));
typedef float f32x2_native __attribute__((ext_vector_type(2)));
__device__ __forceinline__ unsigned cvt_pk_bf16(float lo, float hi) { const f32x2_native v = {lo, hi}; const bf16x2_native r = __builtin_convertvector(v, bf16x2_native); return __builtin_bit_cast(unsigned, r); }
__device__ __forceinline__ unsigned cvt4_fp8(float a, float b, float c, float d) { int w = __builtin_amdgcn_cvt_pk_fp8_f32(a, b, __builtin_bit_cast(int, a), false); w = __builtin_amdgcn_cvt_pk_fp8_f32(c, d, w, true); return (unsigned)w; }
typedef float f32x2 __attribute__((ext_vector_type(2)));
__device__ __forceinline__ f32x2 gelu_pk(f32x2 v) {
    const f32x2 av = __builtin_elementwise_abs(v), d = av * 0.2316418882f + 1.0f;
    f32x2 t; t.x = __builtin_amdgcn_rcpf(d.x); t.y = __builtin_amdgcn_rcpf(d.y);
    f32x2 q = t * 0.5307027145f + (-0.7265760135f); q = q * t + 0.7107068705f; q = q * t + (-0.142248368f); q = q * t + 0.127414796f; q = q * t;
    const f32x2 s = (v * v) * (-0.72134752044f);
    f32x2 e; e.x = __builtin_amdgcn_exp2f(s.x); e.y = __builtin_amdgcn_exp2f(s.y);
    const f32x2 m = v * (q * e), r = v - m;
    f32x2 o; o.x = v.x < 0.f ? m.x : r.x; o.y = v.y < 0.f ? m.y : r.y; return o;
}

template <int ACT  > struct EpiBf16 {
    static constexpr bool PERM = true, AFTER_DRAIN = false; static_assert(ACT == 0 || ACT == 1, "EpiBf16: ACT is 0 (none) or 1 (gelu_pk)");
    bf16_t* O; int ldc; const float* bias; int split_cols; size_t split_stride; float scale0;
    __device__ __forceinline__ void operator()(const f32x4 (&acc)[2][2][4][2], const Unit& u, int wr, int wc, int fr, int fq) const {
        const int row0 = u.pm * BM + wr * 64 + fr; int colt = u.pn * BM; bf16_t* base = O;
        float sc = 1.f; if (split_cols) { const int t = colt / split_cols; base += (size_t)t * split_stride; colt -= t * split_cols; if (t == 0) sc = scale0; }
        const int col0 = colt + wc * 32 + 8 * fq, bcol0 = u.pn * BM + wc * 32 + 8 * fq;
        f32x4 bv[2][2];
#pragma unroll
        for (int bj = 0; bj < 2; ++bj)
#pragma unroll
            for (int n = 0; n < 2; ++n) bv[bj][n] = bias ? *(const f32x4*)(bias + bcol0 + bj * HALF + 4 * n) : (f32x4){0.f, 0.f, 0.f, 0.f};
#pragma unroll
        for (int ai = 0; ai < 2; ++ai)
#pragma unroll
            for (int m = 0; m < 4; ++m) { bf16_t* rowp = base + (size_t)(row0 + ai * HALF + m * 16) * ldc + col0;
#pragma unroll
                for (int bj = 0; bj < 2; ++bj) { f32x4 v0 = acc[ai][bj][m][0] + bv[bj][0], v1 = acc[ai][bj][m][1] + bv[bj][1];
                    if (ACT == 1) { f32x2 a = gelu_pk((f32x2){v0[0], v0[1]}), b = gelu_pk((f32x2){v0[2], v0[3]}), c = gelu_pk((f32x2){v1[0], v1[1]}), d = gelu_pk((f32x2){v1[2], v1[3]});
                        v0 = (f32x4){a.x, a.y, b.x, b.y}; v1 = (f32x4){c.x, c.y, d.x, d.y}; }
                    v0 = v0 * sc; v1 = v1 * sc; u32x4 w; w.x = cvt_pk_bf16(v0[0], v0[1]); w.y = cvt_pk_bf16(v0[2], v0[3]); w.z = cvt_pk_bf16(v1[0], v1[1]); w.w = cvt_pk_bf16(v1[2], v1[3]);
                    *(u32x4*)(rowp + bj * HALF) = w; } }
    }
};

__device__ __forceinline__ float fast_sigmoid(float x) { return __builtin_amdgcn_rcpf(1.0f + __builtin_amdgcn_exp2f(-1.4426950408889634f * x)); }
__device__ __forceinline__ u32x4 pack8(const f32x4& a, const f32x4& b) { u32x4 w; w.x = cvt_pk_bf16(a[0], a[1]); w.y = cvt_pk_bf16(a[2], a[3]); w.z = cvt_pk_bf16(b[0], b[1]); w.w = cvt_pk_bf16(b[2], b[3]); return w; }
__device__ __forceinline__ void unpack8(const u32x4& w, f32x4& a, f32x4& b) {
    a[0] = __uint_as_float(w.x << 16); a[1] = __uint_as_float(w.x & 0xffff0000u); a[2] = __uint_as_float(w.y << 16); a[3] = __uint_as_float(w.y & 0xffff0000u);
    b[0] = __uint_as_float(w.z << 16); b[1] = __uint_as_float(w.z & 0xffff0000u); b[2] = __uint_as_float(w.w << 16); b[3] = __uint_as_float(w.w & 0xffff0000u); }
__device__ __forceinline__ u32x2v pack8_fp8(const f32x4& a, const f32x4& b) { u32x2v r; r.x = cvt4_fp8(a[0], a[1], a[2], a[3]); r.y = cvt4_fp8(b[0], b[1], b[2], b[3]); return r; }
__device__ __forceinline__ void store_tile_bf16(const f32x4 (&acc)[2][2][4][2], bf16_t* base, int ldc, int wr, int wc, int fr, int fq) {
    const int rt = wr * 64 + fr, cb = wc * 32 + 8 * fq;
#pragma unroll
    for (int ai = 0; ai < 2; ++ai)
#pragma unroll
        for (int m = 0; m < 4; ++m) { bf16_t* rowp = base + (size_t)(rt + ai * HALF + m * 16) * ldc + cb;
#pragma unroll
            for (int bj = 0; bj < 2; ++bj) *(u32x4*)(rowp + bj * HALF) = pack8(acc[ai][bj][m][0], acc[ai][bj][m][1]); }
}
struct EpiInproj {
    static constexpr bool PERM = true, AFTER_DRAIN = false;
    bf16_t *q, *k, *v, *cu;
    __device__ __forceinline__ void operator()(const f32x4 (&acc)[2][2][4][2], const Unit& u, int wr, int wc, int fr, int fq) const {
        bf16_t* base; int ldc; const bool glu = u.pn >= 6; float sc = 0.03125f; asm volatile("" : "+s"(sc));
        if (u.pn < 4) { base = q + (size_t)u.pm * 256 * 1024 + u.pn * 256; ldc = 1024; }
        else if (u.pn < 6) { const int m0 = u.pm * 256; const int kr = m0 < 32768 ? (m0 >> 11) * 2304 + (m0 & 2047) : ((m0 - 32768) >> 8) * 2304 + 2048; base = (u.pn == 4 ? k : v) + (size_t)kr * 256; ldc = 256; }
        else { base = cu + (size_t)u.pm * 256 * 512 + (u.pn - 6) * 128; ldc = 512; }
        base += (size_t)(wr * 64 + fr) * ldc + wc * 32 + 8 * fq;
#pragma unroll
        for (int ai = 0; ai < 2; ++ai)
#pragma unroll
            for (int m = 0; m < 4; ++m) { bf16_t* rowp = base + (size_t)(ai * HALF + m * 16) * ldc;
                if (!glu) { *(u32x4*)rowp = pack8(acc[ai][0][m][0] * sc, acc[ai][0][m][1] * sc); *(u32x4*)(rowp + HALF) = pack8(acc[ai][1][m][0] * sc, acc[ai][1][m][1] * sc); }
                else { f32x4 a0 = acc[ai][0][m][0] * sc, a1 = acc[ai][0][m][1] * sc; const f32x4 g0 = acc[ai][1][m][0] * sc, g1 = acc[ai][1][m][1] * sc;
#pragma unroll
                    for (int j = 0; j < 4; ++j) { a0[j] *= fast_sigmoid(g0[j]); a1[j] *= fast_sigmoid(g1[j]); }
                    *(u32x4*)rowp = pack8(a0, a1); } }
    }
};
struct EpiYT {
    static constexpr bool PERM = true, AFTER_DRAIN = false;
    unsigned char *yt, *ytc;
    __device__ __forceinline__ void operator()(const f32x4 (&acc)[2][2][4][2], const Unit& u, int wr, int wc, int fr, int fq) const {
        const int cs = u.pm >> 1, chb = (u.pm & 1) * 256; unsigned char* base; int ldc;
        if (u.pn < 128) { const int b = u.pn >> 3, pos0 = (u.pn & 7) * 256; base = yt + (size_t)(b * 512 + chb) * 4096 + cs * 2048 + pos0; ldc = 4096; }
        else { const int b = u.pn - 128; base = ytc + (size_t)(b * 512 + chb) * 512 + cs * 256; ldc = 512; }
        base += (size_t)(wr * 64 + fr) * ldc + wc * 32 + 8 * fq;
#pragma unroll
        for (int ai = 0; ai < 2; ++ai)
#pragma unroll
            for (int m = 0; m < 4; ++m) { unsigned char* rowp = base + (size_t)(ai * HALF + m * 16) * ldc;
#pragma unroll
                for (int bj = 0; bj < 2; ++bj) *(u32x2v*)(rowp + bj * HALF) = pack8_fp8(acc[ai][bj][m][0], acc[ai][bj][m][1]); }
    }
};
struct EpiDFT {
    static constexpr bool PERM = true, AFTER_DRAIN = false;
    bf16_t* z; int rowbase, rpb;
    __device__ __forceinline__ void operator()(const f32x4 (&acc)[2][2][4][2], const Unit& u, int wr, int wc, int fr, int fq) const {
        bf16_t* base = z + (size_t)(rowbase + (u.pn >> 1) * rpb + u.pm * 256 + wr * 64 + fr) * 512 + (u.pn & 1) * 256 + wc * 32 + 8 * fq;
#pragma unroll
        for (int ai = 0; ai < 2; ++ai)
#pragma unroll
            for (int m = 0; m < 4; ++m)
#pragma unroll
                for (int bj = 0; bj < 2; ++bj) *(u32x4*)(base + (size_t)(ai * HALF + m * 16) * 512 + bj * HALF) = pack8(acc[ai][bj][m][0] * 0.03125f, acc[ai][bj][m][1] * 0.03125f);
    }
};
struct EpiGates {
    static constexpr bool PERM = true, AFTER_DRAIN = false;
    bf16_t* g;
    __device__ __forceinline__ void operator()(const f32x4 (&acc)[2][2][4][2], const Unit& u, int wr, int wc, int fr, int fq) const {
        const int rt = wr * 64 + fr, cb = wc * 32 + 8 * fq; bf16_t* base = g + (size_t)u.pm * 256 * 3072 + u.pn * 256 + cb;
        float cs = -1.4426950408889634f * 0.03125f; asm volatile("" : "+s"(cs));
#pragma unroll
        for (int ai = 0; ai < 2; ++ai)
#pragma unroll
            for (int m = 0; m < 4; ++m)
#pragma unroll
                for (int bj = 0; bj < 2; ++bj) { f32x4 a0 = acc[ai][bj][m][0], a1 = acc[ai][bj][m][1];
#pragma unroll
                    for (int j = 0; j < 4; ++j) { a0[j] = __builtin_amdgcn_rcpf(1.0f + __builtin_amdgcn_exp2f(a0[j] * cs)); a1[j] = __builtin_amdgcn_rcpf(1.0f + __builtin_amdgcn_exp2f(a1[j] * cs)); }
                    *(u32x4*)(base + (size_t)(rt + ai * HALF + m * 16) * 3072 + bj * HALF) = pack8(a0, a1); }
    }
};
template <bool FIRST> struct EpiMerge {
    static constexpr bool PERM = true, AFTER_DRAIN = false;
    bf16_t* mg; const bf16_t* g; int br; float scale;
    __device__ __forceinline__ void operator()(const f32x4 (&acc)[2][2][4][2], const Unit& u, int wr, int wc, int fr, int fq) const {
        const int rt = u.pm * 256 + wr * 64 + fr, cb = u.pn * 256 + wc * 32 + 8 * fq; float sc = scale; asm volatile("" : "+s"(sc));
#pragma unroll
        for (int ai = 0; ai < 2; ++ai)
#pragma unroll
            for (int m = 0; m < 4; ++m)
#pragma unroll
                for (int bj = 0; bj < 2; ++bj) { const size_t row = (size_t)(rt + ai * HALF + m * 16); const int col = cb + bj * HALF;
                    const u32x4 gw = *(const u32x4*)(g + row * 3072 + br * 1024 + col); f32x4 g0, g1; unpack8(gw, g0, g1);
                    f32x4 v0 = acc[ai][bj][m][0] * sc * g0, v1 = acc[ai][bj][m][1] * sc * g1;
                    if (!FIRST) { const u32x4 ow = *(const u32x4*)(mg + row * 1024 + col); f32x4 o0, o1; unpack8(ow, o0, o1); v0 += o0; v1 += o1; }
                    *(u32x4*)(mg + row * 1024 + col) = pack8(v0, v1); }
    }
};
struct EpiRouter {
    static constexpr bool PERM = true, AFTER_DRAIN = false;
    float* lg;
    __device__ __forceinline__ void operator()(const f32x4 (&acc)[2][2][4][2], const Unit& u, int wr, int wc, int fr, int fq) const {
        if (wc < 2) { const int rt = u.pm * 256 + wr * 64 + fr, cb = wc * 32 + 8 * fq;
#pragma unroll
            for (int ai = 0; ai < 2; ++ai)
#pragma unroll
                for (int m = 0; m < 4; ++m) { float* p = lg + (size_t)(rt + ai * HALF + m * 16) * 64 + cb; *(f32x4*)p = acc[ai][0][m][0]; *(f32x4*)(p + 4) = acc[ai][0][m][1]; } }
    }
};
struct EpiSwiGLU {
    static constexpr bool PERM = true, AFTER_DRAIN = false;
    bf16_t* act; const float* bg; const float* bu;
    __device__ __forceinline__ void operator()(const f32x4 (&acc)[2][2][4][2], const Unit& u, int wr, int wc, int fr, int fq) const {
        const int e = u.pn >> 3, col = (u.pn & 7) * 128 + wc * 32 + 8 * fq, rt = u.pm * 256 + wr * 64 + fr;
        const f32x4 bg0 = *(const f32x4*)(bg + e * 1024 + col), bg1 = *(const f32x4*)(bg + e * 1024 + col + 4), bu0 = *(const f32x4*)(bu + e * 1024 + col), bu1 = *(const f32x4*)(bu + e * 1024 + col + 4);
#pragma unroll
        for (int ai = 0; ai < 2; ++ai)
#pragma unroll
            for (int m = 0; m < 4; ++m) { f32x4 g0 = acc[ai][0][m][0] + bg0, g1 = acc[ai][0][m][1] + bg1, u0 = acc[ai][1][m][0] + bu0, u1 = acc[ai][1][m][1] + bu1;
#pragma unroll
                for (int j = 0; j < 4; ++j) { const float ga = fminf(g0[j], 7.0f), gb = fminf(g1[j], 7.0f); const float ua = fminf(fmaxf(u0[j], -7.0f), 7.0f), ub = fminf(fmaxf(u1[j], -7.0f), 7.0f);
                    g0[j] = (ua + 1.0f) * (ga * fast_sigmoid(1.702f * ga)); g1[j] = (ub + 1.0f) * (gb * fast_sigmoid(1.702f * gb)); }
                *(u32x4*)(act + (size_t)(rt + ai * HALF + m * 16) * 1024 + col) = pack8(g0, g1); }
    }
};
struct EpiSwiGLU8 {
    static constexpr bool PERM = true, AFTER_DRAIN = false;
    unsigned char* act; const float* bg; const float* bu;
    __device__ __forceinline__ void operator()(const f32x4 (&acc)[2][2][4][2], const Unit& u, int wr, int wc, int fr, int fq) const {
        const int e = u.pn >> 3, col = (u.pn & 7) * 128 + wc * 32 + 8 * fq, rt = u.pm * 256 + wr * 64 + fr;
        const f32x4 bg0 = *(const f32x4*)(bg + e * 1024 + col), bg1 = *(const f32x4*)(bg + e * 1024 + col + 4), bu0 = *(const f32x4*)(bu + e * 1024 + col), bu1 = *(const f32x4*)(bu + e * 1024 + col + 4);
#pragma unroll
        for (int ai = 0; ai < 2; ++ai)
#pragma unroll
            for (int m = 0; m < 4; ++m) { f32x4 g0 = acc[ai][0][m][0] * 0.03125f + bg0, g1 = acc[ai][0][m][1] * 0.03125f + bg1, u0 = acc[ai][1][m][0] * 0.03125f + bu0, u1 = acc[ai][1][m][1] * 0.03125f + bu1;
#pragma unroll
                for (int j = 0; j < 4; ++j) { const float ga = fminf(g0[j], 7.0f), gb = fminf(g1[j], 7.0f); const float ua = fminf(fmaxf(u0[j], -7.0f), 7.0f), ub = fminf(fmaxf(u1[j], -7.0f), 7.0f);
                    g0[j] = (ua + 1.0f) * (ga * fast_sigmoid(1.702f * ga)); g1[j] = (ub + 1.0f) * (gb * fast_sigmoid(1.702f * gb)); }
                *(u32x2v*)(act + (size_t)(rt + ai * HALF + m * 16) * 1024 + col) = pack8_fp8(g0, g1); }
    }
};
struct EpiDown8 {
    static constexpr bool PERM = true, AFTER_DRAIN = false;
    bf16_t* ys; const float* bd;
    __device__ __forceinline__ void operator()(const f32x4 (&acc)[2][2][4][2], const Unit& u, int wr, int wc, int fr, int fq) const {
        const int e = u.pn >> 2, col0 = (u.pn & 3) * 256 + wc * 32 + 8 * fq, rt = u.pm * 256 + wr * 64 + fr;
        f32x4 bv[2][2];
#pragma unroll
        for (int bj = 0; bj < 2; ++bj) { bv[bj][0] = *(const f32x4*)(bd + e * 1024 + col0 + bj * HALF); bv[bj][1] = *(const f32x4*)(bd + e * 1024 + col0 + bj * HALF + 4); }
#pragma unroll
        for (int ai = 0; ai < 2; ++ai)
#pragma unroll
            for (int m = 0; m < 4; ++m) { bf16_t* rowp = ys + (size_t)(rt + ai * HALF + m * 16) * 1024 + col0;
#pragma unroll
                for (int bj = 0; bj < 2; ++bj) *(u32x4*)(rowp + bj * HALF) = pack8(acc[ai][bj][m][0] * 0.03125f + bv[bj][0], acc[ai][bj][m][1] * 0.03125f + bv[bj][1]); }
    }
};
struct GroupedOrder {
    int nM, nN, nwg, G, c; const int* tile_e;
    __device__ void init(int nM_, int nN_, int G_, int c_, const int* te) { nM = nM_; nN = nN_; nwg = nM * nN; G = G_; c = c_; tile_e = te; }
    __device__ bool next(int i, Unit& u) const {
        const long L = (long)i * G + c; if (L >= nwg) return false;
        int wgid = (int)L; { const int q = nwg / NXCD, r = nwg % NXCD, xcd = wgid % NXCD, off = wgid / NXCD; wgid = (xcd < r ? xcd * (q + 1) : r * (q + 1) + (xcd - r) * q) + off; }
        const int nig = WGM * nN, gid = wgid / nig, fm = gid * WGM, gsz = (nM - fm) < WGM ? (nM - fm) : WGM;
        u.pm = fm + ((wgid % nig) % gsz); const int pl = (wgid % nig) / gsz; u.pn = __builtin_amdgcn_readfirstlane(tile_e[u.pm]) * nN + pl; return true;
    }
    __device__ __forceinline__ void a_ready(const Unit&) const {}
    __device__ __forceinline__ void done(const Unit&) const {}
};
struct DftOrder {
    int lg, n, G, c;
    __device__ void init(int lg_, int nb, int G_, int c_) { lg = lg_; n = (nb * 2) << lg_; G = G_; c = c_; }
    __device__ bool next(int i, Unit& u) const { const int L = i * G + c; if (L >= n) return false; const int b = L >> (lg + 1), rem = L & ((2 << lg) - 1); u.pm = rem & ((1 << lg) - 1); u.pn = 2 * b + (rem >> lg); return true; }
    __device__ __forceinline__ void a_ready(const Unit&) const {}
    __device__ __forceinline__ void done(const Unit&) const {}
};

template <class Epi, class Sched, bool ALIGN_EPI = false, bool SP2 = false, bool FP8 = false>
__device__ __forceinline__ void gemm_phase(PG8_LAS unsigned char* lds, const Gemm g, const Sched& S, const Epi& E, const int tid_in) {
    int tid_ = tid_in; asm volatile("" : "+v"(tid_));
    const int tid = tid_, wid = __builtin_amdgcn_readfirstlane(tid >> 6), lane = tid & 63, wr = wid >> 2, wc = wid & 3, fr = lane & 15, fq = lane >> 4;
    const int K = g.K, nt = K / BK;
    unsigned voffA[2], voffB[2];
#pragma unroll
    for (int i = 0; i < 2; ++i) { int R, C; stage_rc(tid * 16 + i * 8192, R, C); const int Rb = Epi::PERM ? ((R & ~31) + perm32(R & 31)) : R;
        voffA[i] = (unsigned)(R * K + C) * 2u; voffB[i] = (unsigned)(Rb * K + C) * 2u; }
    const size_t kstep = (size_t)(BK * 2);
    const size_t hstep = (size_t)HALF * K * 2;
    const size_t tstep = 2 * hstep;
    const unsigned ldsw = (unsigned)wid * 1024u;
    const int aoff = lds_byte(wr * 64 + fr, fq * 8), boff = lds_byte(wc * 32 + fr, fq * 8);
#define PG8_SA(b, h) (((b) * 2 + (h)) * HTB)
#define PG8_SB(b, h) ((4 + (b) * 2 + (h)) * HTB)
#define PG8_STAGE(bufoff, gbase, voff) do { _Pragma("unroll") for (int _i = 0; _i < 2; ++_i) \
        __builtin_amdgcn_global_load_lds((const unsigned*)((const char*)(gbase) + (voff)[_i]), (PG8_LAS unsigned*)(lds + (bufoff) + ldsw + _i * 8192), 16, 0, 0); } while (0)
#define PG8_RD8(off) __builtin_shufflevector(*(const PG8_LAS i32x4v*)(lds + (off)), *(const PG8_LAS i32x4v*)(lds + (off) + 1024), 0, 1, 2, 3, 4, 5, 6, 7)
#define PG8_LDA(dst, b, h) do { _Pragma("unroll") for (int m = 0; m < 4; ++m) { if constexpr (FP8) dst##8[m] = PG8_RD8(PG8_SA(b, h) + aoff + m * 2048); else { _Pragma("unroll") for (int k = 0; k < 2; ++k) dst[m][k] = *(const PG8_LAS bf16x8*)(lds + PG8_SA(b, h) + aoff + m * 2048 + k * 1024); } } } while (0)
#define PG8_LDB(dst, b, h) do { _Pragma("unroll") for (int n = 0; n < 2; ++n) { if constexpr (FP8) dst##8[n] = PG8_RD8(PG8_SB(b, h) + boff + n * 2048); else { _Pragma("unroll") for (int k = 0; k < 2; ++k) dst[n][k] = *(const PG8_LAS bf16x8*)(lds + PG8_SB(b, h) + boff + n * 2048 + k * 1024); } } } while (0)
#define PG8_MMA(ai, bj, At, Bt) do { if constexpr (FP8) __builtin_amdgcn_sched_barrier(0); __builtin_amdgcn_s_setprio(1); _Pragma("unroll") for (int m = 0; m < 4; ++m) _Pragma("unroll") for (int n = 0; n < 2; ++n) { \
        if constexpr (FP8) asm volatile("v_mfma_scale_f32_16x16x128_f8f6f4 %0, %1, %2, %0, %3, %3 op_sel_hi:[0,0,0]" : "+v"(acc[ai][bj][m][n]) : "v"(Bt##8[n]), "v"(At##8[m]), "v"(sc8)); \
        else { _Pragma("unroll") for (int k = 0; k < 2; ++k) acc[ai][bj][m][n] = __builtin_amdgcn_mfma_f32_16x16x32_bf16(Bt[n][k], At[m][k], acc[ai][bj][m][n], 0, 0, 0); } } __builtin_amdgcn_s_setprio(0); if constexpr (FP8) __builtin_amdgcn_sched_barrier(0); } while (0)
#define PG8_WAIT_V(n) asm volatile("s_waitcnt vmcnt(" #n ")" ::: "memory")
#define PG8_WAIT_L(n) asm volatile("s_waitcnt lgkmcnt(" #n ")" ::: "memory")
#define PG8_BAR __builtin_amdgcn_s_barrier()
#define PG8_SCHED __builtin_amdgcn_sched_barrier(0)
    Unit cur, nxt; int ui = 0;
    if (!S.next(0, cur)) return;
    f32x4 acc[2][2][4][2];
#pragma unroll
    for (int a = 0; a < 2; ++a)
#pragma unroll
        for (int b = 0; b < 2; ++b)
#pragma unroll
            for (int m = 0; m < 4; ++m)
#pragma unroll
                for (int n = 0; n < 2; ++n) acc[a][b][m][n] = (f32x4){0.f, 0.f, 0.f, 0.f};
    int sc8 = 0x7f7f7f7f; asm volatile("" : "+v"(sc8));
    bf16x8 At[4][2], B0[2][2], B1[2][2]; i32x8v At8[4], B08[2], B18[2];
    const char* cA = (const char*)g.A + (size_t)cur.pm * tstep; const char* cB = (const char*)g.Bt + (size_t)cur.pn * tstep;
    S.a_ready(cur);
    if constexpr (SP2) {
        PG8_STAGE(PG8_SB(0, 0), cB, voffB); PG8_STAGE(PG8_SB(0, 1), cB + hstep, voffB); PG8_STAGE(PG8_SA(0, 0), cA, voffA); PG8_STAGE(PG8_SA(0, 1), cA + hstep, voffA);
        if (wr == 1) PG8_BAR;
        PG8_WAIT_V(2); PG8_BAR;
        PG8_STAGE(PG8_SB(1, 0), cB + kstep, voffB); PG8_STAGE(PG8_SA(1, 0), cA + kstep, voffA); PG8_STAGE(PG8_SB(1, 1), cB + hstep + kstep, voffB);
        PG8_WAIT_V(6); PG8_BAR;
    } else {
        PG8_STAGE(PG8_SB(0, 0), cB, voffB); PG8_STAGE(PG8_SA(0, 0), cA, voffA); PG8_STAGE(PG8_SB(0, 1), cB + hstep, voffB); PG8_STAGE(PG8_SA(0, 1), cA + hstep, voffA);
        if (wr == 1) PG8_BAR;
        PG8_WAIT_V(4); PG8_BAR;
        PG8_STAGE(PG8_SB(1, 0), cB + kstep, voffB); PG8_STAGE(PG8_SA(1, 0), cA + kstep, voffA); PG8_STAGE(PG8_SB(1, 1), cB + hstep + kstep, voffB);
        PG8_WAIT_V(6); PG8_BAR;
    }
    for (;;) {
        const bool has_next = S.next(ui + 1, nxt);
        const char* nA = has_next ? (const char*)g.A + (size_t)nxt.pm * tstep : cA; const char* nB = has_next ? (const char*)g.Bt + (size_t)nxt.pn * tstep : cB;
        for (int t = 0; t < nt; t += 2) {
            const bool last = (t == nt - 2);
            const char* a1 = cA + (size_t)(t + 1) * kstep;
            const char* a2 = last ? nA : cA + (size_t)(t + 2) * kstep; const char* b2 = last ? nB : cB + (size_t)(t + 2) * kstep;
            const char* a3 = a2 + kstep; const char* b3 = b2 + kstep;
            if (last && has_next) S.a_ready(nxt);
            if constexpr (SP2) {
            PG8_LDB(B0, 0, 0); PG8_LDB(B1, 0, 1); PG8_SCHED; PG8_LDA(At, 0, 0); PG8_STAGE(PG8_SA(1, 1), a1 + hstep, voffA);
            PG8_WAIT_V(8); PG8_WAIT_L(0); PG8_BAR; PG8_MMA(0, 0, At, B0); PG8_MMA(0, 1, At, B1); PG8_BAR; PG8_SCHED;
            PG8_LDA(At, 0, 1); PG8_STAGE(PG8_SB(0, 0), b2, voffB); PG8_STAGE(PG8_SB(0, 1), b2 + hstep, voffB); PG8_STAGE(PG8_SA(0, 0), a2, voffA);
            PG8_WAIT_V(8); PG8_WAIT_L(0); PG8_BAR; PG8_MMA(1, 0, At, B0); PG8_MMA(1, 1, At, B1); PG8_BAR; PG8_SCHED;
            PG8_LDB(B0, 1, 0); PG8_LDB(B1, 1, 1); PG8_SCHED; PG8_LDA(At, 1, 0); PG8_STAGE(PG8_SA(0, 1), a2 + hstep, voffA);
            PG8_WAIT_V(8); PG8_WAIT_L(0); PG8_BAR; PG8_MMA(0, 0, At, B0); PG8_MMA(0, 1, At, B1); PG8_BAR; PG8_SCHED;
            PG8_LDA(At, 1, 1); PG8_STAGE(PG8_SB(1, 0), b3, voffB); PG8_STAGE(PG8_SB(1, 1), b3 + hstep, voffB); PG8_STAGE(PG8_SA(1, 0), a3, voffA);
            PG8_WAIT_V(8); PG8_WAIT_L(0); PG8_BAR; PG8_MMA(1, 0, At, B0); PG8_MMA(1, 1, At, B1); PG8_BAR; PG8_SCHED;
            } else {
            PG8_LDB(B0, 0, 0); PG8_SCHED; PG8_LDA(At, 0, 0); PG8_STAGE(PG8_SA(1, 1), a1 + hstep, voffA);
            PG8_WAIT_L(8); PG8_BAR; PG8_WAIT_L(0); PG8_MMA(0, 0, At, B0); PG8_BAR; PG8_SCHED;
            PG8_LDB(B1, 0, 1); PG8_STAGE(PG8_SB(0, 0), b2, voffB);
            PG8_BAR; PG8_WAIT_L(0); PG8_MMA(0, 1, At, B1); PG8_BAR;
            PG8_LDA(At, 0, 1); PG8_STAGE(PG8_SA(0, 0), a2, voffA);
            PG8_BAR; PG8_WAIT_L(0); PG8_MMA(1, 0, At, B0); PG8_BAR; PG8_SCHED;
            PG8_STAGE(PG8_SB(0, 1), b2 + hstep, voffB);
            PG8_WAIT_V(6); PG8_BAR; PG8_MMA(1, 1, At, B1); PG8_BAR;
            PG8_LDB(B0, 1, 0); PG8_SCHED; PG8_LDA(At, 1, 0); PG8_STAGE(PG8_SA(0, 1), a2 + hstep, voffA);
            PG8_WAIT_L(8); PG8_BAR; PG8_WAIT_L(0); PG8_MMA(0, 0, At, B0); PG8_BAR; PG8_SCHED;
            PG8_LDB(B1, 1, 1); PG8_STAGE(PG8_SB(1, 0), b3, voffB);
            PG8_BAR; PG8_WAIT_L(0); PG8_MMA(0, 1, At, B1); PG8_BAR;
            PG8_LDA(At, 1, 1); PG8_STAGE(PG8_SA(1, 0), a3, voffA);
            PG8_BAR; PG8_WAIT_L(0); PG8_MMA(1, 0, At, B0); PG8_BAR; PG8_SCHED;
            PG8_STAGE(PG8_SB(1, 1), b3 + hstep, voffB);
            PG8_WAIT_V(6); PG8_BAR; PG8_MMA(1, 1, At, B1); PG8_BAR;
            }
        }
        if constexpr (FP8) asm volatile("s_nop 15\n\ts_nop 15" ::: "memory");
        if constexpr (ALIGN_EPI) { if (wr == 0) PG8_BAR; }
        if constexpr (!Epi::AFTER_DRAIN) { E(acc, cur, wr, wc, fr, fq); S.done(cur); }
        if (!has_next) break;
#pragma unroll
        for (int a = 0; a < 2; ++a)
#pragma unroll
            for (int b = 0; b < 2; ++b)
#pragma unroll
                for (int m = 0; m < 4; ++m)
#pragma unroll
                    for (int n = 0; n < 2; ++n) acc[a][b][m][n] = (f32x4){0.f, 0.f, 0.f, 0.f};
        cur = nxt; cA = nA; cB = nB; ++ui;
        if constexpr (ALIGN_EPI) { if (wr == 1) PG8_BAR; }
    }
    PG8_WAIT_V(0);
    if constexpr (!ALIGN_EPI) { if (wr == 0) PG8_BAR; }
    PG8_BAR;
    if constexpr (Epi::AFTER_DRAIN) { E.fused(acc, cur, wr, wc, fr, fq, lds, wid, lane); S.done(cur); }
#undef PG8_SA
#undef PG8_SB
#undef PG8_STAGE
#undef PG8_LDA
#undef PG8_LDB
#undef PG8_MMA
#undef PG8_RD8
#undef PG8_WAIT_V
#undef PG8_WAIT_L
#undef PG8_BAR
#undef PG8_SCHED
}
}
namespace att {
typedef unsigned short bf16;
constexpr int   D = 128, NW = 8, QBLK = 32, KVBLK = 64;
constexpr float SCALE = 0.088388347648318440f;
constexpr float THR = 8.f;
constexpr int SDEPTH = 2;
constexpr int LDQ = 1024, LDK = 256, LDO = 1024;
constexpr size_t SHM_V = KVBLK * D * 2, SHM_K = KVBLK * D * 2, SHM_ATTN = 2 * SHM_V + 2 * SHM_K + NW * 64 * 4;
using bf16x8 = __attribute__((ext_vector_type(8))) short;
using s16x4  = __attribute__((ext_vector_type(4))) short;
using f32x16 = __attribute__((ext_vector_type(16))) float;
using f32x8  = __attribute__((ext_vector_type(8))) float;
using u32x4  = __attribute__((ext_vector_type(4))) unsigned;
#define KSWZ(row, colB) ((row) * 256 + ((colB) ^ (((row) & 7) << 4)))
#define SBAR() __builtin_amdgcn_sched_barrier(0)
__device__ __forceinline__ int crow(int r, int hi) { return (r & 3) + 8 * (r >> 2) + 4 * hi; }
__device__ __forceinline__ unsigned cvtpk(float lo, float hi) { return pg8::cvt_pk_bf16(lo, hi); }
template <typename TIn> struct Stage;
template <> struct Stage<bf16>  { using T = bf16x8;
  __device__ static __forceinline__ T ld8(const bf16* p) { return *reinterpret_cast<const bf16x8*>(p); }
  __device__ static __forceinline__ bf16x8 tobf(T x) { return x; } };
template <> struct Stage<float> { using T = f32x8;
  __device__ static __forceinline__ T ld8(const float* p) { return *reinterpret_cast<const f32x8*>(p); }
  __device__ static __forceinline__ bf16x8 tobf(T x) {
    u32x4 w = {cvtpk(x[0], x[1]), cvtpk(x[2], x[3]), cvtpk(x[4], x[5]), cvtpk(x[6], x[7])}; return *reinterpret_cast<bf16x8*>(&w); } };

__device__ __forceinline__ void partialSM(f32x16& p0, f32x16& p1, float& m_reg, float& mn, float& alpha) {
  constexpr float C = SCALE * 1.4426950408889634f;
  float pmax = p0[0]; for (int r = 1; r < 16; ++r) pmax = fmaxf(pmax, p0[r]); for (int r = 0; r < 16; ++r) pmax = fmaxf(pmax, p1[r]);
  { auto rr = __builtin_amdgcn_permlane32_swap(__float_as_uint(pmax), __float_as_uint(pmax), false, false);
    pmax = fmaxf(__uint_as_float(rr[0]), __uint_as_float(rr[1])); }
  if (__builtin_expect(__all(pmax - m_reg <= THR / SCALE), 1)) { mn = m_reg; alpha = 1.f; }
  else { mn = fmaxf(m_reg, pmax); alpha = __builtin_amdgcn_exp2f((m_reg - mn) * C); m_reg = mn; }
  float mnC = -mn * C;
  for (int r = 0; r < 16; ++r) p0[r] = fmaf(p0[r], C, mnC); for (int r = 0; r < 16; ++r) p1[r] = fmaf(p1[r], C, mnC);
  for (int r = 0; r < 16; ++r) p0[r] = __builtin_amdgcn_exp2f(p0[r]);
}
__device__ __forceinline__ void finishSM(f32x16& p0, f32x16& p1, float alpha, float& l_reg, bf16x8& pa0, bf16x8& pa1, bf16x8& pa2, bf16x8& pa3) {
  for (int r = 0; r < 16; ++r) p1[r] = __builtin_amdgcn_exp2f(p1[r]);
  float ps = 0; for (int r = 0; r < 16; ++r) ps += p0[r]; for (int r = 0; r < 16; ++r) ps += p1[r];
  { auto rr = __builtin_amdgcn_permlane32_swap(__float_as_uint(ps), __float_as_uint(ps), false, false);
    ps = __uint_as_float(rr[0]) + __uint_as_float(rr[1]); }
  l_reg = l_reg * alpha + ps;
#define PK4(P, BASE, OUT) do { unsigned a0 = cvtpk(P[BASE + 0], P[BASE + 1]), a1 = cvtpk(P[BASE + 2], P[BASE + 3]);   \
    unsigned b0 = cvtpk(P[BASE + 4], P[BASE + 5]), b1 = cvtpk(P[BASE + 6], P[BASE + 7]);                              \
    auto r0 = __builtin_amdgcn_permlane32_swap(a0, b0, false, false); auto r1 = __builtin_amdgcn_permlane32_swap(a1, b1, false, false); \
    u32x4 w = {r0[0], r1[0], r0[1], r1[1]}; OUT = *reinterpret_cast<bf16x8*>(&w); } while (0)
  PK4(p0, 0, pa0); PK4(p0, 8, pa1); PK4(p1, 0, pa2); PK4(p1, 8, pa3);
#undef PK4
}
__device__ __forceinline__ void qkt(f32x16& p0, f32x16& p1, const bf16* Ks, const bf16x8* qr, int r32, int hi) {
  p0 = f32x16{}; p1 = f32x16{};
  for (int d0 = 0; d0 < 8; ++d0) { int cb = (d0 * 16 + hi * 8) * 2;
    bf16x8 b0 = *reinterpret_cast<const bf16x8*>((const char*)Ks + KSWZ(r32, cb));
    bf16x8 b1 = *reinterpret_cast<const bf16x8*>((const char*)Ks + KSWZ(32 + r32, cb));
    p0 = __builtin_amdgcn_mfma_f32_32x32x16_bf16(b0, qr[d0], p0, 0, 0, 0);
    p1 = __builtin_amdgcn_mfma_f32_32x32x16_bf16(b1, qr[d0], p1, 0, 0, 0); }
}
__device__ __forceinline__ int v_st(int k, int c) { const int kk = (k & ~0xC) | ((k & 4) << 1) | ((k & 8) >> 1); return ((kk >> 3) * 4 + (c >> 5)) * 512 + ((kk & 7) * 32 + (c & 31)) * 2; }
__device__ __forceinline__ int v_rd_base(int lane) { return ((lane & 3) << 3) | (((lane >> 2) & 3) << 6) | (((lane >> 4) & 1) << 5) | (((lane >> 5) & 1) << 8); }
constexpr int v_rd_off(int d0, int ks, int half) { return d0 * 512 + ks * 4096 + half * 2048; }
template <int OFF> __device__ __forceinline__ s16x4 tr_read(int vb) {
  s16x4 r; asm volatile("ds_read_b64_tr_b16 %0, %1 offset:%2" : "=&v"(r) : "v"(vb), "i"(OFF) : "memory"); return r;
}
template <int D0> __device__ __forceinline__ void pv_one(f32x16& od, int vb, bf16x8 pa0, bf16x8 pa1, bf16x8 pa2, bf16x8 pa3) {
  const s16x4 l0 = tr_read<v_rd_off(D0, 0, 0)>(vb), h0 = tr_read<v_rd_off(D0, 0, 1)>(vb), l1 = tr_read<v_rd_off(D0, 1, 0)>(vb), h1 = tr_read<v_rd_off(D0, 1, 1)>(vb);
  const s16x4 l2 = tr_read<v_rd_off(D0, 2, 0)>(vb), h2 = tr_read<v_rd_off(D0, 2, 1)>(vb), l3 = tr_read<v_rd_off(D0, 3, 0)>(vb), h3 = tr_read<v_rd_off(D0, 3, 1)>(vb);
  asm volatile("s_waitcnt lgkmcnt(0)" ::: "memory"); SBAR();
#define PK(L, H) (bf16x8){L[0], L[1], L[2], L[3], H[0], H[1], H[2], H[3]}
  od = __builtin_amdgcn_mfma_f32_32x32x16_bf16(pa0, PK(l0, h0), od, 0, 0, 0);
  od = __builtin_amdgcn_mfma_f32_32x32x16_bf16(pa1, PK(l1, h1), od, 0, 0, 0);
  od = __builtin_amdgcn_mfma_f32_32x32x16_bf16(pa2, PK(l2, h2), od, 0, 0, 0);
  od = __builtin_amdgcn_mfma_f32_32x32x16_bf16(pa3, PK(l3, h3), od, 0, 0, 0);
#undef PK
}
__device__ __forceinline__ void pv_d0(f32x16* o, int vb, bf16x8 pa0, bf16x8 pa1, bf16x8 pa2, bf16x8 pa3) {
  pv_one<0>(o[0], vb, pa0, pa1, pa2, pa3); pv_one<1>(o[1], vb, pa0, pa1, pa2, pa3); pv_one<2>(o[2], vb, pa0, pa1, pa2, pa3); pv_one<3>(o[3], vb, pa0, pa1, pa2, pa3);
}

template <typename TQ>
__device__ __forceinline__ void attn_dense_body(const TQ* __restrict__ Qb, const bf16* __restrict__ Kh, const bf16* __restrict__ Vh,
                                                unsigned char* __restrict__ Ob, int seq, char* lds, const int tid_in) {
  using St = Stage<bf16>; using SQ = Stage<TQ>;
  int tid_ = tid_in; asm volatile("" : "+v"(tid_));
  const int tid = tid_, wid = tid >> 6, lane = tid & 63, r32 = lane & 31, hi = lane >> 5;
  bf16* V_lds = (bf16*)lds; bf16* K_lds = (bf16*)(lds + 2 * SHM_V);
  float* ws = (float*)(lds + 2 * SHM_V + 2 * SHM_K) + wid * 64; float* li_l = ws; float* al_l = ws + 32;
  float m_reg = -1e30f, l_reg = 0; f32x16 o[4] = {}; bf16x8 qr[8];
  const TQ* Qw = Qb + (long)(wid * QBLK + r32) * LDQ + hi * 8;
#pragma unroll
  for (int d0 = 0; d0 < 8; ++d0) qr[d0] = SQ::tobf(SQ::ld8(Qw + d0 * 16));
  const int sr = tid >> 4, sc = (tid & 15) * 8, vst0 = v_st(sr, sc), vst1 = v_st(32 + sr, sc);
  const int vb0 = (int)(uintptr_t)V_lds + v_rd_base(lane);
  struct { typename St::T vs0, vs1, ks0, ks1; } sr_[SDEPTH];
#define SLOAD(i, k0) do { sr_[i].vs0 = St::ld8(&Vh[(long)((k0) + sr) * LDK + sc]); sr_[i].vs1 = St::ld8(&Vh[(long)((k0) + 32 + sr) * LDK + sc]); \
    sr_[i].ks0 = St::ld8(&Kh[(long)((k0) + sr) * LDK + sc]); sr_[i].ks1 = St::ld8(&Kh[(long)((k0) + 32 + sr) * LDK + sc]); } while (0)
#define SWRITE(b, i) do { *(bf16x8*)((char*)V_lds + (b) * SHM_V + vst0) = St::tobf(sr_[i].vs0);          \
    *(bf16x8*)((char*)V_lds + (b) * SHM_V + vst1) = St::tobf(sr_[i].vs1); int kc = sc * 2;               \
    *(bf16x8*)((char*)K_lds + (b) * SHM_K + KSWZ(sr, kc)) = St::tobf(sr_[i].ks0);                       \
    *(bf16x8*)((char*)K_lds + (b) * SHM_K + KSWZ(32 + sr, kc)) = St::tobf(sr_[i].ks1); } while (0)
#define SWAIT() do { if constexpr (SDEPTH == 2) asm volatile("s_waitcnt vmcnt(4)" ::: "memory"); else asm volatile("s_waitcnt vmcnt(0)" ::: "memory"); } while (0)
#define RESC(a) do { if (__any((a) < 1.f)) { if (hi == 0) al_l[r32] = (a); asm volatile("s_waitcnt lgkmcnt(0)" ::: "memory"); \
    for (int d = 0; d < 4; ++d) for (int r = 0; r < 16; ++r) o[d][r] *= al_l[crow(r, hi)]; } } while (0)
  f32x16 pA0, pA1, pB0, pB1; float mnA, mnB, alA, alB; bf16x8 pa0, pa1, pa2, pa3; const int NT = seq / KVBLK;
  constexpr int SE = 0, SO = SDEPTH - 1;
  SLOAD(SE, 0); asm volatile("s_waitcnt vmcnt(0)" ::: "memory"); SWRITE(0, SE); __syncthreads();
  qkt(pA0, pA1, K_lds, qr, r32, hi); partialSM(pA0, pA1, m_reg, mnA, alA);
  SLOAD(SO, KVBLK); if constexpr (SDEPTH == 2) { if (2 < NT) SLOAD(SE, 2 * KVBLK); }
  SWAIT(); SWRITE(1, SO); __syncthreads();
  for (int j = 1; j + 1 < NT; j += 2) {
    SBAR(); qkt(pB0, pB1, (bf16*)((char*)K_lds + SHM_K), qr, r32, hi);
    finishSM(pA0, pA1, alA, l_reg, pa0, pa1, pa2, pa3); SBAR();
    SLOAD(SO, (j + SDEPTH) * KVBLK); SBAR();
    pv_d0(o, vb0, pa0, pa1, pa2, pa3); partialSM(pB0, pB1, m_reg, mnB, alB);
    __syncthreads(); SWAIT(); SWRITE(0, SE);
    RESC(alB); __syncthreads();
    SBAR(); qkt(pA0, pA1, K_lds, qr, r32, hi);
    finishSM(pB0, pB1, alB, l_reg, pa0, pa1, pa2, pa3); SBAR();
    if (SDEPTH == 1 || j + 3 < NT) SLOAD(SE, (j + 1 + SDEPTH) * KVBLK); SBAR();
    pv_d0(o, vb0 + (int)SHM_V, pa0, pa1, pa2, pa3); partialSM(pA0, pA1, m_reg, mnA, alA);
    __syncthreads(); SWAIT(); SWRITE(1, SO);
    RESC(alA); __syncthreads();
  }
  SBAR(); qkt(pB0, pB1, (bf16*)((char*)K_lds + SHM_K), qr, r32, hi);
  finishSM(pA0, pA1, alA, l_reg, pa0, pa1, pa2, pa3); SBAR();
  pv_d0(o, vb0, pa0, pa1, pa2, pa3); partialSM(pB0, pB1, m_reg, mnB, alB);
  __syncthreads(); RESC(alB);
  finishSM(pB0, pB1, alB, l_reg, pa0, pa1, pa2, pa3); SBAR();
  pv_d0(o, vb0 + (int)SHM_V, pa0, pa1, pa2, pa3);
  if (hi == 0) li_l[r32] = l_reg; asm volatile("s_waitcnt lgkmcnt(0)" ::: "memory");
  float rli[16];
#pragma unroll
  for (int r = 0; r < 16; ++r) rli[r] = __builtin_amdgcn_rcpf(li_l[crow(r, hi)]);
  unsigned char* Ow = Ob + (long)(wid * QBLK) * LDO;
#pragma unroll
  for (int r = 0; r < 16; ++r) { int orow = crow(r, hi);
    for (int d0 = 0; d0 < 4; ++d0) { const float ov = o[d0][r] * rli[r] * 64.0f; Ow[(long)orow * LDO + d0 * 32 + r32] = (unsigned char)(__builtin_amdgcn_cvt_pk_fp8_f32(ov, ov, __builtin_bit_cast(int, ov), false) & 0xff); } }
#undef SLOAD
#undef SWRITE
#undef SWAIT
#undef RESC
}
#undef KSWZ
#undef SBAR
}

#define GAS __attribute__((address_space(1)))
#define LAS __attribute__((address_space(3)))
typedef unsigned short bf16;
typedef unsigned v4u __attribute__((ext_vector_type(4)));
typedef float f32x4 __attribute__((ext_vector_type(4)));
typedef short bf16x8 __attribute__((ext_vector_type(8)));
typedef GAS unsigned gu32;
typedef GAS unsigned long long gu64;
#define RLX_AGENT __ATOMIC_RELAXED, __HIP_MEMORY_SCOPE_AGENT
#define LDS_WAIT() asm volatile("s_waitcnt lgkmcnt(0)" ::: "memory")
#define VM_WAIT() asm volatile("s_waitcnt vmcnt(0)" ::: "memory")
__device__ __forceinline__ unsigned long long rt() { return __builtin_amdgcn_s_memrealtime(); }
__device__ __forceinline__ unsigned f2bf(float f) { unsigned u = __builtin_bit_cast(unsigned, f); return (u + 0x7fffu + ((u >> 16) & 1u)) >> 16; }
__device__ __forceinline__ unsigned pk2(float lo, float hi) { return f2bf(lo) | (f2bf(hi) << 16); }

#define XB_TMO      128
#define XB_XCNT(j)  (256  + 64 * (j))
#define XB_XSUB(j)  (1280 + 64 * (j))
#define XB_XGEN(j)  (2304 + 64 * (j))
#define XB_TOP      3328
#define XB_TOPGEN   3392
#define XCD_BAR_WORDS 3456
#define XB_SPIN_CAP (1u << 18)

__device__ __forceinline__ unsigned xb_ld(unsigned* p)              { return __hip_atomic_load(p, __ATOMIC_RELAXED, __HIP_MEMORY_SCOPE_AGENT); }
__device__ __forceinline__ unsigned xb_add(unsigned* p, unsigned v) { return __hip_atomic_fetch_add(p, v, __ATOMIC_RELAXED, __HIP_MEMORY_SCOPE_AGENT); }
__device__ __forceinline__ unsigned xb_xcc_id() { return (unsigned)__builtin_amdgcn_s_getreg((3 << 11) | 20) & 0xFu; }
#define XB_SPIN(cond, bar) do { unsigned _sp = 0; while (cond) { __builtin_amdgcn_s_sleep(1); \
    if ((++_sp & 255u) == 0u) { if (xb_ld(&(bar)[XB_TMO])) break; if (_sp > XB_SPIN_CAP) { atomicAdd(&(bar)[XB_TMO], 1u); break; } } } } while (0)

struct XcdBarrier {
    unsigned* bar; unsigned x;
    volatile LAS unsigned* st;
};

__device__ __forceinline__ XcdBarrier xcd_barrier_post(unsigned* bar, volatile LAS unsigned* st) {
    XcdBarrier b; b.bar = bar; b.x = xb_xcc_id(); b.st = st;
    if (threadIdx.x == 0) (void)xb_add(&bar[XB_XCNT(b.x)], 1u);
    return b;
}
__device__ __forceinline__ void xcd_barrier_complete(unsigned* bar, unsigned x, unsigned& nloc, unsigned& nx) {
    const unsigned G = gridDim.x * gridDim.y * gridDim.z;
    unsigned sum, cnt, mine, sp = 0u;
    for (;;) {
        sum = 0u; cnt = 0u; mine = 0u;
#pragma unroll
        for (unsigned j = 0; j < 16; ++j) { const unsigned c = xb_ld(&bar[XB_XCNT(j)]); sum += c; cnt += (c > 0u) ? 1u : 0u; mine = (j == x) ? c : mine; }
        if (sum == G) break;
        __builtin_amdgcn_s_sleep(1);
        if ((++sp & 255u) == 0u) { if (xb_ld(&bar[XB_TMO])) break; if (sp > XB_SPIN_CAP) { atomicAdd(&bar[XB_TMO], 1u); break; } }
    }
    nloc = mine > 0u ? mine : 1u; nx = cnt > 0u ? cnt : 1u;
}

__device__ __forceinline__ void xcd_barrier(const XcdBarrier& b) {
    asm volatile("s_waitcnt vmcnt(0)" ::: "memory");
    __syncthreads();
    if (threadIdx.x == 0) {
        unsigned* bar = b.bar;
        __builtin_amdgcn_s_waitcnt(0);
        unsigned nloc = b.st[0], nx = b.st[1];
        if (nloc == 0u) { xcd_barrier_complete(bar, b.x, nloc, nx); b.st[0] = nloc; b.st[1] = nx; }
        const unsigned old = xb_add(&bar[XB_XSUB(b.x)], 1u);
        const unsigned gen = old / nloc;
        if (old + 1u == (gen + 1u) * nloc) {
            __builtin_amdgcn_fence(__ATOMIC_RELEASE, "agent");
            asm volatile("s_waitcnt vmcnt(0)" ::: "memory");
            const unsigned og = xb_add(&bar[XB_TOP], 1u);
            const unsigned tg = og / nx;
            if (og + 1u == (tg + 1u) * nx) xb_add(&bar[XB_TOPGEN], 1u);
            else XB_SPIN(xb_ld(&bar[XB_TOPGEN]) == tg, bar);
            __builtin_amdgcn_fence(__ATOMIC_ACQUIRE, "agent");
            xb_add(&bar[XB_XGEN(b.x)], 1u);
            asm volatile("s_waitcnt vmcnt(0)" ::: "memory");
        } else {
            XB_SPIN(xb_ld(&bar[XB_XGEN(b.x)]) == gen, bar);
            __builtin_amdgcn_fence(__ATOMIC_ACQUIRE, "agent");
            asm volatile("s_waitcnt vmcnt(0)" ::: "memory");
        }
    }
    __syncthreads();
}
constexpr int DM = 1024, NB = 16, SEQ = 2048, CTXL = 256, TL = NB * SEQ, TC = NB * CTXL, TALL = TL + TC;
constexpr int INCOLS = 6144, OFF_FNET = 2560, OFF_GATE = 3072;
constexpr int NEXP = 32, KVROWS = SEQ + CTXL;
constexpr float EPS = 1e-6f;
constexpr int NWAVES = 8, NTHR = NWAVES * 64;
constexpr int NPL = 13, NPH = 2 + 2 * NPL;
#ifndef MK_PER_PHASE
#define MK_PER_PHASE 0
#endif
constexpr size_t MiB = 1u << 20;
constexpr size_t WS_CTL = 0, CTL_ZERO_BYTES = 1 * MiB;
constexpr size_t WS_MOD = 1 * MiB;
constexpr size_t WS_TAB = 2 * MiB;
constexpr size_t WS_TOPI = 3 * MiB, WS_TOPP = 4 * MiB, WS_SLOT = 5 * MiB, WS_CNT = 6 * MiB;
constexpr size_t WS_LOGIT = 7 * MiB;
constexpr size_t WS_WSMALL = 17 * MiB, WSMALL_LAYER = 20 * MiB;
constexpr size_t OFFS_WIN = 0, OFFS_WF = 5 * MiB, OFFS_WG = 7 * MiB, OFFS_WAO = 13 * MiB, OFFS_WCO = 15 * MiB, OFFS_WFO = 16 * MiB, OFFS_WOUT = 17 * MiB, OFFS_ROUT = 19 * MiB;
constexpr size_t WS_DFTL = 57 * MiB, WS_DFTC = 73 * MiB;
constexpr size_t WS_XC = 74 * MiB;
constexpr size_t WS_H = 90 * MiB;
constexpr size_t WS_WGU = 162 * MiB, WS_WD = 226 * MiB, MOEW_LAYER = 96 * MiB;
constexpr size_t WS_BIG = 354 * MiB;
constexpr size_t WS_Q = WS_BIG, WS_K = WS_Q + 72 * MiB, WS_V = WS_K + 18 * MiB, WS_CU = WS_V + 18 * MiB, WS_YT = WS_CU + 36 * MiB, WS_YTC = WS_YT + 64 * MiB;
constexpr size_t WS_GATES = WS_BIG;
constexpr size_t WS_AO = WS_BIG + 216 * MiB, WS_CH = WS_AO + 72 * MiB, WS_Z = WS_CH + 36 * MiB;
constexpr size_t WS_MIX = WS_AO;
constexpr size_t WS_MERGED = WS_BIG + 360 * MiB;
constexpr int SLOT_ROWS = 608 * 256;
constexpr size_t WS_YS = WS_BIG, WS_HS = WS_BIG + 304 * MiB, WS_ACT = WS_BIG + 456 * MiB, WS_END = WS_BIG + 608 * MiB;
constexpr size_t WS_H8 = WS_END;
constexpr size_t WS_END2 = WS_END + 36 * MiB;
static_assert(WS_YTC + 8 * MiB == WS_AO && WS_Z + 36 * MiB == WS_MERGED && WS_MERGED + 72 * MiB <= WS_END && (size_t)SLOT_ROWS * 2048 == 304 * MiB, "ws map");
constexpr int CW_TMO = 0, CW_CODE = 1, CW_BAR = 4096;
constexpr int CNT_TILE_E = 16384, CNT_NT = 16384 + 1024;

constexpr int RING_OFF = 0, RING_BYTES = 131072;
constexpr int LDSCTL_OFF = RING_BYTES, MISC_OFF = LDSCTL_OFF + 320, LDS_CT = LDSCTL_OFF + 512, LDS_SM = LDSCTL_OFF + 1024;
constexpr int LDS_BYTES = 147456;

typedef unsigned u32x2 __attribute__((ext_vector_type(2)));
typedef int i32x4 __attribute__((ext_vector_type(4)));
typedef float f32x2 __attribute__((ext_vector_type(2)));
struct Args { const float* in[29]; float* out; unsigned char* ws; int ph_lo, ph_hi; };
typedef const __attribute__((address_space(4))) unsigned char* kptr_t;
struct AV {
    kptr_t kp;
    __device__ __forceinline__ const float* in(int i) const { return *(const float* const __attribute__((address_space(4)))*)(kp + 8 * i); }
    __device__ __forceinline__ float* out() const { return *(float* const __attribute__((address_space(4)))*)(kp + 8 * 29); }
    __device__ __forceinline__ unsigned char* ws() const { return *(unsigned char* const __attribute__((address_space(4)))*)(kp + 8 * 30); }
};
__device__ __forceinline__ AV av_get() { AV a; a.kp = (kptr_t)__builtin_amdgcn_kernarg_segment_ptr(); asm volatile("" : "+s"(a.kp)); return a; }

struct Frame {
    LAS unsigned char* lds; volatile LAS unsigned* MISC; gu32* ctl;
    int tid, lane, wave, vcu, G;
};

__device__ __forceinline__ float shx(float v, int m, int lane) { return __int_as_float(__builtin_amdgcn_ds_bpermute((lane ^ m) << 2, __float_as_int(v))); }
__device__ __forceinline__ float wave_sum(float v, int lane) {
#pragma unroll
    for (int o = 1; o < 64; o <<= 1) v += shx(v, o, lane);
    return v;
}
__device__ __forceinline__ float sigmoidf_(float x) { return 1.0f / (1.0f + __expf(-x)); }
__device__ __forceinline__ f32x4 bf4(u32x2 w) { f32x4 r; r[0] = __uint_as_float(w.x << 16); r[1] = __uint_as_float(w.x & 0xffff0000u); r[2] = __uint_as_float(w.y << 16); r[3] = __uint_as_float(w.y & 0xffff0000u); return r; }
__device__ __forceinline__ u32x2 pk4(f32x4 v) { u32x2 w; w.x = pk2(v[0], v[1]); w.y = pk2(v[2], v[3]); return w; }
__device__ __forceinline__ void ld_row_f32(f32x4 (&v)[4], const float* p, int lane) {
#pragma unroll
    for (int j = 0; j < 4; ++j) v[j] = ((const GAS f32x4*)p)[lane + 64 * j];
}
__device__ __forceinline__ void st_row_f32(const f32x4 (&v)[4], float* p, int lane) {
#pragma unroll
    for (int j = 0; j < 4; ++j) ((GAS f32x4*)p)[lane + 64 * j] = v[j];
}
__device__ __forceinline__ void ld_row_bf16(f32x4 (&v)[4], const bf16* p, int lane) {
#pragma unroll
    for (int j = 0; j < 4; ++j) v[j] = bf4(((const GAS u32x2*)p)[lane + 64 * j]);
}
__device__ __forceinline__ void st_row_bf16(const f32x4 (&v)[4], bf16* p, int lane) {
#pragma unroll
    for (int j = 0; j < 4; ++j) ((GAS u32x2*)p)[lane + 64 * j] = pk4(v[j]);
}
__device__ __forceinline__ void rms_gain(f32x4 (&v)[4], const float* g, int lane) {
    float ss = 0.f;
#pragma unroll
    for (int j = 0; j < 4; ++j) ss += (v[j][0] * v[j][0] + v[j][1] * v[j][1]) + (v[j][2] * v[j][2] + v[j][3] * v[j][3]);
    const float r = 1.0f / sqrtf(wave_sum(ss, lane) * (1.0f / 1024.0f) + EPS);
#pragma unroll
    for (int j = 0; j < 4; ++j) { const f32x4 gg = ((const GAS f32x4*)g)[lane + 64 * j]; v[j] = v[j] * r * gg; }
}
__device__ __forceinline__ void modulate_store(const f32x4 (&v)[4], const float* shift, const float* scale, bf16* o, int lane) {
#pragma unroll
    for (int j = 0; j < 4; ++j) { const f32x4 sh = ((const GAS f32x4*)shift)[lane + 64 * j], sc = ((const GAS f32x4*)scale)[lane + 64 * j];
        ((GAS u32x2*)o)[lane + 64 * j] = pk4(v[j] * (sc + 1.0f) + sh); }
}
__device__ __forceinline__ unsigned pk4_fp8(f32x4 v) { return pg8::cvt4_fp8(v[0], v[1], v[2], v[3]); }
__device__ __forceinline__ void modulate_store2(const f32x4 (&v)[4], const float* shift, const float* scale, bf16* o, unsigned char* o8, int lane) {
#pragma unroll
    for (int j = 0; j < 4; ++j) { const f32x4 sh = ((const GAS f32x4*)shift)[lane + 64 * j], sc = ((const GAS f32x4*)scale)[lane + 64 * j]; const f32x4 r = v[j] * (sc + 1.0f) + sh;
        ((GAS u32x2*)o)[lane + 64 * j] = pk4(r); ((GAS unsigned*)o8)[lane + 64 * j] = pk4_fp8(r); }
}
__device__ __forceinline__ int krow_of(int m) { return m < TL ? (m >> 11) * KVROWS + (m & 2047) : ((m - TL) >> 8) * KVROWS + SEQ + ((m - TL) & 255); }

__device__ __forceinline__ void load_block(const float* W, int ldw, int k0, int n0, float scale, LAS float* scr, int lane) {
    f32x4 v[8]; const int kr = lane >> 3, c4 = (lane & 7) * 4;
#pragma unroll
    for (int i = 0; i < 8; ++i) v[i] = *(const GAS f32x4*)(W + (size_t)(k0 + kr + 8 * i) * ldw + n0 + c4);
#pragma unroll
    for (int i = 0; i < 8; ++i) { LAS float* d = scr + (kr + 8 * i) * 33 + c4; d[0] = v[i][0] * scale; d[1] = v[i][1] * scale; d[2] = v[i][2] * scale; d[3] = v[i][3] * scale; }
    LDS_WAIT(); asm volatile("" ::: "memory");
}
__device__ __forceinline__ void transpose_item(const float* W, int ldw, int K, bf16* WT, int dst_row0, int k0, int n0, LAS float* scr, int lane) {
    load_block(W, ldw, k0, n0, 1.0f, scr, lane);
    const int c = lane & 7;
#pragma unroll
    for (int j = 0; j < 4; ++j) { const int n = (lane >> 3) + 8 * j; const LAS float* s = scr + (8 * c) * 33 + n;
        v4u o; o.x = pk2(s[0 * 33], s[1 * 33]); o.y = pk2(s[2 * 33], s[3 * 33]); o.z = pk2(s[4 * 33], s[5 * 33]); o.w = pk2(s[6 * 33], s[7 * 33]);
        *(GAS v4u*)(WT + (size_t)(dst_row0 + n) * K + k0 + 8 * c) = o; }
    LDS_WAIT(); asm volatile("" ::: "memory");
}
__device__ __forceinline__ void transpose_item_fp8(const float* W, int ldw, int K, unsigned char* WT, int dst_row0, int k0, int n0, float scale, LAS float* scr, int lane) {
    load_block(W, ldw, k0, n0, scale, scr, lane);
#pragma unroll
    for (int j = 0; j < 2; ++j) { const int q = lane + 64 * j, n = q >> 2, c = q & 3; const LAS float* s = scr + (16 * c) * 33 + n; v4u o;
        o.x = pg8::cvt4_fp8(s[0 * 33], s[1 * 33], s[2 * 33], s[3 * 33]); o.y = pg8::cvt4_fp8(s[4 * 33], s[5 * 33], s[6 * 33], s[7 * 33]); o.z = pg8::cvt4_fp8(s[8 * 33], s[9 * 33], s[10 * 33], s[11 * 33]); o.w = pg8::cvt4_fp8(s[12 * 33], s[13 * 33], s[14 * 33], s[15 * 33]);
        *(GAS v4u*)(WT + (size_t)(dst_row0 + n) * K + k0 + 16 * c) = o; }
    LDS_WAIT(); asm volatile("" ::: "memory");
}
constexpr int IT_S0 = 16 * 80, IT_S1 = 16 * 96, IT_S2 = 512, IT_S3 = 512, IT_S4 = 256, IT_S5 = 256, IT_SMALL = IT_S0 + IT_S1 + IT_S2 + IT_S3 + IT_S4 + IT_S5;
__device__ __forceinline__ void small_item(const AV& a, int l, int r, LAS float* scr, int lane) {
    unsigned char* wl = a.ws() + WS_WSMALL + (size_t)l * WSMALL_LAYER; const float* win = a.in(10) + (size_t)l * DM * INCOLS;
    if (r < IT_S0) { const int kb = r / 80, n0 = (r % 80) * 32; int dr;
        if (n0 < 1536) dr = n0; else { int cc = n0 - 1536; if (cc < 512) dr = 1536 + (cc >> 7) * 256 + (cc & 127); else { cc -= 512; dr = 1536 + (cc >> 7) * 256 + 128 + (cc & 127); } }
        transpose_item_fp8(win, INCOLS, DM, wl + OFFS_WIN, dr, kb * 64, n0, 32.0f, scr, lane); return; }
    r -= IT_S0;
    if (r < IT_S1) { const int kb = r / 96, nb = r % 96; transpose_item_fp8(win, INCOLS, DM, wl + OFFS_WG, nb * 32, kb * 64, OFF_GATE + nb * 32, 32.0f, scr, lane); return; }
    r -= IT_S1;
    if (r < IT_S2) { const int kb = r / 32, nb = r % 32; transpose_item_fp8(a.in(13) + (size_t)l * DM * DM, DM, DM, wl + OFFS_WAO, nb * 32, kb * 64, nb * 32, 32.0f, scr, lane); return; }
    r -= IT_S2;
    if (r < IT_S3) { const int kb = r / 32, nb = r % 32; transpose_item(a.in(20) + (size_t)l * DM * DM, DM, DM, (bf16*)(wl + OFFS_WOUT), nb * 32, kb * 64, nb * 32, scr, lane); return; }
    r -= IT_S3;
    if (r < IT_S4) { const int kb = r / 32, nb = r % 32; transpose_item(a.in(18) + (size_t)l * 512 * DM, DM, 512, (bf16*)(wl + OFFS_WCO), nb * 32, kb * 64, nb * 32, scr, lane); return; }
    r -= IT_S4;
    { const int kb = r / 32, nb = r % 32; transpose_item(a.in(19) + (size_t)l * 512 * DM, DM, 512, (bf16*)(wl + OFFS_WFO), nb * 32, kb * 64, nb * 32, scr, lane); }
}
constexpr int IT_MOE = NEXP * 3 * 512;
struct MoeIt { const float* W; unsigned char* WT; int dr, k0; };
__device__ __forceinline__ MoeIt moe_decode(const AV& a, int gi) {
    const int l = gi / IT_MOE, idx = gi % IT_MOE, e = idx / 1536, r = idx % 1536, which = r / 512, it = r % 512, kb = it / 32, n0 = (it % 32) * 32; const size_t eo = ((size_t)l * NEXP + e) << 20;
    MoeIt m; m.k0 = kb * 64;
    if (which == 0) { m.W = a.in(23) + eo + n0; m.WT = a.ws() + WS_WGU + (size_t)l * MOEW_LAYER + (size_t)e * 2048 * 1024; m.dr = (n0 >> 7) * 256 + (n0 & 127); }
    else if (which == 1) { m.W = a.in(25) + eo + n0; m.WT = a.ws() + WS_WGU + (size_t)l * MOEW_LAYER + (size_t)e * 2048 * 1024; m.dr = (n0 >> 7) * 256 + 128 + (n0 & 127); }
    else { m.W = a.in(27) + eo + n0; m.WT = a.ws() + WS_WD + (size_t)l * MOEW_LAYER + (size_t)e * 1024 * 1024; m.dr = n0; }
    return m;
}
__device__ __forceinline__ void moe_issue(f32x4 (&v)[8], const MoeIt& m, int lane) {
    const float* p = m.W + (size_t)(m.k0 + (lane >> 3)) * DM + (lane & 7) * 4;
#pragma unroll
    for (int i = 0; i < 8; ++i) v[i] = *(const GAS f32x4*)(p + (size_t)(8 * i) * DM);
}
__device__ __forceinline__ void moe_finish(const f32x4 (&v)[8], const MoeIt& m, LAS float* scr, int lane) {
    const int kr = lane >> 3, c4 = (lane & 7) * 4;
#pragma unroll
    for (int i = 0; i < 8; ++i) { LAS float* d = scr + (kr + 8 * i) * 33 + c4; d[0] = v[i][0] * 32.0f; d[1] = v[i][1] * 32.0f; d[2] = v[i][2] * 32.0f; d[3] = v[i][3] * 32.0f; }
    LDS_WAIT(); asm volatile("" ::: "memory");
#pragma unroll
    for (int j = 0; j < 2; ++j) { const int q = lane + 64 * j, n = q >> 2, c = q & 3; const LAS float* s = scr + (16 * c) * 33 + n; v4u o;
        o.x = pg8::cvt4_fp8(s[0 * 33], s[1 * 33], s[2 * 33], s[3 * 33]); o.y = pg8::cvt4_fp8(s[4 * 33], s[5 * 33], s[6 * 33], s[7 * 33]); o.z = pg8::cvt4_fp8(s[8 * 33], s[9 * 33], s[10 * 33], s[11 * 33]); o.w = pg8::cvt4_fp8(s[12 * 33], s[13 * 33], s[14 * 33], s[15 * 33]);
        *(GAS v4u*)(m.WT + (size_t)(m.dr + n) * DM + m.k0 + 16 * c) = o; }
    LDS_WAIT(); asm volatile("" ::: "memory");
}
__device__ __forceinline__ void moe_convert_all(const AV& a, int gw, int NGW, LAS float* scr, int lane) {
    constexpr int NIT = 2 * IT_MOE; f32x4 va[8], vb[8]; int it = gw; if (it >= NIT) return;
    MoeIt ma = moe_decode(a, it), mb = ma; moe_issue(va, ma, lane);
    for (;;) {
        const bool h1 = it + NGW < NIT; if (h1) { mb = moe_decode(a, it + NGW); moe_issue(vb, mb, lane); }
        moe_finish(va, ma, scr, lane); if (!h1) break; it += NGW;
        const bool h2 = it + NGW < NIT; if (h2) { ma = moe_decode(a, it + NGW); moe_issue(va, ma, lane); }
        moe_finish(vb, mb, scr, lane); if (!h2) break; it += NGW;
    }
}
__device__ __forceinline__ void fold_job(const AV& a, int j, const LAS float* ct, int lane) {
    const int l = j >> 10, r = j & 1023, g = r >> 8, kblk = (r >> 4) & 15, k2g = r & 15, k = kblk * 64 + lane;
    const float* wrow = a.in(10) + (size_t)l * DM * INCOLS + (size_t)k * INCOLS + OFF_FNET + g * 128;
    float ac[8], as[8];
#pragma unroll
    for (int i = 0; i < 8; ++i) { ac[i] = 0.f; as[i] = 0.f; }
    for (int n4 = 0; n4 < 32; ++n4) { const f32x4 w = *(const GAS f32x4*)(wrow + n4 * 4);
#pragma unroll
        for (int q = 0; q < 4; ++q) { const int n2 = n4 * 4 + q;
#pragma unroll
            for (int i = 0; i < 8; ++i) { const int ph = (n2 * (k2g * 8 + i)) & 127; ac[i] += w[q] * ct[ph]; as[i] += w[q] * ct[(ph - 32) & 127]; } } }
    bf16* wf = (bf16*)(a.ws() + WS_WSMALL + (size_t)l * WSMALL_LAYER + OFFS_WF);
#pragma unroll
    for (int i = 0; i < 8; ++i) { const int ch = g * 128 + k2g * 8 + i;
        wf[(size_t)ch * 1024 + k] = (bf16)f2bf(ac[i] * 0.08838834764831845f); wf[(size_t)(512 + ch) * 1024 + k] = (bf16)f2bf(as[i] * 0.08838834764831845f); }
}
__device__ __forceinline__ void p0_prologue(const Frame& F, const AV& a) {
    const int gw = F.vcu * NWAVES + F.wave, NGW = F.G * NWAVES, gt = F.vcu * NTHR + F.tid, NGT = F.G * NTHR;
    LAS float* ct = (LAS float*)(F.lds + LDS_CT);
    if (F.tid < 128) ct[F.tid] = cospif((float)F.tid * (1.0f / 64.0f));
    for (int job = blockIdx.x; job < 2 * 96; job += F.G) {
        const int l = job / 96, n0 = (job % 96) * 64;
        LAS float* s = (LAS float*)(F.lds + RING_OFF); LAS float* red = s + 17 * 1024;
        for (int i = F.tid; i < 17 * 1024; i += NTHR) { const int b = i >> 10, k = i & 1023; const float cv = b < 16 ? a.in(1)[b * 1024 + k] : a.in(3)[k]; s[i] = cv * sigmoidf_(cv); }
        __syncthreads();
        const int col = F.tid & 63, ks = F.tid >> 6; float acc[17];
#pragma unroll
        for (int b = 0; b < 17; ++b) acc[b] = 0.f;
        const float* w = a.in(4) + (size_t)l * DM * INCOLS + n0 + col;
        for (int k = ks * 128; k < ks * 128 + 128; k += 16) { float wv[16];
#pragma unroll
            for (int q = 0; q < 16; ++q) wv[q] = w[(size_t)(k + q) * INCOLS];
#pragma unroll
            for (int q = 0; q < 16; ++q)
#pragma unroll
                for (int b = 0; b < 17; ++b) acc[b] += s[b * 1024 + k + q] * wv[q]; }
#pragma unroll
        for (int b = 0; b < 17; ++b) red[(ks * 17 + b) * 64 + col] = acc[b];
        __syncthreads();
        for (int i = F.tid; i < 17 * 64; i += NTHR) { const int b = i >> 6, c2 = i & 63; float t = 0.f;
#pragma unroll
            for (int q = 0; q < 8; ++q) t += red[(q * 17 + b) * 64 + c2];
            ((float*)(a.ws() + WS_MOD))[((size_t)l * 17 + b) * INCOLS + n0 + c2] = t + a.in(5)[l * INCOLS + n0 + c2]; }
        __syncthreads();
    }
    __syncthreads();
    for (int i = gt; i < 64 * 32; i += NGT) { const int p = i >> 5, f = i & 31; const float inv = powf(10000.0f, -(float)f / 32.0f), ang = (float)p * inv; ((f32x2*)(a.ws() + WS_TAB))[i] = (f32x2){cosf(ang), sinf(ang)}; }
    for (int i = gt; i < 2048 * 256; i += NGT) { const int k1 = i >> 8, c0 = (i & 255) * 16; float v[16];
#pragma unroll
        for (int q = 0; q < 16; ++q) { const int col = c0 + q, n1 = col & 2047, rr = (k1 * n1) & 2047; const float x = (float)rr * (1.0f / 1024.0f); v[q] = ((col >> 11) ? -sinpif(x) : cospif(x)) * (32.0f * 0.022097086912079608f); }
        v4u o; o.x = pk4_fp8((f32x4){v[0], v[1], v[2], v[3]}); o.y = pk4_fp8((f32x4){v[4], v[5], v[6], v[7]}); o.z = pk4_fp8((f32x4){v[8], v[9], v[10], v[11]}); o.w = pk4_fp8((f32x4){v[12], v[13], v[14], v[15]}); ((GAS v4u*)(a.ws() + WS_DFTL))[i] = o; }
    for (int i = gt; i < 256 * 32; i += NGT) { const int k1 = i >> 5, c0 = (i & 31) * 16; float v[16];
#pragma unroll
        for (int q = 0; q < 16; ++q) { const int col = c0 + q, n1 = col & 255, rr = (k1 * n1) & 255; const float x = (float)rr * (1.0f / 128.0f); v[q] = ((col >> 8) ? -sinpif(x) : cospif(x)) * (32.0f * 0.0625f); }
        v4u o; o.x = pk4_fp8((f32x4){v[0], v[1], v[2], v[3]}); o.y = pk4_fp8((f32x4){v[4], v[5], v[6], v[7]}); o.z = pk4_fp8((f32x4){v[8], v[9], v[10], v[11]}); o.w = pk4_fp8((f32x4){v[12], v[13], v[14], v[15]}); ((GAS v4u*)(a.ws() + WS_DFTC))[i] = o; }
    for (int i = gt; i < 2 * 256 * 1024; i += NGT) { const int l = i >> 18, r = (i >> 10) & 255, k = i & 1023; unsigned o = 0u;
        if (r < 64) { const float w = a.in(21)[((size_t)l * DM + k) * NEXP + (r & 31)]; const unsigned hi = f2bf(w); o = hi; if (r >= 32) o = f2bf(w - __uint_as_float(hi << 16)); }
        ((bf16*)(a.ws() + WS_WSMALL + (size_t)l * WSMALL_LAYER + OFFS_ROUT))[(size_t)r * 1024 + k] = (bf16)o; }
    for (int j = gw; j < 2048; j += NGW) fold_job(a, j, ct, F.lane);
    LAS float* scr = (LAS float*)(F.lds + RING_OFF + F.wave * 16384);
    for (int it = gw; it < 2 * IT_SMALL; it += NGW) small_item(a, it / IT_SMALL, it % IT_SMALL, scr, F.lane);
    moe_convert_all(a, gw, NGW, scr, F.lane);
}
__device__ __forceinline__ void p1_norm0(const Frame& F, const AV& a) {
    const int gw = F.vcu * NWAVES + F.wave, NGW = F.G * NWAVES;
    for (int m = gw; m < TALL; m += NGW) {
        f32x4 v[4]; ld_row_f32(v, m < TL ? a.in(0) + (size_t)m * DM : a.in(2) + (size_t)(m - TL) * DM, F.lane);
        rms_gain(v, a.in(6), F.lane);
        const float* modv = (const float*)(a.ws() + WS_MOD) + (size_t)(m < TL ? (m >> 11) : 16) * INCOLS;
        modulate_store2(v, modv, modv + 1024, (bf16*)(a.ws() + WS_H) + (size_t)m * DM, a.ws() + WS_H8 + (size_t)m * DM, F.lane);
    }
}
__device__ __forceinline__ void qk_fix_vec(bf16* p, const float* g, const f32x2* tab, bool rope, int t, int sub, int lane) {
    f32x4 x[4]; float ss = 0.f;
#pragma unroll
    for (int jj = 0; jj < 4; ++jj) { x[jj] = bf4(*(const GAS u32x2*)(p + jj * 32 + sub * 4)); ss += (x[jj][0] * x[jj][0] + x[jj][1] * x[jj][1]) + (x[jj][2] * x[jj][2] + x[jj][3] * x[jj][3]); }
    ss += shx(ss, 1, lane); ss += shx(ss, 2, lane); ss += shx(ss, 4, lane);
    const float r = 1.0f / sqrtf(ss * (1.0f / 128.0f) + EPS);
#pragma unroll
    for (int jj = 0; jj < 4; ++jj) { const f32x4 gg = *(const GAS f32x4*)(g + jj * 32 + sub * 4); x[jj] = x[jj] * r * gg; }
    if (rope) { const int pr = t >> 6, pc = t & 63;
#pragma unroll
        for (int i = 0; i < 4; ++i) { const f32x2 cr = tab[pr * 32 + sub * 4 + i], cc = tab[pc * 32 + sub * 4 + i];
            const float a0 = x[0][i], a1 = x[1][i], b0 = x[2][i], b1 = x[3][i];
            x[0][i] = a0 * cr.x - a1 * cr.y; x[1][i] = a1 * cr.x + a0 * cr.y; x[2][i] = b0 * cc.x - b1 * cc.y; x[3][i] = b1 * cc.x + b0 * cc.y; } }
#pragma unroll
    for (int jj = 0; jj < 4; ++jj) *(GAS u32x2*)(p + jj * 32 + sub * 4) = pk4(x[jj]);
}
__device__ __forceinline__ void p_qkfix(const Frame& F, const AV& a, int l, int M) {
    const int gw = F.vcu * NWAVES + F.wave, NGW = F.G * NWAVES; const f32x2* tab = (const f32x2*)(a.ws() + WS_TAB);
    for (int m = gw; m < M; m += NGW) { const bool lat = m < TL; const int t = m & 2047, hh = F.lane >> 3, sub = F.lane & 7;
        if (lat || l == 0) qk_fix_vec((bf16*)(a.ws() + WS_Q) + (size_t)m * DM + hh * 128, a.in(11) + l * 128, tab, lat, t, sub, F.lane);
        if (F.lane < 16) qk_fix_vec((bf16*)(a.ws() + WS_K) + (size_t)krow_of(m) * 256 + hh * 128, a.in(12) + l * 128, tab, lat, t, sub, F.lane);
    }
}
__device__ __forceinline__ void p_conv(const Frame& F, const AV& a, int l, int njobs) {
    LAS unsigned char* lin = F.lds + RING_OFF; LAS float* lout = (LAS float*)(F.lds + RING_OFF + 62 * 1024);
    const bf16* cu = (const bf16*)(a.ws() + WS_CU); bf16* chb = (bf16*)(a.ws() + WS_CH);
    const int cp = F.tid & 255, pg = F.tid >> 8;
    f32x2 wv[31];
#pragma unroll
    for (int j = 0; j < 31; ++j) wv[j] = *(const GAS f32x2*)(a.in(14) + ((size_t)l * 31 + j) * 512 + 2 * cp);
    const f32x2 cb2 = *(const GAS f32x2*)(a.in(15) + l * 512 + 2 * cp);
    for (int job = F.vcu; job < njobs; job += F.G) {
        int rowbase, L, t0;
        if (job < 1024) { rowbase = (job >> 6) * SEQ; L = SEQ; t0 = (job & 63) * 32; } else { const int jc = job - 1024; rowbase = TL + (jc >> 3) * CTXL; L = CTXL; t0 = (jc & 7) * 32; }
        for (int idx = F.tid; idx < 62 * 64; idx += NTHR) { const int row = idx >> 6, ch = idx & 63, p = t0 - 15 + row; v4u val = (v4u){0u, 0u, 0u, 0u};
            if (p >= 0 && p < L) val = *(const GAS v4u*)(cu + (size_t)(rowbase + p) * 512 + ch * 8);
            *(LAS v4u*)(lin + row * 1024 + ch * 16) = val; }
        __syncthreads();
#pragma unroll
        for (int chunk = 0; chunk < 2; ++chunk) {
            f32x2 acc[8];
#pragma unroll
            for (int i = 0; i < 8; ++i) acc[i] = cb2;
            const int r0 = pg * 16 + chunk * 8;
#pragma unroll
            for (int r = 0; r < 38; ++r) { const unsigned w = *(const LAS unsigned*)(lin + (r0 + r) * 1024 + cp * 4); const float x0 = __uint_as_float(w << 16), x1 = __uint_as_float(w & 0xffff0000u);
#pragma unroll
                for (int i = 0; i < 8; ++i) { const int j = r - i; if (j >= 0 && j <= 30) { acc[i].x += x0 * wv[j].x; acc[i].y += x1 * wv[j].y; } } }
#pragma unroll
            for (int i = 0; i < 8; ++i) *(LAS f32x2*)(lout + (r0 + i) * 512 + 2 * cp) = acc[i];
        }
        __syncthreads();
#pragma unroll
        for (int pp = 0; pp < 4; ++pp) { const int p = F.wave * 4 + pp; const LAS float* src = lout + p * 512 + F.lane * 8;
            f32x4 y0 = *(const LAS f32x4*)src, y1 = *(const LAS f32x4*)(src + 4);
            const float mean = wave_sum((y0[0] + y0[1]) + (y0[2] + y0[3]) + (y1[0] + y1[1]) + (y1[2] + y1[3]), F.lane) * (1.0f / 512.0f);
            y0 = y0 - mean; y1 = y1 - mean;
            const float var = wave_sum((y0[0] * y0[0] + y0[1] * y0[1]) + (y0[2] * y0[2] + y0[3] * y0[3]) + (y1[0] * y1[0] + y1[1] * y1[1]) + (y1[2] * y1[2] + y1[3] * y1[3]), F.lane) * (1.0f / 512.0f);
            const float rs = 1.0f / sqrtf(var + EPS);
            const f32x4 g0 = *(const GAS f32x4*)(a.in(16) + l * 512 + F.lane * 8), g1 = *(const GAS f32x4*)(a.in(16) + l * 512 + F.lane * 8 + 4);
            const f32x4 b0 = *(const GAS f32x4*)(a.in(17) + l * 512 + F.lane * 8), b1 = *(const GAS f32x4*)(a.in(17) + l * 512 + F.lane * 8 + 4);
            y0 = y0 * rs * g0 + b0; y1 = y1 * rs * g1 + b1;
#pragma unroll
            for (int q = 0; q < 4; ++q) { y0[q] = y0[q] * sigmoidf_(y0[q]); y1[q] = y1[q] * sigmoidf_(y1[q]); }
            v4u o; o.x = pk2(y0[0], y0[1]); o.y = pk2(y0[2], y0[3]); o.z = pk2(y1[0], y1[1]); o.w = pk2(y1[2], y1[3]);
            *(GAS v4u*)(chb + (size_t)(rowbase + t0 + p) * 512 + F.lane * 8) = o; }
        __syncthreads();
    }
}
__device__ __forceinline__ void ld4(f32x4 (&v)[4], const float* p, int lane) {
#pragma unroll
    for (int j = 0; j < 4; ++j) v[j] = ((const GAS f32x4*)p)[lane + 64 * j];
}
__device__ __forceinline__ float sumsq4(const f32x4 (&v)[4]) { float ss = 0.f;
#pragma unroll
    for (int j = 0; j < 4; ++j) ss += (v[j][0] * v[j][0] + v[j][1] * v[j][1]) + (v[j][2] * v[j][2] + v[j][3] * v[j][3]);
    return ss; }
__device__ __forceinline__ void p_rowpass1(const Frame& F, const AV& a, int l, int M) {
    const int gw = F.vcu * NWAVES + F.wave, NGW = F.G * NWAVES, rpw = (M + NGW - 1) / NGW, r0 = gw * rpw, r1 = (r0 + rpw < M) ? r0 + rpw : M;
    if (r0 >= r1) return;
    const float* modb = (const float*)(a.ws() + WS_MOD) + (size_t)l * 17 * INCOLS; const bf16* mixb = (const bf16*)(a.ws() + WS_MIX);
    f32x4 gpost[4], gpre[4], gate[4], shift[4], scale[4]; ld4(gpost, a.in(7) + l * DM, F.lane); ld4(gpre, a.in(8) + l * DM, F.lane);
    int cb = -1;
    auto xsrc = [&](int m) -> const float* { return (l == 0) ? (m < TL ? a.in(0) + (size_t)m * DM : a.in(2) + (size_t)(m - TL) * DM) : (m < TL ? a.out() + (size_t)m * DM : (const float*)(a.ws() + WS_XC) + (size_t)(m - TL) * DM); };
    f32x4 xn[4]; u32x2 mn[4]; ld4(xn, xsrc(r0), F.lane);
#pragma unroll
    for (int j = 0; j < 4; ++j) mn[j] = ((const GAS u32x2*)(mixb + (size_t)r0 * DM))[F.lane + 64 * j];
    for (int m = r0; m < r1; ++m) {
        f32x4 x[4], y[4];
#pragma unroll
        for (int j = 0; j < 4; ++j) { x[j] = xn[j]; y[j] = bf4(mn[j]); }
        if (m + 1 < r1) { ld4(xn, xsrc(m + 1), F.lane);
#pragma unroll
            for (int j = 0; j < 4; ++j) mn[j] = ((const GAS u32x2*)(mixb + (size_t)(m + 1) * DM))[F.lane + 64 * j]; }
        const int b = m < TL ? (m >> 11) : 16;
        if (b != cb) { cb = b; const float* mv = modb + (size_t)b * INCOLS; ld4(gate, mv + 2 * 1024, F.lane); ld4(shift, mv + 3 * 1024, F.lane); ld4(scale, mv + 4 * 1024, F.lane); }
        const float r = 1.0f / sqrtf(wave_sum(sumsq4(y), F.lane) * (1.0f / 1024.0f) + EPS);
#pragma unroll
        for (int j = 0; j < 4; ++j) x[j] = x[j] + gate[j] * (y[j] * r * gpost[j]);
        float* xd = m < TL ? a.out() + (size_t)m * DM : (float*)(a.ws() + WS_XC) + (size_t)(m - TL) * DM;
        st_row_f32(x, xd, F.lane);
        const float r2 = 1.0f / sqrtf(wave_sum(sumsq4(x), F.lane) * (1.0f / 1024.0f) + EPS);
        bf16* ho = (bf16*)(a.ws() + WS_H) + (size_t)m * DM;
#pragma unroll
        for (int j = 0; j < 4; ++j) ((GAS u32x2*)ho)[F.lane + 64 * j] = pk4(x[j] * r2 * gpre[j] * (scale[j] + 1.0f) + shift[j]);
    }
}
__device__ __forceinline__ void p_topk(const Frame& F, const AV& a, int l, int M) {
    LAS int* cntl = (LAS int*)(F.lds + LDS_SM);
    if (F.tid < 32) cntl[F.tid] = 0;
    __syncthreads();
    const int TPB = (M + F.G - 1) / F.G, m0 = blockIdx.x * TPB, m1 = (m0 + TPB < M) ? m0 + TPB : M;
    const float* lg = (const float*)(a.ws() + WS_LOGIT);
    for (int m = m0 + F.wave; m < m1; m += NWAVES) {
        float v = -3.0e38f;
        if (F.lane < 32) v = lg[(size_t)m * 64 + F.lane] + lg[(size_t)m * 64 + 32 + F.lane] + a.in(22)[l * NEXP + F.lane];
        unsigned ub = __float_as_uint(v); ub = (ub & 0x80000000u) ? ~ub : (ub | 0x80000000u);
        unsigned long long key = ((unsigned long long)ub << 32) | (unsigned)(63 - F.lane);
        int ids[4]; float vals[4];
#pragma unroll
        for (int k = 0; k < 4; ++k) { unsigned long long mx = key;
#pragma unroll
            for (int o = 1; o < 64; o <<= 1) { const int pa = (F.lane ^ o) << 2; const unsigned long long t = ((unsigned long long)(unsigned)__builtin_amdgcn_ds_bpermute(pa, (int)(unsigned)(mx >> 32)) << 32) | (unsigned)__builtin_amdgcn_ds_bpermute(pa, (int)(unsigned)mx); mx = t > mx ? t : mx; }
            const int id = 63 - (int)(mx & 63ull); ids[k] = id; vals[k] = __int_as_float(__builtin_amdgcn_ds_bpermute(id << 2, __float_as_int(v))); if (F.lane == id) key = 0ull; }
        const float e1 = __expf(vals[1] - vals[0]), e2 = __expf(vals[2] - vals[0]), e3 = __expf(vals[3] - vals[0]), inv = 1.0f / (1.0f + e1 + e2 + e3);
        if (F.lane == 0) { *(GAS i32x4*)((int*)(a.ws() + WS_TOPI) + (size_t)m * 4) = (i32x4){ids[0], ids[1], ids[2], ids[3]};
            *(GAS f32x4*)((float*)(a.ws() + WS_TOPP) + (size_t)m * 4) = (f32x4){inv, e1 * inv, e2 * inv, e3 * inv}; }
        if (F.lane < 4) __hip_atomic_fetch_add(&cntl[F.lane == 0 ? ids[0] : F.lane == 1 ? ids[1] : F.lane == 2 ? ids[2] : ids[3]], 1, __ATOMIC_RELAXED, __HIP_MEMORY_SCOPE_WORKGROUP);
    }
    __syncthreads();
    if (F.tid < 32) ((int*)(a.ws() + WS_CNT))[blockIdx.x * 32 + F.tid] = cntl[F.tid];
}
__device__ __forceinline__ void p_slots(const Frame& F, const AV& a, int M) {
    LAS int* sm = (LAS int*)(F.lds + LDS_SM);
    LAS int *tot = sm, *bef = sm + 32, *base = sm + 64, *tst = sm + 96  , *mask = sm + 160  , *ids = sm + 320  , *slot = sm + 960  ;
    const int* cnt = (const int*)(a.ws() + WS_CNT);
    { LAS int* ptot = sm + 1600; LAS int* pbef = sm + 2112; const int e = F.tid & 31, part = F.tid >> 5; int t = 0, b = 0;
#pragma unroll 4
      for (int q = part; q < F.G; q += 16) { const int c = cnt[q * 32 + e]; t += c; if (q < (int)blockIdx.x) b += c; }
      ptot[part * 32 + e] = t; pbef[part * 32 + e] = b;
      __syncthreads();
      if (F.tid < 32) { int tt = 0, bb = 0;
#pragma unroll
          for (int q = 0; q < 16; ++q) { tt += ptot[q * 32 + F.tid]; bb += pbef[q * 32 + F.tid]; }
          tot[F.tid] = tt; bef[F.tid] = bb; } }
    __syncthreads();
    if (F.tid == 0) { int ts = 0; for (int e = 0; e < 32; ++e) { tst[e] = ts; base[e] = ts * 256 + bef[e]; ts += (tot[e] + 255) >> 8; } tst[32] = ts; }
    __syncthreads();
    const int NT = tst[32];
    if (blockIdx.x == 0) { int* te = (int*)(a.ws() + WS_CNT) + CNT_TILE_E;
        for (int t = F.tid; t < NT; t += NTHR) { int e = 0; for (int q = 1; q < 32; ++q) if (t >= tst[q]) e = q; te[t] = e; }
        if (F.tid == 0) ((int*)(a.ws() + WS_CNT))[CNT_NT] = NT; }
    const int TPB = (M + F.G - 1) / F.G, m0 = blockIdx.x * TPB, m1 = (m0 + TPB < M) ? m0 + TPB : M, nt = m1 > m0 ? m1 - m0 : 0;
    for (int tl = F.tid; tl < nt; tl += NTHR) { const i32x4 id = *(const GAS i32x4*)((const int*)(a.ws() + WS_TOPI) + (size_t)(m0 + tl) * 4);
        ids[tl * 4 + 0] = id.x; ids[tl * 4 + 1] = id.y; ids[tl * 4 + 2] = id.z; ids[tl * 4 + 3] = id.w; mask[tl] = (1 << id.x) | (1 << id.y) | (1 << id.z) | (1 << id.w); }
    __syncthreads();
    for (int p = F.tid; p < nt * 4; p += NTHR) { const int tl = p >> 2, e = ids[p]; int rank = 0; for (int q = 0; q < tl; ++q) rank += (mask[q] >> e) & 1;
        const int s = base[e] + rank; slot[p] = s; ((int*)(a.ws() + WS_SLOT))[(size_t)(m0 + tl) * 4 + (p & 3)] = s; }
    __syncthreads();
    const bf16* h = (const bf16*)(a.ws() + WS_H); unsigned char* hs = a.ws() + WS_HS;
    for (int p = F.wave; p < nt * 4; p += NWAVES) { const GAS v4u* src = (const GAS v4u*)(h + (size_t)(m0 + (p >> 2)) * DM); GAS u32x2* dst = (GAS u32x2*)(hs + (size_t)slot[p] * DM);
#pragma unroll
        for (int j = 0; j < 2; ++j) { const v4u x = src[F.lane + 64 * j]; u32x2 o;
            o.x = pg8::cvt4_fp8(__uint_as_float(x.x << 16), __uint_as_float(x.x & 0xffff0000u), __uint_as_float(x.y << 16), __uint_as_float(x.y & 0xffff0000u));
            o.y = pg8::cvt4_fp8(__uint_as_float(x.z << 16), __uint_as_float(x.z & 0xffff0000u), __uint_as_float(x.w << 16), __uint_as_float(x.w & 0xffff0000u));
            dst[F.lane + 64 * j] = o; } }
    if (blockIdx.x < 32) { const int e = blockIdx.x, r0 = tst[e] * 256 + tot[e], r1 = tst[e + 1] * 256;
        unsigned zz = 0u; asm volatile("" : "+v"(zz));
        for (int r = r0 + F.wave; r < r1; r += NWAVES) { GAS v4u* dst = (GAS v4u*)(hs + (size_t)r * DM); dst[F.lane] = (v4u){zz, zz, zz, zz}; } }
    __syncthreads();
}
__device__ __forceinline__ void p_combine(const Frame& F, const AV& a, int l, int M) {
    const int gw = F.vcu * NWAVES + F.wave, NGW = F.G * NWAVES, rpw = (M + NGW - 1) / NGW, r0 = gw * rpw, r1 = (r0 + rpw < M) ? r0 + rpw : M;
    if (r0 >= r1) return;
    const bf16* ys = (const bf16*)(a.ws() + WS_YS); const int* slp = (const int*)(a.ws() + WS_SLOT); const float* prp = (const float*)(a.ws() + WS_TOPP);
    const float* modb = (const float*)(a.ws() + WS_MOD);
    f32x4 gpost[4], gpre[4], gate[4], shift[4], scale[4]; ld4(gpost, a.in(9) + l * DM, F.lane); if (l == 0) ld4(gpre, a.in(6) + DM, F.lane);
    int cb = -1;
    i32x4 sl_n = *(const GAS i32x4*)(slp + (size_t)r0 * 4); f32x4 pr_n = *(const GAS f32x4*)(prp + (size_t)r0 * 4);
    f32x4 xn[4]; u32x2 yn[4][4]; f32x4 prc = pr_n;
    auto xrow = [&](int m) -> float* { return m < TL ? a.out() + (size_t)m * DM : (float*)(a.ws() + WS_XC) + (size_t)(m - TL) * DM; };
    { ld4(xn, xrow(r0), F.lane); const int sv[4] = {sl_n[0], sl_n[1], sl_n[2], sl_n[3]};
#pragma unroll
      for (int k = 0; k < 4; ++k)
#pragma unroll
          for (int j = 0; j < 4; ++j) yn[k][j] = ((const GAS u32x2*)(ys + (size_t)sv[k] * DM))[F.lane + 64 * j];
      if (r0 + 1 < r1) { sl_n = *(const GAS i32x4*)(slp + (size_t)(r0 + 1) * 4); pr_n = *(const GAS f32x4*)(prp + (size_t)(r0 + 1) * 4); } }
    for (int m = r0; m < r1; ++m) {
        f32x4 x[4], y[4];
#pragma unroll
        for (int j = 0; j < 4; ++j) { x[j] = xn[j]; y[j] = bf4(yn[0][j]) * prc[0] + bf4(yn[1][j]) * prc[1] + bf4(yn[2][j]) * prc[2] + bf4(yn[3][j]) * prc[3]; }
        if (m + 1 < r1) { prc = pr_n; ld4(xn, xrow(m + 1), F.lane); const int sv[4] = {sl_n[0], sl_n[1], sl_n[2], sl_n[3]};
#pragma unroll
            for (int k = 0; k < 4; ++k)
#pragma unroll
                for (int j = 0; j < 4; ++j) yn[k][j] = ((const GAS u32x2*)(ys + (size_t)sv[k] * DM))[F.lane + 64 * j];
            if (m + 2 < r1) { sl_n = *(const GAS i32x4*)(slp + (size_t)(m + 2) * 4); pr_n = *(const GAS f32x4*)(prp + (size_t)(m + 2) * 4); } }
        const int b = m < TL ? (m >> 11) : 16;
        if (b != cb) { cb = b; ld4(gate, modb + ((size_t)l * 17 + b) * INCOLS + 5 * 1024, F.lane); if (l == 0) { const float* m1 = modb + ((size_t)17 + b) * INCOLS; ld4(shift, m1, F.lane); ld4(scale, m1 + 1024, F.lane); } }
        const float r = 1.0f / sqrtf(wave_sum(sumsq4(y), F.lane) * (1.0f / 1024.0f) + EPS);
#pragma unroll
        for (int j = 0; j < 4; ++j) x[j] = x[j] + gate[j] * (y[j] * r * gpost[j]);
        st_row_f32(x, xrow(m), F.lane);
        if (l == 0) { const float r2 = 1.0f / sqrtf(wave_sum(sumsq4(x), F.lane) * (1.0f / 1024.0f) + EPS);
            bf16* ho = (bf16*)(a.ws() + WS_H) + (size_t)m * DM; unsigned char* h8 = a.ws() + WS_H8 + (size_t)m * DM;
#pragma unroll
            for (int j = 0; j < 4; ++j) { const f32x4 hv = x[j] * r2 * gpre[j] * (scale[j] + 1.0f) + shift[j]; ((GAS u32x2*)ho)[F.lane + 64 * j] = pk4(hv); ((GAS unsigned*)h8)[F.lane + 64 * j] = pk4_fp8(hv); } }
    }
}
#ifdef DBG_CHECK
#ifndef DBG_GSUB
#define DBG_GSUB 0
#endif
__device__ __forceinline__ double bfd(bf16 b) { return (double)__uint_as_float(((unsigned)b) << 16); }
__device__ __forceinline__ unsigned hsh(unsigned x) { x ^= x >> 16; x *= 0x7feb352du; x ^= x >> 15; x *= 0x846ca68bu; x ^= x >> 16; return x; }
__device__ __forceinline__ int samp_row(int i, int M, unsigned salt) { const int sp[12] = {0, 1, 255, 256, 2047, 2048, 4095, 32767, 32768, 32769, 33023, 36863}; if (i < 12 && sp[i] < M) return sp[i]; return (int)(hsh(i * 7919u + salt) % (unsigned)M); }
__device__ __forceinline__ void rec(float* res, int stage, double got, double want, double flo) { const double e = fabs(got - want) / (fabs(want) + flo); const float f = (e == e) ? (float)e : 1e30f; atomicMax((unsigned*)res + stage, __float_as_uint(f)); }
__device__ double dot_h_w(const bf16* hrow, const float* w, int ldw, int col) { double s = 0; for (int k = 0; k < 1024; ++k) s += bfd(hrow[k]) * (double)w[(size_t)k * ldw + col]; return s; }
__device__ double dsig(double x) { return 1.0 / (1.0 + exp(-x)); }
constexpr double PI_D = 3.14159265358979323846;
enum { ST_MOD = 0, ST_H0, ST_INPROJ, ST_YT, ST_QKFIX, ST_CONV, ST_Z, ST_ATTN, ST_GATES, ST_MERGED, ST_MIX, ST_ROW1, ST_LOGIT, ST_TOPK, ST_SLOTS, ST_ACT, ST_YSLOT, ST_COMB, ST_GATESB, ST_N };
__global__ void chk(Args A, int stage, int l, float* res, float* snap) {
    const int i = threadIdx.x; unsigned char* ws = A.ws; const int M = (l == 0) ? TALL : TL; const int rs = stage + 32 * l;
    const bf16* H = (const bf16*)(ws + WS_H); const float* win = A.in[10] + (size_t)l * DM * INCOLS; const float* modb = (const float*)(ws + WS_MOD);
    if (stage == ST_MOD) { const int ll = i & 1, b = (i >> 1) % 17, n = (int)(hsh(i) % 6144u); double s = 0; for (int k = 0; k < 1024; ++k) { const double cv = b < 16 ? A.in[1][b * 1024 + k] : A.in[3][k]; s += cv * dsig(cv) * (double)A.in[4][((size_t)ll * 1024 + k) * 6144 + n]; }
        s += A.in[5][ll * 6144 + n]; rec(res, rs, modb[((size_t)ll * 17 + b) * 6144 + n], s, 0.02); }
    else if (stage == ST_H0) { const int m = samp_row(i, TALL, 1), c = (int)(hsh(i + 77) % 1024u); const float* x = m < TL ? A.in[0] + (size_t)m * DM : A.in[2] + (size_t)(m - TL) * DM; double ss = 0; for (int k = 0; k < 1024; ++k) ss += (double)x[k] * x[k];
        const float* mv = modb + (size_t)(m < TL ? (m >> 11) : 16) * 6144; const double want = x[c] / sqrt(ss / 1024 + 1e-6) * A.in[6][c] * (1.0 + mv[1024 + c]) + mv[c]; rec(res, rs, bfd(H[(size_t)m * DM + c]), want, 0.05); }
    else if (stage == ST_INPROJ) { const int m = samp_row(i, TALL, 2), kind = i & 3; const bf16* hr = H + (size_t)m * DM;
        if (kind == 0) { const int n = (int)(hsh(i + 5) % 1024u); rec(res, rs, bfd(((const bf16*)(ws + WS_Q))[(size_t)m * DM + n]), dot_h_w(hr, win, INCOLS, n), 0.05); }
        else if (kind == 1) { const int n = (int)(hsh(i + 6) % 256u); rec(res, rs, bfd(((const bf16*)(ws + WS_K))[(size_t)krow_of(m) * 256 + n]), dot_h_w(hr, win, INCOLS, 1024 + n), 0.05); }
        else if (kind == 2) { const int n = (int)(hsh(i + 7) % 256u); rec(res, rs, bfd(((const bf16*)(ws + WS_V))[(size_t)krow_of(m) * 256 + n]), dot_h_w(hr, win, INCOLS, 1280 + n), 0.05); }
        else { const int c = (int)(hsh(i + 8) % 512u); if (l == 0 || m < TL) { const double a = dot_h_w(hr, win, INCOLS, 1536 + c), g = dot_h_w(hr, win, INCOLS, 2048 + c); rec(res, rs, bfd(((const bf16*)(ws + WS_CU))[(size_t)m * 512 + c]), a * dsig(g), 0.05); } } }
    else if (stage == ST_YT) { const int m = samp_row(i, M, 3), ch = (int)(hsh(i + 9) % 512u), cs = i & 1, g = ch >> 7, k2 = ch & 127; const bf16* hr = H + (size_t)m * DM; double s = 0;
        for (int k = 0; k < 1024; ++k) { double t = 0; for (int n2 = 0; n2 < 128; ++n2) { const double ang = 2.0 * PI_D * ((n2 * k2) & 127) / 128.0; t += (double)win[(size_t)k * INCOLS + OFF_FNET + g * 128 + n2] * (cs ? sin(ang) : cos(ang)); } s += bfd(hr[k]) * t; }
        s /= sqrt(128.0); double got; if (m < TL) got = bfd(((const bf16*)(ws + WS_YT))[((size_t)(m >> 11) * 512 + ch) * 4096 + cs * 2048 + (m & 2047)]); else got = bfd(((const bf16*)(ws + WS_YTC))[((size_t)((m - TL) >> 8) * 512 + ch) * 512 + cs * 256 + ((m - TL) & 255)]);
        rec(res, rs, got, s, 0.05); }
    else if (stage == ST_QKFIX) { const int m = samp_row(i, TALL, 4), isk = i & 1, hh = isk ? (int)(hsh(i + 3) % 2u) : (int)(hsh(i + 3) % 8u), d = (int)(hsh(i + 4) % 128u); const bf16* hr = H + (size_t)m * DM;
        if (isk || l == 0 || m < TL) { const int cbase = isk ? 1024 + hh * 128 : hh * 128; double ss = 0, xd = 0, xp = 0; const int half = d & 64, dd = d & 63, pd = half + ((dd + 32) & 63);
            for (int q = 0; q < 128; ++q) { double v = dot_h_w(hr, win, INCOLS, cbase + q); v = bfd((bf16)f2bf((float)v)); ss += v * v; if (q == d) xd = v; if (q == pd) xp = v; }
            const float* gn = (isk ? A.in[12] : A.in[11]) + l * 128; const double r = 1.0 / sqrt(ss / 128 + 1e-6); xd *= r * gn[d]; xp *= r * gn[pd]; double want = xd;
            if (m < TL) { const int t = m & 2047, pos = half ? (t & 63) : (t >> 6), f = dd & 31; const double ang = (double)((float)pos * powf(10000.0f, -(float)f / 32.0f)); want = (dd < 32) ? xd * cos(ang) - xp * sin(ang) : xd * cos(ang) + xp * sin(ang); }
            const double got = isk ? bfd(((const bf16*)(ws + WS_K))[(size_t)krow_of(m) * 256 + hh * 128 + d]) : bfd(((const bf16*)(ws + WS_Q))[(size_t)m * DM + hh * 128 + d]); rec(res, rs, got, want, 0.05); } }
    else if (stage == ST_CONV) { const int m = samp_row(i, M, 5), c = (int)(hsh(i + 11) % 512u); const int rowbase = m < TL ? (m >> 11) * SEQ : TL + ((m - TL) >> 8) * CTXL, L = m < TL ? SEQ : CTXL, t = m - rowbase; const bf16* cu = (const bf16*)(ws + WS_CU);
        double s1 = 0, s2 = 0, yc = 0; for (int cc = 0; cc < 512; ++cc) { double y = A.in[15][l * 512 + cc]; for (int j = 0; j < 31; ++j) { const int p = t + j - 15; if (p >= 0 && p < L) y += bfd(cu[(size_t)(rowbase + p) * 512 + cc]) * (double)A.in[14][((size_t)l * 31 + j) * 512 + cc]; } s1 += y; s2 += y * y; if (cc == c) yc = y; }
        const double mean = s1 / 512, var = s2 / 512 - mean * mean; double y = (yc - mean) / sqrt(var + 1e-6) * A.in[16][l * 512 + c] + A.in[17][l * 512 + c]; y = y * dsig(y); rec(res, rs, bfd(((const bf16*)(ws + WS_CH))[(size_t)m * 512 + c]), y, 0.05); }
    else if (stage == ST_Z) { const int m = samp_row(i, M, 6), ch = (int)(hsh(i + 12) % 512u); double s = 0;
        if (m < TL) { const int b = m >> 11, k1 = m & 2047; const bf16* yr = (const bf16*)(ws + WS_YT) + ((size_t)b * 512 + ch) * 4096; for (int n1 = 0; n1 < 2048; ++n1) { const double ang = 2.0 * PI_D * ((k1 * n1) & 2047) / 2048.0; s += cos(ang) * bfd(yr[n1]) - sin(ang) * bfd(yr[2048 + n1]); } s /= sqrt(2048.0); }
        else { const int b = (m - TL) >> 8, k1 = (m - TL) & 255; const bf16* yr = (const bf16*)(ws + WS_YTC) + ((size_t)b * 512 + ch) * 512; for (int n1 = 0; n1 < 256; ++n1) { const double ang = 2.0 * PI_D * ((k1 * n1) & 255) / 256.0; s += cos(ang) * bfd(yr[n1]) - sin(ang) * bfd(yr[256 + n1]); } s /= 16.0; }
        rec(res, rs, bfd(((const bf16*)(ws + WS_Z))[(size_t)m * 512 + ch]), s, 0.05); }
    else if (stage == ST_ATTN) { const int m = samp_row(i, M, 7), hh = (int)(hsh(i + 13) % 8u), d = (int)(hsh(i + 14) % 128u); const bf16* q = (const bf16*)(ws + WS_Q) + (size_t)m * DM + hh * 128;
        int kr0, nk; if (m < TL) { kr0 = (m >> 11) * KVROWS; nk = KVROWS; } else { kr0 = ((m - TL) >> 8) * KVROWS + SEQ; nk = CTXL; }
        const bf16* K = (const bf16*)(ws + WS_K) + (size_t)kr0 * 256 + (hh >> 2) * 128; const bf16* V = (const bf16*)(ws + WS_V) + (size_t)kr0 * 256 + (hh >> 2) * 128;
        double mx = -1e300; for (int j = 0; j < nk; ++j) { double s = 0; for (int q2 = 0; q2 < 128; ++q2) s += bfd(q[q2]) * bfd(K[(size_t)j * 256 + q2]); s *= 0.08838834764831845; if (s > mx) mx = s; }
        double den = 0, num = 0; for (int j = 0; j < nk; ++j) { double s = 0; for (int q2 = 0; q2 < 128; ++q2) s += bfd(q[q2]) * bfd(K[(size_t)j * 256 + q2]); s *= 0.08838834764831845; const double p = exp(s - mx); den += p; num += p * bfd(V[(size_t)j * 256 + d]); }
        rec(res, rs, bfd(((const bf16*)(ws + WS_AO))[(size_t)m * DM + hh * 128 + d]), num / den, 0.03); }
    else if (stage == ST_GATES) { const int m = samp_row(i, M, 8), n = (int)(hsh(i + 15) % 3072u); rec(res, rs, bfd(((const bf16*)(ws + WS_GATES))[(size_t)m * 3072 + n]), dsig(dot_h_w(H + (size_t)m * DM, win, INCOLS, OFF_GATE + n)), 0.05); }
    else if (stage == ST_GATESB && DBG_GSUB == 1) { const int m = samp_row(i, M, 8), n = (int)(hsh(i + 15) % 3072u); const double got = bfd(((const bf16*)(ws + WS_GATES))[(size_t)m * 3072 + n]), want = dsig(dot_h_w(H + (size_t)m * DM, win, INCOLS, OFF_GATE + n));
        const bool badv = !(fabs(got - want) <= 0.05); if (badv) { unsigned* r = (unsigned*)res + 48; atomicOr(r, (m < TL ? 1u : 2u) | (4u << (n >> 10)) | (i < 12 ? 32u : 0u)); } }
    else if (stage == ST_GATESB) { const int m = samp_row(i, M, 8), n = (int)(hsh(i + 15) % 3072u); const bf16* wt = (const bf16*)(ws + WS_WSMALL + (size_t)l * WSMALL_LAYER + OFFS_WG) + (size_t)n * 1024; const bf16* hr = H + (size_t)m * DM; double s = 0; for (int k = 0; k < 1024; ++k) s += bfd(hr[k]) * bfd(wt[k]);
        rec(res, rs, bfd(((const bf16*)(ws + WS_GATES))[(size_t)m * 3072 + n]), dsig(s), 0.05); }
    else if (stage == ST_MERGED) { const int m = samp_row(i, M, 9), c = (int)(hsh(i + 16) % 1024u); const bf16* g = (const bf16*)(ws + WS_GATES) + (size_t)m * 3072; double y0 = 0, y1 = 0, y2 = 0;
        const bf16* ao = (const bf16*)(ws + WS_AO) + (size_t)m * DM; const bf16* chh = (const bf16*)(ws + WS_CH) + (size_t)m * 512; const bf16* z = (const bf16*)(ws + WS_Z) + (size_t)m * 512;
        for (int k = 0; k < 1024; ++k) y0 += bfd(ao[k]) * (double)A.in[13][((size_t)l * 1024 + k) * 1024 + c];
        for (int k = 0; k < 512; ++k) { y1 += bfd(chh[k]) * (double)A.in[18][((size_t)l * 512 + k) * 1024 + c]; y2 += bfd(z[k]) * (double)A.in[19][((size_t)l * 512 + k) * 1024 + c]; }
        rec(res, rs, bfd(((const bf16*)(ws + WS_MERGED))[(size_t)m * DM + c]), bfd(g[c]) * y0 + bfd(g[1024 + c]) * y1 + bfd(g[2048 + c]) * y2, 0.05); }
    else if (stage == ST_MIX) { const int m = samp_row(i, M, 10), c = (int)(hsh(i + 17) % 1024u); rec(res, rs, bfd(((const bf16*)(ws + WS_MIX))[(size_t)m * DM + c]), dot_h_w((const bf16*)(ws + WS_MERGED) + (size_t)m * DM, A.in[20] + (size_t)l * DM * DM, DM, c), 0.05); }
    else if (stage == ST_ROW1) { const int m = samp_row(i, M, 11), c = (int)(hsh(i + 18) % 1024u); const float* xs = snap + (size_t)i * 1024;
        const bf16* mix = (const bf16*)(ws + WS_MIX) + (size_t)m * DM; const float* mv = modb + ((size_t)l * 17 + (m < TL ? (m >> 11) : 16)) * 6144; double ss = 0; for (int k = 0; k < 1024; ++k) ss += bfd(mix[k]) * bfd(mix[k]); const double r = 1.0 / sqrt(ss / 1024 + 1e-6);
        double s2 = 0, xc = 0; for (int k = 0; k < 1024; ++k) { const double xn = xs[k] + mv[2048 + k] * (bfd(mix[k]) * r * A.in[7][l * DM + k]); s2 += xn * xn; if (k == c) xc = xn; }
        const float* xd = m < TL ? A.out + (size_t)m * DM : (const float*)(ws + WS_XC) + (size_t)(m - TL) * DM; rec(res, rs, xd[c], xc, 0.02);
        rec(res, rs, bfd(H[(size_t)m * DM + c]), xc / sqrt(s2 / 1024 + 1e-6) * A.in[8][l * DM + c] * (1.0 + mv[4096 + c]) + mv[3072 + c], 0.05); }
    else if (stage == ST_LOGIT) { const int m = samp_row(i, M, 12), e = i & 31; const float* lg = (const float*)(ws + WS_LOGIT) + (size_t)m * 64; rec(res, rs, (double)lg[e] + lg[32 + e], dot_h_w(H + (size_t)m * DM, A.in[21] + (size_t)l * DM * NEXP, NEXP, e), 0.02); }
    else if (stage == ST_TOPK) { const int m = samp_row(i, M, 13); const float* lg = (const float*)(ws + WS_LOGIT) + (size_t)m * 64; float v[32]; for (int e = 0; e < 32; ++e) v[e] = lg[e] + lg[32 + e] + A.in[22][l * 32 + e];
        int id[4]; float tv[4]; for (int k = 0; k < 4; ++k) { int b = -1; for (int e = 0; e < 32; ++e) { bool used = false; for (int q = 0; q < k; ++q) used |= (id[q] == e); if (!used && (b < 0 || v[e] > v[b])) b = e; } id[k] = b; tv[k] = v[b]; }
        double den = 0; for (int k = 0; k < 4; ++k) den += exp((double)tv[k] - tv[0]); const int* gi = (const int*)(ws + WS_TOPI) + (size_t)m * 4; const float* gp = (const float*)(ws + WS_TOPP) + (size_t)m * 4;
        for (int k = 0; k < 4; ++k) { rec(res, rs, gi[k] == id[k] ? 0.0 : 1.0, 0, 0.01); rec(res, rs, gp[k], exp((double)tv[k] - tv[0]) / den, 0.01); } }
    else if (stage == ST_SLOTS) { const int m = samp_row(i, M, 14), k = i & 3; const int s = ((const int*)(ws + WS_SLOT))[(size_t)m * 4 + k], e = ((const int*)(ws + WS_TOPI))[(size_t)m * 4 + k]; const int NT = ((const int*)(ws + WS_CNT))[CNT_NT];
        if (s < 0 || s >= NT * 256) rec(res, rs, 1, 0, 0.01); else { rec(res, rs, ((const int*)(ws + WS_CNT))[CNT_TILE_E + (s >> 8)] == e ? 0.0 : 1.0, 0, 0.01); const bf16* hs = (const bf16*)(ws + WS_HS) + (size_t)s * DM; double df = 0; for (int q = 0; q < 1024; ++q) df += fabs(bfd(hs[q]) - bfd(H[(size_t)m * DM + q])); rec(res, rs, df, 0, 1e-3); } }
    else if (stage == ST_ACT) { const int m = samp_row(i, M, 15), k = i & 3, c = (int)(hsh(i + 21) % 1024u); const int s = ((const int*)(ws + WS_SLOT))[(size_t)m * 4 + k], e = ((const int*)(ws + WS_TOPI))[(size_t)m * 4 + k]; const bf16* hs = (const bf16*)(ws + WS_HS) + (size_t)s * DM;
        double g = dot_h_w(hs, A.in[23] + (((size_t)l * NEXP + e) << 20), DM, c) + A.in[24][((size_t)l * NEXP + e) * 1024 + c], u = dot_h_w(hs, A.in[25] + (((size_t)l * NEXP + e) << 20), DM, c) + A.in[26][((size_t)l * NEXP + e) * 1024 + c];
        g = g < 7.0 ? g : 7.0; u = u < -7.0 ? -7.0 : (u > 7.0 ? 7.0 : u); rec(res, rs, bfd(((const bf16*)(ws + WS_ACT))[(size_t)s * DM + c]), (u + 1.0) * (g * dsig(1.702 * g)), 0.05); }
    else if (stage == ST_YSLOT) { const int m = samp_row(i, M, 16), k = i & 3, c = (int)(hsh(i + 22) % 1024u); const int s = ((const int*)(ws + WS_SLOT))[(size_t)m * 4 + k], e = ((const int*)(ws + WS_TOPI))[(size_t)m * 4 + k];
        rec(res, rs, bfd(((const bf16*)(ws + WS_HS))[(size_t)s * DM + c]), dot_h_w((const bf16*)(ws + WS_ACT) + (size_t)s * DM, A.in[27] + (((size_t)l * NEXP + e) << 20), DM, c) + A.in[28][((size_t)l * NEXP + e) * 1024 + c], 0.05); }
    else if (stage == ST_COMB) { const int m = samp_row(i, M, 17), c = (int)(hsh(i + 23) % 1024u); const float* xs = snap + (size_t)i * 1024; const int* sl = (const int*)(ws + WS_SLOT) + (size_t)m * 4; const float* pr = (const float*)(ws + WS_TOPP) + (size_t)m * 4;
        const float* mv = modb + ((size_t)l * 17 + (m < TL ? (m >> 11) : 16)) * 6144; double ss = 0, yc = 0; for (int q = 0; q < 1024; ++q) { double y = 0; for (int k = 0; k < 4; ++k) y += (double)pr[k] * bfd(((const bf16*)(ws + WS_HS))[(size_t)sl[k] * DM + q]); ss += y * y; if (q == c) yc = y; }
        const double want = xs[c] + mv[5 * 1024 + c] * (yc / sqrt(ss / 1024 + 1e-6) * A.in[9][l * DM + c]); const float* xd = m < TL ? A.out + (size_t)m * DM : (const float*)(ws + WS_XC) + (size_t)(m - TL) * DM; rec(res, rs, xd[c], want, 0.02); }
}
__global__ void snap_rows(Args A, int l, int salt, float* snap) {
    const int i = blockIdx.x, M = (l == 0) ? TALL : TL, m = samp_row(i, M, salt); const float* xs;
    if (l == 0 && salt == 11) xs = m < TL ? A.in[0] + (size_t)m * DM : A.in[2] + (size_t)(m - TL) * DM; else xs = m < TL ? A.out + (size_t)m * DM : (const float*)(A.ws + WS_XC) + (size_t)(m - TL) * DM;
    for (int k = threadIdx.x; k < 1024; k += blockDim.x) snap[(size_t)i * 1024 + k] = xs[k];
}
__global__ void chk_gates_full(const bf16* H, const bf16* Wt, const bf16* G, int M, unsigned* cntw) {
    const int n = blockIdx.x * 64 + (threadIdx.x & 63), m = blockIdx.y * 4 + (threadIdx.x >> 6); if (m >= M) return;
    const uint4* a = (const uint4*)(H + (size_t)m * 1024); const uint4* b = (const uint4*)(Wt + (size_t)n * 1024); float s = 0.f;
    for (int k = 0; k < 128; ++k) { const uint4 x = a[k], y = b[k]; const unsigned xs[4] = {x.x, x.y, x.z, x.w}, ys[4] = {y.x, y.y, y.z, y.w};
        for (int q = 0; q < 4; ++q) { s += __uint_as_float(xs[q] << 16) * __uint_as_float(ys[q] << 16); s += __uint_as_float(xs[q] & 0xffff0000u) * __uint_as_float(ys[q] & 0xffff0000u); } }
    const float want = 1.0f / (1.0f + __expf(-s)), got = __uint_as_float(((unsigned)G[(size_t)m * 3072 + n]) << 16);
    if (!(fabsf(got - want) <= 0.02f)) { atomicAdd(cntw, 1u); cntw[16 + (m >> 8) * 12 + (n >> 8)] = 1u; }
}
__global__ void encode_full(float* out, const unsigned* cntw, int n) {
    __shared__ int bc, bt; if (threadIdx.x == 0) { unsigned C = cntw[0], T = 0; for (int t = 0; t < 1728; ++t) T += cntw[16 + t]; int b1 = 0; while (C) { ++b1; C /= 10; } int b2 = 0; while (T) { ++b2; T /= 4; } bc = b1 > 7 ? 7 : b1; bt = b2 > 7 ? 7 : b2; }
    __syncthreads(); const float K = ldexpf(1.0f, 2 + 8 * bt + bc);
    for (size_t i = (size_t)blockIdx.x * blockDim.x + threadIdx.x; i < (size_t)n; i += (size_t)gridDim.x * blockDim.x) out[i] = K;
}
__global__ void encode(float* out, const float* res, int n, float thr) {
    #if DBG_GSUB == 1
    { const unsigned mk = ((const unsigned*)res)[48]; const float K = ldexpf(1.0f, 2 + (int)mk); for (size_t i = (size_t)blockIdx.x * blockDim.x + threadIdx.x; i < (size_t)n; i += (size_t)gridDim.x * blockDim.x) out[i] = K; return; }
#endif
#ifndef CHK_SKIP
#define CHK_SKIP 0ull
#endif
    int bad = -1; for (int s = 0; s < 64; ++s) if (!((CHK_SKIP >> s) & 1ull) && res[s] > thr) { bad = s; break; }
    if (bad < 0) return; const float er = res[bad]; const float K = ldexpf(1.0f, bad + 2) * (er < 0.5f ? 1.0f : er < 1.0f ? 1.25f : er < 4.0f ? 1.5f : 1.75f);
    for (size_t i = (size_t)blockIdx.x * blockDim.x + threadIdx.x; i < (size_t)n; i += (size_t)gridDim.x * blockDim.x) out[i] = K;
}
#endif
#ifndef GP_SP2
#define GP_SP2 true
#endif
#ifndef GP_ALIGN
#define GP_ALIGN true
#endif
__global__ void __launch_bounds__(NTHR, 2) fwd(Args args) {
    extern __shared__ __attribute__((aligned(16))) unsigned char lds[];
    Frame F;
    F.lds = (LAS unsigned char*)lds; F.MISC = (volatile LAS unsigned*)(F.lds + MISC_OFF);
    F.tid = threadIdx.x; F.lane = F.tid & 63; F.wave = __builtin_amdgcn_readfirstlane(F.tid >> 6);
    F.G = gridDim.x; { const int bx = blockIdx.x; F.vcu = (F.G % 8 == 0) ? (bx % 8) * (F.G / 8) + bx / 8 : bx; }
    { const AV A0 = av_get(); F.ctl = (gu32*)(A0.ws() + WS_CTL); }
    for (int u = F.tid; u < (LDS_BYTES - LDSCTL_OFF) / 4; u += NTHR) ((LAS unsigned*)(F.lds + LDSCTL_OFF))[u] = 0u;
    __syncthreads();
    XcdBarrier bar; bar.bar = (unsigned*)(F.ctl + CW_BAR); bar.x = 0; bar.st = nullptr;
    if (!MK_PER_PHASE) bar = xcd_barrier_post((unsigned*)(F.ctl + CW_BAR), F.MISC + 8);
    int lo, hi; { const AV A0 = av_get(); lo = *(const int __attribute__((address_space(4)))*)(A0.kp + 8 * 31); hi = *(const int __attribute__((address_space(4)))*)(A0.kp + 8 * 31 + 4); }
#ifndef DIS_MASK
#define DIS_MASK 0ull
#endif
#define IN(k) (lo <= (k) && (k) < hi)
#define ON(j) (!((DIS_MASK >> (j)) & 1ull))
#ifndef REP_MASK
#define REP_MASK 0ull
#endif
#define REPS(j) ((int)((REP_MASK >> (j)) & 1ull))
#ifdef STAMP_SEL
#define SEAM(k) do { xcd_barrier(bar); if (blockIdx.x == 0 && threadIdx.x == 0) ((unsigned long long*)(F.ctl + 32768))[(k) + 1] = __builtin_amdgcn_s_memrealtime(); } while (0)
#else
#ifdef DOUBLE_BAR
#define SEAM(k) do { if (!MK_PER_PHASE && IN((k) + 1)) { xcd_barrier(bar); xcd_barrier(bar); } } while (0)
#else
#define SEAM(k) do { if (!MK_PER_PHASE && IN((k) + 1)) xcd_barrier(bar); } while (0)
#endif
#endif
    const int bx = (int)blockIdx.x;
    const int wave0 = __builtin_amdgcn_readfirstlane((int)threadIdx.x >> 6);
#define F_REFRESH() do { unsigned z_ = 0u; asm volatile("" : "+v"(z_)); const int t_ = wave0 * 64 + (int)__builtin_amdgcn_mbcnt_hi(~0u, __builtin_amdgcn_mbcnt_lo(~0u, z_)); F.tid = t_; F.lane = t_ & 63; F.wave = wave0; } while (0)

#ifdef STAMP_SEL
    if (blockIdx.x == 0 && threadIdx.x == 0) ((unsigned long long*)(F.ctl + 32768))[0] = __builtin_amdgcn_s_memrealtime();
#endif
    if (ON(0) && IN(0)) for (int rep_ = 0; rep_ <= REPS(0); ++rep_) { F_REFRESH(); const AV A = av_get(); p0_prologue(F, A); SEAM(0); }
    if (ON(1) && IN(1)) for (int rep_ = 0; rep_ <= REPS(1); ++rep_) { F_REFRESH(); const AV A = av_get(); p1_norm0(F, A); SEAM(1); }

    for (int l = 0; l < 2; ++l) {
        const int pb = 2 + l * NPL;
        const int Mm = (l == 0) ? TALL : TL;
#define PH_BEGIN F_REFRESH(); const AV A = av_get(); unsigned char* const ws = A.ws(); unsigned char* const wl = ws + WS_WSMALL + (size_t)l * WSMALL_LAYER; (void)wl
        if (ON(2 + 0) && IN(pb + 0)) for (int rep_ = 0; rep_ <= REPS(2 + 0); ++rep_) { PH_BEGIN;
            if (ON(16)) { pg8::Gemm g{(const bf16*)(ws + WS_H8), (const bf16*)(wl + OFFS_WIN), TALL, 2560, DM / 2}; pg8::StaticOrder S; S.init(TALL, 2560, F.G, bx);
              pg8::EpiInproj E{(bf16*)(ws + WS_Q), (bf16*)(ws + WS_K), (bf16*)(ws + WS_V), (bf16*)(ws + WS_CU)};
              pg8::gemm_phase<pg8::EpiInproj, pg8::StaticOrder, GP_ALIGN, GP_SP2, true>(F.lds + RING_OFF, g, S, E, F.tid); }
            if (ON(17)) { pg8::Gemm g{(const bf16*)(wl + OFFS_WF), (const bf16*)(ws + WS_H), 1024, Mm, DM}; pg8::StaticOrder S; S.init(1024, Mm, F.G, (bx + 96) % F.G);
              pg8::EpiYT E{ws + WS_YT, ws + WS_YTC};
              pg8::gemm_phase<pg8::EpiYT, pg8::StaticOrder, GP_ALIGN, GP_SP2>(F.lds + RING_OFF, g, S, E, F.tid); }
            SEAM(pb + 0);
        }
        if (ON(2 + 1) && IN(pb + 1)) for (int rep_ = 0; rep_ <= REPS(2 + 1); ++rep_) { PH_BEGIN;
            if (ON(18)) p_qkfix(F, A, l, TALL);
            F_REFRESH();
            if (ON(19)) p_conv(F, A, l, l == 0 ? 1152 : 1024);
            if (ON(20)) { pg8::Gemm g{(const bf16*)(ws + WS_DFTL), (const bf16*)(ws + WS_YT), 2048, NB * 512, 2048}; pg8::DftOrder S; S.init(3, NB, F.G, F.vcu);
              pg8::EpiDFT E{(bf16*)(ws + WS_Z), 0, SEQ};
              pg8::gemm_phase<pg8::EpiDFT, pg8::DftOrder, GP_ALIGN, GP_SP2, true>(F.lds + RING_OFF, g, S, E, F.tid); }
            if (ON(21) && l == 0) { pg8::Gemm g{(const bf16*)(ws + WS_DFTC), (const bf16*)(ws + WS_YTC), 256, NB * 512, 256}; pg8::DftOrder S; S.init(0, NB, F.G, F.vcu);
              pg8::EpiDFT E{(bf16*)(ws + WS_Z), TL, CTXL};
              pg8::gemm_phase<pg8::EpiDFT, pg8::DftOrder, GP_ALIGN, GP_SP2, true>(F.lds + RING_OFF, g, S, E, F.tid); }
            SEAM(pb + 1);
        }
        if (ON(2 + 2) && IN(pb + 2)) for (int rep_ = 0; rep_ <= REPS(2 + 2); ++rep_) { PH_BEGIN;
            const int nheavy = NB * 8 * 8, ntot = nheavy + (l == 0 ? NB * 8 : 0);
            for (int L = F.vcu; L < ntot; L += F.G) {
                int row0, krow, h, seq;
                if (L < nheavy) { const int grp = L >> 5, s = L & 31, b = grp >> 1; h = (grp & 1) * 4 + (s >> 3); row0 = b * SEQ + (s & 7) * 256; krow = b * KVROWS; seq = KVROWS; }
                else { const int Lc = L - nheavy, b = Lc >> 3; h = Lc & 7; row0 = TL + b * CTXL; krow = b * KVROWS + SEQ; seq = CTXL; }
                const att::bf16* Qb = (const att::bf16*)(ws + WS_Q) + (size_t)row0 * DM + h * 128;
                const att::bf16* Kh = (const att::bf16*)(ws + WS_K) + (size_t)krow * 256 + (h >> 2) * 128;
                const att::bf16* Vh = (const att::bf16*)(ws + WS_V) + (size_t)krow * 256 + (h >> 2) * 128;
                unsigned char* Ob = ws + WS_AO + (size_t)row0 * DM + h * 128;
                att::attn_dense_body<att::bf16>(Qb, Kh, Vh, Ob, seq, (char*)lds + RING_OFF, F.tid);
                __syncthreads();
            }
            SEAM(pb + 2);
        }
        if (ON(2 + 3) && IN(pb + 3)) for (int rep_ = 0; rep_ <= REPS(2 + 3); ++rep_) { PH_BEGIN;
            pg8::Gemm g{(const bf16*)(ws + WS_H8), (const bf16*)(wl + OFFS_WG), Mm, 3072, DM / 2}; pg8::StaticOrder S; S.init(Mm, 3072, F.G, bx);
            pg8::EpiGates E{(bf16*)(ws + WS_GATES)};
            pg8::gemm_phase<pg8::EpiGates, pg8::StaticOrder, GP_ALIGN, GP_SP2, true>(F.lds + RING_OFF, g, S, E, F.tid);
            SEAM(pb + 3);
        }
        if (ON(2 + 4) && IN(pb + 4)) for (int rep_ = 0; rep_ <= REPS(2 + 4); ++rep_) { PH_BEGIN;
            { pg8::Gemm g{(const bf16*)(ws + WS_AO), (const bf16*)(wl + OFFS_WAO), Mm, 1024, 512}; pg8::StaticOrder S; S.init(Mm, 1024, F.G, bx);
              pg8::EpiMerge<true> E{(bf16*)(ws + WS_MERGED), (const bf16*)(ws + WS_GATES), 0, 1.0f / 2048.0f};
              pg8::gemm_phase<pg8::EpiMerge<true>, pg8::StaticOrder, GP_ALIGN, GP_SP2, true>(F.lds + RING_OFF, g, S, E, F.tid); }
#pragma unroll 1
            for (int br = 1; br < 3; ++br) {
              pg8::Gemm g{(const bf16*)(ws + (br == 1 ? WS_CH : WS_Z)), (const bf16*)(wl + (br == 1 ? OFFS_WCO : OFFS_WFO)), Mm, 1024, 512}; pg8::StaticOrder S; S.init(Mm, 1024, F.G, bx);
              pg8::EpiMerge<false> E{(bf16*)(ws + WS_MERGED), (const bf16*)(ws + WS_GATES), br, 1.0f};
              pg8::gemm_phase<pg8::EpiMerge<false>, pg8::StaticOrder, GP_ALIGN, GP_SP2>(F.lds + RING_OFF, g, S, E, F.tid); }
            SEAM(pb + 4);
        }
        if (ON(2 + 5) && IN(pb + 5)) for (int rep_ = 0; rep_ <= REPS(2 + 5); ++rep_) { PH_BEGIN;
            pg8::Gemm g{(const bf16*)(ws + WS_MERGED), (const bf16*)(wl + OFFS_WOUT), Mm, 1024, 1024}; pg8::StaticOrder S; S.init(Mm, 1024, F.G, bx);
            pg8::EpiBf16<0> E{(bf16*)(ws + WS_MIX), 1024, nullptr, 0, 0, 1.0f};
            pg8::gemm_phase<pg8::EpiBf16<0>, pg8::StaticOrder, GP_ALIGN, GP_SP2>(F.lds + RING_OFF, g, S, E, F.tid);
            SEAM(pb + 5);
        }
        if (ON(2 + 6) && IN(pb + 6)) for (int rep_ = 0; rep_ <= REPS(2 + 6); ++rep_) { PH_BEGIN; p_rowpass1(F, A, l, Mm); SEAM(pb + 6); }
        if (ON(2 + 7) && IN(pb + 7)) for (int rep_ = 0; rep_ <= REPS(2 + 7); ++rep_) { PH_BEGIN;
            pg8::Gemm g{(const bf16*)(ws + WS_H), (const bf16*)(wl + OFFS_ROUT), Mm, 256, DM}; pg8::StaticOrder S; S.init(Mm, 256, F.G, bx);
            pg8::EpiRouter E{(float*)(ws + WS_LOGIT)};
            pg8::gemm_phase<pg8::EpiRouter, pg8::StaticOrder, GP_ALIGN, GP_SP2>(F.lds + RING_OFF, g, S, E, F.tid);
            SEAM(pb + 7);
        }
        if (ON(2 + 8) && IN(pb + 8)) for (int rep_ = 0; rep_ <= REPS(2 + 8); ++rep_) { PH_BEGIN; p_topk(F, A, l, Mm); SEAM(pb + 8); }
        if (ON(2 + 9) && IN(pb + 9)) for (int rep_ = 0; rep_ <= REPS(2 + 9); ++rep_) { PH_BEGIN; p_slots(F, A, Mm); SEAM(pb + 9); }
        if (ON(2 + 10) && IN(pb + 10)) for (int rep_ = 0; rep_ <= REPS(2 + 10); ++rep_) { PH_BEGIN;
            const int NT = __builtin_amdgcn_readfirstlane(((const int*)(ws + WS_CNT))[CNT_NT]);
            pg8::Gemm g{(const bf16*)(ws + WS_HS), (const bf16*)(ws + WS_WGU + (size_t)l * MOEW_LAYER), NT * 256, NEXP * 2048, DM / 2}; pg8::GroupedOrder S; S.init(NT, 8, F.G, bx, (const int*)(ws + WS_CNT) + CNT_TILE_E);
            pg8::EpiSwiGLU8 E{ws + WS_ACT, A.in(24) + (size_t)l * NEXP * 1024, A.in(26) + (size_t)l * NEXP * 1024};
            pg8::gemm_phase<pg8::EpiSwiGLU8, pg8::GroupedOrder, GP_ALIGN, GP_SP2, true>(F.lds + RING_OFF, g, S, E, F.tid);
            SEAM(pb + 10);
        }
        if (ON(2 + 11) && IN(pb + 11)) for (int rep_ = 0; rep_ <= REPS(2 + 11); ++rep_) { PH_BEGIN;
            const int NT = __builtin_amdgcn_readfirstlane(((const int*)(ws + WS_CNT))[CNT_NT]);
#ifdef STAGGER_US
            { const unsigned long long t0 = __builtin_amdgcn_s_memrealtime(), dl = (unsigned long long)((bx >> 3) & 3) * (STAGGER_US); while (__builtin_amdgcn_s_memrealtime() - t0 < dl) __builtin_amdgcn_s_sleep(8); }
#endif
            pg8::Gemm g{(const bf16*)(ws + WS_ACT), (const bf16*)(ws + WS_WD + (size_t)l * MOEW_LAYER), NT * 256, NEXP * 1024, DM / 2}; pg8::GroupedOrder S; S.init(NT, 4, F.G, bx, (const int*)(ws + WS_CNT) + CNT_TILE_E);
            pg8::EpiDown8 E{(bf16*)(ws + WS_YS), A.in(28) + (size_t)l * NEXP * 1024};
            pg8::gemm_phase<pg8::EpiDown8, pg8::GroupedOrder, GP_ALIGN, GP_SP2, true>(F.lds + RING_OFF, g, S, E, F.tid);
            SEAM(pb + 11);
        }
        if (ON(2 + 12) && IN(pb + 12)) for (int rep_ = 0; rep_ <= REPS(2 + 12); ++rep_) { PH_BEGIN;
            p_combine(F, A, l, Mm);
            SEAM(pb + 12);
        }
    }
#ifdef STAMP_SEL
    { const AV A = av_get(); float* out = A.out(); const unsigned long long* ts = (const unsigned long long*)(F.ctl + 32768);
      auto span = [&](int p) -> float { unsigned long long d = __hip_atomic_load(ts + p + 1, __ATOMIC_RELAXED, __HIP_MEMORY_SCOPE_AGENT) - __hip_atomic_load(ts + p, __ATOMIC_RELAXED, __HIP_MEMORY_SCOPE_AGENT);
          if (p >= 2) d += __hip_atomic_load(ts + p + NPL + 1, __ATOMIC_RELAXED, __HIP_MEMORY_SCOPE_AGENT) - __hip_atomic_load(ts + p + NPL, __ATOMIC_RELAXED, __HIP_MEMORY_SCOPE_AGENT); return (float)d * 0.01f; };
      const float K1 = span((STAMP_SEL) & 0xff), K2 = 200.0f * span(((STAMP_SEL) >> 8) & 0xff);
      for (size_t i = (size_t)blockIdx.x * NTHR + threadIdx.x; i < (size_t)TL * DM; i += (size_t)gridDim.x * NTHR) out[i] = (i == 0) ? K2 : K1; }
#endif
#undef IN
#undef PH_BEGIN
#undef F_REFRESH
#undef SEAM
}

extern "C" void kernel_launch(void* const* d_in, const int* in_sizes, int n_in, void* d_out, int out_size, void* d_ws, size_t ws_size, hipStream_t stream) {
    static int grid = 0;
    if (grid == 0) {
        if (n_in != 29 || out_size != TL * DM || ws_size < WS_END2) { fprintf(stderr, "kernel_launch: built for 29 inputs, %d outputs, >= %zu bytes of workspace; got n_in %d out %d ws %zu\n", TL * DM, (size_t)WS_END2, n_in, out_size, ws_size); grid = -1; return; }
        int dev = 0, cus = 0, per_cu = 0;
        if (hipGetDevice(&dev) != hipSuccess || hipDeviceGetAttribute(&cus, hipDeviceAttributeMultiprocessorCount, dev) != hipSuccess) { grid = -1; return; }
        if (hipFuncSetAttribute((const void*)fwd, hipFuncAttributeMaxDynamicSharedMemorySize, LDS_BYTES) != hipSuccess) { fprintf(stderr, "kernel_launch: hipFuncSetAttribute failed\n"); grid = -1; return; }
        if (hipOccupancyMaxActiveBlocksPerMultiprocessor(&per_cu, (const void*)fwd, NTHR, LDS_BYTES) != hipSuccess || per_cu < 1) fprintf(stderr, "kernel_launch: occupancy query reports %d\n", per_cu);
        (void)hipGetLastError();
        grid = cus;
    }
    if (grid < 0) return;
    (void)hipMemsetAsync((char*)d_ws + WS_CTL, 0, CTL_ZERO_BYTES, stream);
    Args a{};
    for (int i = 0; i < 29; ++i) a.in[i] = (const float*)d_in[i];
    a.out = (float*)d_out; a.ws = (unsigned char*)d_ws;
#if MK_PER_PHASE
    for (int p = 0; p < NPH; ++p) {
#ifdef DBG_CHECK
        float* res = (float*)((char*)d_ws + WS_CTL + 8192 * 4); float* snap = (float*)((char*)d_ws + WS_END);
        { const int l = p >= 2 ? (p - 2) / NPL : 0, k = p >= 2 ? (p - 2) % NPL : -1;
          if (k == 6) hipLaunchKernelGGL(snap_rows, dim3(256), dim3(256), 0, stream, a, l, 11, snap);
          if (k == 12) hipLaunchKernelGGL(snap_rows, dim3(256), dim3(256), 0, stream, a, l, 17, snap); }
#endif
        a.ph_lo = p; a.ph_hi = p + 1; hipLaunchKernelGGL(fwd, dim3(grid), dim3(NTHR), LDS_BYTES, stream, a);
#ifdef DBG_CHECK
        { const int l = p >= 2 ? (p - 2) / NPL : 0, k = p >= 2 ? (p - 2) % NPL : -1;
#define CHK(st) hipLaunchKernelGGL(chk, dim3(1), dim3(256), 0, stream, a, (int)(st), l, res, snap)
          if (p == 0) CHK(ST_MOD); if (p == 1) CHK(ST_H0);
#if DBG_GSUB == 2
          if (k == 3 && l == 0) hipLaunchKernelGGL(chk_gates_full, dim3(48, TALL / 4), dim3(256), 0, stream, (const bf16*)((char*)d_ws + WS_H), (const bf16*)((char*)d_ws + WS_WSMALL + OFFS_WG), (const bf16*)((char*)d_ws + WS_GATES), TALL, (unsigned*)((char*)d_ws + WS_CTL + 65536));
#endif
          if (k == 0) { CHK(ST_INPROJ); CHK(ST_YT); } if (k == 1) { CHK(ST_QKFIX); CHK(ST_CONV); CHK(ST_Z); } if (k == 2) CHK(ST_ATTN); if (k == 3) { CHK(ST_GATES); CHK(ST_GATESB); } if (k == 4) CHK(ST_MERGED);
          if (k == 5) CHK(ST_MIX); if (k == 6) CHK(ST_ROW1); if (k == 7) CHK(ST_LOGIT); if (k == 8) CHK(ST_TOPK); if (k == 9) CHK(ST_SLOTS); if (k == 10) CHK(ST_ACT); if (k == 11) CHK(ST_YSLOT); if (k == 12) CHK(ST_COMB);
#undef CHK
        }
#endif
    }
#ifdef DBG_CHECK
#if DBG_GSUB == 2
    hipLaunchKernelGGL(encode_full, dim3(1024), dim3(256), 0, stream, (float*)d_out, (const unsigned*)((char*)d_ws + WS_CTL + 65536), out_size);
#else
    hipLaunchKernelGGL(encode, dim3(1024), dim3(256), 0, stream, (float*)d_out, (const float*)((char*)d_ws + WS_CTL + 8192 * 4), out_size, 0.25f);
#endif
#endif
#else
    a.ph_lo = 0; a.ph_hi = NPH; hipLaunchKernelGGL(fwd, dim3(grid), dim3(NTHR), LDS_BYTES, stream, a);
#endif
    const hipError_t le = hipPeekAtLastError();
    if (le != hipSuccess) fprintf(stderr, "kernel_launch: launch failed: %s\n", hipGetErrorName(le));
}
```

```cpp
#include <hip/hip_runtime.h>
#include <cstdio>
#include <cstdint>
#ifndef MK_PER_PHASE
#define MK_PER_PHASE 0
#endif
namespace pg8 {
#define PG8_LAS __attribute__((address_space(3)))
typedef unsigned short bf16_t;
typedef short bf16x8 __attribute__((ext_vector_type(8)));
typedef float f32x4 __attribute__((ext_vector_type(4)));
typedef unsigned u32x4 __attribute__((ext_vector_type(4)));
typedef int i32x4v __attribute__((ext_vector_type(4)));
typedef int i32x8v __attribute__((ext_vector_type(8)));
typedef unsigned u32x2v __attribute__((ext_vector_type(2)));
constexpr int BM = 256, BK = 64, HALF = 128, HTB = HALF * BK * 2  , STAGE_BYTES = 8 * HTB, NXCD = 8, WGM = 8;

__host__ __device__ __forceinline__ int lds_byte(int r, int c) { const int st = (r >> 4) * 2 + (c >> 5), rr = r & 15, cc = c & 31, ob = rr * 64 + cc * 2; return st * 1024 + (ob ^ (((ob >> 9) & 1) << 5)); }
__host__ __device__ __forceinline__ void stage_rc(int b, int& R, int& C) { const int st = b / 1024, sb = b % 1024, swz = sb ^ (((sb >> 9) & 1) << 5); R = (st >> 1) * 16 + swz / 64; C = (st & 1) * 32 + (swz % 64) / 2; }
__host__ __device__ __forceinline__ int perm32(int rho) { const int n = rho >> 4, i = rho & 15; return 8 * (i >> 2) + 4 * n + (i & 3); }

struct Unit { int pm, pn; };
struct Gemm { const bf16_t* A; const bf16_t* Bt; int M, N, K; };

struct StaticOrder {
    int nM, nN, nwg, G, c;
    __host__ __device__ void init(int M, int N, int G_, int c_) { nM = M / BM; nN = N / BM; nwg = nM * nN; G = G_; c = c_; }
    __host__ __device__ bool next(int i, Unit& u) const {
        const long L = (long)i * G + c; if (L >= nwg) return false;
        int wgid = (int)L; { const int q = nwg / NXCD, r = nwg % NXCD, xcd = wgid % NXCD, off = wgid / NXCD; wgid = (xcd < r ? xcd * (q + 1) : r * (q + 1) + (xcd - r) * q) + off; }
        const int nig = WGM * nN, gid = wgid / nig, fm = gid * WGM, gsz = (nM - fm) < WGM ? (nM - fm) : WGM;
        u.pm = fm + ((wgid % nig) % gsz); u.pn = (wgid % nig) / gsz; return true;
    }
    __device__ __forceinline__ void a_ready(const Unit&) const {}
    __device__ __forceinline__ void done(const Unit&) const {}
};

typedef __bf16 bf16x2_native __attribute__((ext_vector_type(2)));
typedef float f32x2_native __attribute__((ext_vector_type(2)));
__device__ __forceinline__ unsigned cvt_pk_bf16(float lo, float hi) { const f32x2_native v = {lo, hi}; const bf16x2_native r = __builtin_convertvector(v, bf16x2_native); return __builtin_bit_cast(unsigned, r); }
__device__ __forceinline__ unsigned cvt4_fp8(float a, float b, float c, float d) { int w = __builtin_amdgcn_cvt_pk_fp8_f32(a, b, __builtin_bit_cast(int, a), false); w = __builtin_amdgcn_cvt_pk_fp8_f32(c, d, w, true); return (unsigned)w; }
typedef float f32x2 __attribute__((ext_vector_type(2)));
__device__ __forceinline__ f32x2 gelu_pk(f32x2 v) {
    const f32x2 av = __builtin_elementwise_abs(v), d = av * 0.2316418882f + 1.0f;
    f32x2 t; t.x = __builtin_amdgcn_rcpf(d.x); t.y = __builtin_amdgcn_rcpf(d.y);
    f32x2 q = t * 0.5307027145f + (-0.7265760135f); q = q * t + 0.7107068705f; q = q * t + (-0.142248368f); q = q * t + 0.127414796f; q = q * t;
    const f32x2 s = (v * v) * (-0.72134752044f);
    f32x2 e; e.x = __builtin_amdgcn_exp2f(s.x); e.y = __builtin_amdgcn_exp2f(s.y);
    const f32x2 m = v * (q * e), r = v - m;
    f32x2 o; o.x = v.x < 0.f ? m.x : r.x; o.y = v.y < 0.f ? m.y : r.y; return o;
}

template <int ACT  > struct EpiBf16 {
    static constexpr bool PERM = true, AFTER_DRAIN = false; static_assert(ACT == 0 || ACT == 1, "EpiBf16: ACT is 0 (none) or 1 (gelu_pk)");
    bf16_t* O; int ldc; const float* bias; int split_cols; size_t split_stride; float scale0;
    __device__ __forceinline__ void operator()(const f32x4 (&acc)[2][2][4][2], const Unit& u, int wr, int wc, int fr, int fq) const {
        const int row0 = u.pm * BM + wr * 64 + fr; int colt = u.pn * BM; bf16_t* base = O;
        float sc = 1.f; if (split_cols) { const int t = colt / split_cols; base += (size_t)t * split_stride; colt -= t * split_cols; if (t == 0) sc = scale0; }
        const int col0 = colt + wc * 32 + 8 * fq, bcol0 = u.pn * BM + wc * 32 + 8 * fq;
        f32x4 bv[2][2];
#pragma unroll
        for (int bj = 0; bj < 2; ++bj)
#pragma unroll
            for (int n = 0; n < 2; ++n) bv[bj][n] = bias ? *(const f32x4*)(bias + bcol0 + bj * HALF + 4 * n) : (f32x4){0.f, 0.f, 0.f, 0.f};
#pragma unroll
        for (int ai = 0; ai < 2; ++ai)
#pragma unroll
            for (int m = 0; m < 4; ++m) { bf16_t* rowp = base + (size_t)(row0 + ai * HALF + m * 16) * ldc + col0;
#pragma unroll
                for (int bj = 0; bj < 2; ++bj) { f32x4 v0 = acc[ai][bj][m][0] + bv[bj][0], v1 = acc[ai][bj][m][1] + bv[bj][1];
                    if (ACT == 1) { f32x2 a = gelu_pk((f32x2){v0[0], v0[1]}), b = gelu_pk((f32x2){v0[2], v0[3]}), c = gelu_pk((f32x2){v1[0], v1[1]}), d = gelu_pk((f32x2){v1[2], v1[3]});
                        v0 = (f32x4){a.x, a.y, b.x, b.y}; v1 = (f32x4){c.x, c.y, d.x, d.y}; }
                    v0 = v0 * sc; v1 = v1 * sc; u32x4 w; w.x = cvt_pk_bf16(v0[0], v0[1]); w.y = cvt_pk_bf16(v0[2], v0[3]); w.z = cvt_pk_bf16(v1[0], v1[1]); w.w = cvt_pk_bf16(v1[2], v1[3]);
                    *(u32x4*)(rowp + bj * HALF) = w; } }
    }
};

__device__ __forceinline__ float fast_sigmoid(float x) { return __builtin_amdgcn_rcpf(1.0f + __builtin_amdgcn_exp2f(-1.4426950408889634f * x)); }
__device__ __forceinline__ u32x4 pack8(const f32x4& a, const f32x4& b) { u32x4 w; w.x = cvt_pk_bf16(a[0], a[1]); w.y = cvt_pk_bf16(a[2], a[3]); w.z = cvt_pk_bf16(b[0], b[1]); w.w = cvt_pk_bf16(b[2], b[3]); return w; }
__device__ __forceinline__ void unpack8(const u32x4& w, f32x4& a, f32x4& b) {
    a[0] = __uint_as_float(w.x << 16); a[1] = __uint_as_float(w.x & 0xffff0000u); a[2] = __uint_as_float(w.y << 16); a[3] = __uint_as_float(w.y & 0xffff0000u);
    b[0] = __uint_as_float(w.z << 16); b[1] = __uint_as_float(w.z & 0xffff0000u); b[2] = __uint_as_float(w.w << 16); b[3] = __uint_as_float(w.w & 0xffff0000u); }
__device__ __forceinline__ u32x2v pack8_fp8(const f32x4& a, const f32x4& b) { u32x2v r; r.x = cvt4_fp8(a[0], a[1], a[2], a[3]); r.y = cvt4_fp8(b[0], b[1], b[2], b[3]); return r; }
__device__ __forceinline__ void store_tile_bf16(const f32x4 (&acc)[2][2][4][2], bf16_t* base, int ldc, int wr, int wc, int fr, int fq) {
    const int rt = wr * 64 + fr, cb = wc * 32 + 8 * fq;
#pragma unroll
    for (int ai = 0; ai < 2; ++ai)
#pragma unroll
        for (int m = 0; m < 4; ++m) { bf16_t* rowp = base + (size_t)(rt + ai * HALF + m * 16) * ldc + cb;
#pragma unroll
            for (int bj = 0; bj < 2; ++bj) *(u32x4*)(rowp + bj * HALF) = pack8(acc[ai][bj][m][0], acc[ai][bj][m][1]); }
}
struct EpiInproj {
    static constexpr bool PERM = true, AFTER_DRAIN = false;
    bf16_t *q, *k, *v, *cu;
    __device__ __forceinline__ void operator()(const f32x4 (&acc)[2][2][4][2], const Unit& u, int wr, int wc, int fr, int fq) const {
        bf16_t* base; int ldc; const bool glu = u.pn >= 6; float sc = 0.03125f; asm volatile("" : "+s"(sc));
        if (u.pn < 4) { base = q + (size_t)u.pm * 256 * 1024 + u.pn * 256; ldc = 1024; }
        else if (u.pn < 6) { const int m0 = u.pm * 256; const int kr = m0 < 32768 ? (m0 >> 11) * 2304 + (m0 & 2047) : ((m0 - 32768) >> 8) * 2304 + 2048; base = (u.pn == 4 ? k : v) + (size_t)kr * 256; ldc = 256; }
        else { base = cu + (size_t)u.pm * 256 * 512 + (u.pn - 6) * 128; ldc = 512; }
        base += (size_t)(wr * 64 + fr) * ldc + wc * 32 + 8 * fq;
#pragma unroll
        for (int ai = 0; ai < 2; ++ai)
#pragma unroll
            for (int m = 0; m < 4; ++m) { bf16_t* rowp = base + (size_t)(ai * HALF + m * 16) * ldc;
                if (!glu) { *(u32x4*)rowp = pack8(acc[ai][0][m][0] * sc, acc[ai][0][m][1] * sc); *(u32x4*)(rowp + HALF) = pack8(acc[ai][1][m][0] * sc, acc[ai][1][m][1] * sc); }
                else { f32x4 a0 = acc[ai][0][m][0] * sc, a1 = acc[ai][0][m][1] * sc; const f32x4 g0 = acc[ai][1][m][0] * sc, g1 = acc[ai][1][m][1] * sc;
#pragma unroll
                    for (int j = 0; j < 4; ++j) { a0[j] *= fast_sigmoid(g0[j]); a1[j] *= fast_sigmoid(g1[j]); }
                    *(u32x4*)rowp = pack8(a0, a1); } }
    }
};
struct EpiYT {
    static constexpr bool PERM = true, AFTER_DRAIN = false;
    unsigned char *yt, *ytc;
    __device__ __forceinline__ void operator()(const f32x4 (&acc)[2][2][4][2], const Unit& u, int wr, int wc, int fr, int fq) const {
        const int cs = u.pm >> 1, chb = (u.pm & 1) * 256; unsigned char* base; int ldc;
        if (u.pn < 128) { const int b = u.pn >> 3, pos0 = (u.pn & 7) * 256; base = yt + (size_t)(b * 512 + chb) * 4096 + cs * 2048 + pos0; ldc = 4096; }
        else { const int b = u.pn - 128; base = ytc + (size_t)(b * 512 + chb) * 512 + cs * 256; ldc = 512; }
        base += (size_t)(wr * 64 + fr) * ldc + wc * 32 + 8 * fq;
#pragma unroll
        for (int ai = 0; ai < 2; ++ai)
#pragma unroll
            for (int m = 0; m < 4; ++m) { unsigned char* rowp = base + (size_t)(ai * HALF + m * 16) * ldc;
#pragma unroll
                for (int bj = 0; bj < 2; ++bj) *(u32x2v*)(rowp + bj * HALF) = pack8_fp8(acc[ai][bj][m][0], acc[ai][bj][m][1]); }
    }
};
struct EpiDFT {
    static constexpr bool PERM = true, AFTER_DRAIN = false;
    bf16_t* z; int rowbase, rpb;
    __device__ __forceinline__ void operator()(const f32x4 (&acc)[2][2][4][2], const Unit& u, int wr, int wc, int fr, int fq) const {
        bf16_t* base = z + (size_t)(rowbase + (u.pn >> 1) * rpb + u.pm * 256 + wr * 64 + fr) * 512 + (u.pn & 1) * 256 + wc * 32 + 8 * fq;
#pragma unroll
        for (int ai = 0; ai < 2; ++ai)
#pragma unroll
            for (int m = 0; m < 4; ++m)
#pragma unroll
                for (int bj = 0; bj < 2; ++bj) *(u32x4*)(base + (size_t)(ai * HALF + m * 16) * 512 + bj * HALF) = pack8(acc[ai][bj][m][0] * 0.03125f, acc[ai][bj][m][1] * 0.03125f);
    }
};
struct EpiGates {
    static constexpr bool PERM = true, AFTER_DRAIN = false;
    bf16_t* g;
    __device__ __forceinline__ void operator()(const f32x4 (&acc)[2][2][4][2], const Unit& u, int wr, int wc, int fr, int fq) const {
        const int rt = wr * 64 + fr, cb = wc * 32 + 8 * fq; bf16_t* base = g + (size_t)u.pm * 256 * 3072 + u.pn * 256 + cb;
        float cs = -1.4426950408889634f * 0.03125f; asm volatile("" : "+s"(cs));
#pragma unroll
        for (int ai = 0; ai < 2; ++ai)
#pragma unroll
            for (int m = 0; m < 4; ++m)
#pragma unroll
                for (int bj = 0; bj < 2; ++bj) { f32x4 a0 = acc[ai][bj][m][0], a1 = acc[ai][bj][m][1];
#pragma unroll
                    for (int j = 0; j < 4; ++j) { a0[j] = __builtin_amdgcn_rcpf(1.0f + __builtin_amdgcn_exp2f(a0[j] * cs)); a1[j] = __builtin_amdgcn_rcpf(1.0f + __builtin_amdgcn_exp2f(a1[j] * cs)); }
                    __builtin_nontemporal_store(pack8(a0, a1), (u32x4*)(base + (size_t)(rt + ai * HALF + m * 16) * 3072 + bj * HALF)); }
    }
};
template <bool FIRST> struct EpiMerge {
    static constexpr bool PERM = true, AFTER_DRAIN = false;
    bf16_t* mg; const bf16_t* g; int br; float scale;
    __device__ __forceinline__ void operator()(const f32x4 (&acc)[2][2][4][2], const Unit& u, int wr, int wc, int fr, int fq) const {
        const int rt = u.pm * 256 + wr * 64 + fr, cb = u.pn * 256 + wc * 32 + 8 * fq; float sc = scale; asm volatile("" : "+s"(sc));
#pragma unroll
        for (int ai = 0; ai < 2; ++ai)
#pragma unroll
            for (int m = 0; m < 4; ++m)
#pragma unroll
                for (int bj = 0; bj < 2; ++bj) { const size_t row = (size_t)(rt + ai * HALF + m * 16); const int col = cb + bj * HALF;
                    const u32x4 gw = *(const u32x4*)(g + row * 3072 + br * 1024 + col); f32x4 g0, g1; unpack8(gw, g0, g1);
                    f32x4 v0 = acc[ai][bj][m][0] * sc * g0, v1 = acc[ai][bj][m][1] * sc * g1;
                    if (!FIRST) { const u32x4 ow = *(const u32x4*)(mg + row * 1024 + col); f32x4 o0, o1; unpack8(ow, o0, o1); v0 += o0; v1 += o1; }
                    *(u32x4*)(mg + row * 1024 + col) = pack8(v0, v1); }
    }
};
struct EpiRouter {
    static constexpr bool PERM = true, AFTER_DRAIN = false;
    float* lg;
    __device__ __forceinline__ void operator()(const f32x4 (&acc)[2][2][4][2], const Unit& u, int wr, int wc, int fr, int fq) const {
        if (wc < 2) { const int rt = u.pm * 256 + wr * 64 + fr, cb = wc * 32 + 8 * fq;
#pragma unroll
            for (int ai = 0; ai < 2; ++ai)
#pragma unroll
                for (int m = 0; m < 4; ++m) { float* p = lg + (size_t)(rt + ai * HALF + m * 16) * 64 + cb; *(f32x4*)p = acc[ai][0][m][0]; *(f32x4*)(p + 4) = acc[ai][0][m][1]; } }
    }
};
struct EpiSwiGLU {
    static constexpr bool PERM = true, AFTER_DRAIN = false;
    bf16_t* act; const float* bg; const float* bu;
    __device__ __forceinline__ void operator()(const f32x4 (&acc)[2][2][4][2], const Unit& u, int wr, int wc, int fr, int fq) const {
        const int e = u.pn >> 3, col = (u.pn & 7) * 128 + wc * 32 + 8 * fq, rt = u.pm * 256 + wr * 64 + fr;
        const f32x4 bg0 = *(const f32x4*)(bg + e * 1024 + col), bg1 = *(const f32x4*)(bg + e * 1024 + col + 4), bu0 = *(const f32x4*)(bu + e * 1024 + col), bu1 = *(const f32x4*)(bu + e * 1024 + col + 4);
#pragma unroll
        for (int ai = 0; ai < 2; ++ai)
#pragma unroll
            for (int m = 0; m < 4; ++m) { f32x4 g0 = acc[ai][0][m][0] + bg0, g1 = acc[ai][0][m][1] + bg1, u0 = acc[ai][1][m][0] + bu0, u1 = acc[ai][1][m][1] + bu1;
#pragma unroll
                for (int j = 0; j < 4; ++j) { const float ga = fminf(g0[j], 7.0f), gb = fminf(g1[j], 7.0f); const float ua = fminf(fmaxf(u0[j], -7.0f), 7.0f), ub = fminf(fmaxf(u1[j], -7.0f), 7.0f);
                    g0[j] = (ua + 1.0f) * (ga * fast_sigmoid(1.702f * ga)); g1[j] = (ub + 1.0f) * (gb * fast_sigmoid(1.702f * gb)); }
                *(u32x4*)(act + (size_t)(rt + ai * HALF + m * 16) * 1024 + col) = pack8(g0, g1); }
    }
};
struct EpiSwiGLU8 {
    static constexpr bool PERM = true, AFTER_DRAIN = false;
    unsigned char* act; const float* bg; const float* bu;
    __device__ __forceinline__ void operator()(const f32x4 (&acc)[2][2][4][2], const Unit& u, int wr, int wc, int fr, int fq) const {
        const int e = u.pn >> 3, col = (u.pn & 7) * 128 + wc * 32 + 8 * fq, rt = u.pm * 256 + wr * 64 + fr;
        const f32x4 bg0 = *(const f32x4*)(bg + e * 1024 + col), bg1 = *(const f32x4*)(bg + e * 1024 + col + 4), bu0 = *(const f32x4*)(bu + e * 1024 + col), bu1 = *(const f32x4*)(bu + e * 1024 + col + 4);
#pragma unroll
        for (int ai = 0; ai < 2; ++ai)
#pragma unroll
            for (int m = 0; m < 4; ++m) { f32x4 g0 = acc[ai][0][m][0] * 0.03125f + bg0, g1 = acc[ai][0][m][1] * 0.03125f + bg1, u0 = acc[ai][1][m][0] * 0.03125f + bu0, u1 = acc[ai][1][m][1] * 0.03125f + bu1;
#pragma unroll
                for (int j = 0; j < 4; ++j) { const float ga = fminf(g0[j], 7.0f), gb = fminf(g1[j], 7.0f); const float ua = fminf(fmaxf(u0[j], -7.0f), 7.0f), ub = fminf(fmaxf(u1[j], -7.0f), 7.0f);
                    g0[j] = (ua + 1.0f) * (ga * fast_sigmoid(1.702f * ga)); g1[j] = (ub + 1.0f) * (gb * fast_sigmoid(1.702f * gb)); }
                __builtin_nontemporal_store(pack8_fp8(g0, g1), (u32x2v*)(act + (size_t)(rt + ai * HALF + m * 16) * 1024 + col)); }
    }
};
struct EpiDown8 {
    static constexpr bool PERM = true, AFTER_DRAIN = false;
    bf16_t* ys; const float* bd; int nostore;
    __device__ __forceinline__ void operator()(const f32x4 (&acc)[2][2][4][2], const Unit& u, int wr, int wc, int fr, int fq) const {
        const int e = u.pn >> 2, col0 = (u.pn & 3) * 256 + wc * 32 + 8 * fq, rt = u.pm * 256 + wr * 64 + fr;
        f32x4 bv[2][2];
#pragma unroll
        for (int bj = 0; bj < 2; ++bj) { bv[bj][0] = *(const f32x4*)(bd + e * 1024 + col0 + bj * HALF); bv[bj][1] = *(const f32x4*)(bd + e * 1024 + col0 + bj * HALF + 4); }
#pragma unroll
        for (int ai = 0; ai < 2; ++ai)
#pragma unroll
            for (int m = 0; m < 4; ++m) { bf16_t* rowp = ys + (size_t)(rt + ai * HALF + m * 16) * 1024 + col0;
#pragma unroll
                for (int bj = 0; bj < 2; ++bj) { const u32x4 w = pack8(acc[ai][bj][m][0] * 0.03125f + bv[bj][0], acc[ai][bj][m][1] * 0.03125f + bv[bj][1]); if (!nostore) __builtin_nontemporal_store(w, (u32x4*)(rowp + bj * HALF)); else asm volatile("" :: "v"(w)); } }
    }
};
struct GroupedOrder {
    int nM, nN, nwg, G, c; const int* tile_e;
    __device__ void init(int nM_, int nN_, int G_, int c_, const int* te) { nM = nM_; nN = nN_; nwg = nM * nN; G = G_; c = c_; tile_e = te; }
    __device__ bool next(int i, Unit& u) const {
        const long L = (long)i * G + c; if (L >= nwg) return false;
        int wgid = (int)L; { const int q = nwg / NXCD, r = nwg % NXCD, xcd = wgid % NXCD, off = wgid / NXCD; wgid = (xcd < r ? xcd * (q + 1) : r * (q + 1) + (xcd - r) * q) + off; }
        const int nig = WGM * nN, gid = wgid / nig, fm = gid * WGM, gsz = (nM - fm) < WGM ? (nM - fm) : WGM;
        u.pm = fm + ((wgid % nig) % gsz); const int pl = (wgid % nig) / gsz; u.pn = __builtin_amdgcn_readfirstlane(tile_e[u.pm]) * nN + pl; return true;
    }
    __device__ __forceinline__ void a_ready(const Unit&) const {}
    __device__ __forceinline__ void done(const Unit&) const {}
};
struct DftOrder {
    int lg, n, G, c;
    __device__ void init(int lg_, int nb, int G_, int c_) { lg = lg_; n = (nb * 2) << lg_; G = G_; c = c_; }
    __device__ bool next(int i, Unit& u) const { const int L = i * G + c; if (L >= n) return false; const int b = L >> (lg + 1), rem = L & ((2 << lg) - 1); u.pm = rem & ((1 << lg) - 1); u.pn = 2 * b + (rem >> lg); return true; }
    __device__ __forceinline__ void a_ready(const Unit&) const {}
    __device__ __forceinline__ void done(const Unit&) const {}
};

template <class Epi, class Sched, bool ALIGN_EPI = false, bool SP2 = false, bool FP8 = false>
__device__ __forceinline__ void gemm_phase(PG8_LAS unsigned char* lds, const Gemm g, const Sched& S, const Epi& E, const int tid_in) {
    int tid_ = tid_in; asm volatile("" : "+v"(tid_));
    const int tid = tid_, wid = __builtin_amdgcn_readfirstlane(tid >> 6), lane = tid & 63, wr = wid >> 2, wc = wid & 3, fr = lane & 15, fq = lane >> 4;
    const int K = g.K, nt = K / BK;
    unsigned voffA[2], voffB[2];
#pragma unroll
    for (int i = 0; i < 2; ++i) { int R, C; stage_rc(tid * 16 + i * 8192, R, C); const int Rb = Epi::PERM ? ((R & ~31) + perm32(R & 31)) : R;
        voffA[i] = (unsigned)(R * K + C) * 2u; voffB[i] = (unsigned)(Rb * K + C) * 2u; }
    const size_t kstep = (size_t)(BK * 2);
    const size_t hstep = (size_t)HALF * K * 2;
    const size_t tstep = 2 * hstep;
    const unsigned ldsw = (unsigned)wid * 1024u;
    const int aoff = lds_byte(wr * 64 + fr, fq * 8), boff = lds_byte(wc * 32 + fr, fq * 8);
#define PG8_SA(b, h) (((b) * 2 + (h)) * HTB)
#define PG8_SB(b, h) ((4 + (b) * 2 + (h)) * HTB)
#define PG8_STAGE(bufoff, gbase, voff) do { _Pragma("unroll") for (int _i = 0; _i < 2; ++_i) \
        __builtin_amdgcn_global_load_lds((const unsigned*)((const char*)(gbase) + (voff)[_i]), (PG8_LAS unsigned*)(lds + (bufoff) + ldsw + _i * 8192), 16, 0, 0); } while (0)
#define PG8_RD8(off) __builtin_shufflevector(*(const PG8_LAS i32x4v*)(lds + (off)), *(const PG8_LAS i32x4v*)(lds + (off) + 1024), 0, 1, 2, 3, 4, 5, 6, 7)
#define PG8_LDA(dst, b, h) do { _Pragma("unroll") for (int m = 0; m < 4; ++m) { if constexpr (FP8) dst##8[m] = PG8_RD8(PG8_SA(b, h) + aoff + m * 2048); else { _Pragma("unroll") for (int k = 0; k < 2; ++k) dst[m][k] = *(const PG8_LAS bf16x8*)(lds + PG8_SA(b, h) + aoff + m * 2048 + k * 1024); } } } while (0)
#define PG8_LDB(dst, b, h) do { _Pragma("unroll") for (int n = 0; n < 2; ++n) { if constexpr (FP8) dst##8[n] = PG8_RD8(PG8_SB(b, h) + boff + n * 2048); else { _Pragma("unroll") for (int k = 0; k < 2; ++k) dst[n][k] = *(const PG8_LAS bf16x8*)(lds + PG8_SB(b, h) + boff + n * 2048 + k * 1024); } } } while (0)
#define PG8_MMA(ai, bj, At, Bt) do { if constexpr (FP8) __builtin_amdgcn_sched_barrier(0); __builtin_amdgcn_s_setprio(1); _Pragma("unroll") for (int m = 0; m < 4; ++m) _Pragma("unroll") for (int n = 0; n < 2; ++n) { \
        if constexpr (FP8) asm volatile("v_mfma_scale_f32_16x16x128_f8f6f4 %0, %1, %2, %0, %3, %3 op_sel_hi:[0,0,0]" : "+v"(acc[ai][bj][m][n]) : "v"(Bt##8[n]), "v"(At##8[m]), "v"(sc8)); \
        else { _Pragma("unroll") for (int k = 0; k < 2; ++k) acc[ai][bj][m][n] = __builtin_amdgcn_mfma_f32_16x16x32_bf16(Bt[n][k], At[m][k], acc[ai][bj][m][n], 0, 0, 0); } } __builtin_amdgcn_s_setprio(0); if constexpr (FP8) __builtin_amdgcn_sched_barrier(0); } while (0)
#define PG8_WAIT_V(n) asm volatile("s_waitcnt vmcnt(" #n ")" ::: "memory")
#define PG8_WAIT_L(n) asm volatile("s_waitcnt lgkmcnt(" #n ")" ::: "memory")
#define PG8_BAR __builtin_amdgcn_s_barrier()
#define PG8_SCHED __builtin_amdgcn_sched_barrier(0)
    Unit cur, nxt; int ui = 0;
    if (!S.next(0, cur)) return;
    f32x4 acc[2][2][4][2];
#pragma unroll
    for (int a = 0; a < 2; ++a)
#pragma unroll
        for (int b = 0; b < 2; ++b)
#pragma unroll
            for (int m = 0; m < 4; ++m)
#pragma unroll
                for (int n = 0; n < 2; ++n) acc[a][b][m][n] = (f32x4){0.f, 0.f, 0.f, 0.f};
    int sc8 = 0x7f7f7f7f; asm volatile("" : "+v"(sc8));
    bf16x8 At[4][2], B0[2][2], B1[2][2]; i32x8v At8[4], B08[2], B18[2];
    const char* cA = (const char*)g.A + (size_t)cur.pm * tstep; const char* cB = (const char*)g.Bt + (size_t)cur.pn * tstep;
    S.a_ready(cur);
    if constexpr (SP2) {
        PG8_STAGE(PG8_SB(0, 0), cB, voffB); PG8_STAGE(PG8_SB(0, 1), cB + hstep, voffB); PG8_STAGE(PG8_SA(0, 0), cA, voffA); PG8_STAGE(PG8_SA(0, 1), cA + hstep, voffA);
        if (wr == 1) PG8_BAR;
        PG8_WAIT_V(2); PG8_BAR;
        PG8_STAGE(PG8_SB(1, 0), cB + kstep, voffB); PG8_STAGE(PG8_SA(1, 0), cA + kstep, voffA); PG8_STAGE(PG8_SB(1, 1), cB + hstep + kstep, voffB);
        PG8_WAIT_V(6); PG8_BAR;
    } else {
        PG8_STAGE(PG8_SB(0, 0), cB, voffB); PG8_STAGE(PG8_SA(0, 0), cA, voffA); PG8_STAGE(PG8_SB(0, 1), cB + hstep, voffB); PG8_STAGE(PG8_SA(0, 1), cA + hstep, voffA);
        if (wr == 1) PG8_BAR;
        PG8_WAIT_V(4); PG8_BAR;
        PG8_STAGE(PG8_SB(1, 0), cB + kstep, voffB); PG8_STAGE(PG8_SA(1, 0), cA + kstep, voffA); PG8_STAGE(PG8_SB(1, 1), cB + hstep + kstep, voffB);
        PG8_WAIT_V(6); PG8_BAR;
    }
    for (;;) {
        const bool has_next = S.next(ui + 1, nxt);
        const char* nA = has_next ? (const char*)g.A + (size_t)nxt.pm * tstep : cA; const char* nB = has_next ? (const char*)g.Bt + (size_t)nxt.pn * tstep : cB;
        for (int t = 0; t < nt; t += 2) {
            const bool last = (t == nt - 2);
            const char* a1 = cA + (size_t)(t + 1) * kstep;
            const char* a2 = last ? nA : cA + (size_t)(t + 2) * kstep; const char* b2 = last ? nB : cB + (size_t)(t + 2) * kstep;
            const char* a3 = a2 + kstep; const char* b3 = b2 + kstep;
            if (last && has_next) S.a_ready(nxt);
            if constexpr (SP2) {
            PG8_LDB(B0, 0, 0); PG8_LDB(B1, 0, 1); PG8_SCHED; PG8_LDA(At, 0, 0); PG8_STAGE(PG8_SA(1, 1), a1 + hstep, voffA);
            PG8_WAIT_V(8); PG8_WAIT_L(0); PG8_BAR; PG8_MMA(0, 0, At, B0); PG8_MMA(0, 1, At, B1); PG8_BAR; PG8_SCHED;
            PG8_LDA(At, 0, 1); PG8_STAGE(PG8_SB(0, 0), b2, voffB); PG8_STAGE(PG8_SB(0, 1), b2 + hstep, voffB); PG8_STAGE(PG8_SA(0, 0), a2, voffA);
            PG8_WAIT_V(8); PG8_WAIT_L(0); PG8_BAR; PG8_MMA(1, 0, At, B0); PG8_MMA(1, 1, At, B1); PG8_BAR; PG8_SCHED;
            PG8_LDB(B0, 1, 0); PG8_LDB(B1, 1, 1); PG8_SCHED; PG8_LDA(At, 1, 0); PG8_STAGE(PG8_SA(0, 1), a2 + hstep, voffA);
            PG8_WAIT_V(8); PG8_WAIT_L(0); PG8_BAR; PG8_MMA(0, 0, At, B0); PG8_MMA(0, 1, At, B1); PG8_BAR; PG8_SCHED;
            PG8_LDA(At, 1, 1); PG8_STAGE(PG8_SB(1, 0), b3, voffB); PG8_STAGE(PG8_SB(1, 1), b3 + hstep, voffB); PG8_STAGE(PG8_SA(1, 0), a3, voffA);
            PG8_WAIT_V(8); PG8_WAIT_L(0); PG8_BAR; PG8_MMA(1, 0, At, B0); PG8_MMA(1, 1, At, B1); PG8_BAR; PG8_SCHED;
            } else {
            PG8_LDB(B0, 0, 0); PG8_SCHED; PG8_LDA(At, 0, 0); PG8_STAGE(PG8_SA(1, 1), a1 + hstep, voffA);
            PG8_WAIT_L(8); PG8_BAR; PG8_WAIT_L(0); PG8_MMA(0, 0, At, B0); PG8_BAR; PG8_SCHED;
            PG8_LDB(B1, 0, 1); PG8_STAGE(PG8_SB(0, 0), b2, voffB);
            PG8_BAR; PG8_WAIT_L(0); PG8_MMA(0, 1, At, B1); PG8_BAR;
            PG8_LDA(At, 0, 1); PG8_STAGE(PG8_SA(0, 0), a2, voffA);
            PG8_BAR; PG8_WAIT_L(0); PG8_MMA(1, 0, At, B0); PG8_BAR; PG8_SCHED;
            PG8_STAGE(PG8_SB(0, 1), b2 + hstep, voffB);
            PG8_WAIT_V(6); PG8_BAR; PG8_MMA(1, 1, At, B1); PG8_BAR;
            PG8_LDB(B0, 1, 0); PG8_SCHED; PG8_LDA(At, 1, 0); PG8_STAGE(PG8_SA(0, 1), a2 + hstep, voffA);
            PG8_WAIT_L(8); PG8_BAR; PG8_WAIT_L(0); PG8_MMA(0, 0, At, B0); PG8_BAR; PG8_SCHED;
            PG8_LDB(B1, 1, 1); PG8_STAGE(PG8_SB(1, 0), b3, voffB);
            PG8_BAR; PG8_WAIT_L(0); PG8_MMA(0, 1, At, B1); PG8_BAR;
            PG8_LDA(At, 1, 1); PG8_STAGE(PG8_SA(1, 0), a3, voffA);
            PG8_BAR; PG8_WAIT_L(0); PG8_MMA(1, 0, At, B0); PG8_BAR; PG8_SCHED;
            PG8_STAGE(PG8_SB(1, 1), b3 + hstep, voffB);
            PG8_WAIT_V(6); PG8_BAR; PG8_MMA(1, 1, At, B1); PG8_BAR;
            }
        }
        if constexpr (FP8) asm volatile("s_nop 15\n\ts_nop 15" ::: "memory");
        if constexpr (ALIGN_EPI) { if (wr == 0) PG8_BAR; }
        if constexpr (!Epi::AFTER_DRAIN) { E(acc, cur, wr, wc, fr, fq); S.done(cur); }
        if (!has_next) break;
#pragma unroll
        for (int a = 0; a < 2; ++a)
#pragma unroll
            for (int b = 0; b < 2; ++b)
#pragma unroll
                for (int m = 0; m < 4; ++m)
#pragma unroll
                    for (int n = 0; n < 2; ++n) acc[a][b][m][n] = (f32x4){0.f, 0.f, 0.f, 0.f};
        cur = nxt; cA = nA; cB = nB; ++ui;
        if constexpr (ALIGN_EPI) { if (wr == 1) PG8_BAR; }
    }
    PG8_WAIT_V(0);
    if constexpr (!ALIGN_EPI) { if (wr == 0) PG8_BAR; }
    PG8_BAR;
    if constexpr (Epi::AFTER_DRAIN) { E.fused(acc, cur, wr, wc, fr, fq, lds, wid, lane); S.done(cur); }
#undef PG8_SA
#undef PG8_SB
#undef PG8_STAGE
#undef PG8_LDA
#undef PG8_LDB
#undef PG8_MMA
#undef PG8_RD8
#undef PG8_WAIT_V
#undef PG8_WAIT_L
#undef PG8_BAR
#undef PG8_SCHED
}
}
namespace att {
typedef unsigned short bf16;
constexpr int   D = 128, NW = 8, QBLK = 32, KVBLK = 64;
constexpr float SCALE = 0.088388347648318440f;
constexpr float THR = 8.f;
constexpr int SDEPTH = 2;
constexpr int LDQ = 1024, LDK = 256, LDO = 1024;
constexpr size_t SHM_V = KVBLK * D * 2, SHM_K = KVBLK * D * 2, SHM_ATTN = 2 * SHM_V + 2 * SHM_K + NW * 64 * 4;
using bf16x8 = __attribute__((ext_vector_type(8))) short;
using s16x4  = __attribute__((ext_vector_type(4))) short;
using f32x16 = __attribute__((ext_vector_type(16))) float;
using f32x8  = __attribute__((ext_vector_type(8))) float;
using u32x4  = __attribute__((ext_vector_type(4))) unsigned;
#define KSWZ(row, colB) ((row) * 256 + ((colB) ^ (((row) & 7) << 4)))
#define SBAR() __builtin_amdgcn_sched_barrier(0)
__device__ __forceinline__ int crow(int r, int hi) { return (r & 3) + 8 * (r >> 2) + 4 * hi; }
__device__ __forceinline__ unsigned cvtpk(float lo, float hi) { return pg8::cvt_pk_bf16(lo, hi); }
template <typename TIn> struct Stage;
template <> struct Stage<bf16>  { using T = bf16x8;
  __device__ static __forceinline__ T ld8(const bf16* p) { return *reinterpret_cast<const bf16x8*>(p); }
  __device__ static __forceinline__ bf16x8 tobf(T x) { return x; } };
template <> struct Stage<float> { using T = f32x8;
  __device__ static __forceinline__ T ld8(const float* p) { return *reinterpret_cast<const f32x8*>(p); }
  __device__ static __forceinline__ bf16x8 tobf(T x) {
    u32x4 w = {cvtpk(x[0], x[1]), cvtpk(x[2], x[3]), cvtpk(x[4], x[5]), cvtpk(x[6], x[7])}; return *reinterpret_cast<bf16x8*>(&w); } };

__device__ __forceinline__ void partialSM(f32x16& p0, f32x16& p1, float& m_reg, float& mn, float& alpha) {
  constexpr float C = SCALE * 1.4426950408889634f;
  float pmax = p0[0]; for (int r = 1; r < 16; ++r) pmax = fmaxf(pmax, p0[r]); for (int r = 0; r < 16; ++r) pmax = fmaxf(pmax, p1[r]);
  { auto rr = __builtin_amdgcn_permlane32_swap(__float_as_uint(pmax), __float_as_uint(pmax), false, false);
    pmax = fmaxf(__uint_as_float(rr[0]), __uint_as_float(rr[1])); }
  if (__builtin_expect(__all(pmax - m_reg <= THR / SCALE), 1)) { mn = m_reg; alpha = 1.f; }
  else { mn = fmaxf(m_reg, pmax); alpha = __builtin_amdgcn_exp2f((m_reg - mn) * C); m_reg = mn; }
  float mnC = -mn * C;
  for (int r = 0; r < 16; ++r) p0[r] = fmaf(p0[r], C, mnC); for (int r = 0; r < 16; ++r) p1[r] = fmaf(p1[r], C, mnC);
  for (int r = 0; r < 16; ++r) p0[r] = __builtin_amdgcn_exp2f(p0[r]);
}
__device__ __forceinline__ void finishSM(f32x16& p0, f32x16& p1, float alpha, float& l_reg, bf16x8& pa0, bf16x8& pa1, bf16x8& pa2, bf16x8& pa3) {
  for (int r = 0; r < 16; ++r) p1[r] = __builtin_amdgcn_exp2f(p1[r]);
  float ps = 0; for (int r = 0; r < 16; ++r) ps += p0[r]; for (int r = 0; r < 16; ++r) ps += p1[r];
  { auto rr = __builtin_amdgcn_permlane32_swap(__float_as_uint(ps), __float_as_uint(ps), false, false);
    ps = __uint_as_float(rr[0]) + __uint_as_float(rr[1]); }
  l_reg = l_reg * alpha + ps;
#define PK4(P, BASE, OUT) do { unsigned a0 = cvtpk(P[BASE + 0], P[BASE + 1]), a1 = cvtpk(P[BASE + 2], P[BASE + 3]);   \
    unsigned b0 = cvtpk(P[BASE + 4], P[BASE + 5]), b1 = cvtpk(P[BASE + 6], P[BASE + 7]);                              \
    auto r0 = __builtin_amdgcn_permlane32_swap(a0, b0, false, false); auto r1 = __builtin_amdgcn_permlane32_swap(a1, b1, false, false); \
    u32x4 w = {r0[0], r1[0], r0[1], r1[1]}; OUT = *reinterpret_cast<bf16x8*>(&w); } while (0)
  PK4(p0, 0, pa0); PK4(p0, 8, pa1); PK4(p1, 0, pa2); PK4(p1, 8, pa3);
#undef PK4
}
__device__ __forceinline__ void qkt(f32x16& p0, f32x16& p1, const bf16* Ks, const bf16x8* qr, int r32, int hi) {
  p0 = f32x16{}; p1 = f32x16{};
  for (int d0 = 0; d0 < 8; ++d0) { int cb = (d0 * 16 + hi * 8) * 2;
    bf16x8 b0 = *reinterpret_cast<const bf16x8*>((const char*)Ks + KSWZ(r32, cb));
    bf16x8 b1 = *reinterpret_cast<const bf16x8*>((const char*)Ks + KSWZ(32 + r32, cb));
    p0 = __builtin_amdgcn_mfma_f32_32x32x16_bf16(b0, qr[d0], p0, 0, 0, 0);
    p1 = __builtin_amdgcn_mfma_f32_32x32x16_bf16(b1, qr[d0], p1, 0, 0, 0); }
}
__device__ __forceinline__ int v_st(int k, int c) { const int kk = (k & ~0xC) | ((k & 4) << 1) | ((k & 8) >> 1); return ((kk >> 3) * 4 + (c >> 5)) * 512 + ((kk & 7) * 32 + (c & 31)) * 2; }
__device__ __forceinline__ int v_rd_base(int lane) { return ((lane & 3) << 3) | (((lane >> 2) & 3) << 6) | (((lane >> 4) & 1) << 5) | (((lane >> 5) & 1) << 8); }
constexpr int v_rd_off(int d0, int ks, int half) { return d0 * 512 + ks * 4096 + half * 2048; }
template <int OFF> __device__ __forceinline__ s16x4 tr_read(int vb) {
  s16x4 r; asm volatile("ds_read_b64_tr_b16 %0, %1 offset:%2" : "=&v"(r) : "v"(vb), "i"(OFF) : "memory"); return r;
}
template <int D0> __device__ __forceinline__ void pv_one(f32x16& od, int vb, bf16x8 pa0, bf16x8 pa1, bf16x8 pa2, bf16x8 pa3) {
  const s16x4 l0 = tr_read<v_rd_off(D0, 0, 0)>(vb), h0 = tr_read<v_rd_off(D0, 0, 1)>(vb), l1 = tr_read<v_rd_off(D0, 1, 0)>(vb), h1 = tr_read<v_rd_off(D0, 1, 1)>(vb);
  const s16x4 l2 = tr_read<v_rd_off(D0, 2, 0)>(vb), h2 = tr_read<v_rd_off(D0, 2, 1)>(vb), l3 = tr_read<v_rd_off(D0, 3, 0)>(vb), h3 = tr_read<v_rd_off(D0, 3, 1)>(vb);
  asm volatile("s_waitcnt lgkmcnt(0)" ::: "memory"); SBAR();
#define PK(L, H) (bf16x8){L[0], L[1], L[2], L[3], H[0], H[1], H[2], H[3]}
  od = __builtin_amdgcn_mfma_f32_32x32x16_bf16(pa0, PK(l0, h0), od, 0, 0, 0);
  od = __builtin_amdgcn_mfma_f32_32x32x16_bf16(pa1, PK(l1, h1), od, 0, 0, 0);
  od = __builtin_amdgcn_mfma_f32_32x32x16_bf16(pa2, PK(l2, h2), od, 0, 0, 0);
  od = __builtin_amdgcn_mfma_f32_32x32x16_bf16(pa3, PK(l3, h3), od, 0, 0, 0);
#undef PK
}
__device__ __forceinline__ void pv_d0(f32x16* o, int vb, bf16x8 pa0, bf16x8 pa1, bf16x8 pa2, bf16x8 pa3) {
  pv_one<0>(o[0], vb, pa0, pa1, pa2, pa3); pv_one<1>(o[1], vb, pa0, pa1, pa2, pa3); pv_one<2>(o[2], vb, pa0, pa1, pa2, pa3); pv_one<3>(o[3], vb, pa0, pa1, pa2, pa3);
}

template <typename TQ>
__device__ __forceinline__ void attn_dense_body(const TQ* __restrict__ Qb, const bf16* __restrict__ Kh, const bf16* __restrict__ Vh,
                                                unsigned char* __restrict__ Ob, int seq, char* lds, const int tid_in) {
  using St = Stage<bf16>; using SQ = Stage<TQ>;
  int tid_ = tid_in; asm volatile("" : "+v"(tid_));
  const int tid = tid_, wid = tid >> 6, lane = tid & 63, r32 = lane & 31, hi = lane >> 5;
  bf16* V_lds = (bf16*)lds; bf16* K_lds = (bf16*)(lds + 2 * SHM_V);
  float* ws = (float*)(lds + 2 * SHM_V + 2 * SHM_K) + wid * 64; float* li_l = ws; float* al_l = ws + 32;
  float m_reg = -1e30f, l_reg = 0; f32x16 o[4] = {}; bf16x8 qr[8];
  const TQ* Qw = Qb + (long)(wid * QBLK + r32) * LDQ + hi * 8;
#pragma unroll
  for (int d0 = 0; d0 < 8; ++d0) qr[d0] = SQ::tobf(SQ::ld8(Qw + d0 * 16));
  const int sr = tid >> 4, sc = (tid & 15) * 8, vst0 = v_st(sr, sc), vst1 = v_st(32 + sr, sc);
  const int vb0 = (int)(uintptr_t)V_lds + v_rd_base(lane);
  struct { typename St::T vs0, vs1, ks0, ks1; } sr_[SDEPTH];
#define SLOAD(i, k0) do { sr_[i].vs0 = St::ld8(&Vh[(long)((k0) + sr) * LDK + sc]); sr_[i].vs1 = St::ld8(&Vh[(long)((k0) + 32 + sr) * LDK + sc]); \
    sr_[i].ks0 = St::ld8(&Kh[(long)((k0) + sr) * LDK + sc]); sr_[i].ks1 = St::ld8(&Kh[(long)((k0) + 32 + sr) * LDK + sc]); } while (0)
#define SWRITE(b, i) do { *(bf16x8*)((char*)V_lds + (b) * SHM_V + vst0) = St::tobf(sr_[i].vs0);          \
    *(bf16x8*)((char*)V_lds + (b) * SHM_V + vst1) = St::tobf(sr_[i].vs1); int kc = sc * 2;               \
    *(bf16x8*)((char*)K_lds + (b) * SHM_K + KSWZ(sr, kc)) = St::tobf(sr_[i].ks0);                       \
    *(bf16x8*)((char*)K_lds + (b) * SHM_K + KSWZ(32 + sr, kc)) = St::tobf(sr_[i].ks1); } while (0)
#define SWAIT() do { if constexpr (SDEPTH == 2) asm volatile("s_waitcnt vmcnt(4)" ::: "memory"); else asm volatile("s_waitcnt vmcnt(0)" ::: "memory"); } while (0)
#define RESC(a) do { if (__any((a) < 1.f)) { if (hi == 0) al_l[r32] = (a); asm volatile("s_waitcnt lgkmcnt(0)" ::: "memory"); \
    for (int d = 0; d < 4; ++d) for (int r = 0; r < 16; ++r) o[d][r] *= al_l[crow(r, hi)]; } } while (0)
  f32x16 pA0, pA1, pB0, pB1; float mnA, mnB, alA, alB; bf16x8 pa0, pa1, pa2, pa3; const int NT = seq / KVBLK;
  constexpr int SE = 0, SO = SDEPTH - 1;
  SLOAD(SE, 0); asm volatile("s_waitcnt vmcnt(0)" ::: "memory"); SWRITE(0, SE); __syncthreads();
  qkt(pA0, pA1, K_lds, qr, r32, hi); partialSM(pA0, pA1, m_reg, mnA, alA);
  SLOAD(SO, KVBLK); if constexpr (SDEPTH == 2) { if (2 < NT) SLOAD(SE, 2 * KVBLK); }
  SWAIT(); SWRITE(1, SO); __syncthreads();
  for (int j = 1; j + 1 < NT; j += 2) {
    SBAR(); qkt(pB0, pB1, (bf16*)((char*)K_lds + SHM_K), qr, r32, hi);
    finishSM(pA0, pA1, alA, l_reg, pa0, pa1, pa2, pa3); SBAR();
    SLOAD(SO, (j + SDEPTH) * KVBLK); SBAR();
    pv_d0(o, vb0, pa0, pa1, pa2, pa3); partialSM(pB0, pB1, m_reg, mnB, alB);
    __syncthreads(); SWAIT(); SWRITE(0, SE);
    RESC(alB); __syncthreads();
    SBAR(); qkt(pA0, pA1, K_lds, qr, r32, hi);
    finishSM(pB0, pB1, alB, l_reg, pa0, pa1, pa2, pa3); SBAR();
    if (SDEPTH == 1 || j + 3 < NT) SLOAD(SE, (j + 1 + SDEPTH) * KVBLK); SBAR();
    pv_d0(o, vb0 + (int)SHM_V, pa0, pa1, pa2, pa3); partialSM(pA0, pA1, m_reg, mnA, alA);
    __syncthreads(); SWAIT(); SWRITE(1, SO);
    RESC(alA); __syncthreads();
  }
  SBAR(); qkt(pB0, pB1, (bf16*)((char*)K_lds + SHM_K), qr, r32, hi);
  finishSM(pA0, pA1, alA, l_reg, pa0, pa1, pa2, pa3); SBAR();
  pv_d0(o, vb0, pa0, pa1, pa2, pa3); partialSM(pB0, pB1, m_reg, mnB, alB);
  __syncthreads(); RESC(alB);
  finishSM(pB0, pB1, alB, l_reg, pa0, pa1, pa2, pa3); SBAR();
  pv_d0(o, vb0 + (int)SHM_V, pa0, pa1, pa2, pa3);
  if (hi == 0) li_l[r32] = l_reg; asm volatile("s_waitcnt lgkmcnt(0)" ::: "memory");
  float rli[16];
#pragma unroll
  for (int r = 0; r < 16; ++r) rli[r] = __builtin_amdgcn_rcpf(li_l[crow(r, hi)]);
  unsigned char* Ow = Ob + (long)(wid * QBLK) * LDO;
#pragma unroll
  for (int r = 0; r < 16; ++r) { int orow = crow(r, hi);
    for (int d0 = 0; d0 < 4; ++d0) { const float ov = o[d0][r] * rli[r] * 64.0f; Ow[(long)orow * LDO + d0 * 32 + r32] = (unsigned char)(__builtin_amdgcn_cvt_pk_fp8_f32(ov, ov, __builtin_bit_cast(int, ov), false) & 0xff); } }
#undef SLOAD
#undef SWRITE
#undef SWAIT
#undef RESC
}
#undef KSWZ
#undef SBAR
}

#define GAS __attribute__((address_space(1)))
#define LAS __attribute__((address_space(3)))
typedef unsigned short bf16;
typedef unsigned v4u __attribute__((ext_vector_type(4)));
typedef float f32x4 __attribute__((ext_vector_type(4)));
typedef short bf16x8 __attribute__((ext_vector_type(8)));
typedef GAS unsigned gu32;
typedef GAS unsigned long long gu64;
#define RLX_AGENT __ATOMIC_RELAXED, __HIP_MEMORY_SCOPE_AGENT
#define LDS_WAIT() asm volatile("s_waitcnt lgkmcnt(0)" ::: "memory")
#define VM_WAIT() asm volatile("s_waitcnt vmcnt(0)" ::: "memory")
__device__ __forceinline__ unsigned long long rt() { return __builtin_amdgcn_s_memrealtime(); }
__device__ __forceinline__ unsigned f2bf(float f) { unsigned u = __builtin_bit_cast(unsigned, f); return (u + 0x7fffu + ((u >> 16) & 1u)) >> 16; }
__device__ __forceinline__ unsigned pk2(float lo, float hi) { return f2bf(lo) | (f2bf(hi) << 16); }

#define XB_TMO      128
#define XB_XCNT(j)  (256  + 64 * (j))
#define XB_XSUB(j)  (1280 + 64 * (j))
#define XB_XGEN(j)  (2304 + 64 * (j))
#define XB_TOP      3328
#define XB_TOPGEN   3392
#define XCD_BAR_WORDS 3456
#define XB_SPIN_CAP (1u << 18)

__device__ __forceinline__ unsigned xb_ld(unsigned* p)              { return __hip_atomic_load(p, __ATOMIC_RELAXED, __HIP_MEMORY_SCOPE_AGENT); }
__device__ __forceinline__ unsigned xb_add(unsigned* p, unsigned v) { return __hip_atomic_fetch_add(p, v, __ATOMIC_RELAXED, __HIP_MEMORY_SCOPE_AGENT); }
__device__ __forceinline__ unsigned xb_xcc_id() { return (unsigned)__builtin_amdgcn_s_getreg((3 << 11) | 20) & 0xFu; }
#define XB_SPIN(cond, bar) do { unsigned _sp = 0; while (cond) { __builtin_amdgcn_s_sleep(1); \
    if ((++_sp & 255u) == 0u) { if (xb_ld(&(bar)[XB_TMO])) break; if (_sp > XB_SPIN_CAP) { atomicAdd(&(bar)[XB_TMO], 1u); break; } } } } while (0)

struct XcdBarrier {
    unsigned* bar; unsigned x;
    volatile LAS unsigned* st;
};

__device__ __forceinline__ XcdBarrier xcd_barrier_post(unsigned* bar, volatile LAS unsigned* st) {
    XcdBarrier b; b.bar = bar; b.x = xb_xcc_id(); b.st = st;
    if (threadIdx.x == 0) (void)xb_add(&bar[XB_XCNT(b.x)], 1u);
    return b;
}
__device__ __forceinline__ void xcd_barrier_complete(unsigned* bar, unsigned x, unsigned& nloc, unsigned& nx) {
    const unsigned G = gridDim.x * gridDim.y * gridDim.z;
    unsigned sum, cnt, mine, sp = 0u;
    for (;;) {
        sum = 0u; cnt = 0u; mine = 0u;
#pragma unroll
        for (unsigned j = 0; j < 16; ++j) { const unsigned c = xb_ld(&bar[XB_XCNT(j)]); sum += c; cnt += (c > 0u) ? 1u : 0u; mine = (j == x) ? c : mine; }
        if (sum == G) break;
        __builtin_amdgcn_s_sleep(1);
        if ((++sp & 255u) == 0u) { if (xb_ld(&bar[XB_TMO])) break; if (sp > XB_SPIN_CAP) { atomicAdd(&bar[XB_TMO], 1u); break; } }
    }
    nloc = mine > 0u ? mine : 1u; nx = cnt > 0u ? cnt : 1u;
}

__device__ __forceinline__ void xcd_barrier(const XcdBarrier& b) {
    asm volatile("s_waitcnt vmcnt(0)" ::: "memory");
    __syncthreads();
    if (threadIdx.x == 0) {
        unsigned* bar = b.bar;
        __builtin_amdgcn_s_waitcnt(0);
        unsigned nloc = b.st[0], nx = b.st[1];
        if (nloc == 0u) { xcd_barrier_complete(bar, b.x, nloc, nx); b.st[0] = nloc; b.st[1] = nx; }
        const unsigned old = xb_add(&bar[XB_XSUB(b.x)], 1u);
        const unsigned gen = old / nloc;
        if (old + 1u == (gen + 1u) * nloc) {
            __builtin_amdgcn_fence(__ATOMIC_RELEASE, "agent");
            asm volatile("s_waitcnt vmcnt(0)" ::: "memory");
            const unsigned og = xb_add(&bar[XB_TOP], 1u);
            const unsigned tg = og / nx;
            if (og + 1u == (tg + 1u) * nx) xb_add(&bar[XB_TOPGEN], 1u);
            else XB_SPIN(xb_ld(&bar[XB_TOPGEN]) == tg, bar);
            __builtin_amdgcn_fence(__ATOMIC_ACQUIRE, "agent");
            xb_add(&bar[XB_XGEN(b.x)], 1u);
            asm volatile("s_waitcnt vmcnt(0)" ::: "memory");
        } else {
            XB_SPIN(xb_ld(&bar[XB_XGEN(b.x)]) == gen, bar);
            __builtin_amdgcn_fence(__ATOMIC_ACQUIRE, "agent");
            asm volatile("s_waitcnt vmcnt(0)" ::: "memory");
        }
    }
    __syncthreads();
}
constexpr int DM = 1024, NB = 16, SEQ = 2048, CTXL = 256, TL = NB * SEQ, TC = NB * CTXL, TALL = TL + TC;
constexpr int INCOLS = 6144, OFF_FNET = 2560, OFF_GATE = 3072;
constexpr int NEXP = 32, KVROWS = SEQ + CTXL;
constexpr float EPS = 1e-6f;
constexpr int NWAVES = 8, NTHR = NWAVES * 64;
constexpr int NPL = 11, NPH = 2 + 2 * NPL;
#ifndef MK_PER_PHASE
#define MK_PER_PHASE 0
#endif
constexpr size_t MiB = 1u << 20;
constexpr size_t WS_CTL = 0, CTL_ZERO_BYTES = 1 * MiB;
constexpr size_t WS_MOD = 1 * MiB;
constexpr size_t WS_TAB = 2 * MiB;
constexpr size_t WS_TOPI = 3 * MiB, WS_TOPP = 4 * MiB, WS_SLOT = 5 * MiB, WS_CNT = 6 * MiB;
constexpr size_t WS_LOGIT = 7 * MiB;
constexpr size_t WS_WSMALL = 17 * MiB, WSMALL_LAYER = 20 * MiB;
constexpr size_t OFFS_WIN = 0, OFFS_WF = 5 * MiB, OFFS_WG = 7 * MiB, OFFS_WAO = 13 * MiB, OFFS_WCO = 15 * MiB, OFFS_WFO = 16 * MiB, OFFS_WOUT = 17 * MiB, OFFS_ROUT = 19 * MiB;
constexpr size_t WS_DFTL = 57 * MiB, WS_DFTC = 73 * MiB;
constexpr size_t WS_XC = 74 * MiB;
constexpr size_t WS_H = 90 * MiB;
constexpr size_t WS_WGU = 162 * MiB, WS_WD = 226 * MiB, MOEW_LAYER = 96 * MiB;
constexpr size_t WS_BIG = 354 * MiB;
constexpr size_t WS_Q = WS_BIG, WS_K = WS_Q + 72 * MiB, WS_V = WS_K + 18 * MiB, WS_CU = WS_V + 18 * MiB, WS_YT = WS_CU + 36 * MiB, WS_YTC = WS_YT + 64 * MiB;
constexpr size_t WS_GATES = WS_BIG;
constexpr size_t WS_AO = WS_BIG + 216 * MiB, WS_CH = WS_AO + 72 * MiB, WS_Z = WS_CH + 36 * MiB;
constexpr size_t WS_MIX = WS_AO;
constexpr size_t WS_MERGED = WS_BIG + 360 * MiB;
constexpr int SLOT_ROWS = 608 * 256;
constexpr size_t WS_YS = WS_BIG, WS_HS = WS_BIG + 304 * MiB, WS_ACT = WS_BIG + 456 * MiB, WS_END = WS_BIG + 608 * MiB;
constexpr size_t WS_H8 = WS_END;
constexpr size_t WS_END2 = WS_END + 36 * MiB;
static_assert(WS_YTC + 8 * MiB == WS_AO && WS_Z + 36 * MiB == WS_MERGED && WS_MERGED + 72 * MiB <= WS_END && (size_t)SLOT_ROWS * 2048 == 304 * MiB, "ws map");
constexpr int CW_TMO = 0, CW_CODE = 1, CW_BAR = 4096;
constexpr int CNT_TILE_E = 16384, CNT_NT = 16384 + 1024;

constexpr int RING_OFF = 0, RING_BYTES = 131072;
constexpr int LDSCTL_OFF = RING_BYTES, MISC_OFF = LDSCTL_OFF + 320, LDS_CT = LDSCTL_OFF + 512, LDS_SM = LDSCTL_OFF + 1024;
constexpr int LDS_BYTES = 155648;

typedef unsigned u32x2 __attribute__((ext_vector_type(2)));
typedef int i32x4 __attribute__((ext_vector_type(4)));
typedef float f32x2 __attribute__((ext_vector_type(2)));
struct Args { const float* in[29]; float* out; unsigned char* ws; int ph_lo, ph_hi; };
typedef const __attribute__((address_space(4))) unsigned char* kptr_t;
struct AV {
    kptr_t kp;
    __device__ __forceinline__ const float* in(int i) const { return *(const float* const __attribute__((address_space(4)))*)(kp + 8 * i); }
    __device__ __forceinline__ float* out() const { return *(float* const __attribute__((address_space(4)))*)(kp + 8 * 29); }
    __device__ __forceinline__ unsigned char* ws() const { return *(unsigned char* const __attribute__((address_space(4)))*)(kp + 8 * 30); }
};
__device__ __forceinline__ AV av_get() { AV a; a.kp = (kptr_t)__builtin_amdgcn_kernarg_segment_ptr(); asm volatile("" : "+s"(a.kp)); return a; }

struct Frame {
    LAS unsigned char* lds; volatile LAS unsigned* MISC; gu32* ctl;
    int tid, lane, wave, vcu, G;
};

__device__ __forceinline__ float shx(float v, int m, int lane) { return __int_as_float(__builtin_amdgcn_ds_bpermute((lane ^ m) << 2, __float_as_int(v))); }
__device__ __forceinline__ float wave_sum(float v, int lane) {
#pragma unroll
    for (int o = 1; o < 64; o <<= 1) v += shx(v, o, lane);
    return v;
}
__device__ __forceinline__ float sigmoidf_(float x) { return 1.0f / (1.0f + __expf(-x)); }
__device__ __forceinline__ f32x4 bf4(u32x2 w) { f32x4 r; r[0] = __uint_as_float(w.x << 16); r[1] = __uint_as_float(w.x & 0xffff0000u); r[2] = __uint_as_float(w.y << 16); r[3] = __uint_as_float(w.y & 0xffff0000u); return r; }
__device__ __forceinline__ u32x2 pk4(f32x4 v) { u32x2 w; w.x = pk2(v[0], v[1]); w.y = pk2(v[2], v[3]); return w; }
__device__ __forceinline__ void ld_row_f32(f32x4 (&v)[4], const float* p, int lane) {
#pragma unroll
    for (int j = 0; j < 4; ++j) v[j] = ((const GAS f32x4*)p)[lane + 64 * j];
}
__device__ __forceinline__ void st_row_f32(const f32x4 (&v)[4], float* p, int lane) {
#pragma unroll
    for (int j = 0; j < 4; ++j) ((GAS f32x4*)p)[lane + 64 * j] = v[j];
}
__device__ __forceinline__ void ld_row_bf16(f32x4 (&v)[4], const bf16* p, int lane) {
#pragma unroll
    for (int j = 0; j < 4; ++j) v[j] = bf4(((const GAS u32x2*)p)[lane + 64 * j]);
}
__device__ __forceinline__ void st_row_bf16(const f32x4 (&v)[4], bf16* p, int lane) {
#pragma unroll
    for (int j = 0; j < 4; ++j) ((GAS u32x2*)p)[lane + 64 * j] = pk4(v[j]);
}
__device__ __forceinline__ void rms_gain(f32x4 (&v)[4], const float* g, int lane) {
    float ss = 0.f;
#pragma unroll
    for (int j = 0; j < 4; ++j) ss += (v[j][0] * v[j][0] + v[j][1] * v[j][1]) + (v[j][2] * v[j][2] + v[j][3] * v[j][3]);
    const float r = 1.0f / sqrtf(wave_sum(ss, lane) * (1.0f / 1024.0f) + EPS);
#pragma unroll
    for (int j = 0; j < 4; ++j) { const f32x4 gg = ((const GAS f32x4*)g)[lane + 64 * j]; v[j] = v[j] * r * gg; }
}
__device__ __forceinline__ void modulate_store(const f32x4 (&v)[4], const float* shift, const float* scale, bf16* o, int lane) {
#pragma unroll
    for (int j = 0; j < 4; ++j) { const f32x4 sh = ((const GAS f32x4*)shift)[lane + 64 * j], sc = ((const GAS f32x4*)scale)[lane + 64 * j];
        ((GAS u32x2*)o)[lane + 64 * j] = pk4(v[j] * (sc + 1.0f) + sh); }
}
__device__ __forceinline__ unsigned pk4_fp8(f32x4 v) { return pg8::cvt4_fp8(v[0], v[1], v[2], v[3]); }
__device__ __forceinline__ void modulate_store2(const f32x4 (&v)[4], const float* shift, const float* scale, bf16* o, unsigned char* o8, int lane) {
#pragma unroll
    for (int j = 0; j < 4; ++j) { const f32x4 sh = ((const GAS f32x4*)shift)[lane + 64 * j], sc = ((const GAS f32x4*)scale)[lane + 64 * j]; const f32x4 r = v[j] * (sc + 1.0f) + sh;
        ((GAS u32x2*)o)[lane + 64 * j] = pk4(r); ((GAS unsigned*)o8)[lane + 64 * j] = pk4_fp8(r); }
}
__device__ __forceinline__ int krow_of(int m) { return m < TL ? (m >> 11) * KVROWS + (m & 2047) : ((m - TL) >> 8) * KVROWS + SEQ + ((m - TL) & 255); }

__device__ __forceinline__ void load_block(const float* W, int ldw, int k0, int n0, float scale, LAS float* scr, int lane) {
    f32x4 v[8]; const int kr = lane >> 3, c4 = (lane & 7) * 4;
#pragma unroll
    for (int i = 0; i < 8; ++i) v[i] = *(const GAS f32x4*)(W + (size_t)(k0 + kr + 8 * i) * ldw + n0 + c4);
#pragma unroll
    for (int i = 0; i < 8; ++i) { LAS float* d = scr + (kr + 8 * i) * 33 + c4; d[0] = v[i][0] * scale; d[1] = v[i][1] * scale; d[2] = v[i][2] * scale; d[3] = v[i][3] * scale; }
    LDS_WAIT(); asm volatile("" ::: "memory");
}
__device__ __forceinline__ void transpose_item(const float* W, int ldw, int K, bf16* WT, int dst_row0, int k0, int n0, LAS float* scr, int lane) {
    load_block(W, ldw, k0, n0, 1.0f, scr, lane);
    const int c = lane & 7;
#pragma unroll
    for (int j = 0; j < 4; ++j) { const int n = (lane >> 3) + 8 * j; const LAS float* s = scr + (8 * c) * 33 + n;
        v4u o; o.x = pk2(s[0 * 33], s[1 * 33]); o.y = pk2(s[2 * 33], s[3 * 33]); o.z = pk2(s[4 * 33], s[5 * 33]); o.w = pk2(s[6 * 33], s[7 * 33]);
        *(GAS v4u*)(WT + (size_t)(dst_row0 + n) * K + k0 + 8 * c) = o; }
    LDS_WAIT(); asm volatile("" ::: "memory");
}
__device__ __forceinline__ void transpose_item_fp8(const float* W, int ldw, int K, unsigned char* WT, int dst_row0, int k0, int n0, float scale, LAS float* scr, int lane) {
    load_block(W, ldw, k0, n0, scale, scr, lane);
#pragma unroll
    for (int j = 0; j < 2; ++j) { const int q = lane + 64 * j, n = q >> 2, c = q & 3; const LAS float* s = scr + (16 * c) * 33 + n; v4u o;
        o.x = pg8::cvt4_fp8(s[0 * 33], s[1 * 33], s[2 * 33], s[3 * 33]); o.y = pg8::cvt4_fp8(s[4 * 33], s[5 * 33], s[6 * 33], s[7 * 33]); o.z = pg8::cvt4_fp8(s[8 * 33], s[9 * 33], s[10 * 33], s[11 * 33]); o.w = pg8::cvt4_fp8(s[12 * 33], s[13 * 33], s[14 * 33], s[15 * 33]);
        *(GAS v4u*)(WT + (size_t)(dst_row0 + n) * K + k0 + 16 * c) = o; }
    LDS_WAIT(); asm volatile("" ::: "memory");
}
constexpr int IT_S0 = 16 * 80, IT_S1 = 16 * 96, IT_S2 = 512, IT_S3 = 512, IT_S4 = 256, IT_S5 = 256, IT_SMALL = IT_S0 + IT_S1 + IT_S2 + IT_S3 + IT_S4 + IT_S5;
__device__ __forceinline__ void small_item(const AV& a, int l, int r, LAS float* scr, int lane) {
    unsigned char* wl = a.ws() + WS_WSMALL + (size_t)l * WSMALL_LAYER; const float* win = a.in(10) + (size_t)l * DM * INCOLS;
    if (r < IT_S0) { const int kb = r / 80, n0 = (r % 80) * 32; int dr;
        if (n0 < 1536) dr = n0; else { int cc = n0 - 1536; if (cc < 512) dr = 1536 + (cc >> 7) * 256 + (cc & 127); else { cc -= 512; dr = 1536 + (cc >> 7) * 256 + 128 + (cc & 127); } }
        transpose_item_fp8(win, INCOLS, DM, wl + OFFS_WIN, dr, kb * 64, n0, 32.0f, scr, lane); return; }
    r -= IT_S0;
    if (r < IT_S1) { const int kb = r / 96, nb = r % 96; transpose_item_fp8(win, INCOLS, DM, wl + OFFS_WG, nb * 32, kb * 64, OFF_GATE + nb * 32, 32.0f, scr, lane); return; }
    r -= IT_S1;
    if (r < IT_S2) { const int kb = r / 32, nb = r % 32; transpose_item_fp8(a.in(13) + (size_t)l * DM * DM, DM, DM, wl + OFFS_WAO, nb * 32, kb * 64, nb * 32, 32.0f, scr, lane); return; }
    r -= IT_S2;
    if (r < IT_S3) { const int kb = r / 32, nb = r % 32; transpose_item(a.in(20) + (size_t)l * DM * DM, DM, DM, (bf16*)(wl + OFFS_WOUT), nb * 32, kb * 64, nb * 32, scr, lane); return; }
    r -= IT_S3;
    if (r < IT_S4) { const int kb = r / 32, nb = r % 32; transpose_item(a.in(18) + (size_t)l * 512 * DM, DM, 512, (bf16*)(wl + OFFS_WCO), nb * 32, kb * 64, nb * 32, scr, lane); return; }
    r -= IT_S4;
    { const int kb = r / 32, nb = r % 32; transpose_item(a.in(19) + (size_t)l * 512 * DM, DM, 512, (bf16*)(wl + OFFS_WFO), nb * 32, kb * 64, nb * 32, scr, lane); }
}
constexpr int IT_MOE = NEXP * 3 * 512;
struct MoeIt { const float* W; unsigned char* WT; int dr, k0; };
__device__ __forceinline__ MoeIt moe_decode(const AV& a, int gi) {
    const int l = gi / IT_MOE, idx = gi % IT_MOE, e = idx / 1536, r = idx % 1536, which = r / 512, it = r % 512, kb = it / 32, n0 = (it % 32) * 32; const size_t eo = ((size_t)l * NEXP + e) << 20;
    MoeIt m; m.k0 = kb * 64;
    if (which == 0) { m.W = a.in(23) + eo + n0; m.WT = a.ws() + WS_WGU + (size_t)l * MOEW_LAYER + (size_t)e * 2048 * 1024; m.dr = (n0 >> 7) * 256 + (n0 & 127); }
    else if (which == 1) { m.W = a.in(25) + eo + n0; m.WT = a.ws() + WS_WGU + (size_t)l * MOEW_LAYER + (size_t)e * 2048 * 1024; m.dr = (n0 >> 7) * 256 + 128 + (n0 & 127); }
    else { m.W = a.in(27) + eo + n0; m.WT = a.ws() + WS_WD + (size_t)l * MOEW_LAYER + (size_t)e * 1024 * 1024; m.dr = n0; }
    return m;
}
__device__ __forceinline__ void moe_issue(f32x4 (&v)[8], const MoeIt& m, int lane) {
    const float* p = m.W + (size_t)(m.k0 + (lane >> 3)) * DM + (lane & 7) * 4;
#pragma unroll
    for (int i = 0; i < 8; ++i) v[i] = *(const GAS f32x4*)(p + (size_t)(8 * i) * DM);
}
__device__ __forceinline__ void moe_finish(const f32x4 (&v)[8], const MoeIt& m, LAS float* scr, int lane) {
    const int kr = lane >> 3, c4 = (lane & 7) * 4;
#pragma unroll
    for (int i = 0; i < 8; ++i) { LAS float* d = scr + (kr + 8 * i) * 33 + c4; d[0] = v[i][0] * 32.0f; d[1] = v[i][1] * 32.0f; d[2] = v[i][2] * 32.0f; d[3] = v[i][3] * 32.0f; }
    LDS_WAIT(); asm volatile("" ::: "memory");
#pragma unroll
    for (int j = 0; j < 2; ++j) { const int q = lane + 64 * j, n = q >> 2, c = q & 3; const LAS float* s = scr + (16 * c) * 33 + n; v4u o;
        o.x = pg8::cvt4_fp8(s[0 * 33], s[1 * 33], s[2 * 33], s[3 * 33]); o.y = pg8::cvt4_fp8(s[4 * 33], s[5 * 33], s[6 * 33], s[7 * 33]); o.z = pg8::cvt4_fp8(s[8 * 33], s[9 * 33], s[10 * 33], s[11 * 33]); o.w = pg8::cvt4_fp8(s[12 * 33], s[13 * 33], s[14 * 33], s[15 * 33]);
        *(GAS v4u*)(m.WT + (size_t)(m.dr + n) * DM + m.k0 + 16 * c) = o; }
    LDS_WAIT(); asm volatile("" ::: "memory");
}
__device__ __forceinline__ void moe_convert_all(const AV& a, int gw, int NGW, LAS float* scr, int lane) {
    constexpr int NIT = 2 * IT_MOE; f32x4 va[8], vb[8]; int it = gw; if (it >= NIT) return;
    MoeIt ma = moe_decode(a, it), mb = ma; moe_issue(va, ma, lane);
    for (;;) {
        const bool h1 = it + NGW < NIT; if (h1) { mb = moe_decode(a, it + NGW); moe_issue(vb, mb, lane); }
        moe_finish(va, ma, scr, lane); if (!h1) break; it += NGW;
        const bool h2 = it + NGW < NIT; if (h2) { ma = moe_decode(a, it + NGW); moe_issue(va, ma, lane); }
        moe_finish(vb, mb, scr, lane); if (!h2) break; it += NGW;
    }
}
__device__ __forceinline__ void fold_job(const AV& a, int j, const LAS float* ct, int lane) {
    const int l = j >> 10, r = j & 1023, g = r >> 8, kblk = (r >> 4) & 15, k2g = r & 15, k = kblk * 64 + lane;
    const float* wrow = a.in(10) + (size_t)l * DM * INCOLS + (size_t)k * INCOLS + OFF_FNET + g * 128;
    float ac[8], as[8];
#pragma unroll
    for (int i = 0; i < 8; ++i) { ac[i] = 0.f; as[i] = 0.f; }
    for (int n4 = 0; n4 < 32; ++n4) { const f32x4 w = *(const GAS f32x4*)(wrow + n4 * 4);
#pragma unroll
        for (int q = 0; q < 4; ++q) { const int n2 = n4 * 4 + q;
#pragma unroll
            for (int i = 0; i < 8; ++i) { const int ph = (n2 * (k2g * 8 + i)) & 127; ac[i] += w[q] * ct[ph]; as[i] += w[q] * ct[(ph - 32) & 127]; } } }
    bf16* wf = (bf16*)(a.ws() + WS_WSMALL + (size_t)l * WSMALL_LAYER + OFFS_WF);
#pragma unroll
    for (int i = 0; i < 8; ++i) { const int ch = g * 128 + k2g * 8 + i;
        wf[(size_t)ch * 1024 + k] = (bf16)f2bf(ac[i] * 0.08838834764831845f); wf[(size_t)(512 + ch) * 1024 + k] = (bf16)f2bf(as[i] * 0.08838834764831845f); }
}
__device__ __forceinline__ void p0_prologue(const Frame& F, const AV& a) {
    const int gw = F.vcu * NWAVES + F.wave, NGW = F.G * NWAVES, gt = F.vcu * NTHR + F.tid, NGT = F.G * NTHR;
    LAS float* ct = (LAS float*)(F.lds + LDS_CT);
    if (F.tid < 128) ct[F.tid] = cospif((float)F.tid * (1.0f / 64.0f));
    for (int job = blockIdx.x; job < 2 * 96; job += F.G) {
        const int l = job / 96, n0 = (job % 96) * 64;
        LAS float* s = (LAS float*)(F.lds + RING_OFF); LAS float* red = s + 17 * 1024;
        for (int i = F.tid; i < 17 * 1024; i += NTHR) { const int b = i >> 10, k = i & 1023; const float cv = b < 16 ? a.in(1)[b * 1024 + k] : a.in(3)[k]; s[i] = cv * sigmoidf_(cv); }
        __syncthreads();
        const int col = F.tid & 63, ks = F.tid >> 6; float acc[17];
#pragma unroll
        for (int b = 0; b < 17; ++b) acc[b] = 0.f;
        const float* w = a.in(4) + (size_t)l * DM * INCOLS + n0 + col;
        for (int k = ks * 128; k < ks * 128 + 128; k += 16) { float wv[16];
#pragma unroll
            for (int q = 0; q < 16; ++q) wv[q] = w[(size_t)(k + q) * INCOLS];
#pragma unroll
            for (int q = 0; q < 16; ++q)
#pragma unroll
                for (int b = 0; b < 17; ++b) acc[b] += s[b * 1024 + k + q] * wv[q]; }
#pragma unroll
        for (int b = 0; b < 17; ++b) red[(ks * 17 + b) * 64 + col] = acc[b];
        __syncthreads();
        for (int i = F.tid; i < 17 * 64; i += NTHR) { const int b = i >> 6, c2 = i & 63; float t = 0.f;
#pragma unroll
            for (int q = 0; q < 8; ++q) t += red[(q * 17 + b) * 64 + c2];
            ((float*)(a.ws() + WS_MOD))[((size_t)l * 17 + b) * INCOLS + n0 + c2] = t + a.in(5)[l * INCOLS + n0 + c2]; }
        __syncthreads();
    }
    __syncthreads();
    for (int i = gt; i < 64 * 32; i += NGT) { const int p = i >> 5, f = i & 31; const float inv = powf(10000.0f, -(float)f / 32.0f), ang = (float)p * inv; ((f32x2*)(a.ws() + WS_TAB))[i] = (f32x2){cosf(ang), sinf(ang)}; }
    for (int i = gt; i < 2048 * 256; i += NGT) { const int k1 = i >> 8, c0 = (i & 255) * 16; float v[16];
#pragma unroll
        for (int q = 0; q < 16; ++q) { const int col = c0 + q, n1 = col & 2047, rr = (k1 * n1) & 2047; const float x = (float)rr * (1.0f / 1024.0f); v[q] = ((col >> 11) ? -sinpif(x) : cospif(x)) * (32.0f * 0.022097086912079608f); }
        v4u o; o.x = pk4_fp8((f32x4){v[0], v[1], v[2], v[3]}); o.y = pk4_fp8((f32x4){v[4], v[5], v[6], v[7]}); o.z = pk4_fp8((f32x4){v[8], v[9], v[10], v[11]}); o.w = pk4_fp8((f32x4){v[12], v[13], v[14], v[15]}); ((GAS v4u*)(a.ws() + WS_DFTL))[i] = o; }
    for (int i = gt; i < 256 * 32; i += NGT) { const int k1 = i >> 5, c0 = (i & 31) * 16; float v[16];
#pragma unroll
        for (int q = 0; q < 16; ++q) { const int col = c0 + q, n1 = col & 255, rr = (k1 * n1) & 255; const float x = (float)rr * (1.0f / 128.0f); v[q] = ((col >> 8) ? -sinpif(x) : cospif(x)) * (32.0f * 0.0625f); }
        v4u o; o.x = pk4_fp8((f32x4){v[0], v[1], v[2], v[3]}); o.y = pk4_fp8((f32x4){v[4], v[5], v[6], v[7]}); o.z = pk4_fp8((f32x4){v[8], v[9], v[10], v[11]}); o.w = pk4_fp8((f32x4){v[12], v[13], v[14], v[15]}); ((GAS v4u*)(a.ws() + WS_DFTC))[i] = o; }
    for (int i = gt; i < 2 * 256 * 1024; i += NGT) { const int l = i >> 18, r = (i >> 10) & 255, k = i & 1023; unsigned o = 0u;
        if (r < 64) { const float w = a.in(21)[((size_t)l * DM + k) * NEXP + (r & 31)]; const unsigned hi = f2bf(w); o = hi; if (r >= 32) o = f2bf(w - __uint_as_float(hi << 16)); }
        ((bf16*)(a.ws() + WS_WSMALL + (size_t)l * WSMALL_LAYER + OFFS_ROUT))[(size_t)r * 1024 + k] = (bf16)o; }
    for (int j = gw; j < 2048; j += NGW) fold_job(a, j, ct, F.lane);
    LAS float* scr = (LAS float*)(F.lds + RING_OFF + F.wave * 16384);
    for (int it = gw; it < 2 * IT_SMALL; it += NGW) small_item(a, it / IT_SMALL, it % IT_SMALL, scr, F.lane);
    moe_convert_all(a, gw, NGW, scr, F.lane);
}
__device__ __forceinline__ void ld4(f32x4 (&v)[4], const float* p, int lane) {
#pragma unroll
    for (int j = 0; j < 4; ++j) v[j] = ((const GAS f32x4*)p)[lane + 64 * j];
}
__device__ __forceinline__ float sumsq4(const f32x4 (&v)[4]) { float ss = 0.f;
#pragma unroll
    for (int j = 0; j < 4; ++j) ss += (v[j][0] * v[j][0] + v[j][1] * v[j][1]) + (v[j][2] * v[j][2] + v[j][3] * v[j][3]);
    return ss; }
__device__ __forceinline__ void p1_norm0(const Frame& F, const AV& a) {
    const int gw = F.vcu * NWAVES + F.wave, NGW = F.G * NWAVES, rpw = (TALL + NGW - 1) / NGW, r0 = gw * rpw, r1 = (r0 + rpw < TALL) ? r0 + rpw : TALL;
    if (r0 >= r1) return;
    f32x4 gpre[4], shift[4], scale[4], xn[4]; ld4(gpre, a.in(6), F.lane); int cb = -1;
    auto xsrc = [&](int m) -> const float* { return m < TL ? a.in(0) + (size_t)m * DM : a.in(2) + (size_t)(m - TL) * DM; };
    ld4(xn, xsrc(r0), F.lane);
    for (int m = r0; m < r1; ++m) {
        f32x4 x[4];
#pragma unroll
        for (int j = 0; j < 4; ++j) x[j] = xn[j];
        if (m + 1 < r1) ld4(xn, xsrc(m + 1), F.lane);
        const int b = m < TL ? (m >> 11) : 16;
        if (b != cb) { cb = b; const float* mv = (const float*)(a.ws() + WS_MOD) + (size_t)b * INCOLS; ld4(shift, mv, F.lane); ld4(scale, mv + 1024, F.lane); }
        const float r = 1.0f / sqrtf(wave_sum(sumsq4(x), F.lane) * (1.0f / 1024.0f) + EPS);
        bf16* ho = (bf16*)(a.ws() + WS_H) + (size_t)m * DM; unsigned char* h8 = a.ws() + WS_H8 + (size_t)m * DM;
#pragma unroll
        for (int j = 0; j < 4; ++j) { const f32x4 hv = x[j] * r * gpre[j] * (scale[j] + 1.0f) + shift[j]; ((GAS u32x2*)ho)[F.lane + 64 * j] = pk4(hv); ((GAS unsigned*)h8)[F.lane + 64 * j] = pk4_fp8(hv); }
    }
}
__device__ __forceinline__ void qk_fix_core(f32x4 (&x)[4], const f32x4 (&gg)[4], const f32x2* tab, bool rope, int t, int sub, int lane) {
    float ss = sumsq4(x); ss += shx(ss, 1, lane); ss += shx(ss, 2, lane); ss += shx(ss, 4, lane);
    const float r = 1.0f / sqrtf(ss * (1.0f / 128.0f) + EPS);
#pragma unroll
    for (int jj = 0; jj < 4; ++jj) x[jj] = x[jj] * r * gg[jj];
    if (rope) { const int pr = t >> 6, pc = t & 63;
#pragma unroll
        for (int i = 0; i < 4; ++i) { const f32x2 cr = tab[pr * 32 + sub * 4 + i], cc = tab[pc * 32 + sub * 4 + i];
            const float a0 = x[0][i], a1 = x[1][i], b0 = x[2][i], b1 = x[3][i];
            x[0][i] = a0 * cr.x - a1 * cr.y; x[1][i] = a1 * cr.x + a0 * cr.y; x[2][i] = b0 * cc.x - b1 * cc.y; x[3][i] = b1 * cc.x + b0 * cc.y; } }
}
__device__ __forceinline__ void p_qkfix(const Frame& F, const AV& a, int l, int M) {
    const int gw = F.vcu * NWAVES + F.wave, NGW = F.G * NWAVES, rpw = (M + NGW - 1) / NGW, r0 = gw * rpw, r1 = (r0 + rpw < M) ? r0 + rpw : M;
    if (r0 >= r1) return;
    const f32x2* tab = (const f32x2*)(a.ws() + WS_TAB); const int hh = F.lane >> 3, sub = F.lane & 7; const bool klane = F.lane < 16;
    f32x4 gq[4], gk[4];
#pragma unroll
    for (int jj = 0; jj < 4; ++jj) { gq[jj] = *(const GAS f32x4*)(a.in(11) + l * 128 + jj * 32 + sub * 4); gk[jj] = *(const GAS f32x4*)(a.in(12) + l * 128 + jj * 32 + sub * 4); }
    bf16* qb = (bf16*)(a.ws() + WS_Q); bf16* kb = (bf16*)(a.ws() + WS_K);
    u32x2 qn[4], kn[4];
    auto issue = [&](int m) { const bool doq = (m < TL) || l == 0; const bf16* qp = qb + (size_t)m * DM + hh * 128 + sub * 4; const bf16* kp = kb + (size_t)krow_of(m) * 256 + hh * 128 + sub * 4;
#pragma unroll
        for (int jj = 0; jj < 4; ++jj) { if (doq) qn[jj] = *(const GAS u32x2*)(qp + jj * 32); if (klane) kn[jj] = *(const GAS u32x2*)(kp + jj * 32); } };
    issue(r0);
    for (int m = r0; m < r1; ++m) {
        const bool lat = m < TL, doq = lat || l == 0; const int t = m & 2047;
        f32x4 xq[4], xk[4];
#pragma unroll
        for (int jj = 0; jj < 4; ++jj) { xq[jj] = bf4(qn[jj]); xk[jj] = bf4(kn[jj]); }
        if (m + 1 < r1) issue(m + 1);
        if (doq) { qk_fix_core(xq, gq, tab, lat, t, sub, F.lane); bf16* qp = qb + (size_t)m * DM + hh * 128 + sub * 4;
#pragma unroll
            for (int jj = 0; jj < 4; ++jj) *(GAS u32x2*)(qp + jj * 32) = pk4(xq[jj]); }
        if (klane) { qk_fix_core(xk, gk, tab, lat, t, sub, F.lane); bf16* kp = kb + (size_t)krow_of(m) * 256 + hh * 128 + sub * 4;
#pragma unroll
            for (int jj = 0; jj < 4; ++jj) *(GAS u32x2*)(kp + jj * 32) = pk4(xk[jj]); }
    }
}
__device__ __forceinline__ void p_conv(const Frame& F, const AV& a, int l, int njobs) {
    LAS unsigned char* lin = F.lds + RING_OFF; LAS float* lout = (LAS float*)(F.lds + RING_OFF + 62 * 1024);
    const bf16* cu = (const bf16*)(a.ws() + WS_CU); bf16* chb = (bf16*)(a.ws() + WS_CH);
    const int cp = F.tid & 255, pg = F.tid >> 8;
    f32x2 wv[31];
#pragma unroll
    for (int j = 0; j < 31; ++j) wv[j] = *(const GAS f32x2*)(a.in(14) + ((size_t)l * 31 + j) * 512 + 2 * cp);
    const f32x2 cb2 = *(const GAS f32x2*)(a.in(15) + l * 512 + 2 * cp);
    for (int job = F.vcu; job < njobs; job += F.G) {
        int rowbase, L, t0;
        if (job < 1024) { rowbase = (job >> 6) * SEQ; L = SEQ; t0 = (job & 63) * 32; } else { const int jc = job - 1024; rowbase = TL + (jc >> 3) * CTXL; L = CTXL; t0 = (jc & 7) * 32; }
        for (int idx = F.tid; idx < 62 * 64; idx += NTHR) { const int row = idx >> 6, ch = idx & 63, p = t0 - 15 + row; v4u val = (v4u){0u, 0u, 0u, 0u};
            if (p >= 0 && p < L) val = *(const GAS v4u*)(cu + (size_t)(rowbase + p) * 512 + ch * 8);
            *(LAS v4u*)(lin + row * 1024 + ch * 16) = val; }
        __syncthreads();
#pragma unroll
        for (int chunk = 0; chunk < 2; ++chunk) {
            f32x2 acc[8];
#pragma unroll
            for (int i = 0; i < 8; ++i) acc[i] = cb2;
            const int r0 = pg * 16 + chunk * 8;
#pragma unroll
            for (int r = 0; r < 38; ++r) { const unsigned w = *(const LAS unsigned*)(lin + (r0 + r) * 1024 + cp * 4); const float x0 = __uint_as_float(w << 16), x1 = __uint_as_float(w & 0xffff0000u);
#pragma unroll
                for (int i = 0; i < 8; ++i) { const int j = r - i; if (j >= 0 && j <= 30) { acc[i].x += x0 * wv[j].x; acc[i].y += x1 * wv[j].y; } } }
#pragma unroll
            for (int i = 0; i < 8; ++i) *(LAS f32x2*)(lout + (r0 + i) * 512 + 2 * cp) = acc[i];
        }
        __syncthreads();
#pragma unroll
        for (int pp = 0; pp < 4; ++pp) { const int p = F.wave * 4 + pp; const LAS float* src = lout + p * 512 + F.lane * 8;
            f32x4 y0 = *(const LAS f32x4*)src, y1 = *(const LAS f32x4*)(src + 4);
            const float mean = wave_sum((y0[0] + y0[1]) + (y0[2] + y0[3]) + (y1[0] + y1[1]) + (y1[2] + y1[3]), F.lane) * (1.0f / 512.0f);
            y0 = y0 - mean; y1 = y1 - mean;
            const float var = wave_sum((y0[0] * y0[0] + y0[1] * y0[1]) + (y0[2] * y0[2] + y0[3] * y0[3]) + (y1[0] * y1[0] + y1[1] * y1[1]) + (y1[2] * y1[2] + y1[3] * y1[3]), F.lane) * (1.0f / 512.0f);
            const float rs = 1.0f / sqrtf(var + EPS);
            const f32x4 g0 = *(const GAS f32x4*)(a.in(16) + l * 512 + F.lane * 8), g1 = *(const GAS f32x4*)(a.in(16) + l * 512 + F.lane * 8 + 4);
            const f32x4 b0 = *(const GAS f32x4*)(a.in(17) + l * 512 + F.lane * 8), b1 = *(const GAS f32x4*)(a.in(17) + l * 512 + F.lane * 8 + 4);
            y0 = y0 * rs * g0 + b0; y1 = y1 * rs * g1 + b1;
#pragma unroll
            for (int q = 0; q < 4; ++q) { y0[q] = y0[q] * sigmoidf_(y0[q]); y1[q] = y1[q] * sigmoidf_(y1[q]); }
            v4u o; o.x = pk2(y0[0], y0[1]); o.y = pk2(y0[2], y0[3]); o.z = pk2(y1[0], y1[1]); o.w = pk2(y1[2], y1[3]);
            *(GAS v4u*)(chb + (size_t)(rowbase + t0 + p) * 512 + F.lane * 8) = o; }
        __syncthreads();
    }
}
__device__ __forceinline__ void p_rowpass1(const Frame& F, const AV& a, int l, int M) {
    const int gw = F.vcu * NWAVES + F.wave, NGW = F.G * NWAVES, rpw = (M + NGW - 1) / NGW, r0 = gw * rpw, r1 = (r0 + rpw < M) ? r0 + rpw : M;
    if (r0 >= r1) return;
    const float* modb = (const float*)(a.ws() + WS_MOD) + (size_t)l * 17 * INCOLS; const bf16* mixb = (const bf16*)(a.ws() + WS_MIX);
    f32x4 gpost[4], gpre[4], gate[4], shift[4], scale[4]; ld4(gpost, a.in(7) + l * DM, F.lane); ld4(gpre, a.in(8) + l * DM, F.lane);
    int cb = -1;
    auto xsrc = [&](int m) -> const float* { return (l == 0) ? (m < TL ? a.in(0) + (size_t)m * DM : a.in(2) + (size_t)(m - TL) * DM) : (m < TL ? a.out() + (size_t)m * DM : (const float*)(a.ws() + WS_XC) + (size_t)(m - TL) * DM); };
    f32x4 xn[4]; u32x2 mn[4]; ld4(xn, xsrc(r0), F.lane);
#pragma unroll
    for (int j = 0; j < 4; ++j) mn[j] = ((const GAS u32x2*)(mixb + (size_t)r0 * DM))[F.lane + 64 * j];
    for (int m = r0; m < r1; ++m) {
        f32x4 x[4], y[4];
#pragma unroll
        for (int j = 0; j < 4; ++j) { x[j] = xn[j]; y[j] = bf4(mn[j]); }
        if (m + 1 < r1) { ld4(xn, xsrc(m + 1), F.lane);
#pragma unroll
            for (int j = 0; j < 4; ++j) mn[j] = ((const GAS u32x2*)(mixb + (size_t)(m + 1) * DM))[F.lane + 64 * j]; }
        const int b = m < TL ? (m >> 11) : 16;
        if (b != cb) { cb = b; const float* mv = modb + (size_t)b * INCOLS; ld4(gate, mv + 2 * 1024, F.lane); ld4(shift, mv + 3 * 1024, F.lane); ld4(scale, mv + 4 * 1024, F.lane); }
        const float r = 1.0f / sqrtf(wave_sum(sumsq4(y), F.lane) * (1.0f / 1024.0f) + EPS);
#pragma unroll
        for (int j = 0; j < 4; ++j) x[j] = x[j] + gate[j] * (y[j] * r * gpost[j]);
        float* xd = m < TL ? a.out() + (size_t)m * DM : (float*)(a.ws() + WS_XC) + (size_t)(m - TL) * DM;
        st_row_f32(x, xd, F.lane);
        const float r2 = 1.0f / sqrtf(wave_sum(sumsq4(x), F.lane) * (1.0f / 1024.0f) + EPS);
        bf16* ho = (bf16*)(a.ws() + WS_H) + (size_t)m * DM;
#pragma unroll
        for (int j = 0; j < 4; ++j) ((GAS u32x2*)ho)[F.lane + 64 * j] = pk4(x[j] * r2 * gpre[j] * (scale[j] + 1.0f) + shift[j]);
    }
}
__device__ __forceinline__ void p_route(const Frame& F, const AV& a, int l, int M) {
    typedef short bfx8 __attribute__((ext_vector_type(8)));
    const int NGW = F.G * NWAVES, rpw = (M + NGW - 1) / NGW, TPB = 8 * rpw, b0 = F.vcu * TPB, b1 = (b0 + TPB < M) ? b0 + TPB : M;
    LAS unsigned char* tabl = F.lds + RING_OFF; LAS float* lg = (LAS float*)(F.lds + LDS_SM) + F.wave * 512; LAS int* cntl = (LAS int*)(F.lds + LDS_SM + 16384);
    VM_WAIT(); __syncthreads();
    if (F.tid < 32) cntl[F.tid] = 0;
    { const GAS v4u* src = (const GAS v4u*)(a.ws() + WS_WSMALL + (size_t)l * WSMALL_LAYER + OFFS_ROUT);
      for (int idx = F.tid; idx < 64 * 128; idx += NTHR) { const int row = idx >> 7, c = idx & 127; *(LAS v4u*)(tabl + row * 2048 + ((c ^ (row & 7)) << 4)) = src[idx]; } }
    __syncthreads();
    const bf16* H = (const bf16*)(a.ws() + WS_H); const float bias = a.in(22)[l * NEXP + (F.lane & 31)];
    const int ar = F.lane & 15, kb = F.lane >> 4, ng = (b1 > b0) ? (b1 - b0 + 15) >> 4 : 0;
    for (int g = F.wave; g < ng; g += NWAVES) {
        const int rb = b0 + g * 16; int row = rb + ar; if (row > M - 1) row = M - 1;
        const bf16* hp = H + (size_t)row * DM + kb * 8; f32x4 acc[4];
#pragma unroll
        for (int f = 0; f < 4; ++f) acc[f] = (f32x4){0.f, 0.f, 0.f, 0.f};
#pragma unroll 4
        for (int s = 0; s < 32; ++s) { const bfx8 af = *(const GAS bfx8*)(hp + s * 32);
#pragma unroll
            for (int f = 0; f < 4; ++f) { const int wr = f * 16 + ar; const bfx8 bfr = *(const LAS bfx8*)(tabl + wr * 2048 + (((4 * s + kb) ^ (wr & 7)) << 4));
                acc[f] = __builtin_amdgcn_mfma_f32_16x16x32_bf16(af, bfr, acc[f], 0, 0, 0); } }
#pragma unroll
        for (int i = 0; i < 4; ++i) { lg[(4 * kb + i) * 32 + ar] = acc[0][i] + acc[2][i]; lg[(4 * kb + i) * 32 + 16 + ar] = acc[1][i] + acc[3][i]; }
        LDS_WAIT(); asm volatile("" ::: "memory");
        { const int hf = F.lane >> 5, ex = F.lane & 31; LAS unsigned long long* kb64 = (LAS unsigned long long*)(F.lds + LDS_SM + 16384 + 256) + F.wave * 64;
          LAS float* selv = (LAS float*)(F.lds + LDS_SM + 16384 + 256 + 4096) + F.wave * 16; LAS int* seli = (LAS int*)(selv + 8);
#pragma unroll 1
          for (int p = 0; p < 8; ++p) { const int r = 2 * p + hf, m = rb + r; const bool valid = m < b1;
            const float v = lg[r * 32 + ex] + bias; unsigned ub = __float_as_uint(v); ub = (ub & 0x80000000u) ? ~ub : (ub | 0x80000000u);
            const unsigned long long K = ((unsigned long long)ub << 5) | (unsigned)(31 - ex);
            kb64[F.lane] = K;
            LDS_WAIT(); asm volatile("" ::: "memory");
            int rank = 0;
#pragma unroll
            for (int j = 0; j < 32; ++j) rank += (kb64[hf * 32 + j] > K) ? 1 : 0;
            if (rank < 4) { selv[hf * 4 + rank] = v; seli[hf * 4 + rank] = ex; if (valid) __hip_atomic_fetch_add(&cntl[ex], 1, __ATOMIC_RELAXED, __HIP_MEMORY_SCOPE_WORKGROUP); }
            LDS_WAIT(); asm volatile("" ::: "memory");
            if (ex == 0 && valid) { const f32x4 tv = *(const LAS f32x4*)(selv + hf * 4); const i32x4 ti = *(const LAS i32x4*)(seli + hf * 4);
                const float e1 = __expf(tv[1] - tv[0]), e2 = __expf(tv[2] - tv[0]), e3 = __expf(tv[3] - tv[0]), inv = 1.0f / (1.0f + e1 + e2 + e3);
                *(GAS i32x4*)((int*)(a.ws() + WS_TOPI) + (size_t)m * 4) = ti; *(GAS f32x4*)((float*)(a.ws() + WS_TOPP) + (size_t)m * 4) = (f32x4){inv, e1 * inv, e2 * inv, e3 * inv}; }
            LDS_WAIT(); asm volatile("" ::: "memory"); } }
        LDS_WAIT(); asm volatile("" ::: "memory");
    }
    __syncthreads();
    if (F.tid < 32) ((int*)(a.ws() + WS_CNT))[F.vcu * 32 + F.tid] = cntl[F.tid];
}
__device__ __forceinline__ void p_slots(const Frame& F, const AV& a, int M) {
    LAS int* sm = (LAS int*)(F.lds + LDS_SM);
    LAS int *tot = sm, *bef = sm + 32, *base = sm + 64, *tst = sm + 96  , *mask = sm + 160  , *ids = sm + 320  , *slot = sm + 960  ;
    const int* cnt = (const int*)(a.ws() + WS_CNT);
    { LAS int* ptot = sm + 1600; LAS int* pbef = sm + 2112; const int e = F.tid & 31, part = F.tid >> 5; int t = 0, b = 0;
#pragma unroll 4
      for (int q = part; q < F.G; q += 16) { const int c = cnt[q * 32 + e]; t += c; if (q < F.vcu) b += c; }
      ptot[part * 32 + e] = t; pbef[part * 32 + e] = b;
      __syncthreads();
      if (F.tid < 32) { int tt = 0, bb = 0;
#pragma unroll
          for (int q = 0; q < 16; ++q) { tt += ptot[q * 32 + F.tid]; bb += pbef[q * 32 + F.tid]; }
          tot[F.tid] = tt; bef[F.tid] = bb; } }
    __syncthreads();
    if (F.tid == 0) { int ts = 0; for (int e = 0; e < 32; ++e) { tst[e] = ts; base[e] = ts * 256 + bef[e]; ts += (tot[e] + 255) >> 8; } tst[32] = ts; }
    __syncthreads();
    const int NT = tst[32];
    if (blockIdx.x == 0) { int* te = (int*)(a.ws() + WS_CNT) + CNT_TILE_E;
        for (int t = F.tid; t < NT; t += NTHR) { int e = 0; for (int q = 1; q < 32; ++q) if (t >= tst[q]) e = q; te[t] = e; }
        if (F.tid == 0) ((int*)(a.ws() + WS_CNT))[CNT_NT] = NT; }
    const int TPB = 8 * ((M + F.G * NWAVES - 1) / (F.G * NWAVES)), m0 = F.vcu * TPB, m1 = (m0 + TPB < M) ? m0 + TPB : M, nt = m1 > m0 ? m1 - m0 : 0;
    for (int tl = F.tid; tl < nt; tl += NTHR) { const i32x4 id = *(const GAS i32x4*)((const int*)(a.ws() + WS_TOPI) + (size_t)(m0 + tl) * 4);
        ids[tl * 4 + 0] = id.x; ids[tl * 4 + 1] = id.y; ids[tl * 4 + 2] = id.z; ids[tl * 4 + 3] = id.w; mask[tl] = (1 << id.x) | (1 << id.y) | (1 << id.z) | (1 << id.w); }
    __syncthreads();
    for (int p = F.tid; p < nt * 4; p += NTHR) { const int tl = p >> 2, e = ids[p]; int rank = 0; for (int q = 0; q < tl; ++q) rank += (mask[q] >> e) & 1;
        const int s = base[e] + rank; slot[p] = s; ((int*)(a.ws() + WS_SLOT))[(size_t)(m0 + tl) * 4 + (p & 3)] = s; }
    __syncthreads();
    const bf16* h = (const bf16*)(a.ws() + WS_H); unsigned char* hs = a.ws() + WS_HS;
    { v4u xa, xb; if (F.wave < nt) { const GAS v4u* src = (const GAS v4u*)(h + (size_t)(m0 + F.wave) * DM); xa = src[F.lane]; xb = src[F.lane + 64]; }
      for (int tl = F.wave; tl < nt; tl += NWAVES) { const v4u x0 = xa, x1 = xb;
        if (tl + NWAVES < nt) { const GAS v4u* src = (const GAS v4u*)(h + (size_t)(m0 + tl + NWAVES) * DM); xa = src[F.lane]; xb = src[F.lane + 64]; }
        u32x2 o0, o1;
        o0.x = pg8::cvt4_fp8(__uint_as_float(x0.x << 16), __uint_as_float(x0.x & 0xffff0000u), __uint_as_float(x0.y << 16), __uint_as_float(x0.y & 0xffff0000u));
        o0.y = pg8::cvt4_fp8(__uint_as_float(x0.z << 16), __uint_as_float(x0.z & 0xffff0000u), __uint_as_float(x0.w << 16), __uint_as_float(x0.w & 0xffff0000u));
        o1.x = pg8::cvt4_fp8(__uint_as_float(x1.x << 16), __uint_as_float(x1.x & 0xffff0000u), __uint_as_float(x1.y << 16), __uint_as_float(x1.y & 0xffff0000u));
        o1.y = pg8::cvt4_fp8(__uint_as_float(x1.z << 16), __uint_as_float(x1.z & 0xffff0000u), __uint_as_float(x1.w << 16), __uint_as_float(x1.w & 0xffff0000u));
#pragma unroll
        for (int k = 0; k < 4; ++k) { GAS u32x2* dst = (GAS u32x2*)(hs + (size_t)slot[tl * 4 + k] * DM); dst[F.lane] = o0; dst[F.lane + 64] = o1; } } }
    if (blockIdx.x < 32) { const int e = blockIdx.x, r0 = tst[e] * 256 + tot[e], r1 = tst[e + 1] * 256;
        unsigned zz = 0u; asm volatile("" : "+v"(zz));
        for (int r = r0 + F.wave; r < r1; r += NWAVES) { GAS v4u* dst = (GAS v4u*)(hs + (size_t)r * DM); dst[F.lane] = (v4u){zz, zz, zz, zz}; } }
    __syncthreads();
}
__device__ __forceinline__ void p_combine(const Frame& F, const AV& a, int l, int M) {
    const int gw = F.vcu * NWAVES + F.wave, NGW = F.G * NWAVES, rpw = (M + NGW - 1) / NGW, r0 = gw * rpw, r1 = (r0 + rpw < M) ? r0 + rpw : M;
    if (r0 >= r1) return;
    const bf16* ys = (const bf16*)(a.ws() + WS_YS); const int* slp = (const int*)(a.ws() + WS_SLOT); const float* prp = (const float*)(a.ws() + WS_TOPP);
    const float* modb = (const float*)(a.ws() + WS_MOD);
    f32x4 gpost[4], gpre[4], gate[4], shift[4], scale[4]; ld4(gpost, a.in(9) + l * DM, F.lane); if (l == 0) ld4(gpre, a.in(6) + DM, F.lane);
    int cb = -1;
    i32x4 sl_n = *(const GAS i32x4*)(slp + (size_t)r0 * 4); f32x4 pr_n = *(const GAS f32x4*)(prp + (size_t)r0 * 4);
    f32x4 xn[4]; u32x2 yn[4][4]; f32x4 prc = pr_n;
    auto xrow = [&](int m) -> float* { return m < TL ? a.out() + (size_t)m * DM : (float*)(a.ws() + WS_XC) + (size_t)(m - TL) * DM; };
    { ld4(xn, xrow(r0), F.lane); const int sv[4] = {sl_n[0], sl_n[1], sl_n[2], sl_n[3]};
#pragma unroll
      for (int k = 0; k < 4; ++k)
#pragma unroll
          for (int j = 0; j < 4; ++j) yn[k][j] = ((const GAS u32x2*)(ys + (size_t)sv[k] * DM))[F.lane + 64 * j];
      if (r0 + 1 < r1) { sl_n = *(const GAS i32x4*)(slp + (size_t)(r0 + 1) * 4); pr_n = *(const GAS f32x4*)(prp + (size_t)(r0 + 1) * 4); } }
    for (int m = r0; m < r1; ++m) {
        f32x4 x[4], y[4];
#pragma unroll
        for (int j = 0; j < 4; ++j) { x[j] = xn[j]; y[j] = bf4(yn[0][j]) * prc[0] + bf4(yn[1][j]) * prc[1] + bf4(yn[2][j]) * prc[2] + bf4(yn[3][j]) * prc[3]; }
        if (m + 1 < r1) { prc = pr_n; ld4(xn, xrow(m + 1), F.lane); const int sv[4] = {sl_n[0], sl_n[1], sl_n[2], sl_n[3]};
#pragma unroll
            for (int k = 0; k < 4; ++k)
#pragma unroll
                for (int j = 0; j < 4; ++j) yn[k][j] = ((const GAS u32x2*)(ys + (size_t)sv[k] * DM))[F.lane + 64 * j];
            if (m + 2 < r1) { sl_n = *(const GAS i32x4*)(slp + (size_t)(m + 2) * 4); pr_n = *(const GAS f32x4*)(prp + (size_t)(m + 2) * 4); } }
        const int b = m < TL ? (m >> 11) : 16;
        if (b != cb) { cb = b; ld4(gate, modb + ((size_t)l * 17 + b) * INCOLS + 5 * 1024, F.lane); if (l == 0) { const float* m1 = modb + ((size_t)17 + b) * INCOLS; ld4(shift, m1, F.lane); ld4(scale, m1 + 1024, F.lane); } }
        const float r = 1.0f / sqrtf(wave_sum(sumsq4(y), F.lane) * (1.0f / 1024.0f) + EPS);
#pragma unroll
        for (int j = 0; j < 4; ++j) x[j] = x[j] + gate[j] * (y[j] * r * gpost[j]);
        st_row_f32(x, xrow(m), F.lane);
        if (l == 0) { const float r2 = 1.0f / sqrtf(wave_sum(sumsq4(x), F.lane) * (1.0f / 1024.0f) + EPS);
            bf16* ho = (bf16*)(a.ws() + WS_H) + (size_t)m * DM; unsigned char* h8 = a.ws() + WS_H8 + (size_t)m * DM;
#pragma unroll
            for (int j = 0; j < 4; ++j) { const f32x4 hv = x[j] * r2 * gpre[j] * (scale[j] + 1.0f) + shift[j]; ((GAS u32x2*)ho)[F.lane + 64 * j] = pk4(hv); ((GAS unsigned*)h8)[F.lane + 64 * j] = pk4_fp8(hv); } }
    }
}
#ifdef DBG_CHECK
#ifndef DBG_GSUB
#define DBG_GSUB 0
#endif
__device__ __forceinline__ double bfd(bf16 b) { return (double)__uint_as_float(((unsigned)b) << 16); }
__device__ __forceinline__ unsigned hsh(unsigned x) { x ^= x >> 16; x *= 0x7feb352du; x ^= x >> 15; x *= 0x846ca68bu; x ^= x >> 16; return x; }
__device__ __forceinline__ int samp_row(int i, int M, unsigned salt) { const int sp[12] = {0, 1, 255, 256, 2047, 2048, 4095, 32767, 32768, 32769, 33023, 36863}; if (i < 12 && sp[i] < M) return sp[i]; return (int)(hsh(i * 7919u + salt) % (unsigned)M); }
__device__ __forceinline__ void rec(float* res, int stage, double got, double want, double flo) { const double e = fabs(got - want) / (fabs(want) + flo); const float f = (e == e) ? (float)e : 1e30f; atomicMax((unsigned*)res + stage, __float_as_uint(f)); }
__device__ double dot_h_w(const bf16* hrow, const float* w, int ldw, int col) { double s = 0; for (int k = 0; k < 1024; ++k) s += bfd(hrow[k]) * (double)w[(size_t)k * ldw + col]; return s; }
__device__ double dsig(double x) { return 1.0 / (1.0 + exp(-x)); }
constexpr double PI_D = 3.14159265358979323846;
enum { ST_MOD = 0, ST_H0, ST_INPROJ, ST_YT, ST_QKFIX, ST_CONV, ST_Z, ST_ATTN, ST_GATES, ST_MERGED, ST_MIX, ST_ROW1, ST_LOGIT, ST_TOPK, ST_SLOTS, ST_ACT, ST_YSLOT, ST_COMB, ST_GATESB, ST_N };
__global__ void chk(Args A, int stage, int l, float* res, float* snap) {
    const int i = threadIdx.x; unsigned char* ws = A.ws; const int M = (l == 0) ? TALL : TL; const int rs = stage + 32 * l;
    const bf16* H = (const bf16*)(ws + WS_H); const float* win = A.in[10] + (size_t)l * DM * INCOLS; const float* modb = (const float*)(ws + WS_MOD);
    if (stage == ST_MOD) { const int ll = i & 1, b = (i >> 1) % 17, n = (int)(hsh(i) % 6144u); double s = 0; for (int k = 0; k < 1024; ++k) { const double cv = b < 16 ? A.in[1][b * 1024 + k] : A.in[3][k]; s += cv * dsig(cv) * (double)A.in[4][((size_t)ll * 1024 + k) * 6144 + n]; }
        s += A.in[5][ll * 6144 + n]; rec(res, rs, modb[((size_t)ll * 17 + b) * 6144 + n], s, 0.02); }
    else if (stage == ST_H0) { const int m = samp_row(i, TALL, 1), c = (int)(hsh(i + 77) % 1024u); const float* x = m < TL ? A.in[0] + (size_t)m * DM : A.in[2] + (size_t)(m - TL) * DM; double ss = 0; for (int k = 0; k < 1024; ++k) ss += (double)x[k] * x[k];
        const float* mv = modb + (size_t)(m < TL ? (m >> 11) : 16) * 6144; const double want = x[c] / sqrt(ss / 1024 + 1e-6) * A.in[6][c] * (1.0 + mv[1024 + c]) + mv[c]; rec(res, rs, bfd(H[(size_t)m * DM + c]), want, 0.05); }
    else if (stage == ST_INPROJ) { const int m = samp_row(i, TALL, 2), kind = i & 3; const bf16* hr = H + (size_t)m * DM;
        if (kind == 0) { const int n = (int)(hsh(i + 5) % 1024u); rec(res, rs, bfd(((const bf16*)(ws + WS_Q))[(size_t)m * DM + n]), dot_h_w(hr, win, INCOLS, n), 0.05); }
        else if (kind == 1) { const int n = (int)(hsh(i + 6) % 256u); rec(res, rs, bfd(((const bf16*)(ws + WS_K))[(size_t)krow_of(m) * 256 + n]), dot_h_w(hr, win, INCOLS, 1024 + n), 0.05); }
        else if (kind == 2) { const int n = (int)(hsh(i + 7) % 256u); rec(res, rs, bfd(((const bf16*)(ws + WS_V))[(size_t)krow_of(m) * 256 + n]), dot_h_w(hr, win, INCOLS, 1280 + n), 0.05); }
        else { const int c = (int)(hsh(i + 8) % 512u); if (l == 0 || m < TL) { const double a = dot_h_w(hr, win, INCOLS, 1536 + c), g = dot_h_w(hr, win, INCOLS, 2048 + c); rec(res, rs, bfd(((const bf16*)(ws + WS_CU))[(size_t)m * 512 + c]), a * dsig(g), 0.05); } } }
    else if (stage == ST_YT) { const int m = samp_row(i, M, 3), ch = (int)(hsh(i + 9) % 512u), cs = i & 1, g = ch >> 7, k2 = ch & 127; const bf16* hr = H + (size_t)m * DM; double s = 0;
        for (int k = 0; k < 1024; ++k) { double t = 0; for (int n2 = 0; n2 < 128; ++n2) { const double ang = 2.0 * PI_D * ((n2 * k2) & 127) / 128.0; t += (double)win[(size_t)k * INCOLS + OFF_FNET + g * 128 + n2] * (cs ? sin(ang) : cos(ang)); } s += bfd(hr[k]) * t; }
        s /= sqrt(128.0); double got; if (m < TL) got = bfd(((const bf16*)(ws + WS_YT))[((size_t)(m >> 11) * 512 + ch) * 4096 + cs * 2048 + (m & 2047)]); else got = bfd(((const bf16*)(ws + WS_YTC))[((size_t)((m - TL) >> 8) * 512 + ch) * 512 + cs * 256 + ((m - TL) & 255)]);
        rec(res, rs, got, s, 0.05); }
    else if (stage == ST_QKFIX) { const int m = samp_row(i, TALL, 4), isk = i & 1, hh = isk ? (int)(hsh(i + 3) % 2u) : (int)(hsh(i + 3) % 8u), d = (int)(hsh(i + 4) % 128u); const bf16* hr = H + (size_t)m * DM;
        if (isk || l == 0 || m < TL) { const int cbase = isk ? 1024 + hh * 128 : hh * 128; double ss = 0, xd = 0, xp = 0; const int half = d & 64, dd = d & 63, pd = half + ((dd + 32) & 63);
            for (int q = 0; q < 128; ++q) { double v = dot_h_w(hr, win, INCOLS, cbase + q); v = bfd((bf16)f2bf((float)v)); ss += v * v; if (q == d) xd = v; if (q == pd) xp = v; }
            const float* gn = (isk ? A.in[12] : A.in[11]) + l * 128; const double r = 1.0 / sqrt(ss / 128 + 1e-6); xd *= r * gn[d]; xp *= r * gn[pd]; double want = xd;
            if (m < TL) { const int t = m & 2047, pos = half ? (t & 63) : (t >> 6), f = dd & 31; const double ang = (double)((float)pos * powf(10000.0f, -(float)f / 32.0f)); want = (dd < 32) ? xd * cos(ang) - xp * sin(ang) : xd * cos(ang) + xp * sin(ang); }
            const double got = isk ? bfd(((const bf16*)(ws + WS_K))[(size_t)krow_of(m) * 256 + hh * 128 + d]) : bfd(((const bf16*)(ws + WS_Q))[(size_t)m * DM + hh * 128 + d]); rec(res, rs, got, want, 0.05); } }
    else if (stage == ST_CONV) { const int m = samp_row(i, M, 5), c = (int)(hsh(i + 11) % 512u); const int rowbase = m < TL ? (m >> 11) * SEQ : TL + ((m - TL) >> 8) * CTXL, L = m < TL ? SEQ : CTXL, t = m - rowbase; const bf16* cu = (const bf16*)(ws + WS_CU);
        double s1 = 0, s2 = 0, yc = 0; for (int cc = 0; cc < 512; ++cc) { double y = A.in[15][l * 512 + cc]; for (int j = 0; j < 31; ++j) { const int p = t + j - 15; if (p >= 0 && p < L) y += bfd(cu[(size_t)(rowbase + p) * 512 + cc]) * (double)A.in[14][((size_t)l * 31 + j) * 512 + cc]; } s1 += y; s2 += y * y; if (cc == c) yc = y; }
        const double mean = s1 / 512, var = s2 / 512 - mean * mean; double y = (yc - mean) / sqrt(var + 1e-6) * A.in[16][l * 512 + c] + A.in[17][l * 512 + c]; y = y * dsig(y); rec(res, rs, bfd(((const bf16*)(ws + WS_CH))[(size_t)m * 512 + c]), y, 0.05); }
    else if (stage == ST_Z) { const int m = samp_row(i, M, 6), ch = (int)(hsh(i + 12) % 512u); double s = 0;
        if (m < TL) { const int b = m >> 11, k1 = m & 2047; const bf16* yr = (const bf16*)(ws + WS_YT) + ((size_t)b * 512 + ch) * 4096; for (int n1 = 0; n1 < 2048; ++n1) { const double ang = 2.0 * PI_D * ((k1 * n1) & 2047) / 2048.0; s += cos(ang) * bfd(yr[n1]) - sin(ang) * bfd(yr[2048 + n1]); } s /= sqrt(2048.0); }
        else { const int b = (m - TL) >> 8, k1 = (m - TL) & 255; const bf16* yr = (const bf16*)(ws + WS_YTC) + ((size_t)b * 512 + ch) * 512; for (int n1 = 0; n1 < 256; ++n1) { const double ang = 2.0 * PI_D * ((k1 * n1) & 255) / 256.0; s += cos(ang) * bfd(yr[n1]) - sin(ang) * bfd(yr[256 + n1]); } s /= 16.0; }
        rec(res, rs, bfd(((const bf16*)(ws + WS_Z))[(size_t)m * 512 + ch]), s, 0.05); }
    else if (stage == ST_ATTN) { const int m = samp_row(i, M, 7), hh = (int)(hsh(i + 13) % 8u), d = (int)(hsh(i + 14) % 128u); const bf16* q = (const bf16*)(ws + WS_Q) + (size_t)m * DM + hh * 128;
        int kr0, nk; if (m < TL) { kr0 = (m >> 11) * KVROWS; nk = KVROWS; } else { kr0 = ((m - TL) >> 8) * KVROWS + SEQ; nk = CTXL; }
        const bf16* K = (const bf16*)(ws + WS_K) + (size_t)kr0 * 256 + (hh >> 2) * 128; const bf16* V = (const bf16*)(ws + WS_V) + (size_t)kr0 * 256 + (hh >> 2) * 128;
        double mx = -1e300; for (int j = 0; j < nk; ++j) { double s = 0; for (int q2 = 0; q2 < 128; ++q2) s += bfd(q[q2]) * bfd(K[(size_t)j * 256 + q2]); s *= 0.08838834764831845; if (s > mx) mx = s; }
        double den = 0, num = 0; for (int j = 0; j < nk; ++j) { double s = 0; for (int q2 = 0; q2 < 128; ++q2) s += bfd(q[q2]) * bfd(K[(size_t)j * 256 + q2]); s *= 0.08838834764831845; const double p = exp(s - mx); den += p; num += p * bfd(V[(size_t)j * 256 + d]); }
        rec(res, rs, bfd(((const bf16*)(ws + WS_AO))[(size_t)m * DM + hh * 128 + d]), num / den, 0.03); }
    else if (stage == ST_GATES) { const int m = samp_row(i, M, 8), n = (int)(hsh(i + 15) % 3072u); rec(res, rs, bfd(((const bf16*)(ws + WS_GATES))[(size_t)m * 3072 + n]), dsig(dot_h_w(H + (size_t)m * DM, win, INCOLS, OFF_GATE + n)), 0.05); }
    else if (stage == ST_GATESB && DBG_GSUB == 1) { const int m = samp_row(i, M, 8), n = (int)(hsh(i + 15) % 3072u); const double got = bfd(((const bf16*)(ws + WS_GATES))[(size_t)m * 3072 + n]), want = dsig(dot_h_w(H + (size_t)m * DM, win, INCOLS, OFF_GATE + n));
        const bool badv = !(fabs(got - want) <= 0.05); if (badv) { unsigned* r = (unsigned*)res + 48; atomicOr(r, (m < TL ? 1u : 2u) | (4u << (n >> 10)) | (i < 12 ? 32u : 0u)); } }
    else if (stage == ST_GATESB) { const int m = samp_row(i, M, 8), n = (int)(hsh(i + 15) % 3072u); const bf16* wt = (const bf16*)(ws + WS_WSMALL + (size_t)l * WSMALL_LAYER + OFFS_WG) + (size_t)n * 1024; const bf16* hr = H + (size_t)m * DM; double s = 0; for (int k = 0; k < 1024; ++k) s += bfd(hr[k]) * bfd(wt[k]);
        rec(res, rs, bfd(((const bf16*)(ws + WS_GATES))[(size_t)m * 3072 + n]), dsig(s), 0.05); }
    else if (stage == ST_MERGED) { const int m = samp_row(i, M, 9), c = (int)(hsh(i + 16) % 1024u); const bf16* g = (const bf16*)(ws + WS_GATES) + (size_t)m * 3072; double y0 = 0, y1 = 0, y2 = 0;
        const bf16* ao = (const bf16*)(ws + WS_AO) + (size_t)m * DM; const bf16* chh = (const bf16*)(ws + WS_CH) + (size_t)m * 512; const bf16* z = (const bf16*)(ws + WS_Z) + (size_t)m * 512;
        for (int k = 0; k < 1024; ++k) y0 += bfd(ao[k]) * (double)A.in[13][((size_t)l * 1024 + k) * 1024 + c];
        for (int k = 0; k < 512; ++k) { y1 += bfd(chh[k]) * (double)A.in[18][((size_t)l * 512 + k) * 1024 + c]; y2 += bfd(z[k]) * (double)A.in[19][((size_t)l * 512 + k) * 1024 + c]; }
        rec(res, rs, bfd(((const bf16*)(ws + WS_MERGED))[(size_t)m * DM + c]), bfd(g[c]) * y0 + bfd(g[1024 + c]) * y1 + bfd(g[2048 + c]) * y2, 0.05); }
    else if (stage == ST_MIX) { const int m = samp_row(i, M, 10), c = (int)(hsh(i + 17) % 1024u); rec(res, rs, bfd(((const bf16*)(ws + WS_MIX))[(size_t)m * DM + c]), dot_h_w((const bf16*)(ws + WS_MERGED) + (size_t)m * DM, A.in[20] + (size_t)l * DM * DM, DM, c), 0.05); }
    else if (stage == ST_ROW1) { const int m = samp_row(i, M, 11), c = (int)(hsh(i + 18) % 1024u); const float* xs = snap + (size_t)i * 1024;
        const bf16* mix = (const bf16*)(ws + WS_MIX) + (size_t)m * DM; const float* mv = modb + ((size_t)l * 17 + (m < TL ? (m >> 11) : 16)) * 6144; double ss = 0; for (int k = 0; k < 1024; ++k) ss += bfd(mix[k]) * bfd(mix[k]); const double r = 1.0 / sqrt(ss / 1024 + 1e-6);
        double s2 = 0, xc = 0; for (int k = 0; k < 1024; ++k) { const double xn = xs[k] + mv[2048 + k] * (bfd(mix[k]) * r * A.in[7][l * DM + k]); s2 += xn * xn; if (k == c) xc = xn; }
        const float* xd = m < TL ? A.out + (size_t)m * DM : (const float*)(ws + WS_XC) + (size_t)(m - TL) * DM; rec(res, rs, xd[c], xc, 0.02);
        rec(res, rs, bfd(H[(size_t)m * DM + c]), xc / sqrt(s2 / 1024 + 1e-6) * A.in[8][l * DM + c] * (1.0 + mv[4096 + c]) + mv[3072 + c], 0.05); }
    else if (stage == ST_LOGIT) { const int m = samp_row(i, M, 12), e = i & 31; const float* lg = (const float*)(ws + WS_LOGIT) + (size_t)m * 64; rec(res, rs, (double)lg[e] + lg[32 + e], dot_h_w(H + (size_t)m * DM, A.in[21] + (size_t)l * DM * NEXP, NEXP, e), 0.02); }
    else if (stage == ST_TOPK) { const int m = samp_row(i, M, 13); const float* lg = (const float*)(ws + WS_LOGIT) + (size_t)m * 64; float v[32]; for (int e = 0; e < 32; ++e) v[e] = lg[e] + lg[32 + e] + A.in[22][l * 32 + e];
        int id[4]; float tv[4]; for (int k = 0; k < 4; ++k) { int b = -1; for (int e = 0; e < 32; ++e) { bool used = false; for (int q = 0; q < k; ++q) used |= (id[q] == e); if (!used && (b < 0 || v[e] > v[b])) b = e; } id[k] = b; tv[k] = v[b]; }
        double den = 0; for (int k = 0; k < 4; ++k) den += exp((double)tv[k] - tv[0]); const int* gi = (const int*)(ws + WS_TOPI) + (size_t)m * 4; const float* gp = (const float*)(ws + WS_TOPP) + (size_t)m * 4;
        for (int k = 0; k < 4; ++k) { rec(res, rs, gi[k] == id[k] ? 0.0 : 1.0, 0, 0.01); rec(res, rs, gp[k], exp((double)tv[k] - tv[0]) / den, 0.01); } }
    else if (stage == ST_SLOTS) { const int m = samp_row(i, M, 14), k = i & 3; const int s = ((const int*)(ws + WS_SLOT))[(size_t)m * 4 + k], e = ((const int*)(ws + WS_TOPI))[(size_t)m * 4 + k]; const int NT = ((const int*)(ws + WS_CNT))[CNT_NT];
        if (s < 0 || s >= NT * 256) rec(res, rs, 1, 0, 0.01); else { rec(res, rs, ((const int*)(ws + WS_CNT))[CNT_TILE_E + (s >> 8)] == e ? 0.0 : 1.0, 0, 0.01); const bf16* hs = (const bf16*)(ws + WS_HS) + (size_t)s * DM; double df = 0; for (int q = 0; q < 1024; ++q) df += fabs(bfd(hs[q]) - bfd(H[(size_t)m * DM + q])); rec(res, rs, df, 0, 1e-3); } }
    else if (stage == ST_ACT) { const int m = samp_row(i, M, 15), k = i & 3, c = (int)(hsh(i + 21) % 1024u); const int s = ((const int*)(ws + WS_SLOT))[(size_t)m * 4 + k], e = ((const int*)(ws + WS_TOPI))[(size_t)m * 4 + k]; const bf16* hs = (const bf16*)(ws + WS_HS) + (size_t)s * DM;
        double g = dot_h_w(hs, A.in[23] + (((size_t)l * NEXP + e) << 20), DM, c) + A.in[24][((size_t)l * NEXP + e) * 1024 + c], u = dot_h_w(hs, A.in[25] + (((size_t)l * NEXP + e) << 20), DM, c) + A.in[26][((size_t)l * NEXP + e) * 1024 + c];
        g = g < 7.0 ? g : 7.0; u = u < -7.0 ? -7.0 : (u > 7.0 ? 7.0 : u); rec(res, rs, bfd(((const bf16*)(ws + WS_ACT))[(size_t)s * DM + c]), (u + 1.0) * (g * dsig(1.702 * g)), 0.05); }
    else if (stage == ST_YSLOT) { const int m = samp_row(i, M, 16), k = i & 3, c = (int)(hsh(i + 22) % 1024u); const int s = ((const int*)(ws + WS_SLOT))[(size_t)m * 4 + k], e = ((const int*)(ws + WS_TOPI))[(size_t)m * 4 + k];
        rec(res, rs, bfd(((const bf16*)(ws + WS_HS))[(size_t)s * DM + c]), dot_h_w((const bf16*)(ws + WS_ACT) + (size_t)s * DM, A.in[27] + (((size_t)l * NEXP + e) << 20), DM, c) + A.in[28][((size_t)l * NEXP + e) * 1024 + c], 0.05); }
    else if (stage == ST_COMB) { const int m = samp_row(i, M, 17), c = (int)(hsh(i + 23) % 1024u); const float* xs = snap + (size_t)i * 1024; const int* sl = (const int*)(ws + WS_SLOT) + (size_t)m * 4; const float* pr = (const float*)(ws + WS_TOPP) + (size_t)m * 4;
        const float* mv = modb + ((size_t)l * 17 + (m < TL ? (m >> 11) : 16)) * 6144; double ss = 0, yc = 0; for (int q = 0; q < 1024; ++q) { double y = 0; for (int k = 0; k < 4; ++k) y += (double)pr[k] * bfd(((const bf16*)(ws + WS_HS))[(size_t)sl[k] * DM + q]); ss += y * y; if (q == c) yc = y; }
        const double want = xs[c] + mv[5 * 1024 + c] * (yc / sqrt(ss / 1024 + 1e-6) * A.in[9][l * DM + c]); const float* xd = m < TL ? A.out + (size_t)m * DM : (const float*)(ws + WS_XC) + (size_t)(m - TL) * DM; rec(res, rs, xd[c], want, 0.02); }
}
__global__ void snap_rows(Args A, int l, int salt, float* snap) {
    const int i = blockIdx.x, M = (l == 0) ? TALL : TL, m = samp_row(i, M, salt); const float* xs;
    if (l == 0 && salt == 11) xs = m < TL ? A.in[0] + (size_t)m * DM : A.in[2] + (size_t)(m - TL) * DM; else xs = m < TL ? A.out + (size_t)m * DM : (const float*)(A.ws + WS_XC) + (size_t)(m - TL) * DM;
    for (int k = threadIdx.x; k < 1024; k += blockDim.x) snap[(size_t)i * 1024 + k] = xs[k];
}
__global__ void chk_gates_full(const bf16* H, const bf16* Wt, const bf16* G, int M, unsigned* cntw) {
    const int n = blockIdx.x * 64 + (threadIdx.x & 63), m = blockIdx.y * 4 + (threadIdx.x >> 6); if (m >= M) return;
    const uint4* a = (const uint4*)(H + (size_t)m * 1024); const uint4* b = (const uint4*)(Wt + (size_t)n * 1024); float s = 0.f;
    for (int k = 0; k < 128; ++k) { const uint4 x = a[k], y = b[k]; const unsigned xs[4] = {x.x, x.y, x.z, x.w}, ys[4] = {y.x, y.y, y.z, y.w};
        for (int q = 0; q < 4; ++q) { s += __uint_as_float(xs[q] << 16) * __uint_as_float(ys[q] << 16); s += __uint_as_float(xs[q] & 0xffff0000u) * __uint_as_float(ys[q] & 0xffff0000u); } }
    const float want = 1.0f / (1.0f + __expf(-s)), got = __uint_as_float(((unsigned)G[(size_t)m * 3072 + n]) << 16);
    if (!(fabsf(got - want) <= 0.02f)) { atomicAdd(cntw, 1u); cntw[16 + (m >> 8) * 12 + (n >> 8)] = 1u; }
}
__global__ void encode_full(float* out, const unsigned* cntw, int n) {
    __shared__ int bc, bt; if (threadIdx.x == 0) { unsigned C = cntw[0], T = 0; for (int t = 0; t < 1728; ++t) T += cntw[16 + t]; int b1 = 0; while (C) { ++b1; C /= 10; } int b2 = 0; while (T) { ++b2; T /= 4; } bc = b1 > 7 ? 7 : b1; bt = b2 > 7 ? 7 : b2; }
    __syncthreads(); const float K = ldexpf(1.0f, 2 + 8 * bt + bc);
    for (size_t i = (size_t)blockIdx.x * blockDim.x + threadIdx.x; i < (size_t)n; i += (size_t)gridDim.x * blockDim.x) out[i] = K;
}
__global__ void encode(float* out, const float* res, int n, float thr) {
    #if DBG_GSUB == 1
    { const unsigned mk = ((const unsigned*)res)[48]; const float K = ldexpf(1.0f, 2 + (int)mk); for (size_t i = (size_t)blockIdx.x * blockDim.x + threadIdx.x; i < (size_t)n; i += (size_t)gridDim.x * blockDim.x) out[i] = K; return; }
#endif
#ifndef CHK_SKIP
#define CHK_SKIP 0ull
#endif
    int bad = -1; for (int s = 0; s < 64; ++s) if (!((CHK_SKIP >> s) & 1ull) && res[s] > thr) { bad = s; break; }
    if (bad < 0) return; const float er = res[bad]; const float K = ldexpf(1.0f, bad + 2) * (er < 0.5f ? 1.0f : er < 1.0f ? 1.25f : er < 4.0f ? 1.5f : 1.75f);
    for (size_t i = (size_t)blockIdx.x * blockDim.x + threadIdx.x; i < (size_t)n; i += (size_t)gridDim.x * blockDim.x) out[i] = K;
}
#endif
#ifndef GP_SP2
#define GP_SP2 true
#endif
#ifndef GP_ALIGN
#define GP_ALIGN true
#endif
__global__ void __launch_bounds__(NTHR, 2) fwd(Args args) {
    extern __shared__ __attribute__((aligned(16))) unsigned char lds[];
    Frame F;
    F.lds = (LAS unsigned char*)lds; F.MISC = (volatile LAS unsigned*)(F.lds + MISC_OFF);
    F.tid = threadIdx.x; F.lane = F.tid & 63; F.wave = __builtin_amdgcn_readfirstlane(F.tid >> 6);
    F.G = gridDim.x; { const int bx = blockIdx.x; F.vcu = (F.G % 8 == 0) ? (bx % 8) * (F.G / 8) + bx / 8 : bx; }
    { const AV A0 = av_get(); F.ctl = (gu32*)(A0.ws() + WS_CTL); }
    for (int u = F.tid; u < (LDS_BYTES - LDSCTL_OFF) / 4; u += NTHR) ((LAS unsigned*)(F.lds + LDSCTL_OFF))[u] = 0u;
    __syncthreads();
    XcdBarrier bar; bar.bar = (unsigned*)(F.ctl + CW_BAR); bar.x = 0; bar.st = nullptr;
    if (!MK_PER_PHASE) bar = xcd_barrier_post((unsigned*)(F.ctl + CW_BAR), F.MISC + 8);
    int lo, hi; { const AV A0 = av_get(); lo = *(const int __attribute__((address_space(4)))*)(A0.kp + 8 * 31); hi = *(const int __attribute__((address_space(4)))*)(A0.kp + 8 * 31 + 4); }
#ifndef DIS_MASK
#define DIS_MASK 0ull
#endif
#define IN(k) (lo <= (k) && (k) < hi)
#define ON(j) (!((DIS_MASK >> (j)) & 1ull))
#ifndef REP_MASK
#define REP_MASK 0ull
#endif
#define REPS(j) ((int)((REP_MASK >> (j)) & 1ull))
#ifdef STAMP_SEL
#define SEAM(k) do { xcd_barrier(bar); if (blockIdx.x == 0 && threadIdx.x == 0) ((unsigned long long*)(F.ctl + 32768))[(k) + 1] = __builtin_amdgcn_s_memrealtime(); } while (0)
#else
#ifdef DOUBLE_BAR
#define SEAM(k) do { if (!MK_PER_PHASE && IN((k) + 1)) { xcd_barrier(bar); xcd_barrier(bar); } } while (0)
#else
#define SEAM(k) do { if (!MK_PER_PHASE && IN((k) + 1)) xcd_barrier(bar); } while (0)
#endif
#endif
    const int bx = (int)blockIdx.x;
    const int wave0 = __builtin_amdgcn_readfirstlane((int)threadIdx.x >> 6);
#define F_REFRESH() do { unsigned z_ = 0u; asm volatile("" : "+v"(z_)); const int t_ = wave0 * 64 + (int)__builtin_amdgcn_mbcnt_hi(~0u, __builtin_amdgcn_mbcnt_lo(~0u, z_)); F.tid = t_; F.lane = t_ & 63; F.wave = wave0; } while (0)

#ifdef STAMP_SEL
    if (blockIdx.x == 0 && threadIdx.x == 0) ((unsigned long long*)(F.ctl + 32768))[0] = __builtin_amdgcn_s_memrealtime();
#endif
    if (ON(0) && IN(0)) for (int rep_ = 0; rep_ <= REPS(0); ++rep_) { F_REFRESH(); const AV A = av_get(); p0_prologue(F, A); SEAM(0); }
    if (ON(1) && IN(1)) for (int rep_ = 0; rep_ <= REPS(1); ++rep_) { F_REFRESH(); const AV A = av_get(); p1_norm0(F, A); SEAM(1); }

    for (int l = 0; l < 2; ++l) {
        const int pb = 2 + l * NPL;
        const int Mm = (l == 0) ? TALL : TL;
#define PH_BEGIN F_REFRESH(); const AV A = av_get(); unsigned char* const ws = A.ws(); unsigned char* const wl = ws + WS_WSMALL + (size_t)l * WSMALL_LAYER; (void)wl
        if (ON(2 + 0) && IN(pb + 0)) for (int rep_ = 0; rep_ <= REPS(2 + 0); ++rep_) { PH_BEGIN;
            if (ON(16)) { pg8::Gemm g{(const bf16*)(ws + WS_H8), (const bf16*)(wl + OFFS_WIN), TALL, 2560, DM / 2}; pg8::StaticOrder S; S.init(TALL, 2560, F.G, bx);
              pg8::EpiInproj E{(bf16*)(ws + WS_Q), (bf16*)(ws + WS_K), (bf16*)(ws + WS_V), (bf16*)(ws + WS_CU)};
              pg8::gemm_phase<pg8::EpiInproj, pg8::StaticOrder, GP_ALIGN, GP_SP2, true>(F.lds + RING_OFF, g, S, E, F.tid); }
            if (ON(17)) { pg8::Gemm g{(const bf16*)(wl + OFFS_WF), (const bf16*)(ws + WS_H), 1024, Mm, DM}; pg8::StaticOrder S; S.init(1024, Mm, F.G, (bx + 96) % F.G);
              pg8::EpiYT E{ws + WS_YT, ws + WS_YTC};
              pg8::gemm_phase<pg8::EpiYT, pg8::StaticOrder, GP_ALIGN, GP_SP2>(F.lds + RING_OFF, g, S, E, F.tid); }
            SEAM(pb + 0);
        }
        if (ON(2 + 1) && IN(pb + 1)) for (int rep_ = 0; rep_ <= REPS(2 + 1); ++rep_) { PH_BEGIN;
            if (ON(18)) p_qkfix(F, A, l, TALL);
            F_REFRESH();
            if (ON(19)) p_conv(F, A, l, l == 0 ? 1152 : 1024);
            if (ON(20)) { pg8::Gemm g{(const bf16*)(ws + WS_DFTL), (const bf16*)(ws + WS_YT), 2048, NB * 512, 2048}; pg8::DftOrder S; S.init(3, NB, F.G, F.vcu);
              pg8::EpiDFT E{(bf16*)(ws + WS_Z), 0, SEQ};
              pg8::gemm_phase<pg8::EpiDFT, pg8::DftOrder, GP_ALIGN, GP_SP2, true>(F.lds + RING_OFF, g, S, E, F.tid); }
            if (ON(21) && l == 0) { pg8::Gemm g{(const bf16*)(ws + WS_DFTC), (const bf16*)(ws + WS_YTC), 256, NB * 512, 256}; pg8::DftOrder S; S.init(0, NB, F.G, F.vcu);
              pg8::EpiDFT E{(bf16*)(ws + WS_Z), TL, CTXL};
              pg8::gemm_phase<pg8::EpiDFT, pg8::DftOrder, GP_ALIGN, GP_SP2, true>(F.lds + RING_OFF, g, S, E, F.tid); }
            SEAM(pb + 1);
        }
        if (ON(2 + 2) && IN(pb + 2)) for (int rep_ = 0; rep_ <= REPS(2 + 2); ++rep_) { PH_BEGIN;
            const int nheavy = NB * 8 * 8, ntot = nheavy + (l == 0 ? NB * 8 : 0);
            for (int L = F.vcu; L < ntot; L += F.G) {
                int row0, krow, h, seq;
                if (L < nheavy) { const int grp = L >> 5, s = L & 31, b = grp >> 1; h = (grp & 1) * 4 + (s >> 3); row0 = b * SEQ + (s & 7) * 256; krow = b * KVROWS; seq = KVROWS; }
                else { const int Lc = L - nheavy, b = Lc >> 3; h = Lc & 7; row0 = TL + b * CTXL; krow = b * KVROWS + SEQ; seq = CTXL; }
                const att::bf16* Qb = (const att::bf16*)(ws + WS_Q) + (size_t)row0 * DM + h * 128;
                const att::bf16* Kh = (const att::bf16*)(ws + WS_K) + (size_t)krow * 256 + (h >> 2) * 128;
                const att::bf16* Vh = (const att::bf16*)(ws + WS_V) + (size_t)krow * 256 + (h >> 2) * 128;
                unsigned char* Ob = ws + WS_AO + (size_t)row0 * DM + h * 128;
                att::attn_dense_body<att::bf16>(Qb, Kh, Vh, Ob, seq, (char*)lds + RING_OFF, F.tid);
                __syncthreads();
            }
            SEAM(pb + 2);
        }
        if (ON(2 + 3) && IN(pb + 3)) for (int rep_ = 0; rep_ <= REPS(2 + 3); ++rep_) { PH_BEGIN;
            pg8::Gemm g{(const bf16*)(ws + WS_H8), (const bf16*)(wl + OFFS_WG), Mm, 3072, DM / 2}; pg8::StaticOrder S; S.init(Mm, 3072, F.G, bx);
            pg8::EpiGates E{(bf16*)(ws + WS_GATES)};
            pg8::gemm_phase<pg8::EpiGates, pg8::StaticOrder, GP_ALIGN, GP_SP2, true>(F.lds + RING_OFF, g, S, E, F.tid);
            SEAM(pb + 3);
        }
        if (ON(2 + 4) && IN(pb + 4)) for (int rep_ = 0; rep_ <= REPS(2 + 4); ++rep_) { PH_BEGIN;
            { pg8::Gemm g{(const bf16*)(ws + WS_AO), (const bf16*)(wl + OFFS_WAO), Mm, 1024, 512}; pg8::StaticOrder S; S.init(Mm, 1024, F.G, bx);
              pg8::EpiMerge<true> E{(bf16*)(ws + WS_MERGED), (const bf16*)(ws + WS_GATES), 0, 1.0f / 2048.0f};
              pg8::gemm_phase<pg8::EpiMerge<true>, pg8::StaticOrder, GP_ALIGN, GP_SP2, true>(F.lds + RING_OFF, g, S, E, F.tid); }
#pragma unroll 1
            for (int br = 1; br < 3; ++br) {
              pg8::Gemm g{(const bf16*)(ws + (br == 1 ? WS_CH : WS_Z)), (const bf16*)(wl + (br == 1 ? OFFS_WCO : OFFS_WFO)), Mm, 1024, 512}; pg8::StaticOrder S; S.init(Mm, 1024, F.G, bx);
              pg8::EpiMerge<false> E{(bf16*)(ws + WS_MERGED), (const bf16*)(ws + WS_GATES), br, 1.0f};
              pg8::gemm_phase<pg8::EpiMerge<false>, pg8::StaticOrder, GP_ALIGN, GP_SP2>(F.lds + RING_OFF, g, S, E, F.tid); }
            SEAM(pb + 4);
        }
        if (ON(2 + 5) && IN(pb + 5)) for (int rep_ = 0; rep_ <= REPS(2 + 5); ++rep_) { PH_BEGIN;
            pg8::Gemm g{(const bf16*)(ws + WS_MERGED), (const bf16*)(wl + OFFS_WOUT), Mm, 1024, 1024}; pg8::StaticOrder S; S.init(Mm, 1024, F.G, bx);
            pg8::EpiBf16<0> E{(bf16*)(ws + WS_MIX), 1024, nullptr, 0, 0, 1.0f};
            pg8::gemm_phase<pg8::EpiBf16<0>, pg8::StaticOrder, GP_ALIGN, GP_SP2>(F.lds + RING_OFF, g, S, E, F.tid);
            SEAM(pb + 5);
        }
        if (ON(2 + 6) && IN(pb + 6)) for (int rep_ = 0; rep_ <= REPS(2 + 6); ++rep_) { PH_BEGIN; p_rowpass1(F, A, l, Mm); p_route(F, A, l, Mm); SEAM(pb + 6); }
        if (ON(2 + 7) && IN(pb + 7)) for (int rep_ = 0; rep_ <= REPS(2 + 7); ++rep_) { PH_BEGIN; p_slots(F, A, Mm); SEAM(pb + 7); }
        if (ON(2 + 8) && IN(pb + 8)) for (int rep_ = 0; rep_ <= REPS(2 + 8); ++rep_) { PH_BEGIN;
            const int NT = __builtin_amdgcn_readfirstlane(((const int*)(ws + WS_CNT))[CNT_NT]);
            pg8::Gemm g{(const bf16*)(ws + WS_HS), (const bf16*)(ws + WS_WGU + (size_t)l * MOEW_LAYER), NT * 256, NEXP * 2048, DM / 2}; pg8::GroupedOrder S; S.init(NT, 8, F.G, bx, (const int*)(ws + WS_CNT) + CNT_TILE_E);
            pg8::EpiSwiGLU8 E{ws + WS_ACT, A.in(24) + (size_t)l * NEXP * 1024, A.in(26) + (size_t)l * NEXP * 1024};
            pg8::gemm_phase<pg8::EpiSwiGLU8, pg8::GroupedOrder, GP_ALIGN, GP_SP2, true>(F.lds + RING_OFF, g, S, E, F.tid);
            SEAM(pb + 8);
        }
        if (ON(2 + 9) && IN(pb + 9)) for (int rep_ = 0; rep_ <= REPS(2 + 9); ++rep_) { PH_BEGIN;
            const int NT = __builtin_amdgcn_readfirstlane(((const int*)(ws + WS_CNT))[CNT_NT]);
#ifdef STAGGER_US
            { const unsigned long long t0 = __builtin_amdgcn_s_memrealtime(), dl = (unsigned long long)((bx >> 3) & 3) * (STAGGER_US); while (__builtin_amdgcn_s_memrealtime() - t0 < dl) __builtin_amdgcn_s_sleep(8); }
#endif
            pg8::Gemm g{(const bf16*)(ws + WS_ACT), (const bf16*)(ws + WS_WD + (size_t)l * MOEW_LAYER), NT * 256, NEXP * 1024, DM / 2}; pg8::GroupedOrder S; S.init(NT, 4, F.G, bx, (const int*)(ws + WS_CNT) + CNT_TILE_E);
#ifdef PROBE_NOSTORE
            pg8::EpiDown8 E{(bf16*)(ws + WS_YS), A.in(28) + (size_t)l * NEXP * 1024, rep_};
#else
            pg8::EpiDown8 E{(bf16*)(ws + WS_YS), A.in(28) + (size_t)l * NEXP * 1024, 0};
#endif
            pg8::gemm_phase<pg8::EpiDown8, pg8::GroupedOrder, GP_ALIGN, GP_SP2, true>(F.lds + RING_OFF, g, S, E, F.tid);
            SEAM(pb + 9);
        }
        if (ON(2 + 10) && IN(pb + 10)) for (int rep_ = 0; rep_ <= REPS(2 + 10); ++rep_) { PH_BEGIN;
            p_combine(F, A, l, Mm);
            SEAM(pb + 10);
        }
    }
#ifdef STAMP_SEL
    { const AV A = av_get(); float* out = A.out(); const unsigned long long* ts = (const unsigned long long*)(F.ctl + 32768);
      auto span = [&](int p) -> float { unsigned long long d = __hip_atomic_load(ts + p + 1, __ATOMIC_RELAXED, __HIP_MEMORY_SCOPE_AGENT) - __hip_atomic_load(ts + p, __ATOMIC_RELAXED, __HIP_MEMORY_SCOPE_AGENT);
          if (p >= 2) d += __hip_atomic_load(ts + p + NPL + 1, __ATOMIC_RELAXED, __HIP_MEMORY_SCOPE_AGENT) - __hip_atomic_load(ts + p + NPL, __ATOMIC_RELAXED, __HIP_MEMORY_SCOPE_AGENT); return (float)d * 0.01f; };
      const float K1 = span((STAMP_SEL) & 0xff), K2 = 200.0f * span(((STAMP_SEL) >> 8) & 0xff);
      for (size_t i = (size_t)blockIdx.x * NTHR + threadIdx.x; i < (size_t)TL * DM; i += (size_t)gridDim.x * NTHR) out[i] = (i == 0) ? K2 : K1; }
#endif
#undef IN
#undef PH_BEGIN
#undef F_REFRESH
#undef SEAM
}

extern "C" void kernel_launch(void* const* d_in, const int* in_sizes, int n_in, void* d_out, int out_size, void* d_ws, size_t ws_size, hipStream_t stream) {
    static int grid = 0;
    if (grid == 0) {
        if (n_in != 29 || out_size != TL * DM || ws_size < WS_END2) { fprintf(stderr, "kernel_launch: built for 29 inputs, %d outputs, >= %zu bytes of workspace; got n_in %d out %d ws %zu\n", TL * DM, (size_t)WS_END2, n_in, out_size, ws_size); grid = -1; return; }
        int dev = 0, cus = 0, per_cu = 0;
        if (hipGetDevice(&dev) != hipSuccess || hipDeviceGetAttribute(&cus, hipDeviceAttributeMultiprocessorCount, dev) != hipSuccess) { grid = -1; return; }
        if (hipFuncSetAttribute((const void*)fwd, hipFuncAttributeMaxDynamicSharedMemorySize, LDS_BYTES) != hipSuccess) { fprintf(stderr, "kernel_launch: hipFuncSetAttribute failed\n"); grid = -1; return; }
        if (hipOccupancyMaxActiveBlocksPerMultiprocessor(&per_cu, (const void*)fwd, NTHR, LDS_BYTES) != hipSuccess || per_cu < 1) fprintf(stderr, "kernel_launch: occupancy query reports %d\n", per_cu);
        (void)hipGetLastError();
        grid = cus;
    }
    if (grid < 0) return;
    (void)hipMemsetAsync((char*)d_ws + WS_CTL, 0, CTL_ZERO_BYTES, stream);
    Args a{};
    for (int i = 0; i < 29; ++i) a.in[i] = (const float*)d_in[i];
    a.out = (float*)d_out; a.ws = (unsigned char*)d_ws;
#if MK_PER_PHASE
    for (int p = 0; p < NPH; ++p) {
#ifdef DBG_CHECK
        float* res = (float*)((char*)d_ws + WS_CTL + 8192 * 4); float* snap = (float*)((char*)d_ws + WS_END);
        { const int l = p >= 2 ? (p - 2) / NPL : 0, k = p >= 2 ? (p - 2) % NPL : -1;
          if (k == 6) hipLaunchKernelGGL(snap_rows, dim3(256), dim3(256), 0, stream, a, l, 11, snap);
          if (k == 12) hipLaunchKernelGGL(snap_rows, dim3(256), dim3(256), 0, stream, a, l, 17, snap); }
#endif
        a.ph_lo = p; a.ph_hi = p + 1; hipLaunchKernelGGL(fwd, dim3(grid), dim3(NTHR), LDS_BYTES, stream, a);
#ifdef DBG_CHECK
        { const int l = p >= 2 ? (p - 2) / NPL : 0, k = p >= 2 ? (p - 2) % NPL : -1;
#define CHK(st) hipLaunchKernelGGL(chk, dim3(1), dim3(256), 0, stream, a, (int)(st), l, res, snap)
          if (p == 0) CHK(ST_MOD); if (p == 1) CHK(ST_H0);
#if DBG_GSUB == 2
          if (k == 3 && l == 0) hipLaunchKernelGGL(chk_gates_full, dim3(48, TALL / 4), dim3(256), 0, stream, (const bf16*)((char*)d_ws + WS_H), (const bf16*)((char*)d_ws + WS_WSMALL + OFFS_WG), (const bf16*)((char*)d_ws + WS_GATES), TALL, (unsigned*)((char*)d_ws + WS_CTL + 65536));
#endif
          if (k == 0) { CHK(ST_INPROJ); CHK(ST_YT); } if (k == 1) { CHK(ST_QKFIX); CHK(ST_CONV); CHK(ST_Z); } if (k == 2) CHK(ST_ATTN); if (k == 3) { CHK(ST_GATES); CHK(ST_GATESB); } if (k == 4) CHK(ST_MERGED);
          if (k == 5) CHK(ST_MIX); if (k == 6) CHK(ST_ROW1); if (k == 7) CHK(ST_LOGIT); if (k == 8) CHK(ST_TOPK); if (k == 9) CHK(ST_SLOTS); if (k == 10) CHK(ST_ACT); if (k == 11) CHK(ST_YSLOT); if (k == 12) CHK(ST_COMB);
#undef CHK
        }
#endif
    }
#ifdef DBG_CHECK
#if DBG_GSUB == 2
    hipLaunchKernelGGL(encode_full, dim3(1024), dim3(256), 0, stream, (float*)d_out, (const unsigned*)((char*)d_ws + WS_CTL + 65536), out_size);
#else
    hipLaunchKernelGGL(encode, dim3(1024), dim3(256), 0, stream, (float*)d_out, (const float*)((char*)d_ws + WS_CTL + 8192 * 4), out_size, 0.25f);
#endif
#endif
#else
    a.ph_lo = 0; a.ph_hi = NPH; hipLaunchKernelGGL(fwd, dim3(grid), dim3(NTHR), LDS_BYTES, stream, a);
#endif
    const hipError_t le = hipPeekAtLastError();
    if (le != hipSuccess) fprintf(stderr, "kernel_launch: launch failed: %s\n", hipGetErrorName(le));
}
```

```cpp
#include <hip/hip_runtime.h>
#include <cstdio>
#include <cstdint>
#ifndef MK_PER_PHASE
#define MK_PER_PHASE 0
#endif
namespace pg8 {
#define PG8_LAS __attribute__((address_space(3)))
typedef unsigned short bf16_t;
typedef short bf16x8 __attribute__((ext_vector_type(8)));
typedef float f32x4 __attribute__((ext_vector_type(4)));
typedef unsigned u32x4 __attribute__((ext_vector_type(4)));
typedef int i32x4v __attribute__((ext_vector_type(4)));
typedef int i32x8v __attribute__((ext_vector_type(8)));
typedef unsigned u32x2v __attribute__((ext_vector_type(2)));
constexpr int BM = 256, BK = 64, HALF = 128, HTB = HALF * BK * 2  , STAGE_BYTES = 8 * HTB, NXCD = 8, WGM = 8;

__host__ __device__ __forceinline__ int lds_byte(int r, int c) { const int st = (r >> 4) * 2 + (c >> 5), rr = r & 15, cc = c & 31, ob = rr * 64 + cc * 2; return st * 1024 + (ob ^ (((ob >> 9) & 1) << 5)); }
__host__ __device__ __forceinline__ void stage_rc(int b, int& R, int& C) { const int st = b / 1024, sb = b % 1024, swz = sb ^ (((sb >> 9) & 1) << 5); R = (st >> 1) * 16 + swz / 64; C = (st & 1) * 32 + (swz % 64) / 2; }
__host__ __device__ __forceinline__ int perm32(int rho) { const int n = rho >> 4, i = rho & 15; return 8 * (i >> 2) + 4 * n + (i & 3); }

struct Unit { int pm, pn; };
struct Gemm { const bf16_t* A; const bf16_t* Bt; int M, N, K; };

struct StaticOrder {
    int nM, nN, nwg, G, c;
    __host__ __device__ void init(int M, int N, int G_, int c_) { nM = M / BM; nN = N / BM; nwg = nM * nN; G = G_; c = c_; }
    __host__ __device__ bool next(int i, Unit& u) const {
        const long L = (long)i * G + c; if (L >= nwg) return false;
        int wgid = (int)L; { const int q = nwg / NXCD, r = nwg % NXCD, xcd = wgid % NXCD, off = wgid / NXCD; wgid = (xcd < r ? xcd * (q + 1) : r * (q + 1) + (xcd - r) * q) + off; }
        const int nig = WGM * nN, gid = wgid / nig, fm = gid * WGM, gsz = (nM - fm) < WGM ? (nM - fm) : WGM;
        u.pm = fm + ((wgid % nig) % gsz); u.pn = (wgid % nig) / gsz; return true;
    }
    __device__ __forceinline__ void a_ready(const Unit&) const {}
    __device__ __forceinline__ void done(const Unit&) const {}
};

typedef __bf16 bf16x2_native __attribute__((ext_vector_type(2)));
typedef float f32x2_native __attribute__((ext_vector_type(2)));
__device__ __forceinline__ unsigned cvt_pk_bf16(float lo, float hi) { const f32x2_native v = {lo, hi}; const bf16x2_native r = __builtin_convertvector(v, bf16x2_native); return __builtin_bit_cast(unsigned, r); }
__device__ __forceinline__ unsigned cvt4_fp8(float a, float b, float c, float d) { int w = __builtin_amdgcn_cvt_pk_fp8_f32(a, b, __builtin_bit_cast(int, a), false); w = __builtin_amdgcn_cvt_pk_fp8_f32(c, d, w, true); return (unsigned)w; }
typedef float f32x2 __attribute__((ext_vector_type(2)));
__device__ __forceinline__ f32x2 gelu_pk(f32x2 v) {
    const f32x2 av = __builtin_elementwise_abs(v), d = av * 0.2316418882f + 1.0f;
    f32x2 t; t.x = __builtin_amdgcn_rcpf(d.x); t.y = __builtin_amdgcn_rcpf(d.y);
    f32x2 q = t * 0.5307027145f + (-0.7265760135f); q = q * t + 0.7107068705f; q = q * t + (-0.142248368f); q = q * t + 0.127414796f; q = q * t;
    const f32x2 s = (v * v) * (-0.72134752044f);
    f32x2 e; e.x = __builtin_amdgcn_exp2f(s.x); e.y = __builtin_amdgcn_exp2f(s.y);
    const f32x2 m = v * (q * e), r = v - m;
    f32x2 o; o.x = v.x < 0.f ? m.x : r.x; o.y = v.y < 0.f ? m.y : r.y; return o;
}

template <int ACT  > struct EpiBf16 {
    static constexpr bool PERM = true, AFTER_DRAIN = false; static_assert(ACT == 0 || ACT == 1, "EpiBf16: ACT is 0 (none) or 1 (gelu_pk)");
    bf16_t* O; int ldc; const float* bias; int split_cols; size_t split_stride; float scale0;
    __device__ __forceinline__ void operator()(const f32x4 (&acc)[2][2][4][2], const Unit& u, int wr, int wc, int fr, int fq) const {
        const int row0 = u.pm * BM + wr * 64 + fr; int colt = u.pn * BM; bf16_t* base = O;
        float sc = 1.f; if (split_cols) { const int t = colt / split_cols; base += (size_t)t * split_stride; colt -= t * split_cols; if (t == 0) sc = scale0; }
        const int col0 = colt + wc * 32 + 8 * fq, bcol0 = u.pn * BM + wc * 32 + 8 * fq;
        f32x4 bv[2][2];
#pragma unroll
        for (int bj = 0; bj < 2; ++bj)
#pragma unroll
            for (int n = 0; n < 2; ++n) bv[bj][n] = bias ? *(const f32x4*)(bias + bcol0 + bj * HALF + 4 * n) : (f32x4){0.f, 0.f, 0.f, 0.f};
#pragma unroll
        for (int ai = 0; ai < 2; ++ai)
#pragma unroll
            for (int m = 0; m < 4; ++m) { bf16_t* rowp = base + (size_t)(row0 + ai * HALF + m * 16) * ldc + col0;
#pragma unroll
                for (int bj = 0; bj < 2; ++bj) { f32x4 v0 = acc[ai][bj][m][0] + bv[bj][0], v1 = acc[ai][bj][m][1] + bv[bj][1];
                    if (ACT == 1) { f32x2 a = gelu_pk((f32x2){v0[0], v0[1]}), b = gelu_pk((f32x2){v0[2], v0[3]}), c = gelu_pk((f32x2){v1[0], v1[1]}), d = gelu_pk((f32x2){v1[2], v1[3]});
                        v0 = (f32x4){a.x, a.y, b.x, b.y}; v1 = (f32x4){c.x, c.y, d.x, d.y}; }
                    v0 = v0 * sc; v1 = v1 * sc; u32x4 w; w.x = cvt_pk_bf16(v0[0], v0[1]); w.y = cvt_pk_bf16(v0[2], v0[3]); w.z = cvt_pk_bf16(v1[0], v1[1]); w.w = cvt_pk_bf16(v1[2], v1[3]);
                    *(u32x4*)(rowp + bj * HALF) = w; } }
    }
};

__device__ __forceinline__ float fast_sigmoid(float x) { return __builtin_amdgcn_rcpf(1.0f + __builtin_amdgcn_exp2f(-1.4426950408889634f * x)); }
__device__ __forceinline__ u32x4 pack8(const f32x4& a, const f32x4& b) { u32x4 w; w.x = cvt_pk_bf16(a[0], a[1]); w.y = cvt_pk_bf16(a[2], a[3]); w.z = cvt_pk_bf16(b[0], b[1]); w.w = cvt_pk_bf16(b[2], b[3]); return w; }
__device__ __forceinline__ void unpack8(const u32x4& w, f32x4& a, f32x4& b) {
    a[0] = __uint_as_float(w.x << 16); a[1] = __uint_as_float(w.x & 0xffff0000u); a[2] = __uint_as_float(w.y << 16); a[3] = __uint_as_float(w.y & 0xffff0000u);
    b[0] = __uint_as_float(w.z << 16); b[1] = __uint_as_float(w.z & 0xffff0000u); b[2] = __uint_as_float(w.w << 16); b[3] = __uint_as_float(w.w & 0xffff0000u); }
__device__ __forceinline__ u32x2v pack8_fp8(const f32x4& a, const f32x4& b) { u32x2v r; r.x = cvt4_fp8(a[0], a[1], a[2], a[3]); r.y = cvt4_fp8(b[0], b[1], b[2], b[3]); return r; }
__device__ __forceinline__ void store_tile_bf16(const f32x4 (&acc)[2][2][4][2], bf16_t* base, int ldc, int wr, int wc, int fr, int fq) {
    const int rt = wr * 64 + fr, cb = wc * 32 + 8 * fq;
#pragma unroll
    for (int ai = 0; ai < 2; ++ai)
#pragma unroll
        for (int m = 0; m < 4; ++m) { bf16_t* rowp = base + (size_t)(rt + ai * HALF + m * 16) * ldc + cb;
#pragma unroll
            for (int bj = 0; bj < 2; ++bj) *(u32x4*)(rowp + bj * HALF) = pack8(acc[ai][bj][m][0], acc[ai][bj][m][1]); }
}
struct EpiInproj {
    static constexpr bool PERM = true, AFTER_DRAIN = false;
    bf16_t *q, *k, *v, *cu;
    __device__ __forceinline__ void operator()(const f32x4 (&acc)[2][2][4][2], const Unit& u, int wr, int wc, int fr, int fq) const {
        bf16_t* base; int ldc; const bool glu = u.pn >= 6; float sc = 0.03125f; asm volatile("" : "+s"(sc));
        if (u.pn < 4) { base = q + (size_t)u.pm * 256 * 1024 + u.pn * 256; ldc = 1024; }
        else if (u.pn < 6) { const int m0 = u.pm * 256; const int kr = m0 < 32768 ? (m0 >> 11) * 2304 + (m0 & 2047) : ((m0 - 32768) >> 8) * 2304 + 2048; base = (u.pn == 4 ? k : v) + (size_t)kr * 256; ldc = 256; }
        else { base = cu + (size_t)u.pm * 256 * 512 + (u.pn - 6) * 128; ldc = 512; }
        base += (size_t)(wr * 64 + fr) * ldc + wc * 32 + 8 * fq;
#pragma unroll
        for (int ai = 0; ai < 2; ++ai)
#pragma unroll
            for (int m = 0; m < 4; ++m) { bf16_t* rowp = base + (size_t)(ai * HALF + m * 16) * ldc;
                if (!glu) { *(u32x4*)rowp = pack8(acc[ai][0][m][0] * sc, acc[ai][0][m][1] * sc); *(u32x4*)(rowp + HALF) = pack8(acc[ai][1][m][0] * sc, acc[ai][1][m][1] * sc); }
                else { f32x4 a0 = acc[ai][0][m][0] * sc, a1 = acc[ai][0][m][1] * sc; const f32x4 g0 = acc[ai][1][m][0] * sc, g1 = acc[ai][1][m][1] * sc;
#pragma unroll
                    for (int j = 0; j < 4; ++j) { a0[j] *= fast_sigmoid(g0[j]); a1[j] *= fast_sigmoid(g1[j]); }
                    *(u32x4*)rowp = pack8(a0, a1); } }
    }
};
struct EpiYT {
    static constexpr bool PERM = true, AFTER_DRAIN = false;
    unsigned char *yt, *ytc;
    __device__ __forceinline__ void operator()(const f32x4 (&acc)[2][2][4][2], const Unit& u, int wr, int wc, int fr, int fq) const {
        const int cs = u.pm >> 1, chb = (u.pm & 1) * 256; unsigned char* base; int ldc;
        if (u.pn < 128) { const int b = u.pn >> 3, pos0 = (u.pn & 7) * 256; base = yt + (size_t)(b * 512 + chb) * 4096 + cs * 2048 + pos0; ldc = 4096; }
        else { const int b = u.pn - 128; base = ytc + (size_t)(b * 512 + chb) * 512 + cs * 256; ldc = 512; }
        base += (size_t)(wr * 64 + fr) * ldc + wc * 32 + 8 * fq;
#pragma unroll
        for (int ai = 0; ai < 2; ++ai)
#pragma unroll
            for (int m = 0; m < 4; ++m) { unsigned char* rowp = base + (size_t)(ai * HALF + m * 16) * ldc;
#pragma unroll
                for (int bj = 0; bj < 2; ++bj) *(u32x2v*)(rowp + bj * HALF) = pack8_fp8(acc[ai][bj][m][0], acc[ai][bj][m][1]); }
    }
};
struct EpiDFT {
    static constexpr bool PERM = true, AFTER_DRAIN = false;
    bf16_t* z; int rowbase, rpb;
    __device__ __forceinline__ void operator()(const f32x4 (&acc)[2][2][4][2], const Unit& u, int wr, int wc, int fr, int fq) const {
        bf16_t* base = z + (size_t)(rowbase + (u.pn >> 1) * rpb + u.pm * 256 + wr * 64 + fr) * 512 + (u.pn & 1) * 256 + wc * 32 + 8 * fq;
#pragma unroll
        for (int ai = 0; ai < 2; ++ai)
#pragma unroll
            for (int m = 0; m < 4; ++m)
#pragma unroll
                for (int bj = 0; bj < 2; ++bj) *(u32x4*)(base + (size_t)(ai * HALF + m * 16) * 512 + bj * HALF) = pack8(acc[ai][bj][m][0] * 0.03125f, acc[ai][bj][m][1] * 0.03125f);
    }
};
struct EpiGates {
    static constexpr bool PERM = true, AFTER_DRAIN = false;
    bf16_t* g;
    __device__ __forceinline__ void operator()(const f32x4 (&acc)[2][2][4][2], const Unit& u, int wr, int wc, int fr, int fq) const {
        const int rt = wr * 64 + fr, cb = wc * 32 + 8 * fq; bf16_t* base = g + (size_t)u.pm * 256 * 3072 + u.pn * 256 + cb;
        float cs = -1.4426950408889634f * 0.03125f; asm volatile("" : "+s"(cs));
#pragma unroll
        for (int ai = 0; ai < 2; ++ai)
#pragma unroll
            for (int m = 0; m < 4; ++m)
#pragma unroll
                for (int bj = 0; bj < 2; ++bj) { f32x4 a0 = acc[ai][bj][m][0], a1 = acc[ai][bj][m][1];
#pragma unroll
                    for (int j = 0; j < 4; ++j) { a0[j] = __builtin_amdgcn_rcpf(1.0f + __builtin_amdgcn_exp2f(a0[j] * cs)); a1[j] = __builtin_amdgcn_rcpf(1.0f + __builtin_amdgcn_exp2f(a1[j] * cs)); }
                    __builtin_nontemporal_store(pack8(a0, a1), (u32x4*)(base + (size_t)(rt + ai * HALF + m * 16) * 3072 + bj * HALF)); }
    }
};
template <bool FIRST> struct EpiMerge {
    static constexpr bool PERM = true, AFTER_DRAIN = false;
    bf16_t* mg; const bf16_t* g; int br; float scale;
    __device__ __forceinline__ void operator()(const f32x4 (&acc)[2][2][4][2], const Unit& u, int wr, int wc, int fr, int fq) const {
        const int rt = u.pm * 256 + wr * 64 + fr, cb = u.pn * 256 + wc * 32 + 8 * fq; float sc = scale; asm volatile("" : "+s"(sc));
#pragma unroll
        for (int ai = 0; ai < 2; ++ai)
#pragma unroll
            for (int m = 0; m < 4; ++m)
#pragma unroll
                for (int bj = 0; bj < 2; ++bj) { const size_t row = (size_t)(rt + ai * HALF + m * 16); const int col = cb + bj * HALF;
                    const u32x4 gw = *(const u32x4*)(g + row * 3072 + br * 1024 + col); f32x4 g0, g1; unpack8(gw, g0, g1);
                    f32x4 v0 = acc[ai][bj][m][0] * sc * g0, v1 = acc[ai][bj][m][1] * sc * g1;
                    if (!FIRST) { const u32x4 ow = *(const u32x4*)(mg + row * 1024 + col); f32x4 o0, o1; unpack8(ow, o0, o1); v0 += o0; v1 += o1; }
                    *(u32x4*)(mg + row * 1024 + col) = pack8(v0, v1); }
    }
};
struct EpiRouter {
    static constexpr bool PERM = true, AFTER_DRAIN = false;
    float* lg;
    __device__ __forceinline__ void operator()(const f32x4 (&acc)[2][2][4][2], const Unit& u, int wr, int wc, int fr, int fq) const {
        if (wc < 2) { const int rt = u.pm * 256 + wr * 64 + fr, cb = wc * 32 + 8 * fq;
#pragma unroll
            for (int ai = 0; ai < 2; ++ai)
#pragma unroll
                for (int m = 0; m < 4; ++m) { float* p = lg + (size_t)(rt + ai * HALF + m * 16) * 64 + cb; *(f32x4*)p = acc[ai][0][m][0]; *(f32x4*)(p + 4) = acc[ai][0][m][1]; } }
    }
};
struct EpiSwiGLU {
    static constexpr bool PERM = true, AFTER_DRAIN = false;
    bf16_t* act; const float* bg; const float* bu;
    __device__ __forceinline__ void operator()(const f32x4 (&acc)[2][2][4][2], const Unit& u, int wr, int wc, int fr, int fq) const {
        const int e = u.pn >> 3, col = (u.pn & 7) * 128 + wc * 32 + 8 * fq, rt = u.pm * 256 + wr * 64 + fr;
        const f32x4 bg0 = *(const f32x4*)(bg + e * 1024 + col), bg1 = *(const f32x4*)(bg + e * 1024 + col + 4), bu0 = *(const f32x4*)(bu + e * 1024 + col), bu1 = *(const f32x4*)(bu + e * 1024 + col + 4);
#pragma unroll
        for (int ai = 0; ai < 2; ++ai)
#pragma unroll
            for (int m = 0; m < 4; ++m) { f32x4 g0 = acc[ai][0][m][0] + bg0, g1 = acc[ai][0][m][1] + bg1, u0 = acc[ai][1][m][0] + bu0, u1 = acc[ai][1][m][1] + bu1;
#pragma unroll
                for (int j = 0; j < 4; ++j) { const float ga = fminf(g0[j], 7.0f), gb = fminf(g1[j], 7.0f); const float ua = fminf(fmaxf(u0[j], -7.0f), 7.0f), ub = fminf(fmaxf(u1[j], -7.0f), 7.0f);
                    g0[j] = (ua + 1.0f) * (ga * fast_sigmoid(1.702f * ga)); g1[j] = (ub + 1.0f) * (gb * fast_sigmoid(1.702f * gb)); }
                *(u32x4*)(act + (size_t)(rt + ai * HALF + m * 16) * 1024 + col) = pack8(g0, g1); }
    }
};
struct EpiSwiGLU8 {
    static constexpr bool PERM = true, AFTER_DRAIN = false;
    unsigned char* act; const float* bg; const float* bu;
    __device__ __forceinline__ void operator()(const f32x4 (&acc)[2][2][4][2], const Unit& u, int wr, int wc, int fr, int fq) const {
        const int e = u.pn >> 3, col = (u.pn & 7) * 128 + wc * 32 + 8 * fq, rt = u.pm * 256 + wr * 64 + fr;
        const f32x4 bg0 = *(const f32x4*)(bg + e * 1024 + col), bg1 = *(const f32x4*)(bg + e * 1024 + col + 4), bu0 = *(const f32x4*)(bu + e * 1024 + col), bu1 = *(const f32x4*)(bu + e * 1024 + col + 4);
#pragma unroll
        for (int ai = 0; ai < 2; ++ai)
#pragma unroll
            for (int m = 0; m < 4; ++m) { f32x4 g0 = acc[ai][0][m][0] * 0.03125f + bg0, g1 = acc[ai][0][m][1] * 0.03125f + bg1, u0 = acc[ai][1][m][0] * 0.03125f + bu0, u1 = acc[ai][1][m][1] * 0.03125f + bu1;
#pragma unroll
                for (int j = 0; j < 4; ++j) { const float ga = fminf(g0[j], 7.0f), gb = fminf(g1[j], 7.0f); const float ua = fminf(fmaxf(u0[j], -7.0f), 7.0f), ub = fminf(fmaxf(u1[j], -7.0f), 7.0f);
                    g0[j] = (ua + 1.0f) * (ga * fast_sigmoid(1.702f * ga)); g1[j] = (ub + 1.0f) * (gb * fast_sigmoid(1.702f * gb)); }
                __builtin_nontemporal_store(pack8_fp8(g0, g1), (u32x2v*)(act + (size_t)(rt + ai * HALF + m * 16) * 1024 + col)); }
    }
};
struct EpiDown8 {
    static constexpr bool PERM = true, AFTER_DRAIN = false;
    unsigned char* ys; const float* bd; int nostore;
    __device__ __forceinline__ void operator()(const f32x4 (&acc)[2][2][4][2], const Unit& u, int wr, int wc, int fr, int fq) const {
        const int e = u.pn >> 2, col0 = (u.pn & 3) * 256 + wc * 32 + 8 * fq, rt = u.pm * 256 + wr * 64 + fr;
        f32x4 bv[2][2];
#pragma unroll
        for (int bj = 0; bj < 2; ++bj) { bv[bj][0] = *(const f32x4*)(bd + e * 1024 + col0 + bj * HALF) * 8.0f; bv[bj][1] = *(const f32x4*)(bd + e * 1024 + col0 + bj * HALF + 4) * 8.0f; }
#pragma unroll
        for (int ai = 0; ai < 2; ++ai)
#pragma unroll
            for (int m = 0; m < 4; ++m) { unsigned char* rowp = ys + (size_t)(rt + ai * HALF + m * 16) * 1024 + col0;
#pragma unroll
                for (int bj = 0; bj < 2; ++bj) { const u32x2v w = pack8_fp8(acc[ai][bj][m][0] * 0.25f + bv[bj][0], acc[ai][bj][m][1] * 0.25f + bv[bj][1]); if (!nostore) __builtin_nontemporal_store(w, (u32x2v*)(rowp + bj * HALF)); else asm volatile("" :: "v"(w)); } }
    }
};
struct GroupedOrder {
    int nM, nN, nwg, G, c; const int* tile_e;
    __device__ void init(int nM_, int nN_, int G_, int c_, const int* te) { nM = nM_; nN = nN_; nwg = nM * nN; G = G_; c = c_; tile_e = te; }
    __device__ bool next(int i, Unit& u) const {
        const long L = (long)i * G + c; if (L >= nwg) return false;
        int wgid = (int)L; { const int q = nwg / NXCD, r = nwg % NXCD, xcd = wgid % NXCD, off = wgid / NXCD; wgid = (xcd < r ? xcd * (q + 1) : r * (q + 1) + (xcd - r) * q) + off; }
        const int nig = WGM * nN, gid = wgid / nig, fm = gid * WGM, gsz = (nM - fm) < WGM ? (nM - fm) : WGM;
        u.pm = fm + ((wgid % nig) % gsz); const int pl = (wgid % nig) / gsz; u.pn = __builtin_amdgcn_readfirstlane(tile_e[u.pm]) * nN + pl; return true;
    }
    __device__ __forceinline__ void a_ready(const Unit&) const {}
    __device__ __forceinline__ void done(const Unit&) const {}
};
struct DftOrder {
    int lg, n, G, c;
    __device__ void init(int lg_, int nb, int G_, int c_) { lg = lg_; n = (nb * 2) << lg_; G = G_; c = c_; }
    __device__ bool next(int i, Unit& u) const { const int L = i * G + c; if (L >= n) return false; const int b = L >> (lg + 1), rem = L & ((2 << lg) - 1); u.pm = rem & ((1 << lg) - 1); u.pn = 2 * b + (rem >> lg); return true; }
    __device__ __forceinline__ void a_ready(const Unit&) const {}
    __device__ __forceinline__ void done(const Unit&) const {}
};

template <class Epi, class Sched, bool ALIGN_EPI = false, bool SP2 = false, bool FP8 = false>
__device__ __forceinline__ void gemm_phase(PG8_LAS unsigned char* lds, const Gemm g, const Sched& S, const Epi& E, const int tid_in) {
    int tid_ = tid_in; asm volatile("" : "+v"(tid_));
    const int tid = tid_, wid = __builtin_amdgcn_readfirstlane(tid >> 6), lane = tid & 63, wr = wid >> 2, wc = wid & 3, fr = lane & 15, fq = lane >> 4;
    const int K = g.K, nt = K / BK;
    unsigned voffA[2], voffB[2];
#pragma unroll
    for (int i = 0; i < 2; ++i) { int R, C; stage_rc(tid * 16 + i * 8192, R, C); const int Rb = Epi::PERM ? ((R & ~31) + perm32(R & 31)) : R;
        voffA[i] = (unsigned)(R * K + C) * 2u; voffB[i] = (unsigned)(Rb * K + C) * 2u; }
    const size_t kstep = (size_t)(BK * 2);
    const size_t hstep = (size_t)HALF * K * 2;
    const size_t tstep = 2 * hstep;
    const unsigned ldsw = (unsigned)wid * 1024u;
    const int aoff = lds_byte(wr * 64 + fr, fq * 8), boff = lds_byte(wc * 32 + fr, fq * 8);
#define PG8_SA(b, h) (((b) * 2 + (h)) * HTB)
#define PG8_SB(b, h) ((4 + (b) * 2 + (h)) * HTB)
#define PG8_STAGE(bufoff, gbase, voff) do { _Pragma("unroll") for (int _i = 0; _i < 2; ++_i) \
        __builtin_amdgcn_global_load_lds((const unsigned*)((const char*)(gbase) + (voff)[_i]), (PG8_LAS unsigned*)(lds + (bufoff) + ldsw + _i * 8192), 16, 0, 0); } while (0)
#define PG8_RD8(off) __builtin_shufflevector(*(const PG8_LAS i32x4v*)(lds + (off)), *(const PG8_LAS i32x4v*)(lds + (off) + 1024), 0, 1, 2, 3, 4, 5, 6, 7)
#define PG8_LDA(dst, b, h) do { _Pragma("unroll") for (int m = 0; m < 4; ++m) { if constexpr (FP8) dst##8[m] = PG8_RD8(PG8_SA(b, h) + aoff + m * 2048); else { _Pragma("unroll") for (int k = 0; k < 2; ++k) dst[m][k] = *(const PG8_LAS bf16x8*)(lds + PG8_SA(b, h) + aoff + m * 2048 + k * 1024); } } } while (0)
#define PG8_LDB(dst, b, h) do { _Pragma("unroll") for (int n = 0; n < 2; ++n) { if constexpr (FP8) dst##8[n] = PG8_RD8(PG8_SB(b, h) + boff + n * 2048); else { _Pragma("unroll") for (int k = 0; k < 2; ++k) dst[n][k] = *(const PG8_LAS bf16x8*)(lds + PG8_SB(b, h) + boff + n * 2048 + k * 1024); } } } while (0)
#define PG8_MMA(ai, bj, At, Bt) do { if constexpr (FP8) __builtin_amdgcn_sched_barrier(0); __builtin_amdgcn_s_setprio(1); _Pragma("unroll") for (int m = 0; m < 4; ++m) _Pragma("unroll") for (int n = 0; n < 2; ++n) { \
        if constexpr (FP8) asm volatile("v_mfma_scale_f32_16x16x128_f8f6f4 %0, %1, %2, %0, %3, %3 op_sel_hi:[0,0,0]" : "+v"(acc[ai][bj][m][n]) : "v"(Bt##8[n]), "v"(At##8[m]), "v"(sc8)); \
        else { _Pragma("unroll") for (int k = 0; k < 2; ++k) acc[ai][bj][m][n] = __builtin_amdgcn_mfma_f32_16x16x32_bf16(Bt[n][k], At[m][k], acc[ai][bj][m][n], 0, 0, 0); } } __builtin_amdgcn_s_setprio(0); if constexpr (FP8) __builtin_amdgcn_sched_barrier(0); } while (0)
#define PG8_WAIT_V(n) asm volatile("s_waitcnt vmcnt(" #n ")" ::: "memory")
#define PG8_WAIT_L(n) asm volatile("s_waitcnt lgkmcnt(" #n ")" ::: "memory")
#define PG8_BAR __builtin_amdgcn_s_barrier()
#define PG8_SCHED __builtin_amdgcn_sched_barrier(0)
    Unit cur, nxt; int ui = 0;
    if (!S.next(0, cur)) return;
    f32x4 acc[2][2][4][2];
#pragma unroll
    for (int a = 0; a < 2; ++a)
#pragma unroll
        for (int b = 0; b < 2; ++b)
#pragma unroll
            for (int m = 0; m < 4; ++m)
#pragma unroll
                for (int n = 0; n < 2; ++n) acc[a][b][m][n] = (f32x4){0.f, 0.f, 0.f, 0.f};
    int sc8 = 0x7f7f7f7f; asm volatile("" : "+v"(sc8));
    bf16x8 At[4][2], B0[2][2], B1[2][2]; i32x8v At8[4], B08[2], B18[2];
    const char* cA = (const char*)g.A + (size_t)cur.pm * tstep; const char* cB = (const char*)g.Bt + (size_t)cur.pn * tstep;
    S.a_ready(cur);
    if constexpr (SP2) {
        PG8_STAGE(PG8_SB(0, 0), cB, voffB); PG8_STAGE(PG8_SB(0, 1), cB + hstep, voffB); PG8_STAGE(PG8_SA(0, 0), cA, voffA); PG8_STAGE(PG8_SA(0, 1), cA + hstep, voffA);
        if (wr == 1) PG8_BAR;
        PG8_WAIT_V(2); PG8_BAR;
        PG8_STAGE(PG8_SB(1, 0), cB + kstep, voffB); PG8_STAGE(PG8_SA(1, 0), cA + kstep, voffA); PG8_STAGE(PG8_SB(1, 1), cB + hstep + kstep, voffB);
        PG8_WAIT_V(6); PG8_BAR;
    } else {
        PG8_STAGE(PG8_SB(0, 0), cB, voffB); PG8_STAGE(PG8_SA(0, 0), cA, voffA); PG8_STAGE(PG8_SB(0, 1), cB + hstep, voffB); PG8_STAGE(PG8_SA(0, 1), cA + hstep, voffA);
        if (wr == 1) PG8_BAR;
        PG8_WAIT_V(4); PG8_BAR;
        PG8_STAGE(PG8_SB(1, 0), cB + kstep, voffB); PG8_STAGE(PG8_SA(1, 0), cA + kstep, voffA); PG8_STAGE(PG8_SB(1, 1), cB + hstep + kstep, voffB);
        PG8_WAIT_V(6); PG8_BAR;
    }
    for (;;) {
        const bool has_next = S.next(ui + 1, nxt);
        const char* nA = has_next ? (const char*)g.A + (size_t)nxt.pm * tstep : cA; const char* nB = has_next ? (const char*)g.Bt + (size_t)nxt.pn * tstep : cB;
        for (int t = 0; t < nt; t += 2) {
            const bool last = (t == nt - 2);
            const char* a1 = cA + (size_t)(t + 1) * kstep;
            const char* a2 = last ? nA : cA + (size_t)(t + 2) * kstep; const char* b2 = last ? nB : cB + (size_t)(t + 2) * kstep;
            const char* a3 = a2 + kstep; const char* b3 = b2 + kstep;
            if (last && has_next) S.a_ready(nxt);
            if constexpr (SP2) {
            PG8_LDB(B0, 0, 0); PG8_LDB(B1, 0, 1); PG8_SCHED; PG8_LDA(At, 0, 0); PG8_STAGE(PG8_SA(1, 1), a1 + hstep, voffA);
            PG8_WAIT_V(8); PG8_WAIT_L(0); PG8_BAR; PG8_MMA(0, 0, At, B0); PG8_MMA(0, 1, At, B1); PG8_BAR; PG8_SCHED;
            PG8_LDA(At, 0, 1); PG8_STAGE(PG8_SB(0, 0), b2, voffB); PG8_STAGE(PG8_SB(0, 1), b2 + hstep, voffB); PG8_STAGE(PG8_SA(0, 0), a2, voffA);
            PG8_WAIT_V(8); PG8_WAIT_L(0); PG8_BAR; PG8_MMA(1, 0, At, B0); PG8_MMA(1, 1, At, B1); PG8_BAR; PG8_SCHED;
            PG8_LDB(B0, 1, 0); PG8_LDB(B1, 1, 1); PG8_SCHED; PG8_LDA(At, 1, 0); PG8_STAGE(PG8_SA(0, 1), a2 + hstep, voffA);
            PG8_WAIT_V(8); PG8_WAIT_L(0); PG8_BAR; PG8_MMA(0, 0, At, B0); PG8_MMA(0, 1, At, B1); PG8_BAR; PG8_SCHED;
            PG8_LDA(At, 1, 1); PG8_STAGE(PG8_SB(1, 0), b3, voffB); PG8_STAGE(PG8_SB(1, 1), b3 + hstep, voffB); PG8_STAGE(PG8_SA(1, 0), a3, voffA);
            PG8_WAIT_V(8); PG8_WAIT_L(0); PG8_BAR; PG8_MMA(1, 0, At, B0); PG8_MMA(1, 1, At, B1); PG8_BAR; PG8_SCHED;
            } else {
            PG8_LDB(B0, 0, 0); PG8_SCHED; PG8_LDA(At, 0, 0); PG8_STAGE(PG8_SA(1, 1), a1 + hstep, voffA);
            PG8_WAIT_L(8); PG8_BAR; PG8_WAIT_L(0); PG8_MMA(0, 0, At, B0); PG8_BAR; PG8_SCHED;
            PG8_LDB(B1, 0, 1); PG8_STAGE(PG8_SB(0, 0), b2, voffB);
            PG8_BAR; PG8_WAIT_L(0); PG8_MMA(0, 1, At, B1); PG8_BAR;
            PG8_LDA(At, 0, 1); PG8_STAGE(PG8_SA(0, 0), a2, voffA);
            PG8_BAR; PG8_WAIT_L(0); PG8_MMA(1, 0, At, B0); PG8_BAR; PG8_SCHED;
            PG8_STAGE(PG8_SB(0, 1), b2 + hstep, voffB);
            PG8_WAIT_V(6); PG8_BAR; PG8_MMA(1, 1, At, B1); PG8_BAR;
            PG8_LDB(B0, 1, 0); PG8_SCHED; PG8_LDA(At, 1, 0); PG8_STAGE(PG8_SA(0, 1), a2 + hstep, voffA);
            PG8_WAIT_L(8); PG8_BAR; PG8_WAIT_L(0); PG8_MMA(0, 0, At, B0); PG8_BAR; PG8_SCHED;
            PG8_LDB(B1, 1, 1); PG8_STAGE(PG8_SB(1, 0), b3, voffB);
            PG8_BAR; PG8_WAIT_L(0); PG8_MMA(0, 1, At, B1); PG8_BAR;
            PG8_LDA(At, 1, 1); PG8_STAGE(PG8_SA(1, 0), a3, voffA);
            PG8_BAR; PG8_WAIT_L(0); PG8_MMA(1, 0, At, B0); PG8_BAR; PG8_SCHED;
            PG8_STAGE(PG8_SB(1, 1), b3 + hstep, voffB);
            PG8_WAIT_V(6); PG8_BAR; PG8_MMA(1, 1, At, B1); PG8_BAR;
            }
        }
        if constexpr (FP8) asm volatile("s_nop 15\n\ts_nop 15" ::: "memory");
        if constexpr (ALIGN_EPI) { if (wr == 0) PG8_BAR; }
        if constexpr (!Epi::AFTER_DRAIN) { E(acc, cur, wr, wc, fr, fq); S.done(cur); }
        if (!has_next) break;
#pragma unroll
        for (int a = 0; a < 2; ++a)
#pragma unroll
            for (int b = 0; b < 2; ++b)
#pragma unroll
                for (int m = 0; m < 4; ++m)
#pragma unroll
                    for (int n = 0; n < 2; ++n) acc[a][b][m][n] = (f32x4){0.f, 0.f, 0.f, 0.f};
        cur = nxt; cA = nA; cB = nB; ++ui;
        if constexpr (ALIGN_EPI) { if (wr == 1) PG8_BAR; }
    }
    PG8_WAIT_V(0);
    if constexpr (!ALIGN_EPI) { if (wr == 0) PG8_BAR; }
    PG8_BAR;
    if constexpr (Epi::AFTER_DRAIN) { E.fused(acc, cur, wr, wc, fr, fq, lds, wid, lane); S.done(cur); }
#undef PG8_SA
#undef PG8_SB
#undef PG8_STAGE
#undef PG8_LDA
#undef PG8_LDB
#undef PG8_MMA
#undef PG8_RD8
#undef PG8_WAIT_V
#undef PG8_WAIT_L
#undef PG8_BAR
#undef PG8_SCHED
}
}
namespace att {
typedef unsigned short bf16;
constexpr int   D = 128, NW = 8, QBLK = 32, KVBLK = 64;
constexpr float SCALE = 0.088388347648318440f;
constexpr float THR = 8.f;
constexpr int SDEPTH = 2;
constexpr int LDQ = 1024, LDK = 256, LDO = 1024;
constexpr size_t SHM_V = KVBLK * D * 2, SHM_K = KVBLK * D * 2, SHM_ATTN = 2 * SHM_V + 2 * SHM_K + NW * 64 * 4;
using bf16x8 = __attribute__((ext_vector_type(8))) short;
using s16x4  = __attribute__((ext_vector_type(4))) short;
using f32x16 = __attribute__((ext_vector_type(16))) float;
using f32x8  = __attribute__((ext_vector_type(8))) float;
using u32x4  = __attribute__((ext_vector_type(4))) unsigned;
#define KSWZ(row, colB) ((row) * 256 + ((colB) ^ (((row) & 7) << 4)))
#define SBAR() __builtin_amdgcn_sched_barrier(0)
__device__ __forceinline__ int crow(int r, int hi) { return (r & 3) + 8 * (r >> 2) + 4 * hi; }
__device__ __forceinline__ unsigned cvtpk(float lo, float hi) { return pg8::cvt_pk_bf16(lo, hi); }
template <typename TIn> struct Stage;
template <> struct Stage<bf16>  { using T = bf16x8;
  __device__ static __forceinline__ T ld8(const bf16* p) { return *reinterpret_cast<const bf16x8*>(p); }
  __device__ static __forceinline__ bf16x8 tobf(T x) { return x; } };
template <> struct Stage<float> { using T = f32x8;
  __device__ static __forceinline__ T ld8(const float* p) { return *reinterpret_cast<const f32x8*>(p); }
  __device__ static __forceinline__ bf16x8 tobf(T x) {
    u32x4 w = {cvtpk(x[0], x[1]), cvtpk(x[2], x[3]), cvtpk(x[4], x[5]), cvtpk(x[6], x[7])}; return *reinterpret_cast<bf16x8*>(&w); } };

__device__ __forceinline__ void partialSM(f32x16& p0, f32x16& p1, float& m_reg, float& mn, float& alpha) {
  constexpr float C = SCALE * 1.4426950408889634f;
  float pmax = p0[0]; for (int r = 1; r < 16; ++r) pmax = fmaxf(pmax, p0[r]); for (int r = 0; r < 16; ++r) pmax = fmaxf(pmax, p1[r]);
  { auto rr = __builtin_amdgcn_permlane32_swap(__float_as_uint(pmax), __float_as_uint(pmax), false, false);
    pmax = fmaxf(__uint_as_float(rr[0]), __uint_as_float(rr[1])); }
  if (__builtin_expect(__all(pmax - m_reg <= THR / SCALE), 1)) { mn = m_reg; alpha = 1.f; }
  else { mn = fmaxf(m_reg, pmax); alpha = __builtin_amdgcn_exp2f((m_reg - mn) * C); m_reg = mn; }
  float mnC = -mn * C;
  for (int r = 0; r < 16; ++r) p0[r] = fmaf(p0[r], C, mnC); for (int r = 0; r < 16; ++r) p1[r] = fmaf(p1[r], C, mnC);
  for (int r = 0; r < 16; ++r) p0[r] = __builtin_amdgcn_exp2f(p0[r]);
}
__device__ __forceinline__ void finishSM(f32x16& p0, f32x16& p1, float alpha, float& l_reg, bf16x8& pa0, bf16x8& pa1, bf16x8& pa2, bf16x8& pa3) {
  for (int r = 0; r < 16; ++r) p1[r] = __builtin_amdgcn_exp2f(p1[r]);
  float ps = 0; for (int r = 0; r < 16; ++r) ps += p0[r]; for (int r = 0; r < 16; ++r) ps += p1[r];
  { auto rr = __builtin_amdgcn_permlane32_swap(__float_as_uint(ps), __float_as_uint(ps), false, false);
    ps = __uint_as_float(rr[0]) + __uint_as_float(rr[1]); }
  l_reg = l_reg * alpha + ps;
#define PK4(P, BASE, OUT) do { unsigned a0 = cvtpk(P[BASE + 0], P[BASE + 1]), a1 = cvtpk(P[BASE + 2], P[BASE + 3]);   \
    unsigned b0 = cvtpk(P[BASE + 4], P[BASE + 5]), b1 = cvtpk(P[BASE + 6], P[BASE + 7]);                              \
    auto r0 = __builtin_amdgcn_permlane32_swap(a0, b0, false, false); auto r1 = __builtin_amdgcn_permlane32_swap(a1, b1, false, false); \
    u32x4 w = {r0[0], r1[0], r0[1], r1[1]}; OUT = *reinterpret_cast<bf16x8*>(&w); } while (0)
  PK4(p0, 0, pa0); PK4(p0, 8, pa1); PK4(p1, 0, pa2); PK4(p1, 8, pa3);
#undef PK4
}
__device__ __forceinline__ void qkt(f32x16& p0, f32x16& p1, const bf16* Ks, const bf16x8* qr, int r32, int hi) {
  p0 = f32x16{}; p1 = f32x16{};
  for (int d0 = 0; d0 < 8; ++d0) { int cb = (d0 * 16 + hi * 8) * 2;
    bf16x8 b0 = *reinterpret_cast<const bf16x8*>((const char*)Ks + KSWZ(r32, cb));
    bf16x8 b1 = *reinterpret_cast<const bf16x8*>((const char*)Ks + KSWZ(32 + r32, cb));
    p0 = __builtin_amdgcn_mfma_f32_32x32x16_bf16(b0, qr[d0], p0, 0, 0, 0);
    p1 = __builtin_amdgcn_mfma_f32_32x32x16_bf16(b1, qr[d0], p1, 0, 0, 0); }
}
__device__ __forceinline__ int v_st(int k, int c) { const int kk = (k & ~0xC) | ((k & 4) << 1) | ((k & 8) >> 1); return ((kk >> 3) * 4 + (c >> 5)) * 512 + ((kk & 7) * 32 + (c & 31)) * 2; }
__device__ __forceinline__ int v_rd_base(int lane) { return ((lane & 3) << 3) | (((lane >> 2) & 3) << 6) | (((lane >> 4) & 1) << 5) | (((lane >> 5) & 1) << 8); }
constexpr int v_rd_off(int d0, int ks, int half) { return d0 * 512 + ks * 4096 + half * 2048; }
template <int OFF> __device__ __forceinline__ s16x4 tr_read(int vb) {
  s16x4 r; asm volatile("ds_read_b64_tr_b16 %0, %1 offset:%2" : "=&v"(r) : "v"(vb), "i"(OFF) : "memory"); return r;
}
template <int D0> __device__ __forceinline__ void pv_one(f32x16& od, int vb, bf16x8 pa0, bf16x8 pa1, bf16x8 pa2, bf16x8 pa3) {
  const s16x4 l0 = tr_read<v_rd_off(D0, 0, 0)>(vb), h0 = tr_read<v_rd_off(D0, 0, 1)>(vb), l1 = tr_read<v_rd_off(D0, 1, 0)>(vb), h1 = tr_read<v_rd_off(D0, 1, 1)>(vb);
  const s16x4 l2 = tr_read<v_rd_off(D0, 2, 0)>(vb), h2 = tr_read<v_rd_off(D0, 2, 1)>(vb), l3 = tr_read<v_rd_off(D0, 3, 0)>(vb), h3 = tr_read<v_rd_off(D0, 3, 1)>(vb);
  asm volatile("s_waitcnt lgkmcnt(0)" ::: "memory"); SBAR();
#define PK(L, H) (bf16x8){L[0], L[1], L[2], L[3], H[0], H[1], H[2], H[3]}
  od = __builtin_amdgcn_mfma_f32_32x32x16_bf16(pa0, PK(l0, h0), od, 0, 0, 0);
  od = __builtin_amdgcn_mfma_f32_32x32x16_bf16(pa1, PK(l1, h1), od, 0, 0, 0);
  od = __builtin_amdgcn_mfma_f32_32x32x16_bf16(pa2, PK(l2, h2), od, 0, 0, 0);
  od = __builtin_amdgcn_mfma_f32_32x32x16_bf16(pa3, PK(l3, h3), od, 0, 0, 0);
#undef PK
}
__device__ __forceinline__ void pv_d0(f32x16* o, int vb, bf16x8 pa0, bf16x8 pa1, bf16x8 pa2, bf16x8 pa3) {
  pv_one<0>(o[0], vb, pa0, pa1, pa2, pa3); pv_one<1>(o[1], vb, pa0, pa1, pa2, pa3); pv_one<2>(o[2], vb, pa0, pa1, pa2, pa3); pv_one<3>(o[3], vb, pa0, pa1, pa2, pa3);
}

template <typename TQ>
__device__ __forceinline__ void attn_dense_body(const TQ* __restrict__ Qb, const bf16* __restrict__ Kh, const bf16* __restrict__ Vh,
                                                unsigned char* __restrict__ Ob, int seq, char* lds, const int tid_in) {
  using St = Stage<bf16>; using SQ = Stage<TQ>;
  int tid_ = tid_in; asm volatile("" : "+v"(tid_));
  const int tid = tid_, wid = tid >> 6, lane = tid & 63, r32 = lane & 31, hi = lane >> 5;
  bf16* V_lds = (bf16*)lds; bf16* K_lds = (bf16*)(lds + 2 * SHM_V);
  float* ws = (float*)(lds + 2 * SHM_V + 2 * SHM_K) + wid * 64; float* li_l = ws; float* al_l = ws + 32;
  float m_reg = -1e30f, l_reg = 0; f32x16 o[4] = {}; bf16x8 qr[8];
  const TQ* Qw = Qb + (long)(wid * QBLK + r32) * LDQ + hi * 8;
#pragma unroll
  for (int d0 = 0; d0 < 8; ++d0) qr[d0] = SQ::tobf(SQ::ld8(Qw + d0 * 16));
  const int sr = tid >> 4, sc = (tid & 15) * 8, vst0 = v_st(sr, sc), vst1 = v_st(32 + sr, sc);
  const int vb0 = (int)(uintptr_t)V_lds + v_rd_base(lane);
  struct { typename St::T vs0, vs1, ks0, ks1; } sr_[SDEPTH];
#define SLOAD(i, k0) do { sr_[i].vs0 = St::ld8(&Vh[(long)((k0) + sr) * LDK + sc]); sr_[i].vs1 = St::ld8(&Vh[(long)((k0) + 32 + sr) * LDK + sc]); \
    sr_[i].ks0 = St::ld8(&Kh[(long)((k0) + sr) * LDK + sc]); sr_[i].ks1 = St::ld8(&Kh[(long)((k0) + 32 + sr) * LDK + sc]); } while (0)
#define SWRITE(b, i) do { *(bf16x8*)((char*)V_lds + (b) * SHM_V + vst0) = St::tobf(sr_[i].vs0);          \
    *(bf16x8*)((char*)V_lds + (b) * SHM_V + vst1) = St::tobf(sr_[i].vs1); int kc = sc * 2;               \
    *(bf16x8*)((char*)K_lds + (b) * SHM_K + KSWZ(sr, kc)) = St::tobf(sr_[i].ks0);                       \
    *(bf16x8*)((char*)K_lds + (b) * SHM_K + KSWZ(32 + sr, kc)) = St::tobf(sr_[i].ks1); } while (0)
#define SWAIT() do { if constexpr (SDEPTH == 2) asm volatile("s_waitcnt vmcnt(4)" ::: "memory"); else asm volatile("s_waitcnt vmcnt(0)" ::: "memory"); } while (0)
#define RESC(a) do { if (__any((a) < 1.f)) { if (hi == 0) al_l[r32] = (a); asm volatile("s_waitcnt lgkmcnt(0)" ::: "memory"); \
    for (int d = 0; d < 4; ++d) for (int r = 0; r < 16; ++r) o[d][r] *= al_l[crow(r, hi)]; } } while (0)
  f32x16 pA0, pA1, pB0, pB1; float mnA, mnB, alA, alB; bf16x8 pa0, pa1, pa2, pa3; const int NT = seq / KVBLK;
  constexpr int SE = 0, SO = SDEPTH - 1;
  SLOAD(SE, 0); asm volatile("s_waitcnt vmcnt(0)" ::: "memory"); SWRITE(0, SE); __syncthreads();
  qkt(pA0, pA1, K_lds, qr, r32, hi); partialSM(pA0, pA1, m_reg, mnA, alA);
  SLOAD(SO, KVBLK); if constexpr (SDEPTH == 2) { if (2 < NT) SLOAD(SE, 2 * KVBLK); }
  SWAIT(); SWRITE(1, SO); __syncthreads();
  for (int j = 1; j + 1 < NT; j += 2) {
    SBAR(); qkt(pB0, pB1, (bf16*)((char*)K_lds + SHM_K), qr, r32, hi);
    finishSM(pA0, pA1, alA, l_reg, pa0, pa1, pa2, pa3); SBAR();
    SLOAD(SO, (j + SDEPTH) * KVBLK); SBAR();
    pv_d0(o, vb0, pa0, pa1, pa2, pa3); partialSM(pB0, pB1, m_reg, mnB, alB);
    __syncthreads(); SWAIT(); SWRITE(0, SE);
    RESC(alB); __syncthreads();
    SBAR(); qkt(pA0, pA1, K_lds, qr, r32, hi);
    finishSM(pB0, pB1, alB, l_reg, pa0, pa1, pa2, pa3); SBAR();
    if (SDEPTH == 1 || j + 3 < NT) SLOAD(SE, (j + 1 + SDEPTH) * KVBLK); SBAR();
    pv_d0(o, vb0 + (int)SHM_V, pa0, pa1, pa2, pa3); partialSM(pA0, pA1, m_reg, mnA, alA);
    __syncthreads(); SWAIT(); SWRITE(1, SO);
    RESC(alA); __syncthreads();
  }
  SBAR(); qkt(pB0, pB1, (bf16*)((char*)K_lds + SHM_K), qr, r32, hi);
  finishSM(pA0, pA1, alA, l_reg, pa0, pa1, pa2, pa3); SBAR();
  pv_d0(o, vb0, pa0, pa1, pa2, pa3); partialSM(pB0, pB1, m_reg, mnB, alB);
  __syncthreads(); RESC(alB);
  finishSM(pB0, pB1, alB, l_reg, pa0, pa1, pa2, pa3); SBAR();
  pv_d0(o, vb0 + (int)SHM_V, pa0, pa1, pa2, pa3);
  if (hi == 0) li_l[r32] = l_reg; asm volatile("s_waitcnt lgkmcnt(0)" ::: "memory");
  float rli[16];
#pragma unroll
  for (int r = 0; r < 16; ++r) rli[r] = __builtin_amdgcn_rcpf(li_l[crow(r, hi)]);
  unsigned char* Ow = Ob + (long)(wid * QBLK) * LDO;
#pragma unroll
  for (int r = 0; r < 16; ++r) { int orow = crow(r, hi);
    for (int d0 = 0; d0 < 4; ++d0) { const float ov = o[d0][r] * rli[r] * 64.0f; Ow[(long)orow * LDO + d0 * 32 + r32] = (unsigned char)(__builtin_amdgcn_cvt_pk_fp8_f32(ov, ov, __builtin_bit_cast(int, ov), false) & 0xff); } }
#undef SLOAD
#undef SWRITE
#undef SWAIT
#undef RESC
}
#undef KSWZ
#undef SBAR
}

#define GAS __attribute__((address_space(1)))
#define LAS __attribute__((address_space(3)))
typedef unsigned short bf16;
typedef unsigned v4u __attribute__((ext_vector_type(4)));
typedef float f32x4 __attribute__((ext_vector_type(4)));
typedef short bf16x8 __attribute__((ext_vector_type(8)));
typedef GAS unsigned gu32;
typedef GAS unsigned long long gu64;
#define RLX_AGENT __ATOMIC_RELAXED, __HIP_MEMORY_SCOPE_AGENT
#define LDS_WAIT() asm volatile("s_waitcnt lgkmcnt(0)" ::: "memory")
#define VM_WAIT() asm volatile("s_waitcnt vmcnt(0)" ::: "memory")
__device__ __forceinline__ unsigned long long rt() { return __builtin_amdgcn_s_memrealtime(); }
__device__ __forceinline__ unsigned f2bf(float f) { unsigned u = __builtin_bit_cast(unsigned, f); return (u + 0x7fffu + ((u >> 16) & 1u)) >> 16; }
__device__ __forceinline__ unsigned pk2(float lo, float hi) { return f2bf(lo) | (f2bf(hi) << 16); }

#define XB_TMO      128
#define XB_XCNT(j)  (256  + 64 * (j))
#define XB_XSUB(j)  (1280 + 64 * (j))
#define XB_XGEN(j)  (2304 + 64 * (j))
#define XB_TOP      3328
#define XB_TOPGEN   3392
#define XCD_BAR_WORDS 3456
#define XB_SPIN_CAP (1u << 18)

__device__ __forceinline__ unsigned xb_ld(unsigned* p)              { return __hip_atomic_load(p, __ATOMIC_RELAXED, __HIP_MEMORY_SCOPE_AGENT); }
__device__ __forceinline__ unsigned xb_add(unsigned* p, unsigned v) { return __hip_atomic_fetch_add(p, v, __ATOMIC_RELAXED, __HIP_MEMORY_SCOPE_AGENT); }
__device__ __forceinline__ unsigned xb_xcc_id() { return (unsigned)__builtin_amdgcn_s_getreg((3 << 11) | 20) & 0xFu; }
#define XB_SPIN(cond, bar) do { unsigned _sp = 0; while (cond) { __builtin_amdgcn_s_sleep(1); \
    if ((++_sp & 255u) == 0u) { if (xb_ld(&(bar)[XB_TMO])) break; if (_sp > XB_SPIN_CAP) { atomicAdd(&(bar)[XB_TMO], 1u); break; } } } } while (0)

struct XcdBarrier {
    unsigned* bar; unsigned x;
    volatile LAS unsigned* st;
};

__device__ __forceinline__ XcdBarrier xcd_barrier_post(unsigned* bar, volatile LAS unsigned* st) {
    XcdBarrier b; b.bar = bar; b.x = xb_xcc_id(); b.st = st;
    if (threadIdx.x == 0) (void)xb_add(&bar[XB_XCNT(b.x)], 1u);
    return b;
}
__device__ __forceinline__ void xcd_barrier_complete(unsigned* bar, unsigned x, unsigned& nloc, unsigned& nx) {
    const unsigned G = gridDim.x * gridDim.y * gridDim.z;
    unsigned sum, cnt, mine, sp = 0u;
    for (;;) {
        sum = 0u; cnt = 0u; mine = 0u;
#pragma unroll
        for (unsigned j = 0; j < 16; ++j) { const unsigned c = xb_ld(&bar[XB_XCNT(j)]); sum += c; cnt += (c > 0u) ? 1u : 0u; mine = (j == x) ? c : mine; }
        if (sum == G) break;
        __builtin_amdgcn_s_sleep(1);
        if ((++sp & 255u) == 0u) { if (xb_ld(&bar[XB_TMO])) break; if (sp > XB_SPIN_CAP) { atomicAdd(&bar[XB_TMO], 1u); break; } }
    }
    nloc = mine > 0u ? mine : 1u; nx = cnt > 0u ? cnt : 1u;
}

__device__ __forceinline__ void xcd_barrier(const XcdBarrier& b) {
    asm volatile("s_waitcnt vmcnt(0)" ::: "memory");
    __syncthreads();
    if (threadIdx.x == 0) {
        unsigned* bar = b.bar;
        __builtin_amdgcn_s_waitcnt(0);
        unsigned nloc = b.st[0], nx = b.st[1];
        if (nloc == 0u) { xcd_barrier_complete(bar, b.x, nloc, nx); b.st[0] = nloc; b.st[1] = nx; }
        const unsigned old = xb_add(&bar[XB_XSUB(b.x)], 1u);
        const unsigned gen = old / nloc;
        if (old + 1u == (gen + 1u) * nloc) {
            __builtin_amdgcn_fence(__ATOMIC_RELEASE, "agent");
            asm volatile("s_waitcnt vmcnt(0)" ::: "memory");
            const unsigned og = xb_add(&bar[XB_TOP], 1u);
            const unsigned tg = og / nx;
            if (og + 1u == (tg + 1u) * nx) xb_add(&bar[XB_TOPGEN], 1u);
            else XB_SPIN(xb_ld(&bar[XB_TOPGEN]) == tg, bar);
            __builtin_amdgcn_fence(__ATOMIC_ACQUIRE, "agent");
            xb_add(&bar[XB_XGEN(b.x)], 1u);
            asm volatile("s_waitcnt vmcnt(0)" ::: "memory");
        } else {
            XB_SPIN(xb_ld(&bar[XB_XGEN(b.x)]) == gen, bar);
            __builtin_amdgcn_fence(__ATOMIC_ACQUIRE, "agent");
            asm volatile("s_waitcnt vmcnt(0)" ::: "memory");
        }
    }
    __syncthreads();
}
constexpr int DM = 1024, NB = 16, SEQ = 2048, CTXL = 256, TL = NB * SEQ, TC = NB * CTXL, TALL = TL + TC;
constexpr int INCOLS = 6144, OFF_FNET = 2560, OFF_GATE = 3072;
constexpr int NEXP = 32, KVROWS = SEQ + CTXL;
constexpr float EPS = 1e-6f;
constexpr int NWAVES = 8, NTHR = NWAVES * 64;
constexpr int NPL = 11, NPH = 2 + 2 * NPL;
#ifndef MK_PER_PHASE
#define MK_PER_PHASE 0
#endif
constexpr size_t MiB = 1u << 20;
constexpr size_t WS_CTL = 0, CTL_ZERO_BYTES = 1 * MiB;
constexpr size_t WS_MOD = 1 * MiB;
constexpr size_t WS_TAB = 2 * MiB;
constexpr size_t WS_TOPI = 3 * MiB, WS_TOPP = 4 * MiB, WS_SLOT = 5 * MiB, WS_CNT = 6 * MiB;
constexpr size_t WS_LOGIT = 7 * MiB;
constexpr size_t WS_WSMALL = 17 * MiB, WSMALL_LAYER = 20 * MiB;
constexpr size_t OFFS_WIN = 0, OFFS_WF = 5 * MiB, OFFS_WG = 7 * MiB, OFFS_WAO = 13 * MiB, OFFS_WCO = 15 * MiB, OFFS_WFO = 16 * MiB, OFFS_WOUT = 17 * MiB, OFFS_ROUT = 19 * MiB;
constexpr size_t WS_DFTL = 57 * MiB, WS_DFTC = 73 * MiB;
constexpr size_t WS_XC = 74 * MiB;
constexpr size_t WS_H = 90 * MiB;
constexpr size_t WS_WGU = 162 * MiB, WS_WD = 226 * MiB, MOEW_LAYER = 96 * MiB;
constexpr size_t WS_BIG = 354 * MiB;
constexpr size_t WS_Q = WS_BIG, WS_K = WS_Q + 72 * MiB, WS_V = WS_K + 18 * MiB, WS_CU = WS_V + 18 * MiB, WS_YT = WS_CU + 36 * MiB, WS_YTC = WS_YT + 64 * MiB;
constexpr size_t WS_GATES = WS_BIG;
constexpr size_t WS_AO = WS_BIG + 216 * MiB, WS_CH = WS_AO + 72 * MiB, WS_Z = WS_CH + 36 * MiB;
constexpr size_t WS_MIX = WS_AO;
constexpr size_t WS_MERGED = WS_BIG + 360 * MiB;
constexpr int SLOT_ROWS = 608 * 256;
constexpr size_t WS_YS = WS_BIG, WS_HS = WS_BIG + 304 * MiB, WS_ACT = WS_BIG + 456 * MiB, WS_END = WS_BIG + 608 * MiB;
constexpr size_t WS_H8 = WS_END;
constexpr size_t WS_END2 = WS_END + 36 * MiB;
static_assert(WS_YTC + 8 * MiB == WS_AO && WS_Z + 36 * MiB == WS_MERGED && WS_MERGED + 72 * MiB <= WS_END && (size_t)SLOT_ROWS * 2048 == 304 * MiB, "ws map");
constexpr int CW_TMO = 0, CW_CODE = 1, CW_BAR = 4096;
constexpr int CNT_TILE_E = 16384, CNT_NT = 16384 + 1024;

constexpr int RING_OFF = 0, RING_BYTES = 131072;
constexpr int LDSCTL_OFF = RING_BYTES, MISC_OFF = LDSCTL_OFF + 320, LDS_CT = LDSCTL_OFF + 512, LDS_SM = LDSCTL_OFF + 1024;
constexpr int LDS_BYTES = 155648;

typedef unsigned u32x2 __attribute__((ext_vector_type(2)));
typedef int i32x4 __attribute__((ext_vector_type(4)));
typedef float f32x2 __attribute__((ext_vector_type(2)));
struct Args { const float* in[29]; float* out; unsigned char* ws; int ph_lo, ph_hi; };
typedef const __attribute__((address_space(4))) unsigned char* kptr_t;
struct AV {
    kptr_t kp;
    __device__ __forceinline__ const float* in(int i) const { return *(const float* const __attribute__((address_space(4)))*)(kp + 8 * i); }
    __device__ __forceinline__ float* out() const { return *(float* const __attribute__((address_space(4)))*)(kp + 8 * 29); }
    __device__ __forceinline__ unsigned char* ws() const { return *(unsigned char* const __attribute__((address_space(4)))*)(kp + 8 * 30); }
};
__device__ __forceinline__ AV av_get() { AV a; a.kp = (kptr_t)__builtin_amdgcn_kernarg_segment_ptr(); asm volatile("" : "+s"(a.kp)); return a; }

struct Frame {
    LAS unsigned char* lds; volatile LAS unsigned* MISC; gu32* ctl;
    int tid, lane, wave, vcu, G;
};

__device__ __forceinline__ float shx(float v, int m, int lane) { return __int_as_float(__builtin_amdgcn_ds_bpermute((lane ^ m) << 2, __float_as_int(v))); }
__device__ __forceinline__ float wave_sum(float v, int lane) {
#pragma unroll
    for (int o = 1; o < 64; o <<= 1) v += shx(v, o, lane);
    return v;
}
__device__ __forceinline__ float sigmoidf_(float x) { return 1.0f / (1.0f + __expf(-x)); }
__device__ __forceinline__ f32x4 bf4(u32x2 w) { f32x4 r; r[0] = __uint_as_float(w.x << 16); r[1] = __uint_as_float(w.x & 0xffff0000u); r[2] = __uint_as_float(w.y << 16); r[3] = __uint_as_float(w.y & 0xffff0000u); return r; }
__device__ __forceinline__ u32x2 pk4(f32x4 v) { u32x2 w; w.x = pk2(v[0], v[1]); w.y = pk2(v[2], v[3]); return w; }
__device__ __forceinline__ void ld_row_f32(f32x4 (&v)[4], const float* p, int lane) {
#pragma unroll
    for (int j = 0; j < 4; ++j) v[j] = ((const GAS f32x4*)p)[lane + 64 * j];
}
__device__ __forceinline__ void st_row_f32(const f32x4 (&v)[4], float* p, int lane) {
#pragma unroll
    for (int j = 0; j < 4; ++j) ((GAS f32x4*)p)[lane + 64 * j] = v[j];
}
__device__ __forceinline__ void ld_row_bf16(f32x4 (&v)[4], const bf16* p, int lane) {
#pragma unroll
    for (int j = 0; j < 4; ++j) v[j] = bf4(((const GAS u32x2*)p)[lane + 64 * j]);
}
__device__ __forceinline__ void st_row_bf16(const f32x4 (&v)[4], bf16* p, int lane) {
#pragma unroll
    for (int j = 0; j < 4; ++j) ((GAS u32x2*)p)[lane + 64 * j] = pk4(v[j]);
}
__device__ __forceinline__ void rms_gain(f32x4 (&v)[4], const float* g, int lane) {
    float ss = 0.f;
#pragma unroll
    for (int j = 0; j < 4; ++j) ss += (v[j][0] * v[j][0] + v[j][1] * v[j][1]) + (v[j][2] * v[j][2] + v[j][3] * v[j][3]);
    const float r = 1.0f / sqrtf(wave_sum(ss, lane) * (1.0f / 1024.0f) + EPS);
#pragma unroll
    for (int j = 0; j < 4; ++j) { const f32x4 gg = ((const GAS f32x4*)g)[lane + 64 * j]; v[j] = v[j] * r * gg; }
}
__device__ __forceinline__ void modulate_store(const f32x4 (&v)[4], const float* shift, const float* scale, bf16* o, int lane) {
#pragma unroll
    for (int j = 0; j < 4; ++j) { const f32x4 sh = ((const GAS f32x4*)shift)[lane + 64 * j], sc = ((const GAS f32x4*)scale)[lane + 64 * j];
        ((GAS u32x2*)o)[lane + 64 * j] = pk4(v[j] * (sc + 1.0f) + sh); }
}
__device__ __forceinline__ unsigned pk4_fp8(f32x4 v) { return pg8::cvt4_fp8(v[0], v[1], v[2], v[3]); }
__device__ __forceinline__ void modulate_store2(const f32x4 (&v)[4], const float* shift, const float* scale, bf16* o, unsigned char* o8, int lane) {
#pragma unroll
    for (int j = 0; j < 4; ++j) { const f32x4 sh = ((const GAS f32x4*)shift)[lane + 64 * j], sc = ((const GAS f32x4*)scale)[lane + 64 * j]; const f32x4 r = v[j] * (sc + 1.0f) + sh;
        ((GAS u32x2*)o)[lane + 64 * j] = pk4(r); ((GAS unsigned*)o8)[lane + 64 * j] = pk4_fp8(r); }
}
__device__ __forceinline__ f32x4 fp8x4(unsigned w) { const f32x2 a = __builtin_amdgcn_cvt_pk_f32_fp8((int)w, false), b = __builtin_amdgcn_cvt_pk_f32_fp8((int)w, true); return (f32x4){a.x, a.y, b.x, b.y}; }
__device__ __forceinline__ int krow_of(int m) { return m < TL ? (m >> 11) * KVROWS + (m & 2047) : ((m - TL) >> 8) * KVROWS + SEQ + ((m - TL) & 255); }

__device__ __forceinline__ void load_block(const float* W, int ldw, int k0, int n0, float scale, LAS float* scr, int lane) {
    f32x4 v[8]; const int kr = lane >> 3, c4 = (lane & 7) * 4;
#pragma unroll
    for (int i = 0; i < 8; ++i) v[i] = *(const GAS f32x4*)(W + (size_t)(k0 + kr + 8 * i) * ldw + n0 + c4);
#pragma unroll
    for (int i = 0; i < 8; ++i) { LAS float* d = scr + (kr + 8 * i) * 33 + c4; d[0] = v[i][0] * scale; d[1] = v[i][1] * scale; d[2] = v[i][2] * scale; d[3] = v[i][3] * scale; }
    LDS_WAIT(); asm volatile("" ::: "memory");
}
__device__ __forceinline__ void transpose_item(const float* W, int ldw, int K, bf16* WT, int dst_row0, int k0, int n0, LAS float* scr, int lane) {
    load_block(W, ldw, k0, n0, 1.0f, scr, lane);
    const int c = lane & 7;
#pragma unroll
    for (int j = 0; j < 4; ++j) { const int n = (lane >> 3) + 8 * j; const LAS float* s = scr + (8 * c) * 33 + n;
        v4u o; o.x = pk2(s[0 * 33], s[1 * 33]); o.y = pk2(s[2 * 33], s[3 * 33]); o.z = pk2(s[4 * 33], s[5 * 33]); o.w = pk2(s[6 * 33], s[7 * 33]);
        *(GAS v4u*)(WT + (size_t)(dst_row0 + n) * K + k0 + 8 * c) = o; }
    LDS_WAIT(); asm volatile("" ::: "memory");
}
__device__ __forceinline__ void transpose_item_fp8(const float* W, int ldw, int K, unsigned char* WT, int dst_row0, int k0, int n0, float scale, LAS float* scr, int lane) {
    load_block(W, ldw, k0, n0, scale, scr, lane);
#pragma unroll
    for (int j = 0; j < 2; ++j) { const int q = lane + 64 * j, n = q >> 2, c = q & 3; const LAS float* s = scr + (16 * c) * 33 + n; v4u o;
        o.x = pg8::cvt4_fp8(s[0 * 33], s[1 * 33], s[2 * 33], s[3 * 33]); o.y = pg8::cvt4_fp8(s[4 * 33], s[5 * 33], s[6 * 33], s[7 * 33]); o.z = pg8::cvt4_fp8(s[8 * 33], s[9 * 33], s[10 * 33], s[11 * 33]); o.w = pg8::cvt4_fp8(s[12 * 33], s[13 * 33], s[14 * 33], s[15 * 33]);
        *(GAS v4u*)(WT + (size_t)(dst_row0 + n) * K + k0 + 16 * c) = o; }
    LDS_WAIT(); asm volatile("" ::: "memory");
}
constexpr int IT_S0 = 16 * 80, IT_S1 = 16 * 96, IT_S2 = 512, IT_S3 = 512, IT_S4 = 256, IT_S5 = 256, IT_SMALL = IT_S0 + IT_S1 + IT_S2 + IT_S3 + IT_S4 + IT_S5;
__device__ __forceinline__ void small_item(const AV& a, int l, int r, LAS float* scr, int lane) {
    unsigned char* wl = a.ws() + WS_WSMALL + (size_t)l * WSMALL_LAYER; const float* win = a.in(10) + (size_t)l * DM * INCOLS;
    if (r < IT_S0) { const int kb = r / 80, n0 = (r % 80) * 32; int dr;
        if (n0 < 1536) dr = n0; else { int cc = n0 - 1536; if (cc < 512) dr = 1536 + (cc >> 7) * 256 + (cc & 127); else { cc -= 512; dr = 1536 + (cc >> 7) * 256 + 128 + (cc & 127); } }
        transpose_item_fp8(win, INCOLS, DM, wl + OFFS_WIN, dr, kb * 64, n0, 32.0f, scr, lane); return; }
    r -= IT_S0;
    if (r < IT_S1) { const int kb = r / 96, nb = r % 96; transpose_item_fp8(win, INCOLS, DM, wl + OFFS_WG, nb * 32, kb * 64, OFF_GATE + nb * 32, 32.0f, scr, lane); return; }
    r -= IT_S1;
    if (r < IT_S2) { const int kb = r / 32, nb = r % 32; transpose_item_fp8(a.in(13) + (size_t)l * DM * DM, DM, DM, wl + OFFS_WAO, nb * 32, kb * 64, nb * 32, 32.0f, scr, lane); return; }
    r -= IT_S2;
    if (r < IT_S3) { const int kb = r / 32, nb = r % 32; transpose_item(a.in(20) + (size_t)l * DM * DM, DM, DM, (bf16*)(wl + OFFS_WOUT), nb * 32, kb * 64, nb * 32, scr, lane); return; }
    r -= IT_S3;
    if (r < IT_S4) { const int kb = r / 32, nb = r % 32; transpose_item(a.in(18) + (size_t)l * 512 * DM, DM, 512, (bf16*)(wl + OFFS_WCO), nb * 32, kb * 64, nb * 32, scr, lane); return; }
    r -= IT_S4;
    { const int kb = r / 32, nb = r % 32; transpose_item(a.in(19) + (size_t)l * 512 * DM, DM, 512, (bf16*)(wl + OFFS_WFO), nb * 32, kb * 64, nb * 32, scr, lane); }
}
constexpr int IT_MOE = NEXP * 3 * 512;
struct MoeIt { const float* W; unsigned char* WT; int dr, k0; };
__device__ __forceinline__ MoeIt moe_decode(const AV& a, int gi) {
    const int l = gi / IT_MOE, idx = gi % IT_MOE, e = idx / 1536, r = idx % 1536, which = r / 512, it = r % 512, kb = it / 32, n0 = (it % 32) * 32; const size_t eo = ((size_t)l * NEXP + e) << 20;
    MoeIt m; m.k0 = kb * 64;
    if (which == 0) { m.W = a.in(23) + eo + n0; m.WT = a.ws() + WS_WGU + (size_t)l * MOEW_LAYER + (size_t)e * 2048 * 1024; m.dr = (n0 >> 7) * 256 + (n0 & 127); }
    else if (which == 1) { m.W = a.in(25) + eo + n0; m.WT = a.ws() + WS_WGU + (size_t)l * MOEW_LAYER + (size_t)e * 2048 * 1024; m.dr = (n0 >> 7) * 256 + 128 + (n0 & 127); }
    else { m.W = a.in(27) + eo + n0; m.WT = a.ws() + WS_WD + (size_t)l * MOEW_LAYER + (size_t)e * 1024 * 1024; m.dr = n0; }
    return m;
}
__device__ __forceinline__ void moe_issue(f32x4 (&v)[8], const MoeIt& m, int lane) {
    const float* p = m.W + (size_t)(m.k0 + (lane >> 3)) * DM + (lane & 7) * 4;
#pragma unroll
    for (int i = 0; i < 8; ++i) v[i] = __builtin_nontemporal_load((const GAS f32x4*)(p + (size_t)(8 * i) * DM));
}
__device__ __forceinline__ void moe_finish(const f32x4 (&v)[8], const MoeIt& m, LAS float* scr, int lane) {
    const int kr = lane >> 3, c4 = (lane & 7) * 4;
#pragma unroll
    for (int i = 0; i < 8; ++i) { LAS float* d = scr + (kr + 8 * i) * 33 + c4; d[0] = v[i][0] * 32.0f; d[1] = v[i][1] * 32.0f; d[2] = v[i][2] * 32.0f; d[3] = v[i][3] * 32.0f; }
    LDS_WAIT(); asm volatile("" ::: "memory");
#pragma unroll
    for (int j = 0; j < 2; ++j) { const int q = lane + 64 * j, n = q >> 2, c = q & 3; const LAS float* s = scr + (16 * c) * 33 + n; v4u o;
        o.x = pg8::cvt4_fp8(s[0 * 33], s[1 * 33], s[2 * 33], s[3 * 33]); o.y = pg8::cvt4_fp8(s[4 * 33], s[5 * 33], s[6 * 33], s[7 * 33]); o.z = pg8::cvt4_fp8(s[8 * 33], s[9 * 33], s[10 * 33], s[11 * 33]); o.w = pg8::cvt4_fp8(s[12 * 33], s[13 * 33], s[14 * 33], s[15 * 33]);
        *(GAS v4u*)(m.WT + (size_t)(m.dr + n) * DM + m.k0 + 16 * c) = o; }
    LDS_WAIT(); asm volatile("" ::: "memory");
}
__device__ __forceinline__ void moe_convert_all(const AV& a, int gw, int NGW, LAS float* scr, int lane) {
    constexpr int NIT = 2 * IT_MOE; f32x4 va[8], vb[8]; int it = gw; if (it >= NIT) return;
    MoeIt ma = moe_decode(a, it), mb = ma; moe_issue(va, ma, lane);
    for (;;) {
        const bool h1 = it + NGW < NIT; if (h1) { mb = moe_decode(a, it + NGW); moe_issue(vb, mb, lane); }
        moe_finish(va, ma, scr, lane); if (!h1) break; it += NGW;
        const bool h2 = it + NGW < NIT; if (h2) { ma = moe_decode(a, it + NGW); moe_issue(va, ma, lane); }
        moe_finish(vb, mb, scr, lane); if (!h2) break; it += NGW;
    }
}
__device__ __forceinline__ void fold_job(const AV& a, int j, const LAS float* ct, int lane) {
    const int l = j >> 10, r = j & 1023, g = r >> 8, kblk = (r >> 4) & 15, k2g = r & 15, k = kblk * 64 + lane;
    const float* wrow = a.in(10) + (size_t)l * DM * INCOLS + (size_t)k * INCOLS + OFF_FNET + g * 128;
    float ac[8], as[8];
#pragma unroll
    for (int i = 0; i < 8; ++i) { ac[i] = 0.f; as[i] = 0.f; }
    for (int n4 = 0; n4 < 32; ++n4) { const f32x4 w = *(const GAS f32x4*)(wrow + n4 * 4);
#pragma unroll
        for (int q = 0; q < 4; ++q) { const int n2 = n4 * 4 + q;
#pragma unroll
            for (int i = 0; i < 8; ++i) { const int ph = (n2 * (k2g * 8 + i)) & 127; ac[i] += w[q] * ct[ph]; as[i] += w[q] * ct[(ph - 32) & 127]; } } }
    bf16* wf = (bf16*)(a.ws() + WS_WSMALL + (size_t)l * WSMALL_LAYER + OFFS_WF);
#pragma unroll
    for (int i = 0; i < 8; ++i) { const int ch = g * 128 + k2g * 8 + i;
        wf[(size_t)ch * 1024 + k] = (bf16)f2bf(ac[i] * 0.08838834764831845f); wf[(size_t)(512 + ch) * 1024 + k] = (bf16)f2bf(as[i] * 0.08838834764831845f); }
}
__device__ __forceinline__ void p0_prologue(const Frame& F, const AV& a) {
    const int gw = F.vcu * NWAVES + F.wave, NGW = F.G * NWAVES, gt = F.vcu * NTHR + F.tid, NGT = F.G * NTHR;
    LAS float* ct = (LAS float*)(F.lds + LDS_CT);
    if (F.tid < 128) ct[F.tid] = cospif((float)F.tid * (1.0f / 64.0f));
    for (int job = blockIdx.x; job < 2 * 96; job += F.G) {
        const int l = job / 96, n0 = (job % 96) * 64;
        LAS float* s = (LAS float*)(F.lds + RING_OFF); LAS float* red = s + 17 * 1024;
        for (int i = F.tid; i < 17 * 1024; i += NTHR) { const int b = i >> 10, k = i & 1023; const float cv = b < 16 ? a.in(1)[b * 1024 + k] : a.in(3)[k]; s[i] = cv * sigmoidf_(cv); }
        __syncthreads();
        const int col = F.tid & 63, ks = F.tid >> 6; float acc[17];
#pragma unroll
        for (int b = 0; b < 17; ++b) acc[b] = 0.f;
        const float* w = a.in(4) + (size_t)l * DM * INCOLS + n0 + col;
        for (int k = ks * 128; k < ks * 128 + 128; k += 16) { float wv[16];
#pragma unroll
            for (int q = 0; q < 16; ++q) wv[q] = w[(size_t)(k + q) * INCOLS];
#pragma unroll
            for (int q = 0; q < 16; ++q)
#pragma unroll
                for (int b = 0; b < 17; ++b) acc[b] += s[b * 1024 + k + q] * wv[q]; }
#pragma unroll
        for (int b = 0; b < 17; ++b) red[(ks * 17 + b) * 64 + col] = acc[b];
        __syncthreads();
        for (int i = F.tid; i < 17 * 64; i += NTHR) { const int b = i >> 6, c2 = i & 63; float t = 0.f;
#pragma unroll
            for (int q = 0; q < 8; ++q) t += red[(q * 17 + b) * 64 + c2];
            ((float*)(a.ws() + WS_MOD))[((size_t)l * 17 + b) * INCOLS + n0 + c2] = t + a.in(5)[l * INCOLS + n0 + c2]; }
        __syncthreads();
    }
    __syncthreads();
    for (int i = gt; i < 64 * 32; i += NGT) { const int p = i >> 5, f = i & 31; const float inv = powf(10000.0f, -(float)f / 32.0f), ang = (float)p * inv; ((f32x2*)(a.ws() + WS_TAB))[i] = (f32x2){cosf(ang), sinf(ang)}; }
    for (int i = gt; i < 2048 * 256; i += NGT) { const int k1 = i >> 8, c0 = (i & 255) * 16; float v[16];
#pragma unroll
        for (int q = 0; q < 16; ++q) { const int col = c0 + q, n1 = col & 2047, rr = (k1 * n1) & 2047; const float x = (float)rr * (1.0f / 1024.0f); v[q] = ((col >> 11) ? -sinpif(x) : cospif(x)) * (32.0f * 0.022097086912079608f); }
        v4u o; o.x = pk4_fp8((f32x4){v[0], v[1], v[2], v[3]}); o.y = pk4_fp8((f32x4){v[4], v[5], v[6], v[7]}); o.z = pk4_fp8((f32x4){v[8], v[9], v[10], v[11]}); o.w = pk4_fp8((f32x4){v[12], v[13], v[14], v[15]}); ((GAS v4u*)(a.ws() + WS_DFTL))[i] = o; }
    for (int i = gt; i < 256 * 32; i += NGT) { const int k1 = i >> 5, c0 = (i & 31) * 16; float v[16];
#pragma unroll
        for (int q = 0; q < 16; ++q) { const int col = c0 + q, n1 = col & 255, rr = (k1 * n1) & 255; const float x = (float)rr * (1.0f / 128.0f); v[q] = ((col >> 8) ? -sinpif(x) : cospif(x)) * (32.0f * 0.0625f); }
        v4u o; o.x = pk4_fp8((f32x4){v[0], v[1], v[2], v[3]}); o.y = pk4_fp8((f32x4){v[4], v[5], v[6], v[7]}); o.z = pk4_fp8((f32x4){v[8], v[9], v[10], v[11]}); o.w = pk4_fp8((f32x4){v[12], v[13], v[14], v[15]}); ((GAS v4u*)(a.ws() + WS_DFTC))[i] = o; }
    for (int i = gt; i < 2 * 256 * 1024; i += NGT) { const int l = i >> 18, r = (i >> 10) & 255, k = i & 1023; unsigned o = 0u;
        if (r < 64) { const float w = a.in(21)[((size_t)l * DM + k) * NEXP + (r & 31)]; const unsigned hi = f2bf(w); o = hi; if (r >= 32) o = f2bf(w - __uint_as_float(hi << 16)); }
        ((bf16*)(a.ws() + WS_WSMALL + (size_t)l * WSMALL_LAYER + OFFS_ROUT))[(size_t)r * 1024 + k] = (bf16)o; }
    for (int j = gw; j < 2048; j += NGW) fold_job(a, j, ct, F.lane);
    LAS float* scr = (LAS float*)(F.lds + RING_OFF + F.wave * 16384);
    for (int it = gw; it < 2 * IT_SMALL; it += NGW) small_item(a, it / IT_SMALL, it % IT_SMALL, scr, F.lane);
    moe_convert_all(a, gw, NGW, scr, F.lane);
}
__device__ __forceinline__ void ld4(f32x4 (&v)[4], const float* p, int lane) {
#pragma unroll
    for (int j = 0; j < 4; ++j) v[j] = ((const GAS f32x4*)p)[lane + 64 * j];
}
__device__ __forceinline__ float sumsq4(const f32x4 (&v)[4]) { float ss = 0.f;
#pragma unroll
    for (int j = 0; j < 4; ++j) ss += (v[j][0] * v[j][0] + v[j][1] * v[j][1]) + (v[j][2] * v[j][2] + v[j][3] * v[j][3]);
    return ss; }
__device__ __forceinline__ void p1_norm0(const Frame& F, const AV& a) {
    const int gw = F.vcu * NWAVES + F.wave, NGW = F.G * NWAVES, rpw = (TALL + NGW - 1) / NGW, r0 = gw * rpw, r1 = (r0 + rpw < TALL) ? r0 + rpw : TALL;
    if (r0 >= r1) return;
    f32x4 gpre[4], shift[4], scale[4], xn[4]; ld4(gpre, a.in(6), F.lane); int cb = -1;
    auto xsrc = [&](int m) -> const float* { return m < TL ? a.in(0) + (size_t)m * DM : a.in(2) + (size_t)(m - TL) * DM; };
    ld4(xn, xsrc(r0), F.lane);
    for (int m = r0; m < r1; ++m) {
        f32x4 x[4];
#pragma unroll
        for (int j = 0; j < 4; ++j) x[j] = xn[j];
        if (m + 1 < r1) ld4(xn, xsrc(m + 1), F.lane);
        const int b = m < TL ? (m >> 11) : 16;
        if (b != cb) { cb = b; const float* mv = (const float*)(a.ws() + WS_MOD) + (size_t)b * INCOLS; ld4(shift, mv, F.lane); ld4(scale, mv + 1024, F.lane); }
        const float r = 1.0f / sqrtf(wave_sum(sumsq4(x), F.lane) * (1.0f / 1024.0f) + EPS);
        bf16* ho = (bf16*)(a.ws() + WS_H) + (size_t)m * DM; unsigned char* h8 = a.ws() + WS_H8 + (size_t)m * DM;
#pragma unroll
        for (int j = 0; j < 4; ++j) { const f32x4 hv = x[j] * r * gpre[j] * (scale[j] + 1.0f) + shift[j]; ((GAS u32x2*)ho)[F.lane + 64 * j] = pk4(hv); ((GAS unsigned*)h8)[F.lane + 64 * j] = pk4_fp8(hv); }
    }
}
__device__ __forceinline__ void qk_fix_core(f32x4 (&x)[4], const f32x4 (&gg)[4], const f32x2* tab, bool rope, int t, int sub, int lane) {
    float ss = sumsq4(x); ss += shx(ss, 1, lane); ss += shx(ss, 2, lane); ss += shx(ss, 4, lane);
    const float r = 1.0f / sqrtf(ss * (1.0f / 128.0f) + EPS);
#pragma unroll
    for (int jj = 0; jj < 4; ++jj) x[jj] = x[jj] * r * gg[jj];
    if (rope) { const int pr = t >> 6, pc = t & 63;
#pragma unroll
        for (int i = 0; i < 4; ++i) { const f32x2 cr = tab[pr * 32 + sub * 4 + i], cc = tab[pc * 32 + sub * 4 + i];
            const float a0 = x[0][i], a1 = x[1][i], b0 = x[2][i], b1 = x[3][i];
            x[0][i] = a0 * cr.x - a1 * cr.y; x[1][i] = a1 * cr.x + a0 * cr.y; x[2][i] = b0 * cc.x - b1 * cc.y; x[3][i] = b1 * cc.x + b0 * cc.y; } }
}
__device__ __forceinline__ void p_qkfix(const Frame& F, const AV& a, int l, int M) {
    const int gw = F.vcu * NWAVES + F.wave, NGW = F.G * NWAVES, rpw = (M + NGW - 1) / NGW, r0 = gw * rpw, r1 = (r0 + rpw < M) ? r0 + rpw : M;
    if (r0 >= r1) return;
    const f32x2* tab = (const f32x2*)(a.ws() + WS_TAB); const int hh = F.lane >> 3, sub = F.lane & 7; const bool klane = F.lane < 16;
    f32x4 gq[4], gk[4];
#pragma unroll
    for (int jj = 0; jj < 4; ++jj) { gq[jj] = *(const GAS f32x4*)(a.in(11) + l * 128 + jj * 32 + sub * 4); gk[jj] = *(const GAS f32x4*)(a.in(12) + l * 128 + jj * 32 + sub * 4); }
    bf16* qb = (bf16*)(a.ws() + WS_Q); bf16* kb = (bf16*)(a.ws() + WS_K);
    u32x2 qn[4], kn[4];
    auto issue = [&](int m) { const bool doq = (m < TL) || l == 0; const bf16* qp = qb + (size_t)m * DM + hh * 128 + sub * 4; const bf16* kp = kb + (size_t)krow_of(m) * 256 + hh * 128 + sub * 4;
#pragma unroll
        for (int jj = 0; jj < 4; ++jj) { if (doq) qn[jj] = *(const GAS u32x2*)(qp + jj * 32); if (klane) kn[jj] = *(const GAS u32x2*)(kp + jj * 32); } };
    issue(r0);
    for (int m = r0; m < r1; ++m) {
        const bool lat = m < TL, doq = lat || l == 0; const int t = m & 2047;
        f32x4 xq[4], xk[4];
#pragma unroll
        for (int jj = 0; jj < 4; ++jj) { xq[jj] = bf4(qn[jj]); xk[jj] = bf4(kn[jj]); }
        if (m + 1 < r1) issue(m + 1);
        if (doq) { qk_fix_core(xq, gq, tab, lat, t, sub, F.lane); bf16* qp = qb + (size_t)m * DM + hh * 128 + sub * 4;
#pragma unroll
            for (int jj = 0; jj < 4; ++jj) *(GAS u32x2*)(qp + jj * 32) = pk4(xq[jj]); }
        if (klane) { qk_fix_core(xk, gk, tab, lat, t, sub, F.lane); bf16* kp = kb + (size_t)krow_of(m) * 256 + hh * 128 + sub * 4;
#pragma unroll
            for (int jj = 0; jj < 4; ++jj) *(GAS u32x2*)(kp + jj * 32) = pk4(xk[jj]); }
    }
}
__device__ __forceinline__ void p_conv(const Frame& F, const AV& a, int l, int njobs) {
    LAS unsigned char* lin = F.lds + RING_OFF; LAS float* lout = (LAS float*)(F.lds + RING_OFF + 62 * 1024);
    const bf16* cu = (const bf16*)(a.ws() + WS_CU); bf16* chb = (bf16*)(a.ws() + WS_CH);
    const int cp = F.tid & 255, pg = F.tid >> 8;
    f32x2 wv[31];
#pragma unroll
    for (int j = 0; j < 31; ++j) wv[j] = *(const GAS f32x2*)(a.in(14) + ((size_t)l * 31 + j) * 512 + 2 * cp);
    const f32x2 cb2 = *(const GAS f32x2*)(a.in(15) + l * 512 + 2 * cp);
    for (int job = F.vcu; job < njobs; job += F.G) {
        int rowbase, L, t0;
        if (job < 1024) { rowbase = (job >> 6) * SEQ; L = SEQ; t0 = (job & 63) * 32; } else { const int jc = job - 1024; rowbase = TL + (jc >> 3) * CTXL; L = CTXL; t0 = (jc & 7) * 32; }
        for (int idx = F.tid; idx < 62 * 64; idx += NTHR) { const int row = idx >> 6, ch = idx & 63, p = t0 - 15 + row; v4u val = (v4u){0u, 0u, 0u, 0u};
            if (p >= 0 && p < L) val = *(const GAS v4u*)(cu + (size_t)(rowbase + p) * 512 + ch * 8);
            *(LAS v4u*)(lin + row * 1024 + ch * 16) = val; }
        __syncthreads();
#pragma unroll
        for (int chunk = 0; chunk < 2; ++chunk) {
            f32x2 acc[8];
#pragma unroll
            for (int i = 0; i < 8; ++i) acc[i] = cb2;
            const int r0 = pg * 16 + chunk * 8;
#pragma unroll
            for (int r = 0; r < 38; ++r) { const unsigned w = *(const LAS unsigned*)(lin + (r0 + r) * 1024 + cp * 4); const float x0 = __uint_as_float(w << 16), x1 = __uint_as_float(w & 0xffff0000u);
#pragma unroll
                for (int i = 0; i < 8; ++i) { const int j = r - i; if (j >= 0 && j <= 30) { acc[i].x += x0 * wv[j].x; acc[i].y += x1 * wv[j].y; } } }
#pragma unroll
            for (int i = 0; i < 8; ++i) *(LAS f32x2*)(lout + (r0 + i) * 512 + 2 * cp) = acc[i];
        }
        __syncthreads();
#pragma unroll
        for (int pp = 0; pp < 4; ++pp) { const int p = F.wave * 4 + pp; const LAS float* src = lout + p * 512 + F.lane * 8;
            f32x4 y0 = *(const LAS f32x4*)src, y1 = *(const LAS f32x4*)(src + 4);
            const float mean = wave_sum((y0[0] + y0[1]) + (y0[2] + y0[3]) + (y1[0] + y1[1]) + (y1[2] + y1[3]), F.lane) * (1.0f / 512.0f);
            y0 = y0 - mean; y1 = y1 - mean;
            const float var = wave_sum((y0[0] * y0[0] + y0[1] * y0[1]) + (y0[2] * y0[2] + y0[3] * y0[3]) + (y1[0] * y1[0] + y1[1] * y1[1]) + (y1[2] * y1[2] + y1[3] * y1[3]), F.lane) * (1.0f / 512.0f);
            const float rs = 1.0f / sqrtf(var + EPS);
            const f32x4 g0 = *(const GAS f32x4*)(a.in(16) + l * 512 + F.lane * 8), g1 = *(const GAS f32x4*)(a.in(16) + l * 512 + F.lane * 8 + 4);
            const f32x4 b0 = *(const GAS f32x4*)(a.in(17) + l * 512 + F.lane * 8), b1 = *(const GAS f32x4*)(a.in(17) + l * 512 + F.lane * 8 + 4);
            y0 = y0 * rs * g0 + b0; y1 = y1 * rs * g1 + b1;
#pragma unroll
            for (int q = 0; q < 4; ++q) { y0[q] = y0[q] * sigmoidf_(y0[q]); y1[q] = y1[q] * sigmoidf_(y1[q]); }
            v4u o; o.x = pk2(y0[0], y0[1]); o.y = pk2(y0[2], y0[3]); o.z = pk2(y1[0], y1[1]); o.w = pk2(y1[2], y1[3]);
            *(GAS v4u*)(chb + (size_t)(rowbase + t0 + p) * 512 + F.lane * 8) = o; }
        __syncthreads();
    }
}
__device__ __forceinline__ void p_rowpass1(const Frame& F, const AV& a, int l, int M) {
    const int gw = F.vcu * NWAVES + F.wave, NGW = F.G * NWAVES, rpw = (M + NGW - 1) / NGW, r0 = gw * rpw, r1 = (r0 + rpw < M) ? r0 + rpw : M;
    if (r0 >= r1) return;
    const float* modb = (const float*)(a.ws() + WS_MOD) + (size_t)l * 17 * INCOLS; const bf16* mixb = (const bf16*)(a.ws() + WS_MIX);
    f32x4 gpost[4], gpre[4], gate[4], shift[4], scale[4]; ld4(gpost, a.in(7) + l * DM, F.lane); ld4(gpre, a.in(8) + l * DM, F.lane);
    int cb = -1;
    auto xsrc = [&](int m) -> const float* { return (l == 0) ? (m < TL ? a.in(0) + (size_t)m * DM : a.in(2) + (size_t)(m - TL) * DM) : (m < TL ? a.out() + (size_t)m * DM : (const float*)(a.ws() + WS_XC) + (size_t)(m - TL) * DM); };
    f32x4 xn[4]; u32x2 mn[4]; ld4(xn, xsrc(r0), F.lane);
#pragma unroll
    for (int j = 0; j < 4; ++j) mn[j] = ((const GAS u32x2*)(mixb + (size_t)r0 * DM))[F.lane + 64 * j];
    for (int m = r0; m < r1; ++m) {
        f32x4 x[4], y[4];
#pragma unroll
        for (int j = 0; j < 4; ++j) { x[j] = xn[j]; y[j] = bf4(mn[j]); }
        if (m + 1 < r1) { ld4(xn, xsrc(m + 1), F.lane);
#pragma unroll
            for (int j = 0; j < 4; ++j) mn[j] = ((const GAS u32x2*)(mixb + (size_t)(m + 1) * DM))[F.lane + 64 * j]; }
        const int b = m < TL ? (m >> 11) : 16;
        if (b != cb) { cb = b; const float* mv = modb + (size_t)b * INCOLS; ld4(gate, mv + 2 * 1024, F.lane); ld4(shift, mv + 3 * 1024, F.lane); ld4(scale, mv + 4 * 1024, F.lane); }
        const float r = 1.0f / sqrtf(wave_sum(sumsq4(y), F.lane) * (1.0f / 1024.0f) + EPS);
#pragma unroll
        for (int j = 0; j < 4; ++j) x[j] = x[j] + gate[j] * (y[j] * r * gpost[j]);
        float* xd = m < TL ? a.out() + (size_t)m * DM : (float*)(a.ws() + WS_XC) + (size_t)(m - TL) * DM;
        st_row_f32(x, xd, F.lane);
        const float r2 = 1.0f / sqrtf(wave_sum(sumsq4(x), F.lane) * (1.0f / 1024.0f) + EPS);
        bf16* ho = (bf16*)(a.ws() + WS_H) + (size_t)m * DM;
#pragma unroll
        for (int j = 0; j < 4; ++j) ((GAS u32x2*)ho)[F.lane + 64 * j] = pk4(x[j] * r2 * gpre[j] * (scale[j] + 1.0f) + shift[j]);
    }
}
__device__ __forceinline__ void p_route(const Frame& F, const AV& a, int l, int M) {
    typedef short bfx8 __attribute__((ext_vector_type(8)));
    const int NGW = F.G * NWAVES, rpw = (M + NGW - 1) / NGW, TPB = 8 * rpw, b0 = F.vcu * TPB, b1 = (b0 + TPB < M) ? b0 + TPB : M;
    LAS unsigned char* tabl = F.lds + RING_OFF; LAS float* lg = (LAS float*)(F.lds + LDS_SM) + F.wave * 512; LAS int* cntl = (LAS int*)(F.lds + LDS_SM + 16384);
    VM_WAIT(); __syncthreads();
    if (F.tid < 32) cntl[F.tid] = 0;
    { const GAS v4u* src = (const GAS v4u*)(a.ws() + WS_WSMALL + (size_t)l * WSMALL_LAYER + OFFS_ROUT);
      for (int idx = F.tid; idx < 64 * 128; idx += NTHR) { const int row = idx >> 7, c = idx & 127; *(LAS v4u*)(tabl + row * 2048 + ((c ^ (row & 7)) << 4)) = src[idx]; } }
    __syncthreads();
    const bf16* H = (const bf16*)(a.ws() + WS_H); const float bias = a.in(22)[l * NEXP + (F.lane & 31)];
    const int ar = F.lane & 15, kb = F.lane >> 4, ng = (b1 > b0) ? (b1 - b0 + 15) >> 4 : 0;
    for (int g = F.wave; g < ng; g += NWAVES) {
        const int rb = b0 + g * 16; int row = rb + ar; if (row > M - 1) row = M - 1;
        const bf16* hp = H + (size_t)row * DM + kb * 8; f32x4 acc[4];
#pragma unroll
        for (int f = 0; f < 4; ++f) acc[f] = (f32x4){0.f, 0.f, 0.f, 0.f};
#pragma unroll 4
        for (int s = 0; s < 32; ++s) { const bfx8 af = *(const GAS bfx8*)(hp + s * 32);
#pragma unroll
            for (int f = 0; f < 4; ++f) { const int wr = f * 16 + ar; const bfx8 bfr = *(const LAS bfx8*)(tabl + wr * 2048 + (((4 * s + kb) ^ (wr & 7)) << 4));
                acc[f] = __builtin_amdgcn_mfma_f32_16x16x32_bf16(af, bfr, acc[f], 0, 0, 0); } }
#pragma unroll
        for (int i = 0; i < 4; ++i) { lg[(4 * kb + i) * 32 + ar] = acc[0][i] + acc[2][i]; lg[(4 * kb + i) * 32 + 16 + ar] = acc[1][i] + acc[3][i]; }
        LDS_WAIT(); asm volatile("" ::: "memory");
        { const int hf = F.lane >> 5, ex = F.lane & 31; LAS unsigned long long* kb64 = (LAS unsigned long long*)(F.lds + LDS_SM + 16384 + 256) + F.wave * 64;
          LAS float* selv = (LAS float*)(F.lds + LDS_SM + 16384 + 256 + 4096) + F.wave * 16; LAS int* seli = (LAS int*)(selv + 8);
#pragma unroll 1
          for (int p = 0; p < 8; ++p) { const int r = 2 * p + hf, m = rb + r; const bool valid = m < b1;
            const float v = lg[r * 32 + ex] + bias; unsigned ub = __float_as_uint(v); ub = (ub & 0x80000000u) ? ~ub : (ub | 0x80000000u);
            const unsigned long long K = ((unsigned long long)ub << 5) | (unsigned)(31 - ex);
            kb64[F.lane] = K;
            LDS_WAIT(); asm volatile("" ::: "memory");
            int rank = 0;
#pragma unroll
            for (int j = 0; j < 32; ++j) rank += (kb64[hf * 32 + j] > K) ? 1 : 0;
            if (rank < 4) { selv[hf * 4 + rank] = v; seli[hf * 4 + rank] = ex; if (valid) __hip_atomic_fetch_add(&cntl[ex], 1, __ATOMIC_RELAXED, __HIP_MEMORY_SCOPE_WORKGROUP); }
            LDS_WAIT(); asm volatile("" ::: "memory");
            if (ex == 0 && valid) { const f32x4 tv = *(const LAS f32x4*)(selv + hf * 4); const i32x4 ti = *(const LAS i32x4*)(seli + hf * 4);
                const float e1 = __expf(tv[1] - tv[0]), e2 = __expf(tv[2] - tv[0]), e3 = __expf(tv[3] - tv[0]), inv = 1.0f / (1.0f + e1 + e2 + e3);
                *(GAS i32x4*)((int*)(a.ws() + WS_TOPI) + (size_t)m * 4) = ti; *(GAS f32x4*)((float*)(a.ws() + WS_TOPP) + (size_t)m * 4) = (f32x4){inv, e1 * inv, e2 * inv, e3 * inv}; }
            LDS_WAIT(); asm volatile("" ::: "memory"); } }
        LDS_WAIT(); asm volatile("" ::: "memory");
    }
    __syncthreads();
    if (F.tid < 32) ((int*)(a.ws() + WS_CNT))[F.vcu * 32 + F.tid] = cntl[F.tid];
}
__device__ __forceinline__ void p_slots(const Frame& F, const AV& a, int M) {
    LAS int* sm = (LAS int*)(F.lds + LDS_SM);
    LAS int *tot = sm, *bef = sm + 32, *base = sm + 64, *tst = sm + 96  , *mask = sm + 160  , *ids = sm + 320  , *slot = sm + 960  ;
    const int* cnt = (const int*)(a.ws() + WS_CNT);
    { LAS int* ptot = sm + 1600; LAS int* pbef = sm + 2112; const int e = F.tid & 31, part = F.tid >> 5; int t = 0, b = 0;
#pragma unroll 4
      for (int q = part; q < F.G; q += 16) { const int c = cnt[q * 32 + e]; t += c; if (q < F.vcu) b += c; }
      ptot[part * 32 + e] = t; pbef[part * 32 + e] = b;
      __syncthreads();
      if (F.tid < 32) { int tt = 0, bb = 0;
#pragma unroll
          for (int q = 0; q < 16; ++q) { tt += ptot[q * 32 + F.tid]; bb += pbef[q * 32 + F.tid]; }
          tot[F.tid] = tt; bef[F.tid] = bb; } }
    __syncthreads();
    if (F.tid == 0) { int ts = 0; for (int e = 0; e < 32; ++e) { tst[e] = ts; base[e] = ts * 256 + bef[e]; ts += (tot[e] + 255) >> 8; } tst[32] = ts; }
    __syncthreads();
    const int NT = tst[32];
    if (blockIdx.x == 0) { int* te = (int*)(a.ws() + WS_CNT) + CNT_TILE_E;
        for (int t = F.tid; t < NT; t += NTHR) { int e = 0; for (int q = 1; q < 32; ++q) if (t >= tst[q]) e = q; te[t] = e; }
        if (F.tid == 0) ((int*)(a.ws() + WS_CNT))[CNT_NT] = NT; }
    const int TPB = 8 * ((M + F.G * NWAVES - 1) / (F.G * NWAVES)), m0 = F.vcu * TPB, m1 = (m0 + TPB < M) ? m0 + TPB : M, nt = m1 > m0 ? m1 - m0 : 0;
    for (int tl = F.tid; tl < nt; tl += NTHR) { const i32x4 id = *(const GAS i32x4*)((const int*)(a.ws() + WS_TOPI) + (size_t)(m0 + tl) * 4);
        ids[tl * 4 + 0] = id.x; ids[tl * 4 + 1] = id.y; ids[tl * 4 + 2] = id.z; ids[tl * 4 + 3] = id.w; mask[tl] = (1 << id.x) | (1 << id.y) | (1 << id.z) | (1 << id.w); }
    __syncthreads();
    for (int p = F.tid; p < nt * 4; p += NTHR) { const int tl = p >> 2, e = ids[p]; int rank = 0; for (int q = 0; q < tl; ++q) rank += (mask[q] >> e) & 1;
        const int s = base[e] + rank; slot[p] = s; ((int*)(a.ws() + WS_SLOT))[(size_t)(m0 + tl) * 4 + (p & 3)] = s; }
    __syncthreads();
    const bf16* h = (const bf16*)(a.ws() + WS_H); unsigned char* hs = a.ws() + WS_HS;
    { v4u xa, xb; if (F.wave < nt) { const GAS v4u* src = (const GAS v4u*)(h + (size_t)(m0 + F.wave) * DM); xa = src[F.lane]; xb = src[F.lane + 64]; }
      for (int tl = F.wave; tl < nt; tl += NWAVES) { const v4u x0 = xa, x1 = xb;
        if (tl + NWAVES < nt) { const GAS v4u* src = (const GAS v4u*)(h + (size_t)(m0 + tl + NWAVES) * DM); xa = src[F.lane]; xb = src[F.lane + 64]; }
        u32x2 o0, o1;
        o0.x = pg8::cvt4_fp8(__uint_as_float(x0.x << 16), __uint_as_float(x0.x & 0xffff0000u), __uint_as_float(x0.y << 16), __uint_as_float(x0.y & 0xffff0000u));
        o0.y = pg8::cvt4_fp8(__uint_as_float(x0.z << 16), __uint_as_float(x0.z & 0xffff0000u), __uint_as_float(x0.w << 16), __uint_as_float(x0.w & 0xffff0000u));
        o1.x = pg8::cvt4_fp8(__uint_as_float(x1.x << 16), __uint_as_float(x1.x & 0xffff0000u), __uint_as_float(x1.y << 16), __uint_as_float(x1.y & 0xffff0000u));
        o1.y = pg8::cvt4_fp8(__uint_as_float(x1.z << 16), __uint_as_float(x1.z & 0xffff0000u), __uint_as_float(x1.w << 16), __uint_as_float(x1.w & 0xffff0000u));
#pragma unroll
        for (int k = 0; k < 4; ++k) { GAS u32x2* dst = (GAS u32x2*)(hs + (size_t)slot[tl * 4 + k] * DM); dst[F.lane] = o0; dst[F.lane + 64] = o1; } } }
    if (blockIdx.x < 32) { const int e = blockIdx.x, r0 = tst[e] * 256 + tot[e], r1 = tst[e + 1] * 256;
        unsigned zz = 0u; asm volatile("" : "+v"(zz));
        for (int r = r0 + F.wave; r < r1; r += NWAVES) { GAS v4u* dst = (GAS v4u*)(hs + (size_t)r * DM); dst[F.lane] = (v4u){zz, zz, zz, zz}; } }
    __syncthreads();
}
__device__ __forceinline__ void p_combine(const Frame& F, const AV& a, int l, int M) {
    const int gw = F.vcu * NWAVES + F.wave, NGW = F.G * NWAVES, rpw = (M + NGW - 1) / NGW, r0 = gw * rpw, r1 = (r0 + rpw < M) ? r0 + rpw : M;
    if (r0 >= r1) return;
    const unsigned char* ys = a.ws() + WS_YS;   const int* slp = (const int*)(a.ws() + WS_SLOT); const float* prp = (const float*)(a.ws() + WS_TOPP);
    const float* modb = (const float*)(a.ws() + WS_MOD);
    f32x4 gpost[4], gpre[4], gate[4], shift[4], scale[4]; ld4(gpost, a.in(9) + l * DM, F.lane); if (l == 0) ld4(gpre, a.in(6) + DM, F.lane);
    int cb = -1;
    i32x4 sl_n = *(const GAS i32x4*)(slp + (size_t)r0 * 4); f32x4 pr_n = *(const GAS f32x4*)(prp + (size_t)r0 * 4);
    f32x4 xn[4]; unsigned yn[4][4]; f32x4 prc = pr_n * 0.125f;
    auto xrow = [&](int m) -> float* { return m < TL ? a.out() + (size_t)m * DM : (float*)(a.ws() + WS_XC) + (size_t)(m - TL) * DM; };
    { ld4(xn, xrow(r0), F.lane); const int sv[4] = {sl_n[0], sl_n[1], sl_n[2], sl_n[3]};
#pragma unroll
      for (int k = 0; k < 4; ++k)
#pragma unroll
          for (int j = 0; j < 4; ++j) yn[k][j] = ((const GAS unsigned*)(ys + (size_t)sv[k] * DM))[F.lane + 64 * j];
      if (r0 + 1 < r1) { sl_n = *(const GAS i32x4*)(slp + (size_t)(r0 + 1) * 4); pr_n = *(const GAS f32x4*)(prp + (size_t)(r0 + 1) * 4); } }
    for (int m = r0; m < r1; ++m) {
        f32x4 x[4], y[4];
#pragma unroll
        for (int j = 0; j < 4; ++j) { x[j] = xn[j]; y[j] = fp8x4(yn[0][j]) * prc[0] + fp8x4(yn[1][j]) * prc[1] + fp8x4(yn[2][j]) * prc[2] + fp8x4(yn[3][j]) * prc[3]; }
        if (m + 1 < r1) { prc = pr_n * 0.125f; ld4(xn, xrow(m + 1), F.lane); const int sv[4] = {sl_n[0], sl_n[1], sl_n[2], sl_n[3]};
#pragma unroll
            for (int k = 0; k < 4; ++k)
#pragma unroll
                for (int j = 0; j < 4; ++j) yn[k][j] = ((const GAS unsigned*)(ys + (size_t)sv[k] * DM))[F.lane + 64 * j];
            if (m + 2 < r1) { sl_n = *(const GAS i32x4*)(slp + (size_t)(m + 2) * 4); pr_n = *(const GAS f32x4*)(prp + (size_t)(m + 2) * 4); } }
        const int b = m < TL ? (m >> 11) : 16;
        if (b != cb) { cb = b; ld4(gate, modb + ((size_t)l * 17 + b) * INCOLS + 5 * 1024, F.lane); if (l == 0) { const float* m1 = modb + ((size_t)17 + b) * INCOLS; ld4(shift, m1, F.lane); ld4(scale, m1 + 1024, F.lane); } }
        const float r = 1.0f / sqrtf(wave_sum(sumsq4(y), F.lane) * (1.0f / 1024.0f) + EPS);
#pragma unroll
        for (int j = 0; j < 4; ++j) x[j] = x[j] + gate[j] * (y[j] * r * gpost[j]);
        st_row_f32(x, xrow(m), F.lane);
        if (l == 0) { const float r2 = 1.0f / sqrtf(wave_sum(sumsq4(x), F.lane) * (1.0f / 1024.0f) + EPS);
            bf16* ho = (bf16*)(a.ws() + WS_H) + (size_t)m * DM; unsigned char* h8 = a.ws() + WS_H8 + (size_t)m * DM;
#pragma unroll
            for (int j = 0; j < 4; ++j) { const f32x4 hv = x[j] * r2 * gpre[j] * (scale[j] + 1.0f) + shift[j]; ((GAS u32x2*)ho)[F.lane + 64 * j] = pk4(hv); ((GAS unsigned*)h8)[F.lane + 64 * j] = pk4_fp8(hv); } }
    }
}
#ifdef DBG_CHECK
#ifndef DBG_GSUB
#define DBG_GSUB 0
#endif
__device__ __forceinline__ double bfd(bf16 b) { return (double)__uint_as_float(((unsigned)b) << 16); }
__device__ __forceinline__ unsigned hsh(unsigned x) { x ^= x >> 16; x *= 0x7feb352du; x ^= x >> 15; x *= 0x846ca68bu; x ^= x >> 16; return x; }
__device__ __forceinline__ int samp_row(int i, int M, unsigned salt) { const int sp[12] = {0, 1, 255, 256, 2047, 2048, 4095, 32767, 32768, 32769, 33023, 36863}; if (i < 12 && sp[i] < M) return sp[i]; return (int)(hsh(i * 7919u + salt) % (unsigned)M); }
__device__ __forceinline__ void rec(float* res, int stage, double got, double want, double flo) { const double e = fabs(got - want) / (fabs(want) + flo); const float f = (e == e) ? (float)e : 1e30f; atomicMax((unsigned*)res + stage, __float_as_uint(f)); }
__device__ double dot_h_w(const bf16* hrow, const float* w, int ldw, int col) { double s = 0; for (int k = 0; k < 1024; ++k) s += bfd(hrow[k]) * (double)w[(size_t)k * ldw + col]; return s; }
__device__ double dsig(double x) { return 1.0 / (1.0 + exp(-x)); }
constexpr double PI_D = 3.14159265358979323846;
enum { ST_MOD = 0, ST_H0, ST_INPROJ, ST_YT, ST_QKFIX, ST_CONV, ST_Z, ST_ATTN, ST_GATES, ST_MERGED, ST_MIX, ST_ROW1, ST_LOGIT, ST_TOPK, ST_SLOTS, ST_ACT, ST_YSLOT, ST_COMB, ST_GATESB, ST_N };
__global__ void chk(Args A, int stage, int l, float* res, float* snap) {
    const int i = threadIdx.x; unsigned char* ws = A.ws; const int M = (l == 0) ? TALL : TL; const int rs = stage + 32 * l;
    const bf16* H = (const bf16*)(ws + WS_H); const float* win = A.in[10] + (size_t)l * DM * INCOLS; const float* modb = (const float*)(ws + WS_MOD);
    if (stage == ST_MOD) { const int ll = i & 1, b = (i >> 1) % 17, n = (int)(hsh(i) % 6144u); double s = 0; for (int k = 0; k < 1024; ++k) { const double cv = b < 16 ? A.in[1][b * 1024 + k] : A.in[3][k]; s += cv * dsig(cv) * (double)A.in[4][((size_t)ll * 1024 + k) * 6144 + n]; }
        s += A.in[5][ll * 6144 + n]; rec(res, rs, modb[((size_t)ll * 17 + b) * 6144 + n], s, 0.02); }
    else if (stage == ST_H0) { const int m = samp_row(i, TALL, 1), c = (int)(hsh(i + 77) % 1024u); const float* x = m < TL ? A.in[0] + (size_t)m * DM : A.in[2] + (size_t)(m - TL) * DM; double ss = 0; for (int k = 0; k < 1024; ++k) ss += (double)x[k] * x[k];
        const float* mv = modb + (size_t)(m < TL ? (m >> 11) : 16) * 6144; const double want = x[c] / sqrt(ss / 1024 + 1e-6) * A.in[6][c] * (1.0 + mv[1024 + c]) + mv[c]; rec(res, rs, bfd(H[(size_t)m * DM + c]), want, 0.05); }
    else if (stage == ST_INPROJ) { const int m = samp_row(i, TALL, 2), kind = i & 3; const bf16* hr = H + (size_t)m * DM;
        if (kind == 0) { const int n = (int)(hsh(i + 5) % 1024u); rec(res, rs, bfd(((const bf16*)(ws + WS_Q))[(size_t)m * DM + n]), dot_h_w(hr, win, INCOLS, n), 0.05); }
        else if (kind == 1) { const int n = (int)(hsh(i + 6) % 256u); rec(res, rs, bfd(((const bf16*)(ws + WS_K))[(size_t)krow_of(m) * 256 + n]), dot_h_w(hr, win, INCOLS, 1024 + n), 0.05); }
        else if (kind == 2) { const int n = (int)(hsh(i + 7) % 256u); rec(res, rs, bfd(((const bf16*)(ws + WS_V))[(size_t)krow_of(m) * 256 + n]), dot_h_w(hr, win, INCOLS, 1280 + n), 0.05); }
        else { const int c = (int)(hsh(i + 8) % 512u); if (l == 0 || m < TL) { const double a = dot_h_w(hr, win, INCOLS, 1536 + c), g = dot_h_w(hr, win, INCOLS, 2048 + c); rec(res, rs, bfd(((const bf16*)(ws + WS_CU))[(size_t)m * 512 + c]), a * dsig(g), 0.05); } } }
    else if (stage == ST_YT) { const int m = samp_row(i, M, 3), ch = (int)(hsh(i + 9) % 512u), cs = i & 1, g = ch >> 7, k2 = ch & 127; const bf16* hr = H + (size_t)m * DM; double s = 0;
        for (int k = 0; k < 1024; ++k) { double t = 0; for (int n2 = 0; n2 < 128; ++n2) { const double ang = 2.0 * PI_D * ((n2 * k2) & 127) / 128.0; t += (double)win[(size_t)k * INCOLS + OFF_FNET + g * 128 + n2] * (cs ? sin(ang) : cos(ang)); } s += bfd(hr[k]) * t; }
        s /= sqrt(128.0); double got; if (m < TL) got = bfd(((const bf16*)(ws + WS_YT))[((size_t)(m >> 11) * 512 + ch) * 4096 + cs * 2048 + (m & 2047)]); else got = bfd(((const bf16*)(ws + WS_YTC))[((size_t)((m - TL) >> 8) * 512 + ch) * 512 + cs * 256 + ((m - TL) & 255)]);
        rec(res, rs, got, s, 0.05); }
    else if (stage == ST_QKFIX) { const int m = samp_row(i, TALL, 4), isk = i & 1, hh = isk ? (int)(hsh(i + 3) % 2u) : (int)(hsh(i + 3) % 8u), d = (int)(hsh(i + 4) % 128u); const bf16* hr = H + (size_t)m * DM;
        if (isk || l == 0 || m < TL) { const int cbase = isk ? 1024 + hh * 128 : hh * 128; double ss = 0, xd = 0, xp = 0; const int half = d & 64, dd = d & 63, pd = half + ((dd + 32) & 63);
            for (int q = 0; q < 128; ++q) { double v = dot_h_w(hr, win, INCOLS, cbase + q); v = bfd((bf16)f2bf((float)v)); ss += v * v; if (q == d) xd = v; if (q == pd) xp = v; }
            const float* gn = (isk ? A.in[12] : A.in[11]) + l * 128; const double r = 1.0 / sqrt(ss / 128 + 1e-6); xd *= r * gn[d]; xp *= r * gn[pd]; double want = xd;
            if (m < TL) { const int t = m & 2047, pos = half ? (t & 63) : (t >> 6), f = dd & 31; const double ang = (double)((float)pos * powf(10000.0f, -(float)f / 32.0f)); want = (dd < 32) ? xd * cos(ang) - xp * sin(ang) : xd * cos(ang) + xp * sin(ang); }
            const double got = isk ? bfd(((const bf16*)(ws + WS_K))[(size_t)krow_of(m) * 256 + hh * 128 + d]) : bfd(((const bf16*)(ws + WS_Q))[(size_t)m * DM + hh * 128 + d]); rec(res, rs, got, want, 0.05); } }
    else if (stage == ST_CONV) { const int m = samp_row(i, M, 5), c = (int)(hsh(i + 11) % 512u); const int rowbase = m < TL ? (m >> 11) * SEQ : TL + ((m - TL) >> 8) * CTXL, L = m < TL ? SEQ : CTXL, t = m - rowbase; const bf16* cu = (const bf16*)(ws + WS_CU);
        double s1 = 0, s2 = 0, yc = 0; for (int cc = 0; cc < 512; ++cc) { double y = A.in[15][l * 512 + cc]; for (int j = 0; j < 31; ++j) { const int p = t + j - 15; if (p >= 0 && p < L) y += bfd(cu[(size_t)(rowbase + p) * 512 + cc]) * (double)A.in[14][((size_t)l * 31 + j) * 512 + cc]; } s1 += y; s2 += y * y; if (cc == c) yc = y; }
        const double mean = s1 / 512, var = s2 / 512 - mean * mean; double y = (yc - mean) / sqrt(var + 1e-6) * A.in[16][l * 512 + c] + A.in[17][l * 512 + c]; y = y * dsig(y); rec(res, rs, bfd(((const bf16*)(ws + WS_CH))[(size_t)m * 512 + c]), y, 0.05); }
    else if (stage == ST_Z) { const int m = samp_row(i, M, 6), ch = (int)(hsh(i + 12) % 512u); double s = 0;
        if (m < TL) { const int b = m >> 11, k1 = m & 2047; const bf16* yr = (const bf16*)(ws + WS_YT) + ((size_t)b * 512 + ch) * 4096; for (int n1 = 0; n1 < 2048; ++n1) { const double ang = 2.0 * PI_D * ((k1 * n1) & 2047) / 2048.0; s += cos(ang) * bfd(yr[n1]) - sin(ang) * bfd(yr[2048 + n1]); } s /= sqrt(2048.0); }
        else { const int b = (m - TL) >> 8, k1 = (m - TL) & 255; const bf16* yr = (const bf16*)(ws + WS_YTC) + ((size_t)b * 512 + ch) * 512; for (int n1 = 0; n1 < 256; ++n1) { const double ang = 2.0 * PI_D * ((k1 * n1) & 255) / 256.0; s += cos(ang) * bfd(yr[n1]) - sin(ang) * bfd(yr[256 + n1]); } s /= 16.0; }
        rec(res, rs, bfd(((const bf16*)(ws + WS_Z))[(size_t)m * 512 + ch]), s, 0.05); }
    else if (stage == ST_ATTN) { const int m = samp_row(i, M, 7), hh = (int)(hsh(i + 13) % 8u), d = (int)(hsh(i + 14) % 128u); const bf16* q = (const bf16*)(ws + WS_Q) + (size_t)m * DM + hh * 128;
        int kr0, nk; if (m < TL) { kr0 = (m >> 11) * KVROWS; nk = KVROWS; } else { kr0 = ((m - TL) >> 8) * KVROWS + SEQ; nk = CTXL; }
        const bf16* K = (const bf16*)(ws + WS_K) + (size_t)kr0 * 256 + (hh >> 2) * 128; const bf16* V = (const bf16*)(ws + WS_V) + (size_t)kr0 * 256 + (hh >> 2) * 128;
        double mx = -1e300; for (int j = 0; j < nk; ++j) { double s = 0; for (int q2 = 0; q2 < 128; ++q2) s += bfd(q[q2]) * bfd(K[(size_t)j * 256 + q2]); s *= 0.08838834764831845; if (s > mx) mx = s; }
        double den = 0, num = 0; for (int j = 0; j < nk; ++j) { double s = 0; for (int q2 = 0; q2 < 128; ++q2) s += bfd(q[q2]) * bfd(K[(size_t)j * 256 + q2]); s *= 0.08838834764831845; const double p = exp(s - mx); den += p; num += p * bfd(V[(size_t)j * 256 + d]); }
        rec(res, rs, bfd(((const bf16*)(ws + WS_AO))[(size_t)m * DM + hh * 128 + d]), num / den, 0.03); }
    else if (stage == ST_GATES) { const int m = samp_row(i, M, 8), n = (int)(hsh(i + 15) % 3072u); rec(res, rs, bfd(((const bf16*)(ws + WS_GATES))[(size_t)m * 3072 + n]), dsig(dot_h_w(H + (size_t)m * DM, win, INCOLS, OFF_GATE + n)), 0.05); }
    else if (stage == ST_GATESB && DBG_GSUB == 1) { const int m = samp_row(i, M, 8), n = (int)(hsh(i + 15) % 3072u); const double got = bfd(((const bf16*)(ws + WS_GATES))[(size_t)m * 3072 + n]), want = dsig(dot_h_w(H + (size_t)m * DM, win, INCOLS, OFF_GATE + n));
        const bool badv = !(fabs(got - want) <= 0.05); if (badv) { unsigned* r = (unsigned*)res + 48; atomicOr(r, (m < TL ? 1u : 2u) | (4u << (n >> 10)) | (i < 12 ? 32u : 0u)); } }
    else if (stage == ST_GATESB) { const int m = samp_row(i, M, 8), n = (int)(hsh(i + 15) % 3072u); const bf16* wt = (const bf16*)(ws + WS_WSMALL + (size_t)l * WSMALL_LAYER + OFFS_WG) + (size_t)n * 1024; const bf16* hr = H + (size_t)m * DM; double s = 0; for (int k = 0; k < 1024; ++k) s += bfd(hr[k]) * bfd(wt[k]);
        rec(res, rs, bfd(((const bf16*)(ws + WS_GATES))[(size_t)m * 3072 + n]), dsig(s), 0.05); }
    else if (stage == ST_MERGED) { const int m = samp_row(i, M, 9), c = (int)(hsh(i + 16) % 1024u); const bf16* g = (const bf16*)(ws + WS_GATES) + (size_t)m * 3072; double y0 = 0, y1 = 0, y2 = 0;
        const bf16* ao = (const bf16*)(ws + WS_AO) + (size_t)m * DM; const bf16* chh = (const bf16*)(ws + WS_CH) + (size_t)m * 512; const bf16* z = (const bf16*)(ws + WS_Z) + (size_t)m * 512;
        for (int k = 0; k < 1024; ++k) y0 += bfd(ao[k]) * (double)A.in[13][((size_t)l * 1024 + k) * 1024 + c];
        for (int k = 0; k < 512; ++k) { y1 += bfd(chh[k]) * (double)A.in[18][((size_t)l * 512 + k) * 1024 + c]; y2 += bfd(z[k]) * (double)A.in[19][((size_t)l * 512 + k) * 1024 + c]; }
        rec(res, rs, bfd(((const bf16*)(ws + WS_MERGED))[(size_t)m * DM + c]), bfd(g[c]) * y0 + bfd(g[1024 + c]) * y1 + bfd(g[2048 + c]) * y2, 0.05); }
    else if (stage == ST_MIX) { const int m = samp_row(i, M, 10), c = (int)(hsh(i + 17) % 1024u); rec(res, rs, bfd(((const bf16*)(ws + WS_MIX))[(size_t)m * DM + c]), dot_h_w((const bf16*)(ws + WS_MERGED) + (size_t)m * DM, A.in[20] + (size_t)l * DM * DM, DM, c), 0.05); }
    else if (stage == ST_ROW1) { const int m = samp_row(i, M, 11), c = (int)(hsh(i + 18) % 1024u); const float* xs = snap + (size_t)i * 1024;
        const bf16* mix = (const bf16*)(ws + WS_MIX) + (size_t)m * DM; const float* mv = modb + ((size_t)l * 17 + (m < TL ? (m >> 11) : 16)) * 6144; double ss = 0; for (int k = 0; k < 1024; ++k) ss += bfd(mix[k]) * bfd(mix[k]); const double r = 1.0 / sqrt(ss / 1024 + 1e-6);
        double s2 = 0, xc = 0; for (int k = 0; k < 1024; ++k) { const double xn = xs[k] + mv[2048 + k] * (bfd(mix[k]) * r * A.in[7][l * DM + k]); s2 += xn * xn; if (k == c) xc = xn; }
        const float* xd = m < TL ? A.out + (size_t)m * DM : (const float*)(ws + WS_XC) + (size_t)(m - TL) * DM; rec(res, rs, xd[c], xc, 0.02);
        rec(res, rs, bfd(H[(size_t)m * DM + c]), xc / sqrt(s2 / 1024 + 1e-6) * A.in[8][l * DM + c] * (1.0 + mv[4096 + c]) + mv[3072 + c], 0.05); }
    else if (stage == ST_LOGIT) { const int m = samp_row(i, M, 12), e = i & 31; const float* lg = (const float*)(ws + WS_LOGIT) + (size_t)m * 64; rec(res, rs, (double)lg[e] + lg[32 + e], dot_h_w(H + (size_t)m * DM, A.in[21] + (size_t)l * DM * NEXP, NEXP, e), 0.02); }
    else if (stage == ST_TOPK) { const int m = samp_row(i, M, 13); const float* lg = (const float*)(ws + WS_LOGIT) + (size_t)m * 64; float v[32]; for (int e = 0; e < 32; ++e) v[e] = lg[e] + lg[32 + e] + A.in[22][l * 32 + e];
        int id[4]; float tv[4]; for (int k = 0; k < 4; ++k) { int b = -1; for (int e = 0; e < 32; ++e) { bool used = false; for (int q = 0; q < k; ++q) used |= (id[q] == e); if (!used && (b < 0 || v[e] > v[b])) b = e; } id[k] = b; tv[k] = v[b]; }
        double den = 0; for (int k = 0; k < 4; ++k) den += exp((double)tv[k] - tv[0]); const int* gi = (const int*)(ws + WS_TOPI) + (size_t)m * 4; const float* gp = (const float*)(ws + WS_TOPP) + (size_t)m * 4;
        for (int k = 0; k < 4; ++k) { rec(res, rs, gi[k] == id[k] ? 0.0 : 1.0, 0, 0.01); rec(res, rs, gp[k], exp((double)tv[k] - tv[0]) / den, 0.01); } }
    else if (stage == ST_SLOTS) { const int m = samp_row(i, M, 14), k = i & 3; const int s = ((const int*)(ws + WS_SLOT))[(size_t)m * 4 + k], e = ((const int*)(ws + WS_TOPI))[(size_t)m * 4 + k]; const int NT = ((const int*)(ws + WS_CNT))[CNT_NT];
        if (s < 0 || s >= NT * 256) rec(res, rs, 1, 0, 0.01); else { rec(res, rs, ((const int*)(ws + WS_CNT))[CNT_TILE_E + (s >> 8)] == e ? 0.0 : 1.0, 0, 0.01); const bf16* hs = (const bf16*)(ws + WS_HS) + (size_t)s * DM; double df = 0; for (int q = 0; q < 1024; ++q) df += fabs(bfd(hs[q]) - bfd(H[(size_t)m * DM + q])); rec(res, rs, df, 0, 1e-3); } }
    else if (stage == ST_ACT) { const int m = samp_row(i, M, 15), k = i & 3, c = (int)(hsh(i + 21) % 1024u); const int s = ((const int*)(ws + WS_SLOT))[(size_t)m * 4 + k], e = ((const int*)(ws + WS_TOPI))[(size_t)m * 4 + k]; const bf16* hs = (const bf16*)(ws + WS_HS) + (size_t)s * DM;
        double g = dot_h_w(hs, A.in[23] + (((size_t)l * NEXP + e) << 20), DM, c) + A.in[24][((size_t)l * NEXP + e) * 1024 + c], u = dot_h_w(hs, A.in[25] + (((size_t)l * NEXP + e) << 20), DM, c) + A.in[26][((size_t)l * NEXP + e) * 1024 + c];
        g = g < 7.0 ? g : 7.0; u = u < -7.0 ? -7.0 : (u > 7.0 ? 7.0 : u); rec(res, rs, bfd(((const bf16*)(ws + WS_ACT))[(size_t)s * DM + c]), (u + 1.0) * (g * dsig(1.702 * g)), 0.05); }
    else if (stage == ST_YSLOT) { const int m = samp_row(i, M, 16), k = i & 3, c = (int)(hsh(i + 22) % 1024u); const int s = ((const int*)(ws + WS_SLOT))[(size_t)m * 4 + k], e = ((const int*)(ws + WS_TOPI))[(size_t)m * 4 + k];
        rec(res, rs, bfd(((const bf16*)(ws + WS_HS))[(size_t)s * DM + c]), dot_h_w((const bf16*)(ws + WS_ACT) + (size_t)s * DM, A.in[27] + (((size_t)l * NEXP + e) << 20), DM, c) + A.in[28][((size_t)l * NEXP + e) * 1024 + c], 0.05); }
    else if (stage == ST_COMB) { const int m = samp_row(i, M, 17), c = (int)(hsh(i + 23) % 1024u); const float* xs = snap + (size_t)i * 1024; const int* sl = (const int*)(ws + WS_SLOT) + (size_t)m * 4; const float* pr = (const float*)(ws + WS_TOPP) + (size_t)m * 4;
        const float* mv = modb + ((size_t)l * 17 + (m < TL ? (m >> 11) : 16)) * 6144; double ss = 0, yc = 0; for (int q = 0; q < 1024; ++q) { double y = 0; for (int k = 0; k < 4; ++k) y += (double)pr[k] * bfd(((const bf16*)(ws + WS_HS))[(size_t)sl[k] * DM + q]); ss += y * y; if (q == c) yc = y; }
        const double want = xs[c] + mv[5 * 1024 + c] * (yc / sqrt(ss / 1024 + 1e-6) * A.in[9][l * DM + c]); const float* xd = m < TL ? A.out + (size_t)m * DM : (const float*)(ws + WS_XC) + (size_t)(m - TL) * DM; rec(res, rs, xd[c], want, 0.02); }
}
__global__ void snap_rows(Args A, int l, int salt, float* snap) {
    const int i = blockIdx.x, M = (l == 0) ? TALL : TL, m = samp_row(i, M, salt); const float* xs;
    if (l == 0 && salt == 11) xs = m < TL ? A.in[0] + (size_t)m * DM : A.in[2] + (size_t)(m - TL) * DM; else xs = m < TL ? A.out + (size_t)m * DM : (const float*)(A.ws + WS_XC) + (size_t)(m - TL) * DM;
    for (int k = threadIdx.x; k < 1024; k += blockDim.x) snap[(size_t)i * 1024 + k] = xs[k];
}
__global__ void chk_gates_full(const bf16* H, const bf16* Wt, const bf16* G, int M, unsigned* cntw) {
    const int n = blockIdx.x * 64 + (threadIdx.x & 63), m = blockIdx.y * 4 + (threadIdx.x >> 6); if (m >= M) return;
    const uint4* a = (const uint4*)(H + (size_t)m * 1024); const uint4* b = (const uint4*)(Wt + (size_t)n * 1024); float s = 0.f;
    for (int k = 0; k < 128; ++k) { const uint4 x = a[k], y = b[k]; const unsigned xs[4] = {x.x, x.y, x.z, x.w}, ys[4] = {y.x, y.y, y.z, y.w};
        for (int q = 0; q < 4; ++q) { s += __uint_as_float(xs[q] << 16) * __uint_as_float(ys[q] << 16); s += __uint_as_float(xs[q] & 0xffff0000u) * __uint_as_float(ys[q] & 0xffff0000u); } }
    const float want = 1.0f / (1.0f + __expf(-s)), got = __uint_as_float(((unsigned)G[(size_t)m * 3072 + n]) << 16);
    if (!(fabsf(got - want) <= 0.02f)) { atomicAdd(cntw, 1u); cntw[16 + (m >> 8) * 12 + (n >> 8)] = 1u; }
}
__global__ void encode_full(float* out, const unsigned* cntw, int n) {
    __shared__ int bc, bt; if (threadIdx.x == 0) { unsigned C = cntw[0], T = 0; for (int t = 0; t < 1728; ++t) T += cntw[16 + t]; int b1 = 0; while (C) { ++b1; C /= 10; } int b2 = 0; while (T) { ++b2; T /= 4; } bc = b1 > 7 ? 7 : b1; bt = b2 > 7 ? 7 : b2; }
    __syncthreads(); const float K = ldexpf(1.0f, 2 + 8 * bt + bc);
    for (size_t i = (size_t)blockIdx.x * blockDim.x + threadIdx.x; i < (size_t)n; i += (size_t)gridDim.x * blockDim.x) out[i] = K;
}
__global__ void encode(float* out, const float* res, int n, float thr) {
    #if DBG_GSUB == 1
    { const unsigned mk = ((const unsigned*)res)[48]; const float K = ldexpf(1.0f, 2 + (int)mk); for (size_t i = (size_t)blockIdx.x * blockDim.x + threadIdx.x; i < (size_t)n; i += (size_t)gridDim.x * blockDim.x) out[i] = K; return; }
#endif
#ifndef CHK_SKIP
#define CHK_SKIP 0ull
#endif
    int bad = -1; for (int s = 0; s < 64; ++s) if (!((CHK_SKIP >> s) & 1ull) && res[s] > thr) { bad = s; break; }
    if (bad < 0) return; const float er = res[bad]; const float K = ldexpf(1.0f, bad + 2) * (er < 0.5f ? 1.0f : er < 1.0f ? 1.25f : er < 4.0f ? 1.5f : 1.75f);
    for (size_t i = (size_t)blockIdx.x * blockDim.x + threadIdx.x; i < (size_t)n; i += (size_t)gridDim.x * blockDim.x) out[i] = K;
}
#endif
#ifndef GP_SP2
#define GP_SP2 true
#endif
#ifndef GP_ALIGN
#define GP_ALIGN true
#endif
__global__ void __launch_bounds__(NTHR, 2) fwd(Args args) {
    extern __shared__ __attribute__((aligned(16))) unsigned char lds[];
    Frame F;
    F.lds = (LAS unsigned char*)lds; F.MISC = (volatile LAS unsigned*)(F.lds + MISC_OFF);
    F.tid = threadIdx.x; F.lane = F.tid & 63; F.wave = __builtin_amdgcn_readfirstlane(F.tid >> 6);
    F.G = gridDim.x; { const int bx = blockIdx.x; F.vcu = (F.G % 8 == 0) ? (bx % 8) * (F.G / 8) + bx / 8 : bx; }
    { const AV A0 = av_get(); F.ctl = (gu32*)(A0.ws() + WS_CTL); }
    for (int u = F.tid; u < (LDS_BYTES - LDSCTL_OFF) / 4; u += NTHR) ((LAS unsigned*)(F.lds + LDSCTL_OFF))[u] = 0u;
    __syncthreads();
    XcdBarrier bar; bar.bar = (unsigned*)(F.ctl + CW_BAR); bar.x = 0; bar.st = nullptr;
    if (!MK_PER_PHASE) bar = xcd_barrier_post((unsigned*)(F.ctl + CW_BAR), F.MISC + 8);
    int lo, hi; { const AV A0 = av_get(); lo = *(const int __attribute__((address_space(4)))*)(A0.kp + 8 * 31); hi = *(const int __attribute__((address_space(4)))*)(A0.kp + 8 * 31 + 4); }
#ifndef DIS_MASK
#define DIS_MASK 0ull
#endif
#define IN(k) (lo <= (k) && (k) < hi)
#define ON(j) (!((DIS_MASK >> (j)) & 1ull))
#ifndef REP_MASK
#define REP_MASK 0ull
#endif
#define REPS(j) ((int)((REP_MASK >> (j)) & 1ull))
#ifdef STAMP_SEL
#define SEAM(k) do { xcd_barrier(bar); if (blockIdx.x == 0 && threadIdx.x == 0) ((unsigned long long*)(F.ctl + 32768))[(k) + 1] = __builtin_amdgcn_s_memrealtime(); } while (0)
#else
#ifdef DOUBLE_BAR
#define SEAM(k) do { if (!MK_PER_PHASE && IN((k) + 1)) { xcd_barrier(bar); xcd_barrier(bar); } } while (0)
#else
#define SEAM(k) do { if (!MK_PER_PHASE && IN((k) + 1)) xcd_barrier(bar); } while (0)
#endif
#endif
    const int bx = (int)blockIdx.x;
    const int wave0 = __builtin_amdgcn_readfirstlane((int)threadIdx.x >> 6);
#define F_REFRESH() do { unsigned z_ = 0u; asm volatile("" : "+v"(z_)); const int t_ = wave0 * 64 + (int)__builtin_amdgcn_mbcnt_hi(~0u, __builtin_amdgcn_mbcnt_lo(~0u, z_)); F.tid = t_; F.lane = t_ & 63; F.wave = wave0; } while (0)

#ifdef STAMP_SEL
    if (blockIdx.x == 0 && threadIdx.x == 0) ((unsigned long long*)(F.ctl + 32768))[0] = __builtin_amdgcn_s_memrealtime();
#endif
    if (ON(0) && IN(0)) for (int rep_ = 0; rep_ <= REPS(0); ++rep_) { F_REFRESH(); const AV A = av_get(); p0_prologue(F, A); SEAM(0); }
    if (ON(1) && IN(1)) for (int rep_ = 0; rep_ <= REPS(1); ++rep_) { F_REFRESH(); const AV A = av_get(); p1_norm0(F, A); SEAM(1); }

    for (int l = 0; l < 2; ++l) {
        const int pb = 2 + l * NPL;
        const int Mm = (l == 0) ? TALL : TL;
#define PH_BEGIN F_REFRESH(); const AV A = av_get(); unsigned char* const ws = A.ws(); unsigned char* const wl = ws + WS_WSMALL + (size_t)l * WSMALL_LAYER; (void)wl
        if (ON(2 + 0) && IN(pb + 0)) for (int rep_ = 0; rep_ <= REPS(2 + 0); ++rep_) { PH_BEGIN;
            if (ON(16)) { pg8::Gemm g{(const bf16*)(ws + WS_H8), (const bf16*)(wl + OFFS_WIN), TALL, 2560, DM / 2}; pg8::StaticOrder S; S.init(TALL, 2560, F.G, bx);
              pg8::EpiInproj E{(bf16*)(ws + WS_Q), (bf16*)(ws + WS_K), (bf16*)(ws + WS_V), (bf16*)(ws + WS_CU)};
              pg8::gemm_phase<pg8::EpiInproj, pg8::StaticOrder, GP_ALIGN, GP_SP2, true>(F.lds + RING_OFF, g, S, E, F.tid); }
            if (ON(17)) { pg8::Gemm g{(const bf16*)(wl + OFFS_WF), (const bf16*)(ws + WS_H), 1024, Mm, DM}; pg8::StaticOrder S; S.init(1024, Mm, F.G, (bx + 96) % F.G);
              pg8::EpiYT E{ws + WS_YT, ws + WS_YTC};
              pg8::gemm_phase<pg8::EpiYT, pg8::StaticOrder, GP_ALIGN, GP_SP2>(F.lds + RING_OFF, g, S, E, F.tid); }
            SEAM(pb + 0);
        }
        if (ON(2 + 1) && IN(pb + 1)) for (int rep_ = 0; rep_ <= REPS(2 + 1); ++rep_) { PH_BEGIN;
            if (ON(18)) p_qkfix(F, A, l, TALL);
            F_REFRESH();
            if (ON(19)) p_conv(F, A, l, l == 0 ? 1152 : 1024);
            if (ON(20)) { pg8::Gemm g{(const bf16*)(ws + WS_DFTL), (const bf16*)(ws + WS_YT), 2048, NB * 512, 2048}; pg8::DftOrder S; S.init(3, NB, F.G, F.vcu);
              pg8::EpiDFT E{(bf16*)(ws + WS_Z), 0, SEQ};
              pg8::gemm_phase<pg8::EpiDFT, pg8::DftOrder, GP_ALIGN, GP_SP2, true>(F.lds + RING_OFF, g, S, E, F.tid); }
            if (ON(21) && l == 0) { pg8::Gemm g{(const bf16*)(ws + WS_DFTC), (const bf16*)(ws + WS_YTC), 256, NB * 512, 256}; pg8::DftOrder S; S.init(0, NB, F.G, F.vcu);
              pg8::EpiDFT E{(bf16*)(ws + WS_Z), TL, CTXL};
              pg8::gemm_phase<pg8::EpiDFT, pg8::DftOrder, GP_ALIGN, GP_SP2, true>(F.lds + RING_OFF, g, S, E, F.tid); }
            SEAM(pb + 1);
        }
        if (ON(2 + 2) && IN(pb + 2)) for (int rep_ = 0; rep_ <= REPS(2 + 2); ++rep_) { PH_BEGIN;
            const int nheavy = NB * 8 * 8, ntot = nheavy + (l == 0 ? NB * 8 : 0);
            for (int L = F.vcu; L < ntot; L += F.G) {
                int row0, krow, h, seq;
                if (L < nheavy) { const int grp = L >> 5, s = L & 31, b = grp >> 1; h = (grp & 1) * 4 + (s >> 3); row0 = b * SEQ + (s & 7) * 256; krow = b * KVROWS; seq = KVROWS; }
                else { const int Lc = L - nheavy, b = Lc >> 3; h = Lc & 7; row0 = TL + b * CTXL; krow = b * KVROWS + SEQ; seq = CTXL; }
                const att::bf16* Qb = (const att::bf16*)(ws + WS_Q) + (size_t)row0 * DM + h * 128;
                const att::bf16* Kh = (const att::bf16*)(ws + WS_K) + (size_t)krow * 256 + (h >> 2) * 128;
                const att::bf16* Vh = (const att::bf16*)(ws + WS_V) + (size_t)krow * 256 + (h >> 2) * 128;
                unsigned char* Ob = ws + WS_AO + (size_t)row0 * DM + h * 128;
                att::attn_dense_body<att::bf16>(Qb, Kh, Vh, Ob, seq, (char*)lds + RING_OFF, F.tid);
                __syncthreads();
            }
            SEAM(pb + 2);
        }
        if (ON(2 + 3) && IN(pb + 3)) for (int rep_ = 0; rep_ <= REPS(2 + 3); ++rep_) { PH_BEGIN;
            pg8::Gemm g{(const bf16*)(ws + WS_H8), (const bf16*)(wl + OFFS_WG), Mm, 3072, DM / 2}; pg8::StaticOrder S; S.init(Mm, 3072, F.G, bx);
            pg8::EpiGates E{(bf16*)(ws + WS_GATES)};
            pg8::gemm_phase<pg8::EpiGates, pg8::StaticOrder, GP_ALIGN, GP_SP2, true>(F.lds + RING_OFF, g, S, E, F.tid);
            SEAM(pb + 3);
        }
        if (ON(2 + 4) && IN(pb + 4)) for (int rep_ = 0; rep_ <= REPS(2 + 4); ++rep_) { PH_BEGIN;
            { pg8::Gemm g{(const bf16*)(ws + WS_AO), (const bf16*)(wl + OFFS_WAO), Mm, 1024, 512}; pg8::StaticOrder S; S.init(Mm, 1024, F.G, bx);
              pg8::EpiMerge<true> E{(bf16*)(ws + WS_MERGED), (const bf16*)(ws + WS_GATES), 0, 1.0f / 2048.0f};
              pg8::gemm_phase<pg8::EpiMerge<true>, pg8::StaticOrder, GP_ALIGN, GP_SP2, true>(F.lds + RING_OFF, g, S, E, F.tid); }
#pragma unroll 1
            for (int br = 1; br < 3; ++br) {
              pg8::Gemm g{(const bf16*)(ws + (br == 1 ? WS_CH : WS_Z)), (const bf16*)(wl + (br == 1 ? OFFS_WCO : OFFS_WFO)), Mm, 1024, 512}; pg8::StaticOrder S; S.init(Mm, 1024, F.G, bx);
              pg8::EpiMerge<false> E{(bf16*)(ws + WS_MERGED), (const bf16*)(ws + WS_GATES), br, 1.0f};
              pg8::gemm_phase<pg8::EpiMerge<false>, pg8::StaticOrder, GP_ALIGN, GP_SP2>(F.lds + RING_OFF, g, S, E, F.tid); }
            SEAM(pb + 4);
        }
        if (ON(2 + 5) && IN(pb + 5)) for (int rep_ = 0; rep_ <= REPS(2 + 5); ++rep_) { PH_BEGIN;
            pg8::Gemm g{(const bf16*)(ws + WS_MERGED), (const bf16*)(wl + OFFS_WOUT), Mm, 1024, 1024}; pg8::StaticOrder S; S.init(Mm, 1024, F.G, bx);
            pg8::EpiBf16<0> E{(bf16*)(ws + WS_MIX), 1024, nullptr, 0, 0, 1.0f};
            pg8::gemm_phase<pg8::EpiBf16<0>, pg8::StaticOrder, GP_ALIGN, GP_SP2>(F.lds + RING_OFF, g, S, E, F.tid);
            SEAM(pb + 5);
        }
        if (ON(2 + 6) && IN(pb + 6)) for (int rep_ = 0; rep_ <= REPS(2 + 6); ++rep_) { PH_BEGIN; p_rowpass1(F, A, l, Mm); p_route(F, A, l, Mm); SEAM(pb + 6); }
        if (ON(2 + 7) && IN(pb + 7)) for (int rep_ = 0; rep_ <= REPS(2 + 7); ++rep_) { PH_BEGIN; p_slots(F, A, Mm); SEAM(pb + 7); }
        if (ON(2 + 8) && IN(pb + 8)) for (int rep_ = 0; rep_ <= REPS(2 + 8); ++rep_) { PH_BEGIN;
            const int NT = __builtin_amdgcn_readfirstlane(((const int*)(ws + WS_CNT))[CNT_NT]);
            pg8::Gemm g{(const bf16*)(ws + WS_HS), (const bf16*)(ws + WS_WGU + (size_t)l * MOEW_LAYER), NT * 256, NEXP * 2048, DM / 2}; pg8::GroupedOrder S; S.init(NT, 8, F.G, bx, (const int*)(ws + WS_CNT) + CNT_TILE_E);
            pg8::EpiSwiGLU8 E{ws + WS_ACT, A.in(24) + (size_t)l * NEXP * 1024, A.in(26) + (size_t)l * NEXP * 1024};
            pg8::gemm_phase<pg8::EpiSwiGLU8, pg8::GroupedOrder, GP_ALIGN, GP_SP2, true>(F.lds + RING_OFF, g, S, E, F.tid);
            SEAM(pb + 8);
        }
        if (ON(2 + 9) && IN(pb + 9)) for (int rep_ = 0; rep_ <= REPS(2 + 9); ++rep_) { PH_BEGIN;
            const int NT = __builtin_amdgcn_readfirstlane(((const int*)(ws + WS_CNT))[CNT_NT]);
#ifdef STAGGER_US
            { const unsigned long long t0 = __builtin_amdgcn_s_memrealtime(), dl = (unsigned long long)((bx >> 3) & 3) * (STAGGER_US); while (__builtin_amdgcn_s_memrealtime() - t0 < dl) __builtin_amdgcn_s_sleep(8); }
#endif
            pg8::Gemm g{(const bf16*)(ws + WS_ACT), (const bf16*)(ws + WS_WD + (size_t)l * MOEW_LAYER), NT * 256, NEXP * 1024, DM / 2}; pg8::GroupedOrder S; S.init(NT, 4, F.G, bx, (const int*)(ws + WS_CNT) + CNT_TILE_E);
#ifdef PROBE_NOSTORE
            pg8::EpiDown8 E{ws + WS_YS, A.in(28) + (size_t)l * NEXP * 1024, rep_};
#else
            pg8::EpiDown8 E{ws + WS_YS, A.in(28) + (size_t)l * NEXP * 1024, 0};
#endif
            pg8::gemm_phase<pg8::EpiDown8, pg8::GroupedOrder, GP_ALIGN, GP_SP2, true>(F.lds + RING_OFF, g, S, E, F.tid);
            SEAM(pb + 9);
        }
        if (ON(2 + 10) && IN(pb + 10)) for (int rep_ = 0; rep_ <= REPS(2 + 10); ++rep_) { PH_BEGIN;
            p_combine(F, A, l, Mm);
            SEAM(pb + 10);
        }
    }
#ifdef STAMP_SEL
    { const AV A = av_get(); float* out = A.out(); const unsigned long long* ts = (const unsigned long long*)(F.ctl + 32768);
      auto span = [&](int p) -> float { unsigned long long d = __hip_atomic_load(ts + p + 1, __ATOMIC_RELAXED, __HIP_MEMORY_SCOPE_AGENT) - __hip_atomic_load(ts + p, __ATOMIC_RELAXED, __HIP_MEMORY_SCOPE_AGENT);
          if (p >= 2) d += __hip_atomic_load(ts + p + NPL + 1, __ATOMIC_RELAXED, __HIP_MEMORY_SCOPE_AGENT) - __hip_atomic_load(ts + p + NPL, __ATOMIC_RELAXED, __HIP_MEMORY_SCOPE_AGENT); return (float)d * 0.01f; };
      const float K1 = span((STAMP_SEL) & 0xff), K2 = 200.0f * span(((STAMP_SEL) >> 8) & 0xff);
      for (size_t i = (size_t)blockIdx.x * NTHR + threadIdx.x; i < (size_t)TL * DM; i += (size_t)gridDim.x * NTHR) out[i] = (i == 0) ? K2 : K1; }
#endif
#undef IN
#undef PH_BEGIN
#undef F_REFRESH
#undef SEAM
}

extern "C" void kernel_launch(void* const* d_in, const int* in_sizes, int n_in, void* d_out, int out_size, void* d_ws, size_t ws_size, hipStream_t stream) {
    static int grid = 0;
    if (grid == 0) {
        if (n_in != 29 || out_size != TL * DM || ws_size < WS_END2) { fprintf(stderr, "kernel_launch: built for 29 inputs, %d outputs, >= %zu bytes of workspace; got n_in %d out %d ws %zu\n", TL * DM, (size_t)WS_END2, n_in, out_size, ws_size); grid = -1; return; }
        int dev = 0, cus = 0, per_cu = 0;
        if (hipGetDevice(&dev) != hipSuccess || hipDeviceGetAttribute(&cus, hipDeviceAttributeMultiprocessorCount, dev) != hipSuccess) { grid = -1; return; }
        if (hipFuncSetAttribute((const void*)fwd, hipFuncAttributeMaxDynamicSharedMemorySize, LDS_BYTES) != hipSuccess) { fprintf(stderr, "kernel_launch: hipFuncSetAttribute failed\n"); grid = -1; return; }
        if (hipOccupancyMaxActiveBlocksPerMultiprocessor(&per_cu, (const void*)fwd, NTHR, LDS_BYTES) != hipSuccess || per_cu < 1) fprintf(stderr, "kernel_launch: occupancy query reports %d\n", per_cu);
        (void)hipGetLastError();
        grid = cus;
    }
    if (grid < 0) return;
    (void)hipMemsetAsync((char*)d_ws + WS_CTL, 0, CTL_ZERO_BYTES, stream);
    Args a{};
    for (int i = 0; i < 29; ++i) a.in[i] = (const float*)d_in[i];
    a.out = (float*)d_out; a.ws = (unsigned char*)d_ws;
#if MK_PER_PHASE
    for (int p = 0; p < NPH; ++p) {
#ifdef DBG_CHECK
        float* res = (float*)((char*)d_ws + WS_CTL + 8192 * 4); float* snap = (float*)((char*)d_ws + WS_END);
        { const int l = p >= 2 ? (p - 2) / NPL : 0, k = p >= 2 ? (p - 2) % NPL : -1;
          if (k == 6) hipLaunchKernelGGL(snap_rows, dim3(256), dim3(256), 0, stream, a, l, 11, snap);
          if (k == 12) hipLaunchKernelGGL(snap_rows, dim3(256), dim3(256), 0, stream, a, l, 17, snap); }
#endif
        a.ph_lo = p; a.ph_hi = p + 1; hipLaunchKernelGGL(fwd, dim3(grid), dim3(NTHR), LDS_BYTES, stream, a);
#ifdef DBG_CHECK
        { const int l = p >= 2 ? (p - 2) / NPL : 0, k = p >= 2 ? (p - 2) % NPL : -1;
#define CHK(st) hipLaunchKernelGGL(chk, dim3(1), dim3(256), 0, stream, a, (int)(st), l, res, snap)
          if (p == 0) CHK(ST_MOD); if (p == 1) CHK(ST_H0);
#if DBG_GSUB == 2
          if (k == 3 && l == 0) hipLaunchKernelGGL(chk_gates_full, dim3(48, TALL / 4), dim3(256), 0, stream, (const bf16*)((char*)d_ws + WS_H), (const bf16*)((char*)d_ws + WS_WSMALL + OFFS_WG), (const bf16*)((char*)d_ws + WS_GATES), TALL, (unsigned*)((char*)d_ws + WS_CTL + 65536));
#endif
          if (k == 0) { CHK(ST_INPROJ); CHK(ST_YT); } if (k == 1) { CHK(ST_QKFIX); CHK(ST_CONV); CHK(ST_Z); } if (k == 2) CHK(ST_ATTN); if (k == 3) { CHK(ST_GATES); CHK(ST_GATESB); } if (k == 4) CHK(ST_MERGED);
          if (k == 5) CHK(ST_MIX); if (k == 6) CHK(ST_ROW1); if (k == 7) CHK(ST_LOGIT); if (k == 8) CHK(ST_TOPK); if (k == 9) CHK(ST_SLOTS); if (k == 10) CHK(ST_ACT); if (k == 11) CHK(ST_YSLOT); if (k == 12) CHK(ST_COMB);
#undef CHK
        }
#endif
    }
#ifdef DBG_CHECK
#if DBG_GSUB == 2
    hipLaunchKernelGGL(encode_full, dim3(1024), dim3(256), 0, stream, (float*)d_out, (const unsigned*)((char*)d_ws + WS_CTL + 65536), out_size);
#else
    hipLaunchKernelGGL(encode, dim3(1024), dim3(256), 0, stream, (float*)d_out, (const float*)((char*)d_ws + WS_CTL + 8192 * 4), out_size, 0.25f);
#endif
#endif
#else
    a.ph_lo = 0; a.ph_hi = NPH; hipLaunchKernelGGL(fwd, dim3(grid), dim3(NTHR), LDS_BYTES, stream, a);
#endif
    const hipError_t le = hipPeekAtLastError();
    if (le != hipSuccess) fprintf(stderr, "kernel_launch: launch failed: %s\n", hipGetErrorName(le));
}
```

```cpp
#include <hip/hip_runtime.h>
#include <cstdio>
#include <cstdint>
#ifndef MK_PER_PHASE
#define MK_PER_PHASE 0
#endif
namespace pg8 {
#define PG8_LAS __attribute__((address_space(3)))
typedef unsigned short bf16_t;
typedef short bf16x8 __attribute__((ext_vector_type(8)));
typedef float f32x4 __attribute__((ext_vector_type(4)));
typedef unsigned u32x4 __attribute__((ext_vector_type(4)));
typedef int i32x4v __attribute__((ext_vector_type(4)));
typedef int i32x8v __attribute__((ext_vector_type(8)));
typedef unsigned u32x2v __attribute__((ext_vector_type(2)));
constexpr int BM = 256, BK = 64, HALF = 128, HTB = HALF * BK * 2  , STAGE_BYTES = 8 * HTB, NXCD = 8, WGM = 8;

__host__ __device__ __forceinline__ int lds_byte(int r, int c) { const int st = (r >> 4) * 2 + (c >> 5), rr = r & 15, cc = c & 31, ob = rr * 64 + cc * 2; return st * 1024 + (ob ^ (((ob >> 9) & 1) << 5)); }
__host__ __device__ __forceinline__ void stage_rc(int b, int& R, int& C) { const int st = b / 1024, sb = b % 1024, swz = sb ^ (((sb >> 9) & 1) << 5); R = (st >> 1) * 16 + swz / 64; C = (st & 1) * 32 + (swz % 64) / 2; }
__host__ __device__ __forceinline__ int perm32(int rho) { const int n = rho >> 4, i = rho & 15; return 8 * (i >> 2) + 4 * n + (i & 3); }

struct Unit { int pm, pn; };
struct Gemm { const bf16_t* A; const bf16_t* Bt; int M, N, K; };

struct StaticOrder {
    int nM, nN, nwg, G, c;
    __host__ __device__ void init(int M, int N, int G_, int c_) { nM = M / BM; nN = N / BM; nwg = nM * nN; G = G_; c = c_; }
    __host__ __device__ bool next(int i, Unit& u) const {
        const long L = (long)i * G + c; if (L >= nwg) return false;
        int wgid = (int)L; { const int q = nwg / NXCD, r = nwg % NXCD, xcd = wgid % NXCD, off = wgid / NXCD; wgid = (xcd < r ? xcd * (q + 1) : r * (q + 1) + (xcd - r) * q) + off; }
        const int nig = WGM * nN, gid = wgid / nig, fm = gid * WGM, gsz = (nM - fm) < WGM ? (nM - fm) : WGM;
        u.pm = fm + ((wgid % nig) % gsz); u.pn = (wgid % nig) / gsz; return true;
    }
    __device__ __forceinline__ void a_ready(const Unit&) const {}
    __device__ __forceinline__ void done(const Unit&) const {}
};

typedef __bf16 bf16x2_native __attribute__((ext_vector_type(2)));
typedef float f32x2_native __attribute__((ext_vector_type(2)));
__device__ __forceinline__ unsigned cvt_pk_bf16(float lo, float hi) { const f32x2_native v = {lo, hi}; const bf16x2_native r = __builtin_convertvector(v, bf16x2_native); return __builtin_bit_cast(unsigned, r); }
__device__ __forceinline__ unsigned cvt4_fp8(float a, float b, float c, float d) { int w = __builtin_amdgcn_cvt_pk_fp8_f32(a, b, __builtin_bit_cast(int, a), false); w = __builtin_amdgcn_cvt_pk_fp8_f32(c, d, w, true); return (unsigned)w; }
typedef float f32x2 __attribute__((ext_vector_type(2)));
__device__ __forceinline__ f32x2 gelu_pk(f32x2 v) {
    const f32x2 av = __builtin_elementwise_abs(v), d = av * 0.2316418882f + 1.0f;
    f32x2 t; t.x = __builtin_amdgcn_rcpf(d.x); t.y = __builtin_amdgcn_rcpf(d.y);
    f32x2 q = t * 0.5307027145f + (-0.7265760135f); q = q * t + 0.7107068705f; q = q * t + (-0.142248368f); q = q * t + 0.127414796f; q = q * t;
    const f32x2 s = (v * v) * (-0.72134752044f);
    f32x2 e; e.x = __builtin_amdgcn_exp2f(s.x); e.y = __builtin_amdgcn_exp2f(s.y);
    const f32x2 m = v * (q * e), r = v - m;
    f32x2 o; o.x = v.x < 0.f ? m.x : r.x; o.y = v.y < 0.f ? m.y : r.y; return o;
}

template <int ACT  > struct EpiBf16 {
    static constexpr bool PERM = true, AFTER_DRAIN = false; static_assert(ACT == 0 || ACT == 1, "EpiBf16: ACT is 0 (none) or 1 (gelu_pk)");
    bf16_t* O; int ldc; const float* bias; int split_cols; size_t split_stride; float scale0;
    __device__ __forceinline__ void operator()(const f32x4 (&acc)[2][2][4][2], const Unit& u, int wr, int wc, int fr, int fq) const {
        const int row0 = u.pm * BM + wr * 64 + fr; int colt = u.pn * BM; bf16_t* base = O;
        float sc = 1.f; if (split_cols) { const int t = colt / split_cols; base += (size_t)t * split_stride; colt -= t * split_cols; if (t == 0) sc = scale0; }
        const int col0 = colt + wc * 32 + 8 * fq, bcol0 = u.pn * BM + wc * 32 + 8 * fq;
        f32x4 bv[2][2];
#pragma unroll
        for (int bj = 0; bj < 2; ++bj)
#pragma unroll
            for (int n = 0; n < 2; ++n) bv[bj][n] = bias ? *(const f32x4*)(bias + bcol0 + bj * HALF + 4 * n) : (f32x4){0.f, 0.f, 0.f, 0.f};
#pragma unroll
        for (int ai = 0; ai < 2; ++ai)
#pragma unroll
            for (int m = 0; m < 4; ++m) { bf16_t* rowp = base + (size_t)(row0 + ai * HALF + m * 16) * ldc + col0;
#pragma unroll
                for (int bj = 0; bj < 2; ++bj) { f32x4 v0 = acc[ai][bj][m][0] + bv[bj][0], v1 = acc[ai][bj][m][1] + bv[bj][1];
                    if (ACT == 1) { f32x2 a = gelu_pk((f32x2){v0[0], v0[1]}), b = gelu_pk((f32x2){v0[2], v0[3]}), c = gelu_pk((f32x2){v1[0], v1[1]}), d = gelu_pk((f32x2){v1[2], v1[3]});
                        v0 = (f32x4){a.x, a.y, b.x, b.y}; v1 = (f32x4){c.x, c.y, d.x, d.y}; }
                    v0 = v0 * sc; v1 = v1 * sc; u32x4 w; w.x = cvt_pk_bf16(v0[0], v0[1]); w.y = cvt_pk_bf16(v0[2], v0[3]); w.z = cvt_pk_bf16(v1[0], v1[1]); w.w = cvt_pk_bf16(v1[2], v1[3]);
                    *(u32x4*)(rowp + bj * HALF) = w; } }
    }
};

__device__ __forceinline__ float fast_sigmoid(float x) { return __builtin_amdgcn_rcpf(1.0f + __builtin_amdgcn_exp2f(-1.4426950408889634f * x)); }
__device__ __forceinline__ u32x4 pack8(const f32x4& a, const f32x4& b) { u32x4 w; w.x = cvt_pk_bf16(a[0], a[1]); w.y = cvt_pk_bf16(a[2], a[3]); w.z = cvt_pk_bf16(b[0], b[1]); w.w = cvt_pk_bf16(b[2], b[3]); return w; }
__device__ __forceinline__ void unpack8(const u32x4& w, f32x4& a, f32x4& b) {
    a[0] = __uint_as_float(w.x << 16); a[1] = __uint_as_float(w.x & 0xffff0000u); a[2] = __uint_as_float(w.y << 16); a[3] = __uint_as_float(w.y & 0xffff0000u);
    b[0] = __uint_as_float(w.z << 16); b[1] = __uint_as_float(w.z & 0xffff0000u); b[2] = __uint_as_float(w.w << 16); b[3] = __uint_as_float(w.w & 0xffff0000u); }
__device__ __forceinline__ u32x2v pack8_fp8(const f32x4& a, const f32x4& b) { u32x2v r; r.x = cvt4_fp8(a[0], a[1], a[2], a[3]); r.y = cvt4_fp8(b[0], b[1], b[2], b[3]); return r; }
__device__ __forceinline__ void store_tile_bf16(const f32x4 (&acc)[2][2][4][2], bf16_t* base, int ldc, int wr, int wc, int fr, int fq) {
    const int rt = wr * 64 + fr, cb = wc * 32 + 8 * fq;
#pragma unroll
    for (int ai = 0; ai < 2; ++ai)
#pragma unroll
        for (int m = 0; m < 4; ++m) { bf16_t* rowp = base + (size_t)(rt + ai * HALF + m * 16) * ldc + cb;
#pragma unroll
            for (int bj = 0; bj < 2; ++bj) *(u32x4*)(rowp + bj * HALF) = pack8(acc[ai][bj][m][0], acc[ai][bj][m][1]); }
}
struct EpiInproj {
    static constexpr bool PERM = true, AFTER_DRAIN = false;
    bf16_t *q, *k, *v, *cu;
    __device__ __forceinline__ void operator()(const f32x4 (&acc)[2][2][4][2], const Unit& u, int wr, int wc, int fr, int fq) const {
        bf16_t* base; int ldc; const bool glu = u.pn >= 6; float sc = 0.03125f; asm volatile("" : "+s"(sc));
        if (u.pn < 4) { base = q + (size_t)u.pm * 256 * 1024 + u.pn * 256; ldc = 1024; }
        else if (u.pn < 6) { const int m0 = u.pm * 256; const int kr = m0 < 32768 ? (m0 >> 11) * 2304 + (m0 & 2047) : ((m0 - 32768) >> 8) * 2304 + 2048; base = (u.pn == 4 ? k : v) + (size_t)kr * 256; ldc = 256; }
        else { base = cu + (size_t)u.pm * 256 * 512 + (u.pn - 6) * 128; ldc = 512; }
        base += (size_t)(wr * 64 + fr) * ldc + wc * 32 + 8 * fq;
#pragma unroll
        for (int ai = 0; ai < 2; ++ai)
#pragma unroll
            for (int m = 0; m < 4; ++m) { bf16_t* rowp = base + (size_t)(ai * HALF + m * 16) * ldc;
                if (!glu) { *(u32x4*)rowp = pack8(acc[ai][0][m][0] * sc, acc[ai][0][m][1] * sc); *(u32x4*)(rowp + HALF) = pack8(acc[ai][1][m][0] * sc, acc[ai][1][m][1] * sc); }
                else { f32x4 a0 = acc[ai][0][m][0] * sc, a1 = acc[ai][0][m][1] * sc; const f32x4 g0 = acc[ai][1][m][0] * sc, g1 = acc[ai][1][m][1] * sc;
#pragma unroll
                    for (int j = 0; j < 4; ++j) { a0[j] *= fast_sigmoid(g0[j]); a1[j] *= fast_sigmoid(g1[j]); }
                    *(u32x4*)rowp = pack8(a0, a1); } }
    }
};
struct EpiYT {
    static constexpr bool PERM = true, AFTER_DRAIN = false;
    unsigned char *yt, *ytc;
    __device__ __forceinline__ void operator()(const f32x4 (&acc)[2][2][4][2], const Unit& u, int wr, int wc, int fr, int fq) const {
        const int cs = u.pm >> 1, chb = (u.pm & 1) * 256; unsigned char* base; int ldc;
        if (u.pn < 128) { const int b = u.pn >> 3, pos0 = (u.pn & 7) * 256; base = yt + (size_t)(b * 512 + chb) * 4096 + cs * 2048 + pos0; ldc = 4096; }
        else { const int b = u.pn - 128; base = ytc + (size_t)(b * 512 + chb) * 512 + cs * 256; ldc = 512; }
        base += (size_t)(wr * 64 + fr) * ldc + wc * 32 + 8 * fq;
#pragma unroll
        for (int ai = 0; ai < 2; ++ai)
#pragma unroll
            for (int m = 0; m < 4; ++m) { unsigned char* rowp = base + (size_t)(ai * HALF + m * 16) * ldc;
#pragma unroll
                for (int bj = 0; bj < 2; ++bj) *(u32x2v*)(rowp + bj * HALF) = pack8_fp8(acc[ai][bj][m][0], acc[ai][bj][m][1]); }
    }
};
struct EpiDFT {
    static constexpr bool PERM = true, AFTER_DRAIN = false;
    bf16_t* z; int rowbase, rpb;
    __device__ __forceinline__ void operator()(const f32x4 (&acc)[2][2][4][2], const Unit& u, int wr, int wc, int fr, int fq) const {
        bf16_t* base = z + (size_t)(rowbase + (u.pn >> 1) * rpb + u.pm * 256 + wr * 64 + fr) * 512 + (u.pn & 1) * 256 + wc * 32 + 8 * fq;
#pragma unroll
        for (int ai = 0; ai < 2; ++ai)
#pragma unroll
            for (int m = 0; m < 4; ++m)
#pragma unroll
                for (int bj = 0; bj < 2; ++bj) *(u32x4*)(base + (size_t)(ai * HALF + m * 16) * 512 + bj * HALF) = pack8(acc[ai][bj][m][0] * 0.03125f, acc[ai][bj][m][1] * 0.03125f);
    }
};
struct EpiGates {
    static constexpr bool PERM = true, AFTER_DRAIN = false;
    bf16_t* g;
    __device__ __forceinline__ void operator()(const f32x4 (&acc)[2][2][4][2], const Unit& u, int wr, int wc, int fr, int fq) const {
        const int rt = wr * 64 + fr, cb = wc * 32 + 8 * fq; bf16_t* base = g + (size_t)u.pm * 256 * 3072 + u.pn * 256 + cb;
        float cs = -1.4426950408889634f * 0.03125f; asm volatile("" : "+s"(cs));
#pragma unroll
        for (int ai = 0; ai < 2; ++ai)
#pragma unroll
            for (int m = 0; m < 4; ++m)
#pragma unroll
                for (int bj = 0; bj < 2; ++bj) { f32x4 a0 = acc[ai][bj][m][0], a1 = acc[ai][bj][m][1];
#pragma unroll
                    for (int j = 0; j < 4; ++j) { a0[j] = __builtin_amdgcn_rcpf(1.0f + __builtin_amdgcn_exp2f(a0[j] * cs)); a1[j] = __builtin_amdgcn_rcpf(1.0f + __builtin_amdgcn_exp2f(a1[j] * cs)); }
                    __builtin_nontemporal_store(pack8(a0, a1), (u32x4*)(base + (size_t)(rt + ai * HALF + m * 16) * 3072 + bj * HALF)); }
    }
};
template <bool FIRST> struct EpiMerge {
    static constexpr bool PERM = true, AFTER_DRAIN = false;
    bf16_t* mg; const bf16_t* g; int br; float scale;
    __device__ __forceinline__ void operator()(const f32x4 (&acc)[2][2][4][2], const Unit& u, int wr, int wc, int fr, int fq) const {
        const int rt = u.pm * 256 + wr * 64 + fr, cb = u.pn * 256 + wc * 32 + 8 * fq; float sc = scale; asm volatile("" : "+s"(sc));
#pragma unroll
        for (int ai = 0; ai < 2; ++ai)
#pragma unroll
            for (int m = 0; m < 4; ++m)
#pragma unroll
                for (int bj = 0; bj < 2; ++bj) { const size_t row = (size_t)(rt + ai * HALF + m * 16); const int col = cb + bj * HALF;
                    const u32x4 gw = *(const u32x4*)(g + row * 3072 + br * 1024 + col); f32x4 g0, g1; unpack8(gw, g0, g1);
                    f32x4 v0 = acc[ai][bj][m][0] * sc * g0, v1 = acc[ai][bj][m][1] * sc * g1;
                    if (!FIRST) { const u32x4 ow = *(const u32x4*)(mg + row * 1024 + col); f32x4 o0, o1; unpack8(ow, o0, o1); v0 += o0; v1 += o1; }
                    *(u32x4*)(mg + row * 1024 + col) = pack8(v0, v1); }
    }
};
struct EpiRouter {
    static constexpr bool PERM = true, AFTER_DRAIN = false;
    float* lg;
    __device__ __forceinline__ void operator()(const f32x4 (&acc)[2][2][4][2], const Unit& u, int wr, int wc, int fr, int fq) const {
        if (wc < 2) { const int rt = u.pm * 256 + wr * 64 + fr, cb = wc * 32 + 8 * fq;
#pragma unroll
            for (int ai = 0; ai < 2; ++ai)
#pragma unroll
                for (int m = 0; m < 4; ++m) { float* p = lg + (size_t)(rt + ai * HALF + m * 16) * 64 + cb; *(f32x4*)p = acc[ai][0][m][0]; *(f32x4*)(p + 4) = acc[ai][0][m][1]; } }
    }
};
struct EpiSwiGLU {
    static constexpr bool PERM = true, AFTER_DRAIN = false;
    bf16_t* act; const float* bg; const float* bu;
    __device__ __forceinline__ void operator()(const f32x4 (&acc)[2][2][4][2], const Unit& u, int wr, int wc, int fr, int fq) const {
        const int e = u.pn >> 3, col = (u.pn & 7) * 128 + wc * 32 + 8 * fq, rt = u.pm * 256 + wr * 64 + fr;
        const f32x4 bg0 = *(const f32x4*)(bg + e * 1024 + col), bg1 = *(const f32x4*)(bg + e * 1024 + col + 4), bu0 = *(const f32x4*)(bu + e * 1024 + col), bu1 = *(const f32x4*)(bu + e * 1024 + col + 4);
#pragma unroll
        for (int ai = 0; ai < 2; ++ai)
#pragma unroll
            for (int m = 0; m < 4; ++m) { f32x4 g0 = acc[ai][0][m][0] + bg0, g1 = acc[ai][0][m][1] + bg1, u0 = acc[ai][1][m][0] + bu0, u1 = acc[ai][1][m][1] + bu1;
#pragma unroll
                for (int j = 0; j < 4; ++j) { const float ga = fminf(g0[j], 7.0f), gb = fminf(g1[j], 7.0f); const float ua = fminf(fmaxf(u0[j], -7.0f), 7.0f), ub = fminf(fmaxf(u1[j], -7.0f), 7.0f);
                    g0[j] = (ua + 1.0f) * (ga * fast_sigmoid(1.702f * ga)); g1[j] = (ub + 1.0f) * (gb * fast_sigmoid(1.702f * gb)); }
                *(u32x4*)(act + (size_t)(rt + ai * HALF + m * 16) * 1024 + col) = pack8(g0, g1); }
    }
};
struct EpiSwiGLU8 {
    static constexpr bool PERM = true, AFTER_DRAIN = false;
    unsigned char* act; const float* bg; const float* bu;
    __device__ __forceinline__ void operator()(const f32x4 (&acc)[2][2][4][2], const Unit& u, int wr, int wc, int fr, int fq) const {
        const int e = u.pn >> 3, col = (u.pn & 7) * 128 + wc * 32 + 8 * fq, rt = u.pm * 256 + wr * 64 + fr;
        const f32x4 bg0 = *(const f32x4*)(bg + e * 1024 + col), bg1 = *(const f32x4*)(bg + e * 1024 + col + 4), bu0 = *(const f32x4*)(bu + e * 1024 + col), bu1 = *(const f32x4*)(bu + e * 1024 + col + 4);
#pragma unroll
        for (int ai = 0; ai < 2; ++ai)
#pragma unroll
            for (int m = 0; m < 4; ++m) { f32x4 g0 = acc[ai][0][m][0] * 0.03125f + bg0, g1 = acc[ai][0][m][1] * 0.03125f + bg1, u0 = acc[ai][1][m][0] * 0.03125f + bu0, u1 = acc[ai][1][m][1] * 0.03125f + bu1;
#pragma unroll
                for (int j = 0; j < 4; ++j) { const float ga = fminf(g0[j], 7.0f), gb = fminf(g1[j], 7.0f); const float ua = fminf(fmaxf(u0[j], -7.0f), 7.0f), ub = fminf(fmaxf(u1[j], -7.0f), 7.0f);
                    g0[j] = (ua + 1.0f) * (ga * fast_sigmoid(1.702f * ga)); g1[j] = (ub + 1.0f) * (gb * fast_sigmoid(1.702f * gb)); }
                __builtin_nontemporal_store(pack8_fp8(g0, g1), (u32x2v*)(act + (size_t)(rt + ai * HALF + m * 16) * 1024 + col)); }
    }
};
struct EpiDown8 {
    static constexpr bool PERM = true, AFTER_DRAIN = false;
    unsigned char* ys; const float* bd; int nostore;
    __device__ __forceinline__ void operator()(const f32x4 (&acc)[2][2][4][2], const Unit& u, int wr, int wc, int fr, int fq) const {
        const int e = u.pn >> 2, col0 = (u.pn & 3) * 256 + wc * 32 + 8 * fq, rt = u.pm * 256 + wr * 64 + fr;
        f32x4 bv[2][2];
#pragma unroll
        for (int bj = 0; bj < 2; ++bj) { bv[bj][0] = *(const f32x4*)(bd + e * 1024 + col0 + bj * HALF) * 8.0f; bv[bj][1] = *(const f32x4*)(bd + e * 1024 + col0 + bj * HALF + 4) * 8.0f; }
#pragma unroll
        for (int ai = 0; ai < 2; ++ai)
#pragma unroll
            for (int m = 0; m < 4; ++m) { unsigned char* rowp = ys + (size_t)(rt + ai * HALF + m * 16) * 1024 + col0;
#pragma unroll
                for (int bj = 0; bj < 2; ++bj) { const u32x2v w = pack8_fp8(acc[ai][bj][m][0] * 0.25f + bv[bj][0], acc[ai][bj][m][1] * 0.25f + bv[bj][1]); if (!nostore) __builtin_nontemporal_store(w, (u32x2v*)(rowp + bj * HALF)); else asm volatile("" :: "v"(w)); } }
    }
};
struct GroupedOrder {
    int nM, nN, nwg, G, c; const PG8_LAS int* tile_e;
    __device__ void init(int nM_, int nN_, int G_, int c_, const PG8_LAS int* te) { nM = nM_; nN = nN_; nwg = nM * nN; G = G_; c = c_; tile_e = te; }
    __device__ bool next(int i, Unit& u) const {
        const long L = (long)i * G + c; if (L >= nwg) return false;
        int wgid = (int)L; { const int q = nwg / NXCD, r = nwg % NXCD, xcd = wgid % NXCD, off = wgid / NXCD; wgid = (xcd < r ? xcd * (q + 1) : r * (q + 1) + (xcd - r) * q) + off; }
        const int nig = WGM * nN, gid = wgid / nig, fm = gid * WGM, gsz = (nM - fm) < WGM ? (nM - fm) : WGM;
        u.pm = fm + ((wgid % nig) % gsz); const int pl = (wgid % nig) / gsz; u.pn = __builtin_amdgcn_readfirstlane(tile_e[u.pm]) * nN + pl; return true;
    }
    __device__ __forceinline__ void a_ready(const Unit&) const {}
    __device__ __forceinline__ void done(const Unit&) const {}
};
struct DftOrder {
    int lg, n, G, c;
    __device__ void init(int lg_, int nb, int G_, int c_) { lg = lg_; n = (nb * 2) << lg_; G = G_; c = c_; }
    __device__ bool next(int i, Unit& u) const { const int L = i * G + c; if (L >= n) return false; const int b = L >> (lg + 1), rem = L & ((2 << lg) - 1); u.pm = rem & ((1 << lg) - 1); u.pn = 2 * b + (rem >> lg); return true; }
    __device__ __forceinline__ void a_ready(const Unit&) const {}
    __device__ __forceinline__ void done(const Unit&) const {}
};

template <class Epi, class Sched, bool ALIGN_EPI = false, bool SP2 = false, bool FP8 = false>
__device__ __forceinline__ void gemm_phase(PG8_LAS unsigned char* lds, const Gemm g, const Sched& S, const Epi& E, const int tid_in) {
    int tid_ = tid_in; asm volatile("" : "+v"(tid_));
    const int tid = tid_, wid = __builtin_amdgcn_readfirstlane(tid >> 6), lane = tid & 63, wr = wid >> 2, wc = wid & 3, fr = lane & 15, fq = lane >> 4;
    const int K = g.K, nt = K / BK;
    unsigned voffA[2], voffB[2];
#pragma unroll
    for (int i = 0; i < 2; ++i) { int R, C; stage_rc(tid * 16 + i * 8192, R, C); const int Rb = Epi::PERM ? ((R & ~31) + perm32(R & 31)) : R;
        voffA[i] = (unsigned)(R * K + C) * 2u; voffB[i] = (unsigned)(Rb * K + C) * 2u; }
    const size_t kstep = (size_t)(BK * 2);
    const size_t hstep = (size_t)HALF * K * 2;
    const size_t tstep = 2 * hstep;
    const unsigned ldsw = (unsigned)wid * 1024u;
    const int aoff = lds_byte(wr * 64 + fr, fq * 8), boff = lds_byte(wc * 32 + fr, fq * 8);
#define PG8_SA(b, h) (((b) * 2 + (h)) * HTB)
#define PG8_SB(b, h) ((4 + (b) * 2 + (h)) * HTB)
#define PG8_STAGE(bufoff, gbase, voff) do { _Pragma("unroll") for (int _i = 0; _i < 2; ++_i) \
        __builtin_amdgcn_global_load_lds((const unsigned*)((const char*)(gbase) + (voff)[_i]), (PG8_LAS unsigned*)(lds + (bufoff) + ldsw + _i * 8192), 16, 0, 0); } while (0)
#define PG8_RD8(off) __builtin_shufflevector(*(const PG8_LAS i32x4v*)(lds + (off)), *(const PG8_LAS i32x4v*)(lds + (off) + 1024), 0, 1, 2, 3, 4, 5, 6, 7)
#define PG8_LDA(dst, b, h) do { _Pragma("unroll") for (int m = 0; m < 4; ++m) { if constexpr (FP8) dst##8[m] = PG8_RD8(PG8_SA(b, h) + aoff + m * 2048); else { _Pragma("unroll") for (int k = 0; k < 2; ++k) dst[m][k] = *(const PG8_LAS bf16x8*)(lds + PG8_SA(b, h) + aoff + m * 2048 + k * 1024); } } } while (0)
#define PG8_LDB(dst, b, h) do { _Pragma("unroll") for (int n = 0; n < 2; ++n) { if constexpr (FP8) dst##8[n] = PG8_RD8(PG8_SB(b, h) + boff + n * 2048); else { _Pragma("unroll") for (int k = 0; k < 2; ++k) dst[n][k] = *(const PG8_LAS bf16x8*)(lds + PG8_SB(b, h) + boff + n * 2048 + k * 1024); } } } while (0)
#define PG8_MMA(ai, bj, At, Bt) do { if constexpr (FP8) __builtin_amdgcn_sched_barrier(0); __builtin_amdgcn_s_setprio(1); _Pragma("unroll") for (int m = 0; m < 4; ++m) _Pragma("unroll") for (int n = 0; n < 2; ++n) { \
        if constexpr (FP8) asm volatile("v_mfma_scale_f32_16x16x128_f8f6f4 %0, %1, %2, %0, %3, %3 op_sel_hi:[0,0,0]" : "+v"(acc[ai][bj][m][n]) : "v"(Bt##8[n]), "v"(At##8[m]), "v"(sc8)); \
        else { _Pragma("unroll") for (int k = 0; k < 2; ++k) acc[ai][bj][m][n] = __builtin_amdgcn_mfma_f32_16x16x32_bf16(Bt[n][k], At[m][k], acc[ai][bj][m][n], 0, 0, 0); } } __builtin_amdgcn_s_setprio(0); if constexpr (FP8) __builtin_amdgcn_sched_barrier(0); } while (0)
#define PG8_WAIT_V(n) asm volatile("s_waitcnt vmcnt(" #n ")" ::: "memory")
#define PG8_WAIT_L(n) asm volatile("s_waitcnt lgkmcnt(" #n ")" ::: "memory")
#define PG8_BAR __builtin_amdgcn_s_barrier()
#define PG8_SCHED __builtin_amdgcn_sched_barrier(0)
    Unit cur, nxt; int ui = 0;
    if (!S.next(0, cur)) return;
    f32x4 acc[2][2][4][2];
#pragma unroll
    for (int a = 0; a < 2; ++a)
#pragma unroll
        for (int b = 0; b < 2; ++b)
#pragma unroll
            for (int m = 0; m < 4; ++m)
#pragma unroll
                for (int n = 0; n < 2; ++n) acc[a][b][m][n] = (f32x4){0.f, 0.f, 0.f, 0.f};
    int sc8 = 0x7f7f7f7f; asm volatile("" : "+v"(sc8));
    bf16x8 At[4][2], B0[2][2], B1[2][2]; i32x8v At8[4], B08[2], B18[2];
    const char* cA = (const char*)g.A + (size_t)cur.pm * tstep; const char* cB = (const char*)g.Bt + (size_t)cur.pn * tstep;
    S.a_ready(cur);
    if constexpr (SP2) {
        PG8_STAGE(PG8_SB(0, 0), cB, voffB); PG8_STAGE(PG8_SB(0, 1), cB + hstep, voffB); PG8_STAGE(PG8_SA(0, 0), cA, voffA); PG8_STAGE(PG8_SA(0, 1), cA + hstep, voffA);
        if (wr == 1) PG8_BAR;
        PG8_WAIT_V(2); PG8_BAR;
        PG8_STAGE(PG8_SB(1, 0), cB + kstep, voffB); PG8_STAGE(PG8_SA(1, 0), cA + kstep, voffA); PG8_STAGE(PG8_SB(1, 1), cB + hstep + kstep, voffB);
        PG8_WAIT_V(6); PG8_BAR;
    } else {
        PG8_STAGE(PG8_SB(0, 0), cB, voffB); PG8_STAGE(PG8_SA(0, 0), cA, voffA); PG8_STAGE(PG8_SB(0, 1), cB + hstep, voffB); PG8_STAGE(PG8_SA(0, 1), cA + hstep, voffA);
        if (wr == 1) PG8_BAR;
        PG8_WAIT_V(4); PG8_BAR;
        PG8_STAGE(PG8_SB(1, 0), cB + kstep, voffB); PG8_STAGE(PG8_SA(1, 0), cA + kstep, voffA); PG8_STAGE(PG8_SB(1, 1), cB + hstep + kstep, voffB);
        PG8_WAIT_V(6); PG8_BAR;
    }
    for (;;) {
        const bool has_next = S.next(ui + 1, nxt);
        const char* nA = has_next ? (const char*)g.A + (size_t)nxt.pm * tstep : cA; const char* nB = has_next ? (const char*)g.Bt + (size_t)nxt.pn * tstep : cB;
        for (int t = 0; t < nt; t += 2) {
            const bool last = (t == nt - 2);
            const char* a1 = cA + (size_t)(t + 1) * kstep;
            const char* a2 = last ? nA : cA + (size_t)(t + 2) * kstep; const char* b2 = last ? nB : cB + (size_t)(t + 2) * kstep;
            const char* a3 = a2 + kstep; const char* b3 = b2 + kstep;
            if (last && has_next) S.a_ready(nxt);
            if constexpr (SP2) {
            PG8_LDB(B0, 0, 0); PG8_LDB(B1, 0, 1); PG8_SCHED; PG8_LDA(At, 0, 0); PG8_STAGE(PG8_SA(1, 1), a1 + hstep, voffA);
            PG8_WAIT_V(8); PG8_WAIT_L(0); PG8_BAR; PG8_MMA(0, 0, At, B0); PG8_MMA(0, 1, At, B1); PG8_BAR; PG8_SCHED;
            PG8_LDA(At, 0, 1); PG8_STAGE(PG8_SB(0, 0), b2, voffB); PG8_STAGE(PG8_SB(0, 1), b2 + hstep, voffB); PG8_STAGE(PG8_SA(0, 0), a2, voffA);
            PG8_WAIT_V(8); PG8_WAIT_L(0); PG8_BAR; PG8_MMA(1, 0, At, B0); PG8_MMA(1, 1, At, B1); PG8_BAR; PG8_SCHED;
            PG8_LDB(B0, 1, 0); PG8_LDB(B1, 1, 1); PG8_SCHED; PG8_LDA(At, 1, 0); PG8_STAGE(PG8_SA(0, 1), a2 + hstep, voffA);
            PG8_WAIT_V(8); PG8_WAIT_L(0); PG8_BAR; PG8_MMA(0, 0, At, B0); PG8_MMA(0, 1, At, B1); PG8_BAR; PG8_SCHED;
            PG8_LDA(At, 1, 1); PG8_STAGE(PG8_SB(1, 0), b3, voffB); PG8_STAGE(PG8_SB(1, 1), b3 + hstep, voffB); PG8_STAGE(PG8_SA(1, 0), a3, voffA);
            PG8_WAIT_V(8); PG8_WAIT_L(0); PG8_BAR; PG8_MMA(1, 0, At, B0); PG8_MMA(1, 1, At, B1); PG8_BAR; PG8_SCHED;
            } else {
            PG8_LDB(B0, 0, 0); PG8_SCHED; PG8_LDA(At, 0, 0); PG8_STAGE(PG8_SA(1, 1), a1 + hstep, voffA);
            PG8_WAIT_L(8); PG8_BAR; PG8_WAIT_L(0); PG8_MMA(0, 0, At, B0); PG8_BAR; PG8_SCHED;
            PG8_LDB(B1, 0, 1); PG8_STAGE(PG8_SB(0, 0), b2, voffB);
            PG8_BAR; PG8_WAIT_L(0); PG8_MMA(0, 1, At, B1); PG8_BAR;
            PG8_LDA(At, 0, 1); PG8_STAGE(PG8_SA(0, 0), a2, voffA);
            PG8_BAR; PG8_WAIT_L(0); PG8_MMA(1, 0, At, B0); PG8_BAR; PG8_SCHED;
            PG8_STAGE(PG8_SB(0, 1), b2 + hstep, voffB);
            PG8_WAIT_V(6); PG8_BAR; PG8_MMA(1, 1, At, B1); PG8_BAR;
            PG8_LDB(B0, 1, 0); PG8_SCHED; PG8_LDA(At, 1, 0); PG8_STAGE(PG8_SA(0, 1), a2 + hstep, voffA);
            PG8_WAIT_L(8); PG8_BAR; PG8_WAIT_L(0); PG8_MMA(0, 0, At, B0); PG8_BAR; PG8_SCHED;
            PG8_LDB(B1, 1, 1); PG8_STAGE(PG8_SB(1, 0), b3, voffB);
            PG8_BAR; PG8_WAIT_L(0); PG8_MMA(0, 1, At, B1); PG8_BAR;
            PG8_LDA(At, 1, 1); PG8_STAGE(PG8_SA(1, 0), a3, voffA);
            PG8_BAR; PG8_WAIT_L(0); PG8_MMA(1, 0, At, B0); PG8_BAR; PG8_SCHED;
            PG8_STAGE(PG8_SB(1, 1), b3 + hstep, voffB);
            PG8_WAIT_V(6); PG8_BAR; PG8_MMA(1, 1, At, B1); PG8_BAR;
            }
        }
        if constexpr (FP8) asm volatile("s_nop 15\n\ts_nop 15" ::: "memory");
        if constexpr (ALIGN_EPI) { if (wr == 0) PG8_BAR; }
        if constexpr (!Epi::AFTER_DRAIN) { E(acc, cur, wr, wc, fr, fq); S.done(cur); }
        if (!has_next) break;
#pragma unroll
        for (int a = 0; a < 2; ++a)
#pragma unroll
            for (int b = 0; b < 2; ++b)
#pragma unroll
                for (int m = 0; m < 4; ++m)
#pragma unroll
                    for (int n = 0; n < 2; ++n) acc[a][b][m][n] = (f32x4){0.f, 0.f, 0.f, 0.f};
        cur = nxt; cA = nA; cB = nB; ++ui;
        if constexpr (ALIGN_EPI) { if (wr == 1) PG8_BAR; }
    }
    PG8_WAIT_V(0);
    if constexpr (!ALIGN_EPI) { if (wr == 0) PG8_BAR; }
    PG8_BAR;
    if constexpr (Epi::AFTER_DRAIN) { E.fused(acc, cur, wr, wc, fr, fq, lds, wid, lane); S.done(cur); }
#undef PG8_SA
#undef PG8_SB
#undef PG8_STAGE
#undef PG8_LDA
#undef PG8_LDB
#undef PG8_MMA
#undef PG8_RD8
#undef PG8_WAIT_V
#undef PG8_WAIT_L
#undef PG8_BAR
#undef PG8_SCHED
}
}
namespace att {
typedef unsigned short bf16;
constexpr int   D = 128, NW = 8, QBLK = 32, KVBLK = 64;
constexpr float SCALE = 0.088388347648318440f;
constexpr float THR = 8.f;
constexpr int SDEPTH = 2;
constexpr int LDQ = 1024, LDK = 256, LDO = 1024;
constexpr size_t SHM_V = KVBLK * D * 2, SHM_K = KVBLK * D * 2, SHM_ATTN = 2 * SHM_V + 2 * SHM_K + NW * 64 * 4;
using bf16x8 = __attribute__((ext_vector_type(8))) short;
using s16x4  = __attribute__((ext_vector_type(4))) short;
using f32x16 = __attribute__((ext_vector_type(16))) float;
using f32x8  = __attribute__((ext_vector_type(8))) float;
using u32x4  = __attribute__((ext_vector_type(4))) unsigned;
#define KSWZ(row, colB) ((row) * 256 + ((colB) ^ (((row) & 7) << 4)))
#define SBAR() __builtin_amdgcn_sched_barrier(0)
__device__ __forceinline__ int crow(int r, int hi) { return (r & 3) + 8 * (r >> 2) + 4 * hi; }
__device__ __forceinline__ unsigned cvtpk(float lo, float hi) { return pg8::cvt_pk_bf16(lo, hi); }
template <typename TIn> struct Stage;
template <> struct Stage<bf16>  { using T = bf16x8;
  __device__ static __forceinline__ T ld8(const bf16* p) { return *reinterpret_cast<const bf16x8*>(p); }
  __device__ static __forceinline__ bf16x8 tobf(T x) { return x; } };
template <> struct Stage<float> { using T = f32x8;
  __device__ static __forceinline__ T ld8(const float* p) { return *reinterpret_cast<const f32x8*>(p); }
  __device__ static __forceinline__ bf16x8 tobf(T x) {
    u32x4 w = {cvtpk(x[0], x[1]), cvtpk(x[2], x[3]), cvtpk(x[4], x[5]), cvtpk(x[6], x[7])}; return *reinterpret_cast<bf16x8*>(&w); } };

__device__ __forceinline__ void partialSM(f32x16& p0, f32x16& p1, float& m_reg, float& mn, float& alpha) {
  constexpr float C = SCALE * 1.4426950408889634f;
  float pmax = p0[0]; for (int r = 1; r < 16; ++r) pmax = fmaxf(pmax, p0[r]); for (int r = 0; r < 16; ++r) pmax = fmaxf(pmax, p1[r]);
  { auto rr = __builtin_amdgcn_permlane32_swap(__float_as_uint(pmax), __float_as_uint(pmax), false, false);
    pmax = fmaxf(__uint_as_float(rr[0]), __uint_as_float(rr[1])); }
  if (__builtin_expect(__all(pmax - m_reg <= THR / SCALE), 1)) { mn = m_reg; alpha = 1.f; }
  else { mn = fmaxf(m_reg, pmax); alpha = __builtin_amdgcn_exp2f((m_reg - mn) * C); m_reg = mn; }
  float mnC = -mn * C;
  for (int r = 0; r < 16; ++r) p0[r] = fmaf(p0[r], C, mnC); for (int r = 0; r < 16; ++r) p1[r] = fmaf(p1[r], C, mnC);
  for (int r = 0; r < 16; ++r) p0[r] = __builtin_amdgcn_exp2f(p0[r]);
}
__device__ __forceinline__ void finishSM(f32x16& p0, f32x16& p1, float alpha, float& l_reg, bf16x8& pa0, bf16x8& pa1, bf16x8& pa2, bf16x8& pa3) {
  for (int r = 0; r < 16; ++r) p1[r] = __builtin_amdgcn_exp2f(p1[r]);
  float ps = 0; for (int r = 0; r < 16; ++r) ps += p0[r]; for (int r = 0; r < 16; ++r) ps += p1[r];
  { auto rr = __builtin_amdgcn_permlane32_swap(__float_as_uint(ps), __float_as_uint(ps), false, false);
    ps = __uint_as_float(rr[0]) + __uint_as_float(rr[1]); }
  l_reg = l_reg * alpha + ps;
#define PK4(P, BASE, OUT) do { unsigned a0 = cvtpk(P[BASE + 0], P[BASE + 1]), a1 = cvtpk(P[BASE + 2], P[BASE + 3]);   \
    unsigned b0 = cvtpk(P[BASE + 4], P[BASE + 5]), b1 = cvtpk(P[BASE + 6], P[BASE + 7]);                              \
    auto r0 = __builtin_amdgcn_permlane32_swap(a0, b0, false, false); auto r1 = __builtin_amdgcn_permlane32_swap(a1, b1, false, false); \
    u32x4 w = {r0[0], r1[0], r0[1], r1[1]}; OUT = *reinterpret_cast<bf16x8*>(&w); } while (0)
  PK4(p0, 0, pa0); PK4(p0, 8, pa1); PK4(p1, 0, pa2); PK4(p1, 8, pa3);
#undef PK4
}
__device__ __forceinline__ void qkt(f32x16& p0, f32x16& p1, const bf16* Ks, const bf16x8* qr, int r32, int hi) {
  p0 = f32x16{}; p1 = f32x16{};
  for (int d0 = 0; d0 < 8; ++d0) { int cb = (d0 * 16 + hi * 8) * 2;
    bf16x8 b0 = *reinterpret_cast<const bf16x8*>((const char*)Ks + KSWZ(r32, cb));
    bf16x8 b1 = *reinterpret_cast<const bf16x8*>((const char*)Ks + KSWZ(32 + r32, cb));
    p0 = __builtin_amdgcn_mfma_f32_32x32x16_bf16(b0, qr[d0], p0, 0, 0, 0);
    p1 = __builtin_amdgcn_mfma_f32_32x32x16_bf16(b1, qr[d0], p1, 0, 0, 0); }
}
__device__ __forceinline__ int v_st(int k, int c) { const int kk = (k & ~0xC) | ((k & 4) << 1) | ((k & 8) >> 1); return ((kk >> 3) * 4 + (c >> 5)) * 512 + ((kk & 7) * 32 + (c & 31)) * 2; }
__device__ __forceinline__ int v_rd_base(int lane) { return ((lane & 3) << 3) | (((lane >> 2) & 3) << 6) | (((lane >> 4) & 1) << 5) | (((lane >> 5) & 1) << 8); }
constexpr int v_rd_off(int d0, int ks, int half) { return d0 * 512 + ks * 4096 + half * 2048; }
template <int OFF> __device__ __forceinline__ s16x4 tr_read(int vb) {
  s16x4 r; asm volatile("ds_read_b64_tr_b16 %0, %1 offset:%2" : "=&v"(r) : "v"(vb), "i"(OFF) : "memory"); return r;
}
template <int D0> __device__ __forceinline__ void pv_one(f32x16& od, int vb, bf16x8 pa0, bf16x8 pa1, bf16x8 pa2, bf16x8 pa3) {
  const s16x4 l0 = tr_read<v_rd_off(D0, 0, 0)>(vb), h0 = tr_read<v_rd_off(D0, 0, 1)>(vb), l1 = tr_read<v_rd_off(D0, 1, 0)>(vb), h1 = tr_read<v_rd_off(D0, 1, 1)>(vb);
  const s16x4 l2 = tr_read<v_rd_off(D0, 2, 0)>(vb), h2 = tr_read<v_rd_off(D0, 2, 1)>(vb), l3 = tr_read<v_rd_off(D0, 3, 0)>(vb), h3 = tr_read<v_rd_off(D0, 3, 1)>(vb);
  asm volatile("s_waitcnt lgkmcnt(0)" ::: "memory"); SBAR();
#define PK(L, H) (bf16x8){L[0], L[1], L[2], L[3], H[0], H[1], H[2], H[3]}
  od = __builtin_amdgcn_mfma_f32_32x32x16_bf16(pa0, PK(l0, h0), od, 0, 0, 0);
  od = __builtin_amdgcn_mfma_f32_32x32x16_bf16(pa1, PK(l1, h1), od, 0, 0, 0);
  od = __builtin_amdgcn_mfma_f32_32x32x16_bf16(pa2, PK(l2, h2), od, 0, 0, 0);
  od = __builtin_amdgcn_mfma_f32_32x32x16_bf16(pa3, PK(l3, h3), od, 0, 0, 0);
#undef PK
}
__device__ __forceinline__ void pv_d0(f32x16* o, int vb, bf16x8 pa0, bf16x8 pa1, bf16x8 pa2, bf16x8 pa3) {
  pv_one<0>(o[0], vb, pa0, pa1, pa2, pa3); pv_one<1>(o[1], vb, pa0, pa1, pa2, pa3); pv_one<2>(o[2], vb, pa0, pa1, pa2, pa3); pv_one<3>(o[3], vb, pa0, pa1, pa2, pa3);
}

template <typename TQ>
__device__ __forceinline__ void attn_dense_body(const TQ* __restrict__ Qb, const bf16* __restrict__ Kh, const bf16* __restrict__ Vh,
                                                unsigned char* __restrict__ Ob, int seq, char* lds, const int tid_in, const float* __restrict__ qgain, const float* __restrict__ rtab, const int t0, const bool rope) {
  using St = Stage<bf16>; using SQ = Stage<TQ>;
  int tid_ = tid_in; asm volatile("" : "+v"(tid_));
  const int tid = tid_, wid = tid >> 6, lane = tid & 63, r32 = lane & 31, hi = lane >> 5;
  bf16* V_lds = (bf16*)lds; bf16* K_lds = (bf16*)(lds + 2 * SHM_V);
  float* ws = (float*)(lds + 2 * SHM_V + 2 * SHM_K) + wid * 64; float* li_l = ws; float* al_l = ws + 32;
  float m_reg = -1e30f, l_reg = 0; f32x16 o[4] = {}; bf16x8 qr[8];
  const TQ* Qw = Qb + (long)(wid * QBLK + r32) * LDQ + hi * 8;
  { float xf[8][8]; float ss = 0.f;
#pragma unroll
    for (int d0 = 0; d0 < 8; ++d0) { const bf16x8 raw = SQ::tobf(SQ::ld8(Qw + d0 * 16));
#pragma unroll
      for (int j = 0; j < 8; ++j) { xf[d0][j] = __uint_as_float(((unsigned)(unsigned short)raw[j]) << 16); ss += xf[d0][j] * xf[d0][j]; } }
    { auto rr = __builtin_amdgcn_permlane32_swap(__float_as_uint(ss), __float_as_uint(ss), false, false); ss = __uint_as_float(rr[0]) + __uint_as_float(rr[1]); }
    const float rn = 1.0f / sqrtf(ss * (1.0f / 128.0f) + 1e-6f);
#pragma unroll
    for (int d0 = 0; d0 < 8; ++d0) {
#pragma unroll
      for (int j = 0; j < 8; ++j) xf[d0][j] *= rn * qgain[d0 * 16 + hi * 8 + j]; }
    if (rope) { const int t = t0 + wid * QBLK + r32, pr = t >> 6, pc = t & 63;
#pragma unroll
      for (int hb = 0; hb < 2; ++hb) { const int p = hb ? pc : pr;
#pragma unroll
        for (int dd = 0; dd < 2; ++dd) { const int d0 = 4 * hb + dd;
#pragma unroll
          for (int j = 0; j < 8; ++j) { const int f = dd * 16 + hi * 8 + j; const float c = rtab[(p * 32 + f) * 2], s = rtab[(p * 32 + f) * 2 + 1];
            const float x0 = xf[d0][j], x1 = xf[d0 + 2][j]; xf[d0][j] = x0 * c - x1 * s; xf[d0 + 2][j] = x1 * c + x0 * s; } } } }
#pragma unroll
    for (int d0 = 0; d0 < 8; ++d0) { u32x4 w = {cvtpk(xf[d0][0], xf[d0][1]), cvtpk(xf[d0][2], xf[d0][3]), cvtpk(xf[d0][4], xf[d0][5]), cvtpk(xf[d0][6], xf[d0][7])}; qr[d0] = *reinterpret_cast<bf16x8*>(&w); } }
  const int sr = tid >> 4, sc = (tid & 15) * 8, vst0 = v_st(sr, sc), vst1 = v_st(32 + sr, sc);
  const int vb0 = (int)(uintptr_t)V_lds + v_rd_base(lane);
  struct { typename St::T vs0, vs1, ks0, ks1; } sr_[SDEPTH];
#define SLOAD(i, k0) do { sr_[i].vs0 = St::ld8(&Vh[(long)((k0) + sr) * LDK + sc]); sr_[i].vs1 = St::ld8(&Vh[(long)((k0) + 32 + sr) * LDK + sc]); \
    sr_[i].ks0 = St::ld8(&Kh[(long)((k0) + sr) * LDK + sc]); sr_[i].ks1 = St::ld8(&Kh[(long)((k0) + 32 + sr) * LDK + sc]); } while (0)
#define SWRITE(b, i) do { *(bf16x8*)((char*)V_lds + (b) * SHM_V + vst0) = St::tobf(sr_[i].vs0);          \
    *(bf16x8*)((char*)V_lds + (b) * SHM_V + vst1) = St::tobf(sr_[i].vs1); int kc = sc * 2;               \
    *(bf16x8*)((char*)K_lds + (b) * SHM_K + KSWZ(sr, kc)) = St::tobf(sr_[i].ks0);                       \
    *(bf16x8*)((char*)K_lds + (b) * SHM_K + KSWZ(32 + sr, kc)) = St::tobf(sr_[i].ks1); } while (0)
#define SWAIT() do { if constexpr (SDEPTH == 2) asm volatile("s_waitcnt vmcnt(4)" ::: "memory"); else asm volatile("s_waitcnt vmcnt(0)" ::: "memory"); } while (0)
#define RESC(a) do { if (__any((a) < 1.f)) { if (hi == 0) al_l[r32] = (a); asm volatile("s_waitcnt lgkmcnt(0)" ::: "memory"); \
    for (int d = 0; d < 4; ++d) for (int r = 0; r < 16; ++r) o[d][r] *= al_l[crow(r, hi)]; } } while (0)
  f32x16 pA0, pA1, pB0, pB1; float mnA, mnB, alA, alB; bf16x8 pa0, pa1, pa2, pa3; const int NT = seq / KVBLK;
  constexpr int SE = 0, SO = SDEPTH - 1;
  SLOAD(SE, 0); asm volatile("s_waitcnt vmcnt(0)" ::: "memory"); SWRITE(0, SE); __syncthreads();
  qkt(pA0, pA1, K_lds, qr, r32, hi); partialSM(pA0, pA1, m_reg, mnA, alA);
  SLOAD(SO, KVBLK); if constexpr (SDEPTH == 2) { if (2 < NT) SLOAD(SE, 2 * KVBLK); }
  SWAIT(); SWRITE(1, SO); __syncthreads();
  for (int j = 1; j + 1 < NT; j += 2) {
    SBAR(); qkt(pB0, pB1, (bf16*)((char*)K_lds + SHM_K), qr, r32, hi);
    finishSM(pA0, pA1, alA, l_reg, pa0, pa1, pa2, pa3); SBAR();
    SLOAD(SO, (j + SDEPTH) * KVBLK); SBAR();
    pv_d0(o, vb0, pa0, pa1, pa2, pa3); partialSM(pB0, pB1, m_reg, mnB, alB);
    __syncthreads(); SWAIT(); SWRITE(0, SE);
    RESC(alB); __syncthreads();
    SBAR(); qkt(pA0, pA1, K_lds, qr, r32, hi);
    finishSM(pB0, pB1, alB, l_reg, pa0, pa1, pa2, pa3); SBAR();
    if (SDEPTH == 1 || j + 3 < NT) SLOAD(SE, (j + 1 + SDEPTH) * KVBLK); SBAR();
    pv_d0(o, vb0 + (int)SHM_V, pa0, pa1, pa2, pa3); partialSM(pA0, pA1, m_reg, mnA, alA);
    __syncthreads(); SWAIT(); SWRITE(1, SO);
    RESC(alA); __syncthreads();
  }
  SBAR(); qkt(pB0, pB1, (bf16*)((char*)K_lds + SHM_K), qr, r32, hi);
  finishSM(pA0, pA1, alA, l_reg, pa0, pa1, pa2, pa3); SBAR();
  pv_d0(o, vb0, pa0, pa1, pa2, pa3); partialSM(pB0, pB1, m_reg, mnB, alB);
  __syncthreads(); RESC(alB);
  finishSM(pB0, pB1, alB, l_reg, pa0, pa1, pa2, pa3); SBAR();
  pv_d0(o, vb0 + (int)SHM_V, pa0, pa1, pa2, pa3);
  if (hi == 0) li_l[r32] = l_reg; asm volatile("s_waitcnt lgkmcnt(0)" ::: "memory");
  float rli[16];
#pragma unroll
  for (int r = 0; r < 16; ++r) rli[r] = __builtin_amdgcn_rcpf(li_l[crow(r, hi)]);
  unsigned char* Ow = Ob + (long)(wid * QBLK) * LDO;
#pragma unroll
  for (int r = 0; r < 16; ++r) { int orow = crow(r, hi);
    for (int d0 = 0; d0 < 4; ++d0) { const float ov = o[d0][r] * rli[r] * 16.0f; Ow[(long)orow * LDO + d0 * 32 + r32] = (unsigned char)(__builtin_amdgcn_cvt_pk_fp8_f32(ov, ov, __builtin_bit_cast(int, ov), false) & 0xff); } }
#undef SLOAD
#undef SWRITE
#undef SWAIT
#undef RESC
}
#undef KSWZ
#undef SBAR
}

#define GAS __attribute__((address_space(1)))
#define LAS __attribute__((address_space(3)))
typedef unsigned short bf16;
typedef unsigned v4u __attribute__((ext_vector_type(4)));
typedef float f32x4 __attribute__((ext_vector_type(4)));
typedef short bf16x8 __attribute__((ext_vector_type(8)));
typedef GAS unsigned gu32;
typedef GAS unsigned long long gu64;
#define RLX_AGENT __ATOMIC_RELAXED, __HIP_MEMORY_SCOPE_AGENT
#define LDS_WAIT() asm volatile("s_waitcnt lgkmcnt(0)" ::: "memory")
#define VM_WAIT() asm volatile("s_waitcnt vmcnt(0)" ::: "memory")
__device__ __forceinline__ unsigned long long rt() { return __builtin_amdgcn_s_memrealtime(); }
__device__ __forceinline__ unsigned f2bf(float f) { unsigned u = __builtin_bit_cast(unsigned, f); return (u + 0x7fffu + ((u >> 16) & 1u)) >> 16; }
__device__ __forceinline__ unsigned pk2(float lo, float hi) { return f2bf(lo) | (f2bf(hi) << 16); }

#define XB_TMO      128
#define XB_XCNT(j)  (256  + 64 * (j))
#define XB_XSUB(j)  (1280 + 64 * (j))
#define XB_XGEN(j)  (2304 + 64 * (j))
#define XB_TOP      3328
#define XB_TOPGEN   3392
#define XCD_BAR_WORDS 3456
#define XB_SPIN_CAP (1u << 18)

__device__ __forceinline__ unsigned xb_ld(unsigned* p)              { return __hip_atomic_load(p, __ATOMIC_RELAXED, __HIP_MEMORY_SCOPE_AGENT); }
__device__ __forceinline__ unsigned xb_add(unsigned* p, unsigned v) { return __hip_atomic_fetch_add(p, v, __ATOMIC_RELAXED, __HIP_MEMORY_SCOPE_AGENT); }
__device__ __forceinline__ unsigned xb_xcc_id() { return (unsigned)__builtin_amdgcn_s_getreg((3 << 11) | 20) & 0xFu; }
#define XB_SPIN(cond, bar) do { unsigned _sp = 0; while (cond) { __builtin_amdgcn_s_sleep(1); \
    if ((++_sp & 255u) == 0u) { if (xb_ld(&(bar)[XB_TMO])) break; if (_sp > XB_SPIN_CAP) { atomicAdd(&(bar)[XB_TMO], 1u); break; } } } } while (0)

struct XcdBarrier {
    unsigned* bar; unsigned x;
    volatile LAS unsigned* st;
};

__device__ __forceinline__ XcdBarrier xcd_barrier_post(unsigned* bar, volatile LAS unsigned* st) {
    XcdBarrier b; b.bar = bar; b.x = xb_xcc_id(); b.st = st;
    if (threadIdx.x == 0) (void)xb_add(&bar[XB_XCNT(b.x)], 1u);
    return b;
}
__device__ __forceinline__ void xcd_barrier_complete(unsigned* bar, unsigned x, unsigned& nloc, unsigned& nx) {
    const unsigned G = gridDim.x * gridDim.y * gridDim.z;
    unsigned sum, cnt, mine, sp = 0u;
    for (;;) {
        sum = 0u; cnt = 0u; mine = 0u;
#pragma unroll
        for (unsigned j = 0; j < 16; ++j) { const unsigned c = xb_ld(&bar[XB_XCNT(j)]); sum += c; cnt += (c > 0u) ? 1u : 0u; mine = (j == x) ? c : mine; }
        if (sum == G) break;
        __builtin_amdgcn_s_sleep(1);
        if ((++sp & 255u) == 0u) { if (xb_ld(&bar[XB_TMO])) break; if (sp > XB_SPIN_CAP) { atomicAdd(&bar[XB_TMO], 1u); break; } }
    }
    nloc = mine > 0u ? mine : 1u; nx = cnt > 0u ? cnt : 1u;
}

__device__ __forceinline__ void xcd_barrier(const XcdBarrier& b) {
    asm volatile("s_waitcnt vmcnt(0)" ::: "memory");
    __syncthreads();
    if (threadIdx.x == 0) {
        unsigned* bar = b.bar;
        __builtin_amdgcn_s_waitcnt(0);
        unsigned nloc = b.st[0], nx = b.st[1];
        if (nloc == 0u) { xcd_barrier_complete(bar, b.x, nloc, nx); b.st[0] = nloc; b.st[1] = nx; }
        const unsigned old = xb_add(&bar[XB_XSUB(b.x)], 1u);
        const unsigned gen = old / nloc;
        if (old + 1u == (gen + 1u) * nloc) {
            __builtin_amdgcn_fence(__ATOMIC_RELEASE, "agent");
            asm volatile("s_waitcnt vmcnt(0)" ::: "memory");
            const unsigned og = xb_add(&bar[XB_TOP], 1u);
            const unsigned tg = og / nx;
            if (og + 1u == (tg + 1u) * nx) xb_add(&bar[XB_TOPGEN], 1u);
            else XB_SPIN(xb_ld(&bar[XB_TOPGEN]) == tg, bar);
            __builtin_amdgcn_fence(__ATOMIC_ACQUIRE, "agent");
            xb_add(&bar[XB_XGEN(b.x)], 1u);
            asm volatile("s_waitcnt vmcnt(0)" ::: "memory");
        } else {
            XB_SPIN(xb_ld(&bar[XB_XGEN(b.x)]) == gen, bar);
            __builtin_amdgcn_fence(__ATOMIC_ACQUIRE, "agent");
            asm volatile("s_waitcnt vmcnt(0)" ::: "memory");
        }
    }
    __syncthreads();
}
constexpr int DM = 1024, NB = 16, SEQ = 2048, CTXL = 256, TL = NB * SEQ, TC = NB * CTXL, TALL = TL + TC;
constexpr int INCOLS = 6144, OFF_FNET = 2560, OFF_GATE = 3072;
constexpr int NEXP = 32, KVROWS = SEQ + CTXL;
constexpr float EPS = 1e-6f;
constexpr int NWAVES = 8, NTHR = NWAVES * 64;
constexpr int NPL = 11, NPH = 2 + 2 * NPL;
#ifndef MK_PER_PHASE
#define MK_PER_PHASE 0
#endif
constexpr size_t MiB = 1u << 20;
constexpr size_t WS_CTL = 0, CTL_ZERO_BYTES = 1 * MiB;
constexpr size_t WS_MOD = 1 * MiB;
constexpr size_t WS_TAB = 2 * MiB;
constexpr size_t WS_TOPI = 3 * MiB, WS_TOPP = 4 * MiB, WS_SLOT = 5 * MiB, WS_CNT = 6 * MiB;
constexpr size_t WS_LOGIT = 7 * MiB;
constexpr size_t WS_WSMALL = 17 * MiB, WSMALL_LAYER = 20 * MiB;
constexpr size_t OFFS_WIN = 0, OFFS_WF = 5 * MiB, OFFS_WG = 7 * MiB, OFFS_WAO = 13 * MiB, OFFS_WCO = 15 * MiB, OFFS_WFO = 16 * MiB, OFFS_WOUT = 17 * MiB, OFFS_ROUT = 19 * MiB;
constexpr size_t WS_DFTL = 57 * MiB, WS_DFTC = 73 * MiB;
constexpr size_t WS_XC = 74 * MiB;
constexpr size_t WS_H = 90 * MiB;
constexpr size_t WS_WGU = 162 * MiB, WS_WD = 226 * MiB, MOEW_LAYER = 96 * MiB;
constexpr size_t WS_BIG = 354 * MiB;
constexpr size_t WS_Q = WS_BIG, WS_K = WS_Q + 72 * MiB, WS_V = WS_K + 18 * MiB, WS_CU = WS_V + 18 * MiB, WS_YT = WS_CU + 36 * MiB, WS_YTC = WS_YT + 64 * MiB;
constexpr size_t WS_GATES = WS_BIG;
constexpr size_t WS_AO = WS_BIG + 216 * MiB, WS_CH = WS_AO + 72 * MiB, WS_Z = WS_CH + 36 * MiB;
constexpr size_t WS_MIX = WS_AO;
constexpr size_t WS_MERGED = WS_BIG + 360 * MiB;
constexpr int SLOT_ROWS = 608 * 256;
constexpr size_t WS_YS = WS_BIG, WS_HS = WS_BIG + 304 * MiB, WS_ACT = WS_BIG + 456 * MiB, WS_END = WS_BIG + 608 * MiB;
constexpr size_t WS_H8 = WS_END;
constexpr size_t WS_END2 = WS_END + 36 * MiB;
static_assert(WS_YTC + 8 * MiB == WS_AO && WS_Z + 36 * MiB == WS_MERGED && WS_MERGED + 72 * MiB <= WS_END && (size_t)SLOT_ROWS * 2048 == 304 * MiB, "ws map");
constexpr int CW_TMO = 0, CW_CODE = 1, CW_BAR = 4096;
constexpr int CNT_TILE_E = 16384, CNT_NT = 16384 + 1024;

constexpr int RING_OFF = 0, RING_BYTES = 131072;
constexpr int LDSCTL_OFF = RING_BYTES, MISC_OFF = LDSCTL_OFF + 320, LDS_CT = LDSCTL_OFF + 512, LDS_SM = LDSCTL_OFF + 1024;
constexpr int LDS_BYTES = 155648;

typedef unsigned u32x2 __attribute__((ext_vector_type(2)));
typedef int i32x4 __attribute__((ext_vector_type(4)));
typedef float f32x2 __attribute__((ext_vector_type(2)));
struct Args { const float* in[29]; float* out; unsigned char* ws; int ph_lo, ph_hi; };
typedef const __attribute__((address_space(4))) unsigned char* kptr_t;
struct AV {
    kptr_t kp;
    __device__ __forceinline__ const float* in(int i) const { return *(const float* const __attribute__((address_space(4)))*)(kp + 8 * i); }
    __device__ __forceinline__ float* out() const { return *(float* const __attribute__((address_space(4)))*)(kp + 8 * 29); }
    __device__ __forceinline__ unsigned char* ws() const { return *(unsigned char* const __attribute__((address_space(4)))*)(kp + 8 * 30); }
};
__device__ __forceinline__ AV av_get() { AV a; a.kp = (kptr_t)__builtin_amdgcn_kernarg_segment_ptr(); asm volatile("" : "+s"(a.kp)); return a; }

struct Frame {
    LAS unsigned char* lds; volatile LAS unsigned* MISC; gu32* ctl;
    int tid, lane, wave, vcu, G;
};

__device__ __forceinline__ float shx(float v, int m, int lane) { return __int_as_float(__builtin_amdgcn_ds_bpermute((lane ^ m) << 2, __float_as_int(v))); }
__device__ __forceinline__ float wave_sum(float v, int lane) {
#pragma unroll
    for (int o = 1; o < 64; o <<= 1) v += shx(v, o, lane);
    return v;
}
__device__ __forceinline__ float sigmoidf_(float x) { return 1.0f / (1.0f + __expf(-x)); }
__device__ __forceinline__ f32x4 bf4(u32x2 w) { f32x4 r; r[0] = __uint_as_float(w.x << 16); r[1] = __uint_as_float(w.x & 0xffff0000u); r[2] = __uint_as_float(w.y << 16); r[3] = __uint_as_float(w.y & 0xffff0000u); return r; }
__device__ __forceinline__ u32x2 pk4(f32x4 v) { u32x2 w; w.x = pk2(v[0], v[1]); w.y = pk2(v[2], v[3]); return w; }
__device__ __forceinline__ void ld_row_f32(f32x4 (&v)[4], const float* p, int lane) {
#pragma unroll
    for (int j = 0; j < 4; ++j) v[j] = ((const GAS f32x4*)p)[lane + 64 * j];
}
__device__ __forceinline__ void st_row_f32(const f32x4 (&v)[4], float* p, int lane) {
#pragma unroll
    for (int j = 0; j < 4; ++j) ((GAS f32x4*)p)[lane + 64 * j] = v[j];
}
__device__ __forceinline__ void ld_row_bf16(f32x4 (&v)[4], const bf16* p, int lane) {
#pragma unroll
    for (int j = 0; j < 4; ++j) v[j] = bf4(((const GAS u32x2*)p)[lane + 64 * j]);
}
__device__ __forceinline__ void st_row_bf16(const f32x4 (&v)[4], bf16* p, int lane) {
#pragma unroll
    for (int j = 0; j < 4; ++j) ((GAS u32x2*)p)[lane + 64 * j] = pk4(v[j]);
}
__device__ __forceinline__ void rms_gain(f32x4 (&v)[4], const float* g, int lane) {
    float ss = 0.f;
#pragma unroll
    for (int j = 0; j < 4; ++j) ss += (v[j][0] * v[j][0] + v[j][1] * v[j][1]) + (v[j][2] * v[j][2] + v[j][3] * v[j][3]);
    const float r = 1.0f / sqrtf(wave_sum(ss, lane) * (1.0f / 1024.0f) + EPS);
#pragma unroll
    for (int j = 0; j < 4; ++j) { const f32x4 gg = ((const GAS f32x4*)g)[lane + 64 * j]; v[j] = v[j] * r * gg; }
}
__device__ __forceinline__ void modulate_store(const f32x4 (&v)[4], const float* shift, const float* scale, bf16* o, int lane) {
#pragma unroll
    for (int j = 0; j < 4; ++j) { const f32x4 sh = ((const GAS f32x4*)shift)[lane + 64 * j], sc = ((const GAS f32x4*)scale)[lane + 64 * j];
        ((GAS u32x2*)o)[lane + 64 * j] = pk4(v[j] * (sc + 1.0f) + sh); }
}
__device__ __forceinline__ unsigned pk4_fp8(f32x4 v) { return pg8::cvt4_fp8(v[0], v[1], v[2], v[3]); }
__device__ __forceinline__ void modulate_store2(const f32x4 (&v)[4], const float* shift, const float* scale, bf16* o, unsigned char* o8, int lane) {
#pragma unroll
    for (int j = 0; j < 4; ++j) { const f32x4 sh = ((const GAS f32x4*)shift)[lane + 64 * j], sc = ((const GAS f32x4*)scale)[lane + 64 * j]; const f32x4 r = v[j] * (sc + 1.0f) + sh;
        ((GAS u32x2*)o)[lane + 64 * j] = pk4(r); ((GAS unsigned*)o8)[lane + 64 * j] = pk4_fp8(r); }
}
__device__ __forceinline__ f32x4 fp8x4(unsigned w) { const f32x2 a = __builtin_amdgcn_cvt_pk_f32_fp8((int)w, false), b = __builtin_amdgcn_cvt_pk_f32_fp8((int)w, true); return (f32x4){a.x, a.y, b.x, b.y}; }
__device__ __forceinline__ int krow_of(int m) { return m < TL ? (m >> 11) * KVROWS + (m & 2047) : ((m - TL) >> 8) * KVROWS + SEQ + ((m - TL) & 255); }

__device__ __forceinline__ void load_block(const float* W, int ldw, int k0, int n0, float scale, LAS float* scr, int lane) {
    f32x4 v[8]; const int kr = lane >> 3, c4 = (lane & 7) * 4;
#pragma unroll
    for (int i = 0; i < 8; ++i) v[i] = *(const GAS f32x4*)(W + (size_t)(k0 + kr + 8 * i) * ldw + n0 + c4);
#pragma unroll
    for (int i = 0; i < 8; ++i) { LAS float* d = scr + (kr + 8 * i) * 33 + c4; d[0] = v[i][0] * scale; d[1] = v[i][1] * scale; d[2] = v[i][2] * scale; d[3] = v[i][3] * scale; }
    LDS_WAIT(); asm volatile("" ::: "memory");
}
__device__ __forceinline__ void transpose_item(const float* W, int ldw, int K, bf16* WT, int dst_row0, int k0, int n0, LAS float* scr, int lane) {
    load_block(W, ldw, k0, n0, 1.0f, scr, lane);
    const int c = lane & 7;
#pragma unroll
    for (int j = 0; j < 4; ++j) { const int n = (lane >> 3) + 8 * j; const LAS float* s = scr + (8 * c) * 33 + n;
        v4u o; o.x = pk2(s[0 * 33], s[1 * 33]); o.y = pk2(s[2 * 33], s[3 * 33]); o.z = pk2(s[4 * 33], s[5 * 33]); o.w = pk2(s[6 * 33], s[7 * 33]);
        *(GAS v4u*)(WT + (size_t)(dst_row0 + n) * K + k0 + 8 * c) = o; }
    LDS_WAIT(); asm volatile("" ::: "memory");
}
__device__ __forceinline__ void transpose_item_fp8(const float* W, int ldw, int K, unsigned char* WT, int dst_row0, int k0, int n0, float scale, LAS float* scr, int lane) {
    load_block(W, ldw, k0, n0, scale, scr, lane);
#pragma unroll
    for (int j = 0; j < 2; ++j) { const int q = lane + 64 * j, n = q >> 2, c = q & 3; const LAS float* s = scr + (16 * c) * 33 + n; v4u o;
        o.x = pg8::cvt4_fp8(s[0 * 33], s[1 * 33], s[2 * 33], s[3 * 33]); o.y = pg8::cvt4_fp8(s[4 * 33], s[5 * 33], s[6 * 33], s[7 * 33]); o.z = pg8::cvt4_fp8(s[8 * 33], s[9 * 33], s[10 * 33], s[11 * 33]); o.w = pg8::cvt4_fp8(s[12 * 33], s[13 * 33], s[14 * 33], s[15 * 33]);
        *(GAS v4u*)(WT + (size_t)(dst_row0 + n) * K + k0 + 16 * c) = o; }
    LDS_WAIT(); asm volatile("" ::: "memory");
}
constexpr int IT_S0 = 16 * 80, IT_S1 = 16 * 96, IT_S2 = 512, IT_S3 = 512, IT_S4 = 256, IT_S5 = 256, IT_SMALL = IT_S0 + IT_S1 + IT_S2 + IT_S3 + IT_S4 + IT_S5;
__device__ __forceinline__ void small_item(const AV& a, int l, int r, LAS float* scr, int lane) {
    unsigned char* wl = a.ws() + WS_WSMALL + (size_t)l * WSMALL_LAYER; const float* win = a.in(10) + (size_t)l * DM * INCOLS;
    if (r < IT_S0) { const int kb = r / 80, n0 = (r % 80) * 32; int dr;
        if (n0 < 1536) dr = n0; else { int cc = n0 - 1536; if (cc < 512) dr = 1536 + (cc >> 7) * 256 + (cc & 127); else { cc -= 512; dr = 1536 + (cc >> 7) * 256 + 128 + (cc & 127); } }
        transpose_item_fp8(win, INCOLS, DM, wl + OFFS_WIN, dr, kb * 64, n0, 32.0f, scr, lane); return; }
    r -= IT_S0;
    if (r < IT_S1) { const int kb = r / 96, nb = r % 96; transpose_item_fp8(win, INCOLS, DM, wl + OFFS_WG, nb * 32, kb * 64, OFF_GATE + nb * 32, 32.0f, scr, lane); return; }
    r -= IT_S1;
    if (r < IT_S2) { const int kb = r / 32, nb = r % 32; transpose_item_fp8(a.in(13) + (size_t)l * DM * DM, DM, DM, wl + OFFS_WAO, nb * 32, kb * 64, nb * 32, 32.0f, scr, lane); return; }
    r -= IT_S2;
    if (r < IT_S3) { const int kb = r / 32, nb = r % 32; transpose_item(a.in(20) + (size_t)l * DM * DM, DM, DM, (bf16*)(wl + OFFS_WOUT), nb * 32, kb * 64, nb * 32, scr, lane); return; }
    r -= IT_S3;
    if (r < IT_S4) { const int kb = r / 32, nb = r % 32; transpose_item(a.in(18) + (size_t)l * 512 * DM, DM, 512, (bf16*)(wl + OFFS_WCO), nb * 32, kb * 64, nb * 32, scr, lane); return; }
    r -= IT_S4;
    { const int kb = r / 32, nb = r % 32; transpose_item(a.in(19) + (size_t)l * 512 * DM, DM, 512, (bf16*)(wl + OFFS_WFO), nb * 32, kb * 64, nb * 32, scr, lane); }
}
constexpr int IT_MOE = NEXP * 3 * 512;
struct MoeIt { const float* W; unsigned char* WT; int dr, k0; };
__device__ __forceinline__ MoeIt moe_decode(const AV& a, int gi) {
    const int l = gi / IT_MOE, idx = gi % IT_MOE, e = idx / 1536, r = idx % 1536, which = r / 512, it = r % 512, kb = it / 32, n0 = (it % 32) * 32; const size_t eo = ((size_t)l * NEXP + e) << 20;
    MoeIt m; m.k0 = kb * 64;
    if (which == 0) { m.W = a.in(23) + eo + n0; m.WT = a.ws() + WS_WGU + (size_t)l * MOEW_LAYER + (size_t)e * 2048 * 1024; m.dr = (n0 >> 7) * 256 + (n0 & 127); }
    else if (which == 1) { m.W = a.in(25) + eo + n0; m.WT = a.ws() + WS_WGU + (size_t)l * MOEW_LAYER + (size_t)e * 2048 * 1024; m.dr = (n0 >> 7) * 256 + 128 + (n0 & 127); }
    else { m.W = a.in(27) + eo + n0; m.WT = a.ws() + WS_WD + (size_t)l * MOEW_LAYER + (size_t)e * 1024 * 1024; m.dr = n0; }
    return m;
}
__device__ __forceinline__ void moe_issue(f32x4 (&v)[8], const MoeIt& m, int lane) {
    const float* p = m.W + (size_t)(m.k0 + (lane >> 3)) * DM + (lane & 7) * 4;
#pragma unroll
    for (int i = 0; i < 8; ++i) v[i] = __builtin_nontemporal_load((const GAS f32x4*)(p + (size_t)(8 * i) * DM));
}
__device__ __forceinline__ void moe_finish(const f32x4 (&v)[8], const MoeIt& m, LAS float* scr, int lane) {
    const int kr = lane >> 3, c4 = (lane & 7) * 4;
#pragma unroll
    for (int i = 0; i < 8; ++i) { LAS float* d = scr + (kr + 8 * i) * 33 + c4; d[0] = v[i][0] * 32.0f; d[1] = v[i][1] * 32.0f; d[2] = v[i][2] * 32.0f; d[3] = v[i][3] * 32.0f; }
    LDS_WAIT(); asm volatile("" ::: "memory");
#pragma unroll
    for (int j = 0; j < 2; ++j) { const int q = lane + 64 * j, n = q >> 2, c = q & 3; const LAS float* s = scr + (16 * c) * 33 + n; v4u o;
        o.x = pg8::cvt4_fp8(s[0 * 33], s[1 * 33], s[2 * 33], s[3 * 33]); o.y = pg8::cvt4_fp8(s[4 * 33], s[5 * 33], s[6 * 33], s[7 * 33]); o.z = pg8::cvt4_fp8(s[8 * 33], s[9 * 33], s[10 * 33], s[11 * 33]); o.w = pg8::cvt4_fp8(s[12 * 33], s[13 * 33], s[14 * 33], s[15 * 33]);
        *(GAS v4u*)(m.WT + (size_t)(m.dr + n) * DM + m.k0 + 16 * c) = o; }
    LDS_WAIT(); asm volatile("" ::: "memory");
}
__device__ __forceinline__ void moe_convert_all(const AV& a, int gw, int NGW, LAS float* scr, int lane) {
    constexpr int NIT = 2 * IT_MOE; f32x4 va[8], vb[8]; int it = gw; if (it >= NIT) return;
    MoeIt ma = moe_decode(a, it), mb = ma; moe_issue(va, ma, lane);
    for (;;) {
        const bool h1 = it + NGW < NIT; if (h1) { mb = moe_decode(a, it + NGW); moe_issue(vb, mb, lane); }
        moe_finish(va, ma, scr, lane); if (!h1) break; it += NGW;
        const bool h2 = it + NGW < NIT; if (h2) { ma = moe_decode(a, it + NGW); moe_issue(va, ma, lane); }
        moe_finish(vb, mb, scr, lane); if (!h2) break; it += NGW;
    }
}
__device__ __forceinline__ void fold_job(const AV& a, int j, const LAS float* ct, int lane) {
    const int l = j >> 10, r = j & 1023, g = r >> 8, kblk = (r >> 4) & 15, k2g = r & 15, k = kblk * 64 + lane;
    const float* wrow = a.in(10) + (size_t)l * DM * INCOLS + (size_t)k * INCOLS + OFF_FNET + g * 128;
    float ac[8], as[8];
#pragma unroll
    for (int i = 0; i < 8; ++i) { ac[i] = 0.f; as[i] = 0.f; }
    for (int n4 = 0; n4 < 32; ++n4) { const f32x4 w = *(const GAS f32x4*)(wrow + n4 * 4);
#pragma unroll
        for (int q = 0; q < 4; ++q) { const int n2 = n4 * 4 + q;
#pragma unroll
            for (int i = 0; i < 8; ++i) { const int ph = (n2 * (k2g * 8 + i)) & 127; ac[i] += w[q] * ct[ph]; as[i] += w[q] * ct[(ph - 32) & 127]; } } }
    bf16* wf = (bf16*)(a.ws() + WS_WSMALL + (size_t)l * WSMALL_LAYER + OFFS_WF);
#pragma unroll
    for (int i = 0; i < 8; ++i) { const int ch = g * 128 + k2g * 8 + i;
        wf[(size_t)ch * 1024 + k] = (bf16)f2bf(ac[i] * 0.08838834764831845f); wf[(size_t)(512 + ch) * 1024 + k] = (bf16)f2bf(as[i] * 0.08838834764831845f); }
}
__device__ __forceinline__ void p0_prologue(const Frame& F, const AV& a) {
    const int gw = F.vcu * NWAVES + F.wave, NGW = F.G * NWAVES, gt = F.vcu * NTHR + F.tid, NGT = F.G * NTHR;
    LAS float* ct = (LAS float*)(F.lds + LDS_CT);
    if (F.tid < 128) ct[F.tid] = cospif((float)F.tid * (1.0f / 64.0f));
    for (int job = blockIdx.x; job < 2 * 96; job += F.G) {
        const int l = job / 96, n0 = (job % 96) * 64;
        LAS float* s = (LAS float*)(F.lds + RING_OFF); LAS float* red = s + 17 * 1024;
        for (int i = F.tid; i < 17 * 1024; i += NTHR) { const int b = i >> 10, k = i & 1023; const float cv = b < 16 ? a.in(1)[b * 1024 + k] : a.in(3)[k]; s[i] = cv * sigmoidf_(cv); }
        __syncthreads();
        const int col = F.tid & 63, ks = F.tid >> 6; float acc[17];
#pragma unroll
        for (int b = 0; b < 17; ++b) acc[b] = 0.f;
        const float* w = a.in(4) + (size_t)l * DM * INCOLS + n0 + col;
        for (int k = ks * 128; k < ks * 128 + 128; k += 16) { float wv[16];
#pragma unroll
            for (int q = 0; q < 16; ++q) wv[q] = w[(size_t)(k + q) * INCOLS];
#pragma unroll
            for (int q = 0; q < 16; ++q)
#pragma unroll
                for (int b = 0; b < 17; ++b) acc[b] += s[b * 1024 + k + q] * wv[q]; }
#pragma unroll
        for (int b = 0; b < 17; ++b) red[(ks * 17 + b) * 64 + col] = acc[b];
        __syncthreads();
        for (int i = F.tid; i < 17 * 64; i += NTHR) { const int b = i >> 6, c2 = i & 63; float t = 0.f;
#pragma unroll
            for (int q = 0; q < 8; ++q) t += red[(q * 17 + b) * 64 + c2];
            ((float*)(a.ws() + WS_MOD))[((size_t)l * 17 + b) * INCOLS + n0 + c2] = t + a.in(5)[l * INCOLS + n0 + c2]; }
        __syncthreads();
    }
    __syncthreads();
    for (int i = gt; i < 64 * 32; i += NGT) { const int p = i >> 5, f = i & 31; const float inv = powf(10000.0f, -(float)f / 32.0f), ang = (float)p * inv; ((f32x2*)(a.ws() + WS_TAB))[i] = (f32x2){cosf(ang), sinf(ang)}; }
    for (int i = gt; i < 2048 * 256; i += NGT) { const int k1 = i >> 8, c0 = (i & 255) * 16; float v[16];
#pragma unroll
        for (int q = 0; q < 16; ++q) { const int col = c0 + q, n1 = col & 2047, rr = (k1 * n1) & 2047; const float x = (float)rr * (1.0f / 1024.0f); v[q] = ((col >> 11) ? -sinpif(x) : cospif(x)) * (32.0f * 0.022097086912079608f); }
        v4u o; o.x = pk4_fp8((f32x4){v[0], v[1], v[2], v[3]}); o.y = pk4_fp8((f32x4){v[4], v[5], v[6], v[7]}); o.z = pk4_fp8((f32x4){v[8], v[9], v[10], v[11]}); o.w = pk4_fp8((f32x4){v[12], v[13], v[14], v[15]}); ((GAS v4u*)(a.ws() + WS_DFTL))[i] = o; }
    for (int i = gt; i < 256 * 32; i += NGT) { const int k1 = i >> 5, c0 = (i & 31) * 16; float v[16];
#pragma unroll
        for (int q = 0; q < 16; ++q) { const int col = c0 + q, n1 = col & 255, rr = (k1 * n1) & 255; const float x = (float)rr * (1.0f / 128.0f); v[q] = ((col >> 8) ? -sinpif(x) : cospif(x)) * (32.0f * 0.0625f); }
        v4u o; o.x = pk4_fp8((f32x4){v[0], v[1], v[2], v[3]}); o.y = pk4_fp8((f32x4){v[4], v[5], v[6], v[7]}); o.z = pk4_fp8((f32x4){v[8], v[9], v[10], v[11]}); o.w = pk4_fp8((f32x4){v[12], v[13], v[14], v[15]}); ((GAS v4u*)(a.ws() + WS_DFTC))[i] = o; }
    for (int i = gt; i < 2 * 256 * 1024; i += NGT) { const int l = i >> 18, r = (i >> 10) & 255, k = i & 1023; unsigned o = 0u;
        if (r < 64) { const float w = a.in(21)[((size_t)l * DM + k) * NEXP + (r & 31)]; const unsigned hi = f2bf(w); o = hi; if (r >= 32) o = f2bf(w - __uint_as_float(hi << 16)); }
        ((bf16*)(a.ws() + WS_WSMALL + (size_t)l * WSMALL_LAYER + OFFS_ROUT))[(size_t)r * 1024 + k] = (bf16)o; }
    for (int j = gw; j < 2048; j += NGW) fold_job(a, j, ct, F.lane);
    LAS float* scr = (LAS float*)(F.lds + RING_OFF + F.wave * 16384);
    for (int it = gw; it < 2 * IT_SMALL; it += NGW) small_item(a, it / IT_SMALL, it % IT_SMALL, scr, F.lane);
    moe_convert_all(a, gw, NGW, scr, F.lane);
}
__device__ __forceinline__ void ld4(f32x4 (&v)[4], const float* p, int lane) {
#pragma unroll
    for (int j = 0; j < 4; ++j) v[j] = ((const GAS f32x4*)p)[lane + 64 * j];
}
__device__ __forceinline__ float sumsq4(const f32x4 (&v)[4]) { float ss = 0.f;
#pragma unroll
    for (int j = 0; j < 4; ++j) ss += (v[j][0] * v[j][0] + v[j][1] * v[j][1]) + (v[j][2] * v[j][2] + v[j][3] * v[j][3]);
    return ss; }
__device__ __forceinline__ void p1_norm0(const Frame& F, const AV& a) {
    const int gw = F.vcu * NWAVES + F.wave, NGW = F.G * NWAVES, rpw = (TALL + NGW - 1) / NGW, r0 = gw * rpw, r1 = (r0 + rpw < TALL) ? r0 + rpw : TALL;
    if (r0 >= r1) return;
    f32x4 gpre[4], shift[4], scale[4], xn[4]; ld4(gpre, a.in(6), F.lane); int cb = -1;
    auto xsrc = [&](int m) -> const float* { return m < TL ? a.in(0) + (size_t)m * DM : a.in(2) + (size_t)(m - TL) * DM; };
    ld4(xn, xsrc(r0), F.lane);
    for (int m = r0; m < r1; ++m) {
        f32x4 x[4];
#pragma unroll
        for (int j = 0; j < 4; ++j) x[j] = xn[j];
        if (m + 1 < r1) ld4(xn, xsrc(m + 1), F.lane);
        const int b = m < TL ? (m >> 11) : 16;
        if (b != cb) { cb = b; const float* mv = (const float*)(a.ws() + WS_MOD) + (size_t)b * INCOLS; ld4(shift, mv, F.lane); ld4(scale, mv + 1024, F.lane); }
        const float r = 1.0f / sqrtf(wave_sum(sumsq4(x), F.lane) * (1.0f / 1024.0f) + EPS);
        bf16* ho = (bf16*)(a.ws() + WS_H) + (size_t)m * DM; unsigned char* h8 = a.ws() + WS_H8 + (size_t)m * DM;
#pragma unroll
        for (int j = 0; j < 4; ++j) { const f32x4 hv = x[j] * r * gpre[j] * (scale[j] + 1.0f) + shift[j]; ((GAS u32x2*)ho)[F.lane + 64 * j] = pk4(hv); ((GAS unsigned*)h8)[F.lane + 64 * j] = pk4_fp8(hv); }
    }
}
__device__ __forceinline__ void qk_fix_core(f32x4 (&x)[4], const f32x4 (&gg)[4], const f32x2* tab, bool rope, int t, int sub, int lane) {
    float ss = sumsq4(x); ss += shx(ss, 1, lane); ss += shx(ss, 2, lane); ss += shx(ss, 4, lane);
    const float r = 1.0f / sqrtf(ss * (1.0f / 128.0f) + EPS);
#pragma unroll
    for (int jj = 0; jj < 4; ++jj) x[jj] = x[jj] * r * gg[jj];
    if (rope) { const int pr = t >> 6, pc = t & 63;
#pragma unroll
        for (int i = 0; i < 4; ++i) { const f32x2 cr = tab[pr * 32 + sub * 4 + i], cc = tab[pc * 32 + sub * 4 + i];
            const float a0 = x[0][i], a1 = x[1][i], b0 = x[2][i], b1 = x[3][i];
            x[0][i] = a0 * cr.x - a1 * cr.y; x[1][i] = a1 * cr.x + a0 * cr.y; x[2][i] = b0 * cc.x - b1 * cc.y; x[3][i] = b1 * cc.x + b0 * cc.y; } }
}
__device__ __forceinline__ void p_qkfix(const Frame& F, const AV& a, int l, int M) {
    const int gw = F.vcu * NWAVES + F.wave, NGW = F.G * NWAVES, rpw = 4 * ((M + 4 * NGW - 1) / (4 * NGW)), r0 = gw * rpw, r1 = (r0 + rpw < M) ? r0 + rpw : M;
    if (r0 >= r1) return;
    const f32x2* tab = (const f32x2*)(a.ws() + WS_TAB); const int rs = F.lane >> 4, hh = (F.lane >> 3) & 1, sub = F.lane & 7;
    f32x4 gk[4];
#pragma unroll
    for (int jj = 0; jj < 4; ++jj) gk[jj] = *(const GAS f32x4*)(a.in(12) + l * 128 + jj * 32 + sub * 4);
    bf16* kb = (bf16*)(a.ws() + WS_K);
    u32x2 kn[4];
    auto issue = [&](int mb) { const int m = mb + rs; if (m < r1) { const bf16* kp = kb + (size_t)krow_of(m) * 256 + hh * 128 + sub * 4;
#pragma unroll
        for (int jj = 0; jj < 4; ++jj) kn[jj] = *(const GAS u32x2*)(kp + jj * 32); } };
    issue(r0);
    for (int mb = r0; mb < r1; mb += 4) { const int m = mb + rs; const bool act = m < r1;
        f32x4 xk[4];
#pragma unroll
        for (int jj = 0; jj < 4; ++jj) xk[jj] = bf4(kn[jj]);
        if (mb + 4 < r1) issue(mb + 4);
        qk_fix_core(xk, gk, tab, m < TL, m & 2047, sub, F.lane);
        if (act) { bf16* kp = kb + (size_t)krow_of(m) * 256 + hh * 128 + sub * 4;
#pragma unroll
            for (int jj = 0; jj < 4; ++jj) *(GAS u32x2*)(kp + jj * 32) = pk4(xk[jj]); }
    }
}
__device__ __forceinline__ void p_conv(const Frame& F, const AV& a, int l, int njobs) {
    LAS unsigned char* lin = F.lds + RING_OFF; LAS float* lout = (LAS float*)(F.lds + RING_OFF + 62 * 1024);
    const bf16* cu = (const bf16*)(a.ws() + WS_CU); bf16* chb = (bf16*)(a.ws() + WS_CH);
    const int cp = F.tid & 255, pg = F.tid >> 8;
    f32x2 wv[31];
#pragma unroll
    for (int j = 0; j < 31; ++j) wv[j] = *(const GAS f32x2*)(a.in(14) + ((size_t)l * 31 + j) * 512 + 2 * cp);
    const f32x2 cb2 = *(const GAS f32x2*)(a.in(15) + l * 512 + 2 * cp);
    for (int job = F.vcu; job < njobs; job += F.G) {
        int rowbase, L, t0;
        if (job < 1024) { rowbase = (job >> 6) * SEQ; L = SEQ; t0 = (job & 63) * 32; } else { const int jc = job - 1024; rowbase = TL + (jc >> 3) * CTXL; L = CTXL; t0 = (jc & 7) * 32; }
        for (int idx = F.tid; idx < 62 * 64; idx += NTHR) { const int row = idx >> 6, ch = idx & 63, p = t0 - 15 + row; v4u val = (v4u){0u, 0u, 0u, 0u};
            if (p >= 0 && p < L) val = *(const GAS v4u*)(cu + (size_t)(rowbase + p) * 512 + ch * 8);
            *(LAS v4u*)(lin + row * 1024 + ch * 16) = val; }
        __syncthreads();
#pragma unroll
        for (int chunk = 0; chunk < 2; ++chunk) {
            f32x2 acc[8];
#pragma unroll
            for (int i = 0; i < 8; ++i) acc[i] = cb2;
            const int r0 = pg * 16 + chunk * 8;
#pragma unroll
            for (int r = 0; r < 38; ++r) { const unsigned w = *(const LAS unsigned*)(lin + (r0 + r) * 1024 + cp * 4); const float x0 = __uint_as_float(w << 16), x1 = __uint_as_float(w & 0xffff0000u);
#pragma unroll
                for (int i = 0; i < 8; ++i) { const int j = r - i; if (j >= 0 && j <= 30) { acc[i].x += x0 * wv[j].x; acc[i].y += x1 * wv[j].y; } } }
#pragma unroll
            for (int i = 0; i < 8; ++i) *(LAS f32x2*)(lout + (r0 + i) * 512 + 2 * cp) = acc[i];
        }
        __syncthreads();
#pragma unroll
        for (int pp = 0; pp < 4; ++pp) { const int p = F.wave * 4 + pp; const LAS float* src = lout + p * 512 + F.lane * 8;
            f32x4 y0 = *(const LAS f32x4*)src, y1 = *(const LAS f32x4*)(src + 4);
            const float mean = wave_sum((y0[0] + y0[1]) + (y0[2] + y0[3]) + (y1[0] + y1[1]) + (y1[2] + y1[3]), F.lane) * (1.0f / 512.0f);
            y0 = y0 - mean; y1 = y1 - mean;
            const float var = wave_sum((y0[0] * y0[0] + y0[1] * y0[1]) + (y0[2] * y0[2] + y0[3] * y0[3]) + (y1[0] * y1[0] + y1[1] * y1[1]) + (y1[2] * y1[2] + y1[3] * y1[3]), F.lane) * (1.0f / 512.0f);
            const float rs = 1.0f / sqrtf(var + EPS);
            const f32x4 g0 = *(const GAS f32x4*)(a.in(16) + l * 512 + F.lane * 8), g1 = *(const GAS f32x4*)(a.in(16) + l * 512 + F.lane * 8 + 4);
            const f32x4 b0 = *(const GAS f32x4*)(a.in(17) + l * 512 + F.lane * 8), b1 = *(const GAS f32x4*)(a.in(17) + l * 512 + F.lane * 8 + 4);
            y0 = y0 * rs * g0 + b0; y1 = y1 * rs * g1 + b1;
#pragma unroll
            for (int q = 0; q < 4; ++q) { y0[q] = y0[q] * sigmoidf_(y0[q]); y1[q] = y1[q] * sigmoidf_(y1[q]); }
            v4u o; o.x = pk2(y0[0], y0[1]); o.y = pk2(y0[2], y0[3]); o.z = pk2(y1[0], y1[1]); o.w = pk2(y1[2], y1[3]);
            *(GAS v4u*)(chb + (size_t)(rowbase + t0 + p) * 512 + F.lane * 8) = o; }
        __syncthreads();
    }
}
__device__ __forceinline__ void p_rowpass1(const Frame& F, const AV& a, int l, int M) {
    const int gw = F.vcu * NWAVES + F.wave, NGW = F.G * NWAVES, rpw = (M + NGW - 1) / NGW, r0 = gw * rpw, r1 = (r0 + rpw < M) ? r0 + rpw : M;
    if (r0 >= r1) return;
    const float* modb = (const float*)(a.ws() + WS_MOD) + (size_t)l * 17 * INCOLS; const bf16* mixb = (const bf16*)(a.ws() + WS_MIX);
    f32x4 gpost[4], gpre[4], gate[4], shift[4], scale[4]; ld4(gpost, a.in(7) + l * DM, F.lane); ld4(gpre, a.in(8) + l * DM, F.lane);
    int cb = -1;
    auto xsrc = [&](int m) -> const float* { return (l == 0) ? (m < TL ? a.in(0) + (size_t)m * DM : a.in(2) + (size_t)(m - TL) * DM) : (m < TL ? a.out() + (size_t)m * DM : (const float*)(a.ws() + WS_XC) + (size_t)(m - TL) * DM); };
    f32x4 xn[4]; u32x2 mn[4]; ld4(xn, xsrc(r0), F.lane);
#pragma unroll
    for (int j = 0; j < 4; ++j) mn[j] = ((const GAS u32x2*)(mixb + (size_t)r0 * DM))[F.lane + 64 * j];
    for (int m = r0; m < r1; ++m) {
        f32x4 x[4], y[4];
#pragma unroll
        for (int j = 0; j < 4; ++j) { x[j] = xn[j]; y[j] = bf4(mn[j]); }
        if (m + 1 < r1) { ld4(xn, xsrc(m + 1), F.lane);
#pragma unroll
            for (int j = 0; j < 4; ++j) mn[j] = ((const GAS u32x2*)(mixb + (size_t)(m + 1) * DM))[F.lane + 64 * j]; }
        const int b = m < TL ? (m >> 11) : 16;
        if (b != cb) { cb = b; const float* mv = modb + (size_t)b * INCOLS; ld4(gate, mv + 2 * 1024, F.lane); ld4(shift, mv + 3 * 1024, F.lane); ld4(scale, mv + 4 * 1024, F.lane); }
        const float r = 1.0f / sqrtf(wave_sum(sumsq4(y), F.lane) * (1.0f / 1024.0f) + EPS);
#pragma unroll
        for (int j = 0; j < 4; ++j) x[j] = x[j] + gate[j] * (y[j] * r * gpost[j]);
        float* xd = m < TL ? a.out() + (size_t)m * DM : (float*)(a.ws() + WS_XC) + (size_t)(m - TL) * DM;
        st_row_f32(x, xd, F.lane);
        const float r2 = 1.0f / sqrtf(wave_sum(sumsq4(x), F.lane) * (1.0f / 1024.0f) + EPS);
        bf16* ho = (bf16*)(a.ws() + WS_H) + (size_t)m * DM;
#pragma unroll
        for (int j = 0; j < 4; ++j) ((GAS u32x2*)ho)[F.lane + 64 * j] = pk4(x[j] * r2 * gpre[j] * (scale[j] + 1.0f) + shift[j]);
    }
}
__device__ __forceinline__ void p_route(const Frame& F, const AV& a, int l, int M) {
    typedef short bfx8 __attribute__((ext_vector_type(8)));
    const int NGW = F.G * NWAVES, rpw = (M + NGW - 1) / NGW, TPB = 8 * rpw, b0 = F.vcu * TPB, b1 = (b0 + TPB < M) ? b0 + TPB : M;
    LAS unsigned char* tabl = F.lds + RING_OFF; LAS float* lg = (LAS float*)(F.lds + LDS_SM) + F.wave * 512; LAS int* cntl = (LAS int*)(F.lds + LDS_SM + 16384);
    VM_WAIT(); __syncthreads();
    if (F.tid < 32) cntl[F.tid] = 0;
    { const GAS v4u* src = (const GAS v4u*)(a.ws() + WS_WSMALL + (size_t)l * WSMALL_LAYER + OFFS_ROUT);
      for (int idx = F.tid; idx < 64 * 128; idx += NTHR) { const int row = idx >> 7, c = idx & 127; *(LAS v4u*)(tabl + row * 2048 + ((c ^ (row & 7)) << 4)) = src[idx]; } }
    __syncthreads();
    const bf16* H = (const bf16*)(a.ws() + WS_H); const float bias = a.in(22)[l * NEXP + (F.lane & 31)];
    const int ar = F.lane & 15, kb = F.lane >> 4, ng = (b1 > b0) ? (b1 - b0 + 15) >> 4 : 0;
    for (int g = F.wave; g < ng; g += NWAVES) {
        const int rb = b0 + g * 16; int row = rb + ar; if (row > M - 1) row = M - 1;
        const bf16* hp = H + (size_t)row * DM + kb * 8; f32x4 acc[4];
#pragma unroll
        for (int f = 0; f < 4; ++f) acc[f] = (f32x4){0.f, 0.f, 0.f, 0.f};
#pragma unroll 4
        for (int s = 0; s < 32; ++s) { const bfx8 af = *(const GAS bfx8*)(hp + s * 32);
#pragma unroll
            for (int f = 0; f < 4; ++f) { const int wr = f * 16 + ar; const bfx8 bfr = *(const LAS bfx8*)(tabl + wr * 2048 + (((4 * s + kb) ^ (wr & 7)) << 4));
                acc[f] = __builtin_amdgcn_mfma_f32_16x16x32_bf16(af, bfr, acc[f], 0, 0, 0); } }
#pragma unroll
        for (int i = 0; i < 4; ++i) { lg[(4 * kb + i) * 32 + ar] = acc[0][i] + acc[2][i]; lg[(4 * kb + i) * 32 + 16 + ar] = acc[1][i] + acc[3][i]; }
        LDS_WAIT(); asm volatile("" ::: "memory");
        { const int hf = F.lane >> 5, ex = F.lane & 31; LAS unsigned long long* kb64 = (LAS unsigned long long*)(F.lds + LDS_SM + 16384 + 256) + F.wave * 64;
          LAS float* selv = (LAS float*)(F.lds + LDS_SM + 16384 + 256 + 4096) + F.wave * 16; LAS int* seli = (LAS int*)(selv + 8);
#pragma unroll 1
          for (int p = 0; p < 8; ++p) { const int r = 2 * p + hf, m = rb + r; const bool valid = m < b1;
            const float v = lg[r * 32 + ex] + bias; unsigned ub = __float_as_uint(v); ub = (ub & 0x80000000u) ? ~ub : (ub | 0x80000000u);
            const unsigned long long K = ((unsigned long long)ub << 5) | (unsigned)(31 - ex);
            kb64[F.lane] = K;
            LDS_WAIT(); asm volatile("" ::: "memory");
            int rank = 0;
#pragma unroll
            for (int j = 0; j < 32; ++j) rank += (kb64[hf * 32 + j] > K) ? 1 : 0;
            if (rank < 4) { selv[hf * 4 + rank] = v; seli[hf * 4 + rank] = ex; if (valid) __hip_atomic_fetch_add(&cntl[ex], 1, __ATOMIC_RELAXED, __HIP_MEMORY_SCOPE_WORKGROUP); }
            LDS_WAIT(); asm volatile("" ::: "memory");
            if (ex == 0 && valid) { const f32x4 tv = *(const LAS f32x4*)(selv + hf * 4); const i32x4 ti = *(const LAS i32x4*)(seli + hf * 4);
                const float e1 = __expf(tv[1] - tv[0]), e2 = __expf(tv[2] - tv[0]), e3 = __expf(tv[3] - tv[0]), inv = 1.0f / (1.0f + e1 + e2 + e3);
                *(GAS i32x4*)((int*)(a.ws() + WS_TOPI) + (size_t)m * 4) = ti; *(GAS f32x4*)((float*)(a.ws() + WS_TOPP) + (size_t)m * 4) = (f32x4){inv, e1 * inv, e2 * inv, e3 * inv}; }
            LDS_WAIT(); asm volatile("" ::: "memory"); } }
        LDS_WAIT(); asm volatile("" ::: "memory");
    }
    __syncthreads();
    if (F.tid < 32) ((int*)(a.ws() + WS_CNT))[F.vcu * 32 + F.tid] = cntl[F.tid];
}
__device__ __forceinline__ void p_slots(const Frame& F, const AV& a, int M) {
    LAS int* sm = (LAS int*)(F.lds + LDS_SM);
    LAS int *tot = sm, *bef = sm + 32, *base = sm + 64, *tst = sm + 96  , *mask = sm + 160  , *ids = sm + 320  , *slot = sm + 960  ;
    const int* cnt = (const int*)(a.ws() + WS_CNT);
    { LAS int* ptot = sm + 1600; LAS int* pbef = sm + 2112; const int e = F.tid & 31, part = F.tid >> 5; int t = 0, b = 0;
#pragma unroll 4
      for (int q = part; q < F.G; q += 16) { const int c = cnt[q * 32 + e]; t += c; if (q < F.vcu) b += c; }
      ptot[part * 32 + e] = t; pbef[part * 32 + e] = b;
      __syncthreads();
      if (F.tid < 32) { int tt = 0, bb = 0;
#pragma unroll
          for (int q = 0; q < 16; ++q) { tt += ptot[q * 32 + F.tid]; bb += pbef[q * 32 + F.tid]; }
          tot[F.tid] = tt; bef[F.tid] = bb; } }
    __syncthreads();
    if (F.tid == 0) { int ts = 0; for (int e = 0; e < 32; ++e) { tst[e] = ts; base[e] = ts * 256 + bef[e]; ts += (tot[e] + 255) >> 8; } tst[32] = ts; }
    __syncthreads();
    const int NT = tst[32];
    if (blockIdx.x == 0) { int* te = (int*)(a.ws() + WS_CNT) + CNT_TILE_E;
        for (int t = F.tid; t < NT; t += NTHR) { int e = 0; for (int q = 1; q < 32; ++q) if (t >= tst[q]) e = q; te[t] = e; }
        if (F.tid == 0) ((int*)(a.ws() + WS_CNT))[CNT_NT] = NT; }
    const int TPB = 8 * ((M + F.G * NWAVES - 1) / (F.G * NWAVES)), m0 = F.vcu * TPB, m1 = (m0 + TPB < M) ? m0 + TPB : M, nt = m1 > m0 ? m1 - m0 : 0;
    for (int tl = F.tid; tl < nt; tl += NTHR) { const i32x4 id = *(const GAS i32x4*)((const int*)(a.ws() + WS_TOPI) + (size_t)(m0 + tl) * 4);
        ids[tl * 4 + 0] = id.x; ids[tl * 4 + 1] = id.y; ids[tl * 4 + 2] = id.z; ids[tl * 4 + 3] = id.w; mask[tl] = (1 << id.x) | (1 << id.y) | (1 << id.z) | (1 << id.w); }
    __syncthreads();
    for (int p = F.tid; p < nt * 4; p += NTHR) { const int tl = p >> 2, e = ids[p]; int rank = 0; for (int q = 0; q < tl; ++q) rank += (mask[q] >> e) & 1;
        const int s = base[e] + rank; slot[p] = s; ((int*)(a.ws() + WS_SLOT))[(size_t)(m0 + tl) * 4 + (p & 3)] = s; }
    __syncthreads();
    const bf16* h = (const bf16*)(a.ws() + WS_H); unsigned char* hs = a.ws() + WS_HS;
    { v4u xa, xb; if (F.wave < nt) { const GAS v4u* src = (const GAS v4u*)(h + (size_t)(m0 + F.wave) * DM); xa = src[F.lane]; xb = src[F.lane + 64]; }
      for (int tl = F.wave; tl < nt; tl += NWAVES) { const v4u x0 = xa, x1 = xb;
        if (tl + NWAVES < nt) { const GAS v4u* src = (const GAS v4u*)(h + (size_t)(m0 + tl + NWAVES) * DM); xa = src[F.lane]; xb = src[F.lane + 64]; }
        u32x2 o0, o1;
        o0.x = pg8::cvt4_fp8(__uint_as_float(x0.x << 16), __uint_as_float(x0.x & 0xffff0000u), __uint_as_float(x0.y << 16), __uint_as_float(x0.y & 0xffff0000u));
        o0.y = pg8::cvt4_fp8(__uint_as_float(x0.z << 16), __uint_as_float(x0.z & 0xffff0000u), __uint_as_float(x0.w << 16), __uint_as_float(x0.w & 0xffff0000u));
        o1.x = pg8::cvt4_fp8(__uint_as_float(x1.x << 16), __uint_as_float(x1.x & 0xffff0000u), __uint_as_float(x1.y << 16), __uint_as_float(x1.y & 0xffff0000u));
        o1.y = pg8::cvt4_fp8(__uint_as_float(x1.z << 16), __uint_as_float(x1.z & 0xffff0000u), __uint_as_float(x1.w << 16), __uint_as_float(x1.w & 0xffff0000u));
#pragma unroll
        for (int k = 0; k < 4; ++k) { GAS u32x2* dst = (GAS u32x2*)(hs + (size_t)slot[tl * 4 + k] * DM); dst[F.lane] = o0; dst[F.lane + 64] = o1; } } }
    if (blockIdx.x < 32) { const int e = blockIdx.x, r0 = tst[e] * 256 + tot[e], r1 = tst[e + 1] * 256;
        unsigned zz = 0u; asm volatile("" : "+v"(zz));
        for (int r = r0 + F.wave; r < r1; r += NWAVES) { GAS v4u* dst = (GAS v4u*)(hs + (size_t)r * DM); dst[F.lane] = (v4u){zz, zz, zz, zz}; } }
    __syncthreads();
}
__device__ __forceinline__ void p_combine(const Frame& F, const AV& a, int l, int M) {
    const int gw = F.vcu * NWAVES + F.wave, NGW = F.G * NWAVES, rpw = (M + NGW - 1) / NGW, r0 = gw * rpw, r1 = (r0 + rpw < M) ? r0 + rpw : M;
    if (r0 >= r1) return;
    const unsigned char* ys = a.ws() + WS_YS;   const int* slp = (const int*)(a.ws() + WS_SLOT); const float* prp = (const float*)(a.ws() + WS_TOPP);
    const float* modb = (const float*)(a.ws() + WS_MOD);
    f32x4 gpost[4], gpre[4], gate[4], shift[4], scale[4]; ld4(gpost, a.in(9) + l * DM, F.lane); if (l == 0) ld4(gpre, a.in(6) + DM, F.lane);
    int cb = -1;
    i32x4 sl_n = *(const GAS i32x4*)(slp + (size_t)r0 * 4); f32x4 pr_n = *(const GAS f32x4*)(prp + (size_t)r0 * 4);
    f32x4 xn[4]; unsigned yn[4][4]; f32x4 prc = pr_n * 0.125f;
    auto xrow = [&](int m) -> float* { return m < TL ? a.out() + (size_t)m * DM : (float*)(a.ws() + WS_XC) + (size_t)(m - TL) * DM; };
    { ld4(xn, xrow(r0), F.lane); const int sv[4] = {sl_n[0], sl_n[1], sl_n[2], sl_n[3]};
#pragma unroll
      for (int k = 0; k < 4; ++k)
#pragma unroll
          for (int j = 0; j < 4; ++j) yn[k][j] = ((const GAS unsigned*)(ys + (size_t)sv[k] * DM))[F.lane + 64 * j];
      if (r0 + 1 < r1) { sl_n = *(const GAS i32x4*)(slp + (size_t)(r0 + 1) * 4); pr_n = *(const GAS f32x4*)(prp + (size_t)(r0 + 1) * 4); } }
    for (int m = r0; m < r1; ++m) {
        f32x4 x[4], y[4];
#pragma unroll
        for (int j = 0; j < 4; ++j) { x[j] = xn[j]; y[j] = fp8x4(yn[0][j]) * prc[0] + fp8x4(yn[1][j]) * prc[1] + fp8x4(yn[2][j]) * prc[2] + fp8x4(yn[3][j]) * prc[3]; }
        if (m + 1 < r1) { prc = pr_n * 0.125f; ld4(xn, xrow(m + 1), F.lane); const int sv[4] = {sl_n[0], sl_n[1], sl_n[2], sl_n[3]};
#pragma unroll
            for (int k = 0; k < 4; ++k)
#pragma unroll
                for (int j = 0; j < 4; ++j) yn[k][j] = ((const GAS unsigned*)(ys + (size_t)sv[k] * DM))[F.lane + 64 * j];
            if (m + 2 < r1) { sl_n = *(const GAS i32x4*)(slp + (size_t)(m + 2) * 4); pr_n = *(const GAS f32x4*)(prp + (size_t)(m + 2) * 4); } }
        const int b = m < TL ? (m >> 11) : 16;
        if (b != cb) { cb = b; ld4(gate, modb + ((size_t)l * 17 + b) * INCOLS + 5 * 1024, F.lane); if (l == 0) { const float* m1 = modb + ((size_t)17 + b) * INCOLS; ld4(shift, m1, F.lane); ld4(scale, m1 + 1024, F.lane); } }
        const float r = 1.0f / sqrtf(wave_sum(sumsq4(y), F.lane) * (1.0f / 1024.0f) + EPS);
#pragma unroll
        for (int j = 0; j < 4; ++j) x[j] = x[j] + gate[j] * (y[j] * r * gpost[j]);
        st_row_f32(x, xrow(m), F.lane);
        if (l == 0) { const float r2 = 1.0f / sqrtf(wave_sum(sumsq4(x), F.lane) * (1.0f / 1024.0f) + EPS);
            bf16* ho = (bf16*)(a.ws() + WS_H) + (size_t)m * DM; unsigned char* h8 = a.ws() + WS_H8 + (size_t)m * DM;
#pragma unroll
            for (int j = 0; j < 4; ++j) { const f32x4 hv = x[j] * r2 * gpre[j] * (scale[j] + 1.0f) + shift[j]; ((GAS u32x2*)ho)[F.lane + 64 * j] = pk4(hv); ((GAS unsigned*)h8)[F.lane + 64 * j] = pk4_fp8(hv); } }
    }
}
#ifdef DBG_CHECK
#ifndef DBG_GSUB
#define DBG_GSUB 0
#endif
__device__ __forceinline__ double bfd(bf16 b) { return (double)__uint_as_float(((unsigned)b) << 16); }
__device__ __forceinline__ unsigned hsh(unsigned x) { x ^= x >> 16; x *= 0x7feb352du; x ^= x >> 15; x *= 0x846ca68bu; x ^= x >> 16; return x; }
__device__ __forceinline__ int samp_row(int i, int M, unsigned salt) { const int sp[12] = {0, 1, 255, 256, 2047, 2048, 4095, 32767, 32768, 32769, 33023, 36863}; if (i < 12 && sp[i] < M) return sp[i]; return (int)(hsh(i * 7919u + salt) % (unsigned)M); }
__device__ __forceinline__ void rec(float* res, int stage, double got, double want, double flo) { const double e = fabs(got - want) / (fabs(want) + flo); const float f = (e == e) ? (float)e : 1e30f; atomicMax((unsigned*)res + stage, __float_as_uint(f)); }
__device__ double dot_h_w(const bf16* hrow, const float* w, int ldw, int col) { double s = 0; for (int k = 0; k < 1024; ++k) s += bfd(hrow[k]) * (double)w[(size_t)k * ldw + col]; return s; }
__device__ double dsig(double x) { return 1.0 / (1.0 + exp(-x)); }
constexpr double PI_D = 3.14159265358979323846;
enum { ST_MOD = 0, ST_H0, ST_INPROJ, ST_YT, ST_QKFIX, ST_CONV, ST_Z, ST_ATTN, ST_GATES, ST_MERGED, ST_MIX, ST_ROW1, ST_LOGIT, ST_TOPK, ST_SLOTS, ST_ACT, ST_YSLOT, ST_COMB, ST_GATESB, ST_N };
__global__ void chk(Args A, int stage, int l, float* res, float* snap) {
    const int i = threadIdx.x; unsigned char* ws = A.ws; const int M = (l == 0) ? TALL : TL; const int rs = stage + 32 * l;
    const bf16* H = (const bf16*)(ws + WS_H); const float* win = A.in[10] + (size_t)l * DM * INCOLS; const float* modb = (const float*)(ws + WS_MOD);
    if (stage == ST_MOD) { const int ll = i & 1, b = (i >> 1) % 17, n = (int)(hsh(i) % 6144u); double s = 0; for (int k = 0; k < 1024; ++k) { const double cv = b < 16 ? A.in[1][b * 1024 + k] : A.in[3][k]; s += cv * dsig(cv) * (double)A.in[4][((size_t)ll * 1024 + k) * 6144 + n]; }
        s += A.in[5][ll * 6144 + n]; rec(res, rs, modb[((size_t)ll * 17 + b) * 6144 + n], s, 0.02); }
    else if (stage == ST_H0) { const int m = samp_row(i, TALL, 1), c = (int)(hsh(i + 77) % 1024u); const float* x = m < TL ? A.in[0] + (size_t)m * DM : A.in[2] + (size_t)(m - TL) * DM; double ss = 0; for (int k = 0; k < 1024; ++k) ss += (double)x[k] * x[k];
        const float* mv = modb + (size_t)(m < TL ? (m >> 11) : 16) * 6144; const double want = x[c] / sqrt(ss / 1024 + 1e-6) * A.in[6][c] * (1.0 + mv[1024 + c]) + mv[c]; rec(res, rs, bfd(H[(size_t)m * DM + c]), want, 0.05); }
    else if (stage == ST_INPROJ) { const int m = samp_row(i, TALL, 2), kind = i & 3; const bf16* hr = H + (size_t)m * DM;
        if (kind == 0) { const int n = (int)(hsh(i + 5) % 1024u); rec(res, rs, bfd(((const bf16*)(ws + WS_Q))[(size_t)m * DM + n]), dot_h_w(hr, win, INCOLS, n), 0.05); }
        else if (kind == 1) { const int n = (int)(hsh(i + 6) % 256u); rec(res, rs, bfd(((const bf16*)(ws + WS_K))[(size_t)krow_of(m) * 256 + n]), dot_h_w(hr, win, INCOLS, 1024 + n), 0.05); }
        else if (kind == 2) { const int n = (int)(hsh(i + 7) % 256u); rec(res, rs, bfd(((const bf16*)(ws + WS_V))[(size_t)krow_of(m) * 256 + n]), dot_h_w(hr, win, INCOLS, 1280 + n), 0.05); }
        else { const int c = (int)(hsh(i + 8) % 512u); if (l == 0 || m < TL) { const double a = dot_h_w(hr, win, INCOLS, 1536 + c), g = dot_h_w(hr, win, INCOLS, 2048 + c); rec(res, rs, bfd(((const bf16*)(ws + WS_CU))[(size_t)m * 512 + c]), a * dsig(g), 0.05); } } }
    else if (stage == ST_YT) { const int m = samp_row(i, M, 3), ch = (int)(hsh(i + 9) % 512u), cs = i & 1, g = ch >> 7, k2 = ch & 127; const bf16* hr = H + (size_t)m * DM; double s = 0;
        for (int k = 0; k < 1024; ++k) { double t = 0; for (int n2 = 0; n2 < 128; ++n2) { const double ang = 2.0 * PI_D * ((n2 * k2) & 127) / 128.0; t += (double)win[(size_t)k * INCOLS + OFF_FNET + g * 128 + n2] * (cs ? sin(ang) : cos(ang)); } s += bfd(hr[k]) * t; }
        s /= sqrt(128.0); double got; if (m < TL) got = bfd(((const bf16*)(ws + WS_YT))[((size_t)(m >> 11) * 512 + ch) * 4096 + cs * 2048 + (m & 2047)]); else got = bfd(((const bf16*)(ws + WS_YTC))[((size_t)((m - TL) >> 8) * 512 + ch) * 512 + cs * 256 + ((m - TL) & 255)]);
        rec(res, rs, got, s, 0.05); }
    else if (stage == ST_QKFIX) { const int m = samp_row(i, TALL, 4), isk = i & 1, hh = isk ? (int)(hsh(i + 3) % 2u) : (int)(hsh(i + 3) % 8u), d = (int)(hsh(i + 4) % 128u); const bf16* hr = H + (size_t)m * DM;
        if (isk || l == 0 || m < TL) { const int cbase = isk ? 1024 + hh * 128 : hh * 128; double ss = 0, xd = 0, xp = 0; const int half = d & 64, dd = d & 63, pd = half + ((dd + 32) & 63);
            for (int q = 0; q < 128; ++q) { double v = dot_h_w(hr, win, INCOLS, cbase + q); v = bfd((bf16)f2bf((float)v)); ss += v * v; if (q == d) xd = v; if (q == pd) xp = v; }
            const float* gn = (isk ? A.in[12] : A.in[11]) + l * 128; const double r = 1.0 / sqrt(ss / 128 + 1e-6); xd *= r * gn[d]; xp *= r * gn[pd]; double want = xd;
            if (m < TL) { const int t = m & 2047, pos = half ? (t & 63) : (t >> 6), f = dd & 31; const double ang = (double)((float)pos * powf(10000.0f, -(float)f / 32.0f)); want = (dd < 32) ? xd * cos(ang) - xp * sin(ang) : xd * cos(ang) + xp * sin(ang); }
            const double got = isk ? bfd(((const bf16*)(ws + WS_K))[(size_t)krow_of(m) * 256 + hh * 128 + d]) : bfd(((const bf16*)(ws + WS_Q))[(size_t)m * DM + hh * 128 + d]); rec(res, rs, got, want, 0.05); } }
    else if (stage == ST_CONV) { const int m = samp_row(i, M, 5), c = (int)(hsh(i + 11) % 512u); const int rowbase = m < TL ? (m >> 11) * SEQ : TL + ((m - TL) >> 8) * CTXL, L = m < TL ? SEQ : CTXL, t = m - rowbase; const bf16* cu = (const bf16*)(ws + WS_CU);
        double s1 = 0, s2 = 0, yc = 0; for (int cc = 0; cc < 512; ++cc) { double y = A.in[15][l * 512 + cc]; for (int j = 0; j < 31; ++j) { const int p = t + j - 15; if (p >= 0 && p < L) y += bfd(cu[(size_t)(rowbase + p) * 512 + cc]) * (double)A.in[14][((size_t)l * 31 + j) * 512 + cc]; } s1 += y; s2 += y * y; if (cc == c) yc = y; }
        const double mean = s1 / 512, var = s2 / 512 - mean * mean; double y = (yc - mean) / sqrt(var + 1e-6) * A.in[16][l * 512 + c] + A.in[17][l * 512 + c]; y = y * dsig(y); rec(res, rs, bfd(((const bf16*)(ws + WS_CH))[(size_t)m * 512 + c]), y, 0.05); }
    else if (stage == ST_Z) { const int m = samp_row(i, M, 6), ch = (int)(hsh(i + 12) % 512u); double s = 0;
        if (m < TL) { const int b = m >> 11, k1 = m & 2047; const bf16* yr = (const bf16*)(ws + WS_YT) + ((size_t)b * 512 + ch) * 4096; for (int n1 = 0; n1 < 2048; ++n1) { const double ang = 2.0 * PI_D * ((k1 * n1) & 2047) / 2048.0; s += cos(ang) * bfd(yr[n1]) - sin(ang) * bfd(yr[2048 + n1]); } s /= sqrt(2048.0); }
        else { const int b = (m - TL) >> 8, k1 = (m - TL) & 255; const bf16* yr = (const bf16*)(ws + WS_YTC) + ((size_t)b * 512 + ch) * 512; for (int n1 = 0; n1 < 256; ++n1) { const double ang = 2.0 * PI_D * ((k1 * n1) & 255) / 256.0; s += cos(ang) * bfd(yr[n1]) - sin(ang) * bfd(yr[256 + n1]); } s /= 16.0; }
        rec(res, rs, bfd(((const bf16*)(ws + WS_Z))[(size_t)m * 512 + ch]), s, 0.05); }
    else if (stage == ST_ATTN) { const int m = samp_row(i, M, 7), hh = (int)(hsh(i + 13) % 8u), d = (int)(hsh(i + 14) % 128u); const bf16* q = (const bf16*)(ws + WS_Q) + (size_t)m * DM + hh * 128;
        int kr0, nk; if (m < TL) { kr0 = (m >> 11) * KVROWS; nk = KVROWS; } else { kr0 = ((m - TL) >> 8) * KVROWS + SEQ; nk = CTXL; }
        const bf16* K = (const bf16*)(ws + WS_K) + (size_t)kr0 * 256 + (hh >> 2) * 128; const bf16* V = (const bf16*)(ws + WS_V) + (size_t)kr0 * 256 + (hh >> 2) * 128;
        double mx = -1e300; for (int j = 0; j < nk; ++j) { double s = 0; for (int q2 = 0; q2 < 128; ++q2) s += bfd(q[q2]) * bfd(K[(size_t)j * 256 + q2]); s *= 0.08838834764831845; if (s > mx) mx = s; }
        double den = 0, num = 0; for (int j = 0; j < nk; ++j) { double s = 0; for (int q2 = 0; q2 < 128; ++q2) s += bfd(q[q2]) * bfd(K[(size_t)j * 256 + q2]); s *= 0.08838834764831845; const double p = exp(s - mx); den += p; num += p * bfd(V[(size_t)j * 256 + d]); }
        rec(res, rs, bfd(((const bf16*)(ws + WS_AO))[(size_t)m * DM + hh * 128 + d]), num / den, 0.03); }
    else if (stage == ST_GATES) { const int m = samp_row(i, M, 8), n = (int)(hsh(i + 15) % 3072u); rec(res, rs, bfd(((const bf16*)(ws + WS_GATES))[(size_t)m * 3072 + n]), dsig(dot_h_w(H + (size_t)m * DM, win, INCOLS, OFF_GATE + n)), 0.05); }
    else if (stage == ST_GATESB && DBG_GSUB == 1) { const int m = samp_row(i, M, 8), n = (int)(hsh(i + 15) % 3072u); const double got = bfd(((const bf16*)(ws + WS_GATES))[(size_t)m * 3072 + n]), want = dsig(dot_h_w(H + (size_t)m * DM, win, INCOLS, OFF_GATE + n));
        const bool badv = !(fabs(got - want) <= 0.05); if (badv) { unsigned* r = (unsigned*)res + 48; atomicOr(r, (m < TL ? 1u : 2u) | (4u << (n >> 10)) | (i < 12 ? 32u : 0u)); } }
    else if (stage == ST_GATESB) { const int m = samp_row(i, M, 8), n = (int)(hsh(i + 15) % 3072u); const bf16* wt = (const bf16*)(ws + WS_WSMALL + (size_t)l * WSMALL_LAYER + OFFS_WG) + (size_t)n * 1024; const bf16* hr = H + (size_t)m * DM; double s = 0; for (int k = 0; k < 1024; ++k) s += bfd(hr[k]) * bfd(wt[k]);
        rec(res, rs, bfd(((const bf16*)(ws + WS_GATES))[(size_t)m * 3072 + n]), dsig(s), 0.05); }
    else if (stage == ST_MERGED) { const int m = samp_row(i, M, 9), c = (int)(hsh(i + 16) % 1024u); const bf16* g = (const bf16*)(ws + WS_GATES) + (size_t)m * 3072; double y0 = 0, y1 = 0, y2 = 0;
        const bf16* ao = (const bf16*)(ws + WS_AO) + (size_t)m * DM; const bf16* chh = (const bf16*)(ws + WS_CH) + (size_t)m * 512; const bf16* z = (const bf16*)(ws + WS_Z) + (size_t)m * 512;
        for (int k = 0; k < 1024; ++k) y0 += bfd(ao[k]) * (double)A.in[13][((size_t)l * 1024 + k) * 1024 + c];
        for (int k = 0; k < 512; ++k) { y1 += bfd(chh[k]) * (double)A.in[18][((size_t)l * 512 + k) * 1024 + c]; y2 += bfd(z[k]) * (double)A.in[19][((size_t)l * 512 + k) * 1024 + c]; }
        rec(res, rs, bfd(((const bf16*)(ws + WS_MERGED))[(size_t)m * DM + c]), bfd(g[c]) * y0 + bfd(g[1024 + c]) * y1 + bfd(g[2048 + c]) * y2, 0.05); }
    else if (stage == ST_MIX) { const int m = samp_row(i, M, 10), c = (int)(hsh(i + 17) % 1024u); rec(res, rs, bfd(((const bf16*)(ws + WS_MIX))[(size_t)m * DM + c]), dot_h_w((const bf16*)(ws + WS_MERGED) + (size_t)m * DM, A.in[20] + (size_t)l * DM * DM, DM, c), 0.05); }
    else if (stage == ST_ROW1) { const int m = samp_row(i, M, 11), c = (int)(hsh(i + 18) % 1024u); const float* xs = snap + (size_t)i * 1024;
        const bf16* mix = (const bf16*)(ws + WS_MIX) + (size_t)m * DM; const float* mv = modb + ((size_t)l * 17 + (m < TL ? (m >> 11) : 16)) * 6144; double ss = 0; for (int k = 0; k < 1024; ++k) ss += bfd(mix[k]) * bfd(mix[k]); const double r = 1.0 / sqrt(ss / 1024 + 1e-6);
        double s2 = 0, xc = 0; for (int k = 0; k < 1024; ++k) { const double xn = xs[k] + mv[2048 + k] * (bfd(mix[k]) * r * A.in[7][l * DM + k]); s2 += xn * xn; if (k == c) xc = xn; }
        const float* xd = m < TL ? A.out + (size_t)m * DM : (const float*)(ws + WS_XC) + (size_t)(m - TL) * DM; rec(res, rs, xd[c], xc, 0.02);
        rec(res, rs, bfd(H[(size_t)m * DM + c]), xc / sqrt(s2 / 1024 + 1e-6) * A.in[8][l * DM + c] * (1.0 + mv[4096 + c]) + mv[3072 + c], 0.05); }
    else if (stage == ST_LOGIT) { const int m = samp_row(i, M, 12), e = i & 31; const float* lg = (const float*)(ws + WS_LOGIT) + (size_t)m * 64; rec(res, rs, (double)lg[e] + lg[32 + e], dot_h_w(H + (size_t)m * DM, A.in[21] + (size_t)l * DM * NEXP, NEXP, e), 0.02); }
    else if (stage == ST_TOPK) { const int m = samp_row(i, M, 13); const float* lg = (const float*)(ws + WS_LOGIT) + (size_t)m * 64; float v[32]; for (int e = 0; e < 32; ++e) v[e] = lg[e] + lg[32 + e] + A.in[22][l * 32 + e];
        int id[4]; float tv[4]; for (int k = 0; k < 4; ++k) { int b = -1; for (int e = 0; e < 32; ++e) { bool used = false; for (int q = 0; q < k; ++q) used |= (id[q] == e); if (!used && (b < 0 || v[e] > v[b])) b = e; } id[k] = b; tv[k] = v[b]; }
        double den = 0; for (int k = 0; k < 4; ++k) den += exp((double)tv[k] - tv[0]); const int* gi = (const int*)(ws + WS_TOPI) + (size_t)m * 4; const float* gp = (const float*)(ws + WS_TOPP) + (size_t)m * 4;
        for (int k = 0; k < 4; ++k) { rec(res, rs, gi[k] == id[k] ? 0.0 : 1.0, 0, 0.01); rec(res, rs, gp[k], exp((double)tv[k] - tv[0]) / den, 0.01); } }
    else if (stage == ST_SLOTS) { const int m = samp_row(i, M, 14), k = i & 3; const int s = ((const int*)(ws + WS_SLOT))[(size_t)m * 4 + k], e = ((const int*)(ws + WS_TOPI))[(size_t)m * 4 + k]; const int NT = ((const int*)(ws + WS_CNT))[CNT_NT];
        if (s < 0 || s >= NT * 256) rec(res, rs, 1, 0, 0.01); else { rec(res, rs, ((const int*)(ws + WS_CNT))[CNT_TILE_E + (s >> 8)] == e ? 0.0 : 1.0, 0, 0.01); const bf16* hs = (const bf16*)(ws + WS_HS) + (size_t)s * DM; double df = 0; for (int q = 0; q < 1024; ++q) df += fabs(bfd(hs[q]) - bfd(H[(size_t)m * DM + q])); rec(res, rs, df, 0, 1e-3); } }
    else if (stage == ST_ACT) { const int m = samp_row(i, M, 15), k = i & 3, c = (int)(hsh(i + 21) % 1024u); const int s = ((const int*)(ws + WS_SLOT))[(size_t)m * 4 + k], e = ((const int*)(ws + WS_TOPI))[(size_t)m * 4 + k]; const bf16* hs = (const bf16*)(ws + WS_HS) + (size_t)s * DM;
        double g = dot_h_w(hs, A.in[23] + (((size_t)l * NEXP + e) << 20), DM, c) + A.in[24][((size_t)l * NEXP + e) * 1024 + c], u = dot_h_w(hs, A.in[25] + (((size_t)l * NEXP + e) << 20), DM, c) + A.in[26][((size_t)l * NEXP + e) * 1024 + c];
        g = g < 7.0 ? g : 7.0; u = u < -7.0 ? -7.0 : (u > 7.0 ? 7.0 : u); rec(res, rs, bfd(((const bf16*)(ws + WS_ACT))[(size_t)s * DM + c]), (u + 1.0) * (g * dsig(1.702 * g)), 0.05); }
    else if (stage == ST_YSLOT) { const int m = samp_row(i, M, 16), k = i & 3, c = (int)(hsh(i + 22) % 1024u); const int s = ((const int*)(ws + WS_SLOT))[(size_t)m * 4 + k], e = ((const int*)(ws + WS_TOPI))[(size_t)m * 4 + k];
        rec(res, rs, bfd(((const bf16*)(ws + WS_HS))[(size_t)s * DM + c]), dot_h_w((const bf16*)(ws + WS_ACT) + (size_t)s * DM, A.in[27] + (((size_t)l * NEXP + e) << 20), DM, c) + A.in[28][((size_t)l * NEXP + e) * 1024 + c], 0.05); }
    else if (stage == ST_COMB) { const int m = samp_row(i, M, 17), c = (int)(hsh(i + 23) % 1024u); const float* xs = snap + (size_t)i * 1024; const int* sl = (const int*)(ws + WS_SLOT) + (size_t)m * 4; const float* pr = (const float*)(ws + WS_TOPP) + (size_t)m * 4;
        const float* mv = modb + ((size_t)l * 17 + (m < TL ? (m >> 11) : 16)) * 6144; double ss = 0, yc = 0; for (int q = 0; q < 1024; ++q) { double y = 0; for (int k = 0; k < 4; ++k) y += (double)pr[k] * bfd(((const bf16*)(ws + WS_HS))[(size_t)sl[k] * DM + q]); ss += y * y; if (q == c) yc = y; }
        const double want = xs[c] + mv[5 * 1024 + c] * (yc / sqrt(ss / 1024 + 1e-6) * A.in[9][l * DM + c]); const float* xd = m < TL ? A.out + (size_t)m * DM : (const float*)(ws + WS_XC) + (size_t)(m - TL) * DM; rec(res, rs, xd[c], want, 0.02); }
}
__global__ void snap_rows(Args A, int l, int salt, float* snap) {
    const int i = blockIdx.x, M = (l == 0) ? TALL : TL, m = samp_row(i, M, salt); const float* xs;
    if (l == 0 && salt == 11) xs = m < TL ? A.in[0] + (size_t)m * DM : A.in[2] + (size_t)(m - TL) * DM; else xs = m < TL ? A.out + (size_t)m * DM : (const float*)(A.ws + WS_XC) + (size_t)(m - TL) * DM;
    for (int k = threadIdx.x; k < 1024; k += blockDim.x) snap[(size_t)i * 1024 + k] = xs[k];
}
__global__ void chk_gates_full(const bf16* H, const bf16* Wt, const bf16* G, int M, unsigned* cntw) {
    const int n = blockIdx.x * 64 + (threadIdx.x & 63), m = blockIdx.y * 4 + (threadIdx.x >> 6); if (m >= M) return;
    const uint4* a = (const uint4*)(H + (size_t)m * 1024); const uint4* b = (const uint4*)(Wt + (size_t)n * 1024); float s = 0.f;
    for (int k = 0; k < 128; ++k) { const uint4 x = a[k], y = b[k]; const unsigned xs[4] = {x.x, x.y, x.z, x.w}, ys[4] = {y.x, y.y, y.z, y.w};
        for (int q = 0; q < 4; ++q) { s += __uint_as_float(xs[q] << 16) * __uint_as_float(ys[q] << 16); s += __uint_as_float(xs[q] & 0xffff0000u) * __uint_as_float(ys[q] & 0xffff0000u); } }
    const float want = 1.0f / (1.0f + __expf(-s)), got = __uint_as_float(((unsigned)G[(size_t)m * 3072 + n]) << 16);
    if (!(fabsf(got - want) <= 0.02f)) { atomicAdd(cntw, 1u); cntw[16 + (m >> 8) * 12 + (n >> 8)] = 1u; }
}
__global__ void encode_full(float* out, const unsigned* cntw, int n) {
    __shared__ int bc, bt; if (threadIdx.x == 0) { unsigned C = cntw[0], T = 0; for (int t = 0; t < 1728; ++t) T += cntw[16 + t]; int b1 = 0; while (C) { ++b1; C /= 10; } int b2 = 0; while (T) { ++b2; T /= 4; } bc = b1 > 7 ? 7 : b1; bt = b2 > 7 ? 7 : b2; }
    __syncthreads(); const float K = ldexpf(1.0f, 2 + 8 * bt + bc);
    for (size_t i = (size_t)blockIdx.x * blockDim.x + threadIdx.x; i < (size_t)n; i += (size_t)gridDim.x * blockDim.x) out[i] = K;
}
__global__ void encode(float* out, const float* res, int n, float thr) {
    #if DBG_GSUB == 1
    { const unsigned mk = ((const unsigned*)res)[48]; const float K = ldexpf(1.0f, 2 + (int)mk); for (size_t i = (size_t)blockIdx.x * blockDim.x + threadIdx.x; i < (size_t)n; i += (size_t)gridDim.x * blockDim.x) out[i] = K; return; }
#endif
#ifndef CHK_SKIP
#define CHK_SKIP 0ull
#endif
    int bad = -1; for (int s = 0; s < 64; ++s) if (!((CHK_SKIP >> s) & 1ull) && res[s] > thr) { bad = s; break; }
    if (bad < 0) return; const float er = res[bad]; const float K = ldexpf(1.0f, bad + 2) * (er < 0.5f ? 1.0f : er < 1.0f ? 1.25f : er < 4.0f ? 1.5f : 1.75f);
    for (size_t i = (size_t)blockIdx.x * blockDim.x + threadIdx.x; i < (size_t)n; i += (size_t)gridDim.x * blockDim.x) out[i] = K;
}
#endif
#ifndef GP_SP2
#define GP_SP2 true
#endif
#ifndef GP_ALIGN
#define GP_ALIGN true
#endif
__global__ void __launch_bounds__(NTHR, 2) fwd(Args args) {
    extern __shared__ __attribute__((aligned(16))) unsigned char lds[];
    Frame F;
    F.lds = (LAS unsigned char*)lds; F.MISC = (volatile LAS unsigned*)(F.lds + MISC_OFF);
    F.tid = threadIdx.x; F.lane = F.tid & 63; F.wave = __builtin_amdgcn_readfirstlane(F.tid >> 6);
    F.G = gridDim.x; { const int bx = blockIdx.x; F.vcu = (F.G % 8 == 0) ? (bx % 8) * (F.G / 8) + bx / 8 : bx; }
    { const AV A0 = av_get(); F.ctl = (gu32*)(A0.ws() + WS_CTL); }
    for (int u = F.tid; u < (LDS_BYTES - LDSCTL_OFF) / 4; u += NTHR) ((LAS unsigned*)(F.lds + LDSCTL_OFF))[u] = 0u;
    __syncthreads();
    XcdBarrier bar; bar.bar = (unsigned*)(F.ctl + CW_BAR); bar.x = 0; bar.st = nullptr;
    if (!MK_PER_PHASE) bar = xcd_barrier_post((unsigned*)(F.ctl + CW_BAR), F.MISC + 8);
    int lo, hi; { const AV A0 = av_get(); lo = *(const int __attribute__((address_space(4)))*)(A0.kp + 8 * 31); hi = *(const int __attribute__((address_space(4)))*)(A0.kp + 8 * 31 + 4); }
#ifndef DIS_MASK
#define DIS_MASK 0ull
#endif
#define IN(k) (lo <= (k) && (k) < hi)
#define ON(j) (!((DIS_MASK >> (j)) & 1ull))
#ifndef REP_MASK
#define REP_MASK 0ull
#endif
#define REPS(j) ((int)((REP_MASK >> (j)) & 1ull))
#ifdef STAMP_SEL
#define SEAM(k) do { xcd_barrier(bar); if (blockIdx.x == 0 && threadIdx.x == 0) ((unsigned long long*)(F.ctl + 32768))[(k) + 1] = __builtin_amdgcn_s_memrealtime(); } while (0)
#else
#ifdef DOUBLE_BAR
#define SEAM(k) do { if (!MK_PER_PHASE && IN((k) + 1)) { xcd_barrier(bar); xcd_barrier(bar); } } while (0)
#else
#define SEAM(k) do { if (!MK_PER_PHASE && IN((k) + 1)) xcd_barrier(bar); } while (0)
#endif
#endif
    const int bx = (int)blockIdx.x;
    const int wave0 = __builtin_amdgcn_readfirstlane((int)threadIdx.x >> 6);
#define F_REFRESH() do { unsigned z_ = 0u; asm volatile("" : "+v"(z_)); const int t_ = wave0 * 64 + (int)__builtin_amdgcn_mbcnt_hi(~0u, __builtin_amdgcn_mbcnt_lo(~0u, z_)); F.tid = t_; F.lane = t_ & 63; F.wave = wave0; } while (0)

#ifdef STAMP_SEL
    if (blockIdx.x == 0 && threadIdx.x == 0) ((unsigned long long*)(F.ctl + 32768))[0] = __builtin_amdgcn_s_memrealtime();
#endif
    if (ON(0) && IN(0)) for (int rep_ = 0; rep_ <= REPS(0); ++rep_) { F_REFRESH(); const AV A = av_get(); p0_prologue(F, A); SEAM(0); }
    if (ON(1) && IN(1)) for (int rep_ = 0; rep_ <= REPS(1); ++rep_) { F_REFRESH(); const AV A = av_get(); p1_norm0(F, A); SEAM(1); }

    for (int l = 0; l < 2; ++l) {
        const int pb = 2 + l * NPL;
        const int Mm = (l == 0) ? TALL : TL;
#define PH_BEGIN F_REFRESH(); const AV A = av_get(); unsigned char* const ws = A.ws(); unsigned char* const wl = ws + WS_WSMALL + (size_t)l * WSMALL_LAYER; (void)wl
        if (ON(2 + 0) && IN(pb + 0)) for (int rep_ = 0; rep_ <= REPS(2 + 0); ++rep_) { PH_BEGIN;
            if (ON(16)) { pg8::Gemm g{(const bf16*)(ws + WS_H8), (const bf16*)(wl + OFFS_WIN), TALL, 2560, DM / 2}; pg8::StaticOrder S; S.init(TALL, 2560, F.G, bx);
              pg8::EpiInproj E{(bf16*)(ws + WS_Q), (bf16*)(ws + WS_K), (bf16*)(ws + WS_V), (bf16*)(ws + WS_CU)};
              pg8::gemm_phase<pg8::EpiInproj, pg8::StaticOrder, GP_ALIGN, GP_SP2, true>(F.lds + RING_OFF, g, S, E, F.tid); }
            if (ON(17)) { pg8::Gemm g{(const bf16*)(wl + OFFS_WF), (const bf16*)(ws + WS_H), 1024, Mm, DM}; pg8::StaticOrder S; S.init(1024, Mm, F.G, (bx + 96) % F.G);
              pg8::EpiYT E{ws + WS_YT, ws + WS_YTC};
              pg8::gemm_phase<pg8::EpiYT, pg8::StaticOrder, GP_ALIGN, GP_SP2>(F.lds + RING_OFF, g, S, E, F.tid); }
            SEAM(pb + 0);
        }
        if (ON(2 + 1) && IN(pb + 1)) for (int rep_ = 0; rep_ <= REPS(2 + 1); ++rep_) { PH_BEGIN;
            if (ON(18)) p_qkfix(F, A, l, TALL);
            F_REFRESH();
            if (ON(19)) p_conv(F, A, l, l == 0 ? 1152 : 1024);
            if (ON(20)) { pg8::Gemm g{(const bf16*)(ws + WS_DFTL), (const bf16*)(ws + WS_YT), 2048, NB * 512, 2048}; pg8::DftOrder S; S.init(3, NB, F.G, F.vcu);
              pg8::EpiDFT E{(bf16*)(ws + WS_Z), 0, SEQ};
              pg8::gemm_phase<pg8::EpiDFT, pg8::DftOrder, GP_ALIGN, GP_SP2, true>(F.lds + RING_OFF, g, S, E, F.tid); }
            if (ON(21) && l == 0) { pg8::Gemm g{(const bf16*)(ws + WS_DFTC), (const bf16*)(ws + WS_YTC), 256, NB * 512, 256}; pg8::DftOrder S; S.init(0, NB, F.G, F.vcu);
              pg8::EpiDFT E{(bf16*)(ws + WS_Z), TL, CTXL};
              pg8::gemm_phase<pg8::EpiDFT, pg8::DftOrder, GP_ALIGN, GP_SP2, true>(F.lds + RING_OFF, g, S, E, F.tid); }
            SEAM(pb + 1);
        }
        if (ON(2 + 2) && IN(pb + 2)) for (int rep_ = 0; rep_ <= REPS(2 + 2); ++rep_) { PH_BEGIN;
            const int nheavy = NB * 8 * 8, ntot = nheavy + (l == 0 ? NB * 8 : 0);
            for (int L = F.vcu; L < ntot; L += F.G) {
                int row0, krow, h, seq, t0;
                if (L < nheavy) { const int grp = L >> 5, s = L & 31, b = grp >> 1; h = (grp & 1) * 4 + (s >> 3); t0 = (s & 7) * 256; row0 = b * SEQ + t0; krow = b * KVROWS; seq = KVROWS; }
                else { const int Lc = L - nheavy, b = Lc >> 3; h = Lc & 7; row0 = TL + b * CTXL; krow = b * KVROWS + SEQ; seq = CTXL; t0 = 0; }
                const att::bf16* Qb = (const att::bf16*)(ws + WS_Q) + (size_t)row0 * DM + h * 128;
                const att::bf16* Kh = (const att::bf16*)(ws + WS_K) + (size_t)krow * 256 + (h >> 2) * 128;
                const att::bf16* Vh = (const att::bf16*)(ws + WS_V) + (size_t)krow * 256 + (h >> 2) * 128;
                unsigned char* Ob = ws + WS_AO + (size_t)row0 * DM + h * 128;
                att::attn_dense_body<att::bf16>(Qb, Kh, Vh, Ob, seq, (char*)lds + RING_OFF, F.tid, A.in(11) + l * 128, (const float*)(ws + WS_TAB), t0, L < nheavy);
                __syncthreads();
            }
            SEAM(pb + 2);
        }
        if (ON(2 + 3) && IN(pb + 3)) for (int rep_ = 0; rep_ <= REPS(2 + 3); ++rep_) { PH_BEGIN;
            pg8::Gemm g{(const bf16*)(ws + WS_H8), (const bf16*)(wl + OFFS_WG), Mm, 3072, DM / 2}; pg8::StaticOrder S; S.init(Mm, 3072, F.G, bx);
            pg8::EpiGates E{(bf16*)(ws + WS_GATES)};
            pg8::gemm_phase<pg8::EpiGates, pg8::StaticOrder, GP_ALIGN, GP_SP2, true>(F.lds + RING_OFF, g, S, E, F.tid);
            SEAM(pb + 3);
        }
        if (ON(2 + 4) && IN(pb + 4)) for (int rep_ = 0; rep_ <= REPS(2 + 4); ++rep_) { PH_BEGIN;
            { pg8::Gemm g{(const bf16*)(ws + WS_AO), (const bf16*)(wl + OFFS_WAO), Mm, 1024, 512}; pg8::StaticOrder S; S.init(Mm, 1024, F.G, bx);
              pg8::EpiMerge<true> E{(bf16*)(ws + WS_MERGED), (const bf16*)(ws + WS_GATES), 0, 1.0f / 512.0f};
              pg8::gemm_phase<pg8::EpiMerge<true>, pg8::StaticOrder, GP_ALIGN, GP_SP2, true>(F.lds + RING_OFF, g, S, E, F.tid); }
#pragma unroll 1
            for (int br = 1; br < 3; ++br) {
              pg8::Gemm g{(const bf16*)(ws + (br == 1 ? WS_CH : WS_Z)), (const bf16*)(wl + (br == 1 ? OFFS_WCO : OFFS_WFO)), Mm, 1024, 512}; pg8::StaticOrder S; S.init(Mm, 1024, F.G, bx);
              pg8::EpiMerge<false> E{(bf16*)(ws + WS_MERGED), (const bf16*)(ws + WS_GATES), br, 1.0f};
              pg8::gemm_phase<pg8::EpiMerge<false>, pg8::StaticOrder, GP_ALIGN, GP_SP2>(F.lds + RING_OFF, g, S, E, F.tid); }
            SEAM(pb + 4);
        }
        if (ON(2 + 5) && IN(pb + 5)) for (int rep_ = 0; rep_ <= REPS(2 + 5); ++rep_) { PH_BEGIN;
            pg8::Gemm g{(const bf16*)(ws + WS_MERGED), (const bf16*)(wl + OFFS_WOUT), Mm, 1024, 1024}; pg8::StaticOrder S; S.init(Mm, 1024, F.G, bx);
            pg8::EpiBf16<0> E{(bf16*)(ws + WS_MIX), 1024, nullptr, 0, 0, 1.0f};
            pg8::gemm_phase<pg8::EpiBf16<0>, pg8::StaticOrder, GP_ALIGN, GP_SP2>(F.lds + RING_OFF, g, S, E, F.tid);
            SEAM(pb + 5);
        }
        if (ON(2 + 6) && IN(pb + 6)) for (int rep_ = 0; rep_ <= REPS(2 + 6); ++rep_) { PH_BEGIN; p_rowpass1(F, A, l, Mm); p_route(F, A, l, Mm); SEAM(pb + 6); }
        if (ON(2 + 7) && IN(pb + 7)) for (int rep_ = 0; rep_ <= REPS(2 + 7); ++rep_) { PH_BEGIN; p_slots(F, A, Mm); SEAM(pb + 7); }
        if (ON(2 + 8) && IN(pb + 8)) for (int rep_ = 0; rep_ <= REPS(2 + 8); ++rep_) { PH_BEGIN;
            const int NT = __builtin_amdgcn_readfirstlane(((const int*)(ws + WS_CNT))[CNT_NT]);
            LAS int* te_lds = (LAS int*)(F.lds + LDS_SM);
            for (int i = F.tid; i < NT; i += NTHR) te_lds[i] = ((const int*)(ws + WS_CNT))[CNT_TILE_E + i];
            __syncthreads();
            pg8::Gemm g{(const bf16*)(ws + WS_HS), (const bf16*)(ws + WS_WGU + (size_t)l * MOEW_LAYER), NT * 256, NEXP * 2048, DM / 2}; pg8::GroupedOrder S; S.init(NT, 8, F.G, bx, te_lds);
            pg8::EpiSwiGLU8 E{ws + WS_ACT, A.in(24) + (size_t)l * NEXP * 1024, A.in(26) + (size_t)l * NEXP * 1024};
            pg8::gemm_phase<pg8::EpiSwiGLU8, pg8::GroupedOrder, GP_ALIGN, GP_SP2, true>(F.lds + RING_OFF, g, S, E, F.tid);
            SEAM(pb + 8);
        }
        if (ON(2 + 9) && IN(pb + 9)) for (int rep_ = 0; rep_ <= REPS(2 + 9); ++rep_) { PH_BEGIN;
            const int NT = __builtin_amdgcn_readfirstlane(((const int*)(ws + WS_CNT))[CNT_NT]);
            LAS int* te_lds = (LAS int*)(F.lds + LDS_SM);
            for (int i = F.tid; i < NT; i += NTHR) te_lds[i] = ((const int*)(ws + WS_CNT))[CNT_TILE_E + i];
            __syncthreads();
#ifdef STAGGER_US
            { const unsigned long long t0 = __builtin_amdgcn_s_memrealtime(), dl = (unsigned long long)((bx >> 3) & 3) * (STAGGER_US); while (__builtin_amdgcn_s_memrealtime() - t0 < dl) __builtin_amdgcn_s_sleep(8); }
#endif
            pg8::Gemm g{(const bf16*)(ws + WS_ACT), (const bf16*)(ws + WS_WD + (size_t)l * MOEW_LAYER), NT * 256, NEXP * 1024, DM / 2}; pg8::GroupedOrder S; S.init(NT, 4, F.G, bx, te_lds);
#ifdef PROBE_NOSTORE
            pg8::EpiDown8 E{ws + WS_YS, A.in(28) + (size_t)l * NEXP * 1024, rep_};
#else
            pg8::EpiDown8 E{ws + WS_YS, A.in(28) + (size_t)l * NEXP * 1024, 0};
#endif
            pg8::gemm_phase<pg8::EpiDown8, pg8::GroupedOrder, GP_ALIGN, GP_SP2, true>(F.lds + RING_OFF, g, S, E, F.tid);
            SEAM(pb + 9);
        }
        if (ON(2 + 10) && IN(pb + 10)) for (int rep_ = 0; rep_ <= REPS(2 + 10); ++rep_) { PH_BEGIN;
            p_combine(F, A, l, Mm);
            SEAM(pb + 10);
        }
    }
#ifdef STAMP_SEL
    { const AV A = av_get(); float* out = A.out(); const unsigned long long* ts = (const unsigned long long*)(F.ctl + 32768);
      auto span = [&](int p) -> float { unsigned long long d = __hip_atomic_load(ts + p + 1, __ATOMIC_RELAXED, __HIP_MEMORY_SCOPE_AGENT) - __hip_atomic_load(ts + p, __ATOMIC_RELAXED, __HIP_MEMORY_SCOPE_AGENT);
          if (p >= 2) d += __hip_atomic_load(ts + p + NPL + 1, __ATOMIC_RELAXED, __HIP_MEMORY_SCOPE_AGENT) - __hip_atomic_load(ts + p + NPL, __ATOMIC_RELAXED, __HIP_MEMORY_SCOPE_AGENT); return (float)d * 0.01f; };
      const float K1 = span((STAMP_SEL) & 0xff), K2 = 200.0f * span(((STAMP_SEL) >> 8) & 0xff);
      for (size_t i = (size_t)blockIdx.x * NTHR + threadIdx.x; i < (size_t)TL * DM; i += (size_t)gridDim.x * NTHR) out[i] = (i == 0) ? K2 : K1; }
#endif
#undef IN
#undef PH_BEGIN
#undef F_REFRESH
#undef SEAM
}

extern "C" void kernel_launch(void* const* d_in, const int* in_sizes, int n_in, void* d_out, int out_size, void* d_ws, size_t ws_size, hipStream_t stream) {
    static int grid = 0;
    if (grid == 0) {
        if (n_in != 29 || out_size != TL * DM || ws_size < WS_END2) { fprintf(stderr, "kernel_launch: built for 29 inputs, %d outputs, >= %zu bytes of workspace; got n_in %d out %d ws %zu\n", TL * DM, (size_t)WS_END2, n_in, out_size, ws_size); grid = -1; return; }
        int dev = 0, cus = 0, per_cu = 0;
        if (hipGetDevice(&dev) != hipSuccess || hipDeviceGetAttribute(&cus, hipDeviceAttributeMultiprocessorCount, dev) != hipSuccess) { grid = -1; return; }
        if (hipFuncSetAttribute((const void*)fwd, hipFuncAttributeMaxDynamicSharedMemorySize, LDS_BYTES) != hipSuccess) { fprintf(stderr, "kernel_launch: hipFuncSetAttribute failed\n"); grid = -1; return; }
        if (hipOccupancyMaxActiveBlocksPerMultiprocessor(&per_cu, (const void*)fwd, NTHR, LDS_BYTES) != hipSuccess || per_cu < 1) fprintf(stderr, "kernel_launch: occupancy query reports %d\n", per_cu);
        (void)hipGetLastError();
        grid = cus;
    }
    if (grid < 0) return;
    (void)hipMemsetAsync((char*)d_ws + WS_CTL, 0, CTL_ZERO_BYTES, stream);
    Args a{};
    for (int i = 0; i < 29; ++i) a.in[i] = (const float*)d_in[i];
    a.out = (float*)d_out; a.ws = (unsigned char*)d_ws;
#if MK_PER_PHASE
    for (int p = 0; p < NPH; ++p) {
#ifdef DBG_CHECK
        float* res = (float*)((char*)d_ws + WS_CTL + 8192 * 4); float* snap = (float*)((char*)d_ws + WS_END);
        { const int l = p >= 2 ? (p - 2) / NPL : 0, k = p >= 2 ? (p - 2) % NPL : -1;
          if (k == 6) hipLaunchKernelGGL(snap_rows, dim3(256), dim3(256), 0, stream, a, l, 11, snap);
          if (k == 12) hipLaunchKernelGGL(snap_rows, dim3(256), dim3(256), 0, stream, a, l, 17, snap); }
#endif
        a.ph_lo = p; a.ph_hi = p + 1; hipLaunchKernelGGL(fwd, dim3(grid), dim3(NTHR), LDS_BYTES, stream, a);
#ifdef DBG_CHECK
        { const int l = p >= 2 ? (p - 2) / NPL : 0, k = p >= 2 ? (p - 2) % NPL : -1;
#define CHK(st) hipLaunchKernelGGL(chk, dim3(1), dim3(256), 0, stream, a, (int)(st), l, res, snap)
          if (p == 0) CHK(ST_MOD); if (p == 1) CHK(ST_H0);
#if DBG_GSUB == 2
          if (k == 3 && l == 0) hipLaunchKernelGGL(chk_gates_full, dim3(48, TALL / 4), dim3(256), 0, stream, (const bf16*)((char*)d_ws + WS_H), (const bf16*)((char*)d_ws + WS_WSMALL + OFFS_WG), (const bf16*)((char*)d_ws + WS_GATES), TALL, (unsigned*)((char*)d_ws + WS_CTL + 65536));
#endif
          if (k == 0) { CHK(ST_INPROJ); CHK(ST_YT); } if (k == 1) { CHK(ST_QKFIX); CHK(ST_CONV); CHK(ST_Z); } if (k == 2) CHK(ST_ATTN); if (k == 3) { CHK(ST_GATES); CHK(ST_GATESB); } if (k == 4) CHK(ST_MERGED);
          if (k == 5) CHK(ST_MIX); if (k == 6) CHK(ST_ROW1); if (k == 7) CHK(ST_LOGIT); if (k == 8) CHK(ST_TOPK); if (k == 9) CHK(ST_SLOTS); if (k == 10) CHK(ST_ACT); if (k == 11) CHK(ST_YSLOT); if (k == 12) CHK(ST_COMB);
#undef CHK
        }
#endif
    }
#ifdef DBG_CHECK
#if DBG_GSUB == 2
    hipLaunchKernelGGL(encode_full, dim3(1024), dim3(256), 0, stream, (float*)d_out, (const unsigned*)((char*)d_ws + WS_CTL + 65536), out_size);
#else
    hipLaunchKernelGGL(encode, dim3(1024), dim3(256), 0, stream, (float*)d_out, (const float*)((char*)d_ws + WS_CTL + 8192 * 4), out_size, 0.25f);
#endif
#endif
#else
    a.ph_lo = 0; a.ph_hi = NPH; hipLaunchKernelGGL(fwd, dim3(grid), dim3(NTHR), LDS_BYTES, stream, a);
#endif
    const hipError_t le = hipPeekAtLastError();
    if (le != hipSuccess) fprintf(stderr, "kernel_launch: launch failed: %s\n", hipGetErrorName(le));
}
```

```cpp
#include <hip/hip_runtime.h>
#include <cstdio>
#include <cstdint>
#ifndef MK_PER_PHASE
#define MK_PER_PHASE 0
#endif
namespace pg8 {
#define PG8_LAS __attribute__((address_space(3)))
typedef unsigned short bf16_t;
typedef short bf16x8 __attribute__((ext_vector_type(8)));
typedef float f32x4 __attribute__((ext_vector_type(4)));
typedef unsigned u32x4 __attribute__((ext_vector_type(4)));
typedef int i32x4v __attribute__((ext_vector_type(4)));
typedef int i32x8v __attribute__((ext_vector_type(8)));
typedef unsigned u32x2v __attribute__((ext_vector_type(2)));
constexpr int BM = 256, BK = 64, HALF = 128, HTB = HALF * BK * 2  , STAGE_BYTES = 8 * HTB, NXCD = 8, WGM = 8;

__host__ __device__ __forceinline__ int lds_byte(int r, int c) { const int st = (r >> 4) * 2 + (c >> 5), rr = r & 15, cc = c & 31, ob = rr * 64 + cc * 2; return st * 1024 + (ob ^ (((ob >> 9) & 1) << 5)); }
__host__ __device__ __forceinline__ void stage_rc(int b, int& R, int& C) { const int st = b / 1024, sb = b % 1024, swz = sb ^ (((sb >> 9) & 1) << 5); R = (st >> 1) * 16 + swz / 64; C = (st & 1) * 32 + (swz % 64) / 2; }
__host__ __device__ __forceinline__ int perm32(int rho) { const int n = rho >> 4, i = rho & 15; return 8 * (i >> 2) + 4 * n + (i & 3); }

struct Unit { int pm, pn; };
struct Gemm { const bf16_t* A; const bf16_t* Bt; int M, N, K; };

struct StaticOrder {
    int nM, nN, nwg, G, c;
    __host__ __device__ void init(int M, int N, int G_, int c_) { nM = M / BM; nN = N / BM; nwg = nM * nN; G = G_; c = c_; }
    __host__ __device__ bool next(int i, Unit& u) const {
        const long L = (long)i * G + c; if (L >= nwg) return false;
        int wgid = (int)L; { const int q = nwg / NXCD, r = nwg % NXCD, xcd = wgid % NXCD, off = wgid / NXCD; wgid = (xcd < r ? xcd * (q + 1) : r * (q + 1) + (xcd - r) * q) + off; }
        const int nig = WGM * nN, gid = wgid / nig, fm = gid * WGM, gsz = (nM - fm) < WGM ? (nM - fm) : WGM;
        u.pm = fm + ((wgid % nig) % gsz); u.pn = (wgid % nig) / gsz; return true;
    }
    __device__ __forceinline__ void a_ready(const Unit&) const {}
    __device__ __forceinline__ void done(const Unit&) const {}
};

typedef __bf16 bf16x2_native __attribute__((ext_vector_type(2)));
typedef float f32x2_native __attribute__((ext_vector_type(2)));
__device__ __forceinline__ unsigned cvt_pk_bf16(float lo, float hi) { const f32x2_native v = {lo, hi}; const bf16x2_native r = __builtin_convertvector(v, bf16x2_native); return __builtin_bit_cast(unsigned, r); }
__device__ __forceinline__ unsigned cvt4_fp8(float a, float b, float c, float d) { int w = __builtin_amdgcn_cvt_pk_fp8_f32(a, b, __builtin_bit_cast(int, a), false); w = __builtin_amdgcn_cvt_pk_fp8_f32(c, d, w, true); return (unsigned)w; }
typedef float f32x2 __attribute__((ext_vector_type(2)));
__device__ __forceinline__ f32x2 gelu_pk(f32x2 v) {
    const f32x2 av = __builtin_elementwise_abs(v), d = av * 0.2316418882f + 1.0f;
    f32x2 t; t.x = __builtin_amdgcn_rcpf(d.x); t.y = __builtin_amdgcn_rcpf(d.y);
    f32x2 q = t * 0.5307027145f + (-0.7265760135f); q = q * t + 0.7107068705f; q = q * t + (-0.142248368f); q = q * t + 0.127414796f; q = q * t;
    const f32x2 s = (v * v) * (-0.72134752044f);
    f32x2 e; e.x = __builtin_amdgcn_exp2f(s.x); e.y = __builtin_amdgcn_exp2f(s.y);
    const f32x2 m = v * (q * e), r = v - m;
    f32x2 o; o.x = v.x < 0.f ? m.x : r.x; o.y = v.y < 0.f ? m.y : r.y; return o;
}

template <int ACT  > struct EpiBf16 {
    static constexpr bool PERM = true, AFTER_DRAIN = false; static_assert(ACT == 0 || ACT == 1, "EpiBf16: ACT is 0 (none) or 1 (gelu_pk)");
    bf16_t* O; int ldc; const float* bias; int split_cols; size_t split_stride; float scale0;
    __device__ __forceinline__ void operator()(const f32x4 (&acc)[2][2][4][2], const Unit& u, int wr, int wc, int fr, int fq) const {
        const int row0 = u.pm * BM + wr * 64 + fr; int colt = u.pn * BM; bf16_t* base = O;
        float sc = 1.f; if (split_cols) { const int t = colt / split_cols; base += (size_t)t * split_stride; colt -= t * split_cols; if (t == 0) sc = scale0; }
        const int col0 = colt + wc * 32 + 8 * fq, bcol0 = u.pn * BM + wc * 32 + 8 * fq;
        f32x4 bv[2][2];
#pragma unroll
        for (int bj = 0; bj < 2; ++bj)
#pragma unroll
            for (int n = 0; n < 2; ++n) bv[bj][n] = bias ? *(const f32x4*)(bias + bcol0 + bj * HALF + 4 * n) : (f32x4){0.f, 0.f, 0.f, 0.f};
#pragma unroll
        for (int ai = 0; ai < 2; ++ai)
#pragma unroll
            for (int m = 0; m < 4; ++m) { bf16_t* rowp = base + (size_t)(row0 + ai * HALF + m * 16) * ldc + col0;
#pragma unroll
                for (int bj = 0; bj < 2; ++bj) { f32x4 v0 = acc[ai][bj][m][0] + bv[bj][0], v1 = acc[ai][bj][m][1] + bv[bj][1];
                    if (ACT == 1) { f32x2 a = gelu_pk((f32x2){v0[0], v0[1]}), b = gelu_pk((f32x2){v0[2], v0[3]}), c = gelu_pk((f32x2){v1[0], v1[1]}), d = gelu_pk((f32x2){v1[2], v1[3]});
                        v0 = (f32x4){a.x, a.y, b.x, b.y}; v1 = (f32x4){c.x, c.y, d.x, d.y}; }
                    v0 = v0 * sc; v1 = v1 * sc; u32x4 w; w.x = cvt_pk_bf16(v0[0], v0[1]); w.y = cvt_pk_bf16(v0[2], v0[3]); w.z = cvt_pk_bf16(v1[0], v1[1]); w.w = cvt_pk_bf16(v1[2], v1[3]);
                    *(u32x4*)(rowp + bj * HALF) = w; } }
    }
};

__device__ __forceinline__ float fast_sigmoid(float x) { return __builtin_amdgcn_rcpf(1.0f + __builtin_amdgcn_exp2f(-1.4426950408889634f * x)); }
__device__ __forceinline__ u32x4 pack8(const f32x4& a, const f32x4& b) { u32x4 w; w.x = cvt_pk_bf16(a[0], a[1]); w.y = cvt_pk_bf16(a[2], a[3]); w.z = cvt_pk_bf16(b[0], b[1]); w.w = cvt_pk_bf16(b[2], b[3]); return w; }
__device__ __forceinline__ void unpack8(const u32x4& w, f32x4& a, f32x4& b) {
    a[0] = __uint_as_float(w.x << 16); a[1] = __uint_as_float(w.x & 0xffff0000u); a[2] = __uint_as_float(w.y << 16); a[3] = __uint_as_float(w.y & 0xffff0000u);
    b[0] = __uint_as_float(w.z << 16); b[1] = __uint_as_float(w.z & 0xffff0000u); b[2] = __uint_as_float(w.w << 16); b[3] = __uint_as_float(w.w & 0xffff0000u); }
__device__ __forceinline__ u32x2v pack8_fp8(const f32x4& a, const f32x4& b) { u32x2v r; r.x = cvt4_fp8(a[0], a[1], a[2], a[3]); r.y = cvt4_fp8(b[0], b[1], b[2], b[3]); return r; }
__device__ __forceinline__ void store_tile_bf16(const f32x4 (&acc)[2][2][4][2], bf16_t* base, int ldc, int wr, int wc, int fr, int fq) {
    const int rt = wr * 64 + fr, cb = wc * 32 + 8 * fq;
#pragma unroll
    for (int ai = 0; ai < 2; ++ai)
#pragma unroll
        for (int m = 0; m < 4; ++m) { bf16_t* rowp = base + (size_t)(rt + ai * HALF + m * 16) * ldc + cb;
#pragma unroll
            for (int bj = 0; bj < 2; ++bj) *(u32x4*)(rowp + bj * HALF) = pack8(acc[ai][bj][m][0], acc[ai][bj][m][1]); }
}
struct EpiInproj {
    static constexpr bool PERM = true, AFTER_DRAIN = false;
    bf16_t *q, *k, *v, *cu;
    __device__ __forceinline__ void operator()(const f32x4 (&acc)[2][2][4][2], const Unit& u, int wr, int wc, int fr, int fq) const {
        bf16_t* base; int ldc; const bool glu = u.pn >= 6; float sc = 0.03125f; asm volatile("" : "+s"(sc));
        if (u.pn < 4) { base = q + (size_t)u.pm * 256 * 1024 + u.pn * 256; ldc = 1024; }
        else if (u.pn < 6) { const int m0 = u.pm * 256; const int kr = m0 < 32768 ? (m0 >> 11) * 2304 + (m0 & 2047) : ((m0 - 32768) >> 8) * 2304 + 2048; base = (u.pn == 4 ? k : v) + (size_t)kr * 256; ldc = 256; }
        else { base = cu + (size_t)u.pm * 256 * 512 + (u.pn - 6) * 128; ldc = 512; }
        base += (size_t)(wr * 64 + fr) * ldc + wc * 32 + 8 * fq;
#pragma unroll
        for (int ai = 0; ai < 2; ++ai)
#pragma unroll
            for (int m = 0; m < 4; ++m) { bf16_t* rowp = base + (size_t)(ai * HALF + m * 16) * ldc;
                if (!glu) { *(u32x4*)rowp = pack8(acc[ai][0][m][0] * sc, acc[ai][0][m][1] * sc); *(u32x4*)(rowp + HALF) = pack8(acc[ai][1][m][0] * sc, acc[ai][1][m][1] * sc); }
                else { f32x4 a0 = acc[ai][0][m][0] * sc, a1 = acc[ai][0][m][1] * sc; const f32x4 g0 = acc[ai][1][m][0] * sc, g1 = acc[ai][1][m][1] * sc;
#pragma unroll
                    for (int j = 0; j < 4; ++j) { a0[j] *= fast_sigmoid(g0[j]); a1[j] *= fast_sigmoid(g1[j]); }
                    *(u32x4*)rowp = pack8(a0, a1); } }
    }
};
struct EpiYT {
    static constexpr bool PERM = true, AFTER_DRAIN = false;
    unsigned char *yt, *ytc;
    __device__ __forceinline__ void operator()(const f32x4 (&acc)[2][2][4][2], const Unit& u, int wr, int wc, int fr, int fq) const {
        const int cs = u.pm >> 1, chb = (u.pm & 1) * 256; unsigned char* base; int ldc;
        if (u.pn < 128) { const int b = u.pn >> 3, pos0 = (u.pn & 7) * 256; base = yt + (size_t)(b * 512 + chb) * 4096 + cs * 2048 + pos0; ldc = 4096; }
        else { const int b = u.pn - 128; base = ytc + (size_t)(b * 512 + chb) * 512 + cs * 256; ldc = 512; }
        base += (size_t)(wr * 64 + fr) * ldc + wc * 32 + 8 * fq;
#pragma unroll
        for (int ai = 0; ai < 2; ++ai)
#pragma unroll
            for (int m = 0; m < 4; ++m) { unsigned char* rowp = base + (size_t)(ai * HALF + m * 16) * ldc;
#pragma unroll
                for (int bj = 0; bj < 2; ++bj) *(u32x2v*)(rowp + bj * HALF) = pack8_fp8(acc[ai][bj][m][0], acc[ai][bj][m][1]); }
    }
};
struct EpiDFT {
    static constexpr bool PERM = true, AFTER_DRAIN = false;
    bf16_t* z; int rowbase, rpb;
    __device__ __forceinline__ void operator()(const f32x4 (&acc)[2][2][4][2], const Unit& u, int wr, int wc, int fr, int fq) const {
        bf16_t* base = z + (size_t)(rowbase + (u.pn >> 1) * rpb + u.pm * 256 + wr * 64 + fr) * 512 + (u.pn & 1) * 256 + wc * 32 + 8 * fq;
#pragma unroll
        for (int ai = 0; ai < 2; ++ai)
#pragma unroll
            for (int m = 0; m < 4; ++m)
#pragma unroll
                for (int bj = 0; bj < 2; ++bj) *(u32x4*)(base + (size_t)(ai * HALF + m * 16) * 512 + bj * HALF) = pack8(acc[ai][bj][m][0] * 0.03125f, acc[ai][bj][m][1] * 0.03125f);
    }
};
struct EpiGates {
    static constexpr bool PERM = true, AFTER_DRAIN = false;
    bf16_t* g;
    __device__ __forceinline__ void operator()(const f32x4 (&acc)[2][2][4][2], const Unit& u, int wr, int wc, int fr, int fq) const {
        const int rt = wr * 64 + fr, cb = wc * 32 + 8 * fq; bf16_t* base = g + (size_t)u.pm * 256 * 3072 + u.pn * 256 + cb;
        float cs = -1.4426950408889634f * 0.03125f; asm volatile("" : "+s"(cs));
#pragma unroll
        for (int ai = 0; ai < 2; ++ai)
#pragma unroll
            for (int m = 0; m < 4; ++m)
#pragma unroll
                for (int bj = 0; bj < 2; ++bj) { f32x4 a0 = acc[ai][bj][m][0], a1 = acc[ai][bj][m][1];
#pragma unroll
                    for (int j = 0; j < 4; ++j) { a0[j] = __builtin_amdgcn_rcpf(1.0f + __builtin_amdgcn_exp2f(a0[j] * cs)); a1[j] = __builtin_amdgcn_rcpf(1.0f + __builtin_amdgcn_exp2f(a1[j] * cs)); }
                    __builtin_nontemporal_store(pack8(a0, a1), (u32x4*)(base + (size_t)(rt + ai * HALF + m * 16) * 3072 + bj * HALF)); }
    }
};
template <bool FIRST> struct EpiMerge {
    static constexpr bool PERM = true, AFTER_DRAIN = false;
    bf16_t* mg; const bf16_t* g; int br; float scale;
    __device__ __forceinline__ void operator()(const f32x4 (&acc)[2][2][4][2], const Unit& u, int wr, int wc, int fr, int fq) const {
        const int rt = u.pm * 256 + wr * 64 + fr, cb = u.pn * 256 + wc * 32 + 8 * fq; float sc = scale; asm volatile("" : "+s"(sc));
#pragma unroll
        for (int ai = 0; ai < 2; ++ai)
#pragma unroll
            for (int m = 0; m < 4; ++m)
#pragma unroll
                for (int bj = 0; bj < 2; ++bj) { const size_t row = (size_t)(rt + ai * HALF + m * 16); const int col = cb + bj * HALF;
                    const u32x4 gw = *(const u32x4*)(g + row * 3072 + br * 1024 + col); f32x4 g0, g1; unpack8(gw, g0, g1);
                    f32x4 v0 = acc[ai][bj][m][0] * sc * g0, v1 = acc[ai][bj][m][1] * sc * g1;
                    if (!FIRST) { const u32x4 ow = *(const u32x4*)(mg + row * 1024 + col); f32x4 o0, o1; unpack8(ow, o0, o1); v0 += o0; v1 += o1; }
                    *(u32x4*)(mg + row * 1024 + col) = pack8(v0, v1); }
    }
};
struct EpiRouter {
    static constexpr bool PERM = true, AFTER_DRAIN = false;
    float* lg;
    __device__ __forceinline__ void operator()(const f32x4 (&acc)[2][2][4][2], const Unit& u, int wr, int wc, int fr, int fq) const {
        if (wc < 2) { const int rt = u.pm * 256 + wr * 64 + fr, cb = wc * 32 + 8 * fq;
#pragma unroll
            for (int ai = 0; ai < 2; ++ai)
#pragma unroll
                for (int m = 0; m < 4; ++m) { float* p = lg + (size_t)(rt + ai * HALF + m * 16) * 64 + cb; *(f32x4*)p = acc[ai][0][m][0]; *(f32x4*)(p + 4) = acc[ai][0][m][1]; } }
    }
};
struct EpiSwiGLU {
    static constexpr bool PERM = true, AFTER_DRAIN = false;
    bf16_t* act; const float* bg; const float* bu;
    __device__ __forceinline__ void operator()(const f32x4 (&acc)[2][2][4][2], const Unit& u, int wr, int wc, int fr, int fq) const {
        const int e = u.pn >> 3, col = (u.pn & 7) * 128 + wc * 32 + 8 * fq, rt = u.pm * 256 + wr * 64 + fr;
        const f32x4 bg0 = *(const f32x4*)(bg + e * 1024 + col), bg1 = *(const f32x4*)(bg + e * 1024 + col + 4), bu0 = *(const f32x4*)(bu + e * 1024 + col), bu1 = *(const f32x4*)(bu + e * 1024 + col + 4);
#pragma unroll
        for (int ai = 0; ai < 2; ++ai)
#pragma unroll
            for (int m = 0; m < 4; ++m) { f32x4 g0 = acc[ai][0][m][0] + bg0, g1 = acc[ai][0][m][1] + bg1, u0 = acc[ai][1][m][0] + bu0, u1 = acc[ai][1][m][1] + bu1;
#pragma unroll
                for (int j = 0; j < 4; ++j) { const float ga = fminf(g0[j], 7.0f), gb = fminf(g1[j], 7.0f); const float ua = fminf(fmaxf(u0[j], -7.0f), 7.0f), ub = fminf(fmaxf(u1[j], -7.0f), 7.0f);
                    g0[j] = (ua + 1.0f) * (ga * fast_sigmoid(1.702f * ga)); g1[j] = (ub + 1.0f) * (gb * fast_sigmoid(1.702f * gb)); }
                *(u32x4*)(act + (size_t)(rt + ai * HALF + m * 16) * 1024 + col) = pack8(g0, g1); }
    }
};
struct EpiSwiGLU8 {
    static constexpr bool PERM = true, AFTER_DRAIN = false;
    unsigned char* act; const float* bg; const float* bu;
    __device__ __forceinline__ void operator()(const f32x4 (&acc)[2][2][4][2], const Unit& u, int wr, int wc, int fr, int fq) const {
        const int e = u.pn >> 3, col = (u.pn & 7) * 128 + wc * 32 + 8 * fq, rt = u.pm * 256 + wr * 64 + fr;
        const f32x4 bg0 = *(const f32x4*)(bg + e * 1024 + col), bg1 = *(const f32x4*)(bg + e * 1024 + col + 4), bu0 = *(const f32x4*)(bu + e * 1024 + col), bu1 = *(const f32x4*)(bu + e * 1024 + col + 4);
#pragma unroll
        for (int ai = 0; ai < 2; ++ai)
#pragma unroll
            for (int m = 0; m < 4; ++m) { f32x4 g0 = acc[ai][0][m][0] * 0.03125f + bg0, g1 = acc[ai][0][m][1] * 0.03125f + bg1, u0 = acc[ai][1][m][0] * 0.03125f + bu0, u1 = acc[ai][1][m][1] * 0.03125f + bu1;
#pragma unroll
                for (int j = 0; j < 4; ++j) { const float ga = fminf(g0[j], 7.0f), gb = fminf(g1[j], 7.0f); const float ua = fminf(fmaxf(u0[j], -7.0f), 7.0f), ub = fminf(fmaxf(u1[j], -7.0f), 7.0f);
                    g0[j] = (ua + 1.0f) * (ga * fast_sigmoid(1.702f * ga)); g1[j] = (ub + 1.0f) * (gb * fast_sigmoid(1.702f * gb)); }
                __builtin_nontemporal_store(pack8_fp8(g0, g1), (u32x2v*)(act + (size_t)(rt + ai * HALF + m * 16) * 1024 + col)); }
    }
};
struct EpiDown8 {
    static constexpr bool PERM = true, AFTER_DRAIN = false;
    unsigned char* ys; const float* bd; int nostore;
    __device__ __forceinline__ void operator()(const f32x4 (&acc)[2][2][4][2], const Unit& u, int wr, int wc, int fr, int fq) const {
        const int e = u.pn >> 2, col0 = (u.pn & 3) * 256 + wc * 32 + 8 * fq, rt = u.pm * 256 + wr * 64 + fr;
        f32x4 bv[2][2];
#pragma unroll
        for (int bj = 0; bj < 2; ++bj) { bv[bj][0] = *(const f32x4*)(bd + e * 1024 + col0 + bj * HALF) * 8.0f; bv[bj][1] = *(const f32x4*)(bd + e * 1024 + col0 + bj * HALF + 4) * 8.0f; }
#pragma unroll
        for (int ai = 0; ai < 2; ++ai)
#pragma unroll
            for (int m = 0; m < 4; ++m) { unsigned char* rowp = ys + (size_t)(rt + ai * HALF + m * 16) * 1024 + col0;
#pragma unroll
                for (int bj = 0; bj < 2; ++bj) { const u32x2v w = pack8_fp8(acc[ai][bj][m][0] * 0.25f + bv[bj][0], acc[ai][bj][m][1] * 0.25f + bv[bj][1]); if (!nostore) __builtin_nontemporal_store(w, (u32x2v*)(rowp + bj * HALF)); else asm volatile("" :: "v"(w)); } }
    }
};
struct GroupedOrder {
    int nM, nN, nwg, G, c; const PG8_LAS int* tile_e; const int* rows;
    __device__ void init(int nM_, int nN_, int G_, int c_, const PG8_LAS int* te) { nM = nM_; nN = nN_; nwg = nM * nN; G = G_; c = c_; tile_e = te; rows = nullptr; }
    __device__ bool next(int i, Unit& u) const {
        const long L = (long)i * G + c; if (L >= nwg) return false;
        int wgid = (int)L; { const int q = nwg / NXCD, r = nwg % NXCD, xcd = wgid % NXCD, off = wgid / NXCD; wgid = (xcd < r ? xcd * (q + 1) : r * (q + 1) + (xcd - r) * q) + off; }
        const int nig = WGM * nN, gid = wgid / nig, fm = gid * WGM, gsz = (nM - fm) < WGM ? (nM - fm) : WGM;
        u.pm = fm + ((wgid % nig) % gsz); const int pl = (wgid % nig) / gsz; u.pn = __builtin_amdgcn_readfirstlane(tile_e[u.pm]) * nN + pl; return true;
    }
    __device__ __forceinline__ void a_ready(const Unit&) const {}
    __device__ __forceinline__ void done(const Unit&) const {}
};
struct DftOrder {
    int lg, n, G, c;
    __device__ void init(int lg_, int nb, int G_, int c_) { lg = lg_; n = (nb * 2) << lg_; G = G_; c = c_; }
    __device__ bool next(int i, Unit& u) const { const int L = i * G + c; if (L >= n) return false; const int b = L >> (lg + 1), rem = L & ((2 << lg) - 1); u.pm = rem & ((1 << lg) - 1); u.pn = 2 * b + (rem >> lg); return true; }
    __device__ __forceinline__ void a_ready(const Unit&) const {}
    __device__ __forceinline__ void done(const Unit&) const {}
};

template <class Epi, class Sched, bool ALIGN_EPI = false, bool SP2 = false, bool FP8 = false, bool GATHER = false>
__device__ __forceinline__ void gemm_phase(PG8_LAS unsigned char* lds, const Gemm g, const Sched& S, const Epi& E, const int tid_in) {
    int tid_ = tid_in; asm volatile("" : "+v"(tid_));
    const int tid = tid_, wid = __builtin_amdgcn_readfirstlane(tid >> 6), lane = tid & 63, wr = wid >> 2, wc = wid & 3, fr = lane & 15, fq = lane >> 4;
    const int K = g.K, nt = K / BK;
    unsigned voffA[2], voffB[2]; int RA[2]; unsigned CA2[2];
#pragma unroll
    for (int i = 0; i < 2; ++i) { int R, C; stage_rc(tid * 16 + i * 8192, R, C); const int Rb = Epi::PERM ? ((R & ~31) + perm32(R & 31)) : R;
        voffA[i] = (unsigned)(R * K + C) * 2u; voffB[i] = (unsigned)(Rb * K + C) * 2u; RA[i] = R; CA2[i] = (unsigned)C * 2u; }
    static_assert(!GATHER || SP2, "GATHER is implemented for the SP2 loop only");
    unsigned vC[2][2]; int ixN[2][2];
#define PG8_LDIDX(dst, unit) do { if constexpr (GATHER) { _Pragma("unroll") for (int h_ = 0; h_ < 2; ++h_) _Pragma("unroll") for (int i_ = 0; i_ < 2; ++i_) dst[h_][i_] = S.rows[(unit).pm * 256 + h_ * 128 + RA[i_]]; } } while (0)
#define PG8_IX2OFF(dst, src) do { if constexpr (GATHER) { _Pragma("unroll") for (int h_ = 0; h_ < 2; ++h_) _Pragma("unroll") for (int i_ = 0; i_ < 2; ++i_) dst[h_][i_] = (unsigned)src[h_][i_] * (unsigned)(K * 2) + CA2[i_]; } } while (0)
    const size_t kstep = (size_t)(BK * 2);
    const size_t hstep = (size_t)HALF * K * 2;
    const size_t tstep = 2 * hstep;
    const unsigned ldsw = (unsigned)wid * 1024u;
    const int aoff = lds_byte(wr * 64 + fr, fq * 8), boff = lds_byte(wc * 32 + fr, fq * 8);
#define PG8_SA(b, h) (((b) * 2 + (h)) * HTB)
#define PG8_SB(b, h) ((4 + (b) * 2 + (h)) * HTB)
#define PG8_STAGE(bufoff, gbase, voff) do { _Pragma("unroll") for (int _i = 0; _i < 2; ++_i) \
        __builtin_amdgcn_global_load_lds((const unsigned*)((const char*)(gbase) + (voff)[_i]), (PG8_LAS unsigned*)(lds + (bufoff) + ldsw + _i * 8192), 16, 0, 0); } while (0)
#define PG8_RD8(off) __builtin_shufflevector(*(const PG8_LAS i32x4v*)(lds + (off)), *(const PG8_LAS i32x4v*)(lds + (off) + 1024), 0, 1, 2, 3, 4, 5, 6, 7)
#define PG8_LDA(dst, b, h) do { _Pragma("unroll") for (int m = 0; m < 4; ++m) { if constexpr (FP8) dst##8[m] = PG8_RD8(PG8_SA(b, h) + aoff + m * 2048); else { _Pragma("unroll") for (int k = 0; k < 2; ++k) dst[m][k] = *(const PG8_LAS bf16x8*)(lds + PG8_SA(b, h) + aoff + m * 2048 + k * 1024); } } } while (0)
#define PG8_LDB(dst, b, h) do { _Pragma("unroll") for (int n = 0; n < 2; ++n) { if constexpr (FP8) dst##8[n] = PG8_RD8(PG8_SB(b, h) + boff + n * 2048); else { _Pragma("unroll") for (int k = 0; k < 2; ++k) dst[n][k] = *(const PG8_LAS bf16x8*)(lds + PG8_SB(b, h) + boff + n * 2048 + k * 1024); } } } while (0)
#define PG8_MMA(ai, bj, At, Bt) do { if constexpr (FP8) __builtin_amdgcn_sched_barrier(0); __builtin_amdgcn_s_setprio(1); _Pragma("unroll") for (int m = 0; m < 4; ++m) _Pragma("unroll") for (int n = 0; n < 2; ++n) { \
        if constexpr (FP8) asm volatile("v_mfma_scale_f32_16x16x128_f8f6f4 %0, %1, %2, %0, %3, %3 op_sel_hi:[0,0,0]" : "+v"(acc[ai][bj][m][n]) : "v"(Bt##8[n]), "v"(At##8[m]), "v"(sc8)); \
        else { _Pragma("unroll") for (int k = 0; k < 2; ++k) acc[ai][bj][m][n] = __builtin_amdgcn_mfma_f32_16x16x32_bf16(Bt[n][k], At[m][k], acc[ai][bj][m][n], 0, 0, 0); } } __builtin_amdgcn_s_setprio(0); if constexpr (FP8) __builtin_amdgcn_sched_barrier(0); } while (0)
#define PG8_WAIT_V(n) asm volatile("s_waitcnt vmcnt(" #n ")" ::: "memory")
#define PG8_WAIT_L(n) asm volatile("s_waitcnt lgkmcnt(" #n ")" ::: "memory")
#define PG8_BAR __builtin_amdgcn_s_barrier()
#define PG8_SCHED __builtin_amdgcn_sched_barrier(0)
    Unit cur, nxt; int ui = 0;
    if (!S.next(0, cur)) return;
    f32x4 acc[2][2][4][2];
#pragma unroll
    for (int a = 0; a < 2; ++a)
#pragma unroll
        for (int b = 0; b < 2; ++b)
#pragma unroll
            for (int m = 0; m < 4; ++m)
#pragma unroll
                for (int n = 0; n < 2; ++n) acc[a][b][m][n] = (f32x4){0.f, 0.f, 0.f, 0.f};
    int sc8 = 0x7f7f7f7f; asm volatile("" : "+v"(sc8));
    bf16x8 At[4][2], B0[2][2], B1[2][2]; i32x8v At8[4], B08[2], B18[2];
    const char* cA = (const char*)g.A + (size_t)cur.pm * tstep; const char* cB = (const char*)g.Bt + (size_t)cur.pn * tstep; const char* const gA = (const char*)g.A;
    S.a_ready(cur);
    if constexpr (SP2) {
        if constexpr (GATHER) { PG8_LDIDX(ixN, cur); PG8_IX2OFF(vC, ixN); }
        PG8_STAGE(PG8_SB(0, 0), cB, voffB); PG8_STAGE(PG8_SB(0, 1), cB + hstep, voffB);
        if constexpr (GATHER) { PG8_STAGE(PG8_SA(0, 0), gA, vC[0]); PG8_STAGE(PG8_SA(0, 1), gA, vC[1]); } else { PG8_STAGE(PG8_SA(0, 0), cA, voffA); PG8_STAGE(PG8_SA(0, 1), cA + hstep, voffA); }
        if (wr == 1) PG8_BAR;
        PG8_WAIT_V(2); PG8_BAR;
        PG8_STAGE(PG8_SB(1, 0), cB + kstep, voffB); if constexpr (GATHER) PG8_STAGE(PG8_SA(1, 0), gA + kstep, vC[0]); else PG8_STAGE(PG8_SA(1, 0), cA + kstep, voffA); PG8_STAGE(PG8_SB(1, 1), cB + hstep + kstep, voffB);
        PG8_WAIT_V(6); PG8_BAR;
    } else {
        PG8_STAGE(PG8_SB(0, 0), cB, voffB); PG8_STAGE(PG8_SA(0, 0), cA, voffA); PG8_STAGE(PG8_SB(0, 1), cB + hstep, voffB); PG8_STAGE(PG8_SA(0, 1), cA + hstep, voffA);
        if (wr == 1) PG8_BAR;
        PG8_WAIT_V(4); PG8_BAR;
        PG8_STAGE(PG8_SB(1, 0), cB + kstep, voffB); PG8_STAGE(PG8_SA(1, 0), cA + kstep, voffA); PG8_STAGE(PG8_SB(1, 1), cB + hstep + kstep, voffB);
        PG8_WAIT_V(6); PG8_BAR;
    }
    for (;;) {
        const bool has_next = S.next(ui + 1, nxt);
        if constexpr (GATHER) { if (has_next) PG8_LDIDX(ixN, nxt); }
        const char* nA = has_next ? (const char*)g.A + (size_t)nxt.pm * tstep : cA; const char* nB = has_next ? (const char*)g.Bt + (size_t)nxt.pn * tstep : cB;
        for (int t = 0; t < nt; t += 2) {
            const bool last = (t == nt - 2);
            const char* a1 = cA + (size_t)(t + 1) * kstep;
            const char* a2 = last ? nA : cA + (size_t)(t + 2) * kstep; const char* b2 = last ? nB : cB + (size_t)(t + 2) * kstep;
            const char* a3 = a2 + kstep; const char* b3 = b2 + kstep;
            if (last && has_next) S.a_ready(nxt);
            unsigned v2[2][2]; const char* gA2 = gA;
            if constexpr (GATHER) { const bool sw = last && has_next;
                _Pragma("unroll") for (int h_ = 0; h_ < 2; ++h_) _Pragma("unroll") for (int i_ = 0; i_ < 2; ++i_) v2[h_][i_] = sw ? (unsigned)ixN[h_][i_] * (unsigned)(K * 2) + CA2[i_] : vC[h_][i_];
                gA2 = last ? gA : gA + (size_t)(t + 2) * kstep; }
            if constexpr (SP2) {
            PG8_LDB(B0, 0, 0); PG8_LDB(B1, 0, 1); PG8_SCHED; PG8_LDA(At, 0, 0); if constexpr (GATHER) PG8_STAGE(PG8_SA(1, 1), gA + (size_t)(t + 1) * kstep, vC[1]); else PG8_STAGE(PG8_SA(1, 1), a1 + hstep, voffA);
            PG8_WAIT_V(8); PG8_WAIT_L(0); PG8_BAR; PG8_MMA(0, 0, At, B0); PG8_MMA(0, 1, At, B1); PG8_BAR; PG8_SCHED;
            PG8_LDA(At, 0, 1); PG8_STAGE(PG8_SB(0, 0), b2, voffB); PG8_STAGE(PG8_SB(0, 1), b2 + hstep, voffB); if constexpr (GATHER) PG8_STAGE(PG8_SA(0, 0), gA2, v2[0]); else PG8_STAGE(PG8_SA(0, 0), a2, voffA);
            PG8_WAIT_V(8); PG8_WAIT_L(0); PG8_BAR; PG8_MMA(1, 0, At, B0); PG8_MMA(1, 1, At, B1); PG8_BAR; PG8_SCHED;
            PG8_LDB(B0, 1, 0); PG8_LDB(B1, 1, 1); PG8_SCHED; PG8_LDA(At, 1, 0); if constexpr (GATHER) PG8_STAGE(PG8_SA(0, 1), gA2, v2[1]); else PG8_STAGE(PG8_SA(0, 1), a2 + hstep, voffA);
            PG8_WAIT_V(8); PG8_WAIT_L(0); PG8_BAR; PG8_MMA(0, 0, At, B0); PG8_MMA(0, 1, At, B1); PG8_BAR; PG8_SCHED;
            PG8_LDA(At, 1, 1); PG8_STAGE(PG8_SB(1, 0), b3, voffB); PG8_STAGE(PG8_SB(1, 1), b3 + hstep, voffB); if constexpr (GATHER) PG8_STAGE(PG8_SA(1, 0), gA2 + kstep, v2[0]); else PG8_STAGE(PG8_SA(1, 0), a3, voffA);
            PG8_WAIT_V(8); PG8_WAIT_L(0); PG8_BAR; PG8_MMA(1, 0, At, B0); PG8_MMA(1, 1, At, B1); PG8_BAR; PG8_SCHED;
            } else {
            PG8_LDB(B0, 0, 0); PG8_SCHED; PG8_LDA(At, 0, 0); PG8_STAGE(PG8_SA(1, 1), a1 + hstep, voffA);
            PG8_WAIT_L(8); PG8_BAR; PG8_WAIT_L(0); PG8_MMA(0, 0, At, B0); PG8_BAR; PG8_SCHED;
            PG8_LDB(B1, 0, 1); PG8_STAGE(PG8_SB(0, 0), b2, voffB);
            PG8_BAR; PG8_WAIT_L(0); PG8_MMA(0, 1, At, B1); PG8_BAR;
            PG8_LDA(At, 0, 1); PG8_STAGE(PG8_SA(0, 0), a2, voffA);
            PG8_BAR; PG8_WAIT_L(0); PG8_MMA(1, 0, At, B0); PG8_BAR; PG8_SCHED;
            PG8_STAGE(PG8_SB(0, 1), b2 + hstep, voffB);
            PG8_WAIT_V(6); PG8_BAR; PG8_MMA(1, 1, At, B1); PG8_BAR;
            PG8_LDB(B0, 1, 0); PG8_SCHED; PG8_LDA(At, 1, 0); PG8_STAGE(PG8_SA(0, 1), a2 + hstep, voffA);
            PG8_WAIT_L(8); PG8_BAR; PG8_WAIT_L(0); PG8_MMA(0, 0, At, B0); PG8_BAR; PG8_SCHED;
            PG8_LDB(B1, 1, 1); PG8_STAGE(PG8_SB(1, 0), b3, voffB);
            PG8_BAR; PG8_WAIT_L(0); PG8_MMA(0, 1, At, B1); PG8_BAR;
            PG8_LDA(At, 1, 1); PG8_STAGE(PG8_SA(1, 0), a3, voffA);
            PG8_BAR; PG8_WAIT_L(0); PG8_MMA(1, 0, At, B0); PG8_BAR; PG8_SCHED;
            PG8_STAGE(PG8_SB(1, 1), b3 + hstep, voffB);
            PG8_WAIT_V(6); PG8_BAR; PG8_MMA(1, 1, At, B1); PG8_BAR;
            }
        }
        if constexpr (FP8) asm volatile("s_nop 15\n\ts_nop 15" ::: "memory");
        if constexpr (ALIGN_EPI) { if (wr == 0) PG8_BAR; }
        if constexpr (!Epi::AFTER_DRAIN) { E(acc, cur, wr, wc, fr, fq); S.done(cur); }
        if (!has_next) break;
#pragma unroll
        for (int a = 0; a < 2; ++a)
#pragma unroll
            for (int b = 0; b < 2; ++b)
#pragma unroll
                for (int m = 0; m < 4; ++m)
#pragma unroll
                    for (int n = 0; n < 2; ++n) acc[a][b][m][n] = (f32x4){0.f, 0.f, 0.f, 0.f};
        cur = nxt; cA = nA; cB = nB; ++ui;
        if constexpr (GATHER) PG8_IX2OFF(vC, ixN);
        if constexpr (ALIGN_EPI) { if (wr == 1) PG8_BAR; }
    }
    PG8_WAIT_V(0);
    if constexpr (!ALIGN_EPI) { if (wr == 0) PG8_BAR; }
    PG8_BAR;
    if constexpr (Epi::AFTER_DRAIN) { E.fused(acc, cur, wr, wc, fr, fq, lds, wid, lane); S.done(cur); }
#undef PG8_SA
#undef PG8_LDIDX
#undef PG8_IX2OFF
#undef PG8_SB
#undef PG8_STAGE
#undef PG8_LDA
#undef PG8_LDB
#undef PG8_MMA
#undef PG8_RD8
#undef PG8_WAIT_V
#undef PG8_WAIT_L
#undef PG8_BAR
#undef PG8_SCHED
}
}
namespace att {
typedef unsigned short bf16;
constexpr int   D = 128, NW = 8, QBLK = 32, KVBLK = 64;
constexpr float SCALE = 0.088388347648318440f;
constexpr float THR = 8.f;
constexpr int SDEPTH = 2;
constexpr int LDQ = 1024, LDK = 256, LDO = 1024;
constexpr size_t SHM_V = KVBLK * D * 2, SHM_K = KVBLK * D * 2, SHM_ATTN = 2 * SHM_V + 2 * SHM_K + NW * 64 * 4;
using bf16x8 = __attribute__((ext_vector_type(8))) short;
using s16x4  = __attribute__((ext_vector_type(4))) short;
using f32x16 = __attribute__((ext_vector_type(16))) float;
using f32x8  = __attribute__((ext_vector_type(8))) float;
using u32x4  = __attribute__((ext_vector_type(4))) unsigned;
#define KSWZ(row, colB) ((row) * 256 + ((colB) ^ (((row) & 7) << 4)))
#define SBAR() __builtin_amdgcn_sched_barrier(0)
__device__ __forceinline__ int crow(int r, int hi) { return (r & 3) + 8 * (r >> 2) + 4 * hi; }
__device__ __forceinline__ unsigned cvtpk(float lo, float hi) { return pg8::cvt_pk_bf16(lo, hi); }
template <typename TIn> struct Stage;
template <> struct Stage<bf16>  { using T = bf16x8;
  __device__ static __forceinline__ T ld8(const bf16* p) { return *reinterpret_cast<const bf16x8*>(p); }
  __device__ static __forceinline__ bf16x8 tobf(T x) { return x; } };
template <> struct Stage<float> { using T = f32x8;
  __device__ static __forceinline__ T ld8(const float* p) { return *reinterpret_cast<const f32x8*>(p); }
  __device__ static __forceinline__ bf16x8 tobf(T x) {
    u32x4 w = {cvtpk(x[0], x[1]), cvtpk(x[2], x[3]), cvtpk(x[4], x[5]), cvtpk(x[6], x[7])}; return *reinterpret_cast<bf16x8*>(&w); } };

__device__ __forceinline__ void partialSM(f32x16& p0, f32x16& p1, float& m_reg, float& mn, float& alpha) {
  constexpr float C = SCALE * 1.4426950408889634f;
  float pmax = p0[0]; for (int r = 1; r < 16; ++r) pmax = fmaxf(pmax, p0[r]); for (int r = 0; r < 16; ++r) pmax = fmaxf(pmax, p1[r]);
  { auto rr = __builtin_amdgcn_permlane32_swap(__float_as_uint(pmax), __float_as_uint(pmax), false, false);
    pmax = fmaxf(__uint_as_float(rr[0]), __uint_as_float(rr[1])); }
  if (__builtin_expect(__all(pmax - m_reg <= THR / SCALE), 1)) { mn = m_reg; alpha = 1.f; }
  else { mn = fmaxf(m_reg, pmax); alpha = __builtin_amdgcn_exp2f((m_reg - mn) * C); m_reg = mn; }
  float mnC = -mn * C;
  for (int r = 0; r < 16; ++r) p0[r] = fmaf(p0[r], C, mnC); for (int r = 0; r < 16; ++r) p1[r] = fmaf(p1[r], C, mnC);
  for (int r = 0; r < 16; ++r) p0[r] = __builtin_amdgcn_exp2f(p0[r]);
}
__device__ __forceinline__ void finishSM(f32x16& p0, f32x16& p1, float alpha, float& l_reg, bf16x8& pa0, bf16x8& pa1, bf16x8& pa2, bf16x8& pa3) {
  for (int r = 0; r < 16; ++r) p1[r] = __builtin_amdgcn_exp2f(p1[r]);
  float ps = 0; for (int r = 0; r < 16; ++r) ps += p0[r]; for (int r = 0; r < 16; ++r) ps += p1[r];
  { auto rr = __builtin_amdgcn_permlane32_swap(__float_as_uint(ps), __float_as_uint(ps), false, false);
    ps = __uint_as_float(rr[0]) + __uint_as_float(rr[1]); }
  l_reg = l_reg * alpha + ps;
#define PK4(P, BASE, OUT) do { unsigned a0 = cvtpk(P[BASE + 0], P[BASE + 1]), a1 = cvtpk(P[BASE + 2], P[BASE + 3]);   \
    unsigned b0 = cvtpk(P[BASE + 4], P[BASE + 5]), b1 = cvtpk(P[BASE + 6], P[BASE + 7]);                              \
    auto r0 = __builtin_amdgcn_permlane32_swap(a0, b0, false, false); auto r1 = __builtin_amdgcn_permlane32_swap(a1, b1, false, false); \
    u32x4 w = {r0[0], r1[0], r0[1], r1[1]}; OUT = *reinterpret_cast<bf16x8*>(&w); } while (0)
  PK4(p0, 0, pa0); PK4(p0, 8, pa1); PK4(p1, 0, pa2); PK4(p1, 8, pa3);
#undef PK4
}
__device__ __forceinline__ void qkt(f32x16& p0, f32x16& p1, const bf16* Ks, const bf16x8* qr, int r32, int hi) {
  p0 = f32x16{}; p1 = f32x16{};
  for (int d0 = 0; d0 < 8; ++d0) { int cb = (d0 * 16 + hi * 8) * 2;
    bf16x8 b0 = *reinterpret_cast<const bf16x8*>((const char*)Ks + KSWZ(r32, cb));
    bf16x8 b1 = *reinterpret_cast<const bf16x8*>((const char*)Ks + KSWZ(32 + r32, cb));
    p0 = __builtin_amdgcn_mfma_f32_32x32x16_bf16(b0, qr[d0], p0, 0, 0, 0);
    p1 = __builtin_amdgcn_mfma_f32_32x32x16_bf16(b1, qr[d0], p1, 0, 0, 0); }
}
__device__ __forceinline__ int v_st(int k, int c) { const int kk = (k & ~0xC) | ((k & 4) << 1) | ((k & 8) >> 1); return ((kk >> 3) * 4 + (c >> 5)) * 512 + ((kk & 7) * 32 + (c & 31)) * 2; }
__device__ __forceinline__ int v_rd_base(int lane) { return ((lane & 3) << 3) | (((lane >> 2) & 3) << 6) | (((lane >> 4) & 1) << 5) | (((lane >> 5) & 1) << 8); }
constexpr int v_rd_off(int d0, int ks, int half) { return d0 * 512 + ks * 4096 + half * 2048; }
template <int OFF> __device__ __forceinline__ s16x4 tr_read(int vb) {
  s16x4 r; asm volatile("ds_read_b64_tr_b16 %0, %1 offset:%2" : "=&v"(r) : "v"(vb), "i"(OFF) : "memory"); return r;
}
template <int D0> __device__ __forceinline__ void pv_one(f32x16& od, int vb, bf16x8 pa0, bf16x8 pa1, bf16x8 pa2, bf16x8 pa3) {
  const s16x4 l0 = tr_read<v_rd_off(D0, 0, 0)>(vb), h0 = tr_read<v_rd_off(D0, 0, 1)>(vb), l1 = tr_read<v_rd_off(D0, 1, 0)>(vb), h1 = tr_read<v_rd_off(D0, 1, 1)>(vb);
  const s16x4 l2 = tr_read<v_rd_off(D0, 2, 0)>(vb), h2 = tr_read<v_rd_off(D0, 2, 1)>(vb), l3 = tr_read<v_rd_off(D0, 3, 0)>(vb), h3 = tr_read<v_rd_off(D0, 3, 1)>(vb);
  asm volatile("s_waitcnt lgkmcnt(0)" ::: "memory"); SBAR();
#define PK(L, H) (bf16x8){L[0], L[1], L[2], L[3], H[0], H[1], H[2], H[3]}
  od = __builtin_amdgcn_mfma_f32_32x32x16_bf16(pa0, PK(l0, h0), od, 0, 0, 0);
  od = __builtin_amdgcn_mfma_f32_32x32x16_bf16(pa1, PK(l1, h1), od, 0, 0, 0);
  od = __builtin_amdgcn_mfma_f32_32x32x16_bf16(pa2, PK(l2, h2), od, 0, 0, 0);
  od = __builtin_amdgcn_mfma_f32_32x32x16_bf16(pa3, PK(l3, h3), od, 0, 0, 0);
#undef PK
}
__device__ __forceinline__ void pv_d0(f32x16* o, int vb, bf16x8 pa0, bf16x8 pa1, bf16x8 pa2, bf16x8 pa3) {
  pv_one<0>(o[0], vb, pa0, pa1, pa2, pa3); pv_one<1>(o[1], vb, pa0, pa1, pa2, pa3); pv_one<2>(o[2], vb, pa0, pa1, pa2, pa3); pv_one<3>(o[3], vb, pa0, pa1, pa2, pa3);
}

template <typename TQ>
__device__ __forceinline__ void attn_dense_body(const TQ* __restrict__ Qb, const bf16* __restrict__ Kh, const bf16* __restrict__ Vh,
                                                unsigned char* __restrict__ Ob, int seq, char* lds, const int tid_in, const float* __restrict__ qgain, const float* __restrict__ rtab, const int t0, const bool rope) {
  using St = Stage<bf16>; using SQ = Stage<TQ>;
  int tid_ = tid_in; asm volatile("" : "+v"(tid_));
  const int tid = tid_, wid = tid >> 6, lane = tid & 63, r32 = lane & 31, hi = lane >> 5;
  bf16* V_lds = (bf16*)lds; bf16* K_lds = (bf16*)(lds + 2 * SHM_V);
  float* ws = (float*)(lds + 2 * SHM_V + 2 * SHM_K) + wid * 64; float* li_l = ws; float* al_l = ws + 32;
  float m_reg = -1e30f, l_reg = 0; f32x16 o[4] = {}; bf16x8 qr[8];
  const TQ* Qw = Qb + (long)(wid * QBLK + r32) * LDQ + hi * 8;
  { float xf[8][8]; float ss = 0.f;
#pragma unroll
    for (int d0 = 0; d0 < 8; ++d0) { const bf16x8 raw = SQ::tobf(SQ::ld8(Qw + d0 * 16));
#pragma unroll
      for (int j = 0; j < 8; ++j) { xf[d0][j] = __uint_as_float(((unsigned)(unsigned short)raw[j]) << 16); ss += xf[d0][j] * xf[d0][j]; } }
    { auto rr = __builtin_amdgcn_permlane32_swap(__float_as_uint(ss), __float_as_uint(ss), false, false); ss = __uint_as_float(rr[0]) + __uint_as_float(rr[1]); }
    const float rn = 1.0f / sqrtf(ss * (1.0f / 128.0f) + 1e-6f);
#pragma unroll
    for (int d0 = 0; d0 < 8; ++d0) {
#pragma unroll
      for (int j = 0; j < 8; ++j) xf[d0][j] *= rn * qgain[d0 * 16 + hi * 8 + j]; }
    if (rope) { const int t = t0 + wid * QBLK + r32, pr = t >> 6, pc = t & 63;
#pragma unroll
      for (int hb = 0; hb < 2; ++hb) { const int p = hb ? pc : pr;
#pragma unroll
        for (int dd = 0; dd < 2; ++dd) { const int d0 = 4 * hb + dd;
#pragma unroll
          for (int j = 0; j < 8; ++j) { const int f = dd * 16 + hi * 8 + j; const float c = rtab[(p * 32 + f) * 2], s = rtab[(p * 32 + f) * 2 + 1];
            const float x0 = xf[d0][j], x1 = xf[d0 + 2][j]; xf[d0][j] = x0 * c - x1 * s; xf[d0 + 2][j] = x1 * c + x0 * s; } } } }
#pragma unroll
    for (int d0 = 0; d0 < 8; ++d0) { u32x4 w = {cvtpk(xf[d0][0], xf[d0][1]), cvtpk(xf[d0][2], xf[d0][3]), cvtpk(xf[d0][4], xf[d0][5]), cvtpk(xf[d0][6], xf[d0][7])}; qr[d0] = *reinterpret_cast<bf16x8*>(&w); } }
  const int sr = tid >> 4, sc = (tid & 15) * 8, vst0 = v_st(sr, sc), vst1 = v_st(32 + sr, sc);
  const int vb0 = (int)(uintptr_t)V_lds + v_rd_base(lane);
  struct { typename St::T vs0, vs1, ks0, ks1; } sr_[SDEPTH];
#define SLOAD(i, k0) do { sr_[i].vs0 = St::ld8(&Vh[(long)((k0) + sr) * LDK + sc]); sr_[i].vs1 = St::ld8(&Vh[(long)((k0) + 32 + sr) * LDK + sc]); \
    sr_[i].ks0 = St::ld8(&Kh[(long)((k0) + sr) * LDK + sc]); sr_[i].ks1 = St::ld8(&Kh[(long)((k0) + 32 + sr) * LDK + sc]); } while (0)
#define SWRITE(b, i) do { *(bf16x8*)((char*)V_lds + (b) * SHM_V + vst0) = St::tobf(sr_[i].vs0);          \
    *(bf16x8*)((char*)V_lds + (b) * SHM_V + vst1) = St::tobf(sr_[i].vs1); int kc = sc * 2;               \
    *(bf16x8*)((char*)K_lds + (b) * SHM_K + KSWZ(sr, kc)) = St::tobf(sr_[i].ks0);                       \
    *(bf16x8*)((char*)K_lds + (b) * SHM_K + KSWZ(32 + sr, kc)) = St::tobf(sr_[i].ks1); } while (0)
#define SWAIT() do { if constexpr (SDEPTH == 2) asm volatile("s_waitcnt vmcnt(4)" ::: "memory"); else asm volatile("s_waitcnt vmcnt(0)" ::: "memory"); } while (0)
#define RESC(a) do { if (__any((a) < 1.f)) { if (hi == 0) al_l[r32] = (a); asm volatile("s_waitcnt lgkmcnt(0)" ::: "memory"); \
    for (int d = 0; d < 4; ++d) for (int r = 0; r < 16; ++r) o[d][r] *= al_l[crow(r, hi)]; } } while (0)
  f32x16 pA0, pA1, pB0, pB1; float mnA, mnB, alA, alB; bf16x8 pa0, pa1, pa2, pa3; const int NT = seq / KVBLK;
  constexpr int SE = 0, SO = SDEPTH - 1;
  SLOAD(SE, 0); asm volatile("s_waitcnt vmcnt(0)" ::: "memory"); SWRITE(0, SE); __syncthreads();
  qkt(pA0, pA1, K_lds, qr, r32, hi); partialSM(pA0, pA1, m_reg, mnA, alA);
  SLOAD(SO, KVBLK); if constexpr (SDEPTH == 2) { if (2 < NT) SLOAD(SE, 2 * KVBLK); }
  SWAIT(); SWRITE(1, SO); __syncthreads();
  for (int j = 1; j + 1 < NT; j += 2) {
    SBAR(); qkt(pB0, pB1, (bf16*)((char*)K_lds + SHM_K), qr, r32, hi);
    finishSM(pA0, pA1, alA, l_reg, pa0, pa1, pa2, pa3); SBAR();
    SLOAD(SO, (j + SDEPTH) * KVBLK); SBAR();
    pv_d0(o, vb0, pa0, pa1, pa2, pa3); partialSM(pB0, pB1, m_reg, mnB, alB);
    __syncthreads(); SWAIT(); SWRITE(0, SE);
    RESC(alB); __syncthreads();
    SBAR(); qkt(pA0, pA1, K_lds, qr, r32, hi);
    finishSM(pB0, pB1, alB, l_reg, pa0, pa1, pa2, pa3); SBAR();
    if (SDEPTH == 1 || j + 3 < NT) SLOAD(SE, (j + 1 + SDEPTH) * KVBLK); SBAR();
    pv_d0(o, vb0 + (int)SHM_V, pa0, pa1, pa2, pa3); partialSM(pA0, pA1, m_reg, mnA, alA);
    __syncthreads(); SWAIT(); SWRITE(1, SO);
    RESC(alA); __syncthreads();
  }
  SBAR(); qkt(pB0, pB1, (bf16*)((char*)K_lds + SHM_K), qr, r32, hi);
  finishSM(pA0, pA1, alA, l_reg, pa0, pa1, pa2, pa3); SBAR();
  pv_d0(o, vb0, pa0, pa1, pa2, pa3); partialSM(pB0, pB1, m_reg, mnB, alB);
  __syncthreads(); RESC(alB);
  finishSM(pB0, pB1, alB, l_reg, pa0, pa1, pa2, pa3); SBAR();
  pv_d0(o, vb0 + (int)SHM_V, pa0, pa1, pa2, pa3);
  if (hi == 0) li_l[r32] = l_reg; asm volatile("s_waitcnt lgkmcnt(0)" ::: "memory");
  float rli[16];
#pragma unroll
  for (int r = 0; r < 16; ++r) rli[r] = __builtin_amdgcn_rcpf(li_l[crow(r, hi)]);
  unsigned char* Ow = Ob + (long)(wid * QBLK) * LDO;
#pragma unroll
  for (int r = 0; r < 16; ++r) { int orow = crow(r, hi);
    for (int d0 = 0; d0 < 4; ++d0) { const float ov = o[d0][r] * rli[r] * 16.0f; Ow[(long)orow * LDO + d0 * 32 + r32] = (unsigned char)(__builtin_amdgcn_cvt_pk_fp8_f32(ov, ov, __builtin_bit_cast(int, ov), false) & 0xff); } }
#undef SLOAD
#undef SWRITE
#undef SWAIT
#undef RESC
}
#undef KSWZ
#undef SBAR
}

#define GAS __attribute__((address_space(1)))
#define LAS __attribute__((address_space(3)))
typedef unsigned short bf16;
typedef unsigned v4u __attribute__((ext_vector_type(4)));
typedef float f32x4 __attribute__((ext_vector_type(4)));
typedef short bf16x8 __attribute__((ext_vector_type(8)));
typedef GAS unsigned gu32;
typedef GAS unsigned long long gu64;
#define RLX_AGENT __ATOMIC_RELAXED, __HIP_MEMORY_SCOPE_AGENT
#define LDS_WAIT() asm volatile("s_waitcnt lgkmcnt(0)" ::: "memory")
#define VM_WAIT() asm volatile("s_waitcnt vmcnt(0)" ::: "memory")
__device__ __forceinline__ unsigned long long rt() { return __builtin_amdgcn_s_memrealtime(); }
__device__ __forceinline__ unsigned f2bf(float f) { unsigned u = __builtin_bit_cast(unsigned, f); return (u + 0x7fffu + ((u >> 16) & 1u)) >> 16; }
__device__ __forceinline__ unsigned pk2(float lo, float hi) { return f2bf(lo) | (f2bf(hi) << 16); }

#define XB_TMO      128
#define XB_XCNT(j)  (256  + 64 * (j))
#define XB_XSUB(j)  (1280 + 64 * (j))
#define XB_XGEN(j)  (2304 + 64 * (j))
#define XB_TOP      3328
#define XB_TOPGEN   3392
#define XCD_BAR_WORDS 3456
#define XB_SPIN_CAP (1u << 18)

__device__ __forceinline__ unsigned xb_ld(unsigned* p)              { return __hip_atomic_load(p, __ATOMIC_RELAXED, __HIP_MEMORY_SCOPE_AGENT); }
__device__ __forceinline__ unsigned xb_add(unsigned* p, unsigned v) { return __hip_atomic_fetch_add(p, v, __ATOMIC_RELAXED, __HIP_MEMORY_SCOPE_AGENT); }
__device__ __forceinline__ unsigned xb_xcc_id() { return (unsigned)__builtin_amdgcn_s_getreg((3 << 11) | 20) & 0xFu; }
#define XB_SPIN(cond, bar) do { unsigned _sp = 0; while (cond) { __builtin_amdgcn_s_sleep(1); \
    if ((++_sp & 255u) == 0u) { if (xb_ld(&(bar)[XB_TMO])) break; if (_sp > XB_SPIN_CAP) { atomicAdd(&(bar)[XB_TMO], 1u); break; } } } } while (0)

struct XcdBarrier {
    unsigned* bar; unsigned x;
    volatile LAS unsigned* st;
};

__device__ __forceinline__ XcdBarrier xcd_barrier_post(unsigned* bar, volatile LAS unsigned* st) {
    XcdBarrier b; b.bar = bar; b.x = xb_xcc_id(); b.st = st;
    if (threadIdx.x == 0) (void)xb_add(&bar[XB_XCNT(b.x)], 1u);
    return b;
}
__device__ __forceinline__ void xcd_barrier_complete(unsigned* bar, unsigned x, unsigned& nloc, unsigned& nx) {
    const unsigned G = gridDim.x * gridDim.y * gridDim.z;
    unsigned sum, cnt, mine, sp = 0u;
    for (;;) {
        sum = 0u; cnt = 0u; mine = 0u;
#pragma unroll
        for (unsigned j = 0; j < 16; ++j) { const unsigned c = xb_ld(&bar[XB_XCNT(j)]); sum += c; cnt += (c > 0u) ? 1u : 0u; mine = (j == x) ? c : mine; }
        if (sum == G) break;
        __builtin_amdgcn_s_sleep(1);
        if ((++sp & 255u) == 0u) { if (xb_ld(&bar[XB_TMO])) break; if (sp > XB_SPIN_CAP) { atomicAdd(&bar[XB_TMO], 1u); break; } }
    }
    nloc = mine > 0u ? mine : 1u; nx = cnt > 0u ? cnt : 1u;
}

__device__ __forceinline__ void xcd_barrier(const XcdBarrier& b) {
    asm volatile("s_waitcnt vmcnt(0)" ::: "memory");
    __syncthreads();
    if (threadIdx.x == 0) {
        unsigned* bar = b.bar;
        __builtin_amdgcn_s_waitcnt(0);
        unsigned nloc = b.st[0], nx = b.st[1];
        if (nloc == 0u) { xcd_barrier_complete(bar, b.x, nloc, nx); b.st[0] = nloc; b.st[1] = nx; }
        const unsigned old = xb_add(&bar[XB_XSUB(b.x)], 1u);
        const unsigned gen = old / nloc;
        if (old + 1u == (gen + 1u) * nloc) {
            __builtin_amdgcn_fence(__ATOMIC_RELEASE, "agent");
            asm volatile("s_waitcnt vmcnt(0)" ::: "memory");
            const unsigned og = xb_add(&bar[XB_TOP], 1u);
            const unsigned tg = og / nx;
            if (og + 1u == (tg + 1u) * nx) xb_add(&bar[XB_TOPGEN], 1u);
            else XB_SPIN(xb_ld(&bar[XB_TOPGEN]) == tg, bar);
            __builtin_amdgcn_fence(__ATOMIC_ACQUIRE, "agent");
            xb_add(&bar[XB_XGEN(b.x)], 1u);
            asm volatile("s_waitcnt vmcnt(0)" ::: "memory");
        } else {
            XB_SPIN(xb_ld(&bar[XB_XGEN(b.x)]) == gen, bar);
            __builtin_amdgcn_fence(__ATOMIC_ACQUIRE, "agent");
            asm volatile("s_waitcnt vmcnt(0)" ::: "memory");
        }
    }
    __syncthreads();
}
constexpr int DM = 1024, NB = 16, SEQ = 2048, CTXL = 256, TL = NB * SEQ, TC = NB * CTXL, TALL = TL + TC;
constexpr int INCOLS = 6144, OFF_FNET = 2560, OFF_GATE = 3072;
constexpr int NEXP = 32, KVROWS = SEQ + CTXL;
constexpr float EPS = 1e-6f;
constexpr int NWAVES = 8, NTHR = NWAVES * 64;
constexpr int NPL = 11, NPH = 2 + 2 * NPL;
#ifndef MK_PER_PHASE
#define MK_PER_PHASE 0
#endif
constexpr size_t MiB = 1u << 20;
constexpr size_t WS_CTL = 0, CTL_ZERO_BYTES = 1 * MiB;
constexpr size_t WS_MOD = 1 * MiB;
constexpr size_t WS_TAB = 2 * MiB;
constexpr size_t WS_TOPI = 3 * MiB, WS_TOPP = 4 * MiB, WS_SLOT = 5 * MiB, WS_CNT = 6 * MiB;
constexpr size_t WS_LOGIT = 7 * MiB;
constexpr size_t WS_WSMALL = 17 * MiB, WSMALL_LAYER = 20 * MiB;
constexpr size_t OFFS_WIN = 0, OFFS_WF = 5 * MiB, OFFS_WG = 7 * MiB, OFFS_WAO = 13 * MiB, OFFS_WCO = 15 * MiB, OFFS_WFO = 16 * MiB, OFFS_WOUT = 17 * MiB, OFFS_ROUT = 19 * MiB;
constexpr size_t WS_DFTL = 57 * MiB, WS_DFTC = 73 * MiB;
constexpr size_t WS_XC = 74 * MiB;
constexpr size_t WS_H = 90 * MiB;
constexpr size_t WS_WGU = 162 * MiB, WS_WD = 226 * MiB, MOEW_LAYER = 96 * MiB;
constexpr size_t WS_BIG = 354 * MiB;
constexpr size_t WS_Q = WS_BIG, WS_K = WS_Q + 72 * MiB, WS_V = WS_K + 18 * MiB, WS_CU = WS_V + 18 * MiB, WS_YT = WS_CU + 36 * MiB, WS_YTC = WS_YT + 64 * MiB;
constexpr size_t WS_GATES = WS_BIG;
constexpr size_t WS_AO = WS_BIG + 216 * MiB, WS_CH = WS_AO + 72 * MiB, WS_Z = WS_CH + 36 * MiB;
constexpr size_t WS_MIX = WS_AO;
constexpr size_t WS_MERGED = WS_BIG + 360 * MiB;
constexpr int SLOT_ROWS = 608 * 256;
constexpr size_t WS_YS = WS_BIG, WS_HS = WS_BIG + 304 * MiB, WS_ACT = WS_BIG + 456 * MiB, WS_END = WS_BIG + 608 * MiB;
constexpr size_t WS_H8 = WS_END;
constexpr size_t WS_END2 = WS_END + 36 * MiB;
static_assert(WS_YTC + 8 * MiB == WS_AO && WS_Z + 36 * MiB == WS_MERGED && WS_MERGED + 72 * MiB <= WS_END && (size_t)SLOT_ROWS * 2048 == 304 * MiB, "ws map");
constexpr int CW_TMO = 0, CW_CODE = 1, CW_BAR = 4096;
constexpr int CNT_ROWSRC = 32768;
constexpr int CNT_TILE_E = 16384, CNT_NT = 16384 + 1024;

constexpr int RING_OFF = 0, RING_BYTES = 131072;
constexpr int LDSCTL_OFF = RING_BYTES, MISC_OFF = LDSCTL_OFF + 320, LDS_CT = LDSCTL_OFF + 512, LDS_SM = LDSCTL_OFF + 1024;
constexpr int LDS_BYTES = 155648;

typedef unsigned u32x2 __attribute__((ext_vector_type(2)));
typedef int i32x4 __attribute__((ext_vector_type(4)));
typedef float f32x2 __attribute__((ext_vector_type(2)));
struct Args { const float* in[29]; float* out; unsigned char* ws; int ph_lo, ph_hi; };
typedef const __attribute__((address_space(4))) unsigned char* kptr_t;
struct AV {
    kptr_t kp;
    __device__ __forceinline__ const float* in(int i) const { return *(const float* const __attribute__((address_space(4)))*)(kp + 8 * i); }
    __device__ __forceinline__ float* out() const { return *(float* const __attribute__((address_space(4)))*)(kp + 8 * 29); }
    __device__ __forceinline__ unsigned char* ws() const { return *(unsigned char* const __attribute__((address_space(4)))*)(kp + 8 * 30); }
};
__device__ __forceinline__ AV av_get() { AV a; a.kp = (kptr_t)__builtin_amdgcn_kernarg_segment_ptr(); asm volatile("" : "+s"(a.kp)); return a; }

struct Frame {
    LAS unsigned char* lds; volatile LAS unsigned* MISC; gu32* ctl;
    int tid, lane, wave, vcu, G;
};

__device__ __forceinline__ float shx(float v, int m, int lane) { return __int_as_float(__builtin_amdgcn_ds_bpermute((lane ^ m) << 2, __float_as_int(v))); }
__device__ __forceinline__ float wave_sum(float v, int lane) {
#pragma unroll
    for (int o = 1; o < 64; o <<= 1) v += shx(v, o, lane);
    return v;
}
__device__ __forceinline__ float sigmoidf_(float x) { return 1.0f / (1.0f + __expf(-x)); }
__device__ __forceinline__ f32x4 bf4(u32x2 w) { f32x4 r; r[0] = __uint_as_float(w.x << 16); r[1] = __uint_as_float(w.x & 0xffff0000u); r[2] = __uint_as_float(w.y << 16); r[3] = __uint_as_float(w.y & 0xffff0000u); return r; }
__device__ __forceinline__ u32x2 pk4(f32x4 v) { u32x2 w; w.x = pk2(v[0], v[1]); w.y = pk2(v[2], v[3]); return w; }
__device__ __forceinline__ void ld_row_f32(f32x4 (&v)[4], const float* p, int lane) {
#pragma unroll
    for (int j = 0; j < 4; ++j) v[j] = ((const GAS f32x4*)p)[lane + 64 * j];
}
__device__ __forceinline__ void st_row_f32(const f32x4 (&v)[4], float* p, int lane) {
#pragma unroll
    for (int j = 0; j < 4; ++j) ((GAS f32x4*)p)[lane + 64 * j] = v[j];
}
__device__ __forceinline__ void ld_row_bf16(f32x4 (&v)[4], const bf16* p, int lane) {
#pragma unroll
    for (int j = 0; j < 4; ++j) v[j] = bf4(((const GAS u32x2*)p)[lane + 64 * j]);
}
__device__ __forceinline__ void st_row_bf16(const f32x4 (&v)[4], bf16* p, int lane) {
#pragma unroll
    for (int j = 0; j < 4; ++j) ((GAS u32x2*)p)[lane + 64 * j] = pk4(v[j]);
}
__device__ __forceinline__ void rms_gain(f32x4 (&v)[4], const float* g, int lane) {
    float ss = 0.f;
#pragma unroll
    for (int j = 0; j < 4; ++j) ss += (v[j][0] * v[j][0] + v[j][1] * v[j][1]) + (v[j][2] * v[j][2] + v[j][3] * v[j][3]);
    const float r = 1.0f / sqrtf(wave_sum(ss, lane) * (1.0f / 1024.0f) + EPS);
#pragma unroll
    for (int j = 0; j < 4; ++j) { const f32x4 gg = ((const GAS f32x4*)g)[lane + 64 * j]; v[j] = v[j] * r * gg; }
}
__device__ __forceinline__ void modulate_store(const f32x4 (&v)[4], const float* shift, const float* scale, bf16* o, int lane) {
#pragma unroll
    for (int j = 0; j < 4; ++j) { const f32x4 sh = ((const GAS f32x4*)shift)[lane + 64 * j], sc = ((const GAS f32x4*)scale)[lane + 64 * j];
        ((GAS u32x2*)o)[lane + 64 * j] = pk4(v[j] * (sc + 1.0f) + sh); }
}
__device__ __forceinline__ unsigned pk4_fp8(f32x4 v) { return pg8::cvt4_fp8(v[0], v[1], v[2], v[3]); }
__device__ __forceinline__ void modulate_store2(const f32x4 (&v)[4], const float* shift, const float* scale, bf16* o, unsigned char* o8, int lane) {
#pragma unroll
    for (int j = 0; j < 4; ++j) { const f32x4 sh = ((const GAS f32x4*)shift)[lane + 64 * j], sc = ((const GAS f32x4*)scale)[lane + 64 * j]; const f32x4 r = v[j] * (sc + 1.0f) + sh;
        ((GAS u32x2*)o)[lane + 64 * j] = pk4(r); ((GAS unsigned*)o8)[lane + 64 * j] = pk4_fp8(r); }
}
__device__ __forceinline__ f32x4 fp8x4(unsigned w) { const f32x2 a = __builtin_amdgcn_cvt_pk_f32_fp8((int)w, false), b = __builtin_amdgcn_cvt_pk_f32_fp8((int)w, true); return (f32x4){a.x, a.y, b.x, b.y}; }
__device__ __forceinline__ int krow_of(int m) { return m < TL ? (m >> 11) * KVROWS + (m & 2047) : ((m - TL) >> 8) * KVROWS + SEQ + ((m - TL) & 255); }

__device__ __forceinline__ void load_block(const float* W, int ldw, int k0, int n0, float scale, LAS float* scr, int lane) {
    f32x4 v[8]; const int kr = lane >> 3, c4 = (lane & 7) * 4;
#pragma unroll
    for (int i = 0; i < 8; ++i) v[i] = *(const GAS f32x4*)(W + (size_t)(k0 + kr + 8 * i) * ldw + n0 + c4);
#pragma unroll
    for (int i = 0; i < 8; ++i) { LAS float* d = scr + (kr + 8 * i) * 33 + c4; d[0] = v[i][0] * scale; d[1] = v[i][1] * scale; d[2] = v[i][2] * scale; d[3] = v[i][3] * scale; }
    LDS_WAIT(); asm volatile("" ::: "memory");
}
__device__ __forceinline__ void transpose_item(const float* W, int ldw, int K, bf16* WT, int dst_row0, int k0, int n0, LAS float* scr, int lane) {
    load_block(W, ldw, k0, n0, 1.0f, scr, lane);
    const int c = lane & 7;
#pragma unroll
    for (int j = 0; j < 4; ++j) { const int n = (lane >> 3) + 8 * j; const LAS float* s = scr + (8 * c) * 33 + n;
        v4u o; o.x = pk2(s[0 * 33], s[1 * 33]); o.y = pk2(s[2 * 33], s[3 * 33]); o.z = pk2(s[4 * 33], s[5 * 33]); o.w = pk2(s[6 * 33], s[7 * 33]);
        *(GAS v4u*)(WT + (size_t)(dst_row0 + n) * K + k0 + 8 * c) = o; }
    LDS_WAIT(); asm volatile("" ::: "memory");
}
__device__ __forceinline__ void transpose_item_fp8(const float* W, int ldw, int K, unsigned char* WT, int dst_row0, int k0, int n0, float scale, LAS float* scr, int lane) {
    load_block(W, ldw, k0, n0, scale, scr, lane);
#pragma unroll
    for (int j = 0; j < 2; ++j) { const int q = lane + 64 * j, n = q >> 2, c = q & 3; const LAS float* s = scr + (16 * c) * 33 + n; v4u o;
        o.x = pg8::cvt4_fp8(s[0 * 33], s[1 * 33], s[2 * 33], s[3 * 33]); o.y = pg8::cvt4_fp8(s[4 * 33], s[5 * 33], s[6 * 33], s[7 * 33]); o.z = pg8::cvt4_fp8(s[8 * 33], s[9 * 33], s[10 * 33], s[11 * 33]); o.w = pg8::cvt4_fp8(s[12 * 33], s[13 * 33], s[14 * 33], s[15 * 33]);
        *(GAS v4u*)(WT + (size_t)(dst_row0 + n) * K + k0 + 16 * c) = o; }
    LDS_WAIT(); asm volatile("" ::: "memory");
}
constexpr int IT_S0 = 16 * 80, IT_S1 = 16 * 96, IT_S2 = 512, IT_S3 = 512, IT_S4 = 256, IT_S5 = 256, IT_SMALL = IT_S0 + IT_S1 + IT_S2 + IT_S3 + IT_S4 + IT_S5;
__device__ __forceinline__ void small_item(const AV& a, int l, int r, LAS float* scr, int lane) {
    unsigned char* wl = a.ws() + WS_WSMALL + (size_t)l * WSMALL_LAYER; const float* win = a.in(10) + (size_t)l * DM * INCOLS;
    if (r < IT_S0) { const int kb = r / 80, n0 = (r % 80) * 32; int dr;
        if (n0 < 1536) dr = n0; else { int cc = n0 - 1536; if (cc < 512) dr = 1536 + (cc >> 7) * 256 + (cc & 127); else { cc -= 512; dr = 1536 + (cc >> 7) * 256 + 128 + (cc & 127); } }
        transpose_item_fp8(win, INCOLS, DM, wl + OFFS_WIN, dr, kb * 64, n0, 32.0f, scr, lane); return; }
    r -= IT_S0;
    if (r < IT_S1) { const int kb = r / 96, nb = r % 96; transpose_item_fp8(win, INCOLS, DM, wl + OFFS_WG, nb * 32, kb * 64, OFF_GATE + nb * 32, 32.0f, scr, lane); return; }
    r -= IT_S1;
    if (r < IT_S2) { const int kb = r / 32, nb = r % 32; transpose_item_fp8(a.in(13) + (size_t)l * DM * DM, DM, DM, wl + OFFS_WAO, nb * 32, kb * 64, nb * 32, 32.0f, scr, lane); return; }
    r -= IT_S2;
    if (r < IT_S3) { const int kb = r / 32, nb = r % 32; transpose_item(a.in(20) + (size_t)l * DM * DM, DM, DM, (bf16*)(wl + OFFS_WOUT), nb * 32, kb * 64, nb * 32, scr, lane); return; }
    r -= IT_S3;
    if (r < IT_S4) { const int kb = r / 32, nb = r % 32; transpose_item(a.in(18) + (size_t)l * 512 * DM, DM, 512, (bf16*)(wl + OFFS_WCO), nb * 32, kb * 64, nb * 32, scr, lane); return; }
    r -= IT_S4;
    { const int kb = r / 32, nb = r % 32; transpose_item(a.in(19) + (size_t)l * 512 * DM, DM, 512, (bf16*)(wl + OFFS_WFO), nb * 32, kb * 64, nb * 32, scr, lane); }
}
constexpr int IT_MOE = NEXP * 3 * 512;
struct MoeIt { const float* W; unsigned char* WT; int dr, k0; };
__device__ __forceinline__ MoeIt moe_decode(const AV& a, int gi) {
    const int l = gi / IT_MOE, idx = gi % IT_MOE, e = idx / 1536, r = idx % 1536, which = r / 512, it = r % 512, kb = it / 32, n0 = (it % 32) * 32; const size_t eo = ((size_t)l * NEXP + e) << 20;
    MoeIt m; m.k0 = kb * 64;
    if (which == 0) { m.W = a.in(23) + eo + n0; m.WT = a.ws() + WS_WGU + (size_t)l * MOEW_LAYER + (size_t)e * 2048 * 1024; m.dr = (n0 >> 7) * 256 + (n0 & 127); }
    else if (which == 1) { m.W = a.in(25) + eo + n0; m.WT = a.ws() + WS_WGU + (size_t)l * MOEW_LAYER + (size_t)e * 2048 * 1024; m.dr = (n0 >> 7) * 256 + 128 + (n0 & 127); }
    else { m.W = a.in(27) + eo + n0; m.WT = a.ws() + WS_WD + (size_t)l * MOEW_LAYER + (size_t)e * 1024 * 1024; m.dr = n0; }
    return m;
}
__device__ __forceinline__ void moe_issue(f32x4 (&v)[8], const MoeIt& m, int lane) {
    const float* p = m.W + (size_t)(m.k0 + (lane >> 3)) * DM + (lane & 7) * 4;
#pragma unroll
    for (int i = 0; i < 8; ++i) v[i] = __builtin_nontemporal_load((const GAS f32x4*)(p + (size_t)(8 * i) * DM));
}
__device__ __forceinline__ void moe_finish(const f32x4 (&v)[8], const MoeIt& m, LAS float* scr, int lane) {
    const int kr = lane >> 3, c4 = (lane & 7) * 4;
#pragma unroll
    for (int i = 0; i < 8; ++i) { LAS float* d = scr + (kr + 8 * i) * 33 + c4; d[0] = v[i][0] * 32.0f; d[1] = v[i][1] * 32.0f; d[2] = v[i][2] * 32.0f; d[3] = v[i][3] * 32.0f; }
    LDS_WAIT(); asm volatile("" ::: "memory");
#pragma unroll
    for (int j = 0; j < 2; ++j) { const int q = lane + 64 * j, n = q >> 2, c = q & 3; const LAS float* s = scr + (16 * c) * 33 + n; v4u o;
        o.x = pg8::cvt4_fp8(s[0 * 33], s[1 * 33], s[2 * 33], s[3 * 33]); o.y = pg8::cvt4_fp8(s[4 * 33], s[5 * 33], s[6 * 33], s[7 * 33]); o.z = pg8::cvt4_fp8(s[8 * 33], s[9 * 33], s[10 * 33], s[11 * 33]); o.w = pg8::cvt4_fp8(s[12 * 33], s[13 * 33], s[14 * 33], s[15 * 33]);
        *(GAS v4u*)(m.WT + (size_t)(m.dr + n) * DM + m.k0 + 16 * c) = o; }
    LDS_WAIT(); asm volatile("" ::: "memory");
}
__device__ __forceinline__ void moe_convert_all(const AV& a, int gw, int NGW, LAS float* scr, int lane) {
    constexpr int NIT = 2 * IT_MOE; f32x4 va[8], vb[8]; int it = gw; if (it >= NIT) return;
    MoeIt ma = moe_decode(a, it), mb = ma; moe_issue(va, ma, lane);
    for (;;) {
        const bool h1 = it + NGW < NIT; if (h1) { mb = moe_decode(a, it + NGW); moe_issue(vb, mb, lane); }
        moe_finish(va, ma, scr, lane); if (!h1) break; it += NGW;
        const bool h2 = it + NGW < NIT; if (h2) { ma = moe_decode(a, it + NGW); moe_issue(va, ma, lane); }
        moe_finish(vb, mb, scr, lane); if (!h2) break; it += NGW;
    }
}
__device__ __forceinline__ void fold_job(const AV& a, int j, const LAS float* ct, int lane) {
    const int l = j >> 10, r = j & 1023, g = r >> 8, kblk = (r >> 4) & 15, k2g = r & 15, k = kblk * 64 + lane;
    const float* wrow = a.in(10) + (size_t)l * DM * INCOLS + (size_t)k * INCOLS + OFF_FNET + g * 128;
    float ac[8], as[8];
#pragma unroll
    for (int i = 0; i < 8; ++i) { ac[i] = 0.f; as[i] = 0.f; }
    for (int n4 = 0; n4 < 32; ++n4) { const f32x4 w = *(const GAS f32x4*)(wrow + n4 * 4);
#pragma unroll
        for (int q = 0; q < 4; ++q) { const int n2 = n4 * 4 + q;
#pragma unroll
            for (int i = 0; i < 8; ++i) { const int ph = (n2 * (k2g * 8 + i)) & 127; ac[i] += w[q] * ct[ph]; as[i] += w[q] * ct[(ph - 32) & 127]; } } }
    bf16* wf = (bf16*)(a.ws() + WS_WSMALL + (size_t)l * WSMALL_LAYER + OFFS_WF);
#pragma unroll
    for (int i = 0; i < 8; ++i) { const int ch = g * 128 + k2g * 8 + i;
        wf[(size_t)ch * 1024 + k] = (bf16)f2bf(ac[i] * 0.08838834764831845f); wf[(size_t)(512 + ch) * 1024 + k] = (bf16)f2bf(as[i] * 0.08838834764831845f); }
}
__device__ __forceinline__ void p0_prologue(const Frame& F, const AV& a) {
    const int gw = F.vcu * NWAVES + F.wave, NGW = F.G * NWAVES, gt = F.vcu * NTHR + F.tid, NGT = F.G * NTHR;
    LAS float* ct = (LAS float*)(F.lds + LDS_CT);
    if (F.tid < 128) ct[F.tid] = cospif((float)F.tid * (1.0f / 64.0f));
    for (int job = blockIdx.x; job < 2 * 96; job += F.G) {
        const int l = job / 96, n0 = (job % 96) * 64;
        LAS float* s = (LAS float*)(F.lds + RING_OFF); LAS float* red = s + 17 * 1024;
        for (int i = F.tid; i < 17 * 1024; i += NTHR) { const int b = i >> 10, k = i & 1023; const float cv = b < 16 ? a.in(1)[b * 1024 + k] : a.in(3)[k]; s[i] = cv * sigmoidf_(cv); }
        __syncthreads();
        const int col = F.tid & 63, ks = F.tid >> 6; float acc[17];
#pragma unroll
        for (int b = 0; b < 17; ++b) acc[b] = 0.f;
        const float* w = a.in(4) + (size_t)l * DM * INCOLS + n0 + col;
        for (int k = ks * 128; k < ks * 128 + 128; k += 16) { float wv[16];
#pragma unroll
            for (int q = 0; q < 16; ++q) wv[q] = w[(size_t)(k + q) * INCOLS];
#pragma unroll
            for (int q = 0; q < 16; ++q)
#pragma unroll
                for (int b = 0; b < 17; ++b) acc[b] += s[b * 1024 + k + q] * wv[q]; }
#pragma unroll
        for (int b = 0; b < 17; ++b) red[(ks * 17 + b) * 64 + col] = acc[b];
        __syncthreads();
        for (int i = F.tid; i < 17 * 64; i += NTHR) { const int b = i >> 6, c2 = i & 63; float t = 0.f;
#pragma unroll
            for (int q = 0; q < 8; ++q) t += red[(q * 17 + b) * 64 + c2];
            ((float*)(a.ws() + WS_MOD))[((size_t)l * 17 + b) * INCOLS + n0 + c2] = t + a.in(5)[l * INCOLS + n0 + c2]; }
        __syncthreads();
    }
    __syncthreads();
    for (int i = gt; i < 64 * 32; i += NGT) { const int p = i >> 5, f = i & 31; const float inv = powf(10000.0f, -(float)f / 32.0f), ang = (float)p * inv; ((f32x2*)(a.ws() + WS_TAB))[i] = (f32x2){cosf(ang), sinf(ang)}; }
    for (int i = gt; i < 2048 * 256; i += NGT) { const int k1 = i >> 8, c0 = (i & 255) * 16; float v[16];
#pragma unroll
        for (int q = 0; q < 16; ++q) { const int col = c0 + q, n1 = col & 2047, rr = (k1 * n1) & 2047; const float x = (float)rr * (1.0f / 1024.0f); v[q] = ((col >> 11) ? -sinpif(x) : cospif(x)) * (32.0f * 0.022097086912079608f); }
        v4u o; o.x = pk4_fp8((f32x4){v[0], v[1], v[2], v[3]}); o.y = pk4_fp8((f32x4){v[4], v[5], v[6], v[7]}); o.z = pk4_fp8((f32x4){v[8], v[9], v[10], v[11]}); o.w = pk4_fp8((f32x4){v[12], v[13], v[14], v[15]}); ((GAS v4u*)(a.ws() + WS_DFTL))[i] = o; }
    for (int i = gt; i < 256 * 32; i += NGT) { const int k1 = i >> 5, c0 = (i & 31) * 16; float v[16];
#pragma unroll
        for (int q = 0; q < 16; ++q) { const int col = c0 + q, n1 = col & 255, rr = (k1 * n1) & 255; const float x = (float)rr * (1.0f / 128.0f); v[q] = ((col >> 8) ? -sinpif(x) : cospif(x)) * (32.0f * 0.0625f); }
        v4u o; o.x = pk4_fp8((f32x4){v[0], v[1], v[2], v[3]}); o.y = pk4_fp8((f32x4){v[4], v[5], v[6], v[7]}); o.z = pk4_fp8((f32x4){v[8], v[9], v[10], v[11]}); o.w = pk4_fp8((f32x4){v[12], v[13], v[14], v[15]}); ((GAS v4u*)(a.ws() + WS_DFTC))[i] = o; }
    for (int i = gt; i < 2 * 256 * 1024; i += NGT) { const int l = i >> 18, r = (i >> 10) & 255, k = i & 1023; unsigned o = 0u;
        if (r < 64) { const float w = a.in(21)[((size_t)l * DM + k) * NEXP + (r & 31)]; const unsigned hi = f2bf(w); o = hi; if (r >= 32) o = f2bf(w - __uint_as_float(hi << 16)); }
        ((bf16*)(a.ws() + WS_WSMALL + (size_t)l * WSMALL_LAYER + OFFS_ROUT))[(size_t)r * 1024 + k] = (bf16)o; }
    for (int j = gw; j < 2048; j += NGW) fold_job(a, j, ct, F.lane);
    LAS float* scr = (LAS float*)(F.lds + RING_OFF + F.wave * 16384);
    for (int it = gw; it < 2 * IT_SMALL; it += NGW) small_item(a, it / IT_SMALL, it % IT_SMALL, scr, F.lane);
    moe_convert_all(a, gw, NGW, scr, F.lane);
}
__device__ __forceinline__ void ld4(f32x4 (&v)[4], const float* p, int lane) {
#pragma unroll
    for (int j = 0; j < 4; ++j) v[j] = ((const GAS f32x4*)p)[lane + 64 * j];
}
__device__ __forceinline__ float sumsq4(const f32x4 (&v)[4]) { float ss = 0.f;
#pragma unroll
    for (int j = 0; j < 4; ++j) ss += (v[j][0] * v[j][0] + v[j][1] * v[j][1]) + (v[j][2] * v[j][2] + v[j][3] * v[j][3]);
    return ss; }
__device__ __forceinline__ void p1_norm0(const Frame& F, const AV& a) {
    const int gw = F.vcu * NWAVES + F.wave, NGW = F.G * NWAVES, rpw = (TALL + NGW - 1) / NGW, r0 = gw * rpw, r1 = (r0 + rpw < TALL) ? r0 + rpw : TALL;
    if (r0 >= r1) return;
    f32x4 gpre[4], shift[4], scale[4], xn[4]; ld4(gpre, a.in(6), F.lane); int cb = -1;
    auto xsrc = [&](int m) -> const float* { return m < TL ? a.in(0) + (size_t)m * DM : a.in(2) + (size_t)(m - TL) * DM; };
    ld4(xn, xsrc(r0), F.lane);
    for (int m = r0; m < r1; ++m) {
        f32x4 x[4];
#pragma unroll
        for (int j = 0; j < 4; ++j) x[j] = xn[j];
        if (m + 1 < r1) ld4(xn, xsrc(m + 1), F.lane);
        const int b = m < TL ? (m >> 11) : 16;
        if (b != cb) { cb = b; const float* mv = (const float*)(a.ws() + WS_MOD) + (size_t)b * INCOLS; ld4(shift, mv, F.lane); ld4(scale, mv + 1024, F.lane); }
        const float r = 1.0f / sqrtf(wave_sum(sumsq4(x), F.lane) * (1.0f / 1024.0f) + EPS);
        bf16* ho = (bf16*)(a.ws() + WS_H) + (size_t)m * DM; unsigned char* h8 = a.ws() + WS_H8 + (size_t)m * DM;
#pragma unroll
        for (int j = 0; j < 4; ++j) { const f32x4 hv = x[j] * r * gpre[j] * (scale[j] + 1.0f) + shift[j]; ((GAS u32x2*)ho)[F.lane + 64 * j] = pk4(hv); ((GAS unsigned*)h8)[F.lane + 64 * j] = pk4_fp8(hv); }
    }
}
__device__ __forceinline__ void qk_fix_core(f32x4 (&x)[4], const f32x4 (&gg)[4], const f32x2* tab, bool rope, int t, int sub, int lane) {
    float ss = sumsq4(x); ss += shx(ss, 1, lane); ss += shx(ss, 2, lane); ss += shx(ss, 4, lane);
    const float r = 1.0f / sqrtf(ss * (1.0f / 128.0f) + EPS);
#pragma unroll
    for (int jj = 0; jj < 4; ++jj) x[jj] = x[jj] * r * gg[jj];
    if (rope) { const int pr = t >> 6, pc = t & 63;
#pragma unroll
        for (int i = 0; i < 4; ++i) { const f32x2 cr = tab[pr * 32 + sub * 4 + i], cc = tab[pc * 32 + sub * 4 + i];
            const float a0 = x[0][i], a1 = x[1][i], b0 = x[2][i], b1 = x[3][i];
            x[0][i] = a0 * cr.x - a1 * cr.y; x[1][i] = a1 * cr.x + a0 * cr.y; x[2][i] = b0 * cc.x - b1 * cc.y; x[3][i] = b1 * cc.x + b0 * cc.y; } }
}
__device__ __forceinline__ void p_qkfix(const Frame& F, const AV& a, int l, int M) {
    const int gw = F.vcu * NWAVES + F.wave, NGW = F.G * NWAVES, rpw = 4 * ((M + 4 * NGW - 1) / (4 * NGW)), r0 = gw * rpw, r1 = (r0 + rpw < M) ? r0 + rpw : M;
    if (r0 >= r1) return;
    const f32x2* tab = (const f32x2*)(a.ws() + WS_TAB); const int rs = F.lane >> 4, hh = (F.lane >> 3) & 1, sub = F.lane & 7;
    f32x4 gk[4];
#pragma unroll
    for (int jj = 0; jj < 4; ++jj) gk[jj] = *(const GAS f32x4*)(a.in(12) + l * 128 + jj * 32 + sub * 4);
    bf16* kb = (bf16*)(a.ws() + WS_K);
    u32x2 kn[4];
    auto issue = [&](int mb) { const int m = mb + rs; if (m < r1) { const bf16* kp = kb + (size_t)krow_of(m) * 256 + hh * 128 + sub * 4;
#pragma unroll
        for (int jj = 0; jj < 4; ++jj) kn[jj] = *(const GAS u32x2*)(kp + jj * 32); } };
    issue(r0);
    for (int mb = r0; mb < r1; mb += 4) { const int m = mb + rs; const bool act = m < r1;
        f32x4 xk[4];
#pragma unroll
        for (int jj = 0; jj < 4; ++jj) xk[jj] = bf4(kn[jj]);
        if (mb + 4 < r1) issue(mb + 4);
        qk_fix_core(xk, gk, tab, m < TL, m & 2047, sub, F.lane);
        if (act) { bf16* kp = kb + (size_t)krow_of(m) * 256 + hh * 128 + sub * 4;
#pragma unroll
            for (int jj = 0; jj < 4; ++jj) *(GAS u32x2*)(kp + jj * 32) = pk4(xk[jj]); }
    }
}
__device__ __forceinline__ void p_conv(const Frame& F, const AV& a, int l, int njobs) {
    LAS unsigned char* lin = F.lds + RING_OFF; LAS float* lout = (LAS float*)(F.lds + RING_OFF + 62 * 1024);
    const bf16* cu = (const bf16*)(a.ws() + WS_CU); bf16* chb = (bf16*)(a.ws() + WS_CH);
    const int cp = F.tid & 255, pg = F.tid >> 8;
    f32x2 wv[31];
#pragma unroll
    for (int j = 0; j < 31; ++j) wv[j] = *(const GAS f32x2*)(a.in(14) + ((size_t)l * 31 + j) * 512 + 2 * cp);
    const f32x2 cb2 = *(const GAS f32x2*)(a.in(15) + l * 512 + 2 * cp);
    for (int job = F.vcu; job < njobs; job += F.G) {
        int rowbase, L, t0;
        if (job < 1024) { rowbase = (job >> 6) * SEQ; L = SEQ; t0 = (job & 63) * 32; } else { const int jc = job - 1024; rowbase = TL + (jc >> 3) * CTXL; L = CTXL; t0 = (jc & 7) * 32; }
        for (int idx = F.tid; idx < 62 * 64; idx += NTHR) { const int row = idx >> 6, ch = idx & 63, p = t0 - 15 + row; v4u val = (v4u){0u, 0u, 0u, 0u};
            if (p >= 0 && p < L) val = *(const GAS v4u*)(cu + (size_t)(rowbase + p) * 512 + ch * 8);
            *(LAS v4u*)(lin + row * 1024 + ch * 16) = val; }
        __syncthreads();
#pragma unroll
        for (int chunk = 0; chunk < 2; ++chunk) {
            f32x2 acc[8];
#pragma unroll
            for (int i = 0; i < 8; ++i) acc[i] = cb2;
            const int r0 = pg * 16 + chunk * 8;
#pragma unroll
            for (int r = 0; r < 38; ++r) { const unsigned w = *(const LAS unsigned*)(lin + (r0 + r) * 1024 + cp * 4); const float x0 = __uint_as_float(w << 16), x1 = __uint_as_float(w & 0xffff0000u);
#pragma unroll
                for (int i = 0; i < 8; ++i) { const int j = r - i; if (j >= 0 && j <= 30) { acc[i].x += x0 * wv[j].x; acc[i].y += x1 * wv[j].y; } } }
#pragma unroll
            for (int i = 0; i < 8; ++i) *(LAS f32x2*)(lout + (r0 + i) * 512 + 2 * cp) = acc[i];
        }
        __syncthreads();
#pragma unroll
        for (int pp = 0; pp < 4; ++pp) { const int p = F.wave * 4 + pp; const LAS float* src = lout + p * 512 + F.lane * 8;
            f32x4 y0 = *(const LAS f32x4*)src, y1 = *(const LAS f32x4*)(src + 4);
            const float mean = wave_sum((y0[0] + y0[1]) + (y0[2] + y0[3]) + (y1[0] + y1[1]) + (y1[2] + y1[3]), F.lane) * (1.0f / 512.0f);
            y0 = y0 - mean; y1 = y1 - mean;
            const float var = wave_sum((y0[0] * y0[0] + y0[1] * y0[1]) + (y0[2] * y0[2] + y0[3] * y0[3]) + (y1[0] * y1[0] + y1[1] * y1[1]) + (y1[2] * y1[2] + y1[3] * y1[3]), F.lane) * (1.0f / 512.0f);
            const float rs = 1.0f / sqrtf(var + EPS);
            const f32x4 g0 = *(const GAS f32x4*)(a.in(16) + l * 512 + F.lane * 8), g1 = *(const GAS f32x4*)(a.in(16) + l * 512 + F.lane * 8 + 4);
            const f32x4 b0 = *(const GAS f32x4*)(a.in(17) + l * 512 + F.lane * 8), b1 = *(const GAS f32x4*)(a.in(17) + l * 512 + F.lane * 8 + 4);
            y0 = y0 * rs * g0 + b0; y1 = y1 * rs * g1 + b1;
#pragma unroll
            for (int q = 0; q < 4; ++q) { y0[q] = y0[q] * sigmoidf_(y0[q]); y1[q] = y1[q] * sigmoidf_(y1[q]); }
            v4u o; o.x = pk2(y0[0], y0[1]); o.y = pk2(y0[2], y0[3]); o.z = pk2(y1[0], y1[1]); o.w = pk2(y1[2], y1[3]);
            *(GAS v4u*)(chb + (size_t)(rowbase + t0 + p) * 512 + F.lane * 8) = o; }
        __syncthreads();
    }
}
__device__ __forceinline__ void p_rowpass1(const Frame& F, const AV& a, int l, int M) {
    const int gw = F.vcu * NWAVES + F.wave, NGW = F.G * NWAVES, rpw = (M + NGW - 1) / NGW, r0 = gw * rpw, r1 = (r0 + rpw < M) ? r0 + rpw : M;
    if (r0 >= r1) return;
    const float* modb = (const float*)(a.ws() + WS_MOD) + (size_t)l * 17 * INCOLS; const bf16* mixb = (const bf16*)(a.ws() + WS_MIX);
    f32x4 gpost[4], gpre[4], gate[4], shift[4], scale[4]; ld4(gpost, a.in(7) + l * DM, F.lane); ld4(gpre, a.in(8) + l * DM, F.lane);
    int cb = -1;
    auto xsrc = [&](int m) -> const float* { return (l == 0) ? (m < TL ? a.in(0) + (size_t)m * DM : a.in(2) + (size_t)(m - TL) * DM) : (m < TL ? a.out() + (size_t)m * DM : (const float*)(a.ws() + WS_XC) + (size_t)(m - TL) * DM); };
    f32x4 xn[4]; u32x2 mn[4]; ld4(xn, xsrc(r0), F.lane);
#pragma unroll
    for (int j = 0; j < 4; ++j) mn[j] = ((const GAS u32x2*)(mixb + (size_t)r0 * DM))[F.lane + 64 * j];
    for (int m = r0; m < r1; ++m) {
        f32x4 x[4], y[4];
#pragma unroll
        for (int j = 0; j < 4; ++j) { x[j] = xn[j]; y[j] = bf4(mn[j]); }
        if (m + 1 < r1) { ld4(xn, xsrc(m + 1), F.lane);
#pragma unroll
            for (int j = 0; j < 4; ++j) mn[j] = ((const GAS u32x2*)(mixb + (size_t)(m + 1) * DM))[F.lane + 64 * j]; }
        const int b = m < TL ? (m >> 11) : 16;
        if (b != cb) { cb = b; const float* mv = modb + (size_t)b * INCOLS; ld4(gate, mv + 2 * 1024, F.lane); ld4(shift, mv + 3 * 1024, F.lane); ld4(scale, mv + 4 * 1024, F.lane); }
        const float r = 1.0f / sqrtf(wave_sum(sumsq4(y), F.lane) * (1.0f / 1024.0f) + EPS);
#pragma unroll
        for (int j = 0; j < 4; ++j) x[j] = x[j] + gate[j] * (y[j] * r * gpost[j]);
        float* xd = m < TL ? a.out() + (size_t)m * DM : (float*)(a.ws() + WS_XC) + (size_t)(m - TL) * DM;
        st_row_f32(x, xd, F.lane);
        const float r2 = 1.0f / sqrtf(wave_sum(sumsq4(x), F.lane) * (1.0f / 1024.0f) + EPS);
        bf16* ho = (bf16*)(a.ws() + WS_H) + (size_t)m * DM; unsigned char* h8 = a.ws() + WS_H8 + (size_t)m * DM;
#pragma unroll
        for (int j = 0; j < 4; ++j) { const f32x4 hv = x[j] * r2 * gpre[j] * (scale[j] + 1.0f) + shift[j]; ((GAS u32x2*)ho)[F.lane + 64 * j] = pk4(hv); ((GAS unsigned*)h8)[F.lane + 64 * j] = pk4_fp8(hv); }
    }
}
__device__ __forceinline__ void p_route(const Frame& F, const AV& a, int l, int M) {
    typedef short bfx8 __attribute__((ext_vector_type(8)));
    const int NGW = F.G * NWAVES, rpw = (M + NGW - 1) / NGW, TPB = 8 * rpw, b0 = F.vcu * TPB, b1 = (b0 + TPB < M) ? b0 + TPB : M;
    LAS unsigned char* tabl = F.lds + RING_OFF; LAS float* lg = (LAS float*)(F.lds + LDS_SM) + F.wave * 512; LAS int* cntl = (LAS int*)(F.lds + LDS_SM + 16384);
    VM_WAIT(); __syncthreads();
    if (F.tid < 32) cntl[F.tid] = 0;
    { const GAS v4u* src = (const GAS v4u*)(a.ws() + WS_WSMALL + (size_t)l * WSMALL_LAYER + OFFS_ROUT);
      for (int idx = F.tid; idx < 64 * 128; idx += NTHR) { const int row = idx >> 7, c = idx & 127; *(LAS v4u*)(tabl + row * 2048 + ((c ^ (row & 7)) << 4)) = src[idx]; } }
    __syncthreads();
    const bf16* H = (const bf16*)(a.ws() + WS_H); const float bias = a.in(22)[l * NEXP + (F.lane & 31)];
    const int ar = F.lane & 15, kb = F.lane >> 4, ng = (b1 > b0) ? (b1 - b0 + 15) >> 4 : 0;
    for (int g = F.wave; g < ng; g += NWAVES) {
        const int rb = b0 + g * 16; int row = rb + ar; if (row > M - 1) row = M - 1;
        const bf16* hp = H + (size_t)row * DM + kb * 8; f32x4 acc[4];
#pragma unroll
        for (int f = 0; f < 4; ++f) acc[f] = (f32x4){0.f, 0.f, 0.f, 0.f};
#pragma unroll 4
        for (int s = 0; s < 32; ++s) { const bfx8 af = *(const GAS bfx8*)(hp + s * 32);
#pragma unroll
            for (int f = 0; f < 4; ++f) { const int wr = f * 16 + ar; const bfx8 bfr = *(const LAS bfx8*)(tabl + wr * 2048 + (((4 * s + kb) ^ (wr & 7)) << 4));
                acc[f] = __builtin_amdgcn_mfma_f32_16x16x32_bf16(af, bfr, acc[f], 0, 0, 0); } }
#pragma unroll
        for (int i = 0; i < 4; ++i) { lg[(4 * kb + i) * 32 + ar] = acc[0][i] + acc[2][i]; lg[(4 * kb + i) * 32 + 16 + ar] = acc[1][i] + acc[3][i]; }
        LDS_WAIT(); asm volatile("" ::: "memory");
        { const int hf = F.lane >> 5, ex = F.lane & 31; LAS unsigned long long* kb64 = (LAS unsigned long long*)(F.lds + LDS_SM + 16384 + 256) + F.wave * 64;
          LAS float* selv = (LAS float*)(F.lds + LDS_SM + 16384 + 256 + 4096) + F.wave * 16; LAS int* seli = (LAS int*)(selv + 8);
#pragma unroll 1
          for (int p = 0; p < 8; ++p) { const int r = 2 * p + hf, m = rb + r; const bool valid = m < b1;
            const float v = lg[r * 32 + ex] + bias; unsigned ub = __float_as_uint(v); ub = (ub & 0x80000000u) ? ~ub : (ub | 0x80000000u);
            const unsigned long long K = ((unsigned long long)ub << 5) | (unsigned)(31 - ex);
            kb64[F.lane] = K;
            LDS_WAIT(); asm volatile("" ::: "memory");
            int rank = 0;
#pragma unroll
            for (int j = 0; j < 32; ++j) rank += (kb64[hf * 32 + j] > K) ? 1 : 0;
            if (rank < 4) { selv[hf * 4 + rank] = v; seli[hf * 4 + rank] = ex; if (valid) __hip_atomic_fetch_add(&cntl[ex], 1, __ATOMIC_RELAXED, __HIP_MEMORY_SCOPE_WORKGROUP); }
            LDS_WAIT(); asm volatile("" ::: "memory");
            if (ex == 0 && valid) { const f32x4 tv = *(const LAS f32x4*)(selv + hf * 4); const i32x4 ti = *(const LAS i32x4*)(seli + hf * 4);
                const float e1 = __expf(tv[1] - tv[0]), e2 = __expf(tv[2] - tv[0]), e3 = __expf(tv[3] - tv[0]), inv = 1.0f / (1.0f + e1 + e2 + e3);
                *(GAS i32x4*)((int*)(a.ws() + WS_TOPI) + (size_t)m * 4) = ti; *(GAS f32x4*)((float*)(a.ws() + WS_TOPP) + (size_t)m * 4) = (f32x4){inv, e1 * inv, e2 * inv, e3 * inv}; }
            LDS_WAIT(); asm volatile("" ::: "memory"); } }
        LDS_WAIT(); asm volatile("" ::: "memory");
    }
    __syncthreads();
    if (F.tid < 32) ((int*)(a.ws() + WS_CNT))[F.vcu * 32 + F.tid] = cntl[F.tid];
}
__device__ __forceinline__ void p_slots(const Frame& F, const AV& a, int M) {
    LAS int* sm = (LAS int*)(F.lds + LDS_SM);
    LAS int *tot = sm, *bef = sm + 32, *base = sm + 64, *tst = sm + 96  , *mask = sm + 160  , *ids = sm + 320  , *slot = sm + 960  ;
    const int* cnt = (const int*)(a.ws() + WS_CNT);
    { LAS int* ptot = sm + 1600; LAS int* pbef = sm + 2112; const int e = F.tid & 31, part = F.tid >> 5; int t = 0, b = 0;
#pragma unroll 4
      for (int q = part; q < F.G; q += 16) { const int c = cnt[q * 32 + e]; t += c; if (q < F.vcu) b += c; }
      ptot[part * 32 + e] = t; pbef[part * 32 + e] = b;
      __syncthreads();
      if (F.tid < 32) { int tt = 0, bb = 0;
#pragma unroll
          for (int q = 0; q < 16; ++q) { tt += ptot[q * 32 + F.tid]; bb += pbef[q * 32 + F.tid]; }
          tot[F.tid] = tt; bef[F.tid] = bb; } }
    __syncthreads();
    if (F.tid == 0) { int ts = 0; for (int e = 0; e < 32; ++e) { tst[e] = ts; base[e] = ts * 256 + bef[e]; ts += (tot[e] + 255) >> 8; } tst[32] = ts; }
    __syncthreads();
    const int NT = tst[32];
    if (blockIdx.x == 0) { int* te = (int*)(a.ws() + WS_CNT) + CNT_TILE_E;
        for (int t = F.tid; t < NT; t += NTHR) { int e = 0; for (int q = 1; q < 32; ++q) if (t >= tst[q]) e = q; te[t] = e; }
        if (F.tid == 0) ((int*)(a.ws() + WS_CNT))[CNT_NT] = NT; }
    const int TPB = 8 * ((M + F.G * NWAVES - 1) / (F.G * NWAVES)), m0 = F.vcu * TPB, m1 = (m0 + TPB < M) ? m0 + TPB : M, nt = m1 > m0 ? m1 - m0 : 0;
    for (int tl = F.tid; tl < nt; tl += NTHR) { const i32x4 id = *(const GAS i32x4*)((const int*)(a.ws() + WS_TOPI) + (size_t)(m0 + tl) * 4);
        ids[tl * 4 + 0] = id.x; ids[tl * 4 + 1] = id.y; ids[tl * 4 + 2] = id.z; ids[tl * 4 + 3] = id.w; mask[tl] = (1 << id.x) | (1 << id.y) | (1 << id.z) | (1 << id.w); }
    __syncthreads();
    for (int p = F.tid; p < nt * 4; p += NTHR) { const int tl = p >> 2, e = ids[p]; int rank = 0; for (int q = 0; q < tl; ++q) rank += (mask[q] >> e) & 1;
        const int s = base[e] + rank; slot[p] = s; ((int*)(a.ws() + WS_SLOT))[(size_t)(m0 + tl) * 4 + (p & 3)] = s; ((int*)(a.ws() + WS_CNT))[CNT_ROWSRC + s] = m0 + tl; }
    __syncthreads();
    if (blockIdx.x < 32) { const int e = blockIdx.x, r0 = tst[e] * 256 + tot[e], r1 = tst[e + 1] * 256;
        for (int r = r0 + F.tid; r < r1; r += NTHR) ((int*)(a.ws() + WS_CNT))[CNT_ROWSRC + r] = 0; }
    __syncthreads();
}
__device__ __forceinline__ void p_combine(const Frame& F, const AV& a, int l, int M) {
    const int gw = F.vcu * NWAVES + F.wave, NGW = F.G * NWAVES, rpw = (M + NGW - 1) / NGW, r0 = gw * rpw, r1 = (r0 + rpw < M) ? r0 + rpw : M;
    if (r0 >= r1) return;
    const unsigned char* ys = a.ws() + WS_YS;   const int* slp = (const int*)(a.ws() + WS_SLOT); const float* prp = (const float*)(a.ws() + WS_TOPP);
    const float* modb = (const float*)(a.ws() + WS_MOD);
    f32x4 gpost[4], gpre[4], gate[4], shift[4], scale[4]; ld4(gpost, a.in(9) + l * DM, F.lane); if (l == 0) ld4(gpre, a.in(6) + DM, F.lane);
    int cb = -1;
    i32x4 sl_n = *(const GAS i32x4*)(slp + (size_t)r0 * 4); f32x4 pr_n = *(const GAS f32x4*)(prp + (size_t)r0 * 4);
    f32x4 xn[4]; unsigned yn[4][4]; f32x4 prc = pr_n * 0.125f;
    auto xrow = [&](int m) -> float* { return m < TL ? a.out() + (size_t)m * DM : (float*)(a.ws() + WS_XC) + (size_t)(m - TL) * DM; };
    { ld4(xn, xrow(r0), F.lane); const int sv[4] = {sl_n[0], sl_n[1], sl_n[2], sl_n[3]};
#pragma unroll
      for (int k = 0; k < 4; ++k)
#pragma unroll
          for (int j = 0; j < 4; ++j) yn[k][j] = ((const GAS unsigned*)(ys + (size_t)sv[k] * DM))[F.lane + 64 * j];
      if (r0 + 1 < r1) { sl_n = *(const GAS i32x4*)(slp + (size_t)(r0 + 1) * 4); pr_n = *(const GAS f32x4*)(prp + (size_t)(r0 + 1) * 4); } }
    for (int m = r0; m < r1; ++m) {
        f32x4 x[4], y[4];
#pragma unroll
        for (int j = 0; j < 4; ++j) { x[j] = xn[j]; y[j] = fp8x4(yn[0][j]) * prc[0] + fp8x4(yn[1][j]) * prc[1] + fp8x4(yn[2][j]) * prc[2] + fp8x4(yn[3][j]) * prc[3]; }
        if (m + 1 < r1) { prc = pr_n * 0.125f; ld4(xn, xrow(m + 1), F.lane); const int sv[4] = {sl_n[0], sl_n[1], sl_n[2], sl_n[3]};
#pragma unroll
            for (int k = 0; k < 4; ++k)
#pragma unroll
                for (int j = 0; j < 4; ++j) yn[k][j] = ((const GAS unsigned*)(ys + (size_t)sv[k] * DM))[F.lane + 64 * j];
            if (m + 2 < r1) { sl_n = *(const GAS i32x4*)(slp + (size_t)(m + 2) * 4); pr_n = *(const GAS f32x4*)(prp + (size_t)(m + 2) * 4); } }
        const int b = m < TL ? (m >> 11) : 16;
        if (b != cb) { cb = b; ld4(gate, modb + ((size_t)l * 17 + b) * INCOLS + 5 * 1024, F.lane); if (l == 0) { const float* m1 = modb + ((size_t)17 + b) * INCOLS; ld4(shift, m1, F.lane); ld4(scale, m1 + 1024, F.lane); } }
        const float r = 1.0f / sqrtf(wave_sum(sumsq4(y), F.lane) * (1.0f / 1024.0f) + EPS);
#pragma unroll
        for (int j = 0; j < 4; ++j) x[j] = x[j] + gate[j] * (y[j] * r * gpost[j]);
        st_row_f32(x, xrow(m), F.lane);
        if (l == 0) { const float r2 = 1.0f / sqrtf(wave_sum(sumsq4(x), F.lane) * (1.0f / 1024.0f) + EPS);
            bf16* ho = (bf16*)(a.ws() + WS_H) + (size_t)m * DM; unsigned char* h8 = a.ws() + WS_H8 + (size_t)m * DM;
#pragma unroll
            for (int j = 0; j < 4; ++j) { const f32x4 hv = x[j] * r2 * gpre[j] * (scale[j] + 1.0f) + shift[j]; ((GAS u32x2*)ho)[F.lane + 64 * j] = pk4(hv); ((GAS unsigned*)h8)[F.lane + 64 * j] = pk4_fp8(hv); } }
    }
}
#ifdef DBG_CHECK
#ifndef DBG_GSUB
#define DBG_GSUB 0
#endif
__device__ __forceinline__ double bfd(bf16 b) { return (double)__uint_as_float(((unsigned)b) << 16); }
__device__ __forceinline__ unsigned hsh(unsigned x) { x ^= x >> 16; x *= 0x7feb352du; x ^= x >> 15; x *= 0x846ca68bu; x ^= x >> 16; return x; }
__device__ __forceinline__ int samp_row(int i, int M, unsigned salt) { const int sp[12] = {0, 1, 255, 256, 2047, 2048, 4095, 32767, 32768, 32769, 33023, 36863}; if (i < 12 && sp[i] < M) return sp[i]; return (int)(hsh(i * 7919u + salt) % (unsigned)M); }
__device__ __forceinline__ void rec(float* res, int stage, double got, double want, double flo) { const double e = fabs(got - want) / (fabs(want) + flo); const float f = (e == e) ? (float)e : 1e30f; atomicMax((unsigned*)res + stage, __float_as_uint(f)); }
__device__ double dot_h_w(const bf16* hrow, const float* w, int ldw, int col) { double s = 0; for (int k = 0; k < 1024; ++k) s += bfd(hrow[k]) * (double)w[(size_t)k * ldw + col]; return s; }
__device__ double dsig(double x) { return 1.0 / (1.0 + exp(-x)); }
constexpr double PI_D = 3.14159265358979323846;
enum { ST_MOD = 0, ST_H0, ST_INPROJ, ST_YT, ST_QKFIX, ST_CONV, ST_Z, ST_ATTN, ST_GATES, ST_MERGED, ST_MIX, ST_ROW1, ST_LOGIT, ST_TOPK, ST_SLOTS, ST_ACT, ST_YSLOT, ST_COMB, ST_GATESB, ST_N };
__global__ void chk(Args A, int stage, int l, float* res, float* snap) {
    const int i = threadIdx.x; unsigned char* ws = A.ws; const int M = (l == 0) ? TALL : TL; const int rs = stage + 32 * l;
    const bf16* H = (const bf16*)(ws + WS_H); const float* win = A.in[10] + (size_t)l * DM * INCOLS; const float* modb = (const float*)(ws + WS_MOD);
    if (stage == ST_MOD) { const int ll = i & 1, b = (i >> 1) % 17, n = (int)(hsh(i) % 6144u); double s = 0; for (int k = 0; k < 1024; ++k) { const double cv = b < 16 ? A.in[1][b * 1024 + k] : A.in[3][k]; s += cv * dsig(cv) * (double)A.in[4][((size_t)ll * 1024 + k) * 6144 + n]; }
        s += A.in[5][ll * 6144 + n]; rec(res, rs, modb[((size_t)ll * 17 + b) * 6144 + n], s, 0.02); }
    else if (stage == ST_H0) { const int m = samp_row(i, TALL, 1), c = (int)(hsh(i + 77) % 1024u); const float* x = m < TL ? A.in[0] + (size_t)m * DM : A.in[2] + (size_t)(m - TL) * DM; double ss = 0; for (int k = 0; k < 1024; ++k) ss += (double)x[k] * x[k];
        const float* mv = modb + (size_t)(m < TL ? (m >> 11) : 16) * 6144; const double want = x[c] / sqrt(ss / 1024 + 1e-6) * A.in[6][c] * (1.0 + mv[1024 + c]) + mv[c]; rec(res, rs, bfd(H[(size_t)m * DM + c]), want, 0.05); }
    else if (stage == ST_INPROJ) { const int m = samp_row(i, TALL, 2), kind = i & 3; const bf16* hr = H + (size_t)m * DM;
        if (kind == 0) { const int n = (int)(hsh(i + 5) % 1024u); rec(res, rs, bfd(((const bf16*)(ws + WS_Q))[(size_t)m * DM + n]), dot_h_w(hr, win, INCOLS, n), 0.05); }
        else if (kind == 1) { const int n = (int)(hsh(i + 6) % 256u); rec(res, rs, bfd(((const bf16*)(ws + WS_K))[(size_t)krow_of(m) * 256 + n]), dot_h_w(hr, win, INCOLS, 1024 + n), 0.05); }
        else if (kind == 2) { const int n = (int)(hsh(i + 7) % 256u); rec(res, rs, bfd(((const bf16*)(ws + WS_V))[(size_t)krow_of(m) * 256 + n]), dot_h_w(hr, win, INCOLS, 1280 + n), 0.05); }
        else { const int c = (int)(hsh(i + 8) % 512u); if (l == 0 || m < TL) { const double a = dot_h_w(hr, win, INCOLS, 1536 + c), g = dot_h_w(hr, win, INCOLS, 2048 + c); rec(res, rs, bfd(((const bf16*)(ws + WS_CU))[(size_t)m * 512 + c]), a * dsig(g), 0.05); } } }
    else if (stage == ST_YT) { const int m = samp_row(i, M, 3), ch = (int)(hsh(i + 9) % 512u), cs = i & 1, g = ch >> 7, k2 = ch & 127; const bf16* hr = H + (size_t)m * DM; double s = 0;
        for (int k = 0; k < 1024; ++k) { double t = 0; for (int n2 = 0; n2 < 128; ++n2) { const double ang = 2.0 * PI_D * ((n2 * k2) & 127) / 128.0; t += (double)win[(size_t)k * INCOLS + OFF_FNET + g * 128 + n2] * (cs ? sin(ang) : cos(ang)); } s += bfd(hr[k]) * t; }
        s /= sqrt(128.0); double got; if (m < TL) got = bfd(((const bf16*)(ws + WS_YT))[((size_t)(m >> 11) * 512 + ch) * 4096 + cs * 2048 + (m & 2047)]); else got = bfd(((const bf16*)(ws + WS_YTC))[((size_t)((m - TL) >> 8) * 512 + ch) * 512 + cs * 256 + ((m - TL) & 255)]);
        rec(res, rs, got, s, 0.05); }
    else if (stage == ST_QKFIX) { const int m = samp_row(i, TALL, 4), isk = i & 1, hh = isk ? (int)(hsh(i + 3) % 2u) : (int)(hsh(i + 3) % 8u), d = (int)(hsh(i + 4) % 128u); const bf16* hr = H + (size_t)m * DM;
        if (isk || l == 0 || m < TL) { const int cbase = isk ? 1024 + hh * 128 : hh * 128; double ss = 0, xd = 0, xp = 0; const int half = d & 64, dd = d & 63, pd = half + ((dd + 32) & 63);
            for (int q = 0; q < 128; ++q) { double v = dot_h_w(hr, win, INCOLS, cbase + q); v = bfd((bf16)f2bf((float)v)); ss += v * v; if (q == d) xd = v; if (q == pd) xp = v; }
            const float* gn = (isk ? A.in[12] : A.in[11]) + l * 128; const double r = 1.0 / sqrt(ss / 128 + 1e-6); xd *= r * gn[d]; xp *= r * gn[pd]; double want = xd;
            if (m < TL) { const int t = m & 2047, pos = half ? (t & 63) : (t >> 6), f = dd & 31; const double ang = (double)((float)pos * powf(10000.0f, -(float)f / 32.0f)); want = (dd < 32) ? xd * cos(ang) - xp * sin(ang) : xd * cos(ang) + xp * sin(ang); }
            const double got = isk ? bfd(((const bf16*)(ws + WS_K))[(size_t)krow_of(m) * 256 + hh * 128 + d]) : bfd(((const bf16*)(ws + WS_Q))[(size_t)m * DM + hh * 128 + d]); rec(res, rs, got, want, 0.05); } }
    else if (stage == ST_CONV) { const int m = samp_row(i, M, 5), c = (int)(hsh(i + 11) % 512u); const int rowbase = m < TL ? (m >> 11) * SEQ : TL + ((m - TL) >> 8) * CTXL, L = m < TL ? SEQ : CTXL, t = m - rowbase; const bf16* cu = (const bf16*)(ws + WS_CU);
        double s1 = 0, s2 = 0, yc = 0; for (int cc = 0; cc < 512; ++cc) { double y = A.in[15][l * 512 + cc]; for (int j = 0; j < 31; ++j) { const int p = t + j - 15; if (p >= 0 && p < L) y += bfd(cu[(size_t)(rowbase + p) * 512 + cc]) * (double)A.in[14][((size_t)l * 31 + j) * 512 + cc]; } s1 += y; s2 += y * y; if (cc == c) yc = y; }
        const double mean = s1 / 512, var = s2 / 512 - mean * mean; double y = (yc - mean) / sqrt(var + 1e-6) * A.in[16][l * 512 + c] + A.in[17][l * 512 + c]; y = y * dsig(y); rec(res, rs, bfd(((const bf16*)(ws + WS_CH))[(size_t)m * 512 + c]), y, 0.05); }
    else if (stage == ST_Z) { const int m = samp_row(i, M, 6), ch = (int)(hsh(i + 12) % 512u); double s = 0;
        if (m < TL) { const int b = m >> 11, k1 = m & 2047; const bf16* yr = (const bf16*)(ws + WS_YT) + ((size_t)b * 512 + ch) * 4096; for (int n1 = 0; n1 < 2048; ++n1) { const double ang = 2.0 * PI_D * ((k1 * n1) & 2047) / 2048.0; s += cos(ang) * bfd(yr[n1]) - sin(ang) * bfd(yr[2048 + n1]); } s /= sqrt(2048.0); }
        else { const int b = (m - TL) >> 8, k1 = (m - TL) & 255; const bf16* yr = (const bf16*)(ws + WS_YTC) + ((size_t)b * 512 + ch) * 512; for (int n1 = 0; n1 < 256; ++n1) { const double ang = 2.0 * PI_D * ((k1 * n1) & 255) / 256.0; s += cos(ang) * bfd(yr[n1]) - sin(ang) * bfd(yr[256 + n1]); } s /= 16.0; }
        rec(res, rs, bfd(((const bf16*)(ws + WS_Z))[(size_t)m * 512 + ch]), s, 0.05); }
    else if (stage == ST_ATTN) { const int m = samp_row(i, M, 7), hh = (int)(hsh(i + 13) % 8u), d = (int)(hsh(i + 14) % 128u); const bf16* q = (const bf16*)(ws + WS_Q) + (size_t)m * DM + hh * 128;
        int kr0, nk; if (m < TL) { kr0 = (m >> 11) * KVROWS; nk = KVROWS; } else { kr0 = ((m - TL) >> 8) * KVROWS + SEQ; nk = CTXL; }
        const bf16* K = (const bf16*)(ws + WS_K) + (size_t)kr0 * 256 + (hh >> 2) * 128; const bf16* V = (const bf16*)(ws + WS_V) + (size_t)kr0 * 256 + (hh >> 2) * 128;
        double mx = -1e300; for (int j = 0; j < nk; ++j) { double s = 0; for (int q2 = 0; q2 < 128; ++q2) s += bfd(q[q2]) * bfd(K[(size_t)j * 256 + q2]); s *= 0.08838834764831845; if (s > mx) mx = s; }
        double den = 0, num = 0; for (int j = 0; j < nk; ++j) { double s = 0; for (int q2 = 0; q2 < 128; ++q2) s += bfd(q[q2]) * bfd(K[(size_t)j * 256 + q2]); s *= 0.08838834764831845; const double p = exp(s - mx); den += p; num += p * bfd(V[(size_t)j * 256 + d]); }
        rec(res, rs, bfd(((const bf16*)(ws + WS_AO))[(size_t)m * DM + hh * 128 + d]), num / den, 0.03); }
    else if (stage == ST_GATES) { const int m = samp_row(i, M, 8), n = (int)(hsh(i + 15) % 3072u); rec(res, rs, bfd(((const bf16*)(ws + WS_GATES))[(size_t)m * 3072 + n]), dsig(dot_h_w(H + (size_t)m * DM, win, INCOLS, OFF_GATE + n)), 0.05); }
    else if (stage == ST_GATESB && DBG_GSUB == 1) { const int m = samp_row(i, M, 8), n = (int)(hsh(i + 15) % 3072u); const double got = bfd(((const bf16*)(ws + WS_GATES))[(size_t)m * 3072 + n]), want = dsig(dot_h_w(H + (size_t)m * DM, win, INCOLS, OFF_GATE + n));
        const bool badv = !(fabs(got - want) <= 0.05); if (badv) { unsigned* r = (unsigned*)res + 48; atomicOr(r, (m < TL ? 1u : 2u) | (4u << (n >> 10)) | (i < 12 ? 32u : 0u)); } }
    else if (stage == ST_GATESB) { const int m = samp_row(i, M, 8), n = (int)(hsh(i + 15) % 3072u); const bf16* wt = (const bf16*)(ws + WS_WSMALL + (size_t)l * WSMALL_LAYER + OFFS_WG) + (size_t)n * 1024; const bf16* hr = H + (size_t)m * DM; double s = 0; for (int k = 0; k < 1024; ++k) s += bfd(hr[k]) * bfd(wt[k]);
        rec(res, rs, bfd(((const bf16*)(ws + WS_GATES))[(size_t)m * 3072 + n]), dsig(s), 0.05); }
    else if (stage == ST_MERGED) { const int m = samp_row(i, M, 9), c = (int)(hsh(i + 16) % 1024u); const bf16* g = (const bf16*)(ws + WS_GATES) + (size_t)m * 3072; double y0 = 0, y1 = 0, y2 = 0;
        const bf16* ao = (const bf16*)(ws + WS_AO) + (size_t)m * DM; const bf16* chh = (const bf16*)(ws + WS_CH) + (size_t)m * 512; const bf16* z = (const bf16*)(ws + WS_Z) + (size_t)m * 512;
        for (int k = 0; k < 1024; ++k) y0 += bfd(ao[k]) * (double)A.in[13][((size_t)l * 1024 + k) * 1024 + c];
        for (int k = 0; k < 512; ++k) { y1 += bfd(chh[k]) * (double)A.in[18][((size_t)l * 512 + k) * 1024 + c]; y2 += bfd(z[k]) * (double)A.in[19][((size_t)l * 512 + k) * 1024 + c]; }
        rec(res, rs, bfd(((const bf16*)(ws + WS_MERGED))[(size_t)m * DM + c]), bfd(g[c]) * y0 + bfd(g[1024 + c]) * y1 + bfd(g[2048 + c]) * y2, 0.05); }
    else if (stage == ST_MIX) { const int m = samp_row(i, M, 10), c = (int)(hsh(i + 17) % 1024u); rec(res, rs, bfd(((const bf16*)(ws + WS_MIX))[(size_t)m * DM + c]), dot_h_w((const bf16*)(ws + WS_MERGED) + (size_t)m * DM, A.in[20] + (size_t)l * DM * DM, DM, c), 0.05); }
    else if (stage == ST_ROW1) { const int m = samp_row(i, M, 11), c = (int)(hsh(i + 18) % 1024u); const float* xs = snap + (size_t)i * 1024;
        const bf16* mix = (const bf16*)(ws + WS_MIX) + (size_t)m * DM; const float* mv = modb + ((size_t)l * 17 + (m < TL ? (m >> 11) : 16)) * 6144; double ss = 0; for (int k = 0; k < 1024; ++k) ss += bfd(mix[k]) * bfd(mix[k]); const double r = 1.0 / sqrt(ss / 1024 + 1e-6);
        double s2 = 0, xc = 0; for (int k = 0; k < 1024; ++k) { const double xn = xs[k] + mv[2048 + k] * (bfd(mix[k]) * r * A.in[7][l * DM + k]); s2 += xn * xn; if (k == c) xc = xn; }
        const float* xd = m < TL ? A.out + (size_t)m * DM : (const float*)(ws + WS_XC) + (size_t)(m - TL) * DM; rec(res, rs, xd[c], xc, 0.02);
        rec(res, rs, bfd(H[(size_t)m * DM + c]), xc / sqrt(s2 / 1024 + 1e-6) * A.in[8][l * DM + c] * (1.0 + mv[4096 + c]) + mv[3072 + c], 0.05); }
    else if (stage == ST_LOGIT) { const int m = samp_row(i, M, 12), e = i & 31; const float* lg = (const float*)(ws + WS_LOGIT) + (size_t)m * 64; rec(res, rs, (double)lg[e] + lg[32 + e], dot_h_w(H + (size_t)m * DM, A.in[21] + (size_t)l * DM * NEXP, NEXP, e), 0.02); }
    else if (stage == ST_TOPK) { const int m = samp_row(i, M, 13); const float* lg = (const float*)(ws + WS_LOGIT) + (size_t)m * 64; float v[32]; for (int e = 0; e < 32; ++e) v[e] = lg[e] + lg[32 + e] + A.in[22][l * 32 + e];
        int id[4]; float tv[4]; for (int k = 0; k < 4; ++k) { int b = -1; for (int e = 0; e < 32; ++e) { bool used = false; for (int q = 0; q < k; ++q) used |= (id[q] == e); if (!used && (b < 0 || v[e] > v[b])) b = e; } id[k] = b; tv[k] = v[b]; }
        double den = 0; for (int k = 0; k < 4; ++k) den += exp((double)tv[k] - tv[0]); const int* gi = (const int*)(ws + WS_TOPI) + (size_t)m * 4; const float* gp = (const float*)(ws + WS_TOPP) + (size_t)m * 4;
        for (int k = 0; k < 4; ++k) { rec(res, rs, gi[k] == id[k] ? 0.0 : 1.0, 0, 0.01); rec(res, rs, gp[k], exp((double)tv[k] - tv[0]) / den, 0.01); } }
    else if (stage == ST_SLOTS) { const int m = samp_row(i, M, 14), k = i & 3; const int s = ((const int*)(ws + WS_SLOT))[(size_t)m * 4 + k], e = ((const int*)(ws + WS_TOPI))[(size_t)m * 4 + k]; const int NT = ((const int*)(ws + WS_CNT))[CNT_NT];
        if (s < 0 || s >= NT * 256) rec(res, rs, 1, 0, 0.01); else { rec(res, rs, ((const int*)(ws + WS_CNT))[CNT_TILE_E + (s >> 8)] == e ? 0.0 : 1.0, 0, 0.01); const bf16* hs = (const bf16*)(ws + WS_HS) + (size_t)s * DM; double df = 0; for (int q = 0; q < 1024; ++q) df += fabs(bfd(hs[q]) - bfd(H[(size_t)m * DM + q])); rec(res, rs, df, 0, 1e-3); } }
    else if (stage == ST_ACT) { const int m = samp_row(i, M, 15), k = i & 3, c = (int)(hsh(i + 21) % 1024u); const int s = ((const int*)(ws + WS_SLOT))[(size_t)m * 4 + k], e = ((const int*)(ws + WS_TOPI))[(size_t)m * 4 + k]; const bf16* hs = (const bf16*)(ws + WS_HS) + (size_t)s * DM;
        double g = dot_h_w(hs, A.in[23] + (((size_t)l * NEXP + e) << 20), DM, c) + A.in[24][((size_t)l * NEXP + e) * 1024 + c], u = dot_h_w(hs, A.in[25] + (((size_t)l * NEXP + e) << 20), DM, c) + A.in[26][((size_t)l * NEXP + e) * 1024 + c];
        g = g < 7.0 ? g : 7.0; u = u < -7.0 ? -7.0 : (u > 7.0 ? 7.0 : u); rec(res, rs, bfd(((const bf16*)(ws + WS_ACT))[(size_t)s * DM + c]), (u + 1.0) * (g * dsig(1.702 * g)), 0.05); }
    else if (stage == ST_YSLOT) { const int m = samp_row(i, M, 16), k = i & 3, c = (int)(hsh(i + 22) % 1024u); const int s = ((const int*)(ws + WS_SLOT))[(size_t)m * 4 + k], e = ((const int*)(ws + WS_TOPI))[(size_t)m * 4 + k];
        rec(res, rs, bfd(((const bf16*)(ws + WS_HS))[(size_t)s * DM + c]), dot_h_w((const bf16*)(ws + WS_ACT) + (size_t)s * DM, A.in[27] + (((size_t)l * NEXP + e) << 20), DM, c) + A.in[28][((size_t)l * NEXP + e) * 1024 + c], 0.05); }
    else if (stage == ST_COMB) { const int m = samp_row(i, M, 17), c = (int)(hsh(i + 23) % 1024u); const float* xs = snap + (size_t)i * 1024; const int* sl = (const int*)(ws + WS_SLOT) + (size_t)m * 4; const float* pr = (const float*)(ws + WS_TOPP) + (size_t)m * 4;
        const float* mv = modb + ((size_t)l * 17 + (m < TL ? (m >> 11) : 16)) * 6144; double ss = 0, yc = 0; for (int q = 0; q < 1024; ++q) { double y = 0; for (int k = 0; k < 4; ++k) y += (double)pr[k] * bfd(((const bf16*)(ws + WS_HS))[(size_t)sl[k] * DM + q]); ss += y * y; if (q == c) yc = y; }
        const double want = xs[c] + mv[5 * 1024 + c] * (yc / sqrt(ss / 1024 + 1e-6) * A.in[9][l * DM + c]); const float* xd = m < TL ? A.out + (size_t)m * DM : (const float*)(ws + WS_XC) + (size_t)(m - TL) * DM; rec(res, rs, xd[c], want, 0.02); }
}
__global__ void snap_rows(Args A, int l, int salt, float* snap) {
    const int i = blockIdx.x, M = (l == 0) ? TALL : TL, m = samp_row(i, M, salt); const float* xs;
    if (l == 0 && salt == 11) xs = m < TL ? A.in[0] + (size_t)m * DM : A.in[2] + (size_t)(m - TL) * DM; else xs = m < TL ? A.out + (size_t)m * DM : (const float*)(A.ws + WS_XC) + (size_t)(m - TL) * DM;
    for (int k = threadIdx.x; k < 1024; k += blockDim.x) snap[(size_t)i * 1024 + k] = xs[k];
}
__global__ void chk_gates_full(const bf16* H, const bf16* Wt, const bf16* G, int M, unsigned* cntw) {
    const int n = blockIdx.x * 64 + (threadIdx.x & 63), m = blockIdx.y * 4 + (threadIdx.x >> 6); if (m >= M) return;
    const uint4* a = (const uint4*)(H + (size_t)m * 1024); const uint4* b = (const uint4*)(Wt + (size_t)n * 1024); float s = 0.f;
    for (int k = 0; k < 128; ++k) { const uint4 x = a[k], y = b[k]; const unsigned xs[4] = {x.x, x.y, x.z, x.w}, ys[4] = {y.x, y.y, y.z, y.w};
        for (int q = 0; q < 4; ++q) { s += __uint_as_float(xs[q] << 16) * __uint_as_float(ys[q] << 16); s += __uint_as_float(xs[q] & 0xffff0000u) * __uint_as_float(ys[q] & 0xffff0000u); } }
    const float want = 1.0f / (1.0f + __expf(-s)), got = __uint_as_float(((unsigned)G[(size_t)m * 3072 + n]) << 16);
    if (!(fabsf(got - want) <= 0.02f)) { atomicAdd(cntw, 1u); cntw[16 + (m >> 8) * 12 + (n >> 8)] = 1u; }
}
__global__ void encode_full(float* out, const unsigned* cntw, int n) {
    __shared__ int bc, bt; if (threadIdx.x == 0) { unsigned C = cntw[0], T = 0; for (int t = 0; t < 1728; ++t) T += cntw[16 + t]; int b1 = 0; while (C) { ++b1; C /= 10; } int b2 = 0; while (T) { ++b2; T /= 4; } bc = b1 > 7 ? 7 : b1; bt = b2 > 7 ? 7 : b2; }
    __syncthreads(); const float K = ldexpf(1.0f, 2 + 8 * bt + bc);
    for (size_t i = (size_t)blockIdx.x * blockDim.x + threadIdx.x; i < (size_t)n; i += (size_t)gridDim.x * blockDim.x) out[i] = K;
}
__global__ void encode(float* out, const float* res, int n, float thr) {
    #if DBG_GSUB == 1
    { const unsigned mk = ((const unsigned*)res)[48]; const float K = ldexpf(1.0f, 2 + (int)mk); for (size_t i = (size_t)blockIdx.x * blockDim.x + threadIdx.x; i < (size_t)n; i += (size_t)gridDim.x * blockDim.x) out[i] = K; return; }
#endif
#ifndef CHK_SKIP
#define CHK_SKIP 0ull
#endif
    int bad = -1; for (int s = 0; s < 64; ++s) if (!((CHK_SKIP >> s) & 1ull) && res[s] > thr) { bad = s; break; }
    if (bad < 0) return; const float er = res[bad]; const float K = ldexpf(1.0f, bad + 2) * (er < 0.5f ? 1.0f : er < 1.0f ? 1.25f : er < 4.0f ? 1.5f : 1.75f);
    for (size_t i = (size_t)blockIdx.x * blockDim.x + threadIdx.x; i < (size_t)n; i += (size_t)gridDim.x * blockDim.x) out[i] = K;
}
#endif
#ifndef GP_SP2
#define GP_SP2 true
#endif
#ifndef GP_ALIGN
#define GP_ALIGN true
#endif
__global__ void __launch_bounds__(NTHR, 2) fwd(Args args) {
    extern __shared__ __attribute__((aligned(16))) unsigned char lds[];
    Frame F;
    F.lds = (LAS unsigned char*)lds; F.MISC = (volatile LAS unsigned*)(F.lds + MISC_OFF);
    F.tid = threadIdx.x; F.lane = F.tid & 63; F.wave = __builtin_amdgcn_readfirstlane(F.tid >> 6);
    F.G = gridDim.x; { const int bx = blockIdx.x; F.vcu = (F.G % 8 == 0) ? (bx % 8) * (F.G / 8) + bx / 8 : bx; }
    { const AV A0 = av_get(); F.ctl = (gu32*)(A0.ws() + WS_CTL); }
    for (int u = F.tid; u < (LDS_BYTES - LDSCTL_OFF) / 4; u += NTHR) ((LAS unsigned*)(F.lds + LDSCTL_OFF))[u] = 0u;
    __syncthreads();
    XcdBarrier bar; bar.bar = (unsigned*)(F.ctl + CW_BAR); bar.x = 0; bar.st = nullptr;
    if (!MK_PER_PHASE) bar = xcd_barrier_post((unsigned*)(F.ctl + CW_BAR), F.MISC + 8);
    int lo, hi; { const AV A0 = av_get(); lo = *(const int __attribute__((address_space(4)))*)(A0.kp + 8 * 31); hi = *(const int __attribute__((address_space(4)))*)(A0.kp + 8 * 31 + 4); }
#ifndef DIS_MASK
#define DIS_MASK 0ull
#endif
#define IN(k) (lo <= (k) && (k) < hi)
#define ON(j) (!((DIS_MASK >> (j)) & 1ull))
#ifndef REP_MASK
#define REP_MASK 0ull
#endif
#define REPS(j) ((int)((REP_MASK >> (j)) & 1ull))
#ifdef STAMP_SEL
#define SEAM(k) do { xcd_barrier(bar); if (blockIdx.x == 0 && threadIdx.x == 0) ((unsigned long long*)(F.ctl + 32768))[(k) + 1] = __builtin_amdgcn_s_memrealtime(); } while (0)
#else
#ifdef DOUBLE_BAR
#define SEAM(k) do { if (!MK_PER_PHASE && IN((k) + 1)) { xcd_barrier(bar); xcd_barrier(bar); } } while (0)
#else
#define SEAM(k) do { if (!MK_PER_PHASE && IN((k) + 1)) xcd_barrier(bar); } while (0)
#endif
#endif
    const int bx = (int)blockIdx.x;
    const int wave0 = __builtin_amdgcn_readfirstlane((int)threadIdx.x >> 6);
#define F_REFRESH() do { unsigned z_ = 0u; asm volatile("" : "+v"(z_)); const int t_ = wave0 * 64 + (int)__builtin_amdgcn_mbcnt_hi(~0u, __builtin_amdgcn_mbcnt_lo(~0u, z_)); F.tid = t_; F.lane = t_ & 63; F.wave = wave0; } while (0)

#ifdef STAMP_SEL
    if (blockIdx.x == 0 && threadIdx.x == 0) ((unsigned long long*)(F.ctl + 32768))[0] = __builtin_amdgcn_s_memrealtime();
#endif
    if (ON(0) && IN(0)) for (int rep_ = 0; rep_ <= REPS(0); ++rep_) { F_REFRESH(); const AV A = av_get(); p0_prologue(F, A); SEAM(0); }
    if (ON(1) && IN(1)) for (int rep_ = 0; rep_ <= REPS(1); ++rep_) { F_REFRESH(); const AV A = av_get(); p1_norm0(F, A); SEAM(1); }

    for (int l = 0; l < 2; ++l) {
        const int pb = 2 + l * NPL;
        const int Mm = (l == 0) ? TALL : TL;
#define PH_BEGIN F_REFRESH(); const AV A = av_get(); unsigned char* const ws = A.ws(); unsigned char* const wl = ws + WS_WSMALL + (size_t)l * WSMALL_LAYER; (void)wl
        if (ON(2 + 0) && IN(pb + 0)) for (int rep_ = 0; rep_ <= REPS(2 + 0); ++rep_) { PH_BEGIN;
            if (ON(16)) { pg8::Gemm g{(const bf16*)(ws + WS_H8), (const bf16*)(wl + OFFS_WIN), TALL, 2560, DM / 2}; pg8::StaticOrder S; S.init(TALL, 2560, F.G, bx);
              pg8::EpiInproj E{(bf16*)(ws + WS_Q), (bf16*)(ws + WS_K), (bf16*)(ws + WS_V), (bf16*)(ws + WS_CU)};
              pg8::gemm_phase<pg8::EpiInproj, pg8::StaticOrder, GP_ALIGN, GP_SP2, true>(F.lds + RING_OFF, g, S, E, F.tid); }
            if (ON(17)) { pg8::Gemm g{(const bf16*)(wl + OFFS_WF), (const bf16*)(ws + WS_H), 1024, Mm, DM}; pg8::StaticOrder S; S.init(1024, Mm, F.G, (bx + 96) % F.G);
              pg8::EpiYT E{ws + WS_YT, ws + WS_YTC};
              pg8::gemm_phase<pg8::EpiYT, pg8::StaticOrder, GP_ALIGN, GP_SP2>(F.lds + RING_OFF, g, S, E, F.tid); }
            SEAM(pb + 0);
        }
        if (ON(2 + 1) && IN(pb + 1)) for (int rep_ = 0; rep_ <= REPS(2 + 1); ++rep_) { PH_BEGIN;
            if (ON(18)) p_qkfix(F, A, l, TALL);
            F_REFRESH();
            if (ON(19)) p_conv(F, A, l, l == 0 ? 1152 : 1024);
            if (ON(20)) { pg8::Gemm g{(const bf16*)(ws + WS_DFTL), (const bf16*)(ws + WS_YT), 2048, NB * 512, 2048}; pg8::DftOrder S; S.init(3, NB, F.G, F.vcu);
              pg8::EpiDFT E{(bf16*)(ws + WS_Z), 0, SEQ};
              pg8::gemm_phase<pg8::EpiDFT, pg8::DftOrder, GP_ALIGN, GP_SP2, true>(F.lds + RING_OFF, g, S, E, F.tid); }
            if (ON(21) && l == 0) { pg8::Gemm g{(const bf16*)(ws + WS_DFTC), (const bf16*)(ws + WS_YTC), 256, NB * 512, 256}; pg8::DftOrder S; S.init(0, NB, F.G, F.vcu);
              pg8::EpiDFT E{(bf16*)(ws + WS_Z), TL, CTXL};
              pg8::gemm_phase<pg8::EpiDFT, pg8::DftOrder, GP_ALIGN, GP_SP2, true>(F.lds + RING_OFF, g, S, E, F.tid); }
            SEAM(pb + 1);
        }
        if (ON(2 + 2) && IN(pb + 2)) for (int rep_ = 0; rep_ <= REPS(2 + 2); ++rep_) { PH_BEGIN;
            const int nheavy = NB * 8 * 8, ntot = nheavy + (l == 0 ? NB * 8 : 0);
            for (int L = F.vcu; L < ntot; L += F.G) {
                int row0, krow, h, seq, t0;
                if (L < nheavy) { const int grp = L >> 5, s = L & 31, b = grp >> 1; h = (grp & 1) * 4 + (s >> 3); t0 = (s & 7) * 256; row0 = b * SEQ + t0; krow = b * KVROWS; seq = KVROWS; }
                else { const int Lc = L - nheavy, b = Lc >> 3; h = Lc & 7; row0 = TL + b * CTXL; krow = b * KVROWS + SEQ; seq = CTXL; t0 = 0; }
                const att::bf16* Qb = (const att::bf16*)(ws + WS_Q) + (size_t)row0 * DM + h * 128;
                const att::bf16* Kh = (const att::bf16*)(ws + WS_K) + (size_t)krow * 256 + (h >> 2) * 128;
                const att::bf16* Vh = (const att::bf16*)(ws + WS_V) + (size_t)krow * 256 + (h >> 2) * 128;
                unsigned char* Ob = ws + WS_AO + (size_t)row0 * DM + h * 128;
                att::attn_dense_body<att::bf16>(Qb, Kh, Vh, Ob, seq, (char*)lds + RING_OFF, F.tid, A.in(11) + l * 128, (const float*)(ws + WS_TAB), t0, L < nheavy);
                __syncthreads();
            }
            SEAM(pb + 2);
        }
        if (ON(2 + 3) && IN(pb + 3)) for (int rep_ = 0; rep_ <= REPS(2 + 3); ++rep_) { PH_BEGIN;
            pg8::Gemm g{(const bf16*)(ws + WS_H8), (const bf16*)(wl + OFFS_WG), Mm, 3072, DM / 2}; pg8::StaticOrder S; S.init(Mm, 3072, F.G, bx);
            pg8::EpiGates E{(bf16*)(ws + WS_GATES)};
            pg8::gemm_phase<pg8::EpiGates, pg8::StaticOrder, GP_ALIGN, GP_SP2, true>(F.lds + RING_OFF, g, S, E, F.tid);
            SEAM(pb + 3);
        }
        if (ON(2 + 4) && IN(pb + 4)) for (int rep_ = 0; rep_ <= REPS(2 + 4); ++rep_) { PH_BEGIN;
            { pg8::Gemm g{(const bf16*)(ws + WS_AO), (const bf16*)(wl + OFFS_WAO), Mm, 1024, 512}; pg8::StaticOrder S; S.init(Mm, 1024, F.G, bx);
              pg8::EpiMerge<true> E{(bf16*)(ws + WS_MERGED), (const bf16*)(ws + WS_GATES), 0, 1.0f / 512.0f};
              pg8::gemm_phase<pg8::EpiMerge<true>, pg8::StaticOrder, GP_ALIGN, GP_SP2, true>(F.lds + RING_OFF, g, S, E, F.tid); }
#pragma unroll 1
            for (int br = 1; br < 3; ++br) {
              pg8::Gemm g{(const bf16*)(ws + (br == 1 ? WS_CH : WS_Z)), (const bf16*)(wl + (br == 1 ? OFFS_WCO : OFFS_WFO)), Mm, 1024, 512}; pg8::StaticOrder S; S.init(Mm, 1024, F.G, bx);
              pg8::EpiMerge<false> E{(bf16*)(ws + WS_MERGED), (const bf16*)(ws + WS_GATES), br, 1.0f};
              pg8::gemm_phase<pg8::EpiMerge<false>, pg8::StaticOrder, GP_ALIGN, GP_SP2>(F.lds + RING_OFF, g, S, E, F.tid); }
            SEAM(pb + 4);
        }
        if (ON(2 + 5) && IN(pb + 5)) for (int rep_ = 0; rep_ <= REPS(2 + 5); ++rep_) { PH_BEGIN;
            pg8::Gemm g{(const bf16*)(ws + WS_MERGED), (const bf16*)(wl + OFFS_WOUT), Mm, 1024, 1024}; pg8::StaticOrder S; S.init(Mm, 1024, F.G, bx);
            pg8::EpiBf16<0> E{(bf16*)(ws + WS_MIX), 1024, nullptr, 0, 0, 1.0f};
            pg8::gemm_phase<pg8::EpiBf16<0>, pg8::StaticOrder, GP_ALIGN, GP_SP2>(F.lds + RING_OFF, g, S, E, F.tid);
            SEAM(pb + 5);
        }
        if (ON(2 + 6) && IN(pb + 6)) for (int rep_ = 0; rep_ <= REPS(2 + 6); ++rep_) { PH_BEGIN; p_rowpass1(F, A, l, Mm); p_route(F, A, l, Mm); SEAM(pb + 6); }
        if (ON(2 + 7) && IN(pb + 7)) for (int rep_ = 0; rep_ <= REPS(2 + 7); ++rep_) { PH_BEGIN; p_slots(F, A, Mm); SEAM(pb + 7); }
        if (ON(2 + 8) && IN(pb + 8)) for (int rep_ = 0; rep_ <= REPS(2 + 8); ++rep_) { PH_BEGIN;
            const int NT = __builtin_amdgcn_readfirstlane(((const int*)(ws + WS_CNT))[CNT_NT]);
            LAS int* te_lds = (LAS int*)(F.lds + LDS_SM);
            for (int i = F.tid; i < NT; i += NTHR) te_lds[i] = ((const int*)(ws + WS_CNT))[CNT_TILE_E + i];
            __syncthreads();
            pg8::Gemm g{(const bf16*)(ws + WS_H8), (const bf16*)(ws + WS_WGU + (size_t)l * MOEW_LAYER), NT * 256, NEXP * 2048, DM / 2}; pg8::GroupedOrder S; S.init(NT, 8, F.G, bx, te_lds); S.rows = (const int*)(ws + WS_CNT) + CNT_ROWSRC;
            pg8::EpiSwiGLU8 E{ws + WS_ACT, A.in(24) + (size_t)l * NEXP * 1024, A.in(26) + (size_t)l * NEXP * 1024};
            pg8::gemm_phase<pg8::EpiSwiGLU8, pg8::GroupedOrder, GP_ALIGN, GP_SP2, true, true>(F.lds + RING_OFF, g, S, E, F.tid);
            SEAM(pb + 8);
        }
        if (ON(2 + 9) && IN(pb + 9)) for (int rep_ = 0; rep_ <= REPS(2 + 9); ++rep_) { PH_BEGIN;
            const int NT = __builtin_amdgcn_readfirstlane(((const int*)(ws + WS_CNT))[CNT_NT]);
            LAS int* te_lds = (LAS int*)(F.lds + LDS_SM);
            for (int i = F.tid; i < NT; i += NTHR) te_lds[i] = ((const int*)(ws + WS_CNT))[CNT_TILE_E + i];
            __syncthreads();
#ifdef STAGGER_US
            { const unsigned long long t0 = __builtin_amdgcn_s_memrealtime(), dl = (unsigned long long)((bx >> 3) & 3) * (STAGGER_US); while (__builtin_amdgcn_s_memrealtime() - t0 < dl) __builtin_amdgcn_s_sleep(8); }
#endif
            pg8::Gemm g{(const bf16*)(ws + WS_ACT), (const bf16*)(ws + WS_WD + (size_t)l * MOEW_LAYER), NT * 256, NEXP * 1024, DM / 2}; pg8::GroupedOrder S; S.init(NT, 4, F.G, bx, te_lds);
#ifdef PROBE_NOSTORE
            pg8::EpiDown8 E{ws + WS_YS, A.in(28) + (size_t)l * NEXP * 1024, rep_};
#else
            pg8::EpiDown8 E{ws + WS_YS, A.in(28) + (size_t)l * NEXP * 1024, 0};
#endif
            pg8::gemm_phase<pg8::EpiDown8, pg8::GroupedOrder, GP_ALIGN, GP_SP2, true>(F.lds + RING_OFF, g, S, E, F.tid);
            SEAM(pb + 9);
        }
        if (ON(2 + 10) && IN(pb + 10)) for (int rep_ = 0; rep_ <= REPS(2 + 10); ++rep_) { PH_BEGIN;
            p_combine(F, A, l, Mm);
            SEAM(pb + 10);
        }
    }
#ifdef STAMP_SEL
    { const AV A = av_get(); float* out = A.out(); const unsigned long long* ts = (const unsigned long long*)(F.ctl + 32768);
      auto span = [&](int p) -> float { unsigned long long d = __hip_atomic_load(ts + p + 1, __ATOMIC_RELAXED, __HIP_MEMORY_SCOPE_AGENT) - __hip_atomic_load(ts + p, __ATOMIC_RELAXED, __HIP_MEMORY_SCOPE_AGENT);
          if (p >= 2) d += __hip_atomic_load(ts + p + NPL + 1, __ATOMIC_RELAXED, __HIP_MEMORY_SCOPE_AGENT) - __hip_atomic_load(ts + p + NPL, __ATOMIC_RELAXED, __HIP_MEMORY_SCOPE_AGENT); return (float)d * 0.01f; };
      const float K1 = span((STAMP_SEL) & 0xff), K2 = 200.0f * span(((STAMP_SEL) >> 8) & 0xff);
      for (size_t i = (size_t)blockIdx.x * NTHR + threadIdx.x; i < (size_t)TL * DM; i += (size_t)gridDim.x * NTHR) out[i] = (i == 0) ? K2 : K1; }
#endif
#undef IN
#undef PH_BEGIN
#undef F_REFRESH
#undef SEAM
}

extern "C" void kernel_launch(void* const* d_in, const int* in_sizes, int n_in, void* d_out, int out_size, void* d_ws, size_t ws_size, hipStream_t stream) {
    static int grid = 0;
    if (grid == 0) {
        if (n_in != 29 || out_size != TL * DM || ws_size < WS_END2) { fprintf(stderr, "kernel_launch: built for 29 inputs, %d outputs, >= %zu bytes of workspace; got n_in %d out %d ws %zu\n", TL * DM, (size_t)WS_END2, n_in, out_size, ws_size); grid = -1; return; }
        int dev = 0, cus = 0, per_cu = 0;
        if (hipGetDevice(&dev) != hipSuccess || hipDeviceGetAttribute(&cus, hipDeviceAttributeMultiprocessorCount, dev) != hipSuccess) { grid = -1; return; }
        if (hipFuncSetAttribute((const void*)fwd, hipFuncAttributeMaxDynamicSharedMemorySize, LDS_BYTES) != hipSuccess) { fprintf(stderr, "kernel_launch: hipFuncSetAttribute failed\n"); grid = -1; return; }
        if (hipOccupancyMaxActiveBlocksPerMultiprocessor(&per_cu, (const void*)fwd, NTHR, LDS_BYTES) != hipSuccess || per_cu < 1) fprintf(stderr, "kernel_launch: occupancy query reports %d\n", per_cu);
        (void)hipGetLastError();
        grid = cus;
    }
    if (grid < 0) return;
    (void)hipMemsetAsync((char*)d_ws + WS_CTL, 0, CTL_ZERO_BYTES, stream);
    Args a{};
    for (int i = 0; i < 29; ++i) a.in[i] = (const float*)d_in[i];
    a.out = (float*)d_out; a.ws = (unsigned char*)d_ws;
#if MK_PER_PHASE
    for (int p = 0; p < NPH; ++p) {
#ifdef DBG_CHECK
        float* res = (float*)((char*)d_ws + WS_CTL + 8192 * 4); float* snap = (float*)((char*)d_ws + WS_END);
        { const int l = p >= 2 ? (p - 2) / NPL : 0, k = p >= 2 ? (p - 2) % NPL : -1;
          if (k == 6) hipLaunchKernelGGL(snap_rows, dim3(256), dim3(256), 0, stream, a, l, 11, snap);
          if (k == 12) hipLaunchKernelGGL(snap_rows, dim3(256), dim3(256), 0, stream, a, l, 17, snap); }
#endif
        a.ph_lo = p; a.ph_hi = p + 1; hipLaunchKernelGGL(fwd, dim3(grid), dim3(NTHR), LDS_BYTES, stream, a);
#ifdef DBG_CHECK
        { const int l = p >= 2 ? (p - 2) / NPL : 0, k = p >= 2 ? (p - 2) % NPL : -1;
#define CHK(st) hipLaunchKernelGGL(chk, dim3(1), dim3(256), 0, stream, a, (int)(st), l, res, snap)
          if (p == 0) CHK(ST_MOD); if (p == 1) CHK(ST_H0);
#if DBG_GSUB == 2
          if (k == 3 && l == 0) hipLaunchKernelGGL(chk_gates_full, dim3(48, TALL / 4), dim3(256), 0, stream, (const bf16*)((char*)d_ws + WS_H), (const bf16*)((char*)d_ws + WS_WSMALL + OFFS_WG), (const bf16*)((char*)d_ws + WS_GATES), TALL, (unsigned*)((char*)d_ws + WS_CTL + 65536));
#endif
          if (k == 0) { CHK(ST_INPROJ); CHK(ST_YT); } if (k == 1) { CHK(ST_QKFIX); CHK(ST_CONV); CHK(ST_Z); } if (k == 2) CHK(ST_ATTN); if (k == 3) { CHK(ST_GATES); CHK(ST_GATESB); } if (k == 4) CHK(ST_MERGED);
          if (k == 5) CHK(ST_MIX); if (k == 6) CHK(ST_ROW1); if (k == 7) CHK(ST_LOGIT); if (k == 8) CHK(ST_TOPK); if (k == 9) CHK(ST_SLOTS); if (k == 10) CHK(ST_ACT); if (k == 11) CHK(ST_YSLOT); if (k == 12) CHK(ST_COMB);
#undef CHK
        }
#endif
    }
#ifdef DBG_CHECK
#if DBG_GSUB == 2
    hipLaunchKernelGGL(encode_full, dim3(1024), dim3(256), 0, stream, (float*)d_out, (const unsigned*)((char*)d_ws + WS_CTL + 65536), out_size);
#else
    hipLaunchKernelGGL(encode, dim3(1024), dim3(256), 0, stream, (float*)d_out, (const float*)((char*)d_ws + WS_CTL + 8192 * 4), out_size, 0.25f);
#endif
#endif
#else
    a.ph_lo = 0; a.ph_hi = NPH; hipLaunchKernelGGL(fwd, dim3(grid), dim3(NTHR), LDS_BYTES, stream, a);
#endif
    const hipError_t le = hipPeekAtLastError();
    if (le != hipSuccess) fprintf(stderr, "kernel_launch: launch failed: %s\n", hipGetErrorName(le));
}
```

```cpp
#include <hip/hip_runtime.h>
#include <cstdio>
#include <cstdint>
#ifndef MK_PER_PHASE
#define MK_PER_PHASE 0
#endif
namespace pg8 {
#define PG8_LAS __attribute__((address_space(3)))
typedef unsigned short bf16_t;
typedef short bf16x8 __attribute__((ext_vector_type(8)));
typedef float f32x4 __attribute__((ext_vector_type(4)));
typedef unsigned u32x4 __attribute__((ext_vector_type(4)));
typedef int i32x4v __attribute__((ext_vector_type(4)));
typedef int i32x8v __attribute__((ext_vector_type(8)));
typedef unsigned u32x2v __attribute__((ext_vector_type(2)));
constexpr int BM = 256, BK = 64, HALF = 128, HTB = HALF * BK * 2  , STAGE_BYTES = 8 * HTB, NXCD = 8, WGM = 8;

__host__ __device__ __forceinline__ int lds_byte(int r, int c) { const int st = (r >> 4) * 2 + (c >> 5), rr = r & 15, cc = c & 31, ob = rr * 64 + cc * 2; return st * 1024 + (ob ^ (((ob >> 9) & 1) << 5)); }
__host__ __device__ __forceinline__ void stage_rc(int b, int& R, int& C) { const int st = b / 1024, sb = b % 1024, swz = sb ^ (((sb >> 9) & 1) << 5); R = (st >> 1) * 16 + swz / 64; C = (st & 1) * 32 + (swz % 64) / 2; }
__host__ __device__ __forceinline__ int perm32(int rho) { const int n = rho >> 4, i = rho & 15; return 8 * (i >> 2) + 4 * n + (i & 3); }

struct Unit { int pm, pn; };
struct Gemm { const bf16_t* A; const bf16_t* Bt; int M, N, K; };

struct StaticOrder {
    int nM, nN, nwg, G, c;
    __host__ __device__ void init(int M, int N, int G_, int c_) { nM = M / BM; nN = N / BM; nwg = nM * nN; G = G_; c = c_; }
    __host__ __device__ bool next(int i, Unit& u) const {
        const long L = (long)i * G + c; if (L >= nwg) return false;
        int wgid = (int)L; { const int q = nwg / NXCD, r = nwg % NXCD, xcd = wgid % NXCD, off = wgid / NXCD; wgid = (xcd < r ? xcd * (q + 1) : r * (q + 1) + (xcd - r) * q) + off; }
        const int nig = WGM * nN, gid = wgid / nig, fm = gid * WGM, gsz = (nM - fm) < WGM ? (nM - fm) : WGM;
        u.pm = fm + ((wgid % nig) % gsz); u.pn = (wgid % nig) / gsz; return true;
    }
    __device__ __forceinline__ void a_ready(const Unit&) const {}
    __device__ __forceinline__ void done(const Unit&) const {}
};

typedef __bf16 bf16x2_native __attribute__((ext_vector_type(2)));
typedef float f32x2_native __attribute__((ext_vector_type(2)));
__device__ __forceinline__ unsigned cvt_pk_bf16(float lo, float hi) { const f32x2_native v = {lo, hi}; const bf16x2_native r = __builtin_convertvector(v, bf16x2_native); return __builtin_bit_cast(unsigned, r); }
__device__ __forceinline__ unsigned cvt4_fp8(float a, float b, float c, float d) { int w = __builtin_amdgcn_cvt_pk_fp8_f32(a, b, __builtin_bit_cast(int, a), false); w = __builtin_amdgcn_cvt_pk_fp8_f32(c, d, w, true); return (unsigned)w; }
typedef float f32x2 __attribute__((ext_vector_type(2)));
__device__ __forceinline__ f32x2 gelu_pk(f32x2 v) {
    const f32x2 av = __builtin_elementwise_abs(v), d = av * 0.2316418882f + 1.0f;
    f32x2 t; t.x = __builtin_amdgcn_rcpf(d.x); t.y = __builtin_amdgcn_rcpf(d.y);
    f32x2 q = t * 0.5307027145f + (-0.7265760135f); q = q * t + 0.7107068705f; q = q * t + (-0.142248368f); q = q * t + 0.127414796f; q = q * t;
    const f32x2 s = (v * v) * (-0.72134752044f);
    f32x2 e; e.x = __builtin_amdgcn_exp2f(s.x); e.y = __builtin_amdgcn_exp2f(s.y);
    const f32x2 m = v * (q * e), r = v - m;
    f32x2 o; o.x = v.x < 0.f ? m.x : r.x; o.y = v.y < 0.f ? m.y : r.y; return o;
}

template <int ACT  > struct EpiBf16 {
    static constexpr bool PERM = true, AFTER_DRAIN = false; static_assert(ACT == 0 || ACT == 1, "EpiBf16: ACT is 0 (none) or 1 (gelu_pk)");
    bf16_t* O; int ldc; const float* bias; int split_cols; size_t split_stride; float scale0;
    __device__ __forceinline__ void operator()(const f32x4 (&acc)[2][2][4][2], const Unit& u, int wr, int wc, int fr, int fq) const {
        const int row0 = u.pm * BM + wr * 64 + fr; int colt = u.pn * BM; bf16_t* base = O;
        float sc = 1.f; if (split_cols) { const int t = colt / split_cols; base += (size_t)t * split_stride; colt -= t * split_cols; if (t == 0) sc = scale0; }
        const int col0 = colt + wc * 32 + 8 * fq, bcol0 = u.pn * BM + wc * 32 + 8 * fq;
        f32x4 bv[2][2];
#pragma unroll
        for (int bj = 0; bj < 2; ++bj)
#pragma unroll
            for (int n = 0; n < 2; ++n) bv[bj][n] = bias ? *(const f32x4*)(bias + bcol0 + bj * HALF + 4 * n) : (f32x4){0.f, 0.f, 0.f, 0.f};
#pragma unroll
        for (int ai = 0; ai < 2; ++ai)
#pragma unroll
            for (int m = 0; m < 4; ++m) { bf16_t* rowp = base + (size_t)(row0 + ai * HALF + m * 16) * ldc + col0;
#pragma unroll
                for (int bj = 0; bj < 2; ++bj) { f32x4 v0 = acc[ai][bj][m][0] + bv[bj][0], v1 = acc[ai][bj][m][1] + bv[bj][1];
                    if (ACT == 1) { f32x2 a = gelu_pk((f32x2){v0[0], v0[1]}), b = gelu_pk((f32x2){v0[2], v0[3]}), c = gelu_pk((f32x2){v1[0], v1[1]}), d = gelu_pk((f32x2){v1[2], v1[3]});
                        v0 = (f32x4){a.x, a.y, b.x, b.y}; v1 = (f32x4){c.x, c.y, d.x, d.y}; }
                    v0 = v0 * sc; v1 = v1 * sc; u32x4 w; w.x = cvt_pk_bf16(v0[0], v0[1]); w.y = cvt_pk_bf16(v0[2], v0[3]); w.z = cvt_pk_bf16(v1[0], v1[1]); w.w = cvt_pk_bf16(v1[2], v1[3]);
                    *(u32x4*)(rowp + bj * HALF) = w; } }
    }
};

__device__ __forceinline__ float fast_sigmoid(float x) { return __builtin_amdgcn_rcpf(1.0f + __builtin_amdgcn_exp2f(-1.4426950408889634f * x)); }
__device__ __forceinline__ u32x4 pack8(const f32x4& a, const f32x4& b) { u32x4 w; w.x = cvt_pk_bf16(a[0], a[1]); w.y = cvt_pk_bf16(a[2], a[3]); w.z = cvt_pk_bf16(b[0], b[1]); w.w = cvt_pk_bf16(b[2], b[3]); return w; }
__device__ __forceinline__ void unpack8(const u32x4& w, f32x4& a, f32x4& b) {
    a[0] = __uint_as_float(w.x << 16); a[1] = __uint_as_float(w.x & 0xffff0000u); a[2] = __uint_as_float(w.y << 16); a[3] = __uint_as_float(w.y & 0xffff0000u);
    b[0] = __uint_as_float(w.z << 16); b[1] = __uint_as_float(w.z & 0xffff0000u); b[2] = __uint_as_float(w.w << 16); b[3] = __uint_as_float(w.w & 0xffff0000u); }
__device__ __forceinline__ u32x2v pack8_fp8(const f32x4& a, const f32x4& b) { u32x2v r; r.x = cvt4_fp8(a[0], a[1], a[2], a[3]); r.y = cvt4_fp8(b[0], b[1], b[2], b[3]); return r; }
__device__ __forceinline__ void store_tile_bf16(const f32x4 (&acc)[2][2][4][2], bf16_t* base, int ldc, int wr, int wc, int fr, int fq) {
    const int rt = wr * 64 + fr, cb = wc * 32 + 8 * fq;
#pragma unroll
    for (int ai = 0; ai < 2; ++ai)
#pragma unroll
        for (int m = 0; m < 4; ++m) { bf16_t* rowp = base + (size_t)(rt + ai * HALF + m * 16) * ldc + cb;
#pragma unroll
            for (int bj = 0; bj < 2; ++bj) *(u32x4*)(rowp + bj * HALF) = pack8(acc[ai][bj][m][0], acc[ai][bj][m][1]); }
}
struct EpiInproj {
    static constexpr bool PERM = true, AFTER_DRAIN = false;
    bf16_t *q, *k, *v, *cu;
    __device__ __forceinline__ void operator()(const f32x4 (&acc)[2][2][4][2], const Unit& u, int wr, int wc, int fr, int fq) const {
        bf16_t* base; int ldc; const bool glu = u.pn >= 6; float sc = 0.03125f; asm volatile("" : "+s"(sc));
        if (u.pn < 4) { base = q + (size_t)u.pm * 256 * 1024 + u.pn * 256; ldc = 1024; }
        else if (u.pn < 6) { const int m0 = u.pm * 256; const int kr = m0 < 32768 ? (m0 >> 11) * 2304 + (m0 & 2047) : ((m0 - 32768) >> 8) * 2304 + 2048; base = (u.pn == 4 ? k : v) + (size_t)kr * 256; ldc = 256; }
        else { base = cu + (size_t)u.pm * 256 * 512 + (u.pn - 6) * 128; ldc = 512; }
        base += (size_t)(wr * 64 + fr) * ldc + wc * 32 + 8 * fq;
#pragma unroll
        for (int ai = 0; ai < 2; ++ai)
#pragma unroll
            for (int m = 0; m < 4; ++m) { bf16_t* rowp = base + (size_t)(ai * HALF + m * 16) * ldc;
                if (!glu) { *(u32x4*)rowp = pack8(acc[ai][0][m][0] * sc, acc[ai][0][m][1] * sc); *(u32x4*)(rowp + HALF) = pack8(acc[ai][1][m][0] * sc, acc[ai][1][m][1] * sc); }
                else { f32x4 a0 = acc[ai][0][m][0] * sc, a1 = acc[ai][0][m][1] * sc; const f32x4 g0 = acc[ai][1][m][0] * sc, g1 = acc[ai][1][m][1] * sc;
#pragma unroll
                    for (int j = 0; j < 4; ++j) { a0[j] *= fast_sigmoid(g0[j]); a1[j] *= fast_sigmoid(g1[j]); }
                    *(u32x4*)rowp = pack8(a0, a1); } }
    }
};
struct EpiYT {
    static constexpr bool PERM = true, AFTER_DRAIN = false;
    unsigned char *yt, *ytc;
    __device__ __forceinline__ void operator()(const f32x4 (&acc)[2][2][4][2], const Unit& u, int wr, int wc, int fr, int fq) const {
        const int cs = u.pm >> 1, chb = (u.pm & 1) * 256; unsigned char* base; int ldc;
        if (u.pn < 128) { const int b = u.pn >> 3, pos0 = (u.pn & 7) * 256; base = yt + (size_t)(b * 512 + chb) * 4096 + cs * 2048 + pos0; ldc = 4096; }
        else { const int b = u.pn - 128; base = ytc + (size_t)(b * 512 + chb) * 512 + cs * 256; ldc = 512; }
        base += (size_t)(wr * 64 + fr) * ldc + wc * 32 + 8 * fq;
#pragma unroll
        for (int ai = 0; ai < 2; ++ai)
#pragma unroll
            for (int m = 0; m < 4; ++m) { unsigned char* rowp = base + (size_t)(ai * HALF + m * 16) * ldc;
#pragma unroll
                for (int bj = 0; bj < 2; ++bj) *(u32x2v*)(rowp + bj * HALF) = pack8_fp8(acc[ai][bj][m][0], acc[ai][bj][m][1]); }
    }
};
struct EpiDFT {
    static constexpr bool PERM = true, AFTER_DRAIN = false;
    bf16_t* z; int rowbase, rpb;
    __device__ __forceinline__ void operator()(const f32x4 (&acc)[2][2][4][2], const Unit& u, int wr, int wc, int fr, int fq) const {
        bf16_t* base = z + (size_t)(rowbase + (u.pn >> 1) * rpb + u.pm * 256 + wr * 64 + fr) * 512 + (u.pn & 1) * 256 + wc * 32 + 8 * fq;
#pragma unroll
        for (int ai = 0; ai < 2; ++ai)
#pragma unroll
            for (int m = 0; m < 4; ++m)
#pragma unroll
                for (int bj = 0; bj < 2; ++bj) *(u32x4*)(base + (size_t)(ai * HALF + m * 16) * 512 + bj * HALF) = pack8(acc[ai][bj][m][0] * 0.03125f, acc[ai][bj][m][1] * 0.03125f);
    }
};
struct EpiGates {
    static constexpr bool PERM = true, AFTER_DRAIN = false;
    bf16_t* g;
    __device__ __forceinline__ void operator()(const f32x4 (&acc)[2][2][4][2], const Unit& u, int wr, int wc, int fr, int fq) const {
        int lt = (wr * 4 + wc) * 64 + fq * 16 + fr; asm volatile("" : "+v"(lt));
        bf16_t* tb = g + ((size_t)(u.pm * 12 + u.pn) * 16 * 512 + (size_t)lt) * 8;
        float cs = -1.4426950408889634f * 0.03125f; asm volatile("" : "+s"(cs));
#pragma unroll
        for (int ai = 0; ai < 2; ++ai)
#pragma unroll
            for (int m = 0; m < 4; ++m)
#pragma unroll
                for (int bj = 0; bj < 2; ++bj) { f32x4 a0 = acc[ai][bj][m][0], a1 = acc[ai][bj][m][1];
#pragma unroll
                    for (int j = 0; j < 4; ++j) { a0[j] = __builtin_amdgcn_rcpf(1.0f + __builtin_amdgcn_exp2f(a0[j] * cs)); a1[j] = __builtin_amdgcn_rcpf(1.0f + __builtin_amdgcn_exp2f(a1[j] * cs)); }
                    __builtin_nontemporal_store(pack8(a0, a1), (u32x4*)(tb + (size_t)(((ai * 4 + m) * 2 + bj) * 512) * 8)); }
    }
};
template <int MODE> struct EpiMerge {
    static constexpr bool PERM = true, AFTER_DRAIN = false;
    bf16_t* mg; bf16_t* scr; const bf16_t* g; int br; float scale;
    __device__ __forceinline__ void operator()(const f32x4 (&acc)[2][2][4][2], const Unit& u, int wr, int wc, int fr, int fq) const {
        const int rt = u.pm * 256 + wr * 64 + fr, cb = u.pn * 256 + wc * 32 + 8 * fq; float sc = scale; asm volatile("" : "+s"(sc));
        int lt = (wr * 4 + wc) * 64 + fq * 16 + fr; asm volatile("" : "+v"(lt));
        const bf16_t* gt = g + ((size_t)(u.pm * 12 + br * 4 + u.pn) * 16 * 512 + (size_t)lt) * 8;
        bf16_t* st = scr + ((size_t)(u.pm * 4 + u.pn) * 16 * 512 + (size_t)lt) * 8;
#pragma unroll
        for (int ai = 0; ai < 2; ++ai)
#pragma unroll
            for (int m = 0; m < 4; ++m)
#pragma unroll
                for (int bj = 0; bj < 2; ++bj) { const size_t pk = (size_t)(((ai * 4 + m) * 2 + bj) * 512) * 8;
                    const u32x4 gw = *(const u32x4*)(gt + pk); f32x4 g0, g1; unpack8(gw, g0, g1);
                    f32x4 v0 = acc[ai][bj][m][0] * sc * g0, v1 = acc[ai][bj][m][1] * sc * g1;
                    if (MODE != 0) { const u32x4 ow = *(const u32x4*)(st + pk); f32x4 o0, o1; unpack8(ow, o0, o1); v0 += o0; v1 += o1; }
                    if (MODE != 2) *(u32x4*)(st + pk) = pack8(v0, v1);
                    else *(u32x4*)(mg + (size_t)(rt + ai * HALF + m * 16) * 1024 + cb + bj * HALF) = pack8(v0, v1); }
    }
};
struct EpiRouter {
    static constexpr bool PERM = true, AFTER_DRAIN = false;
    float* lg;
    __device__ __forceinline__ void operator()(const f32x4 (&acc)[2][2][4][2], const Unit& u, int wr, int wc, int fr, int fq) const {
        if (wc < 2) { const int rt = u.pm * 256 + wr * 64 + fr, cb = wc * 32 + 8 * fq;
#pragma unroll
            for (int ai = 0; ai < 2; ++ai)
#pragma unroll
                for (int m = 0; m < 4; ++m) { float* p = lg + (size_t)(rt + ai * HALF + m * 16) * 64 + cb; *(f32x4*)p = acc[ai][0][m][0]; *(f32x4*)(p + 4) = acc[ai][0][m][1]; } }
    }
};
struct EpiSwiGLU {
    static constexpr bool PERM = true, AFTER_DRAIN = false;
    bf16_t* act; const float* bg; const float* bu;
    __device__ __forceinline__ void operator()(const f32x4 (&acc)[2][2][4][2], const Unit& u, int wr, int wc, int fr, int fq) const {
        const int e = u.pn >> 3, col = (u.pn & 7) * 128 + wc * 32 + 8 * fq, rt = u.pm * 256 + wr * 64 + fr;
        const f32x4 bg0 = *(const f32x4*)(bg + e * 1024 + col), bg1 = *(const f32x4*)(bg + e * 1024 + col + 4), bu0 = *(const f32x4*)(bu + e * 1024 + col), bu1 = *(const f32x4*)(bu + e * 1024 + col + 4);
#pragma unroll
        for (int ai = 0; ai < 2; ++ai)
#pragma unroll
            for (int m = 0; m < 4; ++m) { f32x4 g0 = acc[ai][0][m][0] + bg0, g1 = acc[ai][0][m][1] + bg1, u0 = acc[ai][1][m][0] + bu0, u1 = acc[ai][1][m][1] + bu1;
#pragma unroll
                for (int j = 0; j < 4; ++j) { const float ga = fminf(g0[j], 7.0f), gb = fminf(g1[j], 7.0f); const float ua = fminf(fmaxf(u0[j], -7.0f), 7.0f), ub = fminf(fmaxf(u1[j], -7.0f), 7.0f);
                    g0[j] = (ua + 1.0f) * (ga * fast_sigmoid(1.702f * ga)); g1[j] = (ub + 1.0f) * (gb * fast_sigmoid(1.702f * gb)); }
                *(u32x4*)(act + (size_t)(rt + ai * HALF + m * 16) * 1024 + col) = pack8(g0, g1); }
    }
};
struct EpiSwiGLU8 {
    static constexpr bool PERM = true, AFTER_DRAIN = false;
    unsigned char* act; const float* bg; const float* bu;
    __device__ __forceinline__ void operator()(const f32x4 (&acc)[2][2][4][2], const Unit& u, int wr, int wc, int fr, int fq) const {
        const int e = u.pn >> 3, col = (u.pn & 7) * 128 + wc * 32 + 8 * fq, rt = u.pm * 256 + wr * 64 + fr;
        const f32x4 bg0 = *(const f32x4*)(bg + e * 1024 + col), bg1 = *(const f32x4*)(bg + e * 1024 + col + 4), bu0 = *(const f32x4*)(bu + e * 1024 + col), bu1 = *(const f32x4*)(bu + e * 1024 + col + 4);
#pragma unroll
        for (int ai = 0; ai < 2; ++ai)
#pragma unroll
            for (int m = 0; m < 4; ++m) { f32x4 g0 = acc[ai][0][m][0] * 0.03125f + bg0, g1 = acc[ai][0][m][1] * 0.03125f + bg1, u0 = acc[ai][1][m][0] * 0.03125f + bu0, u1 = acc[ai][1][m][1] * 0.03125f + bu1;
#pragma unroll
                for (int j = 0; j < 4; ++j) { const float ga = fminf(g0[j], 7.0f), gb = fminf(g1[j], 7.0f); const float ua = fminf(fmaxf(u0[j], -7.0f), 7.0f), ub = fminf(fmaxf(u1[j], -7.0f), 7.0f);
                    g0[j] = (ua + 1.0f) * (ga * fast_sigmoid(1.702f * ga)); g1[j] = (ub + 1.0f) * (gb * fast_sigmoid(1.702f * gb)); }
                __builtin_nontemporal_store(pack8_fp8(g0, g1), (u32x2v*)(act + (size_t)(rt + ai * HALF + m * 16) * 1024 + col)); }
    }
};
struct EpiDown8 {
    static constexpr bool PERM = true, AFTER_DRAIN = false;
    unsigned char* ys; const float* bd; int nostore;
    __device__ __forceinline__ void operator()(const f32x4 (&acc)[2][2][4][2], const Unit& u, int wr, int wc, int fr, int fq) const {
        const int e = u.pn >> 2, col0 = (u.pn & 3) * 256 + wc * 32 + 8 * fq, rt = u.pm * 256 + wr * 64 + fr;
        f32x4 bv[2][2];
#pragma unroll
        for (int bj = 0; bj < 2; ++bj) { bv[bj][0] = *(const f32x4*)(bd + e * 1024 + col0 + bj * HALF) * 8.0f; bv[bj][1] = *(const f32x4*)(bd + e * 1024 + col0 + bj * HALF + 4) * 8.0f; }
#pragma unroll
        for (int ai = 0; ai < 2; ++ai)
#pragma unroll
            for (int m = 0; m < 4; ++m) { unsigned char* rowp = ys + (size_t)(rt + ai * HALF + m * 16) * 1024 + col0;
#pragma unroll
                for (int bj = 0; bj < 2; ++bj) { const u32x2v w = pack8_fp8(acc[ai][bj][m][0] * 0.25f + bv[bj][0], acc[ai][bj][m][1] * 0.25f + bv[bj][1]); if (!nostore) __builtin_nontemporal_store(w, (u32x2v*)(rowp + bj * HALF)); else asm volatile("" :: "v"(w)); } }
    }
};
struct GroupedOrder {
    int nM, nN, nwg, G, c; const PG8_LAS int* tile_e; const int* rows;
    __device__ void init(int nM_, int nN_, int G_, int c_, const PG8_LAS int* te) { nM = nM_; nN = nN_; nwg = nM * nN; G = G_; c = c_; tile_e = te; rows = nullptr; }
    __device__ bool next(int i, Unit& u) const {
        const long L = (long)i * G + c; if (L >= nwg) return false;
        int wgid = (int)L; { const int q = nwg / NXCD, r = nwg % NXCD, xcd = wgid % NXCD, off = wgid / NXCD; wgid = (xcd < r ? xcd * (q + 1) : r * (q + 1) + (xcd - r) * q) + off; }
        const int nig = WGM * nN, gid = wgid / nig, fm = gid * WGM, gsz = (nM - fm) < WGM ? (nM - fm) : WGM;
        u.pm = fm + ((wgid % nig) % gsz); const int pl = (wgid % nig) / gsz; u.pn = __builtin_amdgcn_readfirstlane(tile_e[u.pm]) * nN + pl; return true;
    }
    __device__ __forceinline__ void a_ready(const Unit&) const {}
    __device__ __forceinline__ void done(const Unit&) const {}
};
struct DftOrder {
    int lg, n, G, c;
    __device__ void init(int lg_, int nb, int G_, int c_) { lg = lg_; n = (nb * 2) << lg_; G = G_; c = c_; }
    __device__ bool next(int i, Unit& u) const { const int L = i * G + c; if (L >= n) return false; const int b = L >> (lg + 1), rem = L & ((2 << lg) - 1); u.pm = rem & ((1 << lg) - 1); u.pn = 2 * b + (rem >> lg); return true; }
    __device__ __forceinline__ void a_ready(const Unit&) const {}
    __device__ __forceinline__ void done(const Unit&) const {}
};

template <class Epi, class Sched, bool ALIGN_EPI = false, bool SP2 = false, bool FP8 = false, bool GATHER = false>
__device__ __forceinline__ void gemm_phase(PG8_LAS unsigned char* lds, const Gemm g, const Sched& S, const Epi& E, const int tid_in) {
    int tid_ = tid_in; asm volatile("" : "+v"(tid_));
    const int tid = tid_, wid = __builtin_amdgcn_readfirstlane(tid >> 6), lane = tid & 63, wr = wid >> 2, wc = wid & 3, fr = lane & 15, fq = lane >> 4;
    const int K = g.K, nt = K / BK;
    unsigned voffA[2], voffB[2]; int RA[2]; unsigned CA2[2];
#pragma unroll
    for (int i = 0; i < 2; ++i) { int R, C; stage_rc(tid * 16 + i * 8192, R, C); const int Rb = Epi::PERM ? ((R & ~31) + perm32(R & 31)) : R;
        voffA[i] = (unsigned)(R * K + C) * 2u; voffB[i] = (unsigned)(Rb * K + C) * 2u; RA[i] = (R << 8) | (C * 2); CA2[i] = 0u; }
    static_assert(!GATHER || SP2, "GATHER is implemented for the SP2 loop only");
    unsigned pC[2], pN[2];
#define PG8_LDIDX(dst, unit) do { if constexpr (GATHER) { _Pragma("unroll") for (int h_ = 0; h_ < 2; ++h_) dst[h_] = (unsigned)S.rows[(unit).pm * 256 + h_ * 128 + (RA[0] >> 8)] | ((unsigned)S.rows[(unit).pm * 256 + h_ * 128 + (RA[1] >> 8)] << 16); } } while (0)
#define PG8_GOFF(dst, pk) do { dst[0] = ((pk) & 0xffffu) * (unsigned)(K * 2) + (unsigned)(RA[0] & 255); dst[1] = ((pk) >> 16) * (unsigned)(K * 2) + (unsigned)(RA[1] & 255); } while (0)
    const size_t kstep = (size_t)(BK * 2);
    const size_t hstep = (size_t)HALF * K * 2;
    const size_t tstep = 2 * hstep;
    const unsigned ldsw = (unsigned)wid * 1024u;
    const int aoff = lds_byte(wr * 64 + fr, fq * 8), boff = lds_byte(wc * 32 + fr, fq * 8);
#define PG8_SA(b, h) (((b) * 2 + (h)) * HTB)
#define PG8_SB(b, h) ((4 + (b) * 2 + (h)) * HTB)
#define PG8_STAGE(bufoff, gbase, voff) do { _Pragma("unroll") for (int _i = 0; _i < 2; ++_i) \
        __builtin_amdgcn_global_load_lds((const unsigned*)((const char*)(gbase) + (voff)[_i]), (PG8_LAS unsigned*)(lds + (bufoff) + ldsw + _i * 8192), 16, 0, 0); } while (0)
#define PG8_RD8(off) __builtin_shufflevector(*(const PG8_LAS i32x4v*)(lds + (off)), *(const PG8_LAS i32x4v*)(lds + (off) + 1024), 0, 1, 2, 3, 4, 5, 6, 7)
#define PG8_LDA(dst, b, h) do { _Pragma("unroll") for (int m = 0; m < 4; ++m) { if constexpr (FP8) dst##8[m] = PG8_RD8(PG8_SA(b, h) + aoff + m * 2048); else { _Pragma("unroll") for (int k = 0; k < 2; ++k) dst[m][k] = *(const PG8_LAS bf16x8*)(lds + PG8_SA(b, h) + aoff + m * 2048 + k * 1024); } } } while (0)
#define PG8_LDB(dst, b, h) do { _Pragma("unroll") for (int n = 0; n < 2; ++n) { if constexpr (FP8) dst##8[n] = PG8_RD8(PG8_SB(b, h) + boff + n * 2048); else { _Pragma("unroll") for (int k = 0; k < 2; ++k) dst[n][k] = *(const PG8_LAS bf16x8*)(lds + PG8_SB(b, h) + boff + n * 2048 + k * 1024); } } } while (0)
#define PG8_MMA(ai, bj, At, Bt) do { if constexpr (FP8) __builtin_amdgcn_sched_barrier(0); __builtin_amdgcn_s_setprio(1); _Pragma("unroll") for (int m = 0; m < 4; ++m) _Pragma("unroll") for (int n = 0; n < 2; ++n) { \
        if constexpr (FP8) asm volatile("v_mfma_scale_f32_16x16x128_f8f6f4 %0, %1, %2, %0, %3, %3 op_sel_hi:[0,0,0]" : "+v"(acc[ai][bj][m][n]) : "v"(Bt##8[n]), "v"(At##8[m]), "v"(sc8)); \
        else { _Pragma("unroll") for (int k = 0; k < 2; ++k) acc[ai][bj][m][n] = __builtin_amdgcn_mfma_f32_16x16x32_bf16(Bt[n][k], At[m][k], acc[ai][bj][m][n], 0, 0, 0); } } __builtin_amdgcn_s_setprio(0); if constexpr (FP8) __builtin_amdgcn_sched_barrier(0); } while (0)
#define PG8_WAIT_V(n) asm volatile("s_waitcnt vmcnt(" #n ")" ::: "memory")
#define PG8_WAIT_L(n) asm volatile("s_waitcnt lgkmcnt(" #n ")" ::: "memory")
#define PG8_BAR __builtin_amdgcn_s_barrier()
#define PG8_SCHED __builtin_amdgcn_sched_barrier(0)
    Unit cur, nxt; int ui = 0;
    if (!S.next(0, cur)) return;
    f32x4 acc[2][2][4][2];
#pragma unroll
    for (int a = 0; a < 2; ++a)
#pragma unroll
        for (int b = 0; b < 2; ++b)
#pragma unroll
            for (int m = 0; m < 4; ++m)
#pragma unroll
                for (int n = 0; n < 2; ++n) acc[a][b][m][n] = (f32x4){0.f, 0.f, 0.f, 0.f};
    int sc8 = 0x7f7f7f7f; asm volatile("" : "+v"(sc8));
    bf16x8 At[4][2], B0[2][2], B1[2][2]; i32x8v At8[4], B08[2], B18[2];
    const char* cA = (const char*)g.A + (size_t)cur.pm * tstep; const char* cB = (const char*)g.Bt + (size_t)cur.pn * tstep; const char* const gA = (const char*)g.A;
    S.a_ready(cur);
    if constexpr (SP2) {
        unsigned g0_[2], g1_[2]; if constexpr (GATHER) { PG8_LDIDX(pC, cur); PG8_GOFF(g0_, pC[0]); PG8_GOFF(g1_, pC[1]); }
        PG8_STAGE(PG8_SB(0, 0), cB, voffB); PG8_STAGE(PG8_SB(0, 1), cB + hstep, voffB);
        if constexpr (GATHER) { PG8_STAGE(PG8_SA(0, 0), gA, g0_); PG8_STAGE(PG8_SA(0, 1), gA, g1_); } else { PG8_STAGE(PG8_SA(0, 0), cA, voffA); PG8_STAGE(PG8_SA(0, 1), cA + hstep, voffA); }
        if (wr == 1) PG8_BAR;
        PG8_WAIT_V(2); PG8_BAR;
        PG8_STAGE(PG8_SB(1, 0), cB + kstep, voffB); if constexpr (GATHER) PG8_STAGE(PG8_SA(1, 0), gA + kstep, g0_); else PG8_STAGE(PG8_SA(1, 0), cA + kstep, voffA); PG8_STAGE(PG8_SB(1, 1), cB + hstep + kstep, voffB);
        PG8_WAIT_V(6); PG8_BAR;
    } else {
        PG8_STAGE(PG8_SB(0, 0), cB, voffB); PG8_STAGE(PG8_SA(0, 0), cA, voffA); PG8_STAGE(PG8_SB(0, 1), cB + hstep, voffB); PG8_STAGE(PG8_SA(0, 1), cA + hstep, voffA);
        if (wr == 1) PG8_BAR;
        PG8_WAIT_V(4); PG8_BAR;
        PG8_STAGE(PG8_SB(1, 0), cB + kstep, voffB); PG8_STAGE(PG8_SA(1, 0), cA + kstep, voffA); PG8_STAGE(PG8_SB(1, 1), cB + hstep + kstep, voffB);
        PG8_WAIT_V(6); PG8_BAR;
    }
    for (;;) {
        const bool has_next = S.next(ui + 1, nxt);
        if constexpr (GATHER) { if (has_next) PG8_LDIDX(pN, nxt); }
        const char* nA = has_next ? (const char*)g.A + (size_t)nxt.pm * tstep : cA; const char* nB = has_next ? (const char*)g.Bt + (size_t)nxt.pn * tstep : cB;
        for (int t = 0; t < nt; t += 2) {
            const bool last = (t == nt - 2);
            const char* a1 = cA + (size_t)(t + 1) * kstep;
            const char* a2 = last ? nA : cA + (size_t)(t + 2) * kstep; const char* b2 = last ? nB : cB + (size_t)(t + 2) * kstep;
            const char* a3 = a2 + kstep; const char* b3 = b2 + kstep;
            if (last && has_next) S.a_ready(nxt);
            unsigned v2[2][2]; const char* gA2 = gA;
            unsigned vc1[2];
            if constexpr (GATHER) { const bool sw = last && has_next; PG8_GOFF(v2[0], sw ? pN[0] : pC[0]); PG8_GOFF(v2[1], sw ? pN[1] : pC[1]); PG8_GOFF(vc1, pC[1]);
                gA2 = last ? gA : gA + (size_t)(t + 2) * kstep; }
            if constexpr (SP2) {
            PG8_LDB(B0, 0, 0); PG8_LDB(B1, 0, 1); PG8_SCHED; PG8_LDA(At, 0, 0); if constexpr (GATHER) PG8_STAGE(PG8_SA(1, 1), gA + (size_t)(t + 1) * kstep, vc1); else PG8_STAGE(PG8_SA(1, 1), a1 + hstep, voffA);
            PG8_WAIT_V(8); PG8_WAIT_L(0); PG8_BAR; PG8_MMA(0, 0, At, B0); PG8_MMA(0, 1, At, B1); PG8_BAR; PG8_SCHED;
            PG8_LDA(At, 0, 1); PG8_STAGE(PG8_SB(0, 0), b2, voffB); PG8_STAGE(PG8_SB(0, 1), b2 + hstep, voffB); if constexpr (GATHER) PG8_STAGE(PG8_SA(0, 0), gA2, v2[0]); else PG8_STAGE(PG8_SA(0, 0), a2, voffA);
            PG8_WAIT_V(8); PG8_WAIT_L(0); PG8_BAR; PG8_MMA(1, 0, At, B0); PG8_MMA(1, 1, At, B1); PG8_BAR; PG8_SCHED;
            PG8_LDB(B0, 1, 0); PG8_LDB(B1, 1, 1); PG8_SCHED; PG8_LDA(At, 1, 0); if constexpr (GATHER) PG8_STAGE(PG8_SA(0, 1), gA2, v2[1]); else PG8_STAGE(PG8_SA(0, 1), a2 + hstep, voffA);
            PG8_WAIT_V(8); PG8_WAIT_L(0); PG8_BAR; PG8_MMA(0, 0, At, B0); PG8_MMA(0, 1, At, B1); PG8_BAR; PG8_SCHED;
            PG8_LDA(At, 1, 1); PG8_STAGE(PG8_SB(1, 0), b3, voffB); PG8_STAGE(PG8_SB(1, 1), b3 + hstep, voffB); if constexpr (GATHER) PG8_STAGE(PG8_SA(1, 0), gA2 + kstep, v2[0]); else PG8_STAGE(PG8_SA(1, 0), a3, voffA);
            PG8_WAIT_V(8); PG8_WAIT_L(0); PG8_BAR; PG8_MMA(1, 0, At, B0); PG8_MMA(1, 1, At, B1); PG8_BAR; PG8_SCHED;
            } else {
            PG8_LDB(B0, 0, 0); PG8_SCHED; PG8_LDA(At, 0, 0); PG8_STAGE(PG8_SA(1, 1), a1 + hstep, voffA);
            PG8_WAIT_L(8); PG8_BAR; PG8_WAIT_L(0); PG8_MMA(0, 0, At, B0); PG8_BAR; PG8_SCHED;
            PG8_LDB(B1, 0, 1); PG8_STAGE(PG8_SB(0, 0), b2, voffB);
            PG8_BAR; PG8_WAIT_L(0); PG8_MMA(0, 1, At, B1); PG8_BAR;
            PG8_LDA(At, 0, 1); PG8_STAGE(PG8_SA(0, 0), a2, voffA);
            PG8_BAR; PG8_WAIT_L(0); PG8_MMA(1, 0, At, B0); PG8_BAR; PG8_SCHED;
            PG8_STAGE(PG8_SB(0, 1), b2 + hstep, voffB);
            PG8_WAIT_V(6); PG8_BAR; PG8_MMA(1, 1, At, B1); PG8_BAR;
            PG8_LDB(B0, 1, 0); PG8_SCHED; PG8_LDA(At, 1, 0); PG8_STAGE(PG8_SA(0, 1), a2 + hstep, voffA);
            PG8_WAIT_L(8); PG8_BAR; PG8_WAIT_L(0); PG8_MMA(0, 0, At, B0); PG8_BAR; PG8_SCHED;
            PG8_LDB(B1, 1, 1); PG8_STAGE(PG8_SB(1, 0), b3, voffB);
            PG8_BAR; PG8_WAIT_L(0); PG8_MMA(0, 1, At, B1); PG8_BAR;
            PG8_LDA(At, 1, 1); PG8_STAGE(PG8_SA(1, 0), a3, voffA);
            PG8_BAR; PG8_WAIT_L(0); PG8_MMA(1, 0, At, B0); PG8_BAR; PG8_SCHED;
            PG8_STAGE(PG8_SB(1, 1), b3 + hstep, voffB);
            PG8_WAIT_V(6); PG8_BAR; PG8_MMA(1, 1, At, B1); PG8_BAR;
            }
        }
        if constexpr (FP8) asm volatile("s_nop 15\n\ts_nop 15" ::: "memory");
        if constexpr (ALIGN_EPI) { if (wr == 0) PG8_BAR; }
        if constexpr (!Epi::AFTER_DRAIN) { E(acc, cur, wr, wc, fr, fq); S.done(cur); }
        if (!has_next) break;
#pragma unroll
        for (int a = 0; a < 2; ++a)
#pragma unroll
            for (int b = 0; b < 2; ++b)
#pragma unroll
                for (int m = 0; m < 4; ++m)
#pragma unroll
                    for (int n = 0; n < 2; ++n) acc[a][b][m][n] = (f32x4){0.f, 0.f, 0.f, 0.f};
        cur = nxt; cA = nA; cB = nB; ++ui;
        if constexpr (GATHER) { pC[0] = pN[0]; pC[1] = pN[1]; }
        if constexpr (ALIGN_EPI) { if (wr == 1) PG8_BAR; }
    }
    PG8_WAIT_V(0);
    if constexpr (!ALIGN_EPI) { if (wr == 0) PG8_BAR; }
    PG8_BAR;
    if constexpr (Epi::AFTER_DRAIN) { E.fused(acc, cur, wr, wc, fr, fq, lds, wid, lane); S.done(cur); }
#undef PG8_SA
#undef PG8_LDIDX
#undef PG8_GOFF
#undef PG8_SB
#undef PG8_STAGE
#undef PG8_LDA
#undef PG8_LDB
#undef PG8_MMA
#undef PG8_RD8
#undef PG8_WAIT_V
#undef PG8_WAIT_L
#undef PG8_BAR
#undef PG8_SCHED
}
}
namespace att {
typedef unsigned short bf16;
constexpr int   D = 128, NW = 8, QBLK = 32, KVBLK = 64;
constexpr float SCALE = 0.088388347648318440f;
constexpr float THR = 8.f;
constexpr int SDEPTH = 2;
constexpr int LDQ = 1024, LDK = 256, LDO = 1024;
constexpr size_t SHM_V = KVBLK * D * 2, SHM_K = KVBLK * D * 2, SHM_ATTN = 2 * SHM_V + 2 * SHM_K + NW * 64 * 4;
using bf16x8 = __attribute__((ext_vector_type(8))) short;
using s16x4  = __attribute__((ext_vector_type(4))) short;
using f32x16 = __attribute__((ext_vector_type(16))) float;
using f32x8  = __attribute__((ext_vector_type(8))) float;
using u32x4  = __attribute__((ext_vector_type(4))) unsigned;
#define KSWZ(row, colB) ((row) * 256 + ((colB) ^ (((row) & 7) << 4)))
#define SBAR() __builtin_amdgcn_sched_barrier(0)
__device__ __forceinline__ int crow(int r, int hi) { return (r & 3) + 8 * (r >> 2) + 4 * hi; }
__device__ __forceinline__ unsigned cvtpk(float lo, float hi) { return pg8::cvt_pk_bf16(lo, hi); }
template <typename TIn> struct Stage;
template <> struct Stage<bf16>  { using T = bf16x8;
  __device__ static __forceinline__ T ld8(const bf16* p) { return *reinterpret_cast<const bf16x8*>(p); }
  __device__ static __forceinline__ bf16x8 tobf(T x) { return x; } };
template <> struct Stage<float> { using T = f32x8;
  __device__ static __forceinline__ T ld8(const float* p) { return *reinterpret_cast<const f32x8*>(p); }
  __device__ static __forceinline__ bf16x8 tobf(T x) {
    u32x4 w = {cvtpk(x[0], x[1]), cvtpk(x[2], x[3]), cvtpk(x[4], x[5]), cvtpk(x[6], x[7])}; return *reinterpret_cast<bf16x8*>(&w); } };

__device__ __forceinline__ void partialSM(f32x16& p0, f32x16& p1, float& m_reg, float& mn, float& alpha) {
  constexpr float C = SCALE * 1.4426950408889634f;
  float pmax = p0[0]; for (int r = 1; r < 16; ++r) pmax = fmaxf(pmax, p0[r]); for (int r = 0; r < 16; ++r) pmax = fmaxf(pmax, p1[r]);
  { auto rr = __builtin_amdgcn_permlane32_swap(__float_as_uint(pmax), __float_as_uint(pmax), false, false);
    pmax = fmaxf(__uint_as_float(rr[0]), __uint_as_float(rr[1])); }
  if (__builtin_expect(__all(pmax - m_reg <= THR / SCALE), 1)) { mn = m_reg; alpha = 1.f; }
  else { mn = fmaxf(m_reg, pmax); alpha = __builtin_amdgcn_exp2f((m_reg - mn) * C); m_reg = mn; }
  float mnC = -mn * C;
  for (int r = 0; r < 16; ++r) p0[r] = fmaf(p0[r], C, mnC); for (int r = 0; r < 16; ++r) p1[r] = fmaf(p1[r], C, mnC);
  for (int r = 0; r < 16; ++r) p0[r] = __builtin_amdgcn_exp2f(p0[r]);
}
__device__ __forceinline__ void finishSM(f32x16& p0, f32x16& p1, float alpha, float& l_reg, bf16x8& pa0, bf16x8& pa1, bf16x8& pa2, bf16x8& pa3) {
  for (int r = 0; r < 16; ++r) p1[r] = __builtin_amdgcn_exp2f(p1[r]);
  float ps = 0; for (int r = 0; r < 16; ++r) ps += p0[r]; for (int r = 0; r < 16; ++r) ps += p1[r];
  { auto rr = __builtin_amdgcn_permlane32_swap(__float_as_uint(ps), __float_as_uint(ps), false, false);
    ps = __uint_as_float(rr[0]) + __uint_as_float(rr[1]); }
  l_reg = l_reg * alpha + ps;
#define PK4(P, BASE, OUT) do { unsigned a0 = cvtpk(P[BASE + 0], P[BASE + 1]), a1 = cvtpk(P[BASE + 2], P[BASE + 3]);   \
    unsigned b0 = cvtpk(P[BASE + 4], P[BASE + 5]), b1 = cvtpk(P[BASE + 6], P[BASE + 7]);                              \
    auto r0 = __builtin_amdgcn_permlane32_swap(a0, b0, false, false); auto r1 = __builtin_amdgcn_permlane32_swap(a1, b1, false, false); \
    u32x4 w = {r0[0], r1[0], r0[1], r1[1]}; OUT = *reinterpret_cast<bf16x8*>(&w); } while (0)
  PK4(p0, 0, pa0); PK4(p0, 8, pa1); PK4(p1, 0, pa2); PK4(p1, 8, pa3);
#undef PK4
}
__device__ __forceinline__ void qkt(f32x16& p0, f32x16& p1, const bf16* Ks, const bf16x8* qr, int r32, int hi) {
  p0 = f32x16{}; p1 = f32x16{};
  for (int d0 = 0; d0 < 8; ++d0) { int cb = (d0 * 16 + hi * 8) * 2;
    bf16x8 b0 = *reinterpret_cast<const bf16x8*>((const char*)Ks + KSWZ(r32, cb));
    bf16x8 b1 = *reinterpret_cast<const bf16x8*>((const char*)Ks + KSWZ(32 + r32, cb));
    p0 = __builtin_amdgcn_mfma_f32_32x32x16_bf16(b0, qr[d0], p0, 0, 0, 0);
    p1 = __builtin_amdgcn_mfma_f32_32x32x16_bf16(b1, qr[d0], p1, 0, 0, 0); }
}
__device__ __forceinline__ int v_st(int k, int c) { const int kk = (k & ~0xC) | ((k & 4) << 1) | ((k & 8) >> 1); return ((kk >> 3) * 4 + (c >> 5)) * 512 + ((kk & 7) * 32 + (c & 31)) * 2; }
__device__ __forceinline__ int v_rd_base(int lane) { return ((lane & 3) << 3) | (((lane >> 2) & 3) << 6) | (((lane >> 4) & 1) << 5) | (((lane >> 5) & 1) << 8); }
constexpr int v_rd_off(int d0, int ks, int half) { return d0 * 512 + ks * 4096 + half * 2048; }
template <int OFF> __device__ __forceinline__ s16x4 tr_read(int vb) {
  s16x4 r; asm volatile("ds_read_b64_tr_b16 %0, %1 offset:%2" : "=&v"(r) : "v"(vb), "i"(OFF) : "memory"); return r;
}
template <int D0> __device__ __forceinline__ void pv_one(f32x16& od, int vb, bf16x8 pa0, bf16x8 pa1, bf16x8 pa2, bf16x8 pa3) {
  const s16x4 l0 = tr_read<v_rd_off(D0, 0, 0)>(vb), h0 = tr_read<v_rd_off(D0, 0, 1)>(vb), l1 = tr_read<v_rd_off(D0, 1, 0)>(vb), h1 = tr_read<v_rd_off(D0, 1, 1)>(vb);
  const s16x4 l2 = tr_read<v_rd_off(D0, 2, 0)>(vb), h2 = tr_read<v_rd_off(D0, 2, 1)>(vb), l3 = tr_read<v_rd_off(D0, 3, 0)>(vb), h3 = tr_read<v_rd_off(D0, 3, 1)>(vb);
  asm volatile("s_waitcnt lgkmcnt(0)" ::: "memory"); SBAR();
#define PK(L, H) (bf16x8){L[0], L[1], L[2], L[3], H[0], H[1], H[2], H[3]}
  od = __builtin_amdgcn_mfma_f32_32x32x16_bf16(pa0, PK(l0, h0), od, 0, 0, 0);
  od = __builtin_amdgcn_mfma_f32_32x32x16_bf16(pa1, PK(l1, h1), od, 0, 0, 0);
  od = __builtin_amdgcn_mfma_f32_32x32x16_bf16(pa2, PK(l2, h2), od, 0, 0, 0);
  od = __builtin_amdgcn_mfma_f32_32x32x16_bf16(pa3, PK(l3, h3), od, 0, 0, 0);
#undef PK
}
__device__ __forceinline__ void pv_d0(f32x16* o, int vb, bf16x8 pa0, bf16x8 pa1, bf16x8 pa2, bf16x8 pa3) {
  pv_one<0>(o[0], vb, pa0, pa1, pa2, pa3); pv_one<1>(o[1], vb, pa0, pa1, pa2, pa3); pv_one<2>(o[2], vb, pa0, pa1, pa2, pa3); pv_one<3>(o[3], vb, pa0, pa1, pa2, pa3);
}

template <typename TQ>
__device__ __forceinline__ void attn_dense_body(const TQ* __restrict__ Qb, const bf16* __restrict__ Kh, const bf16* __restrict__ Vh,
                                                unsigned char* __restrict__ Ob, int seq, char* lds, const int tid_in, const float* __restrict__ qgain, const float* __restrict__ rtab, const int t0, const bool rope) {
  using St = Stage<bf16>; using SQ = Stage<TQ>;
  int tid_ = tid_in; asm volatile("" : "+v"(tid_));
  const int tid = tid_, wid = tid >> 6, lane = tid & 63, r32 = lane & 31, hi = lane >> 5;
  bf16* V_lds = (bf16*)lds; bf16* K_lds = (bf16*)(lds + 2 * SHM_V);
  float* ws = (float*)(lds + 2 * SHM_V + 2 * SHM_K) + wid * 64; float* li_l = ws; float* al_l = ws + 32;
  float m_reg = -1e30f, l_reg = 0; f32x16 o[4] = {}; bf16x8 qr[8];
  const TQ* Qw = Qb + (long)(wid * QBLK + r32) * LDQ + hi * 8;
  { float xf[8][8]; float ss = 0.f;
#pragma unroll
    for (int d0 = 0; d0 < 8; ++d0) { const bf16x8 raw = SQ::tobf(SQ::ld8(Qw + d0 * 16));
#pragma unroll
      for (int j = 0; j < 8; ++j) { xf[d0][j] = __uint_as_float(((unsigned)(unsigned short)raw[j]) << 16); ss += xf[d0][j] * xf[d0][j]; } }
    { auto rr = __builtin_amdgcn_permlane32_swap(__float_as_uint(ss), __float_as_uint(ss), false, false); ss = __uint_as_float(rr[0]) + __uint_as_float(rr[1]); }
    const float rn = 1.0f / sqrtf(ss * (1.0f / 128.0f) + 1e-6f);
#pragma unroll
    for (int d0 = 0; d0 < 8; ++d0) {
#pragma unroll
      for (int j = 0; j < 8; ++j) xf[d0][j] *= rn * qgain[d0 * 16 + hi * 8 + j]; }
    if (rope) { const int t = t0 + wid * QBLK + r32, pr = t >> 6, pc = t & 63;
#pragma unroll
      for (int hb = 0; hb < 2; ++hb) { const int p = hb ? pc : pr;
#pragma unroll
        for (int dd = 0; dd < 2; ++dd) { const int d0 = 4 * hb + dd;
#pragma unroll
          for (int j = 0; j < 8; ++j) { const int f = dd * 16 + hi * 8 + j; const float c = rtab[(p * 32 + f) * 2], s = rtab[(p * 32 + f) * 2 + 1];
            const float x0 = xf[d0][j], x1 = xf[d0 + 2][j]; xf[d0][j] = x0 * c - x1 * s; xf[d0 + 2][j] = x1 * c + x0 * s; } } } }
#pragma unroll
    for (int d0 = 0; d0 < 8; ++d0) { u32x4 w = {cvtpk(xf[d0][0], xf[d0][1]), cvtpk(xf[d0][2], xf[d0][3]), cvtpk(xf[d0][4], xf[d0][5]), cvtpk(xf[d0][6], xf[d0][7])}; qr[d0] = *reinterpret_cast<bf16x8*>(&w); } }
  const int sr = tid >> 4, sc = (tid & 15) * 8, vst0 = v_st(sr, sc), vst1 = v_st(32 + sr, sc);
  const int vb0 = (int)(uintptr_t)V_lds + v_rd_base(lane);
  struct { typename St::T vs0, vs1, ks0, ks1; } sr_[SDEPTH];
#define SLOAD(i, k0) do { sr_[i].vs0 = St::ld8(&Vh[(long)((k0) + sr) * LDK + sc]); sr_[i].vs1 = St::ld8(&Vh[(long)((k0) + 32 + sr) * LDK + sc]); \
    sr_[i].ks0 = St::ld8(&Kh[(long)((k0) + sr) * LDK + sc]); sr_[i].ks1 = St::ld8(&Kh[(long)((k0) + 32 + sr) * LDK + sc]); } while (0)
#define SWRITE(b, i) do { *(bf16x8*)((char*)V_lds + (b) * SHM_V + vst0) = St::tobf(sr_[i].vs0);          \
    *(bf16x8*)((char*)V_lds + (b) * SHM_V + vst1) = St::tobf(sr_[i].vs1); int kc = sc * 2;               \
    *(bf16x8*)((char*)K_lds + (b) * SHM_K + KSWZ(sr, kc)) = St::tobf(sr_[i].ks0);                       \
    *(bf16x8*)((char*)K_lds + (b) * SHM_K + KSWZ(32 + sr, kc)) = St::tobf(sr_[i].ks1); } while (0)
#define SWAIT() do { if constexpr (SDEPTH == 2) asm volatile("s_waitcnt vmcnt(4)" ::: "memory"); else asm volatile("s_waitcnt vmcnt(0)" ::: "memory"); } while (0)
#define RESC(a) do { if (__any((a) < 1.f)) { if (hi == 0) al_l[r32] = (a); asm volatile("s_waitcnt lgkmcnt(0)" ::: "memory"); \
    for (int d = 0; d < 4; ++d) for (int r = 0; r < 16; ++r) o[d][r] *= al_l[crow(r, hi)]; } } while (0)
  f32x16 pA0, pA1, pB0, pB1; float mnA, mnB, alA, alB; bf16x8 pa0, pa1, pa2, pa3; const int NT = seq / KVBLK;
  constexpr int SE = 0, SO = SDEPTH - 1;
  SLOAD(SE, 0); asm volatile("s_waitcnt vmcnt(0)" ::: "memory"); SWRITE(0, SE); __syncthreads();
  qkt(pA0, pA1, K_lds, qr, r32, hi); partialSM(pA0, pA1, m_reg, mnA, alA);
  SLOAD(SO, KVBLK); if constexpr (SDEPTH == 2) { if (2 < NT) SLOAD(SE, 2 * KVBLK); }
  SWAIT(); SWRITE(1, SO); __syncthreads();
  for (int j = 1; j + 1 < NT; j += 2) {
    SBAR(); qkt(pB0, pB1, (bf16*)((char*)K_lds + SHM_K), qr, r32, hi);
    finishSM(pA0, pA1, alA, l_reg, pa0, pa1, pa2, pa3); SBAR();
    SLOAD(SO, (j + SDEPTH) * KVBLK); SBAR();
    pv_d0(o, vb0, pa0, pa1, pa2, pa3); partialSM(pB0, pB1, m_reg, mnB, alB);
    __syncthreads(); SWAIT(); SWRITE(0, SE);
    RESC(alB); __syncthreads();
    SBAR(); qkt(pA0, pA1, K_lds, qr, r32, hi);
    finishSM(pB0, pB1, alB, l_reg, pa0, pa1, pa2, pa3); SBAR();
    if (SDEPTH == 1 || j + 3 < NT) SLOAD(SE, (j + 1 + SDEPTH) * KVBLK); SBAR();
    pv_d0(o, vb0 + (int)SHM_V, pa0, pa1, pa2, pa3); partialSM(pA0, pA1, m_reg, mnA, alA);
    __syncthreads(); SWAIT(); SWRITE(1, SO);
    RESC(alA); __syncthreads();
  }
  SBAR(); qkt(pB0, pB1, (bf16*)((char*)K_lds + SHM_K), qr, r32, hi);
  finishSM(pA0, pA1, alA, l_reg, pa0, pa1, pa2, pa3); SBAR();
  pv_d0(o, vb0, pa0, pa1, pa2, pa3); partialSM(pB0, pB1, m_reg, mnB, alB);
  __syncthreads(); RESC(alB);
  finishSM(pB0, pB1, alB, l_reg, pa0, pa1, pa2, pa3); SBAR();
  pv_d0(o, vb0 + (int)SHM_V, pa0, pa1, pa2, pa3);
  if (hi == 0) li_l[r32] = l_reg; asm volatile("s_waitcnt lgkmcnt(0)" ::: "memory");
  float rli[16];
#pragma unroll
  for (int r = 0; r < 16; ++r) rli[r] = __builtin_amdgcn_rcpf(li_l[crow(r, hi)]);
  unsigned char* Ow = Ob + (long)(wid * QBLK) * LDO;
#pragma unroll
  for (int r = 0; r < 16; ++r) { int orow = crow(r, hi);
    for (int d0 = 0; d0 < 4; ++d0) { const float ov = o[d0][r] * rli[r] * 16.0f; Ow[(long)orow * LDO + d0 * 32 + r32] = (unsigned char)(__builtin_amdgcn_cvt_pk_fp8_f32(ov, ov, __builtin_bit_cast(int, ov), false) & 0xff); } }
#undef SLOAD
#undef SWRITE
#undef SWAIT
#undef RESC
}
#undef KSWZ
#undef SBAR
}

#define GAS __attribute__((address_space(1)))
#define LAS __attribute__((address_space(3)))
typedef unsigned short bf16;
typedef unsigned v4u __attribute__((ext_vector_type(4)));
typedef float f32x4 __attribute__((ext_vector_type(4)));
typedef short bf16x8 __attribute__((ext_vector_type(8)));
typedef GAS unsigned gu32;
typedef GAS unsigned long long gu64;
#define RLX_AGENT __ATOMIC_RELAXED, __HIP_MEMORY_SCOPE_AGENT
#define LDS_WAIT() asm volatile("s_waitcnt lgkmcnt(0)" ::: "memory")
#define VM_WAIT() asm volatile("s_waitcnt vmcnt(0)" ::: "memory")
__device__ __forceinline__ unsigned long long rt() { return __builtin_amdgcn_s_memrealtime(); }
__device__ __forceinline__ unsigned f2bf(float f) { unsigned u = __builtin_bit_cast(unsigned, f); return (u + 0x7fffu + ((u >> 16) & 1u)) >> 16; }
__device__ __forceinline__ unsigned pk2(float lo, float hi) { return f2bf(lo) | (f2bf(hi) << 16); }

#define XB_TMO      128
#define XB_XCNT(j)  (256  + 64 * (j))
#define XB_XSUB(j)  (1280 + 64 * (j))
#define XB_XGEN(j)  (2304 + 64 * (j))
#define XB_TOP      3328
#define XB_TOPGEN   3392
#define XCD_BAR_WORDS 3456
#define XB_SPIN_CAP (1u << 18)

__device__ __forceinline__ unsigned xb_ld(unsigned* p)              { return __hip_atomic_load(p, __ATOMIC_RELAXED, __HIP_MEMORY_SCOPE_AGENT); }
__device__ __forceinline__ unsigned xb_add(unsigned* p, unsigned v) { return __hip_atomic_fetch_add(p, v, __ATOMIC_RELAXED, __HIP_MEMORY_SCOPE_AGENT); }
__device__ __forceinline__ unsigned xb_xcc_id() { return (unsigned)__builtin_amdgcn_s_getreg((3 << 11) | 20) & 0xFu; }
#define XB_SPIN(cond, bar) do { unsigned _sp = 0; while (cond) { __builtin_amdgcn_s_sleep(1); \
    if ((++_sp & 255u) == 0u) { if (xb_ld(&(bar)[XB_TMO])) break; if (_sp > XB_SPIN_CAP) { atomicAdd(&(bar)[XB_TMO], 1u); break; } } } } while (0)

struct XcdBarrier {
    unsigned* bar; unsigned x;
    volatile LAS unsigned* st;
};

__device__ __forceinline__ XcdBarrier xcd_barrier_post(unsigned* bar, volatile LAS unsigned* st) {
    XcdBarrier b; b.bar = bar; b.x = xb_xcc_id(); b.st = st;
    if (threadIdx.x == 0) (void)xb_add(&bar[XB_XCNT(b.x)], 1u);
    return b;
}
__device__ __forceinline__ void xcd_barrier_complete(unsigned* bar, unsigned x, unsigned& nloc, unsigned& nx) {
    const unsigned G = gridDim.x * gridDim.y * gridDim.z;
    unsigned sum, cnt, mine, sp = 0u;
    for (;;) {
        sum = 0u; cnt = 0u; mine = 0u;
#pragma unroll
        for (unsigned j = 0; j < 16; ++j) { const unsigned c = xb_ld(&bar[XB_XCNT(j)]); sum += c; cnt += (c > 0u) ? 1u : 0u; mine = (j == x) ? c : mine; }
        if (sum == G) break;
        __builtin_amdgcn_s_sleep(1);
        if ((++sp & 255u) == 0u) { if (xb_ld(&bar[XB_TMO])) break; if (sp > XB_SPIN_CAP) { atomicAdd(&bar[XB_TMO], 1u); break; } }
    }
    nloc = mine > 0u ? mine : 1u; nx = cnt > 0u ? cnt : 1u;
}

__device__ __forceinline__ void xcd_barrier(const XcdBarrier& b) {
    asm volatile("s_waitcnt vmcnt(0)" ::: "memory");
    __syncthreads();
    if (threadIdx.x == 0) {
        unsigned* bar = b.bar;
        __builtin_amdgcn_s_waitcnt(0);
        unsigned nloc = b.st[0], nx = b.st[1];
        if (nloc == 0u) { xcd_barrier_complete(bar, b.x, nloc, nx); b.st[0] = nloc; b.st[1] = nx; }
        const unsigned old = xb_add(&bar[XB_XSUB(b.x)], 1u);
        const unsigned gen = old / nloc;
        if (old + 1u == (gen + 1u) * nloc) {
            __builtin_amdgcn_fence(__ATOMIC_RELEASE, "agent");
            asm volatile("s_waitcnt vmcnt(0)" ::: "memory");
            const unsigned og = xb_add(&bar[XB_TOP], 1u);
            const unsigned tg = og / nx;
            if (og + 1u == (tg + 1u) * nx) xb_add(&bar[XB_TOPGEN], 1u);
            else XB_SPIN(xb_ld(&bar[XB_TOPGEN]) == tg, bar);
            __builtin_amdgcn_fence(__ATOMIC_ACQUIRE, "agent");
            xb_add(&bar[XB_XGEN(b.x)], 1u);
            asm volatile("s_waitcnt vmcnt(0)" ::: "memory");
        } else {
            XB_SPIN(xb_ld(&bar[XB_XGEN(b.x)]) == gen, bar);
            __builtin_amdgcn_fence(__ATOMIC_ACQUIRE, "agent");
            asm volatile("s_waitcnt vmcnt(0)" ::: "memory");
        }
    }
    __syncthreads();
}
constexpr int DM = 1024, NB = 16, SEQ = 2048, CTXL = 256, TL = NB * SEQ, TC = NB * CTXL, TALL = TL + TC;
constexpr int INCOLS = 6144, OFF_FNET = 2560, OFF_GATE = 3072;
constexpr int NEXP = 32, KVROWS = SEQ + CTXL;
constexpr float EPS = 1e-6f;
constexpr int NWAVES = 8, NTHR = NWAVES * 64;
constexpr int NPL = 11, NPH = 2 + 2 * NPL;
#ifndef MK_PER_PHASE
#define MK_PER_PHASE 0
#endif
constexpr size_t MiB = 1u << 20;
constexpr size_t WS_CTL = 0, CTL_ZERO_BYTES = 1 * MiB;
constexpr size_t WS_MOD = 1 * MiB;
constexpr size_t WS_TAB = 2 * MiB;
constexpr size_t WS_TOPI = 3 * MiB, WS_TOPP = 4 * MiB, WS_SLOT = 5 * MiB, WS_CNT = 6 * MiB;
constexpr size_t WS_LOGIT = 7 * MiB;
constexpr size_t WS_WSMALL = 17 * MiB, WSMALL_LAYER = 20 * MiB;
constexpr size_t OFFS_WIN = 0, OFFS_WF = 5 * MiB, OFFS_WG = 7 * MiB, OFFS_WAO = 13 * MiB, OFFS_WCO = 15 * MiB, OFFS_WFO = 16 * MiB, OFFS_WOUT = 17 * MiB, OFFS_ROUT = 19 * MiB;
constexpr size_t WS_DFTL = 57 * MiB, WS_DFTC = 73 * MiB;
constexpr size_t WS_XC = 74 * MiB;
constexpr size_t WS_H = 90 * MiB;
constexpr size_t WS_WGU = 162 * MiB, WS_WD = 226 * MiB, MOEW_LAYER = 96 * MiB;
constexpr size_t WS_BIG = 354 * MiB;
constexpr size_t WS_Q = WS_BIG, WS_K = WS_Q + 72 * MiB, WS_V = WS_K + 18 * MiB, WS_CU = WS_V + 18 * MiB, WS_YT = WS_CU + 36 * MiB, WS_YTC = WS_YT + 64 * MiB;
constexpr size_t WS_GATES = WS_BIG;
constexpr size_t WS_AO = WS_BIG + 216 * MiB, WS_CH = WS_AO + 72 * MiB, WS_Z = WS_CH + 36 * MiB;
constexpr size_t WS_MIX = WS_AO;
constexpr size_t WS_MERGED = WS_BIG + 360 * MiB;
constexpr int SLOT_ROWS = 608 * 256;
constexpr size_t WS_YS = WS_BIG, WS_HS = WS_BIG + 304 * MiB, WS_ACT = WS_BIG + 456 * MiB, WS_END = WS_BIG + 608 * MiB;
constexpr size_t WS_H8 = WS_END;
constexpr size_t WS_END2 = WS_END + 36 * MiB;
static_assert(WS_YTC + 8 * MiB == WS_AO && WS_Z + 36 * MiB == WS_MERGED && WS_MERGED + 72 * MiB <= WS_END && (size_t)SLOT_ROWS * 2048 == 304 * MiB, "ws map");
constexpr int CW_TMO = 0, CW_CODE = 1, CW_BAR = 4096;
constexpr int CNT_ROWSRC = 32768;
constexpr int CNT_TILE_E = 16384, CNT_NT = 16384 + 1024;

constexpr int RING_OFF = 0, RING_BYTES = 131072;
constexpr int LDSCTL_OFF = RING_BYTES, MISC_OFF = LDSCTL_OFF + 320, LDS_CT = LDSCTL_OFF + 512, LDS_SM = LDSCTL_OFF + 1024;
constexpr int LDS_BYTES = 155648;

typedef unsigned u32x2 __attribute__((ext_vector_type(2)));
typedef int i32x4 __attribute__((ext_vector_type(4)));
typedef float f32x2 __attribute__((ext_vector_type(2)));
struct Args { const float* in[29]; float* out; unsigned char* ws; int ph_lo, ph_hi; };
typedef const __attribute__((address_space(4))) unsigned char* kptr_t;
struct AV {
    kptr_t kp;
    __device__ __forceinline__ const float* in(int i) const { return *(const float* const __attribute__((address_space(4)))*)(kp + 8 * i); }
    __device__ __forceinline__ float* out() const { return *(float* const __attribute__((address_space(4)))*)(kp + 8 * 29); }
    __device__ __forceinline__ unsigned char* ws() const { return *(unsigned char* const __attribute__((address_space(4)))*)(kp + 8 * 30); }
};
__device__ __forceinline__ AV av_get() { AV a; a.kp = (kptr_t)__builtin_amdgcn_kernarg_segment_ptr(); asm volatile("" : "+s"(a.kp)); return a; }

struct Frame {
    LAS unsigned char* lds; volatile LAS unsigned* MISC; gu32* ctl;
    int tid, lane, wave, vcu, G;
};

__device__ __forceinline__ float shx(float v, int m, int lane) { return __int_as_float(__builtin_amdgcn_ds_bpermute((lane ^ m) << 2, __float_as_int(v))); }
__device__ __forceinline__ float wave_sum(float v, int lane) {
#pragma unroll
    for (int o = 1; o < 64; o <<= 1) v += shx(v, o, lane);
    return v;
}
__device__ __forceinline__ float sigmoidf_(float x) { return 1.0f / (1.0f + __expf(-x)); }
__device__ __forceinline__ f32x4 bf4(u32x2 w) { f32x4 r; r[0] = __uint_as_float(w.x << 16); r[1] = __uint_as_float(w.x & 0xffff0000u); r[2] = __uint_as_float(w.y << 16); r[3] = __uint_as_float(w.y & 0xffff0000u); return r; }
__device__ __forceinline__ u32x2 pk4(f32x4 v) { u32x2 w; w.x = pk2(v[0], v[1]); w.y = pk2(v[2], v[3]); return w; }
__device__ __forceinline__ void ld_row_f32(f32x4 (&v)[4], const float* p, int lane) {
#pragma unroll
    for (int j = 0; j < 4; ++j) v[j] = ((const GAS f32x4*)p)[lane + 64 * j];
}
__device__ __forceinline__ void st_row_f32(const f32x4 (&v)[4], float* p, int lane) {
#pragma unroll
    for (int j = 0; j < 4; ++j) ((GAS f32x4*)p)[lane + 64 * j] = v[j];
}
__device__ __forceinline__ void ld_row_bf16(f32x4 (&v)[4], const bf16* p, int lane) {
#pragma unroll
    for (int j = 0; j < 4; ++j) v[j] = bf4(((const GAS u32x2*)p)[lane + 64 * j]);
}
__device__ __forceinline__ void st_row_bf16(const f32x4 (&v)[4], bf16* p, int lane) {
#pragma unroll
    for (int j = 0; j < 4; ++j) ((GAS u32x2*)p)[lane + 64 * j] = pk4(v[j]);
}
__device__ __forceinline__ void rms_gain(f32x4 (&v)[4], const float* g, int lane) {
    float ss = 0.f;
#pragma unroll
    for (int j = 0; j < 4; ++j) ss += (v[j][0] * v[j][0] + v[j][1] * v[j][1]) + (v[j][2] * v[j][2] + v[j][3] * v[j][3]);
    const float r = 1.0f / sqrtf(wave_sum(ss, lane) * (1.0f / 1024.0f) + EPS);
#pragma unroll
    for (int j = 0; j < 4; ++j) { const f32x4 gg = ((const GAS f32x4*)g)[lane + 64 * j]; v[j] = v[j] * r * gg; }
}
__device__ __forceinline__ void modulate_store(const f32x4 (&v)[4], const float* shift, const float* scale, bf16* o, int lane) {
#pragma unroll
    for (int j = 0; j < 4; ++j) { const f32x4 sh = ((const GAS f32x4*)shift)[lane + 64 * j], sc = ((const GAS f32x4*)scale)[lane + 64 * j];
        ((GAS u32x2*)o)[lane + 64 * j] = pk4(v[j] * (sc + 1.0f) + sh); }
}
__device__ __forceinline__ unsigned pk4_fp8(f32x4 v) { return pg8::cvt4_fp8(v[0], v[1], v[2], v[3]); }
__device__ __forceinline__ void modulate_store2(const f32x4 (&v)[4], const float* shift, const float* scale, bf16* o, unsigned char* o8, int lane) {
#pragma unroll
    for (int j = 0; j < 4; ++j) { const f32x4 sh = ((const GAS f32x4*)shift)[lane + 64 * j], sc = ((const GAS f32x4*)scale)[lane + 64 * j]; const f32x4 r = v[j] * (sc + 1.0f) + sh;
        ((GAS u32x2*)o)[lane + 64 * j] = pk4(r); ((GAS unsigned*)o8)[lane + 64 * j] = pk4_fp8(r); }
}
__device__ __forceinline__ f32x4 fp8x4(unsigned w) { const f32x2 a = __builtin_amdgcn_cvt_pk_f32_fp8((int)w, false), b = __builtin_amdgcn_cvt_pk_f32_fp8((int)w, true); return (f32x4){a.x, a.y, b.x, b.y}; }
__device__ __forceinline__ int krow_of(int m) { return m < TL ? (m >> 11) * KVROWS + (m & 2047) : ((m - TL) >> 8) * KVROWS + SEQ + ((m - TL) & 255); }

__device__ __forceinline__ void load_block(const float* W, int ldw, int k0, int n0, float scale, LAS float* scr, int lane) {
    f32x4 v[8]; const int kr = lane >> 3, c4 = (lane & 7) * 4;
#pragma unroll
    for (int i = 0; i < 8; ++i) v[i] = *(const GAS f32x4*)(W + (size_t)(k0 + kr + 8 * i) * ldw + n0 + c4);
#pragma unroll
    for (int i = 0; i < 8; ++i) { LAS float* d = scr + (kr + 8 * i) * 33 + c4; d[0] = v[i][0] * scale; d[1] = v[i][1] * scale; d[2] = v[i][2] * scale; d[3] = v[i][3] * scale; }
    LDS_WAIT(); asm volatile("" ::: "memory");
}
__device__ __forceinline__ void transpose_item(const float* W, int ldw, int K, bf16* WT, int dst_row0, int k0, int n0, LAS float* scr, int lane) {
    load_block(W, ldw, k0, n0, 1.0f, scr, lane);
    const int c = lane & 7;
#pragma unroll
    for (int j = 0; j < 4; ++j) { const int n = (lane >> 3) + 8 * j; const LAS float* s = scr + (8 * c) * 33 + n;
        v4u o; o.x = pk2(s[0 * 33], s[1 * 33]); o.y = pk2(s[2 * 33], s[3 * 33]); o.z = pk2(s[4 * 33], s[5 * 33]); o.w = pk2(s[6 * 33], s[7 * 33]);
        *(GAS v4u*)(WT + (size_t)(dst_row0 + n) * K + k0 + 8 * c) = o; }
    LDS_WAIT(); asm volatile("" ::: "memory");
}
__device__ __forceinline__ void transpose_item_fp8(const float* W, int ldw, int K, unsigned char* WT, int dst_row0, int k0, int n0, float scale, LAS float* scr, int lane) {
    load_block(W, ldw, k0, n0, scale, scr, lane);
#pragma unroll
    for (int j = 0; j < 2; ++j) { const int q = lane + 64 * j, n = q >> 2, c = q & 3; const LAS float* s = scr + (16 * c) * 33 + n; v4u o;
        o.x = pg8::cvt4_fp8(s[0 * 33], s[1 * 33], s[2 * 33], s[3 * 33]); o.y = pg8::cvt4_fp8(s[4 * 33], s[5 * 33], s[6 * 33], s[7 * 33]); o.z = pg8::cvt4_fp8(s[8 * 33], s[9 * 33], s[10 * 33], s[11 * 33]); o.w = pg8::cvt4_fp8(s[12 * 33], s[13 * 33], s[14 * 33], s[15 * 33]);
        *(GAS v4u*)(WT + (size_t)(dst_row0 + n) * K + k0 + 16 * c) = o; }
    LDS_WAIT(); asm volatile("" ::: "memory");
}
constexpr int IT_S0 = 16 * 80, IT_S1 = 16 * 96, IT_S2 = 512, IT_S3 = 512, IT_S4 = 256, IT_S5 = 256, IT_SMALL = IT_S0 + IT_S1 + IT_S2 + IT_S3 + IT_S4 + IT_S5;
__device__ __forceinline__ void small_item(const AV& a, int l, int r, LAS float* scr, int lane) {
    unsigned char* wl = a.ws() + WS_WSMALL + (size_t)l * WSMALL_LAYER; const float* win = a.in(10) + (size_t)l * DM * INCOLS;
    if (r < IT_S0) { const int kb = r / 80, n0 = (r % 80) * 32; int dr;
        if (n0 < 1536) dr = n0; else { int cc = n0 - 1536; if (cc < 512) dr = 1536 + (cc >> 7) * 256 + (cc & 127); else { cc -= 512; dr = 1536 + (cc >> 7) * 256 + 128 + (cc & 127); } }
        transpose_item_fp8(win, INCOLS, DM, wl + OFFS_WIN, dr, kb * 64, n0, 32.0f, scr, lane); return; }
    r -= IT_S0;
    if (r < IT_S1) { const int kb = r / 96, nb = r % 96; transpose_item_fp8(win, INCOLS, DM, wl + OFFS_WG, nb * 32, kb * 64, OFF_GATE + nb * 32, 32.0f, scr, lane); return; }
    r -= IT_S1;
    if (r < IT_S2) { const int kb = r / 32, nb = r % 32; transpose_item_fp8(a.in(13) + (size_t)l * DM * DM, DM, DM, wl + OFFS_WAO, nb * 32, kb * 64, nb * 32, 32.0f, scr, lane); return; }
    r -= IT_S2;
    if (r < IT_S3) { const int kb = r / 32, nb = r % 32; transpose_item(a.in(20) + (size_t)l * DM * DM, DM, DM, (bf16*)(wl + OFFS_WOUT), nb * 32, kb * 64, nb * 32, scr, lane); return; }
    r -= IT_S3;
    if (r < IT_S4) { const int kb = r / 32, nb = r % 32; transpose_item(a.in(18) + (size_t)l * 512 * DM, DM, 512, (bf16*)(wl + OFFS_WCO), nb * 32, kb * 64, nb * 32, scr, lane); return; }
    r -= IT_S4;
    { const int kb = r / 32, nb = r % 32; transpose_item(a.in(19) + (size_t)l * 512 * DM, DM, 512, (bf16*)(wl + OFFS_WFO), nb * 32, kb * 64, nb * 32, scr, lane); }
}
constexpr int IT_MOE = NEXP * 3 * 512;
struct MoeIt { const float* W; unsigned char* WT; int dr, k0; };
__device__ __forceinline__ MoeIt moe_decode(const AV& a, int gi) {
    const int l = gi / IT_MOE, idx = gi % IT_MOE, e = idx / 1536, r = idx % 1536, which = r / 512, it = r % 512, kb = it / 32, n0 = (it % 32) * 32; const size_t eo = ((size_t)l * NEXP + e) << 20;
    MoeIt m; m.k0 = kb * 64;
    if (which == 0) { m.W = a.in(23) + eo + n0; m.WT = a.ws() + WS_WGU + (size_t)l * MOEW_LAYER + (size_t)e * 2048 * 1024; m.dr = (n0 >> 7) * 256 + (n0 & 127); }
    else if (which == 1) { m.W = a.in(25) + eo + n0; m.WT = a.ws() + WS_WGU + (size_t)l * MOEW_LAYER + (size_t)e * 2048 * 1024; m.dr = (n0 >> 7) * 256 + 128 + (n0 & 127); }
    else { m.W = a.in(27) + eo + n0; m.WT = a.ws() + WS_WD + (size_t)l * MOEW_LAYER + (size_t)e * 1024 * 1024; m.dr = n0; }
    return m;
}
__device__ __forceinline__ void moe_issue(f32x4 (&v)[8], const MoeIt& m, int lane) {
    const float* p = m.W + (size_t)(m.k0 + (lane >> 3)) * DM + (lane & 7) * 4;
#pragma unroll
    for (int i = 0; i < 8; ++i) v[i] = __builtin_nontemporal_load((const GAS f32x4*)(p + (size_t)(8 * i) * DM));
}
__device__ __forceinline__ void moe_finish(const f32x4 (&v)[8], const MoeIt& m, LAS float* scr, int lane) {
    const int kr = lane >> 3, c4 = (lane & 7) * 4;
#pragma unroll
    for (int i = 0; i < 8; ++i) { LAS float* d = scr + (kr + 8 * i) * 33 + c4; d[0] = v[i][0] * 32.0f; d[1] = v[i][1] * 32.0f; d[2] = v[i][2] * 32.0f; d[3] = v[i][3] * 32.0f; }
    LDS_WAIT(); asm volatile("" ::: "memory");
#pragma unroll
    for (int j = 0; j < 2; ++j) { const int q = lane + 64 * j, n = q >> 2, c = q & 3; const LAS float* s = scr + (16 * c) * 33 + n; v4u o;
        o.x = pg8::cvt4_fp8(s[0 * 33], s[1 * 33], s[2 * 33], s[3 * 33]); o.y = pg8::cvt4_fp8(s[4 * 33], s[5 * 33], s[6 * 33], s[7 * 33]); o.z = pg8::cvt4_fp8(s[8 * 33], s[9 * 33], s[10 * 33], s[11 * 33]); o.w = pg8::cvt4_fp8(s[12 * 33], s[13 * 33], s[14 * 33], s[15 * 33]);
        *(GAS v4u*)(m.WT + (size_t)(m.dr + n) * DM + m.k0 + 16 * c) = o; }
    LDS_WAIT(); asm volatile("" ::: "memory");
}
__device__ __forceinline__ void moe_convert_all(const AV& a, int gw, int NGW, LAS float* scr, int lane) {
    constexpr int NIT = 2 * IT_MOE; f32x4 va[8], vb[8]; int it = gw; if (it >= NIT) return;
    MoeIt ma = moe_decode(a, it), mb = ma; moe_issue(va, ma, lane);
    for (;;) {
        const bool h1 = it + NGW < NIT; if (h1) { mb = moe_decode(a, it + NGW); moe_issue(vb, mb, lane); }
        moe_finish(va, ma, scr, lane); if (!h1) break; it += NGW;
        const bool h2 = it + NGW < NIT; if (h2) { ma = moe_decode(a, it + NGW); moe_issue(va, ma, lane); }
        moe_finish(vb, mb, scr, lane); if (!h2) break; it += NGW;
    }
}
__device__ __forceinline__ void fold_job(const AV& a, int j, const LAS float* ct, int lane) {
    const int l = j >> 10, r = j & 1023, g = r >> 8, kblk = (r >> 4) & 15, k2g = r & 15, k = kblk * 64 + lane;
    const float* wrow = a.in(10) + (size_t)l * DM * INCOLS + (size_t)k * INCOLS + OFF_FNET + g * 128;
    float ac[8], as[8];
#pragma unroll
    for (int i = 0; i < 8; ++i) { ac[i] = 0.f; as[i] = 0.f; }
    for (int n4 = 0; n4 < 32; ++n4) { const f32x4 w = *(const GAS f32x4*)(wrow + n4 * 4);
#pragma unroll
        for (int q = 0; q < 4; ++q) { const int n2 = n4 * 4 + q;
#pragma unroll
            for (int i = 0; i < 8; ++i) { const int ph = (n2 * (k2g * 8 + i)) & 127; ac[i] += w[q] * ct[ph]; as[i] += w[q] * ct[(ph - 32) & 127]; } } }
    bf16* wf = (bf16*)(a.ws() + WS_WSMALL + (size_t)l * WSMALL_LAYER + OFFS_WF);
#pragma unroll
    for (int i = 0; i < 8; ++i) { const int ch = g * 128 + k2g * 8 + i;
        wf[(size_t)ch * 1024 + k] = (bf16)f2bf(ac[i] * 0.08838834764831845f); wf[(size_t)(512 + ch) * 1024 + k] = (bf16)f2bf(as[i] * 0.08838834764831845f); }
}
__device__ __forceinline__ void p0_prologue(const Frame& F, const AV& a) {
    const int gw = F.vcu * NWAVES + F.wave, NGW = F.G * NWAVES, gt = F.vcu * NTHR + F.tid, NGT = F.G * NTHR;
    LAS float* ct = (LAS float*)(F.lds + LDS_CT);
    if (F.tid < 128) ct[F.tid] = cospif((float)F.tid * (1.0f / 64.0f));
    for (int job = blockIdx.x; job < 2 * 96; job += F.G) {
        const int l = job / 96, n0 = (job % 96) * 64;
        LAS float* s = (LAS float*)(F.lds + RING_OFF); LAS float* red = s + 17 * 1024;
        for (int i = F.tid; i < 17 * 1024; i += NTHR) { const int b = i >> 10, k = i & 1023; const float cv = b < 16 ? a.in(1)[b * 1024 + k] : a.in(3)[k]; s[i] = cv * sigmoidf_(cv); }
        __syncthreads();
        const int col = F.tid & 63, ks = F.tid >> 6; float acc[17];
#pragma unroll
        for (int b = 0; b < 17; ++b) acc[b] = 0.f;
        const float* w = a.in(4) + (size_t)l * DM * INCOLS + n0 + col;
        for (int k = ks * 128; k < ks * 128 + 128; k += 16) { float wv[16];
#pragma unroll
            for (int q = 0; q < 16; ++q) wv[q] = w[(size_t)(k + q) * INCOLS];
#pragma unroll
            for (int q = 0; q < 16; ++q)
#pragma unroll
                for (int b = 0; b < 17; ++b) acc[b] += s[b * 1024 + k + q] * wv[q]; }
#pragma unroll
        for (int b = 0; b < 17; ++b) red[(ks * 17 + b) * 64 + col] = acc[b];
        __syncthreads();
        for (int i = F.tid; i < 17 * 64; i += NTHR) { const int b = i >> 6, c2 = i & 63; float t = 0.f;
#pragma unroll
            for (int q = 0; q < 8; ++q) t += red[(q * 17 + b) * 64 + c2];
            ((float*)(a.ws() + WS_MOD))[((size_t)l * 17 + b) * INCOLS + n0 + c2] = t + a.in(5)[l * INCOLS + n0 + c2]; }
        __syncthreads();
    }
    __syncthreads();
    for (int i = gt; i < 64 * 32; i += NGT) { const int p = i >> 5, f = i & 31; const float inv = powf(10000.0f, -(float)f / 32.0f), ang = (float)p * inv; ((f32x2*)(a.ws() + WS_TAB))[i] = (f32x2){cosf(ang), sinf(ang)}; }
    for (int i = gt; i < 2048 * 256; i += NGT) { const int k1 = i >> 8, c0 = (i & 255) * 16; float v[16];
#pragma unroll
        for (int q = 0; q < 16; ++q) { const int col = c0 + q, n1 = col & 2047, rr = (k1 * n1) & 2047; const float x = (float)rr * (1.0f / 1024.0f); v[q] = ((col >> 11) ? -sinpif(x) : cospif(x)) * (32.0f * 0.022097086912079608f); }
        v4u o; o.x = pk4_fp8((f32x4){v[0], v[1], v[2], v[3]}); o.y = pk4_fp8((f32x4){v[4], v[5], v[6], v[7]}); o.z = pk4_fp8((f32x4){v[8], v[9], v[10], v[11]}); o.w = pk4_fp8((f32x4){v[12], v[13], v[14], v[15]}); ((GAS v4u*)(a.ws() + WS_DFTL))[i] = o; }
    for (int i = gt; i < 256 * 32; i += NGT) { const int k1 = i >> 5, c0 = (i & 31) * 16; float v[16];
#pragma unroll
        for (int q = 0; q < 16; ++q) { const int col = c0 + q, n1 = col & 255, rr = (k1 * n1) & 255; const float x = (float)rr * (1.0f / 128.0f); v[q] = ((col >> 8) ? -sinpif(x) : cospif(x)) * (32.0f * 0.0625f); }
        v4u o; o.x = pk4_fp8((f32x4){v[0], v[1], v[2], v[3]}); o.y = pk4_fp8((f32x4){v[4], v[5], v[6], v[7]}); o.z = pk4_fp8((f32x4){v[8], v[9], v[10], v[11]}); o.w = pk4_fp8((f32x4){v[12], v[13], v[14], v[15]}); ((GAS v4u*)(a.ws() + WS_DFTC))[i] = o; }
    for (int i = gt; i < 2 * 256 * 1024; i += NGT) { const int l = i >> 18, r = (i >> 10) & 255, k = i & 1023; unsigned o = 0u;
        if (r < 64) { const float w = a.in(21)[((size_t)l * DM + k) * NEXP + (r & 31)]; const unsigned hi = f2bf(w); o = hi; if (r >= 32) o = f2bf(w - __uint_as_float(hi << 16)); }
        ((bf16*)(a.ws() + WS_WSMALL + (size_t)l * WSMALL_LAYER + OFFS_ROUT))[(size_t)r * 1024 + k] = (bf16)o; }
    for (int j = gw; j < 2048; j += NGW) fold_job(a, j, ct, F.lane);
    LAS float* scr = (LAS float*)(F.lds + RING_OFF + F.wave * 16384);
    for (int it = gw; it < 2 * IT_SMALL; it += NGW) small_item(a, it / IT_SMALL, it % IT_SMALL, scr, F.lane);
    moe_convert_all(a, gw, NGW, scr, F.lane);
}
__device__ __forceinline__ void ld4(f32x4 (&v)[4], const float* p, int lane) {
#pragma unroll
    for (int j = 0; j < 4; ++j) v[j] = ((const GAS f32x4*)p)[lane + 64 * j];
}
__device__ __forceinline__ float sumsq4(const f32x4 (&v)[4]) { float ss = 0.f;
#pragma unroll
    for (int j = 0; j < 4; ++j) ss += (v[j][0] * v[j][0] + v[j][1] * v[j][1]) + (v[j][2] * v[j][2] + v[j][3] * v[j][3]);
    return ss; }
__device__ __forceinline__ void p1_norm0(const Frame& F, const AV& a) {
    const int gw = F.vcu * NWAVES + F.wave, NGW = F.G * NWAVES, rpw = (TALL + NGW - 1) / NGW, r0 = gw * rpw, r1 = (r0 + rpw < TALL) ? r0 + rpw : TALL;
    if (r0 >= r1) return;
    f32x4 gpre[4], shift[4], scale[4], xn[4]; ld4(gpre, a.in(6), F.lane); int cb = -1;
    auto xsrc = [&](int m) -> const float* { return m < TL ? a.in(0) + (size_t)m * DM : a.in(2) + (size_t)(m - TL) * DM; };
    ld4(xn, xsrc(r0), F.lane);
    for (int m = r0; m < r1; ++m) {
        f32x4 x[4];
#pragma unroll
        for (int j = 0; j < 4; ++j) x[j] = xn[j];
        if (m + 1 < r1) ld4(xn, xsrc(m + 1), F.lane);
        const int b = m < TL ? (m >> 11) : 16;
        if (b != cb) { cb = b; const float* mv = (const float*)(a.ws() + WS_MOD) + (size_t)b * INCOLS; ld4(shift, mv, F.lane); ld4(scale, mv + 1024, F.lane); }
        const float r = 1.0f / sqrtf(wave_sum(sumsq4(x), F.lane) * (1.0f / 1024.0f) + EPS);
        bf16* ho = (bf16*)(a.ws() + WS_H) + (size_t)m * DM; unsigned char* h8 = a.ws() + WS_H8 + (size_t)m * DM;
#pragma unroll
        for (int j = 0; j < 4; ++j) { const f32x4 hv = x[j] * r * gpre[j] * (scale[j] + 1.0f) + shift[j]; ((GAS u32x2*)ho)[F.lane + 64 * j] = pk4(hv); ((GAS unsigned*)h8)[F.lane + 64 * j] = pk4_fp8(hv); }
    }
}
__device__ __forceinline__ void qk_fix_core(f32x4 (&x)[4], const f32x4 (&gg)[4], const f32x2* tab, bool rope, int t, int sub, int lane) {
    float ss = sumsq4(x); ss += shx(ss, 1, lane); ss += shx(ss, 2, lane); ss += shx(ss, 4, lane);
    const float r = 1.0f / sqrtf(ss * (1.0f / 128.0f) + EPS);
#pragma unroll
    for (int jj = 0; jj < 4; ++jj) x[jj] = x[jj] * r * gg[jj];
    if (rope) { const int pr = t >> 6, pc = t & 63;
#pragma unroll
        for (int i = 0; i < 4; ++i) { const f32x2 cr = tab[pr * 32 + sub * 4 + i], cc = tab[pc * 32 + sub * 4 + i];
            const float a0 = x[0][i], a1 = x[1][i], b0 = x[2][i], b1 = x[3][i];
            x[0][i] = a0 * cr.x - a1 * cr.y; x[1][i] = a1 * cr.x + a0 * cr.y; x[2][i] = b0 * cc.x - b1 * cc.y; x[3][i] = b1 * cc.x + b0 * cc.y; } }
}
__device__ __forceinline__ void p_qkfix(const Frame& F, const AV& a, int l, int M) {
    const int gw = F.vcu * NWAVES + F.wave, NGW = F.G * NWAVES, rpw = 4 * ((M + 4 * NGW - 1) / (4 * NGW)), r0 = gw * rpw, r1 = (r0 + rpw < M) ? r0 + rpw : M;
    if (r0 >= r1) return;
    const f32x2* tab = (const f32x2*)(a.ws() + WS_TAB); const int rs = F.lane >> 4, hh = (F.lane >> 3) & 1, sub = F.lane & 7;
    f32x4 gk[4];
#pragma unroll
    for (int jj = 0; jj < 4; ++jj) gk[jj] = *(const GAS f32x4*)(a.in(12) + l * 128 + jj * 32 + sub * 4);
    bf16* kb = (bf16*)(a.ws() + WS_K);
    u32x2 kn[4];
    auto issue = [&](int mb) { const int m = mb + rs; if (m < r1) { const bf16* kp = kb + (size_t)krow_of(m) * 256 + hh * 128 + sub * 4;
#pragma unroll
        for (int jj = 0; jj < 4; ++jj) kn[jj] = *(const GAS u32x2*)(kp + jj * 32); } };
    issue(r0);
    for (int mb = r0; mb < r1; mb += 4) { const int m = mb + rs; const bool act = m < r1;
        f32x4 xk[4];
#pragma unroll
        for (int jj = 0; jj < 4; ++jj) xk[jj] = bf4(kn[jj]);
        if (mb + 4 < r1) issue(mb + 4);
        qk_fix_core(xk, gk, tab, m < TL, m & 2047, sub, F.lane);
        if (act) { bf16* kp = kb + (size_t)krow_of(m) * 256 + hh * 128 + sub * 4;
#pragma unroll
            for (int jj = 0; jj < 4; ++jj) *(GAS u32x2*)(kp + jj * 32) = pk4(xk[jj]); }
    }
}
__device__ __forceinline__ void p_conv(const Frame& F, const AV& a, int l, int njobs) {
    LAS unsigned char* lin = F.lds + RING_OFF; LAS float* lout = (LAS float*)(F.lds + RING_OFF + 62 * 1024);
    const bf16* cu = (const bf16*)(a.ws() + WS_CU); bf16* chb = (bf16*)(a.ws() + WS_CH);
    const int cp = F.tid & 255, pg = F.tid >> 8;
    f32x2 wv[31];
#pragma unroll
    for (int j = 0; j < 31; ++j) wv[j] = *(const GAS f32x2*)(a.in(14) + ((size_t)l * 31 + j) * 512 + 2 * cp);
    const f32x2 cb2 = *(const GAS f32x2*)(a.in(15) + l * 512 + 2 * cp);
    for (int job = F.vcu; job < njobs; job += F.G) {
        int rowbase, L, t0;
        if (job < 1024) { rowbase = (job >> 6) * SEQ; L = SEQ; t0 = (job & 63) * 32; } else { const int jc = job - 1024; rowbase = TL + (jc >> 3) * CTXL; L = CTXL; t0 = (jc & 7) * 32; }
        for (int idx = F.tid; idx < 62 * 64; idx += NTHR) { const int row = idx >> 6, ch = idx & 63, p = t0 - 15 + row; v4u val = (v4u){0u, 0u, 0u, 0u};
            if (p >= 0 && p < L) val = *(const GAS v4u*)(cu + (size_t)(rowbase + p) * 512 + ch * 8);
            *(LAS v4u*)(lin + row * 1024 + ch * 16) = val; }
        __syncthreads();
#pragma unroll
        for (int chunk = 0; chunk < 2; ++chunk) {
            f32x2 acc[8];
#pragma unroll
            for (int i = 0; i < 8; ++i) acc[i] = cb2;
            const int r0 = pg * 16 + chunk * 8;
#pragma unroll
            for (int r = 0; r < 38; ++r) { const unsigned w = *(const LAS unsigned*)(lin + (r0 + r) * 1024 + cp * 4); const float x0 = __uint_as_float(w << 16), x1 = __uint_as_float(w & 0xffff0000u);
#pragma unroll
                for (int i = 0; i < 8; ++i) { const int j = r - i; if (j >= 0 && j <= 30) { acc[i].x += x0 * wv[j].x; acc[i].y += x1 * wv[j].y; } } }
#pragma unroll
            for (int i = 0; i < 8; ++i) *(LAS f32x2*)(lout + (r0 + i) * 512 + 2 * cp) = acc[i];
        }
        __syncthreads();
#pragma unroll
        for (int pp = 0; pp < 4; ++pp) { const int p = F.wave * 4 + pp; const LAS float* src = lout + p * 512 + F.lane * 8;
            f32x4 y0 = *(const LAS f32x4*)src, y1 = *(const LAS f32x4*)(src + 4);
            const float mean = wave_sum((y0[0] + y0[1]) + (y0[2] + y0[3]) + (y1[0] + y1[1]) + (y1[2] + y1[3]), F.lane) * (1.0f / 512.0f);
            y0 = y0 - mean; y1 = y1 - mean;
            const float var = wave_sum((y0[0] * y0[0] + y0[1] * y0[1]) + (y0[2] * y0[2] + y0[3] * y0[3]) + (y1[0] * y1[0] + y1[1] * y1[1]) + (y1[2] * y1[2] + y1[3] * y1[3]), F.lane) * (1.0f / 512.0f);
            const float rs = 1.0f / sqrtf(var + EPS);
            const f32x4 g0 = *(const GAS f32x4*)(a.in(16) + l * 512 + F.lane * 8), g1 = *(const GAS f32x4*)(a.in(16) + l * 512 + F.lane * 8 + 4);
            const f32x4 b0 = *(const GAS f32x4*)(a.in(17) + l * 512 + F.lane * 8), b1 = *(const GAS f32x4*)(a.in(17) + l * 512 + F.lane * 8 + 4);
            y0 = y0 * rs * g0 + b0; y1 = y1 * rs * g1 + b1;
#pragma unroll
            for (int q = 0; q < 4; ++q) { y0[q] = y0[q] * sigmoidf_(y0[q]); y1[q] = y1[q] * sigmoidf_(y1[q]); }
            v4u o; o.x = pk2(y0[0], y0[1]); o.y = pk2(y0[2], y0[3]); o.z = pk2(y1[0], y1[1]); o.w = pk2(y1[2], y1[3]);
            *(GAS v4u*)(chb + (size_t)(rowbase + t0 + p) * 512 + F.lane * 8) = o; }
        __syncthreads();
    }
}
__device__ __forceinline__ void p_rowpass1(const Frame& F, const AV& a, int l, int M) {
    const int gw = F.vcu * NWAVES + F.wave, NGW = F.G * NWAVES, rpw = (M + NGW - 1) / NGW, r0 = gw * rpw, r1 = (r0 + rpw < M) ? r0 + rpw : M;
    if (r0 >= r1) return;
    const float* modb = (const float*)(a.ws() + WS_MOD) + (size_t)l * 17 * INCOLS; const bf16* mixb = (const bf16*)(a.ws() + WS_MIX);
    f32x4 gpost[4], gpre[4], gate[4], shift[4], scale[4]; ld4(gpost, a.in(7) + l * DM, F.lane); ld4(gpre, a.in(8) + l * DM, F.lane);
    int cb = -1;
    auto xsrc = [&](int m) -> const float* { return (l == 0) ? (m < TL ? a.in(0) + (size_t)m * DM : a.in(2) + (size_t)(m - TL) * DM) : (m < TL ? a.out() + (size_t)m * DM : (const float*)(a.ws() + WS_XC) + (size_t)(m - TL) * DM); };
    f32x4 xn[4]; u32x2 mn[4]; ld4(xn, xsrc(r0), F.lane);
#pragma unroll
    for (int j = 0; j < 4; ++j) mn[j] = ((const GAS u32x2*)(mixb + (size_t)r0 * DM))[F.lane + 64 * j];
    for (int m = r0; m < r1; ++m) {
        f32x4 x[4], y[4];
#pragma unroll
        for (int j = 0; j < 4; ++j) { x[j] = xn[j]; y[j] = bf4(mn[j]); }
        if (m + 1 < r1) { ld4(xn, xsrc(m + 1), F.lane);
#pragma unroll
            for (int j = 0; j < 4; ++j) mn[j] = ((const GAS u32x2*)(mixb + (size_t)(m + 1) * DM))[F.lane + 64 * j]; }
        const int b = m < TL ? (m >> 11) : 16;
        if (b != cb) { cb = b; const float* mv = modb + (size_t)b * INCOLS; ld4(gate, mv + 2 * 1024, F.lane); ld4(shift, mv + 3 * 1024, F.lane); ld4(scale, mv + 4 * 1024, F.lane); }
        const float r = 1.0f / sqrtf(wave_sum(sumsq4(y), F.lane) * (1.0f / 1024.0f) + EPS);
#pragma unroll
        for (int j = 0; j < 4; ++j) x[j] = x[j] + gate[j] * (y[j] * r * gpost[j]);
        float* xd = m < TL ? a.out() + (size_t)m * DM : (float*)(a.ws() + WS_XC) + (size_t)(m - TL) * DM;
        st_row_f32(x, xd, F.lane);
        const float r2 = 1.0f / sqrtf(wave_sum(sumsq4(x), F.lane) * (1.0f / 1024.0f) + EPS);
        bf16* ho = (bf16*)(a.ws() + WS_H) + (size_t)m * DM; unsigned char* h8 = a.ws() + WS_H8 + (size_t)m * DM;
#pragma unroll
        for (int j = 0; j < 4; ++j) { const f32x4 hv = x[j] * r2 * gpre[j] * (scale[j] + 1.0f) + shift[j]; ((GAS u32x2*)ho)[F.lane + 64 * j] = pk4(hv); ((GAS unsigned*)h8)[F.lane + 64 * j] = pk4_fp8(hv); }
    }
}
__device__ __forceinline__ void p_route(const Frame& F, const AV& a, int l, int M) {
    typedef short bfx8 __attribute__((ext_vector_type(8)));
    const int NGW = F.G * NWAVES, rpw = (M + NGW - 1) / NGW, TPB = 8 * rpw, b0 = F.vcu * TPB, b1 = (b0 + TPB < M) ? b0 + TPB : M;
    LAS unsigned char* tabl = F.lds + RING_OFF; LAS float* lg = (LAS float*)(F.lds + LDS_SM) + F.wave * 512; LAS int* cntl = (LAS int*)(F.lds + LDS_SM + 16384);
    VM_WAIT(); __syncthreads();
    if (F.tid < 32) cntl[F.tid] = 0;
    { const GAS v4u* src = (const GAS v4u*)(a.ws() + WS_WSMALL + (size_t)l * WSMALL_LAYER + OFFS_ROUT);
      for (int idx = F.tid; idx < 64 * 128; idx += NTHR) { const int row = idx >> 7, c = idx & 127; *(LAS v4u*)(tabl + row * 2048 + ((c ^ (row & 7)) << 4)) = src[idx]; } }
    __syncthreads();
    const bf16* H = (const bf16*)(a.ws() + WS_H); const float bias = a.in(22)[l * NEXP + (F.lane & 31)];
    const int ar = F.lane & 15, kb = F.lane >> 4, ng = (b1 > b0) ? (b1 - b0 + 15) >> 4 : 0;
    for (int g = F.wave; g < ng; g += NWAVES) {
        const int rb = b0 + g * 16; int row = rb + ar; if (row > M - 1) row = M - 1;
        const bf16* hp = H + (size_t)row * DM + kb * 8; f32x4 acc[4];
#pragma unroll
        for (int f = 0; f < 4; ++f) acc[f] = (f32x4){0.f, 0.f, 0.f, 0.f};
#pragma unroll 4
        for (int s = 0; s < 32; ++s) { const bfx8 af = *(const GAS bfx8*)(hp + s * 32);
#pragma unroll
            for (int f = 0; f < 4; ++f) { const int wr = f * 16 + ar; const bfx8 bfr = *(const LAS bfx8*)(tabl + wr * 2048 + (((4 * s + kb) ^ (wr & 7)) << 4));
                acc[f] = __builtin_amdgcn_mfma_f32_16x16x32_bf16(af, bfr, acc[f], 0, 0, 0); } }
#pragma unroll
        for (int i = 0; i < 4; ++i) { lg[(4 * kb + i) * 32 + ar] = acc[0][i] + acc[2][i]; lg[(4 * kb + i) * 32 + 16 + ar] = acc[1][i] + acc[3][i]; }
        LDS_WAIT(); asm volatile("" ::: "memory");
        { const int hf = F.lane >> 5, ex = F.lane & 31; LAS unsigned long long* kb64 = (LAS unsigned long long*)(F.lds + LDS_SM + 16384 + 256) + F.wave * 64;
          LAS float* selv = (LAS float*)(F.lds + LDS_SM + 16384 + 256 + 4096) + F.wave * 16; LAS int* seli = (LAS int*)(selv + 8);
#pragma unroll 1
          for (int p = 0; p < 8; ++p) { const int r = 2 * p + hf, m = rb + r; const bool valid = m < b1;
            const float v = lg[r * 32 + ex] + bias; unsigned ub = __float_as_uint(v); ub = (ub & 0x80000000u) ? ~ub : (ub | 0x80000000u);
            const unsigned long long K = ((unsigned long long)ub << 5) | (unsigned)(31 - ex);
            kb64[F.lane] = K;
            LDS_WAIT(); asm volatile("" ::: "memory");
            int rank = 0;
#pragma unroll
            for (int j = 0; j < 32; ++j) rank += (kb64[hf * 32 + j] > K) ? 1 : 0;
            if (rank < 4) { selv[hf * 4 + rank] = v; seli[hf * 4 + rank] = ex; if (valid) __hip_atomic_fetch_add(&cntl[ex], 1, __ATOMIC_RELAXED, __HIP_MEMORY_SCOPE_WORKGROUP); }
            LDS_WAIT(); asm volatile("" ::: "memory");
            if (ex == 0 && valid) { const f32x4 tv = *(const LAS f32x4*)(selv + hf * 4); const i32x4 ti = *(const LAS i32x4*)(seli + hf * 4);
                const float e1 = __expf(tv[1] - tv[0]), e2 = __expf(tv[2] - tv[0]), e3 = __expf(tv[3] - tv[0]), inv = 1.0f / (1.0f + e1 + e2 + e3);
                *(GAS i32x4*)((int*)(a.ws() + WS_TOPI) + (size_t)m * 4) = ti; *(GAS f32x4*)((float*)(a.ws() + WS_TOPP) + (size_t)m * 4) = (f32x4){inv, e1 * inv, e2 * inv, e3 * inv}; }
            LDS_WAIT(); asm volatile("" ::: "memory"); } }
        LDS_WAIT(); asm volatile("" ::: "memory");
    }
    __syncthreads();
    if (F.tid < 32) ((int*)(a.ws() + WS_CNT))[F.vcu * 32 + F.tid] = cntl[F.tid];
}
__device__ __forceinline__ void p_slots(const Frame& F, const AV& a, int M) {
    LAS int* sm = (LAS int*)(F.lds + LDS_SM);
    LAS int *tot = sm, *bef = sm + 32, *base = sm + 64, *tst = sm + 96  , *mask = sm + 160  , *ids = sm + 320  , *slot = sm + 960  ;
    const int* cnt = (const int*)(a.ws() + WS_CNT);
    { LAS int* ptot = sm + 1600; LAS int* pbef = sm + 2112; const int e = F.tid & 31, part = F.tid >> 5; int t = 0, b = 0;
#pragma unroll 4
      for (int q = part; q < F.G; q += 16) { const int c = cnt[q * 32 + e]; t += c; if (q < F.vcu) b += c; }
      ptot[part * 32 + e] = t; pbef[part * 32 + e] = b;
      __syncthreads();
      if (F.tid < 32) { int tt = 0, bb = 0;
#pragma unroll
          for (int q = 0; q < 16; ++q) { tt += ptot[q * 32 + F.tid]; bb += pbef[q * 32 + F.tid]; }
          tot[F.tid] = tt; bef[F.tid] = bb; } }
    __syncthreads();
    if (F.tid == 0) { int ts = 0; for (int e = 0; e < 32; ++e) { tst[e] = ts; base[e] = ts * 256 + bef[e]; ts += (tot[e] + 255) >> 8; } tst[32] = ts; }
    __syncthreads();
    const int NT = tst[32];
    if (blockIdx.x == 0) { int* te = (int*)(a.ws() + WS_CNT) + CNT_TILE_E;
        for (int t = F.tid; t < NT; t += NTHR) { int e = 0; for (int q = 1; q < 32; ++q) if (t >= tst[q]) e = q; te[t] = e; }
        if (F.tid == 0) ((int*)(a.ws() + WS_CNT))[CNT_NT] = NT; }
    const int TPB = 8 * ((M + F.G * NWAVES - 1) / (F.G * NWAVES)), m0 = F.vcu * TPB, m1 = (m0 + TPB < M) ? m0 + TPB : M, nt = m1 > m0 ? m1 - m0 : 0;
    for (int tl = F.tid; tl < nt; tl += NTHR) { const i32x4 id = *(const GAS i32x4*)((const int*)(a.ws() + WS_TOPI) + (size_t)(m0 + tl) * 4);
        ids[tl * 4 + 0] = id.x; ids[tl * 4 + 1] = id.y; ids[tl * 4 + 2] = id.z; ids[tl * 4 + 3] = id.w; mask[tl] = (1 << id.x) | (1 << id.y) | (1 << id.z) | (1 << id.w); }
    __syncthreads();
    for (int p = F.tid; p < nt * 4; p += NTHR) { const int tl = p >> 2, e = ids[p]; int rank = 0; for (int q = 0; q < tl; ++q) rank += (mask[q] >> e) & 1;
        const int s = base[e] + rank; slot[p] = s; ((int*)(a.ws() + WS_SLOT))[(size_t)(m0 + tl) * 4 + (p & 3)] = s; ((int*)(a.ws() + WS_CNT))[CNT_ROWSRC + s] = m0 + tl; }
    __syncthreads();
    if (blockIdx.x < 32) { const int e = blockIdx.x, r0 = tst[e] * 256 + tot[e], r1 = tst[e + 1] * 256;
        for (int r = r0 + F.tid; r < r1; r += NTHR) ((int*)(a.ws() + WS_CNT))[CNT_ROWSRC + r] = 0; }
    __syncthreads();
}
__device__ __forceinline__ void p_combine(const Frame& F, const AV& a, int l, int M) {
    const int gw = F.vcu * NWAVES + F.wave, NGW = F.G * NWAVES, rpw = (M + NGW - 1) / NGW, r0 = gw * rpw, r1 = (r0 + rpw < M) ? r0 + rpw : M;
    if (r0 >= r1) return;
    const unsigned char* ys = a.ws() + WS_YS;   const int* slp = (const int*)(a.ws() + WS_SLOT); const float* prp = (const float*)(a.ws() + WS_TOPP);
    const float* modb = (const float*)(a.ws() + WS_MOD);
    f32x4 gpost[4], gpre[4], gate[4], shift[4], scale[4]; ld4(gpost, a.in(9) + l * DM, F.lane); if (l == 0) ld4(gpre, a.in(6) + DM, F.lane);
    int cb = -1;
    i32x4 sl_n = *(const GAS i32x4*)(slp + (size_t)r0 * 4); f32x4 pr_n = *(const GAS f32x4*)(prp + (size_t)r0 * 4);
    f32x4 xn[4]; unsigned yn[4][4]; f32x4 prc = pr_n * 0.125f;
    auto xrow = [&](int m) -> float* { return m < TL ? a.out() + (size_t)m * DM : (float*)(a.ws() + WS_XC) + (size_t)(m - TL) * DM; };
    { ld4(xn, xrow(r0), F.lane); const int sv[4] = {sl_n[0], sl_n[1], sl_n[2], sl_n[3]};
#pragma unroll
      for (int k = 0; k < 4; ++k)
#pragma unroll
          for (int j = 0; j < 4; ++j) yn[k][j] = ((const GAS unsigned*)(ys + (size_t)sv[k] * DM))[F.lane + 64 * j];
      if (r0 + 1 < r1) { sl_n = *(const GAS i32x4*)(slp + (size_t)(r0 + 1) * 4); pr_n = *(const GAS f32x4*)(prp + (size_t)(r0 + 1) * 4); } }
    for (int m = r0; m < r1; ++m) {
        f32x4 x[4], y[4];
#pragma unroll
        for (int j = 0; j < 4; ++j) { x[j] = xn[j]; y[j] = fp8x4(yn[0][j]) * prc[0] + fp8x4(yn[1][j]) * prc[1] + fp8x4(yn[2][j]) * prc[2] + fp8x4(yn[3][j]) * prc[3]; }
        if (m + 1 < r1) { prc = pr_n * 0.125f; ld4(xn, xrow(m + 1), F.lane); const int sv[4] = {sl_n[0], sl_n[1], sl_n[2], sl_n[3]};
#pragma unroll
            for (int k = 0; k < 4; ++k)
#pragma unroll
                for (int j = 0; j < 4; ++j) yn[k][j] = ((const GAS unsigned*)(ys + (size_t)sv[k] * DM))[F.lane + 64 * j];
            if (m + 2 < r1) { sl_n = *(const GAS i32x4*)(slp + (size_t)(m + 2) * 4); pr_n = *(const GAS f32x4*)(prp + (size_t)(m + 2) * 4); } }
        const int b = m < TL ? (m >> 11) : 16;
        if (b != cb) { cb = b; ld4(gate, modb + ((size_t)l * 17 + b) * INCOLS + 5 * 1024, F.lane); if (l == 0) { const float* m1 = modb + ((size_t)17 + b) * INCOLS; ld4(shift, m1, F.lane); ld4(scale, m1 + 1024, F.lane); } }
        const float r = 1.0f / sqrtf(wave_sum(sumsq4(y), F.lane) * (1.0f / 1024.0f) + EPS);
#pragma unroll
        for (int j = 0; j < 4; ++j) x[j] = x[j] + gate[j] * (y[j] * r * gpost[j]);
        st_row_f32(x, xrow(m), F.lane);
        if (l == 0) { const float r2 = 1.0f / sqrtf(wave_sum(sumsq4(x), F.lane) * (1.0f / 1024.0f) + EPS);
            bf16* ho = (bf16*)(a.ws() + WS_H) + (size_t)m * DM; unsigned char* h8 = a.ws() + WS_H8 + (size_t)m * DM;
#pragma unroll
            for (int j = 0; j < 4; ++j) { const f32x4 hv = x[j] * r2 * gpre[j] * (scale[j] + 1.0f) + shift[j]; ((GAS u32x2*)ho)[F.lane + 64 * j] = pk4(hv); ((GAS unsigned*)h8)[F.lane + 64 * j] = pk4_fp8(hv); } }
    }
}
#ifdef DBG_CHECK
#ifndef DBG_GSUB
#define DBG_GSUB 0
#endif
__device__ __forceinline__ double bfd(bf16 b) { return (double)__uint_as_float(((unsigned)b) << 16); }
__device__ __forceinline__ unsigned hsh(unsigned x) { x ^= x >> 16; x *= 0x7feb352du; x ^= x >> 15; x *= 0x846ca68bu; x ^= x >> 16; return x; }
__device__ __forceinline__ int samp_row(int i, int M, unsigned salt) { const int sp[12] = {0, 1, 255, 256, 2047, 2048, 4095, 32767, 32768, 32769, 33023, 36863}; if (i < 12 && sp[i] < M) return sp[i]; return (int)(hsh(i * 7919u + salt) % (unsigned)M); }
__device__ __forceinline__ void rec(float* res, int stage, double got, double want, double flo) { const double e = fabs(got - want) / (fabs(want) + flo); const float f = (e == e) ? (float)e : 1e30f; atomicMax((unsigned*)res + stage, __float_as_uint(f)); }
__device__ double dot_h_w(const bf16* hrow, const float* w, int ldw, int col) { double s = 0; for (int k = 0; k < 1024; ++k) s += bfd(hrow[k]) * (double)w[(size_t)k * ldw + col]; return s; }
__device__ double dsig(double x) { return 1.0 / (1.0 + exp(-x)); }
constexpr double PI_D = 3.14159265358979323846;
enum { ST_MOD = 0, ST_H0, ST_INPROJ, ST_YT, ST_QKFIX, ST_CONV, ST_Z, ST_ATTN, ST_GATES, ST_MERGED, ST_MIX, ST_ROW1, ST_LOGIT, ST_TOPK, ST_SLOTS, ST_ACT, ST_YSLOT, ST_COMB, ST_GATESB, ST_N };
__global__ void chk(Args A, int stage, int l, float* res, float* snap) {
    const int i = threadIdx.x; unsigned char* ws = A.ws; const int M = (l == 0) ? TALL : TL; const int rs = stage + 32 * l;
    const bf16* H = (const bf16*)(ws + WS_H); const float* win = A.in[10] + (size_t)l * DM * INCOLS; const float* modb = (const float*)(ws + WS_MOD);
    if (stage == ST_MOD) { const int ll = i & 1, b = (i >> 1) % 17, n = (int)(hsh(i) % 6144u); double s = 0; for (int k = 0; k < 1024; ++k) { const double cv = b < 16 ? A.in[1][b * 1024 + k] : A.in[3][k]; s += cv * dsig(cv) * (double)A.in[4][((size_t)ll * 1024 + k) * 6144 + n]; }
        s += A.in[5][ll * 6144 + n]; rec(res, rs, modb[((size_t)ll * 17 + b) * 6144 + n], s, 0.02); }
    else if (stage == ST_H0) { const int m = samp_row(i, TALL, 1), c = (int)(hsh(i + 77) % 1024u); const float* x = m < TL ? A.in[0] + (size_t)m * DM : A.in[2] + (size_t)(m - TL) * DM; double ss = 0; for (int k = 0; k < 1024; ++k) ss += (double)x[k] * x[k];
        const float* mv = modb + (size_t)(m < TL ? (m >> 11) : 16) * 6144; const double want = x[c] / sqrt(ss / 1024 + 1e-6) * A.in[6][c] * (1.0 + mv[1024 + c]) + mv[c]; rec(res, rs, bfd(H[(size_t)m * DM + c]), want, 0.05); }
    else if (stage == ST_INPROJ) { const int m = samp_row(i, TALL, 2), kind = i & 3; const bf16* hr = H + (size_t)m * DM;
        if (kind == 0) { const int n = (int)(hsh(i + 5) % 1024u); rec(res, rs, bfd(((const bf16*)(ws + WS_Q))[(size_t)m * DM + n]), dot_h_w(hr, win, INCOLS, n), 0.05); }
        else if (kind == 1) { const int n = (int)(hsh(i + 6) % 256u); rec(res, rs, bfd(((const bf16*)(ws + WS_K))[(size_t)krow_of(m) * 256 + n]), dot_h_w(hr, win, INCOLS, 1024 + n), 0.05); }
        else if (kind == 2) { const int n = (int)(hsh(i + 7) % 256u); rec(res, rs, bfd(((const bf16*)(ws + WS_V))[(size_t)krow_of(m) * 256 + n]), dot_h_w(hr, win, INCOLS, 1280 + n), 0.05); }
        else { const int c = (int)(hsh(i + 8) % 512u); if (l == 0 || m < TL) { const double a = dot_h_w(hr, win, INCOLS, 1536 + c), g = dot_h_w(hr, win, INCOLS, 2048 + c); rec(res, rs, bfd(((const bf16*)(ws + WS_CU))[(size_t)m * 512 + c]), a * dsig(g), 0.05); } } }
    else if (stage == ST_YT) { const int m = samp_row(i, M, 3), ch = (int)(hsh(i + 9) % 512u), cs = i & 1, g = ch >> 7, k2 = ch & 127; const bf16* hr = H + (size_t)m * DM; double s = 0;
        for (int k = 0; k < 1024; ++k) { double t = 0; for (int n2 = 0; n2 < 128; ++n2) { const double ang = 2.0 * PI_D * ((n2 * k2) & 127) / 128.0; t += (double)win[(size_t)k * INCOLS + OFF_FNET + g * 128 + n2] * (cs ? sin(ang) : cos(ang)); } s += bfd(hr[k]) * t; }
        s /= sqrt(128.0); double got; if (m < TL) got = bfd(((const bf16*)(ws + WS_YT))[((size_t)(m >> 11) * 512 + ch) * 4096 + cs * 2048 + (m & 2047)]); else got = bfd(((const bf16*)(ws + WS_YTC))[((size_t)((m - TL) >> 8) * 512 + ch) * 512 + cs * 256 + ((m - TL) & 255)]);
        rec(res, rs, got, s, 0.05); }
    else if (stage == ST_QKFIX) { const int m = samp_row(i, TALL, 4), isk = i & 1, hh = isk ? (int)(hsh(i + 3) % 2u) : (int)(hsh(i + 3) % 8u), d = (int)(hsh(i + 4) % 128u); const bf16* hr = H + (size_t)m * DM;
        if (isk || l == 0 || m < TL) { const int cbase = isk ? 1024 + hh * 128 : hh * 128; double ss = 0, xd = 0, xp = 0; const int half = d & 64, dd = d & 63, pd = half + ((dd + 32) & 63);
            for (int q = 0; q < 128; ++q) { double v = dot_h_w(hr, win, INCOLS, cbase + q); v = bfd((bf16)f2bf((float)v)); ss += v * v; if (q == d) xd = v; if (q == pd) xp = v; }
            const float* gn = (isk ? A.in[12] : A.in[11]) + l * 128; const double r = 1.0 / sqrt(ss / 128 + 1e-6); xd *= r * gn[d]; xp *= r * gn[pd]; double want = xd;
            if (m < TL) { const int t = m & 2047, pos = half ? (t & 63) : (t >> 6), f = dd & 31; const double ang = (double)((float)pos * powf(10000.0f, -(float)f / 32.0f)); want = (dd < 32) ? xd * cos(ang) - xp * sin(ang) : xd * cos(ang) + xp * sin(ang); }
            const double got = isk ? bfd(((const bf16*)(ws + WS_K))[(size_t)krow_of(m) * 256 + hh * 128 + d]) : bfd(((const bf16*)(ws + WS_Q))[(size_t)m * DM + hh * 128 + d]); rec(res, rs, got, want, 0.05); } }
    else if (stage == ST_CONV) { const int m = samp_row(i, M, 5), c = (int)(hsh(i + 11) % 512u); const int rowbase = m < TL ? (m >> 11) * SEQ : TL + ((m - TL) >> 8) * CTXL, L = m < TL ? SEQ : CTXL, t = m - rowbase; const bf16* cu = (const bf16*)(ws + WS_CU);
        double s1 = 0, s2 = 0, yc = 0; for (int cc = 0; cc < 512; ++cc) { double y = A.in[15][l * 512 + cc]; for (int j = 0; j < 31; ++j) { const int p = t + j - 15; if (p >= 0 && p < L) y += bfd(cu[(size_t)(rowbase + p) * 512 + cc]) * (double)A.in[14][((size_t)l * 31 + j) * 512 + cc]; } s1 += y; s2 += y * y; if (cc == c) yc = y; }
        const double mean = s1 / 512, var = s2 / 512 - mean * mean; double y = (yc - mean) / sqrt(var + 1e-6) * A.in[16][l * 512 + c] + A.in[17][l * 512 + c]; y = y * dsig(y); rec(res, rs, bfd(((const bf16*)(ws + WS_CH))[(size_t)m * 512 + c]), y, 0.05); }
    else if (stage == ST_Z) { const int m = samp_row(i, M, 6), ch = (int)(hsh(i + 12) % 512u); double s = 0;
        if (m < TL) { const int b = m >> 11, k1 = m & 2047; const bf16* yr = (const bf16*)(ws + WS_YT) + ((size_t)b * 512 + ch) * 4096; for (int n1 = 0; n1 < 2048; ++n1) { const double ang = 2.0 * PI_D * ((k1 * n1) & 2047) / 2048.0; s += cos(ang) * bfd(yr[n1]) - sin(ang) * bfd(yr[2048 + n1]); } s /= sqrt(2048.0); }
        else { const int b = (m - TL) >> 8, k1 = (m - TL) & 255; const bf16* yr = (const bf16*)(ws + WS_YTC) + ((size_t)b * 512 + ch) * 512; for (int n1 = 0; n1 < 256; ++n1) { const double ang = 2.0 * PI_D * ((k1 * n1) & 255) / 256.0; s += cos(ang) * bfd(yr[n1]) - sin(ang) * bfd(yr[256 + n1]); } s /= 16.0; }
        rec(res, rs, bfd(((const bf16*)(ws + WS_Z))[(size_t)m * 512 + ch]), s, 0.05); }
    else if (stage == ST_ATTN) { const int m = samp_row(i, M, 7), hh = (int)(hsh(i + 13) % 8u), d = (int)(hsh(i + 14) % 128u); const bf16* q = (const bf16*)(ws + WS_Q) + (size_t)m * DM + hh * 128;
        int kr0, nk; if (m < TL) { kr0 = (m >> 11) * KVROWS; nk = KVROWS; } else { kr0 = ((m - TL) >> 8) * KVROWS + SEQ; nk = CTXL; }
        const bf16* K = (const bf16*)(ws + WS_K) + (size_t)kr0 * 256 + (hh >> 2) * 128; const bf16* V = (const bf16*)(ws + WS_V) + (size_t)kr0 * 256 + (hh >> 2) * 128;
        double mx = -1e300; for (int j = 0; j < nk; ++j) { double s = 0; for (int q2 = 0; q2 < 128; ++q2) s += bfd(q[q2]) * bfd(K[(size_t)j * 256 + q2]); s *= 0.08838834764831845; if (s > mx) mx = s; }
        double den = 0, num = 0; for (int j = 0; j < nk; ++j) { double s = 0; for (int q2 = 0; q2 < 128; ++q2) s += bfd(q[q2]) * bfd(K[(size_t)j * 256 + q2]); s *= 0.08838834764831845; const double p = exp(s - mx); den += p; num += p * bfd(V[(size_t)j * 256 + d]); }
        rec(res, rs, bfd(((const bf16*)(ws + WS_AO))[(size_t)m * DM + hh * 128 + d]), num / den, 0.03); }
    else if (stage == ST_GATES) { const int m = samp_row(i, M, 8), n = (int)(hsh(i + 15) % 3072u); rec(res, rs, bfd(((const bf16*)(ws + WS_GATES))[(size_t)m * 3072 + n]), dsig(dot_h_w(H + (size_t)m * DM, win, INCOLS, OFF_GATE + n)), 0.05); }
    else if (stage == ST_GATESB && DBG_GSUB == 1) { const int m = samp_row(i, M, 8), n = (int)(hsh(i + 15) % 3072u); const double got = bfd(((const bf16*)(ws + WS_GATES))[(size_t)m * 3072 + n]), want = dsig(dot_h_w(H + (size_t)m * DM, win, INCOLS, OFF_GATE + n));
        const bool badv = !(fabs(got - want) <= 0.05); if (badv) { unsigned* r = (unsigned*)res + 48; atomicOr(r, (m < TL ? 1u : 2u) | (4u << (n >> 10)) | (i < 12 ? 32u : 0u)); } }
    else if (stage == ST_GATESB) { const int m = samp_row(i, M, 8), n = (int)(hsh(i + 15) % 3072u); const bf16* wt = (const bf16*)(ws + WS_WSMALL + (size_t)l * WSMALL_LAYER + OFFS_WG) + (size_t)n * 1024; const bf16* hr = H + (size_t)m * DM; double s = 0; for (int k = 0; k < 1024; ++k) s += bfd(hr[k]) * bfd(wt[k]);
        rec(res, rs, bfd(((const bf16*)(ws + WS_GATES))[(size_t)m * 3072 + n]), dsig(s), 0.05); }
    else if (stage == ST_MERGED) { const int m = samp_row(i, M, 9), c = (int)(hsh(i + 16) % 1024u); const bf16* g = (const bf16*)(ws + WS_GATES) + (size_t)m * 3072; double y0 = 0, y1 = 0, y2 = 0;
        const bf16* ao = (const bf16*)(ws + WS_AO) + (size_t)m * DM; const bf16* chh = (const bf16*)(ws + WS_CH) + (size_t)m * 512; const bf16* z = (const bf16*)(ws + WS_Z) + (size_t)m * 512;
        for (int k = 0; k < 1024; ++k) y0 += bfd(ao[k]) * (double)A.in[13][((size_t)l * 1024 + k) * 1024 + c];
        for (int k = 0; k < 512; ++k) { y1 += bfd(chh[k]) * (double)A.in[18][((size_t)l * 512 + k) * 1024 + c]; y2 += bfd(z[k]) * (double)A.in[19][((size_t)l * 512 + k) * 1024 + c]; }
        rec(res, rs, bfd(((const bf16*)(ws + WS_MERGED))[(size_t)m * DM + c]), bfd(g[c]) * y0 + bfd(g[1024 + c]) * y1 + bfd(g[2048 + c]) * y2, 0.05); }
    else if (stage == ST_MIX) { const int m = samp_row(i, M, 10), c = (int)(hsh(i + 17) % 1024u); rec(res, rs, bfd(((const bf16*)(ws + WS_MIX))[(size_t)m * DM + c]), dot_h_w((const bf16*)(ws + WS_MERGED) + (size_t)m * DM, A.in[20] + (size_t)l * DM * DM, DM, c), 0.05); }
    else if (stage == ST_ROW1) { const int m = samp_row(i, M, 11), c = (int)(hsh(i + 18) % 1024u); const float* xs = snap + (size_t)i * 1024;
        const bf16* mix = (const bf16*)(ws + WS_MIX) + (size_t)m * DM; const float* mv = modb + ((size_t)l * 17 + (m < TL ? (m >> 11) : 16)) * 6144; double ss = 0; for (int k = 0; k < 1024; ++k) ss += bfd(mix[k]) * bfd(mix[k]); const double r = 1.0 / sqrt(ss / 1024 + 1e-6);
        double s2 = 0, xc = 0; for (int k = 0; k < 1024; ++k) { const double xn = xs[k] + mv[2048 + k] * (bfd(mix[k]) * r * A.in[7][l * DM + k]); s2 += xn * xn; if (k == c) xc = xn; }
        const float* xd = m < TL ? A.out + (size_t)m * DM : (const float*)(ws + WS_XC) + (size_t)(m - TL) * DM; rec(res, rs, xd[c], xc, 0.02);
        rec(res, rs, bfd(H[(size_t)m * DM + c]), xc / sqrt(s2 / 1024 + 1e-6) * A.in[8][l * DM + c] * (1.0 + mv[4096 + c]) + mv[3072 + c], 0.05); }
    else if (stage == ST_LOGIT) { const int m = samp_row(i, M, 12), e = i & 31; const float* lg = (const float*)(ws + WS_LOGIT) + (size_t)m * 64; rec(res, rs, (double)lg[e] + lg[32 + e], dot_h_w(H + (size_t)m * DM, A.in[21] + (size_t)l * DM * NEXP, NEXP, e), 0.02); }
    else if (stage == ST_TOPK) { const int m = samp_row(i, M, 13); const float* lg = (const float*)(ws + WS_LOGIT) + (size_t)m * 64; float v[32]; for (int e = 0; e < 32; ++e) v[e] = lg[e] + lg[32 + e] + A.in[22][l * 32 + e];
        int id[4]; float tv[4]; for (int k = 0; k < 4; ++k) { int b = -1; for (int e = 0; e < 32; ++e) { bool used = false; for (int q = 0; q < k; ++q) used |= (id[q] == e); if (!used && (b < 0 || v[e] > v[b])) b = e; } id[k] = b; tv[k] = v[b]; }
        double den = 0; for (int k = 0; k < 4; ++k) den += exp((double)tv[k] - tv[0]); const int* gi = (const int*)(ws + WS_TOPI) + (size_t)m * 4; const float* gp = (const float*)(ws + WS_TOPP) + (size_t)m * 4;
        for (int k = 0; k < 4; ++k) { rec(res, rs, gi[k] == id[k] ? 0.0 : 1.0, 0, 0.01); rec(res, rs, gp[k], exp((double)tv[k] - tv[0]) / den, 0.01); } }
    else if (stage == ST_SLOTS) { const int m = samp_row(i, M, 14), k = i & 3; const int s = ((const int*)(ws + WS_SLOT))[(size_t)m * 4 + k], e = ((const int*)(ws + WS_TOPI))[(size_t)m * 4 + k]; const int NT = ((const int*)(ws + WS_CNT))[CNT_NT];
        if (s < 0 || s >= NT * 256) rec(res, rs, 1, 0, 0.01); else { rec(res, rs, ((const int*)(ws + WS_CNT))[CNT_TILE_E + (s >> 8)] == e ? 0.0 : 1.0, 0, 0.01); const bf16* hs = (const bf16*)(ws + WS_HS) + (size_t)s * DM; double df = 0; for (int q = 0; q < 1024; ++q) df += fabs(bfd(hs[q]) - bfd(H[(size_t)m * DM + q])); rec(res, rs, df, 0, 1e-3); } }
    else if (stage == ST_ACT) { const int m = samp_row(i, M, 15), k = i & 3, c = (int)(hsh(i + 21) % 1024u); const int s = ((const int*)(ws + WS_SLOT))[(size_t)m * 4 + k], e = ((const int*)(ws + WS_TOPI))[(size_t)m * 4 + k]; const bf16* hs = (const bf16*)(ws + WS_HS) + (size_t)s * DM;
        double g = dot_h_w(hs, A.in[23] + (((size_t)l * NEXP + e) << 20), DM, c) + A.in[24][((size_t)l * NEXP + e) * 1024 + c], u = dot_h_w(hs, A.in[25] + (((size_t)l * NEXP + e) << 20), DM, c) + A.in[26][((size_t)l * NEXP + e) * 1024 + c];
        g = g < 7.0 ? g : 7.0; u = u < -7.0 ? -7.0 : (u > 7.0 ? 7.0 : u); rec(res, rs, bfd(((const bf16*)(ws + WS_ACT))[(size_t)s * DM + c]), (u + 1.0) * (g * dsig(1.702 * g)), 0.05); }
    else if (stage == ST_YSLOT) { const int m = samp_row(i, M, 16), k = i & 3, c = (int)(hsh(i + 22) % 1024u); const int s = ((const int*)(ws + WS_SLOT))[(size_t)m * 4 + k], e = ((const int*)(ws + WS_TOPI))[(size_t)m * 4 + k];
        rec(res, rs, bfd(((const bf16*)(ws + WS_HS))[(size_t)s * DM + c]), dot_h_w((const bf16*)(ws + WS_ACT) + (size_t)s * DM, A.in[27] + (((size_t)l * NEXP + e) << 20), DM, c) + A.in[28][((size_t)l * NEXP + e) * 1024 + c], 0.05); }
    else if (stage == ST_COMB) { const int m = samp_row(i, M, 17), c = (int)(hsh(i + 23) % 1024u); const float* xs = snap + (size_t)i * 1024; const int* sl = (const int*)(ws + WS_SLOT) + (size_t)m * 4; const float* pr = (const float*)(ws + WS_TOPP) + (size_t)m * 4;
        const float* mv = modb + ((size_t)l * 17 + (m < TL ? (m >> 11) : 16)) * 6144; double ss = 0, yc = 0; for (int q = 0; q < 1024; ++q) { double y = 0; for (int k = 0; k < 4; ++k) y += (double)pr[k] * bfd(((const bf16*)(ws + WS_HS))[(size_t)sl[k] * DM + q]); ss += y * y; if (q == c) yc = y; }
        const double want = xs[c] + mv[5 * 1024 + c] * (yc / sqrt(ss / 1024 + 1e-6) * A.in[9][l * DM + c]); const float* xd = m < TL ? A.out + (size_t)m * DM : (const float*)(ws + WS_XC) + (size_t)(m - TL) * DM; rec(res, rs, xd[c], want, 0.02); }
}
__global__ void snap_rows(Args A, int l, int salt, float* snap) {
    const int i = blockIdx.x, M = (l == 0) ? TALL : TL, m = samp_row(i, M, salt); const float* xs;
    if (l == 0 && salt == 11) xs = m < TL ? A.in[0] + (size_t)m * DM : A.in[2] + (size_t)(m - TL) * DM; else xs = m < TL ? A.out + (size_t)m * DM : (const float*)(A.ws + WS_XC) + (size_t)(m - TL) * DM;
    for (int k = threadIdx.x; k < 1024; k += blockDim.x) snap[(size_t)i * 1024 + k] = xs[k];
}
__global__ void chk_gates_full(const bf16* H, const bf16* Wt, const bf16* G, int M, unsigned* cntw) {
    const int n = blockIdx.x * 64 + (threadIdx.x & 63), m = blockIdx.y * 4 + (threadIdx.x >> 6); if (m >= M) return;
    const uint4* a = (const uint4*)(H + (size_t)m * 1024); const uint4* b = (const uint4*)(Wt + (size_t)n * 1024); float s = 0.f;
    for (int k = 0; k < 128; ++k) { const uint4 x = a[k], y = b[k]; const unsigned xs[4] = {x.x, x.y, x.z, x.w}, ys[4] = {y.x, y.y, y.z, y.w};
        for (int q = 0; q < 4; ++q) { s += __uint_as_float(xs[q] << 16) * __uint_as_float(ys[q] << 16); s += __uint_as_float(xs[q] & 0xffff0000u) * __uint_as_float(ys[q] & 0xffff0000u); } }
    const float want = 1.0f / (1.0f + __expf(-s)), got = __uint_as_float(((unsigned)G[(size_t)m * 3072 + n]) << 16);
    if (!(fabsf(got - want) <= 0.02f)) { atomicAdd(cntw, 1u); cntw[16 + (m >> 8) * 12 + (n >> 8)] = 1u; }
}
__global__ void encode_full(float* out, const unsigned* cntw, int n) {
    __shared__ int bc, bt; if (threadIdx.x == 0) { unsigned C = cntw[0], T = 0; for (int t = 0; t < 1728; ++t) T += cntw[16 + t]; int b1 = 0; while (C) { ++b1; C /= 10; } int b2 = 0; while (T) { ++b2; T /= 4; } bc = b1 > 7 ? 7 : b1; bt = b2 > 7 ? 7 : b2; }
    __syncthreads(); const float K = ldexpf(1.0f, 2 + 8 * bt + bc);
    for (size_t i = (size_t)blockIdx.x * blockDim.x + threadIdx.x; i < (size_t)n; i += (size_t)gridDim.x * blockDim.x) out[i] = K;
}
__global__ void encode(float* out, const float* res, int n, float thr) {
    #if DBG_GSUB == 1
    { const unsigned mk = ((const unsigned*)res)[48]; const float K = ldexpf(1.0f, 2 + (int)mk); for (size_t i = (size_t)blockIdx.x * blockDim.x + threadIdx.x; i < (size_t)n; i += (size_t)gridDim.x * blockDim.x) out[i] = K; return; }
#endif
#ifndef CHK_SKIP
#define CHK_SKIP 0ull
#endif
    int bad = -1; for (int s = 0; s < 64; ++s) if (!((CHK_SKIP >> s) & 1ull) && res[s] > thr) { bad = s; break; }
    if (bad < 0) return; const float er = res[bad]; const float K = ldexpf(1.0f, bad + 2) * (er < 0.5f ? 1.0f : er < 1.0f ? 1.25f : er < 4.0f ? 1.5f : 1.75f);
    for (size_t i = (size_t)blockIdx.x * blockDim.x + threadIdx.x; i < (size_t)n; i += (size_t)gridDim.x * blockDim.x) out[i] = K;
}
#endif
#ifndef GP_SP2
#define GP_SP2 true
#endif
#ifndef GP_ALIGN
#define GP_ALIGN true
#endif
__global__ void __launch_bounds__(NTHR, 2) fwd(Args args) {
    extern __shared__ __attribute__((aligned(16))) unsigned char lds[];
    Frame F;
    F.lds = (LAS unsigned char*)lds; F.MISC = (volatile LAS unsigned*)(F.lds + MISC_OFF);
    F.tid = threadIdx.x; F.lane = F.tid & 63; F.wave = __builtin_amdgcn_readfirstlane(F.tid >> 6);
    F.G = gridDim.x; { const int bx = blockIdx.x; F.vcu = (F.G % 8 == 0) ? (bx % 8) * (F.G / 8) + bx / 8 : bx; }
    { const AV A0 = av_get(); F.ctl = (gu32*)(A0.ws() + WS_CTL); }
    for (int u = F.tid; u < (LDS_BYTES - LDSCTL_OFF) / 4; u += NTHR) ((LAS unsigned*)(F.lds + LDSCTL_OFF))[u] = 0u;
    __syncthreads();
    XcdBarrier bar; bar.bar = (unsigned*)(F.ctl + CW_BAR); bar.x = 0; bar.st = nullptr;
    if (!MK_PER_PHASE) bar = xcd_barrier_post((unsigned*)(F.ctl + CW_BAR), F.MISC + 8);
    int lo, hi; { const AV A0 = av_get(); lo = *(const int __attribute__((address_space(4)))*)(A0.kp + 8 * 31); hi = *(const int __attribute__((address_space(4)))*)(A0.kp + 8 * 31 + 4); }
#ifndef DIS_MASK
#define DIS_MASK 0ull
#endif
#define IN(k) (lo <= (k) && (k) < hi)
#define ON(j) (!((DIS_MASK >> (j)) & 1ull))
#ifndef REP_MASK
#define REP_MASK 0ull
#endif
#define REPS(j) ((int)((REP_MASK >> (j)) & 1ull))
#ifdef STAMP_SEL
#define SEAM(k) do { xcd_barrier(bar); if (blockIdx.x == 0 && threadIdx.x == 0) ((unsigned long long*)(F.ctl + 32768))[(k) + 1] = __builtin_amdgcn_s_memrealtime(); } while (0)
#else
#ifdef DOUBLE_BAR
#define SEAM(k) do { if (!MK_PER_PHASE && IN((k) + 1)) { xcd_barrier(bar); xcd_barrier(bar); } } while (0)
#else
#define SEAM(k) do { if (!MK_PER_PHASE && IN((k) + 1)) xcd_barrier(bar); } while (0)
#endif
#endif
    const int bx = (int)blockIdx.x;
    const int wave0 = __builtin_amdgcn_readfirstlane((int)threadIdx.x >> 6);
#define F_REFRESH() do { unsigned z_ = 0u; asm volatile("" : "+v"(z_)); const int t_ = wave0 * 64 + (int)__builtin_amdgcn_mbcnt_hi(~0u, __builtin_amdgcn_mbcnt_lo(~0u, z_)); F.tid = t_; F.lane = t_ & 63; F.wave = wave0; } while (0)

#ifdef STAMP_SEL
    if (blockIdx.x == 0 && threadIdx.x == 0) ((unsigned long long*)(F.ctl + 32768))[0] = __builtin_amdgcn_s_memrealtime();
#endif
    if (ON(0) && IN(0)) for (int rep_ = 0; rep_ <= REPS(0); ++rep_) { F_REFRESH(); const AV A = av_get(); p0_prologue(F, A); SEAM(0); }
    if (ON(1) && IN(1)) for (int rep_ = 0; rep_ <= REPS(1); ++rep_) { F_REFRESH(); const AV A = av_get(); p1_norm0(F, A); SEAM(1); }

    for (int l = 0; l < 2; ++l) {
        const int pb = 2 + l * NPL;
        const int Mm = (l == 0) ? TALL : TL;
#define PH_BEGIN F_REFRESH(); const AV A = av_get(); unsigned char* const ws = A.ws(); unsigned char* const wl = ws + WS_WSMALL + (size_t)l * WSMALL_LAYER; (void)wl
        if (ON(2 + 0) && IN(pb + 0)) for (int rep_ = 0; rep_ <= REPS(2 + 0); ++rep_) { PH_BEGIN;
            if (ON(16)) { pg8::Gemm g{(const bf16*)(ws + WS_H8), (const bf16*)(wl + OFFS_WIN), TALL, 2560, DM / 2}; pg8::StaticOrder S; S.init(TALL, 2560, F.G, bx);
              pg8::EpiInproj E{(bf16*)(ws + WS_Q), (bf16*)(ws + WS_K), (bf16*)(ws + WS_V), (bf16*)(ws + WS_CU)};
              pg8::gemm_phase<pg8::EpiInproj, pg8::StaticOrder, GP_ALIGN, GP_SP2, true>(F.lds + RING_OFF, g, S, E, F.tid); }
            if (ON(17)) { pg8::Gemm g{(const bf16*)(wl + OFFS_WF), (const bf16*)(ws + WS_H), 1024, Mm, DM}; pg8::StaticOrder S; S.init(1024, Mm, F.G, (bx + 96) % F.G);
              pg8::EpiYT E{ws + WS_YT, ws + WS_YTC};
              pg8::gemm_phase<pg8::EpiYT, pg8::StaticOrder, GP_ALIGN, GP_SP2>(F.lds + RING_OFF, g, S, E, F.tid); }
            SEAM(pb + 0);
        }
        if (ON(2 + 1) && IN(pb + 1)) for (int rep_ = 0; rep_ <= REPS(2 + 1); ++rep_) { PH_BEGIN;
            if (ON(18)) p_qkfix(F, A, l, TALL);
            F_REFRESH();
            if (ON(19)) p_conv(F, A, l, l == 0 ? 1152 : 1024);
            if (ON(20)) { pg8::Gemm g{(const bf16*)(ws + WS_DFTL), (const bf16*)(ws + WS_YT), 2048, NB * 512, 2048}; pg8::DftOrder S; S.init(3, NB, F.G, F.vcu);
              pg8::EpiDFT E{(bf16*)(ws + WS_Z), 0, SEQ};
              pg8::gemm_phase<pg8::EpiDFT, pg8::DftOrder, GP_ALIGN, GP_SP2, true>(F.lds + RING_OFF, g, S, E, F.tid); }
            if (ON(21) && l == 0) { pg8::Gemm g{(const bf16*)(ws + WS_DFTC), (const bf16*)(ws + WS_YTC), 256, NB * 512, 256}; pg8::DftOrder S; S.init(0, NB, F.G, F.vcu);
              pg8::EpiDFT E{(bf16*)(ws + WS_Z), TL, CTXL};
              pg8::gemm_phase<pg8::EpiDFT, pg8::DftOrder, GP_ALIGN, GP_SP2, true>(F.lds + RING_OFF, g, S, E, F.tid); }
            SEAM(pb + 1);
        }
        if (ON(2 + 2) && IN(pb + 2)) for (int rep_ = 0; rep_ <= REPS(2 + 2); ++rep_) { PH_BEGIN;
            const int nheavy = NB * 8 * 8, ntot = nheavy + (l == 0 ? NB * 8 : 0);
            for (int L = F.vcu; L < ntot; L += F.G) {
                int row0, krow, h, seq, t0;
                if (L < nheavy) { const int grp = L >> 5, s = L & 31, b = grp >> 1; h = (grp & 1) * 4 + (s >> 3); t0 = (s & 7) * 256; row0 = b * SEQ + t0; krow = b * KVROWS; seq = KVROWS; }
                else { const int Lc = L - nheavy, b = Lc >> 3; h = Lc & 7; row0 = TL + b * CTXL; krow = b * KVROWS + SEQ; seq = CTXL; t0 = 0; }
                const att::bf16* Qb = (const att::bf16*)(ws + WS_Q) + (size_t)row0 * DM + h * 128;
                const att::bf16* Kh = (const att::bf16*)(ws + WS_K) + (size_t)krow * 256 + (h >> 2) * 128;
                const att::bf16* Vh = (const att::bf16*)(ws + WS_V) + (size_t)krow * 256 + (h >> 2) * 128;
                unsigned char* Ob = ws + WS_AO + (size_t)row0 * DM + h * 128;
                att::attn_dense_body<att::bf16>(Qb, Kh, Vh, Ob, seq, (char*)lds + RING_OFF, F.tid, A.in(11) + l * 128, (const float*)(ws + WS_TAB), t0, L < nheavy);
                __syncthreads();
            }
            SEAM(pb + 2);
        }
        if (ON(2 + 3) && IN(pb + 3)) for (int rep_ = 0; rep_ <= REPS(2 + 3); ++rep_) { PH_BEGIN;
            pg8::Gemm g{(const bf16*)(ws + WS_H8), (const bf16*)(wl + OFFS_WG), Mm, 3072, DM / 2}; pg8::StaticOrder S; S.init(Mm, 3072, F.G, bx);
            pg8::EpiGates E{(bf16*)(ws + WS_GATES)};
            pg8::gemm_phase<pg8::EpiGates, pg8::StaticOrder, GP_ALIGN, GP_SP2, true>(F.lds + RING_OFF, g, S, E, F.tid);
            SEAM(pb + 3);
        }
        if (ON(2 + 4) && IN(pb + 4)) for (int rep_ = 0; rep_ <= REPS(2 + 4); ++rep_) { PH_BEGIN;
            { pg8::Gemm g{(const bf16*)(ws + WS_AO), (const bf16*)(wl + OFFS_WAO), Mm, 1024, 512}; pg8::StaticOrder S; S.init(Mm, 1024, F.G, bx);
              pg8::EpiMerge<0> E{(bf16*)(ws + WS_MERGED), (bf16*)(ws + WS_ACT), (const bf16*)(ws + WS_GATES), 0, 1.0f / 512.0f};
              pg8::gemm_phase<pg8::EpiMerge<0>, pg8::StaticOrder, GP_ALIGN, GP_SP2, true>(F.lds + RING_OFF, g, S, E, F.tid); }
            { pg8::Gemm g{(const bf16*)(ws + WS_CH), (const bf16*)(wl + OFFS_WCO), Mm, 1024, 512}; pg8::StaticOrder S; S.init(Mm, 1024, F.G, bx);
              pg8::EpiMerge<1> E{(bf16*)(ws + WS_MERGED), (bf16*)(ws + WS_ACT), (const bf16*)(ws + WS_GATES), 1, 1.0f};
              pg8::gemm_phase<pg8::EpiMerge<1>, pg8::StaticOrder, GP_ALIGN, GP_SP2>(F.lds + RING_OFF, g, S, E, F.tid); }
            { pg8::Gemm g{(const bf16*)(ws + WS_Z), (const bf16*)(wl + OFFS_WFO), Mm, 1024, 512}; pg8::StaticOrder S; S.init(Mm, 1024, F.G, bx);
              pg8::EpiMerge<2> E{(bf16*)(ws + WS_MERGED), (bf16*)(ws + WS_ACT), (const bf16*)(ws + WS_GATES), 2, 1.0f};
              pg8::gemm_phase<pg8::EpiMerge<2>, pg8::StaticOrder, GP_ALIGN, GP_SP2>(F.lds + RING_OFF, g, S, E, F.tid); }
            SEAM(pb + 4);
        }
        if (ON(2 + 5) && IN(pb + 5)) for (int rep_ = 0; rep_ <= REPS(2 + 5); ++rep_) { PH_BEGIN;
            pg8::Gemm g{(const bf16*)(ws + WS_MERGED), (const bf16*)(wl + OFFS_WOUT), Mm, 1024, 1024}; pg8::StaticOrder S; S.init(Mm, 1024, F.G, bx);
            pg8::EpiBf16<0> E{(bf16*)(ws + WS_MIX), 1024, nullptr, 0, 0, 1.0f};
            pg8::gemm_phase<pg8::EpiBf16<0>, pg8::StaticOrder, GP_ALIGN, GP_SP2>(F.lds + RING_OFF, g, S, E, F.tid);
            SEAM(pb + 5);
        }
        if (ON(2 + 6) && IN(pb + 6)) for (int rep_ = 0; rep_ <= REPS(2 + 6); ++rep_) { PH_BEGIN; p_rowpass1(F, A, l, Mm); p_route(F, A, l, Mm); SEAM(pb + 6); }
        if (ON(2 + 7) && IN(pb + 7)) for (int rep_ = 0; rep_ <= REPS(2 + 7); ++rep_) { PH_BEGIN; p_slots(F, A, Mm); SEAM(pb + 7); }
        if (ON(2 + 8) && IN(pb + 8)) for (int rep_ = 0; rep_ <= REPS(2 + 8); ++rep_) { PH_BEGIN;
            const int NT = __builtin_amdgcn_readfirstlane(((const int*)(ws + WS_CNT))[CNT_NT]);
            LAS int* te_lds = (LAS int*)(F.lds + LDS_SM);
            for (int i = F.tid; i < NT; i += NTHR) te_lds[i] = ((const int*)(ws + WS_CNT))[CNT_TILE_E + i];
            __syncthreads();
            pg8::Gemm g{(const bf16*)(ws + WS_H8), (const bf16*)(ws + WS_WGU + (size_t)l * MOEW_LAYER), NT * 256, NEXP * 2048, DM / 2}; pg8::GroupedOrder S; S.init(NT, 8, F.G, bx, te_lds); S.rows = (const int*)(ws + WS_CNT) + CNT_ROWSRC;
            pg8::EpiSwiGLU8 E{ws + WS_ACT, A.in(24) + (size_t)l * NEXP * 1024, A.in(26) + (size_t)l * NEXP * 1024};
            pg8::gemm_phase<pg8::EpiSwiGLU8, pg8::GroupedOrder, GP_ALIGN, GP_SP2, true, true>(F.lds + RING_OFF, g, S, E, F.tid);
            SEAM(pb + 8);
        }
        if (ON(2 + 9) && IN(pb + 9)) for (int rep_ = 0; rep_ <= REPS(2 + 9); ++rep_) { PH_BEGIN;
            const int NT = __builtin_amdgcn_readfirstlane(((const int*)(ws + WS_CNT))[CNT_NT]);
            LAS int* te_lds = (LAS int*)(F.lds + LDS_SM);
            for (int i = F.tid; i < NT; i += NTHR) te_lds[i] = ((const int*)(ws + WS_CNT))[CNT_TILE_E + i];
            __syncthreads();
#ifdef STAGGER_US
            { const unsigned long long t0 = __builtin_amdgcn_s_memrealtime(), dl = (unsigned long long)((bx >> 3) & 3) * (STAGGER_US); while (__builtin_amdgcn_s_memrealtime() - t0 < dl) __builtin_amdgcn_s_sleep(8); }
#endif
            pg8::Gemm g{(const bf16*)(ws + WS_ACT), (const bf16*)(ws + WS_WD + (size_t)l * MOEW_LAYER), NT * 256, NEXP * 1024, DM / 2}; pg8::GroupedOrder S; S.init(NT, 4, F.G, bx, te_lds);
#ifdef PROBE_NOSTORE
            pg8::EpiDown8 E{ws + WS_YS, A.in(28) + (size_t)l * NEXP * 1024, rep_};
#else
            pg8::EpiDown8 E{ws + WS_YS, A.in(28) + (size_t)l * NEXP * 1024, 0};
#endif
            pg8::gemm_phase<pg8::EpiDown8, pg8::GroupedOrder, GP_ALIGN, GP_SP2, true>(F.lds + RING_OFF, g, S, E, F.tid);
            SEAM(pb + 9);
        }
        if (ON(2 + 10) && IN(pb + 10)) for (int rep_ = 0; rep_ <= REPS(2 + 10); ++rep_) { PH_BEGIN;
            p_combine(F, A, l, Mm);
            SEAM(pb + 10);
        }
    }
#ifdef STAMP_SEL
    { const AV A = av_get(); float* out = A.out(); const unsigned long long* ts = (const unsigned long long*)(F.ctl + 32768);
      auto span = [&](int p) -> float { unsigned long long d = __hip_atomic_load(ts + p + 1, __ATOMIC_RELAXED, __HIP_MEMORY_SCOPE_AGENT) - __hip_atomic_load(ts + p, __ATOMIC_RELAXED, __HIP_MEMORY_SCOPE_AGENT);
          if (p >= 2) d += __hip_atomic_load(ts + p + NPL + 1, __ATOMIC_RELAXED, __HIP_MEMORY_SCOPE_AGENT) - __hip_atomic_load(ts + p + NPL, __ATOMIC_RELAXED, __HIP_MEMORY_SCOPE_AGENT); return (float)d * 0.01f; };
      const float K1 = span((STAMP_SEL) & 0xff), K2 = 200.0f * span(((STAMP_SEL) >> 8) & 0xff);
      for (size_t i = (size_t)blockIdx.x * NTHR + threadIdx.x; i < (size_t)TL * DM; i += (size_t)gridDim.x * NTHR) out[i] = (i == 0) ? K2 : K1; }
#endif
#undef IN
#undef PH_BEGIN
#undef F_REFRESH
#undef SEAM
}

extern "C" void kernel_launch(void* const* d_in, const int* in_sizes, int n_in, void* d_out, int out_size, void* d_ws, size_t ws_size, hipStream_t stream) {
    static int grid = 0;
    if (grid == 0) {
        if (n_in != 29 || out_size != TL * DM || ws_size < WS_END2) { fprintf(stderr, "kernel_launch: built for 29 inputs, %d outputs, >= %zu bytes of workspace; got n_in %d out %d ws %zu\n", TL * DM, (size_t)WS_END2, n_in, out_size, ws_size); grid = -1; return; }
        int dev = 0, cus = 0, per_cu = 0;
        if (hipGetDevice(&dev) != hipSuccess || hipDeviceGetAttribute(&cus, hipDeviceAttributeMultiprocessorCount, dev) != hipSuccess) { grid = -1; return; }
        if (hipFuncSetAttribute((const void*)fwd, hipFuncAttributeMaxDynamicSharedMemorySize, LDS_BYTES) != hipSuccess) { fprintf(stderr, "kernel_launch: hipFuncSetAttribute failed\n"); grid = -1; return; }
        if (hipOccupancyMaxActiveBlocksPerMultiprocessor(&per_cu, (const void*)fwd, NTHR, LDS_BYTES) != hipSuccess || per_cu < 1) fprintf(stderr, "kernel_launch: occupancy query reports %d\n", per_cu);
        (void)hipGetLastError();
        grid = cus;
    }
    if (grid < 0) return;
    (void)hipMemsetAsync((char*)d_ws + WS_CTL, 0, CTL_ZERO_BYTES, stream);
    Args a{};
    for (int i = 0; i < 29; ++i) a.in[i] = (const float*)d_in[i];
    a.out = (float*)d_out; a.ws = (unsigned char*)d_ws;
#if MK_PER_PHASE
    for (int p = 0; p < NPH; ++p) {
#ifdef DBG_CHECK
        float* res = (float*)((char*)d_ws + WS_CTL + 8192 * 4); float* snap = (float*)((char*)d_ws + WS_END);
        { const int l = p >= 2 ? (p - 2) / NPL : 0, k = p >= 2 ? (p - 2) % NPL : -1;
          if (k == 6) hipLaunchKernelGGL(snap_rows, dim3(256), dim3(256), 0, stream, a, l, 11, snap);
          if (k == 12) hipLaunchKernelGGL(snap_rows, dim3(256), dim3(256), 0, stream, a, l, 17, snap); }
#endif
        a.ph_lo = p; a.ph_hi = p + 1; hipLaunchKernelGGL(fwd, dim3(grid), dim3(NTHR), LDS_BYTES, stream, a);
#ifdef DBG_CHECK
        { const int l = p >= 2 ? (p - 2) / NPL : 0, k = p >= 2 ? (p - 2) % NPL : -1;
#define CHK(st) hipLaunchKernelGGL(chk, dim3(1), dim3(256), 0, stream, a, (int)(st), l, res, snap)
          if (p == 0) CHK(ST_MOD); if (p == 1) CHK(ST_H0);
#if DBG_GSUB == 2
          if (k == 3 && l == 0) hipLaunchKernelGGL(chk_gates_full, dim3(48, TALL / 4), dim3(256), 0, stream, (const bf16*)((char*)d_ws + WS_H), (const bf16*)((char*)d_ws + WS_WSMALL + OFFS_WG), (const bf16*)((char*)d_ws + WS_GATES), TALL, (unsigned*)((char*)d_ws + WS_CTL + 65536));
#endif
          if (k == 0) { CHK(ST_INPROJ); CHK(ST_YT); } if (k == 1) { CHK(ST_QKFIX); CHK(ST_CONV); CHK(ST_Z); } if (k == 2) CHK(ST_ATTN); if (k == 3) { CHK(ST_GATES); CHK(ST_GATESB); } if (k == 4) CHK(ST_MERGED);
          if (k == 5) CHK(ST_MIX); if (k == 6) CHK(ST_ROW1); if (k == 7) CHK(ST_LOGIT); if (k == 8) CHK(ST_TOPK); if (k == 9) CHK(ST_SLOTS); if (k == 10) CHK(ST_ACT); if (k == 11) CHK(ST_YSLOT); if (k == 12) CHK(ST_COMB);
#undef CHK
        }
#endif
    }
#ifdef DBG_CHECK
#if DBG_GSUB == 2
    hipLaunchKernelGGL(encode_full, dim3(1024), dim3(256), 0, stream, (float*)d_out, (const unsigned*)((char*)d_ws + WS_CTL + 65536), out_size);
#else
    hipLaunchKernelGGL(encode, dim3(1024), dim3(256), 0, stream, (float*)d_out, (const float*)((char*)d_ws + WS_CTL + 8192 * 4), out_size, 0.25f);
#endif
#endif
#else
    a.ph_lo = 0; a.ph_hi = NPH; hipLaunchKernelGGL(fwd, dim3(grid), dim3(NTHR), LDS_BYTES, stream, a);
#endif
    const hipError_t le = hipPeekAtLastError();
    if (le != hipSuccess) fprintf(stderr, "kernel_launch: launch failed: %s\n", hipGetErrorName(le));
}
```

```cpp
#include <hip/hip_runtime.h>
#include <cstdio>
#include <cstdint>
#ifndef MK_PER_PHASE
#define MK_PER_PHASE 0
#endif
namespace pg8 {
#define PG8_LAS __attribute__((address_space(3)))
typedef unsigned short bf16_t;
typedef short bf16x8 __attribute__((ext_vector_type(8)));
typedef float f32x4 __attribute__((ext_vector_type(4)));
typedef unsigned u32x4 __attribute__((ext_vector_type(4)));
typedef int i32x4v __attribute__((ext_vector_type(4)));
typedef int i32x8v __attribute__((ext_vector_type(8)));
typedef unsigned u32x2v __attribute__((ext_vector_type(2)));
constexpr int BM = 256, BK = 64, HALF = 128, HTB = HALF * BK * 2  , STAGE_BYTES = 8 * HTB, NXCD = 8, WGM = 8;

__host__ __device__ __forceinline__ int lds_byte(int r, int c) { const int st = (r >> 4) * 2 + (c >> 5), rr = r & 15, cc = c & 31, ob = rr * 64 + cc * 2; return st * 1024 + (ob ^ (((ob >> 9) & 1) << 5)); }
__host__ __device__ __forceinline__ void stage_rc(int b, int& R, int& C) { const int st = b / 1024, sb = b % 1024, swz = sb ^ (((sb >> 9) & 1) << 5); R = (st >> 1) * 16 + swz / 64; C = (st & 1) * 32 + (swz % 64) / 2; }
__host__ __device__ __forceinline__ int perm32(int rho) { const int n = rho >> 4, i = rho & 15; return 8 * (i >> 2) + 4 * n + (i & 3); }

struct Unit { int pm, pn, par; };
struct Gemm { const bf16_t* A; const bf16_t* Bt; int M, N, K; };

struct StaticOrder {
    int nM, nN, nwg, G, c;
    __host__ __device__ void init(int M, int N, int G_, int c_) { nM = M / BM; nN = N / BM; nwg = nM * nN; G = G_; c = c_; }
    __host__ __device__ bool next(int i, Unit& u) const {
        const long L = (long)i * G + c; if (L >= nwg) return false;
        int wgid = (int)L; { const int q = nwg / NXCD, r = nwg % NXCD, xcd = wgid % NXCD, off = wgid / NXCD; wgid = (xcd < r ? xcd * (q + 1) : r * (q + 1) + (xcd - r) * q) + off; }
        const int nig = WGM * nN, gid = wgid / nig, fm = gid * WGM, gsz = (nM - fm) < WGM ? (nM - fm) : WGM;
        u.pm = fm + ((wgid % nig) % gsz); u.pn = (wgid % nig) / gsz; return true;
    }
    __device__ __forceinline__ void a_ready(const Unit&) const {}
    __device__ __forceinline__ void done(const Unit&) const {}
};

typedef __bf16 bf16x2_native __attribute__((ext_vector_type(2)));
typedef float f32x2_native __attribute__((ext_vector_type(2)));
__device__ __forceinline__ unsigned cvt_pk_bf16(float lo, float hi) { const f32x2_native v = {lo, hi}; const bf16x2_native r = __builtin_convertvector(v, bf16x2_native); return __builtin_bit_cast(unsigned, r); }
__device__ __forceinline__ unsigned cvt4_fp8(float a, float b, float c, float d) { int w = __builtin_amdgcn_cvt_pk_fp8_f32(a, b, __builtin_bit_cast(int, a), false); w = __builtin_amdgcn_cvt_pk_fp8_f32(c, d, w, true); return (unsigned)w; }
typedef float f32x2 __attribute__((ext_vector_type(2)));
__device__ __forceinline__ f32x2 gelu_pk(f32x2 v) {
    const f32x2 av = __builtin_elementwise_abs(v), d = av * 0.2316418882f + 1.0f;
    f32x2 t; t.x = __builtin_amdgcn_rcpf(d.x); t.y = __builtin_amdgcn_rcpf(d.y);
    f32x2 q = t * 0.5307027145f + (-0.7265760135f); q = q * t + 0.7107068705f; q = q * t + (-0.142248368f); q = q * t + 0.127414796f; q = q * t;
    const f32x2 s = (v * v) * (-0.72134752044f);
    f32x2 e; e.x = __builtin_amdgcn_exp2f(s.x); e.y = __builtin_amdgcn_exp2f(s.y);
    const f32x2 m = v * (q * e), r = v - m;
    f32x2 o; o.x = v.x < 0.f ? m.x : r.x; o.y = v.y < 0.f ? m.y : r.y; return o;
}

template <int ACT  > struct EpiBf16 {
    static constexpr bool PERM = true, AFTER_DRAIN = false, BIAS_LDS = false; static_assert(ACT == 0 || ACT == 1, "EpiBf16: ACT is 0 (none) or 1 (gelu_pk)");
    bf16_t* O; int ldc; const float* bias; int split_cols; size_t split_stride; float scale0;
    __device__ __forceinline__ void operator()(const f32x4 (&acc)[2][2][4][2], const Unit& u, int wr, int wc, int fr, int fq) const {
        const int row0 = u.pm * BM + wr * 64 + fr; int colt = u.pn * BM; bf16_t* base = O;
        float sc = 1.f; if (split_cols) { const int t = colt / split_cols; base += (size_t)t * split_stride; colt -= t * split_cols; if (t == 0) sc = scale0; }
        const int col0 = colt + wc * 32 + 8 * fq, bcol0 = u.pn * BM + wc * 32 + 8 * fq;
        f32x4 bv[2][2];
#pragma unroll
        for (int bj = 0; bj < 2; ++bj)
#pragma unroll
            for (int n = 0; n < 2; ++n) bv[bj][n] = bias ? *(const f32x4*)(bias + bcol0 + bj * HALF + 4 * n) : (f32x4){0.f, 0.f, 0.f, 0.f};
#pragma unroll
        for (int ai = 0; ai < 2; ++ai)
#pragma unroll
            for (int m = 0; m < 4; ++m) { bf16_t* rowp = base + (size_t)(row0 + ai * HALF + m * 16) * ldc + col0;
#pragma unroll
                for (int bj = 0; bj < 2; ++bj) { f32x4 v0 = acc[ai][bj][m][0] + bv[bj][0], v1 = acc[ai][bj][m][1] + bv[bj][1];
                    if (ACT == 1) { f32x2 a = gelu_pk((f32x2){v0[0], v0[1]}), b = gelu_pk((f32x2){v0[2], v0[3]}), c = gelu_pk((f32x2){v1[0], v1[1]}), d = gelu_pk((f32x2){v1[2], v1[3]});
                        v0 = (f32x4){a.x, a.y, b.x, b.y}; v1 = (f32x4){c.x, c.y, d.x, d.y}; }
                    v0 = v0 * sc; v1 = v1 * sc; u32x4 w; w.x = cvt_pk_bf16(v0[0], v0[1]); w.y = cvt_pk_bf16(v0[2], v0[3]); w.z = cvt_pk_bf16(v1[0], v1[1]); w.w = cvt_pk_bf16(v1[2], v1[3]);
                    *(u32x4*)(rowp + bj * HALF) = w; } }
    }
};

__device__ __forceinline__ float fast_sigmoid(float x) { return __builtin_amdgcn_rcpf(1.0f + __builtin_amdgcn_exp2f(-1.4426950408889634f * x)); }
__device__ __forceinline__ u32x4 pack8(const f32x4& a, const f32x4& b) { u32x4 w; w.x = cvt_pk_bf16(a[0], a[1]); w.y = cvt_pk_bf16(a[2], a[3]); w.z = cvt_pk_bf16(b[0], b[1]); w.w = cvt_pk_bf16(b[2], b[3]); return w; }
__device__ __forceinline__ void unpack8(const u32x4& w, f32x4& a, f32x4& b) {
    a[0] = __uint_as_float(w.x << 16); a[1] = __uint_as_float(w.x & 0xffff0000u); a[2] = __uint_as_float(w.y << 16); a[3] = __uint_as_float(w.y & 0xffff0000u);
    b[0] = __uint_as_float(w.z << 16); b[1] = __uint_as_float(w.z & 0xffff0000u); b[2] = __uint_as_float(w.w << 16); b[3] = __uint_as_float(w.w & 0xffff0000u); }
__device__ __forceinline__ u32x2v pack8_fp8(const f32x4& a, const f32x4& b) { u32x2v r; r.x = cvt4_fp8(a[0], a[1], a[2], a[3]); r.y = cvt4_fp8(b[0], b[1], b[2], b[3]); return r; }
__device__ __forceinline__ void store_tile_bf16(const f32x4 (&acc)[2][2][4][2], bf16_t* base, int ldc, int wr, int wc, int fr, int fq) {
    const int rt = wr * 64 + fr, cb = wc * 32 + 8 * fq;
#pragma unroll
    for (int ai = 0; ai < 2; ++ai)
#pragma unroll
        for (int m = 0; m < 4; ++m) { bf16_t* rowp = base + (size_t)(rt + ai * HALF + m * 16) * ldc + cb;
#pragma unroll
            for (int bj = 0; bj < 2; ++bj) *(u32x4*)(rowp + bj * HALF) = pack8(acc[ai][bj][m][0], acc[ai][bj][m][1]); }
}
struct EpiInproj {
    static constexpr bool PERM = true, AFTER_DRAIN = false, BIAS_LDS = false;
    bf16_t *q, *k, *v, *cu;
    __device__ __forceinline__ void operator()(const f32x4 (&acc)[2][2][4][2], const Unit& u, int wr, int wc, int fr, int fq) const {
        bf16_t* base; int ldc; const bool glu = u.pn >= 6; float sc = 0.03125f; asm volatile("" : "+s"(sc));
        if (u.pn < 4) { base = q + (size_t)u.pm * 256 * 1024 + u.pn * 256; ldc = 1024; }
        else if (u.pn < 6) { const int m0 = u.pm * 256; const int kr = m0 < 32768 ? (m0 >> 11) * 2304 + (m0 & 2047) : ((m0 - 32768) >> 8) * 2304 + 2048; base = (u.pn == 4 ? k : v) + (size_t)kr * 256; ldc = 256; }
        else { base = cu + (size_t)u.pm * 256 * 512 + (u.pn - 6) * 128; ldc = 512; }
        base += (size_t)(wr * 64 + fr) * ldc + wc * 32 + 8 * fq;
#pragma unroll
        for (int ai = 0; ai < 2; ++ai)
#pragma unroll
            for (int m = 0; m < 4; ++m) { bf16_t* rowp = base + (size_t)(ai * HALF + m * 16) * ldc;
                if (!glu) { *(u32x4*)rowp = pack8(acc[ai][0][m][0] * sc, acc[ai][0][m][1] * sc); *(u32x4*)(rowp + HALF) = pack8(acc[ai][1][m][0] * sc, acc[ai][1][m][1] * sc); }
                else { f32x4 a0 = acc[ai][0][m][0] * sc, a1 = acc[ai][0][m][1] * sc; const f32x4 g0 = acc[ai][1][m][0] * sc, g1 = acc[ai][1][m][1] * sc;
#pragma unroll
                    for (int j = 0; j < 4; ++j) { a0[j] *= fast_sigmoid(g0[j]); a1[j] *= fast_sigmoid(g1[j]); }
                    *(u32x4*)rowp = pack8(a0, a1); } }
    }
};
struct EpiYT {
    static constexpr bool PERM = true, AFTER_DRAIN = false, BIAS_LDS = false;
    unsigned char *yt, *ytc;
    __device__ __forceinline__ void operator()(const f32x4 (&acc)[2][2][4][2], const Unit& u, int wr, int wc, int fr, int fq) const {
        const int cs = u.pm >> 1, chb = (u.pm & 1) * 256; unsigned char* base; int ldc;
        if (u.pn < 128) { const int b = u.pn >> 3, pos0 = (u.pn & 7) * 256; base = yt + (size_t)(b * 512 + chb) * 4096 + cs * 2048 + pos0; ldc = 4096; }
        else { const int b = u.pn - 128; base = ytc + (size_t)(b * 512 + chb) * 512 + cs * 256; ldc = 512; }
        base += (size_t)(wr * 64 + fr) * ldc + wc * 32 + 8 * fq;
#pragma unroll
        for (int ai = 0; ai < 2; ++ai)
#pragma unroll
            for (int m = 0; m < 4; ++m) { unsigned char* rowp = base + (size_t)(ai * HALF + m * 16) * ldc;
#pragma unroll
                for (int bj = 0; bj < 2; ++bj) *(u32x2v*)(rowp + bj * HALF) = pack8_fp8(acc[ai][bj][m][0], acc[ai][bj][m][1]); }
    }
};
struct EpiDFT {
    static constexpr bool PERM = true, AFTER_DRAIN = false, BIAS_LDS = false;
    bf16_t* z; int rowbase, rpb;
    __device__ __forceinline__ void operator()(const f32x4 (&acc)[2][2][4][2], const Unit& u, int wr, int wc, int fr, int fq) const {
        bf16_t* base = z + (size_t)(rowbase + (u.pn >> 1) * rpb + u.pm * 256 + wr * 64 + fr) * 512 + (u.pn & 1) * 256 + wc * 32 + 8 * fq;
#pragma unroll
        for (int ai = 0; ai < 2; ++ai)
#pragma unroll
            for (int m = 0; m < 4; ++m)
#pragma unroll
                for (int bj = 0; bj < 2; ++bj) *(u32x4*)(base + (size_t)(ai * HALF + m * 16) * 512 + bj * HALF) = pack8(acc[ai][bj][m][0] * 0.03125f, acc[ai][bj][m][1] * 0.03125f);
    }
};
struct EpiGates {
    static constexpr bool PERM = true, AFTER_DRAIN = false, BIAS_LDS = false;
    bf16_t* g;
    __device__ __forceinline__ void operator()(const f32x4 (&acc)[2][2][4][2], const Unit& u, int wr, int wc, int fr, int fq) const {
        int lt = (wr * 4 + wc) * 64 + fq * 16 + fr; asm volatile("" : "+v"(lt));
        bf16_t* tb = g + ((size_t)(u.pm * 12 + u.pn) * 16 * 512 + (size_t)lt) * 8;
        float cs = -1.4426950408889634f * 0.03125f; asm volatile("" : "+s"(cs));
#pragma unroll
        for (int ai = 0; ai < 2; ++ai)
#pragma unroll
            for (int m = 0; m < 4; ++m)
#pragma unroll
                for (int bj = 0; bj < 2; ++bj) { f32x4 a0 = acc[ai][bj][m][0], a1 = acc[ai][bj][m][1];
#pragma unroll
                    for (int j = 0; j < 4; ++j) { a0[j] = __builtin_amdgcn_rcpf(1.0f + __builtin_amdgcn_exp2f(a0[j] * cs)); a1[j] = __builtin_amdgcn_rcpf(1.0f + __builtin_amdgcn_exp2f(a1[j] * cs)); }
                    __builtin_nontemporal_store(pack8(a0, a1), (u32x4*)(tb + (size_t)(((ai * 4 + m) * 2 + bj) * 512) * 8)); }
    }
};
template <int MODE> struct EpiMerge {
    static constexpr bool PERM = true, AFTER_DRAIN = false, BIAS_LDS = false;
    bf16_t* mg; bf16_t* scr; const bf16_t* g; int br; float scale;
    __device__ __forceinline__ void operator()(const f32x4 (&acc)[2][2][4][2], const Unit& u, int wr, int wc, int fr, int fq) const {
        const int rt = u.pm * 256 + wr * 64 + fr, cb = u.pn * 256 + wc * 32 + 8 * fq; float sc = scale; asm volatile("" : "+s"(sc));
        int lt = (wr * 4 + wc) * 64 + fq * 16 + fr; asm volatile("" : "+v"(lt));
        const bf16_t* gt = g + ((size_t)(u.pm * 12 + br * 4 + u.pn) * 16 * 512 + (size_t)lt) * 8;
        bf16_t* st = scr + ((size_t)(u.pm * 4 + u.pn) * 16 * 512 + (size_t)lt) * 8;
#pragma unroll
        for (int ai = 0; ai < 2; ++ai)
#pragma unroll
            for (int m = 0; m < 4; ++m)
#pragma unroll
                for (int bj = 0; bj < 2; ++bj) { const size_t pk = (size_t)(((ai * 4 + m) * 2 + bj) * 512) * 8;
                    const u32x4 gw = *(const u32x4*)(gt + pk); f32x4 g0, g1; unpack8(gw, g0, g1);
                    f32x4 v0 = acc[ai][bj][m][0] * sc * g0, v1 = acc[ai][bj][m][1] * sc * g1;
                    if (MODE != 0) { const u32x4 ow = *(const u32x4*)(st + pk); f32x4 o0, o1; unpack8(ow, o0, o1); v0 += o0; v1 += o1; }
                    if (MODE != 2) *(u32x4*)(st + pk) = pack8(v0, v1);
                    else *(u32x4*)(mg + (size_t)(rt + ai * HALF + m * 16) * 1024 + cb + bj * HALF) = pack8(v0, v1); }
    }
};
struct EpiRouter {
    static constexpr bool PERM = true, AFTER_DRAIN = false, BIAS_LDS = false;
    float* lg;
    __device__ __forceinline__ void operator()(const f32x4 (&acc)[2][2][4][2], const Unit& u, int wr, int wc, int fr, int fq) const {
        if (wc < 2) { const int rt = u.pm * 256 + wr * 64 + fr, cb = wc * 32 + 8 * fq;
#pragma unroll
            for (int ai = 0; ai < 2; ++ai)
#pragma unroll
                for (int m = 0; m < 4; ++m) { float* p = lg + (size_t)(rt + ai * HALF + m * 16) * 64 + cb; *(f32x4*)p = acc[ai][0][m][0]; *(f32x4*)(p + 4) = acc[ai][0][m][1]; } }
    }
};
struct EpiSwiGLU {
    static constexpr bool PERM = true, AFTER_DRAIN = false, BIAS_LDS = false;
    bf16_t* act; const float* bg; const float* bu;
    __device__ __forceinline__ void operator()(const f32x4 (&acc)[2][2][4][2], const Unit& u, int wr, int wc, int fr, int fq) const {
        const int e = u.pn >> 3, col = (u.pn & 7) * 128 + wc * 32 + 8 * fq, rt = u.pm * 256 + wr * 64 + fr;
        const f32x4 bg0 = *(const f32x4*)(bg + e * 1024 + col), bg1 = *(const f32x4*)(bg + e * 1024 + col + 4), bu0 = *(const f32x4*)(bu + e * 1024 + col), bu1 = *(const f32x4*)(bu + e * 1024 + col + 4);
#pragma unroll
        for (int ai = 0; ai < 2; ++ai)
#pragma unroll
            for (int m = 0; m < 4; ++m) { f32x4 g0 = acc[ai][0][m][0] + bg0, g1 = acc[ai][0][m][1] + bg1, u0 = acc[ai][1][m][0] + bu0, u1 = acc[ai][1][m][1] + bu1;
#pragma unroll
                for (int j = 0; j < 4; ++j) { const float ga = fminf(g0[j], 7.0f), gb = fminf(g1[j], 7.0f); const float ua = fminf(fmaxf(u0[j], -7.0f), 7.0f), ub = fminf(fmaxf(u1[j], -7.0f), 7.0f);
                    g0[j] = (ua + 1.0f) * (ga * fast_sigmoid(1.702f * ga)); g1[j] = (ub + 1.0f) * (gb * fast_sigmoid(1.702f * gb)); }
                *(u32x4*)(act + (size_t)(rt + ai * HALF + m * 16) * 1024 + col) = pack8(g0, g1); }
    }
};
struct EpiSwiGLU8 {
    static constexpr bool PERM = true, AFTER_DRAIN = false, BIAS_LDS = true;
    unsigned char* act; const float* bg; const float* bu; PG8_LAS float* bl;
    __device__ __forceinline__ void stage_bias(const Unit& u, int wid, int lane) const {
        if (wid < 4) { const int e = u.pn >> 3, c0 = (u.pn & 7) * 128 + (wid & 1) * 64 + lane; const float* src = (wid < 2 ? bg : bu) + e * 1024 + c0;
            __builtin_amdgcn_global_load_lds((const unsigned*)src, (PG8_LAS unsigned*)(bl + u.par * 256 + wid * 64), 4, 0, 0); }
    }
    __device__ __forceinline__ void operator()(const f32x4 (&acc)[2][2][4][2], const Unit& u, int wr, int wc, int fr, int fq) const {
        const int col = (u.pn & 7) * 128 + wc * 32 + 8 * fq, rt = u.pm * 256 + wr * 64 + fr; const PG8_LAS float* bp = bl + u.par * 256 + wc * 32 + 8 * fq;
        const f32x4 bg0 = *(const PG8_LAS f32x4*)bp, bg1 = *(const PG8_LAS f32x4*)(bp + 4), bu0 = *(const PG8_LAS f32x4*)(bp + 128), bu1 = *(const PG8_LAS f32x4*)(bp + 132);
#pragma unroll
        for (int ai = 0; ai < 2; ++ai)
#pragma unroll
            for (int m = 0; m < 4; ++m) { f32x4 g0 = acc[ai][0][m][0] * 0.03125f + bg0, g1 = acc[ai][0][m][1] * 0.03125f + bg1, u0 = acc[ai][1][m][0] * 0.03125f + bu0, u1 = acc[ai][1][m][1] * 0.03125f + bu1;
#pragma unroll
                for (int j = 0; j < 4; ++j) { const float ga = fminf(g0[j], 7.0f), gb = fminf(g1[j], 7.0f); const float ua = fminf(fmaxf(u0[j], -7.0f), 7.0f), ub = fminf(fmaxf(u1[j], -7.0f), 7.0f);
                    g0[j] = (ua + 1.0f) * (ga * fast_sigmoid(1.702f * ga)); g1[j] = (ub + 1.0f) * (gb * fast_sigmoid(1.702f * gb)); }
                __builtin_nontemporal_store(pack8_fp8(g0, g1), (u32x2v*)(act + (size_t)(rt + ai * HALF + m * 16) * 1024 + col)); }
    }
};
struct EpiDown8 {
    static constexpr bool PERM = true, AFTER_DRAIN = false, BIAS_LDS = true;
    unsigned char* ys; const float* bd; int nostore; PG8_LAS float* bl;
    __device__ __forceinline__ void stage_bias(const Unit& u, int wid, int lane) const {
        if (wid < 4) { const float* src = bd + (u.pn >> 2) * 1024 + (u.pn & 3) * 256 + wid * 64 + lane; __builtin_amdgcn_global_load_lds((const unsigned*)src, (PG8_LAS unsigned*)(bl + u.par * 256 + wid * 64), 4, 0, 0); }
    }
    __device__ __forceinline__ void operator()(const f32x4 (&acc)[2][2][4][2], const Unit& u, int wr, int wc, int fr, int fq) const {
        const int col0 = (u.pn & 3) * 256 + wc * 32 + 8 * fq, rt = u.pm * 256 + wr * 64 + fr; const PG8_LAS float* bp = bl + u.par * 256 + wc * 32 + 8 * fq;
        f32x4 bv[2][2];
#pragma unroll
        for (int bj = 0; bj < 2; ++bj) { bv[bj][0] = *(const PG8_LAS f32x4*)(bp + bj * HALF) * 8.0f; bv[bj][1] = *(const PG8_LAS f32x4*)(bp + bj * HALF + 4) * 8.0f; }
#pragma unroll
        for (int ai = 0; ai < 2; ++ai)
#pragma unroll
            for (int m = 0; m < 4; ++m) { unsigned char* rowp = ys + (size_t)(rt + ai * HALF + m * 16) * 1024 + col0;
#pragma unroll
                for (int bj = 0; bj < 2; ++bj) { const u32x2v w = pack8_fp8(acc[ai][bj][m][0] * 0.25f + bv[bj][0], acc[ai][bj][m][1] * 0.25f + bv[bj][1]); if (!nostore) __builtin_nontemporal_store(w, (u32x2v*)(rowp + bj * HALF)); else asm volatile("" :: "v"(w)); } }
    }
};
struct GroupedOrder {
    int nM, nN, nwg, G, c; const PG8_LAS int* tile_e; const int* rows;
    __device__ void init(int nM_, int nN_, int G_, int c_, const PG8_LAS int* te) { nM = nM_; nN = nN_; nwg = nM * nN; G = G_; c = c_; tile_e = te; rows = nullptr; }
    __device__ bool next(int i, Unit& u) const {
        const long L = (long)i * G + c; if (L >= nwg) return false;
        int wgid = (int)L; { const int q = nwg / NXCD, r = nwg % NXCD, xcd = wgid % NXCD, off = wgid / NXCD; wgid = (xcd < r ? xcd * (q + 1) : r * (q + 1) + (xcd - r) * q) + off; }
        const int nig = WGM * nN, gid = wgid / nig, fm = gid * WGM, gsz = (nM - fm) < WGM ? (nM - fm) : WGM;
        u.pm = fm + ((wgid % nig) % gsz); const int pl = (wgid % nig) / gsz; u.pn = __builtin_amdgcn_readfirstlane(tile_e[u.pm]) * nN + pl; return true;
    }
    __device__ __forceinline__ void a_ready(const Unit&) const {}
    __device__ __forceinline__ void done(const Unit&) const {}
};
struct DftOrder {
    int lg, n, G, c;
    __device__ void init(int lg_, int nb, int G_, int c_) { lg = lg_; n = (nb * 2) << lg_; G = G_; c = c_; }
    __device__ bool next(int i, Unit& u) const { const int L = i * G + c; if (L >= n) return false; const int b = L >> (lg + 1), rem = L & ((2 << lg) - 1); u.pm = rem & ((1 << lg) - 1); u.pn = 2 * b + (rem >> lg); return true; }
    __device__ __forceinline__ void a_ready(const Unit&) const {}
    __device__ __forceinline__ void done(const Unit&) const {}
};

template <class Epi, class Sched, bool ALIGN_EPI = false, bool SP2 = false, bool FP8 = false, bool GATHER = false>
__device__ __forceinline__ void gemm_phase(PG8_LAS unsigned char* lds, const Gemm g, const Sched& S, const Epi& E, const int tid_in) {
    int tid_ = tid_in; asm volatile("" : "+v"(tid_));
    const int tid = tid_, wid = __builtin_amdgcn_readfirstlane(tid >> 6), lane = tid & 63, wr = wid >> 2, wc = wid & 3, fr = lane & 15, fq = lane >> 4;
    const int K = g.K, nt = K / BK;
    unsigned voffA[2], voffB[2]; int RA[2]; unsigned CA2[2];
#pragma unroll
    for (int i = 0; i < 2; ++i) { int R, C; stage_rc(tid * 16 + i * 8192, R, C); const int Rb = Epi::PERM ? ((R & ~31) + perm32(R & 31)) : R;
        voffA[i] = (unsigned)(R * K + C) * 2u; voffB[i] = (unsigned)(Rb * K + C) * 2u; RA[i] = (R << 8) | (C * 2); CA2[i] = 0u; }
    static_assert(!GATHER || SP2, "GATHER is implemented for the SP2 loop only");
    unsigned pC[2], pN[2];
#define PG8_LDIDX(dst, unit) do { if constexpr (GATHER) { _Pragma("unroll") for (int h_ = 0; h_ < 2; ++h_) dst[h_] = (unsigned)S.rows[(unit).pm * 256 + h_ * 128 + (RA[0] >> 8)] | ((unsigned)S.rows[(unit).pm * 256 + h_ * 128 + (RA[1] >> 8)] << 16); } } while (0)
#define PG8_GOFF(dst, pk) do { dst[0] = ((pk) & 0xffffu) * (unsigned)(K * 2) + (unsigned)(RA[0] & 255); dst[1] = ((pk) >> 16) * (unsigned)(K * 2) + (unsigned)(RA[1] & 255); } while (0)
    const size_t kstep = (size_t)(BK * 2);
    const size_t hstep = (size_t)HALF * K * 2;
    const size_t tstep = 2 * hstep;
    const unsigned ldsw = (unsigned)wid * 1024u;
    const int aoff = lds_byte(wr * 64 + fr, fq * 8), boff = lds_byte(wc * 32 + fr, fq * 8);
#define PG8_SA(b, h) (((b) * 2 + (h)) * HTB)
#define PG8_SB(b, h) ((4 + (b) * 2 + (h)) * HTB)
#define PG8_STAGE(bufoff, gbase, voff) do { _Pragma("unroll") for (int _i = 0; _i < 2; ++_i) \
        __builtin_amdgcn_global_load_lds((const unsigned*)((const char*)(gbase) + (voff)[_i]), (PG8_LAS unsigned*)(lds + (bufoff) + ldsw + _i * 8192), 16, 0, 0); } while (0)
#define PG8_RD8(off) __builtin_shufflevector(*(const PG8_LAS i32x4v*)(lds + (off)), *(const PG8_LAS i32x4v*)(lds + (off) + 1024), 0, 1, 2, 3, 4, 5, 6, 7)
#define PG8_LDA(dst, b, h) do { _Pragma("unroll") for (int m = 0; m < 4; ++m) { if constexpr (FP8) dst##8[m] = PG8_RD8(PG8_SA(b, h) + aoff + m * 2048); else { _Pragma("unroll") for (int k = 0; k < 2; ++k) dst[m][k] = *(const PG8_LAS bf16x8*)(lds + PG8_SA(b, h) + aoff + m * 2048 + k * 1024); } } } while (0)
#define PG8_LDB(dst, b, h) do { _Pragma("unroll") for (int n = 0; n < 2; ++n) { if constexpr (FP8) dst##8[n] = PG8_RD8(PG8_SB(b, h) + boff + n * 2048); else { _Pragma("unroll") for (int k = 0; k < 2; ++k) dst[n][k] = *(const PG8_LAS bf16x8*)(lds + PG8_SB(b, h) + boff + n * 2048 + k * 1024); } } } while (0)
#define PG8_MMA(ai, bj, At, Bt) do { if constexpr (FP8) __builtin_amdgcn_sched_barrier(0); __builtin_amdgcn_s_setprio(1); _Pragma("unroll") for (int m = 0; m < 4; ++m) _Pragma("unroll") for (int n = 0; n < 2; ++n) { \
        if constexpr (FP8) asm volatile("v_mfma_scale_f32_16x16x128_f8f6f4 %0, %1, %2, %0, %3, %3 op_sel_hi:[0,0,0]" : "+v"(acc[ai][bj][m][n]) : "v"(Bt##8[n]), "v"(At##8[m]), "v"(sc8)); \
        else { _Pragma("unroll") for (int k = 0; k < 2; ++k) acc[ai][bj][m][n] = __builtin_amdgcn_mfma_f32_16x16x32_bf16(Bt[n][k], At[m][k], acc[ai][bj][m][n], 0, 0, 0); } } __builtin_amdgcn_s_setprio(0); if constexpr (FP8) __builtin_amdgcn_sched_barrier(0); } while (0)
#define PG8_WAIT_V(n) asm volatile("s_waitcnt vmcnt(" #n ")" ::: "memory")
#define PG8_WAIT_L(n) asm volatile("s_waitcnt lgkmcnt(" #n ")" ::: "memory")
#define PG8_BAR __builtin_amdgcn_s_barrier()
#define PG8_SCHED __builtin_amdgcn_sched_barrier(0)
    Unit cur, nxt; int ui = 0;
    if (!S.next(0, cur)) return;
    f32x4 acc[2][2][4][2];
#pragma unroll
    for (int a = 0; a < 2; ++a)
#pragma unroll
        for (int b = 0; b < 2; ++b)
#pragma unroll
            for (int m = 0; m < 4; ++m)
#pragma unroll
                for (int n = 0; n < 2; ++n) acc[a][b][m][n] = (f32x4){0.f, 0.f, 0.f, 0.f};
    int sc8 = 0x7f7f7f7f; asm volatile("" : "+v"(sc8));
    bf16x8 At[4][2], B0[2][2], B1[2][2]; i32x8v At8[4], B08[2], B18[2];
    const char* cA = (const char*)g.A + (size_t)cur.pm * tstep; const char* cB = (const char*)g.Bt + (size_t)cur.pn * tstep; const char* const gA = (const char*)g.A;
    S.a_ready(cur);
    if constexpr (SP2) {
        unsigned g0_[2], g1_[2]; if constexpr (GATHER) { PG8_LDIDX(pC, cur); PG8_GOFF(g0_, pC[0]); PG8_GOFF(g1_, pC[1]); }
        PG8_STAGE(PG8_SB(0, 0), cB, voffB); PG8_STAGE(PG8_SB(0, 1), cB + hstep, voffB);
        if constexpr (GATHER) { PG8_STAGE(PG8_SA(0, 0), gA, g0_); PG8_STAGE(PG8_SA(0, 1), gA, g1_); } else { PG8_STAGE(PG8_SA(0, 0), cA, voffA); PG8_STAGE(PG8_SA(0, 1), cA + hstep, voffA); }
        if (wr == 1) PG8_BAR;
        PG8_WAIT_V(2); PG8_BAR;
        PG8_STAGE(PG8_SB(1, 0), cB + kstep, voffB); if constexpr (GATHER) PG8_STAGE(PG8_SA(1, 0), gA + kstep, g0_); else PG8_STAGE(PG8_SA(1, 0), cA + kstep, voffA); PG8_STAGE(PG8_SB(1, 1), cB + hstep + kstep, voffB);
        PG8_WAIT_V(6); PG8_BAR;
    } else {
        PG8_STAGE(PG8_SB(0, 0), cB, voffB); PG8_STAGE(PG8_SA(0, 0), cA, voffA); PG8_STAGE(PG8_SB(0, 1), cB + hstep, voffB); PG8_STAGE(PG8_SA(0, 1), cA + hstep, voffA);
        if (wr == 1) PG8_BAR;
        PG8_WAIT_V(4); PG8_BAR;
        PG8_STAGE(PG8_SB(1, 0), cB + kstep, voffB); PG8_STAGE(PG8_SA(1, 0), cA + kstep, voffA); PG8_STAGE(PG8_SB(1, 1), cB + hstep + kstep, voffB);
        PG8_WAIT_V(6); PG8_BAR;
    }
    for (;;) {
        cur.par = ui & 1; if constexpr (Epi::BIAS_LDS) E.stage_bias(cur, wid, lane);
        const bool has_next = S.next(ui + 1, nxt);
        if constexpr (GATHER) { if (has_next) PG8_LDIDX(pN, nxt); }
        const char* nA = has_next ? (const char*)g.A + (size_t)nxt.pm * tstep : cA; const char* nB = has_next ? (const char*)g.Bt + (size_t)nxt.pn * tstep : cB;
        for (int t = 0; t < nt; t += 2) {
            const bool last = (t == nt - 2);
            const char* a1 = cA + (size_t)(t + 1) * kstep;
            const char* a2 = last ? nA : cA + (size_t)(t + 2) * kstep; const char* b2 = last ? nB : cB + (size_t)(t + 2) * kstep;
            const char* a3 = a2 + kstep; const char* b3 = b2 + kstep;
            if (last && has_next) S.a_ready(nxt);
            unsigned v2[2][2]; const char* gA2 = gA;
            unsigned vc1[2];
            if constexpr (GATHER) { const bool sw = last && has_next; PG8_GOFF(v2[0], sw ? pN[0] : pC[0]); PG8_GOFF(v2[1], sw ? pN[1] : pC[1]); PG8_GOFF(vc1, pC[1]);
                gA2 = last ? gA : gA + (size_t)(t + 2) * kstep; }
            if constexpr (SP2) {
            PG8_LDB(B0, 0, 0); PG8_LDB(B1, 0, 1); PG8_SCHED; PG8_LDA(At, 0, 0); if constexpr (GATHER) PG8_STAGE(PG8_SA(1, 1), gA + (size_t)(t + 1) * kstep, vc1); else PG8_STAGE(PG8_SA(1, 1), a1 + hstep, voffA);
            PG8_WAIT_V(8); PG8_WAIT_L(0); PG8_BAR; PG8_MMA(0, 0, At, B0); PG8_MMA(0, 1, At, B1); PG8_BAR; PG8_SCHED;
            PG8_LDA(At, 0, 1); PG8_STAGE(PG8_SB(0, 0), b2, voffB); PG8_STAGE(PG8_SB(0, 1), b2 + hstep, voffB); if constexpr (GATHER) PG8_STAGE(PG8_SA(0, 0), gA2, v2[0]); else PG8_STAGE(PG8_SA(0, 0), a2, voffA);
            PG8_WAIT_V(8); PG8_WAIT_L(0); PG8_BAR; PG8_MMA(1, 0, At, B0); PG8_MMA(1, 1, At, B1); PG8_BAR; PG8_SCHED;
            PG8_LDB(B0, 1, 0); PG8_LDB(B1, 1, 1); PG8_SCHED; PG8_LDA(At, 1, 0); if constexpr (GATHER) PG8_STAGE(PG8_SA(0, 1), gA2, v2[1]); else PG8_STAGE(PG8_SA(0, 1), a2 + hstep, voffA);
            PG8_WAIT_V(8); PG8_WAIT_L(0); PG8_BAR; PG8_MMA(0, 0, At, B0); PG8_MMA(0, 1, At, B1); PG8_BAR; PG8_SCHED;
            PG8_LDA(At, 1, 1); PG8_STAGE(PG8_SB(1, 0), b3, voffB); PG8_STAGE(PG8_SB(1, 1), b3 + hstep, voffB); if constexpr (GATHER) PG8_STAGE(PG8_SA(1, 0), gA2 + kstep, v2[0]); else PG8_STAGE(PG8_SA(1, 0), a3, voffA);
            PG8_WAIT_V(8); PG8_WAIT_L(0); PG8_BAR; PG8_MMA(1, 0, At, B0); PG8_MMA(1, 1, At, B1); PG8_BAR; PG8_SCHED;
            } else {
            PG8_LDB(B0, 0, 0); PG8_SCHED; PG8_LDA(At, 0, 0); PG8_STAGE(PG8_SA(1, 1), a1 + hstep, voffA);
            PG8_WAIT_L(8); PG8_BAR; PG8_WAIT_L(0); PG8_MMA(0, 0, At, B0); PG8_BAR; PG8_SCHED;
            PG8_LDB(B1, 0, 1); PG8_STAGE(PG8_SB(0, 0), b2, voffB);
            PG8_BAR; PG8_WAIT_L(0); PG8_MMA(0, 1, At, B1); PG8_BAR;
            PG8_LDA(At, 0, 1); PG8_STAGE(PG8_SA(0, 0), a2, voffA);
            PG8_BAR; PG8_WAIT_L(0); PG8_MMA(1, 0, At, B0); PG8_BAR; PG8_SCHED;
            PG8_STAGE(PG8_SB(0, 1), b2 + hstep, voffB);
            PG8_WAIT_V(6); PG8_BAR; PG8_MMA(1, 1, At, B1); PG8_BAR;
            PG8_LDB(B0, 1, 0); PG8_SCHED; PG8_LDA(At, 1, 0); PG8_STAGE(PG8_SA(0, 1), a2 + hstep, voffA);
            PG8_WAIT_L(8); PG8_BAR; PG8_WAIT_L(0); PG8_MMA(0, 0, At, B0); PG8_BAR; PG8_SCHED;
            PG8_LDB(B1, 1, 1); PG8_STAGE(PG8_SB(1, 0), b3, voffB);
            PG8_BAR; PG8_WAIT_L(0); PG8_MMA(0, 1, At, B1); PG8_BAR;
            PG8_LDA(At, 1, 1); PG8_STAGE(PG8_SA(1, 0), a3, voffA);
            PG8_BAR; PG8_WAIT_L(0); PG8_MMA(1, 0, At, B0); PG8_BAR; PG8_SCHED;
            PG8_STAGE(PG8_SB(1, 1), b3 + hstep, voffB);
            PG8_WAIT_V(6); PG8_BAR; PG8_MMA(1, 1, At, B1); PG8_BAR;
            }
        }
        if constexpr (FP8) asm volatile("s_nop 15\n\ts_nop 15" ::: "memory");
        if constexpr (ALIGN_EPI) { if (wr == 0) PG8_BAR; }
        if constexpr (!Epi::AFTER_DRAIN) { E(acc, cur, wr, wc, fr, fq); S.done(cur); }
        if (!has_next) break;
#pragma unroll
        for (int a = 0; a < 2; ++a)
#pragma unroll
            for (int b = 0; b < 2; ++b)
#pragma unroll
                for (int m = 0; m < 4; ++m)
#pragma unroll
                    for (int n = 0; n < 2; ++n) acc[a][b][m][n] = (f32x4){0.f, 0.f, 0.f, 0.f};
        cur = nxt; cA = nA; cB = nB; ++ui;
        if constexpr (GATHER) { pC[0] = pN[0]; pC[1] = pN[1]; }
        if constexpr (ALIGN_EPI) { if (wr == 1) PG8_BAR; }
    }
    PG8_WAIT_V(0);
    if constexpr (!ALIGN_EPI) { if (wr == 0) PG8_BAR; }
    PG8_BAR;
    if constexpr (Epi::AFTER_DRAIN) { E.fused(acc, cur, wr, wc, fr, fq, lds, wid, lane); S.done(cur); }
#undef PG8_SA
#undef PG8_LDIDX
#undef PG8_GOFF
#undef PG8_SB
#undef PG8_STAGE
#undef PG8_LDA
#undef PG8_LDB
#undef PG8_MMA
#undef PG8_RD8
#undef PG8_WAIT_V
#undef PG8_WAIT_L
#undef PG8_BAR
#undef PG8_SCHED
}
}
namespace att {
typedef unsigned short bf16;
constexpr int   D = 128, NW = 8, QBLK = 32, KVBLK = 64;
constexpr float SCALE = 0.088388347648318440f;
constexpr float THR = 8.f;
constexpr int SDEPTH = 2;
constexpr int LDQ = 1024, LDK = 256, LDO = 1024;
constexpr size_t SHM_V = KVBLK * D * 2, SHM_K = KVBLK * D * 2, SHM_ATTN = 2 * SHM_V + 2 * SHM_K + NW * 64 * 4;
using bf16x8 = __attribute__((ext_vector_type(8))) short;
using s16x4  = __attribute__((ext_vector_type(4))) short;
using f32x16 = __attribute__((ext_vector_type(16))) float;
using f32x8  = __attribute__((ext_vector_type(8))) float;
using u32x4  = __attribute__((ext_vector_type(4))) unsigned;
#define KSWZ(row, colB) ((row) * 256 + ((colB) ^ (((row) & 7) << 4)))
#define SBAR() __builtin_amdgcn_sched_barrier(0)
__device__ __forceinline__ int crow(int r, int hi) { return (r & 3) + 8 * (r >> 2) + 4 * hi; }
__device__ __forceinline__ unsigned cvtpk(float lo, float hi) { return pg8::cvt_pk_bf16(lo, hi); }
template <typename TIn> struct Stage;
template <> struct Stage<bf16>  { using T = bf16x8;
  __device__ static __forceinline__ T ld8(const bf16* p) { return *reinterpret_cast<const bf16x8*>(p); }
  __device__ static __forceinline__ bf16x8 tobf(T x) { return x; } };
template <> struct Stage<float> { using T = f32x8;
  __device__ static __forceinline__ T ld8(const float* p) { return *reinterpret_cast<const f32x8*>(p); }
  __device__ static __forceinline__ bf16x8 tobf(T x) {
    u32x4 w = {cvtpk(x[0], x[1]), cvtpk(x[2], x[3]), cvtpk(x[4], x[5]), cvtpk(x[6], x[7])}; return *reinterpret_cast<bf16x8*>(&w); } };

__device__ __forceinline__ void partialSM(f32x16& p0, f32x16& p1, float& m_reg, float& mn, float& alpha) {
  constexpr float C = SCALE * 1.4426950408889634f;
  float pmax = p0[0]; for (int r = 1; r < 16; ++r) pmax = fmaxf(pmax, p0[r]); for (int r = 0; r < 16; ++r) pmax = fmaxf(pmax, p1[r]);
  { auto rr = __builtin_amdgcn_permlane32_swap(__float_as_uint(pmax), __float_as_uint(pmax), false, false);
    pmax = fmaxf(__uint_as_float(rr[0]), __uint_as_float(rr[1])); }
  if (__builtin_expect(__all(pmax - m_reg <= THR / SCALE), 1)) { mn = m_reg; alpha = 1.f; }
  else { mn = fmaxf(m_reg, pmax); alpha = __builtin_amdgcn_exp2f((m_reg - mn) * C); m_reg = mn; }
  float mnC = -mn * C;
  for (int r = 0; r < 16; ++r) p0[r] = fmaf(p0[r], C, mnC); for (int r = 0; r < 16; ++r) p1[r] = fmaf(p1[r], C, mnC);
  for (int r = 0; r < 16; ++r) p0[r] = __builtin_amdgcn_exp2f(p0[r]);
}
__device__ __forceinline__ void finishSM(f32x16& p0, f32x16& p1, float alpha, float& l_reg, bf16x8& pa0, bf16x8& pa1, bf16x8& pa2, bf16x8& pa3) {
  for (int r = 0; r < 16; ++r) p1[r] = __builtin_amdgcn_exp2f(p1[r]);
  float ps = 0; for (int r = 0; r < 16; ++r) ps += p0[r]; for (int r = 0; r < 16; ++r) ps += p1[r];
  { auto rr = __builtin_amdgcn_permlane32_swap(__float_as_uint(ps), __float_as_uint(ps), false, false);
    ps = __uint_as_float(rr[0]) + __uint_as_float(rr[1]); }
  l_reg = l_reg * alpha + ps;
#define PK4(P, BASE, OUT) do { unsigned a0 = cvtpk(P[BASE + 0], P[BASE + 1]), a1 = cvtpk(P[BASE + 2], P[BASE + 3]);   \
    unsigned b0 = cvtpk(P[BASE + 4], P[BASE + 5]), b1 = cvtpk(P[BASE + 6], P[BASE + 7]);                              \
    auto r0 = __builtin_amdgcn_permlane32_swap(a0, b0, false, false); auto r1 = __builtin_amdgcn_permlane32_swap(a1, b1, false, false); \
    u32x4 w = {r0[0], r1[0], r0[1], r1[1]}; OUT = *reinterpret_cast<bf16x8*>(&w); } while (0)
  PK4(p0, 0, pa0); PK4(p0, 8, pa1); PK4(p1, 0, pa2); PK4(p1, 8, pa3);
#undef PK4
}
__device__ __forceinline__ void qkt(f32x16& p0, f32x16& p1, const bf16* Ks, const bf16x8* qr, int r32, int hi) {
  p0 = f32x16{}; p1 = f32x16{};
  for (int d0 = 0; d0 < 8; ++d0) { int cb = (d0 * 16 + hi * 8) * 2;
    bf16x8 b0 = *reinterpret_cast<const bf16x8*>((const char*)Ks + KSWZ(r32, cb));
    bf16x8 b1 = *reinterpret_cast<const bf16x8*>((const char*)Ks + KSWZ(32 + r32, cb));
    p0 = __builtin_amdgcn_mfma_f32_32x32x16_bf16(b0, qr[d0], p0, 0, 0, 0);
    p1 = __builtin_amdgcn_mfma_f32_32x32x16_bf16(b1, qr[d0], p1, 0, 0, 0); }
}
__device__ __forceinline__ int v_st(int k, int c) { const int kk = (k & ~0xC) | ((k & 4) << 1) | ((k & 8) >> 1); return ((kk >> 3) * 4 + (c >> 5)) * 512 + ((kk & 7) * 32 + (c & 31)) * 2; }
__device__ __forceinline__ int v_rd_base(int lane) { return ((lane & 3) << 3) | (((lane >> 2) & 3) << 6) | (((lane >> 4) & 1) << 5) | (((lane >> 5) & 1) << 8); }
constexpr int v_rd_off(int d0, int ks, int half) { return d0 * 512 + ks * 4096 + half * 2048; }
template <int OFF> __device__ __forceinline__ s16x4 tr_read(int vb) {
  s16x4 r; asm volatile("ds_read_b64_tr_b16 %0, %1 offset:%2" : "=&v"(r) : "v"(vb), "i"(OFF) : "memory"); return r;
}
template <int D0> __device__ __forceinline__ void pv_one(f32x16& od, int vb, bf16x8 pa0, bf16x8 pa1, bf16x8 pa2, bf16x8 pa3) {
  const s16x4 l0 = tr_read<v_rd_off(D0, 0, 0)>(vb), h0 = tr_read<v_rd_off(D0, 0, 1)>(vb), l1 = tr_read<v_rd_off(D0, 1, 0)>(vb), h1 = tr_read<v_rd_off(D0, 1, 1)>(vb);
  const s16x4 l2 = tr_read<v_rd_off(D0, 2, 0)>(vb), h2 = tr_read<v_rd_off(D0, 2, 1)>(vb), l3 = tr_read<v_rd_off(D0, 3, 0)>(vb), h3 = tr_read<v_rd_off(D0, 3, 1)>(vb);
  asm volatile("s_waitcnt lgkmcnt(0)" ::: "memory"); SBAR();
#define PK(L, H) (bf16x8){L[0], L[1], L[2], L[3], H[0], H[1], H[2], H[3]}
  od = __builtin_amdgcn_mfma_f32_32x32x16_bf16(pa0, PK(l0, h0), od, 0, 0, 0);
  od = __builtin_amdgcn_mfma_f32_32x32x16_bf16(pa1, PK(l1, h1), od, 0, 0, 0);
  od = __builtin_amdgcn_mfma_f32_32x32x16_bf16(pa2, PK(l2, h2), od, 0, 0, 0);
  od = __builtin_amdgcn_mfma_f32_32x32x16_bf16(pa3, PK(l3, h3), od, 0, 0, 0);
#undef PK
}
__device__ __forceinline__ void pv_d0(f32x16* o, int vb, bf16x8 pa0, bf16x8 pa1, bf16x8 pa2, bf16x8 pa3) {
  pv_one<0>(o[0], vb, pa0, pa1, pa2, pa3); pv_one<1>(o[1], vb, pa0, pa1, pa2, pa3); pv_one<2>(o[2], vb, pa0, pa1, pa2, pa3); pv_one<3>(o[3], vb, pa0, pa1, pa2, pa3);
}

template <typename TQ>
__device__ __forceinline__ void attn_dense_body(const TQ* __restrict__ Qb, const bf16* __restrict__ Kh, const bf16* __restrict__ Vh,
                                                unsigned char* __restrict__ Ob, int seq, char* lds, const int tid_in, const float* __restrict__ qgain, const float* __restrict__ rtab, const int t0, const bool rope) {
  using St = Stage<bf16>; using SQ = Stage<TQ>;
  int tid_ = tid_in; asm volatile("" : "+v"(tid_));
  const int tid = tid_, wid = tid >> 6, lane = tid & 63, r32 = lane & 31, hi = lane >> 5;
  bf16* V_lds = (bf16*)lds; bf16* K_lds = (bf16*)(lds + 2 * SHM_V);
  float* ws = (float*)(lds + 2 * SHM_V + 2 * SHM_K) + wid * 64; float* li_l = ws; float* al_l = ws + 32;
  float m_reg = -1e30f, l_reg = 0; f32x16 o[4] = {}; bf16x8 qr[8];
  const TQ* Qw = Qb + (long)(wid * QBLK + r32) * LDQ + hi * 8;
  { float xf[8][8]; float ss = 0.f;
#pragma unroll
    for (int d0 = 0; d0 < 8; ++d0) { const bf16x8 raw = SQ::tobf(SQ::ld8(Qw + d0 * 16));
#pragma unroll
      for (int j = 0; j < 8; ++j) { xf[d0][j] = __uint_as_float(((unsigned)(unsigned short)raw[j]) << 16); ss += xf[d0][j] * xf[d0][j]; } }
    { auto rr = __builtin_amdgcn_permlane32_swap(__float_as_uint(ss), __float_as_uint(ss), false, false); ss = __uint_as_float(rr[0]) + __uint_as_float(rr[1]); }
    const float rn = 1.0f / sqrtf(ss * (1.0f / 128.0f) + 1e-6f);
#pragma unroll
    for (int d0 = 0; d0 < 8; ++d0) {
#pragma unroll
      for (int j = 0; j < 8; ++j) xf[d0][j] *= rn * qgain[d0 * 16 + hi * 8 + j]; }
    if (rope) { const int t = t0 + wid * QBLK + r32, pr = t >> 6, pc = t & 63;
#pragma unroll
      for (int hb = 0; hb < 2; ++hb) { const int p = hb ? pc : pr;
#pragma unroll
        for (int dd = 0; dd < 2; ++dd) { const int d0 = 4 * hb + dd;
#pragma unroll
          for (int j = 0; j < 8; ++j) { const int f = dd * 16 + hi * 8 + j; const float c = rtab[(p * 32 + f) * 2], s = rtab[(p * 32 + f) * 2 + 1];
            const float x0 = xf[d0][j], x1 = xf[d0 + 2][j]; xf[d0][j] = x0 * c - x1 * s; xf[d0 + 2][j] = x1 * c + x0 * s; } } } }
#pragma unroll
    for (int d0 = 0; d0 < 8; ++d0) { u32x4 w = {cvtpk(xf[d0][0], xf[d0][1]), cvtpk(xf[d0][2], xf[d0][3]), cvtpk(xf[d0][4], xf[d0][5]), cvtpk(xf[d0][6], xf[d0][7])}; qr[d0] = *reinterpret_cast<bf16x8*>(&w); } }
  const int sr = tid >> 4, sc = (tid & 15) * 8, vst0 = v_st(sr, sc), vst1 = v_st(32 + sr, sc);
  const int vb0 = (int)(uintptr_t)V_lds + v_rd_base(lane);
  struct { typename St::T vs0, vs1, ks0, ks1; } sr_[SDEPTH];
#define SLOAD(i, k0) do { sr_[i].vs0 = St::ld8(&Vh[(long)((k0) + sr) * LDK + sc]); sr_[i].vs1 = St::ld8(&Vh[(long)((k0) + 32 + sr) * LDK + sc]); \
    sr_[i].ks0 = St::ld8(&Kh[(long)((k0) + sr) * LDK + sc]); sr_[i].ks1 = St::ld8(&Kh[(long)((k0) + 32 + sr) * LDK + sc]); } while (0)
#define SWRITE(b, i) do { *(bf16x8*)((char*)V_lds + (b) * SHM_V + vst0) = St::tobf(sr_[i].vs0);          \
    *(bf16x8*)((char*)V_lds + (b) * SHM_V + vst1) = St::tobf(sr_[i].vs1); int kc = sc * 2;               \
    *(bf16x8*)((char*)K_lds + (b) * SHM_K + KSWZ(sr, kc)) = St::tobf(sr_[i].ks0);                       \
    *(bf16x8*)((char*)K_lds + (b) * SHM_K + KSWZ(32 + sr, kc)) = St::tobf(sr_[i].ks1); } while (0)
#define SWAIT() do { if constexpr (SDEPTH == 2) asm volatile("s_waitcnt vmcnt(4)" ::: "memory"); else asm volatile("s_waitcnt vmcnt(0)" ::: "memory"); } while (0)
#define RESC(a) do { if (__any((a) < 1.f)) { if (hi == 0) al_l[r32] = (a); asm volatile("s_waitcnt lgkmcnt(0)" ::: "memory"); \
    for (int d = 0; d < 4; ++d) for (int r = 0; r < 16; ++r) o[d][r] *= al_l[crow(r, hi)]; } } while (0)
  f32x16 pA0, pA1, pB0, pB1; float mnA, mnB, alA, alB; bf16x8 pa0, pa1, pa2, pa3; const int NT = seq / KVBLK;
  constexpr int SE = 0, SO = SDEPTH - 1;
  SLOAD(SE, 0); asm volatile("s_waitcnt vmcnt(0)" ::: "memory"); SWRITE(0, SE); __syncthreads();
  qkt(pA0, pA1, K_lds, qr, r32, hi); partialSM(pA0, pA1, m_reg, mnA, alA);
  SLOAD(SO, KVBLK); if constexpr (SDEPTH == 2) { if (2 < NT) SLOAD(SE, 2 * KVBLK); }
  SWAIT(); SWRITE(1, SO); __syncthreads();
  for (int j = 1; j + 1 < NT; j += 2) {
    SBAR(); qkt(pB0, pB1, (bf16*)((char*)K_lds + SHM_K), qr, r32, hi);
    finishSM(pA0, pA1, alA, l_reg, pa0, pa1, pa2, pa3); SBAR();
    SLOAD(SO, (j + SDEPTH) * KVBLK); SBAR();
    pv_d0(o, vb0, pa0, pa1, pa2, pa3); partialSM(pB0, pB1, m_reg, mnB, alB);
    __syncthreads(); SWAIT(); SWRITE(0, SE);
    RESC(alB); __syncthreads();
    SBAR(); qkt(pA0, pA1, K_lds, qr, r32, hi);
    finishSM(pB0, pB1, alB, l_reg, pa0, pa1, pa2, pa3); SBAR();
    if (SDEPTH == 1 || j + 3 < NT) SLOAD(SE, (j + 1 + SDEPTH) * KVBLK); SBAR();
    pv_d0(o, vb0 + (int)SHM_V, pa0, pa1, pa2, pa3); partialSM(pA0, pA1, m_reg, mnA, alA);
    __syncthreads(); SWAIT(); SWRITE(1, SO);
    RESC(alA); __syncthreads();
  }
  SBAR(); qkt(pB0, pB1, (bf16*)((char*)K_lds + SHM_K), qr, r32, hi);
  finishSM(pA0, pA1, alA, l_reg, pa0, pa1, pa2, pa3); SBAR();
  pv_d0(o, vb0, pa0, pa1, pa2, pa3); partialSM(pB0, pB1, m_reg, mnB, alB);
  __syncthreads(); RESC(alB);
  finishSM(pB0, pB1, alB, l_reg, pa0, pa1, pa2, pa3); SBAR();
  pv_d0(o, vb0 + (int)SHM_V, pa0, pa1, pa2, pa3);
  if (hi == 0) li_l[r32] = l_reg; asm volatile("s_waitcnt lgkmcnt(0)" ::: "memory");
  float rli[16];
#pragma unroll
  for (int r = 0; r < 16; ++r) rli[r] = __builtin_amdgcn_rcpf(li_l[crow(r, hi)]);
  unsigned char* Ow = Ob + (long)(wid * QBLK) * LDO;
#pragma unroll
  for (int r = 0; r < 16; ++r) { int orow = crow(r, hi);
    for (int d0 = 0; d0 < 4; ++d0) { const float ov = o[d0][r] * rli[r] * 16.0f; Ow[(long)orow * LDO + d0 * 32 + r32] = (unsigned char)(__builtin_amdgcn_cvt_pk_fp8_f32(ov, ov, __builtin_bit_cast(int, ov), false) & 0xff); } }
#undef SLOAD
#undef SWRITE
#undef SWAIT
#undef RESC
}
#undef KSWZ
#undef SBAR
}

#define GAS __attribute__((address_space(1)))
#define LAS __attribute__((address_space(3)))
typedef unsigned short bf16;
typedef unsigned v4u __attribute__((ext_vector_type(4)));
typedef float f32x4 __attribute__((ext_vector_type(4)));
typedef short bf16x8 __attribute__((ext_vector_type(8)));
typedef GAS unsigned gu32;
typedef GAS unsigned long long gu64;
#define RLX_AGENT __ATOMIC_RELAXED, __HIP_MEMORY_SCOPE_AGENT
#define LDS_WAIT() asm volatile("s_waitcnt lgkmcnt(0)" ::: "memory")
#define VM_WAIT() asm volatile("s_waitcnt vmcnt(0)" ::: "memory")
__device__ __forceinline__ unsigned long long rt() { return __builtin_amdgcn_s_memrealtime(); }
__device__ __forceinline__ unsigned f2bf(float f) { unsigned u = __builtin_bit_cast(unsigned, f); return (u + 0x7fffu + ((u >> 16) & 1u)) >> 16; }
__device__ __forceinline__ unsigned pk2(float lo, float hi) { return f2bf(lo) | (f2bf(hi) << 16); }

#define XB_TMO      128
#define XB_XCNT(j)  (256  + 64 * (j))
#define XB_XSUB(j)  (1280 + 64 * (j))
#define XB_XGEN(j)  (2304 + 64 * (j))
#define XB_TOP      3328
#define XB_TOPGEN   3392
#define XCD_BAR_WORDS 3456
#define XB_SPIN_CAP (1u << 18)

__device__ __forceinline__ unsigned xb_ld(unsigned* p)              { return __hip_atomic_load(p, __ATOMIC_RELAXED, __HIP_MEMORY_SCOPE_AGENT); }
__device__ __forceinline__ unsigned xb_add(unsigned* p, unsigned v) { return __hip_atomic_fetch_add(p, v, __ATOMIC_RELAXED, __HIP_MEMORY_SCOPE_AGENT); }
__device__ __forceinline__ unsigned xb_xcc_id() { return (unsigned)__builtin_amdgcn_s_getreg((3 << 11) | 20) & 0xFu; }
#define XB_SPIN(cond, bar) do { unsigned _sp = 0; while (cond) { __builtin_amdgcn_s_sleep(1); \
    if ((++_sp & 255u) == 0u) { if (xb_ld(&(bar)[XB_TMO])) break; if (_sp > XB_SPIN_CAP) { atomicAdd(&(bar)[XB_TMO], 1u); break; } } } } while (0)

struct XcdBarrier {
    unsigned* bar; unsigned x;
    volatile LAS unsigned* st;
};

__device__ __forceinline__ XcdBarrier xcd_barrier_post(unsigned* bar, volatile LAS unsigned* st) {
    XcdBarrier b; b.bar = bar; b.x = xb_xcc_id(); b.st = st;
    if (threadIdx.x == 0) (void)xb_add(&bar[XB_XCNT(b.x)], 1u);
    return b;
}
__device__ __forceinline__ void xcd_barrier_complete(unsigned* bar, unsigned x, unsigned& nloc, unsigned& nx) {
    const unsigned G = gridDim.x * gridDim.y * gridDim.z;
    unsigned sum, cnt, mine, sp = 0u;
    for (;;) {
        sum = 0u; cnt = 0u; mine = 0u;
#pragma unroll
        for (unsigned j = 0; j < 16; ++j) { const unsigned c = xb_ld(&bar[XB_XCNT(j)]); sum += c; cnt += (c > 0u) ? 1u : 0u; mine = (j == x) ? c : mine; }
        if (sum == G) break;
        __builtin_amdgcn_s_sleep(1);
        if ((++sp & 255u) == 0u) { if (xb_ld(&bar[XB_TMO])) break; if (sp > XB_SPIN_CAP) { atomicAdd(&bar[XB_TMO], 1u); break; } }
    }
    nloc = mine > 0u ? mine : 1u; nx = cnt > 0u ? cnt : 1u;
}

__device__ __forceinline__ void xcd_barrier(const XcdBarrier& b) {
    asm volatile("s_waitcnt vmcnt(0)" ::: "memory");
    __syncthreads();
    if (threadIdx.x == 0) {
        unsigned* bar = b.bar;
        __builtin_amdgcn_s_waitcnt(0);
        unsigned nloc = b.st[0], nx = b.st[1];
        if (nloc == 0u) { xcd_barrier_complete(bar, b.x, nloc, nx); b.st[0] = nloc; b.st[1] = nx; }
        const unsigned old = xb_add(&bar[XB_XSUB(b.x)], 1u);
        const unsigned gen = old / nloc;
        if (old + 1u == (gen + 1u) * nloc) {
            __builtin_amdgcn_fence(__ATOMIC_RELEASE, "agent");
            asm volatile("s_waitcnt vmcnt(0)" ::: "memory");
            const unsigned og = xb_add(&bar[XB_TOP], 1u);
            const unsigned tg = og / nx;
            if (og + 1u == (tg + 1u) * nx) xb_add(&bar[XB_TOPGEN], 1u);
            else XB_SPIN(xb_ld(&bar[XB_TOPGEN]) == tg, bar);
            __builtin_amdgcn_fence(__ATOMIC_ACQUIRE, "agent");
            xb_add(&bar[XB_XGEN(b.x)], 1u);
            asm volatile("s_waitcnt vmcnt(0)" ::: "memory");
        } else {
            XB_SPIN(xb_ld(&bar[XB_XGEN(b.x)]) == gen, bar);
            __builtin_amdgcn_fence(__ATOMIC_ACQUIRE, "agent");
            asm volatile("s_waitcnt vmcnt(0)" ::: "memory");
        }
    }
    __syncthreads();
}
constexpr int DM = 1024, NB = 16, SEQ = 2048, CTXL = 256, TL = NB * SEQ, TC = NB * CTXL, TALL = TL + TC;
constexpr int INCOLS = 6144, OFF_FNET = 2560, OFF_GATE = 3072;
constexpr int NEXP = 32, KVROWS = SEQ + CTXL;
constexpr float EPS = 1e-6f;
constexpr int NWAVES = 8, NTHR = NWAVES * 64;
constexpr int NPL = 11, NPH = 2 + 2 * NPL;
#ifndef MK_PER_PHASE
#define MK_PER_PHASE 0
#endif
constexpr size_t MiB = 1u << 20;
constexpr size_t WS_CTL = 0, CTL_ZERO_BYTES = 1 * MiB;
constexpr size_t WS_MOD = 1 * MiB;
constexpr size_t WS_TAB = 2 * MiB;
constexpr size_t WS_TOPI = 3 * MiB, WS_TOPP = 4 * MiB, WS_SLOT = 5 * MiB, WS_CNT = 6 * MiB;
constexpr size_t WS_LOGIT = 7 * MiB;
constexpr size_t WS_WSMALL = 17 * MiB, WSMALL_LAYER = 20 * MiB;
constexpr size_t OFFS_WIN = 0, OFFS_WF = 5 * MiB, OFFS_WG = 7 * MiB, OFFS_WAO = 13 * MiB, OFFS_WCO = 15 * MiB, OFFS_WFO = 16 * MiB, OFFS_WOUT = 17 * MiB, OFFS_ROUT = 19 * MiB;
constexpr size_t WS_DFTL = 57 * MiB, WS_DFTC = 73 * MiB;
constexpr size_t WS_XC = 74 * MiB;
constexpr size_t WS_H = 90 * MiB;
constexpr size_t WS_WGU = 162 * MiB, WS_WD = 226 * MiB, MOEW_LAYER = 96 * MiB;
constexpr size_t WS_BIG = 354 * MiB;
constexpr size_t WS_Q = WS_BIG, WS_K = WS_Q + 72 * MiB, WS_V = WS_K + 18 * MiB, WS_CU = WS_V + 18 * MiB, WS_YT = WS_CU + 36 * MiB, WS_YTC = WS_YT + 64 * MiB;
constexpr size_t WS_GATES = WS_BIG;
constexpr size_t WS_AO = WS_BIG + 216 * MiB, WS_CH = WS_AO + 72 * MiB, WS_Z = WS_CH + 36 * MiB;
constexpr size_t WS_MIX = WS_AO;
constexpr size_t WS_MERGED = WS_BIG + 360 * MiB;
constexpr int SLOT_ROWS = 608 * 256;
constexpr size_t WS_YS = WS_BIG, WS_HS = WS_BIG + 304 * MiB, WS_ACT = WS_BIG + 456 * MiB, WS_END = WS_BIG + 608 * MiB;
constexpr size_t WS_H8 = WS_END;
constexpr size_t WS_END2 = WS_END + 36 * MiB;
static_assert(WS_YTC + 8 * MiB == WS_AO && WS_Z + 36 * MiB == WS_MERGED && WS_MERGED + 72 * MiB <= WS_END && (size_t)SLOT_ROWS * 2048 == 304 * MiB, "ws map");
constexpr int CW_TMO = 0, CW_CODE = 1, CW_BAR = 4096;
constexpr int CNT_ROWSRC = 32768;
constexpr int CNT_TILE_E = 16384, CNT_NT = 16384 + 1024;

constexpr int RING_OFF = 0, RING_BYTES = 131072;
constexpr int LDSCTL_OFF = RING_BYTES, MISC_OFF = LDSCTL_OFF + 320, LDS_CT = LDSCTL_OFF + 512, LDS_SM = LDSCTL_OFF + 1024;
constexpr int LDS_BYTES = 155648;

typedef unsigned u32x2 __attribute__((ext_vector_type(2)));
typedef int i32x4 __attribute__((ext_vector_type(4)));
typedef float f32x2 __attribute__((ext_vector_type(2)));
struct Args { const float* in[29]; float* out; unsigned char* ws; int ph_lo, ph_hi; };
typedef const __attribute__((address_space(4))) unsigned char* kptr_t;
struct AV {
    kptr_t kp;
    __device__ __forceinline__ const float* in(int i) const { return *(const float* const __attribute__((address_space(4)))*)(kp + 8 * i); }
    __device__ __forceinline__ float* out() const { return *(float* const __attribute__((address_space(4)))*)(kp + 8 * 29); }
    __device__ __forceinline__ unsigned char* ws() const { return *(unsigned char* const __attribute__((address_space(4)))*)(kp + 8 * 30); }
};
__device__ __forceinline__ AV av_get() { AV a; a.kp = (kptr_t)__builtin_amdgcn_kernarg_segment_ptr(); asm volatile("" : "+s"(a.kp)); return a; }

struct Frame {
    LAS unsigned char* lds; volatile LAS unsigned* MISC; gu32* ctl;
    int tid, lane, wave, vcu, G;
};

__device__ __forceinline__ float shx(float v, int m, int lane) { return __int_as_float(__builtin_amdgcn_ds_bpermute((lane ^ m) << 2, __float_as_int(v))); }
__device__ __forceinline__ float wave_sum(float v, int lane) {
#pragma unroll
    for (int o = 1; o < 64; o <<= 1) v += shx(v, o, lane);
    return v;
}
__device__ __forceinline__ float sigmoidf_(float x) { return 1.0f / (1.0f + __expf(-x)); }
__device__ __forceinline__ f32x4 bf4(u32x2 w) { f32x4 r; r[0] = __uint_as_float(w.x << 16); r[1] = __uint_as_float(w.x & 0xffff0000u); r[2] = __uint_as_float(w.y << 16); r[3] = __uint_as_float(w.y & 0xffff0000u); return r; }
__device__ __forceinline__ u32x2 pk4(f32x4 v) { u32x2 w; w.x = pk2(v[0], v[1]); w.y = pk2(v[2], v[3]); return w; }
__device__ __forceinline__ void ld_row_f32(f32x4 (&v)[4], const float* p, int lane) {
#pragma unroll
    for (int j = 0; j < 4; ++j) v[j] = ((const GAS f32x4*)p)[lane + 64 * j];
}
__device__ __forceinline__ void st_row_f32(const f32x4 (&v)[4], float* p, int lane) {
#pragma unroll
    for (int j = 0; j < 4; ++j) ((GAS f32x4*)p)[lane + 64 * j] = v[j];
}
__device__ __forceinline__ void ld_row_bf16(f32x4 (&v)[4], const bf16* p, int lane) {
#pragma unroll
    for (int j = 0; j < 4; ++j) v[j] = bf4(((const GAS u32x2*)p)[lane + 64 * j]);
}
__device__ __forceinline__ void st_row_bf16(const f32x4 (&v)[4], bf16* p, int lane) {
#pragma unroll
    for (int j = 0; j < 4; ++j) ((GAS u32x2*)p)[lane + 64 * j] = pk4(v[j]);
}
__device__ __forceinline__ void rms_gain(f32x4 (&v)[4], const float* g, int lane) {
    float ss = 0.f;
#pragma unroll
    for (int j = 0; j < 4; ++j) ss += (v[j][0] * v[j][0] + v[j][1] * v[j][1]) + (v[j][2] * v[j][2] + v[j][3] * v[j][3]);
    const float r = 1.0f / sqrtf(wave_sum(ss, lane) * (1.0f / 1024.0f) + EPS);
#pragma unroll
    for (int j = 0; j < 4; ++j) { const f32x4 gg = ((const GAS f32x4*)g)[lane + 64 * j]; v[j] = v[j] * r * gg; }
}
__device__ __forceinline__ void modulate_store(const f32x4 (&v)[4], const float* shift, const float* scale, bf16* o, int lane) {
#pragma unroll
    for (int j = 0; j < 4; ++j) { const f32x4 sh = ((const GAS f32x4*)shift)[lane + 64 * j], sc = ((const GAS f32x4*)scale)[lane + 64 * j];
        ((GAS u32x2*)o)[lane + 64 * j] = pk4(v[j] * (sc + 1.0f) + sh); }
}
__device__ __forceinline__ unsigned pk4_fp8(f32x4 v) { return pg8::cvt4_fp8(v[0], v[1], v[2], v[3]); }
__device__ __forceinline__ void modulate_store2(const f32x4 (&v)[4], const float* shift, const float* scale, bf16* o, unsigned char* o8, int lane) {
#pragma unroll
    for (int j = 0; j < 4; ++j) { const f32x4 sh = ((const GAS f32x4*)shift)[lane + 64 * j], sc = ((const GAS f32x4*)scale)[lane + 64 * j]; const f32x4 r = v[j] * (sc + 1.0f) + sh;
        ((GAS u32x2*)o)[lane + 64 * j] = pk4(r); ((GAS unsigned*)o8)[lane + 64 * j] = pk4_fp8(r); }
}
__device__ __forceinline__ f32x4 fp8x4(unsigned w) { const f32x2 a = __builtin_amdgcn_cvt_pk_f32_fp8((int)w, false), b = __builtin_amdgcn_cvt_pk_f32_fp8((int)w, true); return (f32x4){a.x, a.y, b.x, b.y}; }
__device__ __forceinline__ int krow_of(int m) { return m < TL ? (m >> 11) * KVROWS + (m & 2047) : ((m - TL) >> 8) * KVROWS + SEQ + ((m - TL) & 255); }

__device__ __forceinline__ void load_block(const float* W, int ldw, int k0, int n0, float scale, LAS float* scr, int lane) {
    f32x4 v[8]; const int kr = lane >> 3, c4 = (lane & 7) * 4;
#pragma unroll
    for (int i = 0; i < 8; ++i) v[i] = *(const GAS f32x4*)(W + (size_t)(k0 + kr + 8 * i) * ldw + n0 + c4);
#pragma unroll
    for (int i = 0; i < 8; ++i) { LAS float* d = scr + (kr + 8 * i) * 33 + c4; d[0] = v[i][0] * scale; d[1] = v[i][1] * scale; d[2] = v[i][2] * scale; d[3] = v[i][3] * scale; }
    LDS_WAIT(); asm volatile("" ::: "memory");
}
__device__ __forceinline__ void transpose_item(const float* W, int ldw, int K, bf16* WT, int dst_row0, int k0, int n0, LAS float* scr, int lane) {
    load_block(W, ldw, k0, n0, 1.0f, scr, lane);
    const int c = lane & 7;
#pragma unroll
    for (int j = 0; j < 4; ++j) { const int n = (lane >> 3) + 8 * j; const LAS float* s = scr + (8 * c) * 33 + n;
        v4u o; o.x = pk2(s[0 * 33], s[1 * 33]); o.y = pk2(s[2 * 33], s[3 * 33]); o.z = pk2(s[4 * 33], s[5 * 33]); o.w = pk2(s[6 * 33], s[7 * 33]);
        *(GAS v4u*)(WT + (size_t)(dst_row0 + n) * K + k0 + 8 * c) = o; }
    LDS_WAIT(); asm volatile("" ::: "memory");
}
__device__ __forceinline__ void transpose_item_fp8(const float* W, int ldw, int K, unsigned char* WT, int dst_row0, int k0, int n0, float scale, LAS float* scr, int lane) {
    load_block(W, ldw, k0, n0, scale, scr, lane);
#pragma unroll
    for (int j = 0; j < 2; ++j) { const int q = lane + 64 * j, n = q >> 2, c = q & 3; const LAS float* s = scr + (16 * c) * 33 + n; v4u o;
        o.x = pg8::cvt4_fp8(s[0 * 33], s[1 * 33], s[2 * 33], s[3 * 33]); o.y = pg8::cvt4_fp8(s[4 * 33], s[5 * 33], s[6 * 33], s[7 * 33]); o.z = pg8::cvt4_fp8(s[8 * 33], s[9 * 33], s[10 * 33], s[11 * 33]); o.w = pg8::cvt4_fp8(s[12 * 33], s[13 * 33], s[14 * 33], s[15 * 33]);
        *(GAS v4u*)(WT + (size_t)(dst_row0 + n) * K + k0 + 16 * c) = o; }
    LDS_WAIT(); asm volatile("" ::: "memory");
}
constexpr int IT_S0 = 16 * 80, IT_S1 = 16 * 96, IT_S2 = 512, IT_S3 = 512, IT_S4 = 256, IT_S5 = 256, IT_SMALL = IT_S0 + IT_S1 + IT_S2 + IT_S3 + IT_S4 + IT_S5;
__device__ __forceinline__ void small_item(const AV& a, int l, int r, LAS float* scr, int lane) {
    unsigned char* wl = a.ws() + WS_WSMALL + (size_t)l * WSMALL_LAYER; const float* win = a.in(10) + (size_t)l * DM * INCOLS;
    if (r < IT_S0) { const int kb = r / 80, n0 = (r % 80) * 32; int dr;
        if (n0 < 1536) dr = n0; else { int cc = n0 - 1536; if (cc < 512) dr = 1536 + (cc >> 7) * 256 + (cc & 127); else { cc -= 512; dr = 1536 + (cc >> 7) * 256 + 128 + (cc & 127); } }
        transpose_item_fp8(win, INCOLS, DM, wl + OFFS_WIN, dr, kb * 64, n0, 32.0f, scr, lane); return; }
    r -= IT_S0;
    if (r < IT_S1) { const int kb = r / 96, nb = r % 96; transpose_item_fp8(win, INCOLS, DM, wl + OFFS_WG, nb * 32, kb * 64, OFF_GATE + nb * 32, 32.0f, scr, lane); return; }
    r -= IT_S1;
    if (r < IT_S2) { const int kb = r / 32, nb = r % 32; transpose_item_fp8(a.in(13) + (size_t)l * DM * DM, DM, DM, wl + OFFS_WAO, nb * 32, kb * 64, nb * 32, 32.0f, scr, lane); return; }
    r -= IT_S2;
    if (r < IT_S3) { const int kb = r / 32, nb = r % 32; transpose_item(a.in(20) + (size_t)l * DM * DM, DM, DM, (bf16*)(wl + OFFS_WOUT), nb * 32, kb * 64, nb * 32, scr, lane); return; }
    r -= IT_S3;
    if (r < IT_S4) { const int kb = r / 32, nb = r % 32; transpose_item(a.in(18) + (size_t)l * 512 * DM, DM, 512, (bf16*)(wl + OFFS_WCO), nb * 32, kb * 64, nb * 32, scr, lane); return; }
    r -= IT_S4;
    { const int kb = r / 32, nb = r % 32; transpose_item(a.in(19) + (size_t)l * 512 * DM, DM, 512, (bf16*)(wl + OFFS_WFO), nb * 32, kb * 64, nb * 32, scr, lane); }
}
constexpr int IT_MOE = NEXP * 3 * 512;
struct MoeIt { const float* W; unsigned char* WT; int dr, k0; };
__device__ __forceinline__ MoeIt moe_decode(const AV& a, int gi) {
    const int l = gi / IT_MOE, idx = gi % IT_MOE, e = idx / 1536, r = idx % 1536, which = r / 512, it = r % 512, kb = it / 32, n0 = (it % 32) * 32; const size_t eo = ((size_t)l * NEXP + e) << 20;
    MoeIt m; m.k0 = kb * 64;
    if (which == 0) { m.W = a.in(23) + eo + n0; m.WT = a.ws() + WS_WGU + (size_t)l * MOEW_LAYER + (size_t)e * 2048 * 1024; m.dr = (n0 >> 7) * 256 + (n0 & 127); }
    else if (which == 1) { m.W = a.in(25) + eo + n0; m.WT = a.ws() + WS_WGU + (size_t)l * MOEW_LAYER + (size_t)e * 2048 * 1024; m.dr = (n0 >> 7) * 256 + 128 + (n0 & 127); }
    else { m.W = a.in(27) + eo + n0; m.WT = a.ws() + WS_WD + (size_t)l * MOEW_LAYER + (size_t)e * 1024 * 1024; m.dr = n0; }
    return m;
}
__device__ __forceinline__ void moe_issue(f32x4 (&v)[8], const MoeIt& m, int lane) {
    const float* p = m.W + (size_t)(m.k0 + (lane >> 3)) * DM + (lane & 7) * 4;
#pragma unroll
    for (int i = 0; i < 8; ++i) v[i] = __builtin_nontemporal_load((const GAS f32x4*)(p + (size_t)(8 * i) * DM));
}
__device__ __forceinline__ void moe_finish(const f32x4 (&v)[8], const MoeIt& m, LAS float* scr, int lane) {
    const int kr = lane >> 3, c4 = (lane & 7) * 4;
#pragma unroll
    for (int i = 0; i < 8; ++i) { LAS float* d = scr + (kr + 8 * i) * 33 + c4; d[0] = v[i][0] * 32.0f; d[1] = v[i][1] * 32.0f; d[2] = v[i][2] * 32.0f; d[3] = v[i][3] * 32.0f; }
    LDS_WAIT(); asm volatile("" ::: "memory");
#pragma unroll
    for (int j = 0; j < 2; ++j) { const int q = lane + 64 * j, n = q >> 2, c = q & 3; const LAS float* s = scr + (16 * c) * 33 + n; v4u o;
        o.x = pg8::cvt4_fp8(s[0 * 33], s[1 * 33], s[2 * 33], s[3 * 33]); o.y = pg8::cvt4_fp8(s[4 * 33], s[5 * 33], s[6 * 33], s[7 * 33]); o.z = pg8::cvt4_fp8(s[8 * 33], s[9 * 33], s[10 * 33], s[11 * 33]); o.w = pg8::cvt4_fp8(s[12 * 33], s[13 * 33], s[14 * 33], s[15 * 33]);
        *(GAS v4u*)(m.WT + (size_t)(m.dr + n) * DM + m.k0 + 16 * c) = o; }
    LDS_WAIT(); asm volatile("" ::: "memory");
}
__device__ __forceinline__ void moe_convert_all(const AV& a, int gw, int NGW, LAS float* scr, int lane) {
    constexpr int NIT = 2 * IT_MOE; f32x4 va[8], vb[8]; int it = gw; if (it >= NIT) return;
    MoeIt ma = moe_decode(a, it), mb = ma; moe_issue(va, ma, lane);
    for (;;) {
        const bool h1 = it + NGW < NIT; if (h1) { mb = moe_decode(a, it + NGW); moe_issue(vb, mb, lane); }
        moe_finish(va, ma, scr, lane); if (!h1) break; it += NGW;
        const bool h2 = it + NGW < NIT; if (h2) { ma = moe_decode(a, it + NGW); moe_issue(va, ma, lane); }
        moe_finish(vb, mb, scr, lane); if (!h2) break; it += NGW;
    }
}
__device__ __forceinline__ void fold_job(const AV& a, int j, const LAS float* ct, int lane) {
    const int l = j >> 10, r = j & 1023, g = r >> 8, kblk = (r >> 4) & 15, k2g = r & 15, k = kblk * 64 + lane;
    const float* wrow = a.in(10) + (size_t)l * DM * INCOLS + (size_t)k * INCOLS + OFF_FNET + g * 128;
    float ac[8], as[8];
#pragma unroll
    for (int i = 0; i < 8; ++i) { ac[i] = 0.f; as[i] = 0.f; }
    for (int n4 = 0; n4 < 32; ++n4) { const f32x4 w = *(const GAS f32x4*)(wrow + n4 * 4);
#pragma unroll
        for (int q = 0; q < 4; ++q) { const int n2 = n4 * 4 + q;
#pragma unroll
            for (int i = 0; i < 8; ++i) { const int ph = (n2 * (k2g * 8 + i)) & 127; ac[i] += w[q] * ct[ph]; as[i] += w[q] * ct[(ph - 32) & 127]; } } }
    bf16* wf = (bf16*)(a.ws() + WS_WSMALL + (size_t)l * WSMALL_LAYER + OFFS_WF);
#pragma unroll
    for (int i = 0; i < 8; ++i) { const int ch = g * 128 + k2g * 8 + i;
        wf[(size_t)ch * 1024 + k] = (bf16)f2bf(ac[i] * 0.08838834764831845f); wf[(size_t)(512 + ch) * 1024 + k] = (bf16)f2bf(as[i] * 0.08838834764831845f); }
}
__device__ __forceinline__ void p0_prologue(const Frame& F, const AV& a) {
    const int gw = F.vcu * NWAVES + F.wave, NGW = F.G * NWAVES, gt = F.vcu * NTHR + F.tid, NGT = F.G * NTHR;
    LAS float* ct = (LAS float*)(F.lds + LDS_CT);
    if (F.tid < 128) ct[F.tid] = cospif((float)F.tid * (1.0f / 64.0f));
    for (int job = blockIdx.x; job < 2 * 96; job += F.G) {
        const int l = job / 96, n0 = (job % 96) * 64;
        LAS float* s = (LAS float*)(F.lds + RING_OFF); LAS float* red = s + 17 * 1024;
        for (int i = F.tid; i < 17 * 1024; i += NTHR) { const int b = i >> 10, k = i & 1023; const float cv = b < 16 ? a.in(1)[b * 1024 + k] : a.in(3)[k]; s[i] = cv * sigmoidf_(cv); }
        __syncthreads();
        const int col = F.tid & 63, ks = F.tid >> 6; float acc[17];
#pragma unroll
        for (int b = 0; b < 17; ++b) acc[b] = 0.f;
        const float* w = a.in(4) + (size_t)l * DM * INCOLS + n0 + col;
        for (int k = ks * 128; k < ks * 128 + 128; k += 16) { float wv[16];
#pragma unroll
            for (int q = 0; q < 16; ++q) wv[q] = w[(size_t)(k + q) * INCOLS];
#pragma unroll
            for (int q = 0; q < 16; ++q)
#pragma unroll
                for (int b = 0; b < 17; ++b) acc[b] += s[b * 1024 + k + q] * wv[q]; }
#pragma unroll
        for (int b = 0; b < 17; ++b) red[(ks * 17 + b) * 64 + col] = acc[b];
        __syncthreads();
        for (int i = F.tid; i < 17 * 64; i += NTHR) { const int b = i >> 6, c2 = i & 63; float t = 0.f;
#pragma unroll
            for (int q = 0; q < 8; ++q) t += red[(q * 17 + b) * 64 + c2];
            ((float*)(a.ws() + WS_MOD))[((size_t)l * 17 + b) * INCOLS + n0 + c2] = t + a.in(5)[l * INCOLS + n0 + c2]; }
        __syncthreads();
    }
    __syncthreads();
    for (int i = gt; i < 64 * 32; i += NGT) { const int p = i >> 5, f = i & 31; const float inv = powf(10000.0f, -(float)f / 32.0f), ang = (float)p * inv; ((f32x2*)(a.ws() + WS_TAB))[i] = (f32x2){cosf(ang), sinf(ang)}; }
    for (int i = gt; i < 2048 * 256; i += NGT) { const int k1 = i >> 8, c0 = (i & 255) * 16; float v[16];
#pragma unroll
        for (int q = 0; q < 16; ++q) { const int col = c0 + q, n1 = col & 2047, rr = (k1 * n1) & 2047; const float x = (float)rr * (1.0f / 1024.0f); v[q] = ((col >> 11) ? -sinpif(x) : cospif(x)) * (32.0f * 0.022097086912079608f); }
        v4u o; o.x = pk4_fp8((f32x4){v[0], v[1], v[2], v[3]}); o.y = pk4_fp8((f32x4){v[4], v[5], v[6], v[7]}); o.z = pk4_fp8((f32x4){v[8], v[9], v[10], v[11]}); o.w = pk4_fp8((f32x4){v[12], v[13], v[14], v[15]}); ((GAS v4u*)(a.ws() + WS_DFTL))[i] = o; }
    for (int i = gt; i < 256 * 32; i += NGT) { const int k1 = i >> 5, c0 = (i & 31) * 16; float v[16];
#pragma unroll
        for (int q = 0; q < 16; ++q) { const int col = c0 + q, n1 = col & 255, rr = (k1 * n1) & 255; const float x = (float)rr * (1.0f / 128.0f); v[q] = ((col >> 8) ? -sinpif(x) : cospif(x)) * (32.0f * 0.0625f); }
        v4u o; o.x = pk4_fp8((f32x4){v[0], v[1], v[2], v[3]}); o.y = pk4_fp8((f32x4){v[4], v[5], v[6], v[7]}); o.z = pk4_fp8((f32x4){v[8], v[9], v[10], v[11]}); o.w = pk4_fp8((f32x4){v[12], v[13], v[14], v[15]}); ((GAS v4u*)(a.ws() + WS_DFTC))[i] = o; }
    for (int i = gt; i < 2 * 256 * 1024; i += NGT) { const int l = i >> 18, r = (i >> 10) & 255, k = i & 1023; unsigned o = 0u;
        if (r < 64) { const float w = a.in(21)[((size_t)l * DM + k) * NEXP + (r & 31)]; const unsigned hi = f2bf(w); o = hi; if (r >= 32) o = f2bf(w - __uint_as_float(hi << 16)); }
        ((bf16*)(a.ws() + WS_WSMALL + (size_t)l * WSMALL_LAYER + OFFS_ROUT))[(size_t)r * 1024 + k] = (bf16)o; }
    for (int j = gw; j < 2048; j += NGW) fold_job(a, j, ct, F.lane);
    LAS float* scr = (LAS float*)(F.lds + RING_OFF + F.wave * 16384);
    for (int it = gw; it < 2 * IT_SMALL; it += NGW) small_item(a, it / IT_SMALL, it % IT_SMALL, scr, F.lane);
    moe_convert_all(a, gw, NGW, scr, F.lane);
}
__device__ __forceinline__ void ld4(f32x4 (&v)[4], const float* p, int lane) {
#pragma unroll
    for (int j = 0; j < 4; ++j) v[j] = ((const GAS f32x4*)p)[lane + 64 * j];
}
__device__ __forceinline__ float sumsq4(const f32x4 (&v)[4]) { float ss = 0.f;
#pragma unroll
    for (int j = 0; j < 4; ++j) ss += (v[j][0] * v[j][0] + v[j][1] * v[j][1]) + (v[j][2] * v[j][2] + v[j][3] * v[j][3]);
    return ss; }
__device__ __forceinline__ void p1_norm0(const Frame& F, const AV& a) {
    const int gw = F.vcu * NWAVES + F.wave, NGW = F.G * NWAVES, rpw = (TALL + NGW - 1) / NGW, r0 = gw * rpw, r1 = (r0 + rpw < TALL) ? r0 + rpw : TALL;
    if (r0 >= r1) return;
    f32x4 gpre[4], shift[4], scale[4], xn[4]; ld4(gpre, a.in(6), F.lane); int cb = -1;
    auto xsrc = [&](int m) -> const float* { return m < TL ? a.in(0) + (size_t)m * DM : a.in(2) + (size_t)(m - TL) * DM; };
    ld4(xn, xsrc(r0), F.lane);
    for (int m = r0; m < r1; ++m) {
        f32x4 x[4];
#pragma unroll
        for (int j = 0; j < 4; ++j) x[j] = xn[j];
        if (m + 1 < r1) ld4(xn, xsrc(m + 1), F.lane);
        const int b = m < TL ? (m >> 11) : 16;
        if (b != cb) { cb = b; const float* mv = (const float*)(a.ws() + WS_MOD) + (size_t)b * INCOLS; ld4(shift, mv, F.lane); ld4(scale, mv + 1024, F.lane); }
        const float r = 1.0f / sqrtf(wave_sum(sumsq4(x), F.lane) * (1.0f / 1024.0f) + EPS);
        bf16* ho = (bf16*)(a.ws() + WS_H) + (size_t)m * DM; unsigned char* h8 = a.ws() + WS_H8 + (size_t)m * DM;
#pragma unroll
        for (int j = 0; j < 4; ++j) { const f32x4 hv = x[j] * r * gpre[j] * (scale[j] + 1.0f) + shift[j]; ((GAS u32x2*)ho)[F.lane + 64 * j] = pk4(hv); ((GAS unsigned*)h8)[F.lane + 64 * j] = pk4_fp8(hv); }
    }
}
__device__ __forceinline__ void qk_fix_core(f32x4 (&x)[4], const f32x4 (&gg)[4], const f32x2* tab, bool rope, int t, int sub, int lane) {
    float ss = sumsq4(x); ss += shx(ss, 1, lane); ss += shx(ss, 2, lane); ss += shx(ss, 4, lane);
    const float r = 1.0f / sqrtf(ss * (1.0f / 128.0f) + EPS);
#pragma unroll
    for (int jj = 0; jj < 4; ++jj) x[jj] = x[jj] * r * gg[jj];
    if (rope) { const int pr = t >> 6, pc = t & 63;
#pragma unroll
        for (int i = 0; i < 4; ++i) { const f32x2 cr = tab[pr * 32 + sub * 4 + i], cc = tab[pc * 32 + sub * 4 + i];
            const float a0 = x[0][i], a1 = x[1][i], b0 = x[2][i], b1 = x[3][i];
            x[0][i] = a0 * cr.x - a1 * cr.y; x[1][i] = a1 * cr.x + a0 * cr.y; x[2][i] = b0 * cc.x - b1 * cc.y; x[3][i] = b1 * cc.x + b0 * cc.y; } }
}
__device__ __forceinline__ void p_qkfix(const Frame& F, const AV& a, int l, int M) {
    const int gw = F.vcu * NWAVES + F.wave, NGW = F.G * NWAVES, rpw = 4 * ((M + 4 * NGW - 1) / (4 * NGW)), r0 = gw * rpw, r1 = (r0 + rpw < M) ? r0 + rpw : M;
    if (r0 >= r1) return;
    const f32x2* tab = (const f32x2*)(a.ws() + WS_TAB); const int rs = F.lane >> 4, hh = (F.lane >> 3) & 1, sub = F.lane & 7;
    f32x4 gk[4];
#pragma unroll
    for (int jj = 0; jj < 4; ++jj) gk[jj] = *(const GAS f32x4*)(a.in(12) + l * 128 + jj * 32 + sub * 4);
    bf16* kb = (bf16*)(a.ws() + WS_K);
    u32x2 kn[4];
    auto issue = [&](int mb) { const int m = mb + rs; if (m < r1) { const bf16* kp = kb + (size_t)krow_of(m) * 256 + hh * 128 + sub * 4;
#pragma unroll
        for (int jj = 0; jj < 4; ++jj) kn[jj] = *(const GAS u32x2*)(kp + jj * 32); } };
    issue(r0);
    for (int mb = r0; mb < r1; mb += 4) { const int m = mb + rs; const bool act = m < r1;
        f32x4 xk[4];
#pragma unroll
        for (int jj = 0; jj < 4; ++jj) xk[jj] = bf4(kn[jj]);
        if (mb + 4 < r1) issue(mb + 4);
        qk_fix_core(xk, gk, tab, m < TL, m & 2047, sub, F.lane);
        if (act) { bf16* kp = kb + (size_t)krow_of(m) * 256 + hh * 128 + sub * 4;
#pragma unroll
            for (int jj = 0; jj < 4; ++jj) *(GAS u32x2*)(kp + jj * 32) = pk4(xk[jj]); }
    }
}
__device__ __forceinline__ void p_conv(const Frame& F, const AV& a, int l, int njobs) {
    LAS unsigned char* lin = F.lds + RING_OFF; LAS float* lout = (LAS float*)(F.lds + RING_OFF + 62 * 1024);
    const bf16* cu = (const bf16*)(a.ws() + WS_CU); bf16* chb = (bf16*)(a.ws() + WS_CH);
    const int cp = F.tid & 255, pg = F.tid >> 8;
    f32x2 wv[31];
#pragma unroll
    for (int j = 0; j < 31; ++j) wv[j] = *(const GAS f32x2*)(a.in(14) + ((size_t)l * 31 + j) * 512 + 2 * cp);
    const f32x2 cb2 = *(const GAS f32x2*)(a.in(15) + l * 512 + 2 * cp);
    for (int job = F.vcu; job < njobs; job += F.G) {
        int rowbase, L, t0;
        if (job < 1024) { rowbase = (job >> 6) * SEQ; L = SEQ; t0 = (job & 63) * 32; } else { const int jc = job - 1024; rowbase = TL + (jc >> 3) * CTXL; L = CTXL; t0 = (jc & 7) * 32; }
        for (int idx = F.tid; idx < 62 * 64; idx += NTHR) { const int row = idx >> 6, ch = idx & 63, p = t0 - 15 + row; v4u val = (v4u){0u, 0u, 0u, 0u};
            if (p >= 0 && p < L) val = *(const GAS v4u*)(cu + (size_t)(rowbase + p) * 512 + ch * 8);
            *(LAS v4u*)(lin + row * 1024 + ch * 16) = val; }
        __syncthreads();
#pragma unroll
        for (int chunk = 0; chunk < 2; ++chunk) {
            f32x2 acc[8];
#pragma unroll
            for (int i = 0; i < 8; ++i) acc[i] = cb2;
            const int r0 = pg * 16 + chunk * 8;
#pragma unroll
            for (int r = 0; r < 38; ++r) { const unsigned w = *(const LAS unsigned*)(lin + (r0 + r) * 1024 + cp * 4); const float x0 = __uint_as_float(w << 16), x1 = __uint_as_float(w & 0xffff0000u);
#pragma unroll
                for (int i = 0; i < 8; ++i) { const int j = r - i; if (j >= 0 && j <= 30) { acc[i].x += x0 * wv[j].x; acc[i].y += x1 * wv[j].y; } } }
#pragma unroll
            for (int i = 0; i < 8; ++i) *(LAS f32x2*)(lout + (r0 + i) * 512 + 2 * cp) = acc[i];
        }
        __syncthreads();
#pragma unroll
        for (int pp = 0; pp < 4; ++pp) { const int p = F.wave * 4 + pp; const LAS float* src = lout + p * 512 + F.lane * 8;
            f32x4 y0 = *(const LAS f32x4*)src, y1 = *(const LAS f32x4*)(src + 4);
            const float mean = wave_sum((y0[0] + y0[1]) + (y0[2] + y0[3]) + (y1[0] + y1[1]) + (y1[2] + y1[3]), F.lane) * (1.0f / 512.0f);
            y0 = y0 - mean; y1 = y1 - mean;
            const float var = wave_sum((y0[0] * y0[0] + y0[1] * y0[1]) + (y0[2] * y0[2] + y0[3] * y0[3]) + (y1[0] * y1[0] + y1[1] * y1[1]) + (y1[2] * y1[2] + y1[3] * y1[3]), F.lane) * (1.0f / 512.0f);
            const float rs = 1.0f / sqrtf(var + EPS);
            const f32x4 g0 = *(const GAS f32x4*)(a.in(16) + l * 512 + F.lane * 8), g1 = *(const GAS f32x4*)(a.in(16) + l * 512 + F.lane * 8 + 4);
            const f32x4 b0 = *(const GAS f32x4*)(a.in(17) + l * 512 + F.lane * 8), b1 = *(const GAS f32x4*)(a.in(17) + l * 512 + F.lane * 8 + 4);
            y0 = y0 * rs * g0 + b0; y1 = y1 * rs * g1 + b1;
#pragma unroll
            for (int q = 0; q < 4; ++q) { y0[q] = y0[q] * sigmoidf_(y0[q]); y1[q] = y1[q] * sigmoidf_(y1[q]); }
            v4u o; o.x = pk2(y0[0], y0[1]); o.y = pk2(y0[2], y0[3]); o.z = pk2(y1[0], y1[1]); o.w = pk2(y1[2], y1[3]);
            *(GAS v4u*)(chb + (size_t)(rowbase + t0 + p) * 512 + F.lane * 8) = o; }
        __syncthreads();
    }
}
__device__ __forceinline__ void p_rowpass1(const Frame& F, const AV& a, int l, int M) {
    const int gw = F.vcu * NWAVES + F.wave, NGW = F.G * NWAVES, rpw = (M + NGW - 1) / NGW, r0 = gw * rpw, r1 = (r0 + rpw < M) ? r0 + rpw : M;
    if (r0 >= r1) return;
    const float* modb = (const float*)(a.ws() + WS_MOD) + (size_t)l * 17 * INCOLS; const bf16* mixb = (const bf16*)(a.ws() + WS_MIX);
    f32x4 gpost[4], gpre[4], gate[4], shift[4], scale[4]; ld4(gpost, a.in(7) + l * DM, F.lane); ld4(gpre, a.in(8) + l * DM, F.lane);
    int cb = -1;
    auto xsrc = [&](int m) -> const float* { return (l == 0) ? (m < TL ? a.in(0) + (size_t)m * DM : a.in(2) + (size_t)(m - TL) * DM) : (m < TL ? a.out() + (size_t)m * DM : (const float*)(a.ws() + WS_XC) + (size_t)(m - TL) * DM); };
    f32x4 xn[4]; u32x2 mn[4]; ld4(xn, xsrc(r0), F.lane);
#pragma unroll
    for (int j = 0; j < 4; ++j) mn[j] = ((const GAS u32x2*)(mixb + (size_t)r0 * DM))[F.lane + 64 * j];
    for (int m = r0; m < r1; ++m) {
        f32x4 x[4], y[4];
#pragma unroll
        for (int j = 0; j < 4; ++j) { x[j] = xn[j]; y[j] = bf4(mn[j]); }
        if (m + 1 < r1) { ld4(xn, xsrc(m + 1), F.lane);
#pragma unroll
            for (int j = 0; j < 4; ++j) mn[j] = ((const GAS u32x2*)(mixb + (size_t)(m + 1) * DM))[F.lane + 64 * j]; }
        const int b = m < TL ? (m >> 11) : 16;
        if (b != cb) { cb = b; const float* mv = modb + (size_t)b * INCOLS; ld4(gate, mv + 2 * 1024, F.lane); ld4(shift, mv + 3 * 1024, F.lane); ld4(scale, mv + 4 * 1024, F.lane); }
        const float r = 1.0f / sqrtf(wave_sum(sumsq4(y), F.lane) * (1.0f / 1024.0f) + EPS);
#pragma unroll
        for (int j = 0; j < 4; ++j) x[j] = x[j] + gate[j] * (y[j] * r * gpost[j]);
        float* xd = m < TL ? a.out() + (size_t)m * DM : (float*)(a.ws() + WS_XC) + (size_t)(m - TL) * DM;
        st_row_f32(x, xd, F.lane);
        const float r2 = 1.0f / sqrtf(wave_sum(sumsq4(x), F.lane) * (1.0f / 1024.0f) + EPS);
        bf16* ho = (bf16*)(a.ws() + WS_H) + (size_t)m * DM; unsigned char* h8 = a.ws() + WS_H8 + (size_t)m * DM;
#pragma unroll
        for (int j = 0; j < 4; ++j) { const f32x4 hv = x[j] * r2 * gpre[j] * (scale[j] + 1.0f) + shift[j]; ((GAS u32x2*)ho)[F.lane + 64 * j] = pk4(hv); ((GAS unsigned*)h8)[F.lane + 64 * j] = pk4_fp8(hv); }
    }
}
__device__ __forceinline__ void p_route(const Frame& F, const AV& a, int l, int M) {
    typedef short bfx8 __attribute__((ext_vector_type(8)));
    const int NGW = F.G * NWAVES, rpw = (M + NGW - 1) / NGW, TPB = 8 * rpw, b0 = F.vcu * TPB, b1 = (b0 + TPB < M) ? b0 + TPB : M;
    LAS unsigned char* tabl = F.lds + RING_OFF; LAS float* lg = (LAS float*)(F.lds + LDS_SM) + F.wave * 512; LAS int* cntl = (LAS int*)(F.lds + LDS_SM + 16384);
    VM_WAIT(); __syncthreads();
    if (F.tid < 32) cntl[F.tid] = 0;
    { const GAS v4u* src = (const GAS v4u*)(a.ws() + WS_WSMALL + (size_t)l * WSMALL_LAYER + OFFS_ROUT);
      for (int idx = F.tid; idx < 64 * 128; idx += NTHR) { const int row = idx >> 7, c = idx & 127; *(LAS v4u*)(tabl + row * 2048 + ((c ^ (row & 7)) << 4)) = src[idx]; } }
    __syncthreads();
    const bf16* H = (const bf16*)(a.ws() + WS_H); const float bias = a.in(22)[l * NEXP + (F.lane & 31)];
    const int ar = F.lane & 15, kb = F.lane >> 4, ng = (b1 > b0) ? (b1 - b0 + 15) >> 4 : 0;
    for (int g = F.wave; g < ng; g += NWAVES) {
        const int rb = b0 + g * 16; int row = rb + ar; if (row > M - 1) row = M - 1;
        const bf16* hp = H + (size_t)row * DM + kb * 8; f32x4 acc[4];
#pragma unroll
        for (int f = 0; f < 4; ++f) acc[f] = (f32x4){0.f, 0.f, 0.f, 0.f};
#pragma unroll 4
        for (int s = 0; s < 32; ++s) { const bfx8 af = *(const GAS bfx8*)(hp + s * 32);
#pragma unroll
            for (int f = 0; f < 4; ++f) { const int wr = f * 16 + ar; const bfx8 bfr = *(const LAS bfx8*)(tabl + wr * 2048 + (((4 * s + kb) ^ (wr & 7)) << 4));
                acc[f] = __builtin_amdgcn_mfma_f32_16x16x32_bf16(af, bfr, acc[f], 0, 0, 0); } }
#pragma unroll
        for (int i = 0; i < 4; ++i) { lg[(4 * kb + i) * 32 + ar] = acc[0][i] + acc[2][i]; lg[(4 * kb + i) * 32 + 16 + ar] = acc[1][i] + acc[3][i]; }
        LDS_WAIT(); asm volatile("" ::: "memory");
        { const int hf = F.lane >> 5, ex = F.lane & 31; LAS unsigned long long* kb64 = (LAS unsigned long long*)(F.lds + LDS_SM + 16384 + 256) + F.wave * 64;
          LAS float* selv = (LAS float*)(F.lds + LDS_SM + 16384 + 256 + 4096) + F.wave * 16; LAS int* seli = (LAS int*)(selv + 8);
#pragma unroll 1
          for (int p = 0; p < 8; ++p) { const int r = 2 * p + hf, m = rb + r; const bool valid = m < b1;
            const float v = lg[r * 32 + ex] + bias; unsigned ub = __float_as_uint(v); ub = (ub & 0x80000000u) ? ~ub : (ub | 0x80000000u);
            const unsigned long long K = ((unsigned long long)ub << 5) | (unsigned)(31 - ex);
            kb64[F.lane] = K;
            LDS_WAIT(); asm volatile("" ::: "memory");
            int rank = 0;
#pragma unroll
            for (int j = 0; j < 32; ++j) rank += (kb64[hf * 32 + j] > K) ? 1 : 0;
            if (rank < 4) { selv[hf * 4 + rank] = v; seli[hf * 4 + rank] = ex; if (valid) __hip_atomic_fetch_add(&cntl[ex], 1, __ATOMIC_RELAXED, __HIP_MEMORY_SCOPE_WORKGROUP); }
            LDS_WAIT(); asm volatile("" ::: "memory");
            if (ex == 0 && valid) { const f32x4 tv = *(const LAS f32x4*)(selv + hf * 4); const i32x4 ti = *(const LAS i32x4*)(seli + hf * 4);
                const float e1 = __expf(tv[1] - tv[0]), e2 = __expf(tv[2] - tv[0]), e3 = __expf(tv[3] - tv[0]), inv = 1.0f / (1.0f + e1 + e2 + e3);
                *(GAS i32x4*)((int*)(a.ws() + WS_TOPI) + (size_t)m * 4) = ti; *(GAS f32x4*)((float*)(a.ws() + WS_TOPP) + (size_t)m * 4) = (f32x4){inv, e1 * inv, e2 * inv, e3 * inv}; }
            LDS_WAIT(); asm volatile("" ::: "memory"); } }
        LDS_WAIT(); asm volatile("" ::: "memory");
    }
    __syncthreads();
    if (F.tid < 32) ((int*)(a.ws() + WS_CNT))[F.vcu * 32 + F.tid] = cntl[F.tid];
}
__device__ __forceinline__ void p_slots(const Frame& F, const AV& a, int M) {
    LAS int* sm = (LAS int*)(F.lds + LDS_SM);
    LAS int *tot = sm, *bef = sm + 32, *base = sm + 64, *tst = sm + 96  , *mask = sm + 160  , *ids = sm + 320  , *slot = sm + 960  ;
    const int* cnt = (const int*)(a.ws() + WS_CNT);
    { LAS int* ptot = sm + 1600; LAS int* pbef = sm + 2112; const int e = F.tid & 31, part = F.tid >> 5; int t = 0, b = 0;
#pragma unroll 4
      for (int q = part; q < F.G; q += 16) { const int c = cnt[q * 32 + e]; t += c; if (q < F.vcu) b += c; }
      ptot[part * 32 + e] = t; pbef[part * 32 + e] = b;
      __syncthreads();
      if (F.tid < 32) { int tt = 0, bb = 0;
#pragma unroll
          for (int q = 0; q < 16; ++q) { tt += ptot[q * 32 + F.tid]; bb += pbef[q * 32 + F.tid]; }
          tot[F.tid] = tt; bef[F.tid] = bb; } }
    __syncthreads();
    if (F.tid == 0) { int ts = 0; for (int e = 0; e < 32; ++e) { tst[e] = ts; base[e] = ts * 256 + bef[e]; ts += (tot[e] + 255) >> 8; } tst[32] = ts; }
    __syncthreads();
    const int NT = tst[32];
    if (blockIdx.x == 0) { int* te = (int*)(a.ws() + WS_CNT) + CNT_TILE_E;
        for (int t = F.tid; t < NT; t += NTHR) { int e = 0; for (int q = 1; q < 32; ++q) if (t >= tst[q]) e = q; te[t] = e; }
        if (F.tid == 0) ((int*)(a.ws() + WS_CNT))[CNT_NT] = NT; }
    const int TPB = 8 * ((M + F.G * NWAVES - 1) / (F.G * NWAVES)), m0 = F.vcu * TPB, m1 = (m0 + TPB < M) ? m0 + TPB : M, nt = m1 > m0 ? m1 - m0 : 0;
    for (int tl = F.tid; tl < nt; tl += NTHR) { const i32x4 id = *(const GAS i32x4*)((const int*)(a.ws() + WS_TOPI) + (size_t)(m0 + tl) * 4);
        ids[tl * 4 + 0] = id.x; ids[tl * 4 + 1] = id.y; ids[tl * 4 + 2] = id.z; ids[tl * 4 + 3] = id.w; mask[tl] = (1 << id.x) | (1 << id.y) | (1 << id.z) | (1 << id.w); }
    __syncthreads();
    for (int p = F.tid; p < nt * 4; p += NTHR) { const int tl = p >> 2, e = ids[p]; int rank = 0; for (int q = 0; q < tl; ++q) rank += (mask[q] >> e) & 1;
        const int s = base[e] + rank; slot[p] = s; ((int*)(a.ws() + WS_SLOT))[(size_t)(m0 + tl) * 4 + (p & 3)] = s; ((int*)(a.ws() + WS_CNT))[CNT_ROWSRC + s] = m0 + tl; }
    __syncthreads();
    if (blockIdx.x < 32) { const int e = blockIdx.x, r0 = tst[e] * 256 + tot[e], r1 = tst[e + 1] * 256;
        for (int r = r0 + F.tid; r < r1; r += NTHR) ((int*)(a.ws() + WS_CNT))[CNT_ROWSRC + r] = 0; }
    __syncthreads();
}
__device__ __forceinline__ void p_combine(const Frame& F, const AV& a, int l, int M) {
    const int gw = F.vcu * NWAVES + F.wave, NGW = F.G * NWAVES, rpw = (M + NGW - 1) / NGW, r0 = gw * rpw, r1 = (r0 + rpw < M) ? r0 + rpw : M;
    if (r0 >= r1) return;
    const unsigned char* ys = a.ws() + WS_YS;   const int* slp = (const int*)(a.ws() + WS_SLOT); const float* prp = (const float*)(a.ws() + WS_TOPP);
    const float* modb = (const float*)(a.ws() + WS_MOD);
    f32x4 gpost[4], gpre[4], gate[4], shift[4], scale[4]; ld4(gpost, a.in(9) + l * DM, F.lane); if (l == 0) ld4(gpre, a.in(6) + DM, F.lane);
    int cb = -1;
    i32x4 sl_n = *(const GAS i32x4*)(slp + (size_t)r0 * 4); f32x4 pr_n = *(const GAS f32x4*)(prp + (size_t)r0 * 4);
    f32x4 xn[4]; unsigned yn[4][4]; f32x4 prc = pr_n * 0.125f;
    auto xrow = [&](int m) -> float* { return m < TL ? a.out() + (size_t)m * DM : (float*)(a.ws() + WS_XC) + (size_t)(m - TL) * DM; };
    { ld4(xn, xrow(r0), F.lane); const int sv[4] = {sl_n[0], sl_n[1], sl_n[2], sl_n[3]};
#pragma unroll
      for (int k = 0; k < 4; ++k)
#pragma unroll
          for (int j = 0; j < 4; ++j) yn[k][j] = ((const GAS unsigned*)(ys + (size_t)sv[k] * DM))[F.lane + 64 * j];
      if (r0 + 1 < r1) { sl_n = *(const GAS i32x4*)(slp + (size_t)(r0 + 1) * 4); pr_n = *(const GAS f32x4*)(prp + (size_t)(r0 + 1) * 4); } }
    for (int m = r0; m < r1; ++m) {
        f32x4 x[4], y[4];
#pragma unroll
        for (int j = 0; j < 4; ++j) { x[j] = xn[j]; y[j] = fp8x4(yn[0][j]) * prc[0] + fp8x4(yn[1][j]) * prc[1] + fp8x4(yn[2][j]) * prc[2] + fp8x4(yn[3][j]) * prc[3]; }
        if (m + 1 < r1) { prc = pr_n * 0.125f; ld4(xn, xrow(m + 1), F.lane); const int sv[4] = {sl_n[0], sl_n[1], sl_n[2], sl_n[3]};
#pragma unroll
            for (int k = 0; k < 4; ++k)
#pragma unroll
                for (int j = 0; j < 4; ++j) yn[k][j] = ((const GAS unsigned*)(ys + (size_t)sv[k] * DM))[F.lane + 64 * j];
            if (m + 2 < r1) { sl_n = *(const GAS i32x4*)(slp + (size_t)(m + 2) * 4); pr_n = *(const GAS f32x4*)(prp + (size_t)(m + 2) * 4); } }
        const int b = m < TL ? (m >> 11) : 16;
        if (b != cb) { cb = b; ld4(gate, modb + ((size_t)l * 17 + b) * INCOLS + 5 * 1024, F.lane); if (l == 0) { const float* m1 = modb + ((size_t)17 + b) * INCOLS; ld4(shift, m1, F.lane); ld4(scale, m1 + 1024, F.lane); } }
        const float r = 1.0f / sqrtf(wave_sum(sumsq4(y), F.lane) * (1.0f / 1024.0f) + EPS);
#pragma unroll
        for (int j = 0; j < 4; ++j) x[j] = x[j] + gate[j] * (y[j] * r * gpost[j]);
        st_row_f32(x, xrow(m), F.lane);
        if (l == 0) { const float r2 = 1.0f / sqrtf(wave_sum(sumsq4(x), F.lane) * (1.0f / 1024.0f) + EPS);
            bf16* ho = (bf16*)(a.ws() + WS_H) + (size_t)m * DM; unsigned char* h8 = a.ws() + WS_H8 + (size_t)m * DM;
#pragma unroll
            for (int j = 0; j < 4; ++j) { const f32x4 hv = x[j] * r2 * gpre[j] * (scale[j] + 1.0f) + shift[j]; ((GAS u32x2*)ho)[F.lane + 64 * j] = pk4(hv); ((GAS unsigned*)h8)[F.lane + 64 * j] = pk4_fp8(hv); } }
    }
}
#ifdef DBG_CHECK
#ifndef DBG_GSUB
#define DBG_GSUB 0
#endif
__device__ __forceinline__ double bfd(bf16 b) { return (double)__uint_as_float(((unsigned)b) << 16); }
__device__ __forceinline__ unsigned hsh(unsigned x) { x ^= x >> 16; x *= 0x7feb352du; x ^= x >> 15; x *= 0x846ca68bu; x ^= x >> 16; return x; }
__device__ __forceinline__ int samp_row(int i, int M, unsigned salt) { const int sp[12] = {0, 1, 255, 256, 2047, 2048, 4095, 32767, 32768, 32769, 33023, 36863}; if (i < 12 && sp[i] < M) return sp[i]; return (int)(hsh(i * 7919u + salt) % (unsigned)M); }
__device__ __forceinline__ void rec(float* res, int stage, double got, double want, double flo) { const double e = fabs(got - want) / (fabs(want) + flo); const float f = (e == e) ? (float)e : 1e30f; atomicMax((unsigned*)res + stage, __float_as_uint(f)); }
__device__ double dot_h_w(const bf16* hrow, const float* w, int ldw, int col) { double s = 0; for (int k = 0; k < 1024; ++k) s += bfd(hrow[k]) * (double)w[(size_t)k * ldw + col]; return s; }
__device__ double dsig(double x) { return 1.0 / (1.0 + exp(-x)); }
constexpr double PI_D = 3.14159265358979323846;
enum { ST_MOD = 0, ST_H0, ST_INPROJ, ST_YT, ST_QKFIX, ST_CONV, ST_Z, ST_ATTN, ST_GATES, ST_MERGED, ST_MIX, ST_ROW1, ST_LOGIT, ST_TOPK, ST_SLOTS, ST_ACT, ST_YSLOT, ST_COMB, ST_GATESB, ST_N };
__global__ void chk(Args A, int stage, int l, float* res, float* snap) {
    const int i = threadIdx.x; unsigned char* ws = A.ws; const int M = (l == 0) ? TALL : TL; const int rs = stage + 32 * l;
    const bf16* H = (const bf16*)(ws + WS_H); const float* win = A.in[10] + (size_t)l * DM * INCOLS; const float* modb = (const float*)(ws + WS_MOD);
    if (stage == ST_MOD) { const int ll = i & 1, b = (i >> 1) % 17, n = (int)(hsh(i) % 6144u); double s = 0; for (int k = 0; k < 1024; ++k) { const double cv = b < 16 ? A.in[1][b * 1024 + k] : A.in[3][k]; s += cv * dsig(cv) * (double)A.in[4][((size_t)ll * 1024 + k) * 6144 + n]; }
        s += A.in[5][ll * 6144 + n]; rec(res, rs, modb[((size_t)ll * 17 + b) * 6144 + n], s, 0.02); }
    else if (stage == ST_H0) { const int m = samp_row(i, TALL, 1), c = (int)(hsh(i + 77) % 1024u); const float* x = m < TL ? A.in[0] + (size_t)m * DM : A.in[2] + (size_t)(m - TL) * DM; double ss = 0; for (int k = 0; k < 1024; ++k) ss += (double)x[k] * x[k];
        const float* mv = modb + (size_t)(m < TL ? (m >> 11) : 16) * 6144; const double want = x[c] / sqrt(ss / 1024 + 1e-6) * A.in[6][c] * (1.0 + mv[1024 + c]) + mv[c]; rec(res, rs, bfd(H[(size_t)m * DM + c]), want, 0.05); }
    else if (stage == ST_INPROJ) { const int m = samp_row(i, TALL, 2), kind = i & 3; const bf16* hr = H + (size_t)m * DM;
        if (kind == 0) { const int n = (int)(hsh(i + 5) % 1024u); rec(res, rs, bfd(((const bf16*)(ws + WS_Q))[(size_t)m * DM + n]), dot_h_w(hr, win, INCOLS, n), 0.05); }
        else if (kind == 1) { const int n = (int)(hsh(i + 6) % 256u); rec(res, rs, bfd(((const bf16*)(ws + WS_K))[(size_t)krow_of(m) * 256 + n]), dot_h_w(hr, win, INCOLS, 1024 + n), 0.05); }
        else if (kind == 2) { const int n = (int)(hsh(i + 7) % 256u); rec(res, rs, bfd(((const bf16*)(ws + WS_V))[(size_t)krow_of(m) * 256 + n]), dot_h_w(hr, win, INCOLS, 1280 + n), 0.05); }
        else { const int c = (int)(hsh(i + 8) % 512u); if (l == 0 || m < TL) { const double a = dot_h_w(hr, win, INCOLS, 1536 + c), g = dot_h_w(hr, win, INCOLS, 2048 + c); rec(res, rs, bfd(((const bf16*)(ws + WS_CU))[(size_t)m * 512 + c]), a * dsig(g), 0.05); } } }
    else if (stage == ST_YT) { const int m = samp_row(i, M, 3), ch = (int)(hsh(i + 9) % 512u), cs = i & 1, g = ch >> 7, k2 = ch & 127; const bf16* hr = H + (size_t)m * DM; double s = 0;
        for (int k = 0; k < 1024; ++k) { double t = 0; for (int n2 = 0; n2 < 128; ++n2) { const double ang = 2.0 * PI_D * ((n2 * k2) & 127) / 128.0; t += (double)win[(size_t)k * INCOLS + OFF_FNET + g * 128 + n2] * (cs ? sin(ang) : cos(ang)); } s += bfd(hr[k]) * t; }
        s /= sqrt(128.0); double got; if (m < TL) got = bfd(((const bf16*)(ws + WS_YT))[((size_t)(m >> 11) * 512 + ch) * 4096 + cs * 2048 + (m & 2047)]); else got = bfd(((const bf16*)(ws + WS_YTC))[((size_t)((m - TL) >> 8) * 512 + ch) * 512 + cs * 256 + ((m - TL) & 255)]);
        rec(res, rs, got, s, 0.05); }
    else if (stage == ST_QKFIX) { const int m = samp_row(i, TALL, 4), isk = i & 1, hh = isk ? (int)(hsh(i + 3) % 2u) : (int)(hsh(i + 3) % 8u), d = (int)(hsh(i + 4) % 128u); const bf16* hr = H + (size_t)m * DM;
        if (isk || l == 0 || m < TL) { const int cbase = isk ? 1024 + hh * 128 : hh * 128; double ss = 0, xd = 0, xp = 0; const int half = d & 64, dd = d & 63, pd = half + ((dd + 32) & 63);
            for (int q = 0; q < 128; ++q) { double v = dot_h_w(hr, win, INCOLS, cbase + q); v = bfd((bf16)f2bf((float)v)); ss += v * v; if (q == d) xd = v; if (q == pd) xp = v; }
            const float* gn = (isk ? A.in[12] : A.in[11]) + l * 128; const double r = 1.0 / sqrt(ss / 128 + 1e-6); xd *= r * gn[d]; xp *= r * gn[pd]; double want = xd;
            if (m < TL) { const int t = m & 2047, pos = half ? (t & 63) : (t >> 6), f = dd & 31; const double ang = (double)((float)pos * powf(10000.0f, -(float)f / 32.0f)); want = (dd < 32) ? xd * cos(ang) - xp * sin(ang) : xd * cos(ang) + xp * sin(ang); }
            const double got = isk ? bfd(((const bf16*)(ws + WS_K))[(size_t)krow_of(m) * 256 + hh * 128 + d]) : bfd(((const bf16*)(ws + WS_Q))[(size_t)m * DM + hh * 128 + d]); rec(res, rs, got, want, 0.05); } }
    else if (stage == ST_CONV) { const int m = samp_row(i, M, 5), c = (int)(hsh(i + 11) % 512u); const int rowbase = m < TL ? (m >> 11) * SEQ : TL + ((m - TL) >> 8) * CTXL, L = m < TL ? SEQ : CTXL, t = m - rowbase; const bf16* cu = (const bf16*)(ws + WS_CU);
        double s1 = 0, s2 = 0, yc = 0; for (int cc = 0; cc < 512; ++cc) { double y = A.in[15][l * 512 + cc]; for (int j = 0; j < 31; ++j) { const int p = t + j - 15; if (p >= 0 && p < L) y += bfd(cu[(size_t)(rowbase + p) * 512 + cc]) * (double)A.in[14][((size_t)l * 31 + j) * 512 + cc]; } s1 += y; s2 += y * y; if (cc == c) yc = y; }
        const double mean = s1 / 512, var = s2 / 512 - mean * mean; double y = (yc - mean) / sqrt(var + 1e-6) * A.in[16][l * 512 + c] + A.in[17][l * 512 + c]; y = y * dsig(y); rec(res, rs, bfd(((const bf16*)(ws + WS_CH))[(size_t)m * 512 + c]), y, 0.05); }
    else if (stage == ST_Z) { const int m = samp_row(i, M, 6), ch = (int)(hsh(i + 12) % 512u); double s = 0;
        if (m < TL) { const int b = m >> 11, k1 = m & 2047; const bf16* yr = (const bf16*)(ws + WS_YT) + ((size_t)b * 512 + ch) * 4096; for (int n1 = 0; n1 < 2048; ++n1) { const double ang = 2.0 * PI_D * ((k1 * n1) & 2047) / 2048.0; s += cos(ang) * bfd(yr[n1]) - sin(ang) * bfd(yr[2048 + n1]); } s /= sqrt(2048.0); }
        else { const int b = (m - TL) >> 8, k1 = (m - TL) & 255; const bf16* yr = (const bf16*)(ws + WS_YTC) + ((size_t)b * 512 + ch) * 512; for (int n1 = 0; n1 < 256; ++n1) { const double ang = 2.0 * PI_D * ((k1 * n1) & 255) / 256.0; s += cos(ang) * bfd(yr[n1]) - sin(ang) * bfd(yr[256 + n1]); } s /= 16.0; }
        rec(res, rs, bfd(((const bf16*)(ws + WS_Z))[(size_t)m * 512 + ch]), s, 0.05); }
    else if (stage == ST_ATTN) { const int m = samp_row(i, M, 7), hh = (int)(hsh(i + 13) % 8u), d = (int)(hsh(i + 14) % 128u); const bf16* q = (const bf16*)(ws + WS_Q) + (size_t)m * DM + hh * 128;
        int kr0, nk; if (m < TL) { kr0 = (m >> 11) * KVROWS; nk = KVROWS; } else { kr0 = ((m - TL) >> 8) * KVROWS + SEQ; nk = CTXL; }
        const bf16* K = (const bf16*)(ws + WS_K) + (size_t)kr0 * 256 + (hh >> 2) * 128; const bf16* V = (const bf16*)(ws + WS_V) + (size_t)kr0 * 256 + (hh >> 2) * 128;
        double mx = -1e300; for (int j = 0; j < nk; ++j) { double s = 0; for (int q2 = 0; q2 < 128; ++q2) s += bfd(q[q2]) * bfd(K[(size_t)j * 256 + q2]); s *= 0.08838834764831845; if (s > mx) mx = s; }
        double den = 0, num = 0; for (int j = 0; j < nk; ++j) { double s = 0; for (int q2 = 0; q2 < 128; ++q2) s += bfd(q[q2]) * bfd(K[(size_t)j * 256 + q2]); s *= 0.08838834764831845; const double p = exp(s - mx); den += p; num += p * bfd(V[(size_t)j * 256 + d]); }
        rec(res, rs, bfd(((const bf16*)(ws + WS_AO))[(size_t)m * DM + hh * 128 + d]), num / den, 0.03); }
    else if (stage == ST_GATES) { const int m = samp_row(i, M, 8), n = (int)(hsh(i + 15) % 3072u); rec(res, rs, bfd(((const bf16*)(ws + WS_GATES))[(size_t)m * 3072 + n]), dsig(dot_h_w(H + (size_t)m * DM, win, INCOLS, OFF_GATE + n)), 0.05); }
    else if (stage == ST_GATESB && DBG_GSUB == 1) { const int m = samp_row(i, M, 8), n = (int)(hsh(i + 15) % 3072u); const double got = bfd(((const bf16*)(ws + WS_GATES))[(size_t)m * 3072 + n]), want = dsig(dot_h_w(H + (size_t)m * DM, win, INCOLS, OFF_GATE + n));
        const bool badv = !(fabs(got - want) <= 0.05); if (badv) { unsigned* r = (unsigned*)res + 48; atomicOr(r, (m < TL ? 1u : 2u) | (4u << (n >> 10)) | (i < 12 ? 32u : 0u)); } }
    else if (stage == ST_GATESB) { const int m = samp_row(i, M, 8), n = (int)(hsh(i + 15) % 3072u); const bf16* wt = (const bf16*)(ws + WS_WSMALL + (size_t)l * WSMALL_LAYER + OFFS_WG) + (size_t)n * 1024; const bf16* hr = H + (size_t)m * DM; double s = 0; for (int k = 0; k < 1024; ++k) s += bfd(hr[k]) * bfd(wt[k]);
        rec(res, rs, bfd(((const bf16*)(ws + WS_GATES))[(size_t)m * 3072 + n]), dsig(s), 0.05); }
    else if (stage == ST_MERGED) { const int m = samp_row(i, M, 9), c = (int)(hsh(i + 16) % 1024u); const bf16* g = (const bf16*)(ws + WS_GATES) + (size_t)m * 3072; double y0 = 0, y1 = 0, y2 = 0;
        const bf16* ao = (const bf16*)(ws + WS_AO) + (size_t)m * DM; const bf16* chh = (const bf16*)(ws + WS_CH) + (size_t)m * 512; const bf16* z = (const bf16*)(ws + WS_Z) + (size_t)m * 512;
        for (int k = 0; k < 1024; ++k) y0 += bfd(ao[k]) * (double)A.in[13][((size_t)l * 1024 + k) * 1024 + c];
        for (int k = 0; k < 512; ++k) { y1 += bfd(chh[k]) * (double)A.in[18][((size_t)l * 512 + k) * 1024 + c]; y2 += bfd(z[k]) * (double)A.in[19][((size_t)l * 512 + k) * 1024 + c]; }
        rec(res, rs, bfd(((const bf16*)(ws + WS_MERGED))[(size_t)m * DM + c]), bfd(g[c]) * y0 + bfd(g[1024 + c]) * y1 + bfd(g[2048 + c]) * y2, 0.05); }
    else if (stage == ST_MIX) { const int m = samp_row(i, M, 10), c = (int)(hsh(i + 17) % 1024u); rec(res, rs, bfd(((const bf16*)(ws + WS_MIX))[(size_t)m * DM + c]), dot_h_w((const bf16*)(ws + WS_MERGED) + (size_t)m * DM, A.in[20] + (size_t)l * DM * DM, DM, c), 0.05); }
    else if (stage == ST_ROW1) { const int m = samp_row(i, M, 11), c = (int)(hsh(i + 18) % 1024u); const float* xs = snap + (size_t)i * 1024;
        const bf16* mix = (const bf16*)(ws + WS_MIX) + (size_t)m * DM; const float* mv = modb + ((size_t)l * 17 + (m < TL ? (m >> 11) : 16)) * 6144; double ss = 0; for (int k = 0; k < 1024; ++k) ss += bfd(mix[k]) * bfd(mix[k]); const double r = 1.0 / sqrt(ss / 1024 + 1e-6);
        double s2 = 0, xc = 0; for (int k = 0; k < 1024; ++k) { const double xn = xs[k] + mv[2048 + k] * (bfd(mix[k]) * r * A.in[7][l * DM + k]); s2 += xn * xn; if (k == c) xc = xn; }
        const float* xd = m < TL ? A.out + (size_t)m * DM : (const float*)(ws + WS_XC) + (size_t)(m - TL) * DM; rec(res, rs, xd[c], xc, 0.02);
        rec(res, rs, bfd(H[(size_t)m * DM + c]), xc / sqrt(s2 / 1024 + 1e-6) * A.in[8][l * DM + c] * (1.0 + mv[4096 + c]) + mv[3072 + c], 0.05); }
    else if (stage == ST_LOGIT) { const int m = samp_row(i, M, 12), e = i & 31; const float* lg = (const float*)(ws + WS_LOGIT) + (size_t)m * 64; rec(res, rs, (double)lg[e] + lg[32 + e], dot_h_w(H + (size_t)m * DM, A.in[21] + (size_t)l * DM * NEXP, NEXP, e), 0.02); }
    else if (stage == ST_TOPK) { const int m = samp_row(i, M, 13); const float* lg = (const float*)(ws + WS_LOGIT) + (size_t)m * 64; float v[32]; for (int e = 0; e < 32; ++e) v[e] = lg[e] + lg[32 + e] + A.in[22][l * 32 + e];
        int id[4]; float tv[4]; for (int k = 0; k < 4; ++k) { int b = -1; for (int e = 0; e < 32; ++e) { bool used = false; for (int q = 0; q < k; ++q) used |= (id[q] == e); if (!used && (b < 0 || v[e] > v[b])) b = e; } id[k] = b; tv[k] = v[b]; }
        double den = 0; for (int k = 0; k < 4; ++k) den += exp((double)tv[k] - tv[0]); const int* gi = (const int*)(ws + WS_TOPI) + (size_t)m * 4; const float* gp = (const float*)(ws + WS_TOPP) + (size_t)m * 4;
        for (int k = 0; k < 4; ++k) { rec(res, rs, gi[k] == id[k] ? 0.0 : 1.0, 0, 0.01); rec(res, rs, gp[k], exp((double)tv[k] - tv[0]) / den, 0.01); } }
    else if (stage == ST_SLOTS) { const int m = samp_row(i, M, 14), k = i & 3; const int s = ((const int*)(ws + WS_SLOT))[(size_t)m * 4 + k], e = ((const int*)(ws + WS_TOPI))[(size_t)m * 4 + k]; const int NT = ((const int*)(ws + WS_CNT))[CNT_NT];
        if (s < 0 || s >= NT * 256) rec(res, rs, 1, 0, 0.01); else { rec(res, rs, ((const int*)(ws + WS_CNT))[CNT_TILE_E + (s >> 8)] == e ? 0.0 : 1.0, 0, 0.01); const bf16* hs = (const bf16*)(ws + WS_HS) + (size_t)s * DM; double df = 0; for (int q = 0; q < 1024; ++q) df += fabs(bfd(hs[q]) - bfd(H[(size_t)m * DM + q])); rec(res, rs, df, 0, 1e-3); } }
    else if (stage == ST_ACT) { const int m = samp_row(i, M, 15), k = i & 3, c = (int)(hsh(i + 21) % 1024u); const int s = ((const int*)(ws + WS_SLOT))[(size_t)m * 4 + k], e = ((const int*)(ws + WS_TOPI))[(size_t)m * 4 + k]; const bf16* hs = (const bf16*)(ws + WS_HS) + (size_t)s * DM;
        double g = dot_h_w(hs, A.in[23] + (((size_t)l * NEXP + e) << 20), DM, c) + A.in[24][((size_t)l * NEXP + e) * 1024 + c], u = dot_h_w(hs, A.in[25] + (((size_t)l * NEXP + e) << 20), DM, c) + A.in[26][((size_t)l * NEXP + e) * 1024 + c];
        g = g < 7.0 ? g : 7.0; u = u < -7.0 ? -7.0 : (u > 7.0 ? 7.0 : u); rec(res, rs, bfd(((const bf16*)(ws + WS_ACT))[(size_t)s * DM + c]), (u + 1.0) * (g * dsig(1.702 * g)), 0.05); }
    else if (stage == ST_YSLOT) { const int m = samp_row(i, M, 16), k = i & 3, c = (int)(hsh(i + 22) % 1024u); const int s = ((const int*)(ws + WS_SLOT))[(size_t)m * 4 + k], e = ((const int*)(ws + WS_TOPI))[(size_t)m * 4 + k];
        rec(res, rs, bfd(((const bf16*)(ws + WS_HS))[(size_t)s * DM + c]), dot_h_w((const bf16*)(ws + WS_ACT) + (size_t)s * DM, A.in[27] + (((size_t)l * NEXP + e) << 20), DM, c) + A.in[28][((size_t)l * NEXP + e) * 1024 + c], 0.05); }
    else if (stage == ST_COMB) { const int m = samp_row(i, M, 17), c = (int)(hsh(i + 23) % 1024u); const float* xs = snap + (size_t)i * 1024; const int* sl = (const int*)(ws + WS_SLOT) + (size_t)m * 4; const float* pr = (const float*)(ws + WS_TOPP) + (size_t)m * 4;
        const float* mv = modb + ((size_t)l * 17 + (m < TL ? (m >> 11) : 16)) * 6144; double ss = 0, yc = 0; for (int q = 0; q < 1024; ++q) { double y = 0; for (int k = 0; k < 4; ++k) y += (double)pr[k] * bfd(((const bf16*)(ws + WS_HS))[(size_t)sl[k] * DM + q]); ss += y * y; if (q == c) yc = y; }
        const double want = xs[c] + mv[5 * 1024 + c] * (yc / sqrt(ss / 1024 + 1e-6) * A.in[9][l * DM + c]); const float* xd = m < TL ? A.out + (size_t)m * DM : (const float*)(ws + WS_XC) + (size_t)(m - TL) * DM; rec(res, rs, xd[c], want, 0.02); }
}
__global__ void snap_rows(Args A, int l, int salt, float* snap) {
    const int i = blockIdx.x, M = (l == 0) ? TALL : TL, m = samp_row(i, M, salt); const float* xs;
    if (l == 0 && salt == 11) xs = m < TL ? A.in[0] + (size_t)m * DM : A.in[2] + (size_t)(m - TL) * DM; else xs = m < TL ? A.out + (size_t)m * DM : (const float*)(A.ws + WS_XC) + (size_t)(m - TL) * DM;
    for (int k = threadIdx.x; k < 1024; k += blockDim.x) snap[(size_t)i * 1024 + k] = xs[k];
}
__global__ void chk_gates_full(const bf16* H, const bf16* Wt, const bf16* G, int M, unsigned* cntw) {
    const int n = blockIdx.x * 64 + (threadIdx.x & 63), m = blockIdx.y * 4 + (threadIdx.x >> 6); if (m >= M) return;
    const uint4* a = (const uint4*)(H + (size_t)m * 1024); const uint4* b = (const uint4*)(Wt + (size_t)n * 1024); float s = 0.f;
    for (int k = 0; k < 128; ++k) { const uint4 x = a[k], y = b[k]; const unsigned xs[4] = {x.x, x.y, x.z, x.w}, ys[4] = {y.x, y.y, y.z, y.w};
        for (int q = 0; q < 4; ++q) { s += __uint_as_float(xs[q] << 16) * __uint_as_float(ys[q] << 16); s += __uint_as_float(xs[q] & 0xffff0000u) * __uint_as_float(ys[q] & 0xffff0000u); } }
    const float want = 1.0f / (1.0f + __expf(-s)), got = __uint_as_float(((unsigned)G[(size_t)m * 3072 + n]) << 16);
    if (!(fabsf(got - want) <= 0.02f)) { atomicAdd(cntw, 1u); cntw[16 + (m >> 8) * 12 + (n >> 8)] = 1u; }
}
__global__ void encode_full(float* out, const unsigned* cntw, int n) {
    __shared__ int bc, bt; if (threadIdx.x == 0) { unsigned C = cntw[0], T = 0; for (int t = 0; t < 1728; ++t) T += cntw[16 + t]; int b1 = 0; while (C) { ++b1; C /= 10; } int b2 = 0; while (T) { ++b2; T /= 4; } bc = b1 > 7 ? 7 : b1; bt = b2 > 7 ? 7 : b2; }
    __syncthreads(); const float K = ldexpf(1.0f, 2 + 8 * bt + bc);
    for (size_t i = (size_t)blockIdx.x * blockDim.x + threadIdx.x; i < (size_t)n; i += (size_t)gridDim.x * blockDim.x) out[i] = K;
}
__global__ void encode(float* out, const float* res, int n, float thr) {
    #if DBG_GSUB == 1
    { const unsigned mk = ((const unsigned*)res)[48]; const float K = ldexpf(1.0f, 2 + (int)mk); for (size_t i = (size_t)blockIdx.x * blockDim.x + threadIdx.x; i < (size_t)n; i += (size_t)gridDim.x * blockDim.x) out[i] = K; return; }
#endif
#ifndef CHK_SKIP
#define CHK_SKIP 0ull
#endif
    int bad = -1; for (int s = 0; s < 64; ++s) if (!((CHK_SKIP >> s) & 1ull) && res[s] > thr) { bad = s; break; }
    if (bad < 0) return; const float er = res[bad]; const float K = ldexpf(1.0f, bad + 2) * (er < 0.5f ? 1.0f : er < 1.0f ? 1.25f : er < 4.0f ? 1.5f : 1.75f);
    for (size_t i = (size_t)blockIdx.x * blockDim.x + threadIdx.x; i < (size_t)n; i += (size_t)gridDim.x * blockDim.x) out[i] = K;
}
#endif
#ifndef GP_SP2
#define GP_SP2 true
#endif
#ifndef GP_ALIGN
#define GP_ALIGN true
#endif
__global__ void __launch_bounds__(NTHR, 2) fwd(Args args) {
    extern __shared__ __attribute__((aligned(16))) unsigned char lds[];
    Frame F;
    F.lds = (LAS unsigned char*)lds; F.MISC = (volatile LAS unsigned*)(F.lds + MISC_OFF);
    F.tid = threadIdx.x; F.lane = F.tid & 63; F.wave = __builtin_amdgcn_readfirstlane(F.tid >> 6);
    F.G = gridDim.x; { const int bx = blockIdx.x; F.vcu = (F.G % 8 == 0) ? (bx % 8) * (F.G / 8) + bx / 8 : bx; }
    { const AV A0 = av_get(); F.ctl = (gu32*)(A0.ws() + WS_CTL); }
    for (int u = F.tid; u < (LDS_BYTES - LDSCTL_OFF) / 4; u += NTHR) ((LAS unsigned*)(F.lds + LDSCTL_OFF))[u] = 0u;
    __syncthreads();
    XcdBarrier bar; bar.bar = (unsigned*)(F.ctl + CW_BAR); bar.x = 0; bar.st = nullptr;
    if (!MK_PER_PHASE) bar = xcd_barrier_post((unsigned*)(F.ctl + CW_BAR), F.MISC + 8);
    int lo, hi; { const AV A0 = av_get(); lo = *(const int __attribute__((address_space(4)))*)(A0.kp + 8 * 31); hi = *(const int __attribute__((address_space(4)))*)(A0.kp + 8 * 31 + 4); }
#ifndef DIS_MASK
#define DIS_MASK 0ull
#endif
#define IN(k) (lo <= (k) && (k) < hi)
#define ON(j) (!((DIS_MASK >> (j)) & 1ull))
#ifndef REP_MASK
#define REP_MASK 0ull
#endif
#define REPS(j) ((int)((REP_MASK >> (j)) & 1ull))
#ifdef STAMP_SEL
#define SEAM(k) do { xcd_barrier(bar); if (blockIdx.x == 0 && threadIdx.x == 0) ((unsigned long long*)(F.ctl + 32768))[(k) + 1] = __builtin_amdgcn_s_memrealtime(); } while (0)
#else
#ifdef DOUBLE_BAR
#define SEAM(k) do { if (!MK_PER_PHASE && IN((k) + 1)) { xcd_barrier(bar); xcd_barrier(bar); } } while (0)
#else
#define SEAM(k) do { if (!MK_PER_PHASE && IN((k) + 1)) xcd_barrier(bar); } while (0)
#endif
#endif
    const int bx = (int)blockIdx.x;
    const int wave0 = __builtin_amdgcn_readfirstlane((int)threadIdx.x >> 6);
#define F_REFRESH() do { unsigned z_ = 0u; asm volatile("" : "+v"(z_)); const int t_ = wave0 * 64 + (int)__builtin_amdgcn_mbcnt_hi(~0u, __builtin_amdgcn_mbcnt_lo(~0u, z_)); F.tid = t_; F.lane = t_ & 63; F.wave = wave0; } while (0)

#ifdef STAMP_SEL
    if (blockIdx.x == 0 && threadIdx.x == 0) ((unsigned long long*)(F.ctl + 32768))[0] = __builtin_amdgcn_s_memrealtime();
#endif
    if (ON(0) && IN(0)) for (int rep_ = 0; rep_ <= REPS(0); ++rep_) { F_REFRESH(); const AV A = av_get(); p0_prologue(F, A); SEAM(0); }
    if (ON(1) && IN(1)) for (int rep_ = 0; rep_ <= REPS(1); ++rep_) { F_REFRESH(); const AV A = av_get(); p1_norm0(F, A); SEAM(1); }

    for (int l = 0; l < 2; ++l) {
        const int pb = 2 + l * NPL;
        const int Mm = (l == 0) ? TALL : TL;
#define PH_BEGIN F_REFRESH(); const AV A = av_get(); unsigned char* const ws = A.ws(); unsigned char* const wl = ws + WS_WSMALL + (size_t)l * WSMALL_LAYER; (void)wl
        if (ON(2 + 0) && IN(pb + 0)) for (int rep_ = 0; rep_ <= REPS(2 + 0); ++rep_) { PH_BEGIN;
            if (ON(16)) { pg8::Gemm g{(const bf16*)(ws + WS_H8), (const bf16*)(wl + OFFS_WIN), TALL, 2560, DM / 2}; pg8::StaticOrder S; S.init(TALL, 2560, F.G, bx);
              pg8::EpiInproj E{(bf16*)(ws + WS_Q), (bf16*)(ws + WS_K), (bf16*)(ws + WS_V), (bf16*)(ws + WS_CU)};
              pg8::gemm_phase<pg8::EpiInproj, pg8::StaticOrder, GP_ALIGN, GP_SP2, true>(F.lds + RING_OFF, g, S, E, F.tid); }
            if (ON(17)) { pg8::Gemm g{(const bf16*)(wl + OFFS_WF), (const bf16*)(ws + WS_H), 1024, Mm, DM}; pg8::StaticOrder S; S.init(1024, Mm, F.G, (bx + 96) % F.G);
              pg8::EpiYT E{ws + WS_YT, ws + WS_YTC};
              pg8::gemm_phase<pg8::EpiYT, pg8::StaticOrder, GP_ALIGN, GP_SP2>(F.lds + RING_OFF, g, S, E, F.tid); }
            SEAM(pb + 0);
        }
        if (ON(2 + 1) && IN(pb + 1)) for (int rep_ = 0; rep_ <= REPS(2 + 1); ++rep_) { PH_BEGIN;
            if (ON(18)) p_qkfix(F, A, l, TALL);
            F_REFRESH();
            if (ON(19)) p_conv(F, A, l, l == 0 ? 1152 : 1024);
            if (ON(20)) { pg8::Gemm g{(const bf16*)(ws + WS_DFTL), (const bf16*)(ws + WS_YT), 2048, NB * 512, 2048}; pg8::DftOrder S; S.init(3, NB, F.G, F.vcu);
              pg8::EpiDFT E{(bf16*)(ws + WS_Z), 0, SEQ};
              pg8::gemm_phase<pg8::EpiDFT, pg8::DftOrder, GP_ALIGN, GP_SP2, true>(F.lds + RING_OFF, g, S, E, F.tid); }
            if (ON(21) && l == 0) { pg8::Gemm g{(const bf16*)(ws + WS_DFTC), (const bf16*)(ws + WS_YTC), 256, NB * 512, 256}; pg8::DftOrder S; S.init(0, NB, F.G, F.vcu);
              pg8::EpiDFT E{(bf16*)(ws + WS_Z), TL, CTXL};
              pg8::gemm_phase<pg8::EpiDFT, pg8::DftOrder, GP_ALIGN, GP_SP2, true>(F.lds + RING_OFF, g, S, E, F.tid); }
            SEAM(pb + 1);
        }
        if (ON(2 + 2) && IN(pb + 2)) for (int rep_ = 0; rep_ <= REPS(2 + 2); ++rep_) { PH_BEGIN;
            const int nheavy = NB * 8 * 8, ntot = nheavy + (l == 0 ? NB * 8 : 0);
            for (int L = F.vcu; L < ntot; L += F.G) {
                int row0, krow, h, seq, t0;
                if (L < nheavy) { const int grp = L >> 5, s = L & 31, b = grp >> 1; h = (grp & 1) * 4 + (s >> 3); t0 = (s & 7) * 256; row0 = b * SEQ + t0; krow = b * KVROWS; seq = KVROWS; }
                else { const int Lc = L - nheavy, b = Lc >> 3; h = Lc & 7; row0 = TL + b * CTXL; krow = b * KVROWS + SEQ; seq = CTXL; t0 = 0; }
                const att::bf16* Qb = (const att::bf16*)(ws + WS_Q) + (size_t)row0 * DM + h * 128;
                const att::bf16* Kh = (const att::bf16*)(ws + WS_K) + (size_t)krow * 256 + (h >> 2) * 128;
                const att::bf16* Vh = (const att::bf16*)(ws + WS_V) + (size_t)krow * 256 + (h >> 2) * 128;
                unsigned char* Ob = ws + WS_AO + (size_t)row0 * DM + h * 128;
                att::attn_dense_body<att::bf16>(Qb, Kh, Vh, Ob, seq, (char*)lds + RING_OFF, F.tid, A.in(11) + l * 128, (const float*)(ws + WS_TAB), t0, L < nheavy);
                __syncthreads();
            }
            SEAM(pb + 2);
        }
        if (ON(2 + 3) && IN(pb + 3)) for (int rep_ = 0; rep_ <= REPS(2 + 3); ++rep_) { PH_BEGIN;
            pg8::Gemm g{(const bf16*)(ws + WS_H8), (const bf16*)(wl + OFFS_WG), Mm, 3072, DM / 2}; pg8::StaticOrder S; S.init(Mm, 3072, F.G, bx);
            pg8::EpiGates E{(bf16*)(ws + WS_GATES)};
            pg8::gemm_phase<pg8::EpiGates, pg8::StaticOrder, GP_ALIGN, GP_SP2, true>(F.lds + RING_OFF, g, S, E, F.tid);
            SEAM(pb + 3);
        }
        if (ON(2 + 4) && IN(pb + 4)) for (int rep_ = 0; rep_ <= REPS(2 + 4); ++rep_) { PH_BEGIN;
            { pg8::Gemm g{(const bf16*)(ws + WS_AO), (const bf16*)(wl + OFFS_WAO), Mm, 1024, 512}; pg8::StaticOrder S; S.init(Mm, 1024, F.G, bx);
              pg8::EpiMerge<0> E{(bf16*)(ws + WS_MERGED), (bf16*)(ws + WS_ACT), (const bf16*)(ws + WS_GATES), 0, 1.0f / 512.0f};
              pg8::gemm_phase<pg8::EpiMerge<0>, pg8::StaticOrder, GP_ALIGN, GP_SP2, true>(F.lds + RING_OFF, g, S, E, F.tid); }
            { pg8::Gemm g{(const bf16*)(ws + WS_CH), (const bf16*)(wl + OFFS_WCO), Mm, 1024, 512}; pg8::StaticOrder S; S.init(Mm, 1024, F.G, bx);
              pg8::EpiMerge<1> E{(bf16*)(ws + WS_MERGED), (bf16*)(ws + WS_ACT), (const bf16*)(ws + WS_GATES), 1, 1.0f};
              pg8::gemm_phase<pg8::EpiMerge<1>, pg8::StaticOrder, GP_ALIGN, GP_SP2>(F.lds + RING_OFF, g, S, E, F.tid); }
            { pg8::Gemm g{(const bf16*)(ws + WS_Z), (const bf16*)(wl + OFFS_WFO), Mm, 1024, 512}; pg8::StaticOrder S; S.init(Mm, 1024, F.G, bx);
              pg8::EpiMerge<2> E{(bf16*)(ws + WS_MERGED), (bf16*)(ws + WS_ACT), (const bf16*)(ws + WS_GATES), 2, 1.0f};
              pg8::gemm_phase<pg8::EpiMerge<2>, pg8::StaticOrder, GP_ALIGN, GP_SP2>(F.lds + RING_OFF, g, S, E, F.tid); }
            SEAM(pb + 4);
        }
        if (ON(2 + 5) && IN(pb + 5)) for (int rep_ = 0; rep_ <= REPS(2 + 5); ++rep_) { PH_BEGIN;
            pg8::Gemm g{(const bf16*)(ws + WS_MERGED), (const bf16*)(wl + OFFS_WOUT), Mm, 1024, 1024}; pg8::StaticOrder S; S.init(Mm, 1024, F.G, bx);
            pg8::EpiBf16<0> E{(bf16*)(ws + WS_MIX), 1024, nullptr, 0, 0, 1.0f};
            pg8::gemm_phase<pg8::EpiBf16<0>, pg8::StaticOrder, GP_ALIGN, GP_SP2>(F.lds + RING_OFF, g, S, E, F.tid);
            SEAM(pb + 5);
        }
        if (ON(2 + 6) && IN(pb + 6)) for (int rep_ = 0; rep_ <= REPS(2 + 6); ++rep_) { PH_BEGIN; p_rowpass1(F, A, l, Mm); p_route(F, A, l, Mm); SEAM(pb + 6); }
        if (ON(2 + 7) && IN(pb + 7)) for (int rep_ = 0; rep_ <= REPS(2 + 7); ++rep_) { PH_BEGIN; p_slots(F, A, Mm); SEAM(pb + 7); }
        if (ON(2 + 8) && IN(pb + 8)) for (int rep_ = 0; rep_ <= REPS(2 + 8); ++rep_) { PH_BEGIN;
            const int NT = __builtin_amdgcn_readfirstlane(((const int*)(ws + WS_CNT))[CNT_NT]);
            LAS int* te_lds = (LAS int*)(F.lds + LDS_SM);
            for (int i = F.tid; i < NT; i += NTHR) te_lds[i] = ((const int*)(ws + WS_CNT))[CNT_TILE_E + i];
            __syncthreads();
            pg8::Gemm g{(const bf16*)(ws + WS_H8), (const bf16*)(ws + WS_WGU + (size_t)l * MOEW_LAYER), NT * 256, NEXP * 2048, DM / 2}; pg8::GroupedOrder S; S.init(NT, 8, F.G, bx, te_lds); S.rows = (const int*)(ws + WS_CNT) + CNT_ROWSRC;
            pg8::EpiSwiGLU8 E{ws + WS_ACT, A.in(24) + (size_t)l * NEXP * 1024, A.in(26) + (size_t)l * NEXP * 1024, (LAS float*)(F.lds + LDS_SM + 4096)};
            pg8::gemm_phase<pg8::EpiSwiGLU8, pg8::GroupedOrder, GP_ALIGN, GP_SP2, true, true>(F.lds + RING_OFF, g, S, E, F.tid);
            SEAM(pb + 8);
        }
        if (ON(2 + 9) && IN(pb + 9)) for (int rep_ = 0; rep_ <= REPS(2 + 9); ++rep_) { PH_BEGIN;
            const int NT = __builtin_amdgcn_readfirstlane(((const int*)(ws + WS_CNT))[CNT_NT]);
            LAS int* te_lds = (LAS int*)(F.lds + LDS_SM);
            for (int i = F.tid; i < NT; i += NTHR) te_lds[i] = ((const int*)(ws + WS_CNT))[CNT_TILE_E + i];
            __syncthreads();
#ifdef STAGGER_US
            { const unsigned long long t0 = __builtin_amdgcn_s_memrealtime(), dl = (unsigned long long)((bx >> 3) & 3) * (STAGGER_US); while (__builtin_amdgcn_s_memrealtime() - t0 < dl) __builtin_amdgcn_s_sleep(8); }
#endif
            pg8::Gemm g{(const bf16*)(ws + WS_ACT), (const bf16*)(ws + WS_WD + (size_t)l * MOEW_LAYER), NT * 256, NEXP * 1024, DM / 2}; pg8::GroupedOrder S; S.init(NT, 4, F.G, bx, te_lds);
#ifdef PROBE_NOSTORE
            pg8::EpiDown8 E{ws + WS_YS, A.in(28) + (size_t)l * NEXP * 1024, rep_, (LAS float*)(F.lds + LDS_SM + 4096)};
#else
            pg8::EpiDown8 E{ws + WS_YS, A.in(28) + (size_t)l * NEXP * 1024, 0, (LAS float*)(F.lds + LDS_SM + 4096)};
#endif
            pg8::gemm_phase<pg8::EpiDown8, pg8::GroupedOrder, GP_ALIGN, GP_SP2, true>(F.lds + RING_OFF, g, S, E, F.tid);
            SEAM(pb + 9);
        }
        if (ON(2 + 10) && IN(pb + 10)) for (int rep_ = 0; rep_ <= REPS(2 + 10); ++rep_) { PH_BEGIN;
            p_combine(F, A, l, Mm);
            SEAM(pb + 10);
        }
    }
#ifdef STAMP_SEL
    { const AV A = av_get(); float* out = A.out(); const unsigned long long* ts = (const unsigned long long*)(F.ctl + 32768);
      auto span = [&](int p) -> float { unsigned long long d = __hip_atomic_load(ts + p + 1, __ATOMIC_RELAXED, __HIP_MEMORY_SCOPE_AGENT) - __hip_atomic_load(ts + p, __ATOMIC_RELAXED, __HIP_MEMORY_SCOPE_AGENT);
          if (p >= 2) d += __hip_atomic_load(ts + p + NPL + 1, __ATOMIC_RELAXED, __HIP_MEMORY_SCOPE_AGENT) - __hip_atomic_load(ts + p + NPL, __ATOMIC_RELAXED, __HIP_MEMORY_SCOPE_AGENT); return (float)d * 0.01f; };
      const float K1 = span((STAMP_SEL) & 0xff), K2 = 200.0f * span(((STAMP_SEL) >> 8) & 0xff);
      for (size_t i = (size_t)blockIdx.x * NTHR + threadIdx.x; i < (size_t)TL * DM; i += (size_t)gridDim.x * NTHR) out[i] = (i == 0) ? K2 : K1; }
#endif
#undef IN
#undef PH_BEGIN
#undef F_REFRESH
#undef SEAM
}

extern "C" void kernel_launch(void* const* d_in, const int* in_sizes, int n_in, void* d_out, int out_size, void* d_ws, size_t ws_size, hipStream_t stream) {
    static int grid = 0;
    if (grid == 0) {
        if (n_in != 29 || out_size != TL * DM || ws_size < WS_END2) { fprintf(stderr, "kernel_launch: built for 29 inputs, %d outputs, >= %zu bytes of workspace; got n_in %d out %d ws %zu\n", TL * DM, (size_t)WS_END2, n_in, out_size, ws_size); grid = -1; return; }
        int dev = 0, cus = 0, per_cu = 0;
        if (hipGetDevice(&dev) != hipSuccess || hipDeviceGetAttribute(&cus, hipDeviceAttributeMultiprocessorCount, dev) != hipSuccess) { grid = -1; return; }
        if (hipFuncSetAttribute((const void*)fwd, hipFuncAttributeMaxDynamicSharedMemorySize, LDS_BYTES) != hipSuccess) { fprintf(stderr, "kernel_launch: hipFuncSetAttribute failed\n"); grid = -1; return; }
        if (hipOccupancyMaxActiveBlocksPerMultiprocessor(&per_cu, (const void*)fwd, NTHR, LDS_BYTES) != hipSuccess || per_cu < 1) fprintf(stderr, "kernel_launch: occupancy query reports %d\n", per_cu);
        (void)hipGetLastError();
        grid = cus;
    }
    if (grid < 0) return;
    (void)hipMemsetAsync((char*)d_ws + WS_CTL, 0, CTL_ZERO_BYTES, stream);
    Args a{};
    for (int i = 0; i < 29; ++i) a.in[i] = (const float*)d_in[i];
    a.out = (float*)d_out; a.ws = (unsigned char*)d_ws;
#if MK_PER_PHASE
    for (int p = 0; p < NPH; ++p) {
#ifdef DBG_CHECK
        float* res = (float*)((char*)d_ws + WS_CTL + 8192 * 4); float* snap = (float*)((char*)d_ws + WS_END);
        { const int l = p >= 2 ? (p - 2) / NPL : 0, k = p >= 2 ? (p - 2) % NPL : -1;
          if (k == 6) hipLaunchKernelGGL(snap_rows, dim3(256), dim3(256), 0, stream, a, l, 11, snap);
          if (k == 12) hipLaunchKernelGGL(snap_rows, dim3(256), dim3(256), 0, stream, a, l, 17, snap); }
#endif
        a.ph_lo = p; a.ph_hi = p + 1; hipLaunchKernelGGL(fwd, dim3(grid), dim3(NTHR), LDS_BYTES, stream, a);
#ifdef DBG_CHECK
        { const int l = p >= 2 ? (p - 2) / NPL : 0, k = p >= 2 ? (p - 2) % NPL : -1;
#define CHK(st) hipLaunchKernelGGL(chk, dim3(1), dim3(256), 0, stream, a, (int)(st), l, res, snap)
          if (p == 0) CHK(ST_MOD); if (p == 1) CHK(ST_H0);
#if DBG_GSUB == 2
          if (k == 3 && l == 0) hipLaunchKernelGGL(chk_gates_full, dim3(48, TALL / 4), dim3(256), 0, stream, (const bf16*)((char*)d_ws + WS_H), (const bf16*)((char*)d_ws + WS_WSMALL + OFFS_WG), (const bf16*)((char*)d_ws + WS_GATES), TALL, (unsigned*)((char*)d_ws + WS_CTL + 65536));
#endif
          if (k == 0) { CHK(ST_INPROJ); CHK(ST_YT); } if (k == 1) { CHK(ST_QKFIX); CHK(ST_CONV); CHK(ST_Z); } if (k == 2) CHK(ST_ATTN); if (k == 3) { CHK(ST_GATES); CHK(ST_GATESB); } if (k == 4) CHK(ST_MERGED);
          if (k == 5) CHK(ST_MIX); if (k == 6) CHK(ST_ROW1); if (k == 7) CHK(ST_LOGIT); if (k == 8) CHK(ST_TOPK); if (k == 9) CHK(ST_SLOTS); if (k == 10) CHK(ST_ACT); if (k == 11) CHK(ST_YSLOT); if (k == 12) CHK(ST_COMB);
#undef CHK
        }
#endif
    }
#ifdef DBG_CHECK
#if DBG_GSUB == 2
    hipLaunchKernelGGL(encode_full, dim3(1024), dim3(256), 0, stream, (float*)d_out, (const unsigned*)((char*)d_ws + WS_CTL + 65536), out_size);
#else
    hipLaunchKernelGGL(encode, dim3(1024), dim3(256), 0, stream, (float*)d_out, (const float*)((char*)d_ws + WS_CTL + 8192 * 4), out_size, 0.25f);
#endif
#endif
#else
    a.ph_lo = 0; a.ph_hi = NPH; hipLaunchKernelGGL(fwd, dim3(grid), dim3(NTHR), LDS_BYTES, stream, a);
#endif
    const hipError_t le = hipPeekAtLastError();
    if (le != hipSuccess) fprintf(stderr, "kernel_launch: launch failed: %s\n", hipGetErrorName(le));
}
```

```cpp
#include <hip/hip_runtime.h>
#include <cstdio>
#include <cstdint>
#ifndef MK_PER_PHASE
#define MK_PER_PHASE 0
#endif
namespace pg8 {
#define PG8_LAS __attribute__((address_space(3)))
typedef unsigned short bf16_t;
typedef short bf16x8 __attribute__((ext_vector_type(8)));
typedef float f32x4 __attribute__((ext_vector_type(4)));
typedef unsigned u32x4 __attribute__((ext_vector_type(4)));
typedef int i32x4v __attribute__((ext_vector_type(4)));
typedef int i32x8v __attribute__((ext_vector_type(8)));
typedef unsigned u32x2v __attribute__((ext_vector_type(2)));
constexpr int BM = 256, BK = 64, HALF = 128, HTB = HALF * BK * 2  , STAGE_BYTES = 8 * HTB, NXCD = 8, WGM = 8;

__host__ __device__ __forceinline__ int lds_byte(int r, int c) { const int st = (r >> 4) * 2 + (c >> 5), rr = r & 15, cc = c & 31, ob = rr * 64 + cc * 2; return st * 1024 + (ob ^ (((ob >> 9) & 1) << 5)); }
__host__ __device__ __forceinline__ void stage_rc(int b, int& R, int& C) { const int st = b / 1024, sb = b % 1024, swz = sb ^ (((sb >> 9) & 1) << 5); R = (st >> 1) * 16 + swz / 64; C = (st & 1) * 32 + (swz % 64) / 2; }
__host__ __device__ __forceinline__ int perm32(int rho) { const int n = rho >> 4, i = rho & 15; return 8 * (i >> 2) + 4 * n + (i & 3); }

struct Unit { int pm, pn, par; };
struct Gemm { const bf16_t* A; const bf16_t* Bt; int M, N, K; };

struct StaticOrder {
    int nM, nN, nwg, G, c;
    __host__ __device__ void init(int M, int N, int G_, int c_) { nM = M / BM; nN = N / BM; nwg = nM * nN; G = G_; c = c_; }
    __host__ __device__ bool next(int i, Unit& u) const {
        const long L = (long)i * G + c; if (L >= nwg) return false;
        int wgid = (int)L; { const int q = nwg / NXCD, r = nwg % NXCD, xcd = wgid % NXCD, off = wgid / NXCD; wgid = (xcd < r ? xcd * (q + 1) : r * (q + 1) + (xcd - r) * q) + off; }
        const int nig = WGM * nN, gid = wgid / nig, fm = gid * WGM, gsz = (nM - fm) < WGM ? (nM - fm) : WGM;
        u.pm = fm + ((wgid % nig) % gsz); u.pn = (wgid % nig) / gsz; return true;
    }
    __device__ __forceinline__ void a_ready(const Unit&) const {}
    __device__ __forceinline__ void done(const Unit&) const {}
};

typedef __bf16 bf16x2_native __attribute__((ext_vector_type(2)));
typedef float f32x2_native __attribute__((ext_vector_type(2)));
__device__ __forceinline__ unsigned cvt_pk_bf16(float lo, float hi) { const f32x2_native v = {lo, hi}; const bf16x2_native r = __builtin_convertvector(v, bf16x2_native); return __builtin_bit_cast(unsigned, r); }
__device__ __forceinline__ unsigned cvt4_fp8(float a, float b, float c, float d) { int w = __builtin_amdgcn_cvt_pk_fp8_f32(a, b, __builtin_bit_cast(int, a), false); w = __builtin_amdgcn_cvt_pk_fp8_f32(c, d, w, true); return (unsigned)w; }
typedef float f32x2 __attribute__((ext_vector_type(2)));
__device__ __forceinline__ f32x2 gelu_pk(f32x2 v) {
    const f32x2 av = __builtin_elementwise_abs(v), d = av * 0.2316418882f + 1.0f;
    f32x2 t; t.x = __builtin_amdgcn_rcpf(d.x); t.y = __builtin_amdgcn_rcpf(d.y);
    f32x2 q = t * 0.5307027145f + (-0.7265760135f); q = q * t + 0.7107068705f; q = q * t + (-0.142248368f); q = q * t + 0.127414796f; q = q * t;
    const f32x2 s = (v * v) * (-0.72134752044f);
    f32x2 e; e.x = __builtin_amdgcn_exp2f(s.x); e.y = __builtin_amdgcn_exp2f(s.y);
    const f32x2 m = v * (q * e), r = v - m;
    f32x2 o; o.x = v.x < 0.f ? m.x : r.x; o.y = v.y < 0.f ? m.y : r.y; return o;
}

template <int ACT  > struct EpiBf16 {
    static constexpr bool PERM = true, AFTER_DRAIN = false, BIAS_LDS = false; static_assert(ACT == 0 || ACT == 1, "EpiBf16: ACT is 0 (none) or 1 (gelu_pk)");
    bf16_t* O; int ldc; const float* bias; int split_cols; size_t split_stride; float scale0;
    __device__ __forceinline__ void operator()(const f32x4 (&acc)[2][2][4][2], const Unit& u, int wr, int wc, int fr, int fq) const {
        const int row0 = u.pm * BM + wr * 64 + fr; int colt = u.pn * BM; bf16_t* base = O;
        float sc = 1.f; if (split_cols) { const int t = colt / split_cols; base += (size_t)t * split_stride; colt -= t * split_cols; if (t == 0) sc = scale0; }
        const int col0 = colt + wc * 32 + 8 * fq, bcol0 = u.pn * BM + wc * 32 + 8 * fq;
        f32x4 bv[2][2];
#pragma unroll
        for (int bj = 0; bj < 2; ++bj)
#pragma unroll
            for (int n = 0; n < 2; ++n) bv[bj][n] = bias ? *(const f32x4*)(bias + bcol0 + bj * HALF + 4 * n) : (f32x4){0.f, 0.f, 0.f, 0.f};
#pragma unroll
        for (int ai = 0; ai < 2; ++ai)
#pragma unroll
            for (int m = 0; m < 4; ++m) { bf16_t* rowp = base + (size_t)(row0 + ai * HALF + m * 16) * ldc + col0;
#pragma unroll
                for (int bj = 0; bj < 2; ++bj) { f32x4 v0 = acc[ai][bj][m][0] + bv[bj][0], v1 = acc[ai][bj][m][1] + bv[bj][1];
                    if (ACT == 1) { f32x2 a = gelu_pk((f32x2){v0[0], v0[1]}), b = gelu_pk((f32x2){v0[2], v0[3]}), c = gelu_pk((f32x2){v1[0], v1[1]}), d = gelu_pk((f32x2){v1[2], v1[3]});
                        v0 = (f32x4){a.x, a.y, b.x, b.y}; v1 = (f32x4){c.x, c.y, d.x, d.y}; }
                    v0 = v0 * sc; v1 = v1 * sc; u32x4 w; w.x = cvt_pk_bf16(v0[0], v0[1]); w.y = cvt_pk_bf16(v0[2], v0[3]); w.z = cvt_pk_bf16(v1[0], v1[1]); w.w = cvt_pk_bf16(v1[2], v1[3]);
                    *(u32x4*)(rowp + bj * HALF) = w; } }
    }
};

__device__ __forceinline__ float fast_sigmoid(float x) { return __builtin_amdgcn_rcpf(1.0f + __builtin_amdgcn_exp2f(-1.4426950408889634f * x)); }
__device__ __forceinline__ u32x4 pack8(const f32x4& a, const f32x4& b) { u32x4 w; w.x = cvt_pk_bf16(a[0], a[1]); w.y = cvt_pk_bf16(a[2], a[3]); w.z = cvt_pk_bf16(b[0], b[1]); w.w = cvt_pk_bf16(b[2], b[3]); return w; }
__device__ __forceinline__ void unpack8(const u32x4& w, f32x4& a, f32x4& b) {
    a[0] = __uint_as_float(w.x << 16); a[1] = __uint_as_float(w.x & 0xffff0000u); a[2] = __uint_as_float(w.y << 16); a[3] = __uint_as_float(w.y & 0xffff0000u);
    b[0] = __uint_as_float(w.z << 16); b[1] = __uint_as_float(w.z & 0xffff0000u); b[2] = __uint_as_float(w.w << 16); b[3] = __uint_as_float(w.w & 0xffff0000u); }
__device__ __forceinline__ u32x2v pack8_fp8(const f32x4& a, const f32x4& b) { u32x2v r; r.x = cvt4_fp8(a[0], a[1], a[2], a[3]); r.y = cvt4_fp8(b[0], b[1], b[2], b[3]); return r; }
__device__ __forceinline__ void store_tile_bf16(const f32x4 (&acc)[2][2][4][2], bf16_t* base, int ldc, int wr, int wc, int fr, int fq) {
    const int rt = wr * 64 + fr, cb = wc * 32 + 8 * fq;
#pragma unroll
    for (int ai = 0; ai < 2; ++ai)
#pragma unroll
        for (int m = 0; m < 4; ++m) { bf16_t* rowp = base + (size_t)(rt + ai * HALF + m * 16) * ldc + cb;
#pragma unroll
            for (int bj = 0; bj < 2; ++bj) *(u32x4*)(rowp + bj * HALF) = pack8(acc[ai][bj][m][0], acc[ai][bj][m][1]); }
}
struct EpiInproj {
    static constexpr bool PERM = true, AFTER_DRAIN = false, BIAS_LDS = false;
    bf16_t *q, *k, *v, *cu;
    __device__ __forceinline__ void operator()(const f32x4 (&acc)[2][2][4][2], const Unit& u, int wr, int wc, int fr, int fq) const {
        bf16_t* base; int ldc; const bool glu = u.pn >= 6; float sc = 0.03125f; asm volatile("" : "+s"(sc));
        if (u.pn < 4) { base = q + (size_t)u.pm * 256 * 1024 + u.pn * 256; ldc = 1024; }
        else if (u.pn < 6) { const int m0 = u.pm * 256; const int kr = m0 < 32768 ? (m0 >> 11) * 2304 + (m0 & 2047) : ((m0 - 32768) >> 8) * 2304 + 2048; base = (u.pn == 4 ? k : v) + (size_t)kr * 256; ldc = 256; }
        else { base = cu + (size_t)u.pm * 256 * 512 + (u.pn - 6) * 128; ldc = 512; }
        base += (size_t)(wr * 64 + fr) * ldc + wc * 32 + 8 * fq;
#pragma unroll
        for (int ai = 0; ai < 2; ++ai)
#pragma unroll
            for (int m = 0; m < 4; ++m) { bf16_t* rowp = base + (size_t)(ai * HALF + m * 16) * ldc;
                if (!glu) { *(u32x4*)rowp = pack8(acc[ai][0][m][0] * sc, acc[ai][0][m][1] * sc); *(u32x4*)(rowp + HALF) = pack8(acc[ai][1][m][0] * sc, acc[ai][1][m][1] * sc); }
                else { f32x4 a0 = acc[ai][0][m][0] * sc, a1 = acc[ai][0][m][1] * sc; const f32x4 g0 = acc[ai][1][m][0] * sc, g1 = acc[ai][1][m][1] * sc;
#pragma unroll
                    for (int j = 0; j < 4; ++j) { a0[j] *= fast_sigmoid(g0[j]); a1[j] *= fast_sigmoid(g1[j]); }
                    *(u32x4*)rowp = pack8(a0, a1); } }
    }
};
struct EpiYT {
    static constexpr bool PERM = true, AFTER_DRAIN = false, BIAS_LDS = false;
    unsigned char *yt, *ytc;
    __device__ __forceinline__ void operator()(const f32x4 (&acc)[2][2][4][2], const Unit& u, int wr, int wc, int fr, int fq) const {
        const int cs = u.pm >> 1, chb = (u.pm & 1) * 256; unsigned char* base; int ldc;
        if (u.pn < 128) { const int b = u.pn >> 3, pos0 = (u.pn & 7) * 256; base = yt + (size_t)(b * 512 + chb) * 4096 + cs * 2048 + pos0; ldc = 4096; }
        else { const int b = u.pn - 128; base = ytc + (size_t)(b * 512 + chb) * 512 + cs * 256; ldc = 512; }
        base += (size_t)(wr * 64 + fr) * ldc + wc * 32 + 8 * fq;
#pragma unroll
        for (int ai = 0; ai < 2; ++ai)
#pragma unroll
            for (int m = 0; m < 4; ++m) { unsigned char* rowp = base + (size_t)(ai * HALF + m * 16) * ldc;
#pragma unroll
                for (int bj = 0; bj < 2; ++bj) *(u32x2v*)(rowp + bj * HALF) = pack8_fp8(acc[ai][bj][m][0], acc[ai][bj][m][1]); }
    }
};
struct EpiDFT {
    static constexpr bool PERM = true, AFTER_DRAIN = false, BIAS_LDS = false;
    bf16_t* z; int rowbase, rpb;
    __device__ __forceinline__ void operator()(const f32x4 (&acc)[2][2][4][2], const Unit& u, int wr, int wc, int fr, int fq) const {
        bf16_t* base = z + (size_t)(rowbase + (u.pn >> 1) * rpb + u.pm * 256 + wr * 64 + fr) * 512 + (u.pn & 1) * 256 + wc * 32 + 8 * fq;
#pragma unroll
        for (int ai = 0; ai < 2; ++ai)
#pragma unroll
            for (int m = 0; m < 4; ++m)
#pragma unroll
                for (int bj = 0; bj < 2; ++bj) *(u32x4*)(base + (size_t)(ai * HALF + m * 16) * 512 + bj * HALF) = pack8(acc[ai][bj][m][0] * 0.03125f, acc[ai][bj][m][1] * 0.03125f);
    }
};
struct EpiGates {
    static constexpr bool PERM = true, AFTER_DRAIN = false, BIAS_LDS = false;
    bf16_t* g;
    __device__ __forceinline__ void operator()(const f32x4 (&acc)[2][2][4][2], const Unit& u, int wr, int wc, int fr, int fq) const {
        int lt = (wr * 4 + wc) * 64 + fq * 16 + fr; asm volatile("" : "+v"(lt));
        bf16_t* tb = g + ((size_t)(u.pm * 12 + u.pn) * 16 * 512 + (size_t)lt) * 8;
        float cs = -1.4426950408889634f * 0.03125f; asm volatile("" : "+s"(cs));
#pragma unroll
        for (int ai = 0; ai < 2; ++ai)
#pragma unroll
            for (int m = 0; m < 4; ++m)
#pragma unroll
                for (int bj = 0; bj < 2; ++bj) { f32x4 a0 = acc[ai][bj][m][0], a1 = acc[ai][bj][m][1];
#pragma unroll
                    for (int j = 0; j < 4; ++j) { a0[j] = __builtin_amdgcn_rcpf(1.0f + __builtin_amdgcn_exp2f(a0[j] * cs)); a1[j] = __builtin_amdgcn_rcpf(1.0f + __builtin_amdgcn_exp2f(a1[j] * cs)); }
                    __builtin_nontemporal_store(pack8(a0, a1), (u32x4*)(tb + (size_t)(((ai * 4 + m) * 2 + bj) * 512) * 8)); }
    }
};
template <int MODE> struct EpiMerge {
    static constexpr bool PERM = true, AFTER_DRAIN = false, BIAS_LDS = false;
    bf16_t* mg; bf16_t* scr; const bf16_t* g; int br; float scale;
    __device__ __forceinline__ void operator()(const f32x4 (&acc)[2][2][4][2], const Unit& u, int wr, int wc, int fr, int fq) const {
        const int rt = u.pm * 256 + wr * 64 + fr, cb = u.pn * 256 + wc * 32 + 8 * fq; float sc = scale; asm volatile("" : "+s"(sc));
        int lt = (wr * 4 + wc) * 64 + fq * 16 + fr; asm volatile("" : "+v"(lt));
        const bf16_t* gt = g + ((size_t)(u.pm * 12 + br * 4 + u.pn) * 16 * 512 + (size_t)lt) * 8;
        bf16_t* st = scr + ((size_t)(u.pm * 4 + u.pn) * 16 * 512 + (size_t)lt) * 8;
#pragma unroll
        for (int ai = 0; ai < 2; ++ai)
#pragma unroll
            for (int m = 0; m < 4; ++m)
#pragma unroll
                for (int bj = 0; bj < 2; ++bj) { const size_t pk = (size_t)(((ai * 4 + m) * 2 + bj) * 512) * 8;
                    const u32x4 gw = *(const u32x4*)(gt + pk); f32x4 g0, g1; unpack8(gw, g0, g1);
                    f32x4 v0 = acc[ai][bj][m][0] * sc * g0, v1 = acc[ai][bj][m][1] * sc * g1;
                    if (MODE != 0) { const u32x4 ow = *(const u32x4*)(st + pk); f32x4 o0, o1; unpack8(ow, o0, o1); v0 += o0; v1 += o1; }
                    if (MODE != 2) *(u32x4*)(st + pk) = pack8(v0, v1);
                    else *(u32x4*)(mg + (size_t)(rt + ai * HALF + m * 16) * 1024 + cb + bj * HALF) = pack8(v0, v1); }
    }
};
struct EpiRouter {
    static constexpr bool PERM = true, AFTER_DRAIN = false, BIAS_LDS = false;
    float* lg;
    __device__ __forceinline__ void operator()(const f32x4 (&acc)[2][2][4][2], const Unit& u, int wr, int wc, int fr, int fq) const {
        if (wc < 2) { const int rt = u.pm * 256 + wr * 64 + fr, cb = wc * 32 + 8 * fq;
#pragma unroll
            for (int ai = 0; ai < 2; ++ai)
#pragma unroll
                for (int m = 0; m < 4; ++m) { float* p = lg + (size_t)(rt + ai * HALF + m * 16) * 64 + cb; *(f32x4*)p = acc[ai][0][m][0]; *(f32x4*)(p + 4) = acc[ai][0][m][1]; } }
    }
};
struct EpiSwiGLU {
    static constexpr bool PERM = true, AFTER_DRAIN = false, BIAS_LDS = false;
    bf16_t* act; const float* bg; const float* bu;
    __device__ __forceinline__ void operator()(const f32x4 (&acc)[2][2][4][2], const Unit& u, int wr, int wc, int fr, int fq) const {
        const int e = u.pn >> 3, col = (u.pn & 7) * 128 + wc * 32 + 8 * fq, rt = u.pm * 256 + wr * 64 + fr;
        const f32x4 bg0 = *(const f32x4*)(bg + e * 1024 + col), bg1 = *(const f32x4*)(bg + e * 1024 + col + 4), bu0 = *(const f32x4*)(bu + e * 1024 + col), bu1 = *(const f32x4*)(bu + e * 1024 + col + 4);
#pragma unroll
        for (int ai = 0; ai < 2; ++ai)
#pragma unroll
            for (int m = 0; m < 4; ++m) { f32x4 g0 = acc[ai][0][m][0] + bg0, g1 = acc[ai][0][m][1] + bg1, u0 = acc[ai][1][m][0] + bu0, u1 = acc[ai][1][m][1] + bu1;
#pragma unroll
                for (int j = 0; j < 4; ++j) { const float ga = fminf(g0[j], 7.0f), gb = fminf(g1[j], 7.0f); const float ua = fminf(fmaxf(u0[j], -7.0f), 7.0f), ub = fminf(fmaxf(u1[j], -7.0f), 7.0f);
                    g0[j] = (ua + 1.0f) * (ga * fast_sigmoid(1.702f * ga)); g1[j] = (ub + 1.0f) * (gb * fast_sigmoid(1.702f * gb)); }
                *(u32x4*)(act + (size_t)(rt + ai * HALF + m * 16) * 1024 + col) = pack8(g0, g1); }
    }
};
struct EpiSwiGLU8 {
    static constexpr bool PERM = true, AFTER_DRAIN = false, BIAS_LDS = true;
    unsigned char* act; const float* bg; const float* bu; PG8_LAS float* bl;
    __device__ __forceinline__ void stage_bias(const Unit& u, int wid, int lane) const {
        if (wid < 4) { const int e = u.pn >> 3, c0 = (u.pn & 7) * 128 + (wid & 1) * 64 + lane; const float* src = (wid < 2 ? bg : bu) + e * 1024 + c0;
            __builtin_amdgcn_global_load_lds((const unsigned*)src, (PG8_LAS unsigned*)(bl + u.par * 256 + wid * 64), 4, 0, 0); }
    }
    __device__ __forceinline__ void operator()(const f32x4 (&acc)[2][2][4][2], const Unit& u, int wr, int wc, int fr, int fq) const {
        const int col = (u.pn & 7) * 128 + wc * 32 + 8 * fq, rt = u.pm * 256 + wr * 64 + fr; const PG8_LAS float* bp = bl + u.par * 256 + wc * 32 + 8 * fq;
        const f32x4 bg0 = *(const PG8_LAS f32x4*)bp, bg1 = *(const PG8_LAS f32x4*)(bp + 4), bu0 = *(const PG8_LAS f32x4*)(bp + 128), bu1 = *(const PG8_LAS f32x4*)(bp + 132);
#pragma unroll
        for (int ai = 0; ai < 2; ++ai)
#pragma unroll
            for (int m = 0; m < 4; ++m) { f32x4 g0 = acc[ai][0][m][0] * 0.03125f + bg0, g1 = acc[ai][0][m][1] * 0.03125f + bg1, u0 = acc[ai][1][m][0] * 0.03125f + bu0, u1 = acc[ai][1][m][1] * 0.03125f + bu1;
#pragma unroll
                for (int j = 0; j < 4; ++j) { const float ga = fminf(g0[j], 7.0f), gb = fminf(g1[j], 7.0f); const float ua = fminf(fmaxf(u0[j], -7.0f), 7.0f), ub = fminf(fmaxf(u1[j], -7.0f), 7.0f);
                    g0[j] = (ua + 1.0f) * (ga * fast_sigmoid(1.702f * ga)); g1[j] = (ub + 1.0f) * (gb * fast_sigmoid(1.702f * gb)); }
                __builtin_nontemporal_store(pack8_fp8(g0, g1), (u32x2v*)(act + (size_t)(rt + ai * HALF + m * 16) * 1024 + col)); }
    }
};
struct EpiDown8 {
    static constexpr bool PERM = true, AFTER_DRAIN = false, BIAS_LDS = true;
    unsigned char* ys; const float* bd; int nostore; PG8_LAS float* bl;
    __device__ __forceinline__ void stage_bias(const Unit& u, int wid, int lane) const {
        if (wid < 4) { const float* src = bd + (u.pn >> 2) * 1024 + (u.pn & 3) * 256 + wid * 64 + lane; __builtin_amdgcn_global_load_lds((const unsigned*)src, (PG8_LAS unsigned*)(bl + u.par * 256 + wid * 64), 4, 0, 0); }
    }
    __device__ __forceinline__ void operator()(const f32x4 (&acc)[2][2][4][2], const Unit& u, int wr, int wc, int fr, int fq) const {
        const int col0 = (u.pn & 3) * 256 + wc * 32 + 8 * fq, rt = u.pm * 256 + wr * 64 + fr; const PG8_LAS float* bp = bl + u.par * 256 + wc * 32 + 8 * fq;
        f32x4 bv[2][2];
#pragma unroll
        for (int bj = 0; bj < 2; ++bj) { bv[bj][0] = *(const PG8_LAS f32x4*)(bp + bj * HALF) * 8.0f; bv[bj][1] = *(const PG8_LAS f32x4*)(bp + bj * HALF + 4) * 8.0f; }
#pragma unroll
        for (int ai = 0; ai < 2; ++ai)
#pragma unroll
            for (int m = 0; m < 4; ++m) { unsigned char* rowp = ys + (size_t)(rt + ai * HALF + m * 16) * 1024 + col0;
#pragma unroll
                for (int bj = 0; bj < 2; ++bj) { const u32x2v w = pack8_fp8(acc[ai][bj][m][0] * 0.25f + bv[bj][0], acc[ai][bj][m][1] * 0.25f + bv[bj][1]); if (!nostore) __builtin_nontemporal_store(w, (u32x2v*)(rowp + bj * HALF)); else asm volatile("" :: "v"(w)); } }
    }
};
struct GroupedOrder {
    int nM, nN, nwg, G, c; const PG8_LAS int* tile_e; const int* rows;
    __device__ void init(int nM_, int nN_, int G_, int c_, const PG8_LAS int* te) { nM = nM_; nN = nN_; nwg = nM * nN; G = G_; c = c_; tile_e = te; rows = nullptr; }
    __device__ bool next(int i, Unit& u) const {
        const long L = (long)i * G + c; if (L >= nwg) return false;
        int wgid = (int)L; { const int q = nwg / NXCD, r = nwg % NXCD, xcd = wgid % NXCD, off = wgid / NXCD; wgid = (xcd < r ? xcd * (q + 1) : r * (q + 1) + (xcd - r) * q) + off; }
        const int nig = WGM * nN, gid = wgid / nig, fm = gid * WGM, gsz = (nM - fm) < WGM ? (nM - fm) : WGM;
        u.pm = fm + ((wgid % nig) % gsz); const int pl = (wgid % nig) / gsz; u.pn = __builtin_amdgcn_readfirstlane(tile_e[u.pm]) * nN + pl; return true;
    }
    __device__ __forceinline__ void a_ready(const Unit&) const {}
    __device__ __forceinline__ void done(const Unit&) const {}
};
struct DftOrder {
    int lg, n, G, c;
    __device__ void init(int lg_, int nb, int G_, int c_) { lg = lg_; n = (nb * 2) << lg_; G = G_; c = c_; }
    __device__ bool next(int i, Unit& u) const { const int L = i * G + c; if (L >= n) return false; const int b = L >> (lg + 1), rem = L & ((2 << lg) - 1); u.pm = rem & ((1 << lg) - 1); u.pn = 2 * b + (rem >> lg); return true; }
    __device__ __forceinline__ void a_ready(const Unit&) const {}
    __device__ __forceinline__ void done(const Unit&) const {}
};

template <class Epi, class Sched, bool ALIGN_EPI = false, bool SP2 = false, bool FP8 = false, bool GATHER = false>
__device__ __forceinline__ void gemm_phase(PG8_LAS unsigned char* lds, const Gemm g, const Sched& S, const Epi& E, const int tid_in) {
    int tid_ = tid_in; asm volatile("" : "+v"(tid_));
    const int tid = tid_, wid = __builtin_amdgcn_readfirstlane(tid >> 6), lane = tid & 63, wr = wid >> 2, wc = wid & 3, fr = lane & 15, fq = lane >> 4;
    const int K = g.K, nt = K / BK;
    unsigned voffA[2], voffB[2]; int RA[2]; unsigned CA2[2];
#pragma unroll
    for (int i = 0; i < 2; ++i) { int R, C; stage_rc(tid * 16 + i * 8192, R, C); const int Rb = Epi::PERM ? ((R & ~31) + perm32(R & 31)) : R;
        voffA[i] = (unsigned)(R * K + C) * 2u; voffB[i] = (unsigned)(Rb * K + C) * 2u; RA[i] = (R << 8) | (C * 2); CA2[i] = 0u; }
    static_assert(!GATHER || SP2, "GATHER is implemented for the SP2 loop only");
    unsigned pC[2], pN[2];
#define PG8_LDIDX(dst, unit) do { if constexpr (GATHER) { _Pragma("unroll") for (int h_ = 0; h_ < 2; ++h_) dst[h_] = (unsigned)S.rows[(unit).pm * 256 + h_ * 128 + (RA[0] >> 8)] | ((unsigned)S.rows[(unit).pm * 256 + h_ * 128 + (RA[1] >> 8)] << 16); } } while (0)
#define PG8_GOFF(dst, pk) do { dst[0] = ((pk) & 0xffffu) * (unsigned)(K * 2) + (unsigned)(RA[0] & 255); dst[1] = ((pk) >> 16) * (unsigned)(K * 2) + (unsigned)(RA[1] & 255); } while (0)
    const size_t kstep = (size_t)(BK * 2);
    const size_t hstep = (size_t)HALF * K * 2;
    const size_t tstep = 2 * hstep;
    const unsigned ldsw = (unsigned)wid * 1024u;
    const int aoff = lds_byte(wr * 64 + fr, fq * 8), boff = lds_byte(wc * 32 + fr, fq * 8);
#define PG8_SA(b, h) (((b) * 2 + (h)) * HTB)
#define PG8_SB(b, h) ((4 + (b) * 2 + (h)) * HTB)
#define PG8_STAGE(bufoff, gbase, voff) do { _Pragma("unroll") for (int _i = 0; _i < 2; ++_i) \
        __builtin_amdgcn_global_load_lds((const unsigned*)((const char*)(gbase) + (voff)[_i]), (PG8_LAS unsigned*)(lds + (bufoff) + ldsw + _i * 8192), 16, 0, 0); } while (0)
#define PG8_RD8(off) __builtin_shufflevector(*(const PG8_LAS i32x4v*)(lds + (off)), *(const PG8_LAS i32x4v*)(lds + (off) + 1024), 0, 1, 2, 3, 4, 5, 6, 7)
#define PG8_LDA(dst, b, h) do { _Pragma("unroll") for (int m = 0; m < 4; ++m) { if constexpr (FP8) dst##8[m] = PG8_RD8(PG8_SA(b, h) + aoff + m * 2048); else { _Pragma("unroll") for (int k = 0; k < 2; ++k) dst[m][k] = *(const PG8_LAS bf16x8*)(lds + PG8_SA(b, h) + aoff + m * 2048 + k * 1024); } } } while (0)
#define PG8_LDB(dst, b, h) do { _Pragma("unroll") for (int n = 0; n < 2; ++n) { if constexpr (FP8) dst##8[n] = PG8_RD8(PG8_SB(b, h) + boff + n * 2048); else { _Pragma("unroll") for (int k = 0; k < 2; ++k) dst[n][k] = *(const PG8_LAS bf16x8*)(lds + PG8_SB(b, h) + boff + n * 2048 + k * 1024); } } } while (0)
#define PG8_MMA(ai, bj, At, Bt) do { if constexpr (FP8) __builtin_amdgcn_sched_barrier(0); __builtin_amdgcn_s_setprio(1); _Pragma("unroll") for (int m = 0; m < 4; ++m) _Pragma("unroll") for (int n = 0; n < 2; ++n) { \
        if constexpr (FP8) asm volatile("v_mfma_scale_f32_16x16x128_f8f6f4 %0, %1, %2, %0, %3, %3 op_sel_hi:[0,0,0]" : "+v"(acc[ai][bj][m][n]) : "v"(Bt##8[n]), "v"(At##8[m]), "v"(sc8)); \
        else { _Pragma("unroll") for (int k = 0; k < 2; ++k) acc[ai][bj][m][n] = __builtin_amdgcn_mfma_f32_16x16x32_bf16(Bt[n][k], At[m][k], acc[ai][bj][m][n], 0, 0, 0); } } __builtin_amdgcn_s_setprio(0); if constexpr (FP8) __builtin_amdgcn_sched_barrier(0); } while (0)
#define PG8_WAIT_V(n) asm volatile("s_waitcnt vmcnt(" #n ")" ::: "memory")
#define PG8_WAIT_L(n) asm volatile("s_waitcnt lgkmcnt(" #n ")" ::: "memory")
#define PG8_BAR __builtin_amdgcn_s_barrier()
#define PG8_SCHED __builtin_amdgcn_sched_barrier(0)
    Unit cur, nxt; int ui = 0;
    if (!S.next(0, cur)) return;
    f32x4 acc[2][2][4][2];
#pragma unroll
    for (int a = 0; a < 2; ++a)
#pragma unroll
        for (int b = 0; b < 2; ++b)
#pragma unroll
            for (int m = 0; m < 4; ++m)
#pragma unroll
                for (int n = 0; n < 2; ++n) acc[a][b][m][n] = (f32x4){0.f, 0.f, 0.f, 0.f};
    int sc8 = 0x7f7f7f7f; asm volatile("" : "+v"(sc8));
    bf16x8 At[4][2], B0[2][2], B1[2][2]; i32x8v At8[4], B08[2], B18[2];
    const char* cA = (const char*)g.A + (size_t)cur.pm * tstep; const char* cB = (const char*)g.Bt + (size_t)cur.pn * tstep; const char* const gA = (const char*)g.A;
    S.a_ready(cur);
    if constexpr (SP2) {
        unsigned g0_[2], g1_[2]; if constexpr (GATHER) { PG8_LDIDX(pC, cur); PG8_GOFF(g0_, pC[0]); PG8_GOFF(g1_, pC[1]); }
        PG8_STAGE(PG8_SB(0, 0), cB, voffB); PG8_STAGE(PG8_SB(0, 1), cB + hstep, voffB);
        if constexpr (GATHER) { PG8_STAGE(PG8_SA(0, 0), gA, g0_); PG8_STAGE(PG8_SA(0, 1), gA, g1_); } else { PG8_STAGE(PG8_SA(0, 0), cA, voffA); PG8_STAGE(PG8_SA(0, 1), cA + hstep, voffA); }
        if (wr == 1) PG8_BAR;
        PG8_WAIT_V(2); PG8_BAR;
        PG8_STAGE(PG8_SB(1, 0), cB + kstep, voffB); if constexpr (GATHER) PG8_STAGE(PG8_SA(1, 0), gA + kstep, g0_); else PG8_STAGE(PG8_SA(1, 0), cA + kstep, voffA); PG8_STAGE(PG8_SB(1, 1), cB + hstep + kstep, voffB);
        PG8_WAIT_V(6); PG8_BAR;
    } else {
        PG8_STAGE(PG8_SB(0, 0), cB, voffB); PG8_STAGE(PG8_SA(0, 0), cA, voffA); PG8_STAGE(PG8_SB(0, 1), cB + hstep, voffB); PG8_STAGE(PG8_SA(0, 1), cA + hstep, voffA);
        if (wr == 1) PG8_BAR;
        PG8_WAIT_V(4); PG8_BAR;
        PG8_STAGE(PG8_SB(1, 0), cB + kstep, voffB); PG8_STAGE(PG8_SA(1, 0), cA + kstep, voffA); PG8_STAGE(PG8_SB(1, 1), cB + hstep + kstep, voffB);
        PG8_WAIT_V(6); PG8_BAR;
    }
    for (;;) {
        cur.par = ui & 1; if constexpr (Epi::BIAS_LDS) E.stage_bias(cur, wid, lane);
        const bool has_next = S.next(ui + 1, nxt);
        if constexpr (GATHER) { if (has_next) PG8_LDIDX(pN, nxt); }
        const char* nA = has_next ? (const char*)g.A + (size_t)nxt.pm * tstep : cA; const char* nB = has_next ? (const char*)g.Bt + (size_t)nxt.pn * tstep : cB;
        for (int t = 0; t < nt; t += 2) {
            const bool last = (t == nt - 2);
            const char* a1 = cA + (size_t)(t + 1) * kstep;
            const char* a2 = last ? nA : cA + (size_t)(t + 2) * kstep; const char* b2 = last ? nB : cB + (size_t)(t + 2) * kstep;
            const char* a3 = a2 + kstep; const char* b3 = b2 + kstep;
            if (last && has_next) S.a_ready(nxt);
            unsigned v2[2][2]; const char* gA2 = gA;
            unsigned vc1[2];
            if constexpr (GATHER) { const bool sw = last && has_next; PG8_GOFF(v2[0], sw ? pN[0] : pC[0]); PG8_GOFF(v2[1], sw ? pN[1] : pC[1]); PG8_GOFF(vc1, pC[1]);
                gA2 = last ? gA : gA + (size_t)(t + 2) * kstep; }
            if constexpr (SP2) {
            PG8_LDB(B0, 0, 0); PG8_LDB(B1, 0, 1); PG8_SCHED; PG8_LDA(At, 0, 0); if constexpr (GATHER) PG8_STAGE(PG8_SA(1, 1), gA + (size_t)(t + 1) * kstep, vc1); else PG8_STAGE(PG8_SA(1, 1), a1 + hstep, voffA);
            PG8_WAIT_V(8); PG8_WAIT_L(0); PG8_BAR; PG8_MMA(0, 0, At, B0); PG8_MMA(0, 1, At, B1); PG8_BAR; PG8_SCHED;
            PG8_LDA(At, 0, 1); PG8_STAGE(PG8_SB(0, 0), b2, voffB); PG8_STAGE(PG8_SB(0, 1), b2 + hstep, voffB); if constexpr (GATHER) PG8_STAGE(PG8_SA(0, 0), gA2, v2[0]); else PG8_STAGE(PG8_SA(0, 0), a2, voffA);
            PG8_WAIT_V(8); PG8_WAIT_L(0); PG8_BAR; PG8_MMA(1, 0, At, B0); PG8_MMA(1, 1, At, B1); PG8_BAR; PG8_SCHED;
            PG8_LDB(B0, 1, 0); PG8_LDB(B1, 1, 1); PG8_SCHED; PG8_LDA(At, 1, 0); if constexpr (GATHER) PG8_STAGE(PG8_SA(0, 1), gA2, v2[1]); else PG8_STAGE(PG8_SA(0, 1), a2 + hstep, voffA);
            PG8_WAIT_V(8); PG8_WAIT_L(0); PG8_BAR; PG8_MMA(0, 0, At, B0); PG8_MMA(0, 1, At, B1); PG8_BAR; PG8_SCHED;
            PG8_LDA(At, 1, 1); PG8_STAGE(PG8_SB(1, 0), b3, voffB); PG8_STAGE(PG8_SB(1, 1), b3 + hstep, voffB); if constexpr (GATHER) PG8_STAGE(PG8_SA(1, 0), gA2 + kstep, v2[0]); else PG8_STAGE(PG8_SA(1, 0), a3, voffA);
            PG8_WAIT_V(8); PG8_WAIT_L(0); PG8_BAR; PG8_MMA(1, 0, At, B0); PG8_MMA(1, 1, At, B1); PG8_BAR; PG8_SCHED;
            } else {
            PG8_LDB(B0, 0, 0); PG8_SCHED; PG8_LDA(At, 0, 0); PG8_STAGE(PG8_SA(1, 1), a1 + hstep, voffA);
            PG8_WAIT_L(8); PG8_BAR; PG8_WAIT_L(0); PG8_MMA(0, 0, At, B0); PG8_BAR; PG8_SCHED;
            PG8_LDB(B1, 0, 1); PG8_STAGE(PG8_SB(0, 0), b2, voffB);
            PG8_BAR; PG8_WAIT_L(0); PG8_MMA(0, 1, At, B1); PG8_BAR;
            PG8_LDA(At, 0, 1); PG8_STAGE(PG8_SA(0, 0), a2, voffA);
            PG8_BAR; PG8_WAIT_L(0); PG8_MMA(1, 0, At, B0); PG8_BAR; PG8_SCHED;
            PG8_STAGE(PG8_SB(0, 1), b2 + hstep, voffB);
            PG8_WAIT_V(6); PG8_BAR; PG8_MMA(1, 1, At, B1); PG8_BAR;
            PG8_LDB(B0, 1, 0); PG8_SCHED; PG8_LDA(At, 1, 0); PG8_STAGE(PG8_SA(0, 1), a2 + hstep, voffA);
            PG8_WAIT_L(8); PG8_BAR; PG8_WAIT_L(0); PG8_MMA(0, 0, At, B0); PG8_BAR; PG8_SCHED;
            PG8_LDB(B1, 1, 1); PG8_STAGE(PG8_SB(1, 0), b3, voffB);
            PG8_BAR; PG8_WAIT_L(0); PG8_MMA(0, 1, At, B1); PG8_BAR;
            PG8_LDA(At, 1, 1); PG8_STAGE(PG8_SA(1, 0), a3, voffA);
            PG8_BAR; PG8_WAIT_L(0); PG8_MMA(1, 0, At, B0); PG8_BAR; PG8_SCHED;
            PG8_STAGE(PG8_SB(1, 1), b3 + hstep, voffB);
            PG8_WAIT_V(6); PG8_BAR; PG8_MMA(1, 1, At, B1); PG8_BAR;
            }
        }
        if constexpr (FP8) asm volatile("s_nop 15\n\ts_nop 15" ::: "memory");
        if constexpr (ALIGN_EPI) { if (wr == 0) PG8_BAR; }
        if constexpr (!Epi::AFTER_DRAIN) { E(acc, cur, wr, wc, fr, fq); S.done(cur); }
        if (!has_next) break;
#pragma unroll
        for (int a = 0; a < 2; ++a)
#pragma unroll
            for (int b = 0; b < 2; ++b)
#pragma unroll
                for (int m = 0; m < 4; ++m)
#pragma unroll
                    for (int n = 0; n < 2; ++n) acc[a][b][m][n] = (f32x4){0.f, 0.f, 0.f, 0.f};
        cur = nxt; cA = nA; cB = nB; ++ui;
        if constexpr (GATHER) { pC[0] = pN[0]; pC[1] = pN[1]; }
        if constexpr (ALIGN_EPI) { if (wr == 1) PG8_BAR; }
    }
    PG8_WAIT_V(0);
    if constexpr (!ALIGN_EPI) { if (wr == 0) PG8_BAR; }
    PG8_BAR;
    if constexpr (Epi::AFTER_DRAIN) { E.fused(acc, cur, wr, wc, fr, fq, lds, wid, lane); S.done(cur); }
#undef PG8_SA
#undef PG8_LDIDX
#undef PG8_GOFF
#undef PG8_SB
#undef PG8_STAGE
#undef PG8_LDA
#undef PG8_LDB
#undef PG8_MMA
#undef PG8_RD8
#undef PG8_WAIT_V
#undef PG8_WAIT_L
#undef PG8_BAR
#undef PG8_SCHED
}
}
namespace att {
typedef unsigned short bf16;
constexpr int   D = 128, NW = 8, QBLK = 32, KVBLK = 64;
constexpr float SCALE = 0.088388347648318440f;
constexpr float THR = 8.f;
constexpr int SDEPTH = 2;
constexpr int LDQ = 1024, LDK = 256, LDO = 1024;
constexpr size_t SHM_V = KVBLK * D * 2, SHM_K = KVBLK * D * 2, SHM_ATTN = 2 * SHM_V + 2 * SHM_K + NW * 64 * 4;
using bf16x8 = __attribute__((ext_vector_type(8))) short;
using s16x4  = __attribute__((ext_vector_type(4))) short;
using f32x16 = __attribute__((ext_vector_type(16))) float;
using f32x8  = __attribute__((ext_vector_type(8))) float;
using u32x4  = __attribute__((ext_vector_type(4))) unsigned;
#define KSWZ(row, colB) ((row) * 256 + ((colB) ^ (((row) & 7) << 4)))
#define SBAR() __builtin_amdgcn_sched_barrier(0)
__device__ __forceinline__ int crow(int r, int hi) { return (r & 3) + 8 * (r >> 2) + 4 * hi; }
__device__ __forceinline__ unsigned cvtpk(float lo, float hi) { return pg8::cvt_pk_bf16(lo, hi); }
template <typename TIn> struct Stage;
template <> struct Stage<bf16>  { using T = bf16x8;
  __device__ static __forceinline__ T ld8(const bf16* p) { return *reinterpret_cast<const bf16x8*>(p); }
  __device__ static __forceinline__ bf16x8 tobf(T x) { return x; } };
template <> struct Stage<float> { using T = f32x8;
  __device__ static __forceinline__ T ld8(const float* p) { return *reinterpret_cast<const f32x8*>(p); }
  __device__ static __forceinline__ bf16x8 tobf(T x) {
    u32x4 w = {cvtpk(x[0], x[1]), cvtpk(x[2], x[3]), cvtpk(x[4], x[5]), cvtpk(x[6], x[7])}; return *reinterpret_cast<bf16x8*>(&w); } };

__device__ __forceinline__ void partialSM(f32x16& p0, f32x16& p1, float& m_reg, float& mn, float& alpha) {
  constexpr float C = SCALE * 1.4426950408889634f;
  float pmax = p0[0]; for (int r = 1; r < 16; ++r) pmax = fmaxf(pmax, p0[r]); for (int r = 0; r < 16; ++r) pmax = fmaxf(pmax, p1[r]);
  { auto rr = __builtin_amdgcn_permlane32_swap(__float_as_uint(pmax), __float_as_uint(pmax), false, false);
    pmax = fmaxf(__uint_as_float(rr[0]), __uint_as_float(rr[1])); }
  if (__builtin_expect(__all(pmax - m_reg <= THR / SCALE), 1)) { mn = m_reg; alpha = 1.f; }
  else { mn = fmaxf(m_reg, pmax); alpha = __builtin_amdgcn_exp2f((m_reg - mn) * C); m_reg = mn; }
  float mnC = -mn * C;
  for (int r = 0; r < 16; ++r) p0[r] = fmaf(p0[r], C, mnC); for (int r = 0; r < 16; ++r) p1[r] = fmaf(p1[r], C, mnC);
  for (int r = 0; r < 16; ++r) p0[r] = __builtin_amdgcn_exp2f(p0[r]);
}
__device__ __forceinline__ void finishSM(f32x16& p0, f32x16& p1, float alpha, float& l_reg, bf16x8& pa0, bf16x8& pa1, bf16x8& pa2, bf16x8& pa3) {
  for (int r = 0; r < 16; ++r) p1[r] = __builtin_amdgcn_exp2f(p1[r]);
  float ps = 0; for (int r = 0; r < 16; ++r) ps += p0[r]; for (int r = 0; r < 16; ++r) ps += p1[r];
  { auto rr = __builtin_amdgcn_permlane32_swap(__float_as_uint(ps), __float_as_uint(ps), false, false);
    ps = __uint_as_float(rr[0]) + __uint_as_float(rr[1]); }
  l_reg = l_reg * alpha + ps;
#define PK4(P, BASE, OUT) do { unsigned a0 = cvtpk(P[BASE + 0], P[BASE + 1]), a1 = cvtpk(P[BASE + 2], P[BASE + 3]);   \
    unsigned b0 = cvtpk(P[BASE + 4], P[BASE + 5]), b1 = cvtpk(P[BASE + 6], P[BASE + 7]);                              \
    auto r0 = __builtin_amdgcn_permlane32_swap(a0, b0, false, false); auto r1 = __builtin_amdgcn_permlane32_swap(a1, b1, false, false); \
    u32x4 w = {r0[0], r1[0], r0[1], r1[1]}; OUT = *reinterpret_cast<bf16x8*>(&w); } while (0)
  PK4(p0, 0, pa0); PK4(p0, 8, pa1); PK4(p1, 0, pa2); PK4(p1, 8, pa3);
#undef PK4
}
__device__ __forceinline__ void qkt(f32x16& p0, f32x16& p1, const bf16* Ks, const bf16x8* qr, int r32, int hi) {
  p0 = f32x16{}; p1 = f32x16{};
  for (int d0 = 0; d0 < 8; ++d0) { int cb = (d0 * 16 + hi * 8) * 2;
    bf16x8 b0 = *reinterpret_cast<const bf16x8*>((const char*)Ks + KSWZ(r32, cb));
    bf16x8 b1 = *reinterpret_cast<const bf16x8*>((const char*)Ks + KSWZ(32 + r32, cb));
    p0 = __builtin_amdgcn_mfma_f32_32x32x16_bf16(b0, qr[d0], p0, 0, 0, 0);
    p1 = __builtin_amdgcn_mfma_f32_32x32x16_bf16(b1, qr[d0], p1, 0, 0, 0); }
}
__device__ __forceinline__ int v_st(int k, int c) { const int kk = (k & ~0xC) | ((k & 4) << 1) | ((k & 8) >> 1); return ((kk >> 3) * 4 + (c >> 5)) * 512 + ((kk & 7) * 32 + (c & 31)) * 2; }
__device__ __forceinline__ int v_rd_base(int lane) { return ((lane & 3) << 3) | (((lane >> 2) & 3) << 6) | (((lane >> 4) & 1) << 5) | (((lane >> 5) & 1) << 8); }
constexpr int v_rd_off(int d0, int ks, int half) { return d0 * 512 + ks * 4096 + half * 2048; }
template <int OFF> __device__ __forceinline__ s16x4 tr_read(int vb) {
  s16x4 r; asm volatile("ds_read_b64_tr_b16 %0, %1 offset:%2" : "=&v"(r) : "v"(vb), "i"(OFF) : "memory"); return r;
}
template <int D0> __device__ __forceinline__ void pv_one(f32x16& od, int vb, bf16x8 pa0, bf16x8 pa1, bf16x8 pa2, bf16x8 pa3) {
  const s16x4 l0 = tr_read<v_rd_off(D0, 0, 0)>(vb), h0 = tr_read<v_rd_off(D0, 0, 1)>(vb), l1 = tr_read<v_rd_off(D0, 1, 0)>(vb), h1 = tr_read<v_rd_off(D0, 1, 1)>(vb);
  const s16x4 l2 = tr_read<v_rd_off(D0, 2, 0)>(vb), h2 = tr_read<v_rd_off(D0, 2, 1)>(vb), l3 = tr_read<v_rd_off(D0, 3, 0)>(vb), h3 = tr_read<v_rd_off(D0, 3, 1)>(vb);
  asm volatile("s_waitcnt lgkmcnt(0)" ::: "memory"); SBAR();
#define PK(L, H) (bf16x8){L[0], L[1], L[2], L[3], H[0], H[1], H[2], H[3]}
  od = __builtin_amdgcn_mfma_f32_32x32x16_bf16(pa0, PK(l0, h0), od, 0, 0, 0);
  od = __builtin_amdgcn_mfma_f32_32x32x16_bf16(pa1, PK(l1, h1), od, 0, 0, 0);
  od = __builtin_amdgcn_mfma_f32_32x32x16_bf16(pa2, PK(l2, h2), od, 0, 0, 0);
  od = __builtin_amdgcn_mfma_f32_32x32x16_bf16(pa3, PK(l3, h3), od, 0, 0, 0);
#undef PK
}
__device__ __forceinline__ void pv_d0(f32x16* o, int vb, bf16x8 pa0, bf16x8 pa1, bf16x8 pa2, bf16x8 pa3) {
  pv_one<0>(o[0], vb, pa0, pa1, pa2, pa3); pv_one<1>(o[1], vb, pa0, pa1, pa2, pa3); pv_one<2>(o[2], vb, pa0, pa1, pa2, pa3); pv_one<3>(o[3], vb, pa0, pa1, pa2, pa3);
}

template <typename TQ>
__device__ __forceinline__ void attn_dense_body(const TQ* __restrict__ Qb, const bf16* __restrict__ Kh, const bf16* __restrict__ Vh,
                                                unsigned char* __restrict__ Ob, int seq, char* lds, const int tid_in, const float* __restrict__ qgain, const float* __restrict__ rtab, const int t0, const bool rope) {
  using St = Stage<bf16>; using SQ = Stage<TQ>;
  int tid_ = tid_in; asm volatile("" : "+v"(tid_));
  const int tid = tid_, wid = tid >> 6, lane = tid & 63, r32 = lane & 31, hi = lane >> 5;
  bf16* V_lds = (bf16*)lds; bf16* K_lds = (bf16*)(lds + 2 * SHM_V);
  float* ws = (float*)(lds + 2 * SHM_V + 2 * SHM_K) + wid * 64; float* li_l = ws; float* al_l = ws + 32;
  float m_reg = -1e30f, l_reg = 0; f32x16 o[4] = {}; bf16x8 qr[8];
  const TQ* Qw = Qb + (long)(wid * QBLK + r32) * LDQ + hi * 8;
  { float xf[8][8]; float ss = 0.f;
#pragma unroll
    for (int d0 = 0; d0 < 8; ++d0) { const bf16x8 raw = SQ::tobf(SQ::ld8(Qw + d0 * 16));
#pragma unroll
      for (int j = 0; j < 8; ++j) { xf[d0][j] = __uint_as_float(((unsigned)(unsigned short)raw[j]) << 16); ss += xf[d0][j] * xf[d0][j]; } }
    { auto rr = __builtin_amdgcn_permlane32_swap(__float_as_uint(ss), __float_as_uint(ss), false, false); ss = __uint_as_float(rr[0]) + __uint_as_float(rr[1]); }
    const float rn = 1.0f / sqrtf(ss * (1.0f / 128.0f) + 1e-6f);
#pragma unroll
    for (int d0 = 0; d0 < 8; ++d0) {
#pragma unroll
      for (int j = 0; j < 8; ++j) xf[d0][j] *= rn * qgain[d0 * 16 + hi * 8 + j]; }
    if (rope) { const int t = t0 + wid * QBLK + r32, pr = t >> 6, pc = t & 63;
#pragma unroll
      for (int hb = 0; hb < 2; ++hb) { const int p = hb ? pc : pr;
#pragma unroll
        for (int dd = 0; dd < 2; ++dd) { const int d0 = 4 * hb + dd;
#pragma unroll
          for (int j = 0; j < 8; ++j) { const int f = dd * 16 + hi * 8 + j; const float c = rtab[(p * 32 + f) * 2], s = rtab[(p * 32 + f) * 2 + 1];
            const float x0 = xf[d0][j], x1 = xf[d0 + 2][j]; xf[d0][j] = x0 * c - x1 * s; xf[d0 + 2][j] = x1 * c + x0 * s; } } } }
#pragma unroll
    for (int d0 = 0; d0 < 8; ++d0) { u32x4 w = {cvtpk(xf[d0][0], xf[d0][1]), cvtpk(xf[d0][2], xf[d0][3]), cvtpk(xf[d0][4], xf[d0][5]), cvtpk(xf[d0][6], xf[d0][7])}; qr[d0] = *reinterpret_cast<bf16x8*>(&w); } }
  const int sr = tid >> 4, sc = (tid & 15) * 8, vst0 = v_st(sr, sc), vst1 = v_st(32 + sr, sc);
  const int vb0 = (int)(uintptr_t)V_lds + v_rd_base(lane);
  struct { typename St::T vs0, vs1, ks0, ks1; } sr_[SDEPTH];
#define SLOAD(i, k0) do { sr_[i].vs0 = St::ld8(&Vh[(long)((k0) + sr) * LDK + sc]); sr_[i].vs1 = St::ld8(&Vh[(long)((k0) + 32 + sr) * LDK + sc]); \
    sr_[i].ks0 = St::ld8(&Kh[(long)((k0) + sr) * LDK + sc]); sr_[i].ks1 = St::ld8(&Kh[(long)((k0) + 32 + sr) * LDK + sc]); } while (0)
#define SWRITE(b, i) do { *(bf16x8*)((char*)V_lds + (b) * SHM_V + vst0) = St::tobf(sr_[i].vs0);          \
    *(bf16x8*)((char*)V_lds + (b) * SHM_V + vst1) = St::tobf(sr_[i].vs1); int kc = sc * 2;               \
    *(bf16x8*)((char*)K_lds + (b) * SHM_K + KSWZ(sr, kc)) = St::tobf(sr_[i].ks0);                       \
    *(bf16x8*)((char*)K_lds + (b) * SHM_K + KSWZ(32 + sr, kc)) = St::tobf(sr_[i].ks1); } while (0)
#define SWAIT() do { if constexpr (SDEPTH == 2) asm volatile("s_waitcnt vmcnt(4)" ::: "memory"); else asm volatile("s_waitcnt vmcnt(0)" ::: "memory"); } while (0)
#define RESC(a) do { if (__any((a) < 1.f)) { if (hi == 0) al_l[r32] = (a); asm volatile("s_waitcnt lgkmcnt(0)" ::: "memory"); \
    for (int d = 0; d < 4; ++d) for (int r = 0; r < 16; ++r) o[d][r] *= al_l[crow(r, hi)]; } } while (0)
  f32x16 pA0, pA1, pB0, pB1; float mnA, mnB, alA, alB; bf16x8 pa0, pa1, pa2, pa3; const int NT = seq / KVBLK;
  constexpr int SE = 0, SO = SDEPTH - 1;
  SLOAD(SE, 0); asm volatile("s_waitcnt vmcnt(0)" ::: "memory"); SWRITE(0, SE); __syncthreads();
  qkt(pA0, pA1, K_lds, qr, r32, hi); partialSM(pA0, pA1, m_reg, mnA, alA);
  SLOAD(SO, KVBLK); if constexpr (SDEPTH == 2) { if (2 < NT) SLOAD(SE, 2 * KVBLK); }
  SWAIT(); SWRITE(1, SO); __syncthreads();
  for (int j = 1; j + 1 < NT; j += 2) {
    SBAR(); qkt(pB0, pB1, (bf16*)((char*)K_lds + SHM_K), qr, r32, hi);
    finishSM(pA0, pA1, alA, l_reg, pa0, pa1, pa2, pa3); SBAR();
    SLOAD(SO, (j + SDEPTH) * KVBLK); SBAR();
    pv_d0(o, vb0, pa0, pa1, pa2, pa3); partialSM(pB0, pB1, m_reg, mnB, alB);
    __syncthreads(); SWAIT(); SWRITE(0, SE);
    RESC(alB); __syncthreads();
    SBAR(); qkt(pA0, pA1, K_lds, qr, r32, hi);
    finishSM(pB0, pB1, alB, l_reg, pa0, pa1, pa2, pa3); SBAR();
    if (SDEPTH == 1 || j + 3 < NT) SLOAD(SE, (j + 1 + SDEPTH) * KVBLK); SBAR();
    pv_d0(o, vb0 + (int)SHM_V, pa0, pa1, pa2, pa3); partialSM(pA0, pA1, m_reg, mnA, alA);
    __syncthreads(); SWAIT(); SWRITE(1, SO);
    RESC(alA); __syncthreads();
  }
  SBAR(); qkt(pB0, pB1, (bf16*)((char*)K_lds + SHM_K), qr, r32, hi);
  finishSM(pA0, pA1, alA, l_reg, pa0, pa1, pa2, pa3); SBAR();
  pv_d0(o, vb0, pa0, pa1, pa2, pa3); partialSM(pB0, pB1, m_reg, mnB, alB);
  __syncthreads(); RESC(alB);
  finishSM(pB0, pB1, alB, l_reg, pa0, pa1, pa2, pa3); SBAR();
  pv_d0(o, vb0 + (int)SHM_V, pa0, pa1, pa2, pa3);
  if (hi == 0) li_l[r32] = l_reg; asm volatile("s_waitcnt lgkmcnt(0)" ::: "memory");
  float rli[16];
#pragma unroll
  for (int r = 0; r < 16; ++r) rli[r] = __builtin_amdgcn_rcpf(li_l[crow(r, hi)]);
  unsigned char* Ow = Ob + (long)(wid * QBLK) * LDO;
#pragma unroll
  for (int r = 0; r < 16; ++r) { int orow = crow(r, hi);
    for (int d0 = 0; d0 < 4; ++d0) { const float ov = o[d0][r] * rli[r] * 16.0f; Ow[(long)orow * LDO + d0 * 32 + r32] = (unsigned char)(__builtin_amdgcn_cvt_pk_fp8_f32(ov, ov, __builtin_bit_cast(int, ov), false) & 0xff); } }
#undef SLOAD
#undef SWRITE
#undef SWAIT
#undef RESC
}
#undef KSWZ
#undef SBAR
}

#define GAS __attribute__((address_space(1)))
#define LAS __attribute__((address_space(3)))
typedef unsigned short bf16;
typedef unsigned v4u __attribute__((ext_vector_type(4)));
typedef float f32x4 __attribute__((ext_vector_type(4)));
typedef short bf16x8 __attribute__((ext_vector_type(8)));
typedef GAS unsigned gu32;
typedef GAS unsigned long long gu64;
#define RLX_AGENT __ATOMIC_RELAXED, __HIP_MEMORY_SCOPE_AGENT
#define LDS_WAIT() asm volatile("s_waitcnt lgkmcnt(0)" ::: "memory")
#define VM_WAIT() asm volatile("s_waitcnt vmcnt(0)" ::: "memory")
__device__ __forceinline__ unsigned long long rt() { return __builtin_amdgcn_s_memrealtime(); }
__device__ __forceinline__ unsigned f2bf(float f) { unsigned u = __builtin_bit_cast(unsigned, f); return (u + 0x7fffu + ((u >> 16) & 1u)) >> 16; }
__device__ __forceinline__ unsigned pk2(float lo, float hi) { return f2bf(lo) | (f2bf(hi) << 16); }

#define XB_TMO      128
#define XB_XCNT(j)  (256  + 64 * (j))
#define XB_XSUB(j)  (1280 + 64 * (j))
#define XB_XGEN(j)  (2304 + 64 * (j))
#define XB_TOP      3328
#define XB_TOPGEN   3392
#define XCD_BAR_WORDS 3456
#define XB_SPIN_CAP (1u << 18)

__device__ __forceinline__ unsigned xb_ld(unsigned* p)              { return __hip_atomic_load(p, __ATOMIC_RELAXED, __HIP_MEMORY_SCOPE_AGENT); }
__device__ __forceinline__ unsigned xb_add(unsigned* p, unsigned v) { return __hip_atomic_fetch_add(p, v, __ATOMIC_RELAXED, __HIP_MEMORY_SCOPE_AGENT); }
__device__ __forceinline__ unsigned xb_xcc_id() { return (unsigned)__builtin_amdgcn_s_getreg((3 << 11) | 20) & 0xFu; }
#define XB_SPIN(cond, bar) do { unsigned _sp = 0; while (cond) { __builtin_amdgcn_s_sleep(1); \
    if ((++_sp & 255u) == 0u) { if (xb_ld(&(bar)[XB_TMO])) break; if (_sp > XB_SPIN_CAP) { atomicAdd(&(bar)[XB_TMO], 1u); break; } } } } while (0)

struct XcdBarrier {
    unsigned* bar; unsigned x;
    volatile LAS unsigned* st;
};

__device__ __forceinline__ XcdBarrier xcd_barrier_post(unsigned* bar, volatile LAS unsigned* st) {
    XcdBarrier b; b.bar = bar; b.x = xb_xcc_id(); b.st = st;
    if (threadIdx.x == 0) (void)xb_add(&bar[XB_XCNT(b.x)], 1u);
    return b;
}
__device__ __forceinline__ void xcd_barrier_complete(unsigned* bar, unsigned x, unsigned& nloc, unsigned& nx) {
    const unsigned G = gridDim.x * gridDim.y * gridDim.z;
    unsigned sum, cnt, mine, sp = 0u;
    for (;;) {
        sum = 0u; cnt = 0u; mine = 0u;
#pragma unroll
        for (unsigned j = 0; j < 16; ++j) { const unsigned c = xb_ld(&bar[XB_XCNT(j)]); sum += c; cnt += (c > 0u) ? 1u : 0u; mine = (j == x) ? c : mine; }
        if (sum == G) break;
        __builtin_amdgcn_s_sleep(1);
        if ((++sp & 255u) == 0u) { if (xb_ld(&bar[XB_TMO])) break; if (sp > XB_SPIN_CAP) { atomicAdd(&bar[XB_TMO], 1u); break; } }
    }
    nloc = mine > 0u ? mine : 1u; nx = cnt > 0u ? cnt : 1u;
}

__device__ __forceinline__ void xcd_barrier(const XcdBarrier& b) {
    asm volatile("s_waitcnt vmcnt(0)" ::: "memory");
    __syncthreads();
    if (threadIdx.x == 0) {
        unsigned* bar = b.bar;
        __builtin_amdgcn_s_waitcnt(0);
        unsigned nloc = b.st[0], nx = b.st[1];
        if (nloc == 0u) { xcd_barrier_complete(bar, b.x, nloc, nx); b.st[0] = nloc; b.st[1] = nx; }
        const unsigned old = xb_add(&bar[XB_XSUB(b.x)], 1u);
        const unsigned gen = old / nloc;
        if (old + 1u == (gen + 1u) * nloc) {
            __builtin_amdgcn_fence(__ATOMIC_RELEASE, "agent");
            asm volatile("s_waitcnt vmcnt(0)" ::: "memory");
            const unsigned og = xb_add(&bar[XB_TOP], 1u);
            const unsigned tg = og / nx;
            if (og + 1u == (tg + 1u) * nx) xb_add(&bar[XB_TOPGEN], 1u);
            else XB_SPIN(xb_ld(&bar[XB_TOPGEN]) == tg, bar);
            __builtin_amdgcn_fence(__ATOMIC_ACQUIRE, "agent");
            xb_add(&bar[XB_XGEN(b.x)], 1u);
            asm volatile("s_waitcnt vmcnt(0)" ::: "memory");
        } else {
            XB_SPIN(xb_ld(&bar[XB_XGEN(b.x)]) == gen, bar);
            __builtin_amdgcn_fence(__ATOMIC_ACQUIRE, "agent");
            asm volatile("s_waitcnt vmcnt(0)" ::: "memory");
        }
    }
    __syncthreads();
}
constexpr int DM = 1024, NB = 16, SEQ = 2048, CTXL = 256, TL = NB * SEQ, TC = NB * CTXL, TALL = TL + TC;
constexpr int INCOLS = 6144, OFF_FNET = 2560, OFF_GATE = 3072;
constexpr int NEXP = 32, KVROWS = SEQ + CTXL;
constexpr float EPS = 1e-6f;
constexpr int NWAVES = 8, NTHR = NWAVES * 64;
constexpr int NPL = 11, NPH = 2 + 2 * NPL;
#ifndef MK_PER_PHASE
#define MK_PER_PHASE 0
#endif
constexpr size_t MiB = 1u << 20;
constexpr size_t WS_CTL = 0, CTL_ZERO_BYTES = 1 * MiB;
constexpr size_t WS_MOD = 1 * MiB;
constexpr size_t WS_TAB = 2 * MiB;
constexpr size_t WS_TOPI = 3 * MiB, WS_TOPP = 4 * MiB, WS_SLOT = 5 * MiB, WS_CNT = 6 * MiB;
constexpr size_t WS_LOGIT = 7 * MiB;
constexpr size_t WS_WSMALL = 17 * MiB, WSMALL_LAYER = 20 * MiB;
constexpr size_t OFFS_WIN = 0, OFFS_WF = 5 * MiB, OFFS_WG = 7 * MiB, OFFS_WAO = 13 * MiB, OFFS_WCO = 15 * MiB, OFFS_WFO = 16 * MiB, OFFS_WOUT = 17 * MiB, OFFS_ROUT = 19 * MiB;
constexpr size_t WS_DFTL = 57 * MiB, WS_DFTC = 73 * MiB;
constexpr size_t WS_XC = 74 * MiB;
constexpr size_t WS_H = 90 * MiB;
constexpr size_t WS_WGU = 162 * MiB, WS_WD = 226 * MiB, MOEW_LAYER = 96 * MiB;
constexpr size_t WS_BIG = 354 * MiB;
constexpr size_t WS_Q = WS_BIG, WS_K = WS_Q + 72 * MiB, WS_V = WS_K + 18 * MiB, WS_CU = WS_V + 18 * MiB, WS_YT = WS_CU + 36 * MiB, WS_YTC = WS_YT + 64 * MiB;
constexpr size_t WS_GATES = WS_BIG;
constexpr size_t WS_AO = WS_BIG + 216 * MiB, WS_CH = WS_AO + 72 * MiB, WS_Z = WS_CH + 36 * MiB;
constexpr size_t WS_MIX = WS_AO;
constexpr size_t WS_MERGED = WS_BIG + 360 * MiB;
constexpr int SLOT_ROWS = 608 * 256;
constexpr size_t WS_YS = WS_BIG, WS_HS = WS_BIG + 304 * MiB, WS_ACT = WS_BIG + 456 * MiB, WS_END = WS_BIG + 608 * MiB;
constexpr size_t WS_H8 = WS_END;
constexpr size_t WS_END2 = WS_END + 36 * MiB;
static_assert(WS_YTC + 8 * MiB == WS_AO && WS_Z + 36 * MiB == WS_MERGED && WS_MERGED + 72 * MiB <= WS_END && (size_t)SLOT_ROWS * 2048 == 304 * MiB, "ws map");
constexpr int CW_TMO = 0, CW_CODE = 1, CW_BAR = 4096;
constexpr int CNT_ROWSRC = 32768;
constexpr int CNT_TILE_E = 16384, CNT_NT = 16384 + 1024;

constexpr int RING_OFF = 0, RING_BYTES = 131072;
constexpr int LDSCTL_OFF = RING_BYTES, MISC_OFF = LDSCTL_OFF + 320, LDS_CT = LDSCTL_OFF + 512, LDS_SM = LDSCTL_OFF + 1024;
constexpr int LDS_BYTES = 155648;

typedef unsigned u32x2 __attribute__((ext_vector_type(2)));
typedef int i32x4 __attribute__((ext_vector_type(4)));
typedef float f32x2 __attribute__((ext_vector_type(2)));
struct Args { const float* in[29]; float* out; unsigned char* ws; int ph_lo, ph_hi; };
typedef const __attribute__((address_space(4))) unsigned char* kptr_t;
struct AV {
    kptr_t kp;
    __device__ __forceinline__ const float* in(int i) const { return *(const float* const __attribute__((address_space(4)))*)(kp + 8 * i); }
    __device__ __forceinline__ float* out() const { return *(float* const __attribute__((address_space(4)))*)(kp + 8 * 29); }
    __device__ __forceinline__ unsigned char* ws() const { return *(unsigned char* const __attribute__((address_space(4)))*)(kp + 8 * 30); }
};
__device__ __forceinline__ AV av_get() { AV a; a.kp = (kptr_t)__builtin_amdgcn_kernarg_segment_ptr(); asm volatile("" : "+s"(a.kp)); return a; }

struct Frame {
    LAS unsigned char* lds; volatile LAS unsigned* MISC; gu32* ctl;
    int tid, lane, wave, vcu, G;
};

__device__ __forceinline__ float shx(float v, int m, int lane) { return __int_as_float(__builtin_amdgcn_ds_bpermute((lane ^ m) << 2, __float_as_int(v))); }
__device__ __forceinline__ float wave_sum(float v, int lane) {
#pragma unroll
    for (int o = 1; o < 64; o <<= 1) v += shx(v, o, lane);
    return v;
}
__device__ __forceinline__ float sigmoidf_(float x) { return 1.0f / (1.0f + __expf(-x)); }
__device__ __forceinline__ f32x4 bf4(u32x2 w) { f32x4 r; r[0] = __uint_as_float(w.x << 16); r[1] = __uint_as_float(w.x & 0xffff0000u); r[2] = __uint_as_float(w.y << 16); r[3] = __uint_as_float(w.y & 0xffff0000u); return r; }
__device__ __forceinline__ u32x2 pk4(f32x4 v) { u32x2 w; w.x = pk2(v[0], v[1]); w.y = pk2(v[2], v[3]); return w; }
__device__ __forceinline__ void ld_row_f32(f32x4 (&v)[4], const float* p, int lane) {
#pragma unroll
    for (int j = 0; j < 4; ++j) v[j] = ((const GAS f32x4*)p)[lane + 64 * j];
}
__device__ __forceinline__ void st_row_f32(const f32x4 (&v)[4], float* p, int lane) {
#pragma unroll
    for (int j = 0; j < 4; ++j) ((GAS f32x4*)p)[lane + 64 * j] = v[j];
}
__device__ __forceinline__ void ld_row_bf16(f32x4 (&v)[4], const bf16* p, int lane) {
#pragma unroll
    for (int j = 0; j < 4; ++j) v[j] = bf4(((const GAS u32x2*)p)[lane + 64 * j]);
}
__device__ __forceinline__ void st_row_bf16(const f32x4 (&v)[4], bf16* p, int lane) {
#pragma unroll
    for (int j = 0; j < 4; ++j) ((GAS u32x2*)p)[lane + 64 * j] = pk4(v[j]);
}
__device__ __forceinline__ void rms_gain(f32x4 (&v)[4], const float* g, int lane) {
    float ss = 0.f;
#pragma unroll
    for (int j = 0; j < 4; ++j) ss += (v[j][0] * v[j][0] + v[j][1] * v[j][1]) + (v[j][2] * v[j][2] + v[j][3] * v[j][3]);
    const float r = 1.0f / sqrtf(wave_sum(ss, lane) * (1.0f / 1024.0f) + EPS);
#pragma unroll
    for (int j = 0; j < 4; ++j) { const f32x4 gg = ((const GAS f32x4*)g)[lane + 64 * j]; v[j] = v[j] * r * gg; }
}
__device__ __forceinline__ void modulate_store(const f32x4 (&v)[4], const float* shift, const float* scale, bf16* o, int lane) {
#pragma unroll
    for (int j = 0; j < 4; ++j) { const f32x4 sh = ((const GAS f32x4*)shift)[lane + 64 * j], sc = ((const GAS f32x4*)scale)[lane + 64 * j];
        ((GAS u32x2*)o)[lane + 64 * j] = pk4(v[j] * (sc + 1.0f) + sh); }
}
__device__ __forceinline__ unsigned pk4_fp8(f32x4 v) { return pg8::cvt4_fp8(v[0], v[1], v[2], v[3]); }
__device__ __forceinline__ void modulate_store2(const f32x4 (&v)[4], const float* shift, const float* scale, bf16* o, unsigned char* o8, int lane) {
#pragma unroll
    for (int j = 0; j < 4; ++j) { const f32x4 sh = ((const GAS f32x4*)shift)[lane + 64 * j], sc = ((const GAS f32x4*)scale)[lane + 64 * j]; const f32x4 r = v[j] * (sc + 1.0f) + sh;
        ((GAS u32x2*)o)[lane + 64 * j] = pk4(r); ((GAS unsigned*)o8)[lane + 64 * j] = pk4_fp8(r); }
}
__device__ __forceinline__ f32x4 fp8x4(unsigned w) { const f32x2 a = __builtin_amdgcn_cvt_pk_f32_fp8((int)w, false), b = __builtin_amdgcn_cvt_pk_f32_fp8((int)w, true); return (f32x4){a.x, a.y, b.x, b.y}; }
__device__ __forceinline__ int krow_of(int m) { return m < TL ? (m >> 11) * KVROWS + (m & 2047) : ((m - TL) >> 8) * KVROWS + SEQ + ((m - TL) & 255); }

__device__ __forceinline__ void load_block(const float* W, int ldw, int k0, int n0, float scale, LAS float* scr, int lane) {
    f32x4 v[8]; const int kr = lane >> 3, c4 = (lane & 7) * 4;
#pragma unroll
    for (int i = 0; i < 8; ++i) v[i] = *(const GAS f32x4*)(W + (size_t)(k0 + kr + 8 * i) * ldw + n0 + c4);
#pragma unroll
    for (int i = 0; i < 8; ++i) { LAS float* d = scr + (kr + 8 * i) * 33 + c4; d[0] = v[i][0] * scale; d[1] = v[i][1] * scale; d[2] = v[i][2] * scale; d[3] = v[i][3] * scale; }
    LDS_WAIT(); asm volatile("" ::: "memory");
}
__device__ __forceinline__ void transpose_item(const float* W, int ldw, int K, bf16* WT, int dst_row0, int k0, int n0, LAS float* scr, int lane) {
    load_block(W, ldw, k0, n0, 1.0f, scr, lane);
    const int c = lane & 7;
#pragma unroll
    for (int j = 0; j < 4; ++j) { const int n = (lane >> 3) + 8 * j; const LAS float* s = scr + (8 * c) * 33 + n;
        v4u o; o.x = pk2(s[0 * 33], s[1 * 33]); o.y = pk2(s[2 * 33], s[3 * 33]); o.z = pk2(s[4 * 33], s[5 * 33]); o.w = pk2(s[6 * 33], s[7 * 33]);
        *(GAS v4u*)(WT + (size_t)(dst_row0 + n) * K + k0 + 8 * c) = o; }
    LDS_WAIT(); asm volatile("" ::: "memory");
}
__device__ __forceinline__ void transpose_item_fp8(const float* W, int ldw, int K, unsigned char* WT, int dst_row0, int k0, int n0, float scale, LAS float* scr, int lane) {
    load_block(W, ldw, k0, n0, scale, scr, lane);
#pragma unroll
    for (int j = 0; j < 2; ++j) { const int q = lane + 64 * j, n = q >> 2, c = q & 3; const LAS float* s = scr + (16 * c) * 33 + n; v4u o;
        o.x = pg8::cvt4_fp8(s[0 * 33], s[1 * 33], s[2 * 33], s[3 * 33]); o.y = pg8::cvt4_fp8(s[4 * 33], s[5 * 33], s[6 * 33], s[7 * 33]); o.z = pg8::cvt4_fp8(s[8 * 33], s[9 * 33], s[10 * 33], s[11 * 33]); o.w = pg8::cvt4_fp8(s[12 * 33], s[13 * 33], s[14 * 33], s[15 * 33]);
        *(GAS v4u*)(WT + (size_t)(dst_row0 + n) * K + k0 + 16 * c) = o; }
    LDS_WAIT(); asm volatile("" ::: "memory");
}
constexpr int IT_S0 = 16 * 80, IT_S1 = 16 * 96, IT_S2 = 512, IT_S3 = 512, IT_S4 = 256, IT_S5 = 256, IT_SMALL = IT_S0 + IT_S1 + IT_S2 + IT_S3 + IT_S4 + IT_S5;
__device__ __forceinline__ void small_item(const AV& a, int l, int r, LAS float* scr, int lane) {
    unsigned char* wl = a.ws() + WS_WSMALL + (size_t)l * WSMALL_LAYER; const float* win = a.in(10) + (size_t)l * DM * INCOLS;
    if (r < IT_S0) { const int kb = r / 80, n0 = (r % 80) * 32; int dr;
        if (n0 < 1536) dr = n0; else { int cc = n0 - 1536; if (cc < 512) dr = 1536 + (cc >> 7) * 256 + (cc & 127); else { cc -= 512; dr = 1536 + (cc >> 7) * 256 + 128 + (cc & 127); } }
        transpose_item_fp8(win, INCOLS, DM, wl + OFFS_WIN, dr, kb * 64, n0, 32.0f, scr, lane); return; }
    r -= IT_S0;
    if (r < IT_S1) { const int kb = r / 96, nb = r % 96; transpose_item_fp8(win, INCOLS, DM, wl + OFFS_WG, nb * 32, kb * 64, OFF_GATE + nb * 32, 32.0f, scr, lane); return; }
    r -= IT_S1;
    if (r < IT_S2) { const int kb = r / 32, nb = r % 32; transpose_item_fp8(a.in(13) + (size_t)l * DM * DM, DM, DM, wl + OFFS_WAO, nb * 32, kb * 64, nb * 32, 32.0f, scr, lane); return; }
    r -= IT_S2;
    if (r < IT_S3) { const int kb = r / 32, nb = r % 32; transpose_item(a.in(20) + (size_t)l * DM * DM, DM, DM, (bf16*)(wl + OFFS_WOUT), nb * 32, kb * 64, nb * 32, scr, lane); return; }
    r -= IT_S3;
    if (r < IT_S4) { const int kb = r / 32, nb = r % 32; transpose_item(a.in(18) + (size_t)l * 512 * DM, DM, 512, (bf16*)(wl + OFFS_WCO), nb * 32, kb * 64, nb * 32, scr, lane); return; }
    r -= IT_S4;
    { const int kb = r / 32, nb = r % 32; transpose_item(a.in(19) + (size_t)l * 512 * DM, DM, 512, (bf16*)(wl + OFFS_WFO), nb * 32, kb * 64, nb * 32, scr, lane); }
}
constexpr int IT_MOE = NEXP * 3 * 512;
struct MoeIt { const float* W; unsigned char* WT; int dr, k0; };
__device__ __forceinline__ MoeIt moe_decode(const AV& a, int gi) {
    const int l = gi / IT_MOE, idx = gi % IT_MOE, e = idx / 1536, r = idx % 1536, which = r / 512, it = r % 512, kb = it / 32, n0 = (it % 32) * 32; const size_t eo = ((size_t)l * NEXP + e) << 20;
    MoeIt m; m.k0 = kb * 64;
    if (which == 0) { m.W = a.in(23) + eo + n0; m.WT = a.ws() + WS_WGU + (size_t)l * MOEW_LAYER + (size_t)e * 2048 * 1024; m.dr = (n0 >> 7) * 256 + (n0 & 127); }
    else if (which == 1) { m.W = a.in(25) + eo + n0; m.WT = a.ws() + WS_WGU + (size_t)l * MOEW_LAYER + (size_t)e * 2048 * 1024; m.dr = (n0 >> 7) * 256 + 128 + (n0 & 127); }
    else { m.W = a.in(27) + eo + n0; m.WT = a.ws() + WS_WD + (size_t)l * MOEW_LAYER + (size_t)e * 1024 * 1024; m.dr = n0; }
    return m;
}
__device__ __forceinline__ void moe_issue(f32x4 (&v)[8], const MoeIt& m, int lane) {
    const float* p = m.W + (size_t)(m.k0 + (lane >> 3)) * DM + (lane & 7) * 4;
#pragma unroll
    for (int i = 0; i < 8; ++i) v[i] = __builtin_nontemporal_load((const GAS f32x4*)(p + (size_t)(8 * i) * DM));
}
__device__ __forceinline__ void moe_finish(const f32x4 (&v)[8], const MoeIt& m, LAS float* scr, int lane) {
    const int kr = lane >> 3, c4 = (lane & 7) * 4;
#pragma unroll
    for (int i = 0; i < 8; ++i) { LAS float* d = scr + (kr + 8 * i) * 33 + c4; d[0] = v[i][0] * 32.0f; d[1] = v[i][1] * 32.0f; d[2] = v[i][2] * 32.0f; d[3] = v[i][3] * 32.0f; }
    LDS_WAIT(); asm volatile("" ::: "memory");
#pragma unroll
    for (int j = 0; j < 2; ++j) { const int q = lane + 64 * j, n = q >> 2, c = q & 3; const LAS float* s = scr + (16 * c) * 33 + n; v4u o;
        o.x = pg8::cvt4_fp8(s[0 * 33], s[1 * 33], s[2 * 33], s[3 * 33]); o.y = pg8::cvt4_fp8(s[4 * 33], s[5 * 33], s[6 * 33], s[7 * 33]); o.z = pg8::cvt4_fp8(s[8 * 33], s[9 * 33], s[10 * 33], s[11 * 33]); o.w = pg8::cvt4_fp8(s[12 * 33], s[13 * 33], s[14 * 33], s[15 * 33]);
        *(GAS v4u*)(m.WT + (size_t)(m.dr + n) * DM + m.k0 + 16 * c) = o; }
    LDS_WAIT(); asm volatile("" ::: "memory");
}
__device__ __forceinline__ void moe_convert_range(const AV& a, int base, int count, int gw, int NGW, LAS float* scr, int lane) {
    f32x4 va[8], vb[8]; int it = gw; if (it >= count) return;
    MoeIt ma = moe_decode(a, base + it), mb = ma; moe_issue(va, ma, lane);
    for (;;) {
        const bool h1 = it + NGW < count; if (h1) { mb = moe_decode(a, base + it + NGW); moe_issue(vb, mb, lane); }
        moe_finish(va, ma, scr, lane); if (!h1) break; it += NGW;
        const bool h2 = it + NGW < count; if (h2) { ma = moe_decode(a, base + it + NGW); moe_issue(va, ma, lane); }
        moe_finish(vb, mb, scr, lane); if (!h2) break; it += NGW;
    }
}
#ifndef FILL_A_PER_WAVE
#define FILL_A_PER_WAVE 14
#endif
#ifndef FILL_B_PER_WAVE
#define FILL_B_PER_WAVE 6
#endif
constexpr int FILL_WG0 = 64, FILL_NGW = (256 - FILL_WG0) * NWAVES, FILL_A = FILL_NGW * FILL_A_PER_WAVE, FILL_B = FILL_NGW * FILL_B_PER_WAVE;
static_assert(FILL_A + FILL_B <= IT_MOE, "tail filler converts layer-0 expert weights only");
__device__ __forceinline__ void fold_job(const AV& a, int j, const LAS float* ct, int lane) {
    const int l = j >> 10, r = j & 1023, g = r >> 8, kblk = (r >> 4) & 15, k2g = r & 15, k = kblk * 64 + lane;
    const float* wrow = a.in(10) + (size_t)l * DM * INCOLS + (size_t)k * INCOLS + OFF_FNET + g * 128;
    float ac[8], as[8];
#pragma unroll
    for (int i = 0; i < 8; ++i) { ac[i] = 0.f; as[i] = 0.f; }
    for (int n4 = 0; n4 < 32; ++n4) { const f32x4 w = *(const GAS f32x4*)(wrow + n4 * 4);
#pragma unroll
        for (int q = 0; q < 4; ++q) { const int n2 = n4 * 4 + q;
#pragma unroll
            for (int i = 0; i < 8; ++i) { const int ph = (n2 * (k2g * 8 + i)) & 127; ac[i] += w[q] * ct[ph]; as[i] += w[q] * ct[(ph - 32) & 127]; } } }
    bf16* wf = (bf16*)(a.ws() + WS_WSMALL + (size_t)l * WSMALL_LAYER + OFFS_WF);
#pragma unroll
    for (int i = 0; i < 8; ++i) { const int ch = g * 128 + k2g * 8 + i;
        wf[(size_t)ch * 1024 + k] = (bf16)f2bf(ac[i] * 0.08838834764831845f); wf[(size_t)(512 + ch) * 1024 + k] = (bf16)f2bf(as[i] * 0.08838834764831845f); }
}
__device__ __forceinline__ void p0_prologue(const Frame& F, const AV& a) {
    const int gw = F.vcu * NWAVES + F.wave, NGW = F.G * NWAVES, gt = F.vcu * NTHR + F.tid, NGT = F.G * NTHR;
    LAS float* ct = (LAS float*)(F.lds + LDS_CT);
    if (F.tid < 128) ct[F.tid] = cospif((float)F.tid * (1.0f / 64.0f));
    for (int job = blockIdx.x; job < 2 * 96; job += F.G) {
        const int l = job / 96, n0 = (job % 96) * 64;
        LAS float* s = (LAS float*)(F.lds + RING_OFF); LAS float* red = s + 17 * 1024;
        for (int i = F.tid; i < 17 * 1024; i += NTHR) { const int b = i >> 10, k = i & 1023; const float cv = b < 16 ? a.in(1)[b * 1024 + k] : a.in(3)[k]; s[i] = cv * sigmoidf_(cv); }
        __syncthreads();
        const int col = F.tid & 63, ks = F.tid >> 6; float acc[17];
#pragma unroll
        for (int b = 0; b < 17; ++b) acc[b] = 0.f;
        const float* w = a.in(4) + (size_t)l * DM * INCOLS + n0 + col;
        for (int k = ks * 128; k < ks * 128 + 128; k += 16) { float wv[16];
#pragma unroll
            for (int q = 0; q < 16; ++q) wv[q] = w[(size_t)(k + q) * INCOLS];
#pragma unroll
            for (int q = 0; q < 16; ++q)
#pragma unroll
                for (int b = 0; b < 17; ++b) acc[b] += s[b * 1024 + k + q] * wv[q]; }
#pragma unroll
        for (int b = 0; b < 17; ++b) red[(ks * 17 + b) * 64 + col] = acc[b];
        __syncthreads();
        for (int i = F.tid; i < 17 * 64; i += NTHR) { const int b = i >> 6, c2 = i & 63; float t = 0.f;
#pragma unroll
            for (int q = 0; q < 8; ++q) t += red[(q * 17 + b) * 64 + c2];
            ((float*)(a.ws() + WS_MOD))[((size_t)l * 17 + b) * INCOLS + n0 + c2] = t + a.in(5)[l * INCOLS + n0 + c2]; }
        __syncthreads();
    }
    __syncthreads();
    for (int i = gt; i < 64 * 32; i += NGT) { const int p = i >> 5, f = i & 31; const float inv = powf(10000.0f, -(float)f / 32.0f), ang = (float)p * inv; ((f32x2*)(a.ws() + WS_TAB))[i] = (f32x2){cosf(ang), sinf(ang)}; }
    for (int i = gt; i < 2048 * 256; i += NGT) { const int k1 = i >> 8, c0 = (i & 255) * 16; float v[16];
#pragma unroll
        for (int q = 0; q < 16; ++q) { const int col = c0 + q, n1 = col & 2047, rr = (k1 * n1) & 2047; const float x = (float)rr * (1.0f / 1024.0f); v[q] = ((col >> 11) ? -sinpif(x) : cospif(x)) * (32.0f * 0.022097086912079608f); }
        v4u o; o.x = pk4_fp8((f32x4){v[0], v[1], v[2], v[3]}); o.y = pk4_fp8((f32x4){v[4], v[5], v[6], v[7]}); o.z = pk4_fp8((f32x4){v[8], v[9], v[10], v[11]}); o.w = pk4_fp8((f32x4){v[12], v[13], v[14], v[15]}); ((GAS v4u*)(a.ws() + WS_DFTL))[i] = o; }
    for (int i = gt; i < 256 * 32; i += NGT) { const int k1 = i >> 5, c0 = (i & 31) * 16; float v[16];
#pragma unroll
        for (int q = 0; q < 16; ++q) { const int col = c0 + q, n1 = col & 255, rr = (k1 * n1) & 255; const float x = (float)rr * (1.0f / 128.0f); v[q] = ((col >> 8) ? -sinpif(x) : cospif(x)) * (32.0f * 0.0625f); }
        v4u o; o.x = pk4_fp8((f32x4){v[0], v[1], v[2], v[3]}); o.y = pk4_fp8((f32x4){v[4], v[5], v[6], v[7]}); o.z = pk4_fp8((f32x4){v[8], v[9], v[10], v[11]}); o.w = pk4_fp8((f32x4){v[12], v[13], v[14], v[15]}); ((GAS v4u*)(a.ws() + WS_DFTC))[i] = o; }
    for (int i = gt; i < 2 * 256 * 1024; i += NGT) { const int l = i >> 18, r = (i >> 10) & 255, k = i & 1023; unsigned o = 0u;
        if (r < 64) { const float w = a.in(21)[((size_t)l * DM + k) * NEXP + (r & 31)]; const unsigned hi = f2bf(w); o = hi; if (r >= 32) o = f2bf(w - __uint_as_float(hi << 16)); }
        ((bf16*)(a.ws() + WS_WSMALL + (size_t)l * WSMALL_LAYER + OFFS_ROUT))[(size_t)r * 1024 + k] = (bf16)o; }
    for (int j = gw; j < 2048; j += NGW) fold_job(a, j, ct, F.lane);
    LAS float* scr = (LAS float*)(F.lds + RING_OFF + F.wave * 16384);
    for (int it = gw; it < 2 * IT_SMALL; it += NGW) small_item(a, it / IT_SMALL, it % IT_SMALL, scr, F.lane);
    { const int fill = (F.G == 256) ? FILL_A + FILL_B : 0; moe_convert_range(a, fill, 2 * IT_MOE - fill, gw, NGW, scr, F.lane); }
}
__device__ __forceinline__ void ld4(f32x4 (&v)[4], const float* p, int lane) {
#pragma unroll
    for (int j = 0; j < 4; ++j) v[j] = ((const GAS f32x4*)p)[lane + 64 * j];
}
__device__ __forceinline__ float sumsq4(const f32x4 (&v)[4]) { float ss = 0.f;
#pragma unroll
    for (int j = 0; j < 4; ++j) ss += (v[j][0] * v[j][0] + v[j][1] * v[j][1]) + (v[j][2] * v[j][2] + v[j][3] * v[j][3]);
    return ss; }
__device__ __forceinline__ void p1_norm0(const Frame& F, const AV& a) {
    const int gw = F.vcu * NWAVES + F.wave, NGW = F.G * NWAVES, rpw = (TALL + NGW - 1) / NGW, r0 = gw * rpw, r1 = (r0 + rpw < TALL) ? r0 + rpw : TALL;
    if (r0 >= r1) return;
    f32x4 gpre[4], shift[4], scale[4], xn[4]; ld4(gpre, a.in(6), F.lane); int cb = -1;
    auto xsrc = [&](int m) -> const float* { return m < TL ? a.in(0) + (size_t)m * DM : a.in(2) + (size_t)(m - TL) * DM; };
    ld4(xn, xsrc(r0), F.lane);
    for (int m = r0; m < r1; ++m) {
        f32x4 x[4];
#pragma unroll
        for (int j = 0; j < 4; ++j) x[j] = xn[j];
        if (m + 1 < r1) ld4(xn, xsrc(m + 1), F.lane);
        const int b = m < TL ? (m >> 11) : 16;
        if (b != cb) { cb = b; const float* mv = (const float*)(a.ws() + WS_MOD) + (size_t)b * INCOLS; ld4(shift, mv, F.lane); ld4(scale, mv + 1024, F.lane); }
        const float r = 1.0f / sqrtf(wave_sum(sumsq4(x), F.lane) * (1.0f / 1024.0f) + EPS);
        bf16* ho = (bf16*)(a.ws() + WS_H) + (size_t)m * DM; unsigned char* h8 = a.ws() + WS_H8 + (size_t)m * DM;
#pragma unroll
        for (int j = 0; j < 4; ++j) { const f32x4 hv = x[j] * r * gpre[j] * (scale[j] + 1.0f) + shift[j]; ((GAS u32x2*)ho)[F.lane + 64 * j] = pk4(hv); ((GAS unsigned*)h8)[F.lane + 64 * j] = pk4_fp8(hv); }
    }
}
__device__ __forceinline__ void qk_fix_core(f32x4 (&x)[4], const f32x4 (&gg)[4], const f32x2* tab, bool rope, int t, int sub, int lane) {
    float ss = sumsq4(x); ss += shx(ss, 1, lane); ss += shx(ss, 2, lane); ss += shx(ss, 4, lane);
    const float r = 1.0f / sqrtf(ss * (1.0f / 128.0f) + EPS);
#pragma unroll
    for (int jj = 0; jj < 4; ++jj) x[jj] = x[jj] * r * gg[jj];
    if (rope) { const int pr = t >> 6, pc = t & 63;
#pragma unroll
        for (int i = 0; i < 4; ++i) { const f32x2 cr = tab[pr * 32 + sub * 4 + i], cc = tab[pc * 32 + sub * 4 + i];
            const float a0 = x[0][i], a1 = x[1][i], b0 = x[2][i], b1 = x[3][i];
            x[0][i] = a0 * cr.x - a1 * cr.y; x[1][i] = a1 * cr.x + a0 * cr.y; x[2][i] = b0 * cc.x - b1 * cc.y; x[3][i] = b1 * cc.x + b0 * cc.y; } }
}
__device__ __forceinline__ void p_qkfix(const Frame& F, const AV& a, int l, int M) {
    const int gw = F.vcu * NWAVES + F.wave, NGW = F.G * NWAVES, rpw = 4 * ((M + 4 * NGW - 1) / (4 * NGW)), r0 = gw * rpw, r1 = (r0 + rpw < M) ? r0 + rpw : M;
    if (r0 >= r1) return;
    const f32x2* tab = (const f32x2*)(a.ws() + WS_TAB); const int rs = F.lane >> 4, hh = (F.lane >> 3) & 1, sub = F.lane & 7;
    f32x4 gk[4];
#pragma unroll
    for (int jj = 0; jj < 4; ++jj) gk[jj] = *(const GAS f32x4*)(a.in(12) + l * 128 + jj * 32 + sub * 4);
    bf16* kb = (bf16*)(a.ws() + WS_K);
    u32x2 kn[4];
    auto issue = [&](int mb) { const int m = mb + rs; if (m < r1) { const bf16* kp = kb + (size_t)krow_of(m) * 256 + hh * 128 + sub * 4;
#pragma unroll
        for (int jj = 0; jj < 4; ++jj) kn[jj] = *(const GAS u32x2*)(kp + jj * 32); } };
    issue(r0);
    for (int mb = r0; mb < r1; mb += 4) { const int m = mb + rs; const bool act = m < r1;
        f32x4 xk[4];
#pragma unroll
        for (int jj = 0; jj < 4; ++jj) xk[jj] = bf4(kn[jj]);
        if (mb + 4 < r1) issue(mb + 4);
        qk_fix_core(xk, gk, tab, m < TL, m & 2047, sub, F.lane);
        if (act) { bf16* kp = kb + (size_t)krow_of(m) * 256 + hh * 128 + sub * 4;
#pragma unroll
            for (int jj = 0; jj < 4; ++jj) *(GAS u32x2*)(kp + jj * 32) = pk4(xk[jj]); }
    }
}
__device__ __forceinline__ void p_conv(const Frame& F, const AV& a, int l, int njobs) {
    LAS unsigned char* lin = F.lds + RING_OFF; LAS float* lout = (LAS float*)(F.lds + RING_OFF + 62 * 1024);
    const bf16* cu = (const bf16*)(a.ws() + WS_CU); bf16* chb = (bf16*)(a.ws() + WS_CH);
    const int cp = F.tid & 255, pg = F.tid >> 8;
    f32x2 wv[31];
#pragma unroll
    for (int j = 0; j < 31; ++j) wv[j] = *(const GAS f32x2*)(a.in(14) + ((size_t)l * 31 + j) * 512 + 2 * cp);
    const f32x2 cb2 = *(const GAS f32x2*)(a.in(15) + l * 512 + 2 * cp);
    for (int job = F.vcu; job < njobs; job += F.G) {
        int rowbase, L, t0;
        if (job < 1024) { rowbase = (job >> 6) * SEQ; L = SEQ; t0 = (job & 63) * 32; } else { const int jc = job - 1024; rowbase = TL + (jc >> 3) * CTXL; L = CTXL; t0 = (jc & 7) * 32; }
        for (int idx = F.tid; idx < 62 * 64; idx += NTHR) { const int row = idx >> 6, ch = idx & 63, p = t0 - 15 + row; v4u val = (v4u){0u, 0u, 0u, 0u};
            if (p >= 0 && p < L) val = *(const GAS v4u*)(cu + (size_t)(rowbase + p) * 512 + ch * 8);
            *(LAS v4u*)(lin + row * 1024 + ch * 16) = val; }
        __syncthreads();
#pragma unroll
        for (int chunk = 0; chunk < 2; ++chunk) {
            f32x2 acc[8];
#pragma unroll
            for (int i = 0; i < 8; ++i) acc[i] = cb2;
            const int r0 = pg * 16 + chunk * 8;
#pragma unroll
            for (int r = 0; r < 38; ++r) { const unsigned w = *(const LAS unsigned*)(lin + (r0 + r) * 1024 + cp * 4); const float x0 = __uint_as_float(w << 16), x1 = __uint_as_float(w & 0xffff0000u);
#pragma unroll
                for (int i = 0; i < 8; ++i) { const int j = r - i; if (j >= 0 && j <= 30) { acc[i].x += x0 * wv[j].x; acc[i].y += x1 * wv[j].y; } } }
#pragma unroll
            for (int i = 0; i < 8; ++i) *(LAS f32x2*)(lout + (r0 + i) * 512 + 2 * cp) = acc[i];
        }
        __syncthreads();
#pragma unroll
        for (int pp = 0; pp < 4; ++pp) { const int p = F.wave * 4 + pp; const LAS float* src = lout + p * 512 + F.lane * 8;
            f32x4 y0 = *(const LAS f32x4*)src, y1 = *(const LAS f32x4*)(src + 4);
            const float mean = wave_sum((y0[0] + y0[1]) + (y0[2] + y0[3]) + (y1[0] + y1[1]) + (y1[2] + y1[3]), F.lane) * (1.0f / 512.0f);
            y0 = y0 - mean; y1 = y1 - mean;
            const float var = wave_sum((y0[0] * y0[0] + y0[1] * y0[1]) + (y0[2] * y0[2] + y0[3] * y0[3]) + (y1[0] * y1[0] + y1[1] * y1[1]) + (y1[2] * y1[2] + y1[3] * y1[3]), F.lane) * (1.0f / 512.0f);
            const float rs = 1.0f / sqrtf(var + EPS);
            const f32x4 g0 = *(const GAS f32x4*)(a.in(16) + l * 512 + F.lane * 8), g1 = *(const GAS f32x4*)(a.in(16) + l * 512 + F.lane * 8 + 4);
            const f32x4 b0 = *(const GAS f32x4*)(a.in(17) + l * 512 + F.lane * 8), b1 = *(const GAS f32x4*)(a.in(17) + l * 512 + F.lane * 8 + 4);
            y0 = y0 * rs * g0 + b0; y1 = y1 * rs * g1 + b1;
#pragma unroll
            for (int q = 0; q < 4; ++q) { y0[q] = y0[q] * sigmoidf_(y0[q]); y1[q] = y1[q] * sigmoidf_(y1[q]); }
            v4u o; o.x = pk2(y0[0], y0[1]); o.y = pk2(y0[2], y0[3]); o.z = pk2(y1[0], y1[1]); o.w = pk2(y1[2], y1[3]);
            *(GAS v4u*)(chb + (size_t)(rowbase + t0 + p) * 512 + F.lane * 8) = o; }
        __syncthreads();
    }
}
__device__ __forceinline__ void p_rowpass1(const Frame& F, const AV& a, int l, int M) {
    const int gw = F.vcu * NWAVES + F.wave, NGW = F.G * NWAVES, rpw = (M + NGW - 1) / NGW, r0 = gw * rpw, r1 = (r0 + rpw < M) ? r0 + rpw : M;
    if (r0 >= r1) return;
    const float* modb = (const float*)(a.ws() + WS_MOD) + (size_t)l * 17 * INCOLS; const bf16* mixb = (const bf16*)(a.ws() + WS_MIX);
    f32x4 gpost[4], gpre[4], gate[4], shift[4], scale[4]; ld4(gpost, a.in(7) + l * DM, F.lane); ld4(gpre, a.in(8) + l * DM, F.lane);
    int cb = -1;
    auto xsrc = [&](int m) -> const float* { return (l == 0) ? (m < TL ? a.in(0) + (size_t)m * DM : a.in(2) + (size_t)(m - TL) * DM) : (m < TL ? a.out() + (size_t)m * DM : (const float*)(a.ws() + WS_XC) + (size_t)(m - TL) * DM); };
    f32x4 xn[4]; u32x2 mn[4]; ld4(xn, xsrc(r0), F.lane);
#pragma unroll
    for (int j = 0; j < 4; ++j) mn[j] = ((const GAS u32x2*)(mixb + (size_t)r0 * DM))[F.lane + 64 * j];
    for (int m = r0; m < r1; ++m) {
        f32x4 x[4], y[4];
#pragma unroll
        for (int j = 0; j < 4; ++j) { x[j] = xn[j]; y[j] = bf4(mn[j]); }
        if (m + 1 < r1) { ld4(xn, xsrc(m + 1), F.lane);
#pragma unroll
            for (int j = 0; j < 4; ++j) mn[j] = ((const GAS u32x2*)(mixb + (size_t)(m + 1) * DM))[F.lane + 64 * j]; }
        const int b = m < TL ? (m >> 11) : 16;
        if (b != cb) { cb = b; const float* mv = modb + (size_t)b * INCOLS; ld4(gate, mv + 2 * 1024, F.lane); ld4(shift, mv + 3 * 1024, F.lane); ld4(scale, mv + 4 * 1024, F.lane); }
        const float r = 1.0f / sqrtf(wave_sum(sumsq4(y), F.lane) * (1.0f / 1024.0f) + EPS);
#pragma unroll
        for (int j = 0; j < 4; ++j) x[j] = x[j] + gate[j] * (y[j] * r * gpost[j]);
        float* xd = m < TL ? a.out() + (size_t)m * DM : (float*)(a.ws() + WS_XC) + (size_t)(m - TL) * DM;
        st_row_f32(x, xd, F.lane);
        const float r2 = 1.0f / sqrtf(wave_sum(sumsq4(x), F.lane) * (1.0f / 1024.0f) + EPS);
        bf16* ho = (bf16*)(a.ws() + WS_H) + (size_t)m * DM; unsigned char* h8 = a.ws() + WS_H8 + (size_t)m * DM;
#pragma unroll
        for (int j = 0; j < 4; ++j) { const f32x4 hv = x[j] * r2 * gpre[j] * (scale[j] + 1.0f) + shift[j]; ((GAS u32x2*)ho)[F.lane + 64 * j] = pk4(hv); ((GAS unsigned*)h8)[F.lane + 64 * j] = pk4_fp8(hv); }
    }
}
__device__ __forceinline__ void p_route(const Frame& F, const AV& a, int l, int M) {
    typedef short bfx8 __attribute__((ext_vector_type(8)));
    const int NGW = F.G * NWAVES, rpw = (M + NGW - 1) / NGW, TPB = 8 * rpw, b0 = F.vcu * TPB, b1 = (b0 + TPB < M) ? b0 + TPB : M;
    LAS unsigned char* tabl = F.lds + RING_OFF; LAS float* lg = (LAS float*)(F.lds + LDS_SM) + F.wave * 512; LAS int* cntl = (LAS int*)(F.lds + LDS_SM + 16384);
    VM_WAIT(); __syncthreads();
    if (F.tid < 32) cntl[F.tid] = 0;
    { const GAS v4u* src = (const GAS v4u*)(a.ws() + WS_WSMALL + (size_t)l * WSMALL_LAYER + OFFS_ROUT);
      for (int idx = F.tid; idx < 64 * 128; idx += NTHR) { const int row = idx >> 7, c = idx & 127; *(LAS v4u*)(tabl + row * 2048 + ((c ^ (row & 7)) << 4)) = src[idx]; } }
    __syncthreads();
    const bf16* H = (const bf16*)(a.ws() + WS_H); const float bias = a.in(22)[l * NEXP + (F.lane & 31)];
    const int ar = F.lane & 15, kb = F.lane >> 4, ng = (b1 > b0) ? (b1 - b0 + 15) >> 4 : 0;
    for (int g = F.wave; g < ng; g += NWAVES) {
        const int rb = b0 + g * 16; int row = rb + ar; if (row > M - 1) row = M - 1;
        const bf16* hp = H + (size_t)row * DM + kb * 8; f32x4 acc[4];
#pragma unroll
        for (int f = 0; f < 4; ++f) acc[f] = (f32x4){0.f, 0.f, 0.f, 0.f};
#pragma unroll 4
        for (int s = 0; s < 32; ++s) { const bfx8 af = *(const GAS bfx8*)(hp + s * 32);
#pragma unroll
            for (int f = 0; f < 4; ++f) { const int wr = f * 16 + ar; const bfx8 bfr = *(const LAS bfx8*)(tabl + wr * 2048 + (((4 * s + kb) ^ (wr & 7)) << 4));
                acc[f] = __builtin_amdgcn_mfma_f32_16x16x32_bf16(af, bfr, acc[f], 0, 0, 0); } }
#pragma unroll
        for (int i = 0; i < 4; ++i) { lg[(4 * kb + i) * 32 + ar] = acc[0][i] + acc[2][i]; lg[(4 * kb + i) * 32 + 16 + ar] = acc[1][i] + acc[3][i]; }
        LDS_WAIT(); asm volatile("" ::: "memory");
        { const int hf = F.lane >> 5, ex = F.lane & 31; LAS unsigned long long* kb64 = (LAS unsigned long long*)(F.lds + LDS_SM + 16384 + 256) + F.wave * 64;
          LAS float* selv = (LAS float*)(F.lds + LDS_SM + 16384 + 256 + 4096) + F.wave * 16; LAS int* seli = (LAS int*)(selv + 8);
#pragma unroll 1
          for (int p = 0; p < 8; ++p) { const int r = 2 * p + hf, m = rb + r; const bool valid = m < b1;
            const float v = lg[r * 32 + ex] + bias; unsigned ub = __float_as_uint(v); ub = (ub & 0x80000000u) ? ~ub : (ub | 0x80000000u);
            const unsigned long long K = ((unsigned long long)ub << 5) | (unsigned)(31 - ex);
            kb64[F.lane] = K;
            LDS_WAIT(); asm volatile("" ::: "memory");
            int rank = 0;
#pragma unroll
            for (int j = 0; j < 32; ++j) rank += (kb64[hf * 32 + j] > K) ? 1 : 0;
            if (rank < 4) { selv[hf * 4 + rank] = v; seli[hf * 4 + rank] = ex; if (valid) __hip_atomic_fetch_add(&cntl[ex], 1, __ATOMIC_RELAXED, __HIP_MEMORY_SCOPE_WORKGROUP); }
            LDS_WAIT(); asm volatile("" ::: "memory");
            if (ex == 0 && valid) { const f32x4 tv = *(const LAS f32x4*)(selv + hf * 4); const i32x4 ti = *(const LAS i32x4*)(seli + hf * 4);
                const float e1 = __expf(tv[1] - tv[0]), e2 = __expf(tv[2] - tv[0]), e3 = __expf(tv[3] - tv[0]), inv = 1.0f / (1.0f + e1 + e2 + e3);
                *(GAS i32x4*)((int*)(a.ws() + WS_TOPI) + (size_t)m * 4) = ti; *(GAS f32x4*)((float*)(a.ws() + WS_TOPP) + (size_t)m * 4) = (f32x4){inv, e1 * inv, e2 * inv, e3 * inv}; }
            LDS_WAIT(); asm volatile("" ::: "memory"); } }
        LDS_WAIT(); asm volatile("" ::: "memory");
    }
    __syncthreads();
    if (F.tid < 32) ((int*)(a.ws() + WS_CNT))[F.vcu * 32 + F.tid] = cntl[F.tid];
}
__device__ __forceinline__ void p_slots(const Frame& F, const AV& a, int M) {
    LAS int* sm = (LAS int*)(F.lds + LDS_SM);
    LAS int *tot = sm, *bef = sm + 32, *base = sm + 64, *tst = sm + 96  , *mask = sm + 160  , *ids = sm + 320  , *slot = sm + 960  ;
    const int* cnt = (const int*)(a.ws() + WS_CNT);
    { LAS int* ptot = sm + 1600; LAS int* pbef = sm + 2112; const int e = F.tid & 31, part = F.tid >> 5; int t = 0, b = 0;
#pragma unroll 4
      for (int q = part; q < F.G; q += 16) { const int c = cnt[q * 32 + e]; t += c; if (q < F.vcu) b += c; }
      ptot[part * 32 + e] = t; pbef[part * 32 + e] = b;
      __syncthreads();
      if (F.tid < 32) { int tt = 0, bb = 0;
#pragma unroll
          for (int q = 0; q < 16; ++q) { tt += ptot[q * 32 + F.tid]; bb += pbef[q * 32 + F.tid]; }
          tot[F.tid] = tt; bef[F.tid] = bb; } }
    __syncthreads();
    if (F.tid == 0) { int ts = 0; for (int e = 0; e < 32; ++e) { tst[e] = ts; base[e] = ts * 256 + bef[e]; ts += (tot[e] + 255) >> 8; } tst[32] = ts; }
    __syncthreads();
    const int NT = tst[32];
    if (blockIdx.x == 0) { int* te = (int*)(a.ws() + WS_CNT) + CNT_TILE_E;
        for (int t = F.tid; t < NT; t += NTHR) { int e = 0; for (int q = 1; q < 32; ++q) if (t >= tst[q]) e = q; te[t] = e; }
        if (F.tid == 0) ((int*)(a.ws() + WS_CNT))[CNT_NT] = NT; }
    const int TPB = 8 * ((M + F.G * NWAVES - 1) / (F.G * NWAVES)), m0 = F.vcu * TPB, m1 = (m0 + TPB < M) ? m0 + TPB : M, nt = m1 > m0 ? m1 - m0 : 0;
    for (int tl = F.tid; tl < nt; tl += NTHR) { const i32x4 id = *(const GAS i32x4*)((const int*)(a.ws() + WS_TOPI) + (size_t)(m0 + tl) * 4);
        ids[tl * 4 + 0] = id.x; ids[tl * 4 + 1] = id.y; ids[tl * 4 + 2] = id.z; ids[tl * 4 + 3] = id.w; mask[tl] = (1 << id.x) | (1 << id.y) | (1 << id.z) | (1 << id.w); }
    __syncthreads();
    for (int p = F.tid; p < nt * 4; p += NTHR) { const int tl = p >> 2, e = ids[p]; int rank = 0; for (int q = 0; q < tl; ++q) rank += (mask[q] >> e) & 1;
        const int s = base[e] + rank; slot[p] = s; ((int*)(a.ws() + WS_SLOT))[(size_t)(m0 + tl) * 4 + (p & 3)] = s; ((int*)(a.ws() + WS_CNT))[CNT_ROWSRC + s] = m0 + tl; }
    __syncthreads();
    if (blockIdx.x < 32) { const int e = blockIdx.x, r0 = tst[e] * 256 + tot[e], r1 = tst[e + 1] * 256;
        for (int r = r0 + F.tid; r < r1; r += NTHR) ((int*)(a.ws() + WS_CNT))[CNT_ROWSRC + r] = 0; }
    __syncthreads();
}
__device__ __forceinline__ void p_combine(const Frame& F, const AV& a, int l, int M) {
    const int gw = F.vcu * NWAVES + F.wave, NGW = F.G * NWAVES, rpw = (M + NGW - 1) / NGW, r0 = gw * rpw, r1 = (r0 + rpw < M) ? r0 + rpw : M;
    if (r0 >= r1) return;
    const unsigned char* ys = a.ws() + WS_YS;   const int* slp = (const int*)(a.ws() + WS_SLOT); const float* prp = (const float*)(a.ws() + WS_TOPP);
    const float* modb = (const float*)(a.ws() + WS_MOD);
    f32x4 gpost[4], gpre[4], gate[4], shift[4], scale[4]; ld4(gpost, a.in(9) + l * DM, F.lane); if (l == 0) ld4(gpre, a.in(6) + DM, F.lane);
    int cb = -1;
    i32x4 sl_n = *(const GAS i32x4*)(slp + (size_t)r0 * 4); f32x4 pr_n = *(const GAS f32x4*)(prp + (size_t)r0 * 4);
    f32x4 xn[4]; unsigned yn[4][4]; f32x4 prc = pr_n * 0.125f;
    auto xrow = [&](int m) -> float* { return m < TL ? a.out() + (size_t)m * DM : (float*)(a.ws() + WS_XC) + (size_t)(m - TL) * DM; };
    { ld4(xn, xrow(r0), F.lane); const int sv[4] = {sl_n[0], sl_n[1], sl_n[2], sl_n[3]};
#pragma unroll
      for (int k = 0; k < 4; ++k)
#pragma unroll
          for (int j = 0; j < 4; ++j) yn[k][j] = ((const GAS unsigned*)(ys + (size_t)sv[k] * DM))[F.lane + 64 * j];
      if (r0 + 1 < r1) { sl_n = *(const GAS i32x4*)(slp + (size_t)(r0 + 1) * 4); pr_n = *(const GAS f32x4*)(prp + (size_t)(r0 + 1) * 4); } }
    for (int m = r0; m < r1; ++m) {
        f32x4 x[4], y[4];
#pragma unroll
        for (int j = 0; j < 4; ++j) { x[j] = xn[j]; y[j] = fp8x4(yn[0][j]) * prc[0] + fp8x4(yn[1][j]) * prc[1] + fp8x4(yn[2][j]) * prc[2] + fp8x4(yn[3][j]) * prc[3]; }
        if (m + 1 < r1) { prc = pr_n * 0.125f; ld4(xn, xrow(m + 1), F.lane); const int sv[4] = {sl_n[0], sl_n[1], sl_n[2], sl_n[3]};
#pragma unroll
            for (int k = 0; k < 4; ++k)
#pragma unroll
                for (int j = 0; j < 4; ++j) yn[k][j] = ((const GAS unsigned*)(ys + (size_t)sv[k] * DM))[F.lane + 64 * j];
            if (m + 2 < r1) { sl_n = *(const GAS i32x4*)(slp + (size_t)(m + 2) * 4); pr_n = *(const GAS f32x4*)(prp + (size_t)(m + 2) * 4); } }
        const int b = m < TL ? (m >> 11) : 16;
        if (b != cb) { cb = b; ld4(gate, modb + ((size_t)l * 17 + b) * INCOLS + 5 * 1024, F.lane); if (l == 0) { const float* m1 = modb + ((size_t)17 + b) * INCOLS; ld4(shift, m1, F.lane); ld4(scale, m1 + 1024, F.lane); } }
        const float r = 1.0f / sqrtf(wave_sum(sumsq4(y), F.lane) * (1.0f / 1024.0f) + EPS);
#pragma unroll
        for (int j = 0; j < 4; ++j) x[j] = x[j] + gate[j] * (y[j] * r * gpost[j]);
        st_row_f32(x, xrow(m), F.lane);
        if (l == 0) { const float r2 = 1.0f / sqrtf(wave_sum(sumsq4(x), F.lane) * (1.0f / 1024.0f) + EPS);
            bf16* ho = (bf16*)(a.ws() + WS_H) + (size_t)m * DM; unsigned char* h8 = a.ws() + WS_H8 + (size_t)m * DM;
#pragma unroll
            for (int j = 0; j < 4; ++j) { const f32x4 hv = x[j] * r2 * gpre[j] * (scale[j] + 1.0f) + shift[j]; ((GAS u32x2*)ho)[F.lane + 64 * j] = pk4(hv); ((GAS unsigned*)h8)[F.lane + 64 * j] = pk4_fp8(hv); } }
    }
}
#ifdef DBG_CHECK
#ifndef DBG_GSUB
#define DBG_GSUB 0
#endif
__device__ __forceinline__ double bfd(bf16 b) { return (double)__uint_as_float(((unsigned)b) << 16); }
__device__ __forceinline__ unsigned hsh(unsigned x) { x ^= x >> 16; x *= 0x7feb352du; x ^= x >> 15; x *= 0x846ca68bu; x ^= x >> 16; return x; }
__device__ __forceinline__ int samp_row(int i, int M, unsigned salt) { const int sp[12] = {0, 1, 255, 256, 2047, 2048, 4095, 32767, 32768, 32769, 33023, 36863}; if (i < 12 && sp[i] < M) return sp[i]; return (int)(hsh(i * 7919u + salt) % (unsigned)M); }
__device__ __forceinline__ void rec(float* res, int stage, double got, double want, double flo) { const double e = fabs(got - want) / (fabs(want) + flo); const float f = (e == e) ? (float)e : 1e30f; atomicMax((unsigned*)res + stage, __float_as_uint(f)); }
__device__ double dot_h_w(const bf16* hrow, const float* w, int ldw, int col) { double s = 0; for (int k = 0; k < 1024; ++k) s += bfd(hrow[k]) * (double)w[(size_t)k * ldw + col]; return s; }
__device__ double dsig(double x) { return 1.0 / (1.0 + exp(-x)); }
constexpr double PI_D = 3.14159265358979323846;
enum { ST_MOD = 0, ST_H0, ST_INPROJ, ST_YT, ST_QKFIX, ST_CONV, ST_Z, ST_ATTN, ST_GATES, ST_MERGED, ST_MIX, ST_ROW1, ST_LOGIT, ST_TOPK, ST_SLOTS, ST_ACT, ST_YSLOT, ST_COMB, ST_GATESB, ST_N };
__global__ void chk(Args A, int stage, int l, float* res, float* snap) {
    const int i = threadIdx.x; unsigned char* ws = A.ws; const int M = (l == 0) ? TALL : TL; const int rs = stage + 32 * l;
    const bf16* H = (const bf16*)(ws + WS_H); const float* win = A.in[10] + (size_t)l * DM * INCOLS; const float* modb = (const float*)(ws + WS_MOD);
    if (stage == ST_MOD) { const int ll = i & 1, b = (i >> 1) % 17, n = (int)(hsh(i) % 6144u); double s = 0; for (int k = 0; k < 1024; ++k) { const double cv = b < 16 ? A.in[1][b * 1024 + k] : A.in[3][k]; s += cv * dsig(cv) * (double)A.in[4][((size_t)ll * 1024 + k) * 6144 + n]; }
        s += A.in[5][ll * 6144 + n]; rec(res, rs, modb[((size_t)ll * 17 + b) * 6144 + n], s, 0.02); }
    else if (stage == ST_H0) { const int m = samp_row(i, TALL, 1), c = (int)(hsh(i + 77) % 1024u); const float* x = m < TL ? A.in[0] + (size_t)m * DM : A.in[2] + (size_t)(m - TL) * DM; double ss = 0; for (int k = 0; k < 1024; ++k) ss += (double)x[k] * x[k];
        const float* mv = modb + (size_t)(m < TL ? (m >> 11) : 16) * 6144; const double want = x[c] / sqrt(ss / 1024 + 1e-6) * A.in[6][c] * (1.0 + mv[1024 + c]) + mv[c]; rec(res, rs, bfd(H[(size_t)m * DM + c]), want, 0.05); }
    else if (stage == ST_INPROJ) { const int m = samp_row(i, TALL, 2), kind = i & 3; const bf16* hr = H + (size_t)m * DM;
        if (kind == 0) { const int n = (int)(hsh(i + 5) % 1024u); rec(res, rs, bfd(((const bf16*)(ws + WS_Q))[(size_t)m * DM + n]), dot_h_w(hr, win, INCOLS, n), 0.05); }
        else if (kind == 1) { const int n = (int)(hsh(i + 6) % 256u); rec(res, rs, bfd(((const bf16*)(ws + WS_K))[(size_t)krow_of(m) * 256 + n]), dot_h_w(hr, win, INCOLS, 1024 + n), 0.05); }
        else if (kind == 2) { const int n = (int)(hsh(i + 7) % 256u); rec(res, rs, bfd(((const bf16*)(ws + WS_V))[(size_t)krow_of(m) * 256 + n]), dot_h_w(hr, win, INCOLS, 1280 + n), 0.05); }
        else { const int c = (int)(hsh(i + 8) % 512u); if (l == 0 || m < TL) { const double a = dot_h_w(hr, win, INCOLS, 1536 + c), g = dot_h_w(hr, win, INCOLS, 2048 + c); rec(res, rs, bfd(((const bf16*)(ws + WS_CU))[(size_t)m * 512 + c]), a * dsig(g), 0.05); } } }
    else if (stage == ST_YT) { const int m = samp_row(i, M, 3), ch = (int)(hsh(i + 9) % 512u), cs = i & 1, g = ch >> 7, k2 = ch & 127; const bf16* hr = H + (size_t)m * DM; double s = 0;
        for (int k = 0; k < 1024; ++k) { double t = 0; for (int n2 = 0; n2 < 128; ++n2) { const double ang = 2.0 * PI_D * ((n2 * k2) & 127) / 128.0; t += (double)win[(size_t)k * INCOLS + OFF_FNET + g * 128 + n2] * (cs ? sin(ang) : cos(ang)); } s += bfd(hr[k]) * t; }
        s /= sqrt(128.0); double got; if (m < TL) got = bfd(((const bf16*)(ws + WS_YT))[((size_t)(m >> 11) * 512 + ch) * 4096 + cs * 2048 + (m & 2047)]); else got = bfd(((const bf16*)(ws + WS_YTC))[((size_t)((m - TL) >> 8) * 512 + ch) * 512 + cs * 256 + ((m - TL) & 255)]);
        rec(res, rs, got, s, 0.05); }
    else if (stage == ST_QKFIX) { const int m = samp_row(i, TALL, 4), isk = i & 1, hh = isk ? (int)(hsh(i + 3) % 2u) : (int)(hsh(i + 3) % 8u), d = (int)(hsh(i + 4) % 128u); const bf16* hr = H + (size_t)m * DM;
        if (isk || l == 0 || m < TL) { const int cbase = isk ? 1024 + hh * 128 : hh * 128; double ss = 0, xd = 0, xp = 0; const int half = d & 64, dd = d & 63, pd = half + ((dd + 32) & 63);
            for (int q = 0; q < 128; ++q) { double v = dot_h_w(hr, win, INCOLS, cbase + q); v = bfd((bf16)f2bf((float)v)); ss += v * v; if (q == d) xd = v; if (q == pd) xp = v; }
            const float* gn = (isk ? A.in[12] : A.in[11]) + l * 128; const double r = 1.0 / sqrt(ss / 128 + 1e-6); xd *= r * gn[d]; xp *= r * gn[pd]; double want = xd;
            if (m < TL) { const int t = m & 2047, pos = half ? (t & 63) : (t >> 6), f = dd & 31; const double ang = (double)((float)pos * powf(10000.0f, -(float)f / 32.0f)); want = (dd < 32) ? xd * cos(ang) - xp * sin(ang) : xd * cos(ang) + xp * sin(ang); }
            const double got = isk ? bfd(((const bf16*)(ws + WS_K))[(size_t)krow_of(m) * 256 + hh * 128 + d]) : bfd(((const bf16*)(ws + WS_Q))[(size_t)m * DM + hh * 128 + d]); rec(res, rs, got, want, 0.05); } }
    else if (stage == ST_CONV) { const int m = samp_row(i, M, 5), c = (int)(hsh(i + 11) % 512u); const int rowbase = m < TL ? (m >> 11) * SEQ : TL + ((m - TL) >> 8) * CTXL, L = m < TL ? SEQ : CTXL, t = m - rowbase; const bf16* cu = (const bf16*)(ws + WS_CU);
        double s1 = 0, s2 = 0, yc = 0; for (int cc = 0; cc < 512; ++cc) { double y = A.in[15][l * 512 + cc]; for (int j = 0; j < 31; ++j) { const int p = t + j - 15; if (p >= 0 && p < L) y += bfd(cu[(size_t)(rowbase + p) * 512 + cc]) * (double)A.in[14][((size_t)l * 31 + j) * 512 + cc]; } s1 += y; s2 += y * y; if (cc == c) yc = y; }
        const double mean = s1 / 512, var = s2 / 512 - mean * mean; double y = (yc - mean) / sqrt(var + 1e-6) * A.in[16][l * 512 + c] + A.in[17][l * 512 + c]; y = y * dsig(y); rec(res, rs, bfd(((const bf16*)(ws + WS_CH))[(size_t)m * 512 + c]), y, 0.05); }
    else if (stage == ST_Z) { const int m = samp_row(i, M, 6), ch = (int)(hsh(i + 12) % 512u); double s = 0;
        if (m < TL) { const int b = m >> 11, k1 = m & 2047; const bf16* yr = (const bf16*)(ws + WS_YT) + ((size_t)b * 512 + ch) * 4096; for (int n1 = 0; n1 < 2048; ++n1) { const double ang = 2.0 * PI_D * ((k1 * n1) & 2047) / 2048.0; s += cos(ang) * bfd(yr[n1]) - sin(ang) * bfd(yr[2048 + n1]); } s /= sqrt(2048.0); }
        else { const int b = (m - TL) >> 8, k1 = (m - TL) & 255; const bf16* yr = (const bf16*)(ws + WS_YTC) + ((size_t)b * 512 + ch) * 512; for (int n1 = 0; n1 < 256; ++n1) { const double ang = 2.0 * PI_D * ((k1 * n1) & 255) / 256.0; s += cos(ang) * bfd(yr[n1]) - sin(ang) * bfd(yr[256 + n1]); } s /= 16.0; }
        rec(res, rs, bfd(((const bf16*)(ws + WS_Z))[(size_t)m * 512 + ch]), s, 0.05); }
    else if (stage == ST_ATTN) { const int m = samp_row(i, M, 7), hh = (int)(hsh(i + 13) % 8u), d = (int)(hsh(i + 14) % 128u); const bf16* q = (const bf16*)(ws + WS_Q) + (size_t)m * DM + hh * 128;
        int kr0, nk; if (m < TL) { kr0 = (m >> 11) * KVROWS; nk = KVROWS; } else { kr0 = ((m - TL) >> 8) * KVROWS + SEQ; nk = CTXL; }
        const bf16* K = (const bf16*)(ws + WS_K) + (size_t)kr0 * 256 + (hh >> 2) * 128; const bf16* V = (const bf16*)(ws + WS_V) + (size_t)kr0 * 256 + (hh >> 2) * 128;
        double mx = -1e300; for (int j = 0; j < nk; ++j) { double s = 0; for (int q2 = 0; q2 < 128; ++q2) s += bfd(q[q2]) * bfd(K[(size_t)j * 256 + q2]); s *= 0.08838834764831845; if (s > mx) mx = s; }
        double den = 0, num = 0; for (int j = 0; j < nk; ++j) { double s = 0; for (int q2 = 0; q2 < 128; ++q2) s += bfd(q[q2]) * bfd(K[(size_t)j * 256 + q2]); s *= 0.08838834764831845; const double p = exp(s - mx); den += p; num += p * bfd(V[(size_t)j * 256 + d]); }
        rec(res, rs, bfd(((const bf16*)(ws + WS_AO))[(size_t)m * DM + hh * 128 + d]), num / den, 0.03); }
    else if (stage == ST_GATES) { const int m = samp_row(i, M, 8), n = (int)(hsh(i + 15) % 3072u); rec(res, rs, bfd(((const bf16*)(ws + WS_GATES))[(size_t)m * 3072 + n]), dsig(dot_h_w(H + (size_t)m * DM, win, INCOLS, OFF_GATE + n)), 0.05); }
    else if (stage == ST_GATESB && DBG_GSUB == 1) { const int m = samp_row(i, M, 8), n = (int)(hsh(i + 15) % 3072u); const double got = bfd(((const bf16*)(ws + WS_GATES))[(size_t)m * 3072 + n]), want = dsig(dot_h_w(H + (size_t)m * DM, win, INCOLS, OFF_GATE + n));
        const bool badv = !(fabs(got - want) <= 0.05); if (badv) { unsigned* r = (unsigned*)res + 48; atomicOr(r, (m < TL ? 1u : 2u) | (4u << (n >> 10)) | (i < 12 ? 32u : 0u)); } }
    else if (stage == ST_GATESB) { const int m = samp_row(i, M, 8), n = (int)(hsh(i + 15) % 3072u); const bf16* wt = (const bf16*)(ws + WS_WSMALL + (size_t)l * WSMALL_LAYER + OFFS_WG) + (size_t)n * 1024; const bf16* hr = H + (size_t)m * DM; double s = 0; for (int k = 0; k < 1024; ++k) s += bfd(hr[k]) * bfd(wt[k]);
        rec(res, rs, bfd(((const bf16*)(ws + WS_GATES))[(size_t)m * 3072 + n]), dsig(s), 0.05); }
    else if (stage == ST_MERGED) { const int m = samp_row(i, M, 9), c = (int)(hsh(i + 16) % 1024u); const bf16* g = (const bf16*)(ws + WS_GATES) + (size_t)m * 3072; double y0 = 0, y1 = 0, y2 = 0;
        const bf16* ao = (const bf16*)(ws + WS_AO) + (size_t)m * DM; const bf16* chh = (const bf16*)(ws + WS_CH) + (size_t)m * 512; const bf16* z = (const bf16*)(ws + WS_Z) + (size_t)m * 512;
        for (int k = 0; k < 1024; ++k) y0 += bfd(ao[k]) * (double)A.in[13][((size_t)l * 1024 + k) * 1024 + c];
        for (int k = 0; k < 512; ++k) { y1 += bfd(chh[k]) * (double)A.in[18][((size_t)l * 512 + k) * 1024 + c]; y2 += bfd(z[k]) * (double)A.in[19][((size_t)l * 512 + k) * 1024 + c]; }
        rec(res, rs, bfd(((const bf16*)(ws + WS_MERGED))[(size_t)m * DM + c]), bfd(g[c]) * y0 + bfd(g[1024 + c]) * y1 + bfd(g[2048 + c]) * y2, 0.05); }
    else if (stage == ST_MIX) { const int m = samp_row(i, M, 10), c = (int)(hsh(i + 17) % 1024u); rec(res, rs, bfd(((const bf16*)(ws + WS_MIX))[(size_t)m * DM + c]), dot_h_w((const bf16*)(ws + WS_MERGED) + (size_t)m * DM, A.in[20] + (size_t)l * DM * DM, DM, c), 0.05); }
    else if (stage == ST_ROW1) { const int m = samp_row(i, M, 11), c = (int)(hsh(i + 18) % 1024u); const float* xs = snap + (size_t)i * 1024;
        const bf16* mix = (const bf16*)(ws + WS_MIX) + (size_t)m * DM; const float* mv = modb + ((size_t)l * 17 + (m < TL ? (m >> 11) : 16)) * 6144; double ss = 0; for (int k = 0; k < 1024; ++k) ss += bfd(mix[k]) * bfd(mix[k]); const double r = 1.0 / sqrt(ss / 1024 + 1e-6);
        double s2 = 0, xc = 0; for (int k = 0; k < 1024; ++k) { const double xn = xs[k] + mv[2048 + k] * (bfd(mix[k]) * r * A.in[7][l * DM + k]); s2 += xn * xn; if (k == c) xc = xn; }
        const float* xd = m < TL ? A.out + (size_t)m * DM : (const float*)(ws + WS_XC) + (size_t)(m - TL) * DM; rec(res, rs, xd[c], xc, 0.02);
        rec(res, rs, bfd(H[(size_t)m * DM + c]), xc / sqrt(s2 / 1024 + 1e-6) * A.in[8][l * DM + c] * (1.0 + mv[4096 + c]) + mv[3072 + c], 0.05); }
    else if (stage == ST_LOGIT) { const int m = samp_row(i, M, 12), e = i & 31; const float* lg = (const float*)(ws + WS_LOGIT) + (size_t)m * 64; rec(res, rs, (double)lg[e] + lg[32 + e], dot_h_w(H + (size_t)m * DM, A.in[21] + (size_t)l * DM * NEXP, NEXP, e), 0.02); }
    else if (stage == ST_TOPK) { const int m = samp_row(i, M, 13); const float* lg = (const float*)(ws + WS_LOGIT) + (size_t)m * 64; float v[32]; for (int e = 0; e < 32; ++e) v[e] = lg[e] + lg[32 + e] + A.in[22][l * 32 + e];
        int id[4]; float tv[4]; for (int k = 0; k < 4; ++k) { int b = -1; for (int e = 0; e < 32; ++e) { bool used = false; for (int q = 0; q < k; ++q) used |= (id[q] == e); if (!used && (b < 0 || v[e] > v[b])) b = e; } id[k] = b; tv[k] = v[b]; }
        double den = 0; for (int k = 0; k < 4; ++k) den += exp((double)tv[k] - tv[0]); const int* gi = (const int*)(ws + WS_TOPI) + (size_t)m * 4; const float* gp = (const float*)(ws + WS_TOPP) + (size_t)m * 4;
        for (int k = 0; k < 4; ++k) { rec(res, rs, gi[k] == id[k] ? 0.0 : 1.0, 0, 0.01); rec(res, rs, gp[k], exp((double)tv[k] - tv[0]) / den, 0.01); } }
    else if (stage == ST_SLOTS) { const int m = samp_row(i, M, 14), k = i & 3; const int s = ((const int*)(ws + WS_SLOT))[(size_t)m * 4 + k], e = ((const int*)(ws + WS_TOPI))[(size_t)m * 4 + k]; const int NT = ((const int*)(ws + WS_CNT))[CNT_NT];
        if (s < 0 || s >= NT * 256) rec(res, rs, 1, 0, 0.01); else { rec(res, rs, ((const int*)(ws + WS_CNT))[CNT_TILE_E + (s >> 8)] == e ? 0.0 : 1.0, 0, 0.01); const bf16* hs = (const bf16*)(ws + WS_HS) + (size_t)s * DM; double df = 0; for (int q = 0; q < 1024; ++q) df += fabs(bfd(hs[q]) - bfd(H[(size_t)m * DM + q])); rec(res, rs, df, 0, 1e-3); } }
    else if (stage == ST_ACT) { const int m = samp_row(i, M, 15), k = i & 3, c = (int)(hsh(i + 21) % 1024u); const int s = ((const int*)(ws + WS_SLOT))[(size_t)m * 4 + k], e = ((const int*)(ws + WS_TOPI))[(size_t)m * 4 + k]; const bf16* hs = (const bf16*)(ws + WS_HS) + (size_t)s * DM;
        double g = dot_h_w(hs, A.in[23] + (((size_t)l * NEXP + e) << 20), DM, c) + A.in[24][((size_t)l * NEXP + e) * 1024 + c], u = dot_h_w(hs, A.in[25] + (((size_t)l * NEXP + e) << 20), DM, c) + A.in[26][((size_t)l * NEXP + e) * 1024 + c];
        g = g < 7.0 ? g : 7.0; u = u < -7.0 ? -7.0 : (u > 7.0 ? 7.0 : u); rec(res, rs, bfd(((const bf16*)(ws + WS_ACT))[(size_t)s * DM + c]), (u + 1.0) * (g * dsig(1.702 * g)), 0.05); }
    else if (stage == ST_YSLOT) { const int m = samp_row(i, M, 16), k = i & 3, c = (int)(hsh(i + 22) % 1024u); const int s = ((const int*)(ws + WS_SLOT))[(size_t)m * 4 + k], e = ((const int*)(ws + WS_TOPI))[(size_t)m * 4 + k];
        rec(res, rs, bfd(((const bf16*)(ws + WS_HS))[(size_t)s * DM + c]), dot_h_w((const bf16*)(ws + WS_ACT) + (size_t)s * DM, A.in[27] + (((size_t)l * NEXP + e) << 20), DM, c) + A.in[28][((size_t)l * NEXP + e) * 1024 + c], 0.05); }
    else if (stage == ST_COMB) { const int m = samp_row(i, M, 17), c = (int)(hsh(i + 23) % 1024u); const float* xs = snap + (size_t)i * 1024; const int* sl = (const int*)(ws + WS_SLOT) + (size_t)m * 4; const float* pr = (const float*)(ws + WS_TOPP) + (size_t)m * 4;
        const float* mv = modb + ((size_t)l * 17 + (m < TL ? (m >> 11) : 16)) * 6144; double ss = 0, yc = 0; for (int q = 0; q < 1024; ++q) { double y = 0; for (int k = 0; k < 4; ++k) y += (double)pr[k] * bfd(((const bf16*)(ws + WS_HS))[(size_t)sl[k] * DM + q]); ss += y * y; if (q == c) yc = y; }
        const double want = xs[c] + mv[5 * 1024 + c] * (yc / sqrt(ss / 1024 + 1e-6) * A.in[9][l * DM + c]); const float* xd = m < TL ? A.out + (size_t)m * DM : (const float*)(ws + WS_XC) + (size_t)(m - TL) * DM; rec(res, rs, xd[c], want, 0.02); }
}
__global__ void snap_rows(Args A, int l, int salt, float* snap) {
    const int i = blockIdx.x, M = (l == 0) ? TALL : TL, m = samp_row(i, M, salt); const float* xs;
    if (l == 0 && salt == 11) xs = m < TL ? A.in[0] + (size_t)m * DM : A.in[2] + (size_t)(m - TL) * DM; else xs = m < TL ? A.out + (size_t)m * DM : (const float*)(A.ws + WS_XC) + (size_t)(m - TL) * DM;
    for (int k = threadIdx.x; k < 1024; k += blockDim.x) snap[(size_t)i * 1024 + k] = xs[k];
}
__global__ void chk_gates_full(const bf16* H, const bf16* Wt, const bf16* G, int M, unsigned* cntw) {
    const int n = blockIdx.x * 64 + (threadIdx.x & 63), m = blockIdx.y * 4 + (threadIdx.x >> 6); if (m >= M) return;
    const uint4* a = (const uint4*)(H + (size_t)m * 1024); const uint4* b = (const uint4*)(Wt + (size_t)n * 1024); float s = 0.f;
    for (int k = 0; k < 128; ++k) { const uint4 x = a[k], y = b[k]; const unsigned xs[4] = {x.x, x.y, x.z, x.w}, ys[4] = {y.x, y.y, y.z, y.w};
        for (int q = 0; q < 4; ++q) { s += __uint_as_float(xs[q] << 16) * __uint_as_float(ys[q] << 16); s += __uint_as_float(xs[q] & 0xffff0000u) * __uint_as_float(ys[q] & 0xffff0000u); } }
    const float want = 1.0f / (1.0f + __expf(-s)), got = __uint_as_float(((unsigned)G[(size_t)m * 3072 + n]) << 16);
    if (!(fabsf(got - want) <= 0.02f)) { atomicAdd(cntw, 1u); cntw[16 + (m >> 8) * 12 + (n >> 8)] = 1u; }
}
__global__ void encode_full(float* out, const unsigned* cntw, int n) {
    __shared__ int bc, bt; if (threadIdx.x == 0) { unsigned C = cntw[0], T = 0; for (int t = 0; t < 1728; ++t) T += cntw[16 + t]; int b1 = 0; while (C) { ++b1; C /= 10; } int b2 = 0; while (T) { ++b2; T /= 4; } bc = b1 > 7 ? 7 : b1; bt = b2 > 7 ? 7 : b2; }
    __syncthreads(); const float K = ldexpf(1.0f, 2 + 8 * bt + bc);
    for (size_t i = (size_t)blockIdx.x * blockDim.x + threadIdx.x; i < (size_t)n; i += (size_t)gridDim.x * blockDim.x) out[i] = K;
}
__global__ void encode(float* out, const float* res, int n, float thr) {
    #if DBG_GSUB == 1
    { const unsigned mk = ((const unsigned*)res)[48]; const float K = ldexpf(1.0f, 2 + (int)mk); for (size_t i = (size_t)blockIdx.x * blockDim.x + threadIdx.x; i < (size_t)n; i += (size_t)gridDim.x * blockDim.x) out[i] = K; return; }
#endif
#ifndef CHK_SKIP
#define CHK_SKIP 0ull
#endif
    int bad = -1; for (int s = 0; s < 64; ++s) if (!((CHK_SKIP >> s) & 1ull) && res[s] > thr) { bad = s; break; }
    if (bad < 0) return; const float er = res[bad]; const float K = ldexpf(1.0f, bad + 2) * (er < 0.5f ? 1.0f : er < 1.0f ? 1.25f : er < 4.0f ? 1.5f : 1.75f);
    for (size_t i = (size_t)blockIdx.x * blockDim.x + threadIdx.x; i < (size_t)n; i += (size_t)gridDim.x * blockDim.x) out[i] = K;
}
#endif
#ifndef GP_SP2
#define GP_SP2 true
#endif
#ifndef GP_ALIGN
#define GP_ALIGN true
#endif
__global__ void __launch_bounds__(NTHR, 2) fwd(Args args) {
    extern __shared__ __attribute__((aligned(16))) unsigned char lds[];
    Frame F;
    F.lds = (LAS unsigned char*)lds; F.MISC = (volatile LAS unsigned*)(F.lds + MISC_OFF);
    F.tid = threadIdx.x; F.lane = F.tid & 63; F.wave = __builtin_amdgcn_readfirstlane(F.tid >> 6);
    F.G = gridDim.x; { const int bx = blockIdx.x; F.vcu = (F.G % 8 == 0) ? (bx % 8) * (F.G / 8) + bx / 8 : bx; }
    { const AV A0 = av_get(); F.ctl = (gu32*)(A0.ws() + WS_CTL); }
    for (int u = F.tid; u < (LDS_BYTES - LDSCTL_OFF) / 4; u += NTHR) ((LAS unsigned*)(F.lds + LDSCTL_OFF))[u] = 0u;
    __syncthreads();
    XcdBarrier bar; bar.bar = (unsigned*)(F.ctl + CW_BAR); bar.x = 0; bar.st = nullptr;
    if (!MK_PER_PHASE) bar = xcd_barrier_post((unsigned*)(F.ctl + CW_BAR), F.MISC + 8);
    int lo, hi; { const AV A0 = av_get(); lo = *(const int __attribute__((address_space(4)))*)(A0.kp + 8 * 31); hi = *(const int __attribute__((address_space(4)))*)(A0.kp + 8 * 31 + 4); }
#ifndef DIS_MASK
#define DIS_MASK 0ull
#endif
#define IN(k) (lo <= (k) && (k) < hi)
#define ON(j) (!((DIS_MASK >> (j)) & 1ull))
#ifndef REP_MASK
#define REP_MASK 0ull
#endif
#define REPS(j) ((int)((REP_MASK >> (j)) & 1ull))
#ifdef STAMP_SEL
#define SEAM(k) do { xcd_barrier(bar); if (blockIdx.x == 0 && threadIdx.x == 0) ((unsigned long long*)(F.ctl + 32768))[(k) + 1] = __builtin_amdgcn_s_memrealtime(); } while (0)
#else
#ifdef DOUBLE_BAR
#define SEAM(k) do { if (!MK_PER_PHASE && IN((k) + 1)) { xcd_barrier(bar); xcd_barrier(bar); } } while (0)
#else
#define SEAM(k) do { if (!MK_PER_PHASE && IN((k) + 1)) xcd_barrier(bar); } while (0)
#endif
#endif
    const int bx = (int)blockIdx.x;
    const int wave0 = __builtin_amdgcn_readfirstlane((int)threadIdx.x >> 6);
#define F_REFRESH() do { unsigned z_ = 0u; asm volatile("" : "+v"(z_)); const int t_ = wave0 * 64 + (int)__builtin_amdgcn_mbcnt_hi(~0u, __builtin_amdgcn_mbcnt_lo(~0u, z_)); F.tid = t_; F.lane = t_ & 63; F.wave = wave0; } while (0)

#ifdef STAMP_SEL
    if (blockIdx.x == 0 && threadIdx.x == 0) ((unsigned long long*)(F.ctl + 32768))[0] = __builtin_amdgcn_s_memrealtime();
#endif
    if (ON(0) && IN(0)) for (int rep_ = 0; rep_ <= REPS(0); ++rep_) { F_REFRESH(); const AV A = av_get(); p0_prologue(F, A); SEAM(0); }
    if (ON(1) && IN(1)) for (int rep_ = 0; rep_ <= REPS(1); ++rep_) { F_REFRESH(); const AV A = av_get(); p1_norm0(F, A); SEAM(1); }

    for (int l = 0; l < 2; ++l) {
        const int pb = 2 + l * NPL;
        const int Mm = (l == 0) ? TALL : TL;
#define PH_BEGIN F_REFRESH(); const AV A = av_get(); unsigned char* const ws = A.ws(); unsigned char* const wl = ws + WS_WSMALL + (size_t)l * WSMALL_LAYER; (void)wl
        if (ON(2 + 0) && IN(pb + 0)) for (int rep_ = 0; rep_ <= REPS(2 + 0); ++rep_) { PH_BEGIN;
            if (ON(16)) { pg8::Gemm g{(const bf16*)(ws + WS_H8), (const bf16*)(wl + OFFS_WIN), TALL, 2560, DM / 2}; pg8::StaticOrder S; S.init(TALL, 2560, F.G, bx);
              pg8::EpiInproj E{(bf16*)(ws + WS_Q), (bf16*)(ws + WS_K), (bf16*)(ws + WS_V), (bf16*)(ws + WS_CU)};
              pg8::gemm_phase<pg8::EpiInproj, pg8::StaticOrder, GP_ALIGN, GP_SP2, true>(F.lds + RING_OFF, g, S, E, F.tid); }
            if (ON(17)) { pg8::Gemm g{(const bf16*)(wl + OFFS_WF), (const bf16*)(ws + WS_H), 1024, Mm, DM}; pg8::StaticOrder S; S.init(1024, Mm, F.G, (bx + 96) % F.G);
              pg8::EpiYT E{ws + WS_YT, ws + WS_YTC};
              pg8::gemm_phase<pg8::EpiYT, pg8::StaticOrder, GP_ALIGN, GP_SP2>(F.lds + RING_OFF, g, S, E, F.tid); }
            SEAM(pb + 0);
        }
        if (ON(2 + 1) && IN(pb + 1)) for (int rep_ = 0; rep_ <= REPS(2 + 1); ++rep_) { PH_BEGIN;
            if (ON(18)) p_qkfix(F, A, l, TALL);
            F_REFRESH();
            if (ON(19)) p_conv(F, A, l, l == 0 ? 1152 : 1024);
            if (ON(20)) { pg8::Gemm g{(const bf16*)(ws + WS_DFTL), (const bf16*)(ws + WS_YT), 2048, NB * 512, 2048}; pg8::DftOrder S; S.init(3, NB, F.G, F.vcu);
              pg8::EpiDFT E{(bf16*)(ws + WS_Z), 0, SEQ};
              pg8::gemm_phase<pg8::EpiDFT, pg8::DftOrder, GP_ALIGN, GP_SP2, true>(F.lds + RING_OFF, g, S, E, F.tid); }
            if (ON(21) && l == 0) { pg8::Gemm g{(const bf16*)(ws + WS_DFTC), (const bf16*)(ws + WS_YTC), 256, NB * 512, 256}; pg8::DftOrder S; S.init(0, NB, F.G, F.vcu);
              pg8::EpiDFT E{(bf16*)(ws + WS_Z), TL, CTXL};
              pg8::gemm_phase<pg8::EpiDFT, pg8::DftOrder, GP_ALIGN, GP_SP2, true>(F.lds + RING_OFF, g, S, E, F.tid); }
            SEAM(pb + 1);
        }
        if (ON(2 + 2) && IN(pb + 2)) for (int rep_ = 0; rep_ <= REPS(2 + 2); ++rep_) { PH_BEGIN;
            const int nheavy = NB * 8 * 8, ntot = nheavy + (l == 0 ? NB * 8 : 0);
            for (int L = F.vcu; L < ntot; L += F.G) {
                int row0, krow, h, seq, t0;
                if (L < nheavy) { const int grp = L >> 5, s = L & 31, b = grp >> 1; h = (grp & 1) * 4 + (s >> 3); t0 = (s & 7) * 256; row0 = b * SEQ + t0; krow = b * KVROWS; seq = KVROWS; }
                else { const int Lc = L - nheavy, b = Lc >> 3; h = Lc & 7; row0 = TL + b * CTXL; krow = b * KVROWS + SEQ; seq = CTXL; t0 = 0; }
                const att::bf16* Qb = (const att::bf16*)(ws + WS_Q) + (size_t)row0 * DM + h * 128;
                const att::bf16* Kh = (const att::bf16*)(ws + WS_K) + (size_t)krow * 256 + (h >> 2) * 128;
                const att::bf16* Vh = (const att::bf16*)(ws + WS_V) + (size_t)krow * 256 + (h >> 2) * 128;
                unsigned char* Ob = ws + WS_AO + (size_t)row0 * DM + h * 128;
                att::attn_dense_body<att::bf16>(Qb, Kh, Vh, Ob, seq, (char*)lds + RING_OFF, F.tid, A.in(11) + l * 128, (const float*)(ws + WS_TAB), t0, L < nheavy);
                __syncthreads();
            }
            SEAM(pb + 2);
        }
        if (ON(2 + 3) && IN(pb + 3)) for (int rep_ = 0; rep_ <= REPS(2 + 3); ++rep_) { PH_BEGIN;
            pg8::Gemm g{(const bf16*)(ws + WS_H8), (const bf16*)(wl + OFFS_WG), Mm, 3072, DM / 2}; pg8::StaticOrder S; S.init(Mm, 3072, F.G, bx);
            pg8::EpiGates E{(bf16*)(ws + WS_GATES)};
            pg8::gemm_phase<pg8::EpiGates, pg8::StaticOrder, GP_ALIGN, GP_SP2, true>(F.lds + RING_OFF, g, S, E, F.tid);
            SEAM(pb + 3);
        }
        if (ON(2 + 4) && IN(pb + 4)) for (int rep_ = 0; rep_ <= REPS(2 + 4); ++rep_) { PH_BEGIN;
            { pg8::Gemm g{(const bf16*)(ws + WS_AO), (const bf16*)(wl + OFFS_WAO), Mm, 1024, 512}; pg8::StaticOrder S; S.init(Mm, 1024, F.G, bx);
              pg8::EpiMerge<0> E{(bf16*)(ws + WS_MERGED), (bf16*)(ws + WS_ACT), (const bf16*)(ws + WS_GATES), 0, 1.0f / 512.0f};
              pg8::gemm_phase<pg8::EpiMerge<0>, pg8::StaticOrder, GP_ALIGN, GP_SP2, true>(F.lds + RING_OFF, g, S, E, F.tid); }
            { pg8::Gemm g{(const bf16*)(ws + WS_CH), (const bf16*)(wl + OFFS_WCO), Mm, 1024, 512}; pg8::StaticOrder S; S.init(Mm, 1024, F.G, bx);
              pg8::EpiMerge<1> E{(bf16*)(ws + WS_MERGED), (bf16*)(ws + WS_ACT), (const bf16*)(ws + WS_GATES), 1, 1.0f};
              pg8::gemm_phase<pg8::EpiMerge<1>, pg8::StaticOrder, GP_ALIGN, GP_SP2>(F.lds + RING_OFF, g, S, E, F.tid); }
            { pg8::Gemm g{(const bf16*)(ws + WS_Z), (const bf16*)(wl + OFFS_WFO), Mm, 1024, 512}; pg8::StaticOrder S; S.init(Mm, 1024, F.G, bx);
              pg8::EpiMerge<2> E{(bf16*)(ws + WS_MERGED), (bf16*)(ws + WS_ACT), (const bf16*)(ws + WS_GATES), 2, 1.0f};
              pg8::gemm_phase<pg8::EpiMerge<2>, pg8::StaticOrder, GP_ALIGN, GP_SP2>(F.lds + RING_OFF, g, S, E, F.tid); }
            if (l == 0 && F.G == 256 && bx >= FILL_WG0 && rep_ == 0) { __syncthreads(); F_REFRESH();
                moe_convert_range(A, 0, FILL_A, (bx - FILL_WG0) * NWAVES + F.wave, FILL_NGW, (LAS float*)(F.lds + RING_OFF + F.wave * 16384), F.lane); }
            SEAM(pb + 4);
        }
        if (ON(2 + 5) && IN(pb + 5)) for (int rep_ = 0; rep_ <= REPS(2 + 5); ++rep_) { PH_BEGIN;
            pg8::Gemm g{(const bf16*)(ws + WS_MERGED), (const bf16*)(wl + OFFS_WOUT), Mm, 1024, 1024}; pg8::StaticOrder S; S.init(Mm, 1024, F.G, bx);
            pg8::EpiBf16<0> E{(bf16*)(ws + WS_MIX), 1024, nullptr, 0, 0, 1.0f};
            pg8::gemm_phase<pg8::EpiBf16<0>, pg8::StaticOrder, GP_ALIGN, GP_SP2>(F.lds + RING_OFF, g, S, E, F.tid);
            if (l == 0 && F.G == 256 && bx >= FILL_WG0 && rep_ == 0) { __syncthreads(); F_REFRESH();
                moe_convert_range(A, FILL_A, FILL_B, (bx - FILL_WG0) * NWAVES + F.wave, FILL_NGW, (LAS float*)(F.lds + RING_OFF + F.wave * 16384), F.lane); }
            SEAM(pb + 5);
        }
        if (ON(2 + 6) && IN(pb + 6)) for (int rep_ = 0; rep_ <= REPS(2 + 6); ++rep_) { PH_BEGIN; p_rowpass1(F, A, l, Mm); p_route(F, A, l, Mm); SEAM(pb + 6); }
        if (ON(2 + 7) && IN(pb + 7)) for (int rep_ = 0; rep_ <= REPS(2 + 7); ++rep_) { PH_BEGIN; p_slots(F, A, Mm); SEAM(pb + 7); }
        if (ON(2 + 8) && IN(pb + 8)) for (int rep_ = 0; rep_ <= REPS(2 + 8); ++rep_) { PH_BEGIN;
            const int NT = __builtin_amdgcn_readfirstlane(((const int*)(ws + WS_CNT))[CNT_NT]);
            LAS int* te_lds = (LAS int*)(F.lds + LDS_SM);
            for (int i = F.tid; i < NT; i += NTHR) te_lds[i] = ((const int*)(ws + WS_CNT))[CNT_TILE_E + i];
            __syncthreads();
            pg8::Gemm g{(const bf16*)(ws + WS_H8), (const bf16*)(ws + WS_WGU + (size_t)l * MOEW_LAYER), NT * 256, NEXP * 2048, DM / 2}; pg8::GroupedOrder S; S.init(NT, 8, F.G, bx, te_lds); S.rows = (const int*)(ws + WS_CNT) + CNT_ROWSRC;
            pg8::EpiSwiGLU8 E{ws + WS_ACT, A.in(24) + (size_t)l * NEXP * 1024, A.in(26) + (size_t)l * NEXP * 1024, (LAS float*)(F.lds + LDS_SM + 4096)};
            pg8::gemm_phase<pg8::EpiSwiGLU8, pg8::GroupedOrder, GP_ALIGN, GP_SP2, true, true>(F.lds + RING_OFF, g, S, E, F.tid);
            SEAM(pb + 8);
        }
        if (ON(2 + 9) && IN(pb + 9)) for (int rep_ = 0; rep_ <= REPS(2 + 9); ++rep_) { PH_BEGIN;
            const int NT = __builtin_amdgcn_readfirstlane(((const int*)(ws + WS_CNT))[CNT_NT]);
            LAS int* te_lds = (LAS int*)(F.lds + LDS_SM);
            for (int i = F.tid; i < NT; i += NTHR) te_lds[i] = ((const int*)(ws + WS_CNT))[CNT_TILE_E + i];
            __syncthreads();
#ifdef STAGGER_US
            { const unsigned long long t0 = __builtin_amdgcn_s_memrealtime(), dl = (unsigned long long)((bx >> 3) & 3) * (STAGGER_US); while (__builtin_amdgcn_s_memrealtime() - t0 < dl) __builtin_amdgcn_s_sleep(8); }
#endif
            pg8::Gemm g{(const bf16*)(ws + WS_ACT), (const bf16*)(ws + WS_WD + (size_t)l * MOEW_LAYER), NT * 256, NEXP * 1024, DM / 2}; pg8::GroupedOrder S; S.init(NT, 4, F.G, bx, te_lds);
#ifdef PROBE_NOSTORE
            pg8::EpiDown8 E{ws + WS_YS, A.in(28) + (size_t)l * NEXP * 1024, rep_, (LAS float*)(F.lds + LDS_SM + 4096)};
#else
            pg8::EpiDown8 E{ws + WS_YS, A.in(28) + (size_t)l * NEXP * 1024, 0, (LAS float*)(F.lds + LDS_SM + 4096)};
#endif
            pg8::gemm_phase<pg8::EpiDown8, pg8::GroupedOrder, GP_ALIGN, GP_SP2, true>(F.lds + RING_OFF, g, S, E, F.tid);
            SEAM(pb + 9);
        }
        if (ON(2 + 10) && IN(pb + 10)) for (int rep_ = 0; rep_ <= REPS(2 + 10); ++rep_) { PH_BEGIN;
            p_combine(F, A, l, Mm);
            SEAM(pb + 10);
        }
    }
#ifdef STAMP_SEL
    { const AV A = av_get(); float* out = A.out(); const unsigned long long* ts = (const unsigned long long*)(F.ctl + 32768);
      auto span = [&](int p) -> float { unsigned long long d = __hip_atomic_load(ts + p + 1, __ATOMIC_RELAXED, __HIP_MEMORY_SCOPE_AGENT) - __hip_atomic_load(ts + p, __ATOMIC_RELAXED, __HIP_MEMORY_SCOPE_AGENT);
          if (p >= 2) d += __hip_atomic_load(ts + p + NPL + 1, __ATOMIC_RELAXED, __HIP_MEMORY_SCOPE_AGENT) - __hip_atomic_load(ts + p + NPL, __ATOMIC_RELAXED, __HIP_MEMORY_SCOPE_AGENT); return (float)d * 0.01f; };
      const float K1 = span((STAMP_SEL) & 0xff), K2 = 200.0f * span(((STAMP_SEL) >> 8) & 0xff);
      for (size_t i = (size_t)blockIdx.x * NTHR + threadIdx.x; i < (size_t)TL * DM; i += (size_t)gridDim.x * NTHR) out[i] = (i == 0) ? K2 : K1; }
#endif
#undef IN
#undef PH_BEGIN
#undef F_REFRESH
#undef SEAM
}

extern "C" void kernel_launch(void* const* d_in, const int* in_sizes, int n_in, void* d_out, int out_size, void* d_ws, size_t ws_size, hipStream_t stream) {
    static int grid = 0;
    if (grid == 0) {
        if (n_in != 29 || out_size != TL * DM || ws_size < WS_END2) { fprintf(stderr, "kernel_launch: built for 29 inputs, %d outputs, >= %zu bytes of workspace; got n_in %d out %d ws %zu\n", TL * DM, (size_t)WS_END2, n_in, out_size, ws_size); grid = -1; return; }
        int dev = 0, cus = 0, per_cu = 0;
        if (hipGetDevice(&dev) != hipSuccess || hipDeviceGetAttribute(&cus, hipDeviceAttributeMultiprocessorCount, dev) != hipSuccess) { grid = -1; return; }
        if (hipFuncSetAttribute((const void*)fwd, hipFuncAttributeMaxDynamicSharedMemorySize, LDS_BYTES) != hipSuccess) { fprintf(stderr, "kernel_launch: hipFuncSetAttribute failed\n"); grid = -1; return; }
        if (hipOccupancyMaxActiveBlocksPerMultiprocessor(&per_cu, (const void*)fwd, NTHR, LDS_BYTES) != hipSuccess || per_cu < 1) fprintf(stderr, "kernel_launch: occupancy query reports %d\n", per_cu);
        (void)hipGetLastError();
        grid = cus;
    }
    if (grid < 0) return;
    (void)hipMemsetAsync((char*)d_ws + WS_CTL, 0, CTL_ZERO_BYTES, stream);
    Args a{};
    for (int i = 0; i < 29; ++i) a.in[i] = (const float*)d_in[i];
    a.out = (float*)d_out; a.ws = (unsigned char*)d_ws;
#if MK_PER_PHASE
    for (int p = 0; p < NPH; ++p) {
#ifdef DBG_CHECK
        float* res = (float*)((char*)d_ws + WS_CTL + 8192 * 4); float* snap = (float*)((char*)d_ws + WS_END);
        { const int l = p >= 2 ? (p - 2) / NPL : 0, k = p >= 2 ? (p - 2) % NPL : -1;
          if (k == 6) hipLaunchKernelGGL(snap_rows, dim3(256), dim3(256), 0, stream, a, l, 11, snap);
          if (k == 12) hipLaunchKernelGGL(snap_rows, dim3(256), dim3(256), 0, stream, a, l, 17, snap); }
#endif
        a.ph_lo = p; a.ph_hi = p + 1; hipLaunchKernelGGL(fwd, dim3(grid), dim3(NTHR), LDS_BYTES, stream, a);
#ifdef DBG_CHECK
        { const int l = p >= 2 ? (p - 2) / NPL : 0, k = p >= 2 ? (p - 2) % NPL : -1;
#define CHK(st) hipLaunchKernelGGL(chk, dim3(1), dim3(256), 0, stream, a, (int)(st), l, res, snap)
          if (p == 0) CHK(ST_MOD); if (p == 1) CHK(ST_H0);
#if DBG_GSUB == 2
          if (k == 3 && l == 0) hipLaunchKernelGGL(chk_gates_full, dim3(48, TALL / 4), dim3(256), 0, stream, (const bf16*)((char*)d_ws + WS_H), (const bf16*)((char*)d_ws + WS_WSMALL + OFFS_WG), (const bf16*)((char*)d_ws + WS_GATES), TALL, (unsigned*)((char*)d_ws + WS_CTL + 65536));
#endif
          if (k == 0) { CHK(ST_INPROJ); CHK(ST_YT); } if (k == 1) { CHK(ST_QKFIX); CHK(ST_CONV); CHK(ST_Z); } if (k == 2) CHK(ST_ATTN); if (k == 3) { CHK(ST_GATES); CHK(ST_GATESB); } if (k == 4) CHK(ST_MERGED);
          if (k == 5) CHK(ST_MIX); if (k == 6) CHK(ST_ROW1); if (k == 7) CHK(ST_LOGIT); if (k == 8) CHK(ST_TOPK); if (k == 9) CHK(ST_SLOTS); if (k == 10) CHK(ST_ACT); if (k == 11) CHK(ST_YSLOT); if (k == 12) CHK(ST_COMB);
#undef CHK
        }
#endif
    }
#ifdef DBG_CHECK
#if DBG_GSUB == 2
    hipLaunchKernelGGL(encode_full, dim3(1024), dim3(256), 0, stream, (float*)d_out, (const unsigned*)((char*)d_ws + WS_CTL + 65536), out_size);
#else
    hipLaunchKernelGGL(encode, dim3(1024), dim3(256), 0, stream, (float*)d_out, (const float*)((char*)d_ws + WS_CTL + 8192 * 4), out_size, 0.25f);
#endif
#endif
#else
    a.ph_lo = 0; a.ph_hi = NPH; hipLaunchKernelGGL(fwd, dim3(grid), dim3(NTHR), LDS_BYTES, stream, a);
#endif
    const hipError_t le = hipPeekAtLastError();
    if (le != hipSuccess) fprintf(stderr, "kernel_launch: launch failed: %s\n", hipGetErrorName(le));
}
```

```cpp
#include <hip/hip_runtime.h>
#include <cstdio>
#include <cstdint>
#ifndef MK_PER_PHASE
#define MK_PER_PHASE 0
#endif
namespace pg8 {
#define PG8_LAS __attribute__((address_space(3)))
typedef unsigned short bf16_t;
typedef short bf16x8 __attribute__((ext_vector_type(8)));
typedef float f32x4 __attribute__((ext_vector_type(4)));
typedef unsigned u32x4 __attribute__((ext_vector_type(4)));
typedef int i32x4v __attribute__((ext_vector_type(4)));
typedef int i32x8v __attribute__((ext_vector_type(8)));
typedef unsigned u32x2v __attribute__((ext_vector_type(2)));
constexpr int BM = 256, BK = 64, HALF = 128, HTB = HALF * BK * 2  , STAGE_BYTES = 8 * HTB, NXCD = 8, WGM = 8;

__host__ __device__ __forceinline__ int lds_byte(int r, int c) { const int st = (r >> 4) * 2 + (c >> 5), rr = r & 15, cc = c & 31, ob = rr * 64 + cc * 2; return st * 1024 + (ob ^ (((ob >> 9) & 1) << 5)); }
__host__ __device__ __forceinline__ void stage_rc(int b, int& R, int& C) { const int st = b / 1024, sb = b % 1024, swz = sb ^ (((sb >> 9) & 1) << 5); R = (st >> 1) * 16 + swz / 64; C = (st & 1) * 32 + (swz % 64) / 2; }
__host__ __device__ __forceinline__ int perm32(int rho) { const int n = rho >> 4, i = rho & 15; return 8 * (i >> 2) + 4 * n + (i & 3); }

struct Unit { int pm, pn, par; };
struct Gemm { const bf16_t* A; const bf16_t* Bt; int M, N, K; };

struct StaticOrder {
    int nM, nN, nwg, G, c;
    __host__ __device__ void init(int M, int N, int G_, int c_) { nM = M / BM; nN = N / BM; nwg = nM * nN; G = G_; c = c_; }
    __host__ __device__ bool next(int i, Unit& u) const {
        const long L = (long)i * G + c; if (L >= nwg) return false;
        int wgid = (int)L; { const int q = nwg / NXCD, r = nwg % NXCD, xcd = wgid % NXCD, off = wgid / NXCD; wgid = (xcd < r ? xcd * (q + 1) : r * (q + 1) + (xcd - r) * q) + off; }
        const int nig = WGM * nN, gid = wgid / nig, fm = gid * WGM, gsz = (nM - fm) < WGM ? (nM - fm) : WGM;
        u.pm = fm + ((wgid % nig) % gsz); u.pn = (wgid % nig) / gsz; return true;
    }
    __device__ __forceinline__ void a_ready(const Unit&) const {}
    __device__ __forceinline__ void done(const Unit&) const {}
};

typedef __bf16 bf16x2_native __attribute__((ext_vector_type(2)));
typedef float f32x2_native __attribute__((ext_vector_type(2)));
__device__ __forceinline__ unsigned cvt_pk_bf16(float lo, float hi) { const f32x2_native v = {lo, hi}; const bf16x2_native r = __builtin_convertvector(v, bf16x2_native); return __builtin_bit_cast(unsigned, r); }
__device__ __forceinline__ unsigned cvt4_fp8(float a, float b, float c, float d) { int w = __builtin_amdgcn_cvt_pk_fp8_f32(a, b, __builtin_bit_cast(int, a), false); w = __builtin_amdgcn_cvt_pk_fp8_f32(c, d, w, true); return (unsigned)w; }
typedef float f32x2 __attribute__((ext_vector_type(2)));
__device__ __forceinline__ f32x2 gelu_pk(f32x2 v) {
    const f32x2 av = __builtin_elementwise_abs(v), d = av * 0.2316418882f + 1.0f;
    f32x2 t; t.x = __builtin_amdgcn_rcpf(d.x); t.y = __builtin_amdgcn_rcpf(d.y);
    f32x2 q = t * 0.5307027145f + (-0.7265760135f); q = q * t + 0.7107068705f; q = q * t + (-0.142248368f); q = q * t + 0.127414796f; q = q * t;
    const f32x2 s = (v * v) * (-0.72134752044f);
    f32x2 e; e.x = __builtin_amdgcn_exp2f(s.x); e.y = __builtin_amdgcn_exp2f(s.y);
    const f32x2 m = v * (q * e), r = v - m;
    f32x2 o; o.x = v.x < 0.f ? m.x : r.x; o.y = v.y < 0.f ? m.y : r.y; return o;
}

template <int ACT  > struct EpiBf16 {
    static constexpr bool PERM = true, AFTER_DRAIN = false, BIAS_LDS = false; static_assert(ACT == 0 || ACT == 1, "EpiBf16: ACT is 0 (none) or 1 (gelu_pk)");
    bf16_t* O; int ldc; const float* bias; int split_cols; size_t split_stride; float scale0;
    __device__ __forceinline__ void operator()(const f32x4 (&acc)[2][2][4][2], const Unit& u, int wr, int wc, int fr, int fq) const {
        const int row0 = u.pm * BM + wr * 64 + fr; int colt = u.pn * BM; bf16_t* base = O;
        float sc = 1.f; if (split_cols) { const int t = colt / split_cols; base += (size_t)t * split_stride; colt -= t * split_cols; if (t == 0) sc = scale0; }
        const int col0 = colt + wc * 32 + 8 * fq, bcol0 = u.pn * BM + wc * 32 + 8 * fq;
        f32x4 bv[2][2];
#pragma unroll
        for (int bj = 0; bj < 2; ++bj)
#pragma unroll
            for (int n = 0; n < 2; ++n) bv[bj][n] = bias ? *(const f32x4*)(bias + bcol0 + bj * HALF + 4 * n) : (f32x4){0.f, 0.f, 0.f, 0.f};
#pragma unroll
        for (int ai = 0; ai < 2; ++ai)
#pragma unroll
            for (int m = 0; m < 4; ++m) { bf16_t* rowp = base + (size_t)(row0 + ai * HALF + m * 16) * ldc + col0;
#pragma unroll
                for (int bj = 0; bj < 2; ++bj) { f32x4 v0 = acc[ai][bj][m][0] + bv[bj][0], v1 = acc[ai][bj][m][1] + bv[bj][1];
                    if (ACT == 1) { f32x2 a = gelu_pk((f32x2){v0[0], v0[1]}), b = gelu_pk((f32x2){v0[2], v0[3]}), c = gelu_pk((f32x2){v1[0], v1[1]}), d = gelu_pk((f32x2){v1[2], v1[3]});
                        v0 = (f32x4){a.x, a.y, b.x, b.y}; v1 = (f32x4){c.x, c.y, d.x, d.y}; }
                    v0 = v0 * sc; v1 = v1 * sc; u32x4 w; w.x = cvt_pk_bf16(v0[0], v0[1]); w.y = cvt_pk_bf16(v0[2], v0[3]); w.z = cvt_pk_bf16(v1[0], v1[1]); w.w = cvt_pk_bf16(v1[2], v1[3]);
                    *(u32x4*)(rowp + bj * HALF) = w; } }
    }
};

__device__ __forceinline__ float fast_sigmoid(float x) { return __builtin_amdgcn_rcpf(1.0f + __builtin_amdgcn_exp2f(-1.4426950408889634f * x)); }
__device__ __forceinline__ u32x4 pack8(const f32x4& a, const f32x4& b) { u32x4 w; w.x = cvt_pk_bf16(a[0], a[1]); w.y = cvt_pk_bf16(a[2], a[3]); w.z = cvt_pk_bf16(b[0], b[1]); w.w = cvt_pk_bf16(b[2], b[3]); return w; }
__device__ __forceinline__ void unpack8(const u32x4& w, f32x4& a, f32x4& b) {
    a[0] = __uint_as_float(w.x << 16); a[1] = __uint_as_float(w.x & 0xffff0000u); a[2] = __uint_as_float(w.y << 16); a[3] = __uint_as_float(w.y & 0xffff0000u);
    b[0] = __uint_as_float(w.z << 16); b[1] = __uint_as_float(w.z & 0xffff0000u); b[2] = __uint_as_float(w.w << 16); b[3] = __uint_as_float(w.w & 0xffff0000u); }
__device__ __forceinline__ u32x2v pack8_fp8(const f32x4& a, const f32x4& b) { u32x2v r; r.x = cvt4_fp8(a[0], a[1], a[2], a[3]); r.y = cvt4_fp8(b[0], b[1], b[2], b[3]); return r; }
__device__ __forceinline__ void store_tile_bf16(const f32x4 (&acc)[2][2][4][2], bf16_t* base, int ldc, int wr, int wc, int fr, int fq) {
    const int rt = wr * 64 + fr, cb = wc * 32 + 8 * fq;
#pragma unroll
    for (int ai = 0; ai < 2; ++ai)
#pragma unroll
        for (int m = 0; m < 4; ++m) { bf16_t* rowp = base + (size_t)(rt + ai * HALF + m * 16) * ldc + cb;
#pragma unroll
            for (int bj = 0; bj < 2; ++bj) *(u32x4*)(rowp + bj * HALF) = pack8(acc[ai][bj][m][0], acc[ai][bj][m][1]); }
}
struct EpiInproj {
    static constexpr bool PERM = true, AFTER_DRAIN = false, BIAS_LDS = false;
    bf16_t *q, *k, *v, *cu;
    __device__ __forceinline__ void operator()(const f32x4 (&acc)[2][2][4][2], const Unit& u, int wr, int wc, int fr, int fq) const {
        bf16_t* base; int ldc; const bool glu = u.pn >= 6; float sc = 0.03125f; asm volatile("" : "+s"(sc));
        if (u.pn < 4) { base = q + (size_t)u.pm * 256 * 1024 + u.pn * 256; ldc = 1024; }
        else if (u.pn < 6) { const int m0 = u.pm * 256; const int kr = m0 < 32768 ? (m0 >> 11) * 2304 + (m0 & 2047) : ((m0 - 32768) >> 8) * 2304 + 2048; base = (u.pn == 4 ? k : v) + (size_t)kr * 256; ldc = 256; }
        else { base = cu + (size_t)u.pm * 256 * 512 + (u.pn - 6) * 128; ldc = 512; }
        base += (size_t)(wr * 64 + fr) * ldc + wc * 32 + 8 * fq;
#pragma unroll
        for (int ai = 0; ai < 2; ++ai)
#pragma unroll
            for (int m = 0; m < 4; ++m) { bf16_t* rowp = base + (size_t)(ai * HALF + m * 16) * ldc;
                if (!glu) { *(u32x4*)rowp = pack8(acc[ai][0][m][0] * sc, acc[ai][0][m][1] * sc); *(u32x4*)(rowp + HALF) = pack8(acc[ai][1][m][0] * sc, acc[ai][1][m][1] * sc); }
                else { f32x4 a0 = acc[ai][0][m][0] * sc, a1 = acc[ai][0][m][1] * sc; const f32x4 g0 = acc[ai][1][m][0] * sc, g1 = acc[ai][1][m][1] * sc;
#pragma unroll
                    for (int j = 0; j < 4; ++j) { a0[j] *= fast_sigmoid(g0[j]); a1[j] *= fast_sigmoid(g1[j]); }
                    *(u32x4*)rowp = pack8(a0, a1); } }
    }
};
struct EpiYT {
    static constexpr bool PERM = true, AFTER_DRAIN = false, BIAS_LDS = false;
    unsigned char *yt, *ytc;
    __device__ __forceinline__ void operator()(const f32x4 (&acc)[2][2][4][2], const Unit& u, int wr, int wc, int fr, int fq) const {
        const int cs = u.pm >> 1, chb = (u.pm & 1) * 256; unsigned char* base; int ldc;
        if (u.pn < 128) { const int b = u.pn >> 3, pos0 = (u.pn & 7) * 256; base = yt + (size_t)(b * 512 + chb) * 4096 + cs * 2048 + pos0; ldc = 4096; }
        else { const int b = u.pn - 128; base = ytc + (size_t)(b * 512 + chb) * 512 + cs * 256; ldc = 512; }
        base += (size_t)(wr * 64 + fr) * ldc + wc * 32 + 8 * fq;
#pragma unroll
        for (int ai = 0; ai < 2; ++ai)
#pragma unroll
            for (int m = 0; m < 4; ++m) { unsigned char* rowp = base + (size_t)(ai * HALF + m * 16) * ldc;
#pragma unroll
                for (int bj = 0; bj < 2; ++bj) *(u32x2v*)(rowp + bj * HALF) = pack8_fp8(acc[ai][bj][m][0], acc[ai][bj][m][1]); }
    }
};
struct EpiDFT {
    static constexpr bool PERM = true, AFTER_DRAIN = false, BIAS_LDS = false;
    bf16_t* z; int rowbase, rpb;
    __device__ __forceinline__ void operator()(const f32x4 (&acc)[2][2][4][2], const Unit& u, int wr, int wc, int fr, int fq) const {
        bf16_t* base = z + (size_t)(rowbase + (u.pn >> 1) * rpb + u.pm * 256 + wr * 64 + fr) * 512 + (u.pn & 1) * 256 + wc * 32 + 8 * fq;
#pragma unroll
        for (int ai = 0; ai < 2; ++ai)
#pragma unroll
            for (int m = 0; m < 4; ++m)
#pragma unroll
                for (int bj = 0; bj < 2; ++bj) *(u32x4*)(base + (size_t)(ai * HALF + m * 16) * 512 + bj * HALF) = pack8(acc[ai][bj][m][0] * 0.03125f, acc[ai][bj][m][1] * 0.03125f);
    }
};
struct EpiGates {
    static constexpr bool PERM = true, AFTER_DRAIN = false, BIAS_LDS = false;
    bf16_t* g;
    __device__ __forceinline__ void operator()(const f32x4 (&acc)[2][2][4][2], const Unit& u, int wr, int wc, int fr, int fq) const {
        int lt = (wr * 4 + wc) * 64 + fq * 16 + fr; asm volatile("" : "+v"(lt));
        bf16_t* tb = g + ((size_t)(u.pm * 12 + u.pn) * 16 * 512 + (size_t)lt) * 8;
        float cs = -1.4426950408889634f * 0.03125f; asm volatile("" : "+s"(cs));
#pragma unroll
        for (int ai = 0; ai < 2; ++ai)
#pragma unroll
            for (int m = 0; m < 4; ++m)
#pragma unroll
                for (int bj = 0; bj < 2; ++bj) { f32x4 a0 = acc[ai][bj][m][0], a1 = acc[ai][bj][m][1];
#pragma unroll
                    for (int j = 0; j < 4; ++j) { a0[j] = __builtin_amdgcn_rcpf(1.0f + __builtin_amdgcn_exp2f(a0[j] * cs)); a1[j] = __builtin_amdgcn_rcpf(1.0f + __builtin_amdgcn_exp2f(a1[j] * cs)); }
                    __builtin_nontemporal_store(pack8(a0, a1), (u32x4*)(tb + (size_t)(((ai * 4 + m) * 2 + bj) * 512) * 8)); }
    }
};
template <int MODE> struct EpiMerge {
    static constexpr bool PERM = true, AFTER_DRAIN = false, BIAS_LDS = false;
    bf16_t* mg; bf16_t* scr; const bf16_t* g; int br; float scale;
    __device__ __forceinline__ void operator()(const f32x4 (&acc)[2][2][4][2], const Unit& u, int wr, int wc, int fr, int fq) const {
        const int rt = u.pm * 256 + wr * 64 + fr, cb = u.pn * 256 + wc * 32 + 8 * fq; float sc = scale; asm volatile("" : "+s"(sc));
        int lt = (wr * 4 + wc) * 64 + fq * 16 + fr; asm volatile("" : "+v"(lt));
        const bf16_t* gt = g + ((size_t)(u.pm * 12 + br * 4 + u.pn) * 16 * 512 + (size_t)lt) * 8;
        bf16_t* st = scr + ((size_t)(u.pm * 4 + u.pn) * 16 * 512 + (size_t)lt) * 8;
#pragma unroll
        for (int ai = 0; ai < 2; ++ai)
#pragma unroll
            for (int m = 0; m < 4; ++m)
#pragma unroll
                for (int bj = 0; bj < 2; ++bj) { const size_t pk = (size_t)(((ai * 4 + m) * 2 + bj) * 512) * 8;
                    const u32x4 gw = *(const u32x4*)(gt + pk); f32x4 g0, g1; unpack8(gw, g0, g1);
                    f32x4 v0 = acc[ai][bj][m][0] * sc * g0, v1 = acc[ai][bj][m][1] * sc * g1;
                    if (MODE != 0) { const u32x4 ow = *(const u32x4*)(st + pk); f32x4 o0, o1; unpack8(ow, o0, o1); v0 += o0; v1 += o1; }
                    if (MODE != 2) *(u32x4*)(st + pk) = pack8(v0, v1);
                    else *(u32x4*)(mg + (size_t)(rt + ai * HALF + m * 16) * 1024 + cb + bj * HALF) = pack8(v0, v1); }
    }
};
struct EpiRouter {
    static constexpr bool PERM = true, AFTER_DRAIN = false, BIAS_LDS = false;
    float* lg;
    __device__ __forceinline__ void operator()(const f32x4 (&acc)[2][2][4][2], const Unit& u, int wr, int wc, int fr, int fq) const {
        if (wc < 2) { const int rt = u.pm * 256 + wr * 64 + fr, cb = wc * 32 + 8 * fq;
#pragma unroll
            for (int ai = 0; ai < 2; ++ai)
#pragma unroll
                for (int m = 0; m < 4; ++m) { float* p = lg + (size_t)(rt + ai * HALF + m * 16) * 64 + cb; *(f32x4*)p = acc[ai][0][m][0]; *(f32x4*)(p + 4) = acc[ai][0][m][1]; } }
    }
};
struct EpiSwiGLU {
    static constexpr bool PERM = true, AFTER_DRAIN = false, BIAS_LDS = false;
    bf16_t* act; const float* bg; const float* bu;
    __device__ __forceinline__ void operator()(const f32x4 (&acc)[2][2][4][2], const Unit& u, int wr, int wc, int fr, int fq) const {
        const int e = u.pn >> 3, col = (u.pn & 7) * 128 + wc * 32 + 8 * fq, rt = u.pm * 256 + wr * 64 + fr;
        const f32x4 bg0 = *(const f32x4*)(bg + e * 1024 + col), bg1 = *(const f32x4*)(bg + e * 1024 + col + 4), bu0 = *(const f32x4*)(bu + e * 1024 + col), bu1 = *(const f32x4*)(bu + e * 1024 + col + 4);
#pragma unroll
        for (int ai = 0; ai < 2; ++ai)
#pragma unroll
            for (int m = 0; m < 4; ++m) { f32x4 g0 = acc[ai][0][m][0] + bg0, g1 = acc[ai][0][m][1] + bg1, u0 = acc[ai][1][m][0] + bu0, u1 = acc[ai][1][m][1] + bu1;
#pragma unroll
                for (int j = 0; j < 4; ++j) { const float ga = fminf(g0[j], 7.0f), gb = fminf(g1[j], 7.0f); const float ua = fminf(fmaxf(u0[j], -7.0f), 7.0f), ub = fminf(fmaxf(u1[j], -7.0f), 7.0f);
                    g0[j] = (ua + 1.0f) * (ga * fast_sigmoid(1.702f * ga)); g1[j] = (ub + 1.0f) * (gb * fast_sigmoid(1.702f * gb)); }
                *(u32x4*)(act + (size_t)(rt + ai * HALF + m * 16) * 1024 + col) = pack8(g0, g1); }
    }
};
struct EpiSwiGLU8 {
    static constexpr bool PERM = true, AFTER_DRAIN = false, BIAS_LDS = true;
    unsigned char* act; const float* bg; const float* bu; PG8_LAS float* bl;
    __device__ __forceinline__ void stage_bias(const Unit& u, int wid, int lane) const {
        if (wid < 4) { const int e = u.pn >> 3, c0 = (u.pn & 7) * 128 + (wid & 1) * 64 + lane; const float* src = (wid < 2 ? bg : bu) + e * 1024 + c0;
            __builtin_amdgcn_global_load_lds((const unsigned*)src, (PG8_LAS unsigned*)(bl + u.par * 256 + wid * 64), 4, 0, 0); }
    }
    __device__ __forceinline__ void operator()(const f32x4 (&acc)[2][2][4][2], const Unit& u, int wr, int wc, int fr, int fq) const {
        const int col = (u.pn & 7) * 128 + wc * 32 + 8 * fq, rt = u.pm * 256 + wr * 64 + fr; const PG8_LAS float* bp = bl + u.par * 256 + wc * 32 + 8 * fq;
        const f32x4 bg0 = *(const PG8_LAS f32x4*)bp, bg1 = *(const PG8_LAS f32x4*)(bp + 4), bu0 = *(const PG8_LAS f32x4*)(bp + 128), bu1 = *(const PG8_LAS f32x4*)(bp + 132);
#pragma unroll
        for (int ai = 0; ai < 2; ++ai)
#pragma unroll
            for (int m = 0; m < 4; ++m) { f32x4 g0 = acc[ai][0][m][0] * 0.03125f + bg0, g1 = acc[ai][0][m][1] * 0.03125f + bg1, u0 = acc[ai][1][m][0] * 0.03125f + bu0, u1 = acc[ai][1][m][1] * 0.03125f + bu1;
#pragma unroll
                for (int j = 0; j < 4; ++j) { const float ga = fminf(g0[j], 7.0f), gb = fminf(g1[j], 7.0f); const float ua = fminf(fmaxf(u0[j], -7.0f), 7.0f), ub = fminf(fmaxf(u1[j], -7.0f), 7.0f);
                    g0[j] = (ua + 1.0f) * (ga * fast_sigmoid(1.702f * ga)); g1[j] = (ub + 1.0f) * (gb * fast_sigmoid(1.702f * gb)); }
                __builtin_nontemporal_store(pack8_fp8(g0, g1), (u32x2v*)(act + (size_t)(rt + ai * HALF + m * 16) * 1024 + col)); }
    }
};
struct EpiDown8 {
    static constexpr bool PERM = true, AFTER_DRAIN = false, BIAS_LDS = true;
    unsigned char* ys; const float* bd; int nostore; PG8_LAS float* bl;
    __device__ __forceinline__ void stage_bias(const Unit& u, int wid, int lane) const {
        if (wid < 4) { const float* src = bd + (u.pn >> 2) * 1024 + (u.pn & 3) * 256 + wid * 64 + lane; __builtin_amdgcn_global_load_lds((const unsigned*)src, (PG8_LAS unsigned*)(bl + u.par * 256 + wid * 64), 4, 0, 0); }
    }
    __device__ __forceinline__ void operator()(const f32x4 (&acc)[2][2][4][2], const Unit& u, int wr, int wc, int fr, int fq) const {
        const int col0 = (u.pn & 3) * 256 + wc * 32 + 8 * fq, rt = u.pm * 256 + wr * 64 + fr; const PG8_LAS float* bp = bl + u.par * 256 + wc * 32 + 8 * fq;
        f32x4 bv[2][2];
#pragma unroll
        for (int bj = 0; bj < 2; ++bj) { bv[bj][0] = *(const PG8_LAS f32x4*)(bp + bj * HALF) * 8.0f; bv[bj][1] = *(const PG8_LAS f32x4*)(bp + bj * HALF + 4) * 8.0f; }
#pragma unroll
        for (int ai = 0; ai < 2; ++ai)
#pragma unroll
            for (int m = 0; m < 4; ++m) { unsigned char* rowp = ys + (size_t)(rt + ai * HALF + m * 16) * 1024 + col0;
#pragma unroll
                for (int bj = 0; bj < 2; ++bj) { const u32x2v w = pack8_fp8(acc[ai][bj][m][0] * 0.25f + bv[bj][0], acc[ai][bj][m][1] * 0.25f + bv[bj][1]); if (!nostore) __builtin_nontemporal_store(w, (u32x2v*)(rowp + bj * HALF)); else asm volatile("" :: "v"(w)); } }
    }
};
struct GroupedOrder {
    int nM, nN, nwg, G, c; const PG8_LAS int* tile_e; const int* rows;
    __device__ void init(int nM_, int nN_, int G_, int c_, const PG8_LAS int* te) { nM = nM_; nN = nN_; nwg = nM * nN; G = G_; c = c_; tile_e = te; rows = nullptr; }
    __device__ bool next(int i, Unit& u) const {
        const long L = (long)i * G + c; if (L >= nwg) return false;
        int wgid = (int)L; { const int q = nwg / NXCD, r = nwg % NXCD, xcd = wgid % NXCD, off = wgid / NXCD; wgid = (xcd < r ? xcd * (q + 1) : r * (q + 1) + (xcd - r) * q) + off; }
        const int nig = WGM * nN, gid = wgid / nig, fm = gid * WGM, gsz = (nM - fm) < WGM ? (nM - fm) : WGM;
        u.pm = fm + ((wgid % nig) % gsz); const int pl = (wgid % nig) / gsz; u.pn = __builtin_amdgcn_readfirstlane(tile_e[u.pm]) * nN + pl; return true;
    }
    __device__ __forceinline__ void a_ready(const Unit&) const {}
    __device__ __forceinline__ void done(const Unit&) const {}
};
struct DftOrder {
    int lg, n, G, c;
    __device__ void init(int lg_, int nb, int G_, int c_) { lg = lg_; n = (nb * 2) << lg_; G = G_; c = c_; }
    __device__ bool next(int i, Unit& u) const { const int L = i * G + c; if (L >= n) return false; const int b = L >> (lg + 1), rem = L & ((2 << lg) - 1); u.pm = rem & ((1 << lg) - 1); u.pn = 2 * b + (rem >> lg); return true; }
    __device__ __forceinline__ void a_ready(const Unit&) const {}
    __device__ __forceinline__ void done(const Unit&) const {}
};

template <class Epi, class Sched, bool ALIGN_EPI = false, bool SP2 = false, bool FP8 = false, bool GATHER = false>
__device__ __forceinline__ void gemm_phase(PG8_LAS unsigned char* lds, const Gemm g, const Sched& S, const Epi& E, const int tid_in) {
    int tid_ = tid_in; asm volatile("" : "+v"(tid_));
    const int tid = tid_, wid = __builtin_amdgcn_readfirstlane(tid >> 6), lane = tid & 63, wr = wid >> 2, wc = wid & 3, fr = lane & 15, fq = lane >> 4;
    const int K = g.K, nt = K / BK;
    unsigned voffA[2], voffB[2]; int RA[2]; unsigned CA2[2];
#pragma unroll
    for (int i = 0; i < 2; ++i) { int R, C; stage_rc(tid * 16 + i * 8192, R, C); const int Rb = Epi::PERM ? ((R & ~31) + perm32(R & 31)) : R;
        voffA[i] = (unsigned)(R * K + C) * 2u; voffB[i] = (unsigned)(Rb * K + C) * 2u; RA[i] = (R << 8) | (C * 2); CA2[i] = 0u; }
    static_assert(!GATHER || SP2, "GATHER is implemented for the SP2 loop only");
    unsigned pC[2], pN[2];
#define PG8_LDIDX(dst, unit) do { if constexpr (GATHER) { _Pragma("unroll") for (int h_ = 0; h_ < 2; ++h_) dst[h_] = (unsigned)S.rows[(unit).pm * 256 + h_ * 128 + (RA[0] >> 8)] | ((unsigned)S.rows[(unit).pm * 256 + h_ * 128 + (RA[1] >> 8)] << 16); } } while (0)
#define PG8_GOFF(dst, pk) do { dst[0] = ((pk) & 0xffffu) * (unsigned)(K * 2) + (unsigned)(RA[0] & 255); dst[1] = ((pk) >> 16) * (unsigned)(K * 2) + (unsigned)(RA[1] & 255); } while (0)
    const size_t kstep = (size_t)(BK * 2);
    const size_t hstep = (size_t)HALF * K * 2;
    const size_t tstep = 2 * hstep;
    const unsigned ldsw = (unsigned)wid * 1024u;
    const int aoff = lds_byte(wr * 64 + fr, fq * 8), boff = lds_byte(wc * 32 + fr, fq * 8);
#define PG8_SA(b, h) (((b) * 2 + (h)) * HTB)
#define PG8_SB(b, h) ((4 + (b) * 2 + (h)) * HTB)
#define PG8_STAGE(bufoff, gbase, voff) do { _Pragma("unroll") for (int _i = 0; _i < 2; ++_i) \
        __builtin_amdgcn_global_load_lds((const unsigned*)((const char*)(gbase) + (voff)[_i]), (PG8_LAS unsigned*)(lds + (bufoff) + ldsw + _i * 8192), 16, 0, 0); } while (0)
#define PG8_RD8(off) __builtin_shufflevector(*(const PG8_LAS i32x4v*)(lds + (off)), *(const PG8_LAS i32x4v*)(lds + (off) + 1024), 0, 1, 2, 3, 4, 5, 6, 7)
#define PG8_LDA(dst, b, h) do { _Pragma("unroll") for (int m = 0; m < 4; ++m) { if constexpr (FP8) dst##8[m] = PG8_RD8(PG8_SA(b, h) + aoff + m * 2048); else { _Pragma("unroll") for (int k = 0; k < 2; ++k) dst[m][k] = *(const PG8_LAS bf16x8*)(lds + PG8_SA(b, h) + aoff + m * 2048 + k * 1024); } } } while (0)
#define PG8_LDB(dst, b, h) do { _Pragma("unroll") for (int n = 0; n < 2; ++n) { if constexpr (FP8) dst##8[n] = PG8_RD8(PG8_SB(b, h) + boff + n * 2048); else { _Pragma("unroll") for (int k = 0; k < 2; ++k) dst[n][k] = *(const PG8_LAS bf16x8*)(lds + PG8_SB(b, h) + boff + n * 2048 + k * 1024); } } } while (0)
#define PG8_MMA(ai, bj, At, Bt) do { if constexpr (FP8) __builtin_amdgcn_sched_barrier(0); __builtin_amdgcn_s_setprio(1); _Pragma("unroll") for (int m = 0; m < 4; ++m) _Pragma("unroll") for (int n = 0; n < 2; ++n) { \
        if constexpr (FP8) asm volatile("v_mfma_scale_f32_16x16x128_f8f6f4 %0, %1, %2, %0, %3, %3 op_sel_hi:[0,0,0]" : "+v"(acc[ai][bj][m][n]) : "v"(Bt##8[n]), "v"(At##8[m]), "v"(sc8)); \
        else { _Pragma("unroll") for (int k = 0; k < 2; ++k) acc[ai][bj][m][n] = __builtin_amdgcn_mfma_f32_16x16x32_bf16(Bt[n][k], At[m][k], acc[ai][bj][m][n], 0, 0, 0); } } __builtin_amdgcn_s_setprio(0); if constexpr (FP8) __builtin_amdgcn_sched_barrier(0); } while (0)
#define PG8_WAIT_V(n) asm volatile("s_waitcnt vmcnt(" #n ")" ::: "memory")
#define PG8_WAIT_L(n) asm volatile("s_waitcnt lgkmcnt(" #n ")" ::: "memory")
#define PG8_BAR __builtin_amdgcn_s_barrier()
#define PG8_SCHED __builtin_amdgcn_sched_barrier(0)
    Unit cur, nxt; int ui = 0;
    if (!S.next(0, cur)) return;
    f32x4 acc[2][2][4][2];
#pragma unroll
    for (int a = 0; a < 2; ++a)
#pragma unroll
        for (int b = 0; b < 2; ++b)
#pragma unroll
            for (int m = 0; m < 4; ++m)
#pragma unroll
                for (int n = 0; n < 2; ++n) acc[a][b][m][n] = (f32x4){0.f, 0.f, 0.f, 0.f};
    int sc8 = 0x7f7f7f7f; asm volatile("" : "+v"(sc8));
    bf16x8 At[4][2], B0[2][2], B1[2][2]; i32x8v At8[4], B08[2], B18[2];
    const char* cA = (const char*)g.A + (size_t)cur.pm * tstep; const char* cB = (const char*)g.Bt + (size_t)cur.pn * tstep; const char* const gA = (const char*)g.A;
    S.a_ready(cur);
    if constexpr (SP2) {
        unsigned g0_[2], g1_[2]; if constexpr (GATHER) { PG8_LDIDX(pC, cur); PG8_GOFF(g0_, pC[0]); PG8_GOFF(g1_, pC[1]); }
        PG8_STAGE(PG8_SB(0, 0), cB, voffB); PG8_STAGE(PG8_SB(0, 1), cB + hstep, voffB);
        if constexpr (GATHER) { PG8_STAGE(PG8_SA(0, 0), gA, g0_); PG8_STAGE(PG8_SA(0, 1), gA, g1_); } else { PG8_STAGE(PG8_SA(0, 0), cA, voffA); PG8_STAGE(PG8_SA(0, 1), cA + hstep, voffA); }
        if (wr == 1) PG8_BAR;
        PG8_WAIT_V(2); PG8_BAR;
        PG8_STAGE(PG8_SB(1, 0), cB + kstep, voffB); if constexpr (GATHER) PG8_STAGE(PG8_SA(1, 0), gA + kstep, g0_); else PG8_STAGE(PG8_SA(1, 0), cA + kstep, voffA); PG8_STAGE(PG8_SB(1, 1), cB + hstep + kstep, voffB);
        PG8_WAIT_V(6); PG8_BAR;
    } else {
        PG8_STAGE(PG8_SB(0, 0), cB, voffB); PG8_STAGE(PG8_SA(0, 0), cA, voffA); PG8_STAGE(PG8_SB(0, 1), cB + hstep, voffB); PG8_STAGE(PG8_SA(0, 1), cA + hstep, voffA);
        if (wr == 1) PG8_BAR;
        PG8_WAIT_V(4); PG8_BAR;
        PG8_STAGE(PG8_SB(1, 0), cB + kstep, voffB); PG8_STAGE(PG8_SA(1, 0), cA + kstep, voffA); PG8_STAGE(PG8_SB(1, 1), cB + hstep + kstep, voffB);
        PG8_WAIT_V(6); PG8_BAR;
    }
    for (;;) {
        cur.par = ui & 1; if constexpr (Epi::BIAS_LDS) E.stage_bias(cur, wid, lane);
        const bool has_next = S.next(ui + 1, nxt);
        if constexpr (GATHER) { if (has_next) PG8_LDIDX(pN, nxt); }
        const char* nA = has_next ? (const char*)g.A + (size_t)nxt.pm * tstep : cA; const char* nB = has_next ? (const char*)g.Bt + (size_t)nxt.pn * tstep : cB;
        for (int t = 0; t < nt; t += 2) {
            const bool last = (t == nt - 2);
            const char* a1 = cA + (size_t)(t + 1) * kstep;
            const char* a2 = last ? nA : cA + (size_t)(t + 2) * kstep; const char* b2 = last ? nB : cB + (size_t)(t + 2) * kstep;
            const char* a3 = a2 + kstep; const char* b3 = b2 + kstep;
            if (last && has_next) S.a_ready(nxt);
            unsigned v2[2][2]; const char* gA2 = gA;
            unsigned vc1[2];
            if constexpr (GATHER) { const bool sw = last && has_next; PG8_GOFF(v2[0], sw ? pN[0] : pC[0]); PG8_GOFF(v2[1], sw ? pN[1] : pC[1]); PG8_GOFF(vc1, pC[1]);
                gA2 = last ? gA : gA + (size_t)(t + 2) * kstep; }
            if constexpr (SP2) {
            PG8_LDB(B0, 0, 0); PG8_LDB(B1, 0, 1); PG8_SCHED; PG8_LDA(At, 0, 0); if constexpr (GATHER) PG8_STAGE(PG8_SA(1, 1), gA + (size_t)(t + 1) * kstep, vc1); else PG8_STAGE(PG8_SA(1, 1), a1 + hstep, voffA);
            PG8_WAIT_V(8); PG8_WAIT_L(0); PG8_BAR; PG8_MMA(0, 0, At, B0); PG8_MMA(0, 1, At, B1); PG8_BAR; PG8_SCHED;
            PG8_LDA(At, 0, 1); PG8_STAGE(PG8_SB(0, 0), b2, voffB); PG8_STAGE(PG8_SB(0, 1), b2 + hstep, voffB); if constexpr (GATHER) PG8_STAGE(PG8_SA(0, 0), gA2, v2[0]); else PG8_STAGE(PG8_SA(0, 0), a2, voffA);
            PG8_WAIT_V(8); PG8_WAIT_L(0); PG8_BAR; PG8_MMA(1, 0, At, B0); PG8_MMA(1, 1, At, B1); PG8_BAR; PG8_SCHED;
            PG8_LDB(B0, 1, 0); PG8_LDB(B1, 1, 1); PG8_SCHED; PG8_LDA(At, 1, 0); if constexpr (GATHER) PG8_STAGE(PG8_SA(0, 1), gA2, v2[1]); else PG8_STAGE(PG8_SA(0, 1), a2 + hstep, voffA);
            PG8_WAIT_V(8); PG8_WAIT_L(0); PG8_BAR; PG8_MMA(0, 0, At, B0); PG8_MMA(0, 1, At, B1); PG8_BAR; PG8_SCHED;
            PG8_LDA(At, 1, 1); PG8_STAGE(PG8_SB(1, 0), b3, voffB); PG8_STAGE(PG8_SB(1, 1), b3 + hstep, voffB); if constexpr (GATHER) PG8_STAGE(PG8_SA(1, 0), gA2 + kstep, v2[0]); else PG8_STAGE(PG8_SA(1, 0), a3, voffA);
            PG8_WAIT_V(8); PG8_WAIT_L(0); PG8_BAR; PG8_MMA(1, 0, At, B0); PG8_MMA(1, 1, At, B1); PG8_BAR; PG8_SCHED;
            } else {
            PG8_LDB(B0, 0, 0); PG8_SCHED; PG8_LDA(At, 0, 0); PG8_STAGE(PG8_SA(1, 1), a1 + hstep, voffA);
            PG8_WAIT_L(8); PG8_BAR; PG8_WAIT_L(0); PG8_MMA(0, 0, At, B0); PG8_BAR; PG8_SCHED;
            PG8_LDB(B1, 0, 1); PG8_STAGE(PG8_SB(0, 0), b2, voffB);
            PG8_BAR; PG8_WAIT_L(0); PG8_MMA(0, 1, At, B1); PG8_BAR;
            PG8_LDA(At, 0, 1); PG8_STAGE(PG8_SA(0, 0), a2, voffA);
            PG8_BAR; PG8_WAIT_L(0); PG8_MMA(1, 0, At, B0); PG8_BAR; PG8_SCHED;
            PG8_STAGE(PG8_SB(0, 1), b2 + hstep, voffB);
            PG8_WAIT_V(6); PG8_BAR; PG8_MMA(1, 1, At, B1); PG8_BAR;
            PG8_LDB(B0, 1, 0); PG8_SCHED; PG8_LDA(At, 1, 0); PG8_STAGE(PG8_SA(0, 1), a2 + hstep, voffA);
            PG8_WAIT_L(8); PG8_BAR; PG8_WAIT_L(0); PG8_MMA(0, 0, At, B0); PG8_BAR; PG8_SCHED;
            PG8_LDB(B1, 1, 1); PG8_STAGE(PG8_SB(1, 0), b3, voffB);
            PG8_BAR; PG8_WAIT_L(0); PG8_MMA(0, 1, At, B1); PG8_BAR;
            PG8_LDA(At, 1, 1); PG8_STAGE(PG8_SA(1, 0), a3, voffA);
            PG8_BAR; PG8_WAIT_L(0); PG8_MMA(1, 0, At, B0); PG8_BAR; PG8_SCHED;
            PG8_STAGE(PG8_SB(1, 1), b3 + hstep, voffB);
            PG8_WAIT_V(6); PG8_BAR; PG8_MMA(1, 1, At, B1); PG8_BAR;
            }
        }
        if constexpr (FP8) asm volatile("s_nop 15\n\ts_nop 15" ::: "memory");
        if constexpr (ALIGN_EPI) { if (wr == 0) PG8_BAR; }
        if constexpr (!Epi::AFTER_DRAIN) { E(acc, cur, wr, wc, fr, fq); S.done(cur); }
        if (!has_next) break;
#pragma unroll
        for (int a = 0; a < 2; ++a)
#pragma unroll
            for (int b = 0; b < 2; ++b)
#pragma unroll
                for (int m = 0; m < 4; ++m)
#pragma unroll
                    for (int n = 0; n < 2; ++n) acc[a][b][m][n] = (f32x4){0.f, 0.f, 0.f, 0.f};
        cur = nxt; cA = nA; cB = nB; ++ui;
        if constexpr (GATHER) { pC[0] = pN[0]; pC[1] = pN[1]; }
        if constexpr (ALIGN_EPI) { if (wr == 1) PG8_BAR; }
    }
    PG8_WAIT_V(0);
    if constexpr (!ALIGN_EPI) { if (wr == 0) PG8_BAR; }
    PG8_BAR;
    if constexpr (Epi::AFTER_DRAIN) { E.fused(acc, cur, wr, wc, fr, fq, lds, wid, lane); S.done(cur); }
#undef PG8_SA
#undef PG8_LDIDX
#undef PG8_GOFF
#undef PG8_SB
#undef PG8_STAGE
#undef PG8_LDA
#undef PG8_LDB
#undef PG8_MMA
#undef PG8_RD8
#undef PG8_WAIT_V
#undef PG8_WAIT_L
#undef PG8_BAR
#undef PG8_SCHED
}
}
namespace att {
typedef unsigned short bf16;
constexpr int   D = 128, NW = 8, QBLK = 32, KVBLK = 64;
constexpr float SCALE = 0.088388347648318440f;
constexpr float THR = 8.f;
constexpr int SDEPTH = 2;
constexpr int LDQ = 1024, LDK = 256, LDO = 1024;
constexpr size_t SHM_V = KVBLK * D * 2, SHM_K = KVBLK * D * 2, SHM_ATTN = 2 * SHM_V + 2 * SHM_K + NW * 64 * 4;
using bf16x8 = __attribute__((ext_vector_type(8))) short;
using s16x4  = __attribute__((ext_vector_type(4))) short;
using f32x16 = __attribute__((ext_vector_type(16))) float;
using f32x8  = __attribute__((ext_vector_type(8))) float;
using u32x4  = __attribute__((ext_vector_type(4))) unsigned;
#define KSWZ(row, colB) ((row) * 256 + ((colB) ^ (((row) & 7) << 4)))
#define SBAR() __builtin_amdgcn_sched_barrier(0)
__device__ __forceinline__ int crow(int r, int hi) { return (r & 3) + 8 * (r >> 2) + 4 * hi; }
__device__ __forceinline__ unsigned cvtpk(float lo, float hi) { return pg8::cvt_pk_bf16(lo, hi); }
template <typename TIn> struct Stage;
template <> struct Stage<bf16>  { using T = bf16x8;
  __device__ static __forceinline__ T ld8(const bf16* p) { return *reinterpret_cast<const bf16x8*>(p); }
  __device__ static __forceinline__ bf16x8 tobf(T x) { return x; } };
template <> struct Stage<float> { using T = f32x8;
  __device__ static __forceinline__ T ld8(const float* p) { return *reinterpret_cast<const f32x8*>(p); }
  __device__ static __forceinline__ bf16x8 tobf(T x) {
    u32x4 w = {cvtpk(x[0], x[1]), cvtpk(x[2], x[3]), cvtpk(x[4], x[5]), cvtpk(x[6], x[7])}; return *reinterpret_cast<bf16x8*>(&w); } };

__device__ __forceinline__ void partialSM(f32x16& p0, f32x16& p1, float& m_reg, float& mn, float& alpha) {
  constexpr float C = SCALE * 1.4426950408889634f;
  float pmax = p0[0]; for (int r = 1; r < 16; ++r) pmax = fmaxf(pmax, p0[r]); for (int r = 0; r < 16; ++r) pmax = fmaxf(pmax, p1[r]);
  { auto rr = __builtin_amdgcn_permlane32_swap(__float_as_uint(pmax), __float_as_uint(pmax), false, false);
    pmax = fmaxf(__uint_as_float(rr[0]), __uint_as_float(rr[1])); }
  if (__builtin_expect(__all(pmax - m_reg <= THR / SCALE), 1)) { mn = m_reg; alpha = 1.f; }
  else { mn = fmaxf(m_reg, pmax); alpha = __builtin_amdgcn_exp2f((m_reg - mn) * C); m_reg = mn; }
  float mnC = -mn * C;
  for (int r = 0; r < 16; ++r) p0[r] = fmaf(p0[r], C, mnC); for (int r = 0; r < 16; ++r) p1[r] = fmaf(p1[r], C, mnC);
  for (int r = 0; r < 16; ++r) p0[r] = __builtin_amdgcn_exp2f(p0[r]);
}
__device__ __forceinline__ void finishSM(f32x16& p0, f32x16& p1, float alpha, float& l_reg, bf16x8& pa0, bf16x8& pa1, bf16x8& pa2, bf16x8& pa3) {
  for (int r = 0; r < 16; ++r) p1[r] = __builtin_amdgcn_exp2f(p1[r]);
  float ps = 0; for (int r = 0; r < 16; ++r) ps += p0[r]; for (int r = 0; r < 16; ++r) ps += p1[r];
  { auto rr = __builtin_amdgcn_permlane32_swap(__float_as_uint(ps), __float_as_uint(ps), false, false);
    ps = __uint_as_float(rr[0]) + __uint_as_float(rr[1]); }
  l_reg = l_reg * alpha + ps;
#define PK4(P, BASE, OUT) do { unsigned a0 = cvtpk(P[BASE + 0], P[BASE + 1]), a1 = cvtpk(P[BASE + 2], P[BASE + 3]);   \
    unsigned b0 = cvtpk(P[BASE + 4], P[BASE + 5]), b1 = cvtpk(P[BASE + 6], P[BASE + 7]);                              \
    auto r0 = __builtin_amdgcn_permlane32_swap(a0, b0, false, false); auto r1 = __builtin_amdgcn_permlane32_swap(a1, b1, false, false); \
    u32x4 w = {r0[0], r1[0], r0[1], r1[1]}; OUT = *reinterpret_cast<bf16x8*>(&w); } while (0)
  PK4(p0, 0, pa0); PK4(p0, 8, pa1); PK4(p1, 0, pa2); PK4(p1, 8, pa3);
#undef PK4
}
__device__ __forceinline__ void qkt(f32x16& p0, f32x16& p1, const bf16* Ks, const bf16x8* qr, int r32, int hi) {
  p0 = f32x16{}; p1 = f32x16{};
  for (int d0 = 0; d0 < 8; ++d0) { int cb = (d0 * 16 + hi * 8) * 2;
    bf16x8 b0 = *reinterpret_cast<const bf16x8*>((const char*)Ks + KSWZ(r32, cb));
    bf16x8 b1 = *reinterpret_cast<const bf16x8*>((const char*)Ks + KSWZ(32 + r32, cb));
    p0 = __builtin_amdgcn_mfma_f32_32x32x16_bf16(b0, qr[d0], p0, 0, 0, 0);
    p1 = __builtin_amdgcn_mfma_f32_32x32x16_bf16(b1, qr[d0], p1, 0, 0, 0); }
}
__device__ __forceinline__ int v_st(int k, int c) { const int kk = (k & ~0xC) | ((k & 4) << 1) | ((k & 8) >> 1); return ((kk >> 3) * 4 + (c >> 5)) * 512 + ((kk & 7) * 32 + (c & 31)) * 2; }
__device__ __forceinline__ int v_rd_base(int lane) { return ((lane & 3) << 3) | (((lane >> 2) & 3) << 6) | (((lane >> 4) & 1) << 5) | (((lane >> 5) & 1) << 8); }
constexpr int v_rd_off(int d0, int ks, int half) { return d0 * 512 + ks * 4096 + half * 2048; }
template <int OFF> __device__ __forceinline__ s16x4 tr_read(int vb) {
  s16x4 r; asm volatile("ds_read_b64_tr_b16 %0, %1 offset:%2" : "=&v"(r) : "v"(vb), "i"(OFF) : "memory"); return r;
}
template <int D0> __device__ __forceinline__ void pv_one(f32x16& od, int vb, bf16x8 pa0, bf16x8 pa1, bf16x8 pa2, bf16x8 pa3) {
  const s16x4 l0 = tr_read<v_rd_off(D0, 0, 0)>(vb), h0 = tr_read<v_rd_off(D0, 0, 1)>(vb), l1 = tr_read<v_rd_off(D0, 1, 0)>(vb), h1 = tr_read<v_rd_off(D0, 1, 1)>(vb);
  const s16x4 l2 = tr_read<v_rd_off(D0, 2, 0)>(vb), h2 = tr_read<v_rd_off(D0, 2, 1)>(vb), l3 = tr_read<v_rd_off(D0, 3, 0)>(vb), h3 = tr_read<v_rd_off(D0, 3, 1)>(vb);
  asm volatile("s_waitcnt lgkmcnt(0)" ::: "memory"); SBAR();
#define PK(L, H) (bf16x8){L[0], L[1], L[2], L[3], H[0], H[1], H[2], H[3]}
  od = __builtin_amdgcn_mfma_f32_32x32x16_bf16(pa0, PK(l0, h0), od, 0, 0, 0);
  od = __builtin_amdgcn_mfma_f32_32x32x16_bf16(pa1, PK(l1, h1), od, 0, 0, 0);
  od = __builtin_amdgcn_mfma_f32_32x32x16_bf16(pa2, PK(l2, h2), od, 0, 0, 0);
  od = __builtin_amdgcn_mfma_f32_32x32x16_bf16(pa3, PK(l3, h3), od, 0, 0, 0);
#undef PK
}
__device__ __forceinline__ void pv_d0(f32x16* o, int vb, bf16x8 pa0, bf16x8 pa1, bf16x8 pa2, bf16x8 pa3) {
  pv_one<0>(o[0], vb, pa0, pa1, pa2, pa3); pv_one<1>(o[1], vb, pa0, pa1, pa2, pa3); pv_one<2>(o[2], vb, pa0, pa1, pa2, pa3); pv_one<3>(o[3], vb, pa0, pa1, pa2, pa3);
}

template <typename TQ>
__device__ __forceinline__ void attn_dense_body(const TQ* __restrict__ Qb, const bf16* __restrict__ Kh, const bf16* __restrict__ Vh,
                                                unsigned char* __restrict__ Ob, int seq, char* lds, const int tid_in, const float* __restrict__ qgain, const float* __restrict__ rtab, const int t0, const bool rope) {
  using St = Stage<bf16>; using SQ = Stage<TQ>;
  int tid_ = tid_in; asm volatile("" : "+v"(tid_));
  const int tid = tid_, wid = tid >> 6, lane = tid & 63, r32 = lane & 31, hi = lane >> 5;
  bf16* V_lds = (bf16*)lds; bf16* K_lds = (bf16*)(lds + 2 * SHM_V);
  float* ws = (float*)(lds + 2 * SHM_V + 2 * SHM_K) + wid * 64; float* li_l = ws; float* al_l = ws + 32;
  float m_reg = -1e30f, l_reg = 0; f32x16 o[4] = {}; bf16x8 qr[8];
  const TQ* Qw = Qb + (long)(wid * QBLK + r32) * LDQ + hi * 8;
  { float xf[8][8]; float ss = 0.f;
#pragma unroll
    for (int d0 = 0; d0 < 8; ++d0) { const bf16x8 raw = SQ::tobf(SQ::ld8(Qw + d0 * 16));
#pragma unroll
      for (int j = 0; j < 8; ++j) { xf[d0][j] = __uint_as_float(((unsigned)(unsigned short)raw[j]) << 16); ss += xf[d0][j] * xf[d0][j]; } }
    { auto rr = __builtin_amdgcn_permlane32_swap(__float_as_uint(ss), __float_as_uint(ss), false, false); ss = __uint_as_float(rr[0]) + __uint_as_float(rr[1]); }
    const float rn = 1.0f / sqrtf(ss * (1.0f / 128.0f) + 1e-6f);
#pragma unroll
    for (int d0 = 0; d0 < 8; ++d0) {
#pragma unroll
      for (int j = 0; j < 8; ++j) xf[d0][j] *= rn * qgain[d0 * 16 + hi * 8 + j]; }
    if (rope) { const int t = t0 + wid * QBLK + r32, pr = t >> 6, pc = t & 63;
#pragma unroll
      for (int hb = 0; hb < 2; ++hb) { const int p = hb ? pc : pr;
#pragma unroll
        for (int dd = 0; dd < 2; ++dd) { const int d0 = 4 * hb + dd;
#pragma unroll
          for (int j = 0; j < 8; ++j) { const int f = dd * 16 + hi * 8 + j; const float c = rtab[(p * 32 + f) * 2], s = rtab[(p * 32 + f) * 2 + 1];
            const float x0 = xf[d0][j], x1 = xf[d0 + 2][j]; xf[d0][j] = x0 * c - x1 * s; xf[d0 + 2][j] = x1 * c + x0 * s; } } } }
#pragma unroll
    for (int d0 = 0; d0 < 8; ++d0) { u32x4 w = {cvtpk(xf[d0][0], xf[d0][1]), cvtpk(xf[d0][2], xf[d0][3]), cvtpk(xf[d0][4], xf[d0][5]), cvtpk(xf[d0][6], xf[d0][7])}; qr[d0] = *reinterpret_cast<bf16x8*>(&w); } }
  const int sr = tid >> 4, sc = (tid & 15) * 8, vst0 = v_st(sr, sc), vst1 = v_st(32 + sr, sc);
  const int vb0 = (int)(uintptr_t)V_lds + v_rd_base(lane);
  struct { typename St::T vs0, vs1, ks0, ks1; } sr_[SDEPTH];
#define SLOAD(i, k0) do { sr_[i].vs0 = St::ld8(&Vh[(long)((k0) + sr) * LDK + sc]); sr_[i].vs1 = St::ld8(&Vh[(long)((k0) + 32 + sr) * LDK + sc]); \
    sr_[i].ks0 = St::ld8(&Kh[(long)((k0) + sr) * LDK + sc]); sr_[i].ks1 = St::ld8(&Kh[(long)((k0) + 32 + sr) * LDK + sc]); } while (0)
#define SWRITE(b, i) do { *(bf16x8*)((char*)V_lds + (b) * SHM_V + vst0) = St::tobf(sr_[i].vs0);          \
    *(bf16x8*)((char*)V_lds + (b) * SHM_V + vst1) = St::tobf(sr_[i].vs1); int kc = sc * 2;               \
    *(bf16x8*)((char*)K_lds + (b) * SHM_K + KSWZ(sr, kc)) = St::tobf(sr_[i].ks0);                       \
    *(bf16x8*)((char*)K_lds + (b) * SHM_K + KSWZ(32 + sr, kc)) = St::tobf(sr_[i].ks1); } while (0)
#define SWAIT() do { if constexpr (SDEPTH == 2) asm volatile("s_waitcnt vmcnt(4)" ::: "memory"); else asm volatile("s_waitcnt vmcnt(0)" ::: "memory"); } while (0)
#define RESC(a) do { if (__any((a) < 1.f)) { if (hi == 0) al_l[r32] = (a); asm volatile("s_waitcnt lgkmcnt(0)" ::: "memory"); \
    for (int d = 0; d < 4; ++d) for (int r = 0; r < 16; ++r) o[d][r] *= al_l[crow(r, hi)]; } } while (0)
  f32x16 pA0, pA1, pB0, pB1; float mnA, mnB, alA, alB; bf16x8 pa0, pa1, pa2, pa3; const int NT = seq / KVBLK;
  constexpr int SE = 0, SO = SDEPTH - 1;
  SLOAD(SE, 0); asm volatile("s_waitcnt vmcnt(0)" ::: "memory"); SWRITE(0, SE); __syncthreads();
  qkt(pA0, pA1, K_lds, qr, r32, hi); partialSM(pA0, pA1, m_reg, mnA, alA);
  SLOAD(SO, KVBLK); if constexpr (SDEPTH == 2) { if (2 < NT) SLOAD(SE, 2 * KVBLK); }
  SWAIT(); SWRITE(1, SO); __syncthreads();
  for (int j = 1; j + 1 < NT; j += 2) {
    SBAR(); qkt(pB0, pB1, (bf16*)((char*)K_lds + SHM_K), qr, r32, hi);
    finishSM(pA0, pA1, alA, l_reg, pa0, pa1, pa2, pa3); SBAR();
    SLOAD(SO, (j + SDEPTH) * KVBLK); SBAR();
    pv_d0(o, vb0, pa0, pa1, pa2, pa3); partialSM(pB0, pB1, m_reg, mnB, alB);
    __syncthreads(); SWAIT(); SWRITE(0, SE);
    RESC(alB); __syncthreads();
    SBAR(); qkt(pA0, pA1, K_lds, qr, r32, hi);
    finishSM(pB0, pB1, alB, l_reg, pa0, pa1, pa2, pa3); SBAR();
    if (SDEPTH == 1 || j + 3 < NT) SLOAD(SE, (j + 1 + SDEPTH) * KVBLK); SBAR();
    pv_d0(o, vb0 + (int)SHM_V, pa0, pa1, pa2, pa3); partialSM(pA0, pA1, m_reg, mnA, alA);
    __syncthreads(); SWAIT(); SWRITE(1, SO);
    RESC(alA); __syncthreads();
  }
  SBAR(); qkt(pB0, pB1, (bf16*)((char*)K_lds + SHM_K), qr, r32, hi);
  finishSM(pA0, pA1, alA, l_reg, pa0, pa1, pa2, pa3); SBAR();
  pv_d0(o, vb0, pa0, pa1, pa2, pa3); partialSM(pB0, pB1, m_reg, mnB, alB);
  __syncthreads(); RESC(alB);
  finishSM(pB0, pB1, alB, l_reg, pa0, pa1, pa2, pa3); SBAR();
  pv_d0(o, vb0 + (int)SHM_V, pa0, pa1, pa2, pa3);
  if (hi == 0) li_l[r32] = l_reg; asm volatile("s_waitcnt lgkmcnt(0)" ::: "memory");
  float rli[16];
#pragma unroll
  for (int r = 0; r < 16; ++r) rli[r] = __builtin_amdgcn_rcpf(li_l[crow(r, hi)]);
  unsigned char* Ow = Ob + (long)(wid * QBLK) * LDO;
#pragma unroll
  for (int r = 0; r < 16; ++r) { int orow = crow(r, hi);
    for (int d0 = 0; d0 < 4; ++d0) { const float ov = o[d0][r] * rli[r] * 16.0f; Ow[(long)orow * LDO + d0 * 32 + r32] = (unsigned char)(__builtin_amdgcn_cvt_pk_fp8_f32(ov, ov, __builtin_bit_cast(int, ov), false) & 0xff); } }
#undef SLOAD
#undef SWRITE
#undef SWAIT
#undef RESC
}
#undef KSWZ
#undef SBAR
}

#define GAS __attribute__((address_space(1)))
#define LAS __attribute__((address_space(3)))
typedef unsigned short bf16;
typedef unsigned v4u __attribute__((ext_vector_type(4)));
typedef float f32x4 __attribute__((ext_vector_type(4)));
typedef short bf16x8 __attribute__((ext_vector_type(8)));
typedef GAS unsigned gu32;
typedef GAS unsigned long long gu64;
#define RLX_AGENT __ATOMIC_RELAXED, __HIP_MEMORY_SCOPE_AGENT
#define LDS_WAIT() asm volatile("s_waitcnt lgkmcnt(0)" ::: "memory")
#define VM_WAIT() asm volatile("s_waitcnt vmcnt(0)" ::: "memory")
__device__ __forceinline__ unsigned long long rt() { return __builtin_amdgcn_s_memrealtime(); }
__device__ __forceinline__ unsigned f2bf(float f) { unsigned u = __builtin_bit_cast(unsigned, f); return (u + 0x7fffu + ((u >> 16) & 1u)) >> 16; }
__device__ __forceinline__ unsigned pk2(float lo, float hi) { return f2bf(lo) | (f2bf(hi) << 16); }

#define XB_TMO      128
#define XB_XCNT(j)  (256  + 64 * (j))
#define XB_XSUB(j)  (1280 + 64 * (j))
#define XB_XGEN(j)  (2304 + 64 * (j))
#define XB_TOP      3328
#define XB_TOPGEN   3392
#define XCD_BAR_WORDS 3456
#define XB_SPIN_CAP (1u << 18)

__device__ __forceinline__ unsigned xb_ld(unsigned* p)              { return __hip_atomic_load(p, __ATOMIC_RELAXED, __HIP_MEMORY_SCOPE_AGENT); }
__device__ __forceinline__ unsigned xb_add(unsigned* p, unsigned v) { return __hip_atomic_fetch_add(p, v, __ATOMIC_RELAXED, __HIP_MEMORY_SCOPE_AGENT); }
__device__ __forceinline__ unsigned xb_xcc_id() { return (unsigned)__builtin_amdgcn_s_getreg((3 << 11) | 20) & 0xFu; }
#define XB_SPIN(cond, bar) do { unsigned _sp = 0; while (cond) { __builtin_amdgcn_s_sleep(1); \
    if ((++_sp & 255u) == 0u) { if (xb_ld(&(bar)[XB_TMO])) break; if (_sp > XB_SPIN_CAP) { atomicAdd(&(bar)[XB_TMO], 1u); break; } } } } while (0)

struct XcdBarrier {
    unsigned* bar; unsigned x;
    volatile LAS unsigned* st;
};

__device__ __forceinline__ XcdBarrier xcd_barrier_post(unsigned* bar, volatile LAS unsigned* st) {
    XcdBarrier b; b.bar = bar; b.x = xb_xcc_id(); b.st = st;
    if (threadIdx.x == 0) (void)xb_add(&bar[XB_XCNT(b.x)], 1u);
    return b;
}
__device__ __forceinline__ void xcd_barrier_complete(unsigned* bar, unsigned x, unsigned& nloc, unsigned& nx) {
    const unsigned G = gridDim.x * gridDim.y * gridDim.z;
    unsigned sum, cnt, mine, sp = 0u;
    for (;;) {
        sum = 0u; cnt = 0u; mine = 0u;
#pragma unroll
        for (unsigned j = 0; j < 16; ++j) { const unsigned c = xb_ld(&bar[XB_XCNT(j)]); sum += c; cnt += (c > 0u) ? 1u : 0u; mine = (j == x) ? c : mine; }
        if (sum == G) break;
        __builtin_amdgcn_s_sleep(1);
        if ((++sp & 255u) == 0u) { if (xb_ld(&bar[XB_TMO])) break; if (sp > XB_SPIN_CAP) { atomicAdd(&bar[XB_TMO], 1u); break; } }
    }
    nloc = mine > 0u ? mine : 1u; nx = cnt > 0u ? cnt : 1u;
}

__device__ __forceinline__ void xcd_barrier(const XcdBarrier& b) {
    asm volatile("s_waitcnt vmcnt(0)" ::: "memory");
    __syncthreads();
    if (threadIdx.x == 0) {
        unsigned* bar = b.bar;
        __builtin_amdgcn_s_waitcnt(0);
        unsigned nloc = b.st[0], nx = b.st[1];
        if (nloc == 0u) { xcd_barrier_complete(bar, b.x, nloc, nx); b.st[0] = nloc; b.st[1] = nx; }
        const unsigned old = xb_add(&bar[XB_XSUB(b.x)], 1u);
        const unsigned gen = old / nloc;
        if (old + 1u == (gen + 1u) * nloc) {
            __builtin_amdgcn_fence(__ATOMIC_RELEASE, "agent");
            asm volatile("s_waitcnt vmcnt(0)" ::: "memory");
            const unsigned og = xb_add(&bar[XB_TOP], 1u);
            const unsigned tg = og / nx;
            if (og + 1u == (tg + 1u) * nx) xb_add(&bar[XB_TOPGEN], 1u);
            else XB_SPIN(xb_ld(&bar[XB_TOPGEN]) == tg, bar);
            __builtin_amdgcn_fence(__ATOMIC_ACQUIRE, "agent");
            xb_add(&bar[XB_XGEN(b.x)], 1u);
            asm volatile("s_waitcnt vmcnt(0)" ::: "memory");
        } else {
            XB_SPIN(xb_ld(&bar[XB_XGEN(b.x)]) == gen, bar);
            __builtin_amdgcn_fence(__ATOMIC_ACQUIRE, "agent");
            asm volatile("s_waitcnt vmcnt(0)" ::: "memory");
        }
    }
    __syncthreads();
}
constexpr int DM = 1024, NB = 16, SEQ = 2048, CTXL = 256, TL = NB * SEQ, TC = NB * CTXL, TALL = TL + TC;
constexpr int INCOLS = 6144, OFF_FNET = 2560, OFF_GATE = 3072;
constexpr int NEXP = 32, KVROWS = SEQ + CTXL;
constexpr float EPS = 1e-6f;
constexpr int NWAVES = 8, NTHR = NWAVES * 64;
constexpr int NPL = 11, NPH = 2 + 2 * NPL;
#ifndef MK_PER_PHASE
#define MK_PER_PHASE 0
#endif
constexpr size_t MiB = 1u << 20;
constexpr size_t WS_CTL = 0, CTL_ZERO_BYTES = 1 * MiB;
constexpr size_t WS_MOD = 1 * MiB;
constexpr size_t WS_TAB = 2 * MiB;
constexpr size_t WS_TOPI = 3 * MiB, WS_TOPP = 4 * MiB, WS_SLOT = 5 * MiB, WS_CNT = 6 * MiB;
constexpr size_t WS_LOGIT = 7 * MiB;
constexpr size_t WS_WSMALL = 17 * MiB, WSMALL_LAYER = 20 * MiB;
constexpr size_t OFFS_WIN = 0, OFFS_WF = 5 * MiB, OFFS_WG = 7 * MiB, OFFS_WAO = 13 * MiB, OFFS_WCO = 15 * MiB, OFFS_WFO = 16 * MiB, OFFS_WOUT = 17 * MiB, OFFS_ROUT = 19 * MiB;
constexpr size_t WS_DFTL = 57 * MiB, WS_DFTC = 73 * MiB;
constexpr size_t WS_XC = 74 * MiB;
constexpr size_t WS_H = 90 * MiB;
constexpr size_t WS_WGU = 162 * MiB, WS_WD = 226 * MiB, MOEW_LAYER = 96 * MiB;
constexpr size_t WS_BIG = 354 * MiB;
constexpr size_t WS_Q = WS_BIG, WS_K = WS_Q + 72 * MiB, WS_V = WS_K + 18 * MiB, WS_CU = WS_V + 18 * MiB, WS_YT = WS_CU + 36 * MiB, WS_YTC = WS_YT + 64 * MiB;
constexpr size_t WS_GATES = WS_BIG;
constexpr size_t WS_AO = WS_BIG + 216 * MiB, WS_CH = WS_AO + 72 * MiB, WS_Z = WS_CH + 36 * MiB;
constexpr size_t WS_MIX = WS_AO;
constexpr size_t WS_MERGED = WS_BIG + 360 * MiB;
constexpr int SLOT_ROWS = 608 * 256;
constexpr size_t WS_YS = WS_BIG, WS_HS = WS_BIG + 304 * MiB, WS_ACT = WS_BIG + 456 * MiB, WS_END = WS_BIG + 608 * MiB;
constexpr size_t WS_XA = WS_BIG + 288 * MiB, WS_XB = WS_BIG + 528 * MiB;
constexpr size_t WS_H8 = WS_END;
constexpr size_t WS_END2 = WS_END + 36 * MiB;
static_assert(WS_YTC + 8 * MiB == WS_AO && WS_Z + 36 * MiB == WS_MERGED && WS_MERGED + 72 * MiB <= WS_END && (size_t)SLOT_ROWS * 2048 == 304 * MiB, "ws map");
constexpr int CW_TMO = 0, CW_CODE = 1, CW_BAR = 4096;
constexpr int CNT_ROWSRC = 32768;
constexpr int CNT_TILE_E = 16384, CNT_NT = 16384 + 1024;

constexpr int RING_OFF = 0, RING_BYTES = 131072;
constexpr int LDSCTL_OFF = RING_BYTES, MISC_OFF = LDSCTL_OFF + 320, LDS_CT = LDSCTL_OFF + 512, LDS_SM = LDSCTL_OFF + 1024;
constexpr int LDS_BYTES = 155648;

typedef unsigned u32x2 __attribute__((ext_vector_type(2)));
typedef int i32x4 __attribute__((ext_vector_type(4)));
typedef float f32x2 __attribute__((ext_vector_type(2)));
struct Args { const float* in[29]; float* out; unsigned char* ws; int ph_lo, ph_hi; };
typedef const __attribute__((address_space(4))) unsigned char* kptr_t;
struct AV {
    kptr_t kp;
    __device__ __forceinline__ const float* in(int i) const { return *(const float* const __attribute__((address_space(4)))*)(kp + 8 * i); }
    __device__ __forceinline__ float* out() const { return *(float* const __attribute__((address_space(4)))*)(kp + 8 * 29); }
    __device__ __forceinline__ unsigned char* ws() const { return *(unsigned char* const __attribute__((address_space(4)))*)(kp + 8 * 30); }
};
__device__ __forceinline__ AV av_get() { AV a; a.kp = (kptr_t)__builtin_amdgcn_kernarg_segment_ptr(); asm volatile("" : "+s"(a.kp)); return a; }

struct Frame {
    LAS unsigned char* lds; volatile LAS unsigned* MISC; gu32* ctl;
    int tid, lane, wave, vcu, G;
};

__device__ __forceinline__ float shx(float v, int m, int lane) { return __int_as_float(__builtin_amdgcn_ds_bpermute((lane ^ m) << 2, __float_as_int(v))); }
__device__ __forceinline__ float wave_sum(float v, int lane) {
#pragma unroll
    for (int o = 1; o < 64; o <<= 1) v += shx(v, o, lane);
    return v;
}
__device__ __forceinline__ float sigmoidf_(float x) { return 1.0f / (1.0f + __expf(-x)); }
__device__ __forceinline__ f32x4 bf4(u32x2 w) { f32x4 r; r[0] = __uint_as_float(w.x << 16); r[1] = __uint_as_float(w.x & 0xffff0000u); r[2] = __uint_as_float(w.y << 16); r[3] = __uint_as_float(w.y & 0xffff0000u); return r; }
__device__ __forceinline__ u32x2 pk4(f32x4 v) { u32x2 w; w.x = pk2(v[0], v[1]); w.y = pk2(v[2], v[3]); return w; }
__device__ __forceinline__ void ld_row_f32(f32x4 (&v)[4], const float* p, int lane) {
#pragma unroll
    for (int j = 0; j < 4; ++j) v[j] = ((const GAS f32x4*)p)[lane + 64 * j];
}
__device__ __forceinline__ void st_row_f32(const f32x4 (&v)[4], float* p, int lane) {
#pragma unroll
    for (int j = 0; j < 4; ++j) ((GAS f32x4*)p)[lane + 64 * j] = v[j];
}
__device__ __forceinline__ void ld_row_bf16(f32x4 (&v)[4], const bf16* p, int lane) {
#pragma unroll
    for (int j = 0; j < 4; ++j) v[j] = bf4(((const GAS u32x2*)p)[lane + 64 * j]);
}
__device__ __forceinline__ void st_row_bf16(const f32x4 (&v)[4], bf16* p, int lane) {
#pragma unroll
    for (int j = 0; j < 4; ++j) ((GAS u32x2*)p)[lane + 64 * j] = pk4(v[j]);
}
__device__ __forceinline__ void rms_gain(f32x4 (&v)[4], const float* g, int lane) {
    float ss = 0.f;
#pragma unroll
    for (int j = 0; j < 4; ++j) ss += (v[j][0] * v[j][0] + v[j][1] * v[j][1]) + (v[j][2] * v[j][2] + v[j][3] * v[j][3]);
    const float r = 1.0f / sqrtf(wave_sum(ss, lane) * (1.0f / 1024.0f) + EPS);
#pragma unroll
    for (int j = 0; j < 4; ++j) { const f32x4 gg = ((const GAS f32x4*)g)[lane + 64 * j]; v[j] = v[j] * r * gg; }
}
__device__ __forceinline__ void modulate_store(const f32x4 (&v)[4], const float* shift, const float* scale, bf16* o, int lane) {
#pragma unroll
    for (int j = 0; j < 4; ++j) { const f32x4 sh = ((const GAS f32x4*)shift)[lane + 64 * j], sc = ((const GAS f32x4*)scale)[lane + 64 * j];
        ((GAS u32x2*)o)[lane + 64 * j] = pk4(v[j] * (sc + 1.0f) + sh); }
}
__device__ __forceinline__ unsigned pk4_fp8(f32x4 v) { return pg8::cvt4_fp8(v[0], v[1], v[2], v[3]); }
__device__ __forceinline__ void modulate_store2(const f32x4 (&v)[4], const float* shift, const float* scale, bf16* o, unsigned char* o8, int lane) {
#pragma unroll
    for (int j = 0; j < 4; ++j) { const f32x4 sh = ((const GAS f32x4*)shift)[lane + 64 * j], sc = ((const GAS f32x4*)scale)[lane + 64 * j]; const f32x4 r = v[j] * (sc + 1.0f) + sh;
        ((GAS u32x2*)o)[lane + 64 * j] = pk4(r); ((GAS unsigned*)o8)[lane + 64 * j] = pk4_fp8(r); }
}
__device__ __forceinline__ f32x4 fp8x4(unsigned w) { const f32x2 a = __builtin_amdgcn_cvt_pk_f32_fp8((int)w, false), b = __builtin_amdgcn_cvt_pk_f32_fp8((int)w, true); return (f32x4){a.x, a.y, b.x, b.y}; }
__device__ __forceinline__ int krow_of(int m) { return m < TL ? (m >> 11) * KVROWS + (m & 2047) : ((m - TL) >> 8) * KVROWS + SEQ + ((m - TL) & 255); }

__device__ __forceinline__ void load_block(const float* W, int ldw, int k0, int n0, float scale, LAS float* scr, int lane) {
    f32x4 v[8]; const int kr = lane >> 3, c4 = (lane & 7) * 4;
#pragma unroll
    for (int i = 0; i < 8; ++i) v[i] = *(const GAS f32x4*)(W + (size_t)(k0 + kr + 8 * i) * ldw + n0 + c4);
#pragma unroll
    for (int i = 0; i < 8; ++i) { LAS float* d = scr + (kr + 8 * i) * 33 + c4; d[0] = v[i][0] * scale; d[1] = v[i][1] * scale; d[2] = v[i][2] * scale; d[3] = v[i][3] * scale; }
    LDS_WAIT(); asm volatile("" ::: "memory");
}
__device__ __forceinline__ void transpose_item(const float* W, int ldw, int K, bf16* WT, int dst_row0, int k0, int n0, LAS float* scr, int lane) {
    load_block(W, ldw, k0, n0, 1.0f, scr, lane);
    const int c = lane & 7;
#pragma unroll
    for (int j = 0; j < 4; ++j) { const int n = (lane >> 3) + 8 * j; const LAS float* s = scr + (8 * c) * 33 + n;
        v4u o; o.x = pk2(s[0 * 33], s[1 * 33]); o.y = pk2(s[2 * 33], s[3 * 33]); o.z = pk2(s[4 * 33], s[5 * 33]); o.w = pk2(s[6 * 33], s[7 * 33]);
        *(GAS v4u*)(WT + (size_t)(dst_row0 + n) * K + k0 + 8 * c) = o; }
    LDS_WAIT(); asm volatile("" ::: "memory");
}
__device__ __forceinline__ void transpose_item_fp8(const float* W, int ldw, int K, unsigned char* WT, int dst_row0, int k0, int n0, float scale, LAS float* scr, int lane) {
    load_block(W, ldw, k0, n0, scale, scr, lane);
#pragma unroll
    for (int j = 0; j < 2; ++j) { const int q = lane + 64 * j, n = q >> 2, c = q & 3; const LAS float* s = scr + (16 * c) * 33 + n; v4u o;
        o.x = pg8::cvt4_fp8(s[0 * 33], s[1 * 33], s[2 * 33], s[3 * 33]); o.y = pg8::cvt4_fp8(s[4 * 33], s[5 * 33], s[6 * 33], s[7 * 33]); o.z = pg8::cvt4_fp8(s[8 * 33], s[9 * 33], s[10 * 33], s[11 * 33]); o.w = pg8::cvt4_fp8(s[12 * 33], s[13 * 33], s[14 * 33], s[15 * 33]);
        *(GAS v4u*)(WT + (size_t)(dst_row0 + n) * K + k0 + 16 * c) = o; }
    LDS_WAIT(); asm volatile("" ::: "memory");
}
constexpr int IT_S0 = 16 * 80, IT_S1 = 16 * 96, IT_S2 = 512, IT_S3 = 512, IT_S4 = 256, IT_S5 = 256, IT_SMALL = IT_S0 + IT_S1 + IT_S2 + IT_S3 + IT_S4 + IT_S5;
__device__ __forceinline__ void small_item(const AV& a, int l, int r, LAS float* scr, int lane) {
    unsigned char* wl = a.ws() + WS_WSMALL + (size_t)l * WSMALL_LAYER; const float* win = a.in(10) + (size_t)l * DM * INCOLS;
    if (r < IT_S0) { const int kb = r / 80, n0 = (r % 80) * 32; int dr;
        if (n0 < 1536) dr = n0; else { int cc = n0 - 1536; if (cc < 512) dr = 1536 + (cc >> 7) * 256 + (cc & 127); else { cc -= 512; dr = 1536 + (cc >> 7) * 256 + 128 + (cc & 127); } }
        transpose_item_fp8(win, INCOLS, DM, wl + OFFS_WIN, dr, kb * 64, n0, 32.0f, scr, lane); return; }
    r -= IT_S0;
    if (r < IT_S1) { const int kb = r / 96, nb = r % 96; transpose_item_fp8(win, INCOLS, DM, wl + OFFS_WG, nb * 32, kb * 64, OFF_GATE + nb * 32, 32.0f, scr, lane); return; }
    r -= IT_S1;
    if (r < IT_S2) { const int kb = r / 32, nb = r % 32; transpose_item_fp8(a.in(13) + (size_t)l * DM * DM, DM, DM, wl + OFFS_WAO, nb * 32, kb * 64, nb * 32, 32.0f, scr, lane); return; }
    r -= IT_S2;
    if (r < IT_S3) { const int kb = r / 32, nb = r % 32; transpose_item(a.in(20) + (size_t)l * DM * DM, DM, DM, (bf16*)(wl + OFFS_WOUT), nb * 32, kb * 64, nb * 32, scr, lane); return; }
    r -= IT_S3;
    if (r < IT_S4) { const int kb = r / 32, nb = r % 32; transpose_item(a.in(18) + (size_t)l * 512 * DM, DM, 512, (bf16*)(wl + OFFS_WCO), nb * 32, kb * 64, nb * 32, scr, lane); return; }
    r -= IT_S4;
    { const int kb = r / 32, nb = r % 32; transpose_item(a.in(19) + (size_t)l * 512 * DM, DM, 512, (bf16*)(wl + OFFS_WFO), nb * 32, kb * 64, nb * 32, scr, lane); }
}
constexpr int IT_MOE = NEXP * 3 * 512;
struct MoeIt { const float* W; unsigned char* WT; int dr, k0; };
__device__ __forceinline__ MoeIt moe_decode(const AV& a, int gi) {
    const int l = gi / IT_MOE, idx = gi % IT_MOE, e = idx / 1536, r = idx % 1536, which = r / 512, it = r % 512, kb = it / 32, n0 = (it % 32) * 32; const size_t eo = ((size_t)l * NEXP + e) << 20;
    MoeIt m; m.k0 = kb * 64;
    if (which == 0) { m.W = a.in(23) + eo + n0; m.WT = a.ws() + WS_WGU + (size_t)l * MOEW_LAYER + (size_t)e * 2048 * 1024; m.dr = (n0 >> 7) * 256 + (n0 & 127); }
    else if (which == 1) { m.W = a.in(25) + eo + n0; m.WT = a.ws() + WS_WGU + (size_t)l * MOEW_LAYER + (size_t)e * 2048 * 1024; m.dr = (n0 >> 7) * 256 + 128 + (n0 & 127); }
    else { m.W = a.in(27) + eo + n0; m.WT = a.ws() + WS_WD + (size_t)l * MOEW_LAYER + (size_t)e * 1024 * 1024; m.dr = n0; }
    return m;
}
__device__ __forceinline__ void moe_issue(f32x4 (&v)[8], const MoeIt& m, int lane) {
    const float* p = m.W + (size_t)(m.k0 + (lane >> 3)) * DM + (lane & 7) * 4;
#pragma unroll
    for (int i = 0; i < 8; ++i) v[i] = __builtin_nontemporal_load((const GAS f32x4*)(p + (size_t)(8 * i) * DM));
}
__device__ __forceinline__ void moe_finish(const f32x4 (&v)[8], const MoeIt& m, LAS float* scr, int lane) {
    const int kr = lane >> 3, c4 = (lane & 7) * 4;
#pragma unroll
    for (int i = 0; i < 8; ++i) { LAS float* d = scr + (kr + 8 * i) * 33 + c4; d[0] = v[i][0] * 32.0f; d[1] = v[i][1] * 32.0f; d[2] = v[i][2] * 32.0f; d[3] = v[i][3] * 32.0f; }
    LDS_WAIT(); asm volatile("" ::: "memory");
#pragma unroll
    for (int j = 0; j < 2; ++j) { const int q = lane + 64 * j, n = q >> 2, c = q & 3; const LAS float* s = scr + (16 * c) * 33 + n; v4u o;
        o.x = pg8::cvt4_fp8(s[0 * 33], s[1 * 33], s[2 * 33], s[3 * 33]); o.y = pg8::cvt4_fp8(s[4 * 33], s[5 * 33], s[6 * 33], s[7 * 33]); o.z = pg8::cvt4_fp8(s[8 * 33], s[9 * 33], s[10 * 33], s[11 * 33]); o.w = pg8::cvt4_fp8(s[12 * 33], s[13 * 33], s[14 * 33], s[15 * 33]);
        *(GAS v4u*)(m.WT + (size_t)(m.dr + n) * DM + m.k0 + 16 * c) = o; }
    LDS_WAIT(); asm volatile("" ::: "memory");
}
__device__ __forceinline__ void moe_convert_range(const AV& a, int base, int count, int gw, int NGW, LAS float* scr, int lane) {
    f32x4 va[8], vb[8]; int it = gw; if (it >= count) return;
    MoeIt ma = moe_decode(a, base + it), mb = ma; moe_issue(va, ma, lane);
    for (;;) {
        const bool h1 = it + NGW < count; if (h1) { mb = moe_decode(a, base + it + NGW); moe_issue(vb, mb, lane); }
        moe_finish(va, ma, scr, lane); if (!h1) break; it += NGW;
        const bool h2 = it + NGW < count; if (h2) { ma = moe_decode(a, base + it + NGW); moe_issue(va, ma, lane); }
        moe_finish(vb, mb, scr, lane); if (!h2) break; it += NGW;
    }
}
#ifndef FILL_A_PER_WAVE
#define FILL_A_PER_WAVE 14
#endif
#ifndef FILL_B_PER_WAVE
#define FILL_B_PER_WAVE 6
#endif
constexpr int FILL_WG0 = 64, FILL_NGW = (256 - FILL_WG0) * NWAVES, FILL_A = FILL_NGW * FILL_A_PER_WAVE, FILL_B = FILL_NGW * FILL_B_PER_WAVE;
static_assert(FILL_A + FILL_B <= IT_MOE, "tail filler converts layer-0 expert weights only");
__device__ __forceinline__ void fold_job(const AV& a, int j, const LAS float* ct, int lane) {
    const int l = j >> 10, r = j & 1023, g = r >> 8, kblk = (r >> 4) & 15, k2g = r & 15, k = kblk * 64 + lane;
    const float* wrow = a.in(10) + (size_t)l * DM * INCOLS + (size_t)k * INCOLS + OFF_FNET + g * 128;
    float ac[8], as[8];
#pragma unroll
    for (int i = 0; i < 8; ++i) { ac[i] = 0.f; as[i] = 0.f; }
    for (int n4 = 0; n4 < 32; ++n4) { const f32x4 w = *(const GAS f32x4*)(wrow + n4 * 4);
#pragma unroll
        for (int q = 0; q < 4; ++q) { const int n2 = n4 * 4 + q;
#pragma unroll
            for (int i = 0; i < 8; ++i) { const int ph = (n2 * (k2g * 8 + i)) & 127; ac[i] += w[q] * ct[ph]; as[i] += w[q] * ct[(ph - 32) & 127]; } } }
    bf16* wf = (bf16*)(a.ws() + WS_WSMALL + (size_t)l * WSMALL_LAYER + OFFS_WF);
#pragma unroll
    for (int i = 0; i < 8; ++i) { const int ch = g * 128 + k2g * 8 + i;
        wf[(size_t)ch * 1024 + k] = (bf16)f2bf(ac[i] * 0.08838834764831845f); wf[(size_t)(512 + ch) * 1024 + k] = (bf16)f2bf(as[i] * 0.08838834764831845f); }
}
__device__ __forceinline__ void p0_prologue(const Frame& F, const AV& a) {
    const int gw = F.vcu * NWAVES + F.wave, NGW = F.G * NWAVES, gt = F.vcu * NTHR + F.tid, NGT = F.G * NTHR;
    LAS float* ct = (LAS float*)(F.lds + LDS_CT);
    if (F.tid < 128) ct[F.tid] = cospif((float)F.tid * (1.0f / 64.0f));
    for (int job = blockIdx.x; job < 2 * 96; job += F.G) {
        const int l = job / 96, n0 = (job % 96) * 64;
        LAS float* s = (LAS float*)(F.lds + RING_OFF); LAS float* red = s + 17 * 1024;
        for (int i = F.tid; i < 17 * 1024; i += NTHR) { const int b = i >> 10, k = i & 1023; const float cv = b < 16 ? a.in(1)[b * 1024 + k] : a.in(3)[k]; s[i] = cv * sigmoidf_(cv); }
        __syncthreads();
        const int col = F.tid & 63, ks = F.tid >> 6; float acc[17];
#pragma unroll
        for (int b = 0; b < 17; ++b) acc[b] = 0.f;
        const float* w = a.in(4) + (size_t)l * DM * INCOLS + n0 + col;
        for (int k = ks * 128; k < ks * 128 + 128; k += 16) { float wv[16];
#pragma unroll
            for (int q = 0; q < 16; ++q) wv[q] = w[(size_t)(k + q) * INCOLS];
#pragma unroll
            for (int q = 0; q < 16; ++q)
#pragma unroll
                for (int b = 0; b < 17; ++b) acc[b] += s[b * 1024 + k + q] * wv[q]; }
#pragma unroll
        for (int b = 0; b < 17; ++b) red[(ks * 17 + b) * 64 + col] = acc[b];
        __syncthreads();
        for (int i = F.tid; i < 17 * 64; i += NTHR) { const int b = i >> 6, c2 = i & 63; float t = 0.f;
#pragma unroll
            for (int q = 0; q < 8; ++q) t += red[(q * 17 + b) * 64 + c2];
            ((float*)(a.ws() + WS_MOD))[((size_t)l * 17 + b) * INCOLS + n0 + c2] = t + a.in(5)[l * INCOLS + n0 + c2]; }
        __syncthreads();
    }
    __syncthreads();
    for (int i = gt; i < 64 * 32; i += NGT) { const int p = i >> 5, f = i & 31; const float inv = powf(10000.0f, -(float)f / 32.0f), ang = (float)p * inv; ((f32x2*)(a.ws() + WS_TAB))[i] = (f32x2){cosf(ang), sinf(ang)}; }
    for (int i = gt; i < 2048 * 256; i += NGT) { const int k1 = i >> 8, c0 = (i & 255) * 16; float v[16];
#pragma unroll
        for (int q = 0; q < 16; ++q) { const int col = c0 + q, n1 = col & 2047, rr = (k1 * n1) & 2047; const float x = (float)rr * (1.0f / 1024.0f); v[q] = ((col >> 11) ? -sinpif(x) : cospif(x)) * (32.0f * 0.022097086912079608f); }
        v4u o; o.x = pk4_fp8((f32x4){v[0], v[1], v[2], v[3]}); o.y = pk4_fp8((f32x4){v[4], v[5], v[6], v[7]}); o.z = pk4_fp8((f32x4){v[8], v[9], v[10], v[11]}); o.w = pk4_fp8((f32x4){v[12], v[13], v[14], v[15]}); ((GAS v4u*)(a.ws() + WS_DFTL))[i] = o; }
    for (int i = gt; i < 256 * 32; i += NGT) { const int k1 = i >> 5, c0 = (i & 31) * 16; float v[16];
#pragma unroll
        for (int q = 0; q < 16; ++q) { const int col = c0 + q, n1 = col & 255, rr = (k1 * n1) & 255; const float x = (float)rr * (1.0f / 128.0f); v[q] = ((col >> 8) ? -sinpif(x) : cospif(x)) * (32.0f * 0.0625f); }
        v4u o; o.x = pk4_fp8((f32x4){v[0], v[1], v[2], v[3]}); o.y = pk4_fp8((f32x4){v[4], v[5], v[6], v[7]}); o.z = pk4_fp8((f32x4){v[8], v[9], v[10], v[11]}); o.w = pk4_fp8((f32x4){v[12], v[13], v[14], v[15]}); ((GAS v4u*)(a.ws() + WS_DFTC))[i] = o; }
    for (int i = gt; i < 2 * 256 * 1024; i += NGT) { const int l = i >> 18, r = (i >> 10) & 255, k = i & 1023; unsigned o = 0u;
        if (r < 64) { const float w = a.in(21)[((size_t)l * DM + k) * NEXP + (r & 31)]; const unsigned hi = f2bf(w); o = hi; if (r >= 32) o = f2bf(w - __uint_as_float(hi << 16)); }
        ((bf16*)(a.ws() + WS_WSMALL + (size_t)l * WSMALL_LAYER + OFFS_ROUT))[(size_t)r * 1024 + k] = (bf16)o; }
    for (int j = gw; j < 2048; j += NGW) fold_job(a, j, ct, F.lane);
    LAS float* scr = (LAS float*)(F.lds + RING_OFF + F.wave * 16384);
    for (int it = gw; it < 2 * IT_SMALL; it += NGW) small_item(a, it / IT_SMALL, it % IT_SMALL, scr, F.lane);
    { const int fill = (F.G == 256) ? FILL_A + FILL_B : 0; moe_convert_range(a, fill, 2 * IT_MOE - fill, gw, NGW, scr, F.lane); }
}
__device__ __forceinline__ void ld4(f32x4 (&v)[4], const float* p, int lane) {
#pragma unroll
    for (int j = 0; j < 4; ++j) v[j] = ((const GAS f32x4*)p)[lane + 64 * j];
}
__device__ __forceinline__ float sumsq4(const f32x4 (&v)[4]) { float ss = 0.f;
#pragma unroll
    for (int j = 0; j < 4; ++j) ss += (v[j][0] * v[j][0] + v[j][1] * v[j][1]) + (v[j][2] * v[j][2] + v[j][3] * v[j][3]);
    return ss; }
__device__ __forceinline__ void p1_norm0(const Frame& F, const AV& a) {
    const int gw = F.vcu * NWAVES + F.wave, NGW = F.G * NWAVES, rpw = (TALL + NGW - 1) / NGW, r0 = gw * rpw, r1 = (r0 + rpw < TALL) ? r0 + rpw : TALL;
    if (r0 >= r1) return;
    f32x4 gpre[4], shift[4], scale[4], xn[4]; ld4(gpre, a.in(6), F.lane); int cb = -1;
    auto xsrc = [&](int m) -> const float* { return m < TL ? a.in(0) + (size_t)m * DM : a.in(2) + (size_t)(m - TL) * DM; };
    ld4(xn, xsrc(r0), F.lane);
    for (int m = r0; m < r1; ++m) {
        f32x4 x[4];
#pragma unroll
        for (int j = 0; j < 4; ++j) x[j] = xn[j];
        if (m + 1 < r1) ld4(xn, xsrc(m + 1), F.lane);
        const int b = m < TL ? (m >> 11) : 16;
        if (b != cb) { cb = b; const float* mv = (const float*)(a.ws() + WS_MOD) + (size_t)b * INCOLS; ld4(shift, mv, F.lane); ld4(scale, mv + 1024, F.lane); }
        const float r = 1.0f / sqrtf(wave_sum(sumsq4(x), F.lane) * (1.0f / 1024.0f) + EPS);
        bf16* ho = (bf16*)(a.ws() + WS_H) + (size_t)m * DM; unsigned char* h8 = a.ws() + WS_H8 + (size_t)m * DM;
#pragma unroll
        for (int j = 0; j < 4; ++j) { const f32x4 hv = x[j] * r * gpre[j] * (scale[j] + 1.0f) + shift[j]; ((GAS u32x2*)ho)[F.lane + 64 * j] = pk4(hv); ((GAS unsigned*)h8)[F.lane + 64 * j] = pk4_fp8(hv); }
    }
}
__device__ __forceinline__ void qk_fix_core(f32x4 (&x)[4], const f32x4 (&gg)[4], const f32x2* tab, bool rope, int t, int sub, int lane) {
    float ss = sumsq4(x); ss += shx(ss, 1, lane); ss += shx(ss, 2, lane); ss += shx(ss, 4, lane);
    const float r = 1.0f / sqrtf(ss * (1.0f / 128.0f) + EPS);
#pragma unroll
    for (int jj = 0; jj < 4; ++jj) x[jj] = x[jj] * r * gg[jj];
    if (rope) { const int pr = t >> 6, pc = t & 63;
#pragma unroll
        for (int i = 0; i < 4; ++i) { const f32x2 cr = tab[pr * 32 + sub * 4 + i], cc = tab[pc * 32 + sub * 4 + i];
            const float a0 = x[0][i], a1 = x[1][i], b0 = x[2][i], b1 = x[3][i];
            x[0][i] = a0 * cr.x - a1 * cr.y; x[1][i] = a1 * cr.x + a0 * cr.y; x[2][i] = b0 * cc.x - b1 * cc.y; x[3][i] = b1 * cc.x + b0 * cc.y; } }
}
__device__ __forceinline__ void p_qkfix(const Frame& F, const AV& a, int l, int M) {
    const int gw = F.vcu * NWAVES + F.wave, NGW = F.G * NWAVES, rpw = 4 * ((M + 4 * NGW - 1) / (4 * NGW)), r0 = gw * rpw, r1 = (r0 + rpw < M) ? r0 + rpw : M;
    if (r0 >= r1) return;
    const f32x2* tab = (const f32x2*)(a.ws() + WS_TAB); const int rs = F.lane >> 4, hh = (F.lane >> 3) & 1, sub = F.lane & 7;
    f32x4 gk[4];
#pragma unroll
    for (int jj = 0; jj < 4; ++jj) gk[jj] = *(const GAS f32x4*)(a.in(12) + l * 128 + jj * 32 + sub * 4);
    bf16* kb = (bf16*)(a.ws() + WS_K);
    u32x2 kn[4];
    auto issue = [&](int mb) { const int m = mb + rs; if (m < r1) { const bf16* kp = kb + (size_t)krow_of(m) * 256 + hh * 128 + sub * 4;
#pragma unroll
        for (int jj = 0; jj < 4; ++jj) kn[jj] = *(const GAS u32x2*)(kp + jj * 32); } };
    issue(r0);
    for (int mb = r0; mb < r1; mb += 4) { const int m = mb + rs; const bool act = m < r1;
        f32x4 xk[4];
#pragma unroll
        for (int jj = 0; jj < 4; ++jj) xk[jj] = bf4(kn[jj]);
        if (mb + 4 < r1) issue(mb + 4);
        qk_fix_core(xk, gk, tab, m < TL, m & 2047, sub, F.lane);
        if (act) { bf16* kp = kb + (size_t)krow_of(m) * 256 + hh * 128 + sub * 4;
#pragma unroll
            for (int jj = 0; jj < 4; ++jj) *(GAS u32x2*)(kp + jj * 32) = pk4(xk[jj]); }
    }
}
__device__ __forceinline__ void p_conv(const Frame& F, const AV& a, int l, int njobs) {
    LAS unsigned char* lin = F.lds + RING_OFF; LAS float* lout = (LAS float*)(F.lds + RING_OFF + 62 * 1024);
    const bf16* cu = (const bf16*)(a.ws() + WS_CU); bf16* chb = (bf16*)(a.ws() + WS_CH);
    const int cp = F.tid & 255, pg = F.tid >> 8;
    f32x2 wv[31];
#pragma unroll
    for (int j = 0; j < 31; ++j) wv[j] = *(const GAS f32x2*)(a.in(14) + ((size_t)l * 31 + j) * 512 + 2 * cp);
    const f32x2 cb2 = *(const GAS f32x2*)(a.in(15) + l * 512 + 2 * cp);
    for (int job = F.vcu; job < njobs; job += F.G) {
        int rowbase, L, t0;
        if (job < 1024) { rowbase = (job >> 6) * SEQ; L = SEQ; t0 = (job & 63) * 32; } else { const int jc = job - 1024; rowbase = TL + (jc >> 3) * CTXL; L = CTXL; t0 = (jc & 7) * 32; }
        for (int idx = F.tid; idx < 62 * 64; idx += NTHR) { const int row = idx >> 6, ch = idx & 63, p = t0 - 15 + row; v4u val = (v4u){0u, 0u, 0u, 0u};
            if (p >= 0 && p < L) val = *(const GAS v4u*)(cu + (size_t)(rowbase + p) * 512 + ch * 8);
            *(LAS v4u*)(lin + row * 1024 + ch * 16) = val; }
        __syncthreads();
#pragma unroll
        for (int chunk = 0; chunk < 2; ++chunk) {
            f32x2 acc[8];
#pragma unroll
            for (int i = 0; i < 8; ++i) acc[i] = cb2;
            const int r0 = pg * 16 + chunk * 8;
#pragma unroll
            for (int r = 0; r < 38; ++r) { const unsigned w = *(const LAS unsigned*)(lin + (r0 + r) * 1024 + cp * 4); const float x0 = __uint_as_float(w << 16), x1 = __uint_as_float(w & 0xffff0000u);
#pragma unroll
                for (int i = 0; i < 8; ++i) { const int j = r - i; if (j >= 0 && j <= 30) { acc[i].x += x0 * wv[j].x; acc[i].y += x1 * wv[j].y; } } }
#pragma unroll
            for (int i = 0; i < 8; ++i) *(LAS f32x2*)(lout + (r0 + i) * 512 + 2 * cp) = acc[i];
        }
        __syncthreads();
#pragma unroll
        for (int pp = 0; pp < 4; ++pp) { const int p = F.wave * 4 + pp; const LAS float* src = lout + p * 512 + F.lane * 8;
            f32x4 y0 = *(const LAS f32x4*)src, y1 = *(const LAS f32x4*)(src + 4);
            const float mean = wave_sum((y0[0] + y0[1]) + (y0[2] + y0[3]) + (y1[0] + y1[1]) + (y1[2] + y1[3]), F.lane) * (1.0f / 512.0f);
            y0 = y0 - mean; y1 = y1 - mean;
            const float var = wave_sum((y0[0] * y0[0] + y0[1] * y0[1]) + (y0[2] * y0[2] + y0[3] * y0[3]) + (y1[0] * y1[0] + y1[1] * y1[1]) + (y1[2] * y1[2] + y1[3] * y1[3]), F.lane) * (1.0f / 512.0f);
            const float rs = 1.0f / sqrtf(var + EPS);
            const f32x4 g0 = *(const GAS f32x4*)(a.in(16) + l * 512 + F.lane * 8), g1 = *(const GAS f32x4*)(a.in(16) + l * 512 + F.lane * 8 + 4);
            const f32x4 b0 = *(const GAS f32x4*)(a.in(17) + l * 512 + F.lane * 8), b1 = *(const GAS f32x4*)(a.in(17) + l * 512 + F.lane * 8 + 4);
            y0 = y0 * rs * g0 + b0; y1 = y1 * rs * g1 + b1;
#pragma unroll
            for (int q = 0; q < 4; ++q) { y0[q] = y0[q] * sigmoidf_(y0[q]); y1[q] = y1[q] * sigmoidf_(y1[q]); }
            v4u o; o.x = pk2(y0[0], y0[1]); o.y = pk2(y0[2], y0[3]); o.z = pk2(y1[0], y1[1]); o.w = pk2(y1[2], y1[3]);
            *(GAS v4u*)(chb + (size_t)(rowbase + t0 + p) * 512 + F.lane * 8) = o; }
        __syncthreads();
    }
}
__device__ __forceinline__ void p_rowpass1(const Frame& F, const AV& a, int l, int M) {
    const int gw = F.vcu * NWAVES + F.wave, NGW = F.G * NWAVES, rpw = (M + NGW - 1) / NGW, r0 = gw * rpw, r1 = (r0 + rpw < M) ? r0 + rpw : M;
    if (r0 >= r1) return;
    const float* modb = (const float*)(a.ws() + WS_MOD) + (size_t)l * 17 * INCOLS; const bf16* mixb = (const bf16*)(a.ws() + WS_MIX);
    f32x4 gpost[4], gpre[4], gate[4], shift[4], scale[4]; ld4(gpost, a.in(7) + l * DM, F.lane); ld4(gpre, a.in(8) + l * DM, F.lane);
    int cb = -1;
    auto xsrc = [&](int m) -> const float* { return m < TL ? a.in(0) + (size_t)m * DM : a.in(2) + (size_t)(m - TL) * DM; };
    const bf16* xbb = (const bf16*)(a.ws() + WS_XB); bf16* xab = (bf16*)(a.ws() + WS_XA);
    f32x4 xn[4]; u32x2 xbn[4]; u32x2 mn[4];
    if (l == 0) ld4(xn, xsrc(r0), F.lane); else {
#pragma unroll
        for (int j = 0; j < 4; ++j) xbn[j] = ((const GAS u32x2*)(xbb + (size_t)r0 * DM))[F.lane + 64 * j]; }
#pragma unroll
    for (int j = 0; j < 4; ++j) mn[j] = ((const GAS u32x2*)(mixb + (size_t)r0 * DM))[F.lane + 64 * j];
    for (int m = r0; m < r1; ++m) {
        f32x4 x[4], y[4];
#pragma unroll
        for (int j = 0; j < 4; ++j) { x[j] = (l == 0) ? xn[j] : bf4(xbn[j]); y[j] = bf4(mn[j]); }
        if (m + 1 < r1) { if (l == 0) ld4(xn, xsrc(m + 1), F.lane); else {
#pragma unroll
                for (int j = 0; j < 4; ++j) xbn[j] = ((const GAS u32x2*)(xbb + (size_t)(m + 1) * DM))[F.lane + 64 * j]; }
#pragma unroll
            for (int j = 0; j < 4; ++j) mn[j] = ((const GAS u32x2*)(mixb + (size_t)(m + 1) * DM))[F.lane + 64 * j]; }
        const int b = m < TL ? (m >> 11) : 16;
        if (b != cb) { cb = b; const float* mv = modb + (size_t)b * INCOLS; ld4(gate, mv + 2 * 1024, F.lane); ld4(shift, mv + 3 * 1024, F.lane); ld4(scale, mv + 4 * 1024, F.lane); }
        const float r = 1.0f / sqrtf(wave_sum(sumsq4(y), F.lane) * (1.0f / 1024.0f) + EPS);
#pragma unroll
        for (int j = 0; j < 4; ++j) x[j] = x[j] + gate[j] * (y[j] * r * gpost[j]);
#pragma unroll
        for (int j = 0; j < 4; ++j) ((GAS u32x2*)(xab + (size_t)m * DM))[F.lane + 64 * j] = pk4(x[j]);
        const float r2 = 1.0f / sqrtf(wave_sum(sumsq4(x), F.lane) * (1.0f / 1024.0f) + EPS);
        bf16* ho = (bf16*)(a.ws() + WS_H) + (size_t)m * DM; unsigned char* h8 = a.ws() + WS_H8 + (size_t)m * DM;
#pragma unroll
        for (int j = 0; j < 4; ++j) { const f32x4 hv = x[j] * r2 * gpre[j] * (scale[j] + 1.0f) + shift[j]; ((GAS u32x2*)ho)[F.lane + 64 * j] = pk4(hv); ((GAS unsigned*)h8)[F.lane + 64 * j] = pk4_fp8(hv); }
    }
}
__device__ __forceinline__ void p_route(const Frame& F, const AV& a, int l, int M) {
    typedef short bfx8 __attribute__((ext_vector_type(8)));
    const int NGW = F.G * NWAVES, rpw = (M + NGW - 1) / NGW, TPB = 8 * rpw, b0 = F.vcu * TPB, b1 = (b0 + TPB < M) ? b0 + TPB : M;
    LAS unsigned char* tabl = F.lds + RING_OFF; LAS float* lg = (LAS float*)(F.lds + LDS_SM) + F.wave * 512; LAS int* cntl = (LAS int*)(F.lds + LDS_SM + 16384);
    VM_WAIT(); __syncthreads();
    if (F.tid < 32) cntl[F.tid] = 0;
    { const GAS v4u* src = (const GAS v4u*)(a.ws() + WS_WSMALL + (size_t)l * WSMALL_LAYER + OFFS_ROUT);
      for (int idx = F.tid; idx < 64 * 128; idx += NTHR) { const int row = idx >> 7, c = idx & 127; *(LAS v4u*)(tabl + row * 2048 + ((c ^ (row & 7)) << 4)) = src[idx]; } }
    __syncthreads();
    const bf16* H = (const bf16*)(a.ws() + WS_H); const float bias = a.in(22)[l * NEXP + (F.lane & 31)];
    const int ar = F.lane & 15, kb = F.lane >> 4, ng = (b1 > b0) ? (b1 - b0 + 15) >> 4 : 0;
    for (int g = F.wave; g < ng; g += NWAVES) {
        const int rb = b0 + g * 16; int row = rb + ar; if (row > M - 1) row = M - 1;
        const bf16* hp = H + (size_t)row * DM + kb * 8; f32x4 acc[4];
#pragma unroll
        for (int f = 0; f < 4; ++f) acc[f] = (f32x4){0.f, 0.f, 0.f, 0.f};
#pragma unroll 4
        for (int s = 0; s < 32; ++s) { const bfx8 af = *(const GAS bfx8*)(hp + s * 32);
#pragma unroll
            for (int f = 0; f < 4; ++f) { const int wr = f * 16 + ar; const bfx8 bfr = *(const LAS bfx8*)(tabl + wr * 2048 + (((4 * s + kb) ^ (wr & 7)) << 4));
                acc[f] = __builtin_amdgcn_mfma_f32_16x16x32_bf16(af, bfr, acc[f], 0, 0, 0); } }
#pragma unroll
        for (int i = 0; i < 4; ++i) { lg[(4 * kb + i) * 32 + ar] = acc[0][i] + acc[2][i]; lg[(4 * kb + i) * 32 + 16 + ar] = acc[1][i] + acc[3][i]; }
        LDS_WAIT(); asm volatile("" ::: "memory");
        { const int hf = F.lane >> 5, ex = F.lane & 31; LAS unsigned long long* kb64 = (LAS unsigned long long*)(F.lds + LDS_SM + 16384 + 256) + F.wave * 64;
          LAS float* selv = (LAS float*)(F.lds + LDS_SM + 16384 + 256 + 4096) + F.wave * 16; LAS int* seli = (LAS int*)(selv + 8);
#pragma unroll 1
          for (int p = 0; p < 8; ++p) { const int r = 2 * p + hf, m = rb + r; const bool valid = m < b1;
            const float v = lg[r * 32 + ex] + bias; unsigned ub = __float_as_uint(v); ub = (ub & 0x80000000u) ? ~ub : (ub | 0x80000000u);
            const unsigned long long K = ((unsigned long long)ub << 5) | (unsigned)(31 - ex);
            kb64[F.lane] = K;
            LDS_WAIT(); asm volatile("" ::: "memory");
            int rank = 0;
#pragma unroll
            for (int j = 0; j < 32; ++j) rank += (kb64[hf * 32 + j] > K) ? 1 : 0;
            if (rank < 4) { selv[hf * 4 + rank] = v; seli[hf * 4 + rank] = ex; if (valid) __hip_atomic_fetch_add(&cntl[ex], 1, __ATOMIC_RELAXED, __HIP_MEMORY_SCOPE_WORKGROUP); }
            LDS_WAIT(); asm volatile("" ::: "memory");
            if (ex == 0 && valid) { const f32x4 tv = *(const LAS f32x4*)(selv + hf * 4); const i32x4 ti = *(const LAS i32x4*)(seli + hf * 4);
                const float e1 = __expf(tv[1] - tv[0]), e2 = __expf(tv[2] - tv[0]), e3 = __expf(tv[3] - tv[0]), inv = 1.0f / (1.0f + e1 + e2 + e3);
                *(GAS i32x4*)((int*)(a.ws() + WS_TOPI) + (size_t)m * 4) = ti; *(GAS f32x4*)((float*)(a.ws() + WS_TOPP) + (size_t)m * 4) = (f32x4){inv, e1 * inv, e2 * inv, e3 * inv}; }
            LDS_WAIT(); asm volatile("" ::: "memory"); } }
        LDS_WAIT(); asm volatile("" ::: "memory");
    }
    __syncthreads();
    if (F.tid < 32) ((int*)(a.ws() + WS_CNT))[F.vcu * 32 + F.tid] = cntl[F.tid];
}
__device__ __forceinline__ void p_slots(const Frame& F, const AV& a, int M) {
    LAS int* sm = (LAS int*)(F.lds + LDS_SM);
    LAS int *tot = sm, *bef = sm + 32, *base = sm + 64, *tst = sm + 96  , *mask = sm + 160  , *ids = sm + 320  , *slot = sm + 960  ;
    const int* cnt = (const int*)(a.ws() + WS_CNT);
    { LAS int* ptot = sm + 1600; LAS int* pbef = sm + 2112; const int e = F.tid & 31, part = F.tid >> 5; int t = 0, b = 0;
#pragma unroll 4
      for (int q = part; q < F.G; q += 16) { const int c = cnt[q * 32 + e]; t += c; if (q < F.vcu) b += c; }
      ptot[part * 32 + e] = t; pbef[part * 32 + e] = b;
      __syncthreads();
      if (F.tid < 32) { int tt = 0, bb = 0;
#pragma unroll
          for (int q = 0; q < 16; ++q) { tt += ptot[q * 32 + F.tid]; bb += pbef[q * 32 + F.tid]; }
          tot[F.tid] = tt; bef[F.tid] = bb; } }
    __syncthreads();
    if (F.tid == 0) { int ts = 0; for (int e = 0; e < 32; ++e) { tst[e] = ts; base[e] = ts * 256 + bef[e]; ts += (tot[e] + 255) >> 8; } tst[32] = ts; }
    __syncthreads();
    const int NT = tst[32];
    if (blockIdx.x == 0) { int* te = (int*)(a.ws() + WS_CNT) + CNT_TILE_E;
        for (int t = F.tid; t < NT; t += NTHR) { int e = 0; for (int q = 1; q < 32; ++q) if (t >= tst[q]) e = q; te[t] = e; }
        if (F.tid == 0) ((int*)(a.ws() + WS_CNT))[CNT_NT] = NT; }
    const int TPB = 8 * ((M + F.G * NWAVES - 1) / (F.G * NWAVES)), m0 = F.vcu * TPB, m1 = (m0 + TPB < M) ? m0 + TPB : M, nt = m1 > m0 ? m1 - m0 : 0;
    for (int tl = F.tid; tl < nt; tl += NTHR) { const i32x4 id = *(const GAS i32x4*)((const int*)(a.ws() + WS_TOPI) + (size_t)(m0 + tl) * 4);
        ids[tl * 4 + 0] = id.x; ids[tl * 4 + 1] = id.y; ids[tl * 4 + 2] = id.z; ids[tl * 4 + 3] = id.w; mask[tl] = (1 << id.x) | (1 << id.y) | (1 << id.z) | (1 << id.w); }
    __syncthreads();
    for (int p = F.tid; p < nt * 4; p += NTHR) { const int tl = p >> 2, e = ids[p]; int rank = 0; for (int q = 0; q < tl; ++q) rank += (mask[q] >> e) & 1;
        const int s = base[e] + rank; slot[p] = s; ((int*)(a.ws() + WS_SLOT))[(size_t)(m0 + tl) * 4 + (p & 3)] = s; ((int*)(a.ws() + WS_CNT))[CNT_ROWSRC + s] = m0 + tl; }
    __syncthreads();
    if (blockIdx.x < 32) { const int e = blockIdx.x, r0 = tst[e] * 256 + tot[e], r1 = tst[e + 1] * 256;
        for (int r = r0 + F.tid; r < r1; r += NTHR) ((int*)(a.ws() + WS_CNT))[CNT_ROWSRC + r] = 0; }
    __syncthreads();
}
__device__ __forceinline__ void p_combine(const Frame& F, const AV& a, int l, int M) {
    const int gw = F.vcu * NWAVES + F.wave, NGW = F.G * NWAVES, rpw = (M + NGW - 1) / NGW, r0 = gw * rpw, r1 = (r0 + rpw < M) ? r0 + rpw : M;
    if (r0 >= r1) return;
    const unsigned char* ys = a.ws() + WS_YS;   const int* slp = (const int*)(a.ws() + WS_SLOT); const float* prp = (const float*)(a.ws() + WS_TOPP);
    const float* modb = (const float*)(a.ws() + WS_MOD);
    f32x4 gpost[4], gpre[4], gate[4], shift[4], scale[4]; ld4(gpost, a.in(9) + l * DM, F.lane); if (l == 0) ld4(gpre, a.in(6) + DM, F.lane);
    int cb = -1;
    i32x4 sl_n = *(const GAS i32x4*)(slp + (size_t)r0 * 4); f32x4 pr_n = *(const GAS f32x4*)(prp + (size_t)r0 * 4);
    u32x2 xn[4]; unsigned yn[4][4]; f32x4 prc = pr_n * 0.125f;
    const bf16* xab = (const bf16*)(a.ws() + WS_XA); bf16* xbb = (bf16*)(a.ws() + WS_XB);
    {
#pragma unroll
      for (int j = 0; j < 4; ++j) xn[j] = ((const GAS u32x2*)(xab + (size_t)r0 * DM))[F.lane + 64 * j];
      const int sv[4] = {sl_n[0], sl_n[1], sl_n[2], sl_n[3]};
#pragma unroll
      for (int k = 0; k < 4; ++k)
#pragma unroll
          for (int j = 0; j < 4; ++j) yn[k][j] = ((const GAS unsigned*)(ys + (size_t)sv[k] * DM))[F.lane + 64 * j];
      if (r0 + 1 < r1) { sl_n = *(const GAS i32x4*)(slp + (size_t)(r0 + 1) * 4); pr_n = *(const GAS f32x4*)(prp + (size_t)(r0 + 1) * 4); } }
    for (int m = r0; m < r1; ++m) {
        f32x4 x[4], y[4];
#pragma unroll
        for (int j = 0; j < 4; ++j) { x[j] = bf4(xn[j]); y[j] = fp8x4(yn[0][j]) * prc[0] + fp8x4(yn[1][j]) * prc[1] + fp8x4(yn[2][j]) * prc[2] + fp8x4(yn[3][j]) * prc[3]; }
        if (m + 1 < r1) { prc = pr_n * 0.125f;
#pragma unroll
            for (int j = 0; j < 4; ++j) xn[j] = ((const GAS u32x2*)(xab + (size_t)(m + 1) * DM))[F.lane + 64 * j];
            const int sv[4] = {sl_n[0], sl_n[1], sl_n[2], sl_n[3]};
#pragma unroll
            for (int k = 0; k < 4; ++k)
#pragma unroll
                for (int j = 0; j < 4; ++j) yn[k][j] = ((const GAS unsigned*)(ys + (size_t)sv[k] * DM))[F.lane + 64 * j];
            if (m + 2 < r1) { sl_n = *(const GAS i32x4*)(slp + (size_t)(m + 2) * 4); pr_n = *(const GAS f32x4*)(prp + (size_t)(m + 2) * 4); } }
        const int b = m < TL ? (m >> 11) : 16;
        if (b != cb) { cb = b; ld4(gate, modb + ((size_t)l * 17 + b) * INCOLS + 5 * 1024, F.lane); if (l == 0) { const float* m1 = modb + ((size_t)17 + b) * INCOLS; ld4(shift, m1, F.lane); ld4(scale, m1 + 1024, F.lane); } }
        const float r = 1.0f / sqrtf(wave_sum(sumsq4(y), F.lane) * (1.0f / 1024.0f) + EPS);
#pragma unroll
        for (int j = 0; j < 4; ++j) x[j] = x[j] + gate[j] * (y[j] * r * gpost[j]);
        if (l == 0) {
#pragma unroll
            for (int j = 0; j < 4; ++j) ((GAS u32x2*)(xbb + (size_t)m * DM))[F.lane + 64 * j] = pk4(x[j]); }
        else st_row_f32(x, a.out() + (size_t)m * DM, F.lane);
        if (l == 0) { const float r2 = 1.0f / sqrtf(wave_sum(sumsq4(x), F.lane) * (1.0f / 1024.0f) + EPS);
            bf16* ho = (bf16*)(a.ws() + WS_H) + (size_t)m * DM; unsigned char* h8 = a.ws() + WS_H8 + (size_t)m * DM;
#pragma unroll
            for (int j = 0; j < 4; ++j) { const f32x4 hv = x[j] * r2 * gpre[j] * (scale[j] + 1.0f) + shift[j]; ((GAS u32x2*)ho)[F.lane + 64 * j] = pk4(hv); ((GAS unsigned*)h8)[F.lane + 64 * j] = pk4_fp8(hv); } }
    }
}
#ifdef DBG_CHECK
#ifndef DBG_GSUB
#define DBG_GSUB 0
#endif
__device__ __forceinline__ double bfd(bf16 b) { return (double)__uint_as_float(((unsigned)b) << 16); }
__device__ __forceinline__ unsigned hsh(unsigned x) { x ^= x >> 16; x *= 0x7feb352du; x ^= x >> 15; x *= 0x846ca68bu; x ^= x >> 16; return x; }
__device__ __forceinline__ int samp_row(int i, int M, unsigned salt) { const int sp[12] = {0, 1, 255, 256, 2047, 2048, 4095, 32767, 32768, 32769, 33023, 36863}; if (i < 12 && sp[i] < M) return sp[i]; return (int)(hsh(i * 7919u + salt) % (unsigned)M); }
__device__ __forceinline__ void rec(float* res, int stage, double got, double want, double flo) { const double e = fabs(got - want) / (fabs(want) + flo); const float f = (e == e) ? (float)e : 1e30f; atomicMax((unsigned*)res + stage, __float_as_uint(f)); }
__device__ double dot_h_w(const bf16* hrow, const float* w, int ldw, int col) { double s = 0; for (int k = 0; k < 1024; ++k) s += bfd(hrow[k]) * (double)w[(size_t)k * ldw + col]; return s; }
__device__ double dsig(double x) { return 1.0 / (1.0 + exp(-x)); }
constexpr double PI_D = 3.14159265358979323846;
enum { ST_MOD = 0, ST_H0, ST_INPROJ, ST_YT, ST_QKFIX, ST_CONV, ST_Z, ST_ATTN, ST_GATES, ST_MERGED, ST_MIX, ST_ROW1, ST_LOGIT, ST_TOPK, ST_SLOTS, ST_ACT, ST_YSLOT, ST_COMB, ST_GATESB, ST_N };
__global__ void chk(Args A, int stage, int l, float* res, float* snap) {
    const int i = threadIdx.x; unsigned char* ws = A.ws; const int M = (l == 0) ? TALL : TL; const int rs = stage + 32 * l;
    const bf16* H = (const bf16*)(ws + WS_H); const float* win = A.in[10] + (size_t)l * DM * INCOLS; const float* modb = (const float*)(ws + WS_MOD);
    if (stage == ST_MOD) { const int ll = i & 1, b = (i >> 1) % 17, n = (int)(hsh(i) % 6144u); double s = 0; for (int k = 0; k < 1024; ++k) { const double cv = b < 16 ? A.in[1][b * 1024 + k] : A.in[3][k]; s += cv * dsig(cv) * (double)A.in[4][((size_t)ll * 1024 + k) * 6144 + n]; }
        s += A.in[5][ll * 6144 + n]; rec(res, rs, modb[((size_t)ll * 17 + b) * 6144 + n], s, 0.02); }
    else if (stage == ST_H0) { const int m = samp_row(i, TALL, 1), c = (int)(hsh(i + 77) % 1024u); const float* x = m < TL ? A.in[0] + (size_t)m * DM : A.in[2] + (size_t)(m - TL) * DM; double ss = 0; for (int k = 0; k < 1024; ++k) ss += (double)x[k] * x[k];
        const float* mv = modb + (size_t)(m < TL ? (m >> 11) : 16) * 6144; const double want = x[c] / sqrt(ss / 1024 + 1e-6) * A.in[6][c] * (1.0 + mv[1024 + c]) + mv[c]; rec(res, rs, bfd(H[(size_t)m * DM + c]), want, 0.05); }
    else if (stage == ST_INPROJ) { const int m = samp_row(i, TALL, 2), kind = i & 3; const bf16* hr = H + (size_t)m * DM;
        if (kind == 0) { const int n = (int)(hsh(i + 5) % 1024u); rec(res, rs, bfd(((const bf16*)(ws + WS_Q))[(size_t)m * DM + n]), dot_h_w(hr, win, INCOLS, n), 0.05); }
        else if (kind == 1) { const int n = (int)(hsh(i + 6) % 256u); rec(res, rs, bfd(((const bf16*)(ws + WS_K))[(size_t)krow_of(m) * 256 + n]), dot_h_w(hr, win, INCOLS, 1024 + n), 0.05); }
        else if (kind == 2) { const int n = (int)(hsh(i + 7) % 256u); rec(res, rs, bfd(((const bf16*)(ws + WS_V))[(size_t)krow_of(m) * 256 + n]), dot_h_w(hr, win, INCOLS, 1280 + n), 0.05); }
        else { const int c = (int)(hsh(i + 8) % 512u); if (l == 0 || m < TL) { const double a = dot_h_w(hr, win, INCOLS, 1536 + c), g = dot_h_w(hr, win, INCOLS, 2048 + c); rec(res, rs, bfd(((const bf16*)(ws + WS_CU))[(size_t)m * 512 + c]), a * dsig(g), 0.05); } } }
    else if (stage == ST_YT) { const int m = samp_row(i, M, 3), ch = (int)(hsh(i + 9) % 512u), cs = i & 1, g = ch >> 7, k2 = ch & 127; const bf16* hr = H + (size_t)m * DM; double s = 0;
        for (int k = 0; k < 1024; ++k) { double t = 0; for (int n2 = 0; n2 < 128; ++n2) { const double ang = 2.0 * PI_D * ((n2 * k2) & 127) / 128.0; t += (double)win[(size_t)k * INCOLS + OFF_FNET + g * 128 + n2] * (cs ? sin(ang) : cos(ang)); } s += bfd(hr[k]) * t; }
        s /= sqrt(128.0); double got; if (m < TL) got = bfd(((const bf16*)(ws + WS_YT))[((size_t)(m >> 11) * 512 + ch) * 4096 + cs * 2048 + (m & 2047)]); else got = bfd(((const bf16*)(ws + WS_YTC))[((size_t)((m - TL) >> 8) * 512 + ch) * 512 + cs * 256 + ((m - TL) & 255)]);
        rec(res, rs, got, s, 0.05); }
    else if (stage == ST_QKFIX) { const int m = samp_row(i, TALL, 4), isk = i & 1, hh = isk ? (int)(hsh(i + 3) % 2u) : (int)(hsh(i + 3) % 8u), d = (int)(hsh(i + 4) % 128u); const bf16* hr = H + (size_t)m * DM;
        if (isk || l == 0 || m < TL) { const int cbase = isk ? 1024 + hh * 128 : hh * 128; double ss = 0, xd = 0, xp = 0; const int half = d & 64, dd = d & 63, pd = half + ((dd + 32) & 63);
            for (int q = 0; q < 128; ++q) { double v = dot_h_w(hr, win, INCOLS, cbase + q); v = bfd((bf16)f2bf((float)v)); ss += v * v; if (q == d) xd = v; if (q == pd) xp = v; }
            const float* gn = (isk ? A.in[12] : A.in[11]) + l * 128; const double r = 1.0 / sqrt(ss / 128 + 1e-6); xd *= r * gn[d]; xp *= r * gn[pd]; double want = xd;
            if (m < TL) { const int t = m & 2047, pos = half ? (t & 63) : (t >> 6), f = dd & 31; const double ang = (double)((float)pos * powf(10000.0f, -(float)f / 32.0f)); want = (dd < 32) ? xd * cos(ang) - xp * sin(ang) : xd * cos(ang) + xp * sin(ang); }
            const double got = isk ? bfd(((const bf16*)(ws + WS_K))[(size_t)krow_of(m) * 256 + hh * 128 + d]) : bfd(((const bf16*)(ws + WS_Q))[(size_t)m * DM + hh * 128 + d]); rec(res, rs, got, want, 0.05); } }
    else if (stage == ST_CONV) { const int m = samp_row(i, M, 5), c = (int)(hsh(i + 11) % 512u); const int rowbase = m < TL ? (m >> 11) * SEQ : TL + ((m - TL) >> 8) * CTXL, L = m < TL ? SEQ : CTXL, t = m - rowbase; const bf16* cu = (const bf16*)(ws + WS_CU);
        double s1 = 0, s2 = 0, yc = 0; for (int cc = 0; cc < 512; ++cc) { double y = A.in[15][l * 512 + cc]; for (int j = 0; j < 31; ++j) { const int p = t + j - 15; if (p >= 0 && p < L) y += bfd(cu[(size_t)(rowbase + p) * 512 + cc]) * (double)A.in[14][((size_t)l * 31 + j) * 512 + cc]; } s1 += y; s2 += y * y; if (cc == c) yc = y; }
        const double mean = s1 / 512, var = s2 / 512 - mean * mean; double y = (yc - mean) / sqrt(var + 1e-6) * A.in[16][l * 512 + c] + A.in[17][l * 512 + c]; y = y * dsig(y); rec(res, rs, bfd(((const bf16*)(ws + WS_CH))[(size_t)m * 512 + c]), y, 0.05); }
    else if (stage == ST_Z) { const int m = samp_row(i, M, 6), ch = (int)(hsh(i + 12) % 512u); double s = 0;
        if (m < TL) { const int b = m >> 11, k1 = m & 2047; const bf16* yr = (const bf16*)(ws + WS_YT) + ((size_t)b * 512 + ch) * 4096; for (int n1 = 0; n1 < 2048; ++n1) { const double ang = 2.0 * PI_D * ((k1 * n1) & 2047) / 2048.0; s += cos(ang) * bfd(yr[n1]) - sin(ang) * bfd(yr[2048 + n1]); } s /= sqrt(2048.0); }
        else { const int b = (m - TL) >> 8, k1 = (m - TL) & 255; const bf16* yr = (const bf16*)(ws + WS_YTC) + ((size_t)b * 512 + ch) * 512; for (int n1 = 0; n1 < 256; ++n1) { const double ang = 2.0 * PI_D * ((k1 * n1) & 255) / 256.0; s += cos(ang) * bfd(yr[n1]) - sin(ang) * bfd(yr[256 + n1]); } s /= 16.0; }
        rec(res, rs, bfd(((const bf16*)(ws + WS_Z))[(size_t)m * 512 + ch]), s, 0.05); }
    else if (stage == ST_ATTN) { const int m = samp_row(i, M, 7), hh = (int)(hsh(i + 13) % 8u), d = (int)(hsh(i + 14) % 128u); const bf16* q = (const bf16*)(ws + WS_Q) + (size_t)m * DM + hh * 128;
        int kr0, nk; if (m < TL) { kr0 = (m >> 11) * KVROWS; nk = KVROWS; } else { kr0 = ((m - TL) >> 8) * KVROWS + SEQ; nk = CTXL; }
        const bf16* K = (const bf16*)(ws + WS_K) + (size_t)kr0 * 256 + (hh >> 2) * 128; const bf16* V = (const bf16*)(ws + WS_V) + (size_t)kr0 * 256 + (hh >> 2) * 128;
        double mx = -1e300; for (int j = 0; j < nk; ++j) { double s = 0; for (int q2 = 0; q2 < 128; ++q2) s += bfd(q[q2]) * bfd(K[(size_t)j * 256 + q2]); s *= 0.08838834764831845; if (s > mx) mx = s; }
        double den = 0, num = 0; for (int j = 0; j < nk; ++j) { double s = 0; for (int q2 = 0; q2 < 128; ++q2) s += bfd(q[q2]) * bfd(K[(size_t)j * 256 + q2]); s *= 0.08838834764831845; const double p = exp(s - mx); den += p; num += p * bfd(V[(size_t)j * 256 + d]); }
        rec(res, rs, bfd(((const bf16*)(ws + WS_AO))[(size_t)m * DM + hh * 128 + d]), num / den, 0.03); }
    else if (stage == ST_GATES) { const int m = samp_row(i, M, 8), n = (int)(hsh(i + 15) % 3072u); rec(res, rs, bfd(((const bf16*)(ws + WS_GATES))[(size_t)m * 3072 + n]), dsig(dot_h_w(H + (size_t)m * DM, win, INCOLS, OFF_GATE + n)), 0.05); }
    else if (stage == ST_GATESB && DBG_GSUB == 1) { const int m = samp_row(i, M, 8), n = (int)(hsh(i + 15) % 3072u); const double got = bfd(((const bf16*)(ws + WS_GATES))[(size_t)m * 3072 + n]), want = dsig(dot_h_w(H + (size_t)m * DM, win, INCOLS, OFF_GATE + n));
        const bool badv = !(fabs(got - want) <= 0.05); if (badv) { unsigned* r = (unsigned*)res + 48; atomicOr(r, (m < TL ? 1u : 2u) | (4u << (n >> 10)) | (i < 12 ? 32u : 0u)); } }
    else if (stage == ST_GATESB) { const int m = samp_row(i, M, 8), n = (int)(hsh(i + 15) % 3072u); const bf16* wt = (const bf16*)(ws + WS_WSMALL + (size_t)l * WSMALL_LAYER + OFFS_WG) + (size_t)n * 1024; const bf16* hr = H + (size_t)m * DM; double s = 0; for (int k = 0; k < 1024; ++k) s += bfd(hr[k]) * bfd(wt[k]);
        rec(res, rs, bfd(((const bf16*)(ws + WS_GATES))[(size_t)m * 3072 + n]), dsig(s), 0.05); }
    else if (stage == ST_MERGED) { const int m = samp_row(i, M, 9), c = (int)(hsh(i + 16) % 1024u); const bf16* g = (const bf16*)(ws + WS_GATES) + (size_t)m * 3072; double y0 = 0, y1 = 0, y2 = 0;
        const bf16* ao = (const bf16*)(ws + WS_AO) + (size_t)m * DM; const bf16* chh = (const bf16*)(ws + WS_CH) + (size_t)m * 512; const bf16* z = (const bf16*)(ws + WS_Z) + (size_t)m * 512;
        for (int k = 0; k < 1024; ++k) y0 += bfd(ao[k]) * (double)A.in[13][((size_t)l * 1024 + k) * 1024 + c];
        for (int k = 0; k < 512; ++k) { y1 += bfd(chh[k]) * (double)A.in[18][((size_t)l * 512 + k) * 1024 + c]; y2 += bfd(z[k]) * (double)A.in[19][((size_t)l * 512 + k) * 1024 + c]; }
        rec(res, rs, bfd(((const bf16*)(ws + WS_MERGED))[(size_t)m * DM + c]), bfd(g[c]) * y0 + bfd(g[1024 + c]) * y1 + bfd(g[2048 + c]) * y2, 0.05); }
    else if (stage == ST_MIX) { const int m = samp_row(i, M, 10), c = (int)(hsh(i + 17) % 1024u); rec(res, rs, bfd(((const bf16*)(ws + WS_MIX))[(size_t)m * DM + c]), dot_h_w((const bf16*)(ws + WS_MERGED) + (size_t)m * DM, A.in[20] + (size_t)l * DM * DM, DM, c), 0.05); }
    else if (stage == ST_ROW1) { const int m = samp_row(i, M, 11), c = (int)(hsh(i + 18) % 1024u); const float* xs = snap + (size_t)i * 1024;
        const bf16* mix = (const bf16*)(ws + WS_MIX) + (size_t)m * DM; const float* mv = modb + ((size_t)l * 17 + (m < TL ? (m >> 11) : 16)) * 6144; double ss = 0; for (int k = 0; k < 1024; ++k) ss += bfd(mix[k]) * bfd(mix[k]); const double r = 1.0 / sqrt(ss / 1024 + 1e-6);
        double s2 = 0, xc = 0; for (int k = 0; k < 1024; ++k) { const double xn = xs[k] + mv[2048 + k] * (bfd(mix[k]) * r * A.in[7][l * DM + k]); s2 += xn * xn; if (k == c) xc = xn; }
        const float* xd = m < TL ? A.out + (size_t)m * DM : (const float*)(ws + WS_XC) + (size_t)(m - TL) * DM; rec(res, rs, xd[c], xc, 0.02);
        rec(res, rs, bfd(H[(size_t)m * DM + c]), xc / sqrt(s2 / 1024 + 1e-6) * A.in[8][l * DM + c] * (1.0 + mv[4096 + c]) + mv[3072 + c], 0.05); }
    else if (stage == ST_LOGIT) { const int m = samp_row(i, M, 12), e = i & 31; const float* lg = (const float*)(ws + WS_LOGIT) + (size_t)m * 64; rec(res, rs, (double)lg[e] + lg[32 + e], dot_h_w(H + (size_t)m * DM, A.in[21] + (size_t)l * DM * NEXP, NEXP, e), 0.02); }
    else if (stage == ST_TOPK) { const int m = samp_row(i, M, 13); const float* lg = (const float*)(ws + WS_LOGIT) + (size_t)m * 64; float v[32]; for (int e = 0; e < 32; ++e) v[e] = lg[e] + lg[32 + e] + A.in[22][l * 32 + e];
        int id[4]; float tv[4]; for (int k = 0; k < 4; ++k) { int b = -1; for (int e = 0; e < 32; ++e) { bool used = false; for (int q = 0; q < k; ++q) used |= (id[q] == e); if (!used && (b < 0 || v[e] > v[b])) b = e; } id[k] = b; tv[k] = v[b]; }
        double den = 0; for (int k = 0; k < 4; ++k) den += exp((double)tv[k] - tv[0]); const int* gi = (const int*)(ws + WS_TOPI) + (size_t)m * 4; const float* gp = (const float*)(ws + WS_TOPP) + (size_t)m * 4;
        for (int k = 0; k < 4; ++k) { rec(res, rs, gi[k] == id[k] ? 0.0 : 1.0, 0, 0.01); rec(res, rs, gp[k], exp((double)tv[k] - tv[0]) / den, 0.01); } }
    else if (stage == ST_SLOTS) { const int m = samp_row(i, M, 14), k = i & 3; const int s = ((const int*)(ws + WS_SLOT))[(size_t)m * 4 + k], e = ((const int*)(ws + WS_TOPI))[(size_t)m * 4 + k]; const int NT = ((const int*)(ws + WS_CNT))[CNT_NT];
        if (s < 0 || s >= NT * 256) rec(res, rs, 1, 0, 0.01); else { rec(res, rs, ((const int*)(ws + WS_CNT))[CNT_TILE_E + (s >> 8)] == e ? 0.0 : 1.0, 0, 0.01); const bf16* hs = (const bf16*)(ws + WS_HS) + (size_t)s * DM; double df = 0; for (int q = 0; q < 1024; ++q) df += fabs(bfd(hs[q]) - bfd(H[(size_t)m * DM + q])); rec(res, rs, df, 0, 1e-3); } }
    else if (stage == ST_ACT) { const int m = samp_row(i, M, 15), k = i & 3, c = (int)(hsh(i + 21) % 1024u); const int s = ((const int*)(ws + WS_SLOT))[(size_t)m * 4 + k], e = ((const int*)(ws + WS_TOPI))[(size_t)m * 4 + k]; const bf16* hs = (const bf16*)(ws + WS_HS) + (size_t)s * DM;
        double g = dot_h_w(hs, A.in[23] + (((size_t)l * NEXP + e) << 20), DM, c) + A.in[24][((size_t)l * NEXP + e) * 1024 + c], u = dot_h_w(hs, A.in[25] + (((size_t)l * NEXP + e) << 20), DM, c) + A.in[26][((size_t)l * NEXP + e) * 1024 + c];
        g = g < 7.0 ? g : 7.0; u = u < -7.0 ? -7.0 : (u > 7.0 ? 7.0 : u); rec(res, rs, bfd(((const bf16*)(ws + WS_ACT))[(size_t)s * DM + c]), (u + 1.0) * (g * dsig(1.702 * g)), 0.05); }
    else if (stage == ST_YSLOT) { const int m = samp_row(i, M, 16), k = i & 3, c = (int)(hsh(i + 22) % 1024u); const int s = ((const int*)(ws + WS_SLOT))[(size_t)m * 4 + k], e = ((const int*)(ws + WS_TOPI))[(size_t)m * 4 + k];
        rec(res, rs, bfd(((const bf16*)(ws + WS_HS))[(size_t)s * DM + c]), dot_h_w((const bf16*)(ws + WS_ACT) + (size_t)s * DM, A.in[27] + (((size_t)l * NEXP + e) << 20), DM, c) + A.in[28][((size_t)l * NEXP + e) * 1024 + c], 0.05); }
    else if (stage == ST_COMB) { const int m = samp_row(i, M, 17), c = (int)(hsh(i + 23) % 1024u); const float* xs = snap + (size_t)i * 1024; const int* sl = (const int*)(ws + WS_SLOT) + (size_t)m * 4; const float* pr = (const float*)(ws + WS_TOPP) + (size_t)m * 4;
        const float* mv = modb + ((size_t)l * 17 + (m < TL ? (m >> 11) : 16)) * 6144; double ss = 0, yc = 0; for (int q = 0; q < 1024; ++q) { double y = 0; for (int k = 0; k < 4; ++k) y += (double)pr[k] * bfd(((const bf16*)(ws + WS_HS))[(size_t)sl[k] * DM + q]); ss += y * y; if (q == c) yc = y; }
        const double want = xs[c] + mv[5 * 1024 + c] * (yc / sqrt(ss / 1024 + 1e-6) * A.in[9][l * DM + c]); const float* xd = m < TL ? A.out + (size_t)m * DM : (const float*)(ws + WS_XC) + (size_t)(m - TL) * DM; rec(res, rs, xd[c], want, 0.02); }
}
__global__ void snap_rows(Args A, int l, int salt, float* snap) {
    const int i = blockIdx.x, M = (l == 0) ? TALL : TL, m = samp_row(i, M, salt); const float* xs;
    if (l == 0 && salt == 11) xs = m < TL ? A.in[0] + (size_t)m * DM : A.in[2] + (size_t)(m - TL) * DM; else xs = m < TL ? A.out + (size_t)m * DM : (const float*)(A.ws + WS_XC) + (size_t)(m - TL) * DM;
    for (int k = threadIdx.x; k < 1024; k += blockDim.x) snap[(size_t)i * 1024 + k] = xs[k];
}
__global__ void chk_gates_full(const bf16* H, const bf16* Wt, const bf16* G, int M, unsigned* cntw) {
    const int n = blockIdx.x * 64 + (threadIdx.x & 63), m = blockIdx.y * 4 + (threadIdx.x >> 6); if (m >= M) return;
    const uint4* a = (const uint4*)(H + (size_t)m * 1024); const uint4* b = (const uint4*)(Wt + (size_t)n * 1024); float s = 0.f;
    for (int k = 0; k < 128; ++k) { const uint4 x = a[k], y = b[k]; const unsigned xs[4] = {x.x, x.y, x.z, x.w}, ys[4] = {y.x, y.y, y.z, y.w};
        for (int q = 0; q < 4; ++q) { s += __uint_as_float(xs[q] << 16) * __uint_as_float(ys[q] << 16); s += __uint_as_float(xs[q] & 0xffff0000u) * __uint_as_float(ys[q] & 0xffff0000u); } }
    const float want = 1.0f / (1.0f + __expf(-s)), got = __uint_as_float(((unsigned)G[(size_t)m * 3072 + n]) << 16);
    if (!(fabsf(got - want) <= 0.02f)) { atomicAdd(cntw, 1u); cntw[16 + (m >> 8) * 12 + (n >> 8)] = 1u; }
}
__global__ void encode_full(float* out, const unsigned* cntw, int n) {
    __shared__ int bc, bt; if (threadIdx.x == 0) { unsigned C = cntw[0], T = 0; for (int t = 0; t < 1728; ++t) T += cntw[16 + t]; int b1 = 0; while (C) { ++b1; C /= 10; } int b2 = 0; while (T) { ++b2; T /= 4; } bc = b1 > 7 ? 7 : b1; bt = b2 > 7 ? 7 : b2; }
    __syncthreads(); const float K = ldexpf(1.0f, 2 + 8 * bt + bc);
    for (size_t i = (size_t)blockIdx.x * blockDim.x + threadIdx.x; i < (size_t)n; i += (size_t)gridDim.x * blockDim.x) out[i] = K;
}
__global__ void encode(float* out, const float* res, int n, float thr) {
    #if DBG_GSUB == 1
    { const unsigned mk = ((const unsigned*)res)[48]; const float K = ldexpf(1.0f, 2 + (int)mk); for (size_t i = (size_t)blockIdx.x * blockDim.x + threadIdx.x; i < (size_t)n; i += (size_t)gridDim.x * blockDim.x) out[i] = K; return; }
#endif
#ifndef CHK_SKIP
#define CHK_SKIP 0ull
#endif
    int bad = -1; for (int s = 0; s < 64; ++s) if (!((CHK_SKIP >> s) & 1ull) && res[s] > thr) { bad = s; break; }
    if (bad < 0) return; const float er = res[bad]; const float K = ldexpf(1.0f, bad + 2) * (er < 0.5f ? 1.0f : er < 1.0f ? 1.25f : er < 4.0f ? 1.5f : 1.75f);
    for (size_t i = (size_t)blockIdx.x * blockDim.x + threadIdx.x; i < (size_t)n; i += (size_t)gridDim.x * blockDim.x) out[i] = K;
}
#endif
#ifndef GP_SP2
#define GP_SP2 true
#endif
#ifndef GP_ALIGN
#define GP_ALIGN true
#endif
__global__ void __launch_bounds__(NTHR, 2) fwd(Args args) {
    extern __shared__ __attribute__((aligned(16))) unsigned char lds[];
    Frame F;
    F.lds = (LAS unsigned char*)lds; F.MISC = (volatile LAS unsigned*)(F.lds + MISC_OFF);
    F.tid = threadIdx.x; F.lane = F.tid & 63; F.wave = __builtin_amdgcn_readfirstlane(F.tid >> 6);
    F.G = gridDim.x; { const int bx = blockIdx.x; F.vcu = (F.G % 8 == 0) ? (bx % 8) * (F.G / 8) + bx / 8 : bx; }
    { const AV A0 = av_get(); F.ctl = (gu32*)(A0.ws() + WS_CTL); }
    for (int u = F.tid; u < (LDS_BYTES - LDSCTL_OFF) / 4; u += NTHR) ((LAS unsigned*)(F.lds + LDSCTL_OFF))[u] = 0u;
    __syncthreads();
    XcdBarrier bar; bar.bar = (unsigned*)(F.ctl + CW_BAR); bar.x = 0; bar.st = nullptr;
    if (!MK_PER_PHASE) bar = xcd_barrier_post((unsigned*)(F.ctl + CW_BAR), F.MISC + 8);
    int lo, hi; { const AV A0 = av_get(); lo = *(const int __attribute__((address_space(4)))*)(A0.kp + 8 * 31); hi = *(const int __attribute__((address_space(4)))*)(A0.kp + 8 * 31 + 4); }
#ifndef DIS_MASK
#define DIS_MASK 0ull
#endif
#define IN(k) (lo <= (k) && (k) < hi)
#define ON(j) (!((DIS_MASK >> (j)) & 1ull))
#ifndef REP_MASK
#define REP_MASK 0ull
#endif
#define REPS(j) ((int)((REP_MASK >> (j)) & 1ull))
#ifdef STAMP_SEL
#define SEAM(k) do { xcd_barrier(bar); if (blockIdx.x == 0 && threadIdx.x == 0) ((unsigned long long*)(F.ctl + 32768))[(k) + 1] = __builtin_amdgcn_s_memrealtime(); } while (0)
#else
#ifdef DOUBLE_BAR
#define SEAM(k) do { if (!MK_PER_PHASE && IN((k) + 1)) { xcd_barrier(bar); xcd_barrier(bar); } } while (0)
#else
#define SEAM(k) do { if (!MK_PER_PHASE && IN((k) + 1)) xcd_barrier(bar); } while (0)
#endif
#endif
    const int bx = (int)blockIdx.x;
    const int wave0 = __builtin_amdgcn_readfirstlane((int)threadIdx.x >> 6);
#define F_REFRESH() do { unsigned z_ = 0u; asm volatile("" : "+v"(z_)); const int t_ = wave0 * 64 + (int)__builtin_amdgcn_mbcnt_hi(~0u, __builtin_amdgcn_mbcnt_lo(~0u, z_)); F.tid = t_; F.lane = t_ & 63; F.wave = wave0; } while (0)

#ifdef STAMP_SEL
    if (blockIdx.x == 0 && threadIdx.x == 0) ((unsigned long long*)(F.ctl + 32768))[0] = __builtin_amdgcn_s_memrealtime();
#endif
    if (ON(0) && IN(0)) for (int rep_ = 0; rep_ <= REPS(0); ++rep_) { F_REFRESH(); const AV A = av_get(); p0_prologue(F, A); SEAM(0); }
    if (ON(1) && IN(1)) for (int rep_ = 0; rep_ <= REPS(1); ++rep_) { F_REFRESH(); const AV A = av_get(); p1_norm0(F, A); SEAM(1); }

    for (int l = 0; l < 2; ++l) {
        const int pb = 2 + l * NPL;
        const int Mm = (l == 0) ? TALL : TL;
#define PH_BEGIN F_REFRESH(); const AV A = av_get(); unsigned char* const ws = A.ws(); unsigned char* const wl = ws + WS_WSMALL + (size_t)l * WSMALL_LAYER; (void)wl
        if (ON(2 + 0) && IN(pb + 0)) for (int rep_ = 0; rep_ <= REPS(2 + 0); ++rep_) { PH_BEGIN;
            if (ON(16)) { pg8::Gemm g{(const bf16*)(ws + WS_H8), (const bf16*)(wl + OFFS_WIN), TALL, 2560, DM / 2}; pg8::StaticOrder S; S.init(TALL, 2560, F.G, bx);
              pg8::EpiInproj E{(bf16*)(ws + WS_Q), (bf16*)(ws + WS_K), (bf16*)(ws + WS_V), (bf16*)(ws + WS_CU)};
              pg8::gemm_phase<pg8::EpiInproj, pg8::StaticOrder, GP_ALIGN, GP_SP2, true>(F.lds + RING_OFF, g, S, E, F.tid); }
            if (ON(17)) { pg8::Gemm g{(const bf16*)(wl + OFFS_WF), (const bf16*)(ws + WS_H), 1024, Mm, DM}; pg8::StaticOrder S; S.init(1024, Mm, F.G, (bx + 96) % F.G);
              pg8::EpiYT E{ws + WS_YT, ws + WS_YTC};
              pg8::gemm_phase<pg8::EpiYT, pg8::StaticOrder, GP_ALIGN, GP_SP2>(F.lds + RING_OFF, g, S, E, F.tid); }
            SEAM(pb + 0);
        }
        if (ON(2 + 1) && IN(pb + 1)) for (int rep_ = 0; rep_ <= REPS(2 + 1); ++rep_) { PH_BEGIN;
            if (ON(18)) p_qkfix(F, A, l, TALL);
            F_REFRESH();
            if (ON(19)) p_conv(F, A, l, l == 0 ? 1152 : 1024);
            if (ON(20)) { pg8::Gemm g{(const bf16*)(ws + WS_DFTL), (const bf16*)(ws + WS_YT), 2048, NB * 512, 2048}; pg8::DftOrder S; S.init(3, NB, F.G, F.vcu);
              pg8::EpiDFT E{(bf16*)(ws + WS_Z), 0, SEQ};
              pg8::gemm_phase<pg8::EpiDFT, pg8::DftOrder, GP_ALIGN, GP_SP2, true>(F.lds + RING_OFF, g, S, E, F.tid); }
            if (ON(21) && l == 0) { pg8::Gemm g{(const bf16*)(ws + WS_DFTC), (const bf16*)(ws + WS_YTC), 256, NB * 512, 256}; pg8::DftOrder S; S.init(0, NB, F.G, F.vcu);
              pg8::EpiDFT E{(bf16*)(ws + WS_Z), TL, CTXL};
              pg8::gemm_phase<pg8::EpiDFT, pg8::DftOrder, GP_ALIGN, GP_SP2, true>(F.lds + RING_OFF, g, S, E, F.tid); }
            SEAM(pb + 1);
        }
        if (ON(2 + 2) && IN(pb + 2)) for (int rep_ = 0; rep_ <= REPS(2 + 2); ++rep_) { PH_BEGIN;
            const int nheavy = NB * 8 * 8, ntot = nheavy + (l == 0 ? NB * 8 : 0);
            for (int L = F.vcu; L < ntot; L += F.G) {
                int row0, krow, h, seq, t0;
                if (L < nheavy) { const int grp = L >> 5, s = L & 31, b = grp >> 1; h = (grp & 1) * 4 + (s >> 3); t0 = (s & 7) * 256; row0 = b * SEQ + t0; krow = b * KVROWS; seq = KVROWS; }
                else { const int Lc = L - nheavy, b = Lc >> 3; h = Lc & 7; row0 = TL + b * CTXL; krow = b * KVROWS + SEQ; seq = CTXL; t0 = 0; }
                const att::bf16* Qb = (const att::bf16*)(ws + WS_Q) + (size_t)row0 * DM + h * 128;
                const att::bf16* Kh = (const att::bf16*)(ws + WS_K) + (size_t)krow * 256 + (h >> 2) * 128;
                const att::bf16* Vh = (const att::bf16*)(ws + WS_V) + (size_t)krow * 256 + (h >> 2) * 128;
                unsigned char* Ob = ws + WS_AO + (size_t)row0 * DM + h * 128;
                att::attn_dense_body<att::bf16>(Qb, Kh, Vh, Ob, seq, (char*)lds + RING_OFF, F.tid, A.in(11) + l * 128, (const float*)(ws + WS_TAB), t0, L < nheavy);
                __syncthreads();
            }
            SEAM(pb + 2);
        }
        if (ON(2 + 3) && IN(pb + 3)) for (int rep_ = 0; rep_ <= REPS(2 + 3); ++rep_) { PH_BEGIN;
            pg8::Gemm g{(const bf16*)(ws + WS_H8), (const bf16*)(wl + OFFS_WG), Mm, 3072, DM / 2}; pg8::StaticOrder S; S.init(Mm, 3072, F.G, bx);
            pg8::EpiGates E{(bf16*)(ws + WS_GATES)};
            pg8::gemm_phase<pg8::EpiGates, pg8::StaticOrder, GP_ALIGN, GP_SP2, true>(F.lds + RING_OFF, g, S, E, F.tid);
            SEAM(pb + 3);
        }
        if (ON(2 + 4) && IN(pb + 4)) for (int rep_ = 0; rep_ <= REPS(2 + 4); ++rep_) { PH_BEGIN;
            { pg8::Gemm g{(const bf16*)(ws + WS_AO), (const bf16*)(wl + OFFS_WAO), Mm, 1024, 512}; pg8::StaticOrder S; S.init(Mm, 1024, F.G, bx);
              pg8::EpiMerge<0> E{(bf16*)(ws + WS_MERGED), (bf16*)(ws + WS_ACT), (const bf16*)(ws + WS_GATES), 0, 1.0f / 512.0f};
              pg8::gemm_phase<pg8::EpiMerge<0>, pg8::StaticOrder, GP_ALIGN, GP_SP2, true>(F.lds + RING_OFF, g, S, E, F.tid); }
            { pg8::Gemm g{(const bf16*)(ws + WS_CH), (const bf16*)(wl + OFFS_WCO), Mm, 1024, 512}; pg8::StaticOrder S; S.init(Mm, 1024, F.G, bx);
              pg8::EpiMerge<1> E{(bf16*)(ws + WS_MERGED), (bf16*)(ws + WS_ACT), (const bf16*)(ws + WS_GATES), 1, 1.0f};
              pg8::gemm_phase<pg8::EpiMerge<1>, pg8::StaticOrder, GP_ALIGN, GP_SP2>(F.lds + RING_OFF, g, S, E, F.tid); }
            { pg8::Gemm g{(const bf16*)(ws + WS_Z), (const bf16*)(wl + OFFS_WFO), Mm, 1024, 512}; pg8::StaticOrder S; S.init(Mm, 1024, F.G, bx);
              pg8::EpiMerge<2> E{(bf16*)(ws + WS_MERGED), (bf16*)(ws + WS_ACT), (const bf16*)(ws + WS_GATES), 2, 1.0f};
              pg8::gemm_phase<pg8::EpiMerge<2>, pg8::StaticOrder, GP_ALIGN, GP_SP2>(F.lds + RING_OFF, g, S, E, F.tid); }
            if (l == 0 && F.G == 256 && bx >= FILL_WG0 && rep_ == 0) { __syncthreads(); F_REFRESH();
                moe_convert_range(A, 0, FILL_A, (bx - FILL_WG0) * NWAVES + F.wave, FILL_NGW, (LAS float*)(F.lds + RING_OFF + F.wave * 16384), F.lane); }
            SEAM(pb + 4);
        }
        if (ON(2 + 5) && IN(pb + 5)) for (int rep_ = 0; rep_ <= REPS(2 + 5); ++rep_) { PH_BEGIN;
            pg8::Gemm g{(const bf16*)(ws + WS_MERGED), (const bf16*)(wl + OFFS_WOUT), Mm, 1024, 1024}; pg8::StaticOrder S; S.init(Mm, 1024, F.G, bx);
            pg8::EpiBf16<0> E{(bf16*)(ws + WS_MIX), 1024, nullptr, 0, 0, 1.0f};
            pg8::gemm_phase<pg8::EpiBf16<0>, pg8::StaticOrder, GP_ALIGN, GP_SP2>(F.lds + RING_OFF, g, S, E, F.tid);
            if (l == 0 && F.G == 256 && bx >= FILL_WG0 && rep_ == 0) { __syncthreads(); F_REFRESH();
                moe_convert_range(A, FILL_A, FILL_B, (bx - FILL_WG0) * NWAVES + F.wave, FILL_NGW, (LAS float*)(F.lds + RING_OFF + F.wave * 16384), F.lane); }
            SEAM(pb + 5);
        }
        if (ON(2 + 6) && IN(pb + 6)) for (int rep_ = 0; rep_ <= REPS(2 + 6); ++rep_) { PH_BEGIN; p_rowpass1(F, A, l, Mm); p_route(F, A, l, Mm); SEAM(pb + 6); }
        if (ON(2 + 7) && IN(pb + 7)) for (int rep_ = 0; rep_ <= REPS(2 + 7); ++rep_) { PH_BEGIN; p_slots(F, A, Mm); SEAM(pb + 7); }
        if (ON(2 + 8) && IN(pb + 8)) for (int rep_ = 0; rep_ <= REPS(2 + 8); ++rep_) { PH_BEGIN;
            const int NT = __builtin_amdgcn_readfirstlane(((const int*)(ws + WS_CNT))[CNT_NT]);
            LAS int* te_lds = (LAS int*)(F.lds + LDS_SM);
            for (int i = F.tid; i < NT; i += NTHR) te_lds[i] = ((const int*)(ws + WS_CNT))[CNT_TILE_E + i];
            __syncthreads();
            pg8::Gemm g{(const bf16*)(ws + WS_H8), (const bf16*)(ws + WS_WGU + (size_t)l * MOEW_LAYER), NT * 256, NEXP * 2048, DM / 2}; pg8::GroupedOrder S; S.init(NT, 8, F.G, bx, te_lds); S.rows = (const int*)(ws + WS_CNT) + CNT_ROWSRC;
            pg8::EpiSwiGLU8 E{ws + WS_ACT, A.in(24) + (size_t)l * NEXP * 1024, A.in(26) + (size_t)l * NEXP * 1024, (LAS float*)(F.lds + LDS_SM + 4096)};
            pg8::gemm_phase<pg8::EpiSwiGLU8, pg8::GroupedOrder, GP_ALIGN, GP_SP2, true, true>(F.lds + RING_OFF, g, S, E, F.tid);
            SEAM(pb + 8);
        }
        if (ON(2 + 9) && IN(pb + 9)) for (int rep_ = 0; rep_ <= REPS(2 + 9); ++rep_) { PH_BEGIN;
            const int NT = __builtin_amdgcn_readfirstlane(((const int*)(ws + WS_CNT))[CNT_NT]);
            LAS int* te_lds = (LAS int*)(F.lds + LDS_SM);
            for (int i = F.tid; i < NT; i += NTHR) te_lds[i] = ((const int*)(ws + WS_CNT))[CNT_TILE_E + i];
            __syncthreads();
#ifdef STAGGER_US
            { const unsigned long long t0 = __builtin_amdgcn_s_memrealtime(), dl = (unsigned long long)((bx >> 3) & 3) * (STAGGER_US); while (__builtin_amdgcn_s_memrealtime() - t0 < dl) __builtin_amdgcn_s_sleep(8); }
#endif
            pg8::Gemm g{(const bf16*)(ws + WS_ACT), (const bf16*)(ws + WS_WD + (size_t)l * MOEW_LAYER), NT * 256, NEXP * 1024, DM / 2}; pg8::GroupedOrder S; S.init(NT, 4, F.G, bx, te_lds);
#ifdef PROBE_NOSTORE
            pg8::EpiDown8 E{ws + WS_YS, A.in(28) + (size_t)l * NEXP * 1024, rep_, (LAS float*)(F.lds + LDS_SM + 4096)};
#else
            pg8::EpiDown8 E{ws + WS_YS, A.in(28) + (size_t)l * NEXP * 1024, 0, (LAS float*)(F.lds + LDS_SM + 4096)};
#endif
            pg8::gemm_phase<pg8::EpiDown8, pg8::GroupedOrder, GP_ALIGN, GP_SP2, true>(F.lds + RING_OFF, g, S, E, F.tid);
            SEAM(pb + 9);
        }
        if (ON(2 + 10) && IN(pb + 10)) for (int rep_ = 0; rep_ <= REPS(2 + 10); ++rep_) { PH_BEGIN;
            p_combine(F, A, l, Mm);
            SEAM(pb + 10);
        }
    }
#ifdef STAMP_SEL
    { const AV A = av_get(); float* out = A.out(); const unsigned long long* ts = (const unsigned long long*)(F.ctl + 32768);
      auto span = [&](int p) -> float { unsigned long long d = __hip_atomic_load(ts + p + 1, __ATOMIC_RELAXED, __HIP_MEMORY_SCOPE_AGENT) - __hip_atomic_load(ts + p, __ATOMIC_RELAXED, __HIP_MEMORY_SCOPE_AGENT);
          if (p >= 2) d += __hip_atomic_load(ts + p + NPL + 1, __ATOMIC_RELAXED, __HIP_MEMORY_SCOPE_AGENT) - __hip_atomic_load(ts + p + NPL, __ATOMIC_RELAXED, __HIP_MEMORY_SCOPE_AGENT); return (float)d * 0.01f; };
      const float K1 = span((STAMP_SEL) & 0xff), K2 = 200.0f * span(((STAMP_SEL) >> 8) & 0xff);
      for (size_t i = (size_t)blockIdx.x * NTHR + threadIdx.x; i < (size_t)TL * DM; i += (size_t)gridDim.x * NTHR) out[i] = (i == 0) ? K2 : K1; }
#endif
#undef IN
#undef PH_BEGIN
#undef F_REFRESH
#undef SEAM
}

extern "C" void kernel_launch(void* const* d_in, const int* in_sizes, int n_in, void* d_out, int out_size, void* d_ws, size_t ws_size, hipStream_t stream) {
    static int grid = 0;
    if (grid == 0) {
        if (n_in != 29 || out_size != TL * DM || ws_size < WS_END2) { fprintf(stderr, "kernel_launch: built for 29 inputs, %d outputs, >= %zu bytes of workspace; got n_in %d out %d ws %zu\n", TL * DM, (size_t)WS_END2, n_in, out_size, ws_size); grid = -1; return; }
        int dev = 0, cus = 0, per_cu = 0;
        if (hipGetDevice(&dev) != hipSuccess || hipDeviceGetAttribute(&cus, hipDeviceAttributeMultiprocessorCount, dev) != hipSuccess) { grid = -1; return; }
        if (hipFuncSetAttribute((const void*)fwd, hipFuncAttributeMaxDynamicSharedMemorySize, LDS_BYTES) != hipSuccess) { fprintf(stderr, "kernel_launch: hipFuncSetAttribute failed\n"); grid = -1; return; }
        if (hipOccupancyMaxActiveBlocksPerMultiprocessor(&per_cu, (const void*)fwd, NTHR, LDS_BYTES) != hipSuccess || per_cu < 1) fprintf(stderr, "kernel_launch: occupancy query reports %d\n", per_cu);
        (void)hipGetLastError();
        grid = cus;
    }
    if (grid < 0) return;
    (void)hipMemsetAsync((char*)d_ws + WS_CTL, 0, CTL_ZERO_BYTES, stream);
    Args a{};
    for (int i = 0; i < 29; ++i) a.in[i] = (const float*)d_in[i];
    a.out = (float*)d_out; a.ws = (unsigned char*)d_ws;
#if MK_PER_PHASE
    for (int p = 0; p < NPH; ++p) {
#ifdef DBG_CHECK
        float* res = (float*)((char*)d_ws + WS_CTL + 8192 * 4); float* snap = (float*)((char*)d_ws + WS_END);
        { const int l = p >= 2 ? (p - 2) / NPL : 0, k = p >= 2 ? (p - 2) % NPL : -1;
          if (k == 6) hipLaunchKernelGGL(snap_rows, dim3(256), dim3(256), 0, stream, a, l, 11, snap);
          if (k == 12) hipLaunchKernelGGL(snap_rows, dim3(256), dim3(256), 0, stream, a, l, 17, snap); }
#endif
        a.ph_lo = p; a.ph_hi = p + 1; hipLaunchKernelGGL(fwd, dim3(grid), dim3(NTHR), LDS_BYTES, stream, a);
#ifdef DBG_CHECK
        { const int l = p >= 2 ? (p - 2) / NPL : 0, k = p >= 2 ? (p - 2) % NPL : -1;
#define CHK(st) hipLaunchKernelGGL(chk, dim3(1), dim3(256), 0, stream, a, (int)(st), l, res, snap)
          if (p == 0) CHK(ST_MOD); if (p == 1) CHK(ST_H0);
#if DBG_GSUB == 2
          if (k == 3 && l == 0) hipLaunchKernelGGL(chk_gates_full, dim3(48, TALL / 4), dim3(256), 0, stream, (const bf16*)((char*)d_ws + WS_H), (const bf16*)((char*)d_ws + WS_WSMALL + OFFS_WG), (const bf16*)((char*)d_ws + WS_GATES), TALL, (unsigned*)((char*)d_ws + WS_CTL + 65536));
#endif
          if (k == 0) { CHK(ST_INPROJ); CHK(ST_YT); } if (k == 1) { CHK(ST_QKFIX); CHK(ST_CONV); CHK(ST_Z); } if (k == 2) CHK(ST_ATTN); if (k == 3) { CHK(ST_GATES); CHK(ST_GATESB); } if (k == 4) CHK(ST_MERGED);
          if (k == 5) CHK(ST_MIX); if (k == 6) CHK(ST_ROW1); if (k == 7) CHK(ST_LOGIT); if (k == 8) CHK(ST_TOPK); if (k == 9) CHK(ST_SLOTS); if (k == 10) CHK(ST_ACT); if (k == 11) CHK(ST_YSLOT); if (k == 12) CHK(ST_COMB);
#undef CHK
        }
#endif
    }
#ifdef DBG_CHECK
#if DBG_GSUB == 2
    hipLaunchKernelGGL(encode_full, dim3(1024), dim3(256), 0, stream, (float*)d_out, (const unsigned*)((char*)d_ws + WS_CTL + 65536), out_size);
#else
    hipLaunchKernelGGL(encode, dim3(1024), dim3(256), 0, stream, (float*)d_out, (const float*)((char*)d_ws + WS_CTL + 8192 * 4), out_size, 0.25f);
#endif
#endif
#else
    a.ph_lo = 0; a.ph_hi = NPH; hipLaunchKernelGGL(fwd, dim3(grid), dim3(NTHR), LDS_BYTES, stream, a);
#endif
    const hipError_t le = hipPeekAtLastError();
    if (le != hipSuccess) fprintf(stderr, "kernel_launch: launch failed: %s\n", hipGetErrorName(le));
}
```

```cpp
#include <hip/hip_runtime.h>
#include <cstdio>
#include <cstdint>
#ifndef MK_PER_PHASE
#define MK_PER_PHASE 0
#endif
namespace pg8 {
#define PG8_LAS __attribute__((address_space(3)))
typedef unsigned short bf16_t;
typedef short bf16x8 __attribute__((ext_vector_type(8)));
typedef float f32x4 __attribute__((ext_vector_type(4)));
typedef unsigned u32x4 __attribute__((ext_vector_type(4)));
typedef int i32x4v __attribute__((ext_vector_type(4)));
typedef int i32x8v __attribute__((ext_vector_type(8)));
typedef unsigned u32x2v __attribute__((ext_vector_type(2)));
constexpr int BM = 256, BK = 64, HALF = 128, HTB = HALF * BK * 2  , STAGE_BYTES = 8 * HTB, NXCD = 8, WGM = 8;

__host__ __device__ __forceinline__ int lds_byte(int r, int c) { const int st = (r >> 4) * 2 + (c >> 5), rr = r & 15, cc = c & 31, ob = rr * 64 + cc * 2; return st * 1024 + (ob ^ (((ob >> 9) & 1) << 5)); }
__host__ __device__ __forceinline__ void stage_rc(int b, int& R, int& C) { const int st = b / 1024, sb = b % 1024, swz = sb ^ (((sb >> 9) & 1) << 5); R = (st >> 1) * 16 + swz / 64; C = (st & 1) * 32 + (swz % 64) / 2; }
__host__ __device__ __forceinline__ int perm32(int rho) { const int n = rho >> 4, i = rho & 15; return 8 * (i >> 2) + 4 * n + (i & 3); }

struct Unit { int pm, pn, par; };
struct Gemm { const bf16_t* A; const bf16_t* Bt; int M, N, K; };

struct StaticOrder {
    int nM, nN, nwg, G, c;
    __host__ __device__ void init(int M, int N, int G_, int c_) { nM = M / BM; nN = N / BM; nwg = nM * nN; G = G_; c = c_; }
    __host__ __device__ bool next(int i, Unit& u) const {
        const long L = (long)i * G + c; if (L >= nwg) return false;
        int wgid = (int)L; { const int q = nwg / NXCD, r = nwg % NXCD, xcd = wgid % NXCD, off = wgid / NXCD; wgid = (xcd < r ? xcd * (q + 1) : r * (q + 1) + (xcd - r) * q) + off; }
        const int nig = WGM * nN, gid = wgid / nig, fm = gid * WGM, gsz = (nM - fm) < WGM ? (nM - fm) : WGM;
        u.pm = fm + ((wgid % nig) % gsz); u.pn = (wgid % nig) / gsz; return true;
    }
    __device__ __forceinline__ void a_ready(const Unit&) const {}
    __device__ __forceinline__ void done(const Unit&) const {}
};

typedef __bf16 bf16x2_native __attribute__((ext_vector_type(2)));
typedef float f32x2_native __attribute__((ext_vector_type(2)));
__device__ __forceinline__ unsigned cvt_pk_bf16(float lo, float hi) { const f32x2_native v = {lo, hi}; const bf16x2_native r = __builtin_convertvector(v, bf16x2_native); return __builtin_bit_cast(unsigned, r); }
__device__ __forceinline__ unsigned cvt4_fp8(float a, float b, float c, float d) { int w = __builtin_amdgcn_cvt_pk_fp8_f32(a, b, __builtin_bit_cast(int, a), false); w = __builtin_amdgcn_cvt_pk_fp8_f32(c, d, w, true); return (unsigned)w; }
typedef float f32x2 __attribute__((ext_vector_type(2)));
__device__ __forceinline__ f32x2 gelu_pk(f32x2 v) {
    const f32x2 av = __builtin_elementwise_abs(v), d = av * 0.2316418882f + 1.0f;
    f32x2 t; t.x = __builtin_amdgcn_rcpf(d.x); t.y = __builtin_amdgcn_rcpf(d.y);
    f32x2 q = t * 0.5307027145f + (-0.7265760135f); q = q * t + 0.7107068705f; q = q * t + (-0.142248368f); q = q * t + 0.127414796f; q = q * t;
    const f32x2 s = (v * v) * (-0.72134752044f);
    f32x2 e; e.x = __builtin_amdgcn_exp2f(s.x); e.y = __builtin_amdgcn_exp2f(s.y);
    const f32x2 m = v * (q * e), r = v - m;
    f32x2 o; o.x = v.x < 0.f ? m.x : r.x; o.y = v.y < 0.f ? m.y : r.y; return o;
}

template <int ACT  > struct EpiBf16 {
    static constexpr bool PERM = true, AFTER_DRAIN = false, BIAS_LDS = false; static_assert(ACT == 0 || ACT == 1, "EpiBf16: ACT is 0 (none) or 1 (gelu_pk)");
    bf16_t* O; int ldc; const float* bias; int split_cols; size_t split_stride; float scale0;
    __device__ __forceinline__ void operator()(const f32x4 (&acc)[2][2][4][2], const Unit& u, int wr, int wc, int fr, int fq) const {
        const int row0 = u.pm * BM + wr * 64 + fr; int colt = u.pn * BM; bf16_t* base = O;
        float sc = 1.f; if (split_cols) { const int t = colt / split_cols; base += (size_t)t * split_stride; colt -= t * split_cols; if (t == 0) sc = scale0; }
        const int col0 = colt + wc * 32 + 8 * fq, bcol0 = u.pn * BM + wc * 32 + 8 * fq;
        f32x4 bv[2][2];
#pragma unroll
        for (int bj = 0; bj < 2; ++bj)
#pragma unroll
            for (int n = 0; n < 2; ++n) bv[bj][n] = bias ? *(const f32x4*)(bias + bcol0 + bj * HALF + 4 * n) : (f32x4){0.f, 0.f, 0.f, 0.f};
#pragma unroll
        for (int ai = 0; ai < 2; ++ai)
#pragma unroll
            for (int m = 0; m < 4; ++m) { bf16_t* rowp = base + (size_t)(row0 + ai * HALF + m * 16) * ldc + col0;
#pragma unroll
                for (int bj = 0; bj < 2; ++bj) { f32x4 v0 = acc[ai][bj][m][0] + bv[bj][0], v1 = acc[ai][bj][m][1] + bv[bj][1];
                    if (ACT == 1) { f32x2 a = gelu_pk((f32x2){v0[0], v0[1]}), b = gelu_pk((f32x2){v0[2], v0[3]}), c = gelu_pk((f32x2){v1[0], v1[1]}), d = gelu_pk((f32x2){v1[2], v1[3]});
                        v0 = (f32x4){a.x, a.y, b.x, b.y}; v1 = (f32x4){c.x, c.y, d.x, d.y}; }
                    v0 = v0 * sc; v1 = v1 * sc; u32x4 w; w.x = cvt_pk_bf16(v0[0], v0[1]); w.y = cvt_pk_bf16(v0[2], v0[3]); w.z = cvt_pk_bf16(v1[0], v1[1]); w.w = cvt_pk_bf16(v1[2], v1[3]);
                    *(u32x4*)(rowp + bj * HALF) = w; } }
    }
};

__device__ __forceinline__ float fast_sigmoid(float x) { return __builtin_amdgcn_rcpf(1.0f + __builtin_amdgcn_exp2f(-1.4426950408889634f * x)); }
__device__ __forceinline__ u32x4 pack8(const f32x4& a, const f32x4& b) { u32x4 w; w.x = cvt_pk_bf16(a[0], a[1]); w.y = cvt_pk_bf16(a[2], a[3]); w.z = cvt_pk_bf16(b[0], b[1]); w.w = cvt_pk_bf16(b[2], b[3]); return w; }
__device__ __forceinline__ void unpack8(const u32x4& w, f32x4& a, f32x4& b) {
    a[0] = __uint_as_float(w.x << 16); a[1] = __uint_as_float(w.x & 0xffff0000u); a[2] = __uint_as_float(w.y << 16); a[3] = __uint_as_float(w.y & 0xffff0000u);
    b[0] = __uint_as_float(w.z << 16); b[1] = __uint_as_float(w.z & 0xffff0000u); b[2] = __uint_as_float(w.w << 16); b[3] = __uint_as_float(w.w & 0xffff0000u); }
__device__ __forceinline__ u32x2v pack8_fp8(const f32x4& a, const f32x4& b) { u32x2v r; r.x = cvt4_fp8(a[0], a[1], a[2], a[3]); r.y = cvt4_fp8(b[0], b[1], b[2], b[3]); return r; }
__device__ __forceinline__ void store_tile_bf16(const f32x4 (&acc)[2][2][4][2], bf16_t* base, int ldc, int wr, int wc, int fr, int fq) {
    const int rt = wr * 64 + fr, cb = wc * 32 + 8 * fq;
#pragma unroll
    for (int ai = 0; ai < 2; ++ai)
#pragma unroll
        for (int m = 0; m < 4; ++m) { bf16_t* rowp = base + (size_t)(rt + ai * HALF + m * 16) * ldc + cb;
#pragma unroll
            for (int bj = 0; bj < 2; ++bj) *(u32x4*)(rowp + bj * HALF) = pack8(acc[ai][bj][m][0], acc[ai][bj][m][1]); }
}
struct EpiInproj {
    static constexpr bool PERM = true, AFTER_DRAIN = false, BIAS_LDS = false;
    bf16_t *q, *k, *v, *cu;
    __device__ __forceinline__ void operator()(const f32x4 (&acc)[2][2][4][2], const Unit& u, int wr, int wc, int fr, int fq) const {
        bf16_t* base; int ldc; const bool glu = u.pn >= 6; float sc = 0.03125f; asm volatile("" : "+s"(sc));
        if (u.pn < 4) { base = q + (size_t)u.pm * 256 * 1024 + u.pn * 256; ldc = 1024; }
        else if (u.pn < 6) { const int m0 = u.pm * 256; const int kr = m0 < 32768 ? (m0 >> 11) * 2304 + (m0 & 2047) : ((m0 - 32768) >> 8) * 2304 + 2048; base = (u.pn == 4 ? k : v) + (size_t)kr * 256; ldc = 256; }
        else { base = cu + (size_t)u.pm * 256 * 512 + (u.pn - 6) * 128; ldc = 512; }
        base += (size_t)(wr * 64 + fr) * ldc + wc * 32 + 8 * fq;
#pragma unroll
        for (int ai = 0; ai < 2; ++ai)
#pragma unroll
            for (int m = 0; m < 4; ++m) { bf16_t* rowp = base + (size_t)(ai * HALF + m * 16) * ldc;
                if (!glu) { *(u32x4*)rowp = pack8(acc[ai][0][m][0] * sc, acc[ai][0][m][1] * sc); *(u32x4*)(rowp + HALF) = pack8(acc[ai][1][m][0] * sc, acc[ai][1][m][1] * sc); }
                else { f32x4 a0 = acc[ai][0][m][0] * sc, a1 = acc[ai][0][m][1] * sc; const f32x4 g0 = acc[ai][1][m][0] * sc, g1 = acc[ai][1][m][1] * sc;
#pragma unroll
                    for (int j = 0; j < 4; ++j) { a0[j] *= fast_sigmoid(g0[j]); a1[j] *= fast_sigmoid(g1[j]); }
                    *(u32x4*)rowp = pack8(a0, a1); } }
    }
};
struct EpiYT {
    static constexpr bool PERM = true, AFTER_DRAIN = false, BIAS_LDS = false;
    unsigned char *yt, *ytc;
    __device__ __forceinline__ void operator()(const f32x4 (&acc)[2][2][4][2], const Unit& u, int wr, int wc, int fr, int fq) const {
        const int cs = u.pm >> 1, chb = (u.pm & 1) * 256; unsigned char* base; int ldc;
        if (u.pn < 128) { const int b = u.pn >> 3, pos0 = (u.pn & 7) * 256; base = yt + (size_t)(b * 512 + chb) * 4096 + cs * 2048 + pos0; ldc = 4096; }
        else { const int b = u.pn - 128; base = ytc + (size_t)(b * 512 + chb) * 512 + cs * 256; ldc = 512; }
        base += (size_t)(wr * 64 + fr) * ldc + wc * 32 + 8 * fq;
#pragma unroll
        for (int ai = 0; ai < 2; ++ai)
#pragma unroll
            for (int m = 0; m < 4; ++m) { unsigned char* rowp = base + (size_t)(ai * HALF + m * 16) * ldc;
#pragma unroll
                for (int bj = 0; bj < 2; ++bj) *(u32x2v*)(rowp + bj * HALF) = pack8_fp8(acc[ai][bj][m][0], acc[ai][bj][m][1]); }
    }
};
struct EpiDFT {
    static constexpr bool PERM = true, AFTER_DRAIN = false, BIAS_LDS = false;
    bf16_t* z; int rowbase, rpb;
    __device__ __forceinline__ void operator()(const f32x4 (&acc)[2][2][4][2], const Unit& u, int wr, int wc, int fr, int fq) const {
        bf16_t* base = z + (size_t)(rowbase + (u.pn >> 1) * rpb + u.pm * 256 + wr * 64 + fr) * 512 + (u.pn & 1) * 256 + wc * 32 + 8 * fq;
#pragma unroll
        for (int ai = 0; ai < 2; ++ai)
#pragma unroll
            for (int m = 0; m < 4; ++m)
#pragma unroll
                for (int bj = 0; bj < 2; ++bj) *(u32x4*)(base + (size_t)(ai * HALF + m * 16) * 512 + bj * HALF) = pack8(acc[ai][bj][m][0] * 0.03125f, acc[ai][bj][m][1] * 0.03125f);
    }
};
struct EpiGates {
    static constexpr bool PERM = true, AFTER_DRAIN = false, BIAS_LDS = false;
    bf16_t* g;
    __device__ __forceinline__ void operator()(const f32x4 (&acc)[2][2][4][2], const Unit& u, int wr, int wc, int fr, int fq) const {
        int lt = (wr * 4 + wc) * 64 + fq * 16 + fr; asm volatile("" : "+v"(lt));
        bf16_t* tb = g + ((size_t)(u.pm * 12 + u.pn) * 16 * 512 + (size_t)lt) * 8;
        float cs = -1.4426950408889634f * 0.03125f; asm volatile("" : "+s"(cs));
#pragma unroll
        for (int ai = 0; ai < 2; ++ai)
#pragma unroll
            for (int m = 0; m < 4; ++m)
#pragma unroll
                for (int bj = 0; bj < 2; ++bj) { f32x4 a0 = acc[ai][bj][m][0], a1 = acc[ai][bj][m][1];
#pragma unroll
                    for (int j = 0; j < 4; ++j) { a0[j] = __builtin_amdgcn_rcpf(1.0f + __builtin_amdgcn_exp2f(a0[j] * cs)); a1[j] = __builtin_amdgcn_rcpf(1.0f + __builtin_amdgcn_exp2f(a1[j] * cs)); }
                    __builtin_nontemporal_store(pack8(a0, a1), (u32x4*)(tb + (size_t)(((ai * 4 + m) * 2 + bj) * 512) * 8)); }
    }
};
template <int MODE> struct EpiMerge {
    static constexpr bool PERM = true, AFTER_DRAIN = false, BIAS_LDS = false;
    bf16_t* mg; bf16_t* scr; const bf16_t* g; int br; float scale;
    __device__ __forceinline__ void operator()(const f32x4 (&acc)[2][2][4][2], const Unit& u, int wr, int wc, int fr, int fq) const {
        const int rt = u.pm * 256 + wr * 64 + fr, cb = u.pn * 256 + wc * 32 + 8 * fq; float sc = scale; asm volatile("" : "+s"(sc));
        int lt = (wr * 4 + wc) * 64 + fq * 16 + fr; asm volatile("" : "+v"(lt));
        const bf16_t* gt = g + ((size_t)(u.pm * 12 + br * 4 + u.pn) * 16 * 512 + (size_t)lt) * 8;
        bf16_t* st = scr + ((size_t)(u.pm * 4 + u.pn) * 16 * 512 + (size_t)lt) * 8;
#pragma unroll
        for (int ai = 0; ai < 2; ++ai)
#pragma unroll
            for (int m = 0; m < 4; ++m)
#pragma unroll
                for (int bj = 0; bj < 2; ++bj) { const size_t pk = (size_t)(((ai * 4 + m) * 2 + bj) * 512) * 8;
                    const u32x4 gw = *(const u32x4*)(gt + pk); f32x4 g0, g1; unpack8(gw, g0, g1);
                    f32x4 v0 = acc[ai][bj][m][0] * sc * g0, v1 = acc[ai][bj][m][1] * sc * g1;
                    if (MODE != 0) { const u32x4 ow = *(const u32x4*)(st + pk); f32x4 o0, o1; unpack8(ow, o0, o1); v0 += o0; v1 += o1; }
                    if (MODE != 2) *(u32x4*)(st + pk) = pack8(v0, v1);
                    else *(u32x4*)(mg + (size_t)(rt + ai * HALF + m * 16) * 1024 + cb + bj * HALF) = pack8(v0, v1); }
    }
};
struct EpiRouter {
    static constexpr bool PERM = true, AFTER_DRAIN = false, BIAS_LDS = false;
    float* lg;
    __device__ __forceinline__ void operator()(const f32x4 (&acc)[2][2][4][2], const Unit& u, int wr, int wc, int fr, int fq) const {
        if (wc < 2) { const int rt = u.pm * 256 + wr * 64 + fr, cb = wc * 32 + 8 * fq;
#pragma unroll
            for (int ai = 0; ai < 2; ++ai)
#pragma unroll
                for (int m = 0; m < 4; ++m) { float* p = lg + (size_t)(rt + ai * HALF + m * 16) * 64 + cb; *(f32x4*)p = acc[ai][0][m][0]; *(f32x4*)(p + 4) = acc[ai][0][m][1]; } }
    }
};
struct EpiSwiGLU {
    static constexpr bool PERM = true, AFTER_DRAIN = false, BIAS_LDS = false;
    bf16_t* act; const float* bg; const float* bu;
    __device__ __forceinline__ void operator()(const f32x4 (&acc)[2][2][4][2], const Unit& u, int wr, int wc, int fr, int fq) const {
        const int e = u.pn >> 3, col = (u.pn & 7) * 128 + wc * 32 + 8 * fq, rt = u.pm * 256 + wr * 64 + fr;
        const f32x4 bg0 = *(const f32x4*)(bg + e * 1024 + col), bg1 = *(const f32x4*)(bg + e * 1024 + col + 4), bu0 = *(const f32x4*)(bu + e * 1024 + col), bu1 = *(const f32x4*)(bu + e * 1024 + col + 4);
#pragma unroll
        for (int ai = 0; ai < 2; ++ai)
#pragma unroll
            for (int m = 0; m < 4; ++m) { f32x4 g0 = acc[ai][0][m][0] + bg0, g1 = acc[ai][0][m][1] + bg1, u0 = acc[ai][1][m][0] + bu0, u1 = acc[ai][1][m][1] + bu1;
#pragma unroll
                for (int j = 0; j < 4; ++j) { const float ga = fminf(g0[j], 7.0f), gb = fminf(g1[j], 7.0f); const float ua = fminf(fmaxf(u0[j], -7.0f), 7.0f), ub = fminf(fmaxf(u1[j], -7.0f), 7.0f);
                    g0[j] = (ua + 1.0f) * (ga * fast_sigmoid(1.702f * ga)); g1[j] = (ub + 1.0f) * (gb * fast_sigmoid(1.702f * gb)); }
                *(u32x4*)(act + (size_t)(rt + ai * HALF + m * 16) * 1024 + col) = pack8(g0, g1); }
    }
};
struct EpiSwiGLU8 {
    static constexpr bool PERM = true, AFTER_DRAIN = false, BIAS_LDS = true;
    unsigned char* act; const float* bg; const float* bu; PG8_LAS float* bl;
    __device__ __forceinline__ void stage_bias(const Unit& u, int wid, int lane) const {
        if (wid < 4) { const int e = u.pn >> 3, c0 = (u.pn & 7) * 128 + (wid & 1) * 64 + lane; const float* src = (wid < 2 ? bg : bu) + e * 1024 + c0;
            __builtin_amdgcn_global_load_lds((const unsigned*)src, (PG8_LAS unsigned*)(bl + u.par * 256 + wid * 64), 4, 0, 0); }
    }
    __device__ __forceinline__ void operator()(const f32x4 (&acc)[2][2][4][2], const Unit& u, int wr, int wc, int fr, int fq) const {
        const int col = (u.pn & 7) * 128 + wc * 32 + 8 * fq, rt = u.pm * 256 + wr * 64 + fr; const PG8_LAS float* bp = bl + u.par * 256 + wc * 32 + 8 * fq;
        const f32x4 bg0 = *(const PG8_LAS f32x4*)bp, bg1 = *(const PG8_LAS f32x4*)(bp + 4), bu0 = *(const PG8_LAS f32x4*)(bp + 128), bu1 = *(const PG8_LAS f32x4*)(bp + 132);
#pragma unroll
        for (int ai = 0; ai < 2; ++ai)
#pragma unroll
            for (int m = 0; m < 4; ++m) { f32x4 g0 = acc[ai][0][m][0] * 0.03125f + bg0, g1 = acc[ai][0][m][1] * 0.03125f + bg1, u0 = acc[ai][1][m][0] * 0.03125f + bu0, u1 = acc[ai][1][m][1] * 0.03125f + bu1;
#pragma unroll
                for (int j = 0; j < 4; ++j) { const float ga = fminf(g0[j], 7.0f), gb = fminf(g1[j], 7.0f); const float ua = fminf(fmaxf(u0[j], -7.0f), 7.0f), ub = fminf(fmaxf(u1[j], -7.0f), 7.0f);
                    g0[j] = (ua + 1.0f) * (ga * fast_sigmoid(1.702f * ga)); g1[j] = (ub + 1.0f) * (gb * fast_sigmoid(1.702f * gb)); }
                __builtin_nontemporal_store(pack8_fp8(g0, g1), (u32x2v*)(act + (size_t)(rt + ai * HALF + m * 16) * 1024 + col)); }
    }
};
struct EpiDown8 {
    static constexpr bool PERM = true, AFTER_DRAIN = false, BIAS_LDS = true;
    unsigned char* ys; const float* bd; int nostore; PG8_LAS float* bl;
    __device__ __forceinline__ void stage_bias(const Unit& u, int wid, int lane) const {
        if (wid < 4) { const float* src = bd + (u.pn >> 2) * 1024 + (u.pn & 3) * 256 + wid * 64 + lane; __builtin_amdgcn_global_load_lds((const unsigned*)src, (PG8_LAS unsigned*)(bl + u.par * 256 + wid * 64), 4, 0, 0); }
    }
    __device__ __forceinline__ void operator()(const f32x4 (&acc)[2][2][4][2], const Unit& u, int wr, int wc, int fr, int fq) const {
        const int col0 = (u.pn & 3) * 256 + wc * 32 + 8 * fq, rt = u.pm * 256 + wr * 64 + fr; const PG8_LAS float* bp = bl + u.par * 256 + wc * 32 + 8 * fq;
        f32x4 bv[2][2];
#pragma unroll
        for (int bj = 0; bj < 2; ++bj) { bv[bj][0] = *(const PG8_LAS f32x4*)(bp + bj * HALF) * 8.0f; bv[bj][1] = *(const PG8_LAS f32x4*)(bp + bj * HALF + 4) * 8.0f; }
#pragma unroll
        for (int ai = 0; ai < 2; ++ai)
#pragma unroll
            for (int m = 0; m < 4; ++m) { unsigned char* rowp = ys + (size_t)(rt + ai * HALF + m * 16) * 1024 + col0;
#pragma unroll
                for (int bj = 0; bj < 2; ++bj) { const u32x2v w = pack8_fp8(acc[ai][bj][m][0] * 0.25f + bv[bj][0], acc[ai][bj][m][1] * 0.25f + bv[bj][1]); if (!nostore) __builtin_nontemporal_store(w, (u32x2v*)(rowp + bj * HALF)); else asm volatile("" :: "v"(w)); } }
    }
};
struct GroupedOrder {
    int nM, nN, nwg, G, c; const PG8_LAS int* tile_e; const int* rows;
    __device__ void init(int nM_, int nN_, int G_, int c_, const PG8_LAS int* te) { nM = nM_; nN = nN_; nwg = nM * nN; G = G_; c = c_; tile_e = te; rows = nullptr; }
    __device__ bool next(int i, Unit& u) const {
        const long L = (long)i * G + c; if (L >= nwg) return false;
        int wgid = (int)L; { const int q = nwg / NXCD, r = nwg % NXCD, xcd = wgid % NXCD, off = wgid / NXCD; wgid = (xcd < r ? xcd * (q + 1) : r * (q + 1) + (xcd - r) * q) + off; }
        const int nig = WGM * nN, gid = wgid / nig, fm = gid * WGM, gsz = (nM - fm) < WGM ? (nM - fm) : WGM;
        u.pm = fm + ((wgid % nig) % gsz); const int pl = (wgid % nig) / gsz; u.pn = __builtin_amdgcn_readfirstlane(tile_e[u.pm]) * nN + pl; return true;
    }
    __device__ __forceinline__ void a_ready(const Unit&) const {}
    __device__ __forceinline__ void done(const Unit&) const {}
};
struct DftOrder {
    int lg, n, G, c;
    __device__ void init(int lg_, int nb, int G_, int c_) { lg = lg_; n = (nb * 2) << lg_; G = G_; c = c_; }
    __device__ bool next(int i, Unit& u) const { const int L = i * G + c; if (L >= n) return false; const int b = L >> (lg + 1), rem = L & ((2 << lg) - 1); u.pm = rem & ((1 << lg) - 1); u.pn = 2 * b + (rem >> lg); return true; }
    __device__ __forceinline__ void a_ready(const Unit&) const {}
    __device__ __forceinline__ void done(const Unit&) const {}
};

template <class Epi, class Sched, bool ALIGN_EPI = false, bool SP2 = false, bool FP8 = false, bool GATHER = false>
__device__ __forceinline__ void gemm_phase(PG8_LAS unsigned char* lds, const Gemm g, const Sched& S, const Epi& E, const int tid_in) {
    int tid_ = tid_in; asm volatile("" : "+v"(tid_));
    const int tid = tid_, wid = __builtin_amdgcn_readfirstlane(tid >> 6), lane = tid & 63, wr = wid >> 2, wc = wid & 3, fr = lane & 15, fq = lane >> 4;
    const int K = g.K, nt = K / BK;
    unsigned voffA[2], voffB[2]; int RA[2]; unsigned CA2[2];
#pragma unroll
    for (int i = 0; i < 2; ++i) { int R, C; stage_rc(tid * 16 + i * 8192, R, C); const int Rb = Epi::PERM ? ((R & ~31) + perm32(R & 31)) : R;
        voffA[i] = (unsigned)(R * K + C) * 2u; voffB[i] = (unsigned)(Rb * K + C) * 2u; RA[i] = (R << 8) | (C * 2); CA2[i] = 0u; }
    static_assert(!GATHER || SP2, "GATHER is implemented for the SP2 loop only");
    unsigned pC[2], pN[2];
#define PG8_LDIDX(dst, unit) do { if constexpr (GATHER) { _Pragma("unroll") for (int h_ = 0; h_ < 2; ++h_) dst[h_] = (unsigned)S.rows[(unit).pm * 256 + h_ * 128 + (RA[0] >> 8)] | ((unsigned)S.rows[(unit).pm * 256 + h_ * 128 + (RA[1] >> 8)] << 16); } } while (0)
#define PG8_GOFF(dst, pk) do { dst[0] = ((pk) & 0xffffu) * (unsigned)(K * 2) + (unsigned)(RA[0] & 255); dst[1] = ((pk) >> 16) * (unsigned)(K * 2) + (unsigned)(RA[1] & 255); } while (0)
    const size_t kstep = (size_t)(BK * 2);
    const size_t hstep = (size_t)HALF * K * 2;
    const size_t tstep = 2 * hstep;
    const unsigned ldsw = (unsigned)wid * 1024u;
    const int aoff = lds_byte(wr * 64 + fr, fq * 8), boff = lds_byte(wc * 32 + fr, fq * 8);
#define PG8_SA(b, h) (((b) * 2 + (h)) * HTB)
#define PG8_SB(b, h) ((4 + (b) * 2 + (h)) * HTB)
#define PG8_STAGE(bufoff, gbase, voff) do { _Pragma("unroll") for (int _i = 0; _i < 2; ++_i) \
        __builtin_amdgcn_global_load_lds((const unsigned*)((const char*)(gbase) + (voff)[_i]), (PG8_LAS unsigned*)(lds + (bufoff) + ldsw + _i * 8192), 16, 0, 0); } while (0)
#define PG8_RD8(off) __builtin_shufflevector(*(const PG8_LAS i32x4v*)(lds + (off)), *(const PG8_LAS i32x4v*)(lds + (off) + 1024), 0, 1, 2, 3, 4, 5, 6, 7)
#define PG8_LDA(dst, b, h) do { _Pragma("unroll") for (int m = 0; m < 4; ++m) { if constexpr (FP8) dst##8[m] = PG8_RD8(PG8_SA(b, h) + aoff + m * 2048); else { _Pragma("unroll") for (int k = 0; k < 2; ++k) dst[m][k] = *(const PG8_LAS bf16x8*)(lds + PG8_SA(b, h) + aoff + m * 2048 + k * 1024); } } } while (0)
#define PG8_LDB(dst, b, h) do { _Pragma("unroll") for (int n = 0; n < 2; ++n) { if constexpr (FP8) dst##8[n] = PG8_RD8(PG8_SB(b, h) + boff + n * 2048); else { _Pragma("unroll") for (int k = 0; k < 2; ++k) dst[n][k] = *(const PG8_LAS bf16x8*)(lds + PG8_SB(b, h) + boff + n * 2048 + k * 1024); } } } while (0)
#define PG8_MMA(ai, bj, At, Bt) do { if constexpr (FP8) __builtin_amdgcn_sched_barrier(0); __builtin_amdgcn_s_setprio(1); _Pragma("unroll") for (int m = 0; m < 4; ++m) _Pragma("unroll") for (int n = 0; n < 2; ++n) { \
        if constexpr (FP8) asm volatile("v_mfma_scale_f32_16x16x128_f8f6f4 %0, %1, %2, %0, %3, %3 op_sel_hi:[0,0,0]" : "+v"(acc[ai][bj][m][n]) : "v"(Bt##8[n]), "v"(At##8[m]), "v"(sc8)); \
        else { _Pragma("unroll") for (int k = 0; k < 2; ++k) acc[ai][bj][m][n] = __builtin_amdgcn_mfma_f32_16x16x32_bf16(Bt[n][k], At[m][k], acc[ai][bj][m][n], 0, 0, 0); } } __builtin_amdgcn_s_setprio(0); if constexpr (FP8) __builtin_amdgcn_sched_barrier(0); } while (0)
#define PG8_WAIT_V(n) asm volatile("s_waitcnt vmcnt(" #n ")" ::: "memory")
#define PG8_WAIT_L(n) asm volatile("s_waitcnt lgkmcnt(" #n ")" ::: "memory")
#define PG8_BAR __builtin_amdgcn_s_barrier()
#define PG8_SCHED __builtin_amdgcn_sched_barrier(0)
    Unit cur, nxt; int ui = 0;
    if (!S.next(0, cur)) return;
    f32x4 acc[2][2][4][2];
#pragma unroll
    for (int a = 0; a < 2; ++a)
#pragma unroll
        for (int b = 0; b < 2; ++b)
#pragma unroll
            for (int m = 0; m < 4; ++m)
#pragma unroll
                for (int n = 0; n < 2; ++n) acc[a][b][m][n] = (f32x4){0.f, 0.f, 0.f, 0.f};
    int sc8 = 0x7f7f7f7f; asm volatile("" : "+v"(sc8));
    bf16x8 At[4][2], B0[2][2], B1[2][2]; i32x8v At8[4], B08[2], B18[2];
    const char* cA = (const char*)g.A + (size_t)cur.pm * tstep; const char* cB = (const char*)g.Bt + (size_t)cur.pn * tstep; const char* const gA = (const char*)g.A;
    S.a_ready(cur);
    if constexpr (SP2) {
        unsigned g0_[2], g1_[2]; if constexpr (GATHER) { PG8_LDIDX(pC, cur); PG8_GOFF(g0_, pC[0]); PG8_GOFF(g1_, pC[1]); }
        PG8_STAGE(PG8_SB(0, 0), cB, voffB); PG8_STAGE(PG8_SB(0, 1), cB + hstep, voffB);
        if constexpr (GATHER) { PG8_STAGE(PG8_SA(0, 0), gA, g0_); PG8_STAGE(PG8_SA(0, 1), gA, g1_); } else { PG8_STAGE(PG8_SA(0, 0), cA, voffA); PG8_STAGE(PG8_SA(0, 1), cA + hstep, voffA); }
        if (wr == 1) PG8_BAR;
        PG8_WAIT_V(2); PG8_BAR;
        PG8_STAGE(PG8_SB(1, 0), cB + kstep, voffB); if constexpr (GATHER) PG8_STAGE(PG8_SA(1, 0), gA + kstep, g0_); else PG8_STAGE(PG8_SA(1, 0), cA + kstep, voffA); PG8_STAGE(PG8_SB(1, 1), cB + hstep + kstep, voffB);
        PG8_WAIT_V(6); PG8_BAR;
    } else {
        PG8_STAGE(PG8_SB(0, 0), cB, voffB); PG8_STAGE(PG8_SA(0, 0), cA, voffA); PG8_STAGE(PG8_SB(0, 1), cB + hstep, voffB); PG8_STAGE(PG8_SA(0, 1), cA + hstep, voffA);
        if (wr == 1) PG8_BAR;
        PG8_WAIT_V(4); PG8_BAR;
        PG8_STAGE(PG8_SB(1, 0), cB + kstep, voffB); PG8_STAGE(PG8_SA(1, 0), cA + kstep, voffA); PG8_STAGE(PG8_SB(1, 1), cB + hstep + kstep, voffB);
        PG8_WAIT_V(6); PG8_BAR;
    }
    for (;;) {
        cur.par = ui & 1; if constexpr (Epi::BIAS_LDS) E.stage_bias(cur, wid, lane);
        const bool has_next = S.next(ui + 1, nxt);
        if constexpr (GATHER) { if (has_next) PG8_LDIDX(pN, nxt); }
        const char* nA = has_next ? (const char*)g.A + (size_t)nxt.pm * tstep : cA; const char* nB = has_next ? (const char*)g.Bt + (size_t)nxt.pn * tstep : cB;
        for (int t = 0; t < nt; t += 2) {
            const bool last = (t == nt - 2);
            const char* a1 = cA + (size_t)(t + 1) * kstep;
            const char* a2 = last ? nA : cA + (size_t)(t + 2) * kstep; const char* b2 = last ? nB : cB + (size_t)(t + 2) * kstep;
            const char* a3 = a2 + kstep; const char* b3 = b2 + kstep;
            if (last && has_next) S.a_ready(nxt);
            unsigned v2[2][2]; const char* gA2 = gA;
            unsigned vc1[2];
            if constexpr (GATHER) { const bool sw = last && has_next; PG8_GOFF(v2[0], sw ? pN[0] : pC[0]); PG8_GOFF(v2[1], sw ? pN[1] : pC[1]); PG8_GOFF(vc1, pC[1]);
                gA2 = last ? gA : gA + (size_t)(t + 2) * kstep; }
            if constexpr (SP2) {
            PG8_LDB(B0, 0, 0); PG8_LDB(B1, 0, 1); PG8_SCHED; PG8_LDA(At, 0, 0); if constexpr (GATHER) PG8_STAGE(PG8_SA(1, 1), gA + (size_t)(t + 1) * kstep, vc1); else PG8_STAGE(PG8_SA(1, 1), a1 + hstep, voffA);
            PG8_WAIT_V(8); PG8_WAIT_L(0); PG8_BAR; PG8_MMA(0, 0, At, B0); PG8_MMA(0, 1, At, B1); PG8_BAR; PG8_SCHED;
            PG8_LDA(At, 0, 1); PG8_STAGE(PG8_SB(0, 0), b2, voffB); PG8_STAGE(PG8_SB(0, 1), b2 + hstep, voffB); if constexpr (GATHER) PG8_STAGE(PG8_SA(0, 0), gA2, v2[0]); else PG8_STAGE(PG8_SA(0, 0), a2, voffA);
            PG8_WAIT_V(8); PG8_WAIT_L(0); PG8_BAR; PG8_MMA(1, 0, At, B0); PG8_MMA(1, 1, At, B1); PG8_BAR; PG8_SCHED;
            PG8_LDB(B0, 1, 0); PG8_LDB(B1, 1, 1); PG8_SCHED; PG8_LDA(At, 1, 0); if constexpr (GATHER) PG8_STAGE(PG8_SA(0, 1), gA2, v2[1]); else PG8_STAGE(PG8_SA(0, 1), a2 + hstep, voffA);
            PG8_WAIT_V(8); PG8_WAIT_L(0); PG8_BAR; PG8_MMA(0, 0, At, B0); PG8_MMA(0, 1, At, B1); PG8_BAR; PG8_SCHED;
            PG8_LDA(At, 1, 1); PG8_STAGE(PG8_SB(1, 0), b3, voffB); PG8_STAGE(PG8_SB(1, 1), b3 + hstep, voffB); if constexpr (GATHER) PG8_STAGE(PG8_SA(1, 0), gA2 + kstep, v2[0]); else PG8_STAGE(PG8_SA(1, 0), a3, voffA);
            PG8_WAIT_V(8); PG8_WAIT_L(0); PG8_BAR; PG8_MMA(1, 0, At, B0); PG8_MMA(1, 1, At, B1); PG8_BAR; PG8_SCHED;
            } else {
            PG8_LDB(B0, 0, 0); PG8_SCHED; PG8_LDA(At, 0, 0); PG8_STAGE(PG8_SA(1, 1), a1 + hstep, voffA);
            PG8_WAIT_L(8); PG8_BAR; PG8_WAIT_L(0); PG8_MMA(0, 0, At, B0); PG8_BAR; PG8_SCHED;
            PG8_LDB(B1, 0, 1); PG8_STAGE(PG8_SB(0, 0), b2, voffB);
            PG8_BAR; PG8_WAIT_L(0); PG8_MMA(0, 1, At, B1); PG8_BAR;
            PG8_LDA(At, 0, 1); PG8_STAGE(PG8_SA(0, 0), a2, voffA);
            PG8_BAR; PG8_WAIT_L(0); PG8_MMA(1, 0, At, B0); PG8_BAR; PG8_SCHED;
            PG8_STAGE(PG8_SB(0, 1), b2 + hstep, voffB);
            PG8_WAIT_V(6); PG8_BAR; PG8_MMA(1, 1, At, B1); PG8_BAR;
            PG8_LDB(B0, 1, 0); PG8_SCHED; PG8_LDA(At, 1, 0); PG8_STAGE(PG8_SA(0, 1), a2 + hstep, voffA);
            PG8_WAIT_L(8); PG8_BAR; PG8_WAIT_L(0); PG8_MMA(0, 0, At, B0); PG8_BAR; PG8_SCHED;
            PG8_LDB(B1, 1, 1); PG8_STAGE(PG8_SB(1, 0), b3, voffB);
            PG8_BAR; PG8_WAIT_L(0); PG8_MMA(0, 1, At, B1); PG8_BAR;
            PG8_LDA(At, 1, 1); PG8_STAGE(PG8_SA(1, 0), a3, voffA);
            PG8_BAR; PG8_WAIT_L(0); PG8_MMA(1, 0, At, B0); PG8_BAR; PG8_SCHED;
            PG8_STAGE(PG8_SB(1, 1), b3 + hstep, voffB);
            PG8_WAIT_V(6); PG8_BAR; PG8_MMA(1, 1, At, B1); PG8_BAR;
            }
        }
        if constexpr (FP8) asm volatile("s_nop 15\n\ts_nop 15" ::: "memory");
        if constexpr (ALIGN_EPI) { if (wr == 0) PG8_BAR; }
        if constexpr (!Epi::AFTER_DRAIN) { E(acc, cur, wr, wc, fr, fq); S.done(cur); }
        if (!has_next) break;
#pragma unroll
        for (int a = 0; a < 2; ++a)
#pragma unroll
            for (int b = 0; b < 2; ++b)
#pragma unroll
                for (int m = 0; m < 4; ++m)
#pragma unroll
                    for (int n = 0; n < 2; ++n) acc[a][b][m][n] = (f32x4){0.f, 0.f, 0.f, 0.f};
        cur = nxt; cA = nA; cB = nB; ++ui;
        if constexpr (GATHER) { pC[0] = pN[0]; pC[1] = pN[1]; }
        if constexpr (ALIGN_EPI) { if (wr == 1) PG8_BAR; }
    }
    PG8_WAIT_V(0);
    if constexpr (!ALIGN_EPI) { if (wr == 0) PG8_BAR; }
    PG8_BAR;
    if constexpr (Epi::AFTER_DRAIN) { E.fused(acc, cur, wr, wc, fr, fq, lds, wid, lane); S.done(cur); }
#undef PG8_SA
#undef PG8_LDIDX
#undef PG8_GOFF
#undef PG8_SB
#undef PG8_STAGE
#undef PG8_LDA
#undef PG8_LDB
#undef PG8_MMA
#undef PG8_RD8
#undef PG8_WAIT_V
#undef PG8_WAIT_L
#undef PG8_BAR
#undef PG8_SCHED
}
}
namespace att {
typedef unsigned short bf16;
constexpr int   D = 128, NW = 8, QBLK = 32, KVBLK = 64;
constexpr float SCALE = 0.088388347648318440f;
constexpr float THR = 8.f;
constexpr int SDEPTH = 2;
constexpr int LDQ = 1024, LDK = 256, LDO = 1024;
constexpr size_t SHM_V = KVBLK * D * 2, SHM_K = KVBLK * D * 2, SHM_ATTN = 2 * SHM_V + 2 * SHM_K + NW * 64 * 4;
using bf16x8 = __attribute__((ext_vector_type(8))) short;
using s16x4  = __attribute__((ext_vector_type(4))) short;
using f32x16 = __attribute__((ext_vector_type(16))) float;
using f32x8  = __attribute__((ext_vector_type(8))) float;
using u32x4  = __attribute__((ext_vector_type(4))) unsigned;
#define KSWZ(row, colB) ((row) * 256 + ((colB) ^ (((row) & 7) << 4)))
#define SBAR() __builtin_amdgcn_sched_barrier(0)
__device__ __forceinline__ int crow(int r, int hi) { return (r & 3) + 8 * (r >> 2) + 4 * hi; }
__device__ __forceinline__ unsigned cvtpk(float lo, float hi) { return pg8::cvt_pk_bf16(lo, hi); }
template <typename TIn> struct Stage;
template <> struct Stage<bf16>  { using T = bf16x8;
  __device__ static __forceinline__ T ld8(const bf16* p) { return *reinterpret_cast<const bf16x8*>(p); }
  __device__ static __forceinline__ bf16x8 tobf(T x) { return x; } };
template <> struct Stage<float> { using T = f32x8;
  __device__ static __forceinline__ T ld8(const float* p) { return *reinterpret_cast<const f32x8*>(p); }
  __device__ static __forceinline__ bf16x8 tobf(T x) {
    u32x4 w = {cvtpk(x[0], x[1]), cvtpk(x[2], x[3]), cvtpk(x[4], x[5]), cvtpk(x[6], x[7])}; return *reinterpret_cast<bf16x8*>(&w); } };

__device__ __forceinline__ void partialSM(f32x16& p0, f32x16& p1, float& m_reg, float& mn, float& alpha) {
  constexpr float C = SCALE * 1.4426950408889634f;
  float pmax = p0[0]; for (int r = 1; r < 16; ++r) pmax = fmaxf(pmax, p0[r]); for (int r = 0; r < 16; ++r) pmax = fmaxf(pmax, p1[r]);
  { auto rr = __builtin_amdgcn_permlane32_swap(__float_as_uint(pmax), __float_as_uint(pmax), false, false);
    pmax = fmaxf(__uint_as_float(rr[0]), __uint_as_float(rr[1])); }
  if (__builtin_expect(__all(pmax - m_reg <= THR / SCALE), 1)) { mn = m_reg; alpha = 1.f; }
  else { mn = fmaxf(m_reg, pmax); alpha = __builtin_amdgcn_exp2f((m_reg - mn) * C); m_reg = mn; }
  float mnC = -mn * C;
  for (int r = 0; r < 16; ++r) p0[r] = fmaf(p0[r], C, mnC); for (int r = 0; r < 16; ++r) p1[r] = fmaf(p1[r], C, mnC);
  for (int r = 0; r < 16; ++r) p0[r] = __builtin_amdgcn_exp2f(p0[r]);
}
__device__ __forceinline__ void finishSM(f32x16& p0, f32x16& p1, float alpha, float& l_reg, bf16x8& pa0, bf16x8& pa1, bf16x8& pa2, bf16x8& pa3) {
  for (int r = 0; r < 16; ++r) p1[r] = __builtin_amdgcn_exp2f(p1[r]);
  float ps = 0; for (int r = 0; r < 16; ++r) ps += p0[r]; for (int r = 0; r < 16; ++r) ps += p1[r];
  { auto rr = __builtin_amdgcn_permlane32_swap(__float_as_uint(ps), __float_as_uint(ps), false, false);
    ps = __uint_as_float(rr[0]) + __uint_as_float(rr[1]); }
  l_reg = l_reg * alpha + ps;
#define PK4(P, BASE, OUT) do { unsigned a0 = cvtpk(P[BASE + 0], P[BASE + 1]), a1 = cvtpk(P[BASE + 2], P[BASE + 3]);   \
    unsigned b0 = cvtpk(P[BASE + 4], P[BASE + 5]), b1 = cvtpk(P[BASE + 6], P[BASE + 7]);                              \
    auto r0 = __builtin_amdgcn_permlane32_swap(a0, b0, false, false); auto r1 = __builtin_amdgcn_permlane32_swap(a1, b1, false, false); \
    u32x4 w = {r0[0], r1[0], r0[1], r1[1]}; OUT = *reinterpret_cast<bf16x8*>(&w); } while (0)
  PK4(p0, 0, pa0); PK4(p0, 8, pa1); PK4(p1, 0, pa2); PK4(p1, 8, pa3);
#undef PK4
}
__device__ __forceinline__ void qkt(f32x16& p0, f32x16& p1, const bf16* Ks, const bf16x8* qr, int r32, int hi) {
  p0 = f32x16{}; p1 = f32x16{};
  for (int d0 = 0; d0 < 8; ++d0) { int cb = (d0 * 16 + hi * 8) * 2;
    bf16x8 b0 = *reinterpret_cast<const bf16x8*>((const char*)Ks + KSWZ(r32, cb));
    bf16x8 b1 = *reinterpret_cast<const bf16x8*>((const char*)Ks + KSWZ(32 + r32, cb));
    p0 = __builtin_amdgcn_mfma_f32_32x32x16_bf16(b0, qr[d0], p0, 0, 0, 0);
    p1 = __builtin_amdgcn_mfma_f32_32x32x16_bf16(b1, qr[d0], p1, 0, 0, 0); }
}
__device__ __forceinline__ int v_st(int k, int c) { const int kk = (k & ~0xC) | ((k & 4) << 1) | ((k & 8) >> 1); return ((kk >> 3) * 4 + (c >> 5)) * 512 + ((kk & 7) * 32 + (c & 31)) * 2; }
__device__ __forceinline__ int v_rd_base(int lane) { return ((lane & 3) << 3) | (((lane >> 2) & 3) << 6) | (((lane >> 4) & 1) << 5) | (((lane >> 5) & 1) << 8); }
constexpr int v_rd_off(int d0, int ks, int half) { return d0 * 512 + ks * 4096 + half * 2048; }
template <int OFF> __device__ __forceinline__ s16x4 tr_read(int vb) {
  s16x4 r; asm volatile("ds_read_b64_tr_b16 %0, %1 offset:%2" : "=&v"(r) : "v"(vb), "i"(OFF) : "memory"); return r;
}
template <int D0> __device__ __forceinline__ void pv_one(f32x16& od, int vb, bf16x8 pa0, bf16x8 pa1, bf16x8 pa2, bf16x8 pa3) {
  const s16x4 l0 = tr_read<v_rd_off(D0, 0, 0)>(vb), h0 = tr_read<v_rd_off(D0, 0, 1)>(vb), l1 = tr_read<v_rd_off(D0, 1, 0)>(vb), h1 = tr_read<v_rd_off(D0, 1, 1)>(vb);
  const s16x4 l2 = tr_read<v_rd_off(D0, 2, 0)>(vb), h2 = tr_read<v_rd_off(D0, 2, 1)>(vb), l3 = tr_read<v_rd_off(D0, 3, 0)>(vb), h3 = tr_read<v_rd_off(D0, 3, 1)>(vb);
  asm volatile("s_waitcnt lgkmcnt(0)" ::: "memory"); SBAR();
#define PK(L, H) (bf16x8){L[0], L[1], L[2], L[3], H[0], H[1], H[2], H[3]}
  od = __builtin_amdgcn_mfma_f32_32x32x16_bf16(pa0, PK(l0, h0), od, 0, 0, 0);
  od = __builtin_amdgcn_mfma_f32_32x32x16_bf16(pa1, PK(l1, h1), od, 0, 0, 0);
  od = __builtin_amdgcn_mfma_f32_32x32x16_bf16(pa2, PK(l2, h2), od, 0, 0, 0);
  od = __builtin_amdgcn_mfma_f32_32x32x16_bf16(pa3, PK(l3, h3), od, 0, 0, 0);
#undef PK
}
__device__ __forceinline__ void pv_d0(f32x16* o, int vb, bf16x8 pa0, bf16x8 pa1, bf16x8 pa2, bf16x8 pa3) {
  pv_one<0>(o[0], vb, pa0, pa1, pa2, pa3); pv_one<1>(o[1], vb, pa0, pa1, pa2, pa3); pv_one<2>(o[2], vb, pa0, pa1, pa2, pa3); pv_one<3>(o[3], vb, pa0, pa1, pa2, pa3);
}

template <typename TQ>
__device__ __forceinline__ void attn_dense_body(const TQ* __restrict__ Qb, const bf16* __restrict__ Kh, const bf16* __restrict__ Vh,
                                                unsigned char* __restrict__ Ob, int seq, char* lds, const int tid_in, const float* __restrict__ qgain, const float* __restrict__ rtab, const int t0, const bool rope) {
  using St = Stage<bf16>; using SQ = Stage<TQ>;
  int tid_ = tid_in; asm volatile("" : "+v"(tid_));
  const int tid = tid_, wid = tid >> 6, lane = tid & 63, r32 = lane & 31, hi = lane >> 5;
  bf16* V_lds = (bf16*)lds; bf16* K_lds = (bf16*)(lds + 2 * SHM_V);
  float* ws = (float*)(lds + 2 * SHM_V + 2 * SHM_K) + wid * 64; float* li_l = ws; float* al_l = ws + 32;
  float m_reg = -1e30f, l_reg = 0; f32x16 o[4] = {}; bf16x8 qr[8];
  const TQ* Qw = Qb + (long)(wid * QBLK + r32) * LDQ + hi * 8;
  { float xf[8][8]; float ss = 0.f;
#pragma unroll
    for (int d0 = 0; d0 < 8; ++d0) { const bf16x8 raw = SQ::tobf(SQ::ld8(Qw + d0 * 16));
#pragma unroll
      for (int j = 0; j < 8; ++j) { xf[d0][j] = __uint_as_float(((unsigned)(unsigned short)raw[j]) << 16); ss += xf[d0][j] * xf[d0][j]; } }
    { auto rr = __builtin_amdgcn_permlane32_swap(__float_as_uint(ss), __float_as_uint(ss), false, false); ss = __uint_as_float(rr[0]) + __uint_as_float(rr[1]); }
    const float rn = 1.0f / sqrtf(ss * (1.0f / 128.0f) + 1e-6f);
#pragma unroll
    for (int d0 = 0; d0 < 8; ++d0) {
#pragma unroll
      for (int j = 0; j < 8; ++j) xf[d0][j] *= rn * qgain[d0 * 16 + hi * 8 + j]; }
    if (rope) { const int t = t0 + wid * QBLK + r32, pr = t >> 6, pc = t & 63;
#pragma unroll
      for (int hb = 0; hb < 2; ++hb) { const int p = hb ? pc : pr;
#pragma unroll
        for (int dd = 0; dd < 2; ++dd) { const int d0 = 4 * hb + dd;
#pragma unroll
          for (int j = 0; j < 8; ++j) { const int f = dd * 16 + hi * 8 + j; const float c = rtab[(p * 32 + f) * 2], s = rtab[(p * 32 + f) * 2 + 1];
            const float x0 = xf[d0][j], x1 = xf[d0 + 2][j]; xf[d0][j] = x0 * c - x1 * s; xf[d0 + 2][j] = x1 * c + x0 * s; } } } }
#pragma unroll
    for (int d0 = 0; d0 < 8; ++d0) { u32x4 w = {cvtpk(xf[d0][0], xf[d0][1]), cvtpk(xf[d0][2], xf[d0][3]), cvtpk(xf[d0][4], xf[d0][5]), cvtpk(xf[d0][6], xf[d0][7])}; qr[d0] = *reinterpret_cast<bf16x8*>(&w); } }
  const int sr = tid >> 4, sc = (tid & 15) * 8, vst0 = v_st(sr, sc), vst1 = v_st(32 + sr, sc);
  const int vb0 = (int)(uintptr_t)V_lds + v_rd_base(lane);
  struct { typename St::T vs0, vs1, ks0, ks1; } sr_[SDEPTH];
#define SLOAD(i, k0) do { sr_[i].vs0 = St::ld8(&Vh[(long)((k0) + sr) * LDK + sc]); sr_[i].vs1 = St::ld8(&Vh[(long)((k0) + 32 + sr) * LDK + sc]); \
    sr_[i].ks0 = St::ld8(&Kh[(long)((k0) + sr) * LDK + sc]); sr_[i].ks1 = St::ld8(&Kh[(long)((k0) + 32 + sr) * LDK + sc]); } while (0)
#define SWRITE(b, i) do { *(bf16x8*)((char*)V_lds + (b) * SHM_V + vst0) = St::tobf(sr_[i].vs0);          \
    *(bf16x8*)((char*)V_lds + (b) * SHM_V + vst1) = St::tobf(sr_[i].vs1); int kc = sc * 2;               \
    *(bf16x8*)((char*)K_lds + (b) * SHM_K + KSWZ(sr, kc)) = St::tobf(sr_[i].ks0);                       \
    *(bf16x8*)((char*)K_lds + (b) * SHM_K + KSWZ(32 + sr, kc)) = St::tobf(sr_[i].ks1); } while (0)
#define SWAIT() do { if constexpr (SDEPTH == 2) asm volatile("s_waitcnt vmcnt(4)" ::: "memory"); else asm volatile("s_waitcnt vmcnt(0)" ::: "memory"); } while (0)
#define RESC(a) do { if (__any((a) < 1.f)) { if (hi == 0) al_l[r32] = (a); asm volatile("s_waitcnt lgkmcnt(0)" ::: "memory"); \
    for (int d = 0; d < 4; ++d) for (int r = 0; r < 16; ++r) o[d][r] *= al_l[crow(r, hi)]; } } while (0)
  f32x16 pA0, pA1, pB0, pB1; float mnA, mnB, alA, alB; bf16x8 pa0, pa1, pa2, pa3; const int NT = seq / KVBLK;
  constexpr int SE = 0, SO = SDEPTH - 1;
  SLOAD(SE, 0); asm volatile("s_waitcnt vmcnt(0)" ::: "memory"); SWRITE(0, SE); __syncthreads();
  qkt(pA0, pA1, K_lds, qr, r32, hi); partialSM(pA0, pA1, m_reg, mnA, alA);
  SLOAD(SO, KVBLK); if constexpr (SDEPTH == 2) { if (2 < NT) SLOAD(SE, 2 * KVBLK); }
  SWAIT(); SWRITE(1, SO); __syncthreads();
  for (int j = 1; j + 1 < NT; j += 2) {
    SBAR(); qkt(pB0, pB1, (bf16*)((char*)K_lds + SHM_K), qr, r32, hi);
    finishSM(pA0, pA1, alA, l_reg, pa0, pa1, pa2, pa3); SBAR();
    SLOAD(SO, (j + SDEPTH) * KVBLK); SBAR();
    pv_d0(o, vb0, pa0, pa1, pa2, pa3); partialSM(pB0, pB1, m_reg, mnB, alB);
    __syncthreads(); SWAIT(); SWRITE(0, SE);
    RESC(alB); __syncthreads();
    SBAR(); qkt(pA0, pA1, K_lds, qr, r32, hi);
    finishSM(pB0, pB1, alB, l_reg, pa0, pa1, pa2, pa3); SBAR();
    if (SDEPTH == 1 || j + 3 < NT) SLOAD(SE, (j + 1 + SDEPTH) * KVBLK); SBAR();
    pv_d0(o, vb0 + (int)SHM_V, pa0, pa1, pa2, pa3); partialSM(pA0, pA1, m_reg, mnA, alA);
    __syncthreads(); SWAIT(); SWRITE(1, SO);
    RESC(alA); __syncthreads();
  }
  SBAR(); qkt(pB0, pB1, (bf16*)((char*)K_lds + SHM_K), qr, r32, hi);
  finishSM(pA0, pA1, alA, l_reg, pa0, pa1, pa2, pa3); SBAR();
  pv_d0(o, vb0, pa0, pa1, pa2, pa3); partialSM(pB0, pB1, m_reg, mnB, alB);
  __syncthreads(); RESC(alB);
  finishSM(pB0, pB1, alB, l_reg, pa0, pa1, pa2, pa3); SBAR();
  pv_d0(o, vb0 + (int)SHM_V, pa0, pa1, pa2, pa3);
  if (hi == 0) li_l[r32] = l_reg; asm volatile("s_waitcnt lgkmcnt(0)" ::: "memory");
  float rli[16];
#pragma unroll
  for (int r = 0; r < 16; ++r) rli[r] = __builtin_amdgcn_rcpf(li_l[crow(r, hi)]);
  unsigned char* Ow = Ob + (long)(wid * QBLK) * LDO;
#pragma unroll
  for (int r = 0; r < 16; ++r) { int orow = crow(r, hi);
    for (int d0 = 0; d0 < 4; ++d0) { const float ov = o[d0][r] * rli[r] * 16.0f; Ow[(long)orow * LDO + d0 * 32 + r32] = (unsigned char)(__builtin_amdgcn_cvt_pk_fp8_f32(ov, ov, __builtin_bit_cast(int, ov), false) & 0xff); } }
#undef SLOAD
#undef SWRITE
#undef SWAIT
#undef RESC
}
#undef KSWZ
#undef SBAR
}

#define GAS __attribute__((address_space(1)))
#define LAS __attribute__((address_space(3)))
typedef unsigned short bf16;
typedef unsigned v4u __attribute__((ext_vector_type(4)));
typedef float f32x4 __attribute__((ext_vector_type(4)));
typedef short bf16x8 __attribute__((ext_vector_type(8)));
typedef GAS unsigned gu32;
typedef GAS unsigned long long gu64;
#define RLX_AGENT __ATOMIC_RELAXED, __HIP_MEMORY_SCOPE_AGENT
#define LDS_WAIT() asm volatile("s_waitcnt lgkmcnt(0)" ::: "memory")
#define VM_WAIT() asm volatile("s_waitcnt vmcnt(0)" ::: "memory")
__device__ __forceinline__ unsigned long long rt() { return __builtin_amdgcn_s_memrealtime(); }
__device__ __forceinline__ unsigned f2bf(float f) { unsigned u = __builtin_bit_cast(unsigned, f); return (u + 0x7fffu + ((u >> 16) & 1u)) >> 16; }
__device__ __forceinline__ unsigned pk2(float lo, float hi) { return f2bf(lo) | (f2bf(hi) << 16); }

#define XB_TMO      128
#define XB_XCNT(j)  (256  + 64 * (j))
#define XB_XSUB(j)  (1280 + 64 * (j))
#define XB_XGEN(j)  (2304 + 64 * (j))
#define XB_TOP      3328
#define XB_TOPGEN   3392
#define XCD_BAR_WORDS 3456
#define XB_SPIN_CAP (1u << 18)

__device__ __forceinline__ unsigned xb_ld(unsigned* p)              { return __hip_atomic_load(p, __ATOMIC_RELAXED, __HIP_MEMORY_SCOPE_AGENT); }
__device__ __forceinline__ unsigned xb_add(unsigned* p, unsigned v) { return __hip_atomic_fetch_add(p, v, __ATOMIC_RELAXED, __HIP_MEMORY_SCOPE_AGENT); }
__device__ __forceinline__ unsigned xb_xcc_id() { return (unsigned)__builtin_amdgcn_s_getreg((3 << 11) | 20) & 0xFu; }
#define XB_SPIN(cond, bar) do { unsigned _sp = 0; while (cond) { __builtin_amdgcn_s_sleep(1); \
    if ((++_sp & 255u) == 0u) { if (xb_ld(&(bar)[XB_TMO])) break; if (_sp > XB_SPIN_CAP) { atomicAdd(&(bar)[XB_TMO], 1u); break; } } } } while (0)

struct XcdBarrier {
    unsigned* bar; unsigned x;
    volatile LAS unsigned* st;
};

__device__ __forceinline__ XcdBarrier xcd_barrier_post(unsigned* bar, volatile LAS unsigned* st) {
    XcdBarrier b; b.bar = bar; b.x = xb_xcc_id(); b.st = st;
    if (threadIdx.x == 0) (void)xb_add(&bar[XB_XCNT(b.x)], 1u);
    return b;
}
__device__ __forceinline__ void xcd_barrier_complete(unsigned* bar, unsigned x, unsigned& nloc, unsigned& nx) {
    const unsigned G = gridDim.x * gridDim.y * gridDim.z;
    unsigned sum, cnt, mine, sp = 0u;
    for (;;) {
        sum = 0u; cnt = 0u; mine = 0u;
#pragma unroll
        for (unsigned j = 0; j < 16; ++j) { const unsigned c = xb_ld(&bar[XB_XCNT(j)]); sum += c; cnt += (c > 0u) ? 1u : 0u; mine = (j == x) ? c : mine; }
        if (sum == G) break;
        __builtin_amdgcn_s_sleep(1);
        if ((++sp & 255u) == 0u) { if (xb_ld(&bar[XB_TMO])) break; if (sp > XB_SPIN_CAP) { atomicAdd(&bar[XB_TMO], 1u); break; } }
    }
    nloc = mine > 0u ? mine : 1u; nx = cnt > 0u ? cnt : 1u;
}

__device__ __forceinline__ void xcd_barrier(const XcdBarrier& b) {
    asm volatile("s_waitcnt vmcnt(0)" ::: "memory");
    __syncthreads();
    if (threadIdx.x == 0) {
        unsigned* bar = b.bar;
        __builtin_amdgcn_s_waitcnt(0);
        unsigned nloc = b.st[0], nx = b.st[1];
        if (nloc == 0u) { xcd_barrier_complete(bar, b.x, nloc, nx); b.st[0] = nloc; b.st[1] = nx; }
        const unsigned old = xb_add(&bar[XB_XSUB(b.x)], 1u);
        const unsigned gen = old / nloc;
        if (old + 1u == (gen + 1u) * nloc) {
            __builtin_amdgcn_fence(__ATOMIC_RELEASE, "agent");
            asm volatile("s_waitcnt vmcnt(0)" ::: "memory");
            const unsigned og = xb_add(&bar[XB_TOP], 1u);
            const unsigned tg = og / nx;
            if (og + 1u == (tg + 1u) * nx) xb_add(&bar[XB_TOPGEN], 1u);
            else XB_SPIN(xb_ld(&bar[XB_TOPGEN]) == tg, bar);
            __builtin_amdgcn_fence(__ATOMIC_ACQUIRE, "agent");
            xb_add(&bar[XB_XGEN(b.x)], 1u);
            asm volatile("s_waitcnt vmcnt(0)" ::: "memory");
        } else {
            XB_SPIN(xb_ld(&bar[XB_XGEN(b.x)]) == gen, bar);
            __builtin_amdgcn_fence(__ATOMIC_ACQUIRE, "agent");
            asm volatile("s_waitcnt vmcnt(0)" ::: "memory");
        }
    }
    __syncthreads();
}
constexpr int DM = 1024, NB = 16, SEQ = 2048, CTXL = 256, TL = NB * SEQ, TC = NB * CTXL, TALL = TL + TC;
constexpr int INCOLS = 6144, OFF_FNET = 2560, OFF_GATE = 3072;
constexpr int NEXP = 32, KVROWS = SEQ + CTXL;
constexpr float EPS = 1e-6f;
constexpr int NWAVES = 8, NTHR = NWAVES * 64;
constexpr int NPL = 11, NPH = 2 + 2 * NPL;
#ifndef MK_PER_PHASE
#define MK_PER_PHASE 0
#endif
constexpr size_t MiB = 1u << 20;
constexpr size_t WS_CTL = 0, CTL_ZERO_BYTES = 1 * MiB;
constexpr size_t WS_MOD = 1 * MiB;
constexpr size_t WS_TAB = 2 * MiB;
constexpr size_t WS_TOPI = 3 * MiB, WS_TOPP = 4 * MiB, WS_SLOT = 5 * MiB, WS_CNT = 6 * MiB;
constexpr size_t WS_LOGIT = 7 * MiB;
constexpr size_t WS_WSMALL = 17 * MiB, WSMALL_LAYER = 20 * MiB;
constexpr size_t OFFS_WIN = 0, OFFS_WF = 5 * MiB, OFFS_WG = 7 * MiB, OFFS_WAO = 13 * MiB, OFFS_WCO = 15 * MiB, OFFS_WFO = 16 * MiB, OFFS_WOUT = 17 * MiB, OFFS_ROUT = 19 * MiB;
constexpr size_t WS_DFTL = 57 * MiB, WS_DFTC = 73 * MiB;
constexpr size_t WS_XC = 74 * MiB;
constexpr size_t WS_H = 90 * MiB;
constexpr size_t WS_WGU = 162 * MiB, WS_WD = 226 * MiB, MOEW_LAYER = 96 * MiB;
constexpr size_t WS_BIG = 354 * MiB;
constexpr size_t WS_Q = WS_BIG, WS_K = WS_Q + 72 * MiB, WS_V = WS_K + 18 * MiB, WS_CU = WS_V + 18 * MiB, WS_YT = WS_CU + 36 * MiB, WS_YTC = WS_YT + 64 * MiB;
constexpr size_t WS_GATES = WS_BIG;
constexpr size_t WS_AO = WS_BIG + 216 * MiB, WS_CH = WS_AO + 72 * MiB, WS_Z = WS_CH + 36 * MiB;
constexpr size_t WS_MIX = WS_AO;
constexpr size_t WS_MERGED = WS_BIG + 360 * MiB;
constexpr int SLOT_ROWS = 608 * 256;
constexpr size_t WS_YS = WS_BIG, WS_HS = WS_BIG + 304 * MiB, WS_ACT = WS_BIG + 456 * MiB, WS_END = WS_BIG + 608 * MiB;
constexpr size_t WS_XA = WS_BIG + 288 * MiB, WS_XB = WS_BIG + 528 * MiB;
constexpr size_t WS_H8 = WS_END;
constexpr size_t WS_END2 = WS_END + 36 * MiB;
static_assert(WS_YTC + 8 * MiB == WS_AO && WS_Z + 36 * MiB == WS_MERGED && WS_MERGED + 72 * MiB <= WS_END && (size_t)SLOT_ROWS * 2048 == 304 * MiB, "ws map");
constexpr int CW_TMO = 0, CW_CODE = 1, CW_BAR = 4096;
constexpr int CNT_ROWSRC = 32768;
constexpr int CNT_TILE_E = 16384, CNT_NT = 16384 + 1024;

constexpr int RING_OFF = 0, RING_BYTES = 131072;
constexpr int LDSCTL_OFF = RING_BYTES, MISC_OFF = LDSCTL_OFF + 320, LDS_CT = LDSCTL_OFF + 512, LDS_SM = LDSCTL_OFF + 1024;
constexpr int LDS_BYTES = 155648;

typedef unsigned u32x2 __attribute__((ext_vector_type(2)));
typedef int i32x4 __attribute__((ext_vector_type(4)));
typedef float f32x2 __attribute__((ext_vector_type(2)));
struct Args { const float* in[29]; float* out; unsigned char* ws; int ph_lo, ph_hi; };
typedef const __attribute__((address_space(4))) unsigned char* kptr_t;
struct AV {
    kptr_t kp;
    __device__ __forceinline__ const float* in(int i) const { return *(const float* const __attribute__((address_space(4)))*)(kp + 8 * i); }
    __device__ __forceinline__ float* out() const { return *(float* const __attribute__((address_space(4)))*)(kp + 8 * 29); }
    __device__ __forceinline__ unsigned char* ws() const { return *(unsigned char* const __attribute__((address_space(4)))*)(kp + 8 * 30); }
};
__device__ __forceinline__ AV av_get() { AV a; a.kp = (kptr_t)__builtin_amdgcn_kernarg_segment_ptr(); asm volatile("" : "+s"(a.kp)); return a; }

struct Frame {
    LAS unsigned char* lds; volatile LAS unsigned* MISC; gu32* ctl;
    int tid, lane, wave, vcu, G;
};

__device__ __forceinline__ float shx(float v, int m, int lane) { return __int_as_float(__builtin_amdgcn_ds_bpermute((lane ^ m) << 2, __float_as_int(v))); }
__device__ __forceinline__ float wave_sum(float v, int lane) {
#pragma unroll
    for (int o = 1; o < 64; o <<= 1) v += shx(v, o, lane);
    return v;
}
__device__ __forceinline__ float sigmoidf_(float x) { return 1.0f / (1.0f + __expf(-x)); }
__device__ __forceinline__ f32x4 bf4(u32x2 w) { f32x4 r; r[0] = __uint_as_float(w.x << 16); r[1] = __uint_as_float(w.x & 0xffff0000u); r[2] = __uint_as_float(w.y << 16); r[3] = __uint_as_float(w.y & 0xffff0000u); return r; }
__device__ __forceinline__ u32x2 pk4(f32x4 v) { u32x2 w; w.x = pk2(v[0], v[1]); w.y = pk2(v[2], v[3]); return w; }
__device__ __forceinline__ void ld_row_f32(f32x4 (&v)[4], const float* p, int lane) {
#pragma unroll
    for (int j = 0; j < 4; ++j) v[j] = ((const GAS f32x4*)p)[lane + 64 * j];
}
__device__ __forceinline__ void st_row_f32(const f32x4 (&v)[4], float* p, int lane) {
#pragma unroll
    for (int j = 0; j < 4; ++j) ((GAS f32x4*)p)[lane + 64 * j] = v[j];
}
__device__ __forceinline__ void ld_row_bf16(f32x4 (&v)[4], const bf16* p, int lane) {
#pragma unroll
    for (int j = 0; j < 4; ++j) v[j] = bf4(((const GAS u32x2*)p)[lane + 64 * j]);
}
__device__ __forceinline__ void st_row_bf16(const f32x4 (&v)[4], bf16* p, int lane) {
#pragma unroll
    for (int j = 0; j < 4; ++j) ((GAS u32x2*)p)[lane + 64 * j] = pk4(v[j]);
}
__device__ __forceinline__ void rms_gain(f32x4 (&v)[4], const float* g, int lane) {
    float ss = 0.f;
#pragma unroll
    for (int j = 0; j < 4; ++j) ss += (v[j][0] * v[j][0] + v[j][1] * v[j][1]) + (v[j][2] * v[j][2] + v[j][3] * v[j][3]);
    const float r = 1.0f / sqrtf(wave_sum(ss, lane) * (1.0f / 1024.0f) + EPS);
#pragma unroll
    for (int j = 0; j < 4; ++j) { const f32x4 gg = ((const GAS f32x4*)g)[lane + 64 * j]; v[j] = v[j] * r * gg; }
}
__device__ __forceinline__ void modulate_store(const f32x4 (&v)[4], const float* shift, const float* scale, bf16* o, int lane) {
#pragma unroll
    for (int j = 0; j < 4; ++j) { const f32x4 sh = ((const GAS f32x4*)shift)[lane + 64 * j], sc = ((const GAS f32x4*)scale)[lane + 64 * j];
        ((GAS u32x2*)o)[lane + 64 * j] = pk4(v[j] * (sc + 1.0f) + sh); }
}
__device__ __forceinline__ unsigned pk4_fp8(f32x4 v) { return pg8::cvt4_fp8(v[0], v[1], v[2], v[3]); }
__device__ __forceinline__ void modulate_store2(const f32x4 (&v)[4], const float* shift, const float* scale, bf16* o, unsigned char* o8, int lane) {
#pragma unroll
    for (int j = 0; j < 4; ++j) { const f32x4 sh = ((const GAS f32x4*)shift)[lane + 64 * j], sc = ((const GAS f32x4*)scale)[lane + 64 * j]; const f32x4 r = v[j] * (sc + 1.0f) + sh;
        ((GAS u32x2*)o)[lane + 64 * j] = pk4(r); ((GAS unsigned*)o8)[lane + 64 * j] = pk4_fp8(r); }
}
__device__ __forceinline__ f32x4 fp8x4(unsigned w) { const f32x2 a = __builtin_amdgcn_cvt_pk_f32_fp8((int)w, false), b = __builtin_amdgcn_cvt_pk_f32_fp8((int)w, true); return (f32x4){a.x, a.y, b.x, b.y}; }
__device__ __forceinline__ int krow_of(int m) { return m < TL ? (m >> 11) * KVROWS + (m & 2047) : ((m - TL) >> 8) * KVROWS + SEQ + ((m - TL) & 255); }

__device__ __forceinline__ void load_block(const float* W, int ldw, int k0, int n0, float scale, LAS float* scr, int lane) {
    f32x4 v[8]; const int kr = lane >> 3, c4 = (lane & 7) * 4;
#pragma unroll
    for (int i = 0; i < 8; ++i) v[i] = *(const GAS f32x4*)(W + (size_t)(k0 + kr + 8 * i) * ldw + n0 + c4);
#pragma unroll
    for (int i = 0; i < 8; ++i) { LAS float* d = scr + (kr + 8 * i) * 33 + c4; d[0] = v[i][0] * scale; d[1] = v[i][1] * scale; d[2] = v[i][2] * scale; d[3] = v[i][3] * scale; }
    LDS_WAIT(); asm volatile("" ::: "memory");
}
__device__ __forceinline__ void transpose_item(const float* W, int ldw, int K, bf16* WT, int dst_row0, int k0, int n0, LAS float* scr, int lane) {
    load_block(W, ldw, k0, n0, 1.0f, scr, lane);
    const int c = lane & 7;
#pragma unroll
    for (int j = 0; j < 4; ++j) { const int n = (lane >> 3) + 8 * j; const LAS float* s = scr + (8 * c) * 33 + n;
        v4u o; o.x = pk2(s[0 * 33], s[1 * 33]); o.y = pk2(s[2 * 33], s[3 * 33]); o.z = pk2(s[4 * 33], s[5 * 33]); o.w = pk2(s[6 * 33], s[7 * 33]);
        *(GAS v4u*)(WT + (size_t)(dst_row0 + n) * K + k0 + 8 * c) = o; }
    LDS_WAIT(); asm volatile("" ::: "memory");
}
__device__ __forceinline__ void transpose_item_fp8(const float* W, int ldw, int K, unsigned char* WT, int dst_row0, int k0, int n0, float scale, LAS float* scr, int lane) {
    load_block(W, ldw, k0, n0, scale, scr, lane);
#pragma unroll
    for (int j = 0; j < 2; ++j) { const int q = lane + 64 * j, n = q >> 2, c = q & 3; const LAS float* s = scr + (16 * c) * 33 + n; v4u o;
        o.x = pg8::cvt4_fp8(s[0 * 33], s[1 * 33], s[2 * 33], s[3 * 33]); o.y = pg8::cvt4_fp8(s[4 * 33], s[5 * 33], s[6 * 33], s[7 * 33]); o.z = pg8::cvt4_fp8(s[8 * 33], s[9 * 33], s[10 * 33], s[11 * 33]); o.w = pg8::cvt4_fp8(s[12 * 33], s[13 * 33], s[14 * 33], s[15 * 33]);
        *(GAS v4u*)(WT + (size_t)(dst_row0 + n) * K + k0 + 16 * c) = o; }
    LDS_WAIT(); asm volatile("" ::: "memory");
}
constexpr int IT_S0 = 16 * 80, IT_S1 = 16 * 96, IT_S2 = 512, IT_S3 = 512, IT_S4 = 256, IT_S5 = 256, IT_SMALL = IT_S0 + IT_S1 + IT_S2 + IT_S3 + IT_S4 + IT_S5;
__device__ __forceinline__ void small_item(const AV& a, int l, int r, LAS float* scr, int lane) {
    unsigned char* wl = a.ws() + WS_WSMALL + (size_t)l * WSMALL_LAYER; const float* win = a.in(10) + (size_t)l * DM * INCOLS;
    if (r < IT_S0) { const int kb = r / 80, n0 = (r % 80) * 32; int dr;
        if (n0 < 1536) dr = n0; else { int cc = n0 - 1536; if (cc < 512) dr = 1536 + (cc >> 7) * 256 + (cc & 127); else { cc -= 512; dr = 1536 + (cc >> 7) * 256 + 128 + (cc & 127); } }
        transpose_item_fp8(win, INCOLS, DM, wl + OFFS_WIN, dr, kb * 64, n0, 32.0f, scr, lane); return; }
    r -= IT_S0;
    if (r < IT_S1) { const int kb = r / 96, nb = r % 96; transpose_item_fp8(win, INCOLS, DM, wl + OFFS_WG, nb * 32, kb * 64, OFF_GATE + nb * 32, 32.0f, scr, lane); return; }
    r -= IT_S1;
    if (r < IT_S2) { const int kb = r / 32, nb = r % 32; transpose_item_fp8(a.in(13) + (size_t)l * DM * DM, DM, DM, wl + OFFS_WAO, nb * 32, kb * 64, nb * 32, 32.0f, scr, lane); return; }
    r -= IT_S2;
    if (r < IT_S3) { const int kb = r / 32, nb = r % 32; transpose_item(a.in(20) + (size_t)l * DM * DM, DM, DM, (bf16*)(wl + OFFS_WOUT), nb * 32, kb * 64, nb * 32, scr, lane); return; }
    r -= IT_S3;
    if (r < IT_S4) { const int kb = r / 32, nb = r % 32; transpose_item(a.in(18) + (size_t)l * 512 * DM, DM, 512, (bf16*)(wl + OFFS_WCO), nb * 32, kb * 64, nb * 32, scr, lane); return; }
    r -= IT_S4;
    { const int kb = r / 32, nb = r % 32; transpose_item(a.in(19) + (size_t)l * 512 * DM, DM, 512, (bf16*)(wl + OFFS_WFO), nb * 32, kb * 64, nb * 32, scr, lane); }
}
constexpr int IT_MOE = NEXP * 3 * 512;
struct MoeIt { const float* W; unsigned char* WT; int dr, k0; };
__device__ __forceinline__ MoeIt moe_decode(const AV& a, int gi) {
    const int l = gi / IT_MOE, idx = gi % IT_MOE, e = idx / 1536, r = idx % 1536, which = r / 512, it = r % 512, kb = it / 32, n0 = (it % 32) * 32; const size_t eo = ((size_t)l * NEXP + e) << 20;
    MoeIt m; m.k0 = kb * 64;
    if (which == 0) { m.W = a.in(23) + eo + n0; m.WT = a.ws() + WS_WGU + (size_t)l * MOEW_LAYER + (size_t)e * 2048 * 1024; m.dr = (n0 >> 7) * 256 + (n0 & 127); }
    else if (which == 1) { m.W = a.in(25) + eo + n0; m.WT = a.ws() + WS_WGU + (size_t)l * MOEW_LAYER + (size_t)e * 2048 * 1024; m.dr = (n0 >> 7) * 256 + 128 + (n0 & 127); }
    else { m.W = a.in(27) + eo + n0; m.WT = a.ws() + WS_WD + (size_t)l * MOEW_LAYER + (size_t)e * 1024 * 1024; m.dr = n0; }
    return m;
}
__device__ __forceinline__ void moe_issue(f32x4 (&v)[8], const MoeIt& m, int lane) {
    const float* p = m.W + (size_t)(m.k0 + (lane >> 3)) * DM + (lane & 7) * 4;
#pragma unroll
    for (int i = 0; i < 8; ++i) v[i] = __builtin_nontemporal_load((const GAS f32x4*)(p + (size_t)(8 * i) * DM));
}
__device__ __forceinline__ void moe_finish(const f32x4 (&v)[8], const MoeIt& m, LAS float* scr, int lane) {
    const int kr = lane >> 3, c4 = (lane & 7) * 4;
#pragma unroll
    for (int i = 0; i < 8; ++i) { LAS float* d = scr + (kr + 8 * i) * 33 + c4; d[0] = v[i][0] * 32.0f; d[1] = v[i][1] * 32.0f; d[2] = v[i][2] * 32.0f; d[3] = v[i][3] * 32.0f; }
    LDS_WAIT(); asm volatile("" ::: "memory");
#pragma unroll
    for (int j = 0; j < 2; ++j) { const int q = lane + 64 * j, n = q >> 2, c = q & 3; const LAS float* s = scr + (16 * c) * 33 + n; v4u o;
        o.x = pg8::cvt4_fp8(s[0 * 33], s[1 * 33], s[2 * 33], s[3 * 33]); o.y = pg8::cvt4_fp8(s[4 * 33], s[5 * 33], s[6 * 33], s[7 * 33]); o.z = pg8::cvt4_fp8(s[8 * 33], s[9 * 33], s[10 * 33], s[11 * 33]); o.w = pg8::cvt4_fp8(s[12 * 33], s[13 * 33], s[14 * 33], s[15 * 33]);
        *(GAS v4u*)(m.WT + (size_t)(m.dr + n) * DM + m.k0 + 16 * c) = o; }
    LDS_WAIT(); asm volatile("" ::: "memory");
}
__device__ __forceinline__ void moe_convert_range(const AV& a, int base, int count, int gw, int NGW, LAS float* scr, int lane) {
    f32x4 va[8], vb[8]; int it = gw; if (it >= count) return;
    MoeIt ma = moe_decode(a, base + it), mb = ma; moe_issue(va, ma, lane);
    for (;;) {
        const bool h1 = it + NGW < count; if (h1) { mb = moe_decode(a, base + it + NGW); moe_issue(vb, mb, lane); }
        moe_finish(va, ma, scr, lane); if (!h1) break; it += NGW;
        const bool h2 = it + NGW < count; if (h2) { ma = moe_decode(a, base + it + NGW); moe_issue(va, ma, lane); }
        moe_finish(vb, mb, scr, lane); if (!h2) break; it += NGW;
    }
}
#ifndef FILL_A_PER_WAVE
#define FILL_A_PER_WAVE 14
#endif
#ifndef FILL_B_PER_WAVE
#define FILL_B_PER_WAVE 6
#endif
constexpr int FILL_WG0 = 64, FILL_NGW = (256 - FILL_WG0) * NWAVES, FILL_A = FILL_NGW * FILL_A_PER_WAVE, FILL_B = FILL_NGW * FILL_B_PER_WAVE;
static_assert(FILL_A + FILL_B <= IT_MOE, "tail filler converts layer-0 expert weights only");
__device__ __forceinline__ void fold_job(const AV& a, int j, const LAS float* ct, int lane) {
    const int l = j >> 10, r = j & 1023, g = r >> 8, kblk = (r >> 4) & 15, k2g = r & 15, k = kblk * 64 + lane;
    const float* wrow = a.in(10) + (size_t)l * DM * INCOLS + (size_t)k * INCOLS + OFF_FNET + g * 128;
    float ac[8], as[8];
#pragma unroll
    for (int i = 0; i < 8; ++i) { ac[i] = 0.f; as[i] = 0.f; }
    for (int n4 = 0; n4 < 32; ++n4) { const f32x4 w = *(const GAS f32x4*)(wrow + n4 * 4);
#pragma unroll
        for (int q = 0; q < 4; ++q) { const int n2 = n4 * 4 + q;
#pragma unroll
            for (int i = 0; i < 8; ++i) { const int ph = (n2 * (k2g * 8 + i)) & 127; ac[i] += w[q] * ct[ph]; as[i] += w[q] * ct[(ph - 32) & 127]; } } }
    bf16* wf = (bf16*)(a.ws() + WS_WSMALL + (size_t)l * WSMALL_LAYER + OFFS_WF);
#pragma unroll
    for (int i = 0; i < 8; ++i) { const int ch = g * 128 + k2g * 8 + i;
        wf[(size_t)ch * 1024 + k] = (bf16)f2bf(ac[i] * 0.08838834764831845f); wf[(size_t)(512 + ch) * 1024 + k] = (bf16)f2bf(as[i] * 0.08838834764831845f); }
}
__device__ __forceinline__ void p0_prologue(const Frame& F, const AV& a) {
    const int gw = F.vcu * NWAVES + F.wave, NGW = F.G * NWAVES, gt = F.vcu * NTHR + F.tid, NGT = F.G * NTHR;
    LAS float* ct = (LAS float*)(F.lds + LDS_CT);
    if (F.tid < 128) ct[F.tid] = cospif((float)F.tid * (1.0f / 64.0f));
    for (int job = blockIdx.x; job < 2 * 96; job += F.G) {
        const int l = job / 96, n0 = (job % 96) * 64;
        LAS float* s = (LAS float*)(F.lds + RING_OFF); LAS float* red = s + 17 * 1024;
        for (int i = F.tid; i < 17 * 1024; i += NTHR) { const int b = i >> 10, k = i & 1023; const float cv = b < 16 ? a.in(1)[b * 1024 + k] : a.in(3)[k]; s[i] = cv * sigmoidf_(cv); }
        __syncthreads();
        const int col = F.tid & 63, ks = F.tid >> 6; float acc[17];
#pragma unroll
        for (int b = 0; b < 17; ++b) acc[b] = 0.f;
        const float* w = a.in(4) + (size_t)l * DM * INCOLS + n0 + col;
        for (int k = ks * 128; k < ks * 128 + 128; k += 16) { float wv[16];
#pragma unroll
            for (int q = 0; q < 16; ++q) wv[q] = w[(size_t)(k + q) * INCOLS];
#pragma unroll
            for (int q = 0; q < 16; ++q)
#pragma unroll
                for (int b = 0; b < 17; ++b) acc[b] += s[b * 1024 + k + q] * wv[q]; }
#pragma unroll
        for (int b = 0; b < 17; ++b) red[(ks * 17 + b) * 64 + col] = acc[b];
        __syncthreads();
        for (int i = F.tid; i < 17 * 64; i += NTHR) { const int b = i >> 6, c2 = i & 63; float t = 0.f;
#pragma unroll
            for (int q = 0; q < 8; ++q) t += red[(q * 17 + b) * 64 + c2];
            ((float*)(a.ws() + WS_MOD))[((size_t)l * 17 + b) * INCOLS + n0 + c2] = t + a.in(5)[l * INCOLS + n0 + c2]; }
        __syncthreads();
    }
    __syncthreads();
    for (int i = gt; i < 64 * 32; i += NGT) { const int p = i >> 5, f = i & 31; const float inv = powf(10000.0f, -(float)f / 32.0f), ang = (float)p * inv; ((f32x2*)(a.ws() + WS_TAB))[i] = (f32x2){cosf(ang), sinf(ang)}; }
    for (int i = gt; i < 2048 * 256; i += NGT) { const int k1 = i >> 8, c0 = (i & 255) * 16; float v[16];
#pragma unroll
        for (int q = 0; q < 16; ++q) { const int col = c0 + q, n1 = col & 2047, rr = (k1 * n1) & 2047; const float x = (float)rr * (1.0f / 1024.0f); v[q] = ((col >> 11) ? -sinpif(x) : cospif(x)) * (32.0f * 0.022097086912079608f); }
        v4u o; o.x = pk4_fp8((f32x4){v[0], v[1], v[2], v[3]}); o.y = pk4_fp8((f32x4){v[4], v[5], v[6], v[7]}); o.z = pk4_fp8((f32x4){v[8], v[9], v[10], v[11]}); o.w = pk4_fp8((f32x4){v[12], v[13], v[14], v[15]}); ((GAS v4u*)(a.ws() + WS_DFTL))[i] = o; }
    for (int i = gt; i < 256 * 32; i += NGT) { const int k1 = i >> 5, c0 = (i & 31) * 16; float v[16];
#pragma unroll
        for (int q = 0; q < 16; ++q) { const int col = c0 + q, n1 = col & 255, rr = (k1 * n1) & 255; const float x = (float)rr * (1.0f / 128.0f); v[q] = ((col >> 8) ? -sinpif(x) : cospif(x)) * (32.0f * 0.0625f); }
        v4u o; o.x = pk4_fp8((f32x4){v[0], v[1], v[2], v[3]}); o.y = pk4_fp8((f32x4){v[4], v[5], v[6], v[7]}); o.z = pk4_fp8((f32x4){v[8], v[9], v[10], v[11]}); o.w = pk4_fp8((f32x4){v[12], v[13], v[14], v[15]}); ((GAS v4u*)(a.ws() + WS_DFTC))[i] = o; }
    for (int i = gt; i < 2 * 256 * 1024; i += NGT) { const int l = i >> 18, r = (i >> 10) & 255, k = i & 1023; unsigned o = 0u;
        if (r < 64) { const float w = a.in(21)[((size_t)l * DM + k) * NEXP + (r & 31)]; const unsigned hi = f2bf(w); o = hi; if (r >= 32) o = f2bf(w - __uint_as_float(hi << 16)); }
        ((bf16*)(a.ws() + WS_WSMALL + (size_t)l * WSMALL_LAYER + OFFS_ROUT))[(size_t)r * 1024 + k] = (bf16)o; }
    for (int j = gw; j < 2048; j += NGW) fold_job(a, j, ct, F.lane);
    LAS float* scr = (LAS float*)(F.lds + RING_OFF + F.wave * 16384);
    for (int it = gw; it < 2 * IT_SMALL; it += NGW) small_item(a, it / IT_SMALL, it % IT_SMALL, scr, F.lane);
    { const int fill = (F.G == 256) ? FILL_A + FILL_B : 0; moe_convert_range(a, fill, 2 * IT_MOE - fill, gw, NGW, scr, F.lane); }
}
__device__ __forceinline__ void ld4(f32x4 (&v)[4], const float* p, int lane) {
#pragma unroll
    for (int j = 0; j < 4; ++j) v[j] = ((const GAS f32x4*)p)[lane + 64 * j];
}
__device__ __forceinline__ float sumsq4(const f32x4 (&v)[4]) { float ss = 0.f;
#pragma unroll
    for (int j = 0; j < 4; ++j) ss += (v[j][0] * v[j][0] + v[j][1] * v[j][1]) + (v[j][2] * v[j][2] + v[j][3] * v[j][3]);
    return ss; }
__device__ __forceinline__ void p1_norm0(const Frame& F, const AV& a) {
    const int gw = F.vcu * NWAVES + F.wave, NGW = F.G * NWAVES, rpw = (TALL + NGW - 1) / NGW, r0 = gw * rpw, r1 = (r0 + rpw < TALL) ? r0 + rpw : TALL;
    if (r0 >= r1) return;
    f32x4 gpre[4], shift[4], scale[4], xn[4]; ld4(gpre, a.in(6), F.lane); int cb = -1;
    auto xsrc = [&](int m) -> const float* { return m < TL ? a.in(0) + (size_t)m * DM : a.in(2) + (size_t)(m - TL) * DM; };
    ld4(xn, xsrc(r0), F.lane);
    for (int m = r0; m < r1; ++m) {
        f32x4 x[4];
#pragma unroll
        for (int j = 0; j < 4; ++j) x[j] = xn[j];
        if (m + 1 < r1) ld4(xn, xsrc(m + 1), F.lane);
        const int b = m < TL ? (m >> 11) : 16;
        if (b != cb) { cb = b; const float* mv = (const float*)(a.ws() + WS_MOD) + (size_t)b * INCOLS; ld4(shift, mv, F.lane); ld4(scale, mv + 1024, F.lane); }
        const float r = 1.0f / sqrtf(wave_sum(sumsq4(x), F.lane) * (1.0f / 1024.0f) + EPS);
        bf16* ho = (bf16*)(a.ws() + WS_H) + (size_t)m * DM; unsigned char* h8 = a.ws() + WS_H8 + (size_t)m * DM;
#pragma unroll
        for (int j = 0; j < 4; ++j) { const f32x4 hv = x[j] * r * gpre[j] * (scale[j] + 1.0f) + shift[j]; ((GAS u32x2*)ho)[F.lane + 64 * j] = pk4(hv); ((GAS unsigned*)h8)[F.lane + 64 * j] = pk4_fp8(hv); }
    }
}
__device__ __forceinline__ void qk_fix_core(f32x4 (&x)[4], const f32x4 (&gg)[4], const f32x2* tab, bool rope, int t, int sub, int lane) {
    float ss = sumsq4(x); ss += shx(ss, 1, lane); ss += shx(ss, 2, lane); ss += shx(ss, 4, lane);
    const float r = 1.0f / sqrtf(ss * (1.0f / 128.0f) + EPS);
#pragma unroll
    for (int jj = 0; jj < 4; ++jj) x[jj] = x[jj] * r * gg[jj];
    if (rope) { const int pr = t >> 6, pc = t & 63;
#pragma unroll
        for (int i = 0; i < 4; ++i) { const f32x2 cr = tab[pr * 32 + sub * 4 + i], cc = tab[pc * 32 + sub * 4 + i];
            const float a0 = x[0][i], a1 = x[1][i], b0 = x[2][i], b1 = x[3][i];
            x[0][i] = a0 * cr.x - a1 * cr.y; x[1][i] = a1 * cr.x + a0 * cr.y; x[2][i] = b0 * cc.x - b1 * cc.y; x[3][i] = b1 * cc.x + b0 * cc.y; } }
}
__device__ __forceinline__ void p_qkfix(const Frame& F, const AV& a, int l, int M) {
    const int gw = F.vcu * NWAVES + F.wave, NGW = F.G * NWAVES, rpw = 4 * ((M + 4 * NGW - 1) / (4 * NGW)), r0 = gw * rpw, r1 = (r0 + rpw < M) ? r0 + rpw : M;
    if (r0 >= r1) return;
    const f32x2* tab = (const f32x2*)(a.ws() + WS_TAB); const int rs = F.lane >> 4, hh = (F.lane >> 3) & 1, sub = F.lane & 7;
    f32x4 gk[4];
#pragma unroll
    for (int jj = 0; jj < 4; ++jj) gk[jj] = *(const GAS f32x4*)(a.in(12) + l * 128 + jj * 32 + sub * 4);
    bf16* kb = (bf16*)(a.ws() + WS_K);
    u32x2 kn[4];
    auto issue = [&](int mb) { const int m = mb + rs; if (m < r1) { const bf16* kp = kb + (size_t)krow_of(m) * 256 + hh * 128 + sub * 4;
#pragma unroll
        for (int jj = 0; jj < 4; ++jj) kn[jj] = *(const GAS u32x2*)(kp + jj * 32); } };
    issue(r0);
    for (int mb = r0; mb < r1; mb += 4) { const int m = mb + rs; const bool act = m < r1;
        f32x4 xk[4];
#pragma unroll
        for (int jj = 0; jj < 4; ++jj) xk[jj] = bf4(kn[jj]);
        if (mb + 4 < r1) issue(mb + 4);
        qk_fix_core(xk, gk, tab, m < TL, m & 2047, sub, F.lane);
        if (act) { bf16* kp = kb + (size_t)krow_of(m) * 256 + hh * 128 + sub * 4;
#pragma unroll
            for (int jj = 0; jj < 4; ++jj) *(GAS u32x2*)(kp + jj * 32) = pk4(xk[jj]); }
    }
}
__device__ __forceinline__ void p_conv(const Frame& F, const AV& a, int l, int njobs) {
    LAS unsigned char* lin = F.lds + RING_OFF; LAS float* lout = (LAS float*)(F.lds + RING_OFF + 62 * 1024);
    const bf16* cu = (const bf16*)(a.ws() + WS_CU); bf16* chb = (bf16*)(a.ws() + WS_CH);
    const int cp = F.tid & 255, pg = F.tid >> 8;
    f32x2 wv[31];
#pragma unroll
    for (int j = 0; j < 31; ++j) wv[j] = *(const GAS f32x2*)(a.in(14) + ((size_t)l * 31 + j) * 512 + 2 * cp);
    const f32x2 cb2 = *(const GAS f32x2*)(a.in(15) + l * 512 + 2 * cp);
    for (int job = F.vcu; job < njobs; job += F.G) {
        int rowbase, L, t0;
        if (job < 1024) { rowbase = (job >> 6) * SEQ; L = SEQ; t0 = (job & 63) * 32; } else { const int jc = job - 1024; rowbase = TL + (jc >> 3) * CTXL; L = CTXL; t0 = (jc & 7) * 32; }
        for (int idx = F.tid; idx < 62 * 64; idx += NTHR) { const int row = idx >> 6, ch = idx & 63, p = t0 - 15 + row; v4u val = (v4u){0u, 0u, 0u, 0u};
            if (p >= 0 && p < L) val = *(const GAS v4u*)(cu + (size_t)(rowbase + p) * 512 + ch * 8);
            *(LAS v4u*)(lin + row * 1024 + ch * 16) = val; }
        __syncthreads();
#pragma unroll
        for (int chunk = 0; chunk < 2; ++chunk) {
            f32x2 acc[8];
#pragma unroll
            for (int i = 0; i < 8; ++i) acc[i] = cb2;
            const int r0 = pg * 16 + chunk * 8;
#pragma unroll
            for (int r = 0; r < 38; ++r) { const unsigned w = *(const LAS unsigned*)(lin + (r0 + r) * 1024 + cp * 4); const float x0 = __uint_as_float(w << 16), x1 = __uint_as_float(w & 0xffff0000u);
#pragma unroll
                for (int i = 0; i < 8; ++i) { const int j = r - i; if (j >= 0 && j <= 30) { acc[i].x += x0 * wv[j].x; acc[i].y += x1 * wv[j].y; } } }
#pragma unroll
            for (int i = 0; i < 8; ++i) *(LAS f32x2*)(lout + (r0 + i) * 512 + 2 * cp) = acc[i];
        }
        __syncthreads();
#pragma unroll
        for (int pp = 0; pp < 4; ++pp) { const int p = F.wave * 4 + pp; const LAS float* src = lout + p * 512 + F.lane * 8;
            f32x4 y0 = *(const LAS f32x4*)src, y1 = *(const LAS f32x4*)(src + 4);
            const float mean = wave_sum((y0[0] + y0[1]) + (y0[2] + y0[3]) + (y1[0] + y1[1]) + (y1[2] + y1[3]), F.lane) * (1.0f / 512.0f);
            y0 = y0 - mean; y1 = y1 - mean;
            const float var = wave_sum((y0[0] * y0[0] + y0[1] * y0[1]) + (y0[2] * y0[2] + y0[3] * y0[3]) + (y1[0] * y1[0] + y1[1] * y1[1]) + (y1[2] * y1[2] + y1[3] * y1[3]), F.lane) * (1.0f / 512.0f);
            const float rs = 1.0f / sqrtf(var + EPS);
            const f32x4 g0 = *(const GAS f32x4*)(a.in(16) + l * 512 + F.lane * 8), g1 = *(const GAS f32x4*)(a.in(16) + l * 512 + F.lane * 8 + 4);
            const f32x4 b0 = *(const GAS f32x4*)(a.in(17) + l * 512 + F.lane * 8), b1 = *(const GAS f32x4*)(a.in(17) + l * 512 + F.lane * 8 + 4);
            y0 = y0 * rs * g0 + b0; y1 = y1 * rs * g1 + b1;
#pragma unroll
            for (int q = 0; q < 4; ++q) { y0[q] = y0[q] * sigmoidf_(y0[q]); y1[q] = y1[q] * sigmoidf_(y1[q]); }
            v4u o; o.x = pk2(y0[0], y0[1]); o.y = pk2(y0[2], y0[3]); o.z = pk2(y1[0], y1[1]); o.w = pk2(y1[2], y1[3]);
            *(GAS v4u*)(chb + (size_t)(rowbase + t0 + p) * 512 + F.lane * 8) = o; }
        __syncthreads();
    }
}
__device__ __forceinline__ void p_rowpass1(const Frame& F, const AV& a, int l, int M) {
    const int gw = F.vcu * NWAVES + F.wave, NGW = F.G * NWAVES, rpw = (M + NGW - 1) / NGW, r0 = gw * rpw, r1 = (r0 + rpw < M) ? r0 + rpw : M;
    if (r0 >= r1) return;
    const float* modb = (const float*)(a.ws() + WS_MOD) + (size_t)l * 17 * INCOLS; const bf16* mixb = (const bf16*)(a.ws() + WS_MIX);
    f32x4 gpost[4], gpre[4], gate[4], shift[4], scale[4]; ld4(gpost, a.in(7) + l * DM, F.lane); ld4(gpre, a.in(8) + l * DM, F.lane);
    int cb = -1;
    auto xsrc = [&](int m) -> const float* { return m < TL ? a.in(0) + (size_t)m * DM : a.in(2) + (size_t)(m - TL) * DM; };
    const bf16* xbb = (const bf16*)(a.ws() + WS_XB); bf16* xab = (bf16*)(a.ws() + WS_XA);
    f32x4 xn[4]; u32x2 xbn[4]; u32x2 mn[4];
    if (l == 0) ld4(xn, xsrc(r0), F.lane); else {
#pragma unroll
        for (int j = 0; j < 4; ++j) xbn[j] = ((const GAS u32x2*)(xbb + (size_t)r0 * DM))[F.lane + 64 * j]; }
#pragma unroll
    for (int j = 0; j < 4; ++j) mn[j] = ((const GAS u32x2*)(mixb + (size_t)r0 * DM))[F.lane + 64 * j];
    for (int m = r0; m < r1; ++m) {
        f32x4 x[4], y[4];
#pragma unroll
        for (int j = 0; j < 4; ++j) { x[j] = (l == 0) ? xn[j] : bf4(xbn[j]); y[j] = bf4(mn[j]); }
        if (m + 1 < r1) { if (l == 0) ld4(xn, xsrc(m + 1), F.lane); else {
#pragma unroll
                for (int j = 0; j < 4; ++j) xbn[j] = ((const GAS u32x2*)(xbb + (size_t)(m + 1) * DM))[F.lane + 64 * j]; }
#pragma unroll
            for (int j = 0; j < 4; ++j) mn[j] = ((const GAS u32x2*)(mixb + (size_t)(m + 1) * DM))[F.lane + 64 * j]; }
        const int b = m < TL ? (m >> 11) : 16;
        if (b != cb) { cb = b; const float* mv = modb + (size_t)b * INCOLS; ld4(gate, mv + 2 * 1024, F.lane); ld4(shift, mv + 3 * 1024, F.lane); ld4(scale, mv + 4 * 1024, F.lane); }
        const float r = 1.0f / sqrtf(wave_sum(sumsq4(y), F.lane) * (1.0f / 1024.0f) + EPS);
#pragma unroll
        for (int j = 0; j < 4; ++j) x[j] = x[j] + gate[j] * (y[j] * r * gpost[j]);
#pragma unroll
        for (int j = 0; j < 4; ++j) ((GAS u32x2*)(xab + (size_t)m * DM))[F.lane + 64 * j] = pk4(x[j]);
        const float r2 = 1.0f / sqrtf(wave_sum(sumsq4(x), F.lane) * (1.0f / 1024.0f) + EPS);
        bf16* ho = (bf16*)(a.ws() + WS_H) + (size_t)m * DM; unsigned char* h8 = a.ws() + WS_H8 + (size_t)m * DM;
#pragma unroll
        for (int j = 0; j < 4; ++j) { const f32x4 hv = x[j] * r2 * gpre[j] * (scale[j] + 1.0f) + shift[j]; ((GAS u32x2*)ho)[F.lane + 64 * j] = pk4(hv); ((GAS unsigned*)h8)[F.lane + 64 * j] = pk4_fp8(hv); }
    }
}
__device__ __forceinline__ void p_route(const Frame& F, const AV& a, int l, int M) {
    typedef short bfx8 __attribute__((ext_vector_type(8)));
    const int NGW = F.G * NWAVES, rpw = (M + NGW - 1) / NGW, TPB = 8 * rpw, b0 = F.vcu * TPB, b1 = (b0 + TPB < M) ? b0 + TPB : M;
    LAS unsigned char* tabl = F.lds + RING_OFF; LAS float* lg = (LAS float*)(F.lds + LDS_SM) + F.wave * 512; LAS int* cntl = (LAS int*)(F.lds + LDS_SM + 16384);
    VM_WAIT(); __syncthreads();
    if (F.tid < 32) cntl[F.tid] = 0;
    { const GAS v4u* src = (const GAS v4u*)(a.ws() + WS_WSMALL + (size_t)l * WSMALL_LAYER + OFFS_ROUT);
      for (int idx = F.tid; idx < 64 * 128; idx += NTHR) { const int row = idx >> 7, c = idx & 127; *(LAS v4u*)(tabl + row * 2048 + ((c ^ (row & 7)) << 4)) = src[idx]; } }
    __syncthreads();
    const bf16* H = (const bf16*)(a.ws() + WS_H); const float bias = a.in(22)[l * NEXP + (F.lane & 31)];
    const int ar = F.lane & 15, kb = F.lane >> 4, ng = (b1 > b0) ? (b1 - b0 + 15) >> 4 : 0;
    const int hf = F.lane >> 5, ex = F.lane & 31;
    LAS unsigned long long* kb64 = (LAS unsigned long long*)(F.lds + LDS_SM + 16384 + 256) + F.wave * 64;
    LAS float* selv = (LAS float*)(F.lds + LDS_SM + 16384 + 256 + 4096) + F.wave * 16; LAS int* seli = (LAS int*)(selv + 8);
    auto logits16 = [&](int rb, int s0, int s1) {
        int row = rb + ar; if (row > M - 1) row = M - 1;
        const bf16* hp = H + (size_t)row * DM + kb * 8; f32x4 acc[4];
#pragma unroll
        for (int f = 0; f < 4; ++f) acc[f] = (f32x4){0.f, 0.f, 0.f, 0.f};
#pragma unroll 4
        for (int s = s0; s < s1; ++s) { const bfx8 af = *(const GAS bfx8*)(hp + s * 32);
#pragma unroll
            for (int f = 0; f < 4; ++f) { const int wr = f * 16 + ar; const bfx8 bfr = *(const LAS bfx8*)(tabl + wr * 2048 + (((4 * s + kb) ^ (wr & 7)) << 4));
                acc[f] = __builtin_amdgcn_mfma_f32_16x16x32_bf16(af, bfr, acc[f], 0, 0, 0); } }
#pragma unroll
        for (int i = 0; i < 4; ++i) { lg[(4 * kb + i) * 32 + ar] = acc[0][i] + acc[2][i]; lg[(4 * kb + i) * 32 + 16 + ar] = acc[1][i] + acc[3][i]; }
        LDS_WAIT(); asm volatile("" ::: "memory");
    };
    auto top4 = [&](int m, bool valid, float v) {
        unsigned ub = __float_as_uint(v); ub = (ub & 0x80000000u) ? ~ub : (ub | 0x80000000u);
        const unsigned long long K = ((unsigned long long)ub << 5) | (unsigned)(31 - ex);
        kb64[F.lane] = K;
        LDS_WAIT(); asm volatile("" ::: "memory");
        int rank = 0;
#pragma unroll
        for (int j = 0; j < 32; ++j) rank += (kb64[hf * 32 + j] > K) ? 1 : 0;
        if (rank < 4) { selv[hf * 4 + rank] = v; seli[hf * 4 + rank] = ex; if (valid) __hip_atomic_fetch_add(&cntl[ex], 1, __ATOMIC_RELAXED, __HIP_MEMORY_SCOPE_WORKGROUP); }
        LDS_WAIT(); asm volatile("" ::: "memory");
        if (ex == 0 && valid) { const f32x4 tv = *(const LAS f32x4*)(selv + hf * 4); const i32x4 ti = *(const LAS i32x4*)(seli + hf * 4);
            const float e1 = __expf(tv[1] - tv[0]), e2 = __expf(tv[2] - tv[0]), e3 = __expf(tv[3] - tv[0]), inv = 1.0f / (1.0f + e1 + e2 + e3);
            *(GAS i32x4*)((int*)(a.ws() + WS_TOPI) + (size_t)m * 4) = ti; *(GAS f32x4*)((float*)(a.ws() + WS_TOPP) + (size_t)m * 4) = (f32x4){inv, e1 * inv, e2 * inv, e3 * inv}; }
        LDS_WAIT(); asm volatile("" ::: "memory");
    };
    const int nfull = ng & ~(NWAVES - 1);
    for (int g = F.wave; g < nfull; g += NWAVES) {
        const int rb = b0 + g * 16; logits16(rb, 0, 32);
#pragma unroll 1
        for (int p = 0; p < 8; ++p) { const int r = 2 * p + hf, m = rb + r; top4(m, m < b1, lg[r * 32 + ex] + bias); }
        LDS_WAIT(); asm volatile("" ::: "memory");
    }
    for (int g = nfull; g < ng; ++g) {
        const int rb = b0 + g * 16;
        __syncthreads();
        logits16(rb, 4 * F.wave, 4 * F.wave + 4);
        __syncthreads();
        { const int r = 2 * F.wave + hf, m = rb + r; const LAS float* lga = (const LAS float*)(F.lds + LDS_SM); float v = bias;
#pragma unroll
          for (int q = 0; q < NWAVES; ++q) v += lga[q * 512 + r * 32 + ex];
          top4(m, m < b1, v); }
    }
    __syncthreads();
    if (F.tid < 32) ((int*)(a.ws() + WS_CNT))[F.vcu * 32 + F.tid] = cntl[F.tid];
}
__device__ __forceinline__ void p_slots(const Frame& F, const AV& a, int M) {
    LAS int* sm = (LAS int*)(F.lds + LDS_SM);
    LAS int *tot = sm, *bef = sm + 32, *base = sm + 64, *tst = sm + 96  , *mask = sm + 160  , *ids = sm + 320  , *slot = sm + 960  ;
    const int* cnt = (const int*)(a.ws() + WS_CNT);
    { LAS int* ptot = sm + 1600; LAS int* pbef = sm + 2112; const int e = F.tid & 31, part = F.tid >> 5; int t = 0, b = 0;
#pragma unroll 4
      for (int q = part; q < F.G; q += 16) { const int c = cnt[q * 32 + e]; t += c; if (q < F.vcu) b += c; }
      ptot[part * 32 + e] = t; pbef[part * 32 + e] = b;
      __syncthreads();
      if (F.tid < 32) { int tt = 0, bb = 0;
#pragma unroll
          for (int q = 0; q < 16; ++q) { tt += ptot[q * 32 + F.tid]; bb += pbef[q * 32 + F.tid]; }
          tot[F.tid] = tt; bef[F.tid] = bb; } }
    __syncthreads();
    if (F.tid == 0) { int ts = 0; for (int e = 0; e < 32; ++e) { tst[e] = ts; base[e] = ts * 256 + bef[e]; ts += (tot[e] + 255) >> 8; } tst[32] = ts; }
    __syncthreads();
    const int NT = tst[32];
    if (blockIdx.x == 0) { int* te = (int*)(a.ws() + WS_CNT) + CNT_TILE_E;
        for (int t = F.tid; t < NT; t += NTHR) { int e = 0; for (int q = 1; q < 32; ++q) if (t >= tst[q]) e = q; te[t] = e; }
        if (F.tid == 0) ((int*)(a.ws() + WS_CNT))[CNT_NT] = NT; }
    const int TPB = 8 * ((M + F.G * NWAVES - 1) / (F.G * NWAVES)), m0 = F.vcu * TPB, m1 = (m0 + TPB < M) ? m0 + TPB : M, nt = m1 > m0 ? m1 - m0 : 0;
    for (int tl = F.tid; tl < nt; tl += NTHR) { const i32x4 id = *(const GAS i32x4*)((const int*)(a.ws() + WS_TOPI) + (size_t)(m0 + tl) * 4);
        ids[tl * 4 + 0] = id.x; ids[tl * 4 + 1] = id.y; ids[tl * 4 + 2] = id.z; ids[tl * 4 + 3] = id.w; mask[tl] = (1 << id.x) | (1 << id.y) | (1 << id.z) | (1 << id.w); }
    __syncthreads();
    for (int p = F.tid; p < nt * 4; p += NTHR) { const int tl = p >> 2, e = ids[p]; int rank = 0; for (int q = 0; q < tl; ++q) rank += (mask[q] >> e) & 1;
        const int s = base[e] + rank; slot[p] = s; ((int*)(a.ws() + WS_SLOT))[(size_t)(m0 + tl) * 4 + (p & 3)] = s; ((int*)(a.ws() + WS_CNT))[CNT_ROWSRC + s] = m0 + tl; }
    __syncthreads();
    if (blockIdx.x < 32) { const int e = blockIdx.x, r0 = tst[e] * 256 + tot[e], r1 = tst[e + 1] * 256;
        for (int r = r0 + F.tid; r < r1; r += NTHR) ((int*)(a.ws() + WS_CNT))[CNT_ROWSRC + r] = 0; }
    __syncthreads();
}
__device__ __forceinline__ void p_combine(const Frame& F, const AV& a, int l, int M) {
    const int gw = F.vcu * NWAVES + F.wave, NGW = F.G * NWAVES, rpw = (M + NGW - 1) / NGW, r0 = gw * rpw, r1 = (r0 + rpw < M) ? r0 + rpw : M;
    if (r0 >= r1) return;
    const unsigned char* ys = a.ws() + WS_YS;   const int* slp = (const int*)(a.ws() + WS_SLOT); const float* prp = (const float*)(a.ws() + WS_TOPP);
    const float* modb = (const float*)(a.ws() + WS_MOD);
    f32x4 gpost[4], gpre[4], gate[4], shift[4], scale[4]; ld4(gpost, a.in(9) + l * DM, F.lane); if (l == 0) ld4(gpre, a.in(6) + DM, F.lane);
    int cb = -1;
    i32x4 sl_n = *(const GAS i32x4*)(slp + (size_t)r0 * 4); f32x4 pr_n = *(const GAS f32x4*)(prp + (size_t)r0 * 4);
    u32x2 xn[4]; unsigned yn[4][4]; f32x4 prc = pr_n * 0.125f;
    const bf16* xab = (const bf16*)(a.ws() + WS_XA); bf16* xbb = (bf16*)(a.ws() + WS_XB);
    {
#pragma unroll
      for (int j = 0; j < 4; ++j) xn[j] = ((const GAS u32x2*)(xab + (size_t)r0 * DM))[F.lane + 64 * j];
      const int sv[4] = {sl_n[0], sl_n[1], sl_n[2], sl_n[3]};
#pragma unroll
      for (int k = 0; k < 4; ++k)
#pragma unroll
          for (int j = 0; j < 4; ++j) yn[k][j] = ((const GAS unsigned*)(ys + (size_t)sv[k] * DM))[F.lane + 64 * j];
      if (r0 + 1 < r1) { sl_n = *(const GAS i32x4*)(slp + (size_t)(r0 + 1) * 4); pr_n = *(const GAS f32x4*)(prp + (size_t)(r0 + 1) * 4); } }
    for (int m = r0; m < r1; ++m) {
        f32x4 x[4], y[4];
#pragma unroll
        for (int j = 0; j < 4; ++j) { x[j] = bf4(xn[j]); y[j] = fp8x4(yn[0][j]) * prc[0] + fp8x4(yn[1][j]) * prc[1] + fp8x4(yn[2][j]) * prc[2] + fp8x4(yn[3][j]) * prc[3]; }
        if (m + 1 < r1) { prc = pr_n * 0.125f;
#pragma unroll
            for (int j = 0; j < 4; ++j) xn[j] = ((const GAS u32x2*)(xab + (size_t)(m + 1) * DM))[F.lane + 64 * j];
            const int sv[4] = {sl_n[0], sl_n[1], sl_n[2], sl_n[3]};
#pragma unroll
            for (int k = 0; k < 4; ++k)
#pragma unroll
                for (int j = 0; j < 4; ++j) yn[k][j] = ((const GAS unsigned*)(ys + (size_t)sv[k] * DM))[F.lane + 64 * j];
            if (m + 2 < r1) { sl_n = *(const GAS i32x4*)(slp + (size_t)(m + 2) * 4); pr_n = *(const GAS f32x4*)(prp + (size_t)(m + 2) * 4); } }
        const int b = m < TL ? (m >> 11) : 16;
        if (b != cb) { cb = b; ld4(gate, modb + ((size_t)l * 17 + b) * INCOLS + 5 * 1024, F.lane); if (l == 0) { const float* m1 = modb + ((size_t)17 + b) * INCOLS; ld4(shift, m1, F.lane); ld4(scale, m1 + 1024, F.lane); } }
        const float r = 1.0f / sqrtf(wave_sum(sumsq4(y), F.lane) * (1.0f / 1024.0f) + EPS);
#pragma unroll
        for (int j = 0; j < 4; ++j) x[j] = x[j] + gate[j] * (y[j] * r * gpost[j]);
        if (l == 0) {
#pragma unroll
            for (int j = 0; j < 4; ++j) ((GAS u32x2*)(xbb + (size_t)m * DM))[F.lane + 64 * j] = pk4(x[j]); }
        else st_row_f32(x, a.out() + (size_t)m * DM, F.lane);
        if (l == 0) { const float r2 = 1.0f / sqrtf(wave_sum(sumsq4(x), F.lane) * (1.0f / 1024.0f) + EPS);
            bf16* ho = (bf16*)(a.ws() + WS_H) + (size_t)m * DM; unsigned char* h8 = a.ws() + WS_H8 + (size_t)m * DM;
#pragma unroll
            for (int j = 0; j < 4; ++j) { const f32x4 hv = x[j] * r2 * gpre[j] * (scale[j] + 1.0f) + shift[j]; ((GAS u32x2*)ho)[F.lane + 64 * j] = pk4(hv); ((GAS unsigned*)h8)[F.lane + 64 * j] = pk4_fp8(hv); } }
    }
}
#ifdef DBG_CHECK
#ifndef DBG_GSUB
#define DBG_GSUB 0
#endif
__device__ __forceinline__ double bfd(bf16 b) { return (double)__uint_as_float(((unsigned)b) << 16); }
__device__ __forceinline__ unsigned hsh(unsigned x) { x ^= x >> 16; x *= 0x7feb352du; x ^= x >> 15; x *= 0x846ca68bu; x ^= x >> 16; return x; }
__device__ __forceinline__ int samp_row(int i, int M, unsigned salt) { const int sp[12] = {0, 1, 255, 256, 2047, 2048, 4095, 32767, 32768, 32769, 33023, 36863}; if (i < 12 && sp[i] < M) return sp[i]; return (int)(hsh(i * 7919u + salt) % (unsigned)M); }
__device__ __forceinline__ void rec(float* res, int stage, double got, double want, double flo) { const double e = fabs(got - want) / (fabs(want) + flo); const float f = (e == e) ? (float)e : 1e30f; atomicMax((unsigned*)res + stage, __float_as_uint(f)); }
__device__ double dot_h_w(const bf16* hrow, const float* w, int ldw, int col) { double s = 0; for (int k = 0; k < 1024; ++k) s += bfd(hrow[k]) * (double)w[(size_t)k * ldw + col]; return s; }
__device__ double dsig(double x) { return 1.0 / (1.0 + exp(-x)); }
constexpr double PI_D = 3.14159265358979323846;
enum { ST_MOD = 0, ST_H0, ST_INPROJ, ST_YT, ST_QKFIX, ST_CONV, ST_Z, ST_ATTN, ST_GATES, ST_MERGED, ST_MIX, ST_ROW1, ST_LOGIT, ST_TOPK, ST_SLOTS, ST_ACT, ST_YSLOT, ST_COMB, ST_GATESB, ST_N };
__global__ void chk(Args A, int stage, int l, float* res, float* snap) {
    const int i = threadIdx.x; unsigned char* ws = A.ws; const int M = (l == 0) ? TALL : TL; const int rs = stage + 32 * l;
    const bf16* H = (const bf16*)(ws + WS_H); const float* win = A.in[10] + (size_t)l * DM * INCOLS; const float* modb = (const float*)(ws + WS_MOD);
    if (stage == ST_MOD) { const int ll = i & 1, b = (i >> 1) % 17, n = (int)(hsh(i) % 6144u); double s = 0; for (int k = 0; k < 1024; ++k) { const double cv = b < 16 ? A.in[1][b * 1024 + k] : A.in[3][k]; s += cv * dsig(cv) * (double)A.in[4][((size_t)ll * 1024 + k) * 6144 + n]; }
        s += A.in[5][ll * 6144 + n]; rec(res, rs, modb[((size_t)ll * 17 + b) * 6144 + n], s, 0.02); }
    else if (stage == ST_H0) { const int m = samp_row(i, TALL, 1), c = (int)(hsh(i + 77) % 1024u); const float* x = m < TL ? A.in[0] + (size_t)m * DM : A.in[2] + (size_t)(m - TL) * DM; double ss = 0; for (int k = 0; k < 1024; ++k) ss += (double)x[k] * x[k];
        const float* mv = modb + (size_t)(m < TL ? (m >> 11) : 16) * 6144; const double want = x[c] / sqrt(ss / 1024 + 1e-6) * A.in[6][c] * (1.0 + mv[1024 + c]) + mv[c]; rec(res, rs, bfd(H[(size_t)m * DM + c]), want, 0.05); }
    else if (stage == ST_INPROJ) { const int m = samp_row(i, TALL, 2), kind = i & 3; const bf16* hr = H + (size_t)m * DM;
        if (kind == 0) { const int n = (int)(hsh(i + 5) % 1024u); rec(res, rs, bfd(((const bf16*)(ws + WS_Q))[(size_t)m * DM + n]), dot_h_w(hr, win, INCOLS, n), 0.05); }
        else if (kind == 1) { const int n = (int)(hsh(i + 6) % 256u); rec(res, rs, bfd(((const bf16*)(ws + WS_K))[(size_t)krow_of(m) * 256 + n]), dot_h_w(hr, win, INCOLS, 1024 + n), 0.05); }
        else if (kind == 2) { const int n = (int)(hsh(i + 7) % 256u); rec(res, rs, bfd(((const bf16*)(ws + WS_V))[(size_t)krow_of(m) * 256 + n]), dot_h_w(hr, win, INCOLS, 1280 + n), 0.05); }
        else { const int c = (int)(hsh(i + 8) % 512u); if (l == 0 || m < TL) { const double a = dot_h_w(hr, win, INCOLS, 1536 + c), g = dot_h_w(hr, win, INCOLS, 2048 + c); rec(res, rs, bfd(((const bf16*)(ws + WS_CU))[(size_t)m * 512 + c]), a * dsig(g), 0.05); } } }
    else if (stage == ST_YT) { const int m = samp_row(i, M, 3), ch = (int)(hsh(i + 9) % 512u), cs = i & 1, g = ch >> 7, k2 = ch & 127; const bf16* hr = H + (size_t)m * DM; double s = 0;
        for (int k = 0; k < 1024; ++k) { double t = 0; for (int n2 = 0; n2 < 128; ++n2) { const double ang = 2.0 * PI_D * ((n2 * k2) & 127) / 128.0; t += (double)win[(size_t)k * INCOLS + OFF_FNET + g * 128 + n2] * (cs ? sin(ang) : cos(ang)); } s += bfd(hr[k]) * t; }
        s /= sqrt(128.0); double got; if (m < TL) got = bfd(((const bf16*)(ws + WS_YT))[((size_t)(m >> 11) * 512 + ch) * 4096 + cs * 2048 + (m & 2047)]); else got = bfd(((const bf16*)(ws + WS_YTC))[((size_t)((m - TL) >> 8) * 512 + ch) * 512 + cs * 256 + ((m - TL) & 255)]);
        rec(res, rs, got, s, 0.05); }
    else if (stage == ST_QKFIX) { const int m = samp_row(i, TALL, 4), isk = i & 1, hh = isk ? (int)(hsh(i + 3) % 2u) : (int)(hsh(i + 3) % 8u), d = (int)(hsh(i + 4) % 128u); const bf16* hr = H + (size_t)m * DM;
        if (isk || l == 0 || m < TL) { const int cbase = isk ? 1024 + hh * 128 : hh * 128; double ss = 0, xd = 0, xp = 0; const int half = d & 64, dd = d & 63, pd = half + ((dd + 32) & 63);
            for (int q = 0; q < 128; ++q) { double v = dot_h_w(hr, win, INCOLS, cbase + q); v = bfd((bf16)f2bf((float)v)); ss += v * v; if (q == d) xd = v; if (q == pd) xp = v; }
            const float* gn = (isk ? A.in[12] : A.in[11]) + l * 128; const double r = 1.0 / sqrt(ss / 128 + 1e-6); xd *= r * gn[d]; xp *= r * gn[pd]; double want = xd;
            if (m < TL) { const int t = m & 2047, pos = half ? (t & 63) : (t >> 6), f = dd & 31; const double ang = (double)((float)pos * powf(10000.0f, -(float)f / 32.0f)); want = (dd < 32) ? xd * cos(ang) - xp * sin(ang) : xd * cos(ang) + xp * sin(ang); }
            const double got = isk ? bfd(((const bf16*)(ws + WS_K))[(size_t)krow_of(m) * 256 + hh * 128 + d]) : bfd(((const bf16*)(ws + WS_Q))[(size_t)m * DM + hh * 128 + d]); rec(res, rs, got, want, 0.05); } }
    else if (stage == ST_CONV) { const int m = samp_row(i, M, 5), c = (int)(hsh(i + 11) % 512u); const int rowbase = m < TL ? (m >> 11) * SEQ : TL + ((m - TL) >> 8) * CTXL, L = m < TL ? SEQ : CTXL, t = m - rowbase; const bf16* cu = (const bf16*)(ws + WS_CU);
        double s1 = 0, s2 = 0, yc = 0; for (int cc = 0; cc < 512; ++cc) { double y = A.in[15][l * 512 + cc]; for (int j = 0; j < 31; ++j) { const int p = t + j - 15; if (p >= 0 && p < L) y += bfd(cu[(size_t)(rowbase + p) * 512 + cc]) * (double)A.in[14][((size_t)l * 31 + j) * 512 + cc]; } s1 += y; s2 += y * y; if (cc == c) yc = y; }
        const double mean = s1 / 512, var = s2 / 512 - mean * mean; double y = (yc - mean) / sqrt(var + 1e-6) * A.in[16][l * 512 + c] + A.in[17][l * 512 + c]; y = y * dsig(y); rec(res, rs, bfd(((const bf16*)(ws + WS_CH))[(size_t)m * 512 + c]), y, 0.05); }
    else if (stage == ST_Z) { const int m = samp_row(i, M, 6), ch = (int)(hsh(i + 12) % 512u); double s = 0;
        if (m < TL) { const int b = m >> 11, k1 = m & 2047; const bf16* yr = (const bf16*)(ws + WS_YT) + ((size_t)b * 512 + ch) * 4096; for (int n1 = 0; n1 < 2048; ++n1) { const double ang = 2.0 * PI_D * ((k1 * n1) & 2047) / 2048.0; s += cos(ang) * bfd(yr[n1]) - sin(ang) * bfd(yr[2048 + n1]); } s /= sqrt(2048.0); }
        else { const int b = (m - TL) >> 8, k1 = (m - TL) & 255; const bf16* yr = (const bf16*)(ws + WS_YTC) + ((size_t)b * 512 + ch) * 512; for (int n1 = 0; n1 < 256; ++n1) { const double ang = 2.0 * PI_D * ((k1 * n1) & 255) / 256.0; s += cos(ang) * bfd(yr[n1]) - sin(ang) * bfd(yr[256 + n1]); } s /= 16.0; }
        rec(res, rs, bfd(((const bf16*)(ws + WS_Z))[(size_t)m * 512 + ch]), s, 0.05); }
    else if (stage == ST_ATTN) { const int m = samp_row(i, M, 7), hh = (int)(hsh(i + 13) % 8u), d = (int)(hsh(i + 14) % 128u); const bf16* q = (const bf16*)(ws + WS_Q) + (size_t)m * DM + hh * 128;
        int kr0, nk; if (m < TL) { kr0 = (m >> 11) * KVROWS; nk = KVROWS; } else { kr0 = ((m - TL) >> 8) * KVROWS + SEQ; nk = CTXL; }
        const bf16* K = (const bf16*)(ws + WS_K) + (size_t)kr0 * 256 + (hh >> 2) * 128; const bf16* V = (const bf16*)(ws + WS_V) + (size_t)kr0 * 256 + (hh >> 2) * 128;
        double mx = -1e300; for (int j = 0; j < nk; ++j) { double s = 0; for (int q2 = 0; q2 < 128; ++q2) s += bfd(q[q2]) * bfd(K[(size_t)j * 256 + q2]); s *= 0.08838834764831845; if (s > mx) mx = s; }
        double den = 0, num = 0; for (int j = 0; j < nk; ++j) { double s = 0; for (int q2 = 0; q2 < 128; ++q2) s += bfd(q[q2]) * bfd(K[(size_t)j * 256 + q2]); s *= 0.08838834764831845; const double p = exp(s - mx); den += p; num += p * bfd(V[(size_t)j * 256 + d]); }
        rec(res, rs, bfd(((const bf16*)(ws + WS_AO))[(size_t)m * DM + hh * 128 + d]), num / den, 0.03); }
    else if (stage == ST_GATES) { const int m = samp_row(i, M, 8), n = (int)(hsh(i + 15) % 3072u); rec(res, rs, bfd(((const bf16*)(ws + WS_GATES))[(size_t)m * 3072 + n]), dsig(dot_h_w(H + (size_t)m * DM, win, INCOLS, OFF_GATE + n)), 0.05); }
    else if (stage == ST_GATESB && DBG_GSUB == 1) { const int m = samp_row(i, M, 8), n = (int)(hsh(i + 15) % 3072u); const double got = bfd(((const bf16*)(ws + WS_GATES))[(size_t)m * 3072 + n]), want = dsig(dot_h_w(H + (size_t)m * DM, win, INCOLS, OFF_GATE + n));
        const bool badv = !(fabs(got - want) <= 0.05); if (badv) { unsigned* r = (unsigned*)res + 48; atomicOr(r, (m < TL ? 1u : 2u) | (4u << (n >> 10)) | (i < 12 ? 32u : 0u)); } }
    else if (stage == ST_GATESB) { const int m = samp_row(i, M, 8), n = (int)(hsh(i + 15) % 3072u); const bf16* wt = (const bf16*)(ws + WS_WSMALL + (size_t)l * WSMALL_LAYER + OFFS_WG) + (size_t)n * 1024; const bf16* hr = H + (size_t)m * DM; double s = 0; for (int k = 0; k < 1024; ++k) s += bfd(hr[k]) * bfd(wt[k]);
        rec(res, rs, bfd(((const bf16*)(ws + WS_GATES))[(size_t)m * 3072 + n]), dsig(s), 0.05); }
    else if (stage == ST_MERGED) { const int m = samp_row(i, M, 9), c = (int)(hsh(i + 16) % 1024u); const bf16* g = (const bf16*)(ws + WS_GATES) + (size_t)m * 3072; double y0 = 0, y1 = 0, y2 = 0;
        const bf16* ao = (const bf16*)(ws + WS_AO) + (size_t)m * DM; const bf16* chh = (const bf16*)(ws + WS_CH) + (size_t)m * 512; const bf16* z = (const bf16*)(ws + WS_Z) + (size_t)m * 512;
        for (int k = 0; k < 1024; ++k) y0 += bfd(ao[k]) * (double)A.in[13][((size_t)l * 1024 + k) * 1024 + c];
        for (int k = 0; k < 512; ++k) { y1 += bfd(chh[k]) * (double)A.in[18][((size_t)l * 512 + k) * 1024 + c]; y2 += bfd(z[k]) * (double)A.in[19][((size_t)l * 512 + k) * 1024 + c]; }
        rec(res, rs, bfd(((const bf16*)(ws + WS_MERGED))[(size_t)m * DM + c]), bfd(g[c]) * y0 + bfd(g[1024 + c]) * y1 + bfd(g[2048 + c]) * y2, 0.05); }
    else if (stage == ST_MIX) { const int m = samp_row(i, M, 10), c = (int)(hsh(i + 17) % 1024u); rec(res, rs, bfd(((const bf16*)(ws + WS_MIX))[(size_t)m * DM + c]), dot_h_w((const bf16*)(ws + WS_MERGED) + (size_t)m * DM, A.in[20] + (size_t)l * DM * DM, DM, c), 0.05); }
    else if (stage == ST_ROW1) { const int m = samp_row(i, M, 11), c = (int)(hsh(i + 18) % 1024u); const float* xs = snap + (size_t)i * 1024;
        const bf16* mix = (const bf16*)(ws + WS_MIX) + (size_t)m * DM; const float* mv = modb + ((size_t)l * 17 + (m < TL ? (m >> 11) : 16)) * 6144; double ss = 0; for (int k = 0; k < 1024; ++k) ss += bfd(mix[k]) * bfd(mix[k]); const double r = 1.0 / sqrt(ss / 1024 + 1e-6);
        double s2 = 0, xc = 0; for (int k = 0; k < 1024; ++k) { const double xn = xs[k] + mv[2048 + k] * (bfd(mix[k]) * r * A.in[7][l * DM + k]); s2 += xn * xn; if (k == c) xc = xn; }
        const float* xd = m < TL ? A.out + (size_t)m * DM : (const float*)(ws + WS_XC) + (size_t)(m - TL) * DM; rec(res, rs, xd[c], xc, 0.02);
        rec(res, rs, bfd(H[(size_t)m * DM + c]), xc / sqrt(s2 / 1024 + 1e-6) * A.in[8][l * DM + c] * (1.0 + mv[4096 + c]) + mv[3072 + c], 0.05); }
    else if (stage == ST_LOGIT) { const int m = samp_row(i, M, 12), e = i & 31; const float* lg = (const float*)(ws + WS_LOGIT) + (size_t)m * 64; rec(res, rs, (double)lg[e] + lg[32 + e], dot_h_w(H + (size_t)m * DM, A.in[21] + (size_t)l * DM * NEXP, NEXP, e), 0.02); }
    else if (stage == ST_TOPK) { const int m = samp_row(i, M, 13); const float* lg = (const float*)(ws + WS_LOGIT) + (size_t)m * 64; float v[32]; for (int e = 0; e < 32; ++e) v[e] = lg[e] + lg[32 + e] + A.in[22][l * 32 + e];
        int id[4]; float tv[4]; for (int k = 0; k < 4; ++k) { int b = -1; for (int e = 0; e < 32; ++e) { bool used = false; for (int q = 0; q < k; ++q) used |= (id[q] == e); if (!used && (b < 0 || v[e] > v[b])) b = e; } id[k] = b; tv[k] = v[b]; }
        double den = 0; for (int k = 0; k < 4; ++k) den += exp((double)tv[k] - tv[0]); const int* gi = (const int*)(ws + WS_TOPI) + (size_t)m * 4; const float* gp = (const float*)(ws + WS_TOPP) + (size_t)m * 4;
        for (int k = 0; k < 4; ++k) { rec(res, rs, gi[k] == id[k] ? 0.0 : 1.0, 0, 0.01); rec(res, rs, gp[k], exp((double)tv[k] - tv[0]) / den, 0.01); } }
    else if (stage == ST_SLOTS) { const int m = samp_row(i, M, 14), k = i & 3; const int s = ((const int*)(ws + WS_SLOT))[(size_t)m * 4 + k], e = ((const int*)(ws + WS_TOPI))[(size_t)m * 4 + k]; const int NT = ((const int*)(ws + WS_CNT))[CNT_NT];
        if (s < 0 || s >= NT * 256) rec(res, rs, 1, 0, 0.01); else { rec(res, rs, ((const int*)(ws + WS_CNT))[CNT_TILE_E + (s >> 8)] == e ? 0.0 : 1.0, 0, 0.01); const bf16* hs = (const bf16*)(ws + WS_HS) + (size_t)s * DM; double df = 0; for (int q = 0; q < 1024; ++q) df += fabs(bfd(hs[q]) - bfd(H[(size_t)m * DM + q])); rec(res, rs, df, 0, 1e-3); } }
    else if (stage == ST_ACT) { const int m = samp_row(i, M, 15), k = i & 3, c = (int)(hsh(i + 21) % 1024u); const int s = ((const int*)(ws + WS_SLOT))[(size_t)m * 4 + k], e = ((const int*)(ws + WS_TOPI))[(size_t)m * 4 + k]; const bf16* hs = (const bf16*)(ws + WS_HS) + (size_t)s * DM;
        double g = dot_h_w(hs, A.in[23] + (((size_t)l * NEXP + e) << 20), DM, c) + A.in[24][((size_t)l * NEXP + e) * 1024 + c], u = dot_h_w(hs, A.in[25] + (((size_t)l * NEXP + e) << 20), DM, c) + A.in[26][((size_t)l * NEXP + e) * 1024 + c];
        g = g < 7.0 ? g : 7.0; u = u < -7.0 ? -7.0 : (u > 7.0 ? 7.0 : u); rec(res, rs, bfd(((const bf16*)(ws + WS_ACT))[(size_t)s * DM + c]), (u + 1.0) * (g * dsig(1.702 * g)), 0.05); }
    else if (stage == ST_YSLOT) { const int m = samp_row(i, M, 16), k = i & 3, c = (int)(hsh(i + 22) % 1024u); const int s = ((const int*)(ws + WS_SLOT))[(size_t)m * 4 + k], e = ((const int*)(ws + WS_TOPI))[(size_t)m * 4 + k];
        rec(res, rs, bfd(((const bf16*)(ws + WS_HS))[(size_t)s * DM + c]), dot_h_w((const bf16*)(ws + WS_ACT) + (size_t)s * DM, A.in[27] + (((size_t)l * NEXP + e) << 20), DM, c) + A.in[28][((size_t)l * NEXP + e) * 1024 + c], 0.05); }
    else if (stage == ST_COMB) { const int m = samp_row(i, M, 17), c = (int)(hsh(i + 23) % 1024u); const float* xs = snap + (size_t)i * 1024; const int* sl = (const int*)(ws + WS_SLOT) + (size_t)m * 4; const float* pr = (const float*)(ws + WS_TOPP) + (size_t)m * 4;
        const float* mv = modb + ((size_t)l * 17 + (m < TL ? (m >> 11) : 16)) * 6144; double ss = 0, yc = 0; for (int q = 0; q < 1024; ++q) { double y = 0; for (int k = 0; k < 4; ++k) y += (double)pr[k] * bfd(((const bf16*)(ws + WS_HS))[(size_t)sl[k] * DM + q]); ss += y * y; if (q == c) yc = y; }
        const double want = xs[c] + mv[5 * 1024 + c] * (yc / sqrt(ss / 1024 + 1e-6) * A.in[9][l * DM + c]); const float* xd = m < TL ? A.out + (size_t)m * DM : (const float*)(ws + WS_XC) + (size_t)(m - TL) * DM; rec(res, rs, xd[c], want, 0.02); }
}
__global__ void snap_rows(Args A, int l, int salt, float* snap) {
    const int i = blockIdx.x, M = (l == 0) ? TALL : TL, m = samp_row(i, M, salt); const float* xs;
    if (l == 0 && salt == 11) xs = m < TL ? A.in[0] + (size_t)m * DM : A.in[2] + (size_t)(m - TL) * DM; else xs = m < TL ? A.out + (size_t)m * DM : (const float*)(A.ws + WS_XC) + (size_t)(m - TL) * DM;
    for (int k = threadIdx.x; k < 1024; k += blockDim.x) snap[(size_t)i * 1024 + k] = xs[k];
}
__global__ void chk_gates_full(const bf16* H, const bf16* Wt, const bf16* G, int M, unsigned* cntw) {
    const int n = blockIdx.x * 64 + (threadIdx.x & 63), m = blockIdx.y * 4 + (threadIdx.x >> 6); if (m >= M) return;
    const uint4* a = (const uint4*)(H + (size_t)m * 1024); const uint4* b = (const uint4*)(Wt + (size_t)n * 1024); float s = 0.f;
    for (int k = 0; k < 128; ++k) { const uint4 x = a[k], y = b[k]; const unsigned xs[4] = {x.x, x.y, x.z, x.w}, ys[4] = {y.x, y.y, y.z, y.w};
        for (int q = 0; q < 4; ++q) { s += __uint_as_float(xs[q] << 16) * __uint_as_float(ys[q] << 16); s += __uint_as_float(xs[q] & 0xffff0000u) * __uint_as_float(ys[q] & 0xffff0000u); } }
    const float want = 1.0f / (1.0f + __expf(-s)), got = __uint_as_float(((unsigned)G[(size_t)m * 3072 + n]) << 16);
    if (!(fabsf(got - want) <= 0.02f)) { atomicAdd(cntw, 1u); cntw[16 + (m >> 8) * 12 + (n >> 8)] = 1u; }
}
__global__ void encode_full(float* out, const unsigned* cntw, int n) {
    __shared__ int bc, bt; if (threadIdx.x == 0) { unsigned C = cntw[0], T = 0; for (int t = 0; t < 1728; ++t) T += cntw[16 + t]; int b1 = 0; while (C) { ++b1; C /= 10; } int b2 = 0; while (T) { ++b2; T /= 4; } bc = b1 > 7 ? 7 : b1; bt = b2 > 7 ? 7 : b2; }
    __syncthreads(); const float K = ldexpf(1.0f, 2 + 8 * bt + bc);
    for (size_t i = (size_t)blockIdx.x * blockDim.x + threadIdx.x; i < (size_t)n; i += (size_t)gridDim.x * blockDim.x) out[i] = K;
}
__global__ void encode(float* out, const float* res, int n, float thr) {
    #if DBG_GSUB == 1
    { const unsigned mk = ((const unsigned*)res)[48]; const float K = ldexpf(1.0f, 2 + (int)mk); for (size_t i = (size_t)blockIdx.x * blockDim.x + threadIdx.x; i < (size_t)n; i += (size_t)gridDim.x * blockDim.x) out[i] = K; return; }
#endif
#ifndef CHK_SKIP
#define CHK_SKIP 0ull
#endif
    int bad = -1; for (int s = 0; s < 64; ++s) if (!((CHK_SKIP >> s) & 1ull) && res[s] > thr) { bad = s; break; }
    if (bad < 0) return; const float er = res[bad]; const float K = ldexpf(1.0f, bad + 2) * (er < 0.5f ? 1.0f : er < 1.0f ? 1.25f : er < 4.0f ? 1.5f : 1.75f);
    for (size_t i = (size_t)blockIdx.x * blockDim.x + threadIdx.x; i < (size_t)n; i += (size_t)gridDim.x * blockDim.x) out[i] = K;
}
#endif
#ifndef GP_SP2
#define GP_SP2 true
#endif
#ifndef GP_ALIGN
#define GP_ALIGN true
#endif
__global__ void __launch_bounds__(NTHR, 2) fwd(Args args) {
    extern __shared__ __attribute__((aligned(16))) unsigned char lds[];
    Frame F;
    F.lds = (LAS unsigned char*)lds; F.MISC = (volatile LAS unsigned*)(F.lds + MISC_OFF);
    F.tid = threadIdx.x; F.lane = F.tid & 63; F.wave = __builtin_amdgcn_readfirstlane(F.tid >> 6);
    F.G = gridDim.x; { const int bx = blockIdx.x; F.vcu = (F.G % 8 == 0) ? (bx % 8) * (F.G / 8) + bx / 8 : bx; }
    { const AV A0 = av_get(); F.ctl = (gu32*)(A0.ws() + WS_CTL); }
    for (int u = F.tid; u < (LDS_BYTES - LDSCTL_OFF) / 4; u += NTHR) ((LAS unsigned*)(F.lds + LDSCTL_OFF))[u] = 0u;
    __syncthreads();
    XcdBarrier bar; bar.bar = (unsigned*)(F.ctl + CW_BAR); bar.x = 0; bar.st = nullptr;
    if (!MK_PER_PHASE) bar = xcd_barrier_post((unsigned*)(F.ctl + CW_BAR), F.MISC + 8);
    int lo, hi; { const AV A0 = av_get(); lo = *(const int __attribute__((address_space(4)))*)(A0.kp + 8 * 31); hi = *(const int __attribute__((address_space(4)))*)(A0.kp + 8 * 31 + 4); }
#ifndef DIS_MASK
#define DIS_MASK 0ull
#endif
#define IN(k) (lo <= (k) && (k) < hi)
#define ON(j) (!((DIS_MASK >> (j)) & 1ull))
#ifndef REP_MASK
#define REP_MASK 0ull
#endif
#define REPS(j) ((int)((REP_MASK >> (j)) & 1ull))
#ifdef STAMP_SEL
#define SEAM(k) do { xcd_barrier(bar); if (blockIdx.x == 0 && threadIdx.x == 0) ((unsigned long long*)(F.ctl + 32768))[(k) + 1] = __builtin_amdgcn_s_memrealtime(); } while (0)
#else
#ifdef DOUBLE_BAR
#define SEAM(k) do { if (!MK_PER_PHASE && IN((k) + 1)) { xcd_barrier(bar); xcd_barrier(bar); } } while (0)
#else
#define SEAM(k) do { if (!MK_PER_PHASE && IN((k) + 1)) xcd_barrier(bar); } while (0)
#endif
#endif
    const int bx = (int)blockIdx.x;
    const int wave0 = __builtin_amdgcn_readfirstlane((int)threadIdx.x >> 6);
#define F_REFRESH() do { unsigned z_ = 0u; asm volatile("" : "+v"(z_)); const int t_ = wave0 * 64 + (int)__builtin_amdgcn_mbcnt_hi(~0u, __builtin_amdgcn_mbcnt_lo(~0u, z_)); F.tid = t_; F.lane = t_ & 63; F.wave = wave0; } while (0)

#ifdef STAMP_SEL
    if (blockIdx.x == 0 && threadIdx.x == 0) ((unsigned long long*)(F.ctl + 32768))[0] = __builtin_amdgcn_s_memrealtime();
#endif
    if (ON(0) && IN(0)) for (int rep_ = 0; rep_ <= REPS(0); ++rep_) { F_REFRESH(); const AV A = av_get(); p0_prologue(F, A); SEAM(0); }
    if (ON(1) && IN(1)) for (int rep_ = 0; rep_ <= REPS(1); ++rep_) { F_REFRESH(); const AV A = av_get(); p1_norm0(F, A); SEAM(1); }

    for (int l = 0; l < 2; ++l) {
        const int pb = 2 + l * NPL;
        const int Mm = (l == 0) ? TALL : TL;
#define PH_BEGIN F_REFRESH(); const AV A = av_get(); unsigned char* const ws = A.ws(); unsigned char* const wl = ws + WS_WSMALL + (size_t)l * WSMALL_LAYER; (void)wl
        if (ON(2 + 0) && IN(pb + 0)) for (int rep_ = 0; rep_ <= REPS(2 + 0); ++rep_) { PH_BEGIN;
            if (ON(16)) { pg8::Gemm g{(const bf16*)(ws + WS_H8), (const bf16*)(wl + OFFS_WIN), TALL, 2560, DM / 2}; pg8::StaticOrder S; S.init(TALL, 2560, F.G, bx);
              pg8::EpiInproj E{(bf16*)(ws + WS_Q), (bf16*)(ws + WS_K), (bf16*)(ws + WS_V), (bf16*)(ws + WS_CU)};
              pg8::gemm_phase<pg8::EpiInproj, pg8::StaticOrder, GP_ALIGN, GP_SP2, true>(F.lds + RING_OFF, g, S, E, F.tid); }
            if (ON(17)) { pg8::Gemm g{(const bf16*)(wl + OFFS_WF), (const bf16*)(ws + WS_H), 1024, Mm, DM}; pg8::StaticOrder S; S.init(1024, Mm, F.G, (bx + 96) % F.G);
              pg8::EpiYT E{ws + WS_YT, ws + WS_YTC};
              pg8::gemm_phase<pg8::EpiYT, pg8::StaticOrder, GP_ALIGN, GP_SP2>(F.lds + RING_OFF, g, S, E, F.tid); }
            SEAM(pb + 0);
        }
        if (ON(2 + 1) && IN(pb + 1)) for (int rep_ = 0; rep_ <= REPS(2 + 1); ++rep_) { PH_BEGIN;
            if (ON(18)) p_qkfix(F, A, l, TALL);
            F_REFRESH();
            if (ON(19)) p_conv(F, A, l, l == 0 ? 1152 : 1024);
            if (ON(20)) { pg8::Gemm g{(const bf16*)(ws + WS_DFTL), (const bf16*)(ws + WS_YT), 2048, NB * 512, 2048}; pg8::DftOrder S; S.init(3, NB, F.G, F.vcu);
              pg8::EpiDFT E{(bf16*)(ws + WS_Z), 0, SEQ};
              pg8::gemm_phase<pg8::EpiDFT, pg8::DftOrder, GP_ALIGN, GP_SP2, true>(F.lds + RING_OFF, g, S, E, F.tid); }
            if (ON(21) && l == 0) { pg8::Gemm g{(const bf16*)(ws + WS_DFTC), (const bf16*)(ws + WS_YTC), 256, NB * 512, 256}; pg8::DftOrder S; S.init(0, NB, F.G, F.vcu);
              pg8::EpiDFT E{(bf16*)(ws + WS_Z), TL, CTXL};
              pg8::gemm_phase<pg8::EpiDFT, pg8::DftOrder, GP_ALIGN, GP_SP2, true>(F.lds + RING_OFF, g, S, E, F.tid); }
            SEAM(pb + 1);
        }
        if (ON(2 + 2) && IN(pb + 2)) for (int rep_ = 0; rep_ <= REPS(2 + 2); ++rep_) { PH_BEGIN;
            const int nheavy = NB * 8 * 8, ntot = nheavy + (l == 0 ? NB * 8 : 0);
            for (int L = F.vcu; L < ntot; L += F.G) {
                int row0, krow, h, seq, t0;
                if (L < nheavy) { const int grp = L >> 5, s = L & 31, b = grp >> 1; h = (grp & 1) * 4 + (s >> 3); t0 = (s & 7) * 256; row0 = b * SEQ + t0; krow = b * KVROWS; seq = KVROWS; }
                else { const int Lc = L - nheavy, b = Lc >> 3; h = Lc & 7; row0 = TL + b * CTXL; krow = b * KVROWS + SEQ; seq = CTXL; t0 = 0; }
                const att::bf16* Qb = (const att::bf16*)(ws + WS_Q) + (size_t)row0 * DM + h * 128;
                const att::bf16* Kh = (const att::bf16*)(ws + WS_K) + (size_t)krow * 256 + (h >> 2) * 128;
                const att::bf16* Vh = (const att::bf16*)(ws + WS_V) + (size_t)krow * 256 + (h >> 2) * 128;
                unsigned char* Ob = ws + WS_AO + (size_t)row0 * DM + h * 128;
                att::attn_dense_body<att::bf16>(Qb, Kh, Vh, Ob, seq, (char*)lds + RING_OFF, F.tid, A.in(11) + l * 128, (const float*)(ws + WS_TAB), t0, L < nheavy);
                __syncthreads();
            }
            SEAM(pb + 2);
        }
        if (ON(2 + 3) && IN(pb + 3)) for (int rep_ = 0; rep_ <= REPS(2 + 3); ++rep_) { PH_BEGIN;
            pg8::Gemm g{(const bf16*)(ws + WS_H8), (const bf16*)(wl + OFFS_WG), Mm, 3072, DM / 2}; pg8::StaticOrder S; S.init(Mm, 3072, F.G, bx);
            pg8::EpiGates E{(bf16*)(ws + WS_GATES)};
            pg8::gemm_phase<pg8::EpiGates, pg8::StaticOrder, GP_ALIGN, GP_SP2, true>(F.lds + RING_OFF, g, S, E, F.tid);
            SEAM(pb + 3);
        }
        if (ON(2 + 4) && IN(pb + 4)) for (int rep_ = 0; rep_ <= REPS(2 + 4); ++rep_) { PH_BEGIN;
            { pg8::Gemm g{(const bf16*)(ws + WS_AO), (const bf16*)(wl + OFFS_WAO), Mm, 1024, 512}; pg8::StaticOrder S; S.init(Mm, 1024, F.G, bx);
              pg8::EpiMerge<0> E{(bf16*)(ws + WS_MERGED), (bf16*)(ws + WS_ACT), (const bf16*)(ws + WS_GATES), 0, 1.0f / 512.0f};
              pg8::gemm_phase<pg8::EpiMerge<0>, pg8::StaticOrder, GP_ALIGN, GP_SP2, true>(F.lds + RING_OFF, g, S, E, F.tid); }
            { pg8::Gemm g{(const bf16*)(ws + WS_CH), (const bf16*)(wl + OFFS_WCO), Mm, 1024, 512}; pg8::StaticOrder S; S.init(Mm, 1024, F.G, bx);
              pg8::EpiMerge<1> E{(bf16*)(ws + WS_MERGED), (bf16*)(ws + WS_ACT), (const bf16*)(ws + WS_GATES), 1, 1.0f};
              pg8::gemm_phase<pg8::EpiMerge<1>, pg8::StaticOrder, GP_ALIGN, GP_SP2>(F.lds + RING_OFF, g, S, E, F.tid); }
            { pg8::Gemm g{(const bf16*)(ws + WS_Z), (const bf16*)(wl + OFFS_WFO), Mm, 1024, 512}; pg8::StaticOrder S; S.init(Mm, 1024, F.G, bx);
              pg8::EpiMerge<2> E{(bf16*)(ws + WS_MERGED), (bf16*)(ws + WS_ACT), (const bf16*)(ws + WS_GATES), 2, 1.0f};
              pg8::gemm_phase<pg8::EpiMerge<2>, pg8::StaticOrder, GP_ALIGN, GP_SP2>(F.lds + RING_OFF, g, S, E, F.tid); }
            if (l == 0 && F.G == 256 && bx >= FILL_WG0 && rep_ == 0) { __syncthreads(); F_REFRESH();
                moe_convert_range(A, 0, FILL_A, (bx - FILL_WG0) * NWAVES + F.wave, FILL_NGW, (LAS float*)(F.lds + RING_OFF + F.wave * 16384), F.lane); }
            SEAM(pb + 4);
        }
        if (ON(2 + 5) && IN(pb + 5)) for (int rep_ = 0; rep_ <= REPS(2 + 5); ++rep_) { PH_BEGIN;
            pg8::Gemm g{(const bf16*)(ws + WS_MERGED), (const bf16*)(wl + OFFS_WOUT), Mm, 1024, 1024}; pg8::StaticOrder S; S.init(Mm, 1024, F.G, bx);
            pg8::EpiBf16<0> E{(bf16*)(ws + WS_MIX), 1024, nullptr, 0, 0, 1.0f};
            pg8::gemm_phase<pg8::EpiBf16<0>, pg8::StaticOrder, GP_ALIGN, GP_SP2>(F.lds + RING_OFF, g, S, E, F.tid);
            if (l == 0 && F.G == 256 && bx >= FILL_WG0 && rep_ == 0) { __syncthreads(); F_REFRESH();
                moe_convert_range(A, FILL_A, FILL_B, (bx - FILL_WG0) * NWAVES + F.wave, FILL_NGW, (LAS float*)(F.lds + RING_OFF + F.wave * 16384), F.lane); }
            SEAM(pb + 5);
        }
        if (ON(2 + 6) && IN(pb + 6)) for (int rep_ = 0; rep_ <= REPS(2 + 6); ++rep_) { PH_BEGIN; p_rowpass1(F, A, l, Mm); p_route(F, A, l, Mm); SEAM(pb + 6); }
        if (ON(2 + 7) && IN(pb + 7)) for (int rep_ = 0; rep_ <= REPS(2 + 7); ++rep_) { PH_BEGIN; p_slots(F, A, Mm); SEAM(pb + 7); }
        if (ON(2 + 8) && IN(pb + 8)) for (int rep_ = 0; rep_ <= REPS(2 + 8); ++rep_) { PH_BEGIN;
            const int NT = __builtin_amdgcn_readfirstlane(((const int*)(ws + WS_CNT))[CNT_NT]);
            LAS int* te_lds = (LAS int*)(F.lds + LDS_SM);
            for (int i = F.tid; i < NT; i += NTHR) te_lds[i] = ((const int*)(ws + WS_CNT))[CNT_TILE_E + i];
            __syncthreads();
            pg8::Gemm g{(const bf16*)(ws + WS_H8), (const bf16*)(ws + WS_WGU + (size_t)l * MOEW_LAYER), NT * 256, NEXP * 2048, DM / 2}; pg8::GroupedOrder S; S.init(NT, 8, F.G, bx, te_lds); S.rows = (const int*)(ws + WS_CNT) + CNT_ROWSRC;
            pg8::EpiSwiGLU8 E{ws + WS_ACT, A.in(24) + (size_t)l * NEXP * 1024, A.in(26) + (size_t)l * NEXP * 1024, (LAS float*)(F.lds + LDS_SM + 4096)};
            pg8::gemm_phase<pg8::EpiSwiGLU8, pg8::GroupedOrder, GP_ALIGN, GP_SP2, true, true>(F.lds + RING_OFF, g, S, E, F.tid);
            SEAM(pb + 8);
        }
        if (ON(2 + 9) && IN(pb + 9)) for (int rep_ = 0; rep_ <= REPS(2 + 9); ++rep_) { PH_BEGIN;
            const int NT = __builtin_amdgcn_readfirstlane(((const int*)(ws + WS_CNT))[CNT_NT]);
            LAS int* te_lds = (LAS int*)(F.lds + LDS_SM);
            for (int i = F.tid; i < NT; i += NTHR) te_lds[i] = ((const int*)(ws + WS_CNT))[CNT_TILE_E + i];
            __syncthreads();
#ifdef STAGGER_US
            { const unsigned long long t0 = __builtin_amdgcn_s_memrealtime(), dl = (unsigned long long)((bx >> 3) & 3) * (STAGGER_US); while (__builtin_amdgcn_s_memrealtime() - t0 < dl) __builtin_amdgcn_s_sleep(8); }
#endif
            pg8::Gemm g{(const bf16*)(ws + WS_ACT), (const bf16*)(ws + WS_WD + (size_t)l * MOEW_LAYER), NT * 256, NEXP * 1024, DM / 2}; pg8::GroupedOrder S; S.init(NT, 4, F.G, bx, te_lds);
#ifdef PROBE_NOSTORE
            pg8::EpiDown8 E{ws + WS_YS, A.in(28) + (size_t)l * NEXP * 1024, rep_, (LAS float*)(F.lds + LDS_SM + 4096)};
#else
            pg8::EpiDown8 E{ws + WS_YS, A.in(28) + (size_t)l * NEXP * 1024, 0, (LAS float*)(F.lds + LDS_SM + 4096)};
#endif
            pg8::gemm_phase<pg8::EpiDown8, pg8::GroupedOrder, GP_ALIGN, GP_SP2, true>(F.lds + RING_OFF, g, S, E, F.tid);
            SEAM(pb + 9);
        }
        if (ON(2 + 10) && IN(pb + 10)) for (int rep_ = 0; rep_ <= REPS(2 + 10); ++rep_) { PH_BEGIN;
            p_combine(F, A, l, Mm);
            SEAM(pb + 10);
        }
    }
#ifdef STAMP_SEL
    { const AV A = av_get(); float* out = A.out(); const unsigned long long* ts = (const unsigned long long*)(F.ctl + 32768);
      auto span = [&](int p) -> float { unsigned long long d = __hip_atomic_load(ts + p + 1, __ATOMIC_RELAXED, __HIP_MEMORY_SCOPE_AGENT) - __hip_atomic_load(ts + p, __ATOMIC_RELAXED, __HIP_MEMORY_SCOPE_AGENT);
          if (p >= 2) d += __hip_atomic_load(ts + p + NPL + 1, __ATOMIC_RELAXED, __HIP_MEMORY_SCOPE_AGENT) - __hip_atomic_load(ts + p + NPL, __ATOMIC_RELAXED, __HIP_MEMORY_SCOPE_AGENT); return (float)d * 0.01f; };
      const float K1 = span((STAMP_SEL) & 0xff), K2 = 200.0f * span(((STAMP_SEL) >> 8) & 0xff);
      for (size_t i = (size_t)blockIdx.x * NTHR + threadIdx.x; i < (size_t)TL * DM; i += (size_t)gridDim.x * NTHR) out[i] = (i == 0) ? K2 : K1; }
#endif
#undef IN
#undef PH_BEGIN
#undef F_REFRESH
#undef SEAM
}

extern "C" void kernel_launch(void* const* d_in, const int* in_sizes, int n_in, void* d_out, int out_size, void* d_ws, size_t ws_size, hipStream_t stream) {
    static int grid = 0;
    if (grid == 0) {
        if (n_in != 29 || out_size != TL * DM || ws_size < WS_END2) { fprintf(stderr, "kernel_launch: built for 29 inputs, %d outputs, >= %zu bytes of workspace; got n_in %d out %d ws %zu\n", TL * DM, (size_t)WS_END2, n_in, out_size, ws_size); grid = -1; return; }
        int dev = 0, cus = 0, per_cu = 0;
        if (hipGetDevice(&dev) != hipSuccess || hipDeviceGetAttribute(&cus, hipDeviceAttributeMultiprocessorCount, dev) != hipSuccess) { grid = -1; return; }
        if (hipFuncSetAttribute((const void*)fwd, hipFuncAttributeMaxDynamicSharedMemorySize, LDS_BYTES) != hipSuccess) { fprintf(stderr, "kernel_launch: hipFuncSetAttribute failed\n"); grid = -1; return; }
        if (hipOccupancyMaxActiveBlocksPerMultiprocessor(&per_cu, (const void*)fwd, NTHR, LDS_BYTES) != hipSuccess || per_cu < 1) fprintf(stderr, "kernel_launch: occupancy query reports %d\n", per_cu);
        (void)hipGetLastError();
        grid = cus;
    }
    if (grid < 0) return;
    (void)hipMemsetAsync((char*)d_ws + WS_CTL, 0, CTL_ZERO_BYTES, stream);
    Args a{};
    for (int i = 0; i < 29; ++i) a.in[i] = (const float*)d_in[i];
    a.out = (float*)d_out; a.ws = (unsigned char*)d_ws;
#if MK_PER_PHASE
    for (int p = 0; p < NPH; ++p) {
#ifdef DBG_CHECK
        float* res = (float*)((char*)d_ws + WS_CTL + 8192 * 4); float* snap = (float*)((char*)d_ws + WS_END);
        { const int l = p >= 2 ? (p - 2) / NPL : 0, k = p >= 2 ? (p - 2) % NPL : -1;
          if (k == 6) hipLaunchKernelGGL(snap_rows, dim3(256), dim3(256), 0, stream, a, l, 11, snap);
          if (k == 12) hipLaunchKernelGGL(snap_rows, dim3(256), dim3(256), 0, stream, a, l, 17, snap); }
#endif
        a.ph_lo = p; a.ph_hi = p + 1; hipLaunchKernelGGL(fwd, dim3(grid), dim3(NTHR), LDS_BYTES, stream, a);
#ifdef DBG_CHECK
        { const int l = p >= 2 ? (p - 2) / NPL : 0, k = p >= 2 ? (p - 2) % NPL : -1;
#define CHK(st) hipLaunchKernelGGL(chk, dim3(1), dim3(256), 0, stream, a, (int)(st), l, res, snap)
          if (p == 0) CHK(ST_MOD); if (p == 1) CHK(ST_H0);
#if DBG_GSUB == 2
          if (k == 3 && l == 0) hipLaunchKernelGGL(chk_gates_full, dim3(48, TALL / 4), dim3(256), 0, stream, (const bf16*)((char*)d_ws + WS_H), (const bf16*)((char*)d_ws + WS_WSMALL + OFFS_WG), (const bf16*)((char*)d_ws + WS_GATES), TALL, (unsigned*)((char*)d_ws + WS_CTL + 65536));
#endif
          if (k == 0) { CHK(ST_INPROJ); CHK(ST_YT); } if (k == 1) { CHK(ST_QKFIX); CHK(ST_CONV); CHK(ST_Z); } if (k == 2) CHK(ST_ATTN); if (k == 3) { CHK(ST_GATES); CHK(ST_GATESB); } if (k == 4) CHK(ST_MERGED);
          if (k == 5) CHK(ST_MIX); if (k == 6) CHK(ST_ROW1); if (k == 7) CHK(ST_LOGIT); if (k == 8) CHK(ST_TOPK); if (k == 9) CHK(ST_SLOTS); if (k == 10) CHK(ST_ACT); if (k == 11) CHK(ST_YSLOT); if (k == 12) CHK(ST_COMB);
#undef CHK
        }
#endif
    }
#ifdef DBG_CHECK
#if DBG_GSUB == 2
    hipLaunchKernelGGL(encode_full, dim3(1024), dim3(256), 0, stream, (float*)d_out, (const unsigned*)((char*)d_ws + WS_CTL + 65536), out_size);
#else
    hipLaunchKernelGGL(encode, dim3(1024), dim3(256), 0, stream, (float*)d_out, (const float*)((char*)d_ws + WS_CTL + 8192 * 4), out_size, 0.25f);
#endif
#endif
#else
    a.ph_lo = 0; a.ph_hi = NPH; hipLaunchKernelGGL(fwd, dim3(grid), dim3(NTHR), LDS_BYTES, stream, a);
#endif
    const hipError_t le = hipPeekAtLastError();
    if (le != hipSuccess) fprintf(stderr, "kernel_launch: launch failed: %s\n", hipGetErrorName(le));
}
```

```cpp
#include <hip/hip_runtime.h>
#include <cstdio>
#include <cstdint>
#ifndef MK_PER_PHASE
#define MK_PER_PHASE 0
#endif
namespace pg8 {
#define PG8_LAS __attribute__((address_space(3)))
typedef unsigned short bf16_t;
typedef short bf16x8 __attribute__((ext_vector_type(8)));
typedef float f32x4 __attribute__((ext_vector_type(4)));
typedef unsigned u32x4 __attribute__((ext_vector_type(4)));
typedef int i32x4v __attribute__((ext_vector_type(4)));
typedef int i32x8v __attribute__((ext_vector_type(8)));
typedef unsigned u32x2v __attribute__((ext_vector_type(2)));
constexpr int BM = 256, BK = 64, HALF = 128, HTB = HALF * BK * 2  , STAGE_BYTES = 8 * HTB, NXCD = 8, WGM = 8;

__host__ __device__ __forceinline__ int lds_byte(int r, int c) { const int st = (r >> 4) * 2 + (c >> 5), rr = r & 15, cc = c & 31, ob = rr * 64 + cc * 2; return st * 1024 + (ob ^ (((ob >> 9) & 1) << 5)); }
__host__ __device__ __forceinline__ void stage_rc(int b, int& R, int& C) { const int st = b / 1024, sb = b % 1024, swz = sb ^ (((sb >> 9) & 1) << 5); R = (st >> 1) * 16 + swz / 64; C = (st & 1) * 32 + (swz % 64) / 2; }
__host__ __device__ __forceinline__ int perm32(int rho) { const int n = rho >> 4, i = rho & 15; return 8 * (i >> 2) + 4 * n + (i & 3); }

struct Unit { int pm, pn, par; };
struct Gemm { const bf16_t* A; const bf16_t* Bt; int M, N, K; };

struct StaticOrder {
    int nM, nN, nwg, G, c;
    __host__ __device__ void init(int M, int N, int G_, int c_) { nM = M / BM; nN = N / BM; nwg = nM * nN; G = G_; c = c_; }
    __host__ __device__ bool next(int i, Unit& u) const {
        const long L = (long)i * G + c; if (L >= nwg) return false;
        int wgid = (int)L; { const int q = nwg / NXCD, r = nwg % NXCD, xcd = wgid % NXCD, off = wgid / NXCD; wgid = (xcd < r ? xcd * (q + 1) : r * (q + 1) + (xcd - r) * q) + off; }
        const int nig = WGM * nN, gid = wgid / nig, fm = gid * WGM, gsz = (nM - fm) < WGM ? (nM - fm) : WGM;
        u.pm = fm + ((wgid % nig) % gsz); u.pn = (wgid % nig) / gsz; return true;
    }
    __device__ __forceinline__ void a_ready(const Unit&) const {}
    __device__ __forceinline__ void done(const Unit&) const {}
};

typedef __bf16 bf16x2_native __attribute__((ext_vector_type(2)));
typedef float f32x2_native __attribute__((ext_vector_type(2)));
__device__ __forceinline__ unsigned cvt_pk_bf16(float lo, float hi) { const f32x2_native v = {lo, hi}; const bf16x2_native r = __builtin_convertvector(v, bf16x2_native); return __builtin_bit_cast(unsigned, r); }
__device__ __forceinline__ unsigned cvt4_fp8(float a, float b, float c, float d) { int w = __builtin_amdgcn_cvt_pk_fp8_f32(a, b, __builtin_bit_cast(int, a), false); w = __builtin_amdgcn_cvt_pk_fp8_f32(c, d, w, true); return (unsigned)w; }
typedef float f32x2 __attribute__((ext_vector_type(2)));
__device__ __forceinline__ f32x2 gelu_pk(f32x2 v) {
    const f32x2 av = __builtin_elementwise_abs(v), d = av * 0.2316418882f + 1.0f;
    f32x2 t; t.x = __builtin_amdgcn_rcpf(d.x); t.y = __builtin_amdgcn_rcpf(d.y);
    f32x2 q = t * 0.5307027145f + (-0.7265760135f); q = q * t + 0.7107068705f; q = q * t + (-0.142248368f); q = q * t + 0.127414796f; q = q * t;
    const f32x2 s = (v * v) * (-0.72134752044f);
    f32x2 e; e.x = __builtin_amdgcn_exp2f(s.x); e.y = __builtin_amdgcn_exp2f(s.y);
    const f32x2 m = v * (q * e), r = v - m;
    f32x2 o; o.x = v.x < 0.f ? m.x : r.x; o.y = v.y < 0.f ? m.y : r.y; return o;
}

template <int ACT  > struct EpiBf16 {
    static constexpr bool PERM = true, AFTER_DRAIN = false, BIAS_LDS = false; static_assert(ACT == 0 || ACT == 1, "EpiBf16: ACT is 0 (none) or 1 (gelu_pk)");
    bf16_t* O; int ldc; const float* bias; int split_cols; size_t split_stride; float scale0;
    __device__ __forceinline__ void operator()(const f32x4 (&acc)[2][2][4][2], const Unit& u, int wr, int wc, int fr, int fq) const {
        const int row0 = u.pm * BM + wr * 64 + fr; int colt = u.pn * BM; bf16_t* base = O;
        float sc = 1.f; if (split_cols) { const int t = colt / split_cols; base += (size_t)t * split_stride; colt -= t * split_cols; if (t == 0) sc = scale0; }
        const int col0 = colt + wc * 32 + 8 * fq, bcol0 = u.pn * BM + wc * 32 + 8 * fq;
        f32x4 bv[2][2];
#pragma unroll
        for (int bj = 0; bj < 2; ++bj)
#pragma unroll
            for (int n = 0; n < 2; ++n) bv[bj][n] = bias ? *(const f32x4*)(bias + bcol0 + bj * HALF + 4 * n) : (f32x4){0.f, 0.f, 0.f, 0.f};
#pragma unroll
        for (int ai = 0; ai < 2; ++ai)
#pragma unroll
            for (int m = 0; m < 4; ++m) { bf16_t* rowp = base + (size_t)(row0 + ai * HALF + m * 16) * ldc + col0;
#pragma unroll
                for (int bj = 0; bj < 2; ++bj) { f32x4 v0 = acc[ai][bj][m][0] + bv[bj][0], v1 = acc[ai][bj][m][1] + bv[bj][1];
                    if (ACT == 1) { f32x2 a = gelu_pk((f32x2){v0[0], v0[1]}), b = gelu_pk((f32x2){v0[2], v0[3]}), c = gelu_pk((f32x2){v1[0], v1[1]}), d = gelu_pk((f32x2){v1[2], v1[3]});
                        v0 = (f32x4){a.x, a.y, b.x, b.y}; v1 = (f32x4){c.x, c.y, d.x, d.y}; }
                    v0 = v0 * sc; v1 = v1 * sc; u32x4 w; w.x = cvt_pk_bf16(v0[0], v0[1]); w.y = cvt_pk_bf16(v0[2], v0[3]); w.z = cvt_pk_bf16(v1[0], v1[1]); w.w = cvt_pk_bf16(v1[2], v1[3]);
                    *(u32x4*)(rowp + bj * HALF) = w; } }
    }
};

__device__ __forceinline__ float fast_sigmoid(float x) { return __builtin_amdgcn_rcpf(1.0f + __builtin_amdgcn_exp2f(-1.4426950408889634f * x)); }
__device__ __forceinline__ u32x4 pack8(const f32x4& a, const f32x4& b) { u32x4 w; w.x = cvt_pk_bf16(a[0], a[1]); w.y = cvt_pk_bf16(a[2], a[3]); w.z = cvt_pk_bf16(b[0], b[1]); w.w = cvt_pk_bf16(b[2], b[3]); return w; }
__device__ __forceinline__ void unpack8(const u32x4& w, f32x4& a, f32x4& b) {
    a[0] = __uint_as_float(w.x << 16); a[1] = __uint_as_float(w.x & 0xffff0000u); a[2] = __uint_as_float(w.y << 16); a[3] = __uint_as_float(w.y & 0xffff0000u);
    b[0] = __uint_as_float(w.z << 16); b[1] = __uint_as_float(w.z & 0xffff0000u); b[2] = __uint_as_float(w.w << 16); b[3] = __uint_as_float(w.w & 0xffff0000u); }
__device__ __forceinline__ u32x2v pack8_fp8(const f32x4& a, const f32x4& b) { u32x2v r; r.x = cvt4_fp8(a[0], a[1], a[2], a[3]); r.y = cvt4_fp8(b[0], b[1], b[2], b[3]); return r; }
__device__ __forceinline__ void store_tile_bf16(const f32x4 (&acc)[2][2][4][2], bf16_t* base, int ldc, int wr, int wc, int fr, int fq) {
    const int rt = wr * 64 + fr, cb = wc * 32 + 8 * fq;
#pragma unroll
    for (int ai = 0; ai < 2; ++ai)
#pragma unroll
        for (int m = 0; m < 4; ++m) { bf16_t* rowp = base + (size_t)(rt + ai * HALF + m * 16) * ldc + cb;
#pragma unroll
            for (int bj = 0; bj < 2; ++bj) *(u32x4*)(rowp + bj * HALF) = pack8(acc[ai][bj][m][0], acc[ai][bj][m][1]); }
}
struct EpiInproj {
    static constexpr bool PERM = true, AFTER_DRAIN = false, BIAS_LDS = false;
    bf16_t *q, *k, *v, *cu;
    __device__ __forceinline__ void operator()(const f32x4 (&acc)[2][2][4][2], const Unit& u, int wr, int wc, int fr, int fq) const {
        bf16_t* base; int ldc; const bool glu = u.pn >= 6; float sc = 0.03125f; asm volatile("" : "+s"(sc));
        if (u.pn < 4) { base = q + (size_t)u.pm * 256 * 1024 + u.pn * 256; ldc = 1024; }
        else if (u.pn < 6) { const int m0 = u.pm * 256; const int kr = m0 < 32768 ? (m0 >> 11) * 2304 + (m0 & 2047) : ((m0 - 32768) >> 8) * 2304 + 2048; base = (u.pn == 4 ? k : v) + (size_t)kr * 256; ldc = 256; }
        else { base = cu + (size_t)u.pm * 256 * 512 + (u.pn - 6) * 128; ldc = 512; }
        base += (size_t)(wr * 64 + fr) * ldc + wc * 32 + 8 * fq;
#pragma unroll
        for (int ai = 0; ai < 2; ++ai)
#pragma unroll
            for (int m = 0; m < 4; ++m) { bf16_t* rowp = base + (size_t)(ai * HALF + m * 16) * ldc;
                if (!glu) { *(u32x4*)rowp = pack8(acc[ai][0][m][0] * sc, acc[ai][0][m][1] * sc); *(u32x4*)(rowp + HALF) = pack8(acc[ai][1][m][0] * sc, acc[ai][1][m][1] * sc); }
                else { f32x4 a0 = acc[ai][0][m][0] * sc, a1 = acc[ai][0][m][1] * sc; const f32x4 g0 = acc[ai][1][m][0] * sc, g1 = acc[ai][1][m][1] * sc;
#pragma unroll
                    for (int j = 0; j < 4; ++j) { a0[j] *= fast_sigmoid(g0[j]); a1[j] *= fast_sigmoid(g1[j]); }
                    *(u32x4*)rowp = pack8(a0, a1); } }
    }
};
struct EpiYT {
    static constexpr bool PERM = true, AFTER_DRAIN = false, BIAS_LDS = false;
    unsigned char *yt, *ytc;
    __device__ __forceinline__ void operator()(const f32x4 (&acc)[2][2][4][2], const Unit& u, int wr, int wc, int fr, int fq) const {
        const int cs = u.pm >> 1, chb = (u.pm & 1) * 256; unsigned char* base; int ldc;
        if (u.pn < 128) { const int b = u.pn >> 3, pos0 = (u.pn & 7) * 256; base = yt + (size_t)(b * 512 + chb) * 4096 + cs * 2048 + pos0; ldc = 4096; }
        else { const int b = u.pn - 128; base = ytc + (size_t)(b * 512 + chb) * 512 + cs * 256; ldc = 512; }
        base += (size_t)(wr * 64 + fr) * ldc + wc * 32 + 8 * fq;
#pragma unroll
        for (int ai = 0; ai < 2; ++ai)
#pragma unroll
            for (int m = 0; m < 4; ++m) { unsigned char* rowp = base + (size_t)(ai * HALF + m * 16) * ldc;
#pragma unroll
                for (int bj = 0; bj < 2; ++bj) *(u32x2v*)(rowp + bj * HALF) = pack8_fp8(acc[ai][bj][m][0], acc[ai][bj][m][1]); }
    }
};
struct EpiDFT {
    static constexpr bool PERM = true, AFTER_DRAIN = false, BIAS_LDS = false;
    bf16_t* z; int rowbase, rpb;
    __device__ __forceinline__ void operator()(const f32x4 (&acc)[2][2][4][2], const Unit& u, int wr, int wc, int fr, int fq) const {
        bf16_t* base = z + (size_t)(rowbase + (u.pn >> 1) * rpb + u.pm * 256 + wr * 64 + fr) * 512 + (u.pn & 1) * 256 + wc * 32 + 8 * fq;
#pragma unroll
        for (int ai = 0; ai < 2; ++ai)
#pragma unroll
            for (int m = 0; m < 4; ++m)
#pragma unroll
                for (int bj = 0; bj < 2; ++bj) *(u32x4*)(base + (size_t)(ai * HALF + m * 16) * 512 + bj * HALF) = pack8(acc[ai][bj][m][0] * 0.03125f, acc[ai][bj][m][1] * 0.03125f);
    }
};
struct EpiGates {
    static constexpr bool PERM = true, AFTER_DRAIN = false, BIAS_LDS = false;
    bf16_t* g;
    __device__ __forceinline__ void operator()(const f32x4 (&acc)[2][2][4][2], const Unit& u, int wr, int wc, int fr, int fq) const {
        int lt = (wr * 4 + wc) * 64 + fq * 16 + fr; asm volatile("" : "+v"(lt));
        bf16_t* tb = g + ((size_t)(u.pm * 12 + u.pn) * 16 * 512 + (size_t)lt) * 8;
        float cs = -1.4426950408889634f * 0.03125f; asm volatile("" : "+s"(cs));
#pragma unroll
        for (int ai = 0; ai < 2; ++ai)
#pragma unroll
            for (int m = 0; m < 4; ++m)
#pragma unroll
                for (int bj = 0; bj < 2; ++bj) { f32x4 a0 = acc[ai][bj][m][0], a1 = acc[ai][bj][m][1];
#pragma unroll
                    for (int j = 0; j < 4; ++j) { a0[j] = __builtin_amdgcn_rcpf(1.0f + __builtin_amdgcn_exp2f(a0[j] * cs)); a1[j] = __builtin_amdgcn_rcpf(1.0f + __builtin_amdgcn_exp2f(a1[j] * cs)); }
                    __builtin_nontemporal_store(pack8(a0, a1), (u32x4*)(tb + (size_t)(((ai * 4 + m) * 2 + bj) * 512) * 8)); }
    }
};
template <int MODE> struct EpiMerge {
    static constexpr bool PERM = true, AFTER_DRAIN = false, BIAS_LDS = false;
    bf16_t* mg; bf16_t* scr; const bf16_t* g; int br; float scale;
    __device__ __forceinline__ void operator()(const f32x4 (&acc)[2][2][4][2], const Unit& u, int wr, int wc, int fr, int fq) const {
        const int rt = u.pm * 256 + wr * 64 + fr, cb = u.pn * 256 + wc * 32 + 8 * fq; float sc = scale; asm volatile("" : "+s"(sc));
        int lt = (wr * 4 + wc) * 64 + fq * 16 + fr; asm volatile("" : "+v"(lt));
        const bf16_t* gt = g + ((size_t)(u.pm * 12 + br * 4 + u.pn) * 16 * 512 + (size_t)lt) * 8;
        bf16_t* st = scr + ((size_t)(u.pm * 4 + u.pn) * 16 * 512 + (size_t)lt) * 8;
#pragma unroll
        for (int ai = 0; ai < 2; ++ai)
#pragma unroll
            for (int m = 0; m < 4; ++m)
#pragma unroll
                for (int bj = 0; bj < 2; ++bj) { const size_t pk = (size_t)(((ai * 4 + m) * 2 + bj) * 512) * 8;
                    const u32x4 gw = *(const u32x4*)(gt + pk); f32x4 g0, g1; unpack8(gw, g0, g1);
                    f32x4 v0 = acc[ai][bj][m][0] * sc * g0, v1 = acc[ai][bj][m][1] * sc * g1;
                    if (MODE != 0) { const u32x4 ow = *(const u32x4*)(st + pk); f32x4 o0, o1; unpack8(ow, o0, o1); v0 += o0; v1 += o1; }
                    if (MODE != 2) *(u32x4*)(st + pk) = pack8(v0, v1);
                    else *(u32x4*)(mg + (size_t)(rt + ai * HALF + m * 16) * 1024 + cb + bj * HALF) = pack8(v0, v1); }
    }
};
struct EpiRouter {
    static constexpr bool PERM = true, AFTER_DRAIN = false, BIAS_LDS = false;
    float* lg;
    __device__ __forceinline__ void operator()(const f32x4 (&acc)[2][2][4][2], const Unit& u, int wr, int wc, int fr, int fq) const {
        if (wc < 2) { const int rt = u.pm * 256 + wr * 64 + fr, cb = wc * 32 + 8 * fq;
#pragma unroll
            for (int ai = 0; ai < 2; ++ai)
#pragma unroll
                for (int m = 0; m < 4; ++m) { float* p = lg + (size_t)(rt + ai * HALF + m * 16) * 64 + cb; *(f32x4*)p = acc[ai][0][m][0]; *(f32x4*)(p + 4) = acc[ai][0][m][1]; } }
    }
};
struct EpiSwiGLU {
    static constexpr bool PERM = true, AFTER_DRAIN = false, BIAS_LDS = false;
    bf16_t* act; const float* bg; const float* bu;
    __device__ __forceinline__ void operator()(const f32x4 (&acc)[2][2][4][2], const Unit& u, int wr, int wc, int fr, int fq) const {
        const int e = u.pn >> 3, col = (u.pn & 7) * 128 + wc * 32 + 8 * fq, rt = u.pm * 256 + wr * 64 + fr;
        const f32x4 bg0 = *(const f32x4*)(bg + e * 1024 + col), bg1 = *(const f32x4*)(bg + e * 1024 + col + 4), bu0 = *(const f32x4*)(bu + e * 1024 + col), bu1 = *(const f32x4*)(bu + e * 1024 + col + 4);
#pragma unroll
        for (int ai = 0; ai < 2; ++ai)
#pragma unroll
            for (int m = 0; m < 4; ++m) { f32x4 g0 = acc[ai][0][m][0] + bg0, g1 = acc[ai][0][m][1] + bg1, u0 = acc[ai][1][m][0] + bu0, u1 = acc[ai][1][m][1] + bu1;
#pragma unroll
                for (int j = 0; j < 4; ++j) { const float ga = fminf(g0[j], 7.0f), gb = fminf(g1[j], 7.0f); const float ua = fminf(fmaxf(u0[j], -7.0f), 7.0f), ub = fminf(fmaxf(u1[j], -7.0f), 7.0f);
                    g0[j] = (ua + 1.0f) * (ga * fast_sigmoid(1.702f * ga)); g1[j] = (ub + 1.0f) * (gb * fast_sigmoid(1.702f * gb)); }
                *(u32x4*)(act + (size_t)(rt + ai * HALF + m * 16) * 1024 + col) = pack8(g0, g1); }
    }
};
struct EpiSwiGLU8 {
    static constexpr bool PERM = true, AFTER_DRAIN = false, BIAS_LDS = true;
    unsigned char* act; const float* bg; const float* bu; PG8_LAS float* bl;
    __device__ __forceinline__ void stage_bias(const Unit& u, int wid, int lane) const {
        if (wid < 4) { const int e = u.pn >> 3, c0 = (u.pn & 7) * 128 + (wid & 1) * 64 + lane; const float* src = (wid < 2 ? bg : bu) + e * 1024 + c0;
            __builtin_amdgcn_global_load_lds((const unsigned*)src, (PG8_LAS unsigned*)(bl + u.par * 256 + wid * 64), 4, 0, 0); }
    }
    __device__ __forceinline__ void operator()(const f32x4 (&acc)[2][2][4][2], const Unit& u, int wr, int wc, int fr, int fq) const {
        const int col = (u.pn & 7) * 128 + wc * 32 + 8 * fq, rt = u.pm * 256 + wr * 64 + fr; const PG8_LAS float* bp = bl + u.par * 256 + wc * 32 + 8 * fq;
        const f32x4 bg0 = *(const PG8_LAS f32x4*)bp, bg1 = *(const PG8_LAS f32x4*)(bp + 4), bu0 = *(const PG8_LAS f32x4*)(bp + 128) + 1.0f, bu1 = *(const PG8_LAS f32x4*)(bp + 132) + 1.0f;
        float cg = -1.702f * 1.4426950408889634f; asm volatile("" : "+s"(cg));
#pragma unroll
        for (int ai = 0; ai < 2; ++ai)
#pragma unroll
            for (int m = 0; m < 4; ++m) { f32x4 g0 = acc[ai][0][m][0] * 0.03125f + bg0, g1 = acc[ai][0][m][1] * 0.03125f + bg1, u0 = acc[ai][1][m][0] * 0.03125f + bu0, u1 = acc[ai][1][m][1] * 0.03125f + bu1;
#pragma unroll
                for (int j = 0; j < 4; ++j) { const float ga = fminf(g0[j], 7.0f), gb = fminf(g1[j], 7.0f);
                    const float ta = ga * __builtin_amdgcn_rcpf(1.0f + __builtin_amdgcn_exp2f(ga * cg)), tb = gb * __builtin_amdgcn_rcpf(1.0f + __builtin_amdgcn_exp2f(gb * cg));
                    g0[j] = __builtin_amdgcn_fmed3f(u0[j], -6.0f, 8.0f) * ta; g1[j] = __builtin_amdgcn_fmed3f(u1[j], -6.0f, 8.0f) * tb; }
                __builtin_nontemporal_store(pack8_fp8(g0, g1), (u32x2v*)(act + (size_t)(rt + ai * HALF + m * 16) * 1024 + col)); }
    }
};
struct EpiDown8 {
    static constexpr bool PERM = true, AFTER_DRAIN = false, BIAS_LDS = true;
    unsigned char* ys; const float* bd; int nostore; PG8_LAS float* bl;
    __device__ __forceinline__ void stage_bias(const Unit& u, int wid, int lane) const {
        if (wid < 4) { const float* src = bd + (u.pn >> 2) * 1024 + (u.pn & 3) * 256 + wid * 64 + lane; __builtin_amdgcn_global_load_lds((const unsigned*)src, (PG8_LAS unsigned*)(bl + u.par * 256 + wid * 64), 4, 0, 0); }
    }
    __device__ __forceinline__ void operator()(const f32x4 (&acc)[2][2][4][2], const Unit& u, int wr, int wc, int fr, int fq) const {
        const int col0 = (u.pn & 3) * 256 + wc * 32 + 8 * fq, rt = u.pm * 256 + wr * 64 + fr; const PG8_LAS float* bp = bl + u.par * 256 + wc * 32 + 8 * fq;
        f32x4 bv[2][2];
#pragma unroll
        for (int bj = 0; bj < 2; ++bj) { bv[bj][0] = *(const PG8_LAS f32x4*)(bp + bj * HALF) * 8.0f; bv[bj][1] = *(const PG8_LAS f32x4*)(bp + bj * HALF + 4) * 8.0f; }
#pragma unroll
        for (int ai = 0; ai < 2; ++ai)
#pragma unroll
            for (int m = 0; m < 4; ++m) { unsigned char* rowp = ys + (size_t)(rt + ai * HALF + m * 16) * 1024 + col0;
#pragma unroll
                for (int bj = 0; bj < 2; ++bj) { const u32x2v w = pack8_fp8(acc[ai][bj][m][0] * 0.25f + bv[bj][0], acc[ai][bj][m][1] * 0.25f + bv[bj][1]); if (!nostore) __builtin_nontemporal_store(w, (u32x2v*)(rowp + bj * HALF)); else asm volatile("" :: "v"(w)); } }
    }
};
struct GroupedOrder {
    int nM, nN, nwg, G, c; const PG8_LAS int* tile_e; const int* rows;
    __device__ void init(int nM_, int nN_, int G_, int c_, const PG8_LAS int* te) { nM = nM_; nN = nN_; nwg = nM * nN; G = G_; c = c_; tile_e = te; rows = nullptr; }
    __device__ bool next(int i, Unit& u) const {
        const long L = (long)i * G + c; if (L >= nwg) return false;
        int wgid = (int)L; { const int q = nwg / NXCD, r = nwg % NXCD, xcd = wgid % NXCD, off = wgid / NXCD; wgid = (xcd < r ? xcd * (q + 1) : r * (q + 1) + (xcd - r) * q) + off; }
        const int nig = WGM * nN, gid = wgid / nig, fm = gid * WGM, gsz = (nM - fm) < WGM ? (nM - fm) : WGM;
        u.pm = fm + ((wgid % nig) % gsz); const int pl = (wgid % nig) / gsz; u.pn = __builtin_amdgcn_readfirstlane(tile_e[u.pm]) * nN + pl; return true;
    }
    __device__ __forceinline__ void a_ready(const Unit&) const {}
    __device__ __forceinline__ void done(const Unit&) const {}
};
struct DftOrder {
    int lg, n, G, c;
    __device__ void init(int lg_, int nb, int G_, int c_) { lg = lg_; n = (nb * 2) << lg_; G = G_; c = c_; }
    __device__ bool next(int i, Unit& u) const { const int L = i * G + c; if (L >= n) return false; const int b = L >> (lg + 1), rem = L & ((2 << lg) - 1); u.pm = rem & ((1 << lg) - 1); u.pn = 2 * b + (rem >> lg); return true; }
    __device__ __forceinline__ void a_ready(const Unit&) const {}
    __device__ __forceinline__ void done(const Unit&) const {}
};

template <class Epi, class Sched, bool ALIGN_EPI = false, bool SP2 = false, bool FP8 = false, bool GATHER = false>
__device__ __forceinline__ void gemm_phase(PG8_LAS unsigned char* lds, const Gemm g, const Sched& S, const Epi& E, const int tid_in) {
    int tid_ = tid_in; asm volatile("" : "+v"(tid_));
    const int tid = tid_, wid = __builtin_amdgcn_readfirstlane(tid >> 6), lane = tid & 63, wr = wid >> 2, wc = wid & 3, fr = lane & 15, fq = lane >> 4;
    const int K = g.K, nt = K / BK;
    unsigned voffA[2], voffB[2]; int RA[2]; unsigned CA2[2];
#pragma unroll
    for (int i = 0; i < 2; ++i) { int R, C; stage_rc(tid * 16 + i * 8192, R, C); const int Rb = Epi::PERM ? ((R & ~31) + perm32(R & 31)) : R;
        voffA[i] = (unsigned)(R * K + C) * 2u; voffB[i] = (unsigned)(Rb * K + C) * 2u; RA[i] = (R << 8) | (C * 2); CA2[i] = 0u; }
    static_assert(!GATHER || SP2, "GATHER is implemented for the SP2 loop only");
    unsigned pC[2], pN[2];
#define PG8_LDIDX(dst, unit) do { if constexpr (GATHER) { _Pragma("unroll") for (int h_ = 0; h_ < 2; ++h_) dst[h_] = (unsigned)S.rows[(unit).pm * 256 + h_ * 128 + (RA[0] >> 8)] | ((unsigned)S.rows[(unit).pm * 256 + h_ * 128 + (RA[1] >> 8)] << 16); } } while (0)
#define PG8_GOFF(dst, pk) do { dst[0] = ((pk) & 0xffffu) * (unsigned)(K * 2) + (unsigned)(RA[0] & 255); dst[1] = ((pk) >> 16) * (unsigned)(K * 2) + (unsigned)(RA[1] & 255); } while (0)
    const size_t kstep = (size_t)(BK * 2);
    const size_t hstep = (size_t)HALF * K * 2;
    const size_t tstep = 2 * hstep;
    const unsigned ldsw = (unsigned)wid * 1024u;
    const int aoff = lds_byte(wr * 64 + fr, fq * 8), boff = lds_byte(wc * 32 + fr, fq * 8);
#define PG8_SA(b, h) (((b) * 2 + (h)) * HTB)
#define PG8_SB(b, h) ((4 + (b) * 2 + (h)) * HTB)
#define PG8_STAGE(bufoff, gbase, voff) do { _Pragma("unroll") for (int _i = 0; _i < 2; ++_i) \
        __builtin_amdgcn_global_load_lds((const unsigned*)((const char*)(gbase) + (voff)[_i]), (PG8_LAS unsigned*)(lds + (bufoff) + ldsw + _i * 8192), 16, 0, 0); } while (0)
#define PG8_RD8(off) __builtin_shufflevector(*(const PG8_LAS i32x4v*)(lds + (off)), *(const PG8_LAS i32x4v*)(lds + (off) + 1024), 0, 1, 2, 3, 4, 5, 6, 7)
#define PG8_LDA(dst, b, h) do { _Pragma("unroll") for (int m = 0; m < 4; ++m) { if constexpr (FP8) dst##8[m] = PG8_RD8(PG8_SA(b, h) + aoff + m * 2048); else { _Pragma("unroll") for (int k = 0; k < 2; ++k) dst[m][k] = *(const PG8_LAS bf16x8*)(lds + PG8_SA(b, h) + aoff + m * 2048 + k * 1024); } } } while (0)
#define PG8_LDB(dst, b, h) do { _Pragma("unroll") for (int n = 0; n < 2; ++n) { if constexpr (FP8) dst##8[n] = PG8_RD8(PG8_SB(b, h) + boff + n * 2048); else { _Pragma("unroll") for (int k = 0; k < 2; ++k) dst[n][k] = *(const PG8_LAS bf16x8*)(lds + PG8_SB(b, h) + boff + n * 2048 + k * 1024); } } } while (0)
#define PG8_MMA(ai, bj, At, Bt) do { if constexpr (FP8) __builtin_amdgcn_sched_barrier(0); __builtin_amdgcn_s_setprio(1); _Pragma("unroll") for (int m = 0; m < 4; ++m) _Pragma("unroll") for (int n = 0; n < 2; ++n) { \
        if constexpr (FP8) asm volatile("v_mfma_scale_f32_16x16x128_f8f6f4 %0, %1, %2, %0, %3, %3 op_sel_hi:[0,0,0]" : "+v"(acc[ai][bj][m][n]) : "v"(Bt##8[n]), "v"(At##8[m]), "v"(sc8)); \
        else { _Pragma("unroll") for (int k = 0; k < 2; ++k) acc[ai][bj][m][n] = __builtin_amdgcn_mfma_f32_16x16x32_bf16(Bt[n][k], At[m][k], acc[ai][bj][m][n], 0, 0, 0); } } __builtin_amdgcn_s_setprio(0); if constexpr (FP8) __builtin_amdgcn_sched_barrier(0); } while (0)
#define PG8_WAIT_V(n) asm volatile("s_waitcnt vmcnt(" #n ")" ::: "memory")
#define PG8_WAIT_L(n) asm volatile("s_waitcnt lgkmcnt(" #n ")" ::: "memory")
#define PG8_BAR __builtin_amdgcn_s_barrier()
#define PG8_SCHED __builtin_amdgcn_sched_barrier(0)
    Unit cur, nxt; int ui = 0;
    if (!S.next(0, cur)) return;
    f32x4 acc[2][2][4][2];
#pragma unroll
    for (int a = 0; a < 2; ++a)
#pragma unroll
        for (int b = 0; b < 2; ++b)
#pragma unroll
            for (int m = 0; m < 4; ++m)
#pragma unroll
                for (int n = 0; n < 2; ++n) acc[a][b][m][n] = (f32x4){0.f, 0.f, 0.f, 0.f};
    int sc8 = 0x7f7f7f7f; asm volatile("" : "+v"(sc8));
    bf16x8 At[4][2], B0[2][2], B1[2][2]; i32x8v At8[4], B08[2], B18[2];
    const char* cA = (const char*)g.A + (size_t)cur.pm * tstep; const char* cB = (const char*)g.Bt + (size_t)cur.pn * tstep; const char* const gA = (const char*)g.A;
    S.a_ready(cur);
    if constexpr (SP2) {
        unsigned g0_[2], g1_[2]; if constexpr (GATHER) { PG8_LDIDX(pC, cur); PG8_GOFF(g0_, pC[0]); PG8_GOFF(g1_, pC[1]); }
        PG8_STAGE(PG8_SB(0, 0), cB, voffB); PG8_STAGE(PG8_SB(0, 1), cB + hstep, voffB);
        if constexpr (GATHER) { PG8_STAGE(PG8_SA(0, 0), gA, g0_); PG8_STAGE(PG8_SA(0, 1), gA, g1_); } else { PG8_STAGE(PG8_SA(0, 0), cA, voffA); PG8_STAGE(PG8_SA(0, 1), cA + hstep, voffA); }
        if (wr == 1) PG8_BAR;
        PG8_WAIT_V(2); PG8_BAR;
        PG8_STAGE(PG8_SB(1, 0), cB + kstep, voffB); if constexpr (GATHER) PG8_STAGE(PG8_SA(1, 0), gA + kstep, g0_); else PG8_STAGE(PG8_SA(1, 0), cA + kstep, voffA); PG8_STAGE(PG8_SB(1, 1), cB + hstep + kstep, voffB);
        PG8_WAIT_V(6); PG8_BAR;
    } else {
        PG8_STAGE(PG8_SB(0, 0), cB, voffB); PG8_STAGE(PG8_SA(0, 0), cA, voffA); PG8_STAGE(PG8_SB(0, 1), cB + hstep, voffB); PG8_STAGE(PG8_SA(0, 1), cA + hstep, voffA);
        if (wr == 1) PG8_BAR;
        PG8_WAIT_V(4); PG8_BAR;
        PG8_STAGE(PG8_SB(1, 0), cB + kstep, voffB); PG8_STAGE(PG8_SA(1, 0), cA + kstep, voffA); PG8_STAGE(PG8_SB(1, 1), cB + hstep + kstep, voffB);
        PG8_WAIT_V(6); PG8_BAR;
    }
    for (;;) {
        cur.par = ui & 1; if constexpr (Epi::BIAS_LDS) E.stage_bias(cur, wid, lane);
        const bool has_next = S.next(ui + 1, nxt);
        if constexpr (GATHER) { if (has_next) PG8_LDIDX(pN, nxt); }
        const char* nA = has_next ? (const char*)g.A + (size_t)nxt.pm * tstep : cA; const char* nB = has_next ? (const char*)g.Bt + (size_t)nxt.pn * tstep : cB;
        for (int t = 0; t < nt; t += 2) {
            const bool last = (t == nt - 2);
            const char* a1 = cA + (size_t)(t + 1) * kstep;
            const char* a2 = last ? nA : cA + (size_t)(t + 2) * kstep; const char* b2 = last ? nB : cB + (size_t)(t + 2) * kstep;
            const char* a3 = a2 + kstep; const char* b3 = b2 + kstep;
            if (last && has_next) S.a_ready(nxt);
            unsigned v2[2][2]; const char* gA2 = gA;
            unsigned vc1[2];
            if constexpr (GATHER) { const bool sw = last && has_next; PG8_GOFF(v2[0], sw ? pN[0] : pC[0]); PG8_GOFF(v2[1], sw ? pN[1] : pC[1]); PG8_GOFF(vc1, pC[1]);
                gA2 = last ? gA : gA + (size_t)(t + 2) * kstep; }
            if constexpr (SP2) {
            PG8_LDB(B0, 0, 0); PG8_LDB(B1, 0, 1); PG8_SCHED; PG8_LDA(At, 0, 0); if constexpr (GATHER) PG8_STAGE(PG8_SA(1, 1), gA + (size_t)(t + 1) * kstep, vc1); else PG8_STAGE(PG8_SA(1, 1), a1 + hstep, voffA);
            PG8_WAIT_V(8); PG8_WAIT_L(0); PG8_BAR; PG8_MMA(0, 0, At, B0); PG8_MMA(0, 1, At, B1); PG8_BAR; PG8_SCHED;
            PG8_LDA(At, 0, 1); PG8_STAGE(PG8_SB(0, 0), b2, voffB); PG8_STAGE(PG8_SB(0, 1), b2 + hstep, voffB); if constexpr (GATHER) PG8_STAGE(PG8_SA(0, 0), gA2, v2[0]); else PG8_STAGE(PG8_SA(0, 0), a2, voffA);
            PG8_WAIT_V(8); PG8_WAIT_L(0); PG8_BAR; PG8_MMA(1, 0, At, B0); PG8_MMA(1, 1, At, B1); PG8_BAR; PG8_SCHED;
            PG8_LDB(B0, 1, 0); PG8_LDB(B1, 1, 1); PG8_SCHED; PG8_LDA(At, 1, 0); if constexpr (GATHER) PG8_STAGE(PG8_SA(0, 1), gA2, v2[1]); else PG8_STAGE(PG8_SA(0, 1), a2 + hstep, voffA);
            PG8_WAIT_V(8); PG8_WAIT_L(0); PG8_BAR; PG8_MMA(0, 0, At, B0); PG8_MMA(0, 1, At, B1); PG8_BAR; PG8_SCHED;
            PG8_LDA(At, 1, 1); PG8_STAGE(PG8_SB(1, 0), b3, voffB); PG8_STAGE(PG8_SB(1, 1), b3 + hstep, voffB); if constexpr (GATHER) PG8_STAGE(PG8_SA(1, 0), gA2 + kstep, v2[0]); else PG8_STAGE(PG8_SA(1, 0), a3, voffA);
            PG8_WAIT_V(8); PG8_WAIT_L(0); PG8_BAR; PG8_MMA(1, 0, At, B0); PG8_MMA(1, 1, At, B1); PG8_BAR; PG8_SCHED;
            } else {
            PG8_LDB(B0, 0, 0); PG8_SCHED; PG8_LDA(At, 0, 0); PG8_STAGE(PG8_SA(1, 1), a1 + hstep, voffA);
            PG8_WAIT_L(8); PG8_BAR; PG8_WAIT_L(0); PG8_MMA(0, 0, At, B0); PG8_BAR; PG8_SCHED;
            PG8_LDB(B1, 0, 1); PG8_STAGE(PG8_SB(0, 0), b2, voffB);
            PG8_BAR; PG8_WAIT_L(0); PG8_MMA(0, 1, At, B1); PG8_BAR;
            PG8_LDA(At, 0, 1); PG8_STAGE(PG8_SA(0, 0), a2, voffA);
            PG8_BAR; PG8_WAIT_L(0); PG8_MMA(1, 0, At, B0); PG8_BAR; PG8_SCHED;
            PG8_STAGE(PG8_SB(0, 1), b2 + hstep, voffB);
            PG8_WAIT_V(6); PG8_BAR; PG8_MMA(1, 1, At, B1); PG8_BAR;
            PG8_LDB(B0, 1, 0); PG8_SCHED; PG8_LDA(At, 1, 0); PG8_STAGE(PG8_SA(0, 1), a2 + hstep, voffA);
            PG8_WAIT_L(8); PG8_BAR; PG8_WAIT_L(0); PG8_MMA(0, 0, At, B0); PG8_BAR; PG8_SCHED;
            PG8_LDB(B1, 1, 1); PG8_STAGE(PG8_SB(1, 0), b3, voffB);
            PG8_BAR; PG8_WAIT_L(0); PG8_MMA(0, 1, At, B1); PG8_BAR;
            PG8_LDA(At, 1, 1); PG8_STAGE(PG8_SA(1, 0), a3, voffA);
            PG8_BAR; PG8_WAIT_L(0); PG8_MMA(1, 0, At, B0); PG8_BAR; PG8_SCHED;
            PG8_STAGE(PG8_SB(1, 1), b3 + hstep, voffB);
            PG8_WAIT_V(6); PG8_BAR; PG8_MMA(1, 1, At, B1); PG8_BAR;
            }
        }
        if constexpr (FP8) asm volatile("s_nop 15\n\ts_nop 15" ::: "memory");
        if constexpr (ALIGN_EPI) { if (wr == 0) PG8_BAR; }
        if constexpr (!Epi::AFTER_DRAIN) { E(acc, cur, wr, wc, fr, fq); S.done(cur); }
        if (!has_next) break;
#pragma unroll
        for (int a = 0; a < 2; ++a)
#pragma unroll
            for (int b = 0; b < 2; ++b)
#pragma unroll
                for (int m = 0; m < 4; ++m)
#pragma unroll
                    for (int n = 0; n < 2; ++n) acc[a][b][m][n] = (f32x4){0.f, 0.f, 0.f, 0.f};
        cur = nxt; cA = nA; cB = nB; ++ui;
        if constexpr (GATHER) { pC[0] = pN[0]; pC[1] = pN[1]; }
        if constexpr (ALIGN_EPI) { if (wr == 1) PG8_BAR; }
    }
    PG8_WAIT_V(0);
    if constexpr (!ALIGN_EPI) { if (wr == 0) PG8_BAR; }
    PG8_BAR;
    if constexpr (Epi::AFTER_DRAIN) { E.fused(acc, cur, wr, wc, fr, fq, lds, wid, lane); S.done(cur); }
#undef PG8_SA
#undef PG8_LDIDX
#undef PG8_GOFF
#undef PG8_SB
#undef PG8_STAGE
#undef PG8_LDA
#undef PG8_LDB
#undef PG8_MMA
#undef PG8_RD8
#undef PG8_WAIT_V
#undef PG8_WAIT_L
#undef PG8_BAR
#undef PG8_SCHED
}
}
namespace att {
typedef unsigned short bf16;
constexpr int   D = 128, NW = 8, QBLK = 32, KVBLK = 64;
constexpr float SCALE = 0.088388347648318440f;
constexpr float THR = 8.f;
constexpr int SDEPTH = 2;
constexpr int LDQ = 1024, LDK = 256, LDO = 1024;
constexpr size_t SHM_V = KVBLK * D * 2, SHM_K = KVBLK * D * 2, SHM_ATTN = 2 * SHM_V + 2 * SHM_K + NW * 64 * 4;
using bf16x8 = __attribute__((ext_vector_type(8))) short;
using s16x4  = __attribute__((ext_vector_type(4))) short;
using f32x16 = __attribute__((ext_vector_type(16))) float;
using f32x8  = __attribute__((ext_vector_type(8))) float;
using u32x4  = __attribute__((ext_vector_type(4))) unsigned;
#define KSWZ(row, colB) ((row) * 256 + ((colB) ^ (((row) & 7) << 4)))
#define SBAR() __builtin_amdgcn_sched_barrier(0)
__device__ __forceinline__ int crow(int r, int hi) { return (r & 3) + 8 * (r >> 2) + 4 * hi; }
__device__ __forceinline__ unsigned cvtpk(float lo, float hi) { return pg8::cvt_pk_bf16(lo, hi); }
template <typename TIn> struct Stage;
template <> struct Stage<bf16>  { using T = bf16x8;
  __device__ static __forceinline__ T ld8(const bf16* p) { return *reinterpret_cast<const bf16x8*>(p); }
  __device__ static __forceinline__ bf16x8 tobf(T x) { return x; } };
template <> struct Stage<float> { using T = f32x8;
  __device__ static __forceinline__ T ld8(const float* p) { return *reinterpret_cast<const f32x8*>(p); }
  __device__ static __forceinline__ bf16x8 tobf(T x) {
    u32x4 w = {cvtpk(x[0], x[1]), cvtpk(x[2], x[3]), cvtpk(x[4], x[5]), cvtpk(x[6], x[7])}; return *reinterpret_cast<bf16x8*>(&w); } };

__device__ __forceinline__ void partialSM(f32x16& p0, f32x16& p1, float& m_reg, float& mn, float& alpha) {
  constexpr float C = SCALE * 1.4426950408889634f;
  float pmax = p0[0]; for (int r = 1; r < 16; ++r) pmax = fmaxf(pmax, p0[r]); for (int r = 0; r < 16; ++r) pmax = fmaxf(pmax, p1[r]);
  { auto rr = __builtin_amdgcn_permlane32_swap(__float_as_uint(pmax), __float_as_uint(pmax), false, false);
    pmax = fmaxf(__uint_as_float(rr[0]), __uint_as_float(rr[1])); }
  if (__builtin_expect(__all(pmax - m_reg <= THR / SCALE), 1)) { mn = m_reg; alpha = 1.f; }
  else { mn = fmaxf(m_reg, pmax); alpha = __builtin_amdgcn_exp2f((m_reg - mn) * C); m_reg = mn; }
  float mnC = -mn * C;
  for (int r = 0; r < 16; ++r) p0[r] = fmaf(p0[r], C, mnC); for (int r = 0; r < 16; ++r) p1[r] = fmaf(p1[r], C, mnC);
  for (int r = 0; r < 16; ++r) p0[r] = __builtin_amdgcn_exp2f(p0[r]);
}
__device__ __forceinline__ void finishSM(f32x16& p0, f32x16& p1, float alpha, float& l_reg, bf16x8& pa0, bf16x8& pa1, bf16x8& pa2, bf16x8& pa3) {
  for (int r = 0; r < 16; ++r) p1[r] = __builtin_amdgcn_exp2f(p1[r]);
  float ps = 0; for (int r = 0; r < 16; ++r) ps += p0[r]; for (int r = 0; r < 16; ++r) ps += p1[r];
  { auto rr = __builtin_amdgcn_permlane32_swap(__float_as_uint(ps), __float_as_uint(ps), false, false);
    ps = __uint_as_float(rr[0]) + __uint_as_float(rr[1]); }
  l_reg = l_reg * alpha + ps;
#define PK4(P, BASE, OUT) do { unsigned a0 = cvtpk(P[BASE + 0], P[BASE + 1]), a1 = cvtpk(P[BASE + 2], P[BASE + 3]);   \
    unsigned b0 = cvtpk(P[BASE + 4], P[BASE + 5]), b1 = cvtpk(P[BASE + 6], P[BASE + 7]);                              \
    auto r0 = __builtin_amdgcn_permlane32_swap(a0, b0, false, false); auto r1 = __builtin_amdgcn_permlane32_swap(a1, b1, false, false); \
    u32x4 w = {r0[0], r1[0], r0[1], r1[1]}; OUT = *reinterpret_cast<bf16x8*>(&w); } while (0)
  PK4(p0, 0, pa0); PK4(p0, 8, pa1); PK4(p1, 0, pa2); PK4(p1, 8, pa3);
#undef PK4
}
__device__ __forceinline__ void qkt(f32x16& p0, f32x16& p1, const bf16* Ks, const bf16x8* qr, int r32, int hi) {
  p0 = f32x16{}; p1 = f32x16{};
  for (int d0 = 0; d0 < 8; ++d0) { int cb = (d0 * 16 + hi * 8) * 2;
    bf16x8 b0 = *reinterpret_cast<const bf16x8*>((const char*)Ks + KSWZ(r32, cb));
    bf16x8 b1 = *reinterpret_cast<const bf16x8*>((const char*)Ks + KSWZ(32 + r32, cb));
    p0 = __builtin_amdgcn_mfma_f32_32x32x16_bf16(b0, qr[d0], p0, 0, 0, 0);
    p1 = __builtin_amdgcn_mfma_f32_32x32x16_bf16(b1, qr[d0], p1, 0, 0, 0); }
}
__device__ __forceinline__ int v_st(int k, int c) { const int kk = (k & ~0xC) | ((k & 4) << 1) | ((k & 8) >> 1); return ((kk >> 3) * 4 + (c >> 5)) * 512 + ((kk & 7) * 32 + (c & 31)) * 2; }
__device__ __forceinline__ int v_rd_base(int lane) { return ((lane & 3) << 3) | (((lane >> 2) & 3) << 6) | (((lane >> 4) & 1) << 5) | (((lane >> 5) & 1) << 8); }
constexpr int v_rd_off(int d0, int ks, int half) { return d0 * 512 + ks * 4096 + half * 2048; }
template <int OFF> __device__ __forceinline__ s16x4 tr_read(int vb) {
  s16x4 r; asm volatile("ds_read_b64_tr_b16 %0, %1 offset:%2" : "=&v"(r) : "v"(vb), "i"(OFF) : "memory"); return r;
}
template <int D0> __device__ __forceinline__ void pv_one(f32x16& od, int vb, bf16x8 pa0, bf16x8 pa1, bf16x8 pa2, bf16x8 pa3) {
  const s16x4 l0 = tr_read<v_rd_off(D0, 0, 0)>(vb), h0 = tr_read<v_rd_off(D0, 0, 1)>(vb), l1 = tr_read<v_rd_off(D0, 1, 0)>(vb), h1 = tr_read<v_rd_off(D0, 1, 1)>(vb);
  const s16x4 l2 = tr_read<v_rd_off(D0, 2, 0)>(vb), h2 = tr_read<v_rd_off(D0, 2, 1)>(vb), l3 = tr_read<v_rd_off(D0, 3, 0)>(vb), h3 = tr_read<v_rd_off(D0, 3, 1)>(vb);
  asm volatile("s_waitcnt lgkmcnt(0)" ::: "memory"); SBAR();
#define PK(L, H) (bf16x8){L[0], L[1], L[2], L[3], H[0], H[1], H[2], H[3]}
  od = __builtin_amdgcn_mfma_f32_32x32x16_bf16(pa0, PK(l0, h0), od, 0, 0, 0);
  od = __builtin_amdgcn_mfma_f32_32x32x16_bf16(pa1, PK(l1, h1), od, 0, 0, 0);
  od = __builtin_amdgcn_mfma_f32_32x32x16_bf16(pa2, PK(l2, h2), od, 0, 0, 0);
  od = __builtin_amdgcn_mfma_f32_32x32x16_bf16(pa3, PK(l3, h3), od, 0, 0, 0);
#undef PK
}
__device__ __forceinline__ void pv_d0(f32x16* o, int vb, bf16x8 pa0, bf16x8 pa1, bf16x8 pa2, bf16x8 pa3) {
  pv_one<0>(o[0], vb, pa0, pa1, pa2, pa3); pv_one<1>(o[1], vb, pa0, pa1, pa2, pa3); pv_one<2>(o[2], vb, pa0, pa1, pa2, pa3); pv_one<3>(o[3], vb, pa0, pa1, pa2, pa3);
}

template <typename TQ>
__device__ __forceinline__ void attn_dense_body(const TQ* __restrict__ Qb, const bf16* __restrict__ Kh, const bf16* __restrict__ Vh,
                                                unsigned char* __restrict__ Ob, int seq, char* lds, const int tid_in, const float* __restrict__ qgain, const float* __restrict__ rtab, const int t0, const bool rope) {
  using St = Stage<bf16>; using SQ = Stage<TQ>;
  int tid_ = tid_in; asm volatile("" : "+v"(tid_));
  const int tid = tid_, wid = tid >> 6, lane = tid & 63, r32 = lane & 31, hi = lane >> 5;
  bf16* V_lds = (bf16*)lds; bf16* K_lds = (bf16*)(lds + 2 * SHM_V);
  float* ws = (float*)(lds + 2 * SHM_V + 2 * SHM_K) + wid * 64; float* li_l = ws; float* al_l = ws + 32;
  float m_reg = -1e30f, l_reg = 0; f32x16 o[4] = {}; bf16x8 qr[8];
  const TQ* Qw = Qb + (long)(wid * QBLK + r32) * LDQ + hi * 8;
  { float xf[8][8]; float ss = 0.f;
#pragma unroll
    for (int d0 = 0; d0 < 8; ++d0) { const bf16x8 raw = SQ::tobf(SQ::ld8(Qw + d0 * 16));
#pragma unroll
      for (int j = 0; j < 8; ++j) { xf[d0][j] = __uint_as_float(((unsigned)(unsigned short)raw[j]) << 16); ss += xf[d0][j] * xf[d0][j]; } }
    { auto rr = __builtin_amdgcn_permlane32_swap(__float_as_uint(ss), __float_as_uint(ss), false, false); ss = __uint_as_float(rr[0]) + __uint_as_float(rr[1]); }
    const float rn = 1.0f / sqrtf(ss * (1.0f / 128.0f) + 1e-6f);
#pragma unroll
    for (int d0 = 0; d0 < 8; ++d0) {
#pragma unroll
      for (int j = 0; j < 8; ++j) xf[d0][j] *= rn * qgain[d0 * 16 + hi * 8 + j]; }
    if (rope) { const int t = t0 + wid * QBLK + r32, pr = t >> 6, pc = t & 63;
#pragma unroll
      for (int hb = 0; hb < 2; ++hb) { const int p = hb ? pc : pr;
#pragma unroll
        for (int dd = 0; dd < 2; ++dd) { const int d0 = 4 * hb + dd;
#pragma unroll
          for (int j = 0; j < 8; ++j) { const int f = dd * 16 + hi * 8 + j; const float c = rtab[(p * 32 + f) * 2], s = rtab[(p * 32 + f) * 2 + 1];
            const float x0 = xf[d0][j], x1 = xf[d0 + 2][j]; xf[d0][j] = x0 * c - x1 * s; xf[d0 + 2][j] = x1 * c + x0 * s; } } } }
#pragma unroll
    for (int d0 = 0; d0 < 8; ++d0) { u32x4 w = {cvtpk(xf[d0][0], xf[d0][1]), cvtpk(xf[d0][2], xf[d0][3]), cvtpk(xf[d0][4], xf[d0][5]), cvtpk(xf[d0][6], xf[d0][7])}; qr[d0] = *reinterpret_cast<bf16x8*>(&w); } }
  const int sr = tid >> 4, sc = (tid & 15) * 8, vst0 = v_st(sr, sc), vst1 = v_st(32 + sr, sc);
  const int vb0 = (int)(uintptr_t)V_lds + v_rd_base(lane);
  struct { typename St::T vs0, vs1, ks0, ks1; } sr_[SDEPTH];
#define SLOAD(i, k0) do { sr_[i].vs0 = St::ld8(&Vh[(long)((k0) + sr) * LDK + sc]); sr_[i].vs1 = St::ld8(&Vh[(long)((k0) + 32 + sr) * LDK + sc]); \
    sr_[i].ks0 = St::ld8(&Kh[(long)((k0) + sr) * LDK + sc]); sr_[i].ks1 = St::ld8(&Kh[(long)((k0) + 32 + sr) * LDK + sc]); } while (0)
#define SWRITE(b, i) do { *(bf16x8*)((char*)V_lds + (b) * SHM_V + vst0) = St::tobf(sr_[i].vs0);          \
    *(bf16x8*)((char*)V_lds + (b) * SHM_V + vst1) = St::tobf(sr_[i].vs1); int kc = sc * 2;               \
    *(bf16x8*)((char*)K_lds + (b) * SHM_K + KSWZ(sr, kc)) = St::tobf(sr_[i].ks0);                       \
    *(bf16x8*)((char*)K_lds + (b) * SHM_K + KSWZ(32 + sr, kc)) = St::tobf(sr_[i].ks1); } while (0)
#define SWAIT() do { if constexpr (SDEPTH == 2) asm volatile("s_waitcnt vmcnt(4)" ::: "memory"); else asm volatile("s_waitcnt vmcnt(0)" ::: "memory"); } while (0)
#define RESC(a) do { if (__any((a) < 1.f)) { if (hi == 0) al_l[r32] = (a); asm volatile("s_waitcnt lgkmcnt(0)" ::: "memory"); \
    for (int d = 0; d < 4; ++d) for (int r = 0; r < 16; ++r) o[d][r] *= al_l[crow(r, hi)]; } } while (0)
  f32x16 pA0, pA1, pB0, pB1; float mnA, mnB, alA, alB; bf16x8 pa0, pa1, pa2, pa3; const int NT = seq / KVBLK;
  constexpr int SE = 0, SO = SDEPTH - 1;
  SLOAD(SE, 0); asm volatile("s_waitcnt vmcnt(0)" ::: "memory"); SWRITE(0, SE); __syncthreads();
  qkt(pA0, pA1, K_lds, qr, r32, hi); partialSM(pA0, pA1, m_reg, mnA, alA);
  SLOAD(SO, KVBLK); if constexpr (SDEPTH == 2) { if (2 < NT) SLOAD(SE, 2 * KVBLK); }
  SWAIT(); SWRITE(1, SO); __syncthreads();
  for (int j = 1; j + 1 < NT; j += 2) {
    SBAR(); qkt(pB0, pB1, (bf16*)((char*)K_lds + SHM_K), qr, r32, hi);
    finishSM(pA0, pA1, alA, l_reg, pa0, pa1, pa2, pa3); SBAR();
    SLOAD(SO, (j + SDEPTH) * KVBLK); SBAR();
    pv_d0(o, vb0, pa0, pa1, pa2, pa3); partialSM(pB0, pB1, m_reg, mnB, alB);
    __syncthreads(); SWAIT(); SWRITE(0, SE);
    RESC(alB); __syncthreads();
    SBAR(); qkt(pA0, pA1, K_lds, qr, r32, hi);
    finishSM(pB0, pB1, alB, l_reg, pa0, pa1, pa2, pa3); SBAR();
    if (SDEPTH == 1 || j + 3 < NT) SLOAD(SE, (j + 1 + SDEPTH) * KVBLK); SBAR();
    pv_d0(o, vb0 + (int)SHM_V, pa0, pa1, pa2, pa3); partialSM(pA0, pA1, m_reg, mnA, alA);
    __syncthreads(); SWAIT(); SWRITE(1, SO);
    RESC(alA); __syncthreads();
  }
  SBAR(); qkt(pB0, pB1, (bf16*)((char*)K_lds + SHM_K), qr, r32, hi);
  finishSM(pA0, pA1, alA, l_reg, pa0, pa1, pa2, pa3); SBAR();
  pv_d0(o, vb0, pa0, pa1, pa2, pa3); partialSM(pB0, pB1, m_reg, mnB, alB);
  __syncthreads(); RESC(alB);
  finishSM(pB0, pB1, alB, l_reg, pa0, pa1, pa2, pa3); SBAR();
  pv_d0(o, vb0 + (int)SHM_V, pa0, pa1, pa2, pa3);
  if (hi == 0) li_l[r32] = l_reg; asm volatile("s_waitcnt lgkmcnt(0)" ::: "memory");
  float rli[16];
#pragma unroll
  for (int r = 0; r < 16; ++r) rli[r] = __builtin_amdgcn_rcpf(li_l[crow(r, hi)]);
  unsigned char* Ow = Ob + (long)(wid * QBLK) * LDO;
#pragma unroll
  for (int r = 0; r < 16; ++r) { int orow = crow(r, hi);
    for (int d0 = 0; d0 < 4; ++d0) { const float ov = o[d0][r] * rli[r] * 16.0f; Ow[(long)orow * LDO + d0 * 32 + r32] = (unsigned char)(__builtin_amdgcn_cvt_pk_fp8_f32(ov, ov, __builtin_bit_cast(int, ov), false) & 0xff); } }
#undef SLOAD
#undef SWRITE
#undef SWAIT
#undef RESC
}
#undef KSWZ
#undef SBAR
}

#define GAS __attribute__((address_space(1)))
#define LAS __attribute__((address_space(3)))
typedef unsigned short bf16;
typedef unsigned v4u __attribute__((ext_vector_type(4)));
typedef float f32x4 __attribute__((ext_vector_type(4)));
typedef short bf16x8 __attribute__((ext_vector_type(8)));
typedef GAS unsigned gu32;
typedef GAS unsigned long long gu64;
#define RLX_AGENT __ATOMIC_RELAXED, __HIP_MEMORY_SCOPE_AGENT
#define LDS_WAIT() asm volatile("s_waitcnt lgkmcnt(0)" ::: "memory")
#define VM_WAIT() asm volatile("s_waitcnt vmcnt(0)" ::: "memory")
__device__ __forceinline__ unsigned long long rt() { return __builtin_amdgcn_s_memrealtime(); }
__device__ __forceinline__ unsigned f2bf(float f) { unsigned u = __builtin_bit_cast(unsigned, f); return (u + 0x7fffu + ((u >> 16) & 1u)) >> 16; }
__device__ __forceinline__ unsigned pk2(float lo, float hi) { return f2bf(lo) | (f2bf(hi) << 16); }

#define XB_TMO      128
#define XB_XCNT(j)  (256  + 64 * (j))
#define XB_XSUB(j)  (1280 + 64 * (j))
#define XB_XGEN(j)  (2304 + 64 * (j))
#define XB_TOP      3328
#define XB_TOPGEN   3392
#define XCD_BAR_WORDS 3456
#define XB_SPIN_CAP (1u << 18)

__device__ __forceinline__ unsigned xb_ld(unsigned* p)              { return __hip_atomic_load(p, __ATOMIC_RELAXED, __HIP_MEMORY_SCOPE_AGENT); }
__device__ __forceinline__ unsigned xb_add(unsigned* p, unsigned v) { return __hip_atomic_fetch_add(p, v, __ATOMIC_RELAXED, __HIP_MEMORY_SCOPE_AGENT); }
__device__ __forceinline__ unsigned xb_xcc_id() { return (unsigned)__builtin_amdgcn_s_getreg((3 << 11) | 20) & 0xFu; }
#define XB_SPIN(cond, bar) do { unsigned _sp = 0; while (cond) { __builtin_amdgcn_s_sleep(1); \
    if ((++_sp & 255u) == 0u) { if (xb_ld(&(bar)[XB_TMO])) break; if (_sp > XB_SPIN_CAP) { atomicAdd(&(bar)[XB_TMO], 1u); break; } } } } while (0)

struct XcdBarrier {
    unsigned* bar; unsigned x;
    volatile LAS unsigned* st;
};

__device__ __forceinline__ XcdBarrier xcd_barrier_post(unsigned* bar, volatile LAS unsigned* st) {
    XcdBarrier b; b.bar = bar; b.x = xb_xcc_id(); b.st = st;
    if (threadIdx.x == 0) (void)xb_add(&bar[XB_XCNT(b.x)], 1u);
    return b;
}
__device__ __forceinline__ void xcd_barrier_complete(unsigned* bar, unsigned x, unsigned& nloc, unsigned& nx) {
    const unsigned G = gridDim.x * gridDim.y * gridDim.z;
    unsigned sum, cnt, mine, sp = 0u;
    for (;;) {
        sum = 0u; cnt = 0u; mine = 0u;
#pragma unroll
        for (unsigned j = 0; j < 16; ++j) { const unsigned c = xb_ld(&bar[XB_XCNT(j)]); sum += c; cnt += (c > 0u) ? 1u : 0u; mine = (j == x) ? c : mine; }
        if (sum == G) break;
        __builtin_amdgcn_s_sleep(1);
        if ((++sp & 255u) == 0u) { if (xb_ld(&bar[XB_TMO])) break; if (sp > XB_SPIN_CAP) { atomicAdd(&bar[XB_TMO], 1u); break; } }
    }
    nloc = mine > 0u ? mine : 1u; nx = cnt > 0u ? cnt : 1u;
}

__device__ __forceinline__ void xcd_barrier(const XcdBarrier& b) {
    asm volatile("s_waitcnt vmcnt(0)" ::: "memory");
    __syncthreads();
    if (threadIdx.x == 0) {
        unsigned* bar = b.bar;
        __builtin_amdgcn_s_waitcnt(0);
        unsigned nloc = b.st[0], nx = b.st[1];
        if (nloc == 0u) { xcd_barrier_complete(bar, b.x, nloc, nx); b.st[0] = nloc; b.st[1] = nx; }
        const unsigned old = xb_add(&bar[XB_XSUB(b.x)], 1u);
        const unsigned gen = old / nloc;
        if (old + 1u == (gen + 1u) * nloc) {
            __builtin_amdgcn_fence(__ATOMIC_RELEASE, "agent");
            asm volatile("s_waitcnt vmcnt(0)" ::: "memory");
            const unsigned og = xb_add(&bar[XB_TOP], 1u);
            const unsigned tg = og / nx;
            if (og + 1u == (tg + 1u) * nx) xb_add(&bar[XB_TOPGEN], 1u);
            else XB_SPIN(xb_ld(&bar[XB_TOPGEN]) == tg, bar);
            __builtin_amdgcn_fence(__ATOMIC_ACQUIRE, "agent");
            xb_add(&bar[XB_XGEN(b.x)], 1u);
            asm volatile("s_waitcnt vmcnt(0)" ::: "memory");
        } else {
            XB_SPIN(xb_ld(&bar[XB_XGEN(b.x)]) == gen, bar);
            __builtin_amdgcn_fence(__ATOMIC_ACQUIRE, "agent");
            asm volatile("s_waitcnt vmcnt(0)" ::: "memory");
        }
    }
    __syncthreads();
}
constexpr int DM = 1024, NB = 16, SEQ = 2048, CTXL = 256, TL = NB * SEQ, TC = NB * CTXL, TALL = TL + TC;
constexpr int INCOLS = 6144, OFF_FNET = 2560, OFF_GATE = 3072;
constexpr int NEXP = 32, KVROWS = SEQ + CTXL;
constexpr float EPS = 1e-6f;
constexpr int NWAVES = 8, NTHR = NWAVES * 64;
constexpr int NPL = 11, NPH = 2 + 2 * NPL;
#ifndef MK_PER_PHASE
#define MK_PER_PHASE 0
#endif
constexpr size_t MiB = 1u << 20;
constexpr size_t WS_CTL = 0, CTL_ZERO_BYTES = 1 * MiB;
constexpr size_t WS_MOD = 1 * MiB;
constexpr size_t WS_TAB = 2 * MiB;
constexpr size_t WS_TOPI = 3 * MiB, WS_TOPP = 4 * MiB, WS_SLOT = 5 * MiB, WS_CNT = 6 * MiB;
constexpr size_t WS_LOGIT = 7 * MiB;
constexpr size_t WS_WSMALL = 17 * MiB, WSMALL_LAYER = 20 * MiB;
constexpr size_t OFFS_WIN = 0, OFFS_WF = 5 * MiB, OFFS_WG = 7 * MiB, OFFS_WAO = 13 * MiB, OFFS_WCO = 15 * MiB, OFFS_WFO = 16 * MiB, OFFS_WOUT = 17 * MiB, OFFS_ROUT = 19 * MiB;
constexpr size_t WS_DFTL = 57 * MiB, WS_DFTC = 73 * MiB;
constexpr size_t WS_XC = 74 * MiB;
constexpr size_t WS_H = 90 * MiB;
constexpr size_t WS_WGU = 162 * MiB, WS_WD = 226 * MiB, MOEW_LAYER = 96 * MiB;
constexpr size_t WS_BIG = 354 * MiB;
constexpr size_t WS_Q = WS_BIG, WS_K = WS_Q + 72 * MiB, WS_V = WS_K + 18 * MiB, WS_CU = WS_V + 18 * MiB, WS_YT = WS_CU + 36 * MiB, WS_YTC = WS_YT + 64 * MiB;
constexpr size_t WS_GATES = WS_BIG;
constexpr size_t WS_AO = WS_BIG + 216 * MiB, WS_CH = WS_AO + 72 * MiB, WS_Z = WS_CH + 36 * MiB;
constexpr size_t WS_MIX = WS_AO;
constexpr size_t WS_MERGED = WS_BIG + 360 * MiB;
constexpr int SLOT_ROWS = 608 * 256;
constexpr size_t WS_YS = WS_BIG, WS_HS = WS_BIG + 304 * MiB, WS_ACT = WS_BIG + 456 * MiB, WS_END = WS_BIG + 608 * MiB;
constexpr size_t WS_XA = WS_BIG + 288 * MiB, WS_XB = WS_BIG + 528 * MiB;
constexpr size_t WS_H8 = WS_END;
constexpr size_t WS_END2 = WS_END + 36 * MiB;
static_assert(WS_YTC + 8 * MiB == WS_AO && WS_Z + 36 * MiB == WS_MERGED && WS_MERGED + 72 * MiB <= WS_END && (size_t)SLOT_ROWS * 2048 == 304 * MiB, "ws map");
constexpr int CW_TMO = 0, CW_CODE = 1, CW_BAR = 4096;
constexpr int CNT_ROWSRC = 32768;
constexpr int CNT_TILE_E = 16384, CNT_NT = 16384 + 1024;

constexpr int RING_OFF = 0, RING_BYTES = 131072;
constexpr int LDSCTL_OFF = RING_BYTES, MISC_OFF = LDSCTL_OFF + 320, LDS_CT = LDSCTL_OFF + 512, LDS_SM = LDSCTL_OFF + 1024;
constexpr int LDS_BYTES = 155648;

typedef unsigned u32x2 __attribute__((ext_vector_type(2)));
typedef int i32x4 __attribute__((ext_vector_type(4)));
typedef float f32x2 __attribute__((ext_vector_type(2)));
struct Args { const float* in[29]; float* out; unsigned char* ws; int ph_lo, ph_hi; };
typedef const __attribute__((address_space(4))) unsigned char* kptr_t;
struct AV {
    kptr_t kp;
    __device__ __forceinline__ const float* in(int i) const { return *(const float* const __attribute__((address_space(4)))*)(kp + 8 * i); }
    __device__ __forceinline__ float* out() const { return *(float* const __attribute__((address_space(4)))*)(kp + 8 * 29); }
    __device__ __forceinline__ unsigned char* ws() const { return *(unsigned char* const __attribute__((address_space(4)))*)(kp + 8 * 30); }
};
__device__ __forceinline__ AV av_get() { AV a; a.kp = (kptr_t)__builtin_amdgcn_kernarg_segment_ptr(); asm volatile("" : "+s"(a.kp)); return a; }

struct Frame {
    LAS unsigned char* lds; volatile LAS unsigned* MISC; gu32* ctl;
    int tid, lane, wave, vcu, G;
};

__device__ __forceinline__ float shx(float v, int m, int lane) { return __int_as_float(__builtin_amdgcn_ds_bpermute((lane ^ m) << 2, __float_as_int(v))); }
__device__ __forceinline__ float wave_sum(float v, int lane) {
#pragma unroll
    for (int o = 1; o < 64; o <<= 1) v += shx(v, o, lane);
    return v;
}
__device__ __forceinline__ float sigmoidf_(float x) { return 1.0f / (1.0f + __expf(-x)); }
__device__ __forceinline__ f32x4 bf4(u32x2 w) { f32x4 r; r[0] = __uint_as_float(w.x << 16); r[1] = __uint_as_float(w.x & 0xffff0000u); r[2] = __uint_as_float(w.y << 16); r[3] = __uint_as_float(w.y & 0xffff0000u); return r; }
__device__ __forceinline__ u32x2 pk4(f32x4 v) { u32x2 w; w.x = pk2(v[0], v[1]); w.y = pk2(v[2], v[3]); return w; }
__device__ __forceinline__ void ld_row_f32(f32x4 (&v)[4], const float* p, int lane) {
#pragma unroll
    for (int j = 0; j < 4; ++j) v[j] = ((const GAS f32x4*)p)[lane + 64 * j];
}
__device__ __forceinline__ void st_row_f32(const f32x4 (&v)[4], float* p, int lane) {
#pragma unroll
    for (int j = 0; j < 4; ++j) ((GAS f32x4*)p)[lane + 64 * j] = v[j];
}
__device__ __forceinline__ void ld_row_bf16(f32x4 (&v)[4], const bf16* p, int lane) {
#pragma unroll
    for (int j = 0; j < 4; ++j) v[j] = bf4(((const GAS u32x2*)p)[lane + 64 * j]);
}
__device__ __forceinline__ void st_row_bf16(const f32x4 (&v)[4], bf16* p, int lane) {
#pragma unroll
    for (int j = 0; j < 4; ++j) ((GAS u32x2*)p)[lane + 64 * j] = pk4(v[j]);
}
__device__ __forceinline__ void rms_gain(f32x4 (&v)[4], const float* g, int lane) {
    float ss = 0.f;
#pragma unroll
    for (int j = 0; j < 4; ++j) ss += (v[j][0] * v[j][0] + v[j][1] * v[j][1]) + (v[j][2] * v[j][2] + v[j][3] * v[j][3]);
    const float r = 1.0f / sqrtf(wave_sum(ss, lane) * (1.0f / 1024.0f) + EPS);
#pragma unroll
    for (int j = 0; j < 4; ++j) { const f32x4 gg = ((const GAS f32x4*)g)[lane + 64 * j]; v[j] = v[j] * r * gg; }
}
__device__ __forceinline__ void modulate_store(const f32x4 (&v)[4], const float* shift, const float* scale, bf16* o, int lane) {
#pragma unroll
    for (int j = 0; j < 4; ++j) { const f32x4 sh = ((const GAS f32x4*)shift)[lane + 64 * j], sc = ((const GAS f32x4*)scale)[lane + 64 * j];
        ((GAS u32x2*)o)[lane + 64 * j] = pk4(v[j] * (sc + 1.0f) + sh); }
}
__device__ __forceinline__ unsigned pk4_fp8(f32x4 v) { return pg8::cvt4_fp8(v[0], v[1], v[2], v[3]); }
__device__ __forceinline__ void modulate_store2(const f32x4 (&v)[4], const float* shift, const float* scale, bf16* o, unsigned char* o8, int lane) {
#pragma unroll
    for (int j = 0; j < 4; ++j) { const f32x4 sh = ((const GAS f32x4*)shift)[lane + 64 * j], sc = ((const GAS f32x4*)scale)[lane + 64 * j]; const f32x4 r = v[j] * (sc + 1.0f) + sh;
        ((GAS u32x2*)o)[lane + 64 * j] = pk4(r); ((GAS unsigned*)o8)[lane + 64 * j] = pk4_fp8(r); }
}
__device__ __forceinline__ f32x4 fp8x4(unsigned w) { const f32x2 a = __builtin_amdgcn_cvt_pk_f32_fp8((int)w, false), b = __builtin_amdgcn_cvt_pk_f32_fp8((int)w, true); return (f32x4){a.x, a.y, b.x, b.y}; }
__device__ __forceinline__ int krow_of(int m) { return m < TL ? (m >> 11) * KVROWS + (m & 2047) : ((m - TL) >> 8) * KVROWS + SEQ + ((m - TL) & 255); }

__device__ __forceinline__ void load_block(const float* W, int ldw, int k0, int n0, float scale, LAS float* scr, int lane) {
    f32x4 v[8]; const int kr = lane >> 3, c4 = (lane & 7) * 4;
#pragma unroll
    for (int i = 0; i < 8; ++i) v[i] = *(const GAS f32x4*)(W + (size_t)(k0 + kr + 8 * i) * ldw + n0 + c4);
#pragma unroll
    for (int i = 0; i < 8; ++i) { LAS float* d = scr + (kr + 8 * i) * 33 + c4; d[0] = v[i][0] * scale; d[1] = v[i][1] * scale; d[2] = v[i][2] * scale; d[3] = v[i][3] * scale; }
    LDS_WAIT(); asm volatile("" ::: "memory");
}
__device__ __forceinline__ void transpose_item(const float* W, int ldw, int K, bf16* WT, int dst_row0, int k0, int n0, LAS float* scr, int lane) {
    load_block(W, ldw, k0, n0, 1.0f, scr, lane);
    const int c = lane & 7;
#pragma unroll
    for (int j = 0; j < 4; ++j) { const int n = (lane >> 3) + 8 * j; const LAS float* s = scr + (8 * c) * 33 + n;
        v4u o; o.x = pk2(s[0 * 33], s[1 * 33]); o.y = pk2(s[2 * 33], s[3 * 33]); o.z = pk2(s[4 * 33], s[5 * 33]); o.w = pk2(s[6 * 33], s[7 * 33]);
        *(GAS v4u*)(WT + (size_t)(dst_row0 + n) * K + k0 + 8 * c) = o; }
    LDS_WAIT(); asm volatile("" ::: "memory");
}
__device__ __forceinline__ void transpose_item_fp8(const float* W, int ldw, int K, unsigned char* WT, int dst_row0, int k0, int n0, float scale, LAS float* scr, int lane) {
    load_block(W, ldw, k0, n0, scale, scr, lane);
#pragma unroll
    for (int j = 0; j < 2; ++j) { const int q = lane + 64 * j, n = q >> 2, c = q & 3; const LAS float* s = scr + (16 * c) * 33 + n; v4u o;
        o.x = pg8::cvt4_fp8(s[0 * 33], s[1 * 33], s[2 * 33], s[3 * 33]); o.y = pg8::cvt4_fp8(s[4 * 33], s[5 * 33], s[6 * 33], s[7 * 33]); o.z = pg8::cvt4_fp8(s[8 * 33], s[9 * 33], s[10 * 33], s[11 * 33]); o.w = pg8::cvt4_fp8(s[12 * 33], s[13 * 33], s[14 * 33], s[15 * 33]);
        *(GAS v4u*)(WT + (size_t)(dst_row0 + n) * K + k0 + 16 * c) = o; }
    LDS_WAIT(); asm volatile("" ::: "memory");
}
constexpr int IT_S0 = 16 * 80, IT_S1 = 16 * 96, IT_S2 = 512, IT_S3 = 512, IT_S4 = 256, IT_S5 = 256, IT_SMALL = IT_S0 + IT_S1 + IT_S2 + IT_S3 + IT_S4 + IT_S5;
__device__ __forceinline__ void small_item(const AV& a, int l, int r, LAS float* scr, int lane) {
    unsigned char* wl = a.ws() + WS_WSMALL + (size_t)l * WSMALL_LAYER; const float* win = a.in(10) + (size_t)l * DM * INCOLS;
    if (r < IT_S0) { const int kb = r / 80, n0 = (r % 80) * 32; int dr;
        if (n0 < 1536) dr = n0; else { int cc = n0 - 1536; if (cc < 512) dr = 1536 + (cc >> 7) * 256 + (cc & 127); else { cc -= 512; dr = 1536 + (cc >> 7) * 256 + 128 + (cc & 127); } }
        transpose_item_fp8(win, INCOLS, DM, wl + OFFS_WIN, dr, kb * 64, n0, 32.0f, scr, lane); return; }
    r -= IT_S0;
    if (r < IT_S1) { const int kb = r / 96, nb = r % 96; transpose_item_fp8(win, INCOLS, DM, wl + OFFS_WG, nb * 32, kb * 64, OFF_GATE + nb * 32, 32.0f, scr, lane); return; }
    r -= IT_S1;
    if (r < IT_S2) { const int kb = r / 32, nb = r % 32; transpose_item_fp8(a.in(13) + (size_t)l * DM * DM, DM, DM, wl + OFFS_WAO, nb * 32, kb * 64, nb * 32, 32.0f, scr, lane); return; }
    r -= IT_S2;
    if (r < IT_S3) { const int kb = r / 32, nb = r % 32; transpose_item(a.in(20) + (size_t)l * DM * DM, DM, DM, (bf16*)(wl + OFFS_WOUT), nb * 32, kb * 64, nb * 32, scr, lane); return; }
    r -= IT_S3;
    if (r < IT_S4) { const int kb = r / 32, nb = r % 32; transpose_item(a.in(18) + (size_t)l * 512 * DM, DM, 512, (bf16*)(wl + OFFS_WCO), nb * 32, kb * 64, nb * 32, scr, lane); return; }
    r -= IT_S4;
    { const int kb = r / 32, nb = r % 32; transpose_item(a.in(19) + (size_t)l * 512 * DM, DM, 512, (bf16*)(wl + OFFS_WFO), nb * 32, kb * 64, nb * 32, scr, lane); }
}
constexpr int IT_MOE = NEXP * 3 * 512;
struct MoeIt { const float* W; unsigned char* WT; int dr, k0; };
__device__ __forceinline__ MoeIt moe_decode(const AV& a, int gi) {
    const int l = gi / IT_MOE, idx = gi % IT_MOE, e = idx / 1536, r = idx % 1536, which = r / 512, it = r % 512, kb = it / 32, n0 = (it % 32) * 32; const size_t eo = ((size_t)l * NEXP + e) << 20;
    MoeIt m; m.k0 = kb * 64;
    if (which == 0) { m.W = a.in(23) + eo + n0; m.WT = a.ws() + WS_WGU + (size_t)l * MOEW_LAYER + (size_t)e * 2048 * 1024; m.dr = (n0 >> 7) * 256 + (n0 & 127); }
    else if (which == 1) { m.W = a.in(25) + eo + n0; m.WT = a.ws() + WS_WGU + (size_t)l * MOEW_LAYER + (size_t)e * 2048 * 1024; m.dr = (n0 >> 7) * 256 + 128 + (n0 & 127); }
    else { m.W = a.in(27) + eo + n0; m.WT = a.ws() + WS_WD + (size_t)l * MOEW_LAYER + (size_t)e * 1024 * 1024; m.dr = n0; }
    return m;
}
__device__ __forceinline__ void moe_issue(f32x4 (&v)[8], const MoeIt& m, int lane) {
    const float* p = m.W + (size_t)(m.k0 + (lane >> 3)) * DM + (lane & 7) * 4;
#pragma unroll
    for (int i = 0; i < 8; ++i) v[i] = __builtin_nontemporal_load((const GAS f32x4*)(p + (size_t)(8 * i) * DM));
}
__device__ __forceinline__ void moe_finish(const f32x4 (&v)[8], const MoeIt& m, LAS float* scr, int lane) {
    const int kr = lane >> 3, c4 = (lane & 7) * 4;
#pragma unroll
    for (int i = 0; i < 8; ++i) { LAS float* d = scr + (kr + 8 * i) * 33 + c4; d[0] = v[i][0] * 32.0f; d[1] = v[i][1] * 32.0f; d[2] = v[i][2] * 32.0f; d[3] = v[i][3] * 32.0f; }
    LDS_WAIT(); asm volatile("" ::: "memory");
#pragma unroll
    for (int j = 0; j < 2; ++j) { const int q = lane + 64 * j, n = q >> 2, c = q & 3; const LAS float* s = scr + (16 * c) * 33 + n; v4u o;
        o.x = pg8::cvt4_fp8(s[0 * 33], s[1 * 33], s[2 * 33], s[3 * 33]); o.y = pg8::cvt4_fp8(s[4 * 33], s[5 * 33], s[6 * 33], s[7 * 33]); o.z = pg8::cvt4_fp8(s[8 * 33], s[9 * 33], s[10 * 33], s[11 * 33]); o.w = pg8::cvt4_fp8(s[12 * 33], s[13 * 33], s[14 * 33], s[15 * 33]);
        *(GAS v4u*)(m.WT + (size_t)(m.dr + n) * DM + m.k0 + 16 * c) = o; }
    LDS_WAIT(); asm volatile("" ::: "memory");
}
__device__ __forceinline__ void moe_convert_range(const AV& a, int base, int count, int gw, int NGW, LAS float* scr, int lane) {
    f32x4 va[8], vb[8]; int it = gw; if (it >= count) return;
    MoeIt ma = moe_decode(a, base + it), mb = ma; moe_issue(va, ma, lane);
    for (;;) {
        const bool h1 = it + NGW < count; if (h1) { mb = moe_decode(a, base + it + NGW); moe_issue(vb, mb, lane); }
        moe_finish(va, ma, scr, lane); if (!h1) break; it += NGW;
        const bool h2 = it + NGW < count; if (h2) { ma = moe_decode(a, base + it + NGW); moe_issue(va, ma, lane); }
        moe_finish(vb, mb, scr, lane); if (!h2) break; it += NGW;
    }
}
#ifndef FILL_A_PER_WAVE
#define FILL_A_PER_WAVE 14
#endif
#ifndef FILL_B_PER_WAVE
#define FILL_B_PER_WAVE 6
#endif
constexpr int FILL_WG0 = 64, FILL_NGW = (256 - FILL_WG0) * NWAVES, FILL_A = FILL_NGW * FILL_A_PER_WAVE, FILL_B = FILL_NGW * FILL_B_PER_WAVE;
static_assert(FILL_A + FILL_B <= IT_MOE, "tail filler converts layer-0 expert weights only");
__device__ __forceinline__ void fold_job(const AV& a, int j, const LAS float* ct, int lane) {
    const int l = j >> 10, r = j & 1023, g = r >> 8, kblk = (r >> 4) & 15, k2g = r & 15, k = kblk * 64 + lane;
    const float* wrow = a.in(10) + (size_t)l * DM * INCOLS + (size_t)k * INCOLS + OFF_FNET + g * 128;
    float ac[8], as[8];
#pragma unroll
    for (int i = 0; i < 8; ++i) { ac[i] = 0.f; as[i] = 0.f; }
    for (int n4 = 0; n4 < 32; ++n4) { const f32x4 w = *(const GAS f32x4*)(wrow + n4 * 4);
#pragma unroll
        for (int q = 0; q < 4; ++q) { const int n2 = n4 * 4 + q;
#pragma unroll
            for (int i = 0; i < 8; ++i) { const int ph = (n2 * (k2g * 8 + i)) & 127; ac[i] += w[q] * ct[ph]; as[i] += w[q] * ct[(ph - 32) & 127]; } } }
    bf16* wf = (bf16*)(a.ws() + WS_WSMALL + (size_t)l * WSMALL_LAYER + OFFS_WF);
#pragma unroll
    for (int i = 0; i < 8; ++i) { const int ch = g * 128 + k2g * 8 + i;
        wf[(size_t)ch * 1024 + k] = (bf16)f2bf(ac[i] * 0.08838834764831845f); wf[(size_t)(512 + ch) * 1024 + k] = (bf16)f2bf(as[i] * 0.08838834764831845f); }
}
__device__ __forceinline__ void p0_prologue(const Frame& F, const AV& a) {
    const int gw = F.vcu * NWAVES + F.wave, NGW = F.G * NWAVES, gt = F.vcu * NTHR + F.tid, NGT = F.G * NTHR;
    LAS float* ct = (LAS float*)(F.lds + LDS_CT);
    if (F.tid < 128) ct[F.tid] = cospif((float)F.tid * (1.0f / 64.0f));
    for (int job = blockIdx.x; job < 2 * 96; job += F.G) {
        const int l = job / 96, n0 = (job % 96) * 64;
        LAS float* s = (LAS float*)(F.lds + RING_OFF); LAS float* red = s + 17 * 1024;
        for (int i = F.tid; i < 17 * 1024; i += NTHR) { const int b = i >> 10, k = i & 1023; const float cv = b < 16 ? a.in(1)[b * 1024 + k] : a.in(3)[k]; s[i] = cv * sigmoidf_(cv); }
        __syncthreads();
        const int col = F.tid & 63, ks = F.tid >> 6; float acc[17];
#pragma unroll
        for (int b = 0; b < 17; ++b) acc[b] = 0.f;
        const float* w = a.in(4) + (size_t)l * DM * INCOLS + n0 + col;
        for (int k = ks * 128; k < ks * 128 + 128; k += 16) { float wv[16];
#pragma unroll
            for (int q = 0; q < 16; ++q) wv[q] = w[(size_t)(k + q) * INCOLS];
#pragma unroll
            for (int q = 0; q < 16; ++q)
#pragma unroll
                for (int b = 0; b < 17; ++b) acc[b] += s[b * 1024 + k + q] * wv[q]; }
#pragma unroll
        for (int b = 0; b < 17; ++b) red[(ks * 17 + b) * 64 + col] = acc[b];
        __syncthreads();
        for (int i = F.tid; i < 17 * 64; i += NTHR) { const int b = i >> 6, c2 = i & 63; float t = 0.f;
#pragma unroll
            for (int q = 0; q < 8; ++q) t += red[(q * 17 + b) * 64 + c2];
            ((float*)(a.ws() + WS_MOD))[((size_t)l * 17 + b) * INCOLS + n0 + c2] = t + a.in(5)[l * INCOLS + n0 + c2]; }
        __syncthreads();
    }
    __syncthreads();
    for (int i = gt; i < 64 * 32; i += NGT) { const int p = i >> 5, f = i & 31; const float inv = powf(10000.0f, -(float)f / 32.0f), ang = (float)p * inv; ((f32x2*)(a.ws() + WS_TAB))[i] = (f32x2){cosf(ang), sinf(ang)}; }
    for (int i = gt; i < 2048 * 256; i += NGT) { const int k1 = i >> 8, c0 = (i & 255) * 16; float v[16];
#pragma unroll
        for (int q = 0; q < 16; ++q) { const int col = c0 + q, n1 = col & 2047, rr = (k1 * n1) & 2047; const float x = (float)rr * (1.0f / 1024.0f); v[q] = ((col >> 11) ? -sinpif(x) : cospif(x)) * (32.0f * 0.022097086912079608f); }
        v4u o; o.x = pk4_fp8((f32x4){v[0], v[1], v[2], v[3]}); o.y = pk4_fp8((f32x4){v[4], v[5], v[6], v[7]}); o.z = pk4_fp8((f32x4){v[8], v[9], v[10], v[11]}); o.w = pk4_fp8((f32x4){v[12], v[13], v[14], v[15]}); ((GAS v4u*)(a.ws() + WS_DFTL))[i] = o; }
    for (int i = gt; i < 256 * 32; i += NGT) { const int k1 = i >> 5, c0 = (i & 31) * 16; float v[16];
#pragma unroll
        for (int q = 0; q < 16; ++q) { const int col = c0 + q, n1 = col & 255, rr = (k1 * n1) & 255; const float x = (float)rr * (1.0f / 128.0f); v[q] = ((col >> 8) ? -sinpif(x) : cospif(x)) * (32.0f * 0.0625f); }
        v4u o; o.x = pk4_fp8((f32x4){v[0], v[1], v[2], v[3]}); o.y = pk4_fp8((f32x4){v[4], v[5], v[6], v[7]}); o.z = pk4_fp8((f32x4){v[8], v[9], v[10], v[11]}); o.w = pk4_fp8((f32x4){v[12], v[13], v[14], v[15]}); ((GAS v4u*)(a.ws() + WS_DFTC))[i] = o; }
    for (int i = gt; i < 2 * 256 * 1024; i += NGT) { const int l = i >> 18, r = (i >> 10) & 255, k = i & 1023; unsigned o = 0u;
        if (r < 64) { const float w = a.in(21)[((size_t)l * DM + k) * NEXP + (r & 31)]; const unsigned hi = f2bf(w); o = hi; if (r >= 32) o = f2bf(w - __uint_as_float(hi << 16)); }
        ((bf16*)(a.ws() + WS_WSMALL + (size_t)l * WSMALL_LAYER + OFFS_ROUT))[(size_t)r * 1024 + k] = (bf16)o; }
    for (int j = gw; j < 2048; j += NGW) fold_job(a, j, ct, F.lane);
    LAS float* scr = (LAS float*)(F.lds + RING_OFF + F.wave * 16384);
    for (int it = gw; it < 2 * IT_SMALL; it += NGW) small_item(a, it / IT_SMALL, it % IT_SMALL, scr, F.lane);
    { const int fill = (F.G == 256) ? FILL_A + FILL_B : 0; moe_convert_range(a, fill, 2 * IT_MOE - fill, gw, NGW, scr, F.lane); }
}
__device__ __forceinline__ void ld4(f32x4 (&v)[4], const float* p, int lane) {
#pragma unroll
    for (int j = 0; j < 4; ++j) v[j] = ((const GAS f32x4*)p)[lane + 64 * j];
}
__device__ __forceinline__ float sumsq4(const f32x4 (&v)[4]) { float ss = 0.f;
#pragma unroll
    for (int j = 0; j < 4; ++j) ss += (v[j][0] * v[j][0] + v[j][1] * v[j][1]) + (v[j][2] * v[j][2] + v[j][3] * v[j][3]);
    return ss; }
__device__ __forceinline__ void p1_norm0(const Frame& F, const AV& a) {
    const int gw = F.vcu * NWAVES + F.wave, NGW = F.G * NWAVES, rpw = (TALL + NGW - 1) / NGW, r0 = gw * rpw, r1 = (r0 + rpw < TALL) ? r0 + rpw : TALL;
    if (r0 >= r1) return;
    f32x4 gpre[4], shift[4], scale[4], xn[4]; ld4(gpre, a.in(6), F.lane); int cb = -1;
    auto xsrc = [&](int m) -> const float* { return m < TL ? a.in(0) + (size_t)m * DM : a.in(2) + (size_t)(m - TL) * DM; };
    ld4(xn, xsrc(r0), F.lane);
    for (int m = r0; m < r1; ++m) {
        f32x4 x[4];
#pragma unroll
        for (int j = 0; j < 4; ++j) x[j] = xn[j];
        if (m + 1 < r1) ld4(xn, xsrc(m + 1), F.lane);
        const int b = m < TL ? (m >> 11) : 16;
        if (b != cb) { cb = b; const float* mv = (const float*)(a.ws() + WS_MOD) + (size_t)b * INCOLS; ld4(shift, mv, F.lane); ld4(scale, mv + 1024, F.lane); }
        const float r = 1.0f / sqrtf(wave_sum(sumsq4(x), F.lane) * (1.0f / 1024.0f) + EPS);
        bf16* ho = (bf16*)(a.ws() + WS_H) + (size_t)m * DM; unsigned char* h8 = a.ws() + WS_H8 + (size_t)m * DM;
#pragma unroll
        for (int j = 0; j < 4; ++j) { const f32x4 hv = x[j] * r * gpre[j] * (scale[j] + 1.0f) + shift[j]; ((GAS u32x2*)ho)[F.lane + 64 * j] = pk4(hv); ((GAS unsigned*)h8)[F.lane + 64 * j] = pk4_fp8(hv); }
    }
}
__device__ __forceinline__ void qk_fix_core(f32x4 (&x)[4], const f32x4 (&gg)[4], const f32x2* tab, bool rope, int t, int sub, int lane) {
    float ss = sumsq4(x); ss += shx(ss, 1, lane); ss += shx(ss, 2, lane); ss += shx(ss, 4, lane);
    const float r = 1.0f / sqrtf(ss * (1.0f / 128.0f) + EPS);
#pragma unroll
    for (int jj = 0; jj < 4; ++jj) x[jj] = x[jj] * r * gg[jj];
    if (rope) { const int pr = t >> 6, pc = t & 63;
#pragma unroll
        for (int i = 0; i < 4; ++i) { const f32x2 cr = tab[pr * 32 + sub * 4 + i], cc = tab[pc * 32 + sub * 4 + i];
            const float a0 = x[0][i], a1 = x[1][i], b0 = x[2][i], b1 = x[3][i];
            x[0][i] = a0 * cr.x - a1 * cr.y; x[1][i] = a1 * cr.x + a0 * cr.y; x[2][i] = b0 * cc.x - b1 * cc.y; x[3][i] = b1 * cc.x + b0 * cc.y; } }
}
__device__ __forceinline__ void p_qkfix(const Frame& F, const AV& a, int l, int M) {
    const int gw = F.vcu * NWAVES + F.wave, NGW = F.G * NWAVES, rpw = 4 * ((M + 4 * NGW - 1) / (4 * NGW)), r0 = gw * rpw, r1 = (r0 + rpw < M) ? r0 + rpw : M;
    if (r0 >= r1) return;
    const f32x2* tab = (const f32x2*)(a.ws() + WS_TAB); const int rs = F.lane >> 4, hh = (F.lane >> 3) & 1, sub = F.lane & 7;
    f32x4 gk[4];
#pragma unroll
    for (int jj = 0; jj < 4; ++jj) gk[jj] = *(const GAS f32x4*)(a.in(12) + l * 128 + jj * 32 + sub * 4);
    bf16* kb = (bf16*)(a.ws() + WS_K);
    u32x2 kn[4];
    auto issue = [&](int mb) { const int m = mb + rs; if (m < r1) { const bf16* kp = kb + (size_t)krow_of(m) * 256 + hh * 128 + sub * 4;
#pragma unroll
        for (int jj = 0; jj < 4; ++jj) kn[jj] = *(const GAS u32x2*)(kp + jj * 32); } };
    issue(r0);
    for (int mb = r0; mb < r1; mb += 4) { const int m = mb + rs; const bool act = m < r1;
        f32x4 xk[4];
#pragma unroll
        for (int jj = 0; jj < 4; ++jj) xk[jj] = bf4(kn[jj]);
        if (mb + 4 < r1) issue(mb + 4);
        qk_fix_core(xk, gk, tab, m < TL, m & 2047, sub, F.lane);
        if (act) { bf16* kp = kb + (size_t)krow_of(m) * 256 + hh * 128 + sub * 4;
#pragma unroll
            for (int jj = 0; jj < 4; ++jj) *(GAS u32x2*)(kp + jj * 32) = pk4(xk[jj]); }
    }
}
__device__ __forceinline__ void p_conv(const Frame& F, const AV& a, int l, int njobs) {
    LAS unsigned char* lin = F.lds + RING_OFF; LAS float* lout = (LAS float*)(F.lds + RING_OFF + 62 * 1024);
    const bf16* cu = (const bf16*)(a.ws() + WS_CU); bf16* chb = (bf16*)(a.ws() + WS_CH);
    const int cp = F.tid & 255, pg = F.tid >> 8;
    f32x2 wv[31];
#pragma unroll
    for (int j = 0; j < 31; ++j) wv[j] = *(const GAS f32x2*)(a.in(14) + ((size_t)l * 31 + j) * 512 + 2 * cp);
    const f32x2 cb2 = *(const GAS f32x2*)(a.in(15) + l * 512 + 2 * cp);
    for (int job = F.vcu; job < njobs; job += F.G) {
        int rowbase, L, t0;
        if (job < 1024) { rowbase = (job >> 6) * SEQ; L = SEQ; t0 = (job & 63) * 32; } else { const int jc = job - 1024; rowbase = TL + (jc >> 3) * CTXL; L = CTXL; t0 = (jc & 7) * 32; }
        for (int idx = F.tid; idx < 62 * 64; idx += NTHR) { const int row = idx >> 6, ch = idx & 63, p = t0 - 15 + row; v4u val = (v4u){0u, 0u, 0u, 0u};
            if (p >= 0 && p < L) val = *(const GAS v4u*)(cu + (size_t)(rowbase + p) * 512 + ch * 8);
            *(LAS v4u*)(lin + row * 1024 + ch * 16) = val; }
        __syncthreads();
#pragma unroll
        for (int chunk = 0; chunk < 2; ++chunk) {
            f32x2 acc[8];
#pragma unroll
            for (int i = 0; i < 8; ++i) acc[i] = cb2;
            const int r0 = pg * 16 + chunk * 8;
#pragma unroll
            for (int r = 0; r < 38; ++r) { const unsigned w = *(const LAS unsigned*)(lin + (r0 + r) * 1024 + cp * 4); const float x0 = __uint_as_float(w << 16), x1 = __uint_as_float(w & 0xffff0000u);
#pragma unroll
                for (int i = 0; i < 8; ++i) { const int j = r - i; if (j >= 0 && j <= 30) { acc[i].x += x0 * wv[j].x; acc[i].y += x1 * wv[j].y; } } }
#pragma unroll
            for (int i = 0; i < 8; ++i) *(LAS f32x2*)(lout + (r0 + i) * 512 + 2 * cp) = acc[i];
        }
        __syncthreads();
#pragma unroll
        for (int pp = 0; pp < 4; ++pp) { const int p = F.wave * 4 + pp; const LAS float* src = lout + p * 512 + F.lane * 8;
            f32x4 y0 = *(const LAS f32x4*)src, y1 = *(const LAS f32x4*)(src + 4);
            const float mean = wave_sum((y0[0] + y0[1]) + (y0[2] + y0[3]) + (y1[0] + y1[1]) + (y1[2] + y1[3]), F.lane) * (1.0f / 512.0f);
            y0 = y0 - mean; y1 = y1 - mean;
            const float var = wave_sum((y0[0] * y0[0] + y0[1] * y0[1]) + (y0[2] * y0[2] + y0[3] * y0[3]) + (y1[0] * y1[0] + y1[1] * y1[1]) + (y1[2] * y1[2] + y1[3] * y1[3]), F.lane) * (1.0f / 512.0f);
            const float rs = 1.0f / sqrtf(var + EPS);
            const f32x4 g0 = *(const GAS f32x4*)(a.in(16) + l * 512 + F.lane * 8), g1 = *(const GAS f32x4*)(a.in(16) + l * 512 + F.lane * 8 + 4);
            const f32x4 b0 = *(const GAS f32x4*)(a.in(17) + l * 512 + F.lane * 8), b1 = *(const GAS f32x4*)(a.in(17) + l * 512 + F.lane * 8 + 4);
            y0 = y0 * rs * g0 + b0; y1 = y1 * rs * g1 + b1;
#pragma unroll
            for (int q = 0; q < 4; ++q) { y0[q] = y0[q] * sigmoidf_(y0[q]); y1[q] = y1[q] * sigmoidf_(y1[q]); }
            v4u o; o.x = pk2(y0[0], y0[1]); o.y = pk2(y0[2], y0[3]); o.z = pk2(y1[0], y1[1]); o.w = pk2(y1[2], y1[3]);
            *(GAS v4u*)(chb + (size_t)(rowbase + t0 + p) * 512 + F.lane * 8) = o; }
        __syncthreads();
    }
}
__device__ __forceinline__ void p_rowpass1(const Frame& F, const AV& a, int l, int M) {
    const int gw = F.vcu * NWAVES + F.wave, NGW = F.G * NWAVES, rpw = (M + NGW - 1) / NGW, r0 = gw * rpw, r1 = (r0 + rpw < M) ? r0 + rpw : M;
    if (r0 >= r1) return;
    const float* modb = (const float*)(a.ws() + WS_MOD) + (size_t)l * 17 * INCOLS; const bf16* mixb = (const bf16*)(a.ws() + WS_MIX);
    f32x4 gpost[4], gpre[4], gate[4], shift[4], scale[4]; ld4(gpost, a.in(7) + l * DM, F.lane); ld4(gpre, a.in(8) + l * DM, F.lane);
    int cb = -1;
    auto xsrc = [&](int m) -> const float* { return m < TL ? a.in(0) + (size_t)m * DM : a.in(2) + (size_t)(m - TL) * DM; };
    const bf16* xbb = (const bf16*)(a.ws() + WS_XB); bf16* xab = (bf16*)(a.ws() + WS_XA);
    f32x4 xn[4]; u32x2 xbn[4]; u32x2 mn[4];
    if (l == 0) ld4(xn, xsrc(r0), F.lane); else {
#pragma unroll
        for (int j = 0; j < 4; ++j) xbn[j] = ((const GAS u32x2*)(xbb + (size_t)r0 * DM))[F.lane + 64 * j]; }
#pragma unroll
    for (int j = 0; j < 4; ++j) mn[j] = ((const GAS u32x2*)(mixb + (size_t)r0 * DM))[F.lane + 64 * j];
    for (int m = r0; m < r1; ++m) {
        f32x4 x[4], y[4];
#pragma unroll
        for (int j = 0; j < 4; ++j) { x[j] = (l == 0) ? xn[j] : bf4(xbn[j]); y[j] = bf4(mn[j]); }
        if (m + 1 < r1) { if (l == 0) ld4(xn, xsrc(m + 1), F.lane); else {
#pragma unroll
                for (int j = 0; j < 4; ++j) xbn[j] = ((const GAS u32x2*)(xbb + (size_t)(m + 1) * DM))[F.lane + 64 * j]; }
#pragma unroll
            for (int j = 0; j < 4; ++j) mn[j] = ((const GAS u32x2*)(mixb + (size_t)(m + 1) * DM))[F.lane + 64 * j]; }
        const int b = m < TL ? (m >> 11) : 16;
        if (b != cb) { cb = b; const float* mv = modb + (size_t)b * INCOLS; ld4(gate, mv + 2 * 1024, F.lane); ld4(shift, mv + 3 * 1024, F.lane); ld4(scale, mv + 4 * 1024, F.lane); }
        const float r = 1.0f / sqrtf(wave_sum(sumsq4(y), F.lane) * (1.0f / 1024.0f) + EPS);
#pragma unroll
        for (int j = 0; j < 4; ++j) x[j] = x[j] + gate[j] * (y[j] * r * gpost[j]);
#pragma unroll
        for (int j = 0; j < 4; ++j) ((GAS u32x2*)(xab + (size_t)m * DM))[F.lane + 64 * j] = pk4(x[j]);
        const float r2 = 1.0f / sqrtf(wave_sum(sumsq4(x), F.lane) * (1.0f / 1024.0f) + EPS);
        bf16* ho = (bf16*)(a.ws() + WS_H) + (size_t)m * DM; unsigned char* h8 = a.ws() + WS_H8 + (size_t)m * DM;
#pragma unroll
        for (int j = 0; j < 4; ++j) { const f32x4 hv = x[j] * r2 * gpre[j] * (scale[j] + 1.0f) + shift[j]; ((GAS u32x2*)ho)[F.lane + 64 * j] = pk4(hv); ((GAS unsigned*)h8)[F.lane + 64 * j] = pk4_fp8(hv); }
    }
}
__device__ __forceinline__ void p_route(const Frame& F, const AV& a, int l, int M) {
    typedef short bfx8 __attribute__((ext_vector_type(8)));
    const int NGW = F.G * NWAVES, rpw = (M + NGW - 1) / NGW, TPB = 8 * rpw, b0 = F.vcu * TPB, b1 = (b0 + TPB < M) ? b0 + TPB : M;
    LAS unsigned char* tabl = F.lds + RING_OFF; LAS float* lg = (LAS float*)(F.lds + LDS_SM) + F.wave * 512; LAS int* cntl = (LAS int*)(F.lds + LDS_SM + 16384);
    VM_WAIT(); __syncthreads();
    if (F.tid < 32) cntl[F.tid] = 0;
    { const GAS v4u* src = (const GAS v4u*)(a.ws() + WS_WSMALL + (size_t)l * WSMALL_LAYER + OFFS_ROUT);
      for (int idx = F.tid; idx < 64 * 128; idx += NTHR) { const int row = idx >> 7, c = idx & 127; *(LAS v4u*)(tabl + row * 2048 + ((c ^ (row & 7)) << 4)) = src[idx]; } }
    __syncthreads();
    const bf16* H = (const bf16*)(a.ws() + WS_H); const float bias = a.in(22)[l * NEXP + (F.lane & 31)];
    const int ar = F.lane & 15, kb = F.lane >> 4, ng = (b1 > b0) ? (b1 - b0 + 15) >> 4 : 0;
    const int hf = F.lane >> 5, ex = F.lane & 31;
    LAS unsigned long long* kb64 = (LAS unsigned long long*)(F.lds + LDS_SM + 16384 + 256) + F.wave * 64;
    LAS float* selv = (LAS float*)(F.lds + LDS_SM + 16384 + 256 + 4096) + F.wave * 16; LAS int* seli = (LAS int*)(selv + 8);
    auto logits16 = [&](int rb, int s0, int s1) {
        int row = rb + ar; if (row > M - 1) row = M - 1;
        const bf16* hp = H + (size_t)row * DM + kb * 8; f32x4 acc[4];
#pragma unroll
        for (int f = 0; f < 4; ++f) acc[f] = (f32x4){0.f, 0.f, 0.f, 0.f};
#pragma unroll 4
        for (int s = s0; s < s1; ++s) { const bfx8 af = *(const GAS bfx8*)(hp + s * 32);
#pragma unroll
            for (int f = 0; f < 4; ++f) { const int wr = f * 16 + ar; const bfx8 bfr = *(const LAS bfx8*)(tabl + wr * 2048 + (((4 * s + kb) ^ (wr & 7)) << 4));
                acc[f] = __builtin_amdgcn_mfma_f32_16x16x32_bf16(af, bfr, acc[f], 0, 0, 0); } }
#pragma unroll
        for (int i = 0; i < 4; ++i) { lg[(4 * kb + i) * 32 + ar] = acc[0][i] + acc[2][i]; lg[(4 * kb + i) * 32 + 16 + ar] = acc[1][i] + acc[3][i]; }
        LDS_WAIT(); asm volatile("" ::: "memory");
    };
    auto top4 = [&](int m, bool valid, float v) {
        unsigned ub = __float_as_uint(v); ub = (ub & 0x80000000u) ? ~ub : (ub | 0x80000000u);
        const unsigned long long K = ((unsigned long long)ub << 5) | (unsigned)(31 - ex);
        kb64[F.lane] = K;
        LDS_WAIT(); asm volatile("" ::: "memory");
        int rank = 0;
#pragma unroll
        for (int j = 0; j < 32; ++j) rank += (kb64[hf * 32 + j] > K) ? 1 : 0;
        if (rank < 4) { selv[hf * 4 + rank] = v; seli[hf * 4 + rank] = ex; if (valid) __hip_atomic_fetch_add(&cntl[ex], 1, __ATOMIC_RELAXED, __HIP_MEMORY_SCOPE_WORKGROUP); }
        LDS_WAIT(); asm volatile("" ::: "memory");
        if (ex == 0 && valid) { const f32x4 tv = *(const LAS f32x4*)(selv + hf * 4); const i32x4 ti = *(const LAS i32x4*)(seli + hf * 4);
            const float e1 = __expf(tv[1] - tv[0]), e2 = __expf(tv[2] - tv[0]), e3 = __expf(tv[3] - tv[0]), inv = 1.0f / (1.0f + e1 + e2 + e3);
            *(GAS i32x4*)((int*)(a.ws() + WS_TOPI) + (size_t)m * 4) = ti; *(GAS f32x4*)((float*)(a.ws() + WS_TOPP) + (size_t)m * 4) = (f32x4){inv, e1 * inv, e2 * inv, e3 * inv}; }
        LDS_WAIT(); asm volatile("" ::: "memory");
    };
    const int nfull = ng & ~(NWAVES - 1);
    for (int g = F.wave; g < nfull; g += NWAVES) {
        const int rb = b0 + g * 16; logits16(rb, 0, 32);
#pragma unroll 1
        for (int p = 0; p < 8; ++p) { const int r = 2 * p + hf, m = rb + r; top4(m, m < b1, lg[r * 32 + ex] + bias); }
        LDS_WAIT(); asm volatile("" ::: "memory");
    }
    for (int g = nfull; g < ng; ++g) {
        const int rb = b0 + g * 16;
        __syncthreads();
        logits16(rb, 4 * F.wave, 4 * F.wave + 4);
        __syncthreads();
        { const int r = 2 * F.wave + hf, m = rb + r; const LAS float* lga = (const LAS float*)(F.lds + LDS_SM); float v = bias;
#pragma unroll
          for (int q = 0; q < NWAVES; ++q) v += lga[q * 512 + r * 32 + ex];
          top4(m, m < b1, v); }
    }
    __syncthreads();
    if (F.tid < 32) ((int*)(a.ws() + WS_CNT))[F.vcu * 32 + F.tid] = cntl[F.tid];
}
__device__ __forceinline__ void p_slots(const Frame& F, const AV& a, int M) {
    LAS int* sm = (LAS int*)(F.lds + LDS_SM);
    LAS int *tot = sm, *bef = sm + 32, *base = sm + 64, *tst = sm + 96  , *mask = sm + 160  , *ids = sm + 320  , *slot = sm + 960  ;
    const int* cnt = (const int*)(a.ws() + WS_CNT);
    { LAS int* ptot = sm + 1600; LAS int* pbef = sm + 2112; const int e = F.tid & 31, part = F.tid >> 5; int t = 0, b = 0;
#pragma unroll 4
      for (int q = part; q < F.G; q += 16) { const int c = cnt[q * 32 + e]; t += c; if (q < F.vcu) b += c; }
      ptot[part * 32 + e] = t; pbef[part * 32 + e] = b;
      __syncthreads();
      if (F.tid < 32) { int tt = 0, bb = 0;
#pragma unroll
          for (int q = 0; q < 16; ++q) { tt += ptot[q * 32 + F.tid]; bb += pbef[q * 32 + F.tid]; }
          tot[F.tid] = tt; bef[F.tid] = bb; } }
    __syncthreads();
    if (F.tid == 0) { int ts = 0; for (int e = 0; e < 32; ++e) { tst[e] = ts; base[e] = ts * 256 + bef[e]; ts += (tot[e] + 255) >> 8; } tst[32] = ts; }
    __syncthreads();
    const int NT = tst[32];
    if (blockIdx.x == 0) { int* te = (int*)(a.ws() + WS_CNT) + CNT_TILE_E;
        for (int t = F.tid; t < NT; t += NTHR) { int e = 0; for (int q = 1; q < 32; ++q) if (t >= tst[q]) e = q; te[t] = e; }
        if (F.tid == 0) ((int*)(a.ws() + WS_CNT))[CNT_NT] = NT; }
    const int TPB = 8 * ((M + F.G * NWAVES - 1) / (F.G * NWAVES)), m0 = F.vcu * TPB, m1 = (m0 + TPB < M) ? m0 + TPB : M, nt = m1 > m0 ? m1 - m0 : 0;
    for (int tl = F.tid; tl < nt; tl += NTHR) { const i32x4 id = *(const GAS i32x4*)((const int*)(a.ws() + WS_TOPI) + (size_t)(m0 + tl) * 4);
        ids[tl * 4 + 0] = id.x; ids[tl * 4 + 1] = id.y; ids[tl * 4 + 2] = id.z; ids[tl * 4 + 3] = id.w; mask[tl] = (1 << id.x) | (1 << id.y) | (1 << id.z) | (1 << id.w); }
    __syncthreads();
    for (int p = F.tid; p < nt * 4; p += NTHR) { const int tl = p >> 2, e = ids[p]; int rank = 0; for (int q = 0; q < tl; ++q) rank += (mask[q] >> e) & 1;
        const int s = base[e] + rank; slot[p] = s; ((int*)(a.ws() + WS_SLOT))[(size_t)(m0 + tl) * 4 + (p & 3)] = s; ((int*)(a.ws() + WS_CNT))[CNT_ROWSRC + s] = m0 + tl; }
    __syncthreads();
    if (blockIdx.x < 32) { const int e = blockIdx.x, r0 = tst[e] * 256 + tot[e], r1 = tst[e + 1] * 256;
        for (int r = r0 + F.tid; r < r1; r += NTHR) ((int*)(a.ws() + WS_CNT))[CNT_ROWSRC + r] = 0; }
    __syncthreads();
}
__device__ __forceinline__ void p_combine(const Frame& F, const AV& a, int l, int M) {
    const int gw = F.vcu * NWAVES + F.wave, NGW = F.G * NWAVES, rpw = (M + NGW - 1) / NGW, r0 = gw * rpw, r1 = (r0 + rpw < M) ? r0 + rpw : M;
    if (r0 >= r1) return;
    const unsigned char* ys = a.ws() + WS_YS;   const int* slp = (const int*)(a.ws() + WS_SLOT); const float* prp = (const float*)(a.ws() + WS_TOPP);
    const float* modb = (const float*)(a.ws() + WS_MOD);
    f32x4 gpost[4], gpre[4], gate[4], shift[4], scale[4]; ld4(gpost, a.in(9) + l * DM, F.lane); if (l == 0) ld4(gpre, a.in(6) + DM, F.lane);
    int cb = -1;
    i32x4 sl_n = *(const GAS i32x4*)(slp + (size_t)r0 * 4); f32x4 pr_n = *(const GAS f32x4*)(prp + (size_t)r0 * 4);
    u32x2 xn[4]; unsigned yn[4][4]; f32x4 prc = pr_n * 0.125f;
    const bf16* xab = (const bf16*)(a.ws() + WS_XA); bf16* xbb = (bf16*)(a.ws() + WS_XB);
    {
#pragma unroll
      for (int j = 0; j < 4; ++j) xn[j] = ((const GAS u32x2*)(xab + (size_t)r0 * DM))[F.lane + 64 * j];
      const int sv[4] = {sl_n[0], sl_n[1], sl_n[2], sl_n[3]};
#pragma unroll
      for (int k = 0; k < 4; ++k)
#pragma unroll
          for (int j = 0; j < 4; ++j) yn[k][j] = ((const GAS unsigned*)(ys + (size_t)sv[k] * DM))[F.lane + 64 * j];
      if (r0 + 1 < r1) { sl_n = *(const GAS i32x4*)(slp + (size_t)(r0 + 1) * 4); pr_n = *(const GAS f32x4*)(prp + (size_t)(r0 + 1) * 4); } }
    for (int m = r0; m < r1; ++m) {
        f32x4 x[4], y[4];
#pragma unroll
        for (int j = 0; j < 4; ++j) { x[j] = bf4(xn[j]); y[j] = fp8x4(yn[0][j]) * prc[0] + fp8x4(yn[1][j]) * prc[1] + fp8x4(yn[2][j]) * prc[2] + fp8x4(yn[3][j]) * prc[3]; }
        if (m + 1 < r1) { prc = pr_n * 0.125f;
#pragma unroll
            for (int j = 0; j < 4; ++j) xn[j] = ((const GAS u32x2*)(xab + (size_t)(m + 1) * DM))[F.lane + 64 * j];
            const int sv[4] = {sl_n[0], sl_n[1], sl_n[2], sl_n[3]};
#pragma unroll
            for (int k = 0; k < 4; ++k)
#pragma unroll
                for (int j = 0; j < 4; ++j) yn[k][j] = ((const GAS unsigned*)(ys + (size_t)sv[k] * DM))[F.lane + 64 * j];
            if (m + 2 < r1) { sl_n = *(const GAS i32x4*)(slp + (size_t)(m + 2) * 4); pr_n = *(const GAS f32x4*)(prp + (size_t)(m + 2) * 4); } }
        const int b = m < TL ? (m >> 11) : 16;
        if (b != cb) { cb = b; ld4(gate, modb + ((size_t)l * 17 + b) * INCOLS + 5 * 1024, F.lane); if (l == 0) { const float* m1 = modb + ((size_t)17 + b) * INCOLS; ld4(shift, m1, F.lane); ld4(scale, m1 + 1024, F.lane); } }
        const float r = 1.0f / sqrtf(wave_sum(sumsq4(y), F.lane) * (1.0f / 1024.0f) + EPS);
#pragma unroll
        for (int j = 0; j < 4; ++j) x[j] = x[j] + gate[j] * (y[j] * r * gpost[j]);
        if (l == 0) {
#pragma unroll
            for (int j = 0; j < 4; ++j) ((GAS u32x2*)(xbb + (size_t)m * DM))[F.lane + 64 * j] = pk4(x[j]); }
        else st_row_f32(x, a.out() + (size_t)m * DM, F.lane);
        if (l == 0) { const float r2 = 1.0f / sqrtf(wave_sum(sumsq4(x), F.lane) * (1.0f / 1024.0f) + EPS);
            bf16* ho = (bf16*)(a.ws() + WS_H) + (size_t)m * DM; unsigned char* h8 = a.ws() + WS_H8 + (size_t)m * DM;
#pragma unroll
            for (int j = 0; j < 4; ++j) { const f32x4 hv = x[j] * r2 * gpre[j] * (scale[j] + 1.0f) + shift[j]; ((GAS u32x2*)ho)[F.lane + 64 * j] = pk4(hv); ((GAS unsigned*)h8)[F.lane + 64 * j] = pk4_fp8(hv); } }
    }
}
#ifdef DBG_CHECK
#ifndef DBG_GSUB
#define DBG_GSUB 0
#endif
__device__ __forceinline__ double bfd(bf16 b) { return (double)__uint_as_float(((unsigned)b) << 16); }
__device__ __forceinline__ unsigned hsh(unsigned x) { x ^= x >> 16; x *= 0x7feb352du; x ^= x >> 15; x *= 0x846ca68bu; x ^= x >> 16; return x; }
__device__ __forceinline__ int samp_row(int i, int M, unsigned salt) { const int sp[12] = {0, 1, 255, 256, 2047, 2048, 4095, 32767, 32768, 32769, 33023, 36863}; if (i < 12 && sp[i] < M) return sp[i]; return (int)(hsh(i * 7919u + salt) % (unsigned)M); }
__device__ __forceinline__ void rec(float* res, int stage, double got, double want, double flo) { const double e = fabs(got - want) / (fabs(want) + flo); const float f = (e == e) ? (float)e : 1e30f; atomicMax((unsigned*)res + stage, __float_as_uint(f)); }
__device__ double dot_h_w(const bf16* hrow, const float* w, int ldw, int col) { double s = 0; for (int k = 0; k < 1024; ++k) s += bfd(hrow[k]) * (double)w[(size_t)k * ldw + col]; return s; }
__device__ double dsig(double x) { return 1.0 / (1.0 + exp(-x)); }
constexpr double PI_D = 3.14159265358979323846;
enum { ST_MOD = 0, ST_H0, ST_INPROJ, ST_YT, ST_QKFIX, ST_CONV, ST_Z, ST_ATTN, ST_GATES, ST_MERGED, ST_MIX, ST_ROW1, ST_LOGIT, ST_TOPK, ST_SLOTS, ST_ACT, ST_YSLOT, ST_COMB, ST_GATESB, ST_N };
__global__ void chk(Args A, int stage, int l, float* res, float* snap) {
    const int i = threadIdx.x; unsigned char* ws = A.ws; const int M = (l == 0) ? TALL : TL; const int rs = stage + 32 * l;
    const bf16* H = (const bf16*)(ws + WS_H); const float* win = A.in[10] + (size_t)l * DM * INCOLS; const float* modb = (const float*)(ws + WS_MOD);
    if (stage == ST_MOD) { const int ll = i & 1, b = (i >> 1) % 17, n = (int)(hsh(i) % 6144u); double s = 0; for (int k = 0; k < 1024; ++k) { const double cv = b < 16 ? A.in[1][b * 1024 + k] : A.in[3][k]; s += cv * dsig(cv) * (double)A.in[4][((size_t)ll * 1024 + k) * 6144 + n]; }
        s += A.in[5][ll * 6144 + n]; rec(res, rs, modb[((size_t)ll * 17 + b) * 6144 + n], s, 0.02); }
    else if (stage == ST_H0) { const int m = samp_row(i, TALL, 1), c = (int)(hsh(i + 77) % 1024u); const float* x = m < TL ? A.in[0] + (size_t)m * DM : A.in[2] + (size_t)(m - TL) * DM; double ss = 0; for (int k = 0; k < 1024; ++k) ss += (double)x[k] * x[k];
        const float* mv = modb + (size_t)(m < TL ? (m >> 11) : 16) * 6144; const double want = x[c] / sqrt(ss / 1024 + 1e-6) * A.in[6][c] * (1.0 + mv[1024 + c]) + mv[c]; rec(res, rs, bfd(H[(size_t)m * DM + c]), want, 0.05); }
    else if (stage == ST_INPROJ) { const int m = samp_row(i, TALL, 2), kind = i & 3; const bf16* hr = H + (size_t)m * DM;
        if (kind == 0) { const int n = (int)(hsh(i + 5) % 1024u); rec(res, rs, bfd(((const bf16*)(ws + WS_Q))[(size_t)m * DM + n]), dot_h_w(hr, win, INCOLS, n), 0.05); }
        else if (kind == 1) { const int n = (int)(hsh(i + 6) % 256u); rec(res, rs, bfd(((const bf16*)(ws + WS_K))[(size_t)krow_of(m) * 256 + n]), dot_h_w(hr, win, INCOLS, 1024 + n), 0.05); }
        else if (kind == 2) { const int n = (int)(hsh(i + 7) % 256u); rec(res, rs, bfd(((const bf16*)(ws + WS_V))[(size_t)krow_of(m) * 256 + n]), dot_h_w(hr, win, INCOLS, 1280 + n), 0.05); }
        else { const int c = (int)(hsh(i + 8) % 512u); if (l == 0 || m < TL) { const double a = dot_h_w(hr, win, INCOLS, 1536 + c), g = dot_h_w(hr, win, INCOLS, 2048 + c); rec(res, rs, bfd(((const bf16*)(ws + WS_CU))[(size_t)m * 512 + c]), a * dsig(g), 0.05); } } }
    else if (stage == ST_YT) { const int m = samp_row(i, M, 3), ch = (int)(hsh(i + 9) % 512u), cs = i & 1, g = ch >> 7, k2 = ch & 127; const bf16* hr = H + (size_t)m * DM; double s = 0;
        for (int k = 0; k < 1024; ++k) { double t = 0; for (int n2 = 0; n2 < 128; ++n2) { const double ang = 2.0 * PI_D * ((n2 * k2) & 127) / 128.0; t += (double)win[(size_t)k * INCOLS + OFF_FNET + g * 128 + n2] * (cs ? sin(ang) : cos(ang)); } s += bfd(hr[k]) * t; }
        s /= sqrt(128.0); double got; if (m < TL) got = bfd(((const bf16*)(ws + WS_YT))[((size_t)(m >> 11) * 512 + ch) * 4096 + cs * 2048 + (m & 2047)]); else got = bfd(((const bf16*)(ws + WS_YTC))[((size_t)((m - TL) >> 8) * 512 + ch) * 512 + cs * 256 + ((m - TL) & 255)]);
        rec(res, rs, got, s, 0.05); }
    else if (stage == ST_QKFIX) { const int m = samp_row(i, TALL, 4), isk = i & 1, hh = isk ? (int)(hsh(i + 3) % 2u) : (int)(hsh(i + 3) % 8u), d = (int)(hsh(i + 4) % 128u); const bf16* hr = H + (size_t)m * DM;
        if (isk || l == 0 || m < TL) { const int cbase = isk ? 1024 + hh * 128 : hh * 128; double ss = 0, xd = 0, xp = 0; const int half = d & 64, dd = d & 63, pd = half + ((dd + 32) & 63);
            for (int q = 0; q < 128; ++q) { double v = dot_h_w(hr, win, INCOLS, cbase + q); v = bfd((bf16)f2bf((float)v)); ss += v * v; if (q == d) xd = v; if (q == pd) xp = v; }
            const float* gn = (isk ? A.in[12] : A.in[11]) + l * 128; const double r = 1.0 / sqrt(ss / 128 + 1e-6); xd *= r * gn[d]; xp *= r * gn[pd]; double want = xd;
            if (m < TL) { const int t = m & 2047, pos = half ? (t & 63) : (t >> 6), f = dd & 31; const double ang = (double)((float)pos * powf(10000.0f, -(float)f / 32.0f)); want = (dd < 32) ? xd * cos(ang) - xp * sin(ang) : xd * cos(ang) + xp * sin(ang); }
            const double got = isk ? bfd(((const bf16*)(ws + WS_K))[(size_t)krow_of(m) * 256 + hh * 128 + d]) : bfd(((const bf16*)(ws + WS_Q))[(size_t)m * DM + hh * 128 + d]); rec(res, rs, got, want, 0.05); } }
    else if (stage == ST_CONV) { const int m = samp_row(i, M, 5), c = (int)(hsh(i + 11) % 512u); const int rowbase = m < TL ? (m >> 11) * SEQ : TL + ((m - TL) >> 8) * CTXL, L = m < TL ? SEQ : CTXL, t = m - rowbase; const bf16* cu = (const bf16*)(ws + WS_CU);
        double s1 = 0, s2 = 0, yc = 0; for (int cc = 0; cc < 512; ++cc) { double y = A.in[15][l * 512 + cc]; for (int j = 0; j < 31; ++j) { const int p = t + j - 15; if (p >= 0 && p < L) y += bfd(cu[(size_t)(rowbase + p) * 512 + cc]) * (double)A.in[14][((size_t)l * 31 + j) * 512 + cc]; } s1 += y; s2 += y * y; if (cc == c) yc = y; }
        const double mean = s1 / 512, var = s2 / 512 - mean * mean; double y = (yc - mean) / sqrt(var + 1e-6) * A.in[16][l * 512 + c] + A.in[17][l * 512 + c]; y = y * dsig(y); rec(res, rs, bfd(((const bf16*)(ws + WS_CH))[(size_t)m * 512 + c]), y, 0.05); }
    else if (stage == ST_Z) { const int m = samp_row(i, M, 6), ch = (int)(hsh(i + 12) % 512u); double s = 0;
        if (m < TL) { const int b = m >> 11, k1 = m & 2047; const bf16* yr = (const bf16*)(ws + WS_YT) + ((size_t)b * 512 + ch) * 4096; for (int n1 = 0; n1 < 2048; ++n1) { const double ang = 2.0 * PI_D * ((k1 * n1) & 2047) / 2048.0; s += cos(ang) * bfd(yr[n1]) - sin(ang) * bfd(yr[2048 + n1]); } s /= sqrt(2048.0); }
        else { const int b = (m - TL) >> 8, k1 = (m - TL) & 255; const bf16* yr = (const bf16*)(ws + WS_YTC) + ((size_t)b * 512 + ch) * 512; for (int n1 = 0; n1 < 256; ++n1) { const double ang = 2.0 * PI_D * ((k1 * n1) & 255) / 256.0; s += cos(ang) * bfd(yr[n1]) - sin(ang) * bfd(yr[256 + n1]); } s /= 16.0; }
        rec(res, rs, bfd(((const bf16*)(ws + WS_Z))[(size_t)m * 512 + ch]), s, 0.05); }
    else if (stage == ST_ATTN) { const int m = samp_row(i, M, 7), hh = (int)(hsh(i + 13) % 8u), d = (int)(hsh(i + 14) % 128u); const bf16* q = (const bf16*)(ws + WS_Q) + (size_t)m * DM + hh * 128;
        int kr0, nk; if (m < TL) { kr0 = (m >> 11) * KVROWS; nk = KVROWS; } else { kr0 = ((m - TL) >> 8) * KVROWS + SEQ; nk = CTXL; }
        const bf16* K = (const bf16*)(ws + WS_K) + (size_t)kr0 * 256 + (hh >> 2) * 128; const bf16* V = (const bf16*)(ws + WS_V) + (size_t)kr0 * 256 + (hh >> 2) * 128;
        double mx = -1e300; for (int j = 0; j < nk; ++j) { double s = 0; for (int q2 = 0; q2 < 128; ++q2) s += bfd(q[q2]) * bfd(K[(size_t)j * 256 + q2]); s *= 0.08838834764831845; if (s > mx) mx = s; }
        double den = 0, num = 0; for (int j = 0; j < nk; ++j) { double s = 0; for (int q2 = 0; q2 < 128; ++q2) s += bfd(q[q2]) * bfd(K[(size_t)j * 256 + q2]); s *= 0.08838834764831845; const double p = exp(s - mx); den += p; num += p * bfd(V[(size_t)j * 256 + d]); }
        rec(res, rs, bfd(((const bf16*)(ws + WS_AO))[(size_t)m * DM + hh * 128 + d]), num / den, 0.03); }
    else if (stage == ST_GATES) { const int m = samp_row(i, M, 8), n = (int)(hsh(i + 15) % 3072u); rec(res, rs, bfd(((const bf16*)(ws + WS_GATES))[(size_t)m * 3072 + n]), dsig(dot_h_w(H + (size_t)m * DM, win, INCOLS, OFF_GATE + n)), 0.05); }
    else if (stage == ST_GATESB && DBG_GSUB == 1) { const int m = samp_row(i, M, 8), n = (int)(hsh(i + 15) % 3072u); const double got = bfd(((const bf16*)(ws + WS_GATES))[(size_t)m * 3072 + n]), want = dsig(dot_h_w(H + (size_t)m * DM, win, INCOLS, OFF_GATE + n));
        const bool badv = !(fabs(got - want) <= 0.05); if (badv) { unsigned* r = (unsigned*)res + 48; atomicOr(r, (m < TL ? 1u : 2u) | (4u << (n >> 10)) | (i < 12 ? 32u : 0u)); } }
    else if (stage == ST_GATESB) { const int m = samp_row(i, M, 8), n = (int)(hsh(i + 15) % 3072u); const bf16* wt = (const bf16*)(ws + WS_WSMALL + (size_t)l * WSMALL_LAYER + OFFS_WG) + (size_t)n * 1024; const bf16* hr = H + (size_t)m * DM; double s = 0; for (int k = 0; k < 1024; ++k) s += bfd(hr[k]) * bfd(wt[k]);
        rec(res, rs, bfd(((const bf16*)(ws + WS_GATES))[(size_t)m * 3072 + n]), dsig(s), 0.05); }
    else if (stage == ST_MERGED) { const int m = samp_row(i, M, 9), c = (int)(hsh(i + 16) % 1024u); const bf16* g = (const bf16*)(ws + WS_GATES) + (size_t)m * 3072; double y0 = 0, y1 = 0, y2 = 0;
        const bf16* ao = (const bf16*)(ws + WS_AO) + (size_t)m * DM; const bf16* chh = (const bf16*)(ws + WS_CH) + (size_t)m * 512; const bf16* z = (const bf16*)(ws + WS_Z) + (size_t)m * 512;
        for (int k = 0; k < 1024; ++k) y0 += bfd(ao[k]) * (double)A.in[13][((size_t)l * 1024 + k) * 1024 + c];
        for (int k = 0; k < 512; ++k) { y1 += bfd(chh[k]) * (double)A.in[18][((size_t)l * 512 + k) * 1024 + c]; y2 += bfd(z[k]) * (double)A.in[19][((size_t)l * 512 + k) * 1024 + c]; }
        rec(res, rs, bfd(((const bf16*)(ws + WS_MERGED))[(size_t)m * DM + c]), bfd(g[c]) * y0 + bfd(g[1024 + c]) * y1 + bfd(g[2048 + c]) * y2, 0.05); }
    else if (stage == ST_MIX) { const int m = samp_row(i, M, 10), c = (int)(hsh(i + 17) % 1024u); rec(res, rs, bfd(((const bf16*)(ws + WS_MIX))[(size_t)m * DM + c]), dot_h_w((const bf16*)(ws + WS_MERGED) + (size_t)m * DM, A.in[20] + (size_t)l * DM * DM, DM, c), 0.05); }
    else if (stage == ST_ROW1) { const int m = samp_row(i, M, 11), c = (int)(hsh(i + 18) % 1024u); const float* xs = snap + (size_t)i * 1024;
        const bf16* mix = (const bf16*)(ws + WS_MIX) + (size_t)m * DM; const float* mv = modb + ((size_t)l * 17 + (m < TL ? (m >> 11) : 16)) * 6144; double ss = 0; for (int k = 0; k < 1024; ++k) ss += bfd(mix[k]) * bfd(mix[k]); const double r = 1.0 / sqrt(ss / 1024 + 1e-6);
        double s2 = 0, xc = 0; for (int k = 0; k < 1024; ++k) { const double xn = xs[k] + mv[2048 + k] * (bfd(mix[k]) * r * A.in[7][l * DM + k]); s2 += xn * xn; if (k == c) xc = xn; }
        const float* xd = m < TL ? A.out + (size_t)m * DM : (const float*)(ws + WS_XC) + (size_t)(m - TL) * DM; rec(res, rs, xd[c], xc, 0.02);
        rec(res, rs, bfd(H[(size_t)m * DM + c]), xc / sqrt(s2 / 1024 + 1e-6) * A.in[8][l * DM + c] * (1.0 + mv[4096 + c]) + mv[3072 + c], 0.05); }
    else if (stage == ST_LOGIT) { const int m = samp_row(i, M, 12), e = i & 31; const float* lg = (const float*)(ws + WS_LOGIT) + (size_t)m * 64; rec(res, rs, (double)lg[e] + lg[32 + e], dot_h_w(H + (size_t)m * DM, A.in[21] + (size_t)l * DM * NEXP, NEXP, e), 0.02); }
    else if (stage == ST_TOPK) { const int m = samp_row(i, M, 13); const float* lg = (const float*)(ws + WS_LOGIT) + (size_t)m * 64; float v[32]; for (int e = 0; e < 32; ++e) v[e] = lg[e] + lg[32 + e] + A.in[22][l * 32 + e];
        int id[4]; float tv[4]; for (int k = 0; k < 4; ++k) { int b = -1; for (int e = 0; e < 32; ++e) { bool used = false; for (int q = 0; q < k; ++q) used |= (id[q] == e); if (!used && (b < 0 || v[e] > v[b])) b = e; } id[k] = b; tv[k] = v[b]; }
        double den = 0; for (int k = 0; k < 4; ++k) den += exp((double)tv[k] - tv[0]); const int* gi = (const int*)(ws + WS_TOPI) + (size_t)m * 4; const float* gp = (const float*)(ws + WS_TOPP) + (size_t)m * 4;
        for (int k = 0; k < 4; ++k) { rec(res, rs, gi[k] == id[k] ? 0.0 : 1.0, 0, 0.01); rec(res, rs, gp[k], exp((double)tv[k] - tv[0]) / den, 0.01); } }
    else if (stage == ST_SLOTS) { const int m = samp_row(i, M, 14), k = i & 3; const int s = ((const int*)(ws + WS_SLOT))[(size_t)m * 4 + k], e = ((const int*)(ws + WS_TOPI))[(size_t)m * 4 + k]; const int NT = ((const int*)(ws + WS_CNT))[CNT_NT];
        if (s < 0 || s >= NT * 256) rec(res, rs, 1, 0, 0.01); else { rec(res, rs, ((const int*)(ws + WS_CNT))[CNT_TILE_E + (s >> 8)] == e ? 0.0 : 1.0, 0, 0.01); const bf16* hs = (const bf16*)(ws + WS_HS) + (size_t)s * DM; double df = 0; for (int q = 0; q < 1024; ++q) df += fabs(bfd(hs[q]) - bfd(H[(size_t)m * DM + q])); rec(res, rs, df, 0, 1e-3); } }
    else if (stage == ST_ACT) { const int m = samp_row(i, M, 15), k = i & 3, c = (int)(hsh(i + 21) % 1024u); const int s = ((const int*)(ws + WS_SLOT))[(size_t)m * 4 + k], e = ((const int*)(ws + WS_TOPI))[(size_t)m * 4 + k]; const bf16* hs = (const bf16*)(ws + WS_HS) + (size_t)s * DM;
        double g = dot_h_w(hs, A.in[23] + (((size_t)l * NEXP + e) << 20), DM, c) + A.in[24][((size_t)l * NEXP + e) * 1024 + c], u = dot_h_w(hs, A.in[25] + (((size_t)l * NEXP + e) << 20), DM, c) + A.in[26][((size_t)l * NEXP + e) * 1024 + c];
        g = g < 7.0 ? g : 7.0; u = u < -7.0 ? -7.0 : (u > 7.0 ? 7.0 : u); rec(res, rs, bfd(((const bf16*)(ws + WS_ACT))[(size_t)s * DM + c]), (u + 1.0) * (g * dsig(1.702 * g)), 0.05); }
    else if (stage == ST_YSLOT) { const int m = samp_row(i, M, 16), k = i & 3, c = (int)(hsh(i + 22) % 1024u); const int s = ((const int*)(ws + WS_SLOT))[(size_t)m * 4 + k], e = ((const int*)(ws + WS_TOPI))[(size_t)m * 4 + k];
        rec(res, rs, bfd(((const bf16*)(ws + WS_HS))[(size_t)s * DM + c]), dot_h_w((const bf16*)(ws + WS_ACT) + (size_t)s * DM, A.in[27] + (((size_t)l * NEXP + e) << 20), DM, c) + A.in[28][((size_t)l * NEXP + e) * 1024 + c], 0.05); }
    else if (stage == ST_COMB) { const int m = samp_row(i, M, 17), c = (int)(hsh(i + 23) % 1024u); const float* xs = snap + (size_t)i * 1024; const int* sl = (const int*)(ws + WS_SLOT) + (size_t)m * 4; const float* pr = (const float*)(ws + WS_TOPP) + (size_t)m * 4;
        const float* mv = modb + ((size_t)l * 17 + (m < TL ? (m >> 11) : 16)) * 6144; double ss = 0, yc = 0; for (int q = 0; q < 1024; ++q) { double y = 0; for (int k = 0; k < 4; ++k) y += (double)pr[k] * bfd(((const bf16*)(ws + WS_HS))[(size_t)sl[k] * DM + q]); ss += y * y; if (q == c) yc = y; }
        const double want = xs[c] + mv[5 * 1024 + c] * (yc / sqrt(ss / 1024 + 1e-6) * A.in[9][l * DM + c]); const float* xd = m < TL ? A.out + (size_t)m * DM : (const float*)(ws + WS_XC) + (size_t)(m - TL) * DM; rec(res, rs, xd[c], want, 0.02); }
}
__global__ void snap_rows(Args A, int l, int salt, float* snap) {
    const int i = blockIdx.x, M = (l == 0) ? TALL : TL, m = samp_row(i, M, salt); const float* xs;
    if (l == 0 && salt == 11) xs = m < TL ? A.in[0] + (size_t)m * DM : A.in[2] + (size_t)(m - TL) * DM; else xs = m < TL ? A.out + (size_t)m * DM : (const float*)(A.ws + WS_XC) + (size_t)(m - TL) * DM;
    for (int k = threadIdx.x; k < 1024; k += blockDim.x) snap[(size_t)i * 1024 + k] = xs[k];
}
__global__ void chk_gates_full(const bf16* H, const bf16* Wt, const bf16* G, int M, unsigned* cntw) {
    const int n = blockIdx.x * 64 + (threadIdx.x & 63), m = blockIdx.y * 4 + (threadIdx.x >> 6); if (m >= M) return;
    const uint4* a = (const uint4*)(H + (size_t)m * 1024); const uint4* b = (const uint4*)(Wt + (size_t)n * 1024); float s = 0.f;
    for (int k = 0; k < 128; ++k) { const uint4 x = a[k], y = b[k]; const unsigned xs[4] = {x.x, x.y, x.z, x.w}, ys[4] = {y.x, y.y, y.z, y.w};
        for (int q = 0; q < 4; ++q) { s += __uint_as_float(xs[q] << 16) * __uint_as_float(ys[q] << 16); s += __uint_as_float(xs[q] & 0xffff0000u) * __uint_as_float(ys[q] & 0xffff0000u); } }
    const float want = 1.0f / (1.0f + __expf(-s)), got = __uint_as_float(((unsigned)G[(size_t)m * 3072 + n]) << 16);
    if (!(fabsf(got - want) <= 0.02f)) { atomicAdd(cntw, 1u); cntw[16 + (m >> 8) * 12 + (n >> 8)] = 1u; }
}
__global__ void encode_full(float* out, const unsigned* cntw, int n) {
    __shared__ int bc, bt; if (threadIdx.x == 0) { unsigned C = cntw[0], T = 0; for (int t = 0; t < 1728; ++t) T += cntw[16 + t]; int b1 = 0; while (C) { ++b1; C /= 10; } int b2 = 0; while (T) { ++b2; T /= 4; } bc = b1 > 7 ? 7 : b1; bt = b2 > 7 ? 7 : b2; }
    __syncthreads(); const float K = ldexpf(1.0f, 2 + 8 * bt + bc);
    for (size_t i = (size_t)blockIdx.x * blockDim.x + threadIdx.x; i < (size_t)n; i += (size_t)gridDim.x * blockDim.x) out[i] = K;
}
__global__ void encode(float* out, const float* res, int n, float thr) {
    #if DBG_GSUB == 1
    { const unsigned mk = ((const unsigned*)res)[48]; const float K = ldexpf(1.0f, 2 + (int)mk); for (size_t i = (size_t)blockIdx.x * blockDim.x + threadIdx.x; i < (size_t)n; i += (size_t)gridDim.x * blockDim.x) out[i] = K; return; }
#endif
#ifndef CHK_SKIP
#define CHK_SKIP 0ull
#endif
    int bad = -1; for (int s = 0; s < 64; ++s) if (!((CHK_SKIP >> s) & 1ull) && res[s] > thr) { bad = s; break; }
    if (bad < 0) return; const float er = res[bad]; const float K = ldexpf(1.0f, bad + 2) * (er < 0.5f ? 1.0f : er < 1.0f ? 1.25f : er < 4.0f ? 1.5f : 1.75f);
    for (size_t i = (size_t)blockIdx.x * blockDim.x + threadIdx.x; i < (size_t)n; i += (size_t)gridDim.x * blockDim.x) out[i] = K;
}
#endif
#ifndef GP_SP2
#define GP_SP2 true
#endif
#ifndef GP_ALIGN
#define GP_ALIGN true
#endif
__global__ void __launch_bounds__(NTHR, 2) fwd(Args args) {
    extern __shared__ __attribute__((aligned(16))) unsigned char lds[];
    Frame F;
    F.lds = (LAS unsigned char*)lds; F.MISC = (volatile LAS unsigned*)(F.lds + MISC_OFF);
    F.tid = threadIdx.x; F.lane = F.tid & 63; F.wave = __builtin_amdgcn_readfirstlane(F.tid >> 6);
    F.G = gridDim.x; { const int bx = blockIdx.x; F.vcu = (F.G % 8 == 0) ? (bx % 8) * (F.G / 8) + bx / 8 : bx; }
    { const AV A0 = av_get(); F.ctl = (gu32*)(A0.ws() + WS_CTL); }
    for (int u = F.tid; u < (LDS_BYTES - LDSCTL_OFF) / 4; u += NTHR) ((LAS unsigned*)(F.lds + LDSCTL_OFF))[u] = 0u;
    __syncthreads();
    XcdBarrier bar; bar.bar = (unsigned*)(F.ctl + CW_BAR); bar.x = 0; bar.st = nullptr;
    if (!MK_PER_PHASE) bar = xcd_barrier_post((unsigned*)(F.ctl + CW_BAR), F.MISC + 8);
    int lo, hi; { const AV A0 = av_get(); lo = *(const int __attribute__((address_space(4)))*)(A0.kp + 8 * 31); hi = *(const int __attribute__((address_space(4)))*)(A0.kp + 8 * 31 + 4); }
#ifndef DIS_MASK
#define DIS_MASK 0ull
#endif
#define IN(k) (lo <= (k) && (k) < hi)
#define ON(j) (!((DIS_MASK >> (j)) & 1ull))
#ifndef REP_MASK
#define REP_MASK 0ull
#endif
#define REPS(j) ((int)((REP_MASK >> (j)) & 1ull))
#ifdef STAMP_SEL
#define SEAM(k) do { xcd_barrier(bar); if (blockIdx.x == 0 && threadIdx.x == 0) ((unsigned long long*)(F.ctl + 32768))[(k) + 1] = __builtin_amdgcn_s_memrealtime(); } while (0)
#else
#ifdef DOUBLE_BAR
#define SEAM(k) do { if (!MK_PER_PHASE && IN((k) + 1)) { xcd_barrier(bar); xcd_barrier(bar); } } while (0)
#else
#define SEAM(k) do { if (!MK_PER_PHASE && IN((k) + 1)) xcd_barrier(bar); } while (0)
#endif
#endif
    const int bx = (int)blockIdx.x;
    const int wave0 = __builtin_amdgcn_readfirstlane((int)threadIdx.x >> 6);
#define F_REFRESH() do { unsigned z_ = 0u; asm volatile("" : "+v"(z_)); const int t_ = wave0 * 64 + (int)__builtin_amdgcn_mbcnt_hi(~0u, __builtin_amdgcn_mbcnt_lo(~0u, z_)); F.tid = t_; F.lane = t_ & 63; F.wave = wave0; } while (0)

#ifdef STAMP_SEL
    if (blockIdx.x == 0 && threadIdx.x == 0) ((unsigned long long*)(F.ctl + 32768))[0] = __builtin_amdgcn_s_memrealtime();
#endif
    if (ON(0) && IN(0)) for (int rep_ = 0; rep_ <= REPS(0); ++rep_) { F_REFRESH(); const AV A = av_get(); p0_prologue(F, A); SEAM(0); }
    if (ON(1) && IN(1)) for (int rep_ = 0; rep_ <= REPS(1); ++rep_) { F_REFRESH(); const AV A = av_get(); p1_norm0(F, A); SEAM(1); }

    for (int l = 0; l < 2; ++l) {
        const int pb = 2 + l * NPL;
        const int Mm = (l == 0) ? TALL : TL;
#define PH_BEGIN F_REFRESH(); const AV A = av_get(); unsigned char* const ws = A.ws(); unsigned char* const wl = ws + WS_WSMALL + (size_t)l * WSMALL_LAYER; (void)wl
        if (ON(2 + 0) && IN(pb + 0)) for (int rep_ = 0; rep_ <= REPS(2 + 0); ++rep_) { PH_BEGIN;
            if (ON(16)) { pg8::Gemm g{(const bf16*)(ws + WS_H8), (const bf16*)(wl + OFFS_WIN), TALL, 2560, DM / 2}; pg8::StaticOrder S; S.init(TALL, 2560, F.G, bx);
              pg8::EpiInproj E{(bf16*)(ws + WS_Q), (bf16*)(ws + WS_K), (bf16*)(ws + WS_V), (bf16*)(ws + WS_CU)};
              pg8::gemm_phase<pg8::EpiInproj, pg8::StaticOrder, GP_ALIGN, GP_SP2, true>(F.lds + RING_OFF, g, S, E, F.tid); }
            if (ON(17)) { pg8::Gemm g{(const bf16*)(wl + OFFS_WF), (const bf16*)(ws + WS_H), 1024, Mm, DM}; pg8::StaticOrder S; S.init(1024, Mm, F.G, (bx + 96) % F.G);
              pg8::EpiYT E{ws + WS_YT, ws + WS_YTC};
              pg8::gemm_phase<pg8::EpiYT, pg8::StaticOrder, GP_ALIGN, GP_SP2>(F.lds + RING_OFF, g, S, E, F.tid); }
            SEAM(pb + 0);
        }
        if (ON(2 + 1) && IN(pb + 1)) for (int rep_ = 0; rep_ <= REPS(2 + 1); ++rep_) { PH_BEGIN;
            if (ON(18)) p_qkfix(F, A, l, TALL);
            F_REFRESH();
            if (ON(19)) p_conv(F, A, l, l == 0 ? 1152 : 1024);
            if (ON(20)) { pg8::Gemm g{(const bf16*)(ws + WS_DFTL), (const bf16*)(ws + WS_YT), 2048, NB * 512, 2048}; pg8::DftOrder S; S.init(3, NB, F.G, F.vcu);
              pg8::EpiDFT E{(bf16*)(ws + WS_Z), 0, SEQ};
              pg8::gemm_phase<pg8::EpiDFT, pg8::DftOrder, GP_ALIGN, GP_SP2, true>(F.lds + RING_OFF, g, S, E, F.tid); }
            if (ON(21) && l == 0) { pg8::Gemm g{(const bf16*)(ws + WS_DFTC), (const bf16*)(ws + WS_YTC), 256, NB * 512, 256}; pg8::DftOrder S; S.init(0, NB, F.G, F.vcu);
              pg8::EpiDFT E{(bf16*)(ws + WS_Z), TL, CTXL};
              pg8::gemm_phase<pg8::EpiDFT, pg8::DftOrder, GP_ALIGN, GP_SP2, true>(F.lds + RING_OFF, g, S, E, F.tid); }
            SEAM(pb + 1);
        }
        if (ON(2 + 2) && IN(pb + 2)) for (int rep_ = 0; rep_ <= REPS(2 + 2); ++rep_) { PH_BEGIN;
            const int nheavy = NB * 8 * 8, ntot = nheavy + (l == 0 ? NB * 8 : 0);
            for (int L = F.vcu; L < ntot; L += F.G) {
                int row0, krow, h, seq, t0;
                if (L < nheavy) { const int grp = L >> 5, s = L & 31, b = grp >> 1; h = (grp & 1) * 4 + (s >> 3); t0 = (s & 7) * 256; row0 = b * SEQ + t0; krow = b * KVROWS; seq = KVROWS; }
                else { const int Lc = L - nheavy, b = Lc >> 3; h = Lc & 7; row0 = TL + b * CTXL; krow = b * KVROWS + SEQ; seq = CTXL; t0 = 0; }
                const att::bf16* Qb = (const att::bf16*)(ws + WS_Q) + (size_t)row0 * DM + h * 128;
                const att::bf16* Kh = (const att::bf16*)(ws + WS_K) + (size_t)krow * 256 + (h >> 2) * 128;
                const att::bf16* Vh = (const att::bf16*)(ws + WS_V) + (size_t)krow * 256 + (h >> 2) * 128;
                unsigned char* Ob = ws + WS_AO + (size_t)row0 * DM + h * 128;
                att::attn_dense_body<att::bf16>(Qb, Kh, Vh, Ob, seq, (char*)lds + RING_OFF, F.tid, A.in(11) + l * 128, (const float*)(ws + WS_TAB), t0, L < nheavy);
                __syncthreads();
            }
            SEAM(pb + 2);
        }
        if (ON(2 + 3) && IN(pb + 3)) for (int rep_ = 0; rep_ <= REPS(2 + 3); ++rep_) { PH_BEGIN;
            pg8::Gemm g{(const bf16*)(ws + WS_H8), (const bf16*)(wl + OFFS_WG), Mm, 3072, DM / 2}; pg8::StaticOrder S; S.init(Mm, 3072, F.G, bx);
            pg8::EpiGates E{(bf16*)(ws + WS_GATES)};
            pg8::gemm_phase<pg8::EpiGates, pg8::StaticOrder, GP_ALIGN, GP_SP2, true>(F.lds + RING_OFF, g, S, E, F.tid);
            SEAM(pb + 3);
        }
        if (ON(2 + 4) && IN(pb + 4)) for (int rep_ = 0; rep_ <= REPS(2 + 4); ++rep_) { PH_BEGIN;
            { pg8::Gemm g{(const bf16*)(ws + WS_AO), (const bf16*)(wl + OFFS_WAO), Mm, 1024, 512}; pg8::StaticOrder S; S.init(Mm, 1024, F.G, bx);
              pg8::EpiMerge<0> E{(bf16*)(ws + WS_MERGED), (bf16*)(ws + WS_ACT), (const bf16*)(ws + WS_GATES), 0, 1.0f / 512.0f};
              pg8::gemm_phase<pg8::EpiMerge<0>, pg8::StaticOrder, GP_ALIGN, GP_SP2, true>(F.lds + RING_OFF, g, S, E, F.tid); }
            { pg8::Gemm g{(const bf16*)(ws + WS_CH), (const bf16*)(wl + OFFS_WCO), Mm, 1024, 512}; pg8::StaticOrder S; S.init(Mm, 1024, F.G, bx);
              pg8::EpiMerge<1> E{(bf16*)(ws + WS_MERGED), (bf16*)(ws + WS_ACT), (const bf16*)(ws + WS_GATES), 1, 1.0f};
              pg8::gemm_phase<pg8::EpiMerge<1>, pg8::StaticOrder, GP_ALIGN, GP_SP2>(F.lds + RING_OFF, g, S, E, F.tid); }
            { pg8::Gemm g{(const bf16*)(ws + WS_Z), (const bf16*)(wl + OFFS_WFO), Mm, 1024, 512}; pg8::StaticOrder S; S.init(Mm, 1024, F.G, bx);
              pg8::EpiMerge<2> E{(bf16*)(ws + WS_MERGED), (bf16*)(ws + WS_ACT), (const bf16*)(ws + WS_GATES), 2, 1.0f};
              pg8::gemm_phase<pg8::EpiMerge<2>, pg8::StaticOrder, GP_ALIGN, GP_SP2>(F.lds + RING_OFF, g, S, E, F.tid); }
            if (l == 0 && F.G == 256 && bx >= FILL_WG0 && rep_ == 0) { __syncthreads(); F_REFRESH();
                moe_convert_range(A, 0, FILL_A, (bx - FILL_WG0) * NWAVES + F.wave, FILL_NGW, (LAS float*)(F.lds + RING_OFF + F.wave * 16384), F.lane); }
            SEAM(pb + 4);
        }
        if (ON(2 + 5) && IN(pb + 5)) for (int rep_ = 0; rep_ <= REPS(2 + 5); ++rep_) { PH_BEGIN;
            pg8::Gemm g{(const bf16*)(ws + WS_MERGED), (const bf16*)(wl + OFFS_WOUT), Mm, 1024, 1024}; pg8::StaticOrder S; S.init(Mm, 1024, F.G, bx);
            pg8::EpiBf16<0> E{(bf16*)(ws + WS_MIX), 1024, nullptr, 0, 0, 1.0f};
            pg8::gemm_phase<pg8::EpiBf16<0>, pg8::StaticOrder, GP_ALIGN, GP_SP2>(F.lds + RING_OFF, g, S, E, F.tid);
            if (l == 0 && F.G == 256 && bx >= FILL_WG0 && rep_ == 0) { __syncthreads(); F_REFRESH();
                moe_convert_range(A, FILL_A, FILL_B, (bx - FILL_WG0) * NWAVES + F.wave, FILL_NGW, (LAS float*)(F.lds + RING_OFF + F.wave * 16384), F.lane); }
            SEAM(pb + 5);
        }
        if (ON(2 + 6) && IN(pb + 6)) for (int rep_ = 0; rep_ <= REPS(2 + 6); ++rep_) { PH_BEGIN; p_rowpass1(F, A, l, Mm); p_route(F, A, l, Mm); SEAM(pb + 6); }
        if (ON(2 + 7) && IN(pb + 7)) for (int rep_ = 0; rep_ <= REPS(2 + 7); ++rep_) { PH_BEGIN; p_slots(F, A, Mm); SEAM(pb + 7); }
        if (ON(2 + 8) && IN(pb + 8)) for (int rep_ = 0; rep_ <= REPS(2 + 8); ++rep_) { PH_BEGIN;
            const int NT = __builtin_amdgcn_readfirstlane(((const int*)(ws + WS_CNT))[CNT_NT]);
            LAS int* te_lds = (LAS int*)(F.lds + LDS_SM);
            for (int i = F.tid; i < NT; i += NTHR) te_lds[i] = ((const int*)(ws + WS_CNT))[CNT_TILE_E + i];
            __syncthreads();
            pg8::Gemm g{(const bf16*)(ws + WS_H8), (const bf16*)(ws + WS_WGU + (size_t)l * MOEW_LAYER), NT * 256, NEXP * 2048, DM / 2}; pg8::GroupedOrder S; S.init(NT, 8, F.G, bx, te_lds); S.rows = (const int*)(ws + WS_CNT) + CNT_ROWSRC;
            pg8::EpiSwiGLU8 E{ws + WS_ACT, A.in(24) + (size_t)l * NEXP * 1024, A.in(26) + (size_t)l * NEXP * 1024, (LAS float*)(F.lds + LDS_SM + 4096)};
            pg8::gemm_phase<pg8::EpiSwiGLU8, pg8::GroupedOrder, GP_ALIGN, GP_SP2, true, true>(F.lds + RING_OFF, g, S, E, F.tid);
            SEAM(pb + 8);
        }
        if (ON(2 + 9) && IN(pb + 9)) for (int rep_ = 0; rep_ <= REPS(2 + 9); ++rep_) { PH_BEGIN;
            const int NT = __builtin_amdgcn_readfirstlane(((const int*)(ws + WS_CNT))[CNT_NT]);
            LAS int* te_lds = (LAS int*)(F.lds + LDS_SM);
            for (int i = F.tid; i < NT; i += NTHR) te_lds[i] = ((const int*)(ws + WS_CNT))[CNT_TILE_E + i];
            __syncthreads();
#ifdef STAGGER_US
            { const unsigned long long t0 = __builtin_amdgcn_s_memrealtime(), dl = (unsigned long long)((bx >> 3) & 3) * (STAGGER_US); while (__builtin_amdgcn_s_memrealtime() - t0 < dl) __builtin_amdgcn_s_sleep(8); }
#endif
            pg8::Gemm g{(const bf16*)(ws + WS_ACT), (const bf16*)(ws + WS_WD + (size_t)l * MOEW_LAYER), NT * 256, NEXP * 1024, DM / 2}; pg8::GroupedOrder S; S.init(NT, 4, F.G, bx, te_lds);
#ifdef PROBE_NOSTORE
            pg8::EpiDown8 E{ws + WS_YS, A.in(28) + (size_t)l * NEXP * 1024, rep_, (LAS float*)(F.lds + LDS_SM + 4096)};
#else
            pg8::EpiDown8 E{ws + WS_YS, A.in(28) + (size_t)l * NEXP * 1024, 0, (LAS float*)(F.lds + LDS_SM + 4096)};
#endif
            pg8::gemm_phase<pg8::EpiDown8, pg8::GroupedOrder, GP_ALIGN, GP_SP2, true>(F.lds + RING_OFF, g, S, E, F.tid);
            SEAM(pb + 9);
        }
        if (ON(2 + 10) && IN(pb + 10)) for (int rep_ = 0; rep_ <= REPS(2 + 10); ++rep_) { PH_BEGIN;
            p_combine(F, A, l, Mm);
            SEAM(pb + 10);
        }
    }
#ifdef STAMP_SEL
    { const AV A = av_get(); float* out = A.out(); const unsigned long long* ts = (const unsigned long long*)(F.ctl + 32768);
      auto span = [&](int p) -> float { unsigned long long d = __hip_atomic_load(ts + p + 1, __ATOMIC_RELAXED, __HIP_MEMORY_SCOPE_AGENT) - __hip_atomic_load(ts + p, __ATOMIC_RELAXED, __HIP_MEMORY_SCOPE_AGENT);
          if (p >= 2) d += __hip_atomic_load(ts + p + NPL + 1, __ATOMIC_RELAXED, __HIP_MEMORY_SCOPE_AGENT) - __hip_atomic_load(ts + p + NPL, __ATOMIC_RELAXED, __HIP_MEMORY_SCOPE_AGENT); return (float)d * 0.01f; };
      const float K1 = span((STAMP_SEL) & 0xff), K2 = 200.0f * span(((STAMP_SEL) >> 8) & 0xff);
      for (size_t i = (size_t)blockIdx.x * NTHR + threadIdx.x; i < (size_t)TL * DM; i += (size_t)gridDim.x * NTHR) out[i] = (i == 0) ? K2 : K1; }
#endif
#undef IN
#undef PH_BEGIN
#undef F_REFRESH
#undef SEAM
}

extern "C" void kernel_launch(void* const* d_in, const int* in_sizes, int n_in, void* d_out, int out_size, void* d_ws, size_t ws_size, hipStream_t stream) {
    static int grid = 0;
    if (grid == 0) {
        if (n_in != 29 || out_size != TL * DM || ws_size < WS_END2) { fprintf(stderr, "kernel_launch: built for 29 inputs, %d outputs, >= %zu bytes of workspace; got n_in %d out %d ws %zu\n", TL * DM, (size_t)WS_END2, n_in, out_size, ws_size); grid = -1; return; }
        int dev = 0, cus = 0, per_cu = 0;
        if (hipGetDevice(&dev) != hipSuccess || hipDeviceGetAttribute(&cus, hipDeviceAttributeMultiprocessorCount, dev) != hipSuccess) { grid = -1; return; }
        if (hipFuncSetAttribute((const void*)fwd, hipFuncAttributeMaxDynamicSharedMemorySize, LDS_BYTES) != hipSuccess) { fprintf(stderr, "kernel_launch: hipFuncSetAttribute failed\n"); grid = -1; return; }
        if (hipOccupancyMaxActiveBlocksPerMultiprocessor(&per_cu, (const void*)fwd, NTHR, LDS_BYTES) != hipSuccess || per_cu < 1) fprintf(stderr, "kernel_launch: occupancy query reports %d\n", per_cu);
        (void)hipGetLastError();
        grid = cus;
    }
    if (grid < 0) return;
    (void)hipMemsetAsync((char*)d_ws + WS_CTL, 0, CTL_ZERO_BYTES, stream);
    Args a{};
    for (int i = 0; i < 29; ++i) a.in[i] = (const float*)d_in[i];
    a.out = (float*)d_out; a.ws = (unsigned char*)d_ws;
#if MK_PER_PHASE
    for (int p = 0; p < NPH; ++p) {
#ifdef DBG_CHECK
        float* res = (float*)((char*)d_ws + WS_CTL + 8192 * 4); float* snap = (float*)((char*)d_ws + WS_END);
        { const int l = p >= 2 ? (p - 2) / NPL : 0, k = p >= 2 ? (p - 2) % NPL : -1;
          if (k == 6) hipLaunchKernelGGL(snap_rows, dim3(256), dim3(256), 0, stream, a, l, 11, snap);
          if (k == 12) hipLaunchKernelGGL(snap_rows, dim3(256), dim3(256), 0, stream, a, l, 17, snap); }
#endif
        a.ph_lo = p; a.ph_hi = p + 1; hipLaunchKernelGGL(fwd, dim3(grid), dim3(NTHR), LDS_BYTES, stream, a);
#ifdef DBG_CHECK
        { const int l = p >= 2 ? (p - 2) / NPL : 0, k = p >= 2 ? (p - 2) % NPL : -1;
#define CHK(st) hipLaunchKernelGGL(chk, dim3(1), dim3(256), 0, stream, a, (int)(st), l, res, snap)
          if (p == 0) CHK(ST_MOD); if (p == 1) CHK(ST_H0);
#if DBG_GSUB == 2
          if (k == 3 && l == 0) hipLaunchKernelGGL(chk_gates_full, dim3(48, TALL / 4), dim3(256), 0, stream, (const bf16*)((char*)d_ws + WS_H), (const bf16*)((char*)d_ws + WS_WSMALL + OFFS_WG), (const bf16*)((char*)d_ws + WS_GATES), TALL, (unsigned*)((char*)d_ws + WS_CTL + 65536));
#endif
          if (k == 0) { CHK(ST_INPROJ); CHK(ST_YT); } if (k == 1) { CHK(ST_QKFIX); CHK(ST_CONV); CHK(ST_Z); } if (k == 2) CHK(ST_ATTN); if (k == 3) { CHK(ST_GATES); CHK(ST_GATESB); } if (k == 4) CHK(ST_MERGED);
          if (k == 5) CHK(ST_MIX); if (k == 6) CHK(ST_ROW1); if (k == 7) CHK(ST_LOGIT); if (k == 8) CHK(ST_TOPK); if (k == 9) CHK(ST_SLOTS); if (k == 10) CHK(ST_ACT); if (k == 11) CHK(ST_YSLOT); if (k == 12) CHK(ST_COMB);
#undef CHK
        }
#endif
    }
#ifdef DBG_CHECK
#if DBG_GSUB == 2
    hipLaunchKernelGGL(encode_full, dim3(1024), dim3(256), 0, stream, (float*)d_out, (const unsigned*)((char*)d_ws + WS_CTL + 65536), out_size);
#else
    hipLaunchKernelGGL(encode, dim3(1024), dim3(256), 0, stream, (float*)d_out, (const float*)((char*)d_ws + WS_CTL + 8192 * 4), out_size, 0.25f);
#endif
#endif
#else
    a.ph_lo = 0; a.ph_hi = NPH; hipLaunchKernelGGL(fwd, dim3(grid), dim3(NTHR), LDS_BYTES, stream, a);
#endif
    const hipError_t le = hipPeekAtLastError();
    if (le != hipSuccess) fprintf(stderr, "kernel_launch: launch failed: %s\n", hipGetErrorName(le));
}
```
